# Optimizing an MI355X kernel written in HIP

```python
import math
import jax, jax.numpy as jnp
from jax import lax
import numpy as np

D_MODEL = 4096
BATCH = 1
SEQ = 16384
DEPTH = 4

CHUNK = 64
N_META = 16
N_MIXERS = 3
NORM_EPS = 1e-6
N_LAYERS_A = (DEPTH + 2) // 3
N_LAYERS_B = (DEPTH + 1) // 3
N_LAYERS_C = DEPTH // 3

A_HEAD_DIM = 128
A_HEADS = D_MODEL // A_HEAD_DIM

B_QK_DIM = 128
B_HEADS = D_MODEL // (2 * B_QK_DIM)
B_V_DIM = 2 * B_QK_DIM
ROPE_THETA = 500000.0
ROPE_DIM = B_QK_DIM // 4
Q_BLOCK = 128
SUBLN_EPS = 1e-5

C_HEAD_DIM = 64
C_HEADS = D_MODEL // C_HEAD_DIM
C_DECAY_LORA = 128
C_AAA_LORA = 128
C_DECAY_SCALE = 0.606531
LNX_EPS = 64e-5

kernel_name = 'hybrid_hgrn2_diffattn_rwkv7_trunk'

F32 = jnp.float32


def rmsnorm(x, g, eps=NORM_EPS):
    xf = x.astype(F32)
    y = xf * lax.rsqrt(jnp.mean(xf * xf, axis=-1, keepdims=True) + eps)
    return (y * g.astype(F32)).astype(x.dtype)


def chunk_id(pos):
    return jnp.where(pos < N_META, 0, 1 + (pos - N_META) // CHUNK)


def partial_rope(x, cos, sin):
    half = ROPE_DIM // 2
    x1, x2, rest = x[..., :half], x[..., half:ROPE_DIM], x[..., ROPE_DIM:]
    return jnp.concatenate([(x1 * cos - x2 * sin).astype(x.dtype),
                            (x2 * cos + x1 * sin).astype(x.dtype), rest], axis=-1)


def hgrn2_mixer(u, w_in, lb, gnorm_g, w_out):
    bsz, seqlen, d = u.shape
    q, f_logit, i_in, gate = jnp.split(u @ w_in, 4, axis=-1)
    f = lb + (1.0 - lb) * jax.nn.sigmoid(f_logit.astype(F32))
    log_f = jnp.log(f)
    k = 1.0 - f
    pad = (-seqlen) % CHUNK
    n_chunks = (seqlen + pad) // CHUNK

    def to_chunks(t):
        t = jnp.pad(t.astype(F32), ((0, 0), (pad, 0), (0, 0)))
        return t.reshape(bsz, n_chunks, CHUNK, A_HEADS, A_HEAD_DIM).transpose(1, 0, 3, 2, 4)

    qc, kc, vc, gc = (to_chunks(t) for t in (q, k, i_in, log_f))
    causal = jnp.tril(jnp.ones((CHUNK, CHUNK), dtype=bool))[:, :, None]

    def step(state, inp):
        qb, kb, vb, gb = inp
        b = jnp.cumsum(gb, axis=2)
        b_last = b[:, :, -1:, :]
        rel = jnp.where(causal, b[:, :, :, None, :] - b[:, :, None, :, :], -jnp.inf)
        scores = jnp.einsum('bhtd,bhsd,bhtsd->bhts', qb, kb, jnp.exp(rel))
        out = (jnp.einsum('bhts,bhse->bhte', scores, vb)
               + jnp.einsum('bhtd,bhde->bhte', qb * jnp.exp(b), state))
        state = (jnp.exp(b_last[:, :, 0, :, None]) * state
                 + jnp.einsum('bhsd,bhse->bhde', kb * jnp.exp(b_last - b), vb))
        return state, out

    s0 = jnp.zeros((bsz, A_HEADS, A_HEAD_DIM, A_HEAD_DIM), F32)
    _, o = lax.scan(step, s0, (qc, kc, vc, gc))
    o = o.transpose(1, 0, 3, 2, 4).reshape(bsz, n_chunks * CHUNK, A_HEADS, A_HEAD_DIM)[:, pad:]
    o = rmsnorm(o, gnorm_g).reshape(bsz, seqlen, d)
    return (o * jax.nn.silu(gate.astype(F32))).astype(u.dtype) @ w_out


def diff_attn_mixer(u, w_in, lam_q1, lam_k1, lam_q2, lam_k2, subln_g, w_out,
                    lambda_init, cos, sin, kcid):
    bsz, seqlen, d = u.shape
    q, k, v, gate = jnp.split(u @ w_in, 4, axis=-1)
    q = partial_rope(q.reshape(bsz, seqlen, B_HEADS, 2, B_QK_DIM), cos, sin)
    k = partial_rope(k.reshape(bsz, seqlen, B_HEADS, 2, B_QK_DIM), cos, sin)
    k = k.transpose(0, 2, 3, 1, 4)
    v = v.reshape(bsz, seqlen, B_HEADS, B_V_DIM).transpose(0, 2, 1, 3)
    lam = (jnp.exp(jnp.dot(lam_q1.astype(F32), lam_k1.astype(F32)))
           - jnp.exp(jnp.dot(lam_q2.astype(F32), lam_k2.astype(F32))) + lambda_init)
    n_blocks = -(-seqlen // Q_BLOCK)
    q_len = n_blocks * Q_BLOCK
    q = jnp.pad(q, ((0, 0), (0, q_len - seqlen), (0, 0), (0, 0), (0, 0)))
    q = q.reshape(bsz, n_blocks, Q_BLOCK, B_HEADS, 2, B_QK_DIM).transpose(1, 0, 3, 4, 2, 5)
    qcid = chunk_id(jnp.arange(q_len)).reshape(n_blocks, Q_BLOCK)
    scale = B_QK_DIM ** -0.5

    def attend(args):
        qb, qc = args
        s = jnp.einsum('bhcqd,bhckd->bhcqk', qb, k).astype(F32) * scale
        s = jnp.where(kcid[None, :] <= qc[:, None], s, -jnp.inf)
        p = jax.nn.softmax(s, axis=-1)
        a = p[:, :, 0] - lam * p[:, :, 1]
        return jnp.einsum('bhqk,bhke->bhqe', a.astype(v.dtype), v)

    o = lax.map(attend, (q, qcid))
    o = o.transpose(1, 0, 3, 2, 4).reshape(bsz, q_len, B_HEADS, B_V_DIM)[:, :seqlen]
    o = (rmsnorm(o, subln_g, SUBLN_EPS) * (1.0 - lambda_init)).reshape(bsz, seqlen, d)
    return (o * jax.nn.silu(gate)).astype(u.dtype) @ w_out


def rwkv7_mixer(u, mu, w_in, w0, w1, w2, a0, a1, a2, k_k, k_a, r_k, lnx_w, lnx_b, w_out):
    bsz, seqlen, d = u.shape
    delta = jnp.pad(u, ((0, 0), (1, 0), (0, 0)))[:, :-1] - u

    def mixed(s):
        return u + delta * mu[s]

    r, k, v, gate = (mixed(s) @ w_in[:, s * d:(s + 1) * d] for s in range(4))
    decay = jnp.exp(-C_DECAY_SCALE * jax.nn.sigmoid((w0 + jnp.tanh(mixed(4) @ w1) @ w2).astype(F32)))
    a = jax.nn.sigmoid((a0 + (mixed(5) @ a1) @ a2).astype(F32))

    def heads(t):
        return t.astype(F32).reshape(bsz, seqlen, C_HEADS, C_HEAD_DIM)

    r, k, v, decay, a = (heads(t) for t in (r, k, v, decay, a))
    kk = k * k_k.astype(F32).reshape(C_HEADS, C_HEAD_DIM)
    kk = kk / jnp.maximum(jnp.sqrt(jnp.sum(kk * kk, axis=-1, keepdims=True)), 1e-12)
    k = k * (1.0 + (a - 1.0) * k_a.astype(F32).reshape(C_HEADS, C_HEAD_DIM))

    def step(state, inp):
        r_t, w_t, k_t, v_t, kk_t, a_t = inp
        sa = jnp.einsum('bhij,bhj->bhi', state, -kk_t)
        state = (state * w_t[:, :, None, :] + sa[..., None] * (kk_t * a_t)[:, :, None, :]
                 + v_t[..., None] * k_t[:, :, None, :])
        return state, jnp.einsum('bhij,bhj->bhi', state, r_t)

    def seq_first(t):
        return t.transpose(1, 0, 2, 3)

    s0 = jnp.zeros((bsz, C_HEADS, C_HEAD_DIM, C_HEAD_DIM), F32)
    _, o = lax.scan(step, s0, tuple(seq_first(t) for t in (r, decay, k, v, kk, a)))
    o = seq_first(o)
    mean = jnp.mean(o, axis=-1, keepdims=True)
    var = jnp.mean(jnp.square(o - mean), axis=-1, keepdims=True)
    o = ((o - mean) * lax.rsqrt(var + LNX_EPS)).reshape(bsz, seqlen, d) * lnx_w.astype(F32) + lnx_b.astype(F32)
    bonus = jnp.sum(r * k * r_k.astype(F32), axis=-1, keepdims=True) * v
    o = o + bonus.reshape(bsz, seqlen, d)
    return (o * jax.nn.silu(gate.astype(F32))).astype(u.dtype) @ w_out


def setup_inputs(seed: int = 0) -> dict:
    key = jax.random.key(seed)
    ks = iter(jax.random.split(key, 32))
    d = D_MODEL
    s = d ** -0.5

    def nrm(shape, scale):
        return jax.random.normal(next(ks), shape, F32) * scale

    inp = {}
    inp['x'] = nrm((BATCH, SEQ, d), 1.0)
    inp['meta_tokens'] = nrm((N_META, d), 1.0)
    inp['pre_norm_g'] = 1.0 + nrm((DEPTH, d), 0.02)
    inp['post_norm_g'] = 1.0 + nrm((DEPTH, d), 0.02)
    inp['a_w_in'] = nrm((N_LAYERS_A, d, 4 * d), s)
    inp['a_lb_logits'] = nrm((N_LAYERS_A, d), 0.5)
    inp['a_gnorm_g'] = 1.0 + nrm((N_LAYERS_A, A_HEAD_DIM), 0.02)
    inp['a_w_out'] = nrm((N_LAYERS_A, d, d), s)
    inp['b_w_in'] = nrm((N_LAYERS_B, d, 4 * d), s)
    inp['b_lam_q1'] = nrm((N_LAYERS_B, B_QK_DIM), 0.1)
    inp['b_lam_k1'] = nrm((N_LAYERS_B, B_QK_DIM), 0.1)
    inp['b_lam_q2'] = nrm((N_LAYERS_B, B_QK_DIM), 0.1)
    inp['b_lam_k2'] = nrm((N_LAYERS_B, B_QK_DIM), 0.1)
    inp['b_subln_g'] = 1.0 + nrm((N_LAYERS_B, B_V_DIM), 0.02)
    inp['b_w_out'] = nrm((N_LAYERS_B, d, d), s)
    inp['c_mu'] = jax.random.uniform(next(ks), (N_LAYERS_C, 6, d), F32)
    inp['c_w_in'] = nrm((N_LAYERS_C, d, 4 * d), s)
    inp['c_w0'] = nrm((N_LAYERS_C, d), 1.0)
    inp['c_w1'] = nrm((N_LAYERS_C, d, C_DECAY_LORA), s)
    inp['c_w2'] = nrm((N_LAYERS_C, C_DECAY_LORA, d), 0.1 * C_DECAY_LORA ** -0.5)
    inp['c_a0'] = nrm((N_LAYERS_C, d), 0.1)
    inp['c_a1'] = nrm((N_LAYERS_C, d, C_AAA_LORA), s)
    inp['c_a2'] = nrm((N_LAYERS_C, C_AAA_LORA, d), 0.1 * C_AAA_LORA ** -0.5)
    inp['c_k_k'] = 0.85 + nrm((N_LAYERS_C, d), 0.02)
    inp['c_k_a'] = 1.0 + nrm((N_LAYERS_C, d), 0.02)
    inp['c_r_k'] = nrm((N_LAYERS_C, C_HEADS, C_HEAD_DIM), 0.1)
    inp['c_lnx_w'] = 1.0 + nrm((N_LAYERS_C, d), 0.02)
    inp['c_lnx_b'] = nrm((N_LAYERS_C, d), 0.02)
    inp['c_w_out'] = nrm((N_LAYERS_C, d, d), s)
    return inp


def reference(x, meta_tokens, pre_norm_g, post_norm_g,
              a_w_in, a_lb_logits, a_gnorm_g, a_w_out,
              b_w_in, b_lam_q1, b_lam_k1, b_lam_q2, b_lam_k2, b_subln_g, b_w_out,
              c_mu, c_w_in, c_w0, c_w1, c_w2, c_a0, c_a1, c_a2, c_k_k, c_k_a, c_r_k,
              c_lnx_w, c_lnx_b, c_w_out):
    bsz = x.shape[0]
    meta = jnp.broadcast_to(meta_tokens.astype(x.dtype)[None], (bsz, N_META, D_MODEL))
    h = jnp.concatenate([meta, x], axis=1)
    seqlen = h.shape[1]
    pos = jnp.arange(seqlen)
    kcid = chunk_id(pos)
    inv_freq = ROPE_THETA ** (-jnp.arange(0, ROPE_DIM, 2, dtype=F32) / ROPE_DIM)
    ang = pos.astype(F32)[:, None] * inv_freq[None, :]
    cos = jnp.cos(ang)[:, None, None, :]
    sin = jnp.sin(ang)[:, None, None, :]
    lb_p = jax.nn.softmax(a_lb_logits.astype(F32), axis=0)
    lb_all = jnp.cumsum(lb_p, axis=0) - lb_p[0]

    for i in range(DEPTH):
        kind, j = i % N_MIXERS, i // N_MIXERS
        u = rmsnorm(h, pre_norm_g[i])
        if kind == 0:
            y = hgrn2_mixer(u, a_w_in[j], lb_all[j], a_gnorm_g[j], a_w_out[j])
        elif kind == 1:
            lambda_init = 0.8 - 0.6 * math.exp(-0.3 * i)
            y = diff_attn_mixer(u, b_w_in[j], b_lam_q1[j], b_lam_k1[j], b_lam_q2[j], b_lam_k2[j],
                                b_subln_g[j], b_w_out[j], lambda_init, cos, sin, kcid)
        else:
            y = rwkv7_mixer(u, c_mu[j], c_w_in[j], c_w0[j], c_w1[j], c_w2[j], c_a0[j], c_a1[j], c_a2[j],
                            c_k_k[j], c_k_a[j], c_r_k[j], c_lnx_w[j], c_lnx_b[j], c_w_out[j])
        h = h + rmsnorm(y, post_norm_g[i])

    return h[:, N_META:]
```

```cpp
#include <hip/hip_runtime.h>
#include <cstdio>
#include <cstdint>

#define LAS __attribute__((address_space(3)))
#define GAS __attribute__((address_space(1)))
typedef unsigned short bf16_t;
typedef short bf16x8 __attribute__((ext_vector_type(8)));
typedef short s16x4 __attribute__((ext_vector_type(4)));
typedef float f32x4 __attribute__((ext_vector_type(4)));
typedef float f32x16 __attribute__((ext_vector_type(16)));
typedef unsigned u32x4 __attribute__((ext_vector_type(4)));
typedef unsigned u32x2 __attribute__((ext_vector_type(2)));

namespace mk {
constexpr int D = 4096, NPAD = 48, NREAL = 16448, R = 16640, NCH = 257;
constexpr size_t MiB = 1u << 20;
constexpr size_t SLOT = (size_t)R * D * 2;
constexpr size_t WS_CTL = 0, CTL_BYTES = 1 * MiB;
constexpr size_t WS_WTIN = 2 * MiB;
constexpr size_t WS_WTOUT = 134 * MiB;
constexpr size_t WS_W2P = 166 * MiB;
constexpr size_t WS_ROPE = 170 * MiB;
constexpr size_t WS_HMETA = 174 * MiB;
constexpr size_t WS_HE = 175 * MiB;
constexpr size_t WS_HLOGD = 191 * MiB;
constexpr size_t WS_U = 192 * MiB;
constexpr size_t WS_Y = WS_U + 6 * SLOT;
constexpr size_t WS_T = WS_Y + 6 * SLOT;
constexpr size_t WS_END = WS_T + (size_t)R * 256 * 2;
static_assert(WS_END <= 2040 * MiB, "d_ws map");

__device__ __forceinline__ unsigned cvt_pk_bf16(float lo, float hi) { unsigned r; asm volatile("v_cvt_pk_bf16_f32 %0, %1, %2" : "=v"(r) : "v"(lo), "v"(hi)); return r; }
__device__ __forceinline__ float bflo(unsigned w) { return __uint_as_float(w << 16); }
__device__ __forceinline__ float bfhi(unsigned w) { return __uint_as_float(w & 0xffff0000u); }
__device__ __forceinline__ float bf2f(bf16_t b) { return __uint_as_float(((unsigned)b) << 16); }
__device__ __forceinline__ bf16_t f2bf(float f) { return (bf16_t)(cvt_pk_bf16(f, f) & 0xffffu); }
__device__ __forceinline__ float sigmoid_f(float x) { return 1.f / (1.f + __expf(-x)); }
__device__ __forceinline__ float silu_f(float x) { return x / (1.f + __expf(-x)); }
__device__ __forceinline__ float wave_sum(float v) {
#pragma unroll
    for (int o = 1; o < 64; o <<= 1) v += __shfl_xor(v, o);
    return v;
}
template <int CTRL> __device__ __forceinline__ float dppf(float v) { return __int_as_float(__builtin_amdgcn_update_dpp(0, __float_as_int(v), CTRL, 0xf, 0xf, true)); }
__device__ __forceinline__ float red4(float v) { v += dppf<0xB1>(v); v += dppf<0x4E>(v); return v; }
__device__ __forceinline__ float red8(float v) { v = red4(v); v += dppf<0x141>(v); return v; }
__device__ __forceinline__ float red16(float v) { v = red8(v); v += dppf<0x140>(v); return v; }
#define LDS_WAIT() asm volatile("s_waitcnt lgkmcnt(0)" ::: "memory")
}
#define XB_TMO      128
#define XB_XCNT(j)  (256  + 64 * (j))
#define XB_XSUB(j)  (1280 + 64 * (j))
#define XB_XGEN(j)  (2304 + 64 * (j))
#define XB_TOP      3328
#define XB_TOPGEN   3392
#define XCD_BAR_WORDS 3456
#define XB_SPIN_CAP (1u << 18)
#define LAS __attribute__((address_space(3)))

__device__ __forceinline__ unsigned xb_ld(unsigned* p)              { return __hip_atomic_load(p, __ATOMIC_RELAXED, __HIP_MEMORY_SCOPE_AGENT); }
__device__ __forceinline__ unsigned xb_add(unsigned* p, unsigned v) { return __hip_atomic_fetch_add(p, v, __ATOMIC_RELAXED, __HIP_MEMORY_SCOPE_AGENT); }
__device__ __forceinline__ unsigned xb_xcc_id() { return (unsigned)__builtin_amdgcn_s_getreg((3 << 11) | 20) & 0xFu; }
#define XB_SPIN(cond, bar) do { unsigned _sp = 0; while (cond) { __builtin_amdgcn_s_sleep(1); \
    if ((++_sp & 255u) == 0u) { if (xb_ld(&(bar)[XB_TMO])) break; if (_sp > XB_SPIN_CAP) { atomicAdd(&(bar)[XB_TMO], 1u); break; } } } } while (0)

struct XcdBarrier {
    unsigned* bar; unsigned x;
    volatile LAS unsigned* st;
};

__device__ __forceinline__ XcdBarrier xcd_barrier_post(unsigned* bar, volatile LAS unsigned* st) {
    XcdBarrier b; b.bar = bar; b.x = xb_xcc_id(); b.st = st;
    if (threadIdx.x == 0) (void)xb_add(&bar[XB_XCNT(b.x)], 1u);
    return b;
}
__device__ __forceinline__ void xcd_barrier_complete(unsigned* bar, unsigned x, unsigned& nloc, unsigned& nx) {
    const unsigned G = gridDim.x * gridDim.y * gridDim.z;
    unsigned sum, cnt, mine, sp = 0u;
    for (;;) {
        sum = 0u; cnt = 0u; mine = 0u;
#pragma unroll
        for (unsigned j = 0; j < 16; ++j) { const unsigned c = xb_ld(&bar[XB_XCNT(j)]); sum += c; cnt += (c > 0u) ? 1u : 0u; mine = (j == x) ? c : mine; }
        if (sum == G) break;
        __builtin_amdgcn_s_sleep(1);
        if ((++sp & 255u) == 0u) { if (xb_ld(&bar[XB_TMO])) break; if (sp > XB_SPIN_CAP) { atomicAdd(&bar[XB_TMO], 1u); break; } }
    }
    nloc = mine > 0u ? mine : 1u; nx = cnt > 0u ? cnt : 1u;
}

__device__ __forceinline__ void xcd_barrier(const XcdBarrier& b) {
    asm volatile("s_waitcnt vmcnt(0)" ::: "memory");
    __syncthreads();
    if (threadIdx.x == 0) {
        unsigned* bar = b.bar;
        __builtin_amdgcn_s_waitcnt(0);
        unsigned nloc = b.st[0], nx = b.st[1];
        if (nloc == 0u) { xcd_barrier_complete(bar, b.x, nloc, nx); b.st[0] = nloc; b.st[1] = nx; }
        const unsigned old = xb_add(&bar[XB_XSUB(b.x)], 1u);
        const unsigned gen = old / nloc;
        if (old + 1u == (gen + 1u) * nloc) {
            __builtin_amdgcn_fence(__ATOMIC_RELEASE, "agent");
            asm volatile("s_waitcnt vmcnt(0)" ::: "memory");
            const unsigned og = xb_add(&bar[XB_TOP], 1u);
            const unsigned tg = og / nx;
            if (og + 1u == (tg + 1u) * nx) xb_add(&bar[XB_TOPGEN], 1u);
            else XB_SPIN(xb_ld(&bar[XB_TOPGEN]) == tg, bar);
            __builtin_amdgcn_fence(__ATOMIC_ACQUIRE, "agent");
            xb_add(&bar[XB_XGEN(b.x)], 1u);
            asm volatile("s_waitcnt vmcnt(0)" ::: "memory");
        } else {
            XB_SPIN(xb_ld(&bar[XB_XGEN(b.x)]) == gen, bar);
            __builtin_amdgcn_fence(__ATOMIC_ACQUIRE, "agent");
            asm volatile("s_waitcnt vmcnt(0)" ::: "memory");
        }
    }
    __syncthreads();
}
namespace pg8 {
#define PG8_LAS __attribute__((address_space(3)))
typedef unsigned short bf16_t;
typedef short bf16x8 __attribute__((ext_vector_type(8)));
typedef float f32x4 __attribute__((ext_vector_type(4)));
typedef unsigned u32x4 __attribute__((ext_vector_type(4)));
constexpr int BM = 256, BK = 64, HALF = 128, HTB = HALF * BK * 2  , STAGE_BYTES = 8 * HTB, NXCD = 8, WGM = 8;

__host__ __device__ __forceinline__ int lds_byte(int r, int c) { const int st = (r >> 4) * 2 + (c >> 5), rr = r & 15, cc = c & 31, ob = rr * 64 + cc * 2; return st * 1024 + (ob ^ (((ob >> 9) & 1) << 5)); }
__host__ __device__ __forceinline__ void stage_rc(int b, int& R, int& C) { const int st = b / 1024, sb = b % 1024, swz = sb ^ (((sb >> 9) & 1) << 5); R = (st >> 1) * 16 + swz / 64; C = (st & 1) * 32 + (swz % 64) / 2; }
__host__ __device__ __forceinline__ int perm32(int rho) { const int n = rho >> 4, i = rho & 15; return 8 * (i >> 2) + 4 * n + (i & 3); }

struct Unit { int pm, pn; };
struct Gemm { const bf16_t* A; const bf16_t* Bt; int M, N, K; size_t aps; };
__device__ __forceinline__ size_t a_part_bytes(const Gemm& g, int pn) { return g.aps ? (size_t)(pn < 64 ? (pn >> 4) : (pn - 60)) * g.aps * 2 : (size_t)0; }

struct StaticOrder {
    int nM, nN, nwg, G, c;
    __host__ __device__ void init(int M, int N, int G_, int c_) { nM = M / BM; nN = N / BM; nwg = nM * nN; G = G_; c = c_; }
    __host__ __device__ bool next(int i, Unit& u) const {
        const long L = (long)i * G + c; if (L >= nwg) return false;
        int wgid = (int)L; { const int q = nwg / NXCD, r = nwg % NXCD, xcd = wgid % NXCD, off = wgid / NXCD; wgid = (xcd < r ? xcd * (q + 1) : r * (q + 1) + (xcd - r) * q) + off; }
        const int nig = WGM * nN, gid = wgid / nig, fm = gid * WGM, gsz = (nM - fm) < WGM ? (nM - fm) : WGM;
        u.pm = fm + ((wgid % nig) % gsz); u.pn = (wgid % nig) / gsz; return true;
    }
    __device__ __forceinline__ void a_ready(const Unit&) const {}
    __device__ __forceinline__ void done(const Unit&) const {}
};
struct CountedOrder : StaticOrder {
    const unsigned* ready; unsigned need; unsigned* tmo;
    __device__ __forceinline__ void a_ready(const Unit& u) const {
        if (threadIdx.x < 64) {
            const unsigned long long t0 = __builtin_amdgcn_s_memrealtime(); unsigned polls = 0;
            while ((unsigned)__builtin_amdgcn_readfirstlane(__hip_atomic_load(ready + 64 * u.pm, __ATOMIC_RELAXED, __HIP_MEMORY_SCOPE_AGENT)) < need) {
                if ((++polls & 255u) == 0u && __builtin_amdgcn_readfirstlane(__hip_atomic_load(tmo, __ATOMIC_RELAXED, __HIP_MEMORY_SCOPE_AGENT)) != 0u) break;
                if (__builtin_amdgcn_s_memrealtime() - t0 > 2000000ull) {
                    if (threadIdx.x == 0) { unsigned expect = 0u; __hip_atomic_compare_exchange_strong(tmo + 1, &expect, 0x600u | (unsigned)(u.pm & 0xff), __ATOMIC_RELAXED, __ATOMIC_RELAXED, __HIP_MEMORY_SCOPE_AGENT); __hip_atomic_store(tmo, 1u, __ATOMIC_RELAXED, __HIP_MEMORY_SCOPE_AGENT); }
                    break; }
                __builtin_amdgcn_s_sleep(2); }
            __builtin_amdgcn_fence(__ATOMIC_ACQUIRE, "agent");
            asm volatile("s_waitcnt vmcnt(0)" ::: "memory");
        }
#if !defined(BROKEN_HOOK_NO_BARRIER)
        asm volatile("" ::: "memory"); __builtin_amdgcn_s_barrier(); asm volatile("" ::: "memory");
#endif
    }
};
template <class Epi, class Sched, bool STAMP = false>
__device__ __forceinline__ void gemm_phase(PG8_LAS unsigned char* lds, const Gemm g, const Sched& S, const Epi& E, unsigned long long* stamps) {
    int tid_ = threadIdx.x; asm volatile("" : "+v"(tid_));
    const int tid = tid_, wid = __builtin_amdgcn_readfirstlane(tid >> 6), lane = tid & 63, wr = wid >> 2, wc = wid & 3, fr = lane & 15, fq = lane >> 4;
    const int K = g.K, nt = K / BK;
    int ts_lo = 0, ts_hi = 0, nts = 0; const unsigned long long rt_entry = STAMP ? (unsigned long long)wall_clock64() : 0ull;
#define PG8_STAMP() do { if (STAMP && wid == 0 && nts < 64) { const unsigned long long _c = (unsigned long long)clock64(); \
        ts_lo = (lane == nts) ? (int)(unsigned)_c : ts_lo; ts_hi = (lane == nts) ? (int)(unsigned)(_c >> 32) : ts_hi; ++nts; } } while (0)
    PG8_STAMP();
    unsigned voffA[2], voffB[2];
#pragma unroll
    for (int i = 0; i < 2; ++i) { int R, C; stage_rc(tid * 16 + i * 8192, R, C); const int Rb = Epi::PERM ? ((R & ~31) + perm32(R & 31)) : R;
        voffA[i] = (unsigned)(R * K + C) * 2u; voffB[i] = (unsigned)(Rb * K + C) * 2u; }
    const size_t kstep = (size_t)(BK * 2);
    const size_t hstep = (size_t)HALF * K * 2;
    const size_t tstep = 2 * hstep;
    const unsigned ldsw = (unsigned)wid * 1024u;
    const int aoff = lds_byte(wr * 64 + fr, fq * 8), boff = lds_byte(wc * 32 + fr, fq * 8);
#define PG8_SA(b, h) (((b) * 2 + (h)) * HTB)
#define PG8_SB(b, h) ((4 + (b) * 2 + (h)) * HTB)
#define PG8_STAGE(bufoff, gbase, voff) do { _Pragma("unroll") for (int _i = 0; _i < 2; ++_i) \
        __builtin_amdgcn_global_load_lds((const unsigned*)((const char*)(gbase) + (voff)[_i]), (PG8_LAS unsigned*)(lds + (bufoff) + ldsw + _i * 8192), 16, 0, 0); } while (0)
#define PG8_LDA(dst, b, h) do { _Pragma("unroll") for (int m = 0; m < 4; ++m) _Pragma("unroll") for (int k = 0; k < 2; ++k) dst[m][k] = *(const PG8_LAS bf16x8*)(lds + PG8_SA(b, h) + aoff + m * 2048 + k * 1024); } while (0)
#define PG8_LDB(dst, b, h) do { _Pragma("unroll") for (int n = 0; n < 2; ++n) _Pragma("unroll") for (int k = 0; k < 2; ++k) dst[n][k] = *(const PG8_LAS bf16x8*)(lds + PG8_SB(b, h) + boff + n * 2048 + k * 1024); } while (0)
#define PG8_MMA(ai, bj, At, Bt) do { __builtin_amdgcn_s_setprio(1); _Pragma("unroll") for (int m = 0; m < 4; ++m) _Pragma("unroll") for (int n = 0; n < 2; ++n) _Pragma("unroll") for (int k = 0; k < 2; ++k) \
        acc[ai][bj][m][n] = __builtin_amdgcn_mfma_f32_16x16x32_bf16(Bt[n][k], At[m][k], acc[ai][bj][m][n], 0, 0, 0); __builtin_amdgcn_s_setprio(0); } while (0)
#define PG8_WAIT_V(n) asm volatile("s_waitcnt vmcnt(" #n ")" ::: "memory")
#define PG8_WAIT_L(n) asm volatile("s_waitcnt lgkmcnt(" #n ")" ::: "memory")
#define PG8_BAR __builtin_amdgcn_s_barrier()
#define PG8_SCHED __builtin_amdgcn_sched_barrier(0)
    Unit cur, nxt; int ui = 0;
    if (!S.next(0, cur)) return;
    f32x4 acc[2][2][4][2];
#pragma unroll
    for (int a = 0; a < 2; ++a)
#pragma unroll
        for (int b = 0; b < 2; ++b)
#pragma unroll
            for (int m = 0; m < 4; ++m)
#pragma unroll
                for (int n = 0; n < 2; ++n) acc[a][b][m][n] = (f32x4){0.f, 0.f, 0.f, 0.f};
    bf16x8 At[4][2], B0[2][2], B1[2][2];
    const char* cA = (const char*)g.A + a_part_bytes(g, cur.pn) + (size_t)cur.pm * tstep; const char* cB = (const char*)g.Bt + (size_t)cur.pn * tstep;
    S.a_ready(cur);
    PG8_STAGE(PG8_SB(0, 0), cB, voffB); PG8_STAGE(PG8_SA(0, 0), cA, voffA); PG8_STAGE(PG8_SB(0, 1), cB + hstep, voffB); PG8_STAGE(PG8_SA(0, 1), cA + hstep, voffA);
    if (wr == 1) PG8_BAR;
    PG8_WAIT_V(4); PG8_BAR;
    PG8_STAGE(PG8_SB(1, 0), cB + kstep, voffB); PG8_STAGE(PG8_SA(1, 0), cA + kstep, voffA); PG8_STAGE(PG8_SB(1, 1), cB + hstep + kstep, voffB);
    PG8_WAIT_V(6); PG8_BAR;
    PG8_STAMP();
    for (;;) {
        const bool has_next = S.next(ui + 1, nxt);
        const char* nA = has_next ? (const char*)g.A + a_part_bytes(g, nxt.pn) + (size_t)nxt.pm * tstep : cA; const char* nB = has_next ? (const char*)g.Bt + (size_t)nxt.pn * tstep : cB;
        for (int t = 0; t < nt; t += 2) {
            const bool last = (t == nt - 2);
            const char* a1 = cA + (size_t)(t + 1) * kstep;
            const char* a2 = last ? nA : cA + (size_t)(t + 2) * kstep; const char* b2 = last ? nB : cB + (size_t)(t + 2) * kstep;
            const char* a3 = a2 + kstep; const char* b3 = b2 + kstep;
            if (last && has_next) S.a_ready(nxt);
            PG8_LDB(B0, 0, 0); PG8_SCHED; PG8_LDA(At, 0, 0); PG8_STAGE(PG8_SA(1, 1), a1 + hstep, voffA);
            PG8_WAIT_L(8); PG8_BAR; PG8_WAIT_L(0); PG8_MMA(0, 0, At, B0); PG8_BAR; PG8_SCHED;
            PG8_LDB(B1, 0, 1); PG8_STAGE(PG8_SB(0, 0), b2, voffB);
            PG8_BAR; PG8_WAIT_L(0); PG8_MMA(0, 1, At, B1); PG8_BAR;
            PG8_LDA(At, 0, 1); PG8_STAGE(PG8_SA(0, 0), a2, voffA);
            PG8_BAR; PG8_WAIT_L(0); PG8_MMA(1, 0, At, B0); PG8_BAR; PG8_SCHED;
            PG8_STAGE(PG8_SB(0, 1), b2 + hstep, voffB);
            PG8_WAIT_V(6); PG8_BAR; PG8_MMA(1, 1, At, B1); PG8_BAR;
            PG8_LDB(B0, 1, 0); PG8_SCHED; PG8_LDA(At, 1, 0); PG8_STAGE(PG8_SA(0, 1), a2 + hstep, voffA);
            PG8_WAIT_L(8); PG8_BAR; PG8_WAIT_L(0); PG8_MMA(0, 0, At, B0); PG8_BAR; PG8_SCHED;
            PG8_LDB(B1, 1, 1); PG8_STAGE(PG8_SB(1, 0), b3, voffB);
            PG8_BAR; PG8_WAIT_L(0); PG8_MMA(0, 1, At, B1); PG8_BAR;
            PG8_LDA(At, 1, 1); PG8_STAGE(PG8_SA(1, 0), a3, voffA);
            PG8_BAR; PG8_WAIT_L(0); PG8_MMA(1, 0, At, B0); PG8_BAR; PG8_SCHED;
            PG8_STAGE(PG8_SB(1, 1), b3 + hstep, voffB);
            PG8_WAIT_V(6); PG8_BAR; PG8_MMA(1, 1, At, B1); PG8_BAR;
        }
        PG8_STAMP();
        if constexpr (!Epi::AFTER_DRAIN) { E(acc, cur, wr, wc, fr, fq); S.done(cur); }
        PG8_STAMP();
        if (!has_next) break;
#pragma unroll
        for (int a = 0; a < 2; ++a)
#pragma unroll
            for (int b = 0; b < 2; ++b)
#pragma unroll
                for (int m = 0; m < 4; ++m)
#pragma unroll
                    for (int n = 0; n < 2; ++n) acc[a][b][m][n] = (f32x4){0.f, 0.f, 0.f, 0.f};
        cur = nxt; cA = nA; cB = nB; ++ui;
    }
    PG8_WAIT_V(0);
    if (wr == 0) PG8_BAR;
    PG8_BAR;
    if constexpr (Epi::AFTER_DRAIN) { E.fused(acc, cur, wr, wc, fr, fq, lds, wid, lane); S.done(cur); }
    PG8_STAMP();
    if (STAMP && wid == 0) { stamps[lane] = lane < nts ? (((unsigned long long)(unsigned)ts_hi << 32) | (unsigned)ts_lo) : 0ull;
        if (lane == 62) stamps[62] = rt_entry; if (lane == 63) stamps[63] = (unsigned long long)wall_clock64(); }
#undef PG8_STAMP
#undef PG8_SA
#undef PG8_SB
#undef PG8_STAGE
#undef PG8_LDA
#undef PG8_LDB
#undef PG8_MMA
#undef PG8_WAIT_V
#undef PG8_WAIT_L
#undef PG8_BAR
#undef PG8_SCHED
}
}
namespace mk {
typedef pg8::Unit Unit;
typedef const pg8::f32x4 (&AccRef)[2][2][4][2];

__device__ __forceinline__ void st_bf8(bf16_t* p, pg8::f32x4 v0, pg8::f32x4 v1) {
    u32x4 w; w.x = cvt_pk_bf16(v0[0], v0[1]); w.y = cvt_pk_bf16(v0[2], v0[3]); w.z = cvt_pk_bf16(v1[0], v1[1]); w.w = cvt_pk_bf16(v1[2], v1[3]);
    *(u32x4*)p = w;
}
__device__ __forceinline__ void st_bf4(bf16_t* p, pg8::f32x4 v) { u32x2 w; w.x = cvt_pk_bf16(v[0], v[1]); w.y = cvt_pk_bf16(v[2], v[3]); *(u32x2*)p = w; }

struct EpiY {
    static constexpr bool PERM = true, AFTER_DRAIN = false;
    bf16_t* O;
    __device__ __forceinline__ void operator()(AccRef acc, const Unit& u, int wr, int wc, int fr, int fq) const {
        const int row0 = u.pm * 256 + wr * 64 + fr, col0 = u.pn * 256 + wc * 32 + 8 * fq;
#pragma unroll
        for (int ai = 0; ai < 2; ++ai)
#pragma unroll
            for (int m = 0; m < 4; ++m) { bf16_t* rowp = O + (size_t)(row0 + ai * 128 + m * 16) * D + col0;
#pragma unroll
                for (int bj = 0; bj < 2; ++bj) st_bf8(rowp + bj * 128, acc[ai][bj][m][0], acc[ai][bj][m][1]); }
    }
};
struct EpiH1 {
    static constexpr bool PERM = true, AFTER_DRAIN = false;
    bf16_t* Y; const float* lbl; int jl;
    __device__ __forceinline__ void operator()(AccRef acc, const Unit& u, int wr, int wc, int fr, int fq) const {
        const int part = u.pn >> 4, colt = (u.pn & 15) * 256;
        const int row0 = u.pm * 256 + wr * 64 + fr, col0 = colt + wc * 32 + 8 * fq;
        if (part == 1) {
#pragma unroll
            for (int bj = 0; bj < 2; ++bj) {
                pg8::f32x4 lbv[2] = {{0.f, 0.f, 0.f, 0.f}, {0.f, 0.f, 0.f, 0.f}};
                if (jl) {
#pragma unroll
                    for (int n = 0; n < 2; ++n) { const pg8::f32x4 l0 = *(const pg8::f32x4*)(lbl + col0 + bj * 128 + 4 * n), l1 = *(const pg8::f32x4*)(lbl + D + col0 + bj * 128 + 4 * n);
#pragma unroll
                        for (int j = 0; j < 4; ++j) lbv[n][j] = sigmoid_f(l1[j] - l0[j]); }
                }
#pragma unroll
                for (int ai = 0; ai < 2; ++ai)
#pragma unroll
                    for (int m = 0; m < 4; ++m) {
                        const int row = row0 + ai * 128 + m * 16;
                        pg8::f32x4 o[2];
#pragma unroll
                        for (int n = 0; n < 2; ++n)
#pragma unroll
                            for (int j = 0; j < 4; ++j) {
                                const float x = acc[ai][bj][m][n][j]; float g;
                                if (jl) { const float l = lbv[n][j]; g = __logf(l + (1.f - l) * sigmoid_f(x)); }
                                else g = fminf(x, 0.f) - __logf(1.f + __expf(-fabsf(x)));
                                o[n][j] = (row < NPAD) ? 0.f : g;
                            }
                        float* gp = (float*)(Y + 3 * (SLOT / 2)) + (size_t)row * D + col0 + bj * 128;
                        *(pg8::f32x4*)gp = o[0]; *(pg8::f32x4*)(gp + 4) = o[1];
                    }
            }
        } else {
            bf16_t* dst = Y + (size_t)(part == 0 ? 0 : (part == 2 ? 1 : 2)) * (SLOT / 2);
#pragma unroll
            for (int ai = 0; ai < 2; ++ai)
#pragma unroll
                for (int m = 0; m < 4; ++m) { bf16_t* rowp = dst + (size_t)(row0 + ai * 128 + m * 16) * D + col0;
#pragma unroll
                    for (int bj = 0; bj < 2; ++bj) st_bf8(rowp + bj * 128, acc[ai][bj][m][0], acc[ai][bj][m][1]); }
        }
    }
};
struct EpiB1 {
    static constexpr bool PERM = false, AFTER_DRAIN = false;
    bf16_t* Y; const float* cs; const float* sn;
    __device__ __forceinline__ void operator()(AccRef acc, const Unit& u, int wr, int wc, int fr, int fq) const {
        const int part = u.pn >> 4, colt = (u.pn & 15) * 256;
        const int row0 = u.pm * 256 + wr * 64 + fr, col0 = colt + wc * 32 + 4 * fq;
        bf16_t* dst = Y + (size_t)part * (SLOT / 2);
        const bool rope = (part < 2) && (wc == 0);
#pragma unroll
        for (int ai = 0; ai < 2; ++ai)
#pragma unroll
            for (int m = 0; m < 4; ++m) {
                const int row = row0 + ai * 128 + m * 16;
                pg8::f32x4 c4 = {1.f, 1.f, 1.f, 1.f}, s4 = {0.f, 0.f, 0.f, 0.f};
                if (rope) { c4 = *(const pg8::f32x4*)(cs + (size_t)row * 16 + 4 * fq); s4 = *(const pg8::f32x4*)(sn + (size_t)row * 16 + 4 * fq); }
                bf16_t* rowp = dst + (size_t)row * D + col0;
#pragma unroll
                for (int bj = 0; bj < 2; ++bj) {
                    const pg8::f32x4 x1 = acc[ai][bj][m][0], x2 = acc[ai][bj][m][1];
                    const pg8::f32x4 y1 = x1 * c4 - x2 * s4, y2 = x2 * c4 + x1 * s4;
                    st_bf4(rowp + bj * 128, y1); st_bf4(rowp + bj * 128 + 16, y2);
                }
            }
    }
};
struct EpiC1 {
    static constexpr bool PERM = true, AFTER_DRAIN = false;
    bf16_t *Y, *T;
    __device__ __forceinline__ void operator()(AccRef acc, const Unit& u, int wr, int wc, int fr, int fq) const {
        const int row0 = u.pm * 256 + wr * 64 + fr;
        if (u.pn < 64) {
            const int part = u.pn >> 4, col0 = (u.pn & 15) * 256 + wc * 32 + 8 * fq;
            bf16_t* dst = Y + (size_t)part * (SLOT / 2);
#pragma unroll
            for (int ai = 0; ai < 2; ++ai)
#pragma unroll
                for (int m = 0; m < 4; ++m) { bf16_t* rowp = dst + (size_t)(row0 + ai * 128 + m * 16) * D + col0;
#pragma unroll
                    for (int bj = 0; bj < 2; ++bj) st_bf8(rowp + bj * 128, acc[ai][bj][m][0], acc[ai][bj][m][1]); }
        } else {
            const int which = u.pn - 64, col0 = which * 128 + wc * 32 + 8 * fq;
#pragma unroll
            for (int ai = 0; ai < 2; ++ai)
#pragma unroll
                for (int m = 0; m < 4; ++m) {
                    pg8::f32x4 v0 = acc[ai][0][m][0], v1 = acc[ai][0][m][1];
                    if (which == 0) {
#pragma unroll
                        for (int j = 0; j < 4; ++j) { v0[j] = 1.f - 2.f / (1.f + __expf(2.f * v0[j])); v1[j] = 1.f - 2.f / (1.f + __expf(2.f * v1[j])); }
                    }
                    st_bf8(T + (size_t)(row0 + ai * 128 + m * 16) * 256 + col0, v0, v1);
                }
        }
    }
};
struct EpiC2 {
    static constexpr bool PERM = true, AFTER_DRAIN = false;
    bf16_t* Y; const float* w0; const float* a0;
    __device__ __forceinline__ void operator()(AccRef acc, const Unit& u, int wr, int wc, int fr, int fq) const {
        const int row0 = u.pm * 256 + wr * 64 + fr;
        const bool isw = u.pn < 16;
        const int col0 = (u.pn & 15) * 256 + wc * 32 + 8 * fq;
        bf16_t* dst = Y + (size_t)(isw ? 4 : 5) * (SLOT / 2); const float* bias = isw ? w0 : a0;
#pragma unroll
        for (int bj = 0; bj < 2; ++bj) {
            const pg8::f32x4 b0 = *(const pg8::f32x4*)(bias + col0 + bj * 128), b1 = *(const pg8::f32x4*)(bias + col0 + bj * 128 + 4);
#pragma unroll
            for (int ai = 0; ai < 2; ++ai)
#pragma unroll
                for (int m = 0; m < 4; ++m) {
                    pg8::f32x4 v0 = acc[ai][bj][m][0] + b0, v1 = acc[ai][bj][m][1] + b1;
#pragma unroll
                    for (int j = 0; j < 4; ++j) {
                        float s0 = sigmoid_f(v0[j]), s1 = sigmoid_f(v1[j]);
                        if (isw) { s0 = __expf(-0.606531f * s0); s1 = __expf(-0.606531f * s1); }
                        v0[j] = s0; v1[j] = s1;
                    }
                    st_bf8(dst + (size_t)(row0 + ai * 128 + m * 16) * D + col0 + bj * 128, v0, v1);
                    __builtin_amdgcn_sched_barrier(0);
                }
        }
    }
};

struct Fr {
    LAS unsigned char* lds; unsigned char* ldsg;
    int tid, lane, wave, G, bid, gw, NGW;
    float* out; unsigned char* ws;
    __device__ __forceinline__ Fr fresh() const { Fr P = *this; asm volatile("" : "+v"(P.tid)); P.lane = P.tid & 63; P.wave = __builtin_amdgcn_readfirstlane(P.tid >> 6); P.gw = P.bid * 8 + P.wave; return P; }
    __device__ __forceinline__ const float* in(int i) const {
        const __attribute__((address_space(4))) unsigned long long* ka = (const __attribute__((address_space(4))) unsigned long long*)__builtin_amdgcn_kernarg_segment_ptr();
        asm volatile("" : "+s"(ka));
        return (const float*)ka[i];
    }
};
__device__ __forceinline__ bf16_t* slotU(const Fr& F, int s) { return (bf16_t*)(F.ws + WS_U + (size_t)s * SLOT); }
__device__ __forceinline__ bf16_t* slotY(const Fr& F, int s) { return (bf16_t*)(F.ws + WS_Y + (size_t)s * SLOT); }
__device__ __forceinline__ float* hrow(const Fr& F, int r) { return r < 64 ? (float*)(F.ws + WS_HMETA) + (size_t)r * D : F.out + (size_t)(r - 64) * D; }

__device__ __forceinline__ void transpose_item(const float* W, int ldw, bf16_t* WT, int ldt, int koff, LAS float* scr, int kb, int nb, int lane) {
    const int k0 = 64 * kb, n0 = 32 * nb;
#pragma unroll 8
    for (int i = 0; i < 32; ++i) { const int kk = 2 * i + (lane >> 5); scr[kk * 33 + (lane & 31)] = W[(size_t)(k0 + kk) * ldw + n0 + (lane & 31)]; }
    LDS_WAIT(); asm volatile("" ::: "memory");
    const int c = lane & 7;
#pragma unroll
    for (int j = 0; j < 4; ++j) { const int n = (lane >> 3) + 8 * j; const LAS float* s = scr + (8 * c) * 33 + n;
        u32x4 o; o.x = cvt_pk_bf16(s[0 * 33], s[1 * 33]); o.y = cvt_pk_bf16(s[2 * 33], s[3 * 33]); o.z = cvt_pk_bf16(s[4 * 33], s[5 * 33]); o.w = cvt_pk_bf16(s[6 * 33], s[7 * 33]);
        *(u32x4*)(WT + (size_t)(n0 + n) * ldt + koff + k0 + 8 * c) = o; }
    LDS_WAIT(); asm volatile("" ::: "memory");
}
__device__ __forceinline__ void convert_matrix(const Fr& F, const float* W, int K, int N, bf16_t* WT, int ldt, int koff) {
    LAS float* scr = (LAS float*)(F.lds + F.wave * 8704);
    const int nblk = N / 32, nitems = (K / 64) * nblk;
    for (int it = F.gw; it < nitems; it += F.NGW) transpose_item(W, N, WT, ldt, koff, scr, it / nblk, it % nblk, F.lane);
}
__device__ __forceinline__ void zero_bytes(const Fr& F, void* p, size_t nbytes) {
    u32x4* q = (u32x4*)p; const size_t n = nbytes / 16; const u32x4 z = {0u, 0u, 0u, 0u};
    for (size_t i = (size_t)F.bid * 512 + F.tid; i < n; i += (size_t)F.G * 512) q[i] = z;
}
__device__ __forceinline__ void convert_layer(const Fr& F, int L) {
    bf16_t* wtin = (bf16_t*)(F.ws + WS_WTIN); bf16_t* wtout = (bf16_t*)(F.ws + WS_WTOUT);
    if (L == 0 || L == 3) { const int j = L ? 1 : 0;
        convert_matrix(F, F.in(4) + (size_t)j * D * 4 * D, D, 4 * D, wtin, D, 0);
        convert_matrix(F, F.in(7) + (size_t)j * D * D, D, D, wtout, D, 0);
    } else if (L == 1) {
        convert_matrix(F, F.in(8), D, 4 * D, wtin, D, 0);
        convert_matrix(F, F.in(14), D, D, wtout, D, 0);
    } else {
        convert_matrix(F, F.in(16), D, 4 * D, wtin, D, 0);
        convert_matrix(F, F.in(28), D, D, wtout, D, 0);
        convert_matrix(F, F.in(18), D, 128, wtin + (size_t)16384 * D, D, 0);
        convert_matrix(F, F.in(21), D, 128, wtin + (size_t)16640 * D, D, 0);
        zero_bytes(F, wtin + (size_t)16512 * D, (size_t)128 * D * 2);
        zero_bytes(F, wtin + (size_t)16768 * D, (size_t)128 * D * 2);
        bf16_t* w2p = (bf16_t*)(F.ws + WS_W2P);
        zero_bytes(F, w2p, (size_t)8192 * 256 * 2);
    }
}
__device__ __forceinline__ void convert_layer2_b(const Fr& F) {
    bf16_t* w2p = (bf16_t*)(F.ws + WS_W2P);
    convert_matrix(F, F.in(19), 128, D, w2p, 256, 0);
    convert_matrix(F, F.in(22), 128, D, w2p + (size_t)4096 * 256, 256, 128);
}

__constant__ float c_inv_freq[16] = {1.0f, 0.44036659598350525f, 0.1939227432012558f, 0.08539710193872452f, 0.03760603070259094f, 0.01656043902039528f, 0.007292664609849453f, 0.0032114458736032248f,
    0.0014142135623842478f, 0.000622772378847003f, 0.00027424818836152554f, 0.00012076973507646471f, 5.318296098266728e-05f, 2.34199997066753e-05f, 1.0313386155758053e-05f, 4.541670477919979e-06f};
__device__ __forceinline__ void rope_table(const Fr& F) {
    float* cs = (float*)(F.ws + WS_ROPE); float* sn = cs + (size_t)R * 16;
    for (int i = F.bid * 512 + F.tid; i < R * 16; i += F.G * 512) {
        const int row = i >> 4, j = i & 15; const int pos = row - NPAD;
        const double ang = (double)(float)((float)pos * c_inv_freq[j]);
        const double k = __builtin_rint(ang * 0.15915494309189535);
        double x = ang - k * 6.283185307179586;
        const double q = __builtin_rint(x * 0.6366197723675814);
        x -= q * 1.5707963267948966;
        const int qi = ((int)q) & 3;
        const double x2 = x * x;
        const double s = x * (1.0 + x2 * (-1.0 / 6 + x2 * (1.0 / 120 + x2 * (-1.0 / 5040 + x2 * (1.0 / 362880 + x2 * (-1.0 / 39916800))))));
        const double c = 1.0 + x2 * (-0.5 + x2 * (1.0 / 24 + x2 * (-1.0 / 720 + x2 * (1.0 / 40320 + x2 * (-1.0 / 3628800 + x2 * (1.0 / 479001600))))));
        double sv, cv;
        if (qi == 0) { sv = s; cv = c; } else if (qi == 1) { sv = c; cv = -s; } else if (qi == 2) { sv = -s; cv = -c; } else { sv = -c; cv = s; }
        cs[i] = (float)cv; sn[i] = (float)sv;
    }
}

typedef const GAS char* gcp; typedef GAS char* gp_;
#define ROW_F32(nm, base, lane) gp_ nm##0 = (gp_)(base) + (lane) * 16 + 4096; gp_ nm##1 = nm##0 + 8192; asm volatile("" : "+v"(nm##0), "+v"(nm##1))
#define AT_F32(nm, j) (*(GAS f32x4*)((j) < 8 ? nm##0 + ((j) - 4) * 1024 : nm##1 + ((j) - 12) * 1024))
#define ROW_BF(nm, base, lane) gp_ nm##0 = (gp_)(base) + (lane) * 8 + 4096; asm volatile("" : "+v"(nm##0))
#define AT_BF(nm, j) (*(GAS u32x2*)(nm##0 + (j) * 512 - 4096))
__device__ __forceinline__ void norm_phase(const Fr& F, int prev, int next, const bf16_t* y, bf16_t* udst) {
    const float* postg = F.in(3) + (size_t)(prev < 0 ? 0 : prev) * D; const float* preg = F.in(2) + (size_t)(next < 0 ? 0 : next) * D;
    const float* xin = F.in(0); const float* meta = F.in(1);
    for (int r = F.gw; r < R; r += F.NGW) {
        if (r < NPAD || r >= NREAL) {
            if (next >= 0) { ROW_BF(uo, udst + (size_t)r * D, F.lane); const u32x2 z = {0u, 0u};
#pragma unroll
                for (int j = 0; j < 16; ++j) AT_BF(uo, j) = z; }
            continue;
        }
        float* hr = hrow(F, r);
        ROW_F32(hp, hr, F.lane);
        f32x4 hv[16];
        if (prev < 0) {
            const float* src = r < 64 ? meta + (size_t)(r - NPAD) * D : xin + (size_t)(r - 64) * D;
            ROW_F32(sp, src, F.lane);
#pragma unroll
            for (int j = 0; j < 16; ++j) hv[j] = AT_F32(sp, j);
        } else {
            ROW_BF(yp, y + (size_t)r * D, F.lane); ROW_F32(gp, postg, F.lane);
            u32x2 yv[16]; float ss = 0.f;
#pragma unroll
            for (int j = 0; j < 16; ++j) { yv[j] = AT_BF(yp, j); hv[j] = AT_F32(hp, j); }
#pragma unroll
            for (int j = 0; j < 16; ++j) { const float a = bflo(yv[j].x), b = bfhi(yv[j].x), c = bflo(yv[j].y), d = bfhi(yv[j].y); ss += (a * a + b * b) + (c * c + d * d); }
#pragma unroll
            for (int j = 0; j < 16; ++j) asm volatile("" : "+v"(yv[j].x), "+v"(yv[j].y));
            const float rs = __builtin_amdgcn_rsqf(wave_sum(ss) * (1.f / D) + 1e-6f);
#pragma unroll
            for (int j = 0; j < 16; ++j) { const f32x4 g = AT_F32(gp, j);
                hv[j].x += bflo(yv[j].x) * rs * g.x; hv[j].y += bfhi(yv[j].x) * rs * g.y; hv[j].z += bflo(yv[j].y) * rs * g.z; hv[j].w += bfhi(yv[j].y) * rs * g.w; }
        }
        if (next < 0) {
            if (r >= 64) {
#pragma unroll
                for (int j = 0; j < 16; ++j) AT_F32(hp, j) = hv[j];
            }
            continue;
        }
        float s2 = 0.f;
#pragma unroll
        for (int j = 0; j < 16; ++j) { AT_F32(hp, j) = hv[j]; s2 += (hv[j].x * hv[j].x + hv[j].y * hv[j].y) + (hv[j].z * hv[j].z + hv[j].w * hv[j].w); }
        const float rs2 = __builtin_amdgcn_rsqf(wave_sum(s2) * (1.f / D) + 1e-6f);
        ROW_BF(uo, udst + (size_t)r * D, F.lane); ROW_F32(pg, preg, F.lane);
#pragma unroll
        for (int j = 0; j < 16; ++j) { const f32x4 g = AT_F32(pg, j); u32x2 w; w.x = cvt_pk_bf16(hv[j].x * rs2 * g.x, hv[j].y * rs2 * g.y); w.y = cvt_pk_bf16(hv[j].z * rs2 * g.z, hv[j].w * rs2 * g.w); AT_BF(uo, j) = w; }
    }
}
__device__ __forceinline__ void mix_phase(const Fr& F, const bf16_t* u) {
    const float* mu = F.in(15);
    for (int r = F.gw; r < R; r += F.NGW) {
        const bool real = (r >= NPAD && r < NREAL);
        u32x2 cur[16], prv[16];
        const u32x2 z = {0u, 0u};
        { ROW_BF(cp, u + (size_t)r * D, F.lane); ROW_BF(pp, u + (size_t)(r > 0 ? r - 1 : 0) * D, F.lane);
#pragma unroll
          for (int j = 0; j < 16; ++j) { cur[j] = real ? AT_BF(cp, j) : z; prv[j] = (real && r > NPAD) ? AT_BF(pp, j) : z; } }
#pragma unroll 1
        for (int s = 0; s < 6; ++s) {
            ROW_BF(op, slotU(F, s) + (size_t)r * D, F.lane); ROW_F32(mp, mu + (size_t)s * D, F.lane);
#pragma unroll
            for (int j = 0; j < 16; ++j) {
                const f32x4 m = AT_F32(mp, j);
                const float c0 = bflo(cur[j].x), c1 = bfhi(cur[j].x), c2 = bflo(cur[j].y), c3 = bfhi(cur[j].y);
                const float p0 = bflo(prv[j].x), p1 = bfhi(prv[j].x), p2 = bflo(prv[j].y), p3 = bfhi(prv[j].y);
                u32x2 w; w.x = cvt_pk_bf16(c0 + (p0 - c0) * m.x, c1 + (p1 - c1) * m.y); w.y = cvt_pk_bf16(c2 + (p2 - c2) * m.z, c3 + (p3 - c3) * m.w);
                AT_BF(op, j) = real ? w : z;
            }
        }
    }
}
}
namespace mk {
constexpr int H_QE = 0, H_KE = 17408, H_KET = 34816, H_VT = 53248, H_PM = 71680, H_STB = 80896, H_VEC = 115712;
__device__ __forceinline__ bf16x8 ldfrag(const LAS unsigned char* base, int stride_b, int rb, int ks, int lane) {
    return *(const LAS bf16x8*)(base + (16 * rb + (lane & 15)) * stride_b + (32 * ks + 8 * (lane >> 4)) * 2);
}
template <bool OUT>
__device__ __forceinline__ void hgrn_phase(const Fr& F, int jl) {
    const bf16_t* Q = slotY(F, 0); const bf16_t* V = slotY(F, 1); const bf16_t* GT = slotY(F, 2); const float* Gg = (const float*)slotY(F, 3);
    bf16_t* Z = slotU(F, 0);
    float* HE = (float*)(F.ws + WS_HE); float* HLD = (float*)(F.ws + WS_HLOGD);
    const float* gn = F.in(6) + (size_t)jl * 128;
    LAS unsigned char* L = F.lds;
    LAS float* qtot = (LAS float*)(L + H_VEC); LAS float* ebm = qtot + 512; LAS float* ebl = ebm + 128;
    const int tid = F.tid, lane = F.lane, w = F.wave;
    const int d = tid & 127, qt = tid >> 7;
    for (int unit = F.bid; unit < 256; unit += F.G) {
        const int h = unit >> 3, seg = unit & 7;
        if (!OUT && seg == 7) continue;
        const int c0 = seg == 0 ? 0 : 33 + 32 * (seg - 1), c1 = c0 + (seg == 0 ? 33 : 32);
        f32x4 S[8];
#pragma unroll
        for (int i = 0; i < 8; ++i) S[i] = (f32x4){0.f, 0.f, 0.f, 0.f};
        if (OUT) {
            for (int j = 0; j < seg; ++j) {
                const float* ld = HLD + (size_t)(h * 8 + j) * 128; const float* e = HE + ((size_t)(h * 8 + j) * 512 + tid) * 32;
#pragma unroll
                for (int di = 0; di < 8; ++di) { const f32x4 l4 = *(const f32x4*)(ld + 16 * di + 4 * (lane >> 4)); const f32x4 e4 = *(const f32x4*)(e + 4 * di);
                    S[di].x = S[di].x * __expf(l4.x) + e4.x; S[di].y = S[di].y * __expf(l4.y) + e4.y; S[di].z = S[di].z * __expf(l4.z) + e4.z; S[di].w = S[di].w * __expf(l4.w) + e4.w; }
            }
        }
        float logD = 0.f;
        for (int c = c0; c < c1; ++c) {
            const int rowb = 64 * c + 16 * qt; const size_t colb = (size_t)h * 128 + d;
            float g[16]; bf16_t qv[16], vv[16];
#pragma unroll
            for (int i = 0; i < 16; ++i) { g[i] = Gg[(size_t)(rowb + i) * D + colb]; vv[i] = V[(size_t)(rowb + i) * D + colb]; if (OUT) qv[i] = Q[(size_t)(rowb + i) * D + colb]; }
            u32x4 gt0, gt1;
            if (OUT) { const bf16_t* gp = GT + (size_t)(64 * c + (tid >> 3)) * D + h * 128 + 16 * (tid & 7); gt0 = *(const u32x4*)gp; gt1 = *(const u32x4*)(gp + 8); }
            float b[16]; float run = 0.f;
#pragma unroll
            for (int i = 0; i < 16; ++i) { run += g[i]; b[i] = run; }
            qtot[qt * 128 + d] = run;
            __syncthreads();
            const float t0 = qtot[d], t1 = qtot[128 + d], t2 = qtot[256 + d], t3 = qtot[384 + d];
            const float off = qt == 0 ? 0.f : (qt == 1 ? t0 : (qt == 2 ? t0 + t1 : t0 + t1 + t2));
            const float bm = t0 + t1, bl = (t0 + t1) + (t2 + t3);
            if (qt == 0) { ebm[d] = __expf(bm); ebl[d] = __expf(bl); logD += bl; }
            {
                unsigned kt[8], vt[8];
#pragma unroll
                for (int i = 0; i < 16; i += 2) {
                    const float b0 = b[i] + off, b1 = b[i + 1] + off;
                    const float k0 = 1.f - __expf(g[i]), k1 = 1.f - __expf(g[i + 1]);
                    const int t = 16 * qt + i;
                    if (OUT) {
                        *(LAS bf16_t*)(L + H_QE + (t * 136 + d) * 2) = f2bf(bf2f(qv[i]) * __expf(b0 - bm));
                        *(LAS bf16_t*)(L + H_QE + ((t + 1) * 136 + d) * 2) = f2bf(bf2f(qv[i + 1]) * __expf(b1 - bm));
                        *(LAS bf16_t*)(L + H_KE + (t * 136 + d) * 2) = f2bf(k0 * __expf(bm - b0));
                        *(LAS bf16_t*)(L + H_KE + ((t + 1) * 136 + d) * 2) = f2bf(k1 * __expf(bm - b1));
                    }
                    kt[i >> 1] = cvt_pk_bf16(k0 * __expf(bl - b0), k1 * __expf(bl - b1));
                    vt[i >> 1] = (unsigned)vv[i] | ((unsigned)vv[i + 1] << 16);
                }
                LAS u32x4* kp = (LAS u32x4*)(L + H_KET + (d * 72 + 16 * qt) * 2); kp[0] = (u32x4){kt[0], kt[1], kt[2], kt[3]}; kp[1] = (u32x4){kt[4], kt[5], kt[6], kt[7]};
                LAS u32x4* vp = (LAS u32x4*)(L + H_VT + (d * 72 + 16 * qt) * 2); vp[0] = (u32x4){vt[0], vt[1], vt[2], vt[3]}; vp[1] = (u32x4){vt[4], vt[5], vt[6], vt[7]};
            }
            __syncthreads();
            if (OUT) {
#pragma unroll
                for (int di = 0; di < 8; ++di) { const f32x4 m4 = *(const LAS f32x4*)(ebm + 16 * di + 4 * (lane >> 4)); u32x2 o; o.x = cvt_pk_bf16(S[di].x * m4.x, S[di].y * m4.y); o.y = cvt_pk_bf16(S[di].z * m4.z, S[di].w * m4.w);
                    *(LAS u32x2*)(L + H_STB + ((16 * w + (lane & 15)) * 136 + 16 * di + 4 * (lane >> 4)) * 2) = o; }
                const int ti = w >> 1;
#pragma unroll
                for (int s2 = 0; s2 < 2; ++s2) { const int si = 2 * (w & 1) + s2; f32x4 p = {0.f, 0.f, 0.f, 0.f};
                    if (si <= ti) {
#pragma unroll
                        for (int ks = 0; ks < 4; ++ks) p = __builtin_amdgcn_mfma_f32_16x16x32_bf16(ldfrag(L + H_QE, 272, ti, ks, lane), ldfrag(L + H_KE, 272, si, ks, lane), p, 0, 0, 0);
                    }
                    const int sidx = 16 * si + (lane & 15);
#pragma unroll
                    for (int jj = 0; jj < 4; ++jj) { const int tidx = 16 * ti + 4 * (lane >> 4) + jj; *(LAS bf16_t*)(L + H_PM + (tidx * 72 + sidx) * 2) = f2bf(sidx <= tidx ? p[jj] : 0.f); }
                }
                __syncthreads();
            }
            f32x4 O[4];
            if (OUT) {
#pragma unroll
                for (int ti = 0; ti < 4; ++ti) O[ti] = (f32x4){0.f, 0.f, 0.f, 0.f};
#pragma unroll
                for (int ks = 0; ks < 2; ++ks) { const bf16x8 bv = ldfrag(L + H_VT, 144, w, ks, lane);
#pragma unroll
                    for (int ti = 0; ti < 4; ++ti) O[ti] = __builtin_amdgcn_mfma_f32_16x16x32_bf16(ldfrag(L + H_PM, 144, ti, ks, lane), bv, O[ti], 0, 0, 0); }
#pragma unroll
                for (int ks = 0; ks < 4; ++ks) { const bf16x8 bs = ldfrag(L + H_STB, 272, w, ks, lane);
#pragma unroll
                    for (int ti = 0; ti < 4; ++ti) O[ti] = __builtin_amdgcn_mfma_f32_16x16x32_bf16(ldfrag(L + H_QE, 272, ti, ks, lane), bs, O[ti], 0, 0, 0); }
            }
            {
                const bf16x8 bv0 = ldfrag(L + H_VT, 144, w, 0, lane), bv1 = ldfrag(L + H_VT, 144, w, 1, lane);
#pragma unroll
                for (int di = 0; di < 8; ++di) { const f32x4 l4 = *(const LAS f32x4*)(ebl + 16 * di + 4 * (lane >> 4)); S[di] = S[di] * l4;
                    S[di] = __builtin_amdgcn_mfma_f32_16x16x32_bf16(ldfrag(L + H_KET, 144, di, 0, lane), bv0, S[di], 0, 0, 0);
                    S[di] = __builtin_amdgcn_mfma_f32_16x16x32_bf16(ldfrag(L + H_KET, 144, di, 1, lane), bv1, S[di], 0, 0, 0); }
            }
            if (OUT) {
                __syncthreads();
                LAS float* Ot = (LAS float*)(L + H_STB);
#pragma unroll
                for (int ti = 0; ti < 4; ++ti)
#pragma unroll
                    for (int jj = 0; jj < 4; ++jj) Ot[(16 * ti + 4 * (lane >> 4) + jj) * 132 + 16 * w + (lane & 15)] = O[ti][jj];
                __syncthreads();
                const int t = tid >> 3, eg = tid & 7;
                f32x4 o4[4]; float ss = 0.f;
#pragma unroll
                for (int i = 0; i < 4; ++i) { o4[i] = *(const LAS f32x4*)(Ot + t * 132 + 16 * eg + 4 * i); ss += (o4[i].x * o4[i].x + o4[i].y * o4[i].y) + (o4[i].z * o4[i].z + o4[i].w * o4[i].w); }
                ss = red8(ss);
                const float rs = __builtin_amdgcn_rsqf(ss * (1.f / 128.f) + 1e-6f);
                const unsigned gw_[8] = {gt0.x, gt0.y, gt0.z, gt0.w, gt1.x, gt1.y, gt1.z, gt1.w};
                unsigned zo[8];
#pragma unroll
                for (int i = 0; i < 4; ++i) { const f32x4 g4 = *(const f32x4*)(gn + 16 * eg + 4 * i);
                    const float a0 = o4[i].x * rs * g4.x * silu_f(bflo(gw_[2 * i])), a1 = o4[i].y * rs * g4.y * silu_f(bfhi(gw_[2 * i]));
                    const float a2 = o4[i].z * rs * g4.z * silu_f(bflo(gw_[2 * i + 1])), a3 = o4[i].w * rs * g4.w * silu_f(bfhi(gw_[2 * i + 1]));
                    zo[2 * i] = cvt_pk_bf16(a0, a1); zo[2 * i + 1] = cvt_pk_bf16(a2, a3); }
                bf16_t* zp = Z + (size_t)(64 * c + t) * D + h * 128 + 16 * eg;
                *(u32x4*)zp = (u32x4){zo[0], zo[1], zo[2], zo[3]}; *(u32x4*)(zp + 8) = (u32x4){zo[4], zo[5], zo[6], zo[7]};
            } else {
                __syncthreads();
            }
        }
        if (!OUT) {
            float* e = HE + ((size_t)(h * 8 + seg) * 512 + tid) * 32;
#pragma unroll
            for (int di = 0; di < 8; ++di) *(f32x4*)(e + 4 * di) = S[di];
            if (qt == 0) HLD[(size_t)(h * 8 + seg) * 128 + d] = logD;
        }
        __syncthreads();
    }
}

namespace att {
constexpr int NW = 8, QBLK = 32, KVBLK = 64, LDQ = 4096, LDO = 8192;
constexpr float SCALE = 0.088388347648318440f, THR = 8.f;
constexpr int SHM_V = 16384, SHM_K = 16384, SHM = 2 * SHM_V + 2 * SHM_K + NW * 64 * 4;
#define KSWZ(row, colB) ((row) * 256 + ((colB) ^ (((row) & 7) << 4)))
#define SBAR() __builtin_amdgcn_sched_barrier(0)
__device__ __forceinline__ int crow(int r, int hi) { return (r & 3) + 8 * (r >> 2) + 4 * hi; }
__device__ __forceinline__ void partialSM(f32x16& p0, f32x16& p1, float& m_reg, float& mn, float& alpha) {
    constexpr float C = SCALE * 1.4426950408889634f;
    float pmax = p0[0];
#pragma unroll
    for (int r = 1; r < 16; ++r) pmax = fmaxf(pmax, p0[r]);
#pragma unroll
    for (int r = 0; r < 16; ++r) pmax = fmaxf(pmax, p1[r]);
    { auto rr = __builtin_amdgcn_permlane32_swap(__float_as_uint(pmax), __float_as_uint(pmax), false, false);
      pmax = fmaxf(__uint_as_float(rr[0]), __uint_as_float(rr[1])); }
    if (__builtin_expect(__all(pmax - m_reg <= THR / SCALE), 1)) { mn = m_reg; alpha = 1.f; }
    else { mn = fmaxf(m_reg, pmax); alpha = __builtin_amdgcn_exp2f((m_reg - mn) * C); m_reg = mn; }
    const float mnC = -mn * C;
#pragma unroll
    for (int r = 0; r < 16; ++r) p0[r] = fmaf(p0[r], C, mnC);
#pragma unroll
    for (int r = 0; r < 16; ++r) p1[r] = fmaf(p1[r], C, mnC);
#pragma unroll
    for (int r = 0; r < 16; ++r) p0[r] = __builtin_amdgcn_exp2f(p0[r]);
}
__device__ __forceinline__ void finishSM(f32x16& p0, f32x16& p1, float alpha, float& l_reg, bf16x8& pa0, bf16x8& pa1, bf16x8& pa2, bf16x8& pa3) {
#pragma unroll
    for (int r = 0; r < 16; ++r) p1[r] = __builtin_amdgcn_exp2f(p1[r]);
    float ps = 0;
#pragma unroll
    for (int r = 0; r < 16; ++r) ps += p0[r];
#pragma unroll
    for (int r = 0; r < 16; ++r) ps += p1[r];
    { auto rr = __builtin_amdgcn_permlane32_swap(__float_as_uint(ps), __float_as_uint(ps), false, false);
      ps = __uint_as_float(rr[0]) + __uint_as_float(rr[1]); }
    l_reg = l_reg * alpha + ps;
#define PK4(P, BASE, OUT) do { unsigned a0 = cvt_pk_bf16(P[BASE + 0], P[BASE + 1]), a1 = cvt_pk_bf16(P[BASE + 2], P[BASE + 3]);   \
    unsigned b0 = cvt_pk_bf16(P[BASE + 4], P[BASE + 5]), b1 = cvt_pk_bf16(P[BASE + 6], P[BASE + 7]);                              \
    auto r0 = __builtin_amdgcn_permlane32_swap(a0, b0, false, false); auto r1 = __builtin_amdgcn_permlane32_swap(a1, b1, false, false); \
    u32x4 w = {r0[0], r1[0], r0[1], r1[1]}; OUT = *reinterpret_cast<bf16x8*>(&w); } while (0)
    PK4(p0, 0, pa0); PK4(p0, 8, pa1); PK4(p1, 0, pa2); PK4(p1, 8, pa3);
#undef PK4
}
__device__ __forceinline__ void qkt(f32x16& p0, f32x16& p1, const char* Ks, const bf16x8* qr, int r32, int hi) {
    p0 = f32x16{}; p1 = f32x16{};
#pragma unroll
    for (int d0 = 0; d0 < 8; ++d0) { const int cb = (d0 * 16 + hi * 8) * 2;
        const bf16x8 b0 = *reinterpret_cast<const bf16x8*>(Ks + KSWZ(r32, cb));
        const bf16x8 b1 = *reinterpret_cast<const bf16x8*>(Ks + KSWZ(32 + r32, cb));
        p0 = __builtin_amdgcn_mfma_f32_32x32x16_bf16(b0, qr[d0], p0, 0, 0, 0);
        p1 = __builtin_amdgcn_mfma_f32_32x32x16_bf16(b1, qr[d0], p1, 0, 0, 0); }
}
__device__ __forceinline__ int v_st(int k, int c) { const int kk = (k & ~0xC) | ((k & 4) << 1) | ((k & 8) >> 1); return ((kk >> 3) * 4 + (c >> 5)) * 512 + ((kk & 7) * 32 + (c & 31)) * 2; }
__device__ __forceinline__ int v_rd_base(int lane) { return ((lane & 3) << 3) | (((lane >> 2) & 3) << 6) | (((lane >> 4) & 1) << 5) | (((lane >> 5) & 1) << 8); }
constexpr int v_rd_off(int d0, int ks, int half) { return d0 * 512 + ks * 4096 + half * 2048; }
template <int OFF> __device__ __forceinline__ s16x4 tr_read(int vb) {
    s16x4 r; asm volatile("ds_read_b64_tr_b16 %0, %1 offset:%2" : "=&v"(r) : "v"(vb), "i"(OFF) : "memory"); return r;
}
template <int D0> __device__ __forceinline__ void pv_one(f32x16& od, int vb, bf16x8 pa0, bf16x8 pa1, bf16x8 pa2, bf16x8 pa3) {
    const s16x4 l0 = tr_read<v_rd_off(D0, 0, 0)>(vb), h0 = tr_read<v_rd_off(D0, 0, 1)>(vb), l1 = tr_read<v_rd_off(D0, 1, 0)>(vb), h1 = tr_read<v_rd_off(D0, 1, 1)>(vb);
    const s16x4 l2 = tr_read<v_rd_off(D0, 2, 0)>(vb), h2 = tr_read<v_rd_off(D0, 2, 1)>(vb), l3 = tr_read<v_rd_off(D0, 3, 0)>(vb), h3 = tr_read<v_rd_off(D0, 3, 1)>(vb);
    asm volatile("s_waitcnt lgkmcnt(0)" ::: "memory"); SBAR();
#define PK(Lo, Hi) (bf16x8){Lo[0], Lo[1], Lo[2], Lo[3], Hi[0], Hi[1], Hi[2], Hi[3]}
    od = __builtin_amdgcn_mfma_f32_32x32x16_bf16(pa0, PK(l0, h0), od, 0, 0, 0);
    od = __builtin_amdgcn_mfma_f32_32x32x16_bf16(pa1, PK(l1, h1), od, 0, 0, 0);
    od = __builtin_amdgcn_mfma_f32_32x32x16_bf16(pa2, PK(l2, h2), od, 0, 0, 0);
    od = __builtin_amdgcn_mfma_f32_32x32x16_bf16(pa3, PK(l3, h3), od, 0, 0, 0);
#undef PK
}
__device__ __forceinline__ void pv_d0(f32x16* o, int vb, bf16x8 pa0, bf16x8 pa1, bf16x8 pa2, bf16x8 pa3) {
    pv_one<0>(o[0], vb, pa0, pa1, pa2, pa3); pv_one<1>(o[1], vb, pa0, pa1, pa2, pa3); pv_one<2>(o[2], vb, pa0, pa1, pa2, pa3); pv_one<3>(o[3], vb, pa0, pa1, pa2, pa3);
}
__device__ __forceinline__ void mask_tile(f32x16& p0, f32x16& p1, int j, int lim) {
    if (j > lim) {
#pragma unroll
        for (int r = 0; r < 16; ++r) { p0[r] = -1e30f; p1[r] = -1e30f; }
    } else if (j == 0) {
#pragma unroll
        for (int r = 0; r < 16; ++r) p0[r] = -1e30f;
#pragma unroll
        for (int r = 0; r < 8; ++r) p1[r] = -1e30f;
    }
}
__device__ __forceinline__ void unit(const bf16_t* __restrict__ Qb, const bf16_t* __restrict__ Kh, const bf16_t* __restrict__ Vh, bf16_t* __restrict__ Ob, int NT, int lim, char* lds) {
    int tid_ = threadIdx.x; asm volatile("" : "+v"(tid_));
    const int tid = tid_, wid = tid >> 6, lane = tid & 63, r32 = lane & 31, hi = lane >> 5;
    char* V_lds = lds; char* K_lds = lds + 2 * SHM_V;
    float* wsf = (float*)(lds + 2 * SHM_V + 2 * SHM_K) + wid * 64; float* li_l = wsf; float* al_l = wsf + 32;
    float m_reg = -1e30f, l_reg = 0; f32x16 o[4] = {}; bf16x8 qr[8];
    const bf16_t* Qw = Qb + (long)(wid * QBLK + r32) * LDQ + hi * 8;
#pragma unroll
    for (int d0 = 0; d0 < 8; ++d0) qr[d0] = *reinterpret_cast<const bf16x8*>(Qw + d0 * 16);
    const int sr = tid >> 4, sc = (tid & 15) * 8, vst0 = v_st(sr, sc), vst1 = v_st(32 + sr, sc);
    const int vb0 = (int)(uintptr_t)V_lds + v_rd_base(lane);
    struct { bf16x8 vs0, vs1, ks0, ks1; } sr_[2];
#define SLOAD(i, k0) do { sr_[i].vs0 = *reinterpret_cast<const bf16x8*>(&Vh[(long)((k0) + sr) * LDQ + sc]); sr_[i].vs1 = *reinterpret_cast<const bf16x8*>(&Vh[(long)((k0) + 32 + sr) * LDQ + sc]); \
    sr_[i].ks0 = *reinterpret_cast<const bf16x8*>(&Kh[(long)((k0) + sr) * LDQ + sc]); sr_[i].ks1 = *reinterpret_cast<const bf16x8*>(&Kh[(long)((k0) + 32 + sr) * LDQ + sc]); } while (0)
#define SWRITE(b, i) do { *(bf16x8*)(V_lds + (b) * SHM_V + vst0) = sr_[i].vs0;          \
    *(bf16x8*)(V_lds + (b) * SHM_V + vst1) = sr_[i].vs1; int kc = sc * 2;               \
    *(bf16x8*)(K_lds + (b) * SHM_K + KSWZ(sr, kc)) = sr_[i].ks0;                       \
    *(bf16x8*)(K_lds + (b) * SHM_K + KSWZ(32 + sr, kc)) = sr_[i].ks1; } while (0)
#define SWAIT() asm volatile("s_waitcnt vmcnt(4)" ::: "memory")
#define RESC(a) do { if (__any((a) < 1.f)) { if (hi == 0) al_l[r32] = (a); asm volatile("s_waitcnt lgkmcnt(0)" ::: "memory"); \
    _Pragma("unroll") for (int d = 0; d < 4; ++d) _Pragma("unroll") for (int r = 0; r < 16; ++r) o[d][r] *= al_l[crow(r, hi)]; } } while (0)
    f32x16 pA0, pA1, pB0, pB1; float mnA, mnB, alA, alB; bf16x8 pa0, pa1, pa2, pa3;
    constexpr int SE = 0, SO = 1;
    SLOAD(SE, 0); asm volatile("s_waitcnt vmcnt(0)" ::: "memory"); SWRITE(0, SE); __syncthreads();
    qkt(pA0, pA1, K_lds, qr, r32, hi); mask_tile(pA0, pA1, 0, lim); partialSM(pA0, pA1, m_reg, mnA, alA);
    SLOAD(SO, KVBLK); if (2 < NT) SLOAD(SE, 2 * KVBLK);
    SWAIT(); SWRITE(1, SO); __syncthreads();
    for (int j = 1; j + 1 < NT; j += 2) {
        SBAR(); qkt(pB0, pB1, K_lds + SHM_K, qr, r32, hi);
        finishSM(pA0, pA1, alA, l_reg, pa0, pa1, pa2, pa3); SBAR();
        SLOAD(SO, (j + 2) * KVBLK); SBAR();
        pv_d0(o, vb0, pa0, pa1, pa2, pa3); mask_tile(pB0, pB1, j, lim); partialSM(pB0, pB1, m_reg, mnB, alB);
        __syncthreads(); SWAIT(); SWRITE(0, SE);
        RESC(alB); __syncthreads();
        SBAR(); qkt(pA0, pA1, K_lds, qr, r32, hi);
        finishSM(pB0, pB1, alB, l_reg, pa0, pa1, pa2, pa3); SBAR();
        if (j + 3 < NT) SLOAD(SE, (j + 3) * KVBLK); SBAR();
        pv_d0(o, vb0 + SHM_V, pa0, pa1, pa2, pa3); mask_tile(pA0, pA1, j + 1, lim); partialSM(pA0, pA1, m_reg, mnA, alA);
        __syncthreads(); SWAIT(); SWRITE(1, SO);
        RESC(alA); __syncthreads();
    }
    SBAR(); qkt(pB0, pB1, K_lds + SHM_K, qr, r32, hi);
    finishSM(pA0, pA1, alA, l_reg, pa0, pa1, pa2, pa3); SBAR();
    pv_d0(o, vb0, pa0, pa1, pa2, pa3); mask_tile(pB0, pB1, NT - 1, lim); partialSM(pB0, pB1, m_reg, mnB, alB);
    __syncthreads(); RESC(alB);
    finishSM(pB0, pB1, alB, l_reg, pa0, pa1, pa2, pa3); SBAR();
    pv_d0(o, vb0 + SHM_V, pa0, pa1, pa2, pa3);
    if (hi == 0) li_l[r32] = l_reg; asm volatile("s_waitcnt lgkmcnt(0)" ::: "memory");
    float rli[16];
#pragma unroll
    for (int r = 0; r < 16; ++r) rli[r] = __builtin_amdgcn_rcpf(li_l[crow(r, hi)]);
    bf16_t* Ow = Ob + (long)(wid * QBLK) * LDO;
#pragma unroll
    for (int r = 0; r < 16; ++r) { const int orow = crow(r, hi);
#pragma unroll
        for (int d0 = 0; d0 < 4; ++d0) Ow[(long)orow * LDO + d0 * 32 + r32] = f2bf(o[d0][r] * rli[r]); }
    __syncthreads();
#undef SLOAD
#undef SWRITE
#undef SWAIT
#undef RESC
}
}

__device__ __forceinline__ void attn_phase(const Fr& F) {
    const bf16_t* Q = slotY(F, 0); const bf16_t* K = slotY(F, 1); const bf16_t* V = slotY(F, 2);
    bf16_t* AO = slotU(F, 1);
    for (int idx = F.bid; idx < 65 * 64; idx += F.G) {
        const int i = 64 - idx / 64, sub = idx & 63, head = sub >> 2, c = (sub >> 1) & 1, half = sub & 1;
        const int NT = 4 * i + 4, lim = 4 * i + (F.wave >> 1);
        att::unit(Q + (size_t)(256 * i) * D + head * 256 + c * 128, K + head * 256 + c * 128, V + head * 256 + half * 128,
                  AO + (size_t)(256 * i) * 8192 + head * 512 + c * 256 + half * 128, NT, lim, (char*)F.ldsg);
    }
}
__device__ __forceinline__ void attn_post(const Fr& F) {
    const bf16_t* AO = slotU(F, 1); const bf16_t* GT = slotY(F, 3); bf16_t* Z = slotU(F, 0);
    const float* sg = F.in(13);
    constexpr float LINIT = 0.35550906759096934f;
    float lam;
    { const float* q1 = F.in(9); const float* k1 = F.in(10); const float* q2 = F.in(11); const float* k2 = F.in(12);
      const float d1 = wave_sum(q1[F.lane] * k1[F.lane] + q1[F.lane + 64] * k1[F.lane + 64]), d2 = wave_sum(q2[F.lane] * k2[F.lane] + q2[F.lane + 64] * k2[F.lane + 64]);
      lam = expf(d1) - expf(d2) + LINIT; }
    const f32x4 g4 = ((const f32x4*)sg)[F.lane];
    for (int r = F.gw; r < R; r += F.NGW) {
        const bool real = (r >= NPAD && r < NREAL);
        u32x2* zr = (u32x2*)(Z + (size_t)r * D) + F.lane;
        if (!real) { const u32x2 z = {0u, 0u};
#pragma unroll
            for (int hd = 0; hd < 16; ++hd) zr[64 * hd] = z;
            continue; }
#pragma unroll 4
        for (int hd = 0; hd < 16; ++hd) {
            const u32x2 a0 = ((const u32x2*)(AO + (size_t)r * 8192 + hd * 512))[F.lane], a1 = ((const u32x2*)(AO + (size_t)r * 8192 + hd * 512 + 256))[F.lane];
            const u32x2 gt = ((const u32x2*)(GT + (size_t)r * D + hd * 256))[F.lane];
            const float o0 = bflo(a0.x) - lam * bflo(a1.x), o1 = bfhi(a0.x) - lam * bfhi(a1.x), o2 = bflo(a0.y) - lam * bflo(a1.y), o3 = bfhi(a0.y) - lam * bfhi(a1.y);
            const float ss = wave_sum((o0 * o0 + o1 * o1) + (o2 * o2 + o3 * o3));
            const float rs = __builtin_amdgcn_rsqf(ss * (1.f / 256.f) + 1e-5f) * (1.f - LINIT);
            u32x2 w; w.x = cvt_pk_bf16(o0 * rs * g4.x * silu_f(bflo(gt.x)), o1 * rs * g4.y * silu_f(bfhi(gt.x))); w.y = cvt_pk_bf16(o2 * rs * g4.z * silu_f(bflo(gt.y)), o3 * rs * g4.w * silu_f(bfhi(gt.y)));
            zr[64 * hd] = w;
        }
    }
}

constexpr int RW_TT = 32, RW_TOKF = 384, RW_TILEF = RW_TT * RW_TOKF, RW_NTILE = 513;
__device__ __forceinline__ void rwkv_scan(const Fr& F) {
    const bf16_t* Rr = slotY(F, 0); const bf16_t* K = slotY(F, 1); const bf16_t* V = slotY(F, 2); const bf16_t* W = slotY(F, 4); const bf16_t* A = slotY(F, 5);
    float* O32 = (float*)slotU(F, 1);
    LAS float* ring = (LAS float*)F.lds; LAS float* otile = ring + 2 * RW_TILEF;
    const int tid = F.tid, lane = F.lane, wid = F.wave;
    for (int unit = F.bid; unit < 256; unit += F.G) {
        const int h = unit >> 2, rg = unit & 3;
        const int ptid = tid - 256, ptt = ptid >> 3, dg = ptid & 7;
        float kkc[8], kac[8];
        if (wid >= 4) {
#pragma unroll
            for (int i = 0; i < 8; ++i) { kkc[i] = F.in(23)[h * 64 + 8 * dg + i]; kac[i] = F.in(24)[h * 64 + 8 * dg + i]; }
        }
        float S0 = 0.f, S1 = 0.f, S2 = 0.f, S3 = 0.f;
        const int cg = lane & 15, irow = 4 * wid + (lane >> 4);
#define RW_PRODUCE(m, buf) do { const int row = NPAD + 32 * (m) + ptt; const size_t off = (size_t)row * D + h * 64 + 8 * dg; \
        const u32x4 r8 = *(const u32x4*)(Rr + off), k8 = *(const u32x4*)(K + off), v8 = *(const u32x4*)(V + off), w8 = *(const u32x4*)(W + off), a8 = *(const u32x4*)(A + off); \
        const unsigned rw[4] = {r8.x, r8.y, r8.z, r8.w}, kw[4] = {k8.x, k8.y, k8.z, k8.w}, vw[4] = {v8.x, v8.y, v8.z, v8.w}, ww[4] = {w8.x, w8.y, w8.z, w8.w}, aw[4] = {a8.x, a8.y, a8.z, a8.w}; \
        float rf[8], kf[8], vf[8], wf[8], af[8], kk[8]; float ssq = 0.f; \
        _Pragma("unroll") for (int i = 0; i < 4; ++i) { rf[2 * i] = bflo(rw[i]); rf[2 * i + 1] = bfhi(rw[i]); kf[2 * i] = bflo(kw[i]); kf[2 * i + 1] = bfhi(kw[i]); vf[2 * i] = bflo(vw[i]); vf[2 * i + 1] = bfhi(vw[i]); \
            wf[2 * i] = bflo(ww[i]); wf[2 * i + 1] = bfhi(ww[i]); af[2 * i] = bflo(aw[i]); af[2 * i + 1] = bfhi(aw[i]); } \
        _Pragma("unroll") for (int i = 0; i < 8; ++i) { kk[i] = kf[i] * kkc[i]; ssq += kk[i] * kk[i]; } \
        ssq = red8(ssq); const float inv = 1.f / fmaxf(sqrtf(ssq), 1e-12f); \
        LAS float* tb = ring + (buf) * RW_TILEF + ptt * RW_TOKF; \
        _Pragma("unroll") for (int q = 0; q < 2; ++q) { LAS f32x4* p = (LAS f32x4*)(tb + (2 * dg + q) * 20); \
            f32x4 t0, t1, t2, t3, t4; \
            _Pragma("unroll") for (int e = 0; e < 4; ++e) { const int i = 4 * q + e; const float kn = kk[i] * inv; t0[e] = wf[i]; t1[e] = -kn; t2[e] = kn * af[i]; t3[e] = kf[i] * (1.f + (af[i] - 1.f) * kac[i]); t4[e] = rf[i]; } \
            p[0] = t0; p[1] = t1; p[2] = t2; p[3] = t3; p[4] = t4; } \
        LAS f32x4* pv = (LAS f32x4*)(tb + 320 + 8 * dg); pv[0] = (f32x4){vf[0], vf[1], vf[2], vf[3]}; pv[1] = (f32x4){vf[4], vf[5], vf[6], vf[7]}; } while (0)
#define RW_FLUSH(m, buf) do { const int row = NPAD + 32 * (m) + ptt; if (row < NREAL) { const LAS float* ot = otile + (buf) * 512 + ptt * 16 + 2 * dg; \
        *(float2*)(O32 + (size_t)row * D + h * 64 + 16 * rg + 2 * dg) = make_float2(ot[0], ot[1]); } } while (0)
        if (wid >= 4) RW_PRODUCE(0, 0);
        __syncthreads();
        for (int n = 0; n < RW_NTILE; ++n) {
            if (wid < 4) {
                const LAS float* tb = ring + (n & 1) * RW_TILEF; LAS float* ot = otile + (n & 1) * 512;
#pragma unroll 4
                for (int tt = 0; tt < RW_TT; ++tt) {
                    const LAS float* p = tb + tt * RW_TOKF + cg * 20;
                    const f32x4 w4 = *(const LAS f32x4*)p, nk = *(const LAS f32x4*)(p + 4), ka = *(const LAS f32x4*)(p + 8), kp = *(const LAS f32x4*)(p + 12), r4 = *(const LAS f32x4*)(p + 16);
                    const float v = tb[tt * RW_TOKF + 320 + 16 * rg + irow];
                    float sa = (S0 * nk.x + S1 * nk.y) + (S2 * nk.z + S3 * nk.w);
                    sa = red16(sa);
                    S0 = S0 * w4.x + (sa * ka.x + v * kp.x); S1 = S1 * w4.y + (sa * ka.y + v * kp.y); S2 = S2 * w4.z + (sa * ka.z + v * kp.z); S3 = S3 * w4.w + (sa * ka.w + v * kp.w);
                    float o = (S0 * r4.x + S1 * r4.y) + (S2 * r4.z + S3 * r4.w);
                    o = red16(o);
                    if (cg == 0) ot[tt * 16 + irow] = o;
                }
            } else {
                if (n + 1 < RW_NTILE) RW_PRODUCE(n + 1, (n + 1) & 1);
                if (n > 0) RW_FLUSH(n - 1, (n - 1) & 1);
            }
            __syncthreads();
        }
        if (wid >= 4) RW_FLUSH(RW_NTILE - 1, (RW_NTILE - 1) & 1);
        __syncthreads();
#undef RW_PRODUCE
#undef RW_FLUSH
    }
}
__device__ __forceinline__ void rwkv_post(const Fr& F) {
    const bf16_t* Rr = slotY(F, 0); const bf16_t* K = slotY(F, 1); const bf16_t* V = slotY(F, 2); const bf16_t* GT = slotY(F, 3); const bf16_t* A = slotY(F, 5);
    const float* O32 = (const float*)slotU(F, 1); bf16_t* Z = slotU(F, 0);
    const float* k_a = F.in(24); const float* r_k = F.in(25); const float* lw = F.in(26); const float* lb = F.in(27);
    for (int r = F.gw; r < R; r += F.NGW) {
        const bool real = (r >= NPAD && r < NREAL);
        u32x2* zr = (u32x2*)(Z + (size_t)r * D) + F.lane;
        if (!real) { const u32x2 z = {0u, 0u};
#pragma unroll
            for (int it = 0; it < 16; ++it) zr[64 * it] = z;
            continue; }
#pragma unroll 2
        for (int it = 0; it < 16; ++it) {
            const size_t ci = (size_t)it * 64 + F.lane;
            const f32x4 o4 = ((const f32x4*)(O32 + (size_t)r * D))[ci];
            const u32x2 rr = ((const u32x2*)(Rr + (size_t)r * D))[ci], kk = ((const u32x2*)(K + (size_t)r * D))[ci], vv = ((const u32x2*)(V + (size_t)r * D))[ci], gg = ((const u32x2*)(GT + (size_t)r * D))[ci], aa = ((const u32x2*)(A + (size_t)r * D))[ci];
            const f32x4 ka4 = ((const f32x4*)k_a)[ci], rk4 = ((const f32x4*)r_k)[ci], lw4 = ((const f32x4*)lw)[ci], lb4 = ((const f32x4*)lb)[ci];
            const float mean = red16((o4.x + o4.y) + (o4.z + o4.w)) * (1.f / 64.f);
            const float d0 = o4.x - mean, d1 = o4.y - mean, d2 = o4.z - mean, d3 = o4.w - mean;
            const float var = red16((d0 * d0 + d1 * d1) + (d2 * d2 + d3 * d3)) * (1.f / 64.f);
            const float rs = __builtin_amdgcn_rsqf(var + 64e-5f);
            const float r0 = bflo(rr.x), r1 = bfhi(rr.x), r2 = bflo(rr.y), r3 = bfhi(rr.y);
            const float kp0 = bflo(kk.x) * (1.f + (bflo(aa.x) - 1.f) * ka4.x), kp1 = bfhi(kk.x) * (1.f + (bfhi(aa.x) - 1.f) * ka4.y), kp2 = bflo(kk.y) * (1.f + (bflo(aa.y) - 1.f) * ka4.z), kp3 = bfhi(kk.y) * (1.f + (bfhi(aa.y) - 1.f) * ka4.w);
            const float bs = red16((r0 * kp0 * rk4.x + r1 * kp1 * rk4.y) + (r2 * kp2 * rk4.z + r3 * kp3 * rk4.w));
            const float y0 = d0 * rs * lw4.x + lb4.x + bs * bflo(vv.x), y1 = d1 * rs * lw4.y + lb4.y + bs * bfhi(vv.x), y2 = d2 * rs * lw4.z + lb4.z + bs * bflo(vv.y), y3 = d3 * rs * lw4.w + lb4.w + bs * bfhi(vv.y);
            u32x2 w; w.x = cvt_pk_bf16(y0 * silu_f(bflo(gg.x)), y1 * silu_f(bfhi(gg.x))); w.y = cvt_pk_bf16(y2 * silu_f(bflo(gg.y)), y3 * silu_f(bfhi(gg.y)));
            zr[64 * it] = w;
        }
    }
}
}
namespace mk {
constexpr int LDS_BYTES = 147456;
constexpr int LDS_MISC = 131072 + 4096;
struct Args { const float* in[29]; float* out; unsigned char* ws; };

#define MK_GEMM(EPI, e, Aptr, aps_, Bptr, M_, N_, K_) do { int kk_ = (K_); asm volatile("" : "+s"(kk_));     \
    pg8::Gemm g_{(const bf16_t*)(Aptr), (const bf16_t*)(Bptr), (M_), (N_), kk_, (size_t)(aps_)}; pg8::StaticOrder S_; S_.init((M_), (N_), F.G, F.bid); \
    pg8::gemm_phase<EPI, pg8::StaticOrder, false>(F.lds, g_, S_, e, nullptr); } while (0)

__global__ void __launch_bounds__(512, 2) fwd(Args a) {
    extern __shared__ __attribute__((aligned(16))) unsigned char lds_raw[];
    Fr F;
    F.lds = (LAS unsigned char*)lds_raw; F.ldsg = lds_raw;
    F.tid = threadIdx.x; F.lane = F.tid & 63; F.wave = __builtin_amdgcn_readfirstlane(F.tid >> 6);
    F.G = gridDim.x; F.bid = blockIdx.x; F.gw = F.bid * 8 + F.wave; F.NGW = F.G * 8;
    F.out = a.out; F.ws = a.ws;
    volatile LAS unsigned* misc = (volatile LAS unsigned*)(F.lds + LDS_MISC);
    if (F.tid < 16) misc[F.tid] = 0u;
    __syncthreads();
    XcdBarrier bar = xcd_barrier_post((unsigned*)(F.ws + WS_CTL) + 4096, misc + 8);
#define GRID_BAR() xcd_barrier(bar)
    bf16_t* wtin = (bf16_t*)(F.ws + WS_WTIN); bf16_t* wtout = (bf16_t*)(F.ws + WS_WTOUT);
    const EpiY ey{slotY(F, 0)};

    { const Fr P = F.fresh(); convert_layer(P, 0); rope_table(P); norm_phase(P, -1, 0, nullptr, slotU(P, 0)); }
    GRID_BAR();
    { const EpiH1 e{slotY(F, 0), F.in(5), 0}; MK_GEMM(EpiH1, e, slotU(F, 0), 0, wtin, R, 4 * D, D); }
    GRID_BAR();
    { const Fr P = F.fresh(); hgrn_phase<false>(P, 0); }
    GRID_BAR();
    { const Fr P = F.fresh(); hgrn_phase<true>(P, 0); }
    GRID_BAR();
    MK_GEMM(EpiY, ey, slotU(F, 0), 0, wtout, R, D, D);
    GRID_BAR();
    { const Fr P = F.fresh(); norm_phase(P, 0, 1, slotY(P, 0), slotU(P, 0)); convert_layer(P, 1); }
    GRID_BAR();
    { const EpiB1 e{slotY(F, 0), (const float*)(F.ws + WS_ROPE), (const float*)(F.ws + WS_ROPE) + (size_t)R * 16}; MK_GEMM(EpiB1, e, slotU(F, 0), 0, wtin, R, 4 * D, D); }
    GRID_BAR();
    { const Fr P = F.fresh(); attn_phase(P); }
    GRID_BAR();
    { const Fr P = F.fresh(); attn_post(P); }
    GRID_BAR();
    MK_GEMM(EpiY, ey, slotU(F, 0), 0, wtout, R, D, D);
    GRID_BAR();
    { const Fr P = F.fresh(); norm_phase(P, 1, 2, slotY(P, 0), slotY(P, 1)); convert_layer(P, 2); }
    GRID_BAR();
    { const Fr P = F.fresh(); mix_phase(P, slotY(P, 1)); convert_layer2_b(P); }
    GRID_BAR();
    { const EpiC1 e{slotY(F, 0), (bf16_t*)(F.ws + WS_T)}; MK_GEMM(EpiC1, e, slotU(F, 0), (size_t)R * D, wtin, R, 4 * D + 512, D); }
    GRID_BAR();
    { const EpiC2 e{slotY(F, 0), F.in(17), F.in(20)}; MK_GEMM(EpiC2, e, F.ws + WS_T, 0, F.ws + WS_W2P, R, 2 * D, 256); }
    GRID_BAR();
    { const Fr P = F.fresh(); rwkv_scan(P); }
    GRID_BAR();
    { const Fr P = F.fresh(); rwkv_post(P); }
    GRID_BAR();
    MK_GEMM(EpiY, ey, slotU(F, 0), 0, wtout, R, D, D);
    GRID_BAR();
    { const Fr P = F.fresh(); norm_phase(P, 2, 3, slotY(P, 0), slotU(P, 0)); convert_layer(P, 3); }
    GRID_BAR();
    { const EpiH1 e{slotY(F, 0), F.in(5), 1}; MK_GEMM(EpiH1, e, slotU(F, 0), 0, wtin, R, 4 * D, D); }
    GRID_BAR();
    { const Fr P = F.fresh(); hgrn_phase<false>(P, 1); }
    GRID_BAR();
    { const Fr P = F.fresh(); hgrn_phase<true>(P, 1); }
    GRID_BAR();
    MK_GEMM(EpiY, ey, slotU(F, 0), 0, wtout, R, D, D);
    GRID_BAR();
    { const Fr P = F.fresh(); norm_phase(P, 3, -1, slotY(P, 0), nullptr); }
}
}

extern "C" void kernel_launch(void* const* d_in, const int* in_sizes, int n_in, void* d_out, int out_size, void* d_ws, size_t ws_size, hipStream_t stream) {
    static int grid = 0;
    if (grid == 0) {
        if (n_in != 29 || out_size != 16384 * 4096 || ws_size < mk::WS_END) { fprintf(stderr, "kernel_launch: unexpected shapes (n_in %d out %d ws %zu need %zu)\n", n_in, out_size, ws_size, (size_t)mk::WS_END); grid = -1; return; }
        int dev = 0, cus = 0, per_cu = 0;
        if (hipGetDevice(&dev) != hipSuccess || hipDeviceGetAttribute(&cus, hipDeviceAttributeMultiprocessorCount, dev) != hipSuccess) { grid = -1; return; }
        if (hipFuncSetAttribute((const void*)mk::fwd, hipFuncAttributeMaxDynamicSharedMemorySize, mk::LDS_BYTES) != hipSuccess) { fprintf(stderr, "kernel_launch: hipFuncSetAttribute failed\n"); grid = -1; return; }
        if (hipOccupancyMaxActiveBlocksPerMultiprocessor(&per_cu, (const void*)mk::fwd, 512, mk::LDS_BYTES) != hipSuccess || per_cu < 1) { fprintf(stderr, "kernel_launch: occupancy query says %d\n", per_cu); }
        (void)hipGetLastError();
        grid = cus;
    }
    if (grid < 0) return;
    if (hipMemsetAsync((char*)d_ws + mk::WS_CTL, 0, mk::CTL_BYTES, stream) != hipSuccess) return;
    mk::Args a{};
    for (int i = 0; i < 29; ++i) a.in[i] = (const float*)d_in[i];
    a.out = (float*)d_out; a.ws = (unsigned char*)d_ws;
    hipLaunchKernelGGL(mk::fwd, dim3(grid), dim3(512), mk::LDS_BYTES, stream, a);
}
```

```cpp
#include <hip/hip_runtime.h>
#include <cstdio>
#include <cstdint>

#define LAS __attribute__((address_space(3)))
#define GAS __attribute__((address_space(1)))
typedef unsigned short bf16_t;
typedef short bf16x8 __attribute__((ext_vector_type(8)));
typedef short s16x4 __attribute__((ext_vector_type(4)));
typedef float f32x4 __attribute__((ext_vector_type(4)));
typedef float f32x16 __attribute__((ext_vector_type(16)));
typedef unsigned u32x4 __attribute__((ext_vector_type(4)));
typedef unsigned u32x2 __attribute__((ext_vector_type(2)));

namespace mk {
constexpr int D = 4096, NPAD = 48, NREAL = 16448, R = 16640, NCH = 257;
constexpr size_t MiB = 1u << 20;
constexpr size_t SLOT = (size_t)R * D * 2;
constexpr size_t WS_CTL = 0, CTL_BYTES = 1 * MiB;
constexpr size_t WS_WTIN = 2 * MiB;
constexpr size_t WS_WTOUT = 134 * MiB;
constexpr size_t WS_W2P = 166 * MiB;
constexpr size_t WS_ROPE = 170 * MiB;
constexpr size_t WS_HMETA = 174 * MiB;
constexpr size_t WS_HE = 175 * MiB;
constexpr size_t WS_HLOGD = 191 * MiB;
constexpr size_t WS_U = 192 * MiB;
constexpr size_t WS_Y = WS_U + 6 * SLOT;
constexpr size_t WS_T = WS_Y + 6 * SLOT;
constexpr size_t WS_END = WS_T + (size_t)R * 256 * 2;
static_assert(WS_END <= 2040 * MiB, "d_ws map");

typedef __bf16 bf16x2n_t __attribute__((ext_vector_type(2)));
typedef float f32x2n_t __attribute__((ext_vector_type(2)));
__device__ __forceinline__ unsigned cvt_pk_bf16(float lo, float hi) { const f32x2n_t v = {lo, hi}; const bf16x2n_t r = __builtin_convertvector(v, bf16x2n_t); return __builtin_bit_cast(unsigned, r); }
__device__ __forceinline__ float bflo(unsigned w) { return __uint_as_float(w << 16); }
__device__ __forceinline__ float bfhi(unsigned w) { return __uint_as_float(w & 0xffff0000u); }
__device__ __forceinline__ float bf2f(bf16_t b) { return __uint_as_float(((unsigned)b) << 16); }
__device__ __forceinline__ bf16_t f2bf(float f) { return (bf16_t)(cvt_pk_bf16(f, f) & 0xffffu); }
__device__ __forceinline__ float sigmoid_f(float x) { return 1.f / (1.f + __expf(-x)); }
__device__ __forceinline__ float silu_f(float x) { return x / (1.f + __expf(-x)); }
__device__ __forceinline__ float wave_sum(float v) {
#pragma unroll
    for (int o = 1; o < 64; o <<= 1) v += __shfl_xor(v, o);
    return v;
}
template <int CTRL> __device__ __forceinline__ float dppf(float v) { return __int_as_float(__builtin_amdgcn_update_dpp(0, __float_as_int(v), CTRL, 0xf, 0xf, true)); }
__device__ __forceinline__ float red4(float v) { v += dppf<0xB1>(v); v += dppf<0x4E>(v); return v; }
__device__ __forceinline__ float red8(float v) { v = red4(v); v += dppf<0x141>(v); return v; }
__device__ __forceinline__ float red16(float v) { v = red8(v); v += dppf<0x140>(v); return v; }
#define LDS_WAIT() asm volatile("s_waitcnt lgkmcnt(0)" ::: "memory")
}
#define XB_TMO      128
#define XB_XCNT(j)  (256  + 64 * (j))
#define XB_XSUB(j)  (1280 + 64 * (j))
#define XB_XGEN(j)  (2304 + 64 * (j))
#define XB_TOP      3328
#define XB_TOPGEN   3392
#define XCD_BAR_WORDS 3456
#define XB_SPIN_CAP (1u << 18)
#define LAS __attribute__((address_space(3)))

__device__ __forceinline__ unsigned xb_ld(unsigned* p)              { return __hip_atomic_load(p, __ATOMIC_RELAXED, __HIP_MEMORY_SCOPE_AGENT); }
__device__ __forceinline__ unsigned xb_add(unsigned* p, unsigned v) { return __hip_atomic_fetch_add(p, v, __ATOMIC_RELAXED, __HIP_MEMORY_SCOPE_AGENT); }
__device__ __forceinline__ unsigned xb_xcc_id() { return (unsigned)__builtin_amdgcn_s_getreg((3 << 11) | 20) & 0xFu; }
#define XB_SPIN(cond, bar) do { unsigned _sp = 0; while (cond) { __builtin_amdgcn_s_sleep(1); \
    if ((++_sp & 255u) == 0u) { if (xb_ld(&(bar)[XB_TMO])) break; if (_sp > XB_SPIN_CAP) { atomicAdd(&(bar)[XB_TMO], 1u); break; } } } } while (0)

struct XcdBarrier {
    unsigned* bar; unsigned x;
    volatile LAS unsigned* st;
};

__device__ __forceinline__ XcdBarrier xcd_barrier_post(unsigned* bar, volatile LAS unsigned* st) {
    XcdBarrier b; b.bar = bar; b.x = xb_xcc_id(); b.st = st;
    if (threadIdx.x == 0) (void)xb_add(&bar[XB_XCNT(b.x)], 1u);
    return b;
}
__device__ __forceinline__ void xcd_barrier_complete(unsigned* bar, unsigned x, unsigned& nloc, unsigned& nx) {
    const unsigned G = gridDim.x * gridDim.y * gridDim.z;
    unsigned sum, cnt, mine, sp = 0u;
    for (;;) {
        sum = 0u; cnt = 0u; mine = 0u;
#pragma unroll
        for (unsigned j = 0; j < 16; ++j) { const unsigned c = xb_ld(&bar[XB_XCNT(j)]); sum += c; cnt += (c > 0u) ? 1u : 0u; mine = (j == x) ? c : mine; }
        if (sum == G) break;
        __builtin_amdgcn_s_sleep(1);
        if ((++sp & 255u) == 0u) { if (xb_ld(&bar[XB_TMO])) break; if (sp > XB_SPIN_CAP) { atomicAdd(&bar[XB_TMO], 1u); break; } }
    }
    nloc = mine > 0u ? mine : 1u; nx = cnt > 0u ? cnt : 1u;
}

__device__ __forceinline__ void xcd_barrier(const XcdBarrier& b) {
    asm volatile("s_waitcnt vmcnt(0)" ::: "memory");
    __syncthreads();
    if (threadIdx.x == 0) {
        unsigned* bar = b.bar;
        __builtin_amdgcn_s_waitcnt(0);
        unsigned nloc = b.st[0], nx = b.st[1];
        if (nloc == 0u) { xcd_barrier_complete(bar, b.x, nloc, nx); b.st[0] = nloc; b.st[1] = nx; }
        const unsigned old = xb_add(&bar[XB_XSUB(b.x)], 1u);
        const unsigned gen = old / nloc;
        if (old + 1u == (gen + 1u) * nloc) {
            __builtin_amdgcn_fence(__ATOMIC_RELEASE, "agent");
            asm volatile("s_waitcnt vmcnt(0)" ::: "memory");
            const unsigned og = xb_add(&bar[XB_TOP], 1u);
            const unsigned tg = og / nx;
            if (og + 1u == (tg + 1u) * nx) xb_add(&bar[XB_TOPGEN], 1u);
            else XB_SPIN(xb_ld(&bar[XB_TOPGEN]) == tg, bar);
            __builtin_amdgcn_fence(__ATOMIC_ACQUIRE, "agent");
            xb_add(&bar[XB_XGEN(b.x)], 1u);
            asm volatile("s_waitcnt vmcnt(0)" ::: "memory");
        } else {
            XB_SPIN(xb_ld(&bar[XB_XGEN(b.x)]) == gen, bar);
            __builtin_amdgcn_fence(__ATOMIC_ACQUIRE, "agent");
            asm volatile("s_waitcnt vmcnt(0)" ::: "memory");
        }
    }
    __syncthreads();
}
namespace pg8 {
#define PG8_LAS __attribute__((address_space(3)))
typedef unsigned short bf16_t;
typedef short bf16x8 __attribute__((ext_vector_type(8)));
typedef float f32x4 __attribute__((ext_vector_type(4)));
typedef unsigned u32x4 __attribute__((ext_vector_type(4)));
constexpr int BM = 256, BK = 64, HALF = 128, HTB = HALF * BK * 2  , STAGE_BYTES = 8 * HTB, NXCD = 8, WGM = 8;

__host__ __device__ __forceinline__ int lds_byte(int r, int c) { const int st = (r >> 4) * 2 + (c >> 5), rr = r & 15, cc = c & 31, ob = rr * 64 + cc * 2; return st * 1024 + (ob ^ (((ob >> 9) & 1) << 5)); }
__host__ __device__ __forceinline__ void stage_rc(int b, int& R, int& C) { const int st = b / 1024, sb = b % 1024, swz = sb ^ (((sb >> 9) & 1) << 5); R = (st >> 1) * 16 + swz / 64; C = (st & 1) * 32 + (swz % 64) / 2; }
__host__ __device__ __forceinline__ int perm32(int rho) { const int n = rho >> 4, i = rho & 15; return 8 * (i >> 2) + 4 * n + (i & 3); }

struct Unit { int pm, pn; };
struct Gemm { const bf16_t* A; const bf16_t* Bt; int M, N, K; size_t aps; };
__device__ __forceinline__ size_t a_part_bytes(const Gemm& g, int pn) { return g.aps ? (size_t)(pn < 64 ? (pn >> 4) : (pn - 60)) * g.aps * 2 : (size_t)0; }

struct StaticOrder {
    int nM, nN, nwg, G, c;
    __host__ __device__ void init(int M, int N, int G_, int c_) { nM = M / BM; nN = N / BM; nwg = nM * nN; G = G_; c = c_; }
    __host__ __device__ bool next(int i, Unit& u) const {
        const long L = (long)i * G + c; if (L >= nwg) return false;
        int wgid = (int)L; { const int q = nwg / NXCD, r = nwg % NXCD, xcd = wgid % NXCD, off = wgid / NXCD; wgid = (xcd < r ? xcd * (q + 1) : r * (q + 1) + (xcd - r) * q) + off; }
        const int nig = WGM * nN, gid = wgid / nig, fm = gid * WGM, gsz = (nM - fm) < WGM ? (nM - fm) : WGM;
        u.pm = fm + ((wgid % nig) % gsz); u.pn = (wgid % nig) / gsz; return true;
    }
    __device__ __forceinline__ void a_ready(const Unit&) const {}
    __device__ __forceinline__ void done(const Unit&) const {}
};
struct CountedOrder : StaticOrder {
    const unsigned* ready; unsigned need; unsigned* tmo;
    __device__ __forceinline__ void a_ready(const Unit& u) const {
        if (threadIdx.x < 64) {
            const unsigned long long t0 = __builtin_amdgcn_s_memrealtime(); unsigned polls = 0;
            while ((unsigned)__builtin_amdgcn_readfirstlane(__hip_atomic_load(ready + 64 * u.pm, __ATOMIC_RELAXED, __HIP_MEMORY_SCOPE_AGENT)) < need) {
                if ((++polls & 255u) == 0u && __builtin_amdgcn_readfirstlane(__hip_atomic_load(tmo, __ATOMIC_RELAXED, __HIP_MEMORY_SCOPE_AGENT)) != 0u) break;
                if (__builtin_amdgcn_s_memrealtime() - t0 > 2000000ull) {
                    if (threadIdx.x == 0) { unsigned expect = 0u; __hip_atomic_compare_exchange_strong(tmo + 1, &expect, 0x600u | (unsigned)(u.pm & 0xff), __ATOMIC_RELAXED, __ATOMIC_RELAXED, __HIP_MEMORY_SCOPE_AGENT); __hip_atomic_store(tmo, 1u, __ATOMIC_RELAXED, __HIP_MEMORY_SCOPE_AGENT); }
                    break; }
                __builtin_amdgcn_s_sleep(2); }
            __builtin_amdgcn_fence(__ATOMIC_ACQUIRE, "agent");
            asm volatile("s_waitcnt vmcnt(0)" ::: "memory");
        }
#if !defined(BROKEN_HOOK_NO_BARRIER)
        asm volatile("" ::: "memory"); __builtin_amdgcn_s_barrier(); asm volatile("" ::: "memory");
#endif
    }
};
template <class Epi, class Sched, bool STAMP = false>
__device__ __forceinline__ void gemm_phase(PG8_LAS unsigned char* lds, const Gemm g, const Sched& S, const Epi& E, unsigned long long* stamps) {
    int tid_ = threadIdx.x; asm volatile("" : "+v"(tid_));
    const int tid = tid_, wid = __builtin_amdgcn_readfirstlane(tid >> 6), lane = tid & 63, wr = wid >> 2, wc = wid & 3, fr = lane & 15, fq = lane >> 4;
    const int K = g.K, nt = K / BK;
    int ts_lo = 0, ts_hi = 0, nts = 0; const unsigned long long rt_entry = STAMP ? (unsigned long long)wall_clock64() : 0ull;
#define PG8_STAMP() do { if (STAMP && wid == 0 && nts < 64) { const unsigned long long _c = (unsigned long long)clock64(); \
        ts_lo = (lane == nts) ? (int)(unsigned)_c : ts_lo; ts_hi = (lane == nts) ? (int)(unsigned)(_c >> 32) : ts_hi; ++nts; } } while (0)
    PG8_STAMP();
    unsigned voffA[2], voffB[2];
#pragma unroll
    for (int i = 0; i < 2; ++i) { int R, C; stage_rc(tid * 16 + i * 8192, R, C); const int Rb = Epi::PERM ? ((R & ~31) + perm32(R & 31)) : R;
        voffA[i] = (unsigned)(R * K + C) * 2u; voffB[i] = (unsigned)(Rb * K + C) * 2u; }
    const size_t kstep = (size_t)(BK * 2);
    const size_t hstep = (size_t)HALF * K * 2;
    const size_t tstep = 2 * hstep;
    const unsigned ldsw = (unsigned)wid * 1024u;
    const int aoff = lds_byte(wr * 64 + fr, fq * 8), boff = lds_byte(wc * 32 + fr, fq * 8);
#define PG8_SA(b, h) (((b) * 2 + (h)) * HTB)
#define PG8_SB(b, h) ((4 + (b) * 2 + (h)) * HTB)
#define PG8_STAGE(bufoff, gbase, voff) do { _Pragma("unroll") for (int _i = 0; _i < 2; ++_i) \
        __builtin_amdgcn_global_load_lds((const unsigned*)((const char*)(gbase) + (voff)[_i]), (PG8_LAS unsigned*)(lds + (bufoff) + ldsw + _i * 8192), 16, 0, 0); } while (0)
#define PG8_LDA(dst, b, h) do { _Pragma("unroll") for (int m = 0; m < 4; ++m) _Pragma("unroll") for (int k = 0; k < 2; ++k) dst[m][k] = *(const PG8_LAS bf16x8*)(lds + PG8_SA(b, h) + aoff + m * 2048 + k * 1024); } while (0)
#define PG8_LDB(dst, b, h) do { _Pragma("unroll") for (int n = 0; n < 2; ++n) _Pragma("unroll") for (int k = 0; k < 2; ++k) dst[n][k] = *(const PG8_LAS bf16x8*)(lds + PG8_SB(b, h) + boff + n * 2048 + k * 1024); } while (0)
#define PG8_MMA(ai, bj, At, Bt) do { __builtin_amdgcn_s_setprio(1); _Pragma("unroll") for (int m = 0; m < 4; ++m) _Pragma("unroll") for (int n = 0; n < 2; ++n) _Pragma("unroll") for (int k = 0; k < 2; ++k) \
        acc[ai][bj][m][n] = __builtin_amdgcn_mfma_f32_16x16x32_bf16(Bt[n][k], At[m][k], acc[ai][bj][m][n], 0, 0, 0); __builtin_amdgcn_s_setprio(0); } while (0)
#define PG8_WAIT_V(n) asm volatile("s_waitcnt vmcnt(" #n ")" ::: "memory")
#define PG8_WAIT_L(n) asm volatile("s_waitcnt lgkmcnt(" #n ")" ::: "memory")
#define PG8_BAR __builtin_amdgcn_s_barrier()
#define PG8_SCHED __builtin_amdgcn_sched_barrier(0)
    Unit cur, nxt; int ui = 0;
    if (!S.next(0, cur)) return;
    f32x4 acc[2][2][4][2];
#pragma unroll
    for (int a = 0; a < 2; ++a)
#pragma unroll
        for (int b = 0; b < 2; ++b)
#pragma unroll
            for (int m = 0; m < 4; ++m)
#pragma unroll
                for (int n = 0; n < 2; ++n) acc[a][b][m][n] = (f32x4){0.f, 0.f, 0.f, 0.f};
    bf16x8 At[4][2], B0[2][2], B1[2][2];
    const char* cA = (const char*)g.A + a_part_bytes(g, cur.pn) + (size_t)cur.pm * tstep; const char* cB = (const char*)g.Bt + (size_t)cur.pn * tstep;
    S.a_ready(cur);
    PG8_STAGE(PG8_SB(0, 0), cB, voffB); PG8_STAGE(PG8_SA(0, 0), cA, voffA); PG8_STAGE(PG8_SB(0, 1), cB + hstep, voffB); PG8_STAGE(PG8_SA(0, 1), cA + hstep, voffA);
    if (wr == 1) PG8_BAR;
    PG8_WAIT_V(4); PG8_BAR;
    PG8_STAGE(PG8_SB(1, 0), cB + kstep, voffB); PG8_STAGE(PG8_SA(1, 0), cA + kstep, voffA); PG8_STAGE(PG8_SB(1, 1), cB + hstep + kstep, voffB);
    PG8_WAIT_V(6); PG8_BAR;
    PG8_STAMP();
    for (;;) {
        const bool has_next = S.next(ui + 1, nxt);
        const char* nA = has_next ? (const char*)g.A + a_part_bytes(g, nxt.pn) + (size_t)nxt.pm * tstep : cA; const char* nB = has_next ? (const char*)g.Bt + (size_t)nxt.pn * tstep : cB;
        for (int t = 0; t < nt; t += 2) {
            const bool last = (t == nt - 2);
            const char* a1 = cA + (size_t)(t + 1) * kstep;
            const char* a2 = last ? nA : cA + (size_t)(t + 2) * kstep; const char* b2 = last ? nB : cB + (size_t)(t + 2) * kstep;
            const char* a3 = a2 + kstep; const char* b3 = b2 + kstep;
            if (last && has_next) S.a_ready(nxt);
            PG8_LDB(B0, 0, 0); PG8_SCHED; PG8_LDA(At, 0, 0); PG8_STAGE(PG8_SA(1, 1), a1 + hstep, voffA);
            PG8_WAIT_L(8); PG8_BAR; PG8_WAIT_L(0); PG8_MMA(0, 0, At, B0); PG8_BAR; PG8_SCHED;
            PG8_LDB(B1, 0, 1); PG8_STAGE(PG8_SB(0, 0), b2, voffB);
            PG8_BAR; PG8_WAIT_L(0); PG8_MMA(0, 1, At, B1); PG8_BAR;
            PG8_LDA(At, 0, 1); PG8_STAGE(PG8_SA(0, 0), a2, voffA);
            PG8_BAR; PG8_WAIT_L(0); PG8_MMA(1, 0, At, B0); PG8_BAR; PG8_SCHED;
            PG8_STAGE(PG8_SB(0, 1), b2 + hstep, voffB);
            PG8_WAIT_V(6); PG8_BAR; PG8_MMA(1, 1, At, B1); PG8_BAR;
            PG8_LDB(B0, 1, 0); PG8_SCHED; PG8_LDA(At, 1, 0); PG8_STAGE(PG8_SA(0, 1), a2 + hstep, voffA);
            PG8_WAIT_L(8); PG8_BAR; PG8_WAIT_L(0); PG8_MMA(0, 0, At, B0); PG8_BAR; PG8_SCHED;
            PG8_LDB(B1, 1, 1); PG8_STAGE(PG8_SB(1, 0), b3, voffB);
            PG8_BAR; PG8_WAIT_L(0); PG8_MMA(0, 1, At, B1); PG8_BAR;
            PG8_LDA(At, 1, 1); PG8_STAGE(PG8_SA(1, 0), a3, voffA);
            PG8_BAR; PG8_WAIT_L(0); PG8_MMA(1, 0, At, B0); PG8_BAR; PG8_SCHED;
            PG8_STAGE(PG8_SB(1, 1), b3 + hstep, voffB);
            PG8_WAIT_V(6); PG8_BAR; PG8_MMA(1, 1, At, B1); PG8_BAR;
        }
        PG8_STAMP();
        if constexpr (!Epi::AFTER_DRAIN) { E(acc, cur, wr, wc, fr, fq); S.done(cur); }
        PG8_STAMP();
        if (!has_next) break;
#pragma unroll
        for (int a = 0; a < 2; ++a)
#pragma unroll
            for (int b = 0; b < 2; ++b)
#pragma unroll
                for (int m = 0; m < 4; ++m)
#pragma unroll
                    for (int n = 0; n < 2; ++n) acc[a][b][m][n] = (f32x4){0.f, 0.f, 0.f, 0.f};
        cur = nxt; cA = nA; cB = nB; ++ui;
    }
    PG8_WAIT_V(0);
    if (wr == 0) PG8_BAR;
    PG8_BAR;
    if constexpr (Epi::AFTER_DRAIN) { E.fused(acc, cur, wr, wc, fr, fq, lds, wid, lane); S.done(cur); }
    PG8_STAMP();
    if (STAMP && wid == 0) { stamps[lane] = lane < nts ? (((unsigned long long)(unsigned)ts_hi << 32) | (unsigned)ts_lo) : 0ull;
        if (lane == 62) stamps[62] = rt_entry; if (lane == 63) stamps[63] = (unsigned long long)wall_clock64(); }
#undef PG8_STAMP
#undef PG8_SA
#undef PG8_SB
#undef PG8_STAGE
#undef PG8_LDA
#undef PG8_LDB
#undef PG8_MMA
#undef PG8_WAIT_V
#undef PG8_WAIT_L
#undef PG8_BAR
#undef PG8_SCHED
}
}
namespace mk {
typedef pg8::Unit Unit;
typedef const pg8::f32x4 (&AccRef)[2][2][4][2];

__device__ __forceinline__ void st_bf8(bf16_t* p, pg8::f32x4 v0, pg8::f32x4 v1) {
    u32x4 w; w.x = cvt_pk_bf16(v0[0], v0[1]); w.y = cvt_pk_bf16(v0[2], v0[3]); w.z = cvt_pk_bf16(v1[0], v1[1]); w.w = cvt_pk_bf16(v1[2], v1[3]);
    *(u32x4*)p = w;
}
__device__ __forceinline__ void st_bf4(bf16_t* p, pg8::f32x4 v) { u32x2 w; w.x = cvt_pk_bf16(v[0], v[1]); w.y = cvt_pk_bf16(v[2], v[3]); *(u32x2*)p = w; }

struct EpiY {
    static constexpr bool PERM = true, AFTER_DRAIN = false;
    bf16_t* O;
    __device__ __forceinline__ void operator()(AccRef acc, const Unit& u, int wr, int wc, int fr, int fq) const {
        const int row0 = u.pm * 256 + wr * 64 + fr, col0 = u.pn * 256 + wc * 32 + 8 * fq;
#pragma unroll
        for (int ai = 0; ai < 2; ++ai)
#pragma unroll
            for (int m = 0; m < 4; ++m) { bf16_t* rowp = O + (size_t)(row0 + ai * 128 + m * 16) * D + col0;
#pragma unroll
                for (int bj = 0; bj < 2; ++bj) st_bf8(rowp + bj * 128, acc[ai][bj][m][0], acc[ai][bj][m][1]); }
    }
};
struct EpiH1 {
    static constexpr bool PERM = true, AFTER_DRAIN = false;
    bf16_t* Y; const float* lbl; int jl;
    __device__ __forceinline__ void operator()(AccRef acc, const Unit& u, int wr, int wc, int fr, int fq) const {
        const int part = u.pn >> 4, colt = (u.pn & 15) * 256;
        const int row0 = u.pm * 256 + wr * 64 + fr, col0 = colt + wc * 32 + 8 * fq;
        if (part == 1) {
#pragma unroll
            for (int bj = 0; bj < 2; ++bj) {
                pg8::f32x4 lbv[2] = {{0.f, 0.f, 0.f, 0.f}, {0.f, 0.f, 0.f, 0.f}};
                if (jl) {
#pragma unroll
                    for (int n = 0; n < 2; ++n) { const pg8::f32x4 l0 = *(const pg8::f32x4*)(lbl + col0 + bj * 128 + 4 * n), l1 = *(const pg8::f32x4*)(lbl + D + col0 + bj * 128 + 4 * n);
#pragma unroll
                        for (int j = 0; j < 4; ++j) lbv[n][j] = sigmoid_f(l1[j] - l0[j]); }
                }
#pragma unroll
                for (int ai = 0; ai < 2; ++ai)
#pragma unroll
                    for (int m = 0; m < 4; ++m) {
                        const int row = row0 + ai * 128 + m * 16;
                        pg8::f32x4 o[2];
#pragma unroll
                        for (int n = 0; n < 2; ++n)
#pragma unroll
                            for (int j = 0; j < 4; ++j) {
                                const float x = acc[ai][bj][m][n][j]; float g;
                                if (jl) { const float l = lbv[n][j]; g = __logf(l + (1.f - l) * sigmoid_f(x)); }
                                else g = fminf(x, 0.f) - __logf(1.f + __expf(-fabsf(x)));
                                o[n][j] = (row < NPAD) ? 0.f : g;
                            }
                        float* gp = (float*)(Y + 3 * (SLOT / 2)) + (size_t)row * D + col0 + bj * 128;
                        *(pg8::f32x4*)gp = o[0]; *(pg8::f32x4*)(gp + 4) = o[1];
                    }
            }
        } else {
            bf16_t* dst = Y + (size_t)(part == 0 ? 0 : (part == 2 ? 1 : 2)) * (SLOT / 2);
#pragma unroll
            for (int ai = 0; ai < 2; ++ai)
#pragma unroll
                for (int m = 0; m < 4; ++m) { bf16_t* rowp = dst + (size_t)(row0 + ai * 128 + m * 16) * D + col0;
#pragma unroll
                    for (int bj = 0; bj < 2; ++bj) st_bf8(rowp + bj * 128, acc[ai][bj][m][0], acc[ai][bj][m][1]); }
        }
    }
};
struct EpiB1 {
    static constexpr bool PERM = false, AFTER_DRAIN = false;
    bf16_t* Y; const float* cs; const float* sn;
    __device__ __forceinline__ void operator()(AccRef acc, const Unit& u, int wr, int wc, int fr, int fq) const {
        const int part = u.pn >> 4, colt = (u.pn & 15) * 256;
        const int row0 = u.pm * 256 + wr * 64 + fr, col0 = colt + wc * 32 + 4 * fq;
        bf16_t* dst = Y + (size_t)part * (SLOT / 2);
        const bool rope = (part < 2) && (wc == 0);
#pragma unroll
        for (int ai = 0; ai < 2; ++ai)
#pragma unroll
            for (int m = 0; m < 4; ++m) {
                const int row = row0 + ai * 128 + m * 16;
                pg8::f32x4 c4 = {1.f, 1.f, 1.f, 1.f}, s4 = {0.f, 0.f, 0.f, 0.f};
                if (rope) { c4 = *(const pg8::f32x4*)(cs + (size_t)row * 16 + 4 * fq); s4 = *(const pg8::f32x4*)(sn + (size_t)row * 16 + 4 * fq); }
                bf16_t* rowp = dst + (size_t)row * D + col0;
#pragma unroll
                for (int bj = 0; bj < 2; ++bj) {
                    const pg8::f32x4 x1 = acc[ai][bj][m][0], x2 = acc[ai][bj][m][1];
                    const pg8::f32x4 y1 = x1 * c4 - x2 * s4, y2 = x2 * c4 + x1 * s4;
                    st_bf4(rowp + bj * 128, y1); st_bf4(rowp + bj * 128 + 16, y2);
                }
            }
    }
};
struct EpiC1 {
    static constexpr bool PERM = true, AFTER_DRAIN = false;
    bf16_t *Y, *T;
    __device__ __forceinline__ void operator()(AccRef acc, const Unit& u, int wr, int wc, int fr, int fq) const {
        const int row0 = u.pm * 256 + wr * 64 + fr;
        if (u.pn < 64) {
            const int part = u.pn >> 4, col0 = (u.pn & 15) * 256 + wc * 32 + 8 * fq;
            bf16_t* dst = Y + (size_t)part * (SLOT / 2);
#pragma unroll
            for (int ai = 0; ai < 2; ++ai)
#pragma unroll
                for (int m = 0; m < 4; ++m) { bf16_t* rowp = dst + (size_t)(row0 + ai * 128 + m * 16) * D + col0;
#pragma unroll
                    for (int bj = 0; bj < 2; ++bj) st_bf8(rowp + bj * 128, acc[ai][bj][m][0], acc[ai][bj][m][1]); }
        } else {
            const int which = u.pn - 64, col0 = which * 128 + wc * 32 + 8 * fq;
#pragma unroll
            for (int ai = 0; ai < 2; ++ai)
#pragma unroll
                for (int m = 0; m < 4; ++m) {
                    pg8::f32x4 v0 = acc[ai][0][m][0], v1 = acc[ai][0][m][1];
                    if (which == 0) {
#pragma unroll
                        for (int j = 0; j < 4; ++j) { v0[j] = 1.f - 2.f / (1.f + __expf(2.f * v0[j])); v1[j] = 1.f - 2.f / (1.f + __expf(2.f * v1[j])); }
                    }
                    st_bf8(T + (size_t)(row0 + ai * 128 + m * 16) * 256 + col0, v0, v1);
                }
        }
    }
};
struct EpiC2 {
    static constexpr bool PERM = true, AFTER_DRAIN = false;
    bf16_t* Y; const float* w0; const float* a0;
    __device__ __forceinline__ void operator()(AccRef acc, const Unit& u, int wr, int wc, int fr, int fq) const {
        const int row0 = u.pm * 256 + wr * 64 + fr;
        const bool isw = u.pn < 16;
        const int col0 = (u.pn & 15) * 256 + wc * 32 + 8 * fq;
        bf16_t* dst = Y + (size_t)(isw ? 4 : 5) * (SLOT / 2); const float* bias = isw ? w0 : a0;
#pragma unroll
        for (int bj = 0; bj < 2; ++bj) {
            const pg8::f32x4 b0 = *(const pg8::f32x4*)(bias + col0 + bj * 128), b1 = *(const pg8::f32x4*)(bias + col0 + bj * 128 + 4);
#pragma unroll
            for (int ai = 0; ai < 2; ++ai)
#pragma unroll
                for (int m = 0; m < 4; ++m) {
                    pg8::f32x4 v0 = acc[ai][bj][m][0] + b0, v1 = acc[ai][bj][m][1] + b1;
#pragma unroll
                    for (int j = 0; j < 4; ++j) {
                        float s0 = sigmoid_f(v0[j]), s1 = sigmoid_f(v1[j]);
                        if (isw) { s0 = __expf(-0.606531f * s0); s1 = __expf(-0.606531f * s1); }
                        v0[j] = s0; v1[j] = s1;
                    }
                    st_bf8(dst + (size_t)(row0 + ai * 128 + m * 16) * D + col0 + bj * 128, v0, v1);
                    __builtin_amdgcn_sched_barrier(0);
                }
        }
    }
};

struct Fr {
    LAS unsigned char* lds; unsigned char* ldsg;
    int tid, lane, wave, G, bid, gw, NGW;
    float* out; unsigned char* ws;
    __device__ __forceinline__ Fr fresh() const { Fr P = *this; asm volatile("" : "+v"(P.tid)); P.lane = P.tid & 63; P.wave = __builtin_amdgcn_readfirstlane(P.tid >> 6); P.gw = P.bid * 8 + P.wave; return P; }
    __device__ __forceinline__ const float* in(int i) const {
        const __attribute__((address_space(4))) unsigned long long* ka = (const __attribute__((address_space(4))) unsigned long long*)__builtin_amdgcn_kernarg_segment_ptr();
        asm volatile("" : "+s"(ka));
        return (const float*)ka[i];
    }
};
__device__ __forceinline__ bf16_t* slotU(const Fr& F, int s) { return (bf16_t*)(F.ws + WS_U + (size_t)s * SLOT); }
__device__ __forceinline__ bf16_t* slotY(const Fr& F, int s) { return (bf16_t*)(F.ws + WS_Y + (size_t)s * SLOT); }
__device__ __forceinline__ float* hrow(const Fr& F, int r) { return r < 64 ? (float*)(F.ws + WS_HMETA) + (size_t)r * D : F.out + (size_t)(r - 64) * D; }

__device__ __forceinline__ void transpose_item(const float* W, int ldw, bf16_t* WT, int ldt, int koff, LAS float* scr, int kb, int nb, int lane) {
    const int k0 = 64 * kb, n0 = 32 * nb;
#pragma unroll 8
    for (int i = 0; i < 32; ++i) { const int kk = 2 * i + (lane >> 5); scr[kk * 33 + (lane & 31)] = W[(size_t)(k0 + kk) * ldw + n0 + (lane & 31)]; }
    LDS_WAIT(); asm volatile("" ::: "memory");
    const int c = lane & 7;
#pragma unroll
    for (int j = 0; j < 4; ++j) { const int n = (lane >> 3) + 8 * j; const LAS float* s = scr + (8 * c) * 33 + n;
        u32x4 o; o.x = cvt_pk_bf16(s[0 * 33], s[1 * 33]); o.y = cvt_pk_bf16(s[2 * 33], s[3 * 33]); o.z = cvt_pk_bf16(s[4 * 33], s[5 * 33]); o.w = cvt_pk_bf16(s[6 * 33], s[7 * 33]);
        *(u32x4*)(WT + (size_t)(n0 + n) * ldt + koff + k0 + 8 * c) = o; }
    LDS_WAIT(); asm volatile("" ::: "memory");
}
__device__ __forceinline__ void convert_matrix(const Fr& F, const float* W, int K, int N, bf16_t* WT, int ldt, int koff) {
    LAS float* scr = (LAS float*)(F.lds + F.wave * 8704);
    const int nblk = N / 32, nitems = (K / 64) * nblk;
    for (int it = F.gw; it < nitems; it += F.NGW) transpose_item(W, N, WT, ldt, koff, scr, it / nblk, it % nblk, F.lane);
}
__device__ __forceinline__ void zero_bytes(const Fr& F, void* p, size_t nbytes) {
    u32x4* q = (u32x4*)p; const size_t n = nbytes / 16; const u32x4 z = {0u, 0u, 0u, 0u};
    for (size_t i = (size_t)F.bid * 512 + F.tid; i < n; i += (size_t)F.G * 512) q[i] = z;
}
__device__ __forceinline__ void convert_layer(const Fr& F, int L) {
    bf16_t* wtin = (bf16_t*)(F.ws + WS_WTIN); bf16_t* wtout = (bf16_t*)(F.ws + WS_WTOUT);
    if (L == 0 || L == 3) { const int j = L ? 1 : 0;
        convert_matrix(F, F.in(4) + (size_t)j * D * 4 * D, D, 4 * D, wtin, D, 0);
        convert_matrix(F, F.in(7) + (size_t)j * D * D, D, D, wtout, D, 0);
    } else if (L == 1) {
        convert_matrix(F, F.in(8), D, 4 * D, wtin, D, 0);
        convert_matrix(F, F.in(14), D, D, wtout, D, 0);
    } else {
        convert_matrix(F, F.in(16), D, 4 * D, wtin, D, 0);
        convert_matrix(F, F.in(28), D, D, wtout, D, 0);
        convert_matrix(F, F.in(18), D, 128, wtin + (size_t)16384 * D, D, 0);
        convert_matrix(F, F.in(21), D, 128, wtin + (size_t)16640 * D, D, 0);
        zero_bytes(F, wtin + (size_t)16512 * D, (size_t)128 * D * 2);
        zero_bytes(F, wtin + (size_t)16768 * D, (size_t)128 * D * 2);
        bf16_t* w2p = (bf16_t*)(F.ws + WS_W2P);
        zero_bytes(F, w2p, (size_t)8192 * 256 * 2);
    }
}
__device__ __forceinline__ void convert_layer2_b(const Fr& F) {
    bf16_t* w2p = (bf16_t*)(F.ws + WS_W2P);
    convert_matrix(F, F.in(19), 128, D, w2p, 256, 0);
    convert_matrix(F, F.in(22), 128, D, w2p + (size_t)4096 * 256, 256, 128);
}

__constant__ float c_inv_freq[16] = {1.0f, 0.44036659598350525f, 0.1939227432012558f, 0.08539710193872452f, 0.03760603070259094f, 0.01656043902039528f, 0.007292664609849453f, 0.0032114458736032248f,
    0.0014142135623842478f, 0.000622772378847003f, 0.00027424818836152554f, 0.00012076973507646471f, 5.318296098266728e-05f, 2.34199997066753e-05f, 1.0313386155758053e-05f, 4.541670477919979e-06f};
__device__ __forceinline__ void rope_table(const Fr& F) {
    float* cs = (float*)(F.ws + WS_ROPE); float* sn = cs + (size_t)R * 16;
    for (int i = F.bid * 512 + F.tid; i < R * 16; i += F.G * 512) {
        const int row = i >> 4, j = i & 15; const int pos = row - NPAD;
        const double ang = (double)(float)((float)pos * c_inv_freq[j]);
        const double k = __builtin_rint(ang * 0.15915494309189535);
        double x = ang - k * 6.283185307179586;
        const double q = __builtin_rint(x * 0.6366197723675814);
        x -= q * 1.5707963267948966;
        const int qi = ((int)q) & 3;
        const double x2 = x * x;
        const double s = x * (1.0 + x2 * (-1.0 / 6 + x2 * (1.0 / 120 + x2 * (-1.0 / 5040 + x2 * (1.0 / 362880 + x2 * (-1.0 / 39916800))))));
        const double c = 1.0 + x2 * (-0.5 + x2 * (1.0 / 24 + x2 * (-1.0 / 720 + x2 * (1.0 / 40320 + x2 * (-1.0 / 3628800 + x2 * (1.0 / 479001600))))));
        double sv, cv;
        if (qi == 0) { sv = s; cv = c; } else if (qi == 1) { sv = c; cv = -s; } else if (qi == 2) { sv = -s; cv = -c; } else { sv = -c; cv = s; }
        cs[i] = (float)cv; sn[i] = (float)sv;
    }
}

typedef const GAS char* gcp; typedef GAS char* gp_;
#define ROW_F32(nm, base, lane) gp_ nm##0 = (gp_)(base) + (lane) * 16 + 4096; gp_ nm##1 = nm##0 + 8192; asm volatile("" : "+v"(nm##0), "+v"(nm##1))
#define AT_F32(nm, j) (*(GAS f32x4*)((j) < 8 ? nm##0 + ((j) - 4) * 1024 : nm##1 + ((j) - 12) * 1024))
#define ROW_BF(nm, base, lane) gp_ nm##0 = (gp_)(base) + (lane) * 8 + 4096; asm volatile("" : "+v"(nm##0))
#define AT_BF(nm, j) (*(GAS u32x2*)(nm##0 + (j) * 512 - 4096))
__device__ __forceinline__ void norm_phase(const Fr& F, int prev, int next, const bf16_t* y, bf16_t* udst) {
    const float* postg = F.in(3) + (size_t)(prev < 0 ? 0 : prev) * D; const float* preg = F.in(2) + (size_t)(next < 0 ? 0 : next) * D;
    const float* xin = F.in(0); const float* meta = F.in(1);
    for (int r = F.gw; r < R; r += F.NGW) {
        if (r < NPAD || r >= NREAL) {
            if (next >= 0) { ROW_BF(uo, udst + (size_t)r * D, F.lane); const u32x2 z = {0u, 0u};
#pragma unroll
                for (int j = 0; j < 16; ++j) AT_BF(uo, j) = z; }
            continue;
        }
        float* hr = hrow(F, r);
        ROW_F32(hp, hr, F.lane);
        f32x4 hv[16];
        if (prev < 0) {
            const float* src = r < 64 ? meta + (size_t)(r - NPAD) * D : xin + (size_t)(r - 64) * D;
            ROW_F32(sp, src, F.lane);
#pragma unroll
            for (int j = 0; j < 16; ++j) hv[j] = AT_F32(sp, j);
        } else {
            ROW_BF(yp, y + (size_t)r * D, F.lane); ROW_F32(gp, postg, F.lane);
            u32x2 yv[16]; float ss = 0.f;
#pragma unroll
            for (int j = 0; j < 16; ++j) { yv[j] = AT_BF(yp, j); hv[j] = AT_F32(hp, j); }
#pragma unroll
            for (int j = 0; j < 16; ++j) { const float a = bflo(yv[j].x), b = bfhi(yv[j].x), c = bflo(yv[j].y), d = bfhi(yv[j].y); ss += (a * a + b * b) + (c * c + d * d); }
#pragma unroll
            for (int j = 0; j < 16; ++j) asm volatile("" : "+v"(yv[j].x), "+v"(yv[j].y));
            const float rs = __builtin_amdgcn_rsqf(wave_sum(ss) * (1.f / D) + 1e-6f);
#pragma unroll
            for (int j = 0; j < 16; ++j) { const f32x4 g = AT_F32(gp, j);
                hv[j].x += bflo(yv[j].x) * rs * g.x; hv[j].y += bfhi(yv[j].x) * rs * g.y; hv[j].z += bflo(yv[j].y) * rs * g.z; hv[j].w += bfhi(yv[j].y) * rs * g.w; }
        }
        if (next < 0) {
            if (r >= 64) {
#pragma unroll
                for (int j = 0; j < 16; ++j) AT_F32(hp, j) = hv[j];
            }
            continue;
        }
        float s2 = 0.f;
#pragma unroll
        for (int j = 0; j < 16; ++j) { AT_F32(hp, j) = hv[j]; s2 += (hv[j].x * hv[j].x + hv[j].y * hv[j].y) + (hv[j].z * hv[j].z + hv[j].w * hv[j].w); }
        const float rs2 = __builtin_amdgcn_rsqf(wave_sum(s2) * (1.f / D) + 1e-6f);
        ROW_BF(uo, udst + (size_t)r * D, F.lane); ROW_F32(pg, preg, F.lane);
#pragma unroll
        for (int j = 0; j < 16; ++j) { const f32x4 g = AT_F32(pg, j); u32x2 w; w.x = cvt_pk_bf16(hv[j].x * rs2 * g.x, hv[j].y * rs2 * g.y); w.y = cvt_pk_bf16(hv[j].z * rs2 * g.z, hv[j].w * rs2 * g.w); AT_BF(uo, j) = w; }
    }
}
__device__ __forceinline__ void mix_phase(const Fr& F, const bf16_t* u) {
    const float* mu = F.in(15);
    for (int r = F.gw; r < R; r += F.NGW) {
        const bool real = (r >= NPAD && r < NREAL);
        u32x2 cur[16], prv[16];
        const u32x2 z = {0u, 0u};
        { ROW_BF(cp, u + (size_t)r * D, F.lane); ROW_BF(pp, u + (size_t)(r > 0 ? r - 1 : 0) * D, F.lane);
#pragma unroll
          for (int j = 0; j < 16; ++j) { cur[j] = real ? AT_BF(cp, j) : z; prv[j] = (real && r > NPAD) ? AT_BF(pp, j) : z; } }
#pragma unroll 1
        for (int s = 0; s < 6; ++s) {
            ROW_BF(op, slotU(F, s) + (size_t)r * D, F.lane); ROW_F32(mp, mu + (size_t)s * D, F.lane);
#pragma unroll
            for (int j = 0; j < 16; ++j) {
                const f32x4 m = AT_F32(mp, j);
                const float c0 = bflo(cur[j].x), c1 = bfhi(cur[j].x), c2 = bflo(cur[j].y), c3 = bfhi(cur[j].y);
                const float p0 = bflo(prv[j].x), p1 = bfhi(prv[j].x), p2 = bflo(prv[j].y), p3 = bfhi(prv[j].y);
                u32x2 w; w.x = cvt_pk_bf16(c0 + (p0 - c0) * m.x, c1 + (p1 - c1) * m.y); w.y = cvt_pk_bf16(c2 + (p2 - c2) * m.z, c3 + (p3 - c3) * m.w);
                AT_BF(op, j) = real ? w : z;
            }
        }
    }
}
}
namespace mk {
constexpr int H_QE = 0, H_KE = 17408, H_KET = 34816, H_VT = 53248, H_PM = 71680, H_STB = 80896, H_VEC = 115712;
__device__ __forceinline__ bf16x8 ldfrag(const LAS unsigned char* base, int stride_b, int rb, int ks, int lane) {
    return *(const LAS bf16x8*)(base + (16 * rb + (lane & 15)) * stride_b + (32 * ks + 8 * (lane >> 4)) * 2);
}
template <bool OUT>
__device__ __forceinline__ void hgrn_phase(const Fr& F, int jl) {
    const bf16_t* Q = slotY(F, 0); const bf16_t* V = slotY(F, 1); const bf16_t* GT = slotY(F, 2); const float* Gg = (const float*)slotY(F, 3);
    bf16_t* Z = slotU(F, 0);
    float* HE = (float*)(F.ws + WS_HE); float* HLD = (float*)(F.ws + WS_HLOGD);
    const float* gn = F.in(6) + (size_t)jl * 128;
    LAS unsigned char* L = F.lds;
    LAS float* qtot = (LAS float*)(L + H_VEC); LAS float* ebm = qtot + 512; LAS float* ebl = ebm + 128;
    const int tid = F.tid, lane = F.lane, w = F.wave;
    const int d = tid & 127, qt = tid >> 7;
    for (int unit = F.bid; unit < 256; unit += F.G) {
        const int h = unit >> 3, seg = unit & 7;
        if (!OUT && seg == 7) continue;
        const int c0 = seg == 0 ? 0 : 33 + 32 * (seg - 1), c1 = c0 + (seg == 0 ? 33 : 32);
        f32x4 S[8];
#pragma unroll
        for (int i = 0; i < 8; ++i) S[i] = (f32x4){0.f, 0.f, 0.f, 0.f};
        if (OUT) {
            for (int j = 0; j < seg; ++j) {
                const float* ld = HLD + (size_t)(h * 8 + j) * 128; const float* e = HE + ((size_t)(h * 8 + j) * 512 + tid) * 32;
#pragma unroll
                for (int di = 0; di < 8; ++di) { const f32x4 l4 = *(const f32x4*)(ld + 16 * di + 4 * (lane >> 4)); const f32x4 e4 = *(const f32x4*)(e + 4 * di);
                    S[di].x = S[di].x * __expf(l4.x) + e4.x; S[di].y = S[di].y * __expf(l4.y) + e4.y; S[di].z = S[di].z * __expf(l4.z) + e4.z; S[di].w = S[di].w * __expf(l4.w) + e4.w; }
            }
        }
        float logD = 0.f;
        for (int c = c0; c < c1; ++c) {
            const int rowb = 64 * c + 16 * qt; const size_t colb = (size_t)h * 128 + d;
            float g[16]; bf16_t qv[16], vv[16];
#pragma unroll
            for (int i = 0; i < 16; ++i) { g[i] = Gg[(size_t)(rowb + i) * D + colb]; vv[i] = V[(size_t)(rowb + i) * D + colb]; if (OUT) qv[i] = Q[(size_t)(rowb + i) * D + colb]; }
            u32x4 gt0, gt1;
            if (OUT) { const bf16_t* gp = GT + (size_t)(64 * c + (tid >> 3)) * D + h * 128 + 16 * (tid & 7); gt0 = *(const u32x4*)gp; gt1 = *(const u32x4*)(gp + 8); }
            float b[16]; float run = 0.f;
#pragma unroll
            for (int i = 0; i < 16; ++i) { run += g[i]; b[i] = run; }
            qtot[qt * 128 + d] = run;
            __syncthreads();
            const float t0 = qtot[d], t1 = qtot[128 + d], t2 = qtot[256 + d], t3 = qtot[384 + d];
            const float off = qt == 0 ? 0.f : (qt == 1 ? t0 : (qt == 2 ? t0 + t1 : t0 + t1 + t2));
            const float bm = t0 + t1, bl = (t0 + t1) + (t2 + t3);
            if (qt == 0) { ebm[d] = __expf(bm); ebl[d] = __expf(bl); logD += bl; }
            {
                unsigned kt[8], vt[8];
#pragma unroll
                for (int i = 0; i < 16; i += 2) {
                    const float b0 = b[i] + off, b1 = b[i + 1] + off;
                    const float k0 = 1.f - __expf(g[i]), k1 = 1.f - __expf(g[i + 1]);
                    const int t = 16 * qt + i;
                    if (OUT) {
                        *(LAS bf16_t*)(L + H_QE + (t * 136 + d) * 2) = f2bf(bf2f(qv[i]) * __expf(b0 - bm));
                        *(LAS bf16_t*)(L + H_QE + ((t + 1) * 136 + d) * 2) = f2bf(bf2f(qv[i + 1]) * __expf(b1 - bm));
                        *(LAS bf16_t*)(L + H_KE + (t * 136 + d) * 2) = f2bf(k0 * __expf(bm - b0));
                        *(LAS bf16_t*)(L + H_KE + ((t + 1) * 136 + d) * 2) = f2bf(k1 * __expf(bm - b1));
                    }
                    kt[i >> 1] = cvt_pk_bf16(k0 * __expf(bl - b0), k1 * __expf(bl - b1));
                    vt[i >> 1] = (unsigned)vv[i] | ((unsigned)vv[i + 1] << 16);
                }
                LAS u32x4* kp = (LAS u32x4*)(L + H_KET + (d * 72 + 16 * qt) * 2); kp[0] = (u32x4){kt[0], kt[1], kt[2], kt[3]}; kp[1] = (u32x4){kt[4], kt[5], kt[6], kt[7]};
                LAS u32x4* vp = (LAS u32x4*)(L + H_VT + (d * 72 + 16 * qt) * 2); vp[0] = (u32x4){vt[0], vt[1], vt[2], vt[3]}; vp[1] = (u32x4){vt[4], vt[5], vt[6], vt[7]};
            }
            __syncthreads();
            if (OUT) {
#pragma unroll
                for (int di = 0; di < 8; ++di) { const f32x4 m4 = *(const LAS f32x4*)(ebm + 16 * di + 4 * (lane >> 4)); u32x2 o; o.x = cvt_pk_bf16(S[di].x * m4.x, S[di].y * m4.y); o.y = cvt_pk_bf16(S[di].z * m4.z, S[di].w * m4.w);
                    *(LAS u32x2*)(L + H_STB + ((16 * w + (lane & 15)) * 136 + 16 * di + 4 * (lane >> 4)) * 2) = o; }
                const int ti = w >> 1;
#pragma unroll
                for (int s2 = 0; s2 < 2; ++s2) { const int si = 2 * (w & 1) + s2; f32x4 p = {0.f, 0.f, 0.f, 0.f};
                    if (si <= ti) {
#pragma unroll
                        for (int ks = 0; ks < 4; ++ks) p = __builtin_amdgcn_mfma_f32_16x16x32_bf16(ldfrag(L + H_QE, 272, ti, ks, lane), ldfrag(L + H_KE, 272, si, ks, lane), p, 0, 0, 0);
                    }
                    const int sidx = 16 * si + (lane & 15);
#pragma unroll
                    for (int jj = 0; jj < 4; ++jj) { const int tidx = 16 * ti + 4 * (lane >> 4) + jj; *(LAS bf16_t*)(L + H_PM + (tidx * 72 + sidx) * 2) = f2bf(sidx <= tidx ? p[jj] : 0.f); }
                }
                __syncthreads();
            }
            f32x4 O[4];
            if (OUT) {
#pragma unroll
                for (int ti = 0; ti < 4; ++ti) O[ti] = (f32x4){0.f, 0.f, 0.f, 0.f};
#pragma unroll
                for (int ks = 0; ks < 2; ++ks) { const bf16x8 bv = ldfrag(L + H_VT, 144, w, ks, lane);
#pragma unroll
                    for (int ti = 0; ti < 4; ++ti) O[ti] = __builtin_amdgcn_mfma_f32_16x16x32_bf16(ldfrag(L + H_PM, 144, ti, ks, lane), bv, O[ti], 0, 0, 0); }
#pragma unroll
                for (int ks = 0; ks < 4; ++ks) { const bf16x8 bs = ldfrag(L + H_STB, 272, w, ks, lane);
#pragma unroll
                    for (int ti = 0; ti < 4; ++ti) O[ti] = __builtin_amdgcn_mfma_f32_16x16x32_bf16(ldfrag(L + H_QE, 272, ti, ks, lane), bs, O[ti], 0, 0, 0); }
            }
            {
                const bf16x8 bv0 = ldfrag(L + H_VT, 144, w, 0, lane), bv1 = ldfrag(L + H_VT, 144, w, 1, lane);
#pragma unroll
                for (int di = 0; di < 8; ++di) { const f32x4 l4 = *(const LAS f32x4*)(ebl + 16 * di + 4 * (lane >> 4)); S[di] = S[di] * l4;
                    S[di] = __builtin_amdgcn_mfma_f32_16x16x32_bf16(ldfrag(L + H_KET, 144, di, 0, lane), bv0, S[di], 0, 0, 0);
                    S[di] = __builtin_amdgcn_mfma_f32_16x16x32_bf16(ldfrag(L + H_KET, 144, di, 1, lane), bv1, S[di], 0, 0, 0); }
            }
            if (OUT) {
                __syncthreads();
                LAS float* Ot = (LAS float*)(L + H_STB);
#pragma unroll
                for (int ti = 0; ti < 4; ++ti)
#pragma unroll
                    for (int jj = 0; jj < 4; ++jj) Ot[(16 * ti + 4 * (lane >> 4) + jj) * 132 + 16 * w + (lane & 15)] = O[ti][jj];
                __syncthreads();
                const int t = tid >> 3, eg = tid & 7;
                f32x4 o4[4]; float ss = 0.f;
#pragma unroll
                for (int i = 0; i < 4; ++i) { o4[i] = *(const LAS f32x4*)(Ot + t * 132 + 16 * eg + 4 * i); ss += (o4[i].x * o4[i].x + o4[i].y * o4[i].y) + (o4[i].z * o4[i].z + o4[i].w * o4[i].w); }
                ss = red8(ss);
                const float rs = __builtin_amdgcn_rsqf(ss * (1.f / 128.f) + 1e-6f);
                const unsigned gw_[8] = {gt0.x, gt0.y, gt0.z, gt0.w, gt1.x, gt1.y, gt1.z, gt1.w};
                unsigned zo[8];
#pragma unroll
                for (int i = 0; i < 4; ++i) { const f32x4 g4 = *(const f32x4*)(gn + 16 * eg + 4 * i);
                    const float a0 = o4[i].x * rs * g4.x * silu_f(bflo(gw_[2 * i])), a1 = o4[i].y * rs * g4.y * silu_f(bfhi(gw_[2 * i]));
                    const float a2 = o4[i].z * rs * g4.z * silu_f(bflo(gw_[2 * i + 1])), a3 = o4[i].w * rs * g4.w * silu_f(bfhi(gw_[2 * i + 1]));
                    zo[2 * i] = cvt_pk_bf16(a0, a1); zo[2 * i + 1] = cvt_pk_bf16(a2, a3); }
                bf16_t* zp = Z + (size_t)(64 * c + t) * D + h * 128 + 16 * eg;
                *(u32x4*)zp = (u32x4){zo[0], zo[1], zo[2], zo[3]}; *(u32x4*)(zp + 8) = (u32x4){zo[4], zo[5], zo[6], zo[7]};
            } else {
                __syncthreads();
            }
        }
        if (!OUT) {
            float* e = HE + ((size_t)(h * 8 + seg) * 512 + tid) * 32;
#pragma unroll
            for (int di = 0; di < 8; ++di) *(f32x4*)(e + 4 * di) = S[di];
            if (qt == 0) HLD[(size_t)(h * 8 + seg) * 128 + d] = logD;
        }
        __syncthreads();
    }
}

namespace att {
constexpr int NW = 8, QBLK = 32, KVBLK = 64, LDQ = 4096, LDO = 8192;
constexpr float SCALE = 0.088388347648318440f, THR = 8.f;
constexpr int SHM_V = 16384, SHM_K = 16384, SHM = 2 * SHM_V + 2 * SHM_K + NW * 64 * 4;
#define KSWZ(row, colB) ((row) * 256 + ((colB) ^ (((row) & 7) << 4)))
#define SBAR() __builtin_amdgcn_sched_barrier(0)
__device__ __forceinline__ int crow(int r, int hi) { return (r & 3) + 8 * (r >> 2) + 4 * hi; }
__device__ __forceinline__ void partialSM(f32x16& p0, f32x16& p1, float& m_reg, float& mn, float& alpha) {
    constexpr float C = SCALE * 1.4426950408889634f;
    float pmax = p0[0];
#pragma unroll
    for (int r = 1; r < 16; ++r) pmax = fmaxf(pmax, p0[r]);
#pragma unroll
    for (int r = 0; r < 16; ++r) pmax = fmaxf(pmax, p1[r]);
    { auto rr = __builtin_amdgcn_permlane32_swap(__float_as_uint(pmax), __float_as_uint(pmax), false, false);
      pmax = fmaxf(__uint_as_float(rr[0]), __uint_as_float(rr[1])); }
    if (__builtin_expect(__all(pmax - m_reg <= THR / SCALE), 1)) { mn = m_reg; alpha = 1.f; }
    else { mn = fmaxf(m_reg, pmax); alpha = __builtin_amdgcn_exp2f((m_reg - mn) * C); m_reg = mn; }
    const float mnC = -mn * C;
#pragma unroll
    for (int r = 0; r < 16; ++r) p0[r] = fmaf(p0[r], C, mnC);
#pragma unroll
    for (int r = 0; r < 16; ++r) p1[r] = fmaf(p1[r], C, mnC);
#pragma unroll
    for (int r = 0; r < 16; ++r) p0[r] = __builtin_amdgcn_exp2f(p0[r]);
}
__device__ __forceinline__ void finishSM(f32x16& p0, f32x16& p1, float alpha, float& l_reg, bf16x8& pa0, bf16x8& pa1, bf16x8& pa2, bf16x8& pa3) {
#pragma unroll
    for (int r = 0; r < 16; ++r) p1[r] = __builtin_amdgcn_exp2f(p1[r]);
    float ps = 0;
#pragma unroll
    for (int r = 0; r < 16; ++r) ps += p0[r];
#pragma unroll
    for (int r = 0; r < 16; ++r) ps += p1[r];
    { auto rr = __builtin_amdgcn_permlane32_swap(__float_as_uint(ps), __float_as_uint(ps), false, false);
      ps = __uint_as_float(rr[0]) + __uint_as_float(rr[1]); }
    l_reg = l_reg * alpha + ps;
#define PK4(P, BASE, OUT) do { unsigned a0 = cvt_pk_bf16(P[BASE + 0], P[BASE + 1]), a1 = cvt_pk_bf16(P[BASE + 2], P[BASE + 3]);   \
    unsigned b0 = cvt_pk_bf16(P[BASE + 4], P[BASE + 5]), b1 = cvt_pk_bf16(P[BASE + 6], P[BASE + 7]);                              \
    auto r0 = __builtin_amdgcn_permlane32_swap(a0, b0, false, false); auto r1 = __builtin_amdgcn_permlane32_swap(a1, b1, false, false); \
    u32x4 w = {r0[0], r1[0], r0[1], r1[1]}; OUT = *reinterpret_cast<bf16x8*>(&w); } while (0)
    PK4(p0, 0, pa0); PK4(p0, 8, pa1); PK4(p1, 0, pa2); PK4(p1, 8, pa3);
#undef PK4
}
__device__ __forceinline__ void qkt(f32x16& p0, f32x16& p1, const char* Ks, const bf16x8* qr, int r32, int hi) {
    p0 = f32x16{}; p1 = f32x16{};
#pragma unroll
    for (int d0 = 0; d0 < 8; ++d0) { const int cb = (d0 * 16 + hi * 8) * 2;
        const bf16x8 b0 = *reinterpret_cast<const bf16x8*>(Ks + KSWZ(r32, cb));
        const bf16x8 b1 = *reinterpret_cast<const bf16x8*>(Ks + KSWZ(32 + r32, cb));
        p0 = __builtin_amdgcn_mfma_f32_32x32x16_bf16(b0, qr[d0], p0, 0, 0, 0);
        p1 = __builtin_amdgcn_mfma_f32_32x32x16_bf16(b1, qr[d0], p1, 0, 0, 0); }
}
__device__ __forceinline__ int v_st(int k, int c) { const int kk = (k & ~0xC) | ((k & 4) << 1) | ((k & 8) >> 1); return ((kk >> 3) * 4 + (c >> 5)) * 512 + ((kk & 7) * 32 + (c & 31)) * 2; }
__device__ __forceinline__ int v_rd_base(int lane) { return ((lane & 3) << 3) | (((lane >> 2) & 3) << 6) | (((lane >> 4) & 1) << 5) | (((lane >> 5) & 1) << 8); }
constexpr int v_rd_off(int d0, int ks, int half) { return d0 * 512 + ks * 4096 + half * 2048; }
template <int OFF> __device__ __forceinline__ s16x4 tr_read(int vb) {
    s16x4 r; asm volatile("ds_read_b64_tr_b16 %0, %1 offset:%2" : "=&v"(r) : "v"(vb), "i"(OFF) : "memory"); return r;
}
template <int D0> __device__ __forceinline__ void pv_one(f32x16& od, int vb, bf16x8 pa0, bf16x8 pa1, bf16x8 pa2, bf16x8 pa3) {
    const s16x4 l0 = tr_read<v_rd_off(D0, 0, 0)>(vb), h0 = tr_read<v_rd_off(D0, 0, 1)>(vb), l1 = tr_read<v_rd_off(D0, 1, 0)>(vb), h1 = tr_read<v_rd_off(D0, 1, 1)>(vb);
    const s16x4 l2 = tr_read<v_rd_off(D0, 2, 0)>(vb), h2 = tr_read<v_rd_off(D0, 2, 1)>(vb), l3 = tr_read<v_rd_off(D0, 3, 0)>(vb), h3 = tr_read<v_rd_off(D0, 3, 1)>(vb);
    asm volatile("s_waitcnt lgkmcnt(0)" ::: "memory"); SBAR();
#define PK(Lo, Hi) (bf16x8){Lo[0], Lo[1], Lo[2], Lo[3], Hi[0], Hi[1], Hi[2], Hi[3]}
    od = __builtin_amdgcn_mfma_f32_32x32x16_bf16(pa0, PK(l0, h0), od, 0, 0, 0);
    od = __builtin_amdgcn_mfma_f32_32x32x16_bf16(pa1, PK(l1, h1), od, 0, 0, 0);
    od = __builtin_amdgcn_mfma_f32_32x32x16_bf16(pa2, PK(l2, h2), od, 0, 0, 0);
    od = __builtin_amdgcn_mfma_f32_32x32x16_bf16(pa3, PK(l3, h3), od, 0, 0, 0);
#undef PK
}
__device__ __forceinline__ void pv_d0(f32x16* o, int vb, bf16x8 pa0, bf16x8 pa1, bf16x8 pa2, bf16x8 pa3) {
    pv_one<0>(o[0], vb, pa0, pa1, pa2, pa3); pv_one<1>(o[1], vb, pa0, pa1, pa2, pa3); pv_one<2>(o[2], vb, pa0, pa1, pa2, pa3); pv_one<3>(o[3], vb, pa0, pa1, pa2, pa3);
}
__device__ __forceinline__ void mask_tile(f32x16& p0, f32x16& p1, int j, int lim) {
    if (j > lim) {
#pragma unroll
        for (int r = 0; r < 16; ++r) { p0[r] = -1e30f; p1[r] = -1e30f; }
    } else if (j == 0) {
#pragma unroll
        for (int r = 0; r < 16; ++r) p0[r] = -1e30f;
#pragma unroll
        for (int r = 0; r < 8; ++r) p1[r] = -1e30f;
    }
}
__device__ __forceinline__ void unit(const bf16_t* __restrict__ Qb, const bf16_t* __restrict__ Kh, const bf16_t* __restrict__ Vh, bf16_t* __restrict__ Ob, int NT, int lim, char* lds) {
    int tid_ = threadIdx.x; asm volatile("" : "+v"(tid_));
    const int tid = tid_, wid = tid >> 6, lane = tid & 63, r32 = lane & 31, hi = lane >> 5;
    char* V_lds = lds; char* K_lds = lds + 2 * SHM_V;
    float* wsf = (float*)(lds + 2 * SHM_V + 2 * SHM_K) + wid * 64; float* li_l = wsf; float* al_l = wsf + 32;
    float m_reg = -1e30f, l_reg = 0; f32x16 o[4] = {}; bf16x8 qr[8];
    const bf16_t* Qw = Qb + (long)(wid * QBLK + r32) * LDQ + hi * 8;
#pragma unroll
    for (int d0 = 0; d0 < 8; ++d0) qr[d0] = *reinterpret_cast<const bf16x8*>(Qw + d0 * 16);
    const int sr = tid >> 4, sc = (tid & 15) * 8, vst0 = v_st(sr, sc), vst1 = v_st(32 + sr, sc);
    const int vb0 = (int)(uintptr_t)V_lds + v_rd_base(lane);
    struct { bf16x8 vs0, vs1, ks0, ks1; } sr_[2];
#define SLOAD(i, k0) do { sr_[i].vs0 = *reinterpret_cast<const bf16x8*>(&Vh[(long)((k0) + sr) * LDQ + sc]); sr_[i].vs1 = *reinterpret_cast<const bf16x8*>(&Vh[(long)((k0) + 32 + sr) * LDQ + sc]); \
    sr_[i].ks0 = *reinterpret_cast<const bf16x8*>(&Kh[(long)((k0) + sr) * LDQ + sc]); sr_[i].ks1 = *reinterpret_cast<const bf16x8*>(&Kh[(long)((k0) + 32 + sr) * LDQ + sc]); } while (0)
#define SWRITE(b, i) do { *(bf16x8*)(V_lds + (b) * SHM_V + vst0) = sr_[i].vs0;          \
    *(bf16x8*)(V_lds + (b) * SHM_V + vst1) = sr_[i].vs1; int kc = sc * 2;               \
    *(bf16x8*)(K_lds + (b) * SHM_K + KSWZ(sr, kc)) = sr_[i].ks0;                       \
    *(bf16x8*)(K_lds + (b) * SHM_K + KSWZ(32 + sr, kc)) = sr_[i].ks1; } while (0)
#define SWAIT() asm volatile("s_waitcnt vmcnt(4)" ::: "memory")
#define RESC(a) do { if (__any((a) < 1.f)) { if (hi == 0) al_l[r32] = (a); asm volatile("s_waitcnt lgkmcnt(0)" ::: "memory"); \
    _Pragma("unroll") for (int d = 0; d < 4; ++d) _Pragma("unroll") for (int r = 0; r < 16; ++r) o[d][r] *= al_l[crow(r, hi)]; } } while (0)
    f32x16 pA0, pA1, pB0, pB1; float mnA, mnB, alA, alB; bf16x8 pa0, pa1, pa2, pa3;
    constexpr int SE = 0, SO = 1;
    SLOAD(SE, 0); asm volatile("s_waitcnt vmcnt(0)" ::: "memory"); SWRITE(0, SE); __syncthreads();
    qkt(pA0, pA1, K_lds, qr, r32, hi); mask_tile(pA0, pA1, 0, lim); partialSM(pA0, pA1, m_reg, mnA, alA);
    SLOAD(SO, KVBLK); if (2 < NT) SLOAD(SE, 2 * KVBLK);
    SWAIT(); SWRITE(1, SO); __syncthreads();
    for (int j = 1; j + 1 < NT; j += 2) {
        SBAR(); qkt(pB0, pB1, K_lds + SHM_K, qr, r32, hi);
        finishSM(pA0, pA1, alA, l_reg, pa0, pa1, pa2, pa3); SBAR();
        SLOAD(SO, (j + 2) * KVBLK); SBAR();
        pv_d0(o, vb0, pa0, pa1, pa2, pa3); mask_tile(pB0, pB1, j, lim); partialSM(pB0, pB1, m_reg, mnB, alB);
        __syncthreads(); SWAIT(); SWRITE(0, SE);
        RESC(alB); __syncthreads();
        SBAR(); qkt(pA0, pA1, K_lds, qr, r32, hi);
        finishSM(pB0, pB1, alB, l_reg, pa0, pa1, pa2, pa3); SBAR();
        if (j + 3 < NT) SLOAD(SE, (j + 3) * KVBLK); SBAR();
        pv_d0(o, vb0 + SHM_V, pa0, pa1, pa2, pa3); mask_tile(pA0, pA1, j + 1, lim); partialSM(pA0, pA1, m_reg, mnA, alA);
        __syncthreads(); SWAIT(); SWRITE(1, SO);
        RESC(alA); __syncthreads();
    }
    SBAR(); qkt(pB0, pB1, K_lds + SHM_K, qr, r32, hi);
    finishSM(pA0, pA1, alA, l_reg, pa0, pa1, pa2, pa3); SBAR();
    pv_d0(o, vb0, pa0, pa1, pa2, pa3); mask_tile(pB0, pB1, NT - 1, lim); partialSM(pB0, pB1, m_reg, mnB, alB);
    __syncthreads(); RESC(alB);
    finishSM(pB0, pB1, alB, l_reg, pa0, pa1, pa2, pa3); SBAR();
    pv_d0(o, vb0 + SHM_V, pa0, pa1, pa2, pa3);
    if (hi == 0) li_l[r32] = l_reg; asm volatile("s_waitcnt lgkmcnt(0)" ::: "memory");
    float rli[16];
#pragma unroll
    for (int r = 0; r < 16; ++r) rli[r] = __builtin_amdgcn_rcpf(li_l[crow(r, hi)]);
    bf16_t* Ow = Ob + (long)(wid * QBLK) * LDO;
#pragma unroll
    for (int r = 0; r < 16; ++r) { const int orow = crow(r, hi);
#pragma unroll
        for (int d0 = 0; d0 < 4; ++d0) Ow[(long)orow * LDO + d0 * 32 + r32] = f2bf(o[d0][r] * rli[r]); }
    __syncthreads();
#undef SLOAD
#undef SWRITE
#undef SWAIT
#undef RESC
}
}

__device__ __forceinline__ void attn_phase(const Fr& F) {
    const bf16_t* Q = slotY(F, 0); const bf16_t* K = slotY(F, 1); const bf16_t* V = slotY(F, 2);
    bf16_t* AO = slotU(F, 1);
    for (int idx = F.bid; idx < 65 * 64; idx += F.G) {
        const int i = 64 - idx / 64, sub = idx & 63, head = sub >> 2, c = (sub >> 1) & 1, half = sub & 1;
        const int NT = 4 * i + 4, lim = 4 * i + (F.wave >> 1);
        att::unit(Q + (size_t)(256 * i) * D + head * 256 + c * 128, K + head * 256 + c * 128, V + head * 256 + half * 128,
                  AO + (size_t)(256 * i) * 8192 + head * 512 + c * 256 + half * 128, NT, lim, (char*)F.ldsg);
    }
}
__device__ __forceinline__ void attn_post(const Fr& F) {
    const bf16_t* AO = slotU(F, 1); const bf16_t* GT = slotY(F, 3); bf16_t* Z = slotU(F, 0);
    const float* sg = F.in(13);
    constexpr float LINIT = 0.35550906759096934f;
    float lam;
    { const float* q1 = F.in(9); const float* k1 = F.in(10); const float* q2 = F.in(11); const float* k2 = F.in(12);
      const float d1 = wave_sum(q1[F.lane] * k1[F.lane] + q1[F.lane + 64] * k1[F.lane + 64]), d2 = wave_sum(q2[F.lane] * k2[F.lane] + q2[F.lane + 64] * k2[F.lane + 64]);
      lam = expf(d1) - expf(d2) + LINIT; }
    const f32x4 g4 = ((const f32x4*)sg)[F.lane];
    for (int r = F.gw; r < R; r += F.NGW) {
        const bool real = (r >= NPAD && r < NREAL);
        u32x2* zr = (u32x2*)(Z + (size_t)r * D) + F.lane;
        if (!real) { const u32x2 z = {0u, 0u};
#pragma unroll
            for (int hd = 0; hd < 16; ++hd) zr[64 * hd] = z;
            continue; }
#pragma unroll 4
        for (int hd = 0; hd < 16; ++hd) {
            const u32x2 a0 = ((const u32x2*)(AO + (size_t)r * 8192 + hd * 512))[F.lane], a1 = ((const u32x2*)(AO + (size_t)r * 8192 + hd * 512 + 256))[F.lane];
            const u32x2 gt = ((const u32x2*)(GT + (size_t)r * D + hd * 256))[F.lane];
            const float o0 = bflo(a0.x) - lam * bflo(a1.x), o1 = bfhi(a0.x) - lam * bfhi(a1.x), o2 = bflo(a0.y) - lam * bflo(a1.y), o3 = bfhi(a0.y) - lam * bfhi(a1.y);
            const float ss = wave_sum((o0 * o0 + o1 * o1) + (o2 * o2 + o3 * o3));
            const float rs = __builtin_amdgcn_rsqf(ss * (1.f / 256.f) + 1e-5f) * (1.f - LINIT);
            u32x2 w; w.x = cvt_pk_bf16(o0 * rs * g4.x * silu_f(bflo(gt.x)), o1 * rs * g4.y * silu_f(bfhi(gt.x))); w.y = cvt_pk_bf16(o2 * rs * g4.z * silu_f(bflo(gt.y)), o3 * rs * g4.w * silu_f(bfhi(gt.y)));
            zr[64 * hd] = w;
        }
    }
}

constexpr int RW_TT = 32, RW_TOKF = 384, RW_TILEF = RW_TT * RW_TOKF, RW_NTILE = 513;
__device__ __forceinline__ void rwkv_scan_seq(const Fr& F) {
    const bf16_t* Rr = slotY(F, 0); const bf16_t* K = slotY(F, 1); const bf16_t* V = slotY(F, 2); const bf16_t* W = slotY(F, 4); const bf16_t* A = slotY(F, 5);
    float* O32 = (float*)slotU(F, 1);
    LAS float* ring = (LAS float*)F.lds; LAS float* otile = ring + 2 * RW_TILEF;
    const int tid = F.tid, lane = F.lane, wid = F.wave;
    for (int unit = F.bid; unit < 256; unit += F.G) {
        const int h = unit >> 2, rg = unit & 3;
        const int ptid = tid - 256, ptt = ptid >> 3, dg = ptid & 7;
        float kkc[8], kac[8];
        if (wid >= 4) {
#pragma unroll
            for (int i = 0; i < 8; ++i) { kkc[i] = F.in(23)[h * 64 + 8 * dg + i]; kac[i] = F.in(24)[h * 64 + 8 * dg + i]; }
        }
        float S0 = 0.f, S1 = 0.f, S2 = 0.f, S3 = 0.f;
        const int cg = lane & 15, irow = 4 * wid + (lane >> 4);
#define RW_PRODUCE(m, buf) do { const int row = NPAD + 32 * (m) + ptt; const size_t off = (size_t)row * D + h * 64 + 8 * dg; \
        const u32x4 r8 = *(const u32x4*)(Rr + off), k8 = *(const u32x4*)(K + off), v8 = *(const u32x4*)(V + off), w8 = *(const u32x4*)(W + off), a8 = *(const u32x4*)(A + off); \
        const unsigned rw[4] = {r8.x, r8.y, r8.z, r8.w}, kw[4] = {k8.x, k8.y, k8.z, k8.w}, vw[4] = {v8.x, v8.y, v8.z, v8.w}, ww[4] = {w8.x, w8.y, w8.z, w8.w}, aw[4] = {a8.x, a8.y, a8.z, a8.w}; \
        float rf[8], kf[8], vf[8], wf[8], af[8], kk[8]; float ssq = 0.f; \
        _Pragma("unroll") for (int i = 0; i < 4; ++i) { rf[2 * i] = bflo(rw[i]); rf[2 * i + 1] = bfhi(rw[i]); kf[2 * i] = bflo(kw[i]); kf[2 * i + 1] = bfhi(kw[i]); vf[2 * i] = bflo(vw[i]); vf[2 * i + 1] = bfhi(vw[i]); \
            wf[2 * i] = bflo(ww[i]); wf[2 * i + 1] = bfhi(ww[i]); af[2 * i] = bflo(aw[i]); af[2 * i + 1] = bfhi(aw[i]); } \
        _Pragma("unroll") for (int i = 0; i < 8; ++i) { kk[i] = kf[i] * kkc[i]; ssq += kk[i] * kk[i]; } \
        ssq = red8(ssq); const float inv = 1.f / fmaxf(sqrtf(ssq), 1e-12f); \
        LAS float* tb = ring + (buf) * RW_TILEF + ptt * RW_TOKF; \
        _Pragma("unroll") for (int q = 0; q < 2; ++q) { LAS f32x4* p = (LAS f32x4*)(tb + (2 * dg + q) * 20); \
            f32x4 t0, t1, t2, t3, t4; \
            _Pragma("unroll") for (int e = 0; e < 4; ++e) { const int i = 4 * q + e; const float kn = kk[i] * inv; t0[e] = wf[i]; t1[e] = -kn; t2[e] = kn * af[i]; t3[e] = kf[i] * (1.f + (af[i] - 1.f) * kac[i]); t4[e] = rf[i]; } \
            p[0] = t0; p[1] = t1; p[2] = t2; p[3] = t3; p[4] = t4; } \
        LAS f32x4* pv = (LAS f32x4*)(tb + 320 + 8 * dg); pv[0] = (f32x4){vf[0], vf[1], vf[2], vf[3]}; pv[1] = (f32x4){vf[4], vf[5], vf[6], vf[7]}; } while (0)
#define RW_FLUSH(m, buf) do { const int row = NPAD + 32 * (m) + ptt; if (row < NREAL) { const LAS float* ot = otile + (buf) * 512 + ptt * 16 + 2 * dg; \
        *(float2*)(O32 + (size_t)row * D + h * 64 + 16 * rg + 2 * dg) = make_float2(ot[0], ot[1]); } } while (0)
        if (wid >= 4) RW_PRODUCE(0, 0);
        __syncthreads();
        for (int n = 0; n < RW_NTILE; ++n) {
            if (wid < 4) {
                const LAS float* tb = ring + (n & 1) * RW_TILEF; LAS float* ot = otile + (n & 1) * 512;
#pragma unroll 4
                for (int tt = 0; tt < RW_TT; ++tt) {
                    const LAS float* p = tb + tt * RW_TOKF + cg * 20;
                    const f32x4 w4 = *(const LAS f32x4*)p, nk = *(const LAS f32x4*)(p + 4), ka = *(const LAS f32x4*)(p + 8), kp = *(const LAS f32x4*)(p + 12), r4 = *(const LAS f32x4*)(p + 16);
                    const float v = tb[tt * RW_TOKF + 320 + 16 * rg + irow];
                    float sa = (S0 * nk.x + S1 * nk.y) + (S2 * nk.z + S3 * nk.w);
                    sa = red16(sa);
                    S0 = S0 * w4.x + (sa * ka.x + v * kp.x); S1 = S1 * w4.y + (sa * ka.y + v * kp.y); S2 = S2 * w4.z + (sa * ka.z + v * kp.z); S3 = S3 * w4.w + (sa * ka.w + v * kp.w);
                    float o = (S0 * r4.x + S1 * r4.y) + (S2 * r4.z + S3 * r4.w);
                    o = red16(o);
                    if (cg == 0) ot[tt * 16 + irow] = o;
                }
            } else {
                if (n + 1 < RW_NTILE) RW_PRODUCE(n + 1, (n + 1) & 1);
                if (n > 0) RW_FLUSH(n - 1, (n - 1) & 1);
            }
            __syncthreads();
        }
        if (wid >= 4) RW_FLUSH(RW_NTILE - 1, (RW_NTILE - 1) & 1);
        __syncthreads();
#undef RW_PRODUCE
#undef RW_FLUSH
    }
}

#ifndef RC_SYNC
#define RC_SYNC 0
#endif
constexpr int RC_SLOT = 13312, RC_NSLOT = 8, RC_SCR0 = RC_NSLOT * RC_SLOT, RC_SCR = 5632, RC_FLAGS = RC_SCR0 + 7 * RC_SCR, RC_NCH = 1025;
constexpr int RC_AT = 0, RC_RT = 2176, RC_BTT = 4352, RC_KTT = 6912, RC_TT = 9472, RC_G3F = 9984, RC_VTF = 10496, RC_P1 = 11008, RC_P2 = 12032, RC_WC = 13056;
static_assert(RC_FLAGS + 64 <= 147456 - 256, "rwkv LDS map");
typedef short s16x4v __attribute__((ext_vector_type(4)));
__device__ __forceinline__ void rwkv_kknorm(const Fr& F) {
    const bf16_t* K = slotY(F, 1); const float* k_k = F.in(23); float* INV = (float*)(F.ws + WS_HE);
    for (int r = F.gw; r < R; r += F.NGW) {
#pragma unroll 4
        for (int it = 0; it < 16; ++it) {
            const size_t ci = (size_t)it * 64 + F.lane;
            const u32x2 kk = ((const u32x2*)(K + (size_t)r * D))[ci]; const f32x4 c4 = ((const f32x4*)k_k)[ci];
            const float a = bflo(kk.x) * c4.x, b = bfhi(kk.x) * c4.y, c = bflo(kk.y) * c4.z, d = bfhi(kk.y) * c4.w;
            const float ss = red16((a * a + b * b) + (c * c + d * d));
            if ((F.lane & 15) == 0) INV[(size_t)r * 64 + it * 4 + (F.lane >> 4)] = 1.f / fmaxf(sqrtf(ss), 1e-12f);
        }
    }
}
__device__ __forceinline__ unsigned lds_poll(volatile LAS unsigned* p) { return *p; }
__device__ __forceinline__ void rwkv_scan(const Fr& F) {
    const bf16_t* Rr = slotY(F, 0); const bf16_t* K = slotY(F, 1); const bf16_t* V = slotY(F, 2); const bf16_t* W = slotY(F, 4); const bf16_t* A = slotY(F, 5);
    const float* INV = (const float*)(F.ws + WS_HE);
    float* O32 = (float*)slotU(F, 1);
    LAS unsigned char* L = F.lds;
    volatile LAS unsigned* flags = (volatile LAS unsigned*)(L + RC_FLAGS);
    const int lane = F.lane, wid = F.wave, l15 = lane & 15, kg = lane >> 4;
    for (int unit = F.bid; unit < 256; unit += F.G) {
        const int h = unit >> 2, rgw = unit & 3;
        if (F.tid < 16) flags[F.tid] = 0u;
        __syncthreads();
        if (wid == 0) {
            __builtin_amdgcn_s_setprio(3);
            f32x4 S0 = {0.f, 0.f, 0.f, 0.f}, S1 = S0, S2 = S0, S3 = S0;
            for (int n = 0; n < RC_NCH; ++n) {
                const int slot = n & 7; const LAS unsigned char* SL = L + slot * RC_SLOT;
#if RC_SYNC
                if (n % 7 == 0) { __builtin_amdgcn_s_barrier(); __builtin_amdgcn_s_barrier(); }
#else
                { unsigned sp = 0; while (lds_poll(flags + slot) != (unsigned)(n + 1)) { __builtin_amdgcn_s_sleep(1); if (++sp > (1u << 22)) break; } }
#endif
                asm volatile("s_waitcnt lgkmcnt(0)" ::: "memory");
                u32x4 sb0, sb1; sb0.x = cvt_pk_bf16(S0.x, S0.y); sb0.y = cvt_pk_bf16(S0.z, S0.w); sb0.z = cvt_pk_bf16(S1.x, S1.y); sb0.w = cvt_pk_bf16(S1.z, S1.w);
                sb1.x = cvt_pk_bf16(S2.x, S2.y); sb1.y = cvt_pk_bf16(S2.z, S2.w); sb1.z = cvt_pk_bf16(S3.x, S3.y); sb1.w = cvt_pk_bf16(S3.z, S3.w);
                const bf16x8 Sb0 = *reinterpret_cast<bf16x8*>(&sb0), Sb1 = *reinterpret_cast<bf16x8*>(&sb1);
                const LAS unsigned char* ap = SL + RC_AT + l15 * 136 + kg * 8; const LAS unsigned char* rp = SL + RC_RT + l15 * 136 + kg * 8;
                u32x2 a0l = *(const LAS u32x2*)(ap), a0h = *(const LAS u32x2*)(ap + 32), a1l = *(const LAS u32x2*)(ap + 64), a1h = *(const LAS u32x2*)(ap + 96);
                u32x2 r0l = *(const LAS u32x2*)(rp), r0h = *(const LAS u32x2*)(rp + 32), r1l = *(const LAS u32x2*)(rp + 64), r1h = *(const LAS u32x2*)(rp + 96);
                u32x4 t4;
                t4 = (u32x4){a0l.x, a0l.y, a0h.x, a0h.y}; const bf16x8 Aq0 = *reinterpret_cast<bf16x8*>(&t4);
                t4 = (u32x4){a1l.x, a1l.y, a1h.x, a1h.y}; const bf16x8 Aq1 = *reinterpret_cast<bf16x8*>(&t4);
                t4 = (u32x4){r0l.x, r0l.y, r0h.x, r0h.y}; const bf16x8 Rq0 = *reinterpret_cast<bf16x8*>(&t4);
                t4 = (u32x4){r1l.x, r1l.y, r1h.x, r1h.y}; const bf16x8 Rq1 = *reinterpret_cast<bf16x8*>(&t4);
                f32x4 X = *(const LAS f32x4*)(SL + RC_P1 + lane * 16), O = *(const LAS f32x4*)(SL + RC_P2 + lane * 16);
                const s16x4v ttf = *(const LAS s16x4v*)(SL + RC_TT + l15 * 32 + kg * 8);
                const s16x4v g3f = *(const LAS s16x4v*)(SL + RC_G3F + lane * 8), vtf = *(const LAS s16x4v*)(SL + RC_VTF + lane * 8);
                X = __builtin_amdgcn_mfma_f32_16x16x32_bf16(Aq0, Sb0, X, 0, 0, 0);
                X = __builtin_amdgcn_mfma_f32_16x16x32_bf16(Aq1, Sb1, X, 0, 0, 0);
                O = __builtin_amdgcn_mfma_f32_16x16x32_bf16(Rq0, Sb0, O, 0, 0, 0);
                O = __builtin_amdgcn_mfma_f32_16x16x32_bf16(Rq1, Sb1, O, 0, 0, 0);
                u32x2 yb; yb.x = cvt_pk_bf16(X.x, X.y); yb.y = cvt_pk_bf16(X.z, X.w);
                f32x4 U = {0.f, 0.f, 0.f, 0.f};
                U = __builtin_amdgcn_mfma_f32_16x16x16bf16_1k(ttf, *reinterpret_cast<s16x4v*>(&yb), U, 0, 0, 0);
                u32x2 ub; ub.x = cvt_pk_bf16(U.x, U.y); ub.y = cvt_pk_bf16(U.z, U.w);
                const s16x4v Ub = *reinterpret_cast<s16x4v*>(&ub);
                O = __builtin_amdgcn_mfma_f32_16x16x16bf16_1k(g3f, Ub, O, 0, 0, 0);
                const LAS unsigned char* bp = SL + RC_BTT + l15 * 40 + kg * 8; const LAS unsigned char* kp = SL + RC_KTT + l15 * 40 + kg * 8;
                const s16x4v b0 = *(const LAS s16x4v*)(bp), b1 = *(const LAS s16x4v*)(bp + 640), b2 = *(const LAS s16x4v*)(bp + 1280), b3 = *(const LAS s16x4v*)(bp + 1920);
                const s16x4v k0 = *(const LAS s16x4v*)(kp), k1 = *(const LAS s16x4v*)(kp + 640), k2 = *(const LAS s16x4v*)(kp + 1280), k3 = *(const LAS s16x4v*)(kp + 1920);
                const LAS f32x4* wc = (const LAS f32x4*)(SL + RC_WC + kg * 16);
                const f32x4 w0 = wc[0], w1 = wc[4], w2 = wc[8], w3 = wc[12];
                S0 = __builtin_amdgcn_mfma_f32_16x16x16bf16_1k(k0, vtf, S0, 0, 0, 0); S1 = __builtin_amdgcn_mfma_f32_16x16x16bf16_1k(k1, vtf, S1, 0, 0, 0);
                S2 = __builtin_amdgcn_mfma_f32_16x16x16bf16_1k(k2, vtf, S2, 0, 0, 0); S3 = __builtin_amdgcn_mfma_f32_16x16x16bf16_1k(k3, vtf, S3, 0, 0, 0);
                S0 = __builtin_amdgcn_mfma_f32_16x16x16bf16_1k(b0, Ub, S0, 0, 0, 0); S1 = __builtin_amdgcn_mfma_f32_16x16x16bf16_1k(b1, Ub, S1, 0, 0, 0);
                S2 = __builtin_amdgcn_mfma_f32_16x16x16bf16_1k(b2, Ub, S2, 0, 0, 0); S3 = __builtin_amdgcn_mfma_f32_16x16x16bf16_1k(b3, Ub, S3, 0, 0, 0);
                S0 = S0 * w0; S1 = S1 * w1; S2 = S2 * w2; S3 = S3 * w3;
                asm volatile("s_waitcnt lgkmcnt(0)" ::: "memory");
                if (lane == 0) flags[8] = (unsigned)(n + 1);
                float* op = O32 + (size_t)(NPAD + 16 * n + 4 * kg) * D + h * 64 + 16 * rgw + l15;
                op[0] = O.x; op[D] = O.y; op[2 * D] = O.z; op[3 * D] = O.w;
            }
            __builtin_amdgcn_s_setprio(0);
        } else {
            const int p = wid - 1;
            LAS unsigned char* SC = L + RC_SCR0 + p * RC_SCR;
            const float kkc = F.in(23)[h * 64 + lane], kac = F.in(24)[h * 64 + lane];
            for (int n = p; n < RC_NCH; n += 7) {
                const int slot = n & 7; LAS unsigned char* SL = L + slot * RC_SLOT;
                const int r0 = NPAD + 16 * n;
                unsigned short vq[4];
#pragma unroll
                for (int e = 0; e < 4; ++e) vq[e] = V[(size_t)(r0 + 4 * kg + e) * D + h * 64 + 16 * rgw + l15];
#if RC_SYNC
                asm volatile("s_waitcnt lgkmcnt(0)" ::: "memory"); __builtin_amdgcn_s_barrier();
#else
                if (n >= 8) { unsigned sp = 0; while (lds_poll(flags + 8) < (unsigned)(n - 7)) { __builtin_amdgcn_s_sleep(2); if (++sp > (1u << 22)) break; } }
#endif
                asm volatile("" ::: "memory");
                float Wp = 1.f; unsigned btp[8], ktp[8];
#pragma unroll
                for (int hb = 0; hb < 2; ++hb) {
                    unsigned short rq[8], kq[8], wq[8], aq[8]; float iv[8];
#pragma unroll
                    for (int s = 0; s < 8; ++s) { const size_t off = (size_t)(r0 + 8 * hb + s) * D + h * 64 + lane; rq[s] = Rr[off]; kq[s] = K[off]; wq[s] = W[off]; aq[s] = A[off]; iv[s] = INV[(size_t)(r0 + 8 * hb + s) * 64 + h]; }
                    float btv[8], ktv[8];
#pragma unroll
                    for (int s = 0; s < 8; ++s) {
                        const int t = 8 * hb + s;
                        const float rs = bf2f(rq[s]), ks = bf2f(kq[s]), wsv = bf2f(wq[s]), as = bf2f(aq[s]);
                        const float kk = ks * kkc * iv[s];
                        const float Wprev = Wp; Wp *= wsv; const float iW = __builtin_amdgcn_rcpf(Wp);
                        const float at = -kk * Wprev, rt = rs * Wp, bt = kk * as * iW, kt = ks * (1.f + (as - 1.f) * kac) * iW;
                        *(LAS bf16_t*)(SL + RC_AT + t * 136 + lane * 2) = f2bf(at); *(LAS bf16_t*)(SL + RC_RT + t * 136 + lane * 2) = f2bf(rt);
                        *(LAS bf16_t*)(SC + t * 136 + lane * 2) = f2bf(bt); *(LAS bf16_t*)(SC + 2176 + t * 136 + lane * 2) = f2bf(kt);
                        btv[s] = bt; ktv[s] = kt;
                    }
#pragma unroll
                    for (int s = 0; s < 4; ++s) { btp[4 * hb + s] = cvt_pk_bf16(btv[2 * s], btv[2 * s + 1]); ktp[4 * hb + s] = cvt_pk_bf16(ktv[2 * s], ktv[2 * s + 1]); }
                }
                {
                    LAS u32x2* bq = (LAS u32x2*)(SL + RC_BTT + lane * 40); LAS u32x2* kq2 = (LAS u32x2*)(SL + RC_KTT + lane * 40);
#pragma unroll
                    for (int q = 0; q < 4; ++q) { bq[q] = (u32x2){btp[2 * q], btp[2 * q + 1]}; kq2[q] = (u32x2){ktp[2 * q], ktp[2 * q + 1]}; }
                    *(LAS float*)(SL + RC_WC + lane * 4) = Wp;
                    u32x2 vt; vt.x = (unsigned)vq[0] | ((unsigned)vq[1] << 16); vt.y = (unsigned)vq[2] | ((unsigned)vq[3] << 16);
                    *(LAS u32x2*)(SL + RC_VTF + lane * 8) = vt;
                }
                asm volatile("s_waitcnt lgkmcnt(0)" ::: "memory");
                f32x4 G1 = {0.f, 0.f, 0.f, 0.f}, G2 = G1, G3 = G1, G4 = G1;
#pragma unroll
                for (int ks = 0; ks < 2; ++ks) {
                    const bf16x8 fb = *(const LAS bf16x8*)(SC + l15 * 136 + (32 * ks + 8 * kg) * 2), fk = *(const LAS bf16x8*)(SC + 2176 + l15 * 136 + (32 * ks + 8 * kg) * 2);
                    const bf16x8 fa = *(const LAS bf16x8*)(SL + RC_AT + l15 * 136 + (32 * ks + 8 * kg) * 2), fr_ = *(const LAS bf16x8*)(SL + RC_RT + l15 * 136 + (32 * ks + 8 * kg) * 2);
                    G1 = __builtin_amdgcn_mfma_f32_16x16x32_bf16(fb, fa, G1, 0, 0, 0); G2 = __builtin_amdgcn_mfma_f32_16x16x32_bf16(fk, fa, G2, 0, 0, 0);
                    G3 = __builtin_amdgcn_mfma_f32_16x16x32_bf16(fb, fr_, G3, 0, 0, 0); G4 = __builtin_amdgcn_mfma_f32_16x16x32_bf16(fk, fr_, G4, 0, 0, 0);
                }
                {
                    LAS float* NM = (LAS float*)(SC + 4352);
#pragma unroll
                    for (int e = 0; e < 4; ++e) { const int s = 4 * kg + e; const bool lt = s < l15, le = s <= l15;
                        NM[s * 20 + l15] = lt ? G1[e] : 0.f; G2[e] = lt ? G2[e] : 0.f; G3[e] = le ? G3[e] : 0.f; G4[e] = le ? G4[e] : 0.f; }
                    u32x2 g2, g3, g4; g2.x = cvt_pk_bf16(G2.x, G2.y); g2.y = cvt_pk_bf16(G2.z, G2.w); g3.x = cvt_pk_bf16(G3.x, G3.y); g3.y = cvt_pk_bf16(G3.z, G3.w); g4.x = cvt_pk_bf16(G4.x, G4.y); g4.y = cvt_pk_bf16(G4.z, G4.w);
                    *(LAS u32x2*)(SL + RC_G3F + lane * 8) = g3;
                    u32x2 vt; vt.x = (unsigned)vq[0] | ((unsigned)vq[1] << 16); vt.y = (unsigned)vq[2] | ((unsigned)vq[3] << 16);
                    const s16x4v vtf = *reinterpret_cast<s16x4v*>(&vt);
                    f32x4 P1 = {0.f, 0.f, 0.f, 0.f}, P2 = P1;
                    P1 = __builtin_amdgcn_mfma_f32_16x16x16bf16_1k(*reinterpret_cast<s16x4v*>(&g2), vtf, P1, 0, 0, 0);
                    P2 = __builtin_amdgcn_mfma_f32_16x16x16bf16_1k(*reinterpret_cast<s16x4v*>(&g4), vtf, P2, 0, 0, 0);
                    *(LAS f32x4*)(SL + RC_P1 + lane * 16) = P1; *(LAS f32x4*)(SL + RC_P2 + lane * 16) = P2;
                    asm volatile("s_waitcnt lgkmcnt(0)" ::: "memory");
                    float Tc[16];
#pragma unroll
                    for (int s = 15; s >= 0; --s) {
                        float acc = 0.f;
#pragma unroll
                        for (int r4 = (s + 1) / 4; r4 < 4; ++r4) { const f32x4 nv = *(const LAS f32x4*)(NM + s * 20 + 4 * r4);
#pragma unroll
                            for (int e = 0; e < 4; ++e) { const int r = 4 * r4 + e; if (r > s) acc += nv[e] * Tc[r]; } }
                        Tc[s] = (s == l15) ? 1.f : ((s < l15) ? acc : 0.f);
                    }
                    if (kg == 0) {
                        u32x4 o0, o1; o0.x = cvt_pk_bf16(Tc[0], Tc[1]); o0.y = cvt_pk_bf16(Tc[2], Tc[3]); o0.z = cvt_pk_bf16(Tc[4], Tc[5]); o0.w = cvt_pk_bf16(Tc[6], Tc[7]);
                        o1.x = cvt_pk_bf16(Tc[8], Tc[9]); o1.y = cvt_pk_bf16(Tc[10], Tc[11]); o1.z = cvt_pk_bf16(Tc[12], Tc[13]); o1.w = cvt_pk_bf16(Tc[14], Tc[15]);
                        LAS u32x4* tp = (LAS u32x4*)(SL + RC_TT + l15 * 32); tp[0] = o0; tp[1] = o1;
                    }
                }
                asm volatile("s_waitcnt lgkmcnt(0)" ::: "memory");
#if RC_SYNC
                __builtin_amdgcn_s_barrier();
#else
                if (lane == 0) flags[slot] = (unsigned)(n + 1);
#endif
            }
#if RC_SYNC
            if (p >= RC_NCH % 7) { __builtin_amdgcn_s_barrier(); __builtin_amdgcn_s_barrier(); }
#endif
        }
        __syncthreads();
    }
}
__device__ __forceinline__ void rwkv_post(const Fr& F) {
    const bf16_t* Rr = slotY(F, 0); const bf16_t* K = slotY(F, 1); const bf16_t* V = slotY(F, 2); const bf16_t* GT = slotY(F, 3); const bf16_t* A = slotY(F, 5);
    const float* O32 = (const float*)slotU(F, 1); bf16_t* Z = slotU(F, 0);
    const float* k_a = F.in(24); const float* r_k = F.in(25); const float* lw = F.in(26); const float* lb = F.in(27);
    for (int r = F.gw; r < R; r += F.NGW) {
        const bool real = (r >= NPAD && r < NREAL);
        u32x2* zr = (u32x2*)(Z + (size_t)r * D) + F.lane;
        if (!real) { const u32x2 z = {0u, 0u};
#pragma unroll
            for (int it = 0; it < 16; ++it) zr[64 * it] = z;
            continue; }
#pragma unroll 2
        for (int it = 0; it < 16; ++it) {
            const size_t ci = (size_t)it * 64 + F.lane;
            const f32x4 o4 = ((const f32x4*)(O32 + (size_t)r * D))[ci];
            const u32x2 rr = ((const u32x2*)(Rr + (size_t)r * D))[ci], kk = ((const u32x2*)(K + (size_t)r * D))[ci], vv = ((const u32x2*)(V + (size_t)r * D))[ci], gg = ((const u32x2*)(GT + (size_t)r * D))[ci], aa = ((const u32x2*)(A + (size_t)r * D))[ci];
            const f32x4 ka4 = ((const f32x4*)k_a)[ci], rk4 = ((const f32x4*)r_k)[ci], lw4 = ((const f32x4*)lw)[ci], lb4 = ((const f32x4*)lb)[ci];
            const float mean = red16((o4.x + o4.y) + (o4.z + o4.w)) * (1.f / 64.f);
            const float d0 = o4.x - mean, d1 = o4.y - mean, d2 = o4.z - mean, d3 = o4.w - mean;
            const float var = red16((d0 * d0 + d1 * d1) + (d2 * d2 + d3 * d3)) * (1.f / 64.f);
            const float rs = __builtin_amdgcn_rsqf(var + 64e-5f);
            const float r0 = bflo(rr.x), r1 = bfhi(rr.x), r2 = bflo(rr.y), r3 = bfhi(rr.y);
            const float kp0 = bflo(kk.x) * (1.f + (bflo(aa.x) - 1.f) * ka4.x), kp1 = bfhi(kk.x) * (1.f + (bfhi(aa.x) - 1.f) * ka4.y), kp2 = bflo(kk.y) * (1.f + (bflo(aa.y) - 1.f) * ka4.z), kp3 = bfhi(kk.y) * (1.f + (bfhi(aa.y) - 1.f) * ka4.w);
            const float bs = red16((r0 * kp0 * rk4.x + r1 * kp1 * rk4.y) + (r2 * kp2 * rk4.z + r3 * kp3 * rk4.w));
            const float y0 = d0 * rs * lw4.x + lb4.x + bs * bflo(vv.x), y1 = d1 * rs * lw4.y + lb4.y + bs * bfhi(vv.x), y2 = d2 * rs * lw4.z + lb4.z + bs * bflo(vv.y), y3 = d3 * rs * lw4.w + lb4.w + bs * bfhi(vv.y);
            u32x2 w; w.x = cvt_pk_bf16(y0 * silu_f(bflo(gg.x)), y1 * silu_f(bfhi(gg.x))); w.y = cvt_pk_bf16(y2 * silu_f(bflo(gg.y)), y3 * silu_f(bfhi(gg.y)));
            zr[64 * it] = w;
        }
    }
}
}
namespace mk {
constexpr int LDS_BYTES = 147456;
constexpr int LDS_MISC = LDS_BYTES - 128;
struct Args { const float* in[29]; float* out; unsigned char* ws; };

#define MK_GEMM(EPI, e, Aptr, aps_, Bptr, M_, N_, K_) do { int kk_ = (K_); asm volatile("" : "+s"(kk_));     \
    pg8::Gemm g_{(const bf16_t*)(Aptr), (const bf16_t*)(Bptr), (M_), (N_), kk_, (size_t)(aps_)}; pg8::StaticOrder S_; S_.init((M_), (N_), F.G, F.bid); \
    pg8::gemm_phase<EPI, pg8::StaticOrder, false>(F.lds, g_, S_, e, nullptr); } while (0)

__global__ void __launch_bounds__(512, 2) fwd(Args a) {
    extern __shared__ __attribute__((aligned(16))) unsigned char lds_raw[];
    Fr F;
    F.lds = (LAS unsigned char*)lds_raw; F.ldsg = lds_raw;
    F.tid = threadIdx.x; F.lane = F.tid & 63; F.wave = __builtin_amdgcn_readfirstlane(F.tid >> 6);
    F.G = gridDim.x; F.bid = blockIdx.x; F.gw = F.bid * 8 + F.wave; F.NGW = F.G * 8;
    F.out = a.out; F.ws = a.ws;
    volatile LAS unsigned* misc = (volatile LAS unsigned*)(F.lds + LDS_MISC);
    if (F.tid < 16) misc[F.tid] = 0u;
    __syncthreads();
    XcdBarrier bar = xcd_barrier_post((unsigned*)(F.ws + WS_CTL) + 4096, misc + 8);
#define GRID_BAR() xcd_barrier(bar)
#ifndef MK_DUP
#define MK_DUP 0
#endif
#define DUPN(k, ...) do { __VA_ARGS__; if ((MK_DUP >> (k)) & 1) { GRID_BAR(); __VA_ARGS__; } } while (0)
    bf16_t* wtin = (bf16_t*)(F.ws + WS_WTIN); bf16_t* wtout = (bf16_t*)(F.ws + WS_WTOUT);
    const EpiY ey{slotY(F, 0)};

    DUPN(11, { const Fr P = F.fresh(); convert_layer(P, 0); rope_table(P); norm_phase(P, -1, 0, nullptr, slotU(P, 0)); });
    GRID_BAR();
    DUPN(8, { const EpiH1 e{slotY(F, 0), F.in(5), 0}; MK_GEMM(EpiH1, e, slotU(F, 0), 0, wtin, R, 4 * D, D); });
    GRID_BAR();
    DUPN(1, { const Fr P = F.fresh(); hgrn_phase<false>(P, 0); });
    GRID_BAR();
    DUPN(2, { const Fr P = F.fresh(); hgrn_phase<true>(P, 0); });
    GRID_BAR();
    DUPN(10, MK_GEMM(EpiY, ey, slotU(F, 0), 0, wtout, R, D, D));
    GRID_BAR();
    { const Fr P = F.fresh(); norm_phase(P, 0, 1, slotY(P, 0), slotU(P, 0)); DUPN(12, convert_layer(P, 1)); }
    GRID_BAR();
    { const EpiB1 e{slotY(F, 0), (const float*)(F.ws + WS_ROPE), (const float*)(F.ws + WS_ROPE) + (size_t)R * 16}; MK_GEMM(EpiB1, e, slotU(F, 0), 0, wtin, R, 4 * D, D); }
    GRID_BAR();
    DUPN(3, { const Fr P = F.fresh(); attn_phase(P); });
    GRID_BAR();
    DUPN(4, { const Fr P = F.fresh(); attn_post(P); });
    GRID_BAR();
    MK_GEMM(EpiY, ey, slotU(F, 0), 0, wtout, R, D, D);
    GRID_BAR();
    { const Fr P = F.fresh(); norm_phase(P, 1, 2, slotY(P, 0), slotY(P, 1)); convert_layer(P, 2); }
    GRID_BAR();
    DUPN(7, { const Fr P = F.fresh(); mix_phase(P, slotY(P, 1)); convert_layer2_b(P); });
    GRID_BAR();
    { const EpiC1 e{slotY(F, 0), (bf16_t*)(F.ws + WS_T)}; MK_GEMM(EpiC1, e, slotU(F, 0), (size_t)R * D, wtin, R, 4 * D + 512, D); }
    GRID_BAR();
    DUPN(9, { const EpiC2 e{slotY(F, 0), F.in(17), F.in(20)}; MK_GEMM(EpiC2, e, F.ws + WS_T, 0, F.ws + WS_W2P, R, 2 * D, 256); });
    { const Fr P = F.fresh(); rwkv_kknorm(P); }
    GRID_BAR();
    DUPN(5, { const Fr P = F.fresh(); rwkv_scan(P); });
    GRID_BAR();
    DUPN(6, { const Fr P = F.fresh(); rwkv_post(P); });
    GRID_BAR();
    MK_GEMM(EpiY, ey, slotU(F, 0), 0, wtout, R, D, D);
    GRID_BAR();
    { const Fr P = F.fresh(); norm_phase(P, 2, 3, slotY(P, 0), slotU(P, 0)); convert_layer(P, 3); }
    GRID_BAR();
    { const EpiH1 e{slotY(F, 0), F.in(5), 1}; MK_GEMM(EpiH1, e, slotU(F, 0), 0, wtin, R, 4 * D, D); }
    GRID_BAR();
    { const Fr P = F.fresh(); hgrn_phase<false>(P, 1); }
    GRID_BAR();
    { const Fr P = F.fresh(); hgrn_phase<true>(P, 1); }
    GRID_BAR();
    MK_GEMM(EpiY, ey, slotU(F, 0), 0, wtout, R, D, D);
    GRID_BAR();
    { const Fr P = F.fresh(); norm_phase(P, 3, -1, slotY(P, 0), nullptr); }
}
}

extern "C" void kernel_launch(void* const* d_in, const int* in_sizes, int n_in, void* d_out, int out_size, void* d_ws, size_t ws_size, hipStream_t stream) {
    static int grid = 0;
    if (grid == 0) {
        if (n_in != 29 || out_size != 16384 * 4096 || ws_size < mk::WS_END) { fprintf(stderr, "kernel_launch: unexpected shapes (n_in %d out %d ws %zu need %zu)\n", n_in, out_size, ws_size, (size_t)mk::WS_END); grid = -1; return; }
        int dev = 0, cus = 0, per_cu = 0;
        if (hipGetDevice(&dev) != hipSuccess || hipDeviceGetAttribute(&cus, hipDeviceAttributeMultiprocessorCount, dev) != hipSuccess) { grid = -1; return; }
        if (hipFuncSetAttribute((const void*)mk::fwd, hipFuncAttributeMaxDynamicSharedMemorySize, mk::LDS_BYTES) != hipSuccess) { fprintf(stderr, "kernel_launch: hipFuncSetAttribute failed\n"); grid = -1; return; }
        if (hipOccupancyMaxActiveBlocksPerMultiprocessor(&per_cu, (const void*)mk::fwd, 512, mk::LDS_BYTES) != hipSuccess || per_cu < 1) { fprintf(stderr, "kernel_launch: occupancy query says %d\n", per_cu); }
        (void)hipGetLastError();
        grid = cus;
    }
    if (grid < 0) return;
    if (hipMemsetAsync((char*)d_ws + mk::WS_CTL, 0, mk::CTL_BYTES, stream) != hipSuccess) return;
    mk::Args a{};
    for (int i = 0; i < 29; ++i) a.in[i] = (const float*)d_in[i];
    a.out = (float*)d_out; a.ws = (unsigned char*)d_ws;
    hipLaunchKernelGGL(mk::fwd, dim3(grid), dim3(512), mk::LDS_BYTES, stream, a);
}
```

```cpp
#include <hip/hip_runtime.h>
#include <cstdio>
#include <cstdint>

#define LAS __attribute__((address_space(3)))
#define GAS __attribute__((address_space(1)))
typedef unsigned short bf16_t;
typedef short bf16x8 __attribute__((ext_vector_type(8)));
typedef short s16x4 __attribute__((ext_vector_type(4)));
typedef float f32x4 __attribute__((ext_vector_type(4)));
typedef float f32x16 __attribute__((ext_vector_type(16)));
typedef unsigned u32x4 __attribute__((ext_vector_type(4)));
typedef unsigned u32x2 __attribute__((ext_vector_type(2)));

namespace mk {
constexpr int D = 4096, NPAD = 48, NREAL = 16448, R = 16640, NCH = 257;
constexpr size_t MiB = 1u << 20;
constexpr size_t SLOT = (size_t)R * D * 2;
constexpr size_t WS_CTL = 0, CTL_BYTES = 1 * MiB;
constexpr size_t WS_WTIN = 2 * MiB;
constexpr size_t WS_WTOUT = 134 * MiB;
constexpr size_t WS_W2P = 166 * MiB;
constexpr size_t WS_ROPE = 170 * MiB;
constexpr size_t WS_HMETA = 174 * MiB;
constexpr size_t WS_HE = 175 * MiB;
constexpr size_t WS_HLOGD = 191 * MiB;
constexpr size_t WS_U = 192 * MiB;
constexpr size_t WS_Y = WS_U + 6 * SLOT;
constexpr size_t WS_T = WS_Y + 6 * SLOT;
constexpr size_t WS_END = WS_T + (size_t)R * 256 * 2;
static_assert(WS_END <= 2040 * MiB, "d_ws map");

typedef __bf16 bf16x2n_t __attribute__((ext_vector_type(2)));
typedef float f32x2n_t __attribute__((ext_vector_type(2)));
__device__ __forceinline__ unsigned cvt_pk_bf16(float lo, float hi) { const f32x2n_t v = {lo, hi}; const bf16x2n_t r = __builtin_convertvector(v, bf16x2n_t); return __builtin_bit_cast(unsigned, r); }
__device__ __forceinline__ float bflo(unsigned w) { return __uint_as_float(w << 16); }
__device__ __forceinline__ float bfhi(unsigned w) { return __uint_as_float(w & 0xffff0000u); }
__device__ __forceinline__ float bf2f(bf16_t b) { return __uint_as_float(((unsigned)b) << 16); }
__device__ __forceinline__ bf16_t f2bf(float f) { return (bf16_t)(cvt_pk_bf16(f, f) & 0xffffu); }
__device__ __forceinline__ float sigmoid_f(float x) { return 1.f / (1.f + __expf(-x)); }
__device__ __forceinline__ float silu_f(float x) { return x / (1.f + __expf(-x)); }
__device__ __forceinline__ float wave_sum(float v) {
#pragma unroll
    for (int o = 1; o < 64; o <<= 1) v += __shfl_xor(v, o);
    return v;
}
template <int CTRL> __device__ __forceinline__ float dppf(float v) { return __int_as_float(__builtin_amdgcn_update_dpp(0, __float_as_int(v), CTRL, 0xf, 0xf, true)); }
__device__ __forceinline__ float red4(float v) { v += dppf<0xB1>(v); v += dppf<0x4E>(v); return v; }
__device__ __forceinline__ float red8(float v) { v = red4(v); v += dppf<0x141>(v); return v; }
__device__ __forceinline__ float red16(float v) { v = red8(v); v += dppf<0x140>(v); return v; }
#define LDS_WAIT() asm volatile("s_waitcnt lgkmcnt(0)" ::: "memory")
}
#define XB_TMO      128
#define XB_XCNT(j)  (256  + 64 * (j))
#define XB_XSUB(j)  (1280 + 64 * (j))
#define XB_XGEN(j)  (2304 + 64 * (j))
#define XB_TOP      3328
#define XB_TOPGEN   3392
#define XCD_BAR_WORDS 3456
#define XB_SPIN_CAP (1u << 18)
#define LAS __attribute__((address_space(3)))

__device__ __forceinline__ unsigned xb_ld(unsigned* p)              { return __hip_atomic_load(p, __ATOMIC_RELAXED, __HIP_MEMORY_SCOPE_AGENT); }
__device__ __forceinline__ unsigned xb_add(unsigned* p, unsigned v) { return __hip_atomic_fetch_add(p, v, __ATOMIC_RELAXED, __HIP_MEMORY_SCOPE_AGENT); }
__device__ __forceinline__ unsigned xb_xcc_id() { return (unsigned)__builtin_amdgcn_s_getreg((3 << 11) | 20) & 0xFu; }
#define XB_SPIN(cond, bar) do { unsigned _sp = 0; while (cond) { __builtin_amdgcn_s_sleep(1); \
    if ((++_sp & 255u) == 0u) { if (xb_ld(&(bar)[XB_TMO])) break; if (_sp > XB_SPIN_CAP) { atomicAdd(&(bar)[XB_TMO], 1u); break; } } } } while (0)

struct XcdBarrier {
    unsigned* bar; unsigned x;
    volatile LAS unsigned* st;
};

__device__ __forceinline__ XcdBarrier xcd_barrier_post(unsigned* bar, volatile LAS unsigned* st) {
    XcdBarrier b; b.bar = bar; b.x = xb_xcc_id(); b.st = st;
    if (threadIdx.x == 0) (void)xb_add(&bar[XB_XCNT(b.x)], 1u);
    return b;
}
__device__ __forceinline__ void xcd_barrier_complete(unsigned* bar, unsigned x, unsigned& nloc, unsigned& nx) {
    const unsigned G = gridDim.x * gridDim.y * gridDim.z;
    unsigned sum, cnt, mine, sp = 0u;
    for (;;) {
        sum = 0u; cnt = 0u; mine = 0u;
#pragma unroll
        for (unsigned j = 0; j < 16; ++j) { const unsigned c = xb_ld(&bar[XB_XCNT(j)]); sum += c; cnt += (c > 0u) ? 1u : 0u; mine = (j == x) ? c : mine; }
        if (sum == G) break;
        __builtin_amdgcn_s_sleep(1);
        if ((++sp & 255u) == 0u) { if (xb_ld(&bar[XB_TMO])) break; if (sp > XB_SPIN_CAP) { atomicAdd(&bar[XB_TMO], 1u); break; } }
    }
    nloc = mine > 0u ? mine : 1u; nx = cnt > 0u ? cnt : 1u;
}

__device__ __forceinline__ void xcd_barrier(const XcdBarrier& b) {
    asm volatile("s_waitcnt vmcnt(0)" ::: "memory");
    __syncthreads();
    if (threadIdx.x == 0) {
        unsigned* bar = b.bar;
        __builtin_amdgcn_s_waitcnt(0);
        unsigned nloc = b.st[0], nx = b.st[1];
        if (nloc == 0u) { xcd_barrier_complete(bar, b.x, nloc, nx); b.st[0] = nloc; b.st[1] = nx; }
        const unsigned old = xb_add(&bar[XB_XSUB(b.x)], 1u);
        const unsigned gen = old / nloc;
        if (old + 1u == (gen + 1u) * nloc) {
            __builtin_amdgcn_fence(__ATOMIC_RELEASE, "agent");
            asm volatile("s_waitcnt vmcnt(0)" ::: "memory");
            const unsigned og = xb_add(&bar[XB_TOP], 1u);
            const unsigned tg = og / nx;
            if (og + 1u == (tg + 1u) * nx) xb_add(&bar[XB_TOPGEN], 1u);
            else XB_SPIN(xb_ld(&bar[XB_TOPGEN]) == tg, bar);
            __builtin_amdgcn_fence(__ATOMIC_ACQUIRE, "agent");
            xb_add(&bar[XB_XGEN(b.x)], 1u);
            asm volatile("s_waitcnt vmcnt(0)" ::: "memory");
        } else {
            XB_SPIN(xb_ld(&bar[XB_XGEN(b.x)]) == gen, bar);
            __builtin_amdgcn_fence(__ATOMIC_ACQUIRE, "agent");
            asm volatile("s_waitcnt vmcnt(0)" ::: "memory");
        }
    }
    __syncthreads();
}
namespace pg8 {
#define PG8_LAS __attribute__((address_space(3)))
typedef unsigned short bf16_t;
typedef short bf16x8 __attribute__((ext_vector_type(8)));
typedef float f32x4 __attribute__((ext_vector_type(4)));
typedef unsigned u32x4 __attribute__((ext_vector_type(4)));
constexpr int BM = 256, BK = 64, HALF = 128, HTB = HALF * BK * 2  , STAGE_BYTES = 8 * HTB, NXCD = 8, WGM = 8;

__host__ __device__ __forceinline__ int lds_byte(int r, int c) { const int st = (r >> 4) * 2 + (c >> 5), rr = r & 15, cc = c & 31, ob = rr * 64 + cc * 2; return st * 1024 + (ob ^ (((ob >> 9) & 1) << 5)); }
__host__ __device__ __forceinline__ void stage_rc(int b, int& R, int& C) { const int st = b / 1024, sb = b % 1024, swz = sb ^ (((sb >> 9) & 1) << 5); R = (st >> 1) * 16 + swz / 64; C = (st & 1) * 32 + (swz % 64) / 2; }
__host__ __device__ __forceinline__ int perm32(int rho) { const int n = rho >> 4, i = rho & 15; return 8 * (i >> 2) + 4 * n + (i & 3); }

struct Unit { int pm, pn; };
struct Gemm { const bf16_t* A; const bf16_t* Bt; int M, N, K; size_t aps; };
__device__ __forceinline__ size_t a_part_bytes(const Gemm& g, int pn) { return g.aps ? (size_t)(pn < 64 ? (pn >> 4) : (pn - 60)) * g.aps * 2 : (size_t)0; }

struct StaticOrder {
    int nM, nN, nwg, G, c;
    __host__ __device__ void init(int M, int N, int G_, int c_) { nM = M / BM; nN = N / BM; nwg = nM * nN; G = G_; c = c_; }
    __host__ __device__ bool next(int i, Unit& u) const {
        const long L = (long)i * G + c; if (L >= nwg) return false;
        int wgid = (int)L; { const int q = nwg / NXCD, r = nwg % NXCD, xcd = wgid % NXCD, off = wgid / NXCD; wgid = (xcd < r ? xcd * (q + 1) : r * (q + 1) + (xcd - r) * q) + off; }
        const int nig = WGM * nN, gid = wgid / nig, fm = gid * WGM, gsz = (nM - fm) < WGM ? (nM - fm) : WGM;
        u.pm = fm + ((wgid % nig) % gsz); u.pn = (wgid % nig) / gsz; return true;
    }
    __device__ __forceinline__ void a_ready(const Unit&) const {}
    __device__ __forceinline__ void done(const Unit&) const {}
};
struct CountedOrder : StaticOrder {
    const unsigned* ready; unsigned need; unsigned* tmo;
    __device__ __forceinline__ void a_ready(const Unit& u) const {
        if (threadIdx.x < 64) {
            const unsigned long long t0 = __builtin_amdgcn_s_memrealtime(); unsigned polls = 0;
            while ((unsigned)__builtin_amdgcn_readfirstlane(__hip_atomic_load(ready + 64 * u.pm, __ATOMIC_RELAXED, __HIP_MEMORY_SCOPE_AGENT)) < need) {
                if ((++polls & 255u) == 0u && __builtin_amdgcn_readfirstlane(__hip_atomic_load(tmo, __ATOMIC_RELAXED, __HIP_MEMORY_SCOPE_AGENT)) != 0u) break;
                if (__builtin_amdgcn_s_memrealtime() - t0 > 2000000ull) {
                    if (threadIdx.x == 0) { unsigned expect = 0u; __hip_atomic_compare_exchange_strong(tmo + 1, &expect, 0x600u | (unsigned)(u.pm & 0xff), __ATOMIC_RELAXED, __ATOMIC_RELAXED, __HIP_MEMORY_SCOPE_AGENT); __hip_atomic_store(tmo, 1u, __ATOMIC_RELAXED, __HIP_MEMORY_SCOPE_AGENT); }
                    break; }
                __builtin_amdgcn_s_sleep(2); }
            __builtin_amdgcn_fence(__ATOMIC_ACQUIRE, "agent");
            asm volatile("s_waitcnt vmcnt(0)" ::: "memory");
        }
#if !defined(BROKEN_HOOK_NO_BARRIER)
        asm volatile("" ::: "memory"); __builtin_amdgcn_s_barrier(); asm volatile("" ::: "memory");
#endif
    }
};
template <class Epi, class Sched, bool STAMP = false>
__device__ __forceinline__ void gemm_phase(PG8_LAS unsigned char* lds, const Gemm g, const Sched& S, const Epi& E, unsigned long long* stamps) {
    int tid_ = threadIdx.x; asm volatile("" : "+v"(tid_));
    const int tid = tid_, wid = __builtin_amdgcn_readfirstlane(tid >> 6), lane = tid & 63, wr = wid >> 2, wc = wid & 3, fr = lane & 15, fq = lane >> 4;
    const int K = g.K, nt = K / BK;
    int ts_lo = 0, ts_hi = 0, nts = 0; const unsigned long long rt_entry = STAMP ? (unsigned long long)wall_clock64() : 0ull;
#define PG8_STAMP() do { if (STAMP && wid == 0 && nts < 64) { const unsigned long long _c = (unsigned long long)clock64(); \
        ts_lo = (lane == nts) ? (int)(unsigned)_c : ts_lo; ts_hi = (lane == nts) ? (int)(unsigned)(_c >> 32) : ts_hi; ++nts; } } while (0)
    PG8_STAMP();
    unsigned voffA[2], voffB[2];
#pragma unroll
    for (int i = 0; i < 2; ++i) { int R, C; stage_rc(tid * 16 + i * 8192, R, C); const int Rb = Epi::PERM ? ((R & ~31) + perm32(R & 31)) : R;
        voffA[i] = (unsigned)(R * K + C) * 2u; voffB[i] = (unsigned)(Rb * K + C) * 2u; }
    const size_t kstep = (size_t)(BK * 2);
    const size_t hstep = (size_t)HALF * K * 2;
    const size_t tstep = 2 * hstep;
    const unsigned ldsw = (unsigned)wid * 1024u;
    const int aoff = lds_byte(wr * 64 + fr, fq * 8), boff = lds_byte(wc * 32 + fr, fq * 8);
#define PG8_SA(b, h) (((b) * 2 + (h)) * HTB)
#define PG8_SB(b, h) ((4 + (b) * 2 + (h)) * HTB)
#define PG8_STAGE(bufoff, gbase, voff) do { _Pragma("unroll") for (int _i = 0; _i < 2; ++_i) \
        __builtin_amdgcn_global_load_lds((const unsigned*)((const char*)(gbase) + (voff)[_i]), (PG8_LAS unsigned*)(lds + (bufoff) + ldsw + _i * 8192), 16, 0, 0); } while (0)
#define PG8_LDA(dst, b, h) do { _Pragma("unroll") for (int m = 0; m < 4; ++m) _Pragma("unroll") for (int k = 0; k < 2; ++k) dst[m][k] = *(const PG8_LAS bf16x8*)(lds + PG8_SA(b, h) + aoff + m * 2048 + k * 1024); } while (0)
#define PG8_LDB(dst, b, h) do { _Pragma("unroll") for (int n = 0; n < 2; ++n) _Pragma("unroll") for (int k = 0; k < 2; ++k) dst[n][k] = *(const PG8_LAS bf16x8*)(lds + PG8_SB(b, h) + boff + n * 2048 + k * 1024); } while (0)
#define PG8_MMA(ai, bj, At, Bt) do { __builtin_amdgcn_s_setprio(1); _Pragma("unroll") for (int m = 0; m < 4; ++m) _Pragma("unroll") for (int n = 0; n < 2; ++n) _Pragma("unroll") for (int k = 0; k < 2; ++k) \
        acc[ai][bj][m][n] = __builtin_amdgcn_mfma_f32_16x16x32_bf16(Bt[n][k], At[m][k], acc[ai][bj][m][n], 0, 0, 0); __builtin_amdgcn_s_setprio(0); } while (0)
#define PG8_WAIT_V(n) asm volatile("s_waitcnt vmcnt(" #n ")" ::: "memory")
#define PG8_WAIT_L(n) asm volatile("s_waitcnt lgkmcnt(" #n ")" ::: "memory")
#define PG8_BAR __builtin_amdgcn_s_barrier()
#define PG8_SCHED __builtin_amdgcn_sched_barrier(0)
    Unit cur, nxt; int ui = 0;
    if (!S.next(0, cur)) return;
    f32x4 acc[2][2][4][2];
#pragma unroll
    for (int a = 0; a < 2; ++a)
#pragma unroll
        for (int b = 0; b < 2; ++b)
#pragma unroll
            for (int m = 0; m < 4; ++m)
#pragma unroll
                for (int n = 0; n < 2; ++n) acc[a][b][m][n] = (f32x4){0.f, 0.f, 0.f, 0.f};
    bf16x8 At[4][2], B0[2][2], B1[2][2];
    const char* cA = (const char*)g.A + a_part_bytes(g, cur.pn) + (size_t)cur.pm * tstep; const char* cB = (const char*)g.Bt + (size_t)cur.pn * tstep;
    S.a_ready(cur);
    PG8_STAGE(PG8_SB(0, 0), cB, voffB); PG8_STAGE(PG8_SA(0, 0), cA, voffA); PG8_STAGE(PG8_SB(0, 1), cB + hstep, voffB); PG8_STAGE(PG8_SA(0, 1), cA + hstep, voffA);
    if (wr == 1) PG8_BAR;
    PG8_WAIT_V(4); PG8_BAR;
    PG8_STAGE(PG8_SB(1, 0), cB + kstep, voffB); PG8_STAGE(PG8_SA(1, 0), cA + kstep, voffA); PG8_STAGE(PG8_SB(1, 1), cB + hstep + kstep, voffB);
    PG8_WAIT_V(6); PG8_BAR;
    PG8_STAMP();
    for (;;) {
        const bool has_next = S.next(ui + 1, nxt);
        const char* nA = has_next ? (const char*)g.A + a_part_bytes(g, nxt.pn) + (size_t)nxt.pm * tstep : cA; const char* nB = has_next ? (const char*)g.Bt + (size_t)nxt.pn * tstep : cB;
        for (int t = 0; t < nt; t += 2) {
            const bool last = (t == nt - 2);
            const char* a1 = cA + (size_t)(t + 1) * kstep;
            const char* a2 = last ? nA : cA + (size_t)(t + 2) * kstep; const char* b2 = last ? nB : cB + (size_t)(t + 2) * kstep;
            const char* a3 = a2 + kstep; const char* b3 = b2 + kstep;
            if (last && has_next) S.a_ready(nxt);
            PG8_LDB(B0, 0, 0); PG8_SCHED; PG8_LDA(At, 0, 0); PG8_STAGE(PG8_SA(1, 1), a1 + hstep, voffA);
            PG8_WAIT_L(8); PG8_BAR; PG8_WAIT_L(0); PG8_MMA(0, 0, At, B0); PG8_BAR; PG8_SCHED;
            PG8_LDB(B1, 0, 1); PG8_STAGE(PG8_SB(0, 0), b2, voffB);
            PG8_BAR; PG8_WAIT_L(0); PG8_MMA(0, 1, At, B1); PG8_BAR;
            PG8_LDA(At, 0, 1); PG8_STAGE(PG8_SA(0, 0), a2, voffA);
            PG8_BAR; PG8_WAIT_L(0); PG8_MMA(1, 0, At, B0); PG8_BAR; PG8_SCHED;
            PG8_STAGE(PG8_SB(0, 1), b2 + hstep, voffB);
            PG8_WAIT_V(6); PG8_BAR; PG8_MMA(1, 1, At, B1); PG8_BAR;
            PG8_LDB(B0, 1, 0); PG8_SCHED; PG8_LDA(At, 1, 0); PG8_STAGE(PG8_SA(0, 1), a2 + hstep, voffA);
            PG8_WAIT_L(8); PG8_BAR; PG8_WAIT_L(0); PG8_MMA(0, 0, At, B0); PG8_BAR; PG8_SCHED;
            PG8_LDB(B1, 1, 1); PG8_STAGE(PG8_SB(1, 0), b3, voffB);
            PG8_BAR; PG8_WAIT_L(0); PG8_MMA(0, 1, At, B1); PG8_BAR;
            PG8_LDA(At, 1, 1); PG8_STAGE(PG8_SA(1, 0), a3, voffA);
            PG8_BAR; PG8_WAIT_L(0); PG8_MMA(1, 0, At, B0); PG8_BAR; PG8_SCHED;
            PG8_STAGE(PG8_SB(1, 1), b3 + hstep, voffB);
            PG8_WAIT_V(6); PG8_BAR; PG8_MMA(1, 1, At, B1); PG8_BAR;
        }
        PG8_STAMP();
        if constexpr (!Epi::AFTER_DRAIN) { E(acc, cur, wr, wc, fr, fq); S.done(cur); }
        PG8_STAMP();
        if (!has_next) break;
#pragma unroll
        for (int a = 0; a < 2; ++a)
#pragma unroll
            for (int b = 0; b < 2; ++b)
#pragma unroll
                for (int m = 0; m < 4; ++m)
#pragma unroll
                    for (int n = 0; n < 2; ++n) acc[a][b][m][n] = (f32x4){0.f, 0.f, 0.f, 0.f};
        cur = nxt; cA = nA; cB = nB; ++ui;
    }
    PG8_WAIT_V(0);
    if (wr == 0) PG8_BAR;
    PG8_BAR;
    if constexpr (Epi::AFTER_DRAIN) { E.fused(acc, cur, wr, wc, fr, fq, lds, wid, lane); S.done(cur); }
    PG8_STAMP();
    if (STAMP && wid == 0) { stamps[lane] = lane < nts ? (((unsigned long long)(unsigned)ts_hi << 32) | (unsigned)ts_lo) : 0ull;
        if (lane == 62) stamps[62] = rt_entry; if (lane == 63) stamps[63] = (unsigned long long)wall_clock64(); }
#undef PG8_STAMP
#undef PG8_SA
#undef PG8_SB
#undef PG8_STAGE
#undef PG8_LDA
#undef PG8_LDB
#undef PG8_MMA
#undef PG8_WAIT_V
#undef PG8_WAIT_L
#undef PG8_BAR
#undef PG8_SCHED
}
}
namespace mk {
typedef pg8::Unit Unit;
typedef const pg8::f32x4 (&AccRef)[2][2][4][2];

__device__ __forceinline__ void st_bf8(bf16_t* p, pg8::f32x4 v0, pg8::f32x4 v1) {
    u32x4 w; w.x = cvt_pk_bf16(v0[0], v0[1]); w.y = cvt_pk_bf16(v0[2], v0[3]); w.z = cvt_pk_bf16(v1[0], v1[1]); w.w = cvt_pk_bf16(v1[2], v1[3]);
    *(u32x4*)p = w;
}
__device__ __forceinline__ void st_bf4(bf16_t* p, pg8::f32x4 v) { u32x2 w; w.x = cvt_pk_bf16(v[0], v[1]); w.y = cvt_pk_bf16(v[2], v[3]); *(u32x2*)p = w; }

struct EpiY {
    static constexpr bool PERM = true, AFTER_DRAIN = false;
    bf16_t* O;
    __device__ __forceinline__ void operator()(AccRef acc, const Unit& u, int wr, int wc, int fr, int fq) const {
        const int row0 = u.pm * 256 + wr * 64 + fr, col0 = u.pn * 256 + wc * 32 + 8 * fq;
#pragma unroll
        for (int ai = 0; ai < 2; ++ai)
#pragma unroll
            for (int m = 0; m < 4; ++m) { bf16_t* rowp = O + (size_t)(row0 + ai * 128 + m * 16) * D + col0;
#pragma unroll
                for (int bj = 0; bj < 2; ++bj) st_bf8(rowp + bj * 128, acc[ai][bj][m][0], acc[ai][bj][m][1]); }
    }
};
struct EpiH1 {
    static constexpr bool PERM = true, AFTER_DRAIN = false;
    bf16_t* Y; const float* lbl; int jl;
    __device__ __forceinline__ void operator()(AccRef acc, const Unit& u, int wr, int wc, int fr, int fq) const {
        const int part = u.pn >> 4, colt = (u.pn & 15) * 256;
        const int row0 = u.pm * 256 + wr * 64 + fr, col0 = colt + wc * 32 + 8 * fq;
        if (part == 1) {
#pragma unroll
            for (int bj = 0; bj < 2; ++bj) {
                pg8::f32x4 lbv[2] = {{0.f, 0.f, 0.f, 0.f}, {0.f, 0.f, 0.f, 0.f}};
                if (jl) {
#pragma unroll
                    for (int n = 0; n < 2; ++n) { const pg8::f32x4 l0 = *(const pg8::f32x4*)(lbl + col0 + bj * 128 + 4 * n), l1 = *(const pg8::f32x4*)(lbl + D + col0 + bj * 128 + 4 * n);
#pragma unroll
                        for (int j = 0; j < 4; ++j) lbv[n][j] = sigmoid_f(l1[j] - l0[j]); }
                }
#pragma unroll
                for (int ai = 0; ai < 2; ++ai)
#pragma unroll
                    for (int m = 0; m < 4; ++m) {
                        const int row = row0 + ai * 128 + m * 16;
                        pg8::f32x4 o[2];
#pragma unroll
                        for (int n = 0; n < 2; ++n)
#pragma unroll
                            for (int j = 0; j < 4; ++j) {
                                const float x = acc[ai][bj][m][n][j]; float g;
                                if (jl) { const float l = lbv[n][j]; g = __logf(l + (1.f - l) * sigmoid_f(x)); }
                                else g = fminf(x, 0.f) - __logf(1.f + __expf(-fabsf(x)));
                                o[n][j] = (row < NPAD) ? 0.f : g;
                            }
                        float* gp = (float*)(Y + 3 * (SLOT / 2)) + (size_t)row * D + col0 + bj * 128;
                        *(pg8::f32x4*)gp = o[0]; *(pg8::f32x4*)(gp + 4) = o[1];
                    }
            }
        } else {
            bf16_t* dst = Y + (size_t)(part == 0 ? 0 : (part == 2 ? 1 : 2)) * (SLOT / 2);
#pragma unroll
            for (int ai = 0; ai < 2; ++ai)
#pragma unroll
                for (int m = 0; m < 4; ++m) { bf16_t* rowp = dst + (size_t)(row0 + ai * 128 + m * 16) * D + col0;
#pragma unroll
                    for (int bj = 0; bj < 2; ++bj) st_bf8(rowp + bj * 128, acc[ai][bj][m][0], acc[ai][bj][m][1]); }
        }
    }
};
struct EpiB1 {
    static constexpr bool PERM = false, AFTER_DRAIN = false;
    bf16_t* Y; const float* cs; const float* sn;
    __device__ __forceinline__ void operator()(AccRef acc, const Unit& u, int wr, int wc, int fr, int fq) const {
        const int part = u.pn >> 4, colt = (u.pn & 15) * 256;
        const int row0 = u.pm * 256 + wr * 64 + fr, col0 = colt + wc * 32 + 4 * fq;
        bf16_t* dst = Y + (size_t)part * (SLOT / 2);
        const bool rope = (part < 2) && (wc == 0);
#pragma unroll
        for (int ai = 0; ai < 2; ++ai)
#pragma unroll
            for (int m = 0; m < 4; ++m) {
                const int row = row0 + ai * 128 + m * 16;
                pg8::f32x4 c4 = {1.f, 1.f, 1.f, 1.f}, s4 = {0.f, 0.f, 0.f, 0.f};
                if (rope) { c4 = *(const pg8::f32x4*)(cs + (size_t)row * 16 + 4 * fq); s4 = *(const pg8::f32x4*)(sn + (size_t)row * 16 + 4 * fq); }
                bf16_t* rowp = dst + (size_t)row * D + col0;
#pragma unroll
                for (int bj = 0; bj < 2; ++bj) {
                    const pg8::f32x4 x1 = acc[ai][bj][m][0], x2 = acc[ai][bj][m][1];
                    const pg8::f32x4 y1 = x1 * c4 - x2 * s4, y2 = x2 * c4 + x1 * s4;
                    st_bf4(rowp + bj * 128, y1); st_bf4(rowp + bj * 128 + 16, y2);
                }
            }
    }
};
struct EpiC1 {
    static constexpr bool PERM = true, AFTER_DRAIN = false;
    bf16_t *Y, *T;
    __device__ __forceinline__ void operator()(AccRef acc, const Unit& u, int wr, int wc, int fr, int fq) const {
        const int row0 = u.pm * 256 + wr * 64 + fr;
        if (u.pn < 64) {
            const int part = u.pn >> 4, col0 = (u.pn & 15) * 256 + wc * 32 + 8 * fq;
            bf16_t* dst = Y + (size_t)part * (SLOT / 2);
#pragma unroll
            for (int ai = 0; ai < 2; ++ai)
#pragma unroll
                for (int m = 0; m < 4; ++m) { bf16_t* rowp = dst + (size_t)(row0 + ai * 128 + m * 16) * D + col0;
#pragma unroll
                    for (int bj = 0; bj < 2; ++bj) st_bf8(rowp + bj * 128, acc[ai][bj][m][0], acc[ai][bj][m][1]); }
        } else {
            const int which = u.pn - 64, col0 = which * 128 + wc * 32 + 8 * fq;
#pragma unroll
            for (int ai = 0; ai < 2; ++ai)
#pragma unroll
                for (int m = 0; m < 4; ++m) {
                    pg8::f32x4 v0 = acc[ai][0][m][0], v1 = acc[ai][0][m][1];
                    if (which == 0) {
#pragma unroll
                        for (int j = 0; j < 4; ++j) { v0[j] = 1.f - 2.f / (1.f + __expf(2.f * v0[j])); v1[j] = 1.f - 2.f / (1.f + __expf(2.f * v1[j])); }
                    }
                    st_bf8(T + (size_t)(row0 + ai * 128 + m * 16) * 256 + col0, v0, v1);
                }
        }
    }
};
struct EpiC2 {
    static constexpr bool PERM = true, AFTER_DRAIN = false;
    bf16_t* Y; const float* w0; const float* a0;
    __device__ __forceinline__ void operator()(AccRef acc, const Unit& u, int wr, int wc, int fr, int fq) const {
        const int row0 = u.pm * 256 + wr * 64 + fr;
        const bool isw = u.pn < 16;
        const int col0 = (u.pn & 15) * 256 + wc * 32 + 8 * fq;
        bf16_t* dst = Y + (size_t)(isw ? 4 : 5) * (SLOT / 2); const float* bias = isw ? w0 : a0;
#pragma unroll
        for (int bj = 0; bj < 2; ++bj) {
            const pg8::f32x4 b0 = *(const pg8::f32x4*)(bias + col0 + bj * 128), b1 = *(const pg8::f32x4*)(bias + col0 + bj * 128 + 4);
#pragma unroll
            for (int ai = 0; ai < 2; ++ai)
#pragma unroll
                for (int m = 0; m < 4; ++m) {
                    pg8::f32x4 v0 = acc[ai][bj][m][0] + b0, v1 = acc[ai][bj][m][1] + b1;
#pragma unroll
                    for (int j = 0; j < 4; ++j) {
                        float s0 = sigmoid_f(v0[j]), s1 = sigmoid_f(v1[j]);
                        if (isw) { s0 = __expf(-0.606531f * s0); s1 = __expf(-0.606531f * s1); }
                        v0[j] = s0; v1[j] = s1;
                    }
                    st_bf8(dst + (size_t)(row0 + ai * 128 + m * 16) * D + col0 + bj * 128, v0, v1);
                    __builtin_amdgcn_sched_barrier(0);
                }
        }
    }
};

struct Fr {
    LAS unsigned char* lds; unsigned char* ldsg;
    int tid, lane, wave, G, bid, gw, NGW;
    float* out; unsigned char* ws;
    __device__ __forceinline__ Fr fresh() const { Fr P = *this; asm volatile("" : "+v"(P.tid)); P.lane = P.tid & 63; P.wave = __builtin_amdgcn_readfirstlane(P.tid >> 6); P.gw = P.bid * 8 + P.wave; return P; }
    __device__ __forceinline__ const float* in(int i) const {
        const __attribute__((address_space(4))) unsigned long long* ka = (const __attribute__((address_space(4))) unsigned long long*)__builtin_amdgcn_kernarg_segment_ptr();
        asm volatile("" : "+s"(ka));
        return (const float*)ka[i];
    }
};
__device__ __forceinline__ bf16_t* slotU(const Fr& F, int s) { return (bf16_t*)(F.ws + WS_U + (size_t)s * SLOT); }
__device__ __forceinline__ bf16_t* slotY(const Fr& F, int s) { return (bf16_t*)(F.ws + WS_Y + (size_t)s * SLOT); }
__device__ __forceinline__ float* hrow(const Fr& F, int r) { return r < 64 ? (float*)(F.ws + WS_HMETA) + (size_t)r * D : F.out + (size_t)(r - 64) * D; }

__device__ __forceinline__ void transpose_item(const float* W, int ldw, bf16_t* WT, int ldt, int koff, LAS float* scr, int kb, int nb, int lane) {
    const int k0 = 64 * kb, n0 = 32 * nb;
#pragma unroll 8
    for (int i = 0; i < 32; ++i) { const int kk = 2 * i + (lane >> 5); scr[kk * 33 + (lane & 31)] = W[(size_t)(k0 + kk) * ldw + n0 + (lane & 31)]; }
    LDS_WAIT(); asm volatile("" ::: "memory");
    const int c = lane & 7;
#pragma unroll
    for (int j = 0; j < 4; ++j) { const int n = (lane >> 3) + 8 * j; const LAS float* s = scr + (8 * c) * 33 + n;
        u32x4 o; o.x = cvt_pk_bf16(s[0 * 33], s[1 * 33]); o.y = cvt_pk_bf16(s[2 * 33], s[3 * 33]); o.z = cvt_pk_bf16(s[4 * 33], s[5 * 33]); o.w = cvt_pk_bf16(s[6 * 33], s[7 * 33]);
        *(u32x4*)(WT + (size_t)(n0 + n) * ldt + koff + k0 + 8 * c) = o; }
    LDS_WAIT(); asm volatile("" ::: "memory");
}
__device__ __forceinline__ void convert_matrix(const Fr& F, const float* W, int K, int N, bf16_t* WT, int ldt, int koff) {
    LAS float* scr = (LAS float*)(F.lds + F.wave * 8704);
    const int nblk = N / 32, nitems = (K / 64) * nblk;
    for (int it = F.gw; it < nitems; it += F.NGW) transpose_item(W, N, WT, ldt, koff, scr, it / nblk, it % nblk, F.lane);
}
__device__ __forceinline__ void zero_bytes(const Fr& F, void* p, size_t nbytes) {
    u32x4* q = (u32x4*)p; const size_t n = nbytes / 16; const u32x4 z = {0u, 0u, 0u, 0u};
    for (size_t i = (size_t)F.bid * 512 + F.tid; i < n; i += (size_t)F.G * 512) q[i] = z;
}
__device__ __forceinline__ void convert_layer(const Fr& F, int L) {
    bf16_t* wtin = (bf16_t*)(F.ws + WS_WTIN); bf16_t* wtout = (bf16_t*)(F.ws + WS_WTOUT);
    if (L == 0 || L == 3) { const int j = L ? 1 : 0;
        convert_matrix(F, F.in(4) + (size_t)j * D * 4 * D, D, 4 * D, wtin, D, 0);
        convert_matrix(F, F.in(7) + (size_t)j * D * D, D, D, wtout, D, 0);
    } else if (L == 1) {
        convert_matrix(F, F.in(8), D, 4 * D, wtin, D, 0);
        convert_matrix(F, F.in(14), D, D, wtout, D, 0);
    } else {
        convert_matrix(F, F.in(16), D, 4 * D, wtin, D, 0);
        convert_matrix(F, F.in(28), D, D, wtout, D, 0);
        convert_matrix(F, F.in(18), D, 128, wtin + (size_t)16384 * D, D, 0);
        convert_matrix(F, F.in(21), D, 128, wtin + (size_t)16640 * D, D, 0);
        zero_bytes(F, wtin + (size_t)16512 * D, (size_t)128 * D * 2);
        zero_bytes(F, wtin + (size_t)16768 * D, (size_t)128 * D * 2);
        bf16_t* w2p = (bf16_t*)(F.ws + WS_W2P);
        zero_bytes(F, w2p, (size_t)8192 * 256 * 2);
    }
}
__device__ __forceinline__ void convert_layer2_b(const Fr& F) {
    bf16_t* w2p = (bf16_t*)(F.ws + WS_W2P);
    convert_matrix(F, F.in(19), 128, D, w2p, 256, 0);
    convert_matrix(F, F.in(22), 128, D, w2p + (size_t)4096 * 256, 256, 128);
}

__constant__ float c_inv_freq[16] = {1.0f, 0.44036659598350525f, 0.1939227432012558f, 0.08539710193872452f, 0.03760603070259094f, 0.01656043902039528f, 0.007292664609849453f, 0.0032114458736032248f,
    0.0014142135623842478f, 0.000622772378847003f, 0.00027424818836152554f, 0.00012076973507646471f, 5.318296098266728e-05f, 2.34199997066753e-05f, 1.0313386155758053e-05f, 4.541670477919979e-06f};
__device__ __forceinline__ void rope_table(const Fr& F) {
    float* cs = (float*)(F.ws + WS_ROPE); float* sn = cs + (size_t)R * 16;
    for (int i = F.bid * 512 + F.tid; i < R * 16; i += F.G * 512) {
        const int row = i >> 4, j = i & 15; const int pos = row - NPAD;
        const double ang = (double)(float)((float)pos * c_inv_freq[j]);
        const double k = __builtin_rint(ang * 0.15915494309189535);
        double x = ang - k * 6.283185307179586;
        const double q = __builtin_rint(x * 0.6366197723675814);
        x -= q * 1.5707963267948966;
        const int qi = ((int)q) & 3;
        const double x2 = x * x;
        const double s = x * (1.0 + x2 * (-1.0 / 6 + x2 * (1.0 / 120 + x2 * (-1.0 / 5040 + x2 * (1.0 / 362880 + x2 * (-1.0 / 39916800))))));
        const double c = 1.0 + x2 * (-0.5 + x2 * (1.0 / 24 + x2 * (-1.0 / 720 + x2 * (1.0 / 40320 + x2 * (-1.0 / 3628800 + x2 * (1.0 / 479001600))))));
        double sv, cv;
        if (qi == 0) { sv = s; cv = c; } else if (qi == 1) { sv = c; cv = -s; } else if (qi == 2) { sv = -s; cv = -c; } else { sv = -c; cv = s; }
        cs[i] = (float)cv; sn[i] = (float)sv;
    }
}

typedef const GAS char* gcp; typedef GAS char* gp_;
#define ROW_F32(nm, base, lane) gp_ nm##0 = (gp_)(base) + (lane) * 16 + 4096; gp_ nm##1 = nm##0 + 8192; asm volatile("" : "+v"(nm##0), "+v"(nm##1))
#define AT_F32(nm, j) (*(GAS f32x4*)((j) < 8 ? nm##0 + ((j) - 4) * 1024 : nm##1 + ((j) - 12) * 1024))
#define ROW_BF(nm, base, lane) gp_ nm##0 = (gp_)(base) + (lane) * 8 + 4096; asm volatile("" : "+v"(nm##0))
#define AT_BF(nm, j) (*(GAS u32x2*)(nm##0 + (j) * 512 - 4096))
__device__ __forceinline__ void norm_phase(const Fr& F, int prev, int next, const bf16_t* y, bf16_t* udst, int rlo = 0, int rhi = R, int wg_skip = 0) {
    const float* postg = F.in(3) + (size_t)(prev < 0 ? 0 : prev) * D; const float* preg = F.in(2) + (size_t)(next < 0 ? 0 : next) * D;
    const float* xin = F.in(0); const float* meta = F.in(1);
    for (int r = rlo + F.gw - wg_skip * 8; r < rhi; r += F.NGW - wg_skip * 8) {
        if (r < NPAD || r >= NREAL) {
            if (next >= 0) { ROW_BF(uo, udst + (size_t)r * D, F.lane); const u32x2 z = {0u, 0u};
#pragma unroll
                for (int j = 0; j < 16; ++j) AT_BF(uo, j) = z; }
            continue;
        }
        float* hr = hrow(F, r);
        ROW_F32(hp, hr, F.lane);
        f32x4 hv[16];
        if (prev < 0) {
            const float* src = r < 64 ? meta + (size_t)(r - NPAD) * D : xin + (size_t)(r - 64) * D;
            ROW_F32(sp, src, F.lane);
#pragma unroll
            for (int j = 0; j < 16; ++j) hv[j] = AT_F32(sp, j);
        } else {
            ROW_BF(yp, y + (size_t)r * D, F.lane); ROW_F32(gp, postg, F.lane);
            u32x2 yv[16]; float ss = 0.f;
#pragma unroll
            for (int j = 0; j < 16; ++j) { yv[j] = AT_BF(yp, j); hv[j] = AT_F32(hp, j); }
#pragma unroll
            for (int j = 0; j < 16; ++j) { const float a = bflo(yv[j].x), b = bfhi(yv[j].x), c = bflo(yv[j].y), d = bfhi(yv[j].y); ss += (a * a + b * b) + (c * c + d * d); }
#pragma unroll
            for (int j = 0; j < 16; ++j) asm volatile("" : "+v"(yv[j].x), "+v"(yv[j].y));
            const float rs = __builtin_amdgcn_rsqf(wave_sum(ss) * (1.f / D) + 1e-6f);
#pragma unroll
            for (int j = 0; j < 16; ++j) { const f32x4 g = AT_F32(gp, j);
                hv[j].x += bflo(yv[j].x) * rs * g.x; hv[j].y += bfhi(yv[j].x) * rs * g.y; hv[j].z += bflo(yv[j].y) * rs * g.z; hv[j].w += bfhi(yv[j].y) * rs * g.w; }
        }
        if (next < 0) {
            if (r >= 64) {
#pragma unroll
                for (int j = 0; j < 16; ++j) AT_F32(hp, j) = hv[j];
            }
            continue;
        }
        float s2 = 0.f;
#pragma unroll
        for (int j = 0; j < 16; ++j) { AT_F32(hp, j) = hv[j]; s2 += (hv[j].x * hv[j].x + hv[j].y * hv[j].y) + (hv[j].z * hv[j].z + hv[j].w * hv[j].w); }
        const float rs2 = __builtin_amdgcn_rsqf(wave_sum(s2) * (1.f / D) + 1e-6f);
        ROW_BF(uo, udst + (size_t)r * D, F.lane); ROW_F32(pg, preg, F.lane);
#pragma unroll
        for (int j = 0; j < 16; ++j) { const f32x4 g = AT_F32(pg, j); u32x2 w; w.x = cvt_pk_bf16(hv[j].x * rs2 * g.x, hv[j].y * rs2 * g.y); w.y = cvt_pk_bf16(hv[j].z * rs2 * g.z, hv[j].w * rs2 * g.w); AT_BF(uo, j) = w; }
    }
}
__device__ __forceinline__ void mix_phase(const Fr& F, const bf16_t* u) {
    const float* mu = F.in(15);
    for (int r = F.gw; r < R; r += F.NGW) {
        const bool real = (r >= NPAD && r < NREAL);
        u32x2 cur[16], prv[16];
        const u32x2 z = {0u, 0u};
        { ROW_BF(cp, u + (size_t)r * D, F.lane); ROW_BF(pp, u + (size_t)(r > 0 ? r - 1 : 0) * D, F.lane);
#pragma unroll
          for (int j = 0; j < 16; ++j) { cur[j] = real ? AT_BF(cp, j) : z; prv[j] = (real && r > NPAD) ? AT_BF(pp, j) : z; } }
#pragma unroll 1
        for (int s = 0; s < 6; ++s) {
            ROW_BF(op, slotU(F, s) + (size_t)r * D, F.lane); ROW_F32(mp, mu + (size_t)s * D, F.lane);
#pragma unroll
            for (int j = 0; j < 16; ++j) {
                const f32x4 m = AT_F32(mp, j);
                const float c0 = bflo(cur[j].x), c1 = bfhi(cur[j].x), c2 = bflo(cur[j].y), c3 = bfhi(cur[j].y);
                const float p0 = bflo(prv[j].x), p1 = bfhi(prv[j].x), p2 = bflo(prv[j].y), p3 = bfhi(prv[j].y);
                u32x2 w; w.x = cvt_pk_bf16(c0 + (p0 - c0) * m.x, c1 + (p1 - c1) * m.y); w.y = cvt_pk_bf16(c2 + (p2 - c2) * m.z, c3 + (p3 - c3) * m.w);
                AT_BF(op, j) = real ? w : z;
            }
        }
    }
}
}
namespace mk {
constexpr int H_QE = 0, H_KE = 17408, H_KET = 34816, H_VT = 53248, H_PM = 71680, H_STB = 80896, H_VEC = 115712;
__device__ __forceinline__ bf16x8 ldfrag(const LAS unsigned char* base, int stride_b, int rb, int ks, int lane) {
    return *(const LAS bf16x8*)(base + (16 * rb + (lane & 15)) * stride_b + (32 * ks + 8 * (lane >> 4)) * 2);
}
template <bool OUT>
__device__ __forceinline__ void hgrn_phase(const Fr& F, int jl) {
    const bf16_t* Q = slotY(F, 0); const bf16_t* V = slotY(F, 1); const bf16_t* GT = slotY(F, 2); const float* Gg = (const float*)slotY(F, 3);
    bf16_t* Z = slotU(F, 0);
    float* HE = (float*)(F.ws + WS_HE); float* HLD = (float*)(F.ws + WS_HLOGD);
    const float* gn = F.in(6) + (size_t)jl * 128;
    LAS unsigned char* L = F.lds;
    LAS float* qtot = (LAS float*)(L + H_VEC); LAS float* ebm = qtot + 512; LAS float* ebl = ebm + 128;
    const int tid = F.tid, lane = F.lane, w = F.wave;
    const int d = tid & 127, qt = tid >> 7;
    for (int unit = F.bid; unit < 256; unit += F.G) {
        const int h = unit >> 3, seg = unit & 7;
        if (!OUT && seg == 7) continue;
        const int c0 = seg == 0 ? 0 : 33 + 32 * (seg - 1), c1 = c0 + (seg == 0 ? 33 : 32);
        f32x4 S[8];
#pragma unroll
        for (int i = 0; i < 8; ++i) S[i] = (f32x4){0.f, 0.f, 0.f, 0.f};
        if (OUT) {
            for (int j = 0; j < seg; ++j) {
                const float* ld = HLD + (size_t)(h * 8 + j) * 128; const float* e = HE + ((size_t)(h * 8 + j) * 512 + tid) * 32;
#pragma unroll
                for (int di = 0; di < 8; ++di) { const f32x4 l4 = *(const f32x4*)(ld + 16 * di + 4 * (lane >> 4)); const f32x4 e4 = *(const f32x4*)(e + 4 * di);
                    S[di].x = S[di].x * __expf(l4.x) + e4.x; S[di].y = S[di].y * __expf(l4.y) + e4.y; S[di].z = S[di].z * __expf(l4.z) + e4.z; S[di].w = S[di].w * __expf(l4.w) + e4.w; }
            }
        }
        float logD = 0.f;
        float g[16]; bf16_t qv[16], vv[16]; u32x4 gt0 = {0u, 0u, 0u, 0u}, gt1 = gt0, ngt0 = gt0, ngt1 = gt0;
#define HG_LOAD(cc) do { const int rowb_ = 64 * (cc) + 16 * qt; const size_t colb_ = (size_t)h * 128 + d; \
            _Pragma("unroll") for (int i = 0; i < 16; ++i) { g[i] = Gg[(size_t)(rowb_ + i) * D + colb_]; vv[i] = V[(size_t)(rowb_ + i) * D + colb_]; if (OUT) qv[i] = Q[(size_t)(rowb_ + i) * D + colb_]; } \
            if (OUT) { const bf16_t* gp_ = GT + (size_t)(64 * (cc) + (tid >> 3)) * D + h * 128 + 16 * (tid & 7); ngt0 = *(const u32x4*)gp_; ngt1 = *(const u32x4*)(gp_ + 8); } } while (0)
        HG_LOAD(c0);
        for (int c = c0; c < c1; ++c) {
            if (OUT) { gt0 = ngt0; gt1 = ngt1; }
            float b[16]; float run = 0.f;
#pragma unroll
            for (int i = 0; i < 16; ++i) { run += g[i]; b[i] = run; }
            qtot[qt * 128 + d] = run;
            __syncthreads();
            const float t0 = qtot[d], t1 = qtot[128 + d], t2 = qtot[256 + d], t3 = qtot[384 + d];
            const float off = qt == 0 ? 0.f : (qt == 1 ? t0 : (qt == 2 ? t0 + t1 : t0 + t1 + t2));
            const float bm = t0 + t1, bl = (t0 + t1) + (t2 + t3);
            if (qt == 0) { ebm[d] = __expf(bm); ebl[d] = __expf(bl); logD += bl; }
            {
                unsigned kt[8], vt[8];
#pragma unroll
                for (int i = 0; i < 16; i += 2) {
                    const float b0 = b[i] + off, b1 = b[i + 1] + off;
                    const float k0 = 1.f - __expf(g[i]), k1 = 1.f - __expf(g[i + 1]);
                    const int t = 16 * qt + i;
                    if (OUT) {
                        *(LAS bf16_t*)(L + H_QE + (t * 136 + d) * 2) = f2bf(bf2f(qv[i]) * __expf(b0 - bm));
                        *(LAS bf16_t*)(L + H_QE + ((t + 1) * 136 + d) * 2) = f2bf(bf2f(qv[i + 1]) * __expf(b1 - bm));
                        *(LAS bf16_t*)(L + H_KE + (t * 136 + d) * 2) = f2bf(k0 * __expf(bm - b0));
                        *(LAS bf16_t*)(L + H_KE + ((t + 1) * 136 + d) * 2) = f2bf(k1 * __expf(bm - b1));
                    }
                    kt[i >> 1] = cvt_pk_bf16(k0 * __expf(bl - b0), k1 * __expf(bl - b1));
                    vt[i >> 1] = (unsigned)vv[i] | ((unsigned)vv[i + 1] << 16);
                }
                LAS u32x4* kp = (LAS u32x4*)(L + H_KET + (d * 72 + 16 * qt) * 2); kp[0] = (u32x4){kt[0], kt[1], kt[2], kt[3]}; kp[1] = (u32x4){kt[4], kt[5], kt[6], kt[7]};
                LAS u32x4* vp = (LAS u32x4*)(L + H_VT + (d * 72 + 16 * qt) * 2); vp[0] = (u32x4){vt[0], vt[1], vt[2], vt[3]}; vp[1] = (u32x4){vt[4], vt[5], vt[6], vt[7]};
            }
            if (c + 1 < c1) HG_LOAD(c + 1);
            __syncthreads();
            if (OUT) {
#pragma unroll
                for (int di = 0; di < 8; ++di) { const f32x4 m4 = *(const LAS f32x4*)(ebm + 16 * di + 4 * (lane >> 4)); u32x2 o; o.x = cvt_pk_bf16(S[di].x * m4.x, S[di].y * m4.y); o.y = cvt_pk_bf16(S[di].z * m4.z, S[di].w * m4.w);
                    *(LAS u32x2*)(L + H_STB + ((16 * w + (lane & 15)) * 136 + 16 * di + 4 * (lane >> 4)) * 2) = o; }
                const int ti = w >> 1;
#pragma unroll
                for (int s2 = 0; s2 < 2; ++s2) { const int si = 2 * (w & 1) + s2; f32x4 p = {0.f, 0.f, 0.f, 0.f};
                    if (si <= ti) {
#pragma unroll
                        for (int ks = 0; ks < 4; ++ks) p = __builtin_amdgcn_mfma_f32_16x16x32_bf16(ldfrag(L + H_QE, 272, ti, ks, lane), ldfrag(L + H_KE, 272, si, ks, lane), p, 0, 0, 0);
                    }
                    const int sidx = 16 * si + (lane & 15);
#pragma unroll
                    for (int jj = 0; jj < 4; ++jj) { const int tidx = 16 * ti + 4 * (lane >> 4) + jj; *(LAS bf16_t*)(L + H_PM + (tidx * 72 + sidx) * 2) = f2bf(sidx <= tidx ? p[jj] : 0.f); }
                }
                __syncthreads();
            }
            f32x4 O[4];
            if (OUT) {
#pragma unroll
                for (int ti = 0; ti < 4; ++ti) O[ti] = (f32x4){0.f, 0.f, 0.f, 0.f};
#pragma unroll
                for (int ks = 0; ks < 2; ++ks) { const bf16x8 bv = ldfrag(L + H_VT, 144, w, ks, lane);
#pragma unroll
                    for (int ti = 0; ti < 4; ++ti) O[ti] = __builtin_amdgcn_mfma_f32_16x16x32_bf16(ldfrag(L + H_PM, 144, ti, ks, lane), bv, O[ti], 0, 0, 0); }
#pragma unroll
                for (int ks = 0; ks < 4; ++ks) { const bf16x8 bs = ldfrag(L + H_STB, 272, w, ks, lane);
#pragma unroll
                    for (int ti = 0; ti < 4; ++ti) O[ti] = __builtin_amdgcn_mfma_f32_16x16x32_bf16(ldfrag(L + H_QE, 272, ti, ks, lane), bs, O[ti], 0, 0, 0); }
            }
            {
                const bf16x8 bv0 = ldfrag(L + H_VT, 144, w, 0, lane), bv1 = ldfrag(L + H_VT, 144, w, 1, lane);
#pragma unroll
                for (int di = 0; di < 8; ++di) { const f32x4 l4 = *(const LAS f32x4*)(ebl + 16 * di + 4 * (lane >> 4)); S[di] = S[di] * l4;
                    S[di] = __builtin_amdgcn_mfma_f32_16x16x32_bf16(ldfrag(L + H_KET, 144, di, 0, lane), bv0, S[di], 0, 0, 0);
                    S[di] = __builtin_amdgcn_mfma_f32_16x16x32_bf16(ldfrag(L + H_KET, 144, di, 1, lane), bv1, S[di], 0, 0, 0); }
            }
            if (OUT) {
                __syncthreads();
                LAS float* Ot = (LAS float*)(L + H_STB);
#pragma unroll
                for (int ti = 0; ti < 4; ++ti)
#pragma unroll
                    for (int jj = 0; jj < 4; ++jj) Ot[(16 * ti + 4 * (lane >> 4) + jj) * 132 + 16 * w + (lane & 15)] = O[ti][jj];
                __syncthreads();
                const int t = tid >> 3, eg = tid & 7;
                f32x4 o4[4]; float ss = 0.f;
#pragma unroll
                for (int i = 0; i < 4; ++i) { o4[i] = *(const LAS f32x4*)(Ot + t * 132 + 16 * eg + 4 * i); ss += (o4[i].x * o4[i].x + o4[i].y * o4[i].y) + (o4[i].z * o4[i].z + o4[i].w * o4[i].w); }
                ss = red8(ss);
                const float rs = __builtin_amdgcn_rsqf(ss * (1.f / 128.f) + 1e-6f);
                const unsigned gw_[8] = {gt0.x, gt0.y, gt0.z, gt0.w, gt1.x, gt1.y, gt1.z, gt1.w};
                unsigned zo[8];
#pragma unroll
                for (int i = 0; i < 4; ++i) { const f32x4 g4 = *(const f32x4*)(gn + 16 * eg + 4 * i);
                    const float a0 = o4[i].x * rs * g4.x * silu_f(bflo(gw_[2 * i])), a1 = o4[i].y * rs * g4.y * silu_f(bfhi(gw_[2 * i]));
                    const float a2 = o4[i].z * rs * g4.z * silu_f(bflo(gw_[2 * i + 1])), a3 = o4[i].w * rs * g4.w * silu_f(bfhi(gw_[2 * i + 1]));
                    zo[2 * i] = cvt_pk_bf16(a0, a1); zo[2 * i + 1] = cvt_pk_bf16(a2, a3); }
                bf16_t* zp = Z + (size_t)(64 * c + t) * D + h * 128 + 16 * eg;
                *(u32x4*)zp = (u32x4){zo[0], zo[1], zo[2], zo[3]}; *(u32x4*)(zp + 8) = (u32x4){zo[4], zo[5], zo[6], zo[7]};
            } else {
                __syncthreads();
            }
        }
        if (!OUT) {
            float* e = HE + ((size_t)(h * 8 + seg) * 512 + tid) * 32;
#pragma unroll
            for (int di = 0; di < 8; ++di) *(f32x4*)(e + 4 * di) = S[di];
            if (qt == 0) HLD[(size_t)(h * 8 + seg) * 128 + d] = logD;
        }
        __syncthreads();
    }
#undef HG_LOAD
}

namespace att {
constexpr int NW = 8, QBLK = 32, KVBLK = 64, LDQ = 4096, LDO = 8192;
constexpr float SCALE = 0.088388347648318440f, THR = 8.f;
constexpr int SHM_V = 16384, SHM_K = 16384, SHM = 2 * SHM_V + 2 * SHM_K + NW * 64 * 4;
#define KSWZ(row, colB) ((row) * 256 + ((colB) ^ (((row) & 7) << 4)))
#define SBAR() __builtin_amdgcn_sched_barrier(0)
__device__ __forceinline__ int crow(int r, int hi) { return (r & 3) + 8 * (r >> 2) + 4 * hi; }
__device__ __forceinline__ void partialSM(f32x16& p0, f32x16& p1, float& m_reg, float& mn, float& alpha) {
    constexpr float C = SCALE * 1.4426950408889634f;
    float pmax = p0[0];
#pragma unroll
    for (int r = 1; r < 16; ++r) pmax = fmaxf(pmax, p0[r]);
#pragma unroll
    for (int r = 0; r < 16; ++r) pmax = fmaxf(pmax, p1[r]);
    { auto rr = __builtin_amdgcn_permlane32_swap(__float_as_uint(pmax), __float_as_uint(pmax), false, false);
      pmax = fmaxf(__uint_as_float(rr[0]), __uint_as_float(rr[1])); }
    if (__builtin_expect(__all(pmax - m_reg <= THR / SCALE), 1)) { mn = m_reg; alpha = 1.f; }
    else { mn = fmaxf(m_reg, pmax); alpha = __builtin_amdgcn_exp2f((m_reg - mn) * C); m_reg = mn; }
    const float mnC = -mn * C;
#pragma unroll
    for (int r = 0; r < 16; ++r) p0[r] = fmaf(p0[r], C, mnC);
#pragma unroll
    for (int r = 0; r < 16; ++r) p1[r] = fmaf(p1[r], C, mnC);
#pragma unroll
    for (int r = 0; r < 16; ++r) p0[r] = __builtin_amdgcn_exp2f(p0[r]);
}
__device__ __forceinline__ void finishSM(f32x16& p0, f32x16& p1, float alpha, float& l_reg, bf16x8& pa0, bf16x8& pa1, bf16x8& pa2, bf16x8& pa3) {
#pragma unroll
    for (int r = 0; r < 16; ++r) p1[r] = __builtin_amdgcn_exp2f(p1[r]);
    float ps = 0;
#pragma unroll
    for (int r = 0; r < 16; ++r) ps += p0[r];
#pragma unroll
    for (int r = 0; r < 16; ++r) ps += p1[r];
    { auto rr = __builtin_amdgcn_permlane32_swap(__float_as_uint(ps), __float_as_uint(ps), false, false);
      ps = __uint_as_float(rr[0]) + __uint_as_float(rr[1]); }
    l_reg = l_reg * alpha + ps;
#define PK4(P, BASE, OUT) do { unsigned a0 = cvt_pk_bf16(P[BASE + 0], P[BASE + 1]), a1 = cvt_pk_bf16(P[BASE + 2], P[BASE + 3]);   \
    unsigned b0 = cvt_pk_bf16(P[BASE + 4], P[BASE + 5]), b1 = cvt_pk_bf16(P[BASE + 6], P[BASE + 7]);                              \
    auto r0 = __builtin_amdgcn_permlane32_swap(a0, b0, false, false); auto r1 = __builtin_amdgcn_permlane32_swap(a1, b1, false, false); \
    u32x4 w = {r0[0], r1[0], r0[1], r1[1]}; OUT = *reinterpret_cast<bf16x8*>(&w); } while (0)
    PK4(p0, 0, pa0); PK4(p0, 8, pa1); PK4(p1, 0, pa2); PK4(p1, 8, pa3);
#undef PK4
}
__device__ __forceinline__ void qkt(f32x16& p0, f32x16& p1, const char* Ks, const bf16x8* qr, int r32, int hi) {
    p0 = f32x16{}; p1 = f32x16{};
#pragma unroll
    for (int d0 = 0; d0 < 8; ++d0) { const int cb = (d0 * 16 + hi * 8) * 2;
        const bf16x8 b0 = *reinterpret_cast<const bf16x8*>(Ks + KSWZ(r32, cb));
        const bf16x8 b1 = *reinterpret_cast<const bf16x8*>(Ks + KSWZ(32 + r32, cb));
        p0 = __builtin_amdgcn_mfma_f32_32x32x16_bf16(b0, qr[d0], p0, 0, 0, 0);
        p1 = __builtin_amdgcn_mfma_f32_32x32x16_bf16(b1, qr[d0], p1, 0, 0, 0); }
}
__device__ __forceinline__ int v_st(int k, int c) { const int kk = (k & ~0xC) | ((k & 4) << 1) | ((k & 8) >> 1); return ((kk >> 3) * 4 + (c >> 5)) * 512 + ((kk & 7) * 32 + (c & 31)) * 2; }
__device__ __forceinline__ int v_rd_base(int lane) { return ((lane & 3) << 3) | (((lane >> 2) & 3) << 6) | (((lane >> 4) & 1) << 5) | (((lane >> 5) & 1) << 8); }
constexpr int v_rd_off(int d0, int ks, int half) { return d0 * 512 + ks * 4096 + half * 2048; }
template <int OFF> __device__ __forceinline__ s16x4 tr_read(int vb) {
    s16x4 r; asm volatile("ds_read_b64_tr_b16 %0, %1 offset:%2" : "=&v"(r) : "v"(vb), "i"(OFF) : "memory"); return r;
}
template <int D0> __device__ __forceinline__ void pv_one(f32x16& od, int vb, bf16x8 pa0, bf16x8 pa1, bf16x8 pa2, bf16x8 pa3) {
    const s16x4 l0 = tr_read<v_rd_off(D0, 0, 0)>(vb), h0 = tr_read<v_rd_off(D0, 0, 1)>(vb), l1 = tr_read<v_rd_off(D0, 1, 0)>(vb), h1 = tr_read<v_rd_off(D0, 1, 1)>(vb);
    const s16x4 l2 = tr_read<v_rd_off(D0, 2, 0)>(vb), h2 = tr_read<v_rd_off(D0, 2, 1)>(vb), l3 = tr_read<v_rd_off(D0, 3, 0)>(vb), h3 = tr_read<v_rd_off(D0, 3, 1)>(vb);
    asm volatile("s_waitcnt lgkmcnt(0)" ::: "memory"); SBAR();
#define PK(Lo, Hi) (bf16x8){Lo[0], Lo[1], Lo[2], Lo[3], Hi[0], Hi[1], Hi[2], Hi[3]}
    od = __builtin_amdgcn_mfma_f32_32x32x16_bf16(pa0, PK(l0, h0), od, 0, 0, 0);
    od = __builtin_amdgcn_mfma_f32_32x32x16_bf16(pa1, PK(l1, h1), od, 0, 0, 0);
    od = __builtin_amdgcn_mfma_f32_32x32x16_bf16(pa2, PK(l2, h2), od, 0, 0, 0);
    od = __builtin_amdgcn_mfma_f32_32x32x16_bf16(pa3, PK(l3, h3), od, 0, 0, 0);
#undef PK
}
__device__ __forceinline__ void pv_d0(f32x16* o, int vb, bf16x8 pa0, bf16x8 pa1, bf16x8 pa2, bf16x8 pa3) {
    pv_one<0>(o[0], vb, pa0, pa1, pa2, pa3); pv_one<1>(o[1], vb, pa0, pa1, pa2, pa3); pv_one<2>(o[2], vb, pa0, pa1, pa2, pa3); pv_one<3>(o[3], vb, pa0, pa1, pa2, pa3);
}
__device__ __forceinline__ void mask_tile(f32x16& p0, f32x16& p1, int j, int lim) {
    if (j > lim) {
#pragma unroll
        for (int r = 0; r < 16; ++r) { p0[r] = -1e30f; p1[r] = -1e30f; }
    } else if (j == 0) {
#pragma unroll
        for (int r = 0; r < 16; ++r) p0[r] = -1e30f;
#pragma unroll
        for (int r = 0; r < 8; ++r) p1[r] = -1e30f;
    }
}
__device__ __forceinline__ void unit(const bf16_t* __restrict__ Qb, const bf16_t* __restrict__ Kh, const bf16_t* __restrict__ Vh, bf16_t* __restrict__ Ob, int NT, int lim, char* lds) {
    int tid_ = threadIdx.x; asm volatile("" : "+v"(tid_));
    const int tid = tid_, wid = tid >> 6, lane = tid & 63, r32 = lane & 31, hi = lane >> 5;
    char* V_lds = lds; char* K_lds = lds + 2 * SHM_V;
    float* wsf = (float*)(lds + 2 * SHM_V + 2 * SHM_K) + wid * 64; float* li_l = wsf; float* al_l = wsf + 32;
    float m_reg = -1e30f, l_reg = 0; f32x16 o[4] = {}; bf16x8 qr[8];
    const bf16_t* Qw = Qb + (long)(wid * QBLK + r32) * LDQ + hi * 8;
#pragma unroll
    for (int d0 = 0; d0 < 8; ++d0) qr[d0] = *reinterpret_cast<const bf16x8*>(Qw + d0 * 16);
    const int sr = tid >> 4, sc = (tid & 15) * 8, vst0 = v_st(sr, sc), vst1 = v_st(32 + sr, sc);
    const int vb0 = (int)(uintptr_t)V_lds + v_rd_base(lane);
    struct { bf16x8 vs0, vs1, ks0, ks1; } sr_[2];
#define SLOAD(i, k0) do { sr_[i].vs0 = *reinterpret_cast<const bf16x8*>(&Vh[(long)((k0) + sr) * LDQ + sc]); sr_[i].vs1 = *reinterpret_cast<const bf16x8*>(&Vh[(long)((k0) + 32 + sr) * LDQ + sc]); \
    sr_[i].ks0 = *reinterpret_cast<const bf16x8*>(&Kh[(long)((k0) + sr) * LDQ + sc]); sr_[i].ks1 = *reinterpret_cast<const bf16x8*>(&Kh[(long)((k0) + 32 + sr) * LDQ + sc]); } while (0)
#define SWRITE(b, i) do { *(bf16x8*)(V_lds + (b) * SHM_V + vst0) = sr_[i].vs0;          \
    *(bf16x8*)(V_lds + (b) * SHM_V + vst1) = sr_[i].vs1; int kc = sc * 2;               \
    *(bf16x8*)(K_lds + (b) * SHM_K + KSWZ(sr, kc)) = sr_[i].ks0;                       \
    *(bf16x8*)(K_lds + (b) * SHM_K + KSWZ(32 + sr, kc)) = sr_[i].ks1; } while (0)
#define SWAIT() asm volatile("s_waitcnt vmcnt(4)" ::: "memory")
#define RESC(a) do { if (__any((a) < 1.f)) { if (hi == 0) al_l[r32] = (a); asm volatile("s_waitcnt lgkmcnt(0)" ::: "memory"); \
    _Pragma("unroll") for (int d = 0; d < 4; ++d) _Pragma("unroll") for (int r = 0; r < 16; ++r) o[d][r] *= al_l[crow(r, hi)]; } } while (0)
    f32x16 pA0, pA1, pB0, pB1; float mnA, mnB, alA, alB; bf16x8 pa0, pa1, pa2, pa3;
    constexpr int SE = 0, SO = 1;
    SLOAD(SE, 0); asm volatile("s_waitcnt vmcnt(0)" ::: "memory"); SWRITE(0, SE); __syncthreads();
    qkt(pA0, pA1, K_lds, qr, r32, hi); mask_tile(pA0, pA1, 0, lim); partialSM(pA0, pA1, m_reg, mnA, alA);
    SLOAD(SO, KVBLK); if (2 < NT) SLOAD(SE, 2 * KVBLK);
    SWAIT(); SWRITE(1, SO); __syncthreads();
    for (int j = 1; j + 1 < NT; j += 2) {
        SBAR(); qkt(pB0, pB1, K_lds + SHM_K, qr, r32, hi);
        finishSM(pA0, pA1, alA, l_reg, pa0, pa1, pa2, pa3); SBAR();
        SLOAD(SO, (j + 2) * KVBLK); SBAR();
        pv_d0(o, vb0, pa0, pa1, pa2, pa3); mask_tile(pB0, pB1, j, lim); partialSM(pB0, pB1, m_reg, mnB, alB);
        __syncthreads(); SWAIT(); SWRITE(0, SE);
        RESC(alB); __syncthreads();
        SBAR(); qkt(pA0, pA1, K_lds, qr, r32, hi);
        finishSM(pB0, pB1, alB, l_reg, pa0, pa1, pa2, pa3); SBAR();
        if (j + 3 < NT) SLOAD(SE, (j + 3) * KVBLK); SBAR();
        pv_d0(o, vb0 + SHM_V, pa0, pa1, pa2, pa3); mask_tile(pA0, pA1, j + 1, lim); partialSM(pA0, pA1, m_reg, mnA, alA);
        __syncthreads(); SWAIT(); SWRITE(1, SO);
        RESC(alA); __syncthreads();
    }
    SBAR(); qkt(pB0, pB1, K_lds + SHM_K, qr, r32, hi);
    finishSM(pA0, pA1, alA, l_reg, pa0, pa1, pa2, pa3); SBAR();
    pv_d0(o, vb0, pa0, pa1, pa2, pa3); mask_tile(pB0, pB1, NT - 1, lim); partialSM(pB0, pB1, m_reg, mnB, alB);
    __syncthreads(); RESC(alB);
    finishSM(pB0, pB1, alB, l_reg, pa0, pa1, pa2, pa3); SBAR();
    pv_d0(o, vb0 + SHM_V, pa0, pa1, pa2, pa3);
    if (hi == 0) li_l[r32] = l_reg; asm volatile("s_waitcnt lgkmcnt(0)" ::: "memory");
    float rli[16];
#pragma unroll
    for (int r = 0; r < 16; ++r) rli[r] = __builtin_amdgcn_rcpf(li_l[crow(r, hi)]);
    bf16_t* Ow = Ob + (long)(wid * QBLK) * LDO;
#pragma unroll
    for (int r = 0; r < 16; ++r) { const int orow = crow(r, hi);
#pragma unroll
        for (int d0 = 0; d0 < 4; ++d0) Ow[(long)orow * LDO + d0 * 32 + r32] = f2bf(o[d0][r] * rli[r]); }
    __syncthreads();
#undef SLOAD
#undef SWRITE
#undef SWAIT
#undef RESC
}
}

__device__ __forceinline__ void attn_phase(const Fr& F) {
    const bf16_t* Q = slotY(F, 0); const bf16_t* K = slotY(F, 1); const bf16_t* V = slotY(F, 2);
    bf16_t* AO = slotU(F, 1);
    if (F.G == 256) {
        const int x = F.bid & 7, j = F.bid >> 3;
        for (int k = 0; k < 8; ++k) {
            const int sub = 8 * x + k, head = sub >> 2, c = (sub >> 1) & 1, half = sub & 1;
            for (int u = 0; u < 3; ++u) {
                if (u == 2 && j != 4 * k) break;
                const int i = u == 0 ? 64 - j : (u == 1 ? j : 32);
                const int NT = 4 * i + 4, lim = 4 * i + (F.wave >> 1);
                att::unit(Q + (size_t)(256 * i) * D + head * 256 + c * 128, K + head * 256 + c * 128, V + head * 256 + half * 128,
                          AO + (size_t)(256 * i) * 8192 + head * 512 + c * 256 + half * 128, NT, lim, (char*)F.ldsg);
            }
        }
    } else {
        for (int idx = F.bid; idx < 65 * 64; idx += F.G) {
            const int i = 64 - idx / 64, sub = idx & 63, head = sub >> 2, c = (sub >> 1) & 1, half = sub & 1;
            const int NT = 4 * i + 4, lim = 4 * i + (F.wave >> 1);
            att::unit(Q + (size_t)(256 * i) * D + head * 256 + c * 128, K + head * 256 + c * 128, V + head * 256 + half * 128,
                      AO + (size_t)(256 * i) * 8192 + head * 512 + c * 256 + half * 128, NT, lim, (char*)F.ldsg);
        }
    }
}
__device__ __forceinline__ void attn_post(const Fr& F) {
    const bf16_t* AO = slotU(F, 1); const bf16_t* GT = slotY(F, 3); bf16_t* Z = slotU(F, 0);
    const float* sg = F.in(13);
    constexpr float LINIT = 0.35550906759096934f;
    float lam;
    { const float* q1 = F.in(9); const float* k1 = F.in(10); const float* q2 = F.in(11); const float* k2 = F.in(12);
      const float d1 = wave_sum(q1[F.lane] * k1[F.lane] + q1[F.lane + 64] * k1[F.lane + 64]), d2 = wave_sum(q2[F.lane] * k2[F.lane] + q2[F.lane + 64] * k2[F.lane + 64]);
      lam = expf(d1) - expf(d2) + LINIT; }
    const f32x4 g4 = ((const f32x4*)sg)[F.lane];
    for (int r = F.gw; r < R; r += F.NGW) {
        const bool real = (r >= NPAD && r < NREAL);
        u32x2* zr = (u32x2*)(Z + (size_t)r * D) + F.lane;
        if (!real) { const u32x2 z = {0u, 0u};
#pragma unroll
            for (int hd = 0; hd < 16; ++hd) zr[64 * hd] = z;
            continue; }
#pragma unroll 4
        for (int hd = 0; hd < 16; ++hd) {
            const u32x2 a0 = ((const u32x2*)(AO + (size_t)r * 8192 + hd * 512))[F.lane], a1 = ((const u32x2*)(AO + (size_t)r * 8192 + hd * 512 + 256))[F.lane];
            const u32x2 gt = ((const u32x2*)(GT + (size_t)r * D + hd * 256))[F.lane];
            const float o0 = bflo(a0.x) - lam * bflo(a1.x), o1 = bfhi(a0.x) - lam * bfhi(a1.x), o2 = bflo(a0.y) - lam * bflo(a1.y), o3 = bfhi(a0.y) - lam * bfhi(a1.y);
            const float ss = wave_sum((o0 * o0 + o1 * o1) + (o2 * o2 + o3 * o3));
            const float rs = __builtin_amdgcn_rsqf(ss * (1.f / 256.f) + 1e-5f) * (1.f - LINIT);
            u32x2 w; w.x = cvt_pk_bf16(o0 * rs * g4.x * silu_f(bflo(gt.x)), o1 * rs * g4.y * silu_f(bfhi(gt.x))); w.y = cvt_pk_bf16(o2 * rs * g4.z * silu_f(bflo(gt.y)), o3 * rs * g4.w * silu_f(bfhi(gt.y)));
            zr[64 * hd] = w;
        }
    }
}

constexpr int RW_TT = 32, RW_TOKF = 384, RW_TILEF = RW_TT * RW_TOKF, RW_NTILE = 513;
__device__ __forceinline__ void rwkv_scan_seq(const Fr& F) {
    const bf16_t* Rr = slotY(F, 0); const bf16_t* K = slotY(F, 1); const bf16_t* V = slotY(F, 2); const bf16_t* W = slotY(F, 4); const bf16_t* A = slotY(F, 5);
    float* O32 = (float*)slotU(F, 1);
    LAS float* ring = (LAS float*)F.lds; LAS float* otile = ring + 2 * RW_TILEF;
    const int tid = F.tid, lane = F.lane, wid = F.wave;
    for (int unit = F.bid; unit < 256; unit += F.G) {
        const int h = unit >> 2, rg = unit & 3;
        const int ptid = tid - 256, ptt = ptid >> 3, dg = ptid & 7;
        float kkc[8], kac[8];
        if (wid >= 4) {
#pragma unroll
            for (int i = 0; i < 8; ++i) { kkc[i] = F.in(23)[h * 64 + 8 * dg + i]; kac[i] = F.in(24)[h * 64 + 8 * dg + i]; }
        }
        float S0 = 0.f, S1 = 0.f, S2 = 0.f, S3 = 0.f;
        const int cg = lane & 15, irow = 4 * wid + (lane >> 4);
#define RW_PRODUCE(m, buf) do { const int row = NPAD + 32 * (m) + ptt; const size_t off = (size_t)row * D + h * 64 + 8 * dg; \
        const u32x4 r8 = *(const u32x4*)(Rr + off), k8 = *(const u32x4*)(K + off), v8 = *(const u32x4*)(V + off), w8 = *(const u32x4*)(W + off), a8 = *(const u32x4*)(A + off); \
        const unsigned rw[4] = {r8.x, r8.y, r8.z, r8.w}, kw[4] = {k8.x, k8.y, k8.z, k8.w}, vw[4] = {v8.x, v8.y, v8.z, v8.w}, ww[4] = {w8.x, w8.y, w8.z, w8.w}, aw[4] = {a8.x, a8.y, a8.z, a8.w}; \
        float rf[8], kf[8], vf[8], wf[8], af[8], kk[8]; float ssq = 0.f; \
        _Pragma("unroll") for (int i = 0; i < 4; ++i) { rf[2 * i] = bflo(rw[i]); rf[2 * i + 1] = bfhi(rw[i]); kf[2 * i] = bflo(kw[i]); kf[2 * i + 1] = bfhi(kw[i]); vf[2 * i] = bflo(vw[i]); vf[2 * i + 1] = bfhi(vw[i]); \
            wf[2 * i] = bflo(ww[i]); wf[2 * i + 1] = bfhi(ww[i]); af[2 * i] = bflo(aw[i]); af[2 * i + 1] = bfhi(aw[i]); } \
        _Pragma("unroll") for (int i = 0; i < 8; ++i) { kk[i] = kf[i] * kkc[i]; ssq += kk[i] * kk[i]; } \
        ssq = red8(ssq); const float inv = 1.f / fmaxf(sqrtf(ssq), 1e-12f); \
        LAS float* tb = ring + (buf) * RW_TILEF + ptt * RW_TOKF; \
        _Pragma("unroll") for (int q = 0; q < 2; ++q) { LAS f32x4* p = (LAS f32x4*)(tb + (2 * dg + q) * 20); \
            f32x4 t0, t1, t2, t3, t4; \
            _Pragma("unroll") for (int e = 0; e < 4; ++e) { const int i = 4 * q + e; const float kn = kk[i] * inv; t0[e] = wf[i]; t1[e] = -kn; t2[e] = kn * af[i]; t3[e] = kf[i] * (1.f + (af[i] - 1.f) * kac[i]); t4[e] = rf[i]; } \
            p[0] = t0; p[1] = t1; p[2] = t2; p[3] = t3; p[4] = t4; } \
        LAS f32x4* pv = (LAS f32x4*)(tb + 320 + 8 * dg); pv[0] = (f32x4){vf[0], vf[1], vf[2], vf[3]}; pv[1] = (f32x4){vf[4], vf[5], vf[6], vf[7]}; } while (0)
#define RW_FLUSH(m, buf) do { const int row = NPAD + 32 * (m) + ptt; if (row < NREAL) { const LAS float* ot = otile + (buf) * 512 + ptt * 16 + 2 * dg; \
        *(float2*)(O32 + (size_t)row * D + h * 64 + 16 * rg + 2 * dg) = make_float2(ot[0], ot[1]); } } while (0)
        if (wid >= 4) RW_PRODUCE(0, 0);
        __syncthreads();
        for (int n = 0; n < RW_NTILE; ++n) {
            if (wid < 4) {
                const LAS float* tb = ring + (n & 1) * RW_TILEF; LAS float* ot = otile + (n & 1) * 512;
#pragma unroll 4
                for (int tt = 0; tt < RW_TT; ++tt) {
                    const LAS float* p = tb + tt * RW_TOKF + cg * 20;
                    const f32x4 w4 = *(const LAS f32x4*)p, nk = *(const LAS f32x4*)(p + 4), ka = *(const LAS f32x4*)(p + 8), kp = *(const LAS f32x4*)(p + 12), r4 = *(const LAS f32x4*)(p + 16);
                    const float v = tb[tt * RW_TOKF + 320 + 16 * rg + irow];
                    float sa = (S0 * nk.x + S1 * nk.y) + (S2 * nk.z + S3 * nk.w);
                    sa = red16(sa);
                    S0 = S0 * w4.x + (sa * ka.x + v * kp.x); S1 = S1 * w4.y + (sa * ka.y + v * kp.y); S2 = S2 * w4.z + (sa * ka.z + v * kp.z); S3 = S3 * w4.w + (sa * ka.w + v * kp.w);
                    float o = (S0 * r4.x + S1 * r4.y) + (S2 * r4.z + S3 * r4.w);
                    o = red16(o);
                    if (cg == 0) ot[tt * 16 + irow] = o;
                }
            } else {
                if (n + 1 < RW_NTILE) RW_PRODUCE(n + 1, (n + 1) & 1);
                if (n > 0) RW_FLUSH(n - 1, (n - 1) & 1);
            }
            __syncthreads();
        }
        if (wid >= 4) RW_FLUSH(RW_NTILE - 1, (RW_NTILE - 1) & 1);
        __syncthreads();
#undef RW_PRODUCE
#undef RW_FLUSH
    }
}

#ifndef RC_SYNC
#define RC_SYNC 0
#endif
constexpr int RC_SLOT = 13312, RC_NSLOT = 8, RC_SCR0 = RC_NSLOT * RC_SLOT, RC_SCR = 5632, RC_FLAGS = RC_SCR0 + 7 * RC_SCR, RC_NCH = 1025;
constexpr int RC_AT = 0, RC_RT = 2176, RC_BTT = 4352, RC_KTT = 6912, RC_TT = 9472, RC_G3F = 9984, RC_VTF = 10496, RC_P1 = 11008, RC_P2 = 12032, RC_WC = 13056;
static_assert(RC_FLAGS + 64 <= 147456 - 256, "rwkv LDS map");
typedef short s16x4v __attribute__((ext_vector_type(4)));
__device__ __forceinline__ void rwkv_kknorm(const Fr& F) {
    const bf16_t* K = slotY(F, 1); const float* k_k = F.in(23); float* INV = (float*)(F.ws + WS_HE);
    for (int r = F.gw; r < R; r += F.NGW) {
#pragma unroll 4
        for (int it = 0; it < 16; ++it) {
            const size_t ci = (size_t)it * 64 + F.lane;
            const u32x2 kk = ((const u32x2*)(K + (size_t)r * D))[ci]; const f32x4 c4 = ((const f32x4*)k_k)[ci];
            const float a = bflo(kk.x) * c4.x, b = bfhi(kk.x) * c4.y, c = bflo(kk.y) * c4.z, d = bfhi(kk.y) * c4.w;
            const float ss = red16((a * a + b * b) + (c * c + d * d));
            if ((F.lane & 15) == 0) INV[(size_t)r * 64 + it * 4 + (F.lane >> 4)] = 1.f / fmaxf(sqrtf(ss), 1e-12f);
        }
    }
}
__device__ __forceinline__ unsigned lds_poll(volatile LAS unsigned* p) { return *p; }
__device__ __forceinline__ void rwkv_scan(const Fr& F) {
    const bf16_t* Rr = slotY(F, 0); const bf16_t* K = slotY(F, 1); const bf16_t* V = slotY(F, 2); const bf16_t* W = slotY(F, 4); const bf16_t* A = slotY(F, 5);
    const float* INV = (const float*)(F.ws + WS_HE);
    float* O32 = (float*)slotU(F, 1);
    LAS unsigned char* L = F.lds;
    volatile LAS unsigned* flags = (volatile LAS unsigned*)(L + RC_FLAGS);
    const int lane = F.lane, wid = F.wave, l15 = lane & 15, kg = lane >> 4;
    for (int unit = F.bid; unit < 256; unit += F.G) {
        const int h = unit >> 2, rgw = unit & 3;
        if (F.tid < 16) flags[F.tid] = 0u;
        __syncthreads();
        if (wid == 0) {
            __builtin_amdgcn_s_setprio(3);
            f32x4 S0 = {0.f, 0.f, 0.f, 0.f}, S1 = S0, S2 = S0, S3 = S0;
            for (int n = 0; n < RC_NCH; ++n) {
                const int slot = n & 7; const LAS unsigned char* SL = L + slot * RC_SLOT;
#if RC_SYNC
                if (n % 7 == 0) { __builtin_amdgcn_s_barrier(); __builtin_amdgcn_s_barrier(); }
#else
                { unsigned sp = 0; while (lds_poll(flags + slot) != (unsigned)(n + 1)) { __builtin_amdgcn_s_sleep(1); if (++sp > (1u << 22)) break; } }
#endif
                asm volatile("s_waitcnt lgkmcnt(0)" ::: "memory");
                u32x4 sb0, sb1; sb0.x = cvt_pk_bf16(S0.x, S0.y); sb0.y = cvt_pk_bf16(S0.z, S0.w); sb0.z = cvt_pk_bf16(S1.x, S1.y); sb0.w = cvt_pk_bf16(S1.z, S1.w);
                sb1.x = cvt_pk_bf16(S2.x, S2.y); sb1.y = cvt_pk_bf16(S2.z, S2.w); sb1.z = cvt_pk_bf16(S3.x, S3.y); sb1.w = cvt_pk_bf16(S3.z, S3.w);
                const bf16x8 Sb0 = *reinterpret_cast<bf16x8*>(&sb0), Sb1 = *reinterpret_cast<bf16x8*>(&sb1);
                const LAS unsigned char* ap = SL + RC_AT + l15 * 136 + kg * 8; const LAS unsigned char* rp = SL + RC_RT + l15 * 136 + kg * 8;
                u32x2 a0l = *(const LAS u32x2*)(ap), a0h = *(const LAS u32x2*)(ap + 32), a1l = *(const LAS u32x2*)(ap + 64), a1h = *(const LAS u32x2*)(ap + 96);
                u32x2 r0l = *(const LAS u32x2*)(rp), r0h = *(const LAS u32x2*)(rp + 32), r1l = *(const LAS u32x2*)(rp + 64), r1h = *(const LAS u32x2*)(rp + 96);
                u32x4 t4;
                t4 = (u32x4){a0l.x, a0l.y, a0h.x, a0h.y}; const bf16x8 Aq0 = *reinterpret_cast<bf16x8*>(&t4);
                t4 = (u32x4){a1l.x, a1l.y, a1h.x, a1h.y}; const bf16x8 Aq1 = *reinterpret_cast<bf16x8*>(&t4);
                t4 = (u32x4){r0l.x, r0l.y, r0h.x, r0h.y}; const bf16x8 Rq0 = *reinterpret_cast<bf16x8*>(&t4);
                t4 = (u32x4){r1l.x, r1l.y, r1h.x, r1h.y}; const bf16x8 Rq1 = *reinterpret_cast<bf16x8*>(&t4);
                f32x4 X = *(const LAS f32x4*)(SL + RC_P1 + lane * 16), O = *(const LAS f32x4*)(SL + RC_P2 + lane * 16);
                const s16x4v ttf = *(const LAS s16x4v*)(SL + RC_TT + l15 * 32 + kg * 8);
                const s16x4v g3f = *(const LAS s16x4v*)(SL + RC_G3F + lane * 8), vtf = *(const LAS s16x4v*)(SL + RC_VTF + lane * 8);
                X = __builtin_amdgcn_mfma_f32_16x16x32_bf16(Aq0, Sb0, X, 0, 0, 0);
                X = __builtin_amdgcn_mfma_f32_16x16x32_bf16(Aq1, Sb1, X, 0, 0, 0);
                O = __builtin_amdgcn_mfma_f32_16x16x32_bf16(Rq0, Sb0, O, 0, 0, 0);
                O = __builtin_amdgcn_mfma_f32_16x16x32_bf16(Rq1, Sb1, O, 0, 0, 0);
                u32x2 yb; yb.x = cvt_pk_bf16(X.x, X.y); yb.y = cvt_pk_bf16(X.z, X.w);
                f32x4 U = {0.f, 0.f, 0.f, 0.f};
                U = __builtin_amdgcn_mfma_f32_16x16x16bf16_1k(ttf, *reinterpret_cast<s16x4v*>(&yb), U, 0, 0, 0);
                u32x2 ub; ub.x = cvt_pk_bf16(U.x, U.y); ub.y = cvt_pk_bf16(U.z, U.w);
                const s16x4v Ub = *reinterpret_cast<s16x4v*>(&ub);
                O = __builtin_amdgcn_mfma_f32_16x16x16bf16_1k(g3f, Ub, O, 0, 0, 0);
                const LAS unsigned char* bp = SL + RC_BTT + l15 * 40 + kg * 8; const LAS unsigned char* kp = SL + RC_KTT + l15 * 40 + kg * 8;
                const s16x4v b0 = *(const LAS s16x4v*)(bp), b1 = *(const LAS s16x4v*)(bp + 640), b2 = *(const LAS s16x4v*)(bp + 1280), b3 = *(const LAS s16x4v*)(bp + 1920);
                const s16x4v k0 = *(const LAS s16x4v*)(kp), k1 = *(const LAS s16x4v*)(kp + 640), k2 = *(const LAS s16x4v*)(kp + 1280), k3 = *(const LAS s16x4v*)(kp + 1920);
                const LAS f32x4* wc = (const LAS f32x4*)(SL + RC_WC + kg * 16);
                const f32x4 w0 = wc[0], w1 = wc[4], w2 = wc[8], w3 = wc[12];
                S0 = __builtin_amdgcn_mfma_f32_16x16x16bf16_1k(k0, vtf, S0, 0, 0, 0); S1 = __builtin_amdgcn_mfma_f32_16x16x16bf16_1k(k1, vtf, S1, 0, 0, 0);
                S2 = __builtin_amdgcn_mfma_f32_16x16x16bf16_1k(k2, vtf, S2, 0, 0, 0); S3 = __builtin_amdgcn_mfma_f32_16x16x16bf16_1k(k3, vtf, S3, 0, 0, 0);
                S0 = __builtin_amdgcn_mfma_f32_16x16x16bf16_1k(b0, Ub, S0, 0, 0, 0); S1 = __builtin_amdgcn_mfma_f32_16x16x16bf16_1k(b1, Ub, S1, 0, 0, 0);
                S2 = __builtin_amdgcn_mfma_f32_16x16x16bf16_1k(b2, Ub, S2, 0, 0, 0); S3 = __builtin_amdgcn_mfma_f32_16x16x16bf16_1k(b3, Ub, S3, 0, 0, 0);
                S0 = S0 * w0; S1 = S1 * w1; S2 = S2 * w2; S3 = S3 * w3;
                asm volatile("s_waitcnt lgkmcnt(0)" ::: "memory");
                if (lane == 0) flags[8] = (unsigned)(n + 1);
                float* op = O32 + (size_t)(NPAD + 16 * n + 4 * kg) * D + h * 64 + 16 * rgw + l15;
                op[0] = O.x; op[D] = O.y; op[2 * D] = O.z; op[3 * D] = O.w;
            }
            __builtin_amdgcn_s_setprio(0);
        } else {
            const int p = wid - 1;
            LAS unsigned char* SC = L + RC_SCR0 + p * RC_SCR;
            const float kkc = F.in(23)[h * 64 + lane], kac = F.in(24)[h * 64 + lane];
            for (int n = p; n < RC_NCH; n += 7) {
                const int slot = n & 7; LAS unsigned char* SL = L + slot * RC_SLOT;
                const int r0 = NPAD + 16 * n;
                unsigned short vq[4];
#pragma unroll
                for (int e = 0; e < 4; ++e) vq[e] = V[(size_t)(r0 + 4 * kg + e) * D + h * 64 + 16 * rgw + l15];
#if RC_SYNC
                asm volatile("s_waitcnt lgkmcnt(0)" ::: "memory"); __builtin_amdgcn_s_barrier();
#else
                if (n >= 8) { unsigned sp = 0; while (lds_poll(flags + 8) < (unsigned)(n - 7)) { __builtin_amdgcn_s_sleep(2); if (++sp > (1u << 22)) break; } }
#endif
                asm volatile("" ::: "memory");
                float Wp = 1.f; unsigned btp[8], ktp[8];
#pragma unroll
                for (int hb = 0; hb < 2; ++hb) {
                    unsigned short rq[8], kq[8], wq[8], aq[8]; float iv[8];
#pragma unroll
                    for (int s = 0; s < 8; ++s) { const size_t off = (size_t)(r0 + 8 * hb + s) * D + h * 64 + lane; rq[s] = Rr[off]; kq[s] = K[off]; wq[s] = W[off]; aq[s] = A[off]; iv[s] = INV[(size_t)(r0 + 8 * hb + s) * 64 + h]; }
                    float btv[8], ktv[8];
#pragma unroll
                    for (int s = 0; s < 8; ++s) {
                        const int t = 8 * hb + s;
                        const float rs = bf2f(rq[s]), ks = bf2f(kq[s]), wsv = bf2f(wq[s]), as = bf2f(aq[s]);
                        const float kk = ks * kkc * iv[s];
                        const float Wprev = Wp; Wp *= wsv; const float iW = __builtin_amdgcn_rcpf(Wp);
                        const float at = -kk * Wprev, rt = rs * Wp, bt = kk * as * iW, kt = ks * (1.f + (as - 1.f) * kac) * iW;
                        *(LAS bf16_t*)(SL + RC_AT + t * 136 + lane * 2) = f2bf(at); *(LAS bf16_t*)(SL + RC_RT + t * 136 + lane * 2) = f2bf(rt);
                        *(LAS bf16_t*)(SC + t * 136 + lane * 2) = f2bf(bt); *(LAS bf16_t*)(SC + 2176 + t * 136 + lane * 2) = f2bf(kt);
                        btv[s] = bt; ktv[s] = kt;
                    }
#pragma unroll
                    for (int s = 0; s < 4; ++s) { btp[4 * hb + s] = cvt_pk_bf16(btv[2 * s], btv[2 * s + 1]); ktp[4 * hb + s] = cvt_pk_bf16(ktv[2 * s], ktv[2 * s + 1]); }
                }
                {
                    LAS u32x2* bq = (LAS u32x2*)(SL + RC_BTT + lane * 40); LAS u32x2* kq2 = (LAS u32x2*)(SL + RC_KTT + lane * 40);
#pragma unroll
                    for (int q = 0; q < 4; ++q) { bq[q] = (u32x2){btp[2 * q], btp[2 * q + 1]}; kq2[q] = (u32x2){ktp[2 * q], ktp[2 * q + 1]}; }
                    *(LAS float*)(SL + RC_WC + lane * 4) = Wp;
                    u32x2 vt; vt.x = (unsigned)vq[0] | ((unsigned)vq[1] << 16); vt.y = (unsigned)vq[2] | ((unsigned)vq[3] << 16);
                    *(LAS u32x2*)(SL + RC_VTF + lane * 8) = vt;
                }
                asm volatile("s_waitcnt lgkmcnt(0)" ::: "memory");
                f32x4 G1 = {0.f, 0.f, 0.f, 0.f}, G2 = G1, G3 = G1, G4 = G1;
#pragma unroll
                for (int ks = 0; ks < 2; ++ks) {
                    const bf16x8 fb = *(const LAS bf16x8*)(SC + l15 * 136 + (32 * ks + 8 * kg) * 2), fk = *(const LAS bf16x8*)(SC + 2176 + l15 * 136 + (32 * ks + 8 * kg) * 2);
                    const bf16x8 fa = *(const LAS bf16x8*)(SL + RC_AT + l15 * 136 + (32 * ks + 8 * kg) * 2), fr_ = *(const LAS bf16x8*)(SL + RC_RT + l15 * 136 + (32 * ks + 8 * kg) * 2);
                    G1 = __builtin_amdgcn_mfma_f32_16x16x32_bf16(fb, fa, G1, 0, 0, 0); G2 = __builtin_amdgcn_mfma_f32_16x16x32_bf16(fk, fa, G2, 0, 0, 0);
                    G3 = __builtin_amdgcn_mfma_f32_16x16x32_bf16(fb, fr_, G3, 0, 0, 0); G4 = __builtin_amdgcn_mfma_f32_16x16x32_bf16(fk, fr_, G4, 0, 0, 0);
                }
                {
                    LAS float* NM = (LAS float*)(SC + 4352);
#pragma unroll
                    for (int e = 0; e < 4; ++e) { const int s = 4 * kg + e; const bool lt = s < l15, le = s <= l15;
                        NM[s * 20 + l15] = lt ? G1[e] : 0.f; G2[e] = lt ? G2[e] : 0.f; G3[e] = le ? G3[e] : 0.f; G4[e] = le ? G4[e] : 0.f; }
                    u32x2 g2, g3, g4; g2.x = cvt_pk_bf16(G2.x, G2.y); g2.y = cvt_pk_bf16(G2.z, G2.w); g3.x = cvt_pk_bf16(G3.x, G3.y); g3.y = cvt_pk_bf16(G3.z, G3.w); g4.x = cvt_pk_bf16(G4.x, G4.y); g4.y = cvt_pk_bf16(G4.z, G4.w);
                    *(LAS u32x2*)(SL + RC_G3F + lane * 8) = g3;
                    u32x2 vt; vt.x = (unsigned)vq[0] | ((unsigned)vq[1] << 16); vt.y = (unsigned)vq[2] | ((unsigned)vq[3] << 16);
                    const s16x4v vtf = *reinterpret_cast<s16x4v*>(&vt);
                    f32x4 P1 = {0.f, 0.f, 0.f, 0.f}, P2 = P1;
                    P1 = __builtin_amdgcn_mfma_f32_16x16x16bf16_1k(*reinterpret_cast<s16x4v*>(&g2), vtf, P1, 0, 0, 0);
                    P2 = __builtin_amdgcn_mfma_f32_16x16x16bf16_1k(*reinterpret_cast<s16x4v*>(&g4), vtf, P2, 0, 0, 0);
                    *(LAS f32x4*)(SL + RC_P1 + lane * 16) = P1; *(LAS f32x4*)(SL + RC_P2 + lane * 16) = P2;
                    asm volatile("s_waitcnt lgkmcnt(0)" ::: "memory");
                    float Tc[16];
#pragma unroll
                    for (int s = 15; s >= 0; --s) {
                        float acc = 0.f;
#pragma unroll
                        for (int r4 = (s + 1) / 4; r4 < 4; ++r4) { const f32x4 nv = *(const LAS f32x4*)(NM + s * 20 + 4 * r4);
#pragma unroll
                            for (int e = 0; e < 4; ++e) { const int r = 4 * r4 + e; if (r > s) acc += nv[e] * Tc[r]; } }
                        Tc[s] = (s == l15) ? 1.f : ((s < l15) ? acc : 0.f);
                    }
                    if (kg == 0) {
                        u32x4 o0, o1; o0.x = cvt_pk_bf16(Tc[0], Tc[1]); o0.y = cvt_pk_bf16(Tc[2], Tc[3]); o0.z = cvt_pk_bf16(Tc[4], Tc[5]); o0.w = cvt_pk_bf16(Tc[6], Tc[7]);
                        o1.x = cvt_pk_bf16(Tc[8], Tc[9]); o1.y = cvt_pk_bf16(Tc[10], Tc[11]); o1.z = cvt_pk_bf16(Tc[12], Tc[13]); o1.w = cvt_pk_bf16(Tc[14], Tc[15]);
                        LAS u32x4* tp = (LAS u32x4*)(SL + RC_TT + l15 * 32); tp[0] = o0; tp[1] = o1;
                    }
                }
                asm volatile("s_waitcnt lgkmcnt(0)" ::: "memory");
#if RC_SYNC
                __builtin_amdgcn_s_barrier();
#else
                if (lane == 0) flags[slot] = (unsigned)(n + 1);
#endif
            }
#if RC_SYNC
            if (p >= RC_NCH % 7) { __builtin_amdgcn_s_barrier(); __builtin_amdgcn_s_barrier(); }
#endif
        }
        __syncthreads();
    }
}
__device__ __forceinline__ void rwkv_post(const Fr& F) {
    const bf16_t* Rr = slotY(F, 0); const bf16_t* K = slotY(F, 1); const bf16_t* V = slotY(F, 2); const bf16_t* GT = slotY(F, 3); const bf16_t* A = slotY(F, 5);
    const float* O32 = (const float*)slotU(F, 1); bf16_t* Z = slotU(F, 0);
    const float* k_a = F.in(24); const float* r_k = F.in(25); const float* lw = F.in(26); const float* lb = F.in(27);
    for (int r = F.gw; r < R; r += F.NGW) {
        const bool real = (r >= NPAD && r < NREAL);
        u32x2* zr = (u32x2*)(Z + (size_t)r * D) + F.lane;
        if (!real) { const u32x2 z = {0u, 0u};
#pragma unroll
            for (int it = 0; it < 16; ++it) zr[64 * it] = z;
            continue; }
#pragma unroll 2
        for (int it = 0; it < 16; ++it) {
            const size_t ci = (size_t)it * 64 + F.lane;
            const f32x4 o4 = ((const f32x4*)(O32 + (size_t)r * D))[ci];
            const u32x2 rr = ((const u32x2*)(Rr + (size_t)r * D))[ci], kk = ((const u32x2*)(K + (size_t)r * D))[ci], vv = ((const u32x2*)(V + (size_t)r * D))[ci], gg = ((const u32x2*)(GT + (size_t)r * D))[ci], aa = ((const u32x2*)(A + (size_t)r * D))[ci];
            const f32x4 ka4 = ((const f32x4*)k_a)[ci], rk4 = ((const f32x4*)r_k)[ci], lw4 = ((const f32x4*)lw)[ci], lb4 = ((const f32x4*)lb)[ci];
            const float mean = red16((o4.x + o4.y) + (o4.z + o4.w)) * (1.f / 64.f);
            const float d0 = o4.x - mean, d1 = o4.y - mean, d2 = o4.z - mean, d3 = o4.w - mean;
            const float var = red16((d0 * d0 + d1 * d1) + (d2 * d2 + d3 * d3)) * (1.f / 64.f);
            const float rs = __builtin_amdgcn_rsqf(var + 64e-5f);
            const float r0 = bflo(rr.x), r1 = bfhi(rr.x), r2 = bflo(rr.y), r3 = bfhi(rr.y);
            const float kp0 = bflo(kk.x) * (1.f + (bflo(aa.x) - 1.f) * ka4.x), kp1 = bfhi(kk.x) * (1.f + (bfhi(aa.x) - 1.f) * ka4.y), kp2 = bflo(kk.y) * (1.f + (bflo(aa.y) - 1.f) * ka4.z), kp3 = bfhi(kk.y) * (1.f + (bfhi(aa.y) - 1.f) * ka4.w);
            const float bs = red16((r0 * kp0 * rk4.x + r1 * kp1 * rk4.y) + (r2 * kp2 * rk4.z + r3 * kp3 * rk4.w));
            const float y0 = d0 * rs * lw4.x + lb4.x + bs * bflo(vv.x), y1 = d1 * rs * lw4.y + lb4.y + bs * bfhi(vv.x), y2 = d2 * rs * lw4.z + lb4.z + bs * bflo(vv.y), y3 = d3 * rs * lw4.w + lb4.w + bs * bfhi(vv.y);
            u32x2 w; w.x = cvt_pk_bf16(y0 * silu_f(bflo(gg.x)), y1 * silu_f(bfhi(gg.x))); w.y = cvt_pk_bf16(y2 * silu_f(bflo(gg.y)), y3 * silu_f(bfhi(gg.y)));
            zr[64 * it] = w;
        }
    }
}
}
namespace mk {
constexpr int LDS_BYTES = 147456;
constexpr int LDS_MISC = LDS_BYTES - 128;
struct Args { const float* in[29]; float* out; unsigned char* ws; };

#define MK_GEMM(EPI, e, Aptr, aps_, Bptr, M_, N_, K_) do { int kk_ = (K_); asm volatile("" : "+s"(kk_));     \
    pg8::Gemm g_{(const bf16_t*)(Aptr), (const bf16_t*)(Bptr), (M_), (N_), kk_, (size_t)(aps_)}; pg8::StaticOrder S_; S_.init((M_), (N_), F.G, F.bid); \
    pg8::gemm_phase<EPI, pg8::StaticOrder, false>(F.lds, g_, S_, e, nullptr); } while (0)

struct TailOrder { int pn;
    __device__ bool next(int i, pg8::Unit& u) const { if (i > 0 || pn < 0) return false; u.pm = 64; u.pn = pn; return true; }
    __device__ __forceinline__ void a_ready(const pg8::Unit&) const {}
    __device__ __forceinline__ void done(const pg8::Unit&) const {}
};
#define MK_GEMM2_NORM(prev, next, udst) do { \
    MK_GEMM(EpiY, ey, slotU(F, 0), 0, wtout, 16384, D, D); \
    GRID_BAR(); \
    if (F.bid < 16) { int kk_ = D; asm volatile("" : "+s"(kk_)); pg8::Gemm g_{(const bf16_t*)slotU(F, 0), (const bf16_t*)wtout, R, D, kk_, (size_t)0}; TailOrder St_{F.bid}; \
        pg8::gemm_phase<EpiY, TailOrder, false>(F.lds, g_, St_, ey, nullptr); } \
    else { const Fr P = F.fresh(); norm_phase(P, prev, next, slotY(P, 0), udst, 0, 16384, 16); } \
    GRID_BAR(); \
    { const Fr P = F.fresh(); norm_phase(P, prev, next, slotY(P, 0), udst, 16384, R, 0); if ((next) >= 0) convert_layer(P, next); } \
    GRID_BAR(); } while (0)

__global__ void __launch_bounds__(512, 2) fwd(Args a) {
    extern __shared__ __attribute__((aligned(16))) unsigned char lds_raw[];
    Fr F;
    F.lds = (LAS unsigned char*)lds_raw; F.ldsg = lds_raw;
    F.tid = threadIdx.x; F.lane = F.tid & 63; F.wave = __builtin_amdgcn_readfirstlane(F.tid >> 6);
    F.G = gridDim.x; F.bid = blockIdx.x; F.gw = F.bid * 8 + F.wave; F.NGW = F.G * 8;
    F.out = a.out; F.ws = a.ws;
    volatile LAS unsigned* misc = (volatile LAS unsigned*)(F.lds + LDS_MISC);
    if (F.tid < 16) misc[F.tid] = 0u;
    __syncthreads();
    XcdBarrier bar = xcd_barrier_post((unsigned*)(F.ws + WS_CTL) + 4096, misc + 8);
#define GRID_BAR() xcd_barrier(bar)
#ifndef MK_DUP
#define MK_DUP 0
#endif
#define DUPN(k, ...) do { __VA_ARGS__; if ((MK_DUP >> (k)) & 1) { GRID_BAR(); __VA_ARGS__; } } while (0)
    bf16_t* wtin = (bf16_t*)(F.ws + WS_WTIN); bf16_t* wtout = (bf16_t*)(F.ws + WS_WTOUT);
    const EpiY ey{slotY(F, 0)};

    DUPN(11, { const Fr P = F.fresh(); convert_layer(P, 0); rope_table(P); norm_phase(P, -1, 0, nullptr, slotU(P, 0)); });
    GRID_BAR();
    DUPN(8, { const EpiH1 e{slotY(F, 0), F.in(5), 0}; MK_GEMM(EpiH1, e, slotU(F, 0), 0, wtin, R, 4 * D, D); });
    GRID_BAR();
    DUPN(1, { const Fr P = F.fresh(); hgrn_phase<false>(P, 0); });
    GRID_BAR();
    DUPN(2, { const Fr P = F.fresh(); hgrn_phase<true>(P, 0); });
    GRID_BAR();
    MK_GEMM2_NORM(0, 1, slotU(F, 0));
    { const EpiB1 e{slotY(F, 0), (const float*)(F.ws + WS_ROPE), (const float*)(F.ws + WS_ROPE) + (size_t)R * 16}; MK_GEMM(EpiB1, e, slotU(F, 0), 0, wtin, R, 4 * D, D); }
    GRID_BAR();
    DUPN(3, { const Fr P = F.fresh(); attn_phase(P); });
    GRID_BAR();
    DUPN(4, { const Fr P = F.fresh(); attn_post(P); });
    GRID_BAR();
    MK_GEMM2_NORM(1, 2, slotY(F, 1));
    DUPN(7, { const Fr P = F.fresh(); mix_phase(P, slotY(P, 1)); convert_layer2_b(P); });
    GRID_BAR();
    { const EpiC1 e{slotY(F, 0), (bf16_t*)(F.ws + WS_T)}; MK_GEMM(EpiC1, e, slotU(F, 0), (size_t)R * D, wtin, R, 4 * D + 512, D); }
    GRID_BAR();
    DUPN(9, { const EpiC2 e{slotY(F, 0), F.in(17), F.in(20)}; MK_GEMM(EpiC2, e, F.ws + WS_T, 0, F.ws + WS_W2P, R, 2 * D, 256); });
    { const Fr P = F.fresh(); rwkv_kknorm(P); }
    GRID_BAR();
    DUPN(5, { const Fr P = F.fresh(); rwkv_scan(P); });
    GRID_BAR();
    DUPN(6, { const Fr P = F.fresh(); rwkv_post(P); });
    GRID_BAR();
    MK_GEMM2_NORM(2, 3, slotU(F, 0));
    { const EpiH1 e{slotY(F, 0), F.in(5), 1}; MK_GEMM(EpiH1, e, slotU(F, 0), 0, wtin, R, 4 * D, D); }
    GRID_BAR();
    { const Fr P = F.fresh(); hgrn_phase<false>(P, 1); }
    GRID_BAR();
    { const Fr P = F.fresh(); hgrn_phase<true>(P, 1); }
    GRID_BAR();
    MK_GEMM2_NORM(3, -1, (bf16_t*)nullptr);
}
}

extern "C" void kernel_launch(void* const* d_in, const int* in_sizes, int n_in, void* d_out, int out_size, void* d_ws, size_t ws_size, hipStream_t stream) {
    static int grid = 0;
    if (grid == 0) {
        if (n_in != 29 || out_size != 16384 * 4096 || ws_size < mk::WS_END) { fprintf(stderr, "kernel_launch: unexpected shapes (n_in %d out %d ws %zu need %zu)\n", n_in, out_size, ws_size, (size_t)mk::WS_END); grid = -1; return; }
        int dev = 0, cus = 0, per_cu = 0;
        if (hipGetDevice(&dev) != hipSuccess || hipDeviceGetAttribute(&cus, hipDeviceAttributeMultiprocessorCount, dev) != hipSuccess) { grid = -1; return; }
        if (hipFuncSetAttribute((const void*)mk::fwd, hipFuncAttributeMaxDynamicSharedMemorySize, mk::LDS_BYTES) != hipSuccess) { fprintf(stderr, "kernel_launch: hipFuncSetAttribute failed\n"); grid = -1; return; }
        if (hipOccupancyMaxActiveBlocksPerMultiprocessor(&per_cu, (const void*)mk::fwd, 512, mk::LDS_BYTES) != hipSuccess || per_cu < 1) { fprintf(stderr, "kernel_launch: occupancy query says %d\n", per_cu); }
        (void)hipGetLastError();
        grid = cus;
    }
    if (grid < 0) return;
    if (hipMemsetAsync((char*)d_ws + mk::WS_CTL, 0, mk::CTL_BYTES, stream) != hipSuccess) return;
    mk::Args a{};
    for (int i = 0; i < 29; ++i) a.in[i] = (const float*)d_in[i];
    a.out = (float*)d_out; a.ws = (unsigned char*)d_ws;
    hipLaunchKernelGGL(mk::fwd, dim3(grid), dim3(512), mk::LDS_BYTES, stream, a);
}
```

```cpp
#include <hip/hip_runtime.h>
#include <cstdio>
#include <cstdint>

#define LAS __attribute__((address_space(3)))
#define GAS __attribute__((address_space(1)))
typedef unsigned short bf16_t;
typedef short bf16x8 __attribute__((ext_vector_type(8)));
typedef short s16x4 __attribute__((ext_vector_type(4)));
typedef float f32x4 __attribute__((ext_vector_type(4)));
typedef float f32x16 __attribute__((ext_vector_type(16)));
typedef unsigned u32x4 __attribute__((ext_vector_type(4)));
typedef unsigned u32x2 __attribute__((ext_vector_type(2)));

namespace mk {
constexpr int D = 4096, NPAD = 48, NREAL = 16448, R = 16640, NCH = 257;
constexpr size_t MiB = 1u << 20;
constexpr size_t SLOT = (size_t)R * D * 2;
constexpr size_t WS_CTL = 0, CTL_BYTES = 1 * MiB;
constexpr size_t WS_WTIN = 2 * MiB;
constexpr size_t WS_WTOUT = 134 * MiB;
constexpr size_t WS_W2P = 166 * MiB;
constexpr size_t WS_ROPE = 170 * MiB;
constexpr size_t WS_HMETA = 174 * MiB;
constexpr size_t WS_HE = 175 * MiB;
constexpr size_t WS_HLOGD = 191 * MiB;
constexpr size_t WS_U = 192 * MiB;
constexpr size_t WS_Y = WS_U + 6 * SLOT;
constexpr size_t WS_T = WS_Y + 6 * SLOT;
constexpr size_t WS_WTINB = WS_U + 4 * SLOT;
constexpr size_t WS_END = WS_T + (size_t)R * 256 * 2;
static_assert(WS_END <= 2040 * MiB, "d_ws map");

typedef __bf16 bf16x2n_t __attribute__((ext_vector_type(2)));
typedef float f32x2n_t __attribute__((ext_vector_type(2)));
__device__ __forceinline__ unsigned cvt_pk_bf16(float lo, float hi) { const f32x2n_t v = {lo, hi}; const bf16x2n_t r = __builtin_convertvector(v, bf16x2n_t); return __builtin_bit_cast(unsigned, r); }
__device__ __forceinline__ float bflo(unsigned w) { return __uint_as_float(w << 16); }
__device__ __forceinline__ float bfhi(unsigned w) { return __uint_as_float(w & 0xffff0000u); }
__device__ __forceinline__ float bf2f(bf16_t b) { return __uint_as_float(((unsigned)b) << 16); }
__device__ __forceinline__ bf16_t f2bf(float f) { return (bf16_t)(cvt_pk_bf16(f, f) & 0xffffu); }
__device__ __forceinline__ float sigmoid_f(float x) { return 1.f / (1.f + __expf(-x)); }
__device__ __forceinline__ float silu_f(float x) { return x / (1.f + __expf(-x)); }
__device__ __forceinline__ float wave_sum(float v) {
#pragma unroll
    for (int o = 1; o < 64; o <<= 1) v += __shfl_xor(v, o);
    return v;
}
template <int CTRL> __device__ __forceinline__ float dppf(float v) { return __int_as_float(__builtin_amdgcn_update_dpp(0, __float_as_int(v), CTRL, 0xf, 0xf, true)); }
__device__ __forceinline__ float red4(float v) { v += dppf<0xB1>(v); v += dppf<0x4E>(v); return v; }
__device__ __forceinline__ float red8(float v) { v = red4(v); v += dppf<0x141>(v); return v; }
__device__ __forceinline__ float red16(float v) { v = red8(v); v += dppf<0x140>(v); return v; }
#define LDS_WAIT() asm volatile("s_waitcnt lgkmcnt(0)" ::: "memory")
}
#define XB_TMO      128
#define XB_XCNT(j)  (256  + 64 * (j))
#define XB_XSUB(j)  (1280 + 64 * (j))
#define XB_XGEN(j)  (2304 + 64 * (j))
#define XB_TOP      3328
#define XB_TOPGEN   3392
#define XCD_BAR_WORDS 3456
#define XB_SPIN_CAP (1u << 18)
#define LAS __attribute__((address_space(3)))

__device__ __forceinline__ unsigned xb_ld(unsigned* p)              { return __hip_atomic_load(p, __ATOMIC_RELAXED, __HIP_MEMORY_SCOPE_AGENT); }
__device__ __forceinline__ unsigned xb_add(unsigned* p, unsigned v) { return __hip_atomic_fetch_add(p, v, __ATOMIC_RELAXED, __HIP_MEMORY_SCOPE_AGENT); }
__device__ __forceinline__ unsigned xb_xcc_id() { return (unsigned)__builtin_amdgcn_s_getreg((3 << 11) | 20) & 0xFu; }
#define XB_SPIN(cond, bar) do { unsigned _sp = 0; while (cond) { __builtin_amdgcn_s_sleep(1); \
    if ((++_sp & 255u) == 0u) { if (xb_ld(&(bar)[XB_TMO])) break; if (_sp > XB_SPIN_CAP) { atomicAdd(&(bar)[XB_TMO], 1u); break; } } } } while (0)

struct XcdBarrier {
    unsigned* bar; unsigned x;
    volatile LAS unsigned* st;
};

__device__ __forceinline__ XcdBarrier xcd_barrier_post(unsigned* bar, volatile LAS unsigned* st) {
    XcdBarrier b; b.bar = bar; b.x = xb_xcc_id(); b.st = st;
    if (threadIdx.x == 0) (void)xb_add(&bar[XB_XCNT(b.x)], 1u);
    return b;
}
__device__ __forceinline__ void xcd_barrier_complete(unsigned* bar, unsigned x, unsigned& nloc, unsigned& nx) {
    const unsigned G = gridDim.x * gridDim.y * gridDim.z;
    unsigned sum, cnt, mine, sp = 0u;
    for (;;) {
        sum = 0u; cnt = 0u; mine = 0u;
#pragma unroll
        for (unsigned j = 0; j < 16; ++j) { const unsigned c = xb_ld(&bar[XB_XCNT(j)]); sum += c; cnt += (c > 0u) ? 1u : 0u; mine = (j == x) ? c : mine; }
        if (sum == G) break;
        __builtin_amdgcn_s_sleep(1);
        if ((++sp & 255u) == 0u) { if (xb_ld(&bar[XB_TMO])) break; if (sp > XB_SPIN_CAP) { atomicAdd(&bar[XB_TMO], 1u); break; } }
    }
    nloc = mine > 0u ? mine : 1u; nx = cnt > 0u ? cnt : 1u;
}

__device__ __forceinline__ void xcd_barrier(const XcdBarrier& b) {
    asm volatile("s_waitcnt vmcnt(0)" ::: "memory");
    __syncthreads();
    if (threadIdx.x == 0) {
        unsigned* bar = b.bar;
        __builtin_amdgcn_s_waitcnt(0);
        unsigned nloc = b.st[0], nx = b.st[1];
        if (nloc == 0u) { xcd_barrier_complete(bar, b.x, nloc, nx); b.st[0] = nloc; b.st[1] = nx; }
        const unsigned old = xb_add(&bar[XB_XSUB(b.x)], 1u);
        const unsigned gen = old / nloc;
        if (old + 1u == (gen + 1u) * nloc) {
            __builtin_amdgcn_fence(__ATOMIC_RELEASE, "agent");
            asm volatile("s_waitcnt vmcnt(0)" ::: "memory");
            const unsigned og = xb_add(&bar[XB_TOP], 1u);
            const unsigned tg = og / nx;
            if (og + 1u == (tg + 1u) * nx) xb_add(&bar[XB_TOPGEN], 1u);
            else XB_SPIN(xb_ld(&bar[XB_TOPGEN]) == tg, bar);
            __builtin_amdgcn_fence(__ATOMIC_ACQUIRE, "agent");
            xb_add(&bar[XB_XGEN(b.x)], 1u);
            asm volatile("s_waitcnt vmcnt(0)" ::: "memory");
        } else {
            XB_SPIN(xb_ld(&bar[XB_XGEN(b.x)]) == gen, bar);
            __builtin_amdgcn_fence(__ATOMIC_ACQUIRE, "agent");
            asm volatile("s_waitcnt vmcnt(0)" ::: "memory");
        }
    }
    __syncthreads();
}
namespace pg8 {
#define PG8_LAS __attribute__((address_space(3)))
typedef unsigned short bf16_t;
typedef short bf16x8 __attribute__((ext_vector_type(8)));
typedef float f32x4 __attribute__((ext_vector_type(4)));
typedef unsigned u32x4 __attribute__((ext_vector_type(4)));
constexpr int BM = 256, BK = 64, HALF = 128, HTB = HALF * BK * 2  , STAGE_BYTES = 8 * HTB, NXCD = 8, WGM = 8;

__host__ __device__ __forceinline__ int lds_byte(int r, int c) { const int st = (r >> 4) * 2 + (c >> 5), rr = r & 15, cc = c & 31, ob = rr * 64 + cc * 2; return st * 1024 + (ob ^ (((ob >> 9) & 1) << 5)); }
__host__ __device__ __forceinline__ void stage_rc(int b, int& R, int& C) { const int st = b / 1024, sb = b % 1024, swz = sb ^ (((sb >> 9) & 1) << 5); R = (st >> 1) * 16 + swz / 64; C = (st & 1) * 32 + (swz % 64) / 2; }
__host__ __device__ __forceinline__ int perm32(int rho) { const int n = rho >> 4, i = rho & 15; return 8 * (i >> 2) + 4 * n + (i & 3); }

struct Unit { int pm, pn; };
struct Gemm { const bf16_t* A; const bf16_t* Bt; int M, N, K; size_t aps; };
__device__ __forceinline__ size_t a_part_bytes(const Gemm& g, int pn) { return g.aps ? (size_t)(pn < 64 ? (pn >> 4) : (pn - 60)) * g.aps * 2 : (size_t)0; }

struct StaticOrder {
    int nM, nN, nwg, G, c;
    __host__ __device__ void init(int M, int N, int G_, int c_) { nM = M / BM; nN = N / BM; nwg = nM * nN; G = G_; c = c_; }
    __host__ __device__ bool next(int i, Unit& u) const {
        const long L = (long)i * G + c; if (L >= nwg) return false;
        int wgid = (int)L; { const int q = nwg / NXCD, r = nwg % NXCD, xcd = wgid % NXCD, off = wgid / NXCD; wgid = (xcd < r ? xcd * (q + 1) : r * (q + 1) + (xcd - r) * q) + off; }
        const int nig = WGM * nN, gid = wgid / nig, fm = gid * WGM, gsz = (nM - fm) < WGM ? (nM - fm) : WGM;
        u.pm = fm + ((wgid % nig) % gsz); u.pn = (wgid % nig) / gsz; return true;
    }
    __device__ __forceinline__ void a_ready(const Unit&) const {}
    __device__ __forceinline__ void done(const Unit&) const {}
};
struct CountedOrder : StaticOrder {
    const unsigned* ready; unsigned need; unsigned* tmo;
    __device__ __forceinline__ void a_ready(const Unit& u) const {
        if (threadIdx.x < 64) {
            const unsigned long long t0 = __builtin_amdgcn_s_memrealtime(); unsigned polls = 0;
            while ((unsigned)__builtin_amdgcn_readfirstlane(__hip_atomic_load(ready + 64 * u.pm, __ATOMIC_RELAXED, __HIP_MEMORY_SCOPE_AGENT)) < need) {
                if ((++polls & 255u) == 0u && __builtin_amdgcn_readfirstlane(__hip_atomic_load(tmo, __ATOMIC_RELAXED, __HIP_MEMORY_SCOPE_AGENT)) != 0u) break;
                if (__builtin_amdgcn_s_memrealtime() - t0 > 2000000ull) {
                    if (threadIdx.x == 0) { unsigned expect = 0u; __hip_atomic_compare_exchange_strong(tmo + 1, &expect, 0x600u | (unsigned)(u.pm & 0xff), __ATOMIC_RELAXED, __ATOMIC_RELAXED, __HIP_MEMORY_SCOPE_AGENT); __hip_atomic_store(tmo, 1u, __ATOMIC_RELAXED, __HIP_MEMORY_SCOPE_AGENT); }
                    break; }
                __builtin_amdgcn_s_sleep(2); }
            __builtin_amdgcn_fence(__ATOMIC_ACQUIRE, "agent");
            asm volatile("s_waitcnt vmcnt(0)" ::: "memory");
        }
#if !defined(BROKEN_HOOK_NO_BARRIER)
        asm volatile("" ::: "memory"); __builtin_amdgcn_s_barrier(); asm volatile("" ::: "memory");
#endif
    }
};
template <class Epi, class Sched, bool STAMP = false, bool TOPHALF = false>
__device__ __forceinline__ void gemm_phase(PG8_LAS unsigned char* lds, const Gemm g, const Sched& S, const Epi& E, unsigned long long* stamps) {
    int tid_ = threadIdx.x; asm volatile("" : "+v"(tid_));
    const int tid = tid_, wid = __builtin_amdgcn_readfirstlane(tid >> 6), lane = tid & 63, wr = wid >> 2, wc = wid & 3, fr = lane & 15, fq = lane >> 4;
    const int K = g.K, nt = K / BK;
    int ts_lo = 0, ts_hi = 0, nts = 0; const unsigned long long rt_entry = STAMP ? (unsigned long long)wall_clock64() : 0ull;
#define PG8_STAMP() do { if (STAMP && wid == 0 && nts < 64) { const unsigned long long _c = (unsigned long long)clock64(); \
        ts_lo = (lane == nts) ? (int)(unsigned)_c : ts_lo; ts_hi = (lane == nts) ? (int)(unsigned)(_c >> 32) : ts_hi; ++nts; } } while (0)
    PG8_STAMP();
    unsigned voffA[2], voffB[2];
#pragma unroll
    for (int i = 0; i < 2; ++i) { int R, C; stage_rc(tid * 16 + i * 8192, R, C); const int Rb = Epi::PERM ? ((R & ~31) + perm32(R & 31)) : R;
        voffA[i] = (unsigned)(R * K + C) * 2u; voffB[i] = (unsigned)(Rb * K + C) * 2u; }
    const size_t kstep = (size_t)(BK * 2);
    const size_t hstep = (size_t)HALF * K * 2;
    const size_t tstep = 2 * hstep;
    const unsigned ldsw = (unsigned)wid * 1024u;
    const int aoff = lds_byte(wr * 64 + fr, fq * 8), boff = lds_byte(wc * 32 + fr, fq * 8);
#define PG8_SA(b, h) (((b) * 2 + (h)) * HTB)
#define PG8_SB(b, h) ((4 + (b) * 2 + (h)) * HTB)
#define PG8_STAGE(bufoff, gbase, voff) do { _Pragma("unroll") for (int _i = 0; _i < 2; ++_i) \
        __builtin_amdgcn_global_load_lds((const unsigned*)((const char*)(gbase) + (voff)[_i]), (PG8_LAS unsigned*)(lds + (bufoff) + ldsw + _i * 8192), 16, 0, 0); } while (0)
#define PG8_LDA(dst, b, h) do { _Pragma("unroll") for (int m = 0; m < 4; ++m) _Pragma("unroll") for (int k = 0; k < 2; ++k) dst[m][k] = *(const PG8_LAS bf16x8*)(lds + PG8_SA(b, h) + aoff + m * 2048 + k * 1024); } while (0)
#define PG8_LDB(dst, b, h) do { _Pragma("unroll") for (int n = 0; n < 2; ++n) _Pragma("unroll") for (int k = 0; k < 2; ++k) dst[n][k] = *(const PG8_LAS bf16x8*)(lds + PG8_SB(b, h) + boff + n * 2048 + k * 1024); } while (0)
#define PG8_MMA(ai, bj, At, Bt) do { __builtin_amdgcn_s_setprio(1); _Pragma("unroll") for (int m = 0; m < 4; ++m) _Pragma("unroll") for (int n = 0; n < 2; ++n) _Pragma("unroll") for (int k = 0; k < 2; ++k) \
        acc[ai][bj][m][n] = __builtin_amdgcn_mfma_f32_16x16x32_bf16(Bt[n][k], At[m][k], acc[ai][bj][m][n], 0, 0, 0); __builtin_amdgcn_s_setprio(0); } while (0)
#define PG8_WAIT_V(n) asm volatile("s_waitcnt vmcnt(" #n ")" ::: "memory")
#define PG8_WAIT_L(n) asm volatile("s_waitcnt lgkmcnt(" #n ")" ::: "memory")
#define PG8_BAR __builtin_amdgcn_s_barrier()
#define PG8_SCHED __builtin_amdgcn_sched_barrier(0)
    Unit cur, nxt; int ui = 0;
    if (!S.next(0, cur)) return;
    f32x4 acc[2][2][4][2];
#pragma unroll
    for (int a = 0; a < 2; ++a)
#pragma unroll
        for (int b = 0; b < 2; ++b)
#pragma unroll
            for (int m = 0; m < 4; ++m)
#pragma unroll
                for (int n = 0; n < 2; ++n) acc[a][b][m][n] = (f32x4){0.f, 0.f, 0.f, 0.f};
    bf16x8 At[4][2], B0[2][2], B1[2][2];
    const char* cA = (const char*)g.A + a_part_bytes(g, cur.pn) + (size_t)cur.pm * tstep; const char* cB = (const char*)g.Bt + (size_t)cur.pn * tstep;
    S.a_ready(cur);
    PG8_STAGE(PG8_SB(0, 0), cB, voffB); PG8_STAGE(PG8_SA(0, 0), cA, voffA); PG8_STAGE(PG8_SB(0, 1), cB + hstep, voffB); PG8_STAGE(PG8_SA(0, 1), cA + hstep, voffA);
    if (wr == 1) PG8_BAR;
    PG8_WAIT_V(4); PG8_BAR;
    PG8_STAGE(PG8_SB(1, 0), cB + kstep, voffB); PG8_STAGE(PG8_SA(1, 0), cA + kstep, voffA); PG8_STAGE(PG8_SB(1, 1), cB + hstep + kstep, voffB);
    PG8_WAIT_V(6); PG8_BAR;
    PG8_STAMP();
    for (;;) {
        const bool has_next = S.next(ui + 1, nxt);
        const char* nA = has_next ? (const char*)g.A + a_part_bytes(g, nxt.pn) + (size_t)nxt.pm * tstep : cA; const char* nB = has_next ? (const char*)g.Bt + (size_t)nxt.pn * tstep : cB;
        for (int t = 0; t < nt; t += 2) {
            const bool last = (t == nt - 2);
            const char* a1 = cA + (size_t)(t + 1) * kstep;
            const char* a2 = last ? nA : cA + (size_t)(t + 2) * kstep; const char* b2 = last ? nB : cB + (size_t)(t + 2) * kstep;
            const char* a3 = a2 + kstep; const char* b3 = b2 + kstep;
            if (last && has_next) S.a_ready(nxt);
            PG8_LDB(B0, 0, 0); PG8_SCHED; PG8_LDA(At, 0, 0); PG8_STAGE(PG8_SA(1, 1), a1 + hstep, voffA);
            PG8_WAIT_L(8); PG8_BAR; PG8_WAIT_L(0); PG8_MMA(0, 0, At, B0); PG8_BAR; PG8_SCHED;
            PG8_LDB(B1, 0, 1); PG8_STAGE(PG8_SB(0, 0), b2, voffB);
            PG8_BAR; PG8_WAIT_L(0); PG8_MMA(0, 1, At, B1); PG8_BAR;
            if constexpr (!TOPHALF) PG8_LDA(At, 0, 1); PG8_STAGE(PG8_SA(0, 0), a2, voffA);
            PG8_BAR; PG8_WAIT_L(0); if constexpr (!TOPHALF) PG8_MMA(1, 0, At, B0); PG8_BAR; PG8_SCHED;
            PG8_STAGE(PG8_SB(0, 1), b2 + hstep, voffB);
            PG8_WAIT_V(6); PG8_BAR; if constexpr (!TOPHALF) PG8_MMA(1, 1, At, B1); PG8_BAR;
            PG8_LDB(B0, 1, 0); PG8_SCHED; PG8_LDA(At, 1, 0); PG8_STAGE(PG8_SA(0, 1), a2 + hstep, voffA);
            PG8_WAIT_L(8); PG8_BAR; PG8_WAIT_L(0); PG8_MMA(0, 0, At, B0); PG8_BAR; PG8_SCHED;
            PG8_LDB(B1, 1, 1); PG8_STAGE(PG8_SB(1, 0), b3, voffB);
            PG8_BAR; PG8_WAIT_L(0); PG8_MMA(0, 1, At, B1); PG8_BAR;
            if constexpr (!TOPHALF) PG8_LDA(At, 1, 1); PG8_STAGE(PG8_SA(1, 0), a3, voffA);
            PG8_BAR; PG8_WAIT_L(0); if constexpr (!TOPHALF) PG8_MMA(1, 0, At, B0); PG8_BAR; PG8_SCHED;
            PG8_STAGE(PG8_SB(1, 1), b3 + hstep, voffB);
            PG8_WAIT_V(6); PG8_BAR; if constexpr (!TOPHALF) PG8_MMA(1, 1, At, B1); PG8_BAR;
        }
        PG8_STAMP();
        if constexpr (!Epi::AFTER_DRAIN) { E(acc, cur, wr, wc, fr, fq); S.done(cur); }
        PG8_STAMP();
        if (!has_next) break;
#pragma unroll
        for (int a = 0; a < 2; ++a)
#pragma unroll
            for (int b = 0; b < 2; ++b)
#pragma unroll
                for (int m = 0; m < 4; ++m)
#pragma unroll
                    for (int n = 0; n < 2; ++n) acc[a][b][m][n] = (f32x4){0.f, 0.f, 0.f, 0.f};
        cur = nxt; cA = nA; cB = nB; ++ui;
    }
    PG8_WAIT_V(0);
    if (wr == 0) PG8_BAR;
    PG8_BAR;
    if constexpr (Epi::AFTER_DRAIN) { E.fused(acc, cur, wr, wc, fr, fq, lds, wid, lane); S.done(cur); }
    PG8_STAMP();
    if (STAMP && wid == 0) { stamps[lane] = lane < nts ? (((unsigned long long)(unsigned)ts_hi << 32) | (unsigned)ts_lo) : 0ull;
        if (lane == 62) stamps[62] = rt_entry; if (lane == 63) stamps[63] = (unsigned long long)wall_clock64(); }
#undef PG8_STAMP
#undef PG8_SA
#undef PG8_SB
#undef PG8_STAGE
#undef PG8_LDA
#undef PG8_LDB
#undef PG8_MMA
#undef PG8_WAIT_V
#undef PG8_WAIT_L
#undef PG8_BAR
#undef PG8_SCHED
}
}
namespace mk {
typedef pg8::Unit Unit;
typedef const pg8::f32x4 (&AccRef)[2][2][4][2];

__device__ __forceinline__ void st_bf8(bf16_t* p, pg8::f32x4 v0, pg8::f32x4 v1) {
    u32x4 w; w.x = cvt_pk_bf16(v0[0], v0[1]); w.y = cvt_pk_bf16(v0[2], v0[3]); w.z = cvt_pk_bf16(v1[0], v1[1]); w.w = cvt_pk_bf16(v1[2], v1[3]);
    *(u32x4*)p = w;
}
__device__ __forceinline__ void st_bf4(bf16_t* p, pg8::f32x4 v) { u32x2 w; w.x = cvt_pk_bf16(v[0], v[1]); w.y = cvt_pk_bf16(v[2], v[3]); *(u32x2*)p = w; }

struct EpiY {
    static constexpr bool PERM = true, AFTER_DRAIN = false;
    bf16_t* O;
    __device__ __forceinline__ void operator()(AccRef acc, const Unit& u, int wr, int wc, int fr, int fq) const {
        const int row0 = u.pm * 256 + wr * 64 + fr, col0 = u.pn * 256 + wc * 32 + 8 * fq;
#pragma unroll
        for (int ai = 0; ai < 2; ++ai)
#pragma unroll
            for (int m = 0; m < 4; ++m) { bf16_t* rowp = O + (size_t)(row0 + ai * 128 + m * 16) * D + col0;
#pragma unroll
                for (int bj = 0; bj < 2; ++bj) st_bf8(rowp + bj * 128, acc[ai][bj][m][0], acc[ai][bj][m][1]); }
    }
};
struct EpiH1 {
    static constexpr bool PERM = true, AFTER_DRAIN = false;
    bf16_t* Y; const float* lbl; int jl;
    __device__ __forceinline__ void operator()(AccRef acc, const Unit& u, int wr, int wc, int fr, int fq) const {
        const int part = u.pn >> 4, colt = (u.pn & 15) * 256;
        const int row0 = u.pm * 256 + wr * 64 + fr, col0 = colt + wc * 32 + 8 * fq;
        if (part == 1) {
#pragma unroll
            for (int bj = 0; bj < 2; ++bj) {
                pg8::f32x4 lbv[2] = {{0.f, 0.f, 0.f, 0.f}, {0.f, 0.f, 0.f, 0.f}};
                if (jl) {
#pragma unroll
                    for (int n = 0; n < 2; ++n) { const pg8::f32x4 l0 = *(const pg8::f32x4*)(lbl + col0 + bj * 128 + 4 * n), l1 = *(const pg8::f32x4*)(lbl + D + col0 + bj * 128 + 4 * n);
#pragma unroll
                        for (int j = 0; j < 4; ++j) lbv[n][j] = sigmoid_f(l1[j] - l0[j]); }
                }
#pragma unroll
                for (int ai = 0; ai < 2; ++ai)
#pragma unroll
                    for (int m = 0; m < 4; ++m) {
                        const int row = row0 + ai * 128 + m * 16;
                        pg8::f32x4 o[2];
#pragma unroll
                        for (int n = 0; n < 2; ++n)
#pragma unroll
                            for (int j = 0; j < 4; ++j) {
                                const float x = acc[ai][bj][m][n][j]; float g;
                                if (jl) { const float l = lbv[n][j]; g = __logf(l + (1.f - l) * sigmoid_f(x)); }
                                else g = fminf(x, 0.f) - __logf(1.f + __expf(-fabsf(x)));
                                o[n][j] = (row < NPAD) ? 0.f : g;
                            }
                        float* gp = (float*)(Y + 3 * (SLOT / 2)) + (size_t)row * D + col0 + bj * 128;
                        *(pg8::f32x4*)gp = o[0]; *(pg8::f32x4*)(gp + 4) = o[1];
                    }
            }
        } else {
            bf16_t* dst = Y + (size_t)(part == 0 ? 0 : (part == 2 ? 1 : 2)) * (SLOT / 2);
#pragma unroll
            for (int ai = 0; ai < 2; ++ai)
#pragma unroll
                for (int m = 0; m < 4; ++m) { bf16_t* rowp = dst + (size_t)(row0 + ai * 128 + m * 16) * D + col0;
#pragma unroll
                    for (int bj = 0; bj < 2; ++bj) st_bf8(rowp + bj * 128, acc[ai][bj][m][0], acc[ai][bj][m][1]); }
        }
    }
};
struct EpiB1 {
    static constexpr bool PERM = false, AFTER_DRAIN = false;
    bf16_t* Y; const float* cs; const float* sn;
    __device__ __forceinline__ void operator()(AccRef acc, const Unit& u, int wr, int wc, int fr, int fq) const {
        const int part = u.pn >> 4, colt = (u.pn & 15) * 256;
        const int row0 = u.pm * 256 + wr * 64 + fr, col0 = colt + wc * 32 + 4 * fq;
        bf16_t* dst = Y + (size_t)part * (SLOT / 2);
        const bool rope = (part < 2) && (wc == 0);
#pragma unroll
        for (int ai = 0; ai < 2; ++ai)
#pragma unroll
            for (int m = 0; m < 4; ++m) {
                const int row = row0 + ai * 128 + m * 16;
                pg8::f32x4 c4 = {1.f, 1.f, 1.f, 1.f}, s4 = {0.f, 0.f, 0.f, 0.f};
                if (rope) { c4 = *(const pg8::f32x4*)(cs + (size_t)row * 16 + 4 * fq); s4 = *(const pg8::f32x4*)(sn + (size_t)row * 16 + 4 * fq); }
                bf16_t* rowp = dst + (size_t)row * D + col0;
#pragma unroll
                for (int bj = 0; bj < 2; ++bj) {
                    const pg8::f32x4 x1 = acc[ai][bj][m][0], x2 = acc[ai][bj][m][1];
                    const pg8::f32x4 y1 = x1 * c4 - x2 * s4, y2 = x2 * c4 + x1 * s4;
                    st_bf4(rowp + bj * 128, y1); st_bf4(rowp + bj * 128 + 16, y2);
                }
            }
    }
};
struct EpiC1 {
    static constexpr bool PERM = true, AFTER_DRAIN = false;
    bf16_t *Y, *T;
    __device__ __forceinline__ void operator()(AccRef acc, const Unit& u, int wr, int wc, int fr, int fq) const {
        const int row0 = u.pm * 256 + wr * 64 + fr;
        if (u.pn < 64) {
            const int part = u.pn >> 4, col0 = (u.pn & 15) * 256 + wc * 32 + 8 * fq;
            bf16_t* dst = Y + (size_t)part * (SLOT / 2);
#pragma unroll
            for (int ai = 0; ai < 2; ++ai)
#pragma unroll
                for (int m = 0; m < 4; ++m) { bf16_t* rowp = dst + (size_t)(row0 + ai * 128 + m * 16) * D + col0;
#pragma unroll
                    for (int bj = 0; bj < 2; ++bj) st_bf8(rowp + bj * 128, acc[ai][bj][m][0], acc[ai][bj][m][1]); }
        } else {
            const int which = u.pn - 64, col0 = which * 128 + wc * 32 + 8 * fq;
#pragma unroll
            for (int ai = 0; ai < 2; ++ai)
#pragma unroll
                for (int m = 0; m < 4; ++m) {
                    pg8::f32x4 v0 = acc[ai][0][m][0], v1 = acc[ai][0][m][1];
                    if (which == 0) {
#pragma unroll
                        for (int j = 0; j < 4; ++j) { v0[j] = 1.f - 2.f / (1.f + __expf(2.f * v0[j])); v1[j] = 1.f - 2.f / (1.f + __expf(2.f * v1[j])); }
                    }
                    st_bf8(T + (size_t)(row0 + ai * 128 + m * 16) * 256 + col0, v0, v1);
                }
        }
    }
};
struct EpiC2 {
    static constexpr bool PERM = true, AFTER_DRAIN = false;
    bf16_t* Y; const float* w0; const float* a0;
    __device__ __forceinline__ void operator()(AccRef acc, const Unit& u, int wr, int wc, int fr, int fq) const {
        const int row0 = u.pm * 256 + wr * 64 + fr;
        const bool isw = u.pn < 16;
        const int col0 = (u.pn & 15) * 256 + wc * 32 + 8 * fq;
        bf16_t* dst = Y + (size_t)(isw ? 4 : 5) * (SLOT / 2); const float* bias = isw ? w0 : a0;
#pragma unroll
        for (int bj = 0; bj < 2; ++bj) {
            const pg8::f32x4 b0 = *(const pg8::f32x4*)(bias + col0 + bj * 128), b1 = *(const pg8::f32x4*)(bias + col0 + bj * 128 + 4);
#pragma unroll
            for (int ai = 0; ai < 2; ++ai)
#pragma unroll
                for (int m = 0; m < 4; ++m) {
                    pg8::f32x4 v0 = acc[ai][bj][m][0] + b0, v1 = acc[ai][bj][m][1] + b1;
#pragma unroll
                    for (int j = 0; j < 4; ++j) {
                        float s0 = sigmoid_f(v0[j]), s1 = sigmoid_f(v1[j]);
                        if (isw) { s0 = __expf(-0.606531f * s0); s1 = __expf(-0.606531f * s1); }
                        v0[j] = s0; v1[j] = s1;
                    }
                    st_bf8(dst + (size_t)(row0 + ai * 128 + m * 16) * D + col0 + bj * 128, v0, v1);
                    __builtin_amdgcn_sched_barrier(0);
                }
        }
    }
};

struct Fr {
    LAS unsigned char* lds; unsigned char* ldsg;
    int tid, lane, wave, G, bid, gw, NGW;
    float* out; unsigned char* ws;
    __device__ __forceinline__ Fr fresh() const { Fr P = *this; asm volatile("" : "+v"(P.tid)); P.lane = P.tid & 63; P.wave = __builtin_amdgcn_readfirstlane(P.tid >> 6); P.gw = P.bid * 8 + P.wave; return P; }
    __device__ __forceinline__ const float* in(int i) const {
        const __attribute__((address_space(4))) unsigned long long* ka = (const __attribute__((address_space(4))) unsigned long long*)__builtin_amdgcn_kernarg_segment_ptr();
        asm volatile("" : "+s"(ka));
        return (const float*)ka[i];
    }
};
__device__ __forceinline__ bf16_t* slotU(const Fr& F, int s) { return (bf16_t*)(F.ws + WS_U + (size_t)s * SLOT); }
__device__ __forceinline__ bf16_t* slotY(const Fr& F, int s) { return (bf16_t*)(F.ws + WS_Y + (size_t)s * SLOT); }
__device__ __forceinline__ float* hrow(const Fr& F, int r) { return r < 64 ? (float*)(F.ws + WS_HMETA) + (size_t)r * D : F.out + (size_t)(r - 64) * D; }

__device__ __forceinline__ void transpose_item(const float* W, int ldw, bf16_t* WT, int ldt, int koff, LAS float* scr, int kb, int nb, int lane) {
    const int k0 = 64 * kb, n0 = 32 * nb;
#pragma unroll 8
    for (int i = 0; i < 32; ++i) { const int kk = 2 * i + (lane >> 5); scr[kk * 33 + (lane & 31)] = W[(size_t)(k0 + kk) * ldw + n0 + (lane & 31)]; }
    LDS_WAIT(); asm volatile("" ::: "memory");
    const int c = lane & 7;
#pragma unroll
    for (int j = 0; j < 4; ++j) { const int n = (lane >> 3) + 8 * j; const LAS float* s = scr + (8 * c) * 33 + n;
        u32x4 o; o.x = cvt_pk_bf16(s[0 * 33], s[1 * 33]); o.y = cvt_pk_bf16(s[2 * 33], s[3 * 33]); o.z = cvt_pk_bf16(s[4 * 33], s[5 * 33]); o.w = cvt_pk_bf16(s[6 * 33], s[7 * 33]);
        *(u32x4*)(WT + (size_t)(n0 + n) * ldt + koff + k0 + 8 * c) = o; }
    LDS_WAIT(); asm volatile("" ::: "memory");
}
__device__ __forceinline__ void convert_matrix(const Fr& F, const float* W, int K, int N, bf16_t* WT, int ldt, int koff, int wg_skip = 0) {
    LAS float* scr = (LAS float*)(F.lds + F.wave * 8704);
    const int nblk = N / 32, nitems = (K / 64) * nblk;
    for (int it = F.gw - wg_skip * 8; it < nitems; it += F.NGW - wg_skip * 8) transpose_item(W, N, WT, ldt, koff, scr, it / nblk, it % nblk, F.lane);
}
__device__ __forceinline__ void zero_bytes(const Fr& F, void* p, size_t nbytes) {
    u32x4* q = (u32x4*)p; const size_t n = nbytes / 16; const u32x4 z = {0u, 0u, 0u, 0u};
    for (size_t i = (size_t)F.bid * 512 + F.tid; i < n; i += (size_t)F.G * 512) q[i] = z;
}
__device__ __forceinline__ bf16_t* wtin_of(const Fr& F, int L) { return (bf16_t*)(F.ws + ((L & 1) ? WS_WTINB : WS_WTIN)); }
__device__ __forceinline__ void convert_win(const Fr& F, int L, int wg_skip) {
    const float* src = (L == 0 || L == 3) ? F.in(4) + (size_t)(L ? 1 : 0) * D * 4 * D : (L == 1 ? F.in(8) : F.in(16));
    convert_matrix(F, src, D, 4 * D, wtin_of(F, L), D, 0, wg_skip);
}
__device__ __forceinline__ void convert_layer(const Fr& F, int L, bool with_win) {
    bf16_t* wtin = wtin_of(F, L); bf16_t* wtout = (bf16_t*)(F.ws + WS_WTOUT);
    if (with_win) convert_win(F, L, 0);
    if (L == 0 || L == 3) {
        convert_matrix(F, F.in(7) + (size_t)(L ? 1 : 0) * D * D, D, D, wtout, D, 0);
    } else if (L == 1) {
        convert_matrix(F, F.in(14), D, D, wtout, D, 0);
    } else {
        convert_matrix(F, F.in(28), D, D, wtout, D, 0);
        convert_matrix(F, F.in(18), D, 128, wtin + (size_t)16384 * D, D, 0);
        convert_matrix(F, F.in(21), D, 128, wtin + (size_t)16640 * D, D, 0);
        zero_bytes(F, wtin + (size_t)16512 * D, (size_t)128 * D * 2);
        zero_bytes(F, wtin + (size_t)16768 * D, (size_t)128 * D * 2);
        bf16_t* w2p = (bf16_t*)(F.ws + WS_W2P);
        zero_bytes(F, w2p, (size_t)8192 * 256 * 2);
    }
}
__device__ __forceinline__ void convert_layer2_b(const Fr& F) {
    bf16_t* w2p = (bf16_t*)(F.ws + WS_W2P);
    convert_matrix(F, F.in(19), 128, D, w2p, 256, 0);
    convert_matrix(F, F.in(22), 128, D, w2p + (size_t)4096 * 256, 256, 128);
}

__constant__ float c_inv_freq[16] = {1.0f, 0.44036659598350525f, 0.1939227432012558f, 0.08539710193872452f, 0.03760603070259094f, 0.01656043902039528f, 0.007292664609849453f, 0.0032114458736032248f,
    0.0014142135623842478f, 0.000622772378847003f, 0.00027424818836152554f, 0.00012076973507646471f, 5.318296098266728e-05f, 2.34199997066753e-05f, 1.0313386155758053e-05f, 4.541670477919979e-06f};
__device__ __forceinline__ void rope_table(const Fr& F) {
    float* cs = (float*)(F.ws + WS_ROPE); float* sn = cs + (size_t)R * 16;
    for (int i = F.bid * 512 + F.tid; i < R * 16; i += F.G * 512) {
        const int row = i >> 4, j = i & 15; const int pos = row - NPAD;
        const double ang = (double)(float)((float)pos * c_inv_freq[j]);
        const double k = __builtin_rint(ang * 0.15915494309189535);
        double x = ang - k * 6.283185307179586;
        const double q = __builtin_rint(x * 0.6366197723675814);
        x -= q * 1.5707963267948966;
        const int qi = ((int)q) & 3;
        const double x2 = x * x;
        const double s = x * (1.0 + x2 * (-1.0 / 6 + x2 * (1.0 / 120 + x2 * (-1.0 / 5040 + x2 * (1.0 / 362880 + x2 * (-1.0 / 39916800))))));
        const double c = 1.0 + x2 * (-0.5 + x2 * (1.0 / 24 + x2 * (-1.0 / 720 + x2 * (1.0 / 40320 + x2 * (-1.0 / 3628800 + x2 * (1.0 / 479001600))))));
        double sv, cv;
        if (qi == 0) { sv = s; cv = c; } else if (qi == 1) { sv = c; cv = -s; } else if (qi == 2) { sv = -s; cv = -c; } else { sv = -c; cv = s; }
        cs[i] = (float)cv; sn[i] = (float)sv;
    }
}

typedef const GAS char* gcp; typedef GAS char* gp_;
#define ROW_F32(nm, base, lane) gp_ nm##0 = (gp_)(base) + (lane) * 16 + 4096; gp_ nm##1 = nm##0 + 8192; asm volatile("" : "+v"(nm##0), "+v"(nm##1))
#define AT_F32(nm, j) (*(GAS f32x4*)((j) < 8 ? nm##0 + ((j) - 4) * 1024 : nm##1 + ((j) - 12) * 1024))
#define ROW_BF(nm, base, lane) gp_ nm##0 = (gp_)(base) + (lane) * 8 + 4096; asm volatile("" : "+v"(nm##0))
#define AT_BF(nm, j) (*(GAS u32x2*)(nm##0 + (j) * 512 - 4096))
__device__ __forceinline__ void norm_phase(const Fr& F, int prev, int next, const bf16_t* y, bf16_t* udst, int rlo = 0, int rhi = R, int wg_skip = 0) {
    const float* postg = F.in(3) + (size_t)(prev < 0 ? 0 : prev) * D; const float* preg = F.in(2) + (size_t)(next < 0 ? 0 : next) * D;
    const float* xin = F.in(0); const float* meta = F.in(1);
    for (int r = rlo + F.gw - wg_skip * 8; r < rhi; r += F.NGW - wg_skip * 8) {
        if (r < NPAD || r >= NREAL) {
            if (next >= 0) { ROW_BF(uo, udst + (size_t)r * D, F.lane); const u32x2 z = {0u, 0u};
#pragma unroll
                for (int j = 0; j < 16; ++j) AT_BF(uo, j) = z; }
            continue;
        }
        float* hr = hrow(F, r);
        ROW_F32(hp, hr, F.lane);
        f32x4 hv[16];
        if (prev < 0) {
            const float* src = r < 64 ? meta + (size_t)(r - NPAD) * D : xin + (size_t)(r - 64) * D;
            ROW_F32(sp, src, F.lane);
#pragma unroll
            for (int j = 0; j < 16; ++j) hv[j] = AT_F32(sp, j);
        } else {
            ROW_BF(yp, y + (size_t)r * D, F.lane); ROW_F32(gp, postg, F.lane);
            u32x2 yv[16]; float ss = 0.f;
#pragma unroll
            for (int j = 0; j < 16; ++j) { yv[j] = AT_BF(yp, j); hv[j] = AT_F32(hp, j); }
#pragma unroll
            for (int j = 0; j < 16; ++j) { const float a = bflo(yv[j].x), b = bfhi(yv[j].x), c = bflo(yv[j].y), d = bfhi(yv[j].y); ss += (a * a + b * b) + (c * c + d * d); }
#pragma unroll
            for (int j = 0; j < 16; ++j) asm volatile("" : "+v"(yv[j].x), "+v"(yv[j].y));
            const float rs = __builtin_amdgcn_rsqf(wave_sum(ss) * (1.f / D) + 1e-6f);
#pragma unroll
            for (int j = 0; j < 16; ++j) { const f32x4 g = AT_F32(gp, j);
                hv[j].x += bflo(yv[j].x) * rs * g.x; hv[j].y += bfhi(yv[j].x) * rs * g.y; hv[j].z += bflo(yv[j].y) * rs * g.z; hv[j].w += bfhi(yv[j].y) * rs * g.w; }
        }
        if (next < 0) {
            if (r >= 64) {
#pragma unroll
                for (int j = 0; j < 16; ++j) AT_F32(hp, j) = hv[j];
            }
            continue;
        }
        float s2 = 0.f;
#pragma unroll
        for (int j = 0; j < 16; ++j) { AT_F32(hp, j) = hv[j]; s2 += (hv[j].x * hv[j].x + hv[j].y * hv[j].y) + (hv[j].z * hv[j].z + hv[j].w * hv[j].w); }
        const float rs2 = __builtin_amdgcn_rsqf(wave_sum(s2) * (1.f / D) + 1e-6f);
        ROW_BF(uo, udst + (size_t)r * D, F.lane); ROW_F32(pg, preg, F.lane);
#pragma unroll
        for (int j = 0; j < 16; ++j) { const f32x4 g = AT_F32(pg, j); u32x2 w; w.x = cvt_pk_bf16(hv[j].x * rs2 * g.x, hv[j].y * rs2 * g.y); w.y = cvt_pk_bf16(hv[j].z * rs2 * g.z, hv[j].w * rs2 * g.w); AT_BF(uo, j) = w; }
    }
}
__device__ __forceinline__ void mix_phase(const Fr& F, const bf16_t* u) {
    const float* mu = F.in(15);
    for (int r = F.gw; r < R; r += F.NGW) {
        const bool real = (r >= NPAD && r < NREAL);
        u32x2 cur[16], prv[16];
        const u32x2 z = {0u, 0u};
        { ROW_BF(cp, u + (size_t)r * D, F.lane); ROW_BF(pp, u + (size_t)(r > 0 ? r - 1 : 0) * D, F.lane);
#pragma unroll
          for (int j = 0; j < 16; ++j) { cur[j] = real ? AT_BF(cp, j) : z; prv[j] = (real && r > NPAD) ? AT_BF(pp, j) : z; } }
#pragma unroll 1
        for (int s = 0; s < 6; ++s) {
            ROW_BF(op, slotU(F, s) + (size_t)r * D, F.lane); ROW_F32(mp, mu + (size_t)s * D, F.lane);
#pragma unroll
            for (int j = 0; j < 16; ++j) {
                const f32x4 m = AT_F32(mp, j);
                const float c0 = bflo(cur[j].x), c1 = bfhi(cur[j].x), c2 = bflo(cur[j].y), c3 = bfhi(cur[j].y);
                const float p0 = bflo(prv[j].x), p1 = bfhi(prv[j].x), p2 = bflo(prv[j].y), p3 = bfhi(prv[j].y);
                u32x2 w; w.x = cvt_pk_bf16(c0 + (p0 - c0) * m.x, c1 + (p1 - c1) * m.y); w.y = cvt_pk_bf16(c2 + (p2 - c2) * m.z, c3 + (p3 - c3) * m.w);
                AT_BF(op, j) = real ? w : z;
            }
        }
    }
}
}
namespace mk {
constexpr int H_QE = 0, H_KE = 17408, H_KET = 34816, H_VT = 53248, H_PM = 71680, H_STB = 80896, H_VEC = 115712;
__device__ __forceinline__ bf16x8 ldfrag(const LAS unsigned char* base, int stride_b, int rb, int ks, int lane) {
    return *(const LAS bf16x8*)(base + (16 * rb + (lane & 15)) * stride_b + (32 * ks + 8 * (lane >> 4)) * 2);
}
template <bool OUT>
__device__ __forceinline__ void hgrn_phase(const Fr& F, int jl) {
    const bf16_t* Q = slotY(F, 0); const bf16_t* V = slotY(F, 1); const bf16_t* GT = slotY(F, 2); const float* Gg = (const float*)slotY(F, 3);
    bf16_t* Z = slotU(F, 0);
    float* HE = (float*)(F.ws + WS_HE); float* HLD = (float*)(F.ws + WS_HLOGD);
    const float* gn = F.in(6) + (size_t)jl * 128;
    LAS unsigned char* L = F.lds;
    LAS float* qtot = (LAS float*)(L + H_VEC); LAS float* ebm = qtot + 512; LAS float* ebl = ebm + 128;
    const int tid = F.tid, lane = F.lane, w = F.wave;
    const int d = tid & 127, qt = tid >> 7;
    for (int unit = F.bid; unit < 256; unit += F.G) {
        const int h = unit >> 3, seg = unit & 7;
        if (!OUT && seg == 7) continue;
        const int c0 = seg == 0 ? 0 : 33 + 32 * (seg - 1), c1 = c0 + (seg == 0 ? 33 : 32);
        f32x4 S[8];
#pragma unroll
        for (int i = 0; i < 8; ++i) S[i] = (f32x4){0.f, 0.f, 0.f, 0.f};
        if (OUT) {
            for (int j = 0; j < seg; ++j) {
                const float* ld = HLD + (size_t)(h * 8 + j) * 128; const float* e = HE + ((size_t)(h * 8 + j) * 512 + tid) * 32;
#pragma unroll
                for (int di = 0; di < 8; ++di) { const f32x4 l4 = *(const f32x4*)(ld + 16 * di + 4 * (lane >> 4)); const f32x4 e4 = *(const f32x4*)(e + 4 * di);
                    S[di].x = S[di].x * __expf(l4.x) + e4.x; S[di].y = S[di].y * __expf(l4.y) + e4.y; S[di].z = S[di].z * __expf(l4.z) + e4.z; S[di].w = S[di].w * __expf(l4.w) + e4.w; }
            }
        }
        float logD = 0.f;
        float g[16]; bf16_t qv[16], vv[16]; u32x4 gt0 = {0u, 0u, 0u, 0u}, gt1 = gt0, ngt0 = gt0, ngt1 = gt0;
#define HG_LOAD(cc) do { const int rowb_ = 64 * (cc) + 16 * qt; const size_t colb_ = (size_t)h * 128 + d; \
            _Pragma("unroll") for (int i = 0; i < 16; ++i) { g[i] = Gg[(size_t)(rowb_ + i) * D + colb_]; vv[i] = V[(size_t)(rowb_ + i) * D + colb_]; if (OUT) qv[i] = Q[(size_t)(rowb_ + i) * D + colb_]; } \
            if (OUT) { const bf16_t* gp_ = GT + (size_t)(64 * (cc) + (tid >> 3)) * D + h * 128 + 16 * (tid & 7); ngt0 = *(const u32x4*)gp_; ngt1 = *(const u32x4*)(gp_ + 8); } } while (0)
        HG_LOAD(c0);
        for (int c = c0; c < c1; ++c) {
            if (OUT) { gt0 = ngt0; gt1 = ngt1; }
            float b[16]; float run = 0.f;
#pragma unroll
            for (int i = 0; i < 16; ++i) { run += g[i]; b[i] = run; }
            qtot[qt * 128 + d] = run;
            __syncthreads();
            const float t0 = qtot[d], t1 = qtot[128 + d], t2 = qtot[256 + d], t3 = qtot[384 + d];
            const float off = qt == 0 ? 0.f : (qt == 1 ? t0 : (qt == 2 ? t0 + t1 : t0 + t1 + t2));
            const float bm = t0 + t1, bl = (t0 + t1) + (t2 + t3);
            if (qt == 0) { ebm[d] = __expf(bm); ebl[d] = __expf(bl); logD += bl; }
            {
                unsigned kt[8], vt[8];
#pragma unroll
                for (int i = 0; i < 16; i += 2) {
                    const float b0 = b[i] + off, b1 = b[i + 1] + off;
                    const float k0 = 1.f - __expf(g[i]), k1 = 1.f - __expf(g[i + 1]);
                    const int t = 16 * qt + i;
                    if (OUT) {
                        *(LAS bf16_t*)(L + H_QE + (t * 136 + d) * 2) = f2bf(bf2f(qv[i]) * __expf(b0 - bm));
                        *(LAS bf16_t*)(L + H_QE + ((t + 1) * 136 + d) * 2) = f2bf(bf2f(qv[i + 1]) * __expf(b1 - bm));
                        *(LAS bf16_t*)(L + H_KE + (t * 136 + d) * 2) = f2bf(k0 * __expf(bm - b0));
                        *(LAS bf16_t*)(L + H_KE + ((t + 1) * 136 + d) * 2) = f2bf(k1 * __expf(bm - b1));
                    }
                    kt[i >> 1] = cvt_pk_bf16(k0 * __expf(bl - b0), k1 * __expf(bl - b1));
                    vt[i >> 1] = (unsigned)vv[i] | ((unsigned)vv[i + 1] << 16);
                }
                LAS u32x4* kp = (LAS u32x4*)(L + H_KET + (d * 72 + 16 * qt) * 2); kp[0] = (u32x4){kt[0], kt[1], kt[2], kt[3]}; kp[1] = (u32x4){kt[4], kt[5], kt[6], kt[7]};
                LAS u32x4* vp = (LAS u32x4*)(L + H_VT + (d * 72 + 16 * qt) * 2); vp[0] = (u32x4){vt[0], vt[1], vt[2], vt[3]}; vp[1] = (u32x4){vt[4], vt[5], vt[6], vt[7]};
            }
            if (c + 1 < c1) HG_LOAD(c + 1);
            __syncthreads();
            if (OUT) {
#pragma unroll
                for (int di = 0; di < 8; ++di) { const f32x4 m4 = *(const LAS f32x4*)(ebm + 16 * di + 4 * (lane >> 4)); u32x2 o; o.x = cvt_pk_bf16(S[di].x * m4.x, S[di].y * m4.y); o.y = cvt_pk_bf16(S[di].z * m4.z, S[di].w * m4.w);
                    *(LAS u32x2*)(L + H_STB + ((16 * w + (lane & 15)) * 136 + 16 * di + 4 * (lane >> 4)) * 2) = o; }
                const int ti = w >> 1;
#pragma unroll
                for (int s2 = 0; s2 < 2; ++s2) { const int si = 2 * (w & 1) + s2; f32x4 p = {0.f, 0.f, 0.f, 0.f};
                    if (si <= ti) {
#pragma unroll
                        for (int ks = 0; ks < 4; ++ks) p = __builtin_amdgcn_mfma_f32_16x16x32_bf16(ldfrag(L + H_QE, 272, ti, ks, lane), ldfrag(L + H_KE, 272, si, ks, lane), p, 0, 0, 0);
                    }
                    const int sidx = 16 * si + (lane & 15);
#pragma unroll
                    for (int jj = 0; jj < 4; ++jj) { const int tidx = 16 * ti + 4 * (lane >> 4) + jj; *(LAS bf16_t*)(L + H_PM + (tidx * 72 + sidx) * 2) = f2bf(sidx <= tidx ? p[jj] : 0.f); }
                }
                __syncthreads();
            }
            f32x4 O[4];
            if (OUT) {
#pragma unroll
                for (int ti = 0; ti < 4; ++ti) O[ti] = (f32x4){0.f, 0.f, 0.f, 0.f};
#pragma unroll
                for (int ks = 0; ks < 2; ++ks) { const bf16x8 bv = ldfrag(L + H_VT, 144, w, ks, lane);
#pragma unroll
                    for (int ti = 0; ti < 4; ++ti) O[ti] = __builtin_amdgcn_mfma_f32_16x16x32_bf16(ldfrag(L + H_PM, 144, ti, ks, lane), bv, O[ti], 0, 0, 0); }
#pragma unroll
                for (int ks = 0; ks < 4; ++ks) { const bf16x8 bs = ldfrag(L + H_STB, 272, w, ks, lane);
#pragma unroll
                    for (int ti = 0; ti < 4; ++ti) O[ti] = __builtin_amdgcn_mfma_f32_16x16x32_bf16(ldfrag(L + H_QE, 272, ti, ks, lane), bs, O[ti], 0, 0, 0); }
            }
            {
                const bf16x8 bv0 = ldfrag(L + H_VT, 144, w, 0, lane), bv1 = ldfrag(L + H_VT, 144, w, 1, lane);
#pragma unroll
                for (int di = 0; di < 8; ++di) { const f32x4 l4 = *(const LAS f32x4*)(ebl + 16 * di + 4 * (lane >> 4)); S[di] = S[di] * l4;
                    S[di] = __builtin_amdgcn_mfma_f32_16x16x32_bf16(ldfrag(L + H_KET, 144, di, 0, lane), bv0, S[di], 0, 0, 0);
                    S[di] = __builtin_amdgcn_mfma_f32_16x16x32_bf16(ldfrag(L + H_KET, 144, di, 1, lane), bv1, S[di], 0, 0, 0); }
            }
            if (OUT) {
                __syncthreads();
                LAS float* Ot = (LAS float*)(L + H_STB);
#pragma unroll
                for (int ti = 0; ti < 4; ++ti)
#pragma unroll
                    for (int jj = 0; jj < 4; ++jj) Ot[(16 * ti + 4 * (lane >> 4) + jj) * 132 + 16 * w + (lane & 15)] = O[ti][jj];
                __syncthreads();
                const int t = tid >> 3, eg = tid & 7;
                f32x4 o4[4]; float ss = 0.f;
#pragma unroll
                for (int i = 0; i < 4; ++i) { o4[i] = *(const LAS f32x4*)(Ot + t * 132 + 16 * eg + 4 * i); ss += (o4[i].x * o4[i].x + o4[i].y * o4[i].y) + (o4[i].z * o4[i].z + o4[i].w * o4[i].w); }
                ss = red8(ss);
                const float rs = __builtin_amdgcn_rsqf(ss * (1.f / 128.f) + 1e-6f);
                const unsigned gw_[8] = {gt0.x, gt0.y, gt0.z, gt0.w, gt1.x, gt1.y, gt1.z, gt1.w};
                unsigned zo[8];
#pragma unroll
                for (int i = 0; i < 4; ++i) { const f32x4 g4 = *(const f32x4*)(gn + 16 * eg + 4 * i);
                    const float a0 = o4[i].x * rs * g4.x * silu_f(bflo(gw_[2 * i])), a1 = o4[i].y * rs * g4.y * silu_f(bfhi(gw_[2 * i]));
                    const float a2 = o4[i].z * rs * g4.z * silu_f(bflo(gw_[2 * i + 1])), a3 = o4[i].w * rs * g4.w * silu_f(bfhi(gw_[2 * i + 1]));
                    zo[2 * i] = cvt_pk_bf16(a0, a1); zo[2 * i + 1] = cvt_pk_bf16(a2, a3); }
                bf16_t* zp = Z + (size_t)(64 * c + t) * D + h * 128 + 16 * eg;
                *(u32x4*)zp = (u32x4){zo[0], zo[1], zo[2], zo[3]}; *(u32x4*)(zp + 8) = (u32x4){zo[4], zo[5], zo[6], zo[7]};
            } else {
                __syncthreads();
            }
        }
        if (!OUT) {
            float* e = HE + ((size_t)(h * 8 + seg) * 512 + tid) * 32;
#pragma unroll
            for (int di = 0; di < 8; ++di) *(f32x4*)(e + 4 * di) = S[di];
            if (qt == 0) HLD[(size_t)(h * 8 + seg) * 128 + d] = logD;
        }
        __syncthreads();
    }
#undef HG_LOAD
}

namespace att {
constexpr int NW = 8, QBLK = 32, KVBLK = 64, LDQ = 4096, LDO = 8192;
constexpr float SCALE = 0.088388347648318440f, THR = 8.f;
constexpr int SHM_V = 16384, SHM_K = 16384, SHM = 2 * SHM_V + 2 * SHM_K + NW * 64 * 4;
#define KSWZ(row, colB) ((row) * 256 + ((colB) ^ (((row) & 7) << 4)))
#define SBAR() __builtin_amdgcn_sched_barrier(0)
__device__ __forceinline__ int crow(int r, int hi) { return (r & 3) + 8 * (r >> 2) + 4 * hi; }
__device__ __forceinline__ void partialSM(f32x16& p0, f32x16& p1, float& m_reg, float& mn, float& alpha) {
    constexpr float C = SCALE * 1.4426950408889634f;
    float pmax = p0[0];
#pragma unroll
    for (int r = 1; r < 16; ++r) pmax = fmaxf(pmax, p0[r]);
#pragma unroll
    for (int r = 0; r < 16; ++r) pmax = fmaxf(pmax, p1[r]);
    { auto rr = __builtin_amdgcn_permlane32_swap(__float_as_uint(pmax), __float_as_uint(pmax), false, false);
      pmax = fmaxf(__uint_as_float(rr[0]), __uint_as_float(rr[1])); }
    if (__builtin_expect(__all(pmax - m_reg <= THR / SCALE), 1)) { mn = m_reg; alpha = 1.f; }
    else { mn = fmaxf(m_reg, pmax); alpha = __builtin_amdgcn_exp2f((m_reg - mn) * C); m_reg = mn; }
    const float mnC = -mn * C;
#pragma unroll
    for (int r = 0; r < 16; ++r) p0[r] = fmaf(p0[r], C, mnC);
#pragma unroll
    for (int r = 0; r < 16; ++r) p1[r] = fmaf(p1[r], C, mnC);
#pragma unroll
    for (int r = 0; r < 16; ++r) p0[r] = __builtin_amdgcn_exp2f(p0[r]);
}
__device__ __forceinline__ void finishSM(f32x16& p0, f32x16& p1, float alpha, float& l_reg, bf16x8& pa0, bf16x8& pa1, bf16x8& pa2, bf16x8& pa3) {
#pragma unroll
    for (int r = 0; r < 16; ++r) p1[r] = __builtin_amdgcn_exp2f(p1[r]);
    float ps = 0;
#pragma unroll
    for (int r = 0; r < 16; ++r) ps += p0[r];
#pragma unroll
    for (int r = 0; r < 16; ++r) ps += p1[r];
    { auto rr = __builtin_amdgcn_permlane32_swap(__float_as_uint(ps), __float_as_uint(ps), false, false);
      ps = __uint_as_float(rr[0]) + __uint_as_float(rr[1]); }
    l_reg = l_reg * alpha + ps;
#define PK4(P, BASE, OUT) do { unsigned a0 = cvt_pk_bf16(P[BASE + 0], P[BASE + 1]), a1 = cvt_pk_bf16(P[BASE + 2], P[BASE + 3]);   \
    unsigned b0 = cvt_pk_bf16(P[BASE + 4], P[BASE + 5]), b1 = cvt_pk_bf16(P[BASE + 6], P[BASE + 7]);                              \
    auto r0 = __builtin_amdgcn_permlane32_swap(a0, b0, false, false); auto r1 = __builtin_amdgcn_permlane32_swap(a1, b1, false, false); \
    u32x4 w = {r0[0], r1[0], r0[1], r1[1]}; OUT = *reinterpret_cast<bf16x8*>(&w); } while (0)
    PK4(p0, 0, pa0); PK4(p0, 8, pa1); PK4(p1, 0, pa2); PK4(p1, 8, pa3);
#undef PK4
}
__device__ __forceinline__ void qkt(f32x16& p0, f32x16& p1, const char* Ks, const bf16x8* qr, int r32, int hi) {
    p0 = f32x16{}; p1 = f32x16{};
#pragma unroll
    for (int d0 = 0; d0 < 8; ++d0) { const int cb = (d0 * 16 + hi * 8) * 2;
        const bf16x8 b0 = *reinterpret_cast<const bf16x8*>(Ks + KSWZ(r32, cb));
        const bf16x8 b1 = *reinterpret_cast<const bf16x8*>(Ks + KSWZ(32 + r32, cb));
        p0 = __builtin_amdgcn_mfma_f32_32x32x16_bf16(b0, qr[d0], p0, 0, 0, 0);
        p1 = __builtin_amdgcn_mfma_f32_32x32x16_bf16(b1, qr[d0], p1, 0, 0, 0); }
}
__device__ __forceinline__ int v_st(int k, int c) { const int kk = (k & ~0xC) | ((k & 4) << 1) | ((k & 8) >> 1); return ((kk >> 3) * 4 + (c >> 5)) * 512 + ((kk & 7) * 32 + (c & 31)) * 2; }
__device__ __forceinline__ int v_rd_base(int lane) { return ((lane & 3) << 3) | (((lane >> 2) & 3) << 6) | (((lane >> 4) & 1) << 5) | (((lane >> 5) & 1) << 8); }
constexpr int v_rd_off(int d0, int ks, int half) { return d0 * 512 + ks * 4096 + half * 2048; }
template <int OFF> __device__ __forceinline__ s16x4 tr_read(int vb) {
    s16x4 r; asm volatile("ds_read_b64_tr_b16 %0, %1 offset:%2" : "=&v"(r) : "v"(vb), "i"(OFF) : "memory"); return r;
}
template <int D0> __device__ __forceinline__ void pv_one(f32x16& od, int vb, bf16x8 pa0, bf16x8 pa1, bf16x8 pa2, bf16x8 pa3) {
    const s16x4 l0 = tr_read<v_rd_off(D0, 0, 0)>(vb), h0 = tr_read<v_rd_off(D0, 0, 1)>(vb), l1 = tr_read<v_rd_off(D0, 1, 0)>(vb), h1 = tr_read<v_rd_off(D0, 1, 1)>(vb);
    const s16x4 l2 = tr_read<v_rd_off(D0, 2, 0)>(vb), h2 = tr_read<v_rd_off(D0, 2, 1)>(vb), l3 = tr_read<v_rd_off(D0, 3, 0)>(vb), h3 = tr_read<v_rd_off(D0, 3, 1)>(vb);
    asm volatile("s_waitcnt lgkmcnt(0)" ::: "memory"); SBAR();
#define PK(Lo, Hi) (bf16x8){Lo[0], Lo[1], Lo[2], Lo[3], Hi[0], Hi[1], Hi[2], Hi[3]}
    od = __builtin_amdgcn_mfma_f32_32x32x16_bf16(pa0, PK(l0, h0), od, 0, 0, 0);
    od = __builtin_amdgcn_mfma_f32_32x32x16_bf16(pa1, PK(l1, h1), od, 0, 0, 0);
    od = __builtin_amdgcn_mfma_f32_32x32x16_bf16(pa2, PK(l2, h2), od, 0, 0, 0);
    od = __builtin_amdgcn_mfma_f32_32x32x16_bf16(pa3, PK(l3, h3), od, 0, 0, 0);
#undef PK
}
__device__ __forceinline__ void pv_d0(f32x16* o, int vb, bf16x8 pa0, bf16x8 pa1, bf16x8 pa2, bf16x8 pa3) {
    pv_one<0>(o[0], vb, pa0, pa1, pa2, pa3); pv_one<1>(o[1], vb, pa0, pa1, pa2, pa3); pv_one<2>(o[2], vb, pa0, pa1, pa2, pa3); pv_one<3>(o[3], vb, pa0, pa1, pa2, pa3);
}
__device__ __forceinline__ void mask_tile(f32x16& p0, f32x16& p1, int j, int lim) {
    if (j > lim) {
#pragma unroll
        for (int r = 0; r < 16; ++r) { p0[r] = -1e30f; p1[r] = -1e30f; }
    } else if (j == 0) {
#pragma unroll
        for (int r = 0; r < 16; ++r) p0[r] = -1e30f;
#pragma unroll
        for (int r = 0; r < 8; ++r) p1[r] = -1e30f;
    }
}
__device__ __forceinline__ void unit(const bf16_t* __restrict__ Qb, const bf16_t* __restrict__ Kh, const bf16_t* __restrict__ Vh, bf16_t* __restrict__ Ob, int NT, int lim, char* lds) {
    int tid_ = threadIdx.x; asm volatile("" : "+v"(tid_));
    const int tid = tid_, wid = tid >> 6, lane = tid & 63, r32 = lane & 31, hi = lane >> 5;
    char* V_lds = lds; char* K_lds = lds + 2 * SHM_V;
    float* wsf = (float*)(lds + 2 * SHM_V + 2 * SHM_K) + wid * 64; float* li_l = wsf; float* al_l = wsf + 32;
    float m_reg = -1e30f, l_reg = 0; f32x16 o[4] = {}; bf16x8 qr[8];
    const bf16_t* Qw = Qb + (long)(wid * QBLK + r32) * LDQ + hi * 8;
#pragma unroll
    for (int d0 = 0; d0 < 8; ++d0) qr[d0] = *reinterpret_cast<const bf16x8*>(Qw + d0 * 16);
    const int sr = tid >> 4, sc = (tid & 15) * 8, vst0 = v_st(sr, sc), vst1 = v_st(32 + sr, sc);
    const int vb0 = (int)(uintptr_t)V_lds + v_rd_base(lane);
    struct { bf16x8 vs0, vs1, ks0, ks1; } sr_[2];
#define SLOAD(i, k0) do { sr_[i].vs0 = *reinterpret_cast<const bf16x8*>(&Vh[(long)((k0) + sr) * LDQ + sc]); sr_[i].vs1 = *reinterpret_cast<const bf16x8*>(&Vh[(long)((k0) + 32 + sr) * LDQ + sc]); \
    sr_[i].ks0 = *reinterpret_cast<const bf16x8*>(&Kh[(long)((k0) + sr) * LDQ + sc]); sr_[i].ks1 = *reinterpret_cast<const bf16x8*>(&Kh[(long)((k0) + 32 + sr) * LDQ + sc]); } while (0)
#define SWRITE(b, i) do { *(bf16x8*)(V_lds + (b) * SHM_V + vst0) = sr_[i].vs0;          \
    *(bf16x8*)(V_lds + (b) * SHM_V + vst1) = sr_[i].vs1; int kc = sc * 2;               \
    *(bf16x8*)(K_lds + (b) * SHM_K + KSWZ(sr, kc)) = sr_[i].ks0;                       \
    *(bf16x8*)(K_lds + (b) * SHM_K + KSWZ(32 + sr, kc)) = sr_[i].ks1; } while (0)
#define SWAIT() asm volatile("s_waitcnt vmcnt(4)" ::: "memory")
#define RESC(a) do { if (__any((a) < 1.f)) { if (hi == 0) al_l[r32] = (a); asm volatile("s_waitcnt lgkmcnt(0)" ::: "memory"); \
    _Pragma("unroll") for (int d = 0; d < 4; ++d) _Pragma("unroll") for (int r = 0; r < 16; ++r) o[d][r] *= al_l[crow(r, hi)]; } } while (0)
    f32x16 pA0, pA1, pB0, pB1; float mnA, mnB, alA, alB; bf16x8 pa0, pa1, pa2, pa3;
    constexpr int SE = 0, SO = 1;
    SLOAD(SE, 0); asm volatile("s_waitcnt vmcnt(0)" ::: "memory"); SWRITE(0, SE); __syncthreads();
    qkt(pA0, pA1, K_lds, qr, r32, hi); mask_tile(pA0, pA1, 0, lim); partialSM(pA0, pA1, m_reg, mnA, alA);
    SLOAD(SO, KVBLK); if (2 < NT) SLOAD(SE, 2 * KVBLK);
    SWAIT(); SWRITE(1, SO); __syncthreads();
    for (int j = 1; j + 1 < NT; j += 2) {
        SBAR(); qkt(pB0, pB1, K_lds + SHM_K, qr, r32, hi);
        finishSM(pA0, pA1, alA, l_reg, pa0, pa1, pa2, pa3); SBAR();
        SLOAD(SO, (j + 2) * KVBLK); SBAR();
        pv_d0(o, vb0, pa0, pa1, pa2, pa3); mask_tile(pB0, pB1, j, lim); partialSM(pB0, pB1, m_reg, mnB, alB);
        __syncthreads(); SWAIT(); SWRITE(0, SE);
        RESC(alB); __syncthreads();
        SBAR(); qkt(pA0, pA1, K_lds, qr, r32, hi);
        finishSM(pB0, pB1, alB, l_reg, pa0, pa1, pa2, pa3); SBAR();
        if (j + 3 < NT) SLOAD(SE, (j + 3) * KVBLK); SBAR();
        pv_d0(o, vb0 + SHM_V, pa0, pa1, pa2, pa3); mask_tile(pA0, pA1, j + 1, lim); partialSM(pA0, pA1, m_reg, mnA, alA);
        __syncthreads(); SWAIT(); SWRITE(1, SO);
        RESC(alA); __syncthreads();
    }
    SBAR(); qkt(pB0, pB1, K_lds + SHM_K, qr, r32, hi);
    finishSM(pA0, pA1, alA, l_reg, pa0, pa1, pa2, pa3); SBAR();
    pv_d0(o, vb0, pa0, pa1, pa2, pa3); mask_tile(pB0, pB1, NT - 1, lim); partialSM(pB0, pB1, m_reg, mnB, alB);
    __syncthreads(); RESC(alB);
    finishSM(pB0, pB1, alB, l_reg, pa0, pa1, pa2, pa3); SBAR();
    pv_d0(o, vb0 + SHM_V, pa0, pa1, pa2, pa3);
    if (hi == 0) li_l[r32] = l_reg; asm volatile("s_waitcnt lgkmcnt(0)" ::: "memory");
    float rli[16];
#pragma unroll
    for (int r = 0; r < 16; ++r) rli[r] = __builtin_amdgcn_rcpf(li_l[crow(r, hi)]);
    bf16_t* Ow = Ob + (long)(wid * QBLK) * LDO;
#pragma unroll
    for (int r = 0; r < 16; ++r) { const int orow = crow(r, hi);
#pragma unroll
        for (int d0 = 0; d0 < 4; ++d0) Ow[(long)orow * LDO + d0 * 32 + r32] = f2bf(o[d0][r] * rli[r]); }
    __syncthreads();
#undef SLOAD
#undef SWRITE
#undef SWAIT
#undef RESC
}
}

__device__ __forceinline__ void attn_phase(const Fr& F) {
    const bf16_t* Q = slotY(F, 0); const bf16_t* K = slotY(F, 1); const bf16_t* V = slotY(F, 2);
    bf16_t* AO = slotU(F, 1);
    const int x = F.bid & 7, j = (F.bid >> 3) & 31;
#pragma unroll 1
    for (int k = 0; k < 8; ++k) {
        if (F.bid >= 256) break;
        const int sub = 8 * x + k, head = sub >> 2, c = (sub >> 1) & 1, half = sub & 1;
        const bf16_t* Kp = K + head * 256 + c * 128; const bf16_t* Vp = V + head * 256 + half * 128;
#pragma unroll 1
        for (int u = 0; u < 2; ++u) {
            const int t = u == 0 ? 63 - j : j;
            const int row0 = 256 * t + 128;
            att::unit(Q + (size_t)row0 * D + head * 256 + c * 128, Kp, Vp, AO + (size_t)row0 * 8192 + head * 512 + c * 256 + half * 128, 4 * t + 6, 4 * t + 2 + (F.wave >> 1), (char*)F.ldsg);
        }
        if (j == 4 * k) att::unit(Q + head * 256 + c * 128, Kp, Vp, AO + head * 512 + c * 256 + half * 128, 4, F.wave >> 1, (char*)F.ldsg);
    }
}
__device__ __forceinline__ void attn_post(const Fr& F) {
    const bf16_t* AO = slotU(F, 1); const bf16_t* GT = slotY(F, 3); bf16_t* Z = slotU(F, 0);
    const float* sg = F.in(13);
    constexpr float LINIT = 0.35550906759096934f;
    float lam;
    { const float* q1 = F.in(9); const float* k1 = F.in(10); const float* q2 = F.in(11); const float* k2 = F.in(12);
      const float d1 = wave_sum(q1[F.lane] * k1[F.lane] + q1[F.lane + 64] * k1[F.lane + 64]), d2 = wave_sum(q2[F.lane] * k2[F.lane] + q2[F.lane + 64] * k2[F.lane + 64]);
      lam = expf(d1) - expf(d2) + LINIT; }
    const f32x4 g4 = ((const f32x4*)sg)[F.lane];
    for (int r = F.gw; r < R; r += F.NGW) {
        const bool real = (r >= NPAD && r < NREAL);
        u32x2* zr = (u32x2*)(Z + (size_t)r * D) + F.lane;
        if (!real) { const u32x2 z = {0u, 0u};
#pragma unroll
            for (int hd = 0; hd < 16; ++hd) zr[64 * hd] = z;
            continue; }
#pragma unroll 4
        for (int hd = 0; hd < 16; ++hd) {
            const u32x2 a0 = ((const u32x2*)(AO + (size_t)r * 8192 + hd * 512))[F.lane], a1 = ((const u32x2*)(AO + (size_t)r * 8192 + hd * 512 + 256))[F.lane];
            const u32x2 gt = ((const u32x2*)(GT + (size_t)r * D + hd * 256))[F.lane];
            const float o0 = bflo(a0.x) - lam * bflo(a1.x), o1 = bfhi(a0.x) - lam * bfhi(a1.x), o2 = bflo(a0.y) - lam * bflo(a1.y), o3 = bfhi(a0.y) - lam * bfhi(a1.y);
            const float ss = wave_sum((o0 * o0 + o1 * o1) + (o2 * o2 + o3 * o3));
            const float rs = __builtin_amdgcn_rsqf(ss * (1.f / 256.f) + 1e-5f) * (1.f - LINIT);
            u32x2 w; w.x = cvt_pk_bf16(o0 * rs * g4.x * silu_f(bflo(gt.x)), o1 * rs * g4.y * silu_f(bfhi(gt.x))); w.y = cvt_pk_bf16(o2 * rs * g4.z * silu_f(bflo(gt.y)), o3 * rs * g4.w * silu_f(bfhi(gt.y)));
            zr[64 * hd] = w;
        }
    }
}

constexpr int RW_TT = 32, RW_TOKF = 384, RW_TILEF = RW_TT * RW_TOKF, RW_NTILE = 513;
__device__ __forceinline__ void rwkv_scan_seq(const Fr& F) {
    const bf16_t* Rr = slotY(F, 0); const bf16_t* K = slotY(F, 1); const bf16_t* V = slotY(F, 2); const bf16_t* W = slotY(F, 4); const bf16_t* A = slotY(F, 5);
    float* O32 = (float*)slotU(F, 1);
    LAS float* ring = (LAS float*)F.lds; LAS float* otile = ring + 2 * RW_TILEF;
    const int tid = F.tid, lane = F.lane, wid = F.wave;
    for (int unit = F.bid; unit < 256; unit += F.G) {
        const int h = unit >> 2, rg = unit & 3;
        const int ptid = tid - 256, ptt = ptid >> 3, dg = ptid & 7;
        float kkc[8], kac[8];
        if (wid >= 4) {
#pragma unroll
            for (int i = 0; i < 8; ++i) { kkc[i] = F.in(23)[h * 64 + 8 * dg + i]; kac[i] = F.in(24)[h * 64 + 8 * dg + i]; }
        }
        float S0 = 0.f, S1 = 0.f, S2 = 0.f, S3 = 0.f;
        const int cg = lane & 15, irow = 4 * wid + (lane >> 4);
#define RW_PRODUCE(m, buf) do { const int row = NPAD + 32 * (m) + ptt; const size_t off = (size_t)row * D + h * 64 + 8 * dg; \
        const u32x4 r8 = *(const u32x4*)(Rr + off), k8 = *(const u32x4*)(K + off), v8 = *(const u32x4*)(V + off), w8 = *(const u32x4*)(W + off), a8 = *(const u32x4*)(A + off); \
        const unsigned rw[4] = {r8.x, r8.y, r8.z, r8.w}, kw[4] = {k8.x, k8.y, k8.z, k8.w}, vw[4] = {v8.x, v8.y, v8.z, v8.w}, ww[4] = {w8.x, w8.y, w8.z, w8.w}, aw[4] = {a8.x, a8.y, a8.z, a8.w}; \
        float rf[8], kf[8], vf[8], wf[8], af[8], kk[8]; float ssq = 0.f; \
        _Pragma("unroll") for (int i = 0; i < 4; ++i) { rf[2 * i] = bflo(rw[i]); rf[2 * i + 1] = bfhi(rw[i]); kf[2 * i] = bflo(kw[i]); kf[2 * i + 1] = bfhi(kw[i]); vf[2 * i] = bflo(vw[i]); vf[2 * i + 1] = bfhi(vw[i]); \
            wf[2 * i] = bflo(ww[i]); wf[2 * i + 1] = bfhi(ww[i]); af[2 * i] = bflo(aw[i]); af[2 * i + 1] = bfhi(aw[i]); } \
        _Pragma("unroll") for (int i = 0; i < 8; ++i) { kk[i] = kf[i] * kkc[i]; ssq += kk[i] * kk[i]; } \
        ssq = red8(ssq); const float inv = 1.f / fmaxf(sqrtf(ssq), 1e-12f); \
        LAS float* tb = ring + (buf) * RW_TILEF + ptt * RW_TOKF; \
        _Pragma("unroll") for (int q = 0; q < 2; ++q) { LAS f32x4* p = (LAS f32x4*)(tb + (2 * dg + q) * 20); \
            f32x4 t0, t1, t2, t3, t4; \
            _Pragma("unroll") for (int e = 0; e < 4; ++e) { const int i = 4 * q + e; const float kn = kk[i] * inv; t0[e] = wf[i]; t1[e] = -kn; t2[e] = kn * af[i]; t3[e] = kf[i] * (1.f + (af[i] - 1.f) * kac[i]); t4[e] = rf[i]; } \
            p[0] = t0; p[1] = t1; p[2] = t2; p[3] = t3; p[4] = t4; } \
        LAS f32x4* pv = (LAS f32x4*)(tb + 320 + 8 * dg); pv[0] = (f32x4){vf[0], vf[1], vf[2], vf[3]}; pv[1] = (f32x4){vf[4], vf[5], vf[6], vf[7]}; } while (0)
#define RW_FLUSH(m, buf) do { const int row = NPAD + 32 * (m) + ptt; if (row < NREAL) { const LAS float* ot = otile + (buf) * 512 + ptt * 16 + 2 * dg; \
        *(float2*)(O32 + (size_t)row * D + h * 64 + 16 * rg + 2 * dg) = make_float2(ot[0], ot[1]); } } while (0)
        if (wid >= 4) RW_PRODUCE(0, 0);
        __syncthreads();
        for (int n = 0; n < RW_NTILE; ++n) {
            if (wid < 4) {
                const LAS float* tb = ring + (n & 1) * RW_TILEF; LAS float* ot = otile + (n & 1) * 512;
#pragma unroll 4
                for (int tt = 0; tt < RW_TT; ++tt) {
                    const LAS float* p = tb + tt * RW_TOKF + cg * 20;
                    const f32x4 w4 = *(const LAS f32x4*)p, nk = *(const LAS f32x4*)(p + 4), ka = *(const LAS f32x4*)(p + 8), kp = *(const LAS f32x4*)(p + 12), r4 = *(const LAS f32x4*)(p + 16);
                    const float v = tb[tt * RW_TOKF + 320 + 16 * rg + irow];
                    float sa = (S0 * nk.x + S1 * nk.y) + (S2 * nk.z + S3 * nk.w);
                    sa = red16(sa);
                    S0 = S0 * w4.x + (sa * ka.x + v * kp.x); S1 = S1 * w4.y + (sa * ka.y + v * kp.y); S2 = S2 * w4.z + (sa * ka.z + v * kp.z); S3 = S3 * w4.w + (sa * ka.w + v * kp.w);
                    float o = (S0 * r4.x + S1 * r4.y) + (S2 * r4.z + S3 * r4.w);
                    o = red16(o);
                    if (cg == 0) ot[tt * 16 + irow] = o;
                }
            } else {
                if (n + 1 < RW_NTILE) RW_PRODUCE(n + 1, (n + 1) & 1);
                if (n > 0) RW_FLUSH(n - 1, (n - 1) & 1);
            }
            __syncthreads();
        }
        if (wid >= 4) RW_FLUSH(RW_NTILE - 1, (RW_NTILE - 1) & 1);
        __syncthreads();
#undef RW_PRODUCE
#undef RW_FLUSH
    }
}

#ifndef RC_SYNC
#define RC_SYNC 0
#endif
constexpr int RC_SLOT = 13312, RC_NSLOT = 8, RC_SCR0 = RC_NSLOT * RC_SLOT, RC_SCR = 5632, RC_FLAGS = RC_SCR0 + 7 * RC_SCR, RC_NCH = 1025;
constexpr int RC_AT = 0, RC_RT = 2176, RC_BTT = 4352, RC_KTT = 6912, RC_TT = 9472, RC_G3F = 9984, RC_VTF = 10496, RC_P1 = 11008, RC_P2 = 12032, RC_WC = 13056;
static_assert(RC_FLAGS + 64 <= 147456 - 256, "rwkv LDS map");
typedef short s16x4v __attribute__((ext_vector_type(4)));
__device__ __forceinline__ void rwkv_kknorm(const Fr& F) {
    const bf16_t* K = slotY(F, 1); const float* k_k = F.in(23); float* INV = (float*)(F.ws + WS_HE);
    for (int r = F.gw; r < R; r += F.NGW) {
#pragma unroll 4
        for (int it = 0; it < 16; ++it) {
            const size_t ci = (size_t)it * 64 + F.lane;
            const u32x2 kk = ((const u32x2*)(K + (size_t)r * D))[ci]; const f32x4 c4 = ((const f32x4*)k_k)[ci];
            const float a = bflo(kk.x) * c4.x, b = bfhi(kk.x) * c4.y, c = bflo(kk.y) * c4.z, d = bfhi(kk.y) * c4.w;
            const float ss = red16((a * a + b * b) + (c * c + d * d));
            if ((F.lane & 15) == 0) INV[(size_t)r * 64 + it * 4 + (F.lane >> 4)] = 1.f / fmaxf(sqrtf(ss), 1e-12f);
        }
    }
}
__device__ __forceinline__ unsigned lds_poll(volatile LAS unsigned* p) { return *p; }
__device__ __forceinline__ void rwkv_scan(const Fr& F) {
    const bf16_t* Rr = slotY(F, 0); const bf16_t* K = slotY(F, 1); const bf16_t* V = slotY(F, 2); const bf16_t* W = slotY(F, 4); const bf16_t* A = slotY(F, 5);
    const float* INV = (const float*)(F.ws + WS_HE);
    float* O32 = (float*)slotU(F, 1);
    LAS unsigned char* L = F.lds;
    volatile LAS unsigned* flags = (volatile LAS unsigned*)(L + RC_FLAGS);
    const int lane = F.lane, wid = F.wave, l15 = lane & 15, kg = lane >> 4;
    for (int unit = F.bid; unit < 256; unit += F.G) {
        const int h = unit >> 2, rgw = unit & 3;
        if (F.tid < 16) flags[F.tid] = 0u;
        __syncthreads();
        if (wid == 0) {
            __builtin_amdgcn_s_setprio(3);
            f32x4 S0 = {0.f, 0.f, 0.f, 0.f}, S1 = S0, S2 = S0, S3 = S0;
            for (int n = 0; n < RC_NCH; ++n) {
                const int slot = n & 7; const LAS unsigned char* SL = L + slot * RC_SLOT;
#if RC_SYNC
                if (n % 7 == 0) { __builtin_amdgcn_s_barrier(); __builtin_amdgcn_s_barrier(); }
#else
                { unsigned sp = 0; while (lds_poll(flags + slot) != (unsigned)(n + 1)) { __builtin_amdgcn_s_sleep(1); if (++sp > (1u << 22)) break; } }
#endif
                asm volatile("s_waitcnt lgkmcnt(0)" ::: "memory");
                u32x4 sb0, sb1; sb0.x = cvt_pk_bf16(S0.x, S0.y); sb0.y = cvt_pk_bf16(S0.z, S0.w); sb0.z = cvt_pk_bf16(S1.x, S1.y); sb0.w = cvt_pk_bf16(S1.z, S1.w);
                sb1.x = cvt_pk_bf16(S2.x, S2.y); sb1.y = cvt_pk_bf16(S2.z, S2.w); sb1.z = cvt_pk_bf16(S3.x, S3.y); sb1.w = cvt_pk_bf16(S3.z, S3.w);
                const bf16x8 Sb0 = *reinterpret_cast<bf16x8*>(&sb0), Sb1 = *reinterpret_cast<bf16x8*>(&sb1);
                const LAS unsigned char* ap = SL + RC_AT + l15 * 136 + kg * 8; const LAS unsigned char* rp = SL + RC_RT + l15 * 136 + kg * 8;
                u32x2 a0l = *(const LAS u32x2*)(ap), a0h = *(const LAS u32x2*)(ap + 32), a1l = *(const LAS u32x2*)(ap + 64), a1h = *(const LAS u32x2*)(ap + 96);
                u32x2 r0l = *(const LAS u32x2*)(rp), r0h = *(const LAS u32x2*)(rp + 32), r1l = *(const LAS u32x2*)(rp + 64), r1h = *(const LAS u32x2*)(rp + 96);
                u32x4 t4;
                t4 = (u32x4){a0l.x, a0l.y, a0h.x, a0h.y}; const bf16x8 Aq0 = *reinterpret_cast<bf16x8*>(&t4);
                t4 = (u32x4){a1l.x, a1l.y, a1h.x, a1h.y}; const bf16x8 Aq1 = *reinterpret_cast<bf16x8*>(&t4);
                t4 = (u32x4){r0l.x, r0l.y, r0h.x, r0h.y}; const bf16x8 Rq0 = *reinterpret_cast<bf16x8*>(&t4);
                t4 = (u32x4){r1l.x, r1l.y, r1h.x, r1h.y}; const bf16x8 Rq1 = *reinterpret_cast<bf16x8*>(&t4);
                f32x4 X = *(const LAS f32x4*)(SL + RC_P1 + lane * 16), O = *(const LAS f32x4*)(SL + RC_P2 + lane * 16);
                const s16x4v ttf = *(const LAS s16x4v*)(SL + RC_TT + lane * 8);
                const s16x4v g3f = *(const LAS s16x4v*)(SL + RC_G3F + lane * 8), vtf = *(const LAS s16x4v*)(SL + RC_VTF + lane * 8);
                X = __builtin_amdgcn_mfma_f32_16x16x32_bf16(Aq0, Sb0, X, 0, 0, 0);
                X = __builtin_amdgcn_mfma_f32_16x16x32_bf16(Aq1, Sb1, X, 0, 0, 0);
                O = __builtin_amdgcn_mfma_f32_16x16x32_bf16(Rq0, Sb0, O, 0, 0, 0);
                O = __builtin_amdgcn_mfma_f32_16x16x32_bf16(Rq1, Sb1, O, 0, 0, 0);
                u32x2 yb; yb.x = cvt_pk_bf16(X.x, X.y); yb.y = cvt_pk_bf16(X.z, X.w);
                f32x4 U = {0.f, 0.f, 0.f, 0.f};
                U = __builtin_amdgcn_mfma_f32_16x16x16bf16_1k(ttf, *reinterpret_cast<s16x4v*>(&yb), U, 0, 0, 0);
                u32x2 ub; ub.x = cvt_pk_bf16(U.x, U.y); ub.y = cvt_pk_bf16(U.z, U.w);
                const s16x4v Ub = *reinterpret_cast<s16x4v*>(&ub);
                O = __builtin_amdgcn_mfma_f32_16x16x16bf16_1k(g3f, Ub, O, 0, 0, 0);
                const LAS unsigned char* bp = SL + RC_BTT + l15 * 40 + kg * 8; const LAS unsigned char* kp = SL + RC_KTT + l15 * 40 + kg * 8;
                const s16x4v b0 = *(const LAS s16x4v*)(bp), b1 = *(const LAS s16x4v*)(bp + 640), b2 = *(const LAS s16x4v*)(bp + 1280), b3 = *(const LAS s16x4v*)(bp + 1920);
                const s16x4v k0 = *(const LAS s16x4v*)(kp), k1 = *(const LAS s16x4v*)(kp + 640), k2 = *(const LAS s16x4v*)(kp + 1280), k3 = *(const LAS s16x4v*)(kp + 1920);
                const LAS f32x4* wc = (const LAS f32x4*)(SL + RC_WC + kg * 16);
                const f32x4 w0 = wc[0], w1 = wc[4], w2 = wc[8], w3 = wc[12];
                S0 = __builtin_amdgcn_mfma_f32_16x16x16bf16_1k(k0, vtf, S0, 0, 0, 0); S1 = __builtin_amdgcn_mfma_f32_16x16x16bf16_1k(k1, vtf, S1, 0, 0, 0);
                S2 = __builtin_amdgcn_mfma_f32_16x16x16bf16_1k(k2, vtf, S2, 0, 0, 0); S3 = __builtin_amdgcn_mfma_f32_16x16x16bf16_1k(k3, vtf, S3, 0, 0, 0);
                S0 = __builtin_amdgcn_mfma_f32_16x16x16bf16_1k(b0, Ub, S0, 0, 0, 0); S1 = __builtin_amdgcn_mfma_f32_16x16x16bf16_1k(b1, Ub, S1, 0, 0, 0);
                S2 = __builtin_amdgcn_mfma_f32_16x16x16bf16_1k(b2, Ub, S2, 0, 0, 0); S3 = __builtin_amdgcn_mfma_f32_16x16x16bf16_1k(b3, Ub, S3, 0, 0, 0);
                S0 = S0 * w0; S1 = S1 * w1; S2 = S2 * w2; S3 = S3 * w3;
                asm volatile("s_waitcnt lgkmcnt(0)" ::: "memory");
                if (lane == 0) flags[8] = (unsigned)(n + 1);
                float* op = O32 + (size_t)(NPAD + 16 * n + 4 * kg) * D + h * 64 + 16 * rgw + l15;
                op[0] = O.x; op[D] = O.y; op[2 * D] = O.z; op[3 * D] = O.w;
            }
            __builtin_amdgcn_s_setprio(0);
        } else {
            const int p = wid - 1;
            LAS unsigned char* SC = L + RC_SCR0 + p * RC_SCR;
            const float kkc = F.in(23)[h * 64 + lane], kac = F.in(24)[h * 64 + lane];
            unsigned short cr[16], ck[16], cw[16], ca[16], nvq[4]; float civ[16];
#define RC_LOADS(nn) do { const int r0n = NPAD + 16 * (nn); \
                _Pragma("unroll") for (int e = 0; e < 4; ++e) nvq[e] = V[(size_t)(r0n + 4 * kg + e) * D + h * 64 + 16 * rgw + l15]; \
                _Pragma("unroll") for (int s = 0; s < 16; ++s) { const size_t off = (size_t)(r0n + s) * D + h * 64 + lane; cr[s] = Rr[off]; ck[s] = K[off]; cw[s] = W[off]; ca[s] = A[off]; civ[s] = INV[(size_t)(r0n + s) * 64 + h]; } } while (0)
            RC_LOADS(p);
            for (int n = p; n < RC_NCH; n += 7) {
                const int slot = n & 7; LAS unsigned char* SL = L + slot * RC_SLOT;
                unsigned short vq[4];
#pragma unroll
                for (int e = 0; e < 4; ++e) vq[e] = nvq[e];
#if RC_SYNC
                asm volatile("s_waitcnt lgkmcnt(0)" ::: "memory"); __builtin_amdgcn_s_barrier();
#else
                if (n >= 8) { unsigned sp = 0; while (lds_poll(flags + 8) < (unsigned)(n - 7)) { __builtin_amdgcn_s_sleep(2); if (++sp > (1u << 22)) break; } }
#endif
                asm volatile("" ::: "memory");
                float Wp = 1.f; unsigned btp[8], ktp[8];
#pragma unroll
                for (int hb = 0; hb < 2; ++hb) {
                    unsigned short rq[8], kq[8], wq[8], aq[8]; float iv[8];
#pragma unroll
                    for (int s = 0; s < 8; ++s) { rq[s] = cr[8 * hb + s]; kq[s] = ck[8 * hb + s]; wq[s] = cw[8 * hb + s]; aq[s] = ca[8 * hb + s]; iv[s] = civ[8 * hb + s]; }
                    float btv[8], ktv[8];
#pragma unroll
                    for (int s = 0; s < 8; ++s) {
                        const int t = 8 * hb + s;
                        const float rs = bf2f(rq[s]), ks = bf2f(kq[s]), wsv = bf2f(wq[s]), as = bf2f(aq[s]);
                        const float kk = ks * kkc * iv[s];
                        const float Wprev = Wp; Wp *= wsv; const float iW = __builtin_amdgcn_rcpf(Wp);
                        const float at = -kk * Wprev, rt = rs * Wp, bt = kk * as * iW, kt = ks * (1.f + (as - 1.f) * kac) * iW;
                        *(LAS bf16_t*)(SL + RC_AT + t * 136 + lane * 2) = f2bf(at); *(LAS bf16_t*)(SL + RC_RT + t * 136 + lane * 2) = f2bf(rt);
                        *(LAS bf16_t*)(SC + t * 136 + lane * 2) = f2bf(bt); *(LAS bf16_t*)(SC + 2176 + t * 136 + lane * 2) = f2bf(kt);
                        btv[s] = bt; ktv[s] = kt;
                    }
#pragma unroll
                    for (int s = 0; s < 4; ++s) { btp[4 * hb + s] = cvt_pk_bf16(btv[2 * s], btv[2 * s + 1]); ktp[4 * hb + s] = cvt_pk_bf16(ktv[2 * s], ktv[2 * s + 1]); }
                }
                {
                    LAS u32x2* bq = (LAS u32x2*)(SL + RC_BTT + lane * 40); LAS u32x2* kq2 = (LAS u32x2*)(SL + RC_KTT + lane * 40);
#pragma unroll
                    for (int q = 0; q < 4; ++q) { bq[q] = (u32x2){btp[2 * q], btp[2 * q + 1]}; kq2[q] = (u32x2){ktp[2 * q], ktp[2 * q + 1]}; }
                    *(LAS float*)(SL + RC_WC + lane * 4) = Wp;
                    u32x2 vt; vt.x = (unsigned)vq[0] | ((unsigned)vq[1] << 16); vt.y = (unsigned)vq[2] | ((unsigned)vq[3] << 16);
                    *(LAS u32x2*)(SL + RC_VTF + lane * 8) = vt;
                }
                if (n + 7 < RC_NCH) RC_LOADS(n + 7);
                asm volatile("s_waitcnt lgkmcnt(0)" ::: "memory");
                f32x4 G1 = {0.f, 0.f, 0.f, 0.f}, G2 = G1, G3 = G1, G4 = G1, G1t = G1;
#pragma unroll
                for (int ks = 0; ks < 2; ++ks) {
                    const bf16x8 fb = *(const LAS bf16x8*)(SC + l15 * 136 + (32 * ks + 8 * kg) * 2), fk = *(const LAS bf16x8*)(SC + 2176 + l15 * 136 + (32 * ks + 8 * kg) * 2);
                    const bf16x8 fa = *(const LAS bf16x8*)(SL + RC_AT + l15 * 136 + (32 * ks + 8 * kg) * 2), fr_ = *(const LAS bf16x8*)(SL + RC_RT + l15 * 136 + (32 * ks + 8 * kg) * 2);
                    G1 = __builtin_amdgcn_mfma_f32_16x16x32_bf16(fb, fa, G1, 0, 0, 0); G2 = __builtin_amdgcn_mfma_f32_16x16x32_bf16(fk, fa, G2, 0, 0, 0);
                    G1t = __builtin_amdgcn_mfma_f32_16x16x32_bf16(fa, fb, G1t, 0, 0, 0);
                    G3 = __builtin_amdgcn_mfma_f32_16x16x32_bf16(fb, fr_, G3, 0, 0, 0); G4 = __builtin_amdgcn_mfma_f32_16x16x32_bf16(fk, fr_, G4, 0, 0, 0);
                }
                {
#pragma unroll
                    for (int e = 0; e < 4; ++e) { const int s = 4 * kg + e; const bool lt = s < l15, le = s <= l15;
                        G1[e] = lt ? G1[e] : 0.f; G1t[e] = (l15 < s) ? G1t[e] : 0.f; G2[e] = lt ? G2[e] : 0.f; G3[e] = le ? G3[e] : 0.f; G4[e] = le ? G4[e] : 0.f; }
                    u32x2 g2, g3, g4; g2.x = cvt_pk_bf16(G2.x, G2.y); g2.y = cvt_pk_bf16(G2.z, G2.w); g3.x = cvt_pk_bf16(G3.x, G3.y); g3.y = cvt_pk_bf16(G3.z, G3.w); g4.x = cvt_pk_bf16(G4.x, G4.y); g4.y = cvt_pk_bf16(G4.z, G4.w);
                    *(LAS u32x2*)(SL + RC_G3F + lane * 8) = g3;
                    u32x2 vt; vt.x = (unsigned)vq[0] | ((unsigned)vq[1] << 16); vt.y = (unsigned)vq[2] | ((unsigned)vq[3] << 16);
                    const s16x4v vtf = *reinterpret_cast<s16x4v*>(&vt);
                    f32x4 P1 = {0.f, 0.f, 0.f, 0.f}, P2 = P1;
                    P1 = __builtin_amdgcn_mfma_f32_16x16x16bf16_1k(*reinterpret_cast<s16x4v*>(&g2), vtf, P1, 0, 0, 0);
                    P2 = __builtin_amdgcn_mfma_f32_16x16x16bf16_1k(*reinterpret_cast<s16x4v*>(&g4), vtf, P2, 0, 0, 0);
                    *(LAS f32x4*)(SL + RC_P1 + lane * 16) = P1; *(LAS f32x4*)(SL + RC_P2 + lane * 16) = P2;
#define RC_BF(v) ({ u32x2 t_; t_.x = cvt_pk_bf16((v).x, (v).y); t_.y = cvt_pk_bf16((v).z, (v).w); *reinterpret_cast<s16x4v*>(&t_); })
                    const f32x4 Z4 = {0.f, 0.f, 0.f, 0.f};
                    const s16x4v n1 = RC_BF(G1), n1t = RC_BF(G1t);
                    const f32x4 X2 = __builtin_amdgcn_mfma_f32_16x16x16bf16_1k(n1t, n1, Z4, 0, 0, 0), X2t = __builtin_amdgcn_mfma_f32_16x16x16bf16_1k(n1, n1t, Z4, 0, 0, 0);
                    const s16x4v n2 = RC_BF(X2), n2t = RC_BF(X2t);
                    const f32x4 X4 = __builtin_amdgcn_mfma_f32_16x16x16bf16_1k(n2t, n2, Z4, 0, 0, 0), X4t = __builtin_amdgcn_mfma_f32_16x16x16bf16_1k(n2, n2t, Z4, 0, 0, 0);
                    const s16x4v n4 = RC_BF(X4), n4t = RC_BF(X4t);
                    f32x4 Tm = __builtin_amdgcn_mfma_f32_16x16x16bf16_1k(n4t, n4, Z4, 0, 0, 0);
#pragma unroll
                    for (int e = 0; e < 4; ++e) Tm[e] += (4 * kg + e == l15) ? 1.f : 0.f;
                    Tm = __builtin_amdgcn_mfma_f32_16x16x16bf16_1k(n4t, RC_BF(Tm), Tm, 0, 0, 0);
                    Tm = __builtin_amdgcn_mfma_f32_16x16x16bf16_1k(n2t, RC_BF(Tm), Tm, 0, 0, 0);
                    Tm = __builtin_amdgcn_mfma_f32_16x16x16bf16_1k(n1t, RC_BF(Tm), Tm, 0, 0, 0);
                    { u32x2 tt; tt.x = cvt_pk_bf16(Tm.x, Tm.y); tt.y = cvt_pk_bf16(Tm.z, Tm.w); *(LAS u32x2*)(SL + RC_TT + lane * 8) = tt; }
#undef RC_BF
                }
                asm volatile("s_waitcnt lgkmcnt(0)" ::: "memory");
#if RC_SYNC
                __builtin_amdgcn_s_barrier();
#else
                if (lane == 0) flags[slot] = (unsigned)(n + 1);
#endif
            }
#if RC_SYNC
            if (p >= RC_NCH % 7) { __builtin_amdgcn_s_barrier(); __builtin_amdgcn_s_barrier(); }
#endif
        }
#undef RC_LOADS
        __syncthreads();
    }
}
__device__ __forceinline__ void rwkv_post(const Fr& F) {
    const bf16_t* Rr = slotY(F, 0); const bf16_t* K = slotY(F, 1); const bf16_t* V = slotY(F, 2); const bf16_t* GT = slotY(F, 3); const bf16_t* A = slotY(F, 5);
    const float* O32 = (const float*)slotU(F, 1); bf16_t* Z = slotU(F, 0);
    const float* k_a = F.in(24); const float* r_k = F.in(25); const float* lw = F.in(26); const float* lb = F.in(27);
    for (int r = F.gw; r < R; r += F.NGW) {
        const bool real = (r >= NPAD && r < NREAL);
        u32x2* zr = (u32x2*)(Z + (size_t)r * D) + F.lane;
        if (!real) { const u32x2 z = {0u, 0u};
#pragma unroll
            for (int it = 0; it < 16; ++it) zr[64 * it] = z;
            continue; }
#pragma unroll 2
        for (int it = 0; it < 16; ++it) {
            const size_t ci = (size_t)it * 64 + F.lane;
            const f32x4 o4 = ((const f32x4*)(O32 + (size_t)r * D))[ci];
            const u32x2 rr = ((const u32x2*)(Rr + (size_t)r * D))[ci], kk = ((const u32x2*)(K + (size_t)r * D))[ci], vv = ((const u32x2*)(V + (size_t)r * D))[ci], gg = ((const u32x2*)(GT + (size_t)r * D))[ci], aa = ((const u32x2*)(A + (size_t)r * D))[ci];
            const f32x4 ka4 = ((const f32x4*)k_a)[ci], rk4 = ((const f32x4*)r_k)[ci], lw4 = ((const f32x4*)lw)[ci], lb4 = ((const f32x4*)lb)[ci];
            const float mean = red16((o4.x + o4.y) + (o4.z + o4.w)) * (1.f / 64.f);
            const float d0 = o4.x - mean, d1 = o4.y - mean, d2 = o4.z - mean, d3 = o4.w - mean;
            const float var = red16((d0 * d0 + d1 * d1) + (d2 * d2 + d3 * d3)) * (1.f / 64.f);
            const float rs = __builtin_amdgcn_rsqf(var + 64e-5f);
            const float r0 = bflo(rr.x), r1 = bfhi(rr.x), r2 = bflo(rr.y), r3 = bfhi(rr.y);
            const float kp0 = bflo(kk.x) * (1.f + (bflo(aa.x) - 1.f) * ka4.x), kp1 = bfhi(kk.x) * (1.f + (bfhi(aa.x) - 1.f) * ka4.y), kp2 = bflo(kk.y) * (1.f + (bflo(aa.y) - 1.f) * ka4.z), kp3 = bfhi(kk.y) * (1.f + (bfhi(aa.y) - 1.f) * ka4.w);
            const float bs = red16((r0 * kp0 * rk4.x + r1 * kp1 * rk4.y) + (r2 * kp2 * rk4.z + r3 * kp3 * rk4.w));
            const float y0 = d0 * rs * lw4.x + lb4.x + bs * bflo(vv.x), y1 = d1 * rs * lw4.y + lb4.y + bs * bfhi(vv.x), y2 = d2 * rs * lw4.z + lb4.z + bs * bflo(vv.y), y3 = d3 * rs * lw4.w + lb4.w + bs * bfhi(vv.y);
            u32x2 w; w.x = cvt_pk_bf16(y0 * silu_f(bflo(gg.x)), y1 * silu_f(bfhi(gg.x))); w.y = cvt_pk_bf16(y2 * silu_f(bflo(gg.y)), y3 * silu_f(bfhi(gg.y)));
            zr[64 * it] = w;
        }
    }
}
}
namespace mk {
constexpr int LDS_BYTES = 147456;
constexpr int LDS_MISC = LDS_BYTES - 128;
struct Args { const float* in[29]; float* out; unsigned char* ws; };

#define MK_GEMM(EPI, e, Aptr, aps_, Bptr, M_, N_, K_) do { int kk_ = (K_); asm volatile("" : "+s"(kk_));     \
    pg8::Gemm g_{(const bf16_t*)(Aptr), (const bf16_t*)(Bptr), (M_), (N_), kk_, (size_t)(aps_)}; pg8::StaticOrder S_; S_.init((M_), (N_), F.G, F.bid); \
    pg8::gemm_phase<EPI, pg8::StaticOrder, false>(F.lds, g_, S_, e, nullptr); } while (0)

struct TailOrder { int pn;
    __device__ bool next(int i, pg8::Unit& u) const { if (i > 0 || pn < 0) return false; u.pm = 64; u.pn = pn; return true; }
    __device__ __forceinline__ void a_ready(const pg8::Unit&) const {}
    __device__ __forceinline__ void done(const pg8::Unit&) const {}
};
#define MK_GEMM1(EPI, e, aps_, NTOT_, L_) do { MK_GEMM(EPI, e, slotU(F, 0), aps_, wtin_of(F, L_), 16384, NTOT_, D); \
    if (F.bid < (NTOT_) / 256) { int kk_ = D; asm volatile("" : "+s"(kk_)); pg8::Gemm g_{(const bf16_t*)slotU(F, 0), (const bf16_t*)wtin_of(F, L_), R, (NTOT_), kk_, (size_t)(aps_)}; TailOrder St_{F.bid}; \
        pg8::gemm_phase<EPI, TailOrder, false, true>(F.lds, g_, St_, e, nullptr); } } while (0)
#define MK_GEMM2_NORM(prev, next, udst) do { \
    MK_GEMM(EpiY, ey, slotU(F, 0), 0, wtout, 16384, D, D); \
    GRID_BAR(); \
    if (F.bid < 16) { int kk_ = D; asm volatile("" : "+s"(kk_)); pg8::Gemm g_{(const bf16_t*)slotU(F, 0), (const bf16_t*)wtout, R, D, kk_, (size_t)0}; TailOrder St_{F.bid}; \
        pg8::gemm_phase<EpiY, TailOrder, false>(F.lds, g_, St_, ey, nullptr); } \
    else { const Fr P = F.fresh(); norm_phase(P, prev, next, slotY(P, 0), udst, 0, 16384, 16); } \
    GRID_BAR(); \
    { const Fr P = F.fresh(); norm_phase(P, prev, next, slotY(P, 0), udst, 16384, R, 0); if ((next) >= 0) convert_layer(P, next, (next) == 3); } \
    GRID_BAR(); } while (0)

__global__ void __launch_bounds__(512, 2) fwd(Args a) {
    extern __shared__ __attribute__((aligned(16))) unsigned char lds_raw[];
    Fr F;
    F.lds = (LAS unsigned char*)lds_raw; F.ldsg = lds_raw;
    F.tid = threadIdx.x; F.lane = F.tid & 63; F.wave = __builtin_amdgcn_readfirstlane(F.tid >> 6);
    F.G = gridDim.x; F.bid = blockIdx.x; F.gw = F.bid * 8 + F.wave; F.NGW = F.G * 8;
    F.out = a.out; F.ws = a.ws;
    volatile LAS unsigned* misc = (volatile LAS unsigned*)(F.lds + LDS_MISC);
    if (F.tid < 16) misc[F.tid] = 0u;
    __syncthreads();
    XcdBarrier bar = xcd_barrier_post((unsigned*)(F.ws + WS_CTL) + 4096, misc + 8);
#define GRID_BAR() xcd_barrier(bar)
#ifndef MK_DUP
#define MK_DUP 0
#endif
#define DUPN(k, ...) do { __VA_ARGS__; if ((MK_DUP >> (k)) & 1) { GRID_BAR(); __VA_ARGS__; } } while (0)
    bf16_t* wtout = (bf16_t*)(F.ws + WS_WTOUT);
    const EpiY ey{slotY(F, 0)};

    DUPN(11, { const Fr P = F.fresh(); convert_layer(P, 0, true); rope_table(P); norm_phase(P, -1, 0, nullptr, slotU(P, 0)); });
    GRID_BAR();
    { const EpiH1 e{slotY(F, 0), F.in(5), 0}; MK_GEMM1(EpiH1, e, 0, 4 * D, 0); }
    if (F.bid >= 64) { const Fr P = F.fresh(); convert_win(P, 1, 64); }
    GRID_BAR();
    DUPN(1, { const Fr P = F.fresh(); hgrn_phase<false>(P, 0); });
    GRID_BAR();
    DUPN(2, { const Fr P = F.fresh(); hgrn_phase<true>(P, 0); });
    GRID_BAR();
    MK_GEMM2_NORM(0, 1, slotU(F, 0));
    { const EpiB1 e{slotY(F, 0), (const float*)(F.ws + WS_ROPE), (const float*)(F.ws + WS_ROPE) + (size_t)R * 16}; MK_GEMM1(EpiB1, e, 0, 4 * D, 1); }
    if (F.bid >= 64) { const Fr P = F.fresh(); convert_win(P, 2, 64); }
    GRID_BAR();
    DUPN(3, { const Fr P = F.fresh(); attn_phase(P); });
    GRID_BAR();
    DUPN(4, { const Fr P = F.fresh(); attn_post(P); });
    GRID_BAR();
    MK_GEMM2_NORM(1, 2, slotY(F, 1));
    DUPN(7, { const Fr P = F.fresh(); mix_phase(P, slotY(P, 1)); convert_layer2_b(P); });
    GRID_BAR();
    { const EpiC1 e{slotY(F, 0), (bf16_t*)(F.ws + WS_T)}; MK_GEMM(EpiC1, e, slotU(F, 0), (size_t)R * D, wtin_of(F, 2), R, 4 * D + 512, D); }
    GRID_BAR();
    DUPN(9, { const EpiC2 e{slotY(F, 0), F.in(17), F.in(20)}; MK_GEMM(EpiC2, e, F.ws + WS_T, 0, F.ws + WS_W2P, R, 2 * D, 256); });
    { const Fr P = F.fresh(); rwkv_kknorm(P); }
    GRID_BAR();
    DUPN(5, { const Fr P = F.fresh(); rwkv_scan(P); });
    GRID_BAR();
    DUPN(6, { const Fr P = F.fresh(); rwkv_post(P); });
    GRID_BAR();
    MK_GEMM2_NORM(2, 3, slotU(F, 0));
    { const EpiH1 e{slotY(F, 0), F.in(5), 1}; MK_GEMM1(EpiH1, e, 0, 4 * D, 3); }
    GRID_BAR();
    { const Fr P = F.fresh(); hgrn_phase<false>(P, 1); }
    GRID_BAR();
    { const Fr P = F.fresh(); hgrn_phase<true>(P, 1); }
    GRID_BAR();
    MK_GEMM2_NORM(3, -1, (bf16_t*)nullptr);
}
}

extern "C" void kernel_launch(void* const* d_in, const int* in_sizes, int n_in, void* d_out, int out_size, void* d_ws, size_t ws_size, hipStream_t stream) {
    static int grid = 0;
    if (grid == 0) {
        if (n_in != 29 || out_size != 16384 * 4096 || ws_size < mk::WS_END) { fprintf(stderr, "kernel_launch: unexpected shapes (n_in %d out %d ws %zu need %zu)\n", n_in, out_size, ws_size, (size_t)mk::WS_END); grid = -1; return; }
        int dev = 0, cus = 0, per_cu = 0;
        if (hipGetDevice(&dev) != hipSuccess || hipDeviceGetAttribute(&cus, hipDeviceAttributeMultiprocessorCount, dev) != hipSuccess) { grid = -1; return; }
        if (hipFuncSetAttribute((const void*)mk::fwd, hipFuncAttributeMaxDynamicSharedMemorySize, mk::LDS_BYTES) != hipSuccess) { fprintf(stderr, "kernel_launch: hipFuncSetAttribute failed\n"); grid = -1; return; }
        if (hipOccupancyMaxActiveBlocksPerMultiprocessor(&per_cu, (const void*)mk::fwd, 512, mk::LDS_BYTES) != hipSuccess || per_cu < 1) { fprintf(stderr, "kernel_launch: occupancy query says %d\n", per_cu); }
        (void)hipGetLastError();
        grid = cus;
    }
    if (grid < 0) return;
    if (hipMemsetAsync((char*)d_ws + mk::WS_CTL, 0, mk::CTL_BYTES, stream) != hipSuccess) return;
    mk::Args a{};
    for (int i = 0; i < 29; ++i) a.in[i] = (const float*)d_in[i];
    a.out = (float*)d_out; a.ws = (unsigned char*)d_ws;
    hipLaunchKernelGGL(mk::fwd, dim3(grid), dim3(512), mk::LDS_BYTES, stream, a);
}
```

```cpp
#include <hip/hip_runtime.h>
#include <cstdio>
#include <cstdint>

#define LAS __attribute__((address_space(3)))
#define GAS __attribute__((address_space(1)))
typedef unsigned short bf16_t;
typedef short bf16x8 __attribute__((ext_vector_type(8)));
typedef short s16x4 __attribute__((ext_vector_type(4)));
typedef float f32x4 __attribute__((ext_vector_type(4)));
typedef float f32x16 __attribute__((ext_vector_type(16)));
typedef unsigned u32x4 __attribute__((ext_vector_type(4)));
typedef unsigned u32x2 __attribute__((ext_vector_type(2)));

namespace mk {
constexpr int D = 4096, NPAD = 48, NREAL = 16448, R = 16640, NCH = 257;
constexpr size_t MiB = 1u << 20;
constexpr size_t SLOT = (size_t)R * D * 2;
constexpr size_t WS_CTL = 0, CTL_BYTES = 1 * MiB;
constexpr size_t WS_WTIN = 2 * MiB;
constexpr size_t WS_WTOUT = 134 * MiB;
constexpr size_t WS_W2P = 166 * MiB;
constexpr size_t WS_ROPE = 170 * MiB;
constexpr size_t WS_HMETA = 174 * MiB;
constexpr size_t WS_HE = 175 * MiB;
constexpr size_t WS_HLOGD = 191 * MiB;
constexpr size_t WS_U = 192 * MiB;
constexpr size_t WS_Y = WS_U + 6 * SLOT;
constexpr size_t WS_T = WS_Y + 6 * SLOT;
constexpr size_t WS_WTINB = WS_U + 4 * SLOT;
constexpr size_t WS_END = WS_T + (size_t)R * 256 * 2;
static_assert(WS_END <= 2040 * MiB, "d_ws map");

typedef __bf16 bf16x2n_t __attribute__((ext_vector_type(2)));
typedef float f32x2n_t __attribute__((ext_vector_type(2)));
__device__ __forceinline__ unsigned cvt_pk_bf16(float lo, float hi) { const f32x2n_t v = {lo, hi}; const bf16x2n_t r = __builtin_convertvector(v, bf16x2n_t); return __builtin_bit_cast(unsigned, r); }
__device__ __forceinline__ float bflo(unsigned w) { return __uint_as_float(w << 16); }
__device__ __forceinline__ float bfhi(unsigned w) { return __uint_as_float(w & 0xffff0000u); }
__device__ __forceinline__ float bf2f(bf16_t b) { return __uint_as_float(((unsigned)b) << 16); }
__device__ __forceinline__ bf16_t f2bf(float f) { return (bf16_t)(cvt_pk_bf16(f, f) & 0xffffu); }
__device__ __forceinline__ float sigmoid_f(float x) { return 1.f / (1.f + __expf(-x)); }
__device__ __forceinline__ float silu_f(float x) { return x / (1.f + __expf(-x)); }
__device__ __forceinline__ float wave_sum(float v) {
#pragma unroll
    for (int o = 1; o < 64; o <<= 1) v += __shfl_xor(v, o);
    return v;
}
template <int CTRL> __device__ __forceinline__ float dppf(float v) { return __int_as_float(__builtin_amdgcn_update_dpp(0, __float_as_int(v), CTRL, 0xf, 0xf, true)); }
__device__ __forceinline__ float red4(float v) { v += dppf<0xB1>(v); v += dppf<0x4E>(v); return v; }
__device__ __forceinline__ float red8(float v) { v = red4(v); v += dppf<0x141>(v); return v; }
__device__ __forceinline__ float red16(float v) { v = red8(v); v += dppf<0x140>(v); return v; }
#define LDS_WAIT() asm volatile("s_waitcnt lgkmcnt(0)" ::: "memory")
}
#define XB_TMO      128
#define XB_XCNT(j)  (256  + 64 * (j))
#define XB_XSUB(j)  (1280 + 64 * (j))
#define XB_XGEN(j)  (2304 + 64 * (j))
#define XB_TOP      3328
#define XB_TOPGEN   3392
#define XCD_BAR_WORDS 3456
#define XB_SPIN_CAP (1u << 18)
#define LAS __attribute__((address_space(3)))

__device__ __forceinline__ unsigned xb_ld(unsigned* p)              { return __hip_atomic_load(p, __ATOMIC_RELAXED, __HIP_MEMORY_SCOPE_AGENT); }
__device__ __forceinline__ unsigned xb_add(unsigned* p, unsigned v) { return __hip_atomic_fetch_add(p, v, __ATOMIC_RELAXED, __HIP_MEMORY_SCOPE_AGENT); }
__device__ __forceinline__ unsigned xb_xcc_id() { return (unsigned)__builtin_amdgcn_s_getreg((3 << 11) | 20) & 0xFu; }
#define XB_SPIN(cond, bar) do { unsigned _sp = 0; while (cond) { __builtin_amdgcn_s_sleep(1); \
    if ((++_sp & 255u) == 0u) { if (xb_ld(&(bar)[XB_TMO])) break; if (_sp > XB_SPIN_CAP) { atomicAdd(&(bar)[XB_TMO], 1u); break; } } } } while (0)

struct XcdBarrier {
    unsigned* bar; unsigned x;
    volatile LAS unsigned* st;
};

__device__ __forceinline__ XcdBarrier xcd_barrier_post(unsigned* bar, volatile LAS unsigned* st) {
    XcdBarrier b; b.bar = bar; b.x = xb_xcc_id(); b.st = st;
    if (threadIdx.x == 0) (void)xb_add(&bar[XB_XCNT(b.x)], 1u);
    return b;
}
__device__ __forceinline__ void xcd_barrier_complete(unsigned* bar, unsigned x, unsigned& nloc, unsigned& nx) {
    const unsigned G = gridDim.x * gridDim.y * gridDim.z;
    unsigned sum, cnt, mine, sp = 0u;
    for (;;) {
        sum = 0u; cnt = 0u; mine = 0u;
#pragma unroll
        for (unsigned j = 0; j < 16; ++j) { const unsigned c = xb_ld(&bar[XB_XCNT(j)]); sum += c; cnt += (c > 0u) ? 1u : 0u; mine = (j == x) ? c : mine; }
        if (sum == G) break;
        __builtin_amdgcn_s_sleep(1);
        if ((++sp & 255u) == 0u) { if (xb_ld(&bar[XB_TMO])) break; if (sp > XB_SPIN_CAP) { atomicAdd(&bar[XB_TMO], 1u); break; } }
    }
    nloc = mine > 0u ? mine : 1u; nx = cnt > 0u ? cnt : 1u;
}

__device__ __forceinline__ void xcd_barrier(const XcdBarrier& b) {
    asm volatile("s_waitcnt vmcnt(0)" ::: "memory");
    __syncthreads();
    if (threadIdx.x == 0) {
        unsigned* bar = b.bar;
        __builtin_amdgcn_s_waitcnt(0);
        unsigned nloc = b.st[0], nx = b.st[1];
        if (nloc == 0u) { xcd_barrier_complete(bar, b.x, nloc, nx); b.st[0] = nloc; b.st[1] = nx; }
        const unsigned old = xb_add(&bar[XB_XSUB(b.x)], 1u);
        const unsigned gen = old / nloc;
        if (old + 1u == (gen + 1u) * nloc) {
            __builtin_amdgcn_fence(__ATOMIC_RELEASE, "agent");
            asm volatile("s_waitcnt vmcnt(0)" ::: "memory");
            const unsigned og = xb_add(&bar[XB_TOP], 1u);
            const unsigned tg = og / nx;
            if (og + 1u == (tg + 1u) * nx) xb_add(&bar[XB_TOPGEN], 1u);
            else XB_SPIN(xb_ld(&bar[XB_TOPGEN]) == tg, bar);
            __builtin_amdgcn_fence(__ATOMIC_ACQUIRE, "agent");
            xb_add(&bar[XB_XGEN(b.x)], 1u);
            asm volatile("s_waitcnt vmcnt(0)" ::: "memory");
        } else {
            XB_SPIN(xb_ld(&bar[XB_XGEN(b.x)]) == gen, bar);
            __builtin_amdgcn_fence(__ATOMIC_ACQUIRE, "agent");
            asm volatile("s_waitcnt vmcnt(0)" ::: "memory");
        }
    }
    __syncthreads();
}
namespace pg8 {
#define PG8_LAS __attribute__((address_space(3)))
typedef unsigned short bf16_t;
typedef short bf16x8 __attribute__((ext_vector_type(8)));
typedef float f32x4 __attribute__((ext_vector_type(4)));
typedef unsigned u32x4 __attribute__((ext_vector_type(4)));
constexpr int BM = 256, BK = 64, HALF = 128, HTB = HALF * BK * 2  , STAGE_BYTES = 8 * HTB, NXCD = 8, WGM = 8;

__host__ __device__ __forceinline__ int lds_byte(int r, int c) { const int st = (r >> 4) * 2 + (c >> 5), rr = r & 15, cc = c & 31, ob = rr * 64 + cc * 2; return st * 1024 + (ob ^ (((ob >> 9) & 1) << 5)); }
__host__ __device__ __forceinline__ void stage_rc(int b, int& R, int& C) { const int st = b / 1024, sb = b % 1024, swz = sb ^ (((sb >> 9) & 1) << 5); R = (st >> 1) * 16 + swz / 64; C = (st & 1) * 32 + (swz % 64) / 2; }
__host__ __device__ __forceinline__ int perm32(int rho) { const int n = rho >> 4, i = rho & 15; return 8 * (i >> 2) + 4 * n + (i & 3); }

struct Unit { int pm, pn; };
struct Gemm { const bf16_t* A; const bf16_t* Bt; int M, N, K; size_t aps; };
__device__ __forceinline__ size_t a_part_bytes(const Gemm& g, int pn) { return g.aps ? (size_t)(pn < 64 ? (pn >> 4) : (pn - 60)) * g.aps * 2 : (size_t)0; }

struct StaticOrder {
    int nM, nN, nwg, G, c;
    __host__ __device__ void init(int M, int N, int G_, int c_) { nM = M / BM; nN = N / BM; nwg = nM * nN; G = G_; c = c_; }
    __host__ __device__ bool next(int i, Unit& u) const {
        const long L = (long)i * G + c; if (L >= nwg) return false;
        int wgid = (int)L; { const int q = nwg / NXCD, r = nwg % NXCD, xcd = wgid % NXCD, off = wgid / NXCD; wgid = (xcd < r ? xcd * (q + 1) : r * (q + 1) + (xcd - r) * q) + off; }
        const int nig = WGM * nN, gid = wgid / nig, fm = gid * WGM, gsz = (nM - fm) < WGM ? (nM - fm) : WGM;
        u.pm = fm + ((wgid % nig) % gsz); u.pn = (wgid % nig) / gsz; return true;
    }
    __device__ __forceinline__ void a_ready(const Unit&) const {}
    __device__ __forceinline__ void done(const Unit&) const {}
};
struct CountedOrder : StaticOrder {
    const unsigned* ready; unsigned need; unsigned* tmo;
    __device__ __forceinline__ void a_ready(const Unit& u) const {
        if (threadIdx.x < 64) {
            const unsigned long long t0 = __builtin_amdgcn_s_memrealtime(); unsigned polls = 0;
            while ((unsigned)__builtin_amdgcn_readfirstlane(__hip_atomic_load(ready + 64 * u.pm, __ATOMIC_RELAXED, __HIP_MEMORY_SCOPE_AGENT)) < need) {
                if ((++polls & 255u) == 0u && __builtin_amdgcn_readfirstlane(__hip_atomic_load(tmo, __ATOMIC_RELAXED, __HIP_MEMORY_SCOPE_AGENT)) != 0u) break;
                if (__builtin_amdgcn_s_memrealtime() - t0 > 2000000ull) {
                    if (threadIdx.x == 0) { unsigned expect = 0u; __hip_atomic_compare_exchange_strong(tmo + 1, &expect, 0x600u | (unsigned)(u.pm & 0xff), __ATOMIC_RELAXED, __ATOMIC_RELAXED, __HIP_MEMORY_SCOPE_AGENT); __hip_atomic_store(tmo, 1u, __ATOMIC_RELAXED, __HIP_MEMORY_SCOPE_AGENT); }
                    break; }
                __builtin_amdgcn_s_sleep(2); }
            __builtin_amdgcn_fence(__ATOMIC_ACQUIRE, "agent");
            asm volatile("s_waitcnt vmcnt(0)" ::: "memory");
        }
#if !defined(BROKEN_HOOK_NO_BARRIER)
        asm volatile("" ::: "memory"); __builtin_amdgcn_s_barrier(); asm volatile("" ::: "memory");
#endif
    }
};
template <class Epi, class Sched, bool STAMP = false, bool TOPHALF = false>
__device__ __forceinline__ void gemm_phase(PG8_LAS unsigned char* lds, const Gemm g, const Sched& S, const Epi& E, unsigned long long* stamps) {
    int tid_ = threadIdx.x; asm volatile("" : "+v"(tid_));
    const int tid = tid_, wid = __builtin_amdgcn_readfirstlane(tid >> 6), lane = tid & 63, wr = wid >> 2, wc = wid & 3, fr = lane & 15, fq = lane >> 4;
    const int K = g.K, nt = K / BK;
    int ts_lo = 0, ts_hi = 0, nts = 0; const unsigned long long rt_entry = STAMP ? (unsigned long long)wall_clock64() : 0ull;
#define PG8_STAMP() do { if (STAMP && wid == 0 && nts < 64) { const unsigned long long _c = (unsigned long long)clock64(); \
        ts_lo = (lane == nts) ? (int)(unsigned)_c : ts_lo; ts_hi = (lane == nts) ? (int)(unsigned)(_c >> 32) : ts_hi; ++nts; } } while (0)
    PG8_STAMP();
    unsigned voffA[2], voffB[2];
#pragma unroll
    for (int i = 0; i < 2; ++i) { int R, C; stage_rc(tid * 16 + i * 8192, R, C); const int Rb = Epi::PERM ? ((R & ~31) + perm32(R & 31)) : R;
        voffA[i] = (unsigned)(R * K + C) * 2u; voffB[i] = (unsigned)(Rb * K + C) * 2u; }
    const size_t kstep = (size_t)(BK * 2);
    const size_t hstep = (size_t)HALF * K * 2;
    const size_t tstep = 2 * hstep;
    const unsigned ldsw = (unsigned)wid * 1024u;
    const int aoff = lds_byte(wr * 64 + fr, fq * 8), boff = lds_byte(wc * 32 + fr, fq * 8);
#define PG8_SA(b, h) (((b) * 2 + (h)) * HTB)
#define PG8_SB(b, h) ((4 + (b) * 2 + (h)) * HTB)
#define PG8_STAGE(bufoff, gbase, voff) do { _Pragma("unroll") for (int _i = 0; _i < 2; ++_i) \
        __builtin_amdgcn_global_load_lds((const unsigned*)((const char*)(gbase) + (voff)[_i]), (PG8_LAS unsigned*)(lds + (bufoff) + ldsw + _i * 8192), 16, 0, 0); } while (0)
#define PG8_LDA(dst, b, h) do { _Pragma("unroll") for (int m = 0; m < 4; ++m) _Pragma("unroll") for (int k = 0; k < 2; ++k) dst[m][k] = *(const PG8_LAS bf16x8*)(lds + PG8_SA(b, h) + aoff + m * 2048 + k * 1024); } while (0)
#define PG8_LDB(dst, b, h) do { _Pragma("unroll") for (int n = 0; n < 2; ++n) _Pragma("unroll") for (int k = 0; k < 2; ++k) dst[n][k] = *(const PG8_LAS bf16x8*)(lds + PG8_SB(b, h) + boff + n * 2048 + k * 1024); } while (0)
#define PG8_MMA(ai, bj, At, Bt) do { __builtin_amdgcn_s_setprio(1); _Pragma("unroll") for (int m = 0; m < 4; ++m) _Pragma("unroll") for (int n = 0; n < 2; ++n) _Pragma("unroll") for (int k = 0; k < 2; ++k) \
        acc[ai][bj][m][n] = __builtin_amdgcn_mfma_f32_16x16x32_bf16(Bt[n][k], At[m][k], acc[ai][bj][m][n], 0, 0, 0); __builtin_amdgcn_s_setprio(0); } while (0)
#define PG8_WAIT_V(n) asm volatile("s_waitcnt vmcnt(" #n ")" ::: "memory")
#define PG8_WAIT_L(n) asm volatile("s_waitcnt lgkmcnt(" #n ")" ::: "memory")
#define PG8_BAR __builtin_amdgcn_s_barrier()
#define PG8_SCHED __builtin_amdgcn_sched_barrier(0)
    Unit cur, nxt; int ui = 0;
    if (!S.next(0, cur)) return;
    f32x4 acc[2][2][4][2];
#pragma unroll
    for (int a = 0; a < 2; ++a)
#pragma unroll
        for (int b = 0; b < 2; ++b)
#pragma unroll
            for (int m = 0; m < 4; ++m)
#pragma unroll
                for (int n = 0; n < 2; ++n) acc[a][b][m][n] = (f32x4){0.f, 0.f, 0.f, 0.f};
    bf16x8 At[4][2], B0[2][2], B1[2][2];
    const char* cA = (const char*)g.A + a_part_bytes(g, cur.pn) + (size_t)cur.pm * tstep; const char* cB = (const char*)g.Bt + (size_t)cur.pn * tstep;
    S.a_ready(cur);
    PG8_STAGE(PG8_SB(0, 0), cB, voffB); PG8_STAGE(PG8_SA(0, 0), cA, voffA); PG8_STAGE(PG8_SB(0, 1), cB + hstep, voffB); PG8_STAGE(PG8_SA(0, 1), cA + hstep, voffA);
    if (wr == 1) PG8_BAR;
    PG8_WAIT_V(4); PG8_BAR;
    PG8_STAGE(PG8_SB(1, 0), cB + kstep, voffB); PG8_STAGE(PG8_SA(1, 0), cA + kstep, voffA); PG8_STAGE(PG8_SB(1, 1), cB + hstep + kstep, voffB);
    PG8_WAIT_V(6); PG8_BAR;
    PG8_STAMP();
    for (;;) {
        const bool has_next = S.next(ui + 1, nxt);
        const char* nA = has_next ? (const char*)g.A + a_part_bytes(g, nxt.pn) + (size_t)nxt.pm * tstep : cA; const char* nB = has_next ? (const char*)g.Bt + (size_t)nxt.pn * tstep : cB;
        for (int t = 0; t < nt; t += 2) {
            const bool last = (t == nt - 2);
            const char* a1 = cA + (size_t)(t + 1) * kstep;
            const char* a2 = last ? nA : cA + (size_t)(t + 2) * kstep; const char* b2 = last ? nB : cB + (size_t)(t + 2) * kstep;
            const char* a3 = a2 + kstep; const char* b3 = b2 + kstep;
            if (last && has_next) S.a_ready(nxt);
            PG8_LDB(B0, 0, 0); PG8_SCHED; PG8_LDA(At, 0, 0); PG8_STAGE(PG8_SA(1, 1), a1 + hstep, voffA);
            PG8_WAIT_L(8); PG8_BAR; PG8_WAIT_L(0); PG8_MMA(0, 0, At, B0); PG8_BAR; PG8_SCHED;
            PG8_LDB(B1, 0, 1); PG8_STAGE(PG8_SB(0, 0), b2, voffB);
            PG8_BAR; PG8_WAIT_L(0); PG8_MMA(0, 1, At, B1); PG8_BAR;
            if constexpr (!TOPHALF) PG8_LDA(At, 0, 1); PG8_STAGE(PG8_SA(0, 0), a2, voffA);
            PG8_BAR; PG8_WAIT_L(0); if constexpr (!TOPHALF) PG8_MMA(1, 0, At, B0); PG8_BAR; PG8_SCHED;
            PG8_STAGE(PG8_SB(0, 1), b2 + hstep, voffB);
            PG8_WAIT_V(6); PG8_BAR; if constexpr (!TOPHALF) PG8_MMA(1, 1, At, B1); PG8_BAR;
            PG8_LDB(B0, 1, 0); PG8_SCHED; PG8_LDA(At, 1, 0); PG8_STAGE(PG8_SA(0, 1), a2 + hstep, voffA);
            PG8_WAIT_L(8); PG8_BAR; PG8_WAIT_L(0); PG8_MMA(0, 0, At, B0); PG8_BAR; PG8_SCHED;
            PG8_LDB(B1, 1, 1); PG8_STAGE(PG8_SB(1, 0), b3, voffB);
            PG8_BAR; PG8_WAIT_L(0); PG8_MMA(0, 1, At, B1); PG8_BAR;
            if constexpr (!TOPHALF) PG8_LDA(At, 1, 1); PG8_STAGE(PG8_SA(1, 0), a3, voffA);
            PG8_BAR; PG8_WAIT_L(0); if constexpr (!TOPHALF) PG8_MMA(1, 0, At, B0); PG8_BAR; PG8_SCHED;
            PG8_STAGE(PG8_SB(1, 1), b3 + hstep, voffB);
            PG8_WAIT_V(6); PG8_BAR; if constexpr (!TOPHALF) PG8_MMA(1, 1, At, B1); PG8_BAR;
        }
        PG8_STAMP();
        if constexpr (!Epi::AFTER_DRAIN) { E(acc, cur, wr, wc, fr, fq); S.done(cur); }
        PG8_STAMP();
        if (!has_next) break;
#pragma unroll
        for (int a = 0; a < 2; ++a)
#pragma unroll
            for (int b = 0; b < 2; ++b)
#pragma unroll
                for (int m = 0; m < 4; ++m)
#pragma unroll
                    for (int n = 0; n < 2; ++n) acc[a][b][m][n] = (f32x4){0.f, 0.f, 0.f, 0.f};
        cur = nxt; cA = nA; cB = nB; ++ui;
    }
    PG8_WAIT_V(0);
    if (wr == 0) PG8_BAR;
    PG8_BAR;
    if constexpr (Epi::AFTER_DRAIN) { E.fused(acc, cur, wr, wc, fr, fq, lds, wid, lane); S.done(cur); }
    PG8_STAMP();
    if (STAMP && wid == 0) { stamps[lane] = lane < nts ? (((unsigned long long)(unsigned)ts_hi << 32) | (unsigned)ts_lo) : 0ull;
        if (lane == 62) stamps[62] = rt_entry; if (lane == 63) stamps[63] = (unsigned long long)wall_clock64(); }
#undef PG8_STAMP
#undef PG8_SA
#undef PG8_SB
#undef PG8_STAGE
#undef PG8_LDA
#undef PG8_LDB
#undef PG8_MMA
#undef PG8_WAIT_V
#undef PG8_WAIT_L
#undef PG8_BAR
#undef PG8_SCHED
}
}
namespace mk {
typedef pg8::Unit Unit;
typedef const pg8::f32x4 (&AccRef)[2][2][4][2];

__device__ __forceinline__ void st_bf8(bf16_t* p, pg8::f32x4 v0, pg8::f32x4 v1) {
    u32x4 w; w.x = cvt_pk_bf16(v0[0], v0[1]); w.y = cvt_pk_bf16(v0[2], v0[3]); w.z = cvt_pk_bf16(v1[0], v1[1]); w.w = cvt_pk_bf16(v1[2], v1[3]);
    *(u32x4*)p = w;
}
__device__ __forceinline__ void st_bf4(bf16_t* p, pg8::f32x4 v) { u32x2 w; w.x = cvt_pk_bf16(v[0], v[1]); w.y = cvt_pk_bf16(v[2], v[3]); *(u32x2*)p = w; }

struct EpiY {
    static constexpr bool PERM = true, AFTER_DRAIN = false;
    bf16_t* O;
    __device__ __forceinline__ void operator()(AccRef acc, const Unit& u, int wr, int wc, int fr, int fq) const {
        const int row0 = u.pm * 256 + wr * 64 + fr, col0 = u.pn * 256 + wc * 32 + 8 * fq;
#pragma unroll
        for (int ai = 0; ai < 2; ++ai)
#pragma unroll
            for (int m = 0; m < 4; ++m) { bf16_t* rowp = O + (size_t)(row0 + ai * 128 + m * 16) * D + col0;
#pragma unroll
                for (int bj = 0; bj < 2; ++bj) st_bf8(rowp + bj * 128, acc[ai][bj][m][0], acc[ai][bj][m][1]); }
    }
};
struct EpiH1 {
    static constexpr bool PERM = true, AFTER_DRAIN = false;
    bf16_t* Y; const float* lbl; int jl;
    __device__ __forceinline__ void operator()(AccRef acc, const Unit& u, int wr, int wc, int fr, int fq) const {
        const int part = u.pn >> 4, colt = (u.pn & 15) * 256;
        const int row0 = u.pm * 256 + wr * 64 + fr, col0 = colt + wc * 32 + 8 * fq;
        if (part == 1) {
#pragma unroll
            for (int bj = 0; bj < 2; ++bj) {
                pg8::f32x4 lbv[2] = {{0.f, 0.f, 0.f, 0.f}, {0.f, 0.f, 0.f, 0.f}};
                if (jl) {
#pragma unroll
                    for (int n = 0; n < 2; ++n) { const pg8::f32x4 l0 = *(const pg8::f32x4*)(lbl + col0 + bj * 128 + 4 * n), l1 = *(const pg8::f32x4*)(lbl + D + col0 + bj * 128 + 4 * n);
#pragma unroll
                        for (int j = 0; j < 4; ++j) lbv[n][j] = sigmoid_f(l1[j] - l0[j]); }
                }
#pragma unroll
                for (int ai = 0; ai < 2; ++ai)
#pragma unroll
                    for (int m = 0; m < 4; ++m) {
                        const int row = row0 + ai * 128 + m * 16;
                        pg8::f32x4 o[2];
#pragma unroll
                        for (int n = 0; n < 2; ++n)
#pragma unroll
                            for (int j = 0; j < 4; ++j) {
                                const float x = acc[ai][bj][m][n][j]; float g;
                                if (jl) { const float l = lbv[n][j]; g = __logf(l + (1.f - l) * sigmoid_f(x)); }
                                else g = fminf(x, 0.f) - __logf(1.f + __expf(-fabsf(x)));
                                o[n][j] = (row < NPAD) ? 0.f : g;
                            }
                        float* gp = (float*)(Y + 3 * (SLOT / 2)) + (size_t)row * D + col0 + bj * 128;
                        *(pg8::f32x4*)gp = o[0]; *(pg8::f32x4*)(gp + 4) = o[1];
                    }
            }
        } else {
            bf16_t* dst = Y + (size_t)(part == 0 ? 0 : (part == 2 ? 1 : 2)) * (SLOT / 2);
#pragma unroll
            for (int ai = 0; ai < 2; ++ai)
#pragma unroll
                for (int m = 0; m < 4; ++m) { bf16_t* rowp = dst + (size_t)(row0 + ai * 128 + m * 16) * D + col0;
#pragma unroll
                    for (int bj = 0; bj < 2; ++bj) st_bf8(rowp + bj * 128, acc[ai][bj][m][0], acc[ai][bj][m][1]); }
        }
    }
};
struct EpiB1 {
    static constexpr bool PERM = false, AFTER_DRAIN = false;
    bf16_t* Y; const float* cs; const float* sn;
    __device__ __forceinline__ void operator()(AccRef acc, const Unit& u, int wr, int wc, int fr, int fq) const {
        const int part = u.pn >> 4, colt = (u.pn & 15) * 256;
        const int row0 = u.pm * 256 + wr * 64 + fr, col0 = colt + wc * 32 + 4 * fq;
        bf16_t* dst = Y + (size_t)part * (SLOT / 2);
        const bool rope = (part < 2) && (wc == 0);
#pragma unroll
        for (int ai = 0; ai < 2; ++ai)
#pragma unroll
            for (int m = 0; m < 4; ++m) {
                const int row = row0 + ai * 128 + m * 16;
                pg8::f32x4 c4 = {1.f, 1.f, 1.f, 1.f}, s4 = {0.f, 0.f, 0.f, 0.f};
                if (rope) { c4 = *(const pg8::f32x4*)(cs + (size_t)row * 16 + 4 * fq); s4 = *(const pg8::f32x4*)(sn + (size_t)row * 16 + 4 * fq); }
                bf16_t* rowp = dst + (size_t)row * D + col0;
#pragma unroll
                for (int bj = 0; bj < 2; ++bj) {
                    const pg8::f32x4 x1 = acc[ai][bj][m][0], x2 = acc[ai][bj][m][1];
                    const pg8::f32x4 y1 = x1 * c4 - x2 * s4, y2 = x2 * c4 + x1 * s4;
                    st_bf4(rowp + bj * 128, y1); st_bf4(rowp + bj * 128 + 16, y2);
                }
            }
    }
};
struct EpiC1 {
    static constexpr bool PERM = true, AFTER_DRAIN = false;
    bf16_t *Y, *T;
    __device__ __forceinline__ void operator()(AccRef acc, const Unit& u, int wr, int wc, int fr, int fq) const {
        const int row0 = u.pm * 256 + wr * 64 + fr;
        if (u.pn < 64) {
            const int part = u.pn >> 4, col0 = (u.pn & 15) * 256 + wc * 32 + 8 * fq;
            bf16_t* dst = Y + (size_t)part * (SLOT / 2);
#pragma unroll
            for (int ai = 0; ai < 2; ++ai)
#pragma unroll
                for (int m = 0; m < 4; ++m) { bf16_t* rowp = dst + (size_t)(row0 + ai * 128 + m * 16) * D + col0;
#pragma unroll
                    for (int bj = 0; bj < 2; ++bj) st_bf8(rowp + bj * 128, acc[ai][bj][m][0], acc[ai][bj][m][1]); }
        } else {
            const int which = u.pn - 64, col0 = which * 128 + wc * 32 + 8 * fq;
#pragma unroll
            for (int ai = 0; ai < 2; ++ai)
#pragma unroll
                for (int m = 0; m < 4; ++m) {
                    pg8::f32x4 v0 = acc[ai][0][m][0], v1 = acc[ai][0][m][1];
                    if (which == 0) {
#pragma unroll
                        for (int j = 0; j < 4; ++j) { v0[j] = 1.f - 2.f / (1.f + __expf(2.f * v0[j])); v1[j] = 1.f - 2.f / (1.f + __expf(2.f * v1[j])); }
                    }
                    st_bf8(T + (size_t)(row0 + ai * 128 + m * 16) * 256 + col0, v0, v1);
                }
        }
    }
};
struct EpiC2 {
    static constexpr bool PERM = true, AFTER_DRAIN = false;
    bf16_t* Y; const float* w0; const float* a0;
    __device__ __forceinline__ void operator()(AccRef acc, const Unit& u, int wr, int wc, int fr, int fq) const {
        const int row0 = u.pm * 256 + wr * 64 + fr;
        const bool isw = u.pn < 16;
        const int col0 = (u.pn & 15) * 256 + wc * 32 + 8 * fq;
        bf16_t* dst = Y + (size_t)(isw ? 4 : 5) * (SLOT / 2); const float* bias = isw ? w0 : a0;
#pragma unroll
        for (int bj = 0; bj < 2; ++bj) {
            const pg8::f32x4 b0 = *(const pg8::f32x4*)(bias + col0 + bj * 128), b1 = *(const pg8::f32x4*)(bias + col0 + bj * 128 + 4);
#pragma unroll
            for (int ai = 0; ai < 2; ++ai)
#pragma unroll
                for (int m = 0; m < 4; ++m) {
                    pg8::f32x4 v0 = acc[ai][bj][m][0] + b0, v1 = acc[ai][bj][m][1] + b1;
#pragma unroll
                    for (int j = 0; j < 4; ++j) {
                        float s0 = sigmoid_f(v0[j]), s1 = sigmoid_f(v1[j]);
                        if (isw) { s0 = __expf(-0.606531f * s0); s1 = __expf(-0.606531f * s1); }
                        v0[j] = s0; v1[j] = s1;
                    }
                    st_bf8(dst + (size_t)(row0 + ai * 128 + m * 16) * D + col0 + bj * 128, v0, v1);
                    __builtin_amdgcn_sched_barrier(0);
                }
        }
    }
};

struct Fr {
    LAS unsigned char* lds; unsigned char* ldsg;
    int tid, lane, wave, G, bid, gw, NGW;
    float* out; unsigned char* ws;
    __device__ __forceinline__ Fr fresh() const { Fr P = *this; asm volatile("" : "+v"(P.tid)); P.lane = P.tid & 63; P.wave = __builtin_amdgcn_readfirstlane(P.tid >> 6); P.gw = P.bid * 8 + P.wave; return P; }
    __device__ __forceinline__ const float* in(int i) const {
        const __attribute__((address_space(4))) unsigned long long* ka = (const __attribute__((address_space(4))) unsigned long long*)__builtin_amdgcn_kernarg_segment_ptr();
        asm volatile("" : "+s"(ka));
        return (const float*)ka[i];
    }
};
__device__ __forceinline__ bf16_t* slotU(const Fr& F, int s) { return (bf16_t*)(F.ws + WS_U + (size_t)s * SLOT); }
__device__ __forceinline__ bf16_t* slotY(const Fr& F, int s) { return (bf16_t*)(F.ws + WS_Y + (size_t)s * SLOT); }
__device__ __forceinline__ float* hrow(const Fr& F, int r) { return r < 64 ? (float*)(F.ws + WS_HMETA) + (size_t)r * D : F.out + (size_t)(r - 64) * D; }

__device__ __forceinline__ void transpose_item(const float* W, int ldw, bf16_t* WT, int ldt, int koff, LAS float* scr, int kb, int nb, int lane) {
    const int k0 = 64 * kb, n0 = 32 * nb;
#pragma unroll 8
    for (int i = 0; i < 32; ++i) { const int kk = 2 * i + (lane >> 5); scr[kk * 33 + (lane & 31)] = W[(size_t)(k0 + kk) * ldw + n0 + (lane & 31)]; }
    LDS_WAIT(); asm volatile("" ::: "memory");
    const int c = lane & 7;
#pragma unroll
    for (int j = 0; j < 4; ++j) { const int n = (lane >> 3) + 8 * j; const LAS float* s = scr + (8 * c) * 33 + n;
        u32x4 o; o.x = cvt_pk_bf16(s[0 * 33], s[1 * 33]); o.y = cvt_pk_bf16(s[2 * 33], s[3 * 33]); o.z = cvt_pk_bf16(s[4 * 33], s[5 * 33]); o.w = cvt_pk_bf16(s[6 * 33], s[7 * 33]);
        *(u32x4*)(WT + (size_t)(n0 + n) * ldt + koff + k0 + 8 * c) = o; }
    LDS_WAIT(); asm volatile("" ::: "memory");
}
__device__ __forceinline__ void convert_matrix(const Fr& F, const float* W, int K, int N, bf16_t* WT, int ldt, int koff, int wg_skip = 0) {
    LAS float* scr = (LAS float*)(F.lds + F.wave * 8704);
    const int nblk = N / 32, nitems = (K / 64) * nblk;
    for (int it = F.gw - wg_skip * 8; it < nitems; it += F.NGW - wg_skip * 8) transpose_item(W, N, WT, ldt, koff, scr, it / nblk, it % nblk, F.lane);
}
__device__ __forceinline__ void zero_bytes(const Fr& F, void* p, size_t nbytes) {
    u32x4* q = (u32x4*)p; const size_t n = nbytes / 16; const u32x4 z = {0u, 0u, 0u, 0u};
    for (size_t i = (size_t)F.bid * 512 + F.tid; i < n; i += (size_t)F.G * 512) q[i] = z;
}
__device__ __forceinline__ bf16_t* wtin_of(const Fr& F, int L) { return (bf16_t*)(F.ws + ((L & 1) ? WS_WTINB : WS_WTIN)); }
__device__ __forceinline__ void convert_win(const Fr& F, int L, int wg_skip) {
    const float* src = (L == 0 || L == 3) ? F.in(4) + (size_t)(L ? 1 : 0) * D * 4 * D : (L == 1 ? F.in(8) : F.in(16));
    convert_matrix(F, src, D, 4 * D, wtin_of(F, L), D, 0, wg_skip);
}
__device__ __forceinline__ void convert_layer(const Fr& F, int L, bool with_win) {
    bf16_t* wtin = wtin_of(F, L); bf16_t* wtout = (bf16_t*)(F.ws + WS_WTOUT);
    if (with_win) convert_win(F, L, 0);
    if (L == 0 || L == 3) {
        convert_matrix(F, F.in(7) + (size_t)(L ? 1 : 0) * D * D, D, D, wtout, D, 0);
    } else if (L == 1) {
        convert_matrix(F, F.in(14), D, D, wtout, D, 0);
    } else {
        convert_matrix(F, F.in(28), D, D, wtout, D, 0);
        convert_matrix(F, F.in(18), D, 128, wtin + (size_t)16384 * D, D, 0);
        convert_matrix(F, F.in(21), D, 128, wtin + (size_t)16640 * D, D, 0);
        zero_bytes(F, wtin + (size_t)16512 * D, (size_t)128 * D * 2);
        zero_bytes(F, wtin + (size_t)16768 * D, (size_t)128 * D * 2);
        bf16_t* w2p = (bf16_t*)(F.ws + WS_W2P);
        zero_bytes(F, w2p, (size_t)8192 * 256 * 2);
    }
}
__device__ __forceinline__ void convert_layer2_b(const Fr& F) {
    bf16_t* w2p = (bf16_t*)(F.ws + WS_W2P);
    convert_matrix(F, F.in(19), 128, D, w2p, 256, 0);
    convert_matrix(F, F.in(22), 128, D, w2p + (size_t)4096 * 256, 256, 128);
}

__constant__ float c_inv_freq[16] = {1.0f, 0.44036659598350525f, 0.1939227432012558f, 0.08539710193872452f, 0.03760603070259094f, 0.01656043902039528f, 0.007292664609849453f, 0.0032114458736032248f,
    0.0014142135623842478f, 0.000622772378847003f, 0.00027424818836152554f, 0.00012076973507646471f, 5.318296098266728e-05f, 2.34199997066753e-05f, 1.0313386155758053e-05f, 4.541670477919979e-06f};
__device__ __forceinline__ void rope_table(const Fr& F) {
    float* cs = (float*)(F.ws + WS_ROPE); float* sn = cs + (size_t)R * 16;
    for (int i = F.bid * 512 + F.tid; i < R * 16; i += F.G * 512) {
        const int row = i >> 4, j = i & 15; const int pos = row - NPAD;
        const double ang = (double)(float)((float)pos * c_inv_freq[j]);
        const double k = __builtin_rint(ang * 0.15915494309189535);
        double x = ang - k * 6.283185307179586;
        const double q = __builtin_rint(x * 0.6366197723675814);
        x -= q * 1.5707963267948966;
        const int qi = ((int)q) & 3;
        const double x2 = x * x;
        const double s = x * (1.0 + x2 * (-1.0 / 6 + x2 * (1.0 / 120 + x2 * (-1.0 / 5040 + x2 * (1.0 / 362880 + x2 * (-1.0 / 39916800))))));
        const double c = 1.0 + x2 * (-0.5 + x2 * (1.0 / 24 + x2 * (-1.0 / 720 + x2 * (1.0 / 40320 + x2 * (-1.0 / 3628800 + x2 * (1.0 / 479001600))))));
        double sv, cv;
        if (qi == 0) { sv = s; cv = c; } else if (qi == 1) { sv = c; cv = -s; } else if (qi == 2) { sv = -s; cv = -c; } else { sv = -c; cv = s; }
        cs[i] = (float)cv; sn[i] = (float)sv;
    }
}

typedef const GAS char* gcp; typedef GAS char* gp_;
#define ROW_F32(nm, base, lane) gp_ nm##0 = (gp_)(base) + (lane) * 16 + 4096; gp_ nm##1 = nm##0 + 8192; asm volatile("" : "+v"(nm##0), "+v"(nm##1))
#define AT_F32(nm, j) (*(GAS f32x4*)((j) < 8 ? nm##0 + ((j) - 4) * 1024 : nm##1 + ((j) - 12) * 1024))
#define ROW_BF(nm, base, lane) gp_ nm##0 = (gp_)(base) + (lane) * 8 + 4096; asm volatile("" : "+v"(nm##0))
#define AT_BF(nm, j) (*(GAS u32x2*)(nm##0 + (j) * 512 - 4096))
__device__ __forceinline__ void norm_phase(const Fr& F, int prev, int next, const bf16_t* y, bf16_t* udst, int rlo = 0, int rhi = R, int wg_skip = 0) {
    const float* postg = F.in(3) + (size_t)(prev < 0 ? 0 : prev) * D; const float* preg = F.in(2) + (size_t)(next < 0 ? 0 : next) * D;
    const float* xin = F.in(0); const float* meta = F.in(1);
    for (int r = rlo + F.gw - wg_skip * 8; r < rhi; r += F.NGW - wg_skip * 8) {
        if (r < NPAD || r >= NREAL) {
            if (next >= 0) { ROW_BF(uo, udst + (size_t)r * D, F.lane); const u32x2 z = {0u, 0u};
#pragma unroll
                for (int j = 0; j < 16; ++j) AT_BF(uo, j) = z; }
            continue;
        }
        float* hr = hrow(F, r);
        ROW_F32(hp, hr, F.lane);
        f32x4 hv[16];
        if (prev < 0) {
            const float* src = r < 64 ? meta + (size_t)(r - NPAD) * D : xin + (size_t)(r - 64) * D;
            ROW_F32(sp, src, F.lane);
#pragma unroll
            for (int j = 0; j < 16; ++j) hv[j] = AT_F32(sp, j);
        } else {
            ROW_BF(yp, y + (size_t)r * D, F.lane); ROW_F32(gp, postg, F.lane);
            u32x2 yv[16]; float ss = 0.f;
#pragma unroll
            for (int j = 0; j < 16; ++j) { yv[j] = AT_BF(yp, j); hv[j] = AT_F32(hp, j); }
#pragma unroll
            for (int j = 0; j < 16; ++j) { const float a = bflo(yv[j].x), b = bfhi(yv[j].x), c = bflo(yv[j].y), d = bfhi(yv[j].y); ss += (a * a + b * b) + (c * c + d * d); }
#pragma unroll
            for (int j = 0; j < 16; ++j) asm volatile("" : "+v"(yv[j].x), "+v"(yv[j].y));
            const float rs = __builtin_amdgcn_rsqf(wave_sum(ss) * (1.f / D) + 1e-6f);
#pragma unroll
            for (int j = 0; j < 16; ++j) { const f32x4 g = AT_F32(gp, j);
                hv[j].x += bflo(yv[j].x) * rs * g.x; hv[j].y += bfhi(yv[j].x) * rs * g.y; hv[j].z += bflo(yv[j].y) * rs * g.z; hv[j].w += bfhi(yv[j].y) * rs * g.w; }
        }
        if (next < 0) {
            if (r >= 64) {
#pragma unroll
                for (int j = 0; j < 16; ++j) AT_F32(hp, j) = hv[j];
            }
            continue;
        }
        float s2 = 0.f;
#pragma unroll
        for (int j = 0; j < 16; ++j) { AT_F32(hp, j) = hv[j]; s2 += (hv[j].x * hv[j].x + hv[j].y * hv[j].y) + (hv[j].z * hv[j].z + hv[j].w * hv[j].w); }
        const float rs2 = __builtin_amdgcn_rsqf(wave_sum(s2) * (1.f / D) + 1e-6f);
        ROW_BF(uo, udst + (size_t)r * D, F.lane); ROW_F32(pg, preg, F.lane);
#pragma unroll
        for (int j = 0; j < 16; ++j) { const f32x4 g = AT_F32(pg, j); u32x2 w; w.x = cvt_pk_bf16(hv[j].x * rs2 * g.x, hv[j].y * rs2 * g.y); w.y = cvt_pk_bf16(hv[j].z * rs2 * g.z, hv[j].w * rs2 * g.w); AT_BF(uo, j) = w; }
    }
}
__device__ __forceinline__ void mix_phase(const Fr& F, const bf16_t* u) {
    const float* mu = F.in(15);
    for (int r = F.gw; r < R; r += F.NGW) {
        const bool real = (r >= NPAD && r < NREAL);
        u32x2 cur[16], prv[16];
        const u32x2 z = {0u, 0u};
        { ROW_BF(cp, u + (size_t)r * D, F.lane); ROW_BF(pp, u + (size_t)(r > 0 ? r - 1 : 0) * D, F.lane);
#pragma unroll
          for (int j = 0; j < 16; ++j) { cur[j] = real ? AT_BF(cp, j) : z; prv[j] = (real && r > NPAD) ? AT_BF(pp, j) : z; } }
#pragma unroll 1
        for (int s = 0; s < 6; ++s) {
            ROW_BF(op, slotU(F, s) + (size_t)r * D, F.lane); ROW_F32(mp, mu + (size_t)s * D, F.lane);
#pragma unroll
            for (int j = 0; j < 16; ++j) {
                const f32x4 m = AT_F32(mp, j);
                const float c0 = bflo(cur[j].x), c1 = bfhi(cur[j].x), c2 = bflo(cur[j].y), c3 = bfhi(cur[j].y);
                const float p0 = bflo(prv[j].x), p1 = bfhi(prv[j].x), p2 = bflo(prv[j].y), p3 = bfhi(prv[j].y);
                u32x2 w; w.x = cvt_pk_bf16(c0 + (p0 - c0) * m.x, c1 + (p1 - c1) * m.y); w.y = cvt_pk_bf16(c2 + (p2 - c2) * m.z, c3 + (p3 - c3) * m.w);
                AT_BF(op, j) = real ? w : z;
            }
        }
    }
}
}
namespace mk {
constexpr int H_QE = 0, H_KE = 17408, H_KET = 34816, H_VT = 53248, H_PM = 71680, H_STB = 80896, H_VEC = 115712;
__device__ __forceinline__ bf16x8 ldfrag(const LAS unsigned char* base, int stride_b, int rb, int ks, int lane) {
    return *(const LAS bf16x8*)(base + (16 * rb + (lane & 15)) * stride_b + (32 * ks + 8 * (lane >> 4)) * 2);
}
template <bool OUT>
__device__ __forceinline__ void hgrn_phase(const Fr& F, int jl) {
    const bf16_t* Q = slotY(F, 0); const bf16_t* V = slotY(F, 1); const bf16_t* GT = slotY(F, 2); const float* Gg = (const float*)slotY(F, 3);
    bf16_t* Z = slotU(F, 0);
    float* HE = (float*)(F.ws + WS_HE); float* HLD = (float*)(F.ws + WS_HLOGD);
    const float* gn = F.in(6) + (size_t)jl * 128;
    LAS unsigned char* L = F.lds;
    LAS float* qtot = (LAS float*)(L + H_VEC); LAS float* ebm = qtot + 512; LAS float* ebl = ebm + 128;
    const int tid = F.tid, lane = F.lane, w = F.wave;
    const int d = tid & 127, qt = tid >> 7;
    for (int unit = F.bid; unit < 256; unit += F.G) {
        const int h = unit >> 3, seg = unit & 7;
        if (!OUT && seg == 7) continue;
        const int c0 = seg == 0 ? 0 : 33 + 32 * (seg - 1), c1 = c0 + (seg == 0 ? 33 : 32);
        f32x4 S[8];
#pragma unroll
        for (int i = 0; i < 8; ++i) S[i] = (f32x4){0.f, 0.f, 0.f, 0.f};
        if (OUT) {
            for (int j = 0; j < seg; ++j) {
                const float* ld = HLD + (size_t)(h * 8 + j) * 128; const float* e = HE + ((size_t)(h * 8 + j) * 512 + tid) * 32;
#pragma unroll
                for (int di = 0; di < 8; ++di) { const f32x4 l4 = *(const f32x4*)(ld + 16 * di + 4 * (lane >> 4)); const f32x4 e4 = *(const f32x4*)(e + 4 * di);
                    S[di].x = S[di].x * __expf(l4.x) + e4.x; S[di].y = S[di].y * __expf(l4.y) + e4.y; S[di].z = S[di].z * __expf(l4.z) + e4.z; S[di].w = S[di].w * __expf(l4.w) + e4.w; }
            }
        }
        float logD = 0.f;
        float g[16]; bf16_t qv[16], vv[16]; u32x4 gt0 = {0u, 0u, 0u, 0u}, gt1 = gt0, ngt0 = gt0, ngt1 = gt0;
#define HG_LOAD(cc) do { const int rowb_ = 64 * (cc) + 16 * qt; const size_t colb_ = (size_t)h * 128 + d; \
            _Pragma("unroll") for (int i = 0; i < 16; ++i) { g[i] = Gg[(size_t)(rowb_ + i) * D + colb_]; vv[i] = V[(size_t)(rowb_ + i) * D + colb_]; if (OUT) qv[i] = Q[(size_t)(rowb_ + i) * D + colb_]; } \
            if (OUT) { const bf16_t* gp_ = GT + (size_t)(64 * (cc) + (tid >> 3)) * D + h * 128 + 16 * (tid & 7); ngt0 = *(const u32x4*)gp_; ngt1 = *(const u32x4*)(gp_ + 8); } } while (0)
        HG_LOAD(c0);
        for (int c = c0; c < c1; ++c) {
            if (OUT) { gt0 = ngt0; gt1 = ngt1; }
            float b[16]; float run = 0.f;
#pragma unroll
            for (int i = 0; i < 16; ++i) { run += g[i]; b[i] = run; }
            qtot[qt * 128 + d] = run;
            __syncthreads();
            const float t0 = qtot[d], t1 = qtot[128 + d], t2 = qtot[256 + d], t3 = qtot[384 + d];
            const float off = qt == 0 ? 0.f : (qt == 1 ? t0 : (qt == 2 ? t0 + t1 : t0 + t1 + t2));
            const float bm = t0 + t1, bl = (t0 + t1) + (t2 + t3);
            if (qt == 0) { ebm[d] = __expf(bm); ebl[d] = __expf(bl); logD += bl; }
            {
                unsigned kt[8], vt[8];
#pragma unroll
                for (int i = 0; i < 16; i += 2) {
                    const float b0 = b[i] + off, b1 = b[i + 1] + off;
                    const float k0 = 1.f - __expf(g[i]), k1 = 1.f - __expf(g[i + 1]);
                    const int t = 16 * qt + i;
                    if (OUT) {
                        *(LAS bf16_t*)(L + H_QE + (t * 136 + d) * 2) = f2bf(bf2f(qv[i]) * __expf(b0 - bm));
                        *(LAS bf16_t*)(L + H_QE + ((t + 1) * 136 + d) * 2) = f2bf(bf2f(qv[i + 1]) * __expf(b1 - bm));
                        *(LAS bf16_t*)(L + H_KE + (t * 136 + d) * 2) = f2bf(k0 * __expf(bm - b0));
                        *(LAS bf16_t*)(L + H_KE + ((t + 1) * 136 + d) * 2) = f2bf(k1 * __expf(bm - b1));
                    }
                    kt[i >> 1] = cvt_pk_bf16(k0 * __expf(bl - b0), k1 * __expf(bl - b1));
                    vt[i >> 1] = (unsigned)vv[i] | ((unsigned)vv[i + 1] << 16);
                }
                LAS u32x4* kp = (LAS u32x4*)(L + H_KET + (d * 72 + 16 * qt) * 2); kp[0] = (u32x4){kt[0], kt[1], kt[2], kt[3]}; kp[1] = (u32x4){kt[4], kt[5], kt[6], kt[7]};
                LAS u32x4* vp = (LAS u32x4*)(L + H_VT + (d * 72 + 16 * qt) * 2); vp[0] = (u32x4){vt[0], vt[1], vt[2], vt[3]}; vp[1] = (u32x4){vt[4], vt[5], vt[6], vt[7]};
            }
            if (c + 1 < c1) HG_LOAD(c + 1);
            __syncthreads();
            if (OUT) {
#pragma unroll
                for (int di = 0; di < 8; ++di) { const f32x4 m4 = *(const LAS f32x4*)(ebm + 16 * di + 4 * (lane >> 4)); u32x2 o; o.x = cvt_pk_bf16(S[di].x * m4.x, S[di].y * m4.y); o.y = cvt_pk_bf16(S[di].z * m4.z, S[di].w * m4.w);
                    *(LAS u32x2*)(L + H_STB + ((16 * w + (lane & 15)) * 136 + 16 * di + 4 * (lane >> 4)) * 2) = o; }
                const int ti = w >> 1;
#pragma unroll
                for (int s2 = 0; s2 < 2; ++s2) { const int si = 2 * (w & 1) + s2; f32x4 p = {0.f, 0.f, 0.f, 0.f};
                    if (si <= ti) {
#pragma unroll
                        for (int ks = 0; ks < 4; ++ks) p = __builtin_amdgcn_mfma_f32_16x16x32_bf16(ldfrag(L + H_QE, 272, ti, ks, lane), ldfrag(L + H_KE, 272, si, ks, lane), p, 0, 0, 0);
                    }
                    const int sidx = 16 * si + (lane & 15);
#pragma unroll
                    for (int jj = 0; jj < 4; ++jj) { const int tidx = 16 * ti + 4 * (lane >> 4) + jj; *(LAS bf16_t*)(L + H_PM + (tidx * 72 + sidx) * 2) = f2bf(sidx <= tidx ? p[jj] : 0.f); }
                }
                __syncthreads();
            }
            f32x4 O[4];
            if (OUT) {
#pragma unroll
                for (int ti = 0; ti < 4; ++ti) O[ti] = (f32x4){0.f, 0.f, 0.f, 0.f};
#pragma unroll
                for (int ks = 0; ks < 2; ++ks) { const bf16x8 bv = ldfrag(L + H_VT, 144, w, ks, lane);
#pragma unroll
                    for (int ti = 0; ti < 4; ++ti) O[ti] = __builtin_amdgcn_mfma_f32_16x16x32_bf16(ldfrag(L + H_PM, 144, ti, ks, lane), bv, O[ti], 0, 0, 0); }
#pragma unroll
                for (int ks = 0; ks < 4; ++ks) { const bf16x8 bs = ldfrag(L + H_STB, 272, w, ks, lane);
#pragma unroll
                    for (int ti = 0; ti < 4; ++ti) O[ti] = __builtin_amdgcn_mfma_f32_16x16x32_bf16(ldfrag(L + H_QE, 272, ti, ks, lane), bs, O[ti], 0, 0, 0); }
            }
            {
                const bf16x8 bv0 = ldfrag(L + H_VT, 144, w, 0, lane), bv1 = ldfrag(L + H_VT, 144, w, 1, lane);
#pragma unroll
                for (int di = 0; di < 8; ++di) { const f32x4 l4 = *(const LAS f32x4*)(ebl + 16 * di + 4 * (lane >> 4)); S[di] = S[di] * l4;
                    S[di] = __builtin_amdgcn_mfma_f32_16x16x32_bf16(ldfrag(L + H_KET, 144, di, 0, lane), bv0, S[di], 0, 0, 0);
                    S[di] = __builtin_amdgcn_mfma_f32_16x16x32_bf16(ldfrag(L + H_KET, 144, di, 1, lane), bv1, S[di], 0, 0, 0); }
            }
            if (OUT) {
                __syncthreads();
                LAS float* Ot = (LAS float*)(L + H_STB);
#pragma unroll
                for (int ti = 0; ti < 4; ++ti)
#pragma unroll
                    for (int jj = 0; jj < 4; ++jj) Ot[(16 * ti + 4 * (lane >> 4) + jj) * 132 + 16 * w + (lane & 15)] = O[ti][jj];
                __syncthreads();
                const int t = tid >> 3, eg = tid & 7;
                f32x4 o4[4]; float ss = 0.f;
#pragma unroll
                for (int i = 0; i < 4; ++i) { o4[i] = *(const LAS f32x4*)(Ot + t * 132 + 16 * eg + 4 * i); ss += (o4[i].x * o4[i].x + o4[i].y * o4[i].y) + (o4[i].z * o4[i].z + o4[i].w * o4[i].w); }
                ss = red8(ss);
                const float rs = __builtin_amdgcn_rsqf(ss * (1.f / 128.f) + 1e-6f);
                const unsigned gw_[8] = {gt0.x, gt0.y, gt0.z, gt0.w, gt1.x, gt1.y, gt1.z, gt1.w};
                unsigned zo[8];
#pragma unroll
                for (int i = 0; i < 4; ++i) { const f32x4 g4 = *(const f32x4*)(gn + 16 * eg + 4 * i);
                    const float a0 = o4[i].x * rs * g4.x * silu_f(bflo(gw_[2 * i])), a1 = o4[i].y * rs * g4.y * silu_f(bfhi(gw_[2 * i]));
                    const float a2 = o4[i].z * rs * g4.z * silu_f(bflo(gw_[2 * i + 1])), a3 = o4[i].w * rs * g4.w * silu_f(bfhi(gw_[2 * i + 1]));
                    zo[2 * i] = cvt_pk_bf16(a0, a1); zo[2 * i + 1] = cvt_pk_bf16(a2, a3); }
                bf16_t* zp = Z + (size_t)(64 * c + t) * D + h * 128 + 16 * eg;
                *(u32x4*)zp = (u32x4){zo[0], zo[1], zo[2], zo[3]}; *(u32x4*)(zp + 8) = (u32x4){zo[4], zo[5], zo[6], zo[7]};
            } else {
                __syncthreads();
            }
        }
        if (!OUT) {
            float* e = HE + ((size_t)(h * 8 + seg) * 512 + tid) * 32;
#pragma unroll
            for (int di = 0; di < 8; ++di) *(f32x4*)(e + 4 * di) = S[di];
            if (qt == 0) HLD[(size_t)(h * 8 + seg) * 128 + d] = logD;
        }
        __syncthreads();
    }
#undef HG_LOAD
}

namespace att {
constexpr int NW = 8, QBLK = 32, KVBLK = 64, LDQ = 4096, LDO = 8192;
constexpr float SCALE = 0.088388347648318440f, THR = 8.f;
constexpr int SHM_V = 16384, SHM_K = 16384, SHM = 2 * SHM_V + 2 * SHM_K + NW * 64 * 4;
#define KSWZ(row, colB) ((row) * 256 + ((colB) ^ (((row) & 7) << 4)))
#define SBAR() __builtin_amdgcn_sched_barrier(0)
__device__ __forceinline__ int crow(int r, int hi) { return (r & 3) + 8 * (r >> 2) + 4 * hi; }
__device__ __forceinline__ void partialSM(f32x16& p0, f32x16& p1, float& m_reg, float& mn, float& alpha) {
    constexpr float C = SCALE * 1.4426950408889634f;
    float pmax = p0[0];
#pragma unroll
    for (int r = 1; r < 16; ++r) pmax = fmaxf(pmax, p0[r]);
#pragma unroll
    for (int r = 0; r < 16; ++r) pmax = fmaxf(pmax, p1[r]);
    { auto rr = __builtin_amdgcn_permlane32_swap(__float_as_uint(pmax), __float_as_uint(pmax), false, false);
      pmax = fmaxf(__uint_as_float(rr[0]), __uint_as_float(rr[1])); }
    if (__builtin_expect(__all(pmax - m_reg <= THR / SCALE), 1)) { mn = m_reg; alpha = 1.f; }
    else { mn = fmaxf(m_reg, pmax); alpha = __builtin_amdgcn_exp2f((m_reg - mn) * C); m_reg = mn; }
    const float mnC = -mn * C;
#pragma unroll
    for (int r = 0; r < 16; ++r) p0[r] = fmaf(p0[r], C, mnC);
#pragma unroll
    for (int r = 0; r < 16; ++r) p1[r] = fmaf(p1[r], C, mnC);
#pragma unroll
    for (int r = 0; r < 16; ++r) p0[r] = __builtin_amdgcn_exp2f(p0[r]);
}
__device__ __forceinline__ void finishSM(f32x16& p0, f32x16& p1, float alpha, float& l_reg, bf16x8& pa0, bf16x8& pa1, bf16x8& pa2, bf16x8& pa3) {
#pragma unroll
    for (int r = 0; r < 16; ++r) p1[r] = __builtin_amdgcn_exp2f(p1[r]);
    float ps = 0;
#pragma unroll
    for (int r = 0; r < 16; ++r) ps += p0[r];
#pragma unroll
    for (int r = 0; r < 16; ++r) ps += p1[r];
    { auto rr = __builtin_amdgcn_permlane32_swap(__float_as_uint(ps), __float_as_uint(ps), false, false);
      ps = __uint_as_float(rr[0]) + __uint_as_float(rr[1]); }
    l_reg = l_reg * alpha + ps;
#define PK4(P, BASE, OUT) do { unsigned a0 = cvt_pk_bf16(P[BASE + 0], P[BASE + 1]), a1 = cvt_pk_bf16(P[BASE + 2], P[BASE + 3]);   \
    unsigned b0 = cvt_pk_bf16(P[BASE + 4], P[BASE + 5]), b1 = cvt_pk_bf16(P[BASE + 6], P[BASE + 7]);                              \
    auto r0 = __builtin_amdgcn_permlane32_swap(a0, b0, false, false); auto r1 = __builtin_amdgcn_permlane32_swap(a1, b1, false, false); \
    u32x4 w = {r0[0], r1[0], r0[1], r1[1]}; OUT = *reinterpret_cast<bf16x8*>(&w); } while (0)
    PK4(p0, 0, pa0); PK4(p0, 8, pa1); PK4(p1, 0, pa2); PK4(p1, 8, pa3);
#undef PK4
}
__device__ __forceinline__ void qkt(f32x16& p0, f32x16& p1, const char* Ks, const bf16x8* qr, int r32, int hi) {
    p0 = f32x16{}; p1 = f32x16{};
#pragma unroll
    for (int d0 = 0; d0 < 8; ++d0) { const int cb = (d0 * 16 + hi * 8) * 2;
        const bf16x8 b0 = *reinterpret_cast<const bf16x8*>(Ks + KSWZ(r32, cb));
        const bf16x8 b1 = *reinterpret_cast<const bf16x8*>(Ks + KSWZ(32 + r32, cb));
        p0 = __builtin_amdgcn_mfma_f32_32x32x16_bf16(b0, qr[d0], p0, 0, 0, 0);
        p1 = __builtin_amdgcn_mfma_f32_32x32x16_bf16(b1, qr[d0], p1, 0, 0, 0); }
}
__device__ __forceinline__ int v_st(int k, int c) { const int kk = (k & ~0xC) | ((k & 4) << 1) | ((k & 8) >> 1); return ((kk >> 3) * 4 + (c >> 5)) * 512 + ((kk & 7) * 32 + (c & 31)) * 2; }
__device__ __forceinline__ int v_rd_base(int lane) { return ((lane & 3) << 3) | (((lane >> 2) & 3) << 6) | (((lane >> 4) & 1) << 5) | (((lane >> 5) & 1) << 8); }
constexpr int v_rd_off(int d0, int ks, int half) { return d0 * 512 + ks * 4096 + half * 2048; }
template <int OFF> __device__ __forceinline__ s16x4 tr_read(int vb) {
    s16x4 r; asm volatile("ds_read_b64_tr_b16 %0, %1 offset:%2" : "=&v"(r) : "v"(vb), "i"(OFF) : "memory"); return r;
}
template <int D0> __device__ __forceinline__ void pv_one(f32x16& od, int vb, bf16x8 pa0, bf16x8 pa1, bf16x8 pa2, bf16x8 pa3) {
    const s16x4 l0 = tr_read<v_rd_off(D0, 0, 0)>(vb), h0 = tr_read<v_rd_off(D0, 0, 1)>(vb), l1 = tr_read<v_rd_off(D0, 1, 0)>(vb), h1 = tr_read<v_rd_off(D0, 1, 1)>(vb);
    const s16x4 l2 = tr_read<v_rd_off(D0, 2, 0)>(vb), h2 = tr_read<v_rd_off(D0, 2, 1)>(vb), l3 = tr_read<v_rd_off(D0, 3, 0)>(vb), h3 = tr_read<v_rd_off(D0, 3, 1)>(vb);
    asm volatile("s_waitcnt lgkmcnt(0)" ::: "memory"); SBAR();
#define PK(Lo, Hi) (bf16x8){Lo[0], Lo[1], Lo[2], Lo[3], Hi[0], Hi[1], Hi[2], Hi[3]}
    od = __builtin_amdgcn_mfma_f32_32x32x16_bf16(pa0, PK(l0, h0), od, 0, 0, 0);
    od = __builtin_amdgcn_mfma_f32_32x32x16_bf16(pa1, PK(l1, h1), od, 0, 0, 0);
    od = __builtin_amdgcn_mfma_f32_32x32x16_bf16(pa2, PK(l2, h2), od, 0, 0, 0);
    od = __builtin_amdgcn_mfma_f32_32x32x16_bf16(pa3, PK(l3, h3), od, 0, 0, 0);
#undef PK
}
__device__ __forceinline__ void pv_d0(f32x16* o, int vb, bf16x8 pa0, bf16x8 pa1, bf16x8 pa2, bf16x8 pa3) {
    pv_one<0>(o[0], vb, pa0, pa1, pa2, pa3); pv_one<1>(o[1], vb, pa0, pa1, pa2, pa3); pv_one<2>(o[2], vb, pa0, pa1, pa2, pa3); pv_one<3>(o[3], vb, pa0, pa1, pa2, pa3);
}
__device__ __forceinline__ void mask_tile(f32x16& p0, f32x16& p1, int j, int lim) {
    if (j > lim) {
#pragma unroll
        for (int r = 0; r < 16; ++r) { p0[r] = -1e30f; p1[r] = -1e30f; }
    } else if (j == 0) {
#pragma unroll
        for (int r = 0; r < 16; ++r) p0[r] = -1e30f;
#pragma unroll
        for (int r = 0; r < 8; ++r) p1[r] = -1e30f;
    }
}
__device__ __forceinline__ void unit(const bf16_t* __restrict__ Qb, const bf16_t* __restrict__ Kh, const bf16_t* __restrict__ Vh, bf16_t* __restrict__ Ob, int NT, int lim, char* lds) {
    int tid_ = threadIdx.x; asm volatile("" : "+v"(tid_));
    const int tid = tid_, wid = tid >> 6, lane = tid & 63, r32 = lane & 31, hi = lane >> 5;
    char* V_lds = lds; char* K_lds = lds + 2 * SHM_V;
    float* wsf = (float*)(lds + 2 * SHM_V + 2 * SHM_K) + wid * 64; float* li_l = wsf; float* al_l = wsf + 32;
    float m_reg = -1e30f, l_reg = 0; f32x16 o[4] = {}; bf16x8 qr[8];
    const bf16_t* Qw = Qb + (long)(wid * QBLK + r32) * LDQ + hi * 8;
#pragma unroll
    for (int d0 = 0; d0 < 8; ++d0) qr[d0] = *reinterpret_cast<const bf16x8*>(Qw + d0 * 16);
    const int sr = tid >> 4, sc = (tid & 15) * 8, vst0 = v_st(sr, sc), vst1 = v_st(32 + sr, sc);
    const int vb0 = (int)(uintptr_t)V_lds + v_rd_base(lane);
    struct { bf16x8 vs0, vs1, ks0, ks1; } sr_[2];
#define SLOAD(i, k0) do { sr_[i].vs0 = *reinterpret_cast<const bf16x8*>(&Vh[(long)((k0) + sr) * LDQ + sc]); sr_[i].vs1 = *reinterpret_cast<const bf16x8*>(&Vh[(long)((k0) + 32 + sr) * LDQ + sc]); \
    sr_[i].ks0 = *reinterpret_cast<const bf16x8*>(&Kh[(long)((k0) + sr) * LDQ + sc]); sr_[i].ks1 = *reinterpret_cast<const bf16x8*>(&Kh[(long)((k0) + 32 + sr) * LDQ + sc]); } while (0)
#define SWRITE(b, i) do { *(bf16x8*)(V_lds + (b) * SHM_V + vst0) = sr_[i].vs0;          \
    *(bf16x8*)(V_lds + (b) * SHM_V + vst1) = sr_[i].vs1; int kc = sc * 2;               \
    *(bf16x8*)(K_lds + (b) * SHM_K + KSWZ(sr, kc)) = sr_[i].ks0;                       \
    *(bf16x8*)(K_lds + (b) * SHM_K + KSWZ(32 + sr, kc)) = sr_[i].ks1; } while (0)
#define SWAIT() asm volatile("s_waitcnt vmcnt(4)" ::: "memory")
#define RESC(a) do { if (__any((a) < 1.f)) { if (hi == 0) al_l[r32] = (a); asm volatile("s_waitcnt lgkmcnt(0)" ::: "memory"); \
    _Pragma("unroll") for (int d = 0; d < 4; ++d) _Pragma("unroll") for (int r = 0; r < 16; ++r) o[d][r] *= al_l[crow(r, hi)]; } } while (0)
    f32x16 pA0, pA1, pB0, pB1; float mnA, mnB, alA, alB; bf16x8 pa0, pa1, pa2, pa3;
    constexpr int SE = 0, SO = 1;
    SLOAD(SE, 0); asm volatile("s_waitcnt vmcnt(0)" ::: "memory"); SWRITE(0, SE); __syncthreads();
    qkt(pA0, pA1, K_lds, qr, r32, hi); mask_tile(pA0, pA1, 0, lim); partialSM(pA0, pA1, m_reg, mnA, alA);
    SLOAD(SO, KVBLK); if (2 < NT) SLOAD(SE, 2 * KVBLK);
    SWAIT(); SWRITE(1, SO); __syncthreads();
    for (int j = 1; j + 1 < NT; j += 2) {
        SBAR(); qkt(pB0, pB1, K_lds + SHM_K, qr, r32, hi);
        finishSM(pA0, pA1, alA, l_reg, pa0, pa1, pa2, pa3); SBAR();
        SLOAD(SO, (j + 2) * KVBLK); SBAR();
        pv_d0(o, vb0, pa0, pa1, pa2, pa3); mask_tile(pB0, pB1, j, lim); partialSM(pB0, pB1, m_reg, mnB, alB);
        __syncthreads(); SWAIT(); SWRITE(0, SE);
        RESC(alB); __syncthreads();
        SBAR(); qkt(pA0, pA1, K_lds, qr, r32, hi);
        finishSM(pB0, pB1, alB, l_reg, pa0, pa1, pa2, pa3); SBAR();
        if (j + 3 < NT) SLOAD(SE, (j + 3) * KVBLK); SBAR();
        pv_d0(o, vb0 + SHM_V, pa0, pa1, pa2, pa3); mask_tile(pA0, pA1, j + 1, lim); partialSM(pA0, pA1, m_reg, mnA, alA);
        __syncthreads(); SWAIT(); SWRITE(1, SO);
        RESC(alA); __syncthreads();
    }
    SBAR(); qkt(pB0, pB1, K_lds + SHM_K, qr, r32, hi);
    finishSM(pA0, pA1, alA, l_reg, pa0, pa1, pa2, pa3); SBAR();
    pv_d0(o, vb0, pa0, pa1, pa2, pa3); mask_tile(pB0, pB1, NT - 1, lim); partialSM(pB0, pB1, m_reg, mnB, alB);
    __syncthreads(); RESC(alB);
    finishSM(pB0, pB1, alB, l_reg, pa0, pa1, pa2, pa3); SBAR();
    pv_d0(o, vb0 + SHM_V, pa0, pa1, pa2, pa3);
    if (hi == 0) li_l[r32] = l_reg; asm volatile("s_waitcnt lgkmcnt(0)" ::: "memory");
    float rli[16];
#pragma unroll
    for (int r = 0; r < 16; ++r) rli[r] = __builtin_amdgcn_rcpf(li_l[crow(r, hi)]);
    bf16_t* Ow = Ob + (long)(wid * QBLK) * LDO;
#pragma unroll
    for (int r = 0; r < 16; ++r) { const int orow = crow(r, hi);
#pragma unroll
        for (int d0 = 0; d0 < 4; ++d0) Ow[(long)orow * LDO + d0 * 32 + r32] = f2bf(o[d0][r] * rli[r]); }
    __syncthreads();
#undef SLOAD
#undef SWRITE
#undef SWAIT
#undef RESC
}
}


namespace att2 {
using namespace att;
constexpr int KB = 16384, VB = 32768, OFF_V = 3 * KB, OFF_W = OFF_V + 2 * VB, SHM2 = OFF_W + NW * 64 * 4;
constexpr int v2_rd_off(int d0, int ks, int half) { return d0 * 512 + ks * 8192 + half * 4096; }
template <int D0> __device__ __forceinline__ void pv2_one(f32x16& od, int vb, bf16x8 pa0, bf16x8 pa1, bf16x8 pa2, bf16x8 pa3) {
    const s16x4 l0 = tr_read<v2_rd_off(D0, 0, 0)>(vb), h0 = tr_read<v2_rd_off(D0, 0, 1)>(vb), l1 = tr_read<v2_rd_off(D0, 1, 0)>(vb), h1 = tr_read<v2_rd_off(D0, 1, 1)>(vb);
    const s16x4 l2 = tr_read<v2_rd_off(D0, 2, 0)>(vb), h2 = tr_read<v2_rd_off(D0, 2, 1)>(vb), l3 = tr_read<v2_rd_off(D0, 3, 0)>(vb), h3 = tr_read<v2_rd_off(D0, 3, 1)>(vb);
    asm volatile("s_waitcnt lgkmcnt(0)" ::: "memory"); SBAR();
#define PK(Lo, Hi) (bf16x8){Lo[0], Lo[1], Lo[2], Lo[3], Hi[0], Hi[1], Hi[2], Hi[3]}
    od = __builtin_amdgcn_mfma_f32_32x32x16_bf16(pa0, PK(l0, h0), od, 0, 0, 0);
    od = __builtin_amdgcn_mfma_f32_32x32x16_bf16(pa1, PK(l1, h1), od, 0, 0, 0);
    od = __builtin_amdgcn_mfma_f32_32x32x16_bf16(pa2, PK(l2, h2), od, 0, 0, 0);
    od = __builtin_amdgcn_mfma_f32_32x32x16_bf16(pa3, PK(l3, h3), od, 0, 0, 0);
#undef PK
}
__device__ __forceinline__ void unit2(const bf16_t* __restrict__ Qb, const bf16_t* __restrict__ Kh, const bf16_t* __restrict__ Vh, bf16_t* __restrict__ Ob, int NT, int lim, unsigned char* ldsg, LAS unsigned char* lds) {
    int tid_ = threadIdx.x; asm volatile("" : "+v"(tid_));
    const int tid = tid_, wid = __builtin_amdgcn_readfirstlane(tid >> 6), lane = tid & 63, r32 = lane & 31, hi = lane >> 5;
    LAS float* wsf = (LAS float*)(lds + OFF_W) + wid * 64; LAS float* li_l = wsf; LAS float* al_l = wsf + 32;
    float m_reg = -1e30f, l_reg = 0; f32x16 o[8] = {}; bf16x8 qr[8];
    const bf16_t* Qw = Qb + (long)(wid * QBLK + r32) * LDQ + hi * 8;
#pragma unroll
    for (int d0 = 0; d0 < 8; ++d0) qr[d0] = *reinterpret_cast<const bf16x8*>(Qw + d0 * 16);
    unsigned kofs[2], vofs[4];
#pragma unroll
    for (int i = 0; i < 2; ++i) { const int row = wid * 4 + i * 32 + (lane >> 4); const int cb = ((lane & 15) * 16) ^ ((row & 7) << 4); kofs[i] = (unsigned)(row * LDQ * 2 + cb); }
#pragma unroll
    for (int i = 0; i < 4; ++i) { const int st = wid * 2 + i * 16 + (lane >> 5), q = lane & 31; const int kk = (st >> 3) * 8 + (q >> 2); const int k = (kk & ~0xC) | ((kk & 4) << 1) | ((kk & 8) >> 1);
        const int c = (st & 7) * 32 + (q & 3) * 8; vofs[i] = (unsigned)(k * LDQ * 2 + c * 2); }
    const int vb0 = (int)(uintptr_t)(ldsg + OFF_V) + v_rd_base(lane);
#define DMA_K(t_, b_) do { const char* gk = (const char*)Kh + (size_t)(t_) * (KVBLK * LDQ * 2); _Pragma("unroll") for (int i = 0; i < 2; ++i) \
        __builtin_amdgcn_global_load_lds((const unsigned*)(gk + kofs[i]), (LAS unsigned*)(lds + (b_) * KB + wid * 1024 + i * 8192), 16, 0, 0); } while (0)
#define DMA_V(t_, b_) do { const char* gv = (const char*)Vh + (size_t)(t_) * (KVBLK * LDQ * 2); _Pragma("unroll") for (int i = 0; i < 4; ++i) \
        __builtin_amdgcn_global_load_lds((const unsigned*)(gv + vofs[i]), (LAS unsigned*)(lds + OFF_V + (b_) * VB + wid * 1024 + i * 8192), 16, 0, 0); } while (0)
    DMA_K(0, 0); DMA_V(0, 0); if (1 < NT) DMA_K(1, 1);
    asm volatile("s_waitcnt vmcnt(0)" ::: "memory"); __builtin_amdgcn_s_barrier(); asm volatile("" ::: "memory");
    int kb = 0;
    for (int j = 0; j < NT; ++j) {
        const int kb2 = kb == 0 ? 2 : kb - 1;
        if (j + 1 < NT) DMA_V(j + 1, (j + 1) & 1);
        asm volatile("" ::: "memory");
        if (j + 2 < NT) DMA_K(j + 2, kb2);
        asm volatile("" ::: "memory");
        f32x16 p0, p1; float mn, alpha; bf16x8 pa0, pa1, pa2, pa3;
        qkt(p0, p1, (const char*)ldsg + kb * KB, qr, r32, hi);
        mask_tile(p0, p1, j, lim);
        partialSM(p0, p1, m_reg, mn, alpha);
        if (__any(alpha < 1.f)) { if (hi == 0) al_l[r32] = alpha; asm volatile("s_waitcnt lgkmcnt(0)" ::: "memory");
#pragma unroll
            for (int d = 0; d < 8; ++d)
#pragma unroll
                for (int r = 0; r < 16; ++r) o[d][r] *= al_l[crow(r, hi)]; }
        finishSM(p0, p1, alpha, l_reg, pa0, pa1, pa2, pa3); SBAR();
        const int vb = vb0 + (j & 1) * VB;
        pv2_one<0>(o[0], vb, pa0, pa1, pa2, pa3); pv2_one<1>(o[1], vb, pa0, pa1, pa2, pa3); pv2_one<2>(o[2], vb, pa0, pa1, pa2, pa3); pv2_one<3>(o[3], vb, pa0, pa1, pa2, pa3);
        pv2_one<4>(o[4], vb, pa0, pa1, pa2, pa3); pv2_one<5>(o[5], vb, pa0, pa1, pa2, pa3); pv2_one<6>(o[6], vb, pa0, pa1, pa2, pa3); pv2_one<7>(o[7], vb, pa0, pa1, pa2, pa3);
        if (j + 2 < NT) asm volatile("s_waitcnt vmcnt(2)" ::: "memory"); else asm volatile("s_waitcnt vmcnt(0)" ::: "memory");
        __builtin_amdgcn_s_barrier(); asm volatile("" ::: "memory");
        kb = kb == 2 ? 0 : kb + 1;
    }
    if (hi == 0) li_l[r32] = l_reg; asm volatile("s_waitcnt lgkmcnt(0)" ::: "memory");
    float rli[16];
#pragma unroll
    for (int r = 0; r < 16; ++r) rli[r] = __builtin_amdgcn_rcpf(li_l[crow(r, hi)]);
    bf16_t* Ow = Ob + (long)(wid * QBLK) * LDO;
#pragma unroll
    for (int r = 0; r < 16; ++r) { const int orow = crow(r, hi);
#pragma unroll
        for (int d0 = 0; d0 < 8; ++d0) Ow[(long)orow * LDO + d0 * 32 + r32] = f2bf(o[d0][r] * rli[r]); }
    asm volatile("s_waitcnt vmcnt(0) lgkmcnt(0)" ::: "memory"); __builtin_amdgcn_s_barrier(); asm volatile("" ::: "memory");
#undef DMA_K
#undef DMA_V
}
}

#ifndef MK_ATT2
#define MK_ATT2 1
#endif
#if MK_ATT2
__device__ __forceinline__ void attn_phase(const Fr& F) {
    const bf16_t* Q = slotY(F, 0); const bf16_t* K = slotY(F, 1); const bf16_t* V = slotY(F, 2);
    bf16_t* AO = slotU(F, 1);
    const int x = F.bid & 7, j = (F.bid >> 3) & 31;
#pragma unroll 1
    for (int k = 0; k < 4; ++k) {
        if (F.bid >= 256) break;
        const int sub = 4 * x + k, head = sub >> 1, c = sub & 1;
        const bf16_t* Kp = K + head * 256 + c * 128; const bf16_t* Vp = V + head * 256;
#pragma unroll 1
        for (int u = 0; u < 2; ++u) {
            const int t = u == 0 ? 63 - j : j;
            const int row0 = 256 * t + 128;
            att2::unit2(Q + (size_t)row0 * D + head * 256 + c * 128, Kp, Vp, AO + (size_t)row0 * 8192 + head * 512 + c * 256, 4 * t + 6, 4 * t + 2 + (F.wave >> 1), F.ldsg, F.lds);
        }
        if (j == 8 * k) att2::unit2(Q + head * 256 + c * 128, Kp, Vp, AO + head * 512 + c * 256, 4, F.wave >> 1, F.ldsg, F.lds);
    }
}
#else
__device__ __forceinline__ void attn_phase(const Fr& F) {
    const bf16_t* Q = slotY(F, 0); const bf16_t* K = slotY(F, 1); const bf16_t* V = slotY(F, 2);
    bf16_t* AO = slotU(F, 1);
    const int x = F.bid & 7, j = (F.bid >> 3) & 31;
#pragma unroll 1
    for (int k = 0; k < 8; ++k) {
        if (F.bid >= 256) break;
        const int sub = 8 * x + k, head = sub >> 2, c = (sub >> 1) & 1, half = sub & 1;
        const bf16_t* Kp = K + head * 256 + c * 128; const bf16_t* Vp = V + head * 256 + half * 128;
#pragma unroll 1
        for (int u = 0; u < 2; ++u) {
            const int t = u == 0 ? 63 - j : j;
            const int row0 = 256 * t + 128;
            att::unit(Q + (size_t)row0 * D + head * 256 + c * 128, Kp, Vp, AO + (size_t)row0 * 8192 + head * 512 + c * 256 + half * 128, 4 * t + 6, 4 * t + 2 + (F.wave >> 1), (char*)F.ldsg);
        }
        if (j == 4 * k) att::unit(Q + head * 256 + c * 128, Kp, Vp, AO + head * 512 + c * 256 + half * 128, 4, F.wave >> 1, (char*)F.ldsg);
    }
}
#endif
__device__ __forceinline__ void attn_post(const Fr& F) {
    const bf16_t* AO = slotU(F, 1); const bf16_t* GT = slotY(F, 3); bf16_t* Z = slotU(F, 0);
    const float* sg = F.in(13);
    constexpr float LINIT = 0.35550906759096934f;
    float lam;
    { const float* q1 = F.in(9); const float* k1 = F.in(10); const float* q2 = F.in(11); const float* k2 = F.in(12);
      const float d1 = wave_sum(q1[F.lane] * k1[F.lane] + q1[F.lane + 64] * k1[F.lane + 64]), d2 = wave_sum(q2[F.lane] * k2[F.lane] + q2[F.lane + 64] * k2[F.lane + 64]);
      lam = expf(d1) - expf(d2) + LINIT; }
    const f32x4 g4 = ((const f32x4*)sg)[F.lane];
    for (int r = F.gw; r < R; r += F.NGW) {
        const bool real = (r >= NPAD && r < NREAL);
        u32x2* zr = (u32x2*)(Z + (size_t)r * D) + F.lane;
        if (!real) { const u32x2 z = {0u, 0u};
#pragma unroll
            for (int hd = 0; hd < 16; ++hd) zr[64 * hd] = z;
            continue; }
#pragma unroll 4
        for (int hd = 0; hd < 16; ++hd) {
            const u32x2 a0 = ((const u32x2*)(AO + (size_t)r * 8192 + hd * 512))[F.lane], a1 = ((const u32x2*)(AO + (size_t)r * 8192 + hd * 512 + 256))[F.lane];
            const u32x2 gt = ((const u32x2*)(GT + (size_t)r * D + hd * 256))[F.lane];
            const float o0 = bflo(a0.x) - lam * bflo(a1.x), o1 = bfhi(a0.x) - lam * bfhi(a1.x), o2 = bflo(a0.y) - lam * bflo(a1.y), o3 = bfhi(a0.y) - lam * bfhi(a1.y);
            const float ss = wave_sum((o0 * o0 + o1 * o1) + (o2 * o2 + o3 * o3));
            const float rs = __builtin_amdgcn_rsqf(ss * (1.f / 256.f) + 1e-5f) * (1.f - LINIT);
            u32x2 w; w.x = cvt_pk_bf16(o0 * rs * g4.x * silu_f(bflo(gt.x)), o1 * rs * g4.y * silu_f(bfhi(gt.x))); w.y = cvt_pk_bf16(o2 * rs * g4.z * silu_f(bflo(gt.y)), o3 * rs * g4.w * silu_f(bfhi(gt.y)));
            zr[64 * hd] = w;
        }
    }
}

constexpr int RW_TT = 32, RW_TOKF = 384, RW_TILEF = RW_TT * RW_TOKF, RW_NTILE = 513;
__device__ __forceinline__ void rwkv_scan_seq(const Fr& F) {
    const bf16_t* Rr = slotY(F, 0); const bf16_t* K = slotY(F, 1); const bf16_t* V = slotY(F, 2); const bf16_t* W = slotY(F, 4); const bf16_t* A = slotY(F, 5);
    float* O32 = (float*)slotU(F, 1);
    LAS float* ring = (LAS float*)F.lds; LAS float* otile = ring + 2 * RW_TILEF;
    const int tid = F.tid, lane = F.lane, wid = F.wave;
    for (int unit = F.bid; unit < 256; unit += F.G) {
        const int h = unit >> 2, rg = unit & 3;
        const int ptid = tid - 256, ptt = ptid >> 3, dg = ptid & 7;
        float kkc[8], kac[8];
        if (wid >= 4) {
#pragma unroll
            for (int i = 0; i < 8; ++i) { kkc[i] = F.in(23)[h * 64 + 8 * dg + i]; kac[i] = F.in(24)[h * 64 + 8 * dg + i]; }
        }
        float S0 = 0.f, S1 = 0.f, S2 = 0.f, S3 = 0.f;
        const int cg = lane & 15, irow = 4 * wid + (lane >> 4);
#define RW_PRODUCE(m, buf) do { const int row = NPAD + 32 * (m) + ptt; const size_t off = (size_t)row * D + h * 64 + 8 * dg; \
        const u32x4 r8 = *(const u32x4*)(Rr + off), k8 = *(const u32x4*)(K + off), v8 = *(const u32x4*)(V + off), w8 = *(const u32x4*)(W + off), a8 = *(const u32x4*)(A + off); \
        const unsigned rw[4] = {r8.x, r8.y, r8.z, r8.w}, kw[4] = {k8.x, k8.y, k8.z, k8.w}, vw[4] = {v8.x, v8.y, v8.z, v8.w}, ww[4] = {w8.x, w8.y, w8.z, w8.w}, aw[4] = {a8.x, a8.y, a8.z, a8.w}; \
        float rf[8], kf[8], vf[8], wf[8], af[8], kk[8]; float ssq = 0.f; \
        _Pragma("unroll") for (int i = 0; i < 4; ++i) { rf[2 * i] = bflo(rw[i]); rf[2 * i + 1] = bfhi(rw[i]); kf[2 * i] = bflo(kw[i]); kf[2 * i + 1] = bfhi(kw[i]); vf[2 * i] = bflo(vw[i]); vf[2 * i + 1] = bfhi(vw[i]); \
            wf[2 * i] = bflo(ww[i]); wf[2 * i + 1] = bfhi(ww[i]); af[2 * i] = bflo(aw[i]); af[2 * i + 1] = bfhi(aw[i]); } \
        _Pragma("unroll") for (int i = 0; i < 8; ++i) { kk[i] = kf[i] * kkc[i]; ssq += kk[i] * kk[i]; } \
        ssq = red8(ssq); const float inv = 1.f / fmaxf(sqrtf(ssq), 1e-12f); \
        LAS float* tb = ring + (buf) * RW_TILEF + ptt * RW_TOKF; \
        _Pragma("unroll") for (int q = 0; q < 2; ++q) { LAS f32x4* p = (LAS f32x4*)(tb + (2 * dg + q) * 20); \
            f32x4 t0, t1, t2, t3, t4; \
            _Pragma("unroll") for (int e = 0; e < 4; ++e) { const int i = 4 * q + e; const float kn = kk[i] * inv; t0[e] = wf[i]; t1[e] = -kn; t2[e] = kn * af[i]; t3[e] = kf[i] * (1.f + (af[i] - 1.f) * kac[i]); t4[e] = rf[i]; } \
            p[0] = t0; p[1] = t1; p[2] = t2; p[3] = t3; p[4] = t4; } \
        LAS f32x4* pv = (LAS f32x4*)(tb + 320 + 8 * dg); pv[0] = (f32x4){vf[0], vf[1], vf[2], vf[3]}; pv[1] = (f32x4){vf[4], vf[5], vf[6], vf[7]}; } while (0)
#define RW_FLUSH(m, buf) do { const int row = NPAD + 32 * (m) + ptt; if (row < NREAL) { const LAS float* ot = otile + (buf) * 512 + ptt * 16 + 2 * dg; \
        *(float2*)(O32 + (size_t)row * D + h * 64 + 16 * rg + 2 * dg) = make_float2(ot[0], ot[1]); } } while (0)
        if (wid >= 4) RW_PRODUCE(0, 0);
        __syncthreads();
        for (int n = 0; n < RW_NTILE; ++n) {
            if (wid < 4) {
                const LAS float* tb = ring + (n & 1) * RW_TILEF; LAS float* ot = otile + (n & 1) * 512;
#pragma unroll 4
                for (int tt = 0; tt < RW_TT; ++tt) {
                    const LAS float* p = tb + tt * RW_TOKF + cg * 20;
                    const f32x4 w4 = *(const LAS f32x4*)p, nk = *(const LAS f32x4*)(p + 4), ka = *(const LAS f32x4*)(p + 8), kp = *(const LAS f32x4*)(p + 12), r4 = *(const LAS f32x4*)(p + 16);
                    const float v = tb[tt * RW_TOKF + 320 + 16 * rg + irow];
                    float sa = (S0 * nk.x + S1 * nk.y) + (S2 * nk.z + S3 * nk.w);
                    sa = red16(sa);
                    S0 = S0 * w4.x + (sa * ka.x + v * kp.x); S1 = S1 * w4.y + (sa * ka.y + v * kp.y); S2 = S2 * w4.z + (sa * ka.z + v * kp.z); S3 = S3 * w4.w + (sa * ka.w + v * kp.w);
                    float o = (S0 * r4.x + S1 * r4.y) + (S2 * r4.z + S3 * r4.w);
                    o = red16(o);
                    if (cg == 0) ot[tt * 16 + irow] = o;
                }
            } else {
                if (n + 1 < RW_NTILE) RW_PRODUCE(n + 1, (n + 1) & 1);
                if (n > 0) RW_FLUSH(n - 1, (n - 1) & 1);
            }
            __syncthreads();
        }
        if (wid >= 4) RW_FLUSH(RW_NTILE - 1, (RW_NTILE - 1) & 1);
        __syncthreads();
#undef RW_PRODUCE
#undef RW_FLUSH
    }
}

#ifndef RC_SYNC
#define RC_SYNC 0
#endif
constexpr int RC_SLOT = 13312, RC_NSLOT = 8, RC_SCR0 = RC_NSLOT * RC_SLOT, RC_SCR = 5632, RC_FLAGS = RC_SCR0 + 7 * RC_SCR, RC_NCH = 1025;
constexpr int RC_AT = 0, RC_RT = 2176, RC_BTT = 4352, RC_KTT = 6912, RC_TT = 9472, RC_G3F = 9984, RC_VTF = 10496, RC_P1 = 11008, RC_P2 = 12032, RC_WC = 13056;
static_assert(RC_FLAGS + 64 <= 147456 - 256, "rwkv LDS map");
typedef short s16x4v __attribute__((ext_vector_type(4)));
__device__ __forceinline__ void rwkv_kknorm(const Fr& F) {
    const bf16_t* K = slotY(F, 1); const float* k_k = F.in(23); float* INV = (float*)(F.ws + WS_HE);
    for (int r = F.gw; r < R; r += F.NGW) {
#pragma unroll 4
        for (int it = 0; it < 16; ++it) {
            const size_t ci = (size_t)it * 64 + F.lane;
            const u32x2 kk = ((const u32x2*)(K + (size_t)r * D))[ci]; const f32x4 c4 = ((const f32x4*)k_k)[ci];
            const float a = bflo(kk.x) * c4.x, b = bfhi(kk.x) * c4.y, c = bflo(kk.y) * c4.z, d = bfhi(kk.y) * c4.w;
            const float ss = red16((a * a + b * b) + (c * c + d * d));
            if ((F.lane & 15) == 0) INV[(size_t)r * 64 + it * 4 + (F.lane >> 4)] = 1.f / fmaxf(sqrtf(ss), 1e-12f);
        }
    }
}
__device__ __forceinline__ unsigned lds_poll(volatile LAS unsigned* p) { return *p; }
__device__ __forceinline__ void rwkv_scan(const Fr& F) {
    const bf16_t* Rr = slotY(F, 0); const bf16_t* K = slotY(F, 1); const bf16_t* V = slotY(F, 2); const bf16_t* W = slotY(F, 4); const bf16_t* A = slotY(F, 5);
    const float* INV = (const float*)(F.ws + WS_HE);
    float* O32 = (float*)slotU(F, 1);
    LAS unsigned char* L = F.lds;
    volatile LAS unsigned* flags = (volatile LAS unsigned*)(L + RC_FLAGS);
    const int lane = F.lane, wid = F.wave, l15 = lane & 15, kg = lane >> 4;
    for (int unit = F.bid; unit < 256; unit += F.G) {
        const int h = unit >> 2, rgw = unit & 3;
        if (F.tid < 16) flags[F.tid] = 0u;
        __syncthreads();
        if (wid == 0) {
            __builtin_amdgcn_s_setprio(3);
            f32x4 S0 = {0.f, 0.f, 0.f, 0.f}, S1 = S0, S2 = S0, S3 = S0;
            for (int n = 0; n < RC_NCH; ++n) {
                const int slot = n & 7; const LAS unsigned char* SL = L + slot * RC_SLOT;
#if RC_SYNC
                if (n % 7 == 0) { __builtin_amdgcn_s_barrier(); __builtin_amdgcn_s_barrier(); }
#else
                { unsigned sp = 0; while (lds_poll(flags + slot) != (unsigned)(n + 1)) { __builtin_amdgcn_s_sleep(1); if (++sp > (1u << 22)) break; } }
#endif
                asm volatile("s_waitcnt lgkmcnt(0)" ::: "memory");
                u32x4 sb0, sb1; sb0.x = cvt_pk_bf16(S0.x, S0.y); sb0.y = cvt_pk_bf16(S0.z, S0.w); sb0.z = cvt_pk_bf16(S1.x, S1.y); sb0.w = cvt_pk_bf16(S1.z, S1.w);
                sb1.x = cvt_pk_bf16(S2.x, S2.y); sb1.y = cvt_pk_bf16(S2.z, S2.w); sb1.z = cvt_pk_bf16(S3.x, S3.y); sb1.w = cvt_pk_bf16(S3.z, S3.w);
                const bf16x8 Sb0 = *reinterpret_cast<bf16x8*>(&sb0), Sb1 = *reinterpret_cast<bf16x8*>(&sb1);
                const LAS unsigned char* ap = SL + RC_AT + l15 * 136 + kg * 8; const LAS unsigned char* rp = SL + RC_RT + l15 * 136 + kg * 8;
                u32x2 a0l = *(const LAS u32x2*)(ap), a0h = *(const LAS u32x2*)(ap + 32), a1l = *(const LAS u32x2*)(ap + 64), a1h = *(const LAS u32x2*)(ap + 96);
                u32x2 r0l = *(const LAS u32x2*)(rp), r0h = *(const LAS u32x2*)(rp + 32), r1l = *(const LAS u32x2*)(rp + 64), r1h = *(const LAS u32x2*)(rp + 96);
                u32x4 t4;
                t4 = (u32x4){a0l.x, a0l.y, a0h.x, a0h.y}; const bf16x8 Aq0 = *reinterpret_cast<bf16x8*>(&t4);
                t4 = (u32x4){a1l.x, a1l.y, a1h.x, a1h.y}; const bf16x8 Aq1 = *reinterpret_cast<bf16x8*>(&t4);
                t4 = (u32x4){r0l.x, r0l.y, r0h.x, r0h.y}; const bf16x8 Rq0 = *reinterpret_cast<bf16x8*>(&t4);
                t4 = (u32x4){r1l.x, r1l.y, r1h.x, r1h.y}; const bf16x8 Rq1 = *reinterpret_cast<bf16x8*>(&t4);
                f32x4 X = *(const LAS f32x4*)(SL + RC_P1 + lane * 16), O = *(const LAS f32x4*)(SL + RC_P2 + lane * 16);
                const s16x4v ttf = *(const LAS s16x4v*)(SL + RC_TT + lane * 8);
                const s16x4v g3f = *(const LAS s16x4v*)(SL + RC_G3F + lane * 8), vtf = *(const LAS s16x4v*)(SL + RC_VTF + lane * 8);
                X = __builtin_amdgcn_mfma_f32_16x16x32_bf16(Aq0, Sb0, X, 0, 0, 0);
                X = __builtin_amdgcn_mfma_f32_16x16x32_bf16(Aq1, Sb1, X, 0, 0, 0);
                O = __builtin_amdgcn_mfma_f32_16x16x32_bf16(Rq0, Sb0, O, 0, 0, 0);
                O = __builtin_amdgcn_mfma_f32_16x16x32_bf16(Rq1, Sb1, O, 0, 0, 0);
                u32x2 yb; yb.x = cvt_pk_bf16(X.x, X.y); yb.y = cvt_pk_bf16(X.z, X.w);
                f32x4 U = {0.f, 0.f, 0.f, 0.f};
                U = __builtin_amdgcn_mfma_f32_16x16x16bf16_1k(ttf, *reinterpret_cast<s16x4v*>(&yb), U, 0, 0, 0);
                u32x2 ub; ub.x = cvt_pk_bf16(U.x, U.y); ub.y = cvt_pk_bf16(U.z, U.w);
                const s16x4v Ub = *reinterpret_cast<s16x4v*>(&ub);
                O = __builtin_amdgcn_mfma_f32_16x16x16bf16_1k(g3f, Ub, O, 0, 0, 0);
                const LAS unsigned char* bp = SL + RC_BTT + l15 * 40 + kg * 8; const LAS unsigned char* kp = SL + RC_KTT + l15 * 40 + kg * 8;
                const s16x4v b0 = *(const LAS s16x4v*)(bp), b1 = *(const LAS s16x4v*)(bp + 640), b2 = *(const LAS s16x4v*)(bp + 1280), b3 = *(const LAS s16x4v*)(bp + 1920);
                const s16x4v k0 = *(const LAS s16x4v*)(kp), k1 = *(const LAS s16x4v*)(kp + 640), k2 = *(const LAS s16x4v*)(kp + 1280), k3 = *(const LAS s16x4v*)(kp + 1920);
                const LAS f32x4* wc = (const LAS f32x4*)(SL + RC_WC + kg * 16);
                const f32x4 w0 = wc[0], w1 = wc[4], w2 = wc[8], w3 = wc[12];
                S0 = __builtin_amdgcn_mfma_f32_16x16x16bf16_1k(k0, vtf, S0, 0, 0, 0); S1 = __builtin_amdgcn_mfma_f32_16x16x16bf16_1k(k1, vtf, S1, 0, 0, 0);
                S2 = __builtin_amdgcn_mfma_f32_16x16x16bf16_1k(k2, vtf, S2, 0, 0, 0); S3 = __builtin_amdgcn_mfma_f32_16x16x16bf16_1k(k3, vtf, S3, 0, 0, 0);
                S0 = __builtin_amdgcn_mfma_f32_16x16x16bf16_1k(b0, Ub, S0, 0, 0, 0); S1 = __builtin_amdgcn_mfma_f32_16x16x16bf16_1k(b1, Ub, S1, 0, 0, 0);
                S2 = __builtin_amdgcn_mfma_f32_16x16x16bf16_1k(b2, Ub, S2, 0, 0, 0); S3 = __builtin_amdgcn_mfma_f32_16x16x16bf16_1k(b3, Ub, S3, 0, 0, 0);
                S0 = S0 * w0; S1 = S1 * w1; S2 = S2 * w2; S3 = S3 * w3;
                asm volatile("s_waitcnt lgkmcnt(0)" ::: "memory");
                if (lane == 0) flags[8] = (unsigned)(n + 1);
                float* op = O32 + (size_t)(NPAD + 16 * n + 4 * kg) * D + h * 64 + 16 * rgw + l15;
                op[0] = O.x; op[D] = O.y; op[2 * D] = O.z; op[3 * D] = O.w;
            }
            __builtin_amdgcn_s_setprio(0);
        } else {
            const int p = wid - 1;
            LAS unsigned char* SC = L + RC_SCR0 + p * RC_SCR;
            const float kkc = F.in(23)[h * 64 + lane], kac = F.in(24)[h * 64 + lane];
            unsigned short cr[16], ck[16], cw[16], ca[16], nvq[4]; float civ[16];
#define RC_LOADS(nn) do { const int r0n = NPAD + 16 * (nn); \
                _Pragma("unroll") for (int e = 0; e < 4; ++e) nvq[e] = V[(size_t)(r0n + 4 * kg + e) * D + h * 64 + 16 * rgw + l15]; \
                _Pragma("unroll") for (int s = 0; s < 16; ++s) { const size_t off = (size_t)(r0n + s) * D + h * 64 + lane; cr[s] = Rr[off]; ck[s] = K[off]; cw[s] = W[off]; ca[s] = A[off]; civ[s] = INV[(size_t)(r0n + s) * 64 + h]; } } while (0)
            RC_LOADS(p);
            for (int n = p; n < RC_NCH; n += 7) {
                const int slot = n & 7; LAS unsigned char* SL = L + slot * RC_SLOT;
                unsigned short vq[4];
#pragma unroll
                for (int e = 0; e < 4; ++e) vq[e] = nvq[e];
#if RC_SYNC
                asm volatile("s_waitcnt lgkmcnt(0)" ::: "memory"); __builtin_amdgcn_s_barrier();
#else
                if (n >= 8) { unsigned sp = 0; while (lds_poll(flags + 8) < (unsigned)(n - 7)) { __builtin_amdgcn_s_sleep(2); if (++sp > (1u << 22)) break; } }
#endif
                asm volatile("" ::: "memory");
                float Wp = 1.f; unsigned btp[8], ktp[8];
#pragma unroll
                for (int hb = 0; hb < 2; ++hb) {
                    unsigned short rq[8], kq[8], wq[8], aq[8]; float iv[8];
#pragma unroll
                    for (int s = 0; s < 8; ++s) { rq[s] = cr[8 * hb + s]; kq[s] = ck[8 * hb + s]; wq[s] = cw[8 * hb + s]; aq[s] = ca[8 * hb + s]; iv[s] = civ[8 * hb + s]; }
                    float btv[8], ktv[8];
#pragma unroll
                    for (int s = 0; s < 8; ++s) {
                        const int t = 8 * hb + s;
                        const float rs = bf2f(rq[s]), ks = bf2f(kq[s]), wsv = bf2f(wq[s]), as = bf2f(aq[s]);
                        const float kk = ks * kkc * iv[s];
                        const float Wprev = Wp; Wp *= wsv; const float iW = __builtin_amdgcn_rcpf(Wp);
                        const float at = -kk * Wprev, rt = rs * Wp, bt = kk * as * iW, kt = ks * (1.f + (as - 1.f) * kac) * iW;
                        *(LAS bf16_t*)(SL + RC_AT + t * 136 + lane * 2) = f2bf(at); *(LAS bf16_t*)(SL + RC_RT + t * 136 + lane * 2) = f2bf(rt);
                        *(LAS bf16_t*)(SC + t * 136 + lane * 2) = f2bf(bt); *(LAS bf16_t*)(SC + 2176 + t * 136 + lane * 2) = f2bf(kt);
                        btv[s] = bt; ktv[s] = kt;
                    }
#pragma unroll
                    for (int s = 0; s < 4; ++s) { btp[4 * hb + s] = cvt_pk_bf16(btv[2 * s], btv[2 * s + 1]); ktp[4 * hb + s] = cvt_pk_bf16(ktv[2 * s], ktv[2 * s + 1]); }
                }
                {
                    LAS u32x2* bq = (LAS u32x2*)(SL + RC_BTT + lane * 40); LAS u32x2* kq2 = (LAS u32x2*)(SL + RC_KTT + lane * 40);
#pragma unroll
                    for (int q = 0; q < 4; ++q) { bq[q] = (u32x2){btp[2 * q], btp[2 * q + 1]}; kq2[q] = (u32x2){ktp[2 * q], ktp[2 * q + 1]}; }
                    *(LAS float*)(SL + RC_WC + lane * 4) = Wp;
                    u32x2 vt; vt.x = (unsigned)vq[0] | ((unsigned)vq[1] << 16); vt.y = (unsigned)vq[2] | ((unsigned)vq[3] << 16);
                    *(LAS u32x2*)(SL + RC_VTF + lane * 8) = vt;
                }
                if (n + 7 < RC_NCH) RC_LOADS(n + 7);
                asm volatile("s_waitcnt lgkmcnt(0)" ::: "memory");
                f32x4 G1 = {0.f, 0.f, 0.f, 0.f}, G2 = G1, G3 = G1, G4 = G1, G1t = G1;
#pragma unroll
                for (int ks = 0; ks < 2; ++ks) {
                    const bf16x8 fb = *(const LAS bf16x8*)(SC + l15 * 136 + (32 * ks + 8 * kg) * 2), fk = *(const LAS bf16x8*)(SC + 2176 + l15 * 136 + (32 * ks + 8 * kg) * 2);
                    const bf16x8 fa = *(const LAS bf16x8*)(SL + RC_AT + l15 * 136 + (32 * ks + 8 * kg) * 2), fr_ = *(const LAS bf16x8*)(SL + RC_RT + l15 * 136 + (32 * ks + 8 * kg) * 2);
                    G1 = __builtin_amdgcn_mfma_f32_16x16x32_bf16(fb, fa, G1, 0, 0, 0); G2 = __builtin_amdgcn_mfma_f32_16x16x32_bf16(fk, fa, G2, 0, 0, 0);
                    G1t = __builtin_amdgcn_mfma_f32_16x16x32_bf16(fa, fb, G1t, 0, 0, 0);
                    G3 = __builtin_amdgcn_mfma_f32_16x16x32_bf16(fb, fr_, G3, 0, 0, 0); G4 = __builtin_amdgcn_mfma_f32_16x16x32_bf16(fk, fr_, G4, 0, 0, 0);
                }
                {
#pragma unroll
                    for (int e = 0; e < 4; ++e) { const int s = 4 * kg + e; const bool lt = s < l15, le = s <= l15;
                        G1[e] = lt ? G1[e] : 0.f; G1t[e] = (l15 < s) ? G1t[e] : 0.f; G2[e] = lt ? G2[e] : 0.f; G3[e] = le ? G3[e] : 0.f; G4[e] = le ? G4[e] : 0.f; }
                    u32x2 g2, g3, g4; g2.x = cvt_pk_bf16(G2.x, G2.y); g2.y = cvt_pk_bf16(G2.z, G2.w); g3.x = cvt_pk_bf16(G3.x, G3.y); g3.y = cvt_pk_bf16(G3.z, G3.w); g4.x = cvt_pk_bf16(G4.x, G4.y); g4.y = cvt_pk_bf16(G4.z, G4.w);
                    *(LAS u32x2*)(SL + RC_G3F + lane * 8) = g3;
                    u32x2 vt; vt.x = (unsigned)vq[0] | ((unsigned)vq[1] << 16); vt.y = (unsigned)vq[2] | ((unsigned)vq[3] << 16);
                    const s16x4v vtf = *reinterpret_cast<s16x4v*>(&vt);
                    f32x4 P1 = {0.f, 0.f, 0.f, 0.f}, P2 = P1;
                    P1 = __builtin_amdgcn_mfma_f32_16x16x16bf16_1k(*reinterpret_cast<s16x4v*>(&g2), vtf, P1, 0, 0, 0);
                    P2 = __builtin_amdgcn_mfma_f32_16x16x16bf16_1k(*reinterpret_cast<s16x4v*>(&g4), vtf, P2, 0, 0, 0);
                    *(LAS f32x4*)(SL + RC_P1 + lane * 16) = P1; *(LAS f32x4*)(SL + RC_P2 + lane * 16) = P2;
#define RC_BF(v) ({ u32x2 t_; t_.x = cvt_pk_bf16((v).x, (v).y); t_.y = cvt_pk_bf16((v).z, (v).w); *reinterpret_cast<s16x4v*>(&t_); })
                    const f32x4 Z4 = {0.f, 0.f, 0.f, 0.f};
                    const s16x4v n1 = RC_BF(G1), n1t = RC_BF(G1t);
                    const f32x4 X2 = __builtin_amdgcn_mfma_f32_16x16x16bf16_1k(n1t, n1, Z4, 0, 0, 0), X2t = __builtin_amdgcn_mfma_f32_16x16x16bf16_1k(n1, n1t, Z4, 0, 0, 0);
                    const s16x4v n2 = RC_BF(X2), n2t = RC_BF(X2t);
                    const f32x4 X4 = __builtin_amdgcn_mfma_f32_16x16x16bf16_1k(n2t, n2, Z4, 0, 0, 0), X4t = __builtin_amdgcn_mfma_f32_16x16x16bf16_1k(n2, n2t, Z4, 0, 0, 0);
                    const s16x4v n4 = RC_BF(X4), n4t = RC_BF(X4t);
                    f32x4 Tm = __builtin_amdgcn_mfma_f32_16x16x16bf16_1k(n4t, n4, Z4, 0, 0, 0);
#pragma unroll
                    for (int e = 0; e < 4; ++e) Tm[e] += (4 * kg + e == l15) ? 1.f : 0.f;
                    Tm = __builtin_amdgcn_mfma_f32_16x16x16bf16_1k(n4t, RC_BF(Tm), Tm, 0, 0, 0);
                    Tm = __builtin_amdgcn_mfma_f32_16x16x16bf16_1k(n2t, RC_BF(Tm), Tm, 0, 0, 0);
                    Tm = __builtin_amdgcn_mfma_f32_16x16x16bf16_1k(n1t, RC_BF(Tm), Tm, 0, 0, 0);
                    { u32x2 tt; tt.x = cvt_pk_bf16(Tm.x, Tm.y); tt.y = cvt_pk_bf16(Tm.z, Tm.w); *(LAS u32x2*)(SL + RC_TT + lane * 8) = tt; }
#undef RC_BF
                }
                asm volatile("s_waitcnt lgkmcnt(0)" ::: "memory");
#if RC_SYNC
                __builtin_amdgcn_s_barrier();
#else
                if (lane == 0) flags[slot] = (unsigned)(n + 1);
#endif
            }
#if RC_SYNC
            if (p >= RC_NCH % 7) { __builtin_amdgcn_s_barrier(); __builtin_amdgcn_s_barrier(); }
#endif
        }
#undef RC_LOADS
        __syncthreads();
    }
}
__device__ __forceinline__ void rwkv_post(const Fr& F) {
    const bf16_t* Rr = slotY(F, 0); const bf16_t* K = slotY(F, 1); const bf16_t* V = slotY(F, 2); const bf16_t* GT = slotY(F, 3); const bf16_t* A = slotY(F, 5);
    const float* O32 = (const float*)slotU(F, 1); bf16_t* Z = slotU(F, 0);
    const float* k_a = F.in(24); const float* r_k = F.in(25); const float* lw = F.in(26); const float* lb = F.in(27);
    for (int r = F.gw; r < R; r += F.NGW) {
        const bool real = (r >= NPAD && r < NREAL);
        u32x2* zr = (u32x2*)(Z + (size_t)r * D) + F.lane;
        if (!real) { const u32x2 z = {0u, 0u};
#pragma unroll
            for (int it = 0; it < 16; ++it) zr[64 * it] = z;
            continue; }
#pragma unroll 2
        for (int it = 0; it < 16; ++it) {
            const size_t ci = (size_t)it * 64 + F.lane;
            const f32x4 o4 = ((const f32x4*)(O32 + (size_t)r * D))[ci];
            const u32x2 rr = ((const u32x2*)(Rr + (size_t)r * D))[ci], kk = ((const u32x2*)(K + (size_t)r * D))[ci], vv = ((const u32x2*)(V + (size_t)r * D))[ci], gg = ((const u32x2*)(GT + (size_t)r * D))[ci], aa = ((const u32x2*)(A + (size_t)r * D))[ci];
            const f32x4 ka4 = ((const f32x4*)k_a)[ci], rk4 = ((const f32x4*)r_k)[ci], lw4 = ((const f32x4*)lw)[ci], lb4 = ((const f32x4*)lb)[ci];
            const float mean = red16((o4.x + o4.y) + (o4.z + o4.w)) * (1.f / 64.f);
            const float d0 = o4.x - mean, d1 = o4.y - mean, d2 = o4.z - mean, d3 = o4.w - mean;
            const float var = red16((d0 * d0 + d1 * d1) + (d2 * d2 + d3 * d3)) * (1.f / 64.f);
            const float rs = __builtin_amdgcn_rsqf(var + 64e-5f);
            const float r0 = bflo(rr.x), r1 = bfhi(rr.x), r2 = bflo(rr.y), r3 = bfhi(rr.y);
            const float kp0 = bflo(kk.x) * (1.f + (bflo(aa.x) - 1.f) * ka4.x), kp1 = bfhi(kk.x) * (1.f + (bfhi(aa.x) - 1.f) * ka4.y), kp2 = bflo(kk.y) * (1.f + (bflo(aa.y) - 1.f) * ka4.z), kp3 = bfhi(kk.y) * (1.f + (bfhi(aa.y) - 1.f) * ka4.w);
            const float bs = red16((r0 * kp0 * rk4.x + r1 * kp1 * rk4.y) + (r2 * kp2 * rk4.z + r3 * kp3 * rk4.w));
            const float y0 = d0 * rs * lw4.x + lb4.x + bs * bflo(vv.x), y1 = d1 * rs * lw4.y + lb4.y + bs * bfhi(vv.x), y2 = d2 * rs * lw4.z + lb4.z + bs * bflo(vv.y), y3 = d3 * rs * lw4.w + lb4.w + bs * bfhi(vv.y);
            u32x2 w; w.x = cvt_pk_bf16(y0 * silu_f(bflo(gg.x)), y1 * silu_f(bfhi(gg.x))); w.y = cvt_pk_bf16(y2 * silu_f(bflo(gg.y)), y3 * silu_f(bfhi(gg.y)));
            zr[64 * it] = w;
        }
    }
}
}
namespace mk {
constexpr int LDS_BYTES = 147456;
constexpr int LDS_MISC = LDS_BYTES - 128;
struct Args { const float* in[29]; float* out; unsigned char* ws; };

#define MK_GEMM(EPI, e, Aptr, aps_, Bptr, M_, N_, K_) do { int kk_ = (K_); asm volatile("" : "+s"(kk_));     \
    pg8::Gemm g_{(const bf16_t*)(Aptr), (const bf16_t*)(Bptr), (M_), (N_), kk_, (size_t)(aps_)}; pg8::StaticOrder S_; S_.init((M_), (N_), F.G, F.bid); \
    pg8::gemm_phase<EPI, pg8::StaticOrder, false>(F.lds, g_, S_, e, nullptr); } while (0)

struct TailOrder { int pn;
    __device__ bool next(int i, pg8::Unit& u) const { if (i > 0 || pn < 0) return false; u.pm = 64; u.pn = pn; return true; }
    __device__ __forceinline__ void a_ready(const pg8::Unit&) const {}
    __device__ __forceinline__ void done(const pg8::Unit&) const {}
};
#define MK_GEMM1(EPI, e, aps_, NTOT_, L_) do { MK_GEMM(EPI, e, slotU(F, 0), aps_, wtin_of(F, L_), 16384, NTOT_, D); \
    if (F.bid < (NTOT_) / 256) { int kk_ = D; asm volatile("" : "+s"(kk_)); pg8::Gemm g_{(const bf16_t*)slotU(F, 0), (const bf16_t*)wtin_of(F, L_), R, (NTOT_), kk_, (size_t)(aps_)}; TailOrder St_{F.bid}; \
        pg8::gemm_phase<EPI, TailOrder, false, true>(F.lds, g_, St_, e, nullptr); } } while (0)
#define MK_GEMM2_NORM(prev, next, udst) do { \
    MK_GEMM(EpiY, ey, slotU(F, 0), 0, wtout, 16384, D, D); \
    GRID_BAR(); \
    if (F.bid < 16) { int kk_ = D; asm volatile("" : "+s"(kk_)); pg8::Gemm g_{(const bf16_t*)slotU(F, 0), (const bf16_t*)wtout, R, D, kk_, (size_t)0}; TailOrder St_{F.bid}; \
        pg8::gemm_phase<EpiY, TailOrder, false>(F.lds, g_, St_, ey, nullptr); } \
    else { const Fr P = F.fresh(); norm_phase(P, prev, next, slotY(P, 0), udst, 0, 16384, 16); } \
    GRID_BAR(); \
    { const Fr P = F.fresh(); norm_phase(P, prev, next, slotY(P, 0), udst, 16384, R, 0); if ((next) >= 0) convert_layer(P, next, (next) == 3); } \
    GRID_BAR(); } while (0)

__global__ void __launch_bounds__(512, 2) fwd(Args a) {
    extern __shared__ __attribute__((aligned(16))) unsigned char lds_raw[];
    Fr F;
    F.lds = (LAS unsigned char*)lds_raw; F.ldsg = lds_raw;
    F.tid = threadIdx.x; F.lane = F.tid & 63; F.wave = __builtin_amdgcn_readfirstlane(F.tid >> 6);
    F.G = gridDim.x; F.bid = blockIdx.x; F.gw = F.bid * 8 + F.wave; F.NGW = F.G * 8;
    F.out = a.out; F.ws = a.ws;
    volatile LAS unsigned* misc = (volatile LAS unsigned*)(F.lds + LDS_MISC);
    if (F.tid < 16) misc[F.tid] = 0u;
    __syncthreads();
    XcdBarrier bar = xcd_barrier_post((unsigned*)(F.ws + WS_CTL) + 4096, misc + 8);
#define GRID_BAR() xcd_barrier(bar)
#ifndef MK_DUP
#define MK_DUP 0
#endif
#define DUPN(k, ...) do { __VA_ARGS__; if ((MK_DUP >> (k)) & 1) { GRID_BAR(); __VA_ARGS__; } } while (0)
    bf16_t* wtout = (bf16_t*)(F.ws + WS_WTOUT);
    const EpiY ey{slotY(F, 0)};

    DUPN(11, { const Fr P = F.fresh(); convert_layer(P, 0, true); rope_table(P); norm_phase(P, -1, 0, nullptr, slotU(P, 0)); });
    GRID_BAR();
    { const EpiH1 e{slotY(F, 0), F.in(5), 0}; MK_GEMM1(EpiH1, e, 0, 4 * D, 0); }
    if (F.bid >= 64) { const Fr P = F.fresh(); convert_win(P, 1, 64); }
    GRID_BAR();
    DUPN(1, { const Fr P = F.fresh(); hgrn_phase<false>(P, 0); });
    GRID_BAR();
    DUPN(2, { const Fr P = F.fresh(); hgrn_phase<true>(P, 0); });
    GRID_BAR();
    MK_GEMM2_NORM(0, 1, slotU(F, 0));
    { const EpiB1 e{slotY(F, 0), (const float*)(F.ws + WS_ROPE), (const float*)(F.ws + WS_ROPE) + (size_t)R * 16}; MK_GEMM1(EpiB1, e, 0, 4 * D, 1); }
    if (F.bid >= 64) { const Fr P = F.fresh(); convert_win(P, 2, 64); }
    GRID_BAR();
    DUPN(3, { const Fr P = F.fresh(); attn_phase(P); });
    GRID_BAR();
    DUPN(4, { const Fr P = F.fresh(); attn_post(P); });
    GRID_BAR();
    MK_GEMM2_NORM(1, 2, slotY(F, 1));
    DUPN(7, { const Fr P = F.fresh(); mix_phase(P, slotY(P, 1)); convert_layer2_b(P); });
    GRID_BAR();
    { const EpiC1 e{slotY(F, 0), (bf16_t*)(F.ws + WS_T)}; MK_GEMM(EpiC1, e, slotU(F, 0), (size_t)R * D, wtin_of(F, 2), R, 4 * D + 512, D); }
    GRID_BAR();
    DUPN(9, { const EpiC2 e{slotY(F, 0), F.in(17), F.in(20)}; MK_GEMM(EpiC2, e, F.ws + WS_T, 0, F.ws + WS_W2P, R, 2 * D, 256); });
    { const Fr P = F.fresh(); rwkv_kknorm(P); }
    GRID_BAR();
    DUPN(5, { const Fr P = F.fresh(); rwkv_scan(P); });
    GRID_BAR();
    DUPN(6, { const Fr P = F.fresh(); rwkv_post(P); });
    GRID_BAR();
    MK_GEMM2_NORM(2, 3, slotU(F, 0));
    { const EpiH1 e{slotY(F, 0), F.in(5), 1}; MK_GEMM1(EpiH1, e, 0, 4 * D, 3); }
    GRID_BAR();
    { const Fr P = F.fresh(); hgrn_phase<false>(P, 1); }
    GRID_BAR();
    { const Fr P = F.fresh(); hgrn_phase<true>(P, 1); }
    GRID_BAR();
    MK_GEMM2_NORM(3, -1, (bf16_t*)nullptr);
}
}

extern "C" void kernel_launch(void* const* d_in, const int* in_sizes, int n_in, void* d_out, int out_size, void* d_ws, size_t ws_size, hipStream_t stream) {
    static int grid = 0;
    if (grid == 0) {
        if (n_in != 29 || out_size != 16384 * 4096 || ws_size < mk::WS_END) { fprintf(stderr, "kernel_launch: unexpected shapes (n_in %d out %d ws %zu need %zu)\n", n_in, out_size, ws_size, (size_t)mk::WS_END); grid = -1; return; }
        int dev = 0, cus = 0, per_cu = 0;
        if (hipGetDevice(&dev) != hipSuccess || hipDeviceGetAttribute(&cus, hipDeviceAttributeMultiprocessorCount, dev) != hipSuccess) { grid = -1; return; }
        if (hipFuncSetAttribute((const void*)mk::fwd, hipFuncAttributeMaxDynamicSharedMemorySize, mk::LDS_BYTES) != hipSuccess) { fprintf(stderr, "kernel_launch: hipFuncSetAttribute failed\n"); grid = -1; return; }
        if (hipOccupancyMaxActiveBlocksPerMultiprocessor(&per_cu, (const void*)mk::fwd, 512, mk::LDS_BYTES) != hipSuccess || per_cu < 1) { fprintf(stderr, "kernel_launch: occupancy query says %d\n", per_cu); }
        (void)hipGetLastError();
        grid = cus;
    }
    if (grid < 0) return;
    if (hipMemsetAsync((char*)d_ws + mk::WS_CTL, 0, mk::CTL_BYTES, stream) != hipSuccess) return;
    mk::Args a{};
    for (int i = 0; i < 29; ++i) a.in[i] = (const float*)d_in[i];
    a.out = (float*)d_out; a.ws = (unsigned char*)d_ws;
    hipLaunchKernelGGL(mk::fwd, dim3(grid), dim3(512), mk::LDS_BYTES, stream, a);
}
```

```cpp
#include <hip/hip_runtime.h>
#include <cstdio>
#include <cstdint>

#define LAS __attribute__((address_space(3)))
#define GAS __attribute__((address_space(1)))
typedef unsigned short bf16_t;
typedef short bf16x8 __attribute__((ext_vector_type(8)));
typedef short s16x4 __attribute__((ext_vector_type(4)));
typedef float f32x4 __attribute__((ext_vector_type(4)));
typedef float f32x16 __attribute__((ext_vector_type(16)));
typedef unsigned u32x4 __attribute__((ext_vector_type(4)));
typedef unsigned u32x2 __attribute__((ext_vector_type(2)));

namespace mk {
constexpr int D = 4096, NPAD = 48, NREAL = 16448, R = 16640, NCH = 257;
constexpr size_t MiB = 1u << 20;
constexpr size_t SLOT = (size_t)R * D * 2;
constexpr size_t WS_CTL = 0, CTL_BYTES = 1 * MiB;
constexpr size_t WS_WTIN = 2 * MiB;
constexpr size_t WS_WTOUT = 134 * MiB;
constexpr size_t WS_W2P = 166 * MiB;
constexpr size_t WS_ROPE = 170 * MiB;
constexpr size_t WS_HMETA = 174 * MiB;
constexpr size_t WS_HE = 175 * MiB;
constexpr size_t WS_HLOGD = 191 * MiB;
constexpr size_t WS_U = 192 * MiB;
constexpr size_t WS_Y = WS_U + 6 * SLOT;
constexpr size_t WS_T = WS_Y + 6 * SLOT;
constexpr size_t WS_WTINB = WS_U + 4 * SLOT;
constexpr size_t WS_HB = (WS_T + (size_t)R * 256 * 2 + MiB - 1) / MiB * MiB;
constexpr size_t WS_END = WS_HB + SLOT;
static_assert(WS_END <= 2040 * MiB, "d_ws map");

typedef __bf16 bf16x2n_t __attribute__((ext_vector_type(2)));
typedef float f32x2n_t __attribute__((ext_vector_type(2)));
__device__ __forceinline__ unsigned cvt_pk_bf16(float lo, float hi) { const f32x2n_t v = {lo, hi}; const bf16x2n_t r = __builtin_convertvector(v, bf16x2n_t); return __builtin_bit_cast(unsigned, r); }
__device__ __forceinline__ float bflo(unsigned w) { return __uint_as_float(w << 16); }
__device__ __forceinline__ float bfhi(unsigned w) { return __uint_as_float(w & 0xffff0000u); }
__device__ __forceinline__ float bf2f(bf16_t b) { return __uint_as_float(((unsigned)b) << 16); }
__device__ __forceinline__ bf16_t f2bf(float f) { return (bf16_t)(cvt_pk_bf16(f, f) & 0xffffu); }
__device__ __forceinline__ float sigmoid_f(float x) { return 1.f / (1.f + __expf(-x)); }
__device__ __forceinline__ float silu_f(float x) { return x / (1.f + __expf(-x)); }
__device__ __forceinline__ float wave_sum(float v) {
#pragma unroll
    for (int o = 1; o < 64; o <<= 1) v += __shfl_xor(v, o);
    return v;
}
template <int CTRL> __device__ __forceinline__ float dppf(float v) { return __int_as_float(__builtin_amdgcn_update_dpp(0, __float_as_int(v), CTRL, 0xf, 0xf, true)); }
__device__ __forceinline__ float red4(float v) { v += dppf<0xB1>(v); v += dppf<0x4E>(v); return v; }
__device__ __forceinline__ float red8(float v) { v = red4(v); v += dppf<0x141>(v); return v; }
__device__ __forceinline__ float red16(float v) { v = red8(v); v += dppf<0x140>(v); return v; }
#define LDS_WAIT() asm volatile("s_waitcnt lgkmcnt(0)" ::: "memory")
}
#define XB_TMO      128
#define XB_XCNT(j)  (256  + 64 * (j))
#define XB_XSUB(j)  (1280 + 64 * (j))
#define XB_XGEN(j)  (2304 + 64 * (j))
#define XB_TOP      3328
#define XB_TOPGEN   3392
#define XCD_BAR_WORDS 3456
#define XB_SPIN_CAP (1u << 18)
#define LAS __attribute__((address_space(3)))

__device__ __forceinline__ unsigned xb_ld(unsigned* p)              { return __hip_atomic_load(p, __ATOMIC_RELAXED, __HIP_MEMORY_SCOPE_AGENT); }
__device__ __forceinline__ unsigned xb_add(unsigned* p, unsigned v) { return __hip_atomic_fetch_add(p, v, __ATOMIC_RELAXED, __HIP_MEMORY_SCOPE_AGENT); }
__device__ __forceinline__ unsigned xb_xcc_id() { return (unsigned)__builtin_amdgcn_s_getreg((3 << 11) | 20) & 0xFu; }
#define XB_SPIN(cond, bar) do { unsigned _sp = 0; while (cond) { __builtin_amdgcn_s_sleep(1); \
    if ((++_sp & 255u) == 0u) { if (xb_ld(&(bar)[XB_TMO])) break; if (_sp > XB_SPIN_CAP) { atomicAdd(&(bar)[XB_TMO], 1u); break; } } } } while (0)

struct XcdBarrier {
    unsigned* bar; unsigned x;
    volatile LAS unsigned* st;
};

__device__ __forceinline__ XcdBarrier xcd_barrier_post(unsigned* bar, volatile LAS unsigned* st) {
    XcdBarrier b; b.bar = bar; b.x = xb_xcc_id(); b.st = st;
    if (threadIdx.x == 0) (void)xb_add(&bar[XB_XCNT(b.x)], 1u);
    return b;
}
__device__ __forceinline__ void xcd_barrier_complete(unsigned* bar, unsigned x, unsigned& nloc, unsigned& nx) {
    const unsigned G = gridDim.x * gridDim.y * gridDim.z;
    unsigned sum, cnt, mine, sp = 0u;
    for (;;) {
        sum = 0u; cnt = 0u; mine = 0u;
#pragma unroll
        for (unsigned j = 0; j < 16; ++j) { const unsigned c = xb_ld(&bar[XB_XCNT(j)]); sum += c; cnt += (c > 0u) ? 1u : 0u; mine = (j == x) ? c : mine; }
        if (sum == G) break;
        __builtin_amdgcn_s_sleep(1);
        if ((++sp & 255u) == 0u) { if (xb_ld(&bar[XB_TMO])) break; if (sp > XB_SPIN_CAP) { atomicAdd(&bar[XB_TMO], 1u); break; } }
    }
    nloc = mine > 0u ? mine : 1u; nx = cnt > 0u ? cnt : 1u;
}

__device__ __forceinline__ void xcd_barrier(const XcdBarrier& b) {
    asm volatile("s_waitcnt vmcnt(0)" ::: "memory");
    __syncthreads();
    if (threadIdx.x == 0) {
        unsigned* bar = b.bar;
        __builtin_amdgcn_s_waitcnt(0);
        unsigned nloc = b.st[0], nx = b.st[1];
        if (nloc == 0u) { xcd_barrier_complete(bar, b.x, nloc, nx); b.st[0] = nloc; b.st[1] = nx; }
        const unsigned old = xb_add(&bar[XB_XSUB(b.x)], 1u);
        const unsigned gen = old / nloc;
        if (old + 1u == (gen + 1u) * nloc) {
            __builtin_amdgcn_fence(__ATOMIC_RELEASE, "agent");
            asm volatile("s_waitcnt vmcnt(0)" ::: "memory");
            const unsigned og = xb_add(&bar[XB_TOP], 1u);
            const unsigned tg = og / nx;
            if (og + 1u == (tg + 1u) * nx) xb_add(&bar[XB_TOPGEN], 1u);
            else XB_SPIN(xb_ld(&bar[XB_TOPGEN]) == tg, bar);
            __builtin_amdgcn_fence(__ATOMIC_ACQUIRE, "agent");
            xb_add(&bar[XB_XGEN(b.x)], 1u);
            asm volatile("s_waitcnt vmcnt(0)" ::: "memory");
        } else {
            XB_SPIN(xb_ld(&bar[XB_XGEN(b.x)]) == gen, bar);
            __builtin_amdgcn_fence(__ATOMIC_ACQUIRE, "agent");
            asm volatile("s_waitcnt vmcnt(0)" ::: "memory");
        }
    }
    __syncthreads();
}
namespace pg8 {
#define PG8_LAS __attribute__((address_space(3)))
typedef unsigned short bf16_t;
typedef short bf16x8 __attribute__((ext_vector_type(8)));
typedef float f32x4 __attribute__((ext_vector_type(4)));
typedef unsigned u32x4 __attribute__((ext_vector_type(4)));
constexpr int BM = 256, BK = 64, HALF = 128, HTB = HALF * BK * 2  , STAGE_BYTES = 8 * HTB, NXCD = 8, WGM = 8;

__host__ __device__ __forceinline__ int lds_byte(int r, int c) { const int st = (r >> 4) * 2 + (c >> 5), rr = r & 15, cc = c & 31, ob = rr * 64 + cc * 2; return st * 1024 + (ob ^ (((ob >> 9) & 1) << 5)); }
__host__ __device__ __forceinline__ void stage_rc(int b, int& R, int& C) { const int st = b / 1024, sb = b % 1024, swz = sb ^ (((sb >> 9) & 1) << 5); R = (st >> 1) * 16 + swz / 64; C = (st & 1) * 32 + (swz % 64) / 2; }
__host__ __device__ __forceinline__ int perm32(int rho) { const int n = rho >> 4, i = rho & 15; return 8 * (i >> 2) + 4 * n + (i & 3); }

struct Unit { int pm, pn; };
struct Gemm { const bf16_t* A; const bf16_t* Bt; int M, N, K; size_t aps; };
__device__ __forceinline__ size_t a_part_bytes(const Gemm& g, int pn) { return g.aps ? (size_t)(pn < 64 ? (pn >> 4) : (pn - 60)) * g.aps * 2 : (size_t)0; }

struct StaticOrder {
    int nM, nN, nwg, G, c;
    __host__ __device__ void init(int M, int N, int G_, int c_) { nM = M / BM; nN = N / BM; nwg = nM * nN; G = G_; c = c_; }
    __host__ __device__ bool next(int i, Unit& u) const {
        const long L = (long)i * G + c; if (L >= nwg) return false;
        int wgid = (int)L; { const int q = nwg / NXCD, r = nwg % NXCD, xcd = wgid % NXCD, off = wgid / NXCD; wgid = (xcd < r ? xcd * (q + 1) : r * (q + 1) + (xcd - r) * q) + off; }
        const int nig = WGM * nN, gid = wgid / nig, fm = gid * WGM, gsz = (nM - fm) < WGM ? (nM - fm) : WGM;
        u.pm = fm + ((wgid % nig) % gsz); u.pn = (wgid % nig) / gsz; return true;
    }
    __device__ __forceinline__ void a_ready(const Unit&) const {}
    __device__ __forceinline__ void done(const Unit&) const {}
};
struct CountedOrder : StaticOrder {
    const unsigned* ready; unsigned need; unsigned* tmo;
    __device__ __forceinline__ void a_ready(const Unit& u) const {
        if (threadIdx.x < 64) {
            const unsigned long long t0 = __builtin_amdgcn_s_memrealtime(); unsigned polls = 0;
            while ((unsigned)__builtin_amdgcn_readfirstlane(__hip_atomic_load(ready + 64 * u.pm, __ATOMIC_RELAXED, __HIP_MEMORY_SCOPE_AGENT)) < need) {
                if ((++polls & 255u) == 0u && __builtin_amdgcn_readfirstlane(__hip_atomic_load(tmo, __ATOMIC_RELAXED, __HIP_MEMORY_SCOPE_AGENT)) != 0u) break;
                if (__builtin_amdgcn_s_memrealtime() - t0 > 2000000ull) {
                    if (threadIdx.x == 0) { unsigned expect = 0u; __hip_atomic_compare_exchange_strong(tmo + 1, &expect, 0x600u | (unsigned)(u.pm & 0xff), __ATOMIC_RELAXED, __ATOMIC_RELAXED, __HIP_MEMORY_SCOPE_AGENT); __hip_atomic_store(tmo, 1u, __ATOMIC_RELAXED, __HIP_MEMORY_SCOPE_AGENT); }
                    break; }
                __builtin_amdgcn_s_sleep(2); }
            __builtin_amdgcn_fence(__ATOMIC_ACQUIRE, "agent");
            asm volatile("s_waitcnt vmcnt(0)" ::: "memory");
        }
#if !defined(BROKEN_HOOK_NO_BARRIER)
        asm volatile("" ::: "memory"); __builtin_amdgcn_s_barrier(); asm volatile("" ::: "memory");
#endif
    }
};
template <class Epi, class Sched, bool STAMP = false, bool TOPHALF = false>
__device__ __forceinline__ void gemm_phase(PG8_LAS unsigned char* lds, const Gemm g, const Sched& S, const Epi& E, unsigned long long* stamps) {
    int tid_ = threadIdx.x; asm volatile("" : "+v"(tid_));
    const int tid = tid_, wid = __builtin_amdgcn_readfirstlane(tid >> 6), lane = tid & 63, wr = wid >> 2, wc = wid & 3, fr = lane & 15, fq = lane >> 4;
    const int K = g.K, nt = K / BK;
    int ts_lo = 0, ts_hi = 0, nts = 0; const unsigned long long rt_entry = STAMP ? (unsigned long long)wall_clock64() : 0ull;
#define PG8_STAMP() do { if (STAMP && wid == 0 && nts < 64) { const unsigned long long _c = (unsigned long long)clock64(); \
        ts_lo = (lane == nts) ? (int)(unsigned)_c : ts_lo; ts_hi = (lane == nts) ? (int)(unsigned)(_c >> 32) : ts_hi; ++nts; } } while (0)
    PG8_STAMP();
    unsigned voffA[2], voffB[2];
#pragma unroll
    for (int i = 0; i < 2; ++i) { int R, C; stage_rc(tid * 16 + i * 8192, R, C); const int Rb = Epi::PERM ? ((R & ~31) + perm32(R & 31)) : R;
        voffA[i] = (unsigned)(R * K + C) * 2u; voffB[i] = (unsigned)(Rb * K + C) * 2u; }
    const size_t kstep = (size_t)(BK * 2);
    const size_t hstep = (size_t)HALF * K * 2;
    const size_t tstep = 2 * hstep;
    const unsigned ldsw = (unsigned)wid * 1024u;
    const int aoff = lds_byte(wr * 64 + fr, fq * 8), boff = lds_byte(wc * 32 + fr, fq * 8);
#define PG8_SA(b, h) (((b) * 2 + (h)) * HTB)
#define PG8_SB(b, h) ((4 + (b) * 2 + (h)) * HTB)
#define PG8_STAGE(bufoff, gbase, voff) do { _Pragma("unroll") for (int _i = 0; _i < 2; ++_i) \
        __builtin_amdgcn_global_load_lds((const unsigned*)((const char*)(gbase) + (voff)[_i]), (PG8_LAS unsigned*)(lds + (bufoff) + ldsw + _i * 8192), 16, 0, 0); } while (0)
#define PG8_LDA(dst, b, h) do { _Pragma("unroll") for (int m = 0; m < 4; ++m) _Pragma("unroll") for (int k = 0; k < 2; ++k) dst[m][k] = *(const PG8_LAS bf16x8*)(lds + PG8_SA(b, h) + aoff + m * 2048 + k * 1024); } while (0)
#define PG8_LDB(dst, b, h) do { _Pragma("unroll") for (int n = 0; n < 2; ++n) _Pragma("unroll") for (int k = 0; k < 2; ++k) dst[n][k] = *(const PG8_LAS bf16x8*)(lds + PG8_SB(b, h) + boff + n * 2048 + k * 1024); } while (0)
#define PG8_MMA(ai, bj, At, Bt) do { __builtin_amdgcn_s_setprio(1); _Pragma("unroll") for (int m = 0; m < 4; ++m) _Pragma("unroll") for (int n = 0; n < 2; ++n) _Pragma("unroll") for (int k = 0; k < 2; ++k) \
        acc[ai][bj][m][n] = __builtin_amdgcn_mfma_f32_16x16x32_bf16(Bt[n][k], At[m][k], acc[ai][bj][m][n], 0, 0, 0); __builtin_amdgcn_s_setprio(0); } while (0)
#define PG8_WAIT_V(n) asm volatile("s_waitcnt vmcnt(" #n ")" ::: "memory")
#define PG8_WAIT_L(n) asm volatile("s_waitcnt lgkmcnt(" #n ")" ::: "memory")
#define PG8_BAR __builtin_amdgcn_s_barrier()
#define PG8_SCHED __builtin_amdgcn_sched_barrier(0)
    Unit cur, nxt; int ui = 0;
    if (!S.next(0, cur)) return;
    f32x4 acc[2][2][4][2];
#pragma unroll
    for (int a = 0; a < 2; ++a)
#pragma unroll
        for (int b = 0; b < 2; ++b)
#pragma unroll
            for (int m = 0; m < 4; ++m)
#pragma unroll
                for (int n = 0; n < 2; ++n) acc[a][b][m][n] = (f32x4){0.f, 0.f, 0.f, 0.f};
    bf16x8 At[4][2], B0[2][2], B1[2][2];
    const char* cA = (const char*)g.A + a_part_bytes(g, cur.pn) + (size_t)cur.pm * tstep; const char* cB = (const char*)g.Bt + (size_t)cur.pn * tstep;
    S.a_ready(cur);
    PG8_STAGE(PG8_SB(0, 0), cB, voffB); PG8_STAGE(PG8_SA(0, 0), cA, voffA); PG8_STAGE(PG8_SB(0, 1), cB + hstep, voffB); PG8_STAGE(PG8_SA(0, 1), cA + hstep, voffA);
    if (wr == 1) PG8_BAR;
    PG8_WAIT_V(4); PG8_BAR;
    PG8_STAGE(PG8_SB(1, 0), cB + kstep, voffB); PG8_STAGE(PG8_SA(1, 0), cA + kstep, voffA); PG8_STAGE(PG8_SB(1, 1), cB + hstep + kstep, voffB);
    PG8_WAIT_V(6); PG8_BAR;
    PG8_STAMP();
    for (;;) {
        const bool has_next = S.next(ui + 1, nxt);
        const char* nA = has_next ? (const char*)g.A + a_part_bytes(g, nxt.pn) + (size_t)nxt.pm * tstep : cA; const char* nB = has_next ? (const char*)g.Bt + (size_t)nxt.pn * tstep : cB;
        for (int t = 0; t < nt; t += 2) {
            const bool last = (t == nt - 2);
            const char* a1 = cA + (size_t)(t + 1) * kstep;
            const char* a2 = last ? nA : cA + (size_t)(t + 2) * kstep; const char* b2 = last ? nB : cB + (size_t)(t + 2) * kstep;
            const char* a3 = a2 + kstep; const char* b3 = b2 + kstep;
            if (last && has_next) S.a_ready(nxt);
            PG8_LDB(B0, 0, 0); PG8_SCHED; PG8_LDA(At, 0, 0); PG8_STAGE(PG8_SA(1, 1), a1 + hstep, voffA);
            PG8_WAIT_L(8); PG8_BAR; PG8_WAIT_L(0); PG8_MMA(0, 0, At, B0); PG8_BAR; PG8_SCHED;
            PG8_LDB(B1, 0, 1); PG8_STAGE(PG8_SB(0, 0), b2, voffB);
            PG8_BAR; PG8_WAIT_L(0); PG8_MMA(0, 1, At, B1); PG8_BAR;
            if constexpr (!TOPHALF) PG8_LDA(At, 0, 1); PG8_STAGE(PG8_SA(0, 0), a2, voffA);
            PG8_BAR; PG8_WAIT_L(0); if constexpr (!TOPHALF) PG8_MMA(1, 0, At, B0); PG8_BAR; PG8_SCHED;
            PG8_STAGE(PG8_SB(0, 1), b2 + hstep, voffB);
            PG8_WAIT_V(6); PG8_BAR; if constexpr (!TOPHALF) PG8_MMA(1, 1, At, B1); PG8_BAR;
            PG8_LDB(B0, 1, 0); PG8_SCHED; PG8_LDA(At, 1, 0); PG8_STAGE(PG8_SA(0, 1), a2 + hstep, voffA);
            PG8_WAIT_L(8); PG8_BAR; PG8_WAIT_L(0); PG8_MMA(0, 0, At, B0); PG8_BAR; PG8_SCHED;
            PG8_LDB(B1, 1, 1); PG8_STAGE(PG8_SB(1, 0), b3, voffB);
            PG8_BAR; PG8_WAIT_L(0); PG8_MMA(0, 1, At, B1); PG8_BAR;
            if constexpr (!TOPHALF) PG8_LDA(At, 1, 1); PG8_STAGE(PG8_SA(1, 0), a3, voffA);
            PG8_BAR; PG8_WAIT_L(0); if constexpr (!TOPHALF) PG8_MMA(1, 0, At, B0); PG8_BAR; PG8_SCHED;
            PG8_STAGE(PG8_SB(1, 1), b3 + hstep, voffB);
            PG8_WAIT_V(6); PG8_BAR; if constexpr (!TOPHALF) PG8_MMA(1, 1, At, B1); PG8_BAR;
        }
        PG8_STAMP();
        if constexpr (!Epi::AFTER_DRAIN) { E(acc, cur, wr, wc, fr, fq); S.done(cur); }
        PG8_STAMP();
        if (!has_next) break;
#pragma unroll
        for (int a = 0; a < 2; ++a)
#pragma unroll
            for (int b = 0; b < 2; ++b)
#pragma unroll
                for (int m = 0; m < 4; ++m)
#pragma unroll
                    for (int n = 0; n < 2; ++n) acc[a][b][m][n] = (f32x4){0.f, 0.f, 0.f, 0.f};
        cur = nxt; cA = nA; cB = nB; ++ui;
    }
    PG8_WAIT_V(0);
    if (wr == 0) PG8_BAR;
    PG8_BAR;
    if constexpr (Epi::AFTER_DRAIN) { E.fused(acc, cur, wr, wc, fr, fq, lds, wid, lane); S.done(cur); }
    PG8_STAMP();
    if (STAMP && wid == 0) { stamps[lane] = lane < nts ? (((unsigned long long)(unsigned)ts_hi << 32) | (unsigned)ts_lo) : 0ull;
        if (lane == 62) stamps[62] = rt_entry; if (lane == 63) stamps[63] = (unsigned long long)wall_clock64(); }
#undef PG8_STAMP
#undef PG8_SA
#undef PG8_SB
#undef PG8_STAGE
#undef PG8_LDA
#undef PG8_LDB
#undef PG8_MMA
#undef PG8_WAIT_V
#undef PG8_WAIT_L
#undef PG8_BAR
#undef PG8_SCHED
}
}
namespace mk {
typedef pg8::Unit Unit;
typedef const pg8::f32x4 (&AccRef)[2][2][4][2];

__device__ __forceinline__ void st_bf8(bf16_t* p, pg8::f32x4 v0, pg8::f32x4 v1) {
    u32x4 w; w.x = cvt_pk_bf16(v0[0], v0[1]); w.y = cvt_pk_bf16(v0[2], v0[3]); w.z = cvt_pk_bf16(v1[0], v1[1]); w.w = cvt_pk_bf16(v1[2], v1[3]);
    *(u32x4*)p = w;
}
__device__ __forceinline__ void st_bf4(bf16_t* p, pg8::f32x4 v) { u32x2 w; w.x = cvt_pk_bf16(v[0], v[1]); w.y = cvt_pk_bf16(v[2], v[3]); *(u32x2*)p = w; }

struct EpiY {
    static constexpr bool PERM = true, AFTER_DRAIN = false;
    bf16_t* O;
    __device__ __forceinline__ void operator()(AccRef acc, const Unit& u, int wr, int wc, int fr, int fq) const {
        const int row0 = u.pm * 256 + wr * 64 + fr, col0 = u.pn * 256 + wc * 32 + 8 * fq;
#pragma unroll
        for (int ai = 0; ai < 2; ++ai)
#pragma unroll
            for (int m = 0; m < 4; ++m) { bf16_t* rowp = O + (size_t)(row0 + ai * 128 + m * 16) * D + col0;
#pragma unroll
                for (int bj = 0; bj < 2; ++bj) st_bf8(rowp + bj * 128, acc[ai][bj][m][0], acc[ai][bj][m][1]); }
    }
};
struct EpiH1 {
    static constexpr bool PERM = true, AFTER_DRAIN = false;
    bf16_t* Y; const float* lbl; int jl;
    __device__ __forceinline__ void operator()(AccRef acc, const Unit& u, int wr, int wc, int fr, int fq) const {
        const int part = u.pn >> 4, colt = (u.pn & 15) * 256;
        const int row0 = u.pm * 256 + wr * 64 + fr, col0 = colt + wc * 32 + 8 * fq;
        if (part == 1) {
#pragma unroll
            for (int bj = 0; bj < 2; ++bj) {
                pg8::f32x4 lbv[2] = {{0.f, 0.f, 0.f, 0.f}, {0.f, 0.f, 0.f, 0.f}};
                if (jl) {
#pragma unroll
                    for (int n = 0; n < 2; ++n) { const pg8::f32x4 l0 = *(const pg8::f32x4*)(lbl + col0 + bj * 128 + 4 * n), l1 = *(const pg8::f32x4*)(lbl + D + col0 + bj * 128 + 4 * n);
#pragma unroll
                        for (int j = 0; j < 4; ++j) lbv[n][j] = sigmoid_f(l1[j] - l0[j]); }
                }
#pragma unroll
                for (int ai = 0; ai < 2; ++ai)
#pragma unroll
                    for (int m = 0; m < 4; ++m) {
                        const int row = row0 + ai * 128 + m * 16;
                        pg8::f32x4 o[2];
#pragma unroll
                        for (int n = 0; n < 2; ++n)
#pragma unroll
                            for (int j = 0; j < 4; ++j) {
                                const float x = acc[ai][bj][m][n][j]; float g;
                                if (jl) { const float l = lbv[n][j]; g = __logf(l + (1.f - l) * sigmoid_f(x)); }
                                else g = fminf(x, 0.f) - __logf(1.f + __expf(-fabsf(x)));
                                o[n][j] = (row < NPAD) ? 0.f : g;
                            }
                        float* gp = (float*)(Y + 3 * (SLOT / 2)) + (size_t)row * D + col0 + bj * 128;
                        *(pg8::f32x4*)gp = o[0]; *(pg8::f32x4*)(gp + 4) = o[1];
                    }
            }
        } else {
            bf16_t* dst = Y + (size_t)(part == 0 ? 0 : (part == 2 ? 1 : 2)) * (SLOT / 2);
#pragma unroll
            for (int ai = 0; ai < 2; ++ai)
#pragma unroll
                for (int m = 0; m < 4; ++m) { bf16_t* rowp = dst + (size_t)(row0 + ai * 128 + m * 16) * D + col0;
#pragma unroll
                    for (int bj = 0; bj < 2; ++bj) st_bf8(rowp + bj * 128, acc[ai][bj][m][0], acc[ai][bj][m][1]); }
        }
    }
};
struct EpiB1 {
    static constexpr bool PERM = false, AFTER_DRAIN = false;
    bf16_t* Y; const float* cs; const float* sn;
    __device__ __forceinline__ void operator()(AccRef acc, const Unit& u, int wr, int wc, int fr, int fq) const {
        const int part = u.pn >> 4, colt = (u.pn & 15) * 256;
        const int row0 = u.pm * 256 + wr * 64 + fr, col0 = colt + wc * 32 + 4 * fq;
        bf16_t* dst = Y + (size_t)part * (SLOT / 2);
        const bool rope = (part < 2) && (wc == 0);
#pragma unroll
        for (int ai = 0; ai < 2; ++ai)
#pragma unroll
            for (int m = 0; m < 4; ++m) {
                const int row = row0 + ai * 128 + m * 16;
                pg8::f32x4 c4 = {1.f, 1.f, 1.f, 1.f}, s4 = {0.f, 0.f, 0.f, 0.f};
                if (rope) { c4 = *(const pg8::f32x4*)(cs + (size_t)row * 16 + 4 * fq); s4 = *(const pg8::f32x4*)(sn + (size_t)row * 16 + 4 * fq); }
                bf16_t* rowp = dst + (size_t)row * D + col0;
#pragma unroll
                for (int bj = 0; bj < 2; ++bj) {
                    const pg8::f32x4 x1 = acc[ai][bj][m][0], x2 = acc[ai][bj][m][1];
                    const pg8::f32x4 y1 = x1 * c4 - x2 * s4, y2 = x2 * c4 + x1 * s4;
                    st_bf4(rowp + bj * 128, y1); st_bf4(rowp + bj * 128 + 16, y2);
                }
            }
    }
};
struct EpiC1 {
    static constexpr bool PERM = true, AFTER_DRAIN = false;
    bf16_t *Y, *T;
    __device__ __forceinline__ void operator()(AccRef acc, const Unit& u, int wr, int wc, int fr, int fq) const {
        const int row0 = u.pm * 256 + wr * 64 + fr;
        if (u.pn < 64) {
            const int part = u.pn >> 4, col0 = (u.pn & 15) * 256 + wc * 32 + 8 * fq;
            bf16_t* dst = Y + (size_t)part * (SLOT / 2);
#pragma unroll
            for (int ai = 0; ai < 2; ++ai)
#pragma unroll
                for (int m = 0; m < 4; ++m) { bf16_t* rowp = dst + (size_t)(row0 + ai * 128 + m * 16) * D + col0;
#pragma unroll
                    for (int bj = 0; bj < 2; ++bj) st_bf8(rowp + bj * 128, acc[ai][bj][m][0], acc[ai][bj][m][1]); }
        } else {
            const int which = u.pn - 64, col0 = which * 128 + wc * 32 + 8 * fq;
#pragma unroll
            for (int ai = 0; ai < 2; ++ai)
#pragma unroll
                for (int m = 0; m < 4; ++m) {
                    pg8::f32x4 v0 = acc[ai][0][m][0], v1 = acc[ai][0][m][1];
                    if (which == 0) {
#pragma unroll
                        for (int j = 0; j < 4; ++j) { v0[j] = 1.f - 2.f / (1.f + __expf(2.f * v0[j])); v1[j] = 1.f - 2.f / (1.f + __expf(2.f * v1[j])); }
                    }
                    st_bf8(T + (size_t)(row0 + ai * 128 + m * 16) * 256 + col0, v0, v1);
                }
        }
    }
};
struct EpiC2 {
    static constexpr bool PERM = true, AFTER_DRAIN = false;
    bf16_t* Y; const float* w0; const float* a0;
    __device__ __forceinline__ void operator()(AccRef acc, const Unit& u, int wr, int wc, int fr, int fq) const {
        const int row0 = u.pm * 256 + wr * 64 + fr;
        const bool isw = u.pn < 16;
        const int col0 = (u.pn & 15) * 256 + wc * 32 + 8 * fq;
        bf16_t* dst = Y + (size_t)(isw ? 4 : 5) * (SLOT / 2); const float* bias = isw ? w0 : a0;
#pragma unroll
        for (int bj = 0; bj < 2; ++bj) {
            const pg8::f32x4 b0 = *(const pg8::f32x4*)(bias + col0 + bj * 128), b1 = *(const pg8::f32x4*)(bias + col0 + bj * 128 + 4);
#pragma unroll
            for (int ai = 0; ai < 2; ++ai)
#pragma unroll
                for (int m = 0; m < 4; ++m) {
                    pg8::f32x4 v0 = acc[ai][bj][m][0] + b0, v1 = acc[ai][bj][m][1] + b1;
#pragma unroll
                    for (int j = 0; j < 4; ++j) {
                        float s0 = sigmoid_f(v0[j]), s1 = sigmoid_f(v1[j]);
                        if (isw) { s0 = __expf(-0.606531f * s0); s1 = __expf(-0.606531f * s1); }
                        v0[j] = s0; v1[j] = s1;
                    }
                    st_bf8(dst + (size_t)(row0 + ai * 128 + m * 16) * D + col0 + bj * 128, v0, v1);
                    __builtin_amdgcn_sched_barrier(0);
                }
        }
    }
};

struct Fr {
    LAS unsigned char* lds; unsigned char* ldsg;
    int tid, lane, wave, G, bid, gw, NGW;
    float* out; unsigned char* ws;
    __device__ __forceinline__ Fr fresh() const { Fr P = *this; asm volatile("" : "+v"(P.tid)); P.lane = P.tid & 63; P.wave = __builtin_amdgcn_readfirstlane(P.tid >> 6); P.gw = P.bid * 8 + P.wave; return P; }
    __device__ __forceinline__ const float* in(int i) const {
        const __attribute__((address_space(4))) unsigned long long* ka = (const __attribute__((address_space(4))) unsigned long long*)__builtin_amdgcn_kernarg_segment_ptr();
        asm volatile("" : "+s"(ka));
        return (const float*)ka[i];
    }
};
__device__ __forceinline__ bf16_t* slotU(const Fr& F, int s) { return (bf16_t*)(F.ws + WS_U + (size_t)s * SLOT); }
__device__ __forceinline__ bf16_t* slotY(const Fr& F, int s) { return (bf16_t*)(F.ws + WS_Y + (size_t)s * SLOT); }
__device__ __forceinline__ float* hrow(const Fr& F, int r) { return r < 64 ? (float*)(F.ws + WS_HMETA) + (size_t)r * D : F.out + (size_t)(r - 64) * D; }

__device__ __forceinline__ void transpose_item(const float* W, int ldw, bf16_t* WT, int ldt, int koff, LAS float* scr, int kb, int nb, int lane) {
    const int k0 = 64 * kb, n0 = 32 * nb;
#pragma unroll 8
    for (int i = 0; i < 32; ++i) { const int kk = 2 * i + (lane >> 5); scr[kk * 33 + (lane & 31)] = W[(size_t)(k0 + kk) * ldw + n0 + (lane & 31)]; }
    LDS_WAIT(); asm volatile("" ::: "memory");
    const int c = lane & 7;
#pragma unroll
    for (int j = 0; j < 4; ++j) { const int n = (lane >> 3) + 8 * j; const LAS float* s = scr + (8 * c) * 33 + n;
        u32x4 o; o.x = cvt_pk_bf16(s[0 * 33], s[1 * 33]); o.y = cvt_pk_bf16(s[2 * 33], s[3 * 33]); o.z = cvt_pk_bf16(s[4 * 33], s[5 * 33]); o.w = cvt_pk_bf16(s[6 * 33], s[7 * 33]);
        *(u32x4*)(WT + (size_t)(n0 + n) * ldt + koff + k0 + 8 * c) = o; }
    LDS_WAIT(); asm volatile("" ::: "memory");
}
__device__ __forceinline__ void convert_matrix(const Fr& F, const float* W, int K, int N, bf16_t* WT, int ldt, int koff, int wg_skip = 0) {
    LAS float* scr = (LAS float*)(F.lds + F.wave * 8704);
    const int nblk = N / 32, nitems = (K / 64) * nblk;
    for (int it = F.gw - wg_skip * 8; it < nitems; it += F.NGW - wg_skip * 8) transpose_item(W, N, WT, ldt, koff, scr, it / nblk, it % nblk, F.lane);
}
__device__ __forceinline__ void zero_bytes(const Fr& F, void* p, size_t nbytes) {
    u32x4* q = (u32x4*)p; const size_t n = nbytes / 16; const u32x4 z = {0u, 0u, 0u, 0u};
    for (size_t i = (size_t)F.bid * 512 + F.tid; i < n; i += (size_t)F.G * 512) q[i] = z;
}
__device__ __forceinline__ bf16_t* wtin_of(const Fr& F, int L) { return (bf16_t*)(F.ws + ((L & 1) ? WS_WTINB : WS_WTIN)); }
__device__ __forceinline__ void convert_win(const Fr& F, int L, int wg_skip) {
    const float* src = (L == 0 || L == 3) ? F.in(4) + (size_t)(L ? 1 : 0) * D * 4 * D : (L == 1 ? F.in(8) : F.in(16));
    convert_matrix(F, src, D, 4 * D, wtin_of(F, L), D, 0, wg_skip);
}
__device__ __forceinline__ void convert_layer(const Fr& F, int L, bool with_win) {
    bf16_t* wtin = wtin_of(F, L); bf16_t* wtout = (bf16_t*)(F.ws + WS_WTOUT);
    if (with_win) convert_win(F, L, 0);
    if (L == 0 || L == 3) {
        convert_matrix(F, F.in(7) + (size_t)(L ? 1 : 0) * D * D, D, D, wtout, D, 0);
    } else if (L == 1) {
        convert_matrix(F, F.in(14), D, D, wtout, D, 0);
    } else {
        convert_matrix(F, F.in(28), D, D, wtout, D, 0);
        convert_matrix(F, F.in(18), D, 128, wtin + (size_t)16384 * D, D, 0);
        convert_matrix(F, F.in(21), D, 128, wtin + (size_t)16640 * D, D, 0);
        zero_bytes(F, wtin + (size_t)16512 * D, (size_t)128 * D * 2);
        zero_bytes(F, wtin + (size_t)16768 * D, (size_t)128 * D * 2);
        bf16_t* w2p = (bf16_t*)(F.ws + WS_W2P);
        zero_bytes(F, w2p, (size_t)8192 * 256 * 2);
    }
}
__device__ __forceinline__ void convert_layer2_b(const Fr& F) {
    bf16_t* w2p = (bf16_t*)(F.ws + WS_W2P);
    convert_matrix(F, F.in(19), 128, D, w2p, 256, 0);
    convert_matrix(F, F.in(22), 128, D, w2p + (size_t)4096 * 256, 256, 128);
}

__constant__ float c_inv_freq[16] = {1.0f, 0.44036659598350525f, 0.1939227432012558f, 0.08539710193872452f, 0.03760603070259094f, 0.01656043902039528f, 0.007292664609849453f, 0.0032114458736032248f,
    0.0014142135623842478f, 0.000622772378847003f, 0.00027424818836152554f, 0.00012076973507646471f, 5.318296098266728e-05f, 2.34199997066753e-05f, 1.0313386155758053e-05f, 4.541670477919979e-06f};
__device__ __forceinline__ void rope_table(const Fr& F) {
    float* cs = (float*)(F.ws + WS_ROPE); float* sn = cs + (size_t)R * 16;
    for (int i = F.bid * 512 + F.tid; i < R * 16; i += F.G * 512) {
        const int row = i >> 4, j = i & 15; const int pos = row - NPAD;
        const double ang = (double)(float)((float)pos * c_inv_freq[j]);
        const double k = __builtin_rint(ang * 0.15915494309189535);
        double x = ang - k * 6.283185307179586;
        const double q = __builtin_rint(x * 0.6366197723675814);
        x -= q * 1.5707963267948966;
        const int qi = ((int)q) & 3;
        const double x2 = x * x;
        const double s = x * (1.0 + x2 * (-1.0 / 6 + x2 * (1.0 / 120 + x2 * (-1.0 / 5040 + x2 * (1.0 / 362880 + x2 * (-1.0 / 39916800))))));
        const double c = 1.0 + x2 * (-0.5 + x2 * (1.0 / 24 + x2 * (-1.0 / 720 + x2 * (1.0 / 40320 + x2 * (-1.0 / 3628800 + x2 * (1.0 / 479001600))))));
        double sv, cv;
        if (qi == 0) { sv = s; cv = c; } else if (qi == 1) { sv = c; cv = -s; } else if (qi == 2) { sv = -s; cv = -c; } else { sv = -c; cv = s; }
        cs[i] = (float)cv; sn[i] = (float)sv;
    }
}

typedef const GAS char* gcp; typedef GAS char* gp_;
#define ROW_F32(nm, base, lane) gp_ nm##0 = (gp_)(base) + (lane) * 16 + 4096; gp_ nm##1 = nm##0 + 8192; asm volatile("" : "+v"(nm##0), "+v"(nm##1))
#define AT_F32(nm, j) (*(GAS f32x4*)((j) < 8 ? nm##0 + ((j) - 4) * 1024 : nm##1 + ((j) - 12) * 1024))
#define ROW_BF(nm, base, lane) gp_ nm##0 = (gp_)(base) + (lane) * 8 + 4096; asm volatile("" : "+v"(nm##0))
#define AT_BF(nm, j) (*(GAS u32x2*)(nm##0 + (j) * 512 - 4096))
__device__ __forceinline__ void norm_phase(const Fr& F, int prev, int next, const bf16_t* y, bf16_t* udst, int rlo = 0, int rhi = R, int wg_skip = 0) {
    const float* postg = F.in(3) + (size_t)(prev < 0 ? 0 : prev) * D; const float* preg = F.in(2) + (size_t)(next < 0 ? 0 : next) * D;
    const float* xin = F.in(0); const float* meta = F.in(1);
    for (int r = rlo + F.gw - wg_skip * 8; r < rhi; r += F.NGW - wg_skip * 8) {
        if (r < NPAD || r >= NREAL) {
            if (next >= 0) { ROW_BF(uo, udst + (size_t)r * D, F.lane); const u32x2 z = {0u, 0u};
#pragma unroll
                for (int j = 0; j < 16; ++j) AT_BF(uo, j) = z; }
            continue;
        }
        ROW_BF(hp, (bf16_t*)(F.ws + WS_HB) + (size_t)r * D, F.lane);
        f32x4 hv[16];
        if (prev < 0) {
            const float* src = r < 64 ? meta + (size_t)(r - NPAD) * D : xin + (size_t)(r - 64) * D;
            ROW_F32(sp, src, F.lane);
#pragma unroll
            for (int j = 0; j < 16; ++j) hv[j] = AT_F32(sp, j);
        } else {
            ROW_BF(yp, y + (size_t)r * D, F.lane); ROW_F32(gp, postg, F.lane);
            u32x2 yv[16], hb[16]; float ss = 0.f;
#pragma unroll
            for (int j = 0; j < 16; ++j) { yv[j] = AT_BF(yp, j); hb[j] = AT_BF(hp, j); }
#pragma unroll
            for (int j = 0; j < 16; ++j) { const float a = bflo(yv[j].x), b = bfhi(yv[j].x), c = bflo(yv[j].y), d = bfhi(yv[j].y); ss += (a * a + b * b) + (c * c + d * d); }
#pragma unroll
            for (int j = 0; j < 16; ++j) asm volatile("" : "+v"(yv[j].x), "+v"(yv[j].y));
            const float rs = __builtin_amdgcn_rsqf(wave_sum(ss) * (1.f / D) + 1e-6f);
#pragma unroll
            for (int j = 0; j < 16; ++j) { const f32x4 g = AT_F32(gp, j);
                hv[j].x = bflo(hb[j].x) + bflo(yv[j].x) * rs * g.x; hv[j].y = bfhi(hb[j].x) + bfhi(yv[j].x) * rs * g.y; hv[j].z = bflo(hb[j].y) + bflo(yv[j].y) * rs * g.z; hv[j].w = bfhi(hb[j].y) + bfhi(yv[j].y) * rs * g.w; }
        }
        if (next < 0) {
            if (r >= 64) { ROW_F32(op, F.out + (size_t)(r - 64) * D, F.lane);
#pragma unroll
                for (int j = 0; j < 16; ++j) AT_F32(op, j) = hv[j];
            }
            continue;
        }
        float s2 = 0.f;
#pragma unroll
        for (int j = 0; j < 16; ++j) { u32x2 w_; w_.x = cvt_pk_bf16(hv[j].x, hv[j].y); w_.y = cvt_pk_bf16(hv[j].z, hv[j].w); AT_BF(hp, j) = w_; s2 += (hv[j].x * hv[j].x + hv[j].y * hv[j].y) + (hv[j].z * hv[j].z + hv[j].w * hv[j].w); }
        const float rs2 = __builtin_amdgcn_rsqf(wave_sum(s2) * (1.f / D) + 1e-6f);
        ROW_BF(uo, udst + (size_t)r * D, F.lane); ROW_F32(pg, preg, F.lane);
#pragma unroll
        for (int j = 0; j < 16; ++j) { const f32x4 g = AT_F32(pg, j); u32x2 w; w.x = cvt_pk_bf16(hv[j].x * rs2 * g.x, hv[j].y * rs2 * g.y); w.y = cvt_pk_bf16(hv[j].z * rs2 * g.z, hv[j].w * rs2 * g.w); AT_BF(uo, j) = w; }
    }
}
__device__ __forceinline__ void mix_phase(const Fr& F, const bf16_t* u) {
    const float* mu = F.in(15);
    for (int r = F.gw; r < R; r += F.NGW) {
        const bool real = (r >= NPAD && r < NREAL);
        u32x2 cur[16], prv[16];
        const u32x2 z = {0u, 0u};
        { ROW_BF(cp, u + (size_t)r * D, F.lane); ROW_BF(pp, u + (size_t)(r > 0 ? r - 1 : 0) * D, F.lane);
#pragma unroll
          for (int j = 0; j < 16; ++j) { cur[j] = real ? AT_BF(cp, j) : z; prv[j] = (real && r > NPAD) ? AT_BF(pp, j) : z; } }
#pragma unroll 1
        for (int s = 0; s < 6; ++s) {
            ROW_BF(op, slotU(F, s) + (size_t)r * D, F.lane); ROW_F32(mp, mu + (size_t)s * D, F.lane);
#pragma unroll
            for (int j = 0; j < 16; ++j) {
                const f32x4 m = AT_F32(mp, j);
                const float c0 = bflo(cur[j].x), c1 = bfhi(cur[j].x), c2 = bflo(cur[j].y), c3 = bfhi(cur[j].y);
                const float p0 = bflo(prv[j].x), p1 = bfhi(prv[j].x), p2 = bflo(prv[j].y), p3 = bfhi(prv[j].y);
                u32x2 w; w.x = cvt_pk_bf16(c0 + (p0 - c0) * m.x, c1 + (p1 - c1) * m.y); w.y = cvt_pk_bf16(c2 + (p2 - c2) * m.z, c3 + (p3 - c3) * m.w);
                AT_BF(op, j) = real ? w : z;
            }
        }
    }
}
}
namespace mk {
constexpr int H_QE = 0, H_KE = 17408, H_KET = 34816, H_VT = 53248, H_PM = 71680, H_STB = 80896, H_VEC = 115712;
__device__ __forceinline__ bf16x8 ldfrag(const LAS unsigned char* base, int stride_b, int rb, int ks, int lane) {
    return *(const LAS bf16x8*)(base + (16 * rb + (lane & 15)) * stride_b + (32 * ks + 8 * (lane >> 4)) * 2);
}
template <bool OUT>
__device__ __forceinline__ void hgrn_phase(const Fr& F, int jl) {
    const bf16_t* Q = slotY(F, 0); const bf16_t* V = slotY(F, 1); const bf16_t* GT = slotY(F, 2); const float* Gg = (const float*)slotY(F, 3);
    bf16_t* Z = slotU(F, 0);
    float* HE = (float*)(F.ws + WS_HE); float* HLD = (float*)(F.ws + WS_HLOGD);
    const float* gn = F.in(6) + (size_t)jl * 128;
    LAS unsigned char* L = F.lds;
    LAS float* qtot = (LAS float*)(L + H_VEC); LAS float* ebm = qtot + 512; LAS float* ebl = ebm + 128;
    const int tid = F.tid, lane = F.lane, w = F.wave;
    const int d = tid & 127, qt = tid >> 7;
    for (int unit = F.bid; unit < 256; unit += F.G) {
        const int h = unit >> 3, seg = unit & 7;
        if (!OUT && seg == 7) continue;
        const int c0 = seg == 0 ? 0 : 33 + 32 * (seg - 1), c1 = c0 + (seg == 0 ? 33 : 32);
        f32x4 S[8];
#pragma unroll
        for (int i = 0; i < 8; ++i) S[i] = (f32x4){0.f, 0.f, 0.f, 0.f};
        if (OUT) {
            for (int j = 0; j < seg; ++j) {
                const float* ld = HLD + (size_t)(h * 8 + j) * 128; const float* e = HE + ((size_t)(h * 8 + j) * 512 + tid) * 32;
#pragma unroll
                for (int di = 0; di < 8; ++di) { const f32x4 l4 = *(const f32x4*)(ld + 16 * di + 4 * (lane >> 4)); const f32x4 e4 = *(const f32x4*)(e + 4 * di);
                    S[di].x = S[di].x * __expf(l4.x) + e4.x; S[di].y = S[di].y * __expf(l4.y) + e4.y; S[di].z = S[di].z * __expf(l4.z) + e4.z; S[di].w = S[di].w * __expf(l4.w) + e4.w; }
            }
        }
        float logD = 0.f;
        float g[16]; bf16_t qv[16], vv[16]; u32x4 gt0 = {0u, 0u, 0u, 0u}, gt1 = gt0, ngt0 = gt0, ngt1 = gt0;
#define HG_LOAD(cc) do { const int rowb_ = 64 * (cc) + 16 * qt; const size_t colb_ = (size_t)h * 128 + d; \
            _Pragma("unroll") for (int i = 0; i < 16; ++i) { g[i] = Gg[(size_t)(rowb_ + i) * D + colb_]; vv[i] = V[(size_t)(rowb_ + i) * D + colb_]; if (OUT) qv[i] = Q[(size_t)(rowb_ + i) * D + colb_]; } \
            if (OUT) { const bf16_t* gp_ = GT + (size_t)(64 * (cc) + (tid >> 3)) * D + h * 128 + 16 * (tid & 7); ngt0 = *(const u32x4*)gp_; ngt1 = *(const u32x4*)(gp_ + 8); } } while (0)
        HG_LOAD(c0);
        for (int c = c0; c < c1; ++c) {
            if (OUT) { gt0 = ngt0; gt1 = ngt1; }
            float b[16]; float run = 0.f;
#pragma unroll
            for (int i = 0; i < 16; ++i) { run += g[i]; b[i] = run; }
            qtot[qt * 128 + d] = run;
            __syncthreads();
            const float t0 = qtot[d], t1 = qtot[128 + d], t2 = qtot[256 + d], t3 = qtot[384 + d];
            const float off = qt == 0 ? 0.f : (qt == 1 ? t0 : (qt == 2 ? t0 + t1 : t0 + t1 + t2));
            const float bm = t0 + t1, bl = (t0 + t1) + (t2 + t3);
            if (qt == 0) { ebm[d] = __expf(bm); ebl[d] = __expf(bl); logD += bl; }
            {
                unsigned kt[8], vt[8];
#pragma unroll
                for (int i = 0; i < 16; i += 2) {
                    const float b0 = b[i] + off, b1 = b[i + 1] + off;
                    const float k0 = 1.f - __expf(g[i]), k1 = 1.f - __expf(g[i + 1]);
                    const int t = 16 * qt + i;
                    if (OUT) {
                        *(LAS bf16_t*)(L + H_QE + (t * 136 + d) * 2) = f2bf(bf2f(qv[i]) * __expf(b0 - bm));
                        *(LAS bf16_t*)(L + H_QE + ((t + 1) * 136 + d) * 2) = f2bf(bf2f(qv[i + 1]) * __expf(b1 - bm));
                        *(LAS bf16_t*)(L + H_KE + (t * 136 + d) * 2) = f2bf(k0 * __expf(bm - b0));
                        *(LAS bf16_t*)(L + H_KE + ((t + 1) * 136 + d) * 2) = f2bf(k1 * __expf(bm - b1));
                    }
                    kt[i >> 1] = cvt_pk_bf16(k0 * __expf(bl - b0), k1 * __expf(bl - b1));
                    vt[i >> 1] = (unsigned)vv[i] | ((unsigned)vv[i + 1] << 16);
                }
                LAS u32x4* kp = (LAS u32x4*)(L + H_KET + (d * 72 + 16 * qt) * 2); kp[0] = (u32x4){kt[0], kt[1], kt[2], kt[3]}; kp[1] = (u32x4){kt[4], kt[5], kt[6], kt[7]};
                LAS u32x4* vp = (LAS u32x4*)(L + H_VT + (d * 72 + 16 * qt) * 2); vp[0] = (u32x4){vt[0], vt[1], vt[2], vt[3]}; vp[1] = (u32x4){vt[4], vt[5], vt[6], vt[7]};
            }
            if (c + 1 < c1) HG_LOAD(c + 1);
            __syncthreads();
            if (OUT) {
#pragma unroll
                for (int di = 0; di < 8; ++di) { const f32x4 m4 = *(const LAS f32x4*)(ebm + 16 * di + 4 * (lane >> 4)); u32x2 o; o.x = cvt_pk_bf16(S[di].x * m4.x, S[di].y * m4.y); o.y = cvt_pk_bf16(S[di].z * m4.z, S[di].w * m4.w);
                    *(LAS u32x2*)(L + H_STB + ((16 * w + (lane & 15)) * 136 + 16 * di + 4 * (lane >> 4)) * 2) = o; }
                const int ti = w >> 1;
#pragma unroll
                for (int s2 = 0; s2 < 2; ++s2) { const int si = 2 * (w & 1) + s2; f32x4 p = {0.f, 0.f, 0.f, 0.f};
                    if (si <= ti) {
#pragma unroll
                        for (int ks = 0; ks < 4; ++ks) p = __builtin_amdgcn_mfma_f32_16x16x32_bf16(ldfrag(L + H_QE, 272, ti, ks, lane), ldfrag(L + H_KE, 272, si, ks, lane), p, 0, 0, 0);
                    }
                    const int sidx = 16 * si + (lane & 15);
#pragma unroll
                    for (int jj = 0; jj < 4; ++jj) { const int tidx = 16 * ti + 4 * (lane >> 4) + jj; *(LAS bf16_t*)(L + H_PM + (tidx * 72 + sidx) * 2) = f2bf(sidx <= tidx ? p[jj] : 0.f); }
                }
                __syncthreads();
            }
            f32x4 O[4];
            if (OUT) {
#pragma unroll
                for (int ti = 0; ti < 4; ++ti) O[ti] = (f32x4){0.f, 0.f, 0.f, 0.f};
#pragma unroll
                for (int ks = 0; ks < 2; ++ks) { const bf16x8 bv = ldfrag(L + H_VT, 144, w, ks, lane);
#pragma unroll
                    for (int ti = 0; ti < 4; ++ti) O[ti] = __builtin_amdgcn_mfma_f32_16x16x32_bf16(ldfrag(L + H_PM, 144, ti, ks, lane), bv, O[ti], 0, 0, 0); }
#pragma unroll
                for (int ks = 0; ks < 4; ++ks) { const bf16x8 bs = ldfrag(L + H_STB, 272, w, ks, lane);
#pragma unroll
                    for (int ti = 0; ti < 4; ++ti) O[ti] = __builtin_amdgcn_mfma_f32_16x16x32_bf16(ldfrag(L + H_QE, 272, ti, ks, lane), bs, O[ti], 0, 0, 0); }
            }
            {
                const bf16x8 bv0 = ldfrag(L + H_VT, 144, w, 0, lane), bv1 = ldfrag(L + H_VT, 144, w, 1, lane);
#pragma unroll
                for (int di = 0; di < 8; ++di) { const f32x4 l4 = *(const LAS f32x4*)(ebl + 16 * di + 4 * (lane >> 4)); S[di] = S[di] * l4;
                    S[di] = __builtin_amdgcn_mfma_f32_16x16x32_bf16(ldfrag(L + H_KET, 144, di, 0, lane), bv0, S[di], 0, 0, 0);
                    S[di] = __builtin_amdgcn_mfma_f32_16x16x32_bf16(ldfrag(L + H_KET, 144, di, 1, lane), bv1, S[di], 0, 0, 0); }
            }
            if (OUT) {
                __syncthreads();
                LAS float* Ot = (LAS float*)(L + H_STB);
#pragma unroll
                for (int ti = 0; ti < 4; ++ti)
#pragma unroll
                    for (int jj = 0; jj < 4; ++jj) Ot[(16 * ti + 4 * (lane >> 4) + jj) * 132 + 16 * w + (lane & 15)] = O[ti][jj];
                __syncthreads();
                const int t = tid >> 3, eg = tid & 7;
                f32x4 o4[4]; float ss = 0.f;
#pragma unroll
                for (int i = 0; i < 4; ++i) { o4[i] = *(const LAS f32x4*)(Ot + t * 132 + 16 * eg + 4 * i); ss += (o4[i].x * o4[i].x + o4[i].y * o4[i].y) + (o4[i].z * o4[i].z + o4[i].w * o4[i].w); }
                ss = red8(ss);
                const float rs = __builtin_amdgcn_rsqf(ss * (1.f / 128.f) + 1e-6f);
                const unsigned gw_[8] = {gt0.x, gt0.y, gt0.z, gt0.w, gt1.x, gt1.y, gt1.z, gt1.w};
                unsigned zo[8];
#pragma unroll
                for (int i = 0; i < 4; ++i) { const f32x4 g4 = *(const f32x4*)(gn + 16 * eg + 4 * i);
                    const float a0 = o4[i].x * rs * g4.x * silu_f(bflo(gw_[2 * i])), a1 = o4[i].y * rs * g4.y * silu_f(bfhi(gw_[2 * i]));
                    const float a2 = o4[i].z * rs * g4.z * silu_f(bflo(gw_[2 * i + 1])), a3 = o4[i].w * rs * g4.w * silu_f(bfhi(gw_[2 * i + 1]));
                    zo[2 * i] = cvt_pk_bf16(a0, a1); zo[2 * i + 1] = cvt_pk_bf16(a2, a3); }
                bf16_t* zp = Z + (size_t)(64 * c + t) * D + h * 128 + 16 * eg;
                *(u32x4*)zp = (u32x4){zo[0], zo[1], zo[2], zo[3]}; *(u32x4*)(zp + 8) = (u32x4){zo[4], zo[5], zo[6], zo[7]};
            } else {
                __syncthreads();
            }
        }
        if (!OUT) {
            float* e = HE + ((size_t)(h * 8 + seg) * 512 + tid) * 32;
#pragma unroll
            for (int di = 0; di < 8; ++di) *(f32x4*)(e + 4 * di) = S[di];
            if (qt == 0) HLD[(size_t)(h * 8 + seg) * 128 + d] = logD;
        }
        __syncthreads();
    }
#undef HG_LOAD
}

namespace att {
constexpr int NW = 8, QBLK = 32, KVBLK = 64, LDQ = 4096, LDO = 8192;
constexpr float SCALE = 0.088388347648318440f, THR = 8.f;
constexpr int SHM_V = 16384, SHM_K = 16384, SHM = 2 * SHM_V + 2 * SHM_K + NW * 64 * 4;
#define KSWZ(row, colB) ((row) * 256 + ((colB) ^ (((row) & 7) << 4)))
#define SBAR() __builtin_amdgcn_sched_barrier(0)
__device__ __forceinline__ int crow(int r, int hi) { return (r & 3) + 8 * (r >> 2) + 4 * hi; }
__device__ __forceinline__ void partialSM(f32x16& p0, f32x16& p1, float& m_reg, float& mn, float& alpha) {
    constexpr float C = SCALE * 1.4426950408889634f;
    float pmax = p0[0];
#pragma unroll
    for (int r = 1; r < 16; ++r) pmax = fmaxf(pmax, p0[r]);
#pragma unroll
    for (int r = 0; r < 16; ++r) pmax = fmaxf(pmax, p1[r]);
    { auto rr = __builtin_amdgcn_permlane32_swap(__float_as_uint(pmax), __float_as_uint(pmax), false, false);
      pmax = fmaxf(__uint_as_float(rr[0]), __uint_as_float(rr[1])); }
    if (__builtin_expect(__all(pmax - m_reg <= THR / SCALE), 1)) { mn = m_reg; alpha = 1.f; }
    else { mn = fmaxf(m_reg, pmax); alpha = __builtin_amdgcn_exp2f((m_reg - mn) * C); m_reg = mn; }
    const float mnC = -mn * C;
#pragma unroll
    for (int r = 0; r < 16; ++r) p0[r] = fmaf(p0[r], C, mnC);
#pragma unroll
    for (int r = 0; r < 16; ++r) p1[r] = fmaf(p1[r], C, mnC);
#pragma unroll
    for (int r = 0; r < 16; ++r) p0[r] = __builtin_amdgcn_exp2f(p0[r]);
}
__device__ __forceinline__ void finishSM(f32x16& p0, f32x16& p1, float alpha, float& l_reg, bf16x8& pa0, bf16x8& pa1, bf16x8& pa2, bf16x8& pa3) {
#pragma unroll
    for (int r = 0; r < 16; ++r) p1[r] = __builtin_amdgcn_exp2f(p1[r]);
    float ps = 0;
#pragma unroll
    for (int r = 0; r < 16; ++r) ps += p0[r];
#pragma unroll
    for (int r = 0; r < 16; ++r) ps += p1[r];
    { auto rr = __builtin_amdgcn_permlane32_swap(__float_as_uint(ps), __float_as_uint(ps), false, false);
      ps = __uint_as_float(rr[0]) + __uint_as_float(rr[1]); }
    l_reg = l_reg * alpha + ps;
#define PK4(P, BASE, OUT) do { unsigned a0 = cvt_pk_bf16(P[BASE + 0], P[BASE + 1]), a1 = cvt_pk_bf16(P[BASE + 2], P[BASE + 3]);   \
    unsigned b0 = cvt_pk_bf16(P[BASE + 4], P[BASE + 5]), b1 = cvt_pk_bf16(P[BASE + 6], P[BASE + 7]);                              \
    auto r0 = __builtin_amdgcn_permlane32_swap(a0, b0, false, false); auto r1 = __builtin_amdgcn_permlane32_swap(a1, b1, false, false); \
    u32x4 w = {r0[0], r1[0], r0[1], r1[1]}; OUT = *reinterpret_cast<bf16x8*>(&w); } while (0)
    PK4(p0, 0, pa0); PK4(p0, 8, pa1); PK4(p1, 0, pa2); PK4(p1, 8, pa3);
#undef PK4
}
__device__ __forceinline__ void qkt(f32x16& p0, f32x16& p1, const char* Ks, const bf16x8* qr, int r32, int hi) {
    p0 = f32x16{}; p1 = f32x16{};
#pragma unroll
    for (int d0 = 0; d0 < 8; ++d0) { const int cb = (d0 * 16 + hi * 8) * 2;
        const bf16x8 b0 = *reinterpret_cast<const bf16x8*>(Ks + KSWZ(r32, cb));
        const bf16x8 b1 = *reinterpret_cast<const bf16x8*>(Ks + KSWZ(32 + r32, cb));
        p0 = __builtin_amdgcn_mfma_f32_32x32x16_bf16(b0, qr[d0], p0, 0, 0, 0);
        p1 = __builtin_amdgcn_mfma_f32_32x32x16_bf16(b1, qr[d0], p1, 0, 0, 0); }
}
__device__ __forceinline__ int v_st(int k, int c) { const int kk = (k & ~0xC) | ((k & 4) << 1) | ((k & 8) >> 1); return ((kk >> 3) * 4 + (c >> 5)) * 512 + ((kk & 7) * 32 + (c & 31)) * 2; }
__device__ __forceinline__ int v_rd_base(int lane) { return ((lane & 3) << 3) | (((lane >> 2) & 3) << 6) | (((lane >> 4) & 1) << 5) | (((lane >> 5) & 1) << 8); }
constexpr int v_rd_off(int d0, int ks, int half) { return d0 * 512 + ks * 4096 + half * 2048; }
template <int OFF> __device__ __forceinline__ s16x4 tr_read(int vb) {
    s16x4 r; asm volatile("ds_read_b64_tr_b16 %0, %1 offset:%2" : "=&v"(r) : "v"(vb), "i"(OFF) : "memory"); return r;
}
template <int D0> __device__ __forceinline__ void pv_one(f32x16& od, int vb, bf16x8 pa0, bf16x8 pa1, bf16x8 pa2, bf16x8 pa3) {
    const s16x4 l0 = tr_read<v_rd_off(D0, 0, 0)>(vb), h0 = tr_read<v_rd_off(D0, 0, 1)>(vb), l1 = tr_read<v_rd_off(D0, 1, 0)>(vb), h1 = tr_read<v_rd_off(D0, 1, 1)>(vb);
    const s16x4 l2 = tr_read<v_rd_off(D0, 2, 0)>(vb), h2 = tr_read<v_rd_off(D0, 2, 1)>(vb), l3 = tr_read<v_rd_off(D0, 3, 0)>(vb), h3 = tr_read<v_rd_off(D0, 3, 1)>(vb);
    asm volatile("s_waitcnt lgkmcnt(0)" ::: "memory"); SBAR();
#define PK(Lo, Hi) (bf16x8){Lo[0], Lo[1], Lo[2], Lo[3], Hi[0], Hi[1], Hi[2], Hi[3]}
    od = __builtin_amdgcn_mfma_f32_32x32x16_bf16(pa0, PK(l0, h0), od, 0, 0, 0);
    od = __builtin_amdgcn_mfma_f32_32x32x16_bf16(pa1, PK(l1, h1), od, 0, 0, 0);
    od = __builtin_amdgcn_mfma_f32_32x32x16_bf16(pa2, PK(l2, h2), od, 0, 0, 0);
    od = __builtin_amdgcn_mfma_f32_32x32x16_bf16(pa3, PK(l3, h3), od, 0, 0, 0);
#undef PK
}
__device__ __forceinline__ void pv_d0(f32x16* o, int vb, bf16x8 pa0, bf16x8 pa1, bf16x8 pa2, bf16x8 pa3) {
    pv_one<0>(o[0], vb, pa0, pa1, pa2, pa3); pv_one<1>(o[1], vb, pa0, pa1, pa2, pa3); pv_one<2>(o[2], vb, pa0, pa1, pa2, pa3); pv_one<3>(o[3], vb, pa0, pa1, pa2, pa3);
}
__device__ __forceinline__ void mask_tile(f32x16& p0, f32x16& p1, int j, int lim) {
    if (j > lim) {
#pragma unroll
        for (int r = 0; r < 16; ++r) { p0[r] = -1e30f; p1[r] = -1e30f; }
    } else if (j == 0) {
#pragma unroll
        for (int r = 0; r < 16; ++r) p0[r] = -1e30f;
#pragma unroll
        for (int r = 0; r < 8; ++r) p1[r] = -1e30f;
    }
}
__device__ __forceinline__ void unit(const bf16_t* __restrict__ Qb, const bf16_t* __restrict__ Kh, const bf16_t* __restrict__ Vh, bf16_t* __restrict__ Ob, int NT, int lim, char* lds) {
    int tid_ = threadIdx.x; asm volatile("" : "+v"(tid_));
    const int tid = tid_, wid = tid >> 6, lane = tid & 63, r32 = lane & 31, hi = lane >> 5;
    char* V_lds = lds; char* K_lds = lds + 2 * SHM_V;
    float* wsf = (float*)(lds + 2 * SHM_V + 2 * SHM_K) + wid * 64; float* li_l = wsf; float* al_l = wsf + 32;
    float m_reg = -1e30f, l_reg = 0; f32x16 o[4] = {}; bf16x8 qr[8];
    const bf16_t* Qw = Qb + (long)(wid * QBLK + r32) * LDQ + hi * 8;
#pragma unroll
    for (int d0 = 0; d0 < 8; ++d0) qr[d0] = *reinterpret_cast<const bf16x8*>(Qw + d0 * 16);
    const int sr = tid >> 4, sc = (tid & 15) * 8, vst0 = v_st(sr, sc), vst1 = v_st(32 + sr, sc);
    const int vb0 = (int)(uintptr_t)V_lds + v_rd_base(lane);
    struct { bf16x8 vs0, vs1, ks0, ks1; } sr_[2];
#define SLOAD(i, k0) do { sr_[i].vs0 = *reinterpret_cast<const bf16x8*>(&Vh[(long)((k0) + sr) * LDQ + sc]); sr_[i].vs1 = *reinterpret_cast<const bf16x8*>(&Vh[(long)((k0) + 32 + sr) * LDQ + sc]); \
    sr_[i].ks0 = *reinterpret_cast<const bf16x8*>(&Kh[(long)((k0) + sr) * LDQ + sc]); sr_[i].ks1 = *reinterpret_cast<const bf16x8*>(&Kh[(long)((k0) + 32 + sr) * LDQ + sc]); } while (0)
#define SWRITE(b, i) do { *(bf16x8*)(V_lds + (b) * SHM_V + vst0) = sr_[i].vs0;          \
    *(bf16x8*)(V_lds + (b) * SHM_V + vst1) = sr_[i].vs1; int kc = sc * 2;               \
    *(bf16x8*)(K_lds + (b) * SHM_K + KSWZ(sr, kc)) = sr_[i].ks0;                       \
    *(bf16x8*)(K_lds + (b) * SHM_K + KSWZ(32 + sr, kc)) = sr_[i].ks1; } while (0)
#define SWAIT() asm volatile("s_waitcnt vmcnt(4)" ::: "memory")
#define RESC(a) do { if (__any((a) < 1.f)) { if (hi == 0) al_l[r32] = (a); asm volatile("s_waitcnt lgkmcnt(0)" ::: "memory"); \
    _Pragma("unroll") for (int d = 0; d < 4; ++d) _Pragma("unroll") for (int r = 0; r < 16; ++r) o[d][r] *= al_l[crow(r, hi)]; } } while (0)
    f32x16 pA0, pA1, pB0, pB1; float mnA, mnB, alA, alB; bf16x8 pa0, pa1, pa2, pa3;
    constexpr int SE = 0, SO = 1;
    SLOAD(SE, 0); asm volatile("s_waitcnt vmcnt(0)" ::: "memory"); SWRITE(0, SE); __syncthreads();
    qkt(pA0, pA1, K_lds, qr, r32, hi); mask_tile(pA0, pA1, 0, lim); partialSM(pA0, pA1, m_reg, mnA, alA);
    SLOAD(SO, KVBLK); if (2 < NT) SLOAD(SE, 2 * KVBLK);
    SWAIT(); SWRITE(1, SO); __syncthreads();
    for (int j = 1; j + 1 < NT; j += 2) {
        SBAR(); qkt(pB0, pB1, K_lds + SHM_K, qr, r32, hi);
        finishSM(pA0, pA1, alA, l_reg, pa0, pa1, pa2, pa3); SBAR();
        SLOAD(SO, (j + 2) * KVBLK); SBAR();
        pv_d0(o, vb0, pa0, pa1, pa2, pa3); mask_tile(pB0, pB1, j, lim); partialSM(pB0, pB1, m_reg, mnB, alB);
        __syncthreads(); SWAIT(); SWRITE(0, SE);
        RESC(alB); __syncthreads();
        SBAR(); qkt(pA0, pA1, K_lds, qr, r32, hi);
        finishSM(pB0, pB1, alB, l_reg, pa0, pa1, pa2, pa3); SBAR();
        if (j + 3 < NT) SLOAD(SE, (j + 3) * KVBLK); SBAR();
        pv_d0(o, vb0 + SHM_V, pa0, pa1, pa2, pa3); mask_tile(pA0, pA1, j + 1, lim); partialSM(pA0, pA1, m_reg, mnA, alA);
        __syncthreads(); SWAIT(); SWRITE(1, SO);
        RESC(alA); __syncthreads();
    }
    SBAR(); qkt(pB0, pB1, K_lds + SHM_K, qr, r32, hi);
    finishSM(pA0, pA1, alA, l_reg, pa0, pa1, pa2, pa3); SBAR();
    pv_d0(o, vb0, pa0, pa1, pa2, pa3); mask_tile(pB0, pB1, NT - 1, lim); partialSM(pB0, pB1, m_reg, mnB, alB);
    __syncthreads(); RESC(alB);
    finishSM(pB0, pB1, alB, l_reg, pa0, pa1, pa2, pa3); SBAR();
    pv_d0(o, vb0 + SHM_V, pa0, pa1, pa2, pa3);
    if (hi == 0) li_l[r32] = l_reg; asm volatile("s_waitcnt lgkmcnt(0)" ::: "memory");
    float rli[16];
#pragma unroll
    for (int r = 0; r < 16; ++r) rli[r] = __builtin_amdgcn_rcpf(li_l[crow(r, hi)]);
    bf16_t* Ow = Ob + (long)(wid * QBLK) * LDO;
#pragma unroll
    for (int r = 0; r < 16; ++r) { const int orow = crow(r, hi);
#pragma unroll
        for (int d0 = 0; d0 < 4; ++d0) Ow[(long)orow * LDO + d0 * 32 + r32] = f2bf(o[d0][r] * rli[r]); }
    __syncthreads();
#undef SLOAD
#undef SWRITE
#undef SWAIT
#undef RESC
}
}


namespace att2 {
using namespace att;
constexpr int KB = 16384, VB = 32768, OFF_V = 3 * KB, OFF_W = OFF_V + 2 * VB, SHM2 = OFF_W + NW * 64 * 4;
constexpr int v2_rd_off(int d0, int ks, int half) { return d0 * 512 + ks * 8192 + half * 4096; }
template <int D0> __device__ __forceinline__ void pv2_one(f32x16& od, int vb, bf16x8 pa0, bf16x8 pa1, bf16x8 pa2, bf16x8 pa3) {
    const s16x4 l0 = tr_read<v2_rd_off(D0, 0, 0)>(vb), h0 = tr_read<v2_rd_off(D0, 0, 1)>(vb), l1 = tr_read<v2_rd_off(D0, 1, 0)>(vb), h1 = tr_read<v2_rd_off(D0, 1, 1)>(vb);
    const s16x4 l2 = tr_read<v2_rd_off(D0, 2, 0)>(vb), h2 = tr_read<v2_rd_off(D0, 2, 1)>(vb), l3 = tr_read<v2_rd_off(D0, 3, 0)>(vb), h3 = tr_read<v2_rd_off(D0, 3, 1)>(vb);
    asm volatile("s_waitcnt lgkmcnt(0)" ::: "memory"); SBAR();
#define PK(Lo, Hi) (bf16x8){Lo[0], Lo[1], Lo[2], Lo[3], Hi[0], Hi[1], Hi[2], Hi[3]}
    od = __builtin_amdgcn_mfma_f32_32x32x16_bf16(pa0, PK(l0, h0), od, 0, 0, 0);
    od = __builtin_amdgcn_mfma_f32_32x32x16_bf16(pa1, PK(l1, h1), od, 0, 0, 0);
    od = __builtin_amdgcn_mfma_f32_32x32x16_bf16(pa2, PK(l2, h2), od, 0, 0, 0);
    od = __builtin_amdgcn_mfma_f32_32x32x16_bf16(pa3, PK(l3, h3), od, 0, 0, 0);
#undef PK
}
__device__ __forceinline__ void unit2(const bf16_t* __restrict__ Qb, const bf16_t* __restrict__ Kh, const bf16_t* __restrict__ Vh, bf16_t* __restrict__ Ob, int NT, int lim, unsigned char* ldsg, LAS unsigned char* lds) {
    int tid_ = threadIdx.x; asm volatile("" : "+v"(tid_));
    const int tid = tid_, wid = __builtin_amdgcn_readfirstlane(tid >> 6), lane = tid & 63, r32 = lane & 31, hi = lane >> 5;
    LAS float* wsf = (LAS float*)(lds + OFF_W) + wid * 64; LAS float* li_l = wsf; LAS float* al_l = wsf + 32;
    float m_reg = -1e30f, l_reg = 0; f32x16 o[8] = {}; bf16x8 qr[8];
    const bf16_t* Qw = Qb + (long)(wid * QBLK + r32) * LDQ + hi * 8;
#pragma unroll
    for (int d0 = 0; d0 < 8; ++d0) qr[d0] = *reinterpret_cast<const bf16x8*>(Qw + d0 * 16);
    unsigned kofs[2], vofs[4];
#pragma unroll
    for (int i = 0; i < 2; ++i) { const int row = wid * 4 + i * 32 + (lane >> 4); const int cb = ((lane & 15) * 16) ^ ((row & 7) << 4); kofs[i] = (unsigned)(row * LDQ * 2 + cb); }
#pragma unroll
    for (int i = 0; i < 4; ++i) { const int st = wid * 2 + i * 16 + (lane >> 5), q = lane & 31; const int kk = (st >> 3) * 8 + (q >> 2); const int k = (kk & ~0xC) | ((kk & 4) << 1) | ((kk & 8) >> 1);
        const int c = (st & 7) * 32 + (q & 3) * 8; vofs[i] = (unsigned)(k * LDQ * 2 + c * 2); }
    const int vb0 = (int)(uintptr_t)(ldsg + OFF_V) + v_rd_base(lane);
#define DMA_K(t_, b_) do { const char* gk = (const char*)Kh + (size_t)(t_) * (KVBLK * LDQ * 2); _Pragma("unroll") for (int i = 0; i < 2; ++i) \
        __builtin_amdgcn_global_load_lds((const unsigned*)(gk + kofs[i]), (LAS unsigned*)(lds + (b_) * KB + wid * 1024 + i * 8192), 16, 0, 0); } while (0)
#define DMA_V(t_, b_) do { const char* gv = (const char*)Vh + (size_t)(t_) * (KVBLK * LDQ * 2); _Pragma("unroll") for (int i = 0; i < 4; ++i) \
        __builtin_amdgcn_global_load_lds((const unsigned*)(gv + vofs[i]), (LAS unsigned*)(lds + OFF_V + (b_) * VB + wid * 1024 + i * 8192), 16, 0, 0); } while (0)
    DMA_K(0, 0); DMA_V(0, 0); if (1 < NT) DMA_K(1, 1);
    asm volatile("s_waitcnt vmcnt(0)" ::: "memory"); __builtin_amdgcn_s_barrier(); asm volatile("" ::: "memory");
    int kb = 0;
    for (int j = 0; j < NT; ++j) {
        const int kb2 = kb == 0 ? 2 : kb - 1;
        if (j + 1 < NT) DMA_V(j + 1, (j + 1) & 1);
        asm volatile("" ::: "memory");
        if (j + 2 < NT) DMA_K(j + 2, kb2);
        asm volatile("" ::: "memory");
        f32x16 p0, p1; float mn, alpha; bf16x8 pa0, pa1, pa2, pa3;
        qkt(p0, p1, (const char*)ldsg + kb * KB, qr, r32, hi);
        mask_tile(p0, p1, j, lim);
        partialSM(p0, p1, m_reg, mn, alpha);
        if (__any(alpha < 1.f)) { if (hi == 0) al_l[r32] = alpha; asm volatile("s_waitcnt lgkmcnt(0)" ::: "memory");
#pragma unroll
            for (int d = 0; d < 8; ++d)
#pragma unroll
                for (int r = 0; r < 16; ++r) o[d][r] *= al_l[crow(r, hi)]; }
        finishSM(p0, p1, alpha, l_reg, pa0, pa1, pa2, pa3); SBAR();
        const int vb = vb0 + (j & 1) * VB;
        pv2_one<0>(o[0], vb, pa0, pa1, pa2, pa3); pv2_one<1>(o[1], vb, pa0, pa1, pa2, pa3); pv2_one<2>(o[2], vb, pa0, pa1, pa2, pa3); pv2_one<3>(o[3], vb, pa0, pa1, pa2, pa3);
        pv2_one<4>(o[4], vb, pa0, pa1, pa2, pa3); pv2_one<5>(o[5], vb, pa0, pa1, pa2, pa3); pv2_one<6>(o[6], vb, pa0, pa1, pa2, pa3); pv2_one<7>(o[7], vb, pa0, pa1, pa2, pa3);
        if (j + 2 < NT) asm volatile("s_waitcnt vmcnt(2)" ::: "memory"); else asm volatile("s_waitcnt vmcnt(0)" ::: "memory");
        __builtin_amdgcn_s_barrier(); asm volatile("" ::: "memory");
        kb = kb == 2 ? 0 : kb + 1;
    }
    if (hi == 0) li_l[r32] = l_reg; asm volatile("s_waitcnt lgkmcnt(0)" ::: "memory");
    float rli[16];
#pragma unroll
    for (int r = 0; r < 16; ++r) rli[r] = __builtin_amdgcn_rcpf(li_l[crow(r, hi)]);
    bf16_t* Ow = Ob + (long)(wid * QBLK) * LDO;
#pragma unroll
    for (int r = 0; r < 16; ++r) { const int orow = crow(r, hi);
#pragma unroll
        for (int d0 = 0; d0 < 8; ++d0) Ow[(long)orow * LDO + d0 * 32 + r32] = f2bf(o[d0][r] * rli[r]); }
    asm volatile("s_waitcnt vmcnt(0) lgkmcnt(0)" ::: "memory"); __builtin_amdgcn_s_barrier(); asm volatile("" ::: "memory");
#undef DMA_K
#undef DMA_V
}
}

#ifndef MK_ATT2
#define MK_ATT2 1
#endif
#if MK_ATT2
__device__ __forceinline__ void attn_phase(const Fr& F) {
    const bf16_t* Q = slotY(F, 0); const bf16_t* K = slotY(F, 1); const bf16_t* V = slotY(F, 2);
    bf16_t* AO = slotU(F, 1);
    const int x = F.bid & 7, j = (F.bid >> 3) & 31;
#pragma unroll 1
    for (int k = 0; k < 4; ++k) {
        if (F.bid >= 256) break;
        const int sub = 4 * x + k, head = sub >> 1, c = sub & 1;
        const bf16_t* Kp = K + head * 256 + c * 128; const bf16_t* Vp = V + head * 256;
#pragma unroll 1
        for (int u = 0; u < 2; ++u) {
            const int t = u == 0 ? 63 - j : j;
            const int row0 = 256 * t + 128;
            att2::unit2(Q + (size_t)row0 * D + head * 256 + c * 128, Kp, Vp, AO + (size_t)row0 * 8192 + head * 512 + c * 256, 4 * t + 6, 4 * t + 2 + (F.wave >> 1), F.ldsg, F.lds);
        }
        if (j == 8 * k) att2::unit2(Q + head * 256 + c * 128, Kp, Vp, AO + head * 512 + c * 256, 4, F.wave >> 1, F.ldsg, F.lds);
    }
}
#else
__device__ __forceinline__ void attn_phase(const Fr& F) {
    const bf16_t* Q = slotY(F, 0); const bf16_t* K = slotY(F, 1); const bf16_t* V = slotY(F, 2);
    bf16_t* AO = slotU(F, 1);
    const int x = F.bid & 7, j = (F.bid >> 3) & 31;
#pragma unroll 1
    for (int k = 0; k < 8; ++k) {
        if (F.bid >= 256) break;
        const int sub = 8 * x + k, head = sub >> 2, c = (sub >> 1) & 1, half = sub & 1;
        const bf16_t* Kp = K + head * 256 + c * 128; const bf16_t* Vp = V + head * 256 + half * 128;
#pragma unroll 1
        for (int u = 0; u < 2; ++u) {
            const int t = u == 0 ? 63 - j : j;
            const int row0 = 256 * t + 128;
            att::unit(Q + (size_t)row0 * D + head * 256 + c * 128, Kp, Vp, AO + (size_t)row0 * 8192 + head * 512 + c * 256 + half * 128, 4 * t + 6, 4 * t + 2 + (F.wave >> 1), (char*)F.ldsg);
        }
        if (j == 4 * k) att::unit(Q + head * 256 + c * 128, Kp, Vp, AO + head * 512 + c * 256 + half * 128, 4, F.wave >> 1, (char*)F.ldsg);
    }
}
#endif
__device__ __forceinline__ void attn_post(const Fr& F) {
    const bf16_t* AO = slotU(F, 1); const bf16_t* GT = slotY(F, 3); bf16_t* Z = slotU(F, 0);
    const float* sg = F.in(13);
    constexpr float LINIT = 0.35550906759096934f;
    float lam;
    { const float* q1 = F.in(9); const float* k1 = F.in(10); const float* q2 = F.in(11); const float* k2 = F.in(12);
      const float d1 = wave_sum(q1[F.lane] * k1[F.lane] + q1[F.lane + 64] * k1[F.lane + 64]), d2 = wave_sum(q2[F.lane] * k2[F.lane] + q2[F.lane + 64] * k2[F.lane + 64]);
      lam = expf(d1) - expf(d2) + LINIT; }
    const f32x4 g4 = ((const f32x4*)sg)[F.lane];
    for (int r = F.gw; r < R; r += F.NGW) {
        const bool real = (r >= NPAD && r < NREAL);
        u32x2* zr = (u32x2*)(Z + (size_t)r * D) + F.lane;
        if (!real) { const u32x2 z = {0u, 0u};
#pragma unroll
            for (int hd = 0; hd < 16; ++hd) zr[64 * hd] = z;
            continue; }
#pragma unroll 4
        for (int hd = 0; hd < 16; ++hd) {
            const u32x2 a0 = ((const u32x2*)(AO + (size_t)r * 8192 + hd * 512))[F.lane], a1 = ((const u32x2*)(AO + (size_t)r * 8192 + hd * 512 + 256))[F.lane];
            const u32x2 gt = ((const u32x2*)(GT + (size_t)r * D + hd * 256))[F.lane];
            const float o0 = bflo(a0.x) - lam * bflo(a1.x), o1 = bfhi(a0.x) - lam * bfhi(a1.x), o2 = bflo(a0.y) - lam * bflo(a1.y), o3 = bfhi(a0.y) - lam * bfhi(a1.y);
            const float ss = wave_sum((o0 * o0 + o1 * o1) + (o2 * o2 + o3 * o3));
            const float rs = __builtin_amdgcn_rsqf(ss * (1.f / 256.f) + 1e-5f) * (1.f - LINIT);
            u32x2 w; w.x = cvt_pk_bf16(o0 * rs * g4.x * silu_f(bflo(gt.x)), o1 * rs * g4.y * silu_f(bfhi(gt.x))); w.y = cvt_pk_bf16(o2 * rs * g4.z * silu_f(bflo(gt.y)), o3 * rs * g4.w * silu_f(bfhi(gt.y)));
            zr[64 * hd] = w;
        }
    }
}

constexpr int RW_TT = 32, RW_TOKF = 384, RW_TILEF = RW_TT * RW_TOKF, RW_NTILE = 513;
__device__ __forceinline__ void rwkv_scan_seq(const Fr& F) {
    const bf16_t* Rr = slotY(F, 0); const bf16_t* K = slotY(F, 1); const bf16_t* V = slotY(F, 2); const bf16_t* W = slotY(F, 4); const bf16_t* A = slotY(F, 5);
    float* O32 = (float*)slotU(F, 1);
    LAS float* ring = (LAS float*)F.lds; LAS float* otile = ring + 2 * RW_TILEF;
    const int tid = F.tid, lane = F.lane, wid = F.wave;
    for (int unit = F.bid; unit < 256; unit += F.G) {
        const int h = unit >> 2, rg = unit & 3;
        const int ptid = tid - 256, ptt = ptid >> 3, dg = ptid & 7;
        float kkc[8], kac[8];
        if (wid >= 4) {
#pragma unroll
            for (int i = 0; i < 8; ++i) { kkc[i] = F.in(23)[h * 64 + 8 * dg + i]; kac[i] = F.in(24)[h * 64 + 8 * dg + i]; }
        }
        float S0 = 0.f, S1 = 0.f, S2 = 0.f, S3 = 0.f;
        const int cg = lane & 15, irow = 4 * wid + (lane >> 4);
#define RW_PRODUCE(m, buf) do { const int row = NPAD + 32 * (m) + ptt; const size_t off = (size_t)row * D + h * 64 + 8 * dg; \
        const u32x4 r8 = *(const u32x4*)(Rr + off), k8 = *(const u32x4*)(K + off), v8 = *(const u32x4*)(V + off), w8 = *(const u32x4*)(W + off), a8 = *(const u32x4*)(A + off); \
        const unsigned rw[4] = {r8.x, r8.y, r8.z, r8.w}, kw[4] = {k8.x, k8.y, k8.z, k8.w}, vw[4] = {v8.x, v8.y, v8.z, v8.w}, ww[4] = {w8.x, w8.y, w8.z, w8.w}, aw[4] = {a8.x, a8.y, a8.z, a8.w}; \
        float rf[8], kf[8], vf[8], wf[8], af[8], kk[8]; float ssq = 0.f; \
        _Pragma("unroll") for (int i = 0; i < 4; ++i) { rf[2 * i] = bflo(rw[i]); rf[2 * i + 1] = bfhi(rw[i]); kf[2 * i] = bflo(kw[i]); kf[2 * i + 1] = bfhi(kw[i]); vf[2 * i] = bflo(vw[i]); vf[2 * i + 1] = bfhi(vw[i]); \
            wf[2 * i] = bflo(ww[i]); wf[2 * i + 1] = bfhi(ww[i]); af[2 * i] = bflo(aw[i]); af[2 * i + 1] = bfhi(aw[i]); } \
        _Pragma("unroll") for (int i = 0; i < 8; ++i) { kk[i] = kf[i] * kkc[i]; ssq += kk[i] * kk[i]; } \
        ssq = red8(ssq); const float inv = 1.f / fmaxf(sqrtf(ssq), 1e-12f); \
        LAS float* tb = ring + (buf) * RW_TILEF + ptt * RW_TOKF; \
        _Pragma("unroll") for (int q = 0; q < 2; ++q) { LAS f32x4* p = (LAS f32x4*)(tb + (2 * dg + q) * 20); \
            f32x4 t0, t1, t2, t3, t4; \
            _Pragma("unroll") for (int e = 0; e < 4; ++e) { const int i = 4 * q + e; const float kn = kk[i] * inv; t0[e] = wf[i]; t1[e] = -kn; t2[e] = kn * af[i]; t3[e] = kf[i] * (1.f + (af[i] - 1.f) * kac[i]); t4[e] = rf[i]; } \
            p[0] = t0; p[1] = t1; p[2] = t2; p[3] = t3; p[4] = t4; } \
        LAS f32x4* pv = (LAS f32x4*)(tb + 320 + 8 * dg); pv[0] = (f32x4){vf[0], vf[1], vf[2], vf[3]}; pv[1] = (f32x4){vf[4], vf[5], vf[6], vf[7]}; } while (0)
#define RW_FLUSH(m, buf) do { const int row = NPAD + 32 * (m) + ptt; if (row < NREAL) { const LAS float* ot = otile + (buf) * 512 + ptt * 16 + 2 * dg; \
        *(float2*)(O32 + (size_t)row * D + h * 64 + 16 * rg + 2 * dg) = make_float2(ot[0], ot[1]); } } while (0)
        if (wid >= 4) RW_PRODUCE(0, 0);
        __syncthreads();
        for (int n = 0; n < RW_NTILE; ++n) {
            if (wid < 4) {
                const LAS float* tb = ring + (n & 1) * RW_TILEF; LAS float* ot = otile + (n & 1) * 512;
#pragma unroll 4
                for (int tt = 0; tt < RW_TT; ++tt) {
                    const LAS float* p = tb + tt * RW_TOKF + cg * 20;
                    const f32x4 w4 = *(const LAS f32x4*)p, nk = *(const LAS f32x4*)(p + 4), ka = *(const LAS f32x4*)(p + 8), kp = *(const LAS f32x4*)(p + 12), r4 = *(const LAS f32x4*)(p + 16);
                    const float v = tb[tt * RW_TOKF + 320 + 16 * rg + irow];
                    float sa = (S0 * nk.x + S1 * nk.y) + (S2 * nk.z + S3 * nk.w);
                    sa = red16(sa);
                    S0 = S0 * w4.x + (sa * ka.x + v * kp.x); S1 = S1 * w4.y + (sa * ka.y + v * kp.y); S2 = S2 * w4.z + (sa * ka.z + v * kp.z); S3 = S3 * w4.w + (sa * ka.w + v * kp.w);
                    float o = (S0 * r4.x + S1 * r4.y) + (S2 * r4.z + S3 * r4.w);
                    o = red16(o);
                    if (cg == 0) ot[tt * 16 + irow] = o;
                }
            } else {
                if (n + 1 < RW_NTILE) RW_PRODUCE(n + 1, (n + 1) & 1);
                if (n > 0) RW_FLUSH(n - 1, (n - 1) & 1);
            }
            __syncthreads();
        }
        if (wid >= 4) RW_FLUSH(RW_NTILE - 1, (RW_NTILE - 1) & 1);
        __syncthreads();
#undef RW_PRODUCE
#undef RW_FLUSH
    }
}

#ifndef RC_SYNC
#define RC_SYNC 0
#endif
constexpr int RC_SLOT = 13312, RC_NSLOT = 8, RC_SCR0 = RC_NSLOT * RC_SLOT, RC_SCR = 5632, RC_FLAGS = RC_SCR0 + 7 * RC_SCR, RC_NCH = 1025;
constexpr int RC_AT = 0, RC_RT = 2176, RC_BTT = 4352, RC_KTT = 6912, RC_TT = 9472, RC_G3F = 9984, RC_VTF = 10496, RC_P1 = 11008, RC_P2 = 12032, RC_WC = 13056;
static_assert(RC_FLAGS + 64 <= 147456 - 256, "rwkv LDS map");
typedef short s16x4v __attribute__((ext_vector_type(4)));
__device__ __forceinline__ void rwkv_kknorm(const Fr& F) {
    const bf16_t* K = slotY(F, 1); const float* k_k = F.in(23); float* INV = (float*)(F.ws + WS_HE);
    for (int r = F.gw; r < R; r += F.NGW) {
#pragma unroll 4
        for (int it = 0; it < 16; ++it) {
            const size_t ci = (size_t)it * 64 + F.lane;
            const u32x2 kk = ((const u32x2*)(K + (size_t)r * D))[ci]; const f32x4 c4 = ((const f32x4*)k_k)[ci];
            const float a = bflo(kk.x) * c4.x, b = bfhi(kk.x) * c4.y, c = bflo(kk.y) * c4.z, d = bfhi(kk.y) * c4.w;
            const float ss = red16((a * a + b * b) + (c * c + d * d));
            if ((F.lane & 15) == 0) INV[(size_t)r * 64 + it * 4 + (F.lane >> 4)] = 1.f / fmaxf(sqrtf(ss), 1e-12f);
        }
    }
}
__device__ __forceinline__ unsigned lds_poll(volatile LAS unsigned* p) { return *p; }
__device__ __forceinline__ void rwkv_scan(const Fr& F) {
    const bf16_t* Rr = slotY(F, 0); const bf16_t* K = slotY(F, 1); const bf16_t* V = slotY(F, 2); const bf16_t* W = slotY(F, 4); const bf16_t* A = slotY(F, 5);
    const float* INV = (const float*)(F.ws + WS_HE);
    float* O32 = (float*)slotU(F, 1);
    LAS unsigned char* L = F.lds;
    volatile LAS unsigned* flags = (volatile LAS unsigned*)(L + RC_FLAGS);
    const int lane = F.lane, wid = F.wave, l15 = lane & 15, kg = lane >> 4;
    for (int unit = F.bid; unit < 256; unit += F.G) {
        const int h = unit >> 2, rgw = unit & 3;
        if (F.tid < 16) flags[F.tid] = 0u;
        __syncthreads();
        if (wid == 0) {
            __builtin_amdgcn_s_setprio(3);
            f32x4 S0 = {0.f, 0.f, 0.f, 0.f}, S1 = S0, S2 = S0, S3 = S0;
            struct SlotRegs { u32x2 a0l, a0h, a1l, a1h, r0l, r0h, r1l, r1h; f32x4 P1, P2; s16x4v ttf, g3f, vtf, b0, b1, b2, b3, k0, k1, k2, k3; f32x4 w0, w1, w2, w3; };
#if RC_SYNC
#define CH_WAIT(n_) do { if ((n_) % 7 == 0) { __builtin_amdgcn_s_barrier(); __builtin_amdgcn_s_barrier(); } } while (0)
#else
#define CH_WAIT(n_) do { unsigned sp = 0; while (lds_poll(flags + ((n_) & 7)) != (unsigned)((n_) + 1)) { __builtin_amdgcn_s_sleep(1); if (++sp > (1u << 22)) break; } } while (0)
#endif
#define CH_LOAD(R_, n_) do { CH_WAIT(n_); asm volatile("s_waitcnt lgkmcnt(0)" ::: "memory"); const LAS unsigned char* SL = L + ((n_) & 7) * RC_SLOT; \
                const LAS unsigned char* ap = SL + RC_AT + l15 * 136 + kg * 8; const LAS unsigned char* rp = SL + RC_RT + l15 * 136 + kg * 8; \
                R_.a0l = *(const LAS u32x2*)(ap); R_.a0h = *(const LAS u32x2*)(ap + 32); R_.a1l = *(const LAS u32x2*)(ap + 64); R_.a1h = *(const LAS u32x2*)(ap + 96); \
                R_.r0l = *(const LAS u32x2*)(rp); R_.r0h = *(const LAS u32x2*)(rp + 32); R_.r1l = *(const LAS u32x2*)(rp + 64); R_.r1h = *(const LAS u32x2*)(rp + 96); \
                R_.P1 = *(const LAS f32x4*)(SL + RC_P1 + lane * 16); R_.P2 = *(const LAS f32x4*)(SL + RC_P2 + lane * 16); \
                R_.ttf = *(const LAS s16x4v*)(SL + RC_TT + lane * 8); R_.g3f = *(const LAS s16x4v*)(SL + RC_G3F + lane * 8); R_.vtf = *(const LAS s16x4v*)(SL + RC_VTF + lane * 8); \
                const LAS unsigned char* bp = SL + RC_BTT + l15 * 40 + kg * 8; const LAS unsigned char* kp = SL + RC_KTT + l15 * 40 + kg * 8; \
                R_.b0 = *(const LAS s16x4v*)(bp); R_.b1 = *(const LAS s16x4v*)(bp + 640); R_.b2 = *(const LAS s16x4v*)(bp + 1280); R_.b3 = *(const LAS s16x4v*)(bp + 1920); \
                R_.k0 = *(const LAS s16x4v*)(kp); R_.k1 = *(const LAS s16x4v*)(kp + 640); R_.k2 = *(const LAS s16x4v*)(kp + 1280); R_.k3 = *(const LAS s16x4v*)(kp + 1920); \
                const LAS f32x4* wc = (const LAS f32x4*)(SL + RC_WC + kg * 16); R_.w0 = wc[0]; R_.w1 = wc[4]; R_.w2 = wc[8]; R_.w3 = wc[12]; \
                asm volatile("s_waitcnt lgkmcnt(0)" ::: "memory"); \
                if (lane == 0) flags[8] = (unsigned)((n_) + 1); } while (0)
#define CH_COMPUTE(R_, n_, NEXT_) do { \
                u32x4 sb0, sb1; sb0.x = cvt_pk_bf16(S0.x, S0.y); sb0.y = cvt_pk_bf16(S0.z, S0.w); sb0.z = cvt_pk_bf16(S1.x, S1.y); sb0.w = cvt_pk_bf16(S1.z, S1.w); \
                sb1.x = cvt_pk_bf16(S2.x, S2.y); sb1.y = cvt_pk_bf16(S2.z, S2.w); sb1.z = cvt_pk_bf16(S3.x, S3.y); sb1.w = cvt_pk_bf16(S3.z, S3.w); \
                const bf16x8 Sb0 = *reinterpret_cast<bf16x8*>(&sb0), Sb1 = *reinterpret_cast<bf16x8*>(&sb1); \
                u32x4 t4; \
                t4 = (u32x4){R_.a0l.x, R_.a0l.y, R_.a0h.x, R_.a0h.y}; const bf16x8 Aq0 = *reinterpret_cast<bf16x8*>(&t4); \
                t4 = (u32x4){R_.a1l.x, R_.a1l.y, R_.a1h.x, R_.a1h.y}; const bf16x8 Aq1 = *reinterpret_cast<bf16x8*>(&t4); \
                t4 = (u32x4){R_.r0l.x, R_.r0l.y, R_.r0h.x, R_.r0h.y}; const bf16x8 Rq0 = *reinterpret_cast<bf16x8*>(&t4); \
                t4 = (u32x4){R_.r1l.x, R_.r1l.y, R_.r1h.x, R_.r1h.y}; const bf16x8 Rq1 = *reinterpret_cast<bf16x8*>(&t4); \
                f32x4 X = R_.P1, O = R_.P2; \
                X = __builtin_amdgcn_mfma_f32_16x16x32_bf16(Aq0, Sb0, X, 0, 0, 0); \
                X = __builtin_amdgcn_mfma_f32_16x16x32_bf16(Aq1, Sb1, X, 0, 0, 0);                   \
                O = __builtin_amdgcn_mfma_f32_16x16x32_bf16(Rq0, Sb0, O, 0, 0, 0); \
                O = __builtin_amdgcn_mfma_f32_16x16x32_bf16(Rq1, Sb1, O, 0, 0, 0);                   \
                u32x2 yb; yb.x = cvt_pk_bf16(X.x, X.y); yb.y = cvt_pk_bf16(X.z, X.w); \
                f32x4 U = {0.f, 0.f, 0.f, 0.f}; \
                U = __builtin_amdgcn_mfma_f32_16x16x16bf16_1k(R_.ttf, *reinterpret_cast<s16x4v*>(&yb), U, 0, 0, 0);     \
                u32x2 ub; ub.x = cvt_pk_bf16(U.x, U.y); ub.y = cvt_pk_bf16(U.z, U.w); \
                const s16x4v Ub = *reinterpret_cast<s16x4v*>(&ub); \
                S0 = __builtin_amdgcn_mfma_f32_16x16x16bf16_1k(R_.k0, R_.vtf, S0, 0, 0, 0); S1 = __builtin_amdgcn_mfma_f32_16x16x16bf16_1k(R_.k1, R_.vtf, S1, 0, 0, 0); \
                S2 = __builtin_amdgcn_mfma_f32_16x16x16bf16_1k(R_.k2, R_.vtf, S2, 0, 0, 0); S3 = __builtin_amdgcn_mfma_f32_16x16x16bf16_1k(R_.k3, R_.vtf, S3, 0, 0, 0); \
                S0 = __builtin_amdgcn_mfma_f32_16x16x16bf16_1k(R_.b0, Ub, S0, 0, 0, 0); S1 = __builtin_amdgcn_mfma_f32_16x16x16bf16_1k(R_.b1, Ub, S1, 0, 0, 0); \
                S2 = __builtin_amdgcn_mfma_f32_16x16x16bf16_1k(R_.b2, Ub, S2, 0, 0, 0); S3 = __builtin_amdgcn_mfma_f32_16x16x16bf16_1k(R_.b3, Ub, S3, 0, 0, 0); \
                O = __builtin_amdgcn_mfma_f32_16x16x16bf16_1k(R_.g3f, Ub, O, 0, 0, 0);                   \
                NEXT_; \
                S0 = S0 * R_.w0; S1 = S1 * R_.w1; S2 = S2 * R_.w2; S3 = S3 * R_.w3; \
                float* op = O32 + (size_t)(NPAD + 16 * (n_) + 4 * kg) * D + h * 64 + 16 * rgw + l15;     \
                op[0] = O.x; op[D] = O.y; op[2 * D] = O.z; op[3 * D] = O.w; } while (0)
            SlotRegs RA, RB;
            CH_LOAD(RA, 0);
            for (int n = 0; n + 1 < RC_NCH; n += 2) {
                CH_COMPUTE(RA, n, CH_LOAD(RB, n + 1));
                if (n + 2 < RC_NCH) { CH_COMPUTE(RB, n + 1, CH_LOAD(RA, n + 2)); } else { CH_COMPUTE(RB, n + 1, (void)0); }
            }
            if (RC_NCH & 1) { CH_COMPUTE(RA, RC_NCH - 1, (void)0); }
            __builtin_amdgcn_s_setprio(0);
#undef CH_WAIT
#undef CH_LOAD
#undef CH_COMPUTE
        } else {
            const int p = wid - 1;
            LAS unsigned char* SC = L + RC_SCR0 + p * RC_SCR;
            const float kkc = F.in(23)[h * 64 + lane], kac = F.in(24)[h * 64 + lane];
            unsigned short cr[16], ck[16], cw[16], ca[16], nvq[4]; float civ[16];
#define RC_LOADS(nn) do { const int r0n = NPAD + 16 * (nn); \
                _Pragma("unroll") for (int e = 0; e < 4; ++e) nvq[e] = V[(size_t)(r0n + 4 * kg + e) * D + h * 64 + 16 * rgw + l15]; \
                _Pragma("unroll") for (int s = 0; s < 16; ++s) { const size_t off = (size_t)(r0n + s) * D + h * 64 + lane; cr[s] = Rr[off]; ck[s] = K[off]; cw[s] = W[off]; ca[s] = A[off]; civ[s] = INV[(size_t)(r0n + s) * 64 + h]; } } while (0)
            RC_LOADS(p);
            for (int n = p; n < RC_NCH; n += 7) {
                const int slot = n & 7; LAS unsigned char* SL = L + slot * RC_SLOT;
                unsigned short vq[4];
#pragma unroll
                for (int e = 0; e < 4; ++e) vq[e] = nvq[e];
#if RC_SYNC
                asm volatile("s_waitcnt lgkmcnt(0)" ::: "memory"); __builtin_amdgcn_s_barrier();
#else
                if (n >= 8) { unsigned sp = 0; while (lds_poll(flags + 8) < (unsigned)(n - 7)) { __builtin_amdgcn_s_sleep(2); if (++sp > (1u << 22)) break; } }
#endif
                asm volatile("" ::: "memory");
                float Wp = 1.f; unsigned btp[8], ktp[8];
#pragma unroll
                for (int hb = 0; hb < 2; ++hb) {
                    unsigned short rq[8], kq[8], wq[8], aq[8]; float iv[8];
#pragma unroll
                    for (int s = 0; s < 8; ++s) { rq[s] = cr[8 * hb + s]; kq[s] = ck[8 * hb + s]; wq[s] = cw[8 * hb + s]; aq[s] = ca[8 * hb + s]; iv[s] = civ[8 * hb + s]; }
                    float btv[8], ktv[8];
#pragma unroll
                    for (int s = 0; s < 8; ++s) {
                        const int t = 8 * hb + s;
                        const float rs = bf2f(rq[s]), ks = bf2f(kq[s]), wsv = bf2f(wq[s]), as = bf2f(aq[s]);
                        const float kk = ks * kkc * iv[s];
                        const float Wprev = Wp; Wp *= wsv; const float iW = __builtin_amdgcn_rcpf(Wp);
                        const float at = -kk * Wprev, rt = rs * Wp, bt = kk * as * iW, kt = ks * (1.f + (as - 1.f) * kac) * iW;
                        *(LAS bf16_t*)(SL + RC_AT + t * 136 + lane * 2) = f2bf(at); *(LAS bf16_t*)(SL + RC_RT + t * 136 + lane * 2) = f2bf(rt);
                        *(LAS bf16_t*)(SC + t * 136 + lane * 2) = f2bf(bt); *(LAS bf16_t*)(SC + 2176 + t * 136 + lane * 2) = f2bf(kt);
                        btv[s] = bt; ktv[s] = kt;
                    }
#pragma unroll
                    for (int s = 0; s < 4; ++s) { btp[4 * hb + s] = cvt_pk_bf16(btv[2 * s], btv[2 * s + 1]); ktp[4 * hb + s] = cvt_pk_bf16(ktv[2 * s], ktv[2 * s + 1]); }
                }
                {
                    LAS u32x2* bq = (LAS u32x2*)(SL + RC_BTT + lane * 40); LAS u32x2* kq2 = (LAS u32x2*)(SL + RC_KTT + lane * 40);
#pragma unroll
                    for (int q = 0; q < 4; ++q) { bq[q] = (u32x2){btp[2 * q], btp[2 * q + 1]}; kq2[q] = (u32x2){ktp[2 * q], ktp[2 * q + 1]}; }
                    *(LAS float*)(SL + RC_WC + lane * 4) = Wp;
                    u32x2 vt; vt.x = (unsigned)vq[0] | ((unsigned)vq[1] << 16); vt.y = (unsigned)vq[2] | ((unsigned)vq[3] << 16);
                    *(LAS u32x2*)(SL + RC_VTF + lane * 8) = vt;
                }
                if (n + 7 < RC_NCH) RC_LOADS(n + 7);
                asm volatile("s_waitcnt lgkmcnt(0)" ::: "memory");
                f32x4 G1 = {0.f, 0.f, 0.f, 0.f}, G2 = G1, G3 = G1, G4 = G1, G1t = G1;
#pragma unroll
                for (int ks = 0; ks < 2; ++ks) {
                    const bf16x8 fb = *(const LAS bf16x8*)(SC + l15 * 136 + (32 * ks + 8 * kg) * 2), fk = *(const LAS bf16x8*)(SC + 2176 + l15 * 136 + (32 * ks + 8 * kg) * 2);
                    const bf16x8 fa = *(const LAS bf16x8*)(SL + RC_AT + l15 * 136 + (32 * ks + 8 * kg) * 2), fr_ = *(const LAS bf16x8*)(SL + RC_RT + l15 * 136 + (32 * ks + 8 * kg) * 2);
                    G1 = __builtin_amdgcn_mfma_f32_16x16x32_bf16(fb, fa, G1, 0, 0, 0); G2 = __builtin_amdgcn_mfma_f32_16x16x32_bf16(fk, fa, G2, 0, 0, 0);
                    G1t = __builtin_amdgcn_mfma_f32_16x16x32_bf16(fa, fb, G1t, 0, 0, 0);
                    G3 = __builtin_amdgcn_mfma_f32_16x16x32_bf16(fb, fr_, G3, 0, 0, 0); G4 = __builtin_amdgcn_mfma_f32_16x16x32_bf16(fk, fr_, G4, 0, 0, 0);
                }
                {
#pragma unroll
                    for (int e = 0; e < 4; ++e) { const int s = 4 * kg + e; const bool lt = s < l15, le = s <= l15;
                        G1[e] = lt ? G1[e] : 0.f; G1t[e] = (l15 < s) ? G1t[e] : 0.f; G2[e] = lt ? G2[e] : 0.f; G3[e] = le ? G3[e] : 0.f; G4[e] = le ? G4[e] : 0.f; }
                    u32x2 g2, g3, g4; g2.x = cvt_pk_bf16(G2.x, G2.y); g2.y = cvt_pk_bf16(G2.z, G2.w); g3.x = cvt_pk_bf16(G3.x, G3.y); g3.y = cvt_pk_bf16(G3.z, G3.w); g4.x = cvt_pk_bf16(G4.x, G4.y); g4.y = cvt_pk_bf16(G4.z, G4.w);
                    *(LAS u32x2*)(SL + RC_G3F + lane * 8) = g3;
                    u32x2 vt; vt.x = (unsigned)vq[0] | ((unsigned)vq[1] << 16); vt.y = (unsigned)vq[2] | ((unsigned)vq[3] << 16);
                    const s16x4v vtf = *reinterpret_cast<s16x4v*>(&vt);
                    f32x4 P1 = {0.f, 0.f, 0.f, 0.f}, P2 = P1;
                    P1 = __builtin_amdgcn_mfma_f32_16x16x16bf16_1k(*reinterpret_cast<s16x4v*>(&g2), vtf, P1, 0, 0, 0);
                    P2 = __builtin_amdgcn_mfma_f32_16x16x16bf16_1k(*reinterpret_cast<s16x4v*>(&g4), vtf, P2, 0, 0, 0);
                    *(LAS f32x4*)(SL + RC_P1 + lane * 16) = P1; *(LAS f32x4*)(SL + RC_P2 + lane * 16) = P2;
#define RC_BF(v) ({ u32x2 t_; t_.x = cvt_pk_bf16((v).x, (v).y); t_.y = cvt_pk_bf16((v).z, (v).w); *reinterpret_cast<s16x4v*>(&t_); })
                    const f32x4 Z4 = {0.f, 0.f, 0.f, 0.f};
                    const s16x4v n1 = RC_BF(G1), n1t = RC_BF(G1t);
                    const f32x4 X2 = __builtin_amdgcn_mfma_f32_16x16x16bf16_1k(n1t, n1, Z4, 0, 0, 0), X2t = __builtin_amdgcn_mfma_f32_16x16x16bf16_1k(n1, n1t, Z4, 0, 0, 0);
                    const s16x4v n2 = RC_BF(X2), n2t = RC_BF(X2t);
                    const f32x4 X4 = __builtin_amdgcn_mfma_f32_16x16x16bf16_1k(n2t, n2, Z4, 0, 0, 0), X4t = __builtin_amdgcn_mfma_f32_16x16x16bf16_1k(n2, n2t, Z4, 0, 0, 0);
                    const s16x4v n4 = RC_BF(X4), n4t = RC_BF(X4t);
                    f32x4 Tm = __builtin_amdgcn_mfma_f32_16x16x16bf16_1k(n4t, n4, Z4, 0, 0, 0);
#pragma unroll
                    for (int e = 0; e < 4; ++e) Tm[e] += (4 * kg + e == l15) ? 1.f : 0.f;
                    Tm = __builtin_amdgcn_mfma_f32_16x16x16bf16_1k(n4t, RC_BF(Tm), Tm, 0, 0, 0);
                    Tm = __builtin_amdgcn_mfma_f32_16x16x16bf16_1k(n2t, RC_BF(Tm), Tm, 0, 0, 0);
                    Tm = __builtin_amdgcn_mfma_f32_16x16x16bf16_1k(n1t, RC_BF(Tm), Tm, 0, 0, 0);
                    { u32x2 tt; tt.x = cvt_pk_bf16(Tm.x, Tm.y); tt.y = cvt_pk_bf16(Tm.z, Tm.w); *(LAS u32x2*)(SL + RC_TT + lane * 8) = tt; }
#undef RC_BF
                }
                asm volatile("s_waitcnt lgkmcnt(0)" ::: "memory");
#if RC_SYNC
                __builtin_amdgcn_s_barrier();
#else
                if (lane == 0) flags[slot] = (unsigned)(n + 1);
#endif
            }
#if RC_SYNC
            if (p >= RC_NCH % 7) { __builtin_amdgcn_s_barrier(); __builtin_amdgcn_s_barrier(); }
#endif
        }
#undef RC_LOADS
        __syncthreads();
    }
}
__device__ __forceinline__ void rwkv_post(const Fr& F) {
    const bf16_t* Rr = slotY(F, 0); const bf16_t* K = slotY(F, 1); const bf16_t* V = slotY(F, 2); const bf16_t* GT = slotY(F, 3); const bf16_t* A = slotY(F, 5);
    const float* O32 = (const float*)slotU(F, 1); bf16_t* Z = slotU(F, 0);
    const float* k_a = F.in(24); const float* r_k = F.in(25); const float* lw = F.in(26); const float* lb = F.in(27);
    for (int r = F.gw; r < R; r += F.NGW) {
        const bool real = (r >= NPAD && r < NREAL);
        u32x2* zr = (u32x2*)(Z + (size_t)r * D) + F.lane;
        if (!real) { const u32x2 z = {0u, 0u};
#pragma unroll
            for (int it = 0; it < 16; ++it) zr[64 * it] = z;
            continue; }
#pragma unroll 2
        for (int it = 0; it < 16; ++it) {
            const size_t ci = (size_t)it * 64 + F.lane;
            const f32x4 o4 = ((const f32x4*)(O32 + (size_t)r * D))[ci];
            const u32x2 rr = ((const u32x2*)(Rr + (size_t)r * D))[ci], kk = ((const u32x2*)(K + (size_t)r * D))[ci], vv = ((const u32x2*)(V + (size_t)r * D))[ci], gg = ((const u32x2*)(GT + (size_t)r * D))[ci], aa = ((const u32x2*)(A + (size_t)r * D))[ci];
            const f32x4 ka4 = ((const f32x4*)k_a)[ci], rk4 = ((const f32x4*)r_k)[ci], lw4 = ((const f32x4*)lw)[ci], lb4 = ((const f32x4*)lb)[ci];
            const float mean = red16((o4.x + o4.y) + (o4.z + o4.w)) * (1.f / 64.f);
            const float d0 = o4.x - mean, d1 = o4.y - mean, d2 = o4.z - mean, d3 = o4.w - mean;
            const float var = red16((d0 * d0 + d1 * d1) + (d2 * d2 + d3 * d3)) * (1.f / 64.f);
            const float rs = __builtin_amdgcn_rsqf(var + 64e-5f);
            const float r0 = bflo(rr.x), r1 = bfhi(rr.x), r2 = bflo(rr.y), r3 = bfhi(rr.y);
            const float kp0 = bflo(kk.x) * (1.f + (bflo(aa.x) - 1.f) * ka4.x), kp1 = bfhi(kk.x) * (1.f + (bfhi(aa.x) - 1.f) * ka4.y), kp2 = bflo(kk.y) * (1.f + (bflo(aa.y) - 1.f) * ka4.z), kp3 = bfhi(kk.y) * (1.f + (bfhi(aa.y) - 1.f) * ka4.w);
            const float bs = red16((r0 * kp0 * rk4.x + r1 * kp1 * rk4.y) + (r2 * kp2 * rk4.z + r3 * kp3 * rk4.w));
            const float y0 = d0 * rs * lw4.x + lb4.x + bs * bflo(vv.x), y1 = d1 * rs * lw4.y + lb4.y + bs * bfhi(vv.x), y2 = d2 * rs * lw4.z + lb4.z + bs * bflo(vv.y), y3 = d3 * rs * lw4.w + lb4.w + bs * bfhi(vv.y);
            u32x2 w; w.x = cvt_pk_bf16(y0 * silu_f(bflo(gg.x)), y1 * silu_f(bfhi(gg.x))); w.y = cvt_pk_bf16(y2 * silu_f(bflo(gg.y)), y3 * silu_f(bfhi(gg.y)));
            zr[64 * it] = w;
        }
    }
}
}
namespace mk {
constexpr int LDS_BYTES = 147456;
constexpr int LDS_MISC = LDS_BYTES - 128;
struct Args { const float* in[29]; float* out; unsigned char* ws; };

#define MK_GEMM(EPI, e, Aptr, aps_, Bptr, M_, N_, K_) do { int kk_ = (K_); asm volatile("" : "+s"(kk_));     \
    pg8::Gemm g_{(const bf16_t*)(Aptr), (const bf16_t*)(Bptr), (M_), (N_), kk_, (size_t)(aps_)}; pg8::StaticOrder S_; S_.init((M_), (N_), F.G, F.bid); \
    pg8::gemm_phase<EPI, pg8::StaticOrder, false>(F.lds, g_, S_, e, nullptr); } while (0)

struct TailOrder { int pn;
    __device__ bool next(int i, pg8::Unit& u) const { if (i > 0 || pn < 0) return false; u.pm = 64; u.pn = pn; return true; }
    __device__ __forceinline__ void a_ready(const pg8::Unit&) const {}
    __device__ __forceinline__ void done(const pg8::Unit&) const {}
};
#define MK_GEMM1(EPI, e, aps_, NTOT_, L_) do { MK_GEMM(EPI, e, slotU(F, 0), aps_, wtin_of(F, L_), 16384, NTOT_, D); \
    if (F.bid < (NTOT_) / 256) { int kk_ = D; asm volatile("" : "+s"(kk_)); pg8::Gemm g_{(const bf16_t*)slotU(F, 0), (const bf16_t*)wtin_of(F, L_), R, (NTOT_), kk_, (size_t)(aps_)}; TailOrder St_{F.bid}; \
        pg8::gemm_phase<EPI, TailOrder, false, true>(F.lds, g_, St_, e, nullptr); } } while (0)
#define MK_GEMM2_NORM(prev, next, udst) do { \
    MK_GEMM(EpiY, ey, slotU(F, 0), 0, wtout, 16384, D, D); \
    GRID_BAR(); \
    if (F.bid < 16) { int kk_ = D; asm volatile("" : "+s"(kk_)); pg8::Gemm g_{(const bf16_t*)slotU(F, 0), (const bf16_t*)wtout, R, D, kk_, (size_t)0}; TailOrder St_{F.bid}; \
        pg8::gemm_phase<EpiY, TailOrder, false, true>(F.lds, g_, St_, ey, nullptr); } \
    else { const Fr P = F.fresh(); norm_phase(P, prev, next, slotY(P, 0), udst, 0, 16384, 16); } \
    GRID_BAR(); \
    { const Fr P = F.fresh(); norm_phase(P, prev, next, slotY(P, 0), udst, 16384, R, 0); if ((next) >= 0) convert_layer(P, next, (next) == 3); } \
    GRID_BAR(); } while (0)

__global__ void __launch_bounds__(512, 2) fwd(Args a) {
    extern __shared__ __attribute__((aligned(16))) unsigned char lds_raw[];
    Fr F;
    F.lds = (LAS unsigned char*)lds_raw; F.ldsg = lds_raw;
    F.tid = threadIdx.x; F.lane = F.tid & 63; F.wave = __builtin_amdgcn_readfirstlane(F.tid >> 6);
    F.G = gridDim.x; F.bid = blockIdx.x; F.gw = F.bid * 8 + F.wave; F.NGW = F.G * 8;
    F.out = a.out; F.ws = a.ws;
    volatile LAS unsigned* misc = (volatile LAS unsigned*)(F.lds + LDS_MISC);
    if (F.tid < 16) misc[F.tid] = 0u;
    __syncthreads();
    XcdBarrier bar = xcd_barrier_post((unsigned*)(F.ws + WS_CTL) + 4096, misc + 8);
#define GRID_BAR() xcd_barrier(bar)
#ifndef MK_DUP
#define MK_DUP 0
#endif
#define DUPN(k, ...) do { __VA_ARGS__; if ((MK_DUP >> (k)) & 1) { GRID_BAR(); __VA_ARGS__; } } while (0)
    bf16_t* wtout = (bf16_t*)(F.ws + WS_WTOUT);
    const EpiY ey{slotY(F, 0)};

    DUPN(11, { const Fr P = F.fresh(); convert_layer(P, 0, true); rope_table(P); norm_phase(P, -1, 0, nullptr, slotU(P, 0)); });
    GRID_BAR();
    { const EpiH1 e{slotY(F, 0), F.in(5), 0}; MK_GEMM1(EpiH1, e, 0, 4 * D, 0); }
    if (F.bid >= 64) { const Fr P = F.fresh(); convert_win(P, 1, 64); }
    GRID_BAR();
    DUPN(1, { const Fr P = F.fresh(); hgrn_phase<false>(P, 0); });
    GRID_BAR();
    DUPN(2, { const Fr P = F.fresh(); hgrn_phase<true>(P, 0); });
    GRID_BAR();
    MK_GEMM2_NORM(0, 1, slotU(F, 0));
    { const EpiB1 e{slotY(F, 0), (const float*)(F.ws + WS_ROPE), (const float*)(F.ws + WS_ROPE) + (size_t)R * 16}; MK_GEMM1(EpiB1, e, 0, 4 * D, 1); }
    if (F.bid >= 64) { const Fr P = F.fresh(); convert_win(P, 2, 64); }
    GRID_BAR();
    DUPN(3, { const Fr P = F.fresh(); attn_phase(P); });
    GRID_BAR();
    DUPN(4, { const Fr P = F.fresh(); attn_post(P); });
    GRID_BAR();
    MK_GEMM2_NORM(1, 2, slotY(F, 1));
    DUPN(7, { const Fr P = F.fresh(); mix_phase(P, slotY(P, 1)); convert_layer2_b(P); });
    GRID_BAR();
    { const EpiC1 e{slotY(F, 0), (bf16_t*)(F.ws + WS_T)}; MK_GEMM(EpiC1, e, slotU(F, 0), (size_t)R * D, wtin_of(F, 2), R, 4 * D + 512, D); }
    GRID_BAR();
    DUPN(9, { const EpiC2 e{slotY(F, 0), F.in(17), F.in(20)}; MK_GEMM(EpiC2, e, F.ws + WS_T, 0, F.ws + WS_W2P, R, 2 * D, 256); });
    { const Fr P = F.fresh(); rwkv_kknorm(P); }
    GRID_BAR();
    DUPN(5, { const Fr P = F.fresh(); rwkv_scan(P); });
    GRID_BAR();
    DUPN(6, { const Fr P = F.fresh(); rwkv_post(P); });
    GRID_BAR();
    MK_GEMM2_NORM(2, 3, slotU(F, 0));
    { const EpiH1 e{slotY(F, 0), F.in(5), 1}; MK_GEMM1(EpiH1, e, 0, 4 * D, 3); }
    GRID_BAR();
    { const Fr P = F.fresh(); hgrn_phase<false>(P, 1); }
    GRID_BAR();
    { const Fr P = F.fresh(); hgrn_phase<true>(P, 1); }
    GRID_BAR();
    MK_GEMM2_NORM(3, -1, (bf16_t*)nullptr);
}
}

extern "C" void kernel_launch(void* const* d_in, const int* in_sizes, int n_in, void* d_out, int out_size, void* d_ws, size_t ws_size, hipStream_t stream) {
    static int grid = 0;
    if (grid == 0) {
        if (n_in != 29 || out_size != 16384 * 4096 || ws_size < mk::WS_END) { fprintf(stderr, "kernel_launch: unexpected shapes (n_in %d out %d ws %zu need %zu)\n", n_in, out_size, ws_size, (size_t)mk::WS_END); grid = -1; return; }
        int dev = 0, cus = 0, per_cu = 0;
        if (hipGetDevice(&dev) != hipSuccess || hipDeviceGetAttribute(&cus, hipDeviceAttributeMultiprocessorCount, dev) != hipSuccess) { grid = -1; return; }
        if (hipFuncSetAttribute((const void*)mk::fwd, hipFuncAttributeMaxDynamicSharedMemorySize, mk::LDS_BYTES) != hipSuccess) { fprintf(stderr, "kernel_launch: hipFuncSetAttribute failed\n"); grid = -1; return; }
        if (hipOccupancyMaxActiveBlocksPerMultiprocessor(&per_cu, (const void*)mk::fwd, 512, mk::LDS_BYTES) != hipSuccess || per_cu < 1) { fprintf(stderr, "kernel_launch: occupancy query says %d\n", per_cu); }
        (void)hipGetLastError();
        grid = cus;
    }
    if (grid < 0) return;
    if (hipMemsetAsync((char*)d_ws + mk::WS_CTL, 0, mk::CTL_BYTES, stream) != hipSuccess) return;
    mk::Args a{};
    for (int i = 0; i < 29; ++i) a.in[i] = (const float*)d_in[i];
    a.out = (float*)d_out; a.ws = (unsigned char*)d_ws;
    hipLaunchKernelGGL(mk::fwd, dim3(grid), dim3(512), mk::LDS_BYTES, stream, a);
}
```

```cpp
#include <hip/hip_runtime.h>
#include <cstdio>
#include <cstdint>

#define LAS __attribute__((address_space(3)))
#define GAS __attribute__((address_space(1)))
typedef unsigned short bf16_t;
typedef short bf16x8 __attribute__((ext_vector_type(8)));
typedef short s16x4 __attribute__((ext_vector_type(4)));
typedef float f32x4 __attribute__((ext_vector_type(4)));
typedef float f32x16 __attribute__((ext_vector_type(16)));
typedef unsigned u32x4 __attribute__((ext_vector_type(4)));
typedef unsigned u32x2 __attribute__((ext_vector_type(2)));

namespace mk {
constexpr int D = 4096, NPAD = 48, NREAL = 16448, R = 16640, NCH = 257;
constexpr size_t MiB = 1u << 20;
constexpr size_t SLOT = (size_t)R * D * 2;
constexpr size_t WS_CTL = 0, CTL_BYTES = 1 * MiB;
constexpr size_t WS_WTIN = 2 * MiB;
constexpr size_t WS_WTOUT = 134 * MiB;
constexpr size_t WS_W2P = 166 * MiB;
constexpr size_t WS_ROPE = 170 * MiB;
constexpr size_t WS_HMETA = 174 * MiB;
constexpr size_t WS_HE = 175 * MiB;
constexpr size_t WS_HLOGD = 191 * MiB;
constexpr size_t WS_U = 192 * MiB;
constexpr size_t WS_Y = WS_U + 6 * SLOT;
constexpr size_t WS_T = WS_Y + 6 * SLOT;
constexpr size_t WS_WTINB = WS_U + 4 * SLOT;
constexpr size_t WS_HB = (WS_T + (size_t)R * 256 * 2 + MiB - 1) / MiB * MiB;
constexpr size_t WS_END = WS_HB + SLOT;
static_assert(WS_END <= 2040 * MiB, "d_ws map");

typedef __bf16 bf16x2n_t __attribute__((ext_vector_type(2)));
typedef float f32x2n_t __attribute__((ext_vector_type(2)));
__device__ __forceinline__ unsigned cvt_pk_bf16(float lo, float hi) { const f32x2n_t v = {lo, hi}; const bf16x2n_t r = __builtin_convertvector(v, bf16x2n_t); return __builtin_bit_cast(unsigned, r); }
__device__ __forceinline__ float bflo(unsigned w) { return __uint_as_float(w << 16); }
__device__ __forceinline__ float bfhi(unsigned w) { return __uint_as_float(w & 0xffff0000u); }
__device__ __forceinline__ float bf2f(bf16_t b) { return __uint_as_float(((unsigned)b) << 16); }
__device__ __forceinline__ bf16_t f2bf(float f) { return (bf16_t)(cvt_pk_bf16(f, f) & 0xffffu); }
__device__ __forceinline__ float sigmoid_f(float x) { return 1.f / (1.f + __expf(-x)); }
__device__ __forceinline__ float silu_f(float x) { return x / (1.f + __expf(-x)); }
__device__ __forceinline__ float wave_sum(float v) {
#pragma unroll
    for (int o = 1; o < 64; o <<= 1) v += __shfl_xor(v, o);
    return v;
}
template <int CTRL> __device__ __forceinline__ float dppf(float v) { return __int_as_float(__builtin_amdgcn_update_dpp(0, __float_as_int(v), CTRL, 0xf, 0xf, true)); }
__device__ __forceinline__ float red4(float v) { v += dppf<0xB1>(v); v += dppf<0x4E>(v); return v; }
__device__ __forceinline__ float red8(float v) { v = red4(v); v += dppf<0x141>(v); return v; }
__device__ __forceinline__ float red16(float v) { v = red8(v); v += dppf<0x140>(v); return v; }
#define LDS_WAIT() asm volatile("s_waitcnt lgkmcnt(0)" ::: "memory")
}
#define XB_TMO      128
#define XB_XCNT(j)  (256  + 64 * (j))
#define XB_XSUB(j)  (1280 + 64 * (j))
#define XB_XGEN(j)  (2304 + 64 * (j))
#define XB_TOP      3328
#define XB_TOPGEN   3392
#define XCD_BAR_WORDS 3456
#define XB_SPIN_CAP (1u << 18)
#define LAS __attribute__((address_space(3)))

__device__ __forceinline__ unsigned xb_ld(unsigned* p)              { return __hip_atomic_load(p, __ATOMIC_RELAXED, __HIP_MEMORY_SCOPE_AGENT); }
__device__ __forceinline__ unsigned xb_add(unsigned* p, unsigned v) { return __hip_atomic_fetch_add(p, v, __ATOMIC_RELAXED, __HIP_MEMORY_SCOPE_AGENT); }
__device__ __forceinline__ unsigned xb_xcc_id() { return (unsigned)__builtin_amdgcn_s_getreg((3 << 11) | 20) & 0xFu; }
#define XB_SPIN(cond, bar) do { unsigned _sp = 0; while (cond) { __builtin_amdgcn_s_sleep(1); \
    if ((++_sp & 255u) == 0u) { if (xb_ld(&(bar)[XB_TMO])) break; if (_sp > XB_SPIN_CAP) { atomicAdd(&(bar)[XB_TMO], 1u); break; } } } } while (0)

struct XcdBarrier {
    unsigned* bar; unsigned x;
    volatile LAS unsigned* st;
};

__device__ __forceinline__ XcdBarrier xcd_barrier_post(unsigned* bar, volatile LAS unsigned* st) {
    XcdBarrier b; b.bar = bar; b.x = xb_xcc_id(); b.st = st;
    if (threadIdx.x == 0) (void)xb_add(&bar[XB_XCNT(b.x)], 1u);
    return b;
}
__device__ __forceinline__ void xcd_barrier_complete(unsigned* bar, unsigned x, unsigned& nloc, unsigned& nx) {
    const unsigned G = gridDim.x * gridDim.y * gridDim.z;
    unsigned sum, cnt, mine, sp = 0u;
    for (;;) {
        sum = 0u; cnt = 0u; mine = 0u;
#pragma unroll
        for (unsigned j = 0; j < 16; ++j) { const unsigned c = xb_ld(&bar[XB_XCNT(j)]); sum += c; cnt += (c > 0u) ? 1u : 0u; mine = (j == x) ? c : mine; }
        if (sum == G) break;
        __builtin_amdgcn_s_sleep(1);
        if ((++sp & 255u) == 0u) { if (xb_ld(&bar[XB_TMO])) break; if (sp > XB_SPIN_CAP) { atomicAdd(&bar[XB_TMO], 1u); break; } }
    }
    nloc = mine > 0u ? mine : 1u; nx = cnt > 0u ? cnt : 1u;
}

__device__ __forceinline__ void xcd_barrier(const XcdBarrier& b) {
    asm volatile("s_waitcnt vmcnt(0)" ::: "memory");
    __syncthreads();
    if (threadIdx.x == 0) {
        unsigned* bar = b.bar;
        __builtin_amdgcn_s_waitcnt(0);
        unsigned nloc = b.st[0], nx = b.st[1];
        if (nloc == 0u) { xcd_barrier_complete(bar, b.x, nloc, nx); b.st[0] = nloc; b.st[1] = nx; }
        const unsigned old = xb_add(&bar[XB_XSUB(b.x)], 1u);
        const unsigned gen = old / nloc;
        if (old + 1u == (gen + 1u) * nloc) {
            __builtin_amdgcn_fence(__ATOMIC_RELEASE, "agent");
            asm volatile("s_waitcnt vmcnt(0)" ::: "memory");
            const unsigned og = xb_add(&bar[XB_TOP], 1u);
            const unsigned tg = og / nx;
            if (og + 1u == (tg + 1u) * nx) xb_add(&bar[XB_TOPGEN], 1u);
            else XB_SPIN(xb_ld(&bar[XB_TOPGEN]) == tg, bar);
            __builtin_amdgcn_fence(__ATOMIC_ACQUIRE, "agent");
            xb_add(&bar[XB_XGEN(b.x)], 1u);
            asm volatile("s_waitcnt vmcnt(0)" ::: "memory");
        } else {
            XB_SPIN(xb_ld(&bar[XB_XGEN(b.x)]) == gen, bar);
            __builtin_amdgcn_fence(__ATOMIC_ACQUIRE, "agent");
            asm volatile("s_waitcnt vmcnt(0)" ::: "memory");
        }
    }
    __syncthreads();
}
namespace pg8 {
#define PG8_LAS __attribute__((address_space(3)))
typedef unsigned short bf16_t;
typedef short bf16x8 __attribute__((ext_vector_type(8)));
typedef float f32x4 __attribute__((ext_vector_type(4)));
typedef unsigned u32x4 __attribute__((ext_vector_type(4)));
constexpr int BM = 256, BK = 64, HALF = 128, HTB = HALF * BK * 2  , STAGE_BYTES = 8 * HTB, NXCD = 8, WGM = 8;

__host__ __device__ __forceinline__ int lds_byte(int r, int c) { const int st = (r >> 4) * 2 + (c >> 5), rr = r & 15, cc = c & 31, ob = rr * 64 + cc * 2; return st * 1024 + (ob ^ (((ob >> 9) & 1) << 5)); }
__host__ __device__ __forceinline__ void stage_rc(int b, int& R, int& C) { const int st = b / 1024, sb = b % 1024, swz = sb ^ (((sb >> 9) & 1) << 5); R = (st >> 1) * 16 + swz / 64; C = (st & 1) * 32 + (swz % 64) / 2; }
__host__ __device__ __forceinline__ int perm32(int rho) { const int n = rho >> 4, i = rho & 15; return 8 * (i >> 2) + 4 * n + (i & 3); }

struct Unit { int pm, pn; };
struct Gemm { const bf16_t* A; const bf16_t* Bt; int M, N, K; size_t aps; };
__device__ __forceinline__ size_t a_part_bytes(const Gemm& g, int pn) { return g.aps ? (size_t)(pn < 64 ? (pn >> 4) : (pn - 60)) * g.aps * 2 : (size_t)0; }

struct StaticOrder {
    int nM, nN, nwg, G, c;
    __host__ __device__ void init(int M, int N, int G_, int c_) { nM = M / BM; nN = N / BM; nwg = nM * nN; G = G_; c = c_; }
    __host__ __device__ bool next(int i, Unit& u) const {
        const long L = (long)i * G + c; if (L >= nwg) return false;
        int wgid = (int)L; { const int q = nwg / NXCD, r = nwg % NXCD, xcd = wgid % NXCD, off = wgid / NXCD; wgid = (xcd < r ? xcd * (q + 1) : r * (q + 1) + (xcd - r) * q) + off; }
        const int nig = WGM * nN, gid = wgid / nig, fm = gid * WGM, gsz = (nM - fm) < WGM ? (nM - fm) : WGM;
        u.pm = fm + ((wgid % nig) % gsz); u.pn = (wgid % nig) / gsz; return true;
    }
    __device__ __forceinline__ void a_ready(const Unit&) const {}
    __device__ __forceinline__ void done(const Unit&) const {}
};
struct CountedOrder : StaticOrder {
    const unsigned* ready; unsigned need; unsigned* tmo;
    __device__ __forceinline__ void a_ready(const Unit& u) const {
        if (threadIdx.x < 64) {
            const unsigned long long t0 = __builtin_amdgcn_s_memrealtime(); unsigned polls = 0;
            while ((unsigned)__builtin_amdgcn_readfirstlane(__hip_atomic_load(ready + 64 * u.pm, __ATOMIC_RELAXED, __HIP_MEMORY_SCOPE_AGENT)) < need) {
                if ((++polls & 255u) == 0u && __builtin_amdgcn_readfirstlane(__hip_atomic_load(tmo, __ATOMIC_RELAXED, __HIP_MEMORY_SCOPE_AGENT)) != 0u) break;
                if (__builtin_amdgcn_s_memrealtime() - t0 > 2000000ull) {
                    if (threadIdx.x == 0) { unsigned expect = 0u; __hip_atomic_compare_exchange_strong(tmo + 1, &expect, 0x600u | (unsigned)(u.pm & 0xff), __ATOMIC_RELAXED, __ATOMIC_RELAXED, __HIP_MEMORY_SCOPE_AGENT); __hip_atomic_store(tmo, 1u, __ATOMIC_RELAXED, __HIP_MEMORY_SCOPE_AGENT); }
                    break; }
                __builtin_amdgcn_s_sleep(2); }
            __builtin_amdgcn_fence(__ATOMIC_ACQUIRE, "agent");
            asm volatile("s_waitcnt vmcnt(0)" ::: "memory");
        }
#if !defined(BROKEN_HOOK_NO_BARRIER)
        asm volatile("" ::: "memory"); __builtin_amdgcn_s_barrier(); asm volatile("" ::: "memory");
#endif
    }
};
template <class Epi, class Sched, bool STAMP = false, bool TOPHALF = false>
__device__ __forceinline__ void gemm_phase(PG8_LAS unsigned char* lds, const Gemm g, const Sched& S, const Epi& E, unsigned long long* stamps) {
    int tid_ = threadIdx.x; asm volatile("" : "+v"(tid_));
    const int tid = tid_, wid = __builtin_amdgcn_readfirstlane(tid >> 6), lane = tid & 63, wr = wid >> 2, wc = wid & 3, fr = lane & 15, fq = lane >> 4;
    const int K = g.K, nt = K / BK;
    int ts_lo = 0, ts_hi = 0, nts = 0; const unsigned long long rt_entry = STAMP ? (unsigned long long)wall_clock64() : 0ull;
#define PG8_STAMP() do { if (STAMP && wid == 0 && nts < 64) { const unsigned long long _c = (unsigned long long)clock64(); \
        ts_lo = (lane == nts) ? (int)(unsigned)_c : ts_lo; ts_hi = (lane == nts) ? (int)(unsigned)(_c >> 32) : ts_hi; ++nts; } } while (0)
    PG8_STAMP();
    unsigned voffA[2], voffB[2];
#pragma unroll
    for (int i = 0; i < 2; ++i) { int R, C; stage_rc(tid * 16 + i * 8192, R, C); const int Rb = Epi::PERM ? ((R & ~31) + perm32(R & 31)) : R;
        voffA[i] = (unsigned)(R * K + C) * 2u; voffB[i] = (unsigned)(Rb * K + C) * 2u; }
    const size_t kstep = (size_t)(BK * 2);
    const size_t hstep = (size_t)HALF * K * 2;
    const size_t tstep = 2 * hstep;
    const unsigned ldsw = (unsigned)wid * 1024u;
    const int aoff = lds_byte(wr * 64 + fr, fq * 8), boff = lds_byte(wc * 32 + fr, fq * 8);
#define PG8_SA(b, h) (((b) * 2 + (h)) * HTB)
#define PG8_SB(b, h) ((4 + (b) * 2 + (h)) * HTB)
#define PG8_STAGE(bufoff, gbase, voff) do { _Pragma("unroll") for (int _i = 0; _i < 2; ++_i) \
        __builtin_amdgcn_global_load_lds((const unsigned*)((const char*)(gbase) + (voff)[_i]), (PG8_LAS unsigned*)(lds + (bufoff) + ldsw + _i * 8192), 16, 0, 0); } while (0)
#define PG8_LDA(dst, b, h) do { _Pragma("unroll") for (int m = 0; m < 4; ++m) _Pragma("unroll") for (int k = 0; k < 2; ++k) dst[m][k] = *(const PG8_LAS bf16x8*)(lds + PG8_SA(b, h) + aoff + m * 2048 + k * 1024); } while (0)
#define PG8_LDB(dst, b, h) do { _Pragma("unroll") for (int n = 0; n < 2; ++n) _Pragma("unroll") for (int k = 0; k < 2; ++k) dst[n][k] = *(const PG8_LAS bf16x8*)(lds + PG8_SB(b, h) + boff + n * 2048 + k * 1024); } while (0)
#define PG8_MMA(ai, bj, At, Bt) do { __builtin_amdgcn_s_setprio(1); _Pragma("unroll") for (int m = 0; m < 4; ++m) _Pragma("unroll") for (int n = 0; n < 2; ++n) _Pragma("unroll") for (int k = 0; k < 2; ++k) \
        acc[ai][bj][m][n] = __builtin_amdgcn_mfma_f32_16x16x32_bf16(Bt[n][k], At[m][k], acc[ai][bj][m][n], 0, 0, 0); __builtin_amdgcn_s_setprio(0); } while (0)
#define PG8_WAIT_V(n) asm volatile("s_waitcnt vmcnt(" #n ")" ::: "memory")
#define PG8_WAIT_L(n) asm volatile("s_waitcnt lgkmcnt(" #n ")" ::: "memory")
#define PG8_BAR __builtin_amdgcn_s_barrier()
#define PG8_SCHED __builtin_amdgcn_sched_barrier(0)
    Unit cur, nxt; int ui = 0;
    if (!S.next(0, cur)) return;
    f32x4 acc[2][2][4][2];
#pragma unroll
    for (int a = 0; a < 2; ++a)
#pragma unroll
        for (int b = 0; b < 2; ++b)
#pragma unroll
            for (int m = 0; m < 4; ++m)
#pragma unroll
                for (int n = 0; n < 2; ++n) acc[a][b][m][n] = (f32x4){0.f, 0.f, 0.f, 0.f};
    bf16x8 At[4][2], B0[2][2], B1[2][2];
    const char* cA = (const char*)g.A + a_part_bytes(g, cur.pn) + (size_t)cur.pm * tstep; const char* cB = (const char*)g.Bt + (size_t)cur.pn * tstep;
    S.a_ready(cur);
    PG8_STAGE(PG8_SB(0, 0), cB, voffB); PG8_STAGE(PG8_SA(0, 0), cA, voffA); PG8_STAGE(PG8_SB(0, 1), cB + hstep, voffB); PG8_STAGE(PG8_SA(0, 1), cA + hstep, voffA);
    if (wr == 1) PG8_BAR;
    PG8_WAIT_V(4); PG8_BAR;
    PG8_STAGE(PG8_SB(1, 0), cB + kstep, voffB); PG8_STAGE(PG8_SA(1, 0), cA + kstep, voffA); PG8_STAGE(PG8_SB(1, 1), cB + hstep + kstep, voffB);
    PG8_WAIT_V(6); PG8_BAR;
    PG8_STAMP();
    for (;;) {
        const bool has_next = S.next(ui + 1, nxt);
        const char* nA = has_next ? (const char*)g.A + a_part_bytes(g, nxt.pn) + (size_t)nxt.pm * tstep : cA; const char* nB = has_next ? (const char*)g.Bt + (size_t)nxt.pn * tstep : cB;
        for (int t = 0; t < nt; t += 2) {
            const bool last = (t == nt - 2);
            const char* a1 = cA + (size_t)(t + 1) * kstep;
            const char* a2 = last ? nA : cA + (size_t)(t + 2) * kstep; const char* b2 = last ? nB : cB + (size_t)(t + 2) * kstep;
            const char* a3 = a2 + kstep; const char* b3 = b2 + kstep;
            if (last && has_next) S.a_ready(nxt);
            PG8_LDB(B0, 0, 0); PG8_SCHED; PG8_LDA(At, 0, 0); PG8_STAGE(PG8_SA(1, 1), a1 + hstep, voffA);
            PG8_WAIT_L(8); PG8_BAR; PG8_WAIT_L(0); PG8_MMA(0, 0, At, B0); PG8_BAR; PG8_SCHED;
            PG8_LDB(B1, 0, 1); PG8_STAGE(PG8_SB(0, 0), b2, voffB);
            PG8_BAR; PG8_WAIT_L(0); PG8_MMA(0, 1, At, B1); PG8_BAR;
            if constexpr (!TOPHALF) PG8_LDA(At, 0, 1); PG8_STAGE(PG8_SA(0, 0), a2, voffA);
            PG8_BAR; PG8_WAIT_L(0); if constexpr (!TOPHALF) PG8_MMA(1, 0, At, B0); PG8_BAR; PG8_SCHED;
            PG8_STAGE(PG8_SB(0, 1), b2 + hstep, voffB);
            PG8_WAIT_V(6); PG8_BAR; if constexpr (!TOPHALF) PG8_MMA(1, 1, At, B1); PG8_BAR;
            PG8_LDB(B0, 1, 0); PG8_SCHED; PG8_LDA(At, 1, 0); PG8_STAGE(PG8_SA(0, 1), a2 + hstep, voffA);
            PG8_WAIT_L(8); PG8_BAR; PG8_WAIT_L(0); PG8_MMA(0, 0, At, B0); PG8_BAR; PG8_SCHED;
            PG8_LDB(B1, 1, 1); PG8_STAGE(PG8_SB(1, 0), b3, voffB);
            PG8_BAR; PG8_WAIT_L(0); PG8_MMA(0, 1, At, B1); PG8_BAR;
            if constexpr (!TOPHALF) PG8_LDA(At, 1, 1); PG8_STAGE(PG8_SA(1, 0), a3, voffA);
            PG8_BAR; PG8_WAIT_L(0); if constexpr (!TOPHALF) PG8_MMA(1, 0, At, B0); PG8_BAR; PG8_SCHED;
            PG8_STAGE(PG8_SB(1, 1), b3 + hstep, voffB);
            PG8_WAIT_V(6); PG8_BAR; if constexpr (!TOPHALF) PG8_MMA(1, 1, At, B1); PG8_BAR;
        }
        PG8_STAMP();
        if constexpr (!Epi::AFTER_DRAIN) { E(acc, cur, wr, wc, fr, fq); S.done(cur); }
        PG8_STAMP();
        if (!has_next) break;
#pragma unroll
        for (int a = 0; a < 2; ++a)
#pragma unroll
            for (int b = 0; b < 2; ++b)
#pragma unroll
                for (int m = 0; m < 4; ++m)
#pragma unroll
                    for (int n = 0; n < 2; ++n) acc[a][b][m][n] = (f32x4){0.f, 0.f, 0.f, 0.f};
        cur = nxt; cA = nA; cB = nB; ++ui;
    }
    PG8_WAIT_V(0);
    if (wr == 0) PG8_BAR;
    PG8_BAR;
    if constexpr (Epi::AFTER_DRAIN) { E.fused(acc, cur, wr, wc, fr, fq, lds, wid, lane); S.done(cur); }
    PG8_STAMP();
    if (STAMP && wid == 0) { stamps[lane] = lane < nts ? (((unsigned long long)(unsigned)ts_hi << 32) | (unsigned)ts_lo) : 0ull;
        if (lane == 62) stamps[62] = rt_entry; if (lane == 63) stamps[63] = (unsigned long long)wall_clock64(); }
#undef PG8_STAMP
#undef PG8_SA
#undef PG8_SB
#undef PG8_STAGE
#undef PG8_LDA
#undef PG8_LDB
#undef PG8_MMA
#undef PG8_WAIT_V
#undef PG8_WAIT_L
#undef PG8_BAR
#undef PG8_SCHED
}
}
namespace mk {
typedef pg8::Unit Unit;
typedef const pg8::f32x4 (&AccRef)[2][2][4][2];

__device__ __forceinline__ void st_bf8(bf16_t* p, pg8::f32x4 v0, pg8::f32x4 v1) {
    u32x4 w; w.x = cvt_pk_bf16(v0[0], v0[1]); w.y = cvt_pk_bf16(v0[2], v0[3]); w.z = cvt_pk_bf16(v1[0], v1[1]); w.w = cvt_pk_bf16(v1[2], v1[3]);
    *(u32x4*)p = w;
}
__device__ __forceinline__ void st_bf4(bf16_t* p, pg8::f32x4 v) { u32x2 w; w.x = cvt_pk_bf16(v[0], v[1]); w.y = cvt_pk_bf16(v[2], v[3]); *(u32x2*)p = w; }

struct EpiY {
    static constexpr bool PERM = true, AFTER_DRAIN = false;
    bf16_t* O;
    __device__ __forceinline__ void operator()(AccRef acc, const Unit& u, int wr, int wc, int fr, int fq) const {
        const int row0 = u.pm * 256 + wr * 64 + fr, col0 = u.pn * 256 + wc * 32 + 8 * fq;
#pragma unroll
        for (int ai = 0; ai < 2; ++ai)
#pragma unroll
            for (int m = 0; m < 4; ++m) { bf16_t* rowp = O + (size_t)(row0 + ai * 128 + m * 16) * D + col0;
#pragma unroll
                for (int bj = 0; bj < 2; ++bj) st_bf8(rowp + bj * 128, acc[ai][bj][m][0], acc[ai][bj][m][1]); }
    }
};
struct EpiH1 {
    static constexpr bool PERM = true, AFTER_DRAIN = false;
    bf16_t* Y; const float* lbl; int jl;
    __device__ __forceinline__ void operator()(AccRef acc, const Unit& u, int wr, int wc, int fr, int fq) const {
        const int part = u.pn >> 4, colt = (u.pn & 15) * 256;
        const int row0 = u.pm * 256 + wr * 64 + fr, col0 = colt + wc * 32 + 8 * fq;
        if (part == 1) {
#pragma unroll
            for (int bj = 0; bj < 2; ++bj) {
                pg8::f32x4 lbv[2] = {{0.f, 0.f, 0.f, 0.f}, {0.f, 0.f, 0.f, 0.f}};
                if (jl) {
#pragma unroll
                    for (int n = 0; n < 2; ++n) { const pg8::f32x4 l0 = *(const pg8::f32x4*)(lbl + col0 + bj * 128 + 4 * n), l1 = *(const pg8::f32x4*)(lbl + D + col0 + bj * 128 + 4 * n);
#pragma unroll
                        for (int j = 0; j < 4; ++j) lbv[n][j] = sigmoid_f(l1[j] - l0[j]); }
                }
#pragma unroll
                for (int ai = 0; ai < 2; ++ai)
#pragma unroll
                    for (int m = 0; m < 4; ++m) {
                        const int row = row0 + ai * 128 + m * 16;
                        pg8::f32x4 o[2];
#pragma unroll
                        for (int n = 0; n < 2; ++n)
#pragma unroll
                            for (int j = 0; j < 4; ++j) {
                                const float x = acc[ai][bj][m][n][j]; float g;
                                if (jl) { const float l = lbv[n][j]; g = __logf(l + (1.f - l) * sigmoid_f(x)); }
                                else g = fminf(x, 0.f) - __logf(1.f + __expf(-fabsf(x)));
                                o[n][j] = (row < NPAD) ? 0.f : g;
                            }
                        float* gp = (float*)(Y + 3 * (SLOT / 2)) + (size_t)row * D + col0 + bj * 128;
                        *(pg8::f32x4*)gp = o[0]; *(pg8::f32x4*)(gp + 4) = o[1];
                    }
            }
        } else {
            bf16_t* dst = Y + (size_t)(part == 0 ? 0 : (part == 2 ? 1 : 2)) * (SLOT / 2);
#pragma unroll
            for (int ai = 0; ai < 2; ++ai)
#pragma unroll
                for (int m = 0; m < 4; ++m) { bf16_t* rowp = dst + (size_t)(row0 + ai * 128 + m * 16) * D + col0;
#pragma unroll
                    for (int bj = 0; bj < 2; ++bj) st_bf8(rowp + bj * 128, acc[ai][bj][m][0], acc[ai][bj][m][1]); }
        }
    }
};
struct EpiB1 {
    static constexpr bool PERM = false, AFTER_DRAIN = false;
    bf16_t* Y; const float* cs; const float* sn;
    __device__ __forceinline__ void operator()(AccRef acc, const Unit& u, int wr, int wc, int fr, int fq) const {
        const int part = u.pn >> 4, colt = (u.pn & 15) * 256;
        const int row0 = u.pm * 256 + wr * 64 + fr, col0 = colt + wc * 32 + 4 * fq;
        bf16_t* dst = Y + (size_t)part * (SLOT / 2);
        const bool rope = (part < 2) && (wc == 0);
#pragma unroll
        for (int ai = 0; ai < 2; ++ai)
#pragma unroll
            for (int m = 0; m < 4; ++m) {
                const int row = row0 + ai * 128 + m * 16;
                pg8::f32x4 c4 = {1.f, 1.f, 1.f, 1.f}, s4 = {0.f, 0.f, 0.f, 0.f};
                if (rope) { c4 = *(const pg8::f32x4*)(cs + (size_t)row * 16 + 4 * fq); s4 = *(const pg8::f32x4*)(sn + (size_t)row * 16 + 4 * fq); }
                bf16_t* rowp = dst + (size_t)row * D + col0;
#pragma unroll
                for (int bj = 0; bj < 2; ++bj) {
                    const pg8::f32x4 x1 = acc[ai][bj][m][0], x2 = acc[ai][bj][m][1];
                    const pg8::f32x4 y1 = x1 * c4 - x2 * s4, y2 = x2 * c4 + x1 * s4;
                    st_bf4(rowp + bj * 128, y1); st_bf4(rowp + bj * 128 + 16, y2);
                }
            }
    }
};
struct EpiC1 {
    static constexpr bool PERM = true, AFTER_DRAIN = false;
    bf16_t *Y, *T;
    __device__ __forceinline__ void operator()(AccRef acc, const Unit& u, int wr, int wc, int fr, int fq) const {
        const int row0 = u.pm * 256 + wr * 64 + fr;
        if (u.pn < 64) {
            const int part = u.pn >> 4, col0 = (u.pn & 15) * 256 + wc * 32 + 8 * fq;
            bf16_t* dst = Y + (size_t)part * (SLOT / 2);
#pragma unroll
            for (int ai = 0; ai < 2; ++ai)
#pragma unroll
                for (int m = 0; m < 4; ++m) { bf16_t* rowp = dst + (size_t)(row0 + ai * 128 + m * 16) * D + col0;
#pragma unroll
                    for (int bj = 0; bj < 2; ++bj) st_bf8(rowp + bj * 128, acc[ai][bj][m][0], acc[ai][bj][m][1]); }
        } else {
            const int which = u.pn - 64, col0 = which * 128 + wc * 32 + 8 * fq;
#pragma unroll
            for (int ai = 0; ai < 2; ++ai)
#pragma unroll
                for (int m = 0; m < 4; ++m) {
                    pg8::f32x4 v0 = acc[ai][0][m][0], v1 = acc[ai][0][m][1];
                    if (which == 0) {
#pragma unroll
                        for (int j = 0; j < 4; ++j) { v0[j] = 1.f - 2.f / (1.f + __expf(2.f * v0[j])); v1[j] = 1.f - 2.f / (1.f + __expf(2.f * v1[j])); }
                    }
                    st_bf8(T + (size_t)(row0 + ai * 128 + m * 16) * 256 + col0, v0, v1);
                }
        }
    }
};
struct EpiC2 {
    static constexpr bool PERM = true, AFTER_DRAIN = false;
    bf16_t* Y; const float* w0; const float* a0;
    __device__ __forceinline__ void operator()(AccRef acc, const Unit& u, int wr, int wc, int fr, int fq) const {
        const int row0 = u.pm * 256 + wr * 64 + fr;
        const bool isw = u.pn < 16;
        const int col0 = (u.pn & 15) * 256 + wc * 32 + 8 * fq;
        bf16_t* dst = Y + (size_t)(isw ? 4 : 5) * (SLOT / 2); const float* bias = isw ? w0 : a0;
#pragma unroll
        for (int bj = 0; bj < 2; ++bj) {
            const pg8::f32x4 b0 = *(const pg8::f32x4*)(bias + col0 + bj * 128), b1 = *(const pg8::f32x4*)(bias + col0 + bj * 128 + 4);
#pragma unroll
            for (int ai = 0; ai < 2; ++ai)
#pragma unroll
                for (int m = 0; m < 4; ++m) {
                    pg8::f32x4 v0 = acc[ai][bj][m][0] + b0, v1 = acc[ai][bj][m][1] + b1;
#pragma unroll
                    for (int j = 0; j < 4; ++j) {
                        float s0 = sigmoid_f(v0[j]), s1 = sigmoid_f(v1[j]);
                        if (isw) { s0 = __expf(-0.606531f * s0); s1 = __expf(-0.606531f * s1); }
                        v0[j] = s0; v1[j] = s1;
                    }
                    st_bf8(dst + (size_t)(row0 + ai * 128 + m * 16) * D + col0 + bj * 128, v0, v1);
                    __builtin_amdgcn_sched_barrier(0);
                }
        }
    }
};

struct Fr {
    LAS unsigned char* lds; unsigned char* ldsg;
    int tid, lane, wave, G, bid, gw, NGW;
    float* out; unsigned char* ws;
    __device__ __forceinline__ Fr fresh() const { Fr P = *this; asm volatile("" : "+v"(P.tid)); P.lane = P.tid & 63; P.wave = __builtin_amdgcn_readfirstlane(P.tid >> 6); P.gw = P.bid * 8 + P.wave; return P; }
    __device__ __forceinline__ const float* in(int i) const {
        const __attribute__((address_space(4))) unsigned long long* ka = (const __attribute__((address_space(4))) unsigned long long*)__builtin_amdgcn_kernarg_segment_ptr();
        asm volatile("" : "+s"(ka));
        return (const float*)ka[i];
    }
};
__device__ __forceinline__ bf16_t* slotU(const Fr& F, int s) { return (bf16_t*)(F.ws + WS_U + (size_t)s * SLOT); }
__device__ __forceinline__ bf16_t* slotY(const Fr& F, int s) { return (bf16_t*)(F.ws + WS_Y + (size_t)s * SLOT); }
__device__ __forceinline__ float* hrow(const Fr& F, int r) { return r < 64 ? (float*)(F.ws + WS_HMETA) + (size_t)r * D : F.out + (size_t)(r - 64) * D; }

__device__ __forceinline__ void transpose_item(const float* W, int ldw, bf16_t* WT, int ldt, int koff, LAS float* scr, int kb, int nb, int lane) {
    const int k0 = 64 * kb, n0 = 32 * nb;
#pragma unroll 8
    for (int i = 0; i < 32; ++i) { const int kk = 2 * i + (lane >> 5); scr[kk * 33 + (lane & 31)] = W[(size_t)(k0 + kk) * ldw + n0 + (lane & 31)]; }
    LDS_WAIT(); asm volatile("" ::: "memory");
    const int c = lane & 7;
#pragma unroll
    for (int j = 0; j < 4; ++j) { const int n = (lane >> 3) + 8 * j; const LAS float* s = scr + (8 * c) * 33 + n;
        u32x4 o; o.x = cvt_pk_bf16(s[0 * 33], s[1 * 33]); o.y = cvt_pk_bf16(s[2 * 33], s[3 * 33]); o.z = cvt_pk_bf16(s[4 * 33], s[5 * 33]); o.w = cvt_pk_bf16(s[6 * 33], s[7 * 33]);
        *(u32x4*)(WT + (size_t)(n0 + n) * ldt + koff + k0 + 8 * c) = o; }
    LDS_WAIT(); asm volatile("" ::: "memory");
}
__device__ __forceinline__ void convert_matrix(const Fr& F, const float* W, int K, int N, bf16_t* WT, int ldt, int koff, int wg_skip = 0) {
    LAS float* scr = (LAS float*)(F.lds + F.wave * 8704);
    const int nblk = N / 32, nitems = (K / 64) * nblk;
    for (int it = F.gw - wg_skip * 8; it < nitems; it += F.NGW - wg_skip * 8) transpose_item(W, N, WT, ldt, koff, scr, it / nblk, it % nblk, F.lane);
}
__device__ __forceinline__ void zero_bytes(const Fr& F, void* p, size_t nbytes) {
    u32x4* q = (u32x4*)p; const size_t n = nbytes / 16; const u32x4 z = {0u, 0u, 0u, 0u};
    for (size_t i = (size_t)F.bid * 512 + F.tid; i < n; i += (size_t)F.G * 512) q[i] = z;
}
__device__ __forceinline__ bf16_t* wtin_of(const Fr& F, int L) { return (bf16_t*)(F.ws + ((L & 1) ? WS_WTINB : WS_WTIN)); }
__device__ __forceinline__ void convert_win(const Fr& F, int L, int wg_skip) {
    const float* src = (L == 0 || L == 3) ? F.in(4) + (size_t)(L ? 1 : 0) * D * 4 * D : (L == 1 ? F.in(8) : F.in(16));
    convert_matrix(F, src, D, 4 * D, wtin_of(F, L), D, 0, wg_skip);
}
__device__ __forceinline__ void convert_layer(const Fr& F, int L, bool with_win) {
    bf16_t* wtin = wtin_of(F, L); bf16_t* wtout = (bf16_t*)(F.ws + WS_WTOUT);
    if (with_win) convert_win(F, L, 0);
    if (L == 0 || L == 3) {
        convert_matrix(F, F.in(7) + (size_t)(L ? 1 : 0) * D * D, D, D, wtout, D, 0);
    } else if (L == 1) {
        convert_matrix(F, F.in(14), D, D, wtout, D, 0);
    } else {
        convert_matrix(F, F.in(28), D, D, wtout, D, 0);
        convert_matrix(F, F.in(18), D, 128, wtin + (size_t)16384 * D, D, 0);
        convert_matrix(F, F.in(21), D, 128, wtin + (size_t)16640 * D, D, 0);
        zero_bytes(F, wtin + (size_t)16512 * D, (size_t)128 * D * 2);
        zero_bytes(F, wtin + (size_t)16768 * D, (size_t)128 * D * 2);
        bf16_t* w2p = (bf16_t*)(F.ws + WS_W2P);
        zero_bytes(F, w2p, (size_t)8192 * 256 * 2);
    }
}
__device__ __forceinline__ void convert_layer2_b(const Fr& F) {
    bf16_t* w2p = (bf16_t*)(F.ws + WS_W2P);
    convert_matrix(F, F.in(19), 128, D, w2p, 256, 0);
    convert_matrix(F, F.in(22), 128, D, w2p + (size_t)4096 * 256, 256, 128);
}

__constant__ float c_inv_freq[16] = {1.0f, 0.44036659598350525f, 0.1939227432012558f, 0.08539710193872452f, 0.03760603070259094f, 0.01656043902039528f, 0.007292664609849453f, 0.0032114458736032248f,
    0.0014142135623842478f, 0.000622772378847003f, 0.00027424818836152554f, 0.00012076973507646471f, 5.318296098266728e-05f, 2.34199997066753e-05f, 1.0313386155758053e-05f, 4.541670477919979e-06f};
__device__ __forceinline__ void rope_table(const Fr& F) {
    float* cs = (float*)(F.ws + WS_ROPE); float* sn = cs + (size_t)R * 16;
    for (int i = F.bid * 512 + F.tid; i < R * 16; i += F.G * 512) {
        const int row = i >> 4, j = i & 15; const int pos = row - NPAD;
        const double ang = (double)(float)((float)pos * c_inv_freq[j]);
        const double k = __builtin_rint(ang * 0.15915494309189535);
        double x = ang - k * 6.283185307179586;
        const double q = __builtin_rint(x * 0.6366197723675814);
        x -= q * 1.5707963267948966;
        const int qi = ((int)q) & 3;
        const double x2 = x * x;
        const double s = x * (1.0 + x2 * (-1.0 / 6 + x2 * (1.0 / 120 + x2 * (-1.0 / 5040 + x2 * (1.0 / 362880 + x2 * (-1.0 / 39916800))))));
        const double c = 1.0 + x2 * (-0.5 + x2 * (1.0 / 24 + x2 * (-1.0 / 720 + x2 * (1.0 / 40320 + x2 * (-1.0 / 3628800 + x2 * (1.0 / 479001600))))));
        double sv, cv;
        if (qi == 0) { sv = s; cv = c; } else if (qi == 1) { sv = c; cv = -s; } else if (qi == 2) { sv = -s; cv = -c; } else { sv = -c; cv = s; }
        cs[i] = (float)cv; sn[i] = (float)sv;
    }
}

typedef const GAS char* gcp; typedef GAS char* gp_;
#define ROW_F32(nm, base, lane) gp_ nm##0 = (gp_)(base) + (lane) * 16 + 4096; gp_ nm##1 = nm##0 + 8192; asm volatile("" : "+v"(nm##0), "+v"(nm##1))
#define AT_F32(nm, j) (*(GAS f32x4*)((j) < 8 ? nm##0 + ((j) - 4) * 1024 : nm##1 + ((j) - 12) * 1024))
#define ROW_BF(nm, base, lane) gp_ nm##0 = (gp_)(base) + (lane) * 8 + 4096; asm volatile("" : "+v"(nm##0))
#define AT_BF(nm, j) (*(GAS u32x2*)(nm##0 + (j) * 512 - 4096))
__device__ __forceinline__ void norm_phase(const Fr& F, int prev, int next, const bf16_t* y, bf16_t* udst, int rlo = 0, int rhi = R, int wg_skip = 0) {
    const float* postg = F.in(3) + (size_t)(prev < 0 ? 0 : prev) * D; const float* preg = F.in(2) + (size_t)(next < 0 ? 0 : next) * D;
    const float* xin = F.in(0); const float* meta = F.in(1);
    for (int r = rlo + F.gw - wg_skip * 8; r < rhi; r += F.NGW - wg_skip * 8) {
        if (r < NPAD || r >= NREAL) {
            if (next >= 0) { ROW_BF(uo, udst + (size_t)r * D, F.lane); const u32x2 z = {0u, 0u};
#pragma unroll
                for (int j = 0; j < 16; ++j) AT_BF(uo, j) = z; }
            continue;
        }
        ROW_BF(hp, (bf16_t*)(F.ws + WS_HB) + (size_t)r * D, F.lane);
        f32x4 hv[16];
        if (prev < 0) {
            const float* src = r < 64 ? meta + (size_t)(r - NPAD) * D : xin + (size_t)(r - 64) * D;
            ROW_F32(sp, src, F.lane);
#pragma unroll
            for (int j = 0; j < 16; ++j) hv[j] = AT_F32(sp, j);
        } else {
            ROW_BF(yp, y + (size_t)r * D, F.lane); ROW_F32(gp, postg, F.lane);
            u32x2 yv[16], hb[16]; float ss = 0.f;
#pragma unroll
            for (int j = 0; j < 16; ++j) { yv[j] = AT_BF(yp, j); hb[j] = AT_BF(hp, j); }
#pragma unroll
            for (int j = 0; j < 16; ++j) { const float a = bflo(yv[j].x), b = bfhi(yv[j].x), c = bflo(yv[j].y), d = bfhi(yv[j].y); ss += (a * a + b * b) + (c * c + d * d); }
#pragma unroll
            for (int j = 0; j < 16; ++j) asm volatile("" : "+v"(yv[j].x), "+v"(yv[j].y));
            const float rs = __builtin_amdgcn_rsqf(wave_sum(ss) * (1.f / D) + 1e-6f);
#pragma unroll
            for (int j = 0; j < 16; ++j) { const f32x4 g = AT_F32(gp, j);
                hv[j].x = bflo(hb[j].x) + bflo(yv[j].x) * rs * g.x; hv[j].y = bfhi(hb[j].x) + bfhi(yv[j].x) * rs * g.y; hv[j].z = bflo(hb[j].y) + bflo(yv[j].y) * rs * g.z; hv[j].w = bfhi(hb[j].y) + bfhi(yv[j].y) * rs * g.w; }
        }
        if (next < 0) {
            if (r >= 64) { ROW_F32(op, F.out + (size_t)(r - 64) * D, F.lane);
#pragma unroll
                for (int j = 0; j < 16; ++j) AT_F32(op, j) = hv[j];
            }
            continue;
        }
        float s2 = 0.f;
#pragma unroll
        for (int j = 0; j < 16; ++j) { u32x2 w_; w_.x = cvt_pk_bf16(hv[j].x, hv[j].y); w_.y = cvt_pk_bf16(hv[j].z, hv[j].w); AT_BF(hp, j) = w_; s2 += (hv[j].x * hv[j].x + hv[j].y * hv[j].y) + (hv[j].z * hv[j].z + hv[j].w * hv[j].w); }
        const float rs2 = __builtin_amdgcn_rsqf(wave_sum(s2) * (1.f / D) + 1e-6f);
        ROW_BF(uo, udst + (size_t)r * D, F.lane); ROW_F32(pg, preg, F.lane);
#pragma unroll
        for (int j = 0; j < 16; ++j) { const f32x4 g = AT_F32(pg, j); u32x2 w; w.x = cvt_pk_bf16(hv[j].x * rs2 * g.x, hv[j].y * rs2 * g.y); w.y = cvt_pk_bf16(hv[j].z * rs2 * g.z, hv[j].w * rs2 * g.w); AT_BF(uo, j) = w; }
    }
}
__device__ __forceinline__ void mix_phase(const Fr& F, const bf16_t* u) {
    const float* mu = F.in(15);
    for (int r = F.gw; r < R; r += F.NGW) {
        const bool real = (r >= NPAD && r < NREAL);
        u32x2 cur[16], prv[16];
        const u32x2 z = {0u, 0u};
        { ROW_BF(cp, u + (size_t)r * D, F.lane); ROW_BF(pp, u + (size_t)(r > 0 ? r - 1 : 0) * D, F.lane);
#pragma unroll
          for (int j = 0; j < 16; ++j) { cur[j] = real ? AT_BF(cp, j) : z; prv[j] = (real && r > NPAD) ? AT_BF(pp, j) : z; } }
#pragma unroll 1
        for (int s = 0; s < 6; ++s) {
            ROW_BF(op, slotU(F, s) + (size_t)r * D, F.lane); ROW_F32(mp, mu + (size_t)s * D, F.lane);
#pragma unroll
            for (int j = 0; j < 16; ++j) {
                const f32x4 m = AT_F32(mp, j);
                const float c0 = bflo(cur[j].x), c1 = bfhi(cur[j].x), c2 = bflo(cur[j].y), c3 = bfhi(cur[j].y);
                const float p0 = bflo(prv[j].x), p1 = bfhi(prv[j].x), p2 = bflo(prv[j].y), p3 = bfhi(prv[j].y);
                u32x2 w; w.x = cvt_pk_bf16(c0 + (p0 - c0) * m.x, c1 + (p1 - c1) * m.y); w.y = cvt_pk_bf16(c2 + (p2 - c2) * m.z, c3 + (p3 - c3) * m.w);
                AT_BF(op, j) = real ? w : z;
            }
        }
    }
}
}
namespace mk {
constexpr int H_QE = 0, H_KE = 17408, H_KET = 34816, H_VT = 53248, H_PM = 71680, H_STB = 80896, H_VEC = 115712;
__device__ __forceinline__ bf16x8 ldfrag(const LAS unsigned char* base, int stride_b, int rb, int ks, int lane) {
    return *(const LAS bf16x8*)(base + (16 * rb + (lane & 15)) * stride_b + (32 * ks + 8 * (lane >> 4)) * 2);
}
template <bool OUT>
__device__ __forceinline__ void hgrn_phase(const Fr& F, int jl) {
    const bf16_t* Q = slotY(F, 0); const bf16_t* V = slotY(F, 1); const bf16_t* GT = slotY(F, 2); const float* Gg = (const float*)slotY(F, 3);
    bf16_t* Z = slotU(F, 0);
    float* HE = (float*)(F.ws + WS_HE); float* HLD = (float*)(F.ws + WS_HLOGD);
    const float* gn = F.in(6) + (size_t)jl * 128;
    LAS unsigned char* L = F.lds;
    LAS float* qtot = (LAS float*)(L + H_VEC); LAS float* ebm = qtot + 512; LAS float* ebl = ebm + 128;
    const int tid = F.tid, lane = F.lane, w = F.wave;
    const int d = tid & 127, qt = tid >> 7;
    for (int unit = F.bid; unit < 256; unit += F.G) {
        const int h = unit >> 3, seg = unit & 7;
        if (!OUT && seg == 7) continue;
        const int c0 = seg == 0 ? 0 : 33 + 32 * (seg - 1), c1 = c0 + (seg == 0 ? 33 : 32);
        f32x4 S[8];
#pragma unroll
        for (int i = 0; i < 8; ++i) S[i] = (f32x4){0.f, 0.f, 0.f, 0.f};
        if (OUT) {
            for (int j = 0; j < seg; ++j) {
                const float* ld = HLD + (size_t)(h * 8 + j) * 128; const float* e = HE + ((size_t)(h * 8 + j) * 512 + tid) * 32;
#pragma unroll
                for (int di = 0; di < 8; ++di) { const f32x4 l4 = *(const f32x4*)(ld + 16 * di + 4 * (lane >> 4)); const f32x4 e4 = *(const f32x4*)(e + 4 * di);
                    S[di].x = S[di].x * __expf(l4.x) + e4.x; S[di].y = S[di].y * __expf(l4.y) + e4.y; S[di].z = S[di].z * __expf(l4.z) + e4.z; S[di].w = S[di].w * __expf(l4.w) + e4.w; }
            }
        }
        float logD = 0.f;
        float g[16]; bf16_t qv[16], vv[16]; u32x4 gt0 = {0u, 0u, 0u, 0u}, gt1 = gt0, ngt0 = gt0, ngt1 = gt0;
#define HG_LOAD(cc) do { const int rowb_ = 64 * (cc) + 16 * qt; const size_t colb_ = (size_t)h * 128 + d; \
            _Pragma("unroll") for (int i = 0; i < 16; ++i) { g[i] = Gg[(size_t)(rowb_ + i) * D + colb_]; vv[i] = V[(size_t)(rowb_ + i) * D + colb_]; if (OUT) qv[i] = Q[(size_t)(rowb_ + i) * D + colb_]; } \
            if (OUT) { const bf16_t* gp_ = GT + (size_t)(64 * (cc) + (tid >> 3)) * D + h * 128 + 16 * (tid & 7); ngt0 = *(const u32x4*)gp_; ngt1 = *(const u32x4*)(gp_ + 8); } } while (0)
        HG_LOAD(c0);
        for (int c = c0; c < c1; ++c) {
            if (OUT) { gt0 = ngt0; gt1 = ngt1; }
            float f[16]; float run = 0.f;
#pragma unroll
            for (int i = 0; i < 16; ++i) { run += g[i]; f[i] = __expf(g[i]); }
            qtot[qt * 128 + d] = run;
            __syncthreads();
            const float t0 = qtot[d], t1 = qtot[128 + d], t2 = qtot[256 + d], t3 = qtot[384 + d];
            const float off = qt == 0 ? 0.f : (qt == 1 ? t0 : (qt == 2 ? t0 + t1 : t0 + t1 + t2));
            const float bm = t0 + t1, bl = (t0 + t1) + (t2 + t3);
            if (qt == 0) { ebm[d] = __expf(bm); ebl[d] = __expf(bl); logD += bl; }
            {
                unsigned kt[8], vt[8];
                const float ebd = __expf(bl - bm);
                float y = __expf(bm - (run + off)), kx_hi = 0.f;
#pragma unroll
                for (int i = 15; i >= 0; --i) {
                    const float ky = (1.f - f[i]) * y;
                    if (OUT) *(LAS bf16_t*)(L + H_KE + ((16 * qt + i) * 136 + d) * 2) = f2bf(ky);
                    const float kx = ky * ebd;
                    if (i & 1) kx_hi = kx; else kt[i >> 1] = cvt_pk_bf16(kx, kx_hi);
                    y *= f[i];
                }
                if (OUT) {
                    float e = __expf(off - bm);
#pragma unroll
                    for (int i = 0; i < 16; ++i) { e *= f[i]; *(LAS bf16_t*)(L + H_QE + ((16 * qt + i) * 136 + d) * 2) = f2bf(bf2f(qv[i]) * e); }
                }
#pragma unroll
                for (int i = 0; i < 16; i += 2) vt[i >> 1] = (unsigned)vv[i] | ((unsigned)vv[i + 1] << 16);
                LAS u32x4* kp = (LAS u32x4*)(L + H_KET + (d * 72 + 16 * qt) * 2); kp[0] = (u32x4){kt[0], kt[1], kt[2], kt[3]}; kp[1] = (u32x4){kt[4], kt[5], kt[6], kt[7]};
                LAS u32x4* vp = (LAS u32x4*)(L + H_VT + (d * 72 + 16 * qt) * 2); vp[0] = (u32x4){vt[0], vt[1], vt[2], vt[3]}; vp[1] = (u32x4){vt[4], vt[5], vt[6], vt[7]};
            }
            if (c + 1 < c1) HG_LOAD(c + 1);
            __syncthreads();
            if (OUT) {
#pragma unroll
                for (int di = 0; di < 8; ++di) { const f32x4 m4 = *(const LAS f32x4*)(ebm + 16 * di + 4 * (lane >> 4)); u32x2 o; o.x = cvt_pk_bf16(S[di].x * m4.x, S[di].y * m4.y); o.y = cvt_pk_bf16(S[di].z * m4.z, S[di].w * m4.w);
                    *(LAS u32x2*)(L + H_STB + ((16 * w + (lane & 15)) * 136 + 16 * di + 4 * (lane >> 4)) * 2) = o; }
                const int ti = w >> 1;
#pragma unroll
                for (int s2 = 0; s2 < 2; ++s2) { const int si = 2 * (w & 1) + s2; f32x4 p = {0.f, 0.f, 0.f, 0.f};
                    if (si <= ti) {
#pragma unroll
                        for (int ks = 0; ks < 4; ++ks) p = __builtin_amdgcn_mfma_f32_16x16x32_bf16(ldfrag(L + H_QE, 272, ti, ks, lane), ldfrag(L + H_KE, 272, si, ks, lane), p, 0, 0, 0);
                    }
                    const int sidx = 16 * si + (lane & 15);
#pragma unroll
                    for (int jj = 0; jj < 4; ++jj) { const int tidx = 16 * ti + 4 * (lane >> 4) + jj; *(LAS bf16_t*)(L + H_PM + (tidx * 72 + sidx) * 2) = f2bf(sidx <= tidx ? p[jj] : 0.f); }
                }
                __syncthreads();
            }
            f32x4 O[4];
            if (OUT) {
#pragma unroll
                for (int ti = 0; ti < 4; ++ti) O[ti] = (f32x4){0.f, 0.f, 0.f, 0.f};
#pragma unroll
                for (int ks = 0; ks < 2; ++ks) { const bf16x8 bv = ldfrag(L + H_VT, 144, w, ks, lane);
#pragma unroll
                    for (int ti = 0; ti < 4; ++ti) O[ti] = __builtin_amdgcn_mfma_f32_16x16x32_bf16(ldfrag(L + H_PM, 144, ti, ks, lane), bv, O[ti], 0, 0, 0); }
#pragma unroll
                for (int ks = 0; ks < 4; ++ks) { const bf16x8 bs = ldfrag(L + H_STB, 272, w, ks, lane);
#pragma unroll
                    for (int ti = 0; ti < 4; ++ti) O[ti] = __builtin_amdgcn_mfma_f32_16x16x32_bf16(ldfrag(L + H_QE, 272, ti, ks, lane), bs, O[ti], 0, 0, 0); }
            }
            {
                const bf16x8 bv0 = ldfrag(L + H_VT, 144, w, 0, lane), bv1 = ldfrag(L + H_VT, 144, w, 1, lane);
#pragma unroll
                for (int di = 0; di < 8; ++di) { const f32x4 l4 = *(const LAS f32x4*)(ebl + 16 * di + 4 * (lane >> 4)); S[di] = S[di] * l4;
                    S[di] = __builtin_amdgcn_mfma_f32_16x16x32_bf16(ldfrag(L + H_KET, 144, di, 0, lane), bv0, S[di], 0, 0, 0);
                    S[di] = __builtin_amdgcn_mfma_f32_16x16x32_bf16(ldfrag(L + H_KET, 144, di, 1, lane), bv1, S[di], 0, 0, 0); }
            }
            if (OUT) {
                __syncthreads();
                LAS float* Ot = (LAS float*)(L + H_STB);
#pragma unroll
                for (int ti = 0; ti < 4; ++ti)
#pragma unroll
                    for (int jj = 0; jj < 4; ++jj) Ot[(16 * ti + 4 * (lane >> 4) + jj) * 132 + 16 * w + (lane & 15)] = O[ti][jj];
                __syncthreads();
                const int t = tid >> 3, eg = tid & 7;
                f32x4 o4[4]; float ss = 0.f;
#pragma unroll
                for (int i = 0; i < 4; ++i) { o4[i] = *(const LAS f32x4*)(Ot + t * 132 + 16 * eg + 4 * i); ss += (o4[i].x * o4[i].x + o4[i].y * o4[i].y) + (o4[i].z * o4[i].z + o4[i].w * o4[i].w); }
                ss = red8(ss);
                const float rs = __builtin_amdgcn_rsqf(ss * (1.f / 128.f) + 1e-6f);
                const unsigned gw_[8] = {gt0.x, gt0.y, gt0.z, gt0.w, gt1.x, gt1.y, gt1.z, gt1.w};
                unsigned zo[8];
#pragma unroll
                for (int i = 0; i < 4; ++i) { const f32x4 g4 = *(const f32x4*)(gn + 16 * eg + 4 * i);
                    const float a0 = o4[i].x * rs * g4.x * silu_f(bflo(gw_[2 * i])), a1 = o4[i].y * rs * g4.y * silu_f(bfhi(gw_[2 * i]));
                    const float a2 = o4[i].z * rs * g4.z * silu_f(bflo(gw_[2 * i + 1])), a3 = o4[i].w * rs * g4.w * silu_f(bfhi(gw_[2 * i + 1]));
                    zo[2 * i] = cvt_pk_bf16(a0, a1); zo[2 * i + 1] = cvt_pk_bf16(a2, a3); }
                bf16_t* zp = Z + (size_t)(64 * c + t) * D + h * 128 + 16 * eg;
                *(u32x4*)zp = (u32x4){zo[0], zo[1], zo[2], zo[3]}; *(u32x4*)(zp + 8) = (u32x4){zo[4], zo[5], zo[6], zo[7]};
            } else {
                __syncthreads();
            }
        }
        if (!OUT) {
            float* e = HE + ((size_t)(h * 8 + seg) * 512 + tid) * 32;
#pragma unroll
            for (int di = 0; di < 8; ++di) *(f32x4*)(e + 4 * di) = S[di];
            if (qt == 0) HLD[(size_t)(h * 8 + seg) * 128 + d] = logD;
        }
        __syncthreads();
    }
#undef HG_LOAD
}

namespace att {
constexpr int NW = 8, QBLK = 32, KVBLK = 64, LDQ = 4096, LDO = 8192;
constexpr float SCALE = 0.088388347648318440f, THR = 8.f;
constexpr int SHM_V = 16384, SHM_K = 16384, SHM = 2 * SHM_V + 2 * SHM_K + NW * 64 * 4;
#define KSWZ(row, colB) ((row) * 256 + ((colB) ^ (((row) & 7) << 4)))
#define SBAR() __builtin_amdgcn_sched_barrier(0)
__device__ __forceinline__ int crow(int r, int hi) { return (r & 3) + 8 * (r >> 2) + 4 * hi; }
__device__ __forceinline__ void partialSM(f32x16& p0, f32x16& p1, float& m_reg, float& mn, float& alpha) {
    constexpr float C = SCALE * 1.4426950408889634f;
    float pmax = p0[0];
#pragma unroll
    for (int r = 1; r < 16; ++r) pmax = fmaxf(pmax, p0[r]);
#pragma unroll
    for (int r = 0; r < 16; ++r) pmax = fmaxf(pmax, p1[r]);
    { auto rr = __builtin_amdgcn_permlane32_swap(__float_as_uint(pmax), __float_as_uint(pmax), false, false);
      pmax = fmaxf(__uint_as_float(rr[0]), __uint_as_float(rr[1])); }
    if (__builtin_expect(__all(pmax - m_reg <= THR / SCALE), 1)) { mn = m_reg; alpha = 1.f; }
    else { mn = fmaxf(m_reg, pmax); alpha = __builtin_amdgcn_exp2f((m_reg - mn) * C); m_reg = mn; }
    const float mnC = -mn * C;
#pragma unroll
    for (int r = 0; r < 16; ++r) p0[r] = fmaf(p0[r], C, mnC);
#pragma unroll
    for (int r = 0; r < 16; ++r) p1[r] = fmaf(p1[r], C, mnC);
#pragma unroll
    for (int r = 0; r < 16; ++r) p0[r] = __builtin_amdgcn_exp2f(p0[r]);
}
__device__ __forceinline__ void finishSM(f32x16& p0, f32x16& p1, float alpha, float& l_reg, bf16x8& pa0, bf16x8& pa1, bf16x8& pa2, bf16x8& pa3) {
#pragma unroll
    for (int r = 0; r < 16; ++r) p1[r] = __builtin_amdgcn_exp2f(p1[r]);
    float ps = 0;
#pragma unroll
    for (int r = 0; r < 16; ++r) ps += p0[r];
#pragma unroll
    for (int r = 0; r < 16; ++r) ps += p1[r];
    { auto rr = __builtin_amdgcn_permlane32_swap(__float_as_uint(ps), __float_as_uint(ps), false, false);
      ps = __uint_as_float(rr[0]) + __uint_as_float(rr[1]); }
    l_reg = l_reg * alpha + ps;
#define PK4(P, BASE, OUT) do { unsigned a0 = cvt_pk_bf16(P[BASE + 0], P[BASE + 1]), a1 = cvt_pk_bf16(P[BASE + 2], P[BASE + 3]);   \
    unsigned b0 = cvt_pk_bf16(P[BASE + 4], P[BASE + 5]), b1 = cvt_pk_bf16(P[BASE + 6], P[BASE + 7]);                              \
    auto r0 = __builtin_amdgcn_permlane32_swap(a0, b0, false, false); auto r1 = __builtin_amdgcn_permlane32_swap(a1, b1, false, false); \
    u32x4 w = {r0[0], r1[0], r0[1], r1[1]}; OUT = *reinterpret_cast<bf16x8*>(&w); } while (0)
    PK4(p0, 0, pa0); PK4(p0, 8, pa1); PK4(p1, 0, pa2); PK4(p1, 8, pa3);
#undef PK4
}
__device__ __forceinline__ void qkt(f32x16& p0, f32x16& p1, const char* Ks, const bf16x8* qr, int r32, int hi) {
    p0 = f32x16{}; p1 = f32x16{};
#pragma unroll
    for (int d0 = 0; d0 < 8; ++d0) { const int cb = (d0 * 16 + hi * 8) * 2;
        const bf16x8 b0 = *reinterpret_cast<const bf16x8*>(Ks + KSWZ(r32, cb));
        const bf16x8 b1 = *reinterpret_cast<const bf16x8*>(Ks + KSWZ(32 + r32, cb));
        p0 = __builtin_amdgcn_mfma_f32_32x32x16_bf16(b0, qr[d0], p0, 0, 0, 0);
        p1 = __builtin_amdgcn_mfma_f32_32x32x16_bf16(b1, qr[d0], p1, 0, 0, 0); }
}
__device__ __forceinline__ int v_st(int k, int c) { const int kk = (k & ~0xC) | ((k & 4) << 1) | ((k & 8) >> 1); return ((kk >> 3) * 4 + (c >> 5)) * 512 + ((kk & 7) * 32 + (c & 31)) * 2; }
__device__ __forceinline__ int v_rd_base(int lane) { return ((lane & 3) << 3) | (((lane >> 2) & 3) << 6) | (((lane >> 4) & 1) << 5) | (((lane >> 5) & 1) << 8); }
constexpr int v_rd_off(int d0, int ks, int half) { return d0 * 512 + ks * 4096 + half * 2048; }
template <int OFF> __device__ __forceinline__ s16x4 tr_read(int vb) {
    s16x4 r; asm volatile("ds_read_b64_tr_b16 %0, %1 offset:%2" : "=&v"(r) : "v"(vb), "i"(OFF) : "memory"); return r;
}
template <int D0> __device__ __forceinline__ void pv_one(f32x16& od, int vb, bf16x8 pa0, bf16x8 pa1, bf16x8 pa2, bf16x8 pa3) {
    const s16x4 l0 = tr_read<v_rd_off(D0, 0, 0)>(vb), h0 = tr_read<v_rd_off(D0, 0, 1)>(vb), l1 = tr_read<v_rd_off(D0, 1, 0)>(vb), h1 = tr_read<v_rd_off(D0, 1, 1)>(vb);
    const s16x4 l2 = tr_read<v_rd_off(D0, 2, 0)>(vb), h2 = tr_read<v_rd_off(D0, 2, 1)>(vb), l3 = tr_read<v_rd_off(D0, 3, 0)>(vb), h3 = tr_read<v_rd_off(D0, 3, 1)>(vb);
    asm volatile("s_waitcnt lgkmcnt(0)" ::: "memory"); SBAR();
#define PK(Lo, Hi) (bf16x8){Lo[0], Lo[1], Lo[2], Lo[3], Hi[0], Hi[1], Hi[2], Hi[3]}
    od = __builtin_amdgcn_mfma_f32_32x32x16_bf16(pa0, PK(l0, h0), od, 0, 0, 0);
    od = __builtin_amdgcn_mfma_f32_32x32x16_bf16(pa1, PK(l1, h1), od, 0, 0, 0);
    od = __builtin_amdgcn_mfma_f32_32x32x16_bf16(pa2, PK(l2, h2), od, 0, 0, 0);
    od = __builtin_amdgcn_mfma_f32_32x32x16_bf16(pa3, PK(l3, h3), od, 0, 0, 0);
#undef PK
}
__device__ __forceinline__ void pv_d0(f32x16* o, int vb, bf16x8 pa0, bf16x8 pa1, bf16x8 pa2, bf16x8 pa3) {
    pv_one<0>(o[0], vb, pa0, pa1, pa2, pa3); pv_one<1>(o[1], vb, pa0, pa1, pa2, pa3); pv_one<2>(o[2], vb, pa0, pa1, pa2, pa3); pv_one<3>(o[3], vb, pa0, pa1, pa2, pa3);
}
__device__ __forceinline__ void mask_tile(f32x16& p0, f32x16& p1, int j, int lim) {
    if (j > lim) {
#pragma unroll
        for (int r = 0; r < 16; ++r) { p0[r] = -1e30f; p1[r] = -1e30f; }
    } else if (j == 0) {
#pragma unroll
        for (int r = 0; r < 16; ++r) p0[r] = -1e30f;
#pragma unroll
        for (int r = 0; r < 8; ++r) p1[r] = -1e30f;
    }
}
__device__ __forceinline__ void unit(const bf16_t* __restrict__ Qb, const bf16_t* __restrict__ Kh, const bf16_t* __restrict__ Vh, bf16_t* __restrict__ Ob, int NT, int lim, char* lds) {
    int tid_ = threadIdx.x; asm volatile("" : "+v"(tid_));
    const int tid = tid_, wid = tid >> 6, lane = tid & 63, r32 = lane & 31, hi = lane >> 5;
    char* V_lds = lds; char* K_lds = lds + 2 * SHM_V;
    float* wsf = (float*)(lds + 2 * SHM_V + 2 * SHM_K) + wid * 64; float* li_l = wsf; float* al_l = wsf + 32;
    float m_reg = -1e30f, l_reg = 0; f32x16 o[4] = {}; bf16x8 qr[8];
    const bf16_t* Qw = Qb + (long)(wid * QBLK + r32) * LDQ + hi * 8;
#pragma unroll
    for (int d0 = 0; d0 < 8; ++d0) qr[d0] = *reinterpret_cast<const bf16x8*>(Qw + d0 * 16);
    const int sr = tid >> 4, sc = (tid & 15) * 8, vst0 = v_st(sr, sc), vst1 = v_st(32 + sr, sc);
    const int vb0 = (int)(uintptr_t)V_lds + v_rd_base(lane);
    struct { bf16x8 vs0, vs1, ks0, ks1; } sr_[2];
#define SLOAD(i, k0) do { sr_[i].vs0 = *reinterpret_cast<const bf16x8*>(&Vh[(long)((k0) + sr) * LDQ + sc]); sr_[i].vs1 = *reinterpret_cast<const bf16x8*>(&Vh[(long)((k0) + 32 + sr) * LDQ + sc]); \
    sr_[i].ks0 = *reinterpret_cast<const bf16x8*>(&Kh[(long)((k0) + sr) * LDQ + sc]); sr_[i].ks1 = *reinterpret_cast<const bf16x8*>(&Kh[(long)((k0) + 32 + sr) * LDQ + sc]); } while (0)
#define SWRITE(b, i) do { *(bf16x8*)(V_lds + (b) * SHM_V + vst0) = sr_[i].vs0;          \
    *(bf16x8*)(V_lds + (b) * SHM_V + vst1) = sr_[i].vs1; int kc = sc * 2;               \
    *(bf16x8*)(K_lds + (b) * SHM_K + KSWZ(sr, kc)) = sr_[i].ks0;                       \
    *(bf16x8*)(K_lds + (b) * SHM_K + KSWZ(32 + sr, kc)) = sr_[i].ks1; } while (0)
#define SWAIT() asm volatile("s_waitcnt vmcnt(4)" ::: "memory")
#define RESC(a) do { if (__any((a) < 1.f)) { if (hi == 0) al_l[r32] = (a); asm volatile("s_waitcnt lgkmcnt(0)" ::: "memory"); \
    _Pragma("unroll") for (int d = 0; d < 4; ++d) _Pragma("unroll") for (int r = 0; r < 16; ++r) o[d][r] *= al_l[crow(r, hi)]; } } while (0)
    f32x16 pA0, pA1, pB0, pB1; float mnA, mnB, alA, alB; bf16x8 pa0, pa1, pa2, pa3;
    constexpr int SE = 0, SO = 1;
    SLOAD(SE, 0); asm volatile("s_waitcnt vmcnt(0)" ::: "memory"); SWRITE(0, SE); __syncthreads();
    qkt(pA0, pA1, K_lds, qr, r32, hi); mask_tile(pA0, pA1, 0, lim); partialSM(pA0, pA1, m_reg, mnA, alA);
    SLOAD(SO, KVBLK); if (2 < NT) SLOAD(SE, 2 * KVBLK);
    SWAIT(); SWRITE(1, SO); __syncthreads();
    for (int j = 1; j + 1 < NT; j += 2) {
        SBAR(); qkt(pB0, pB1, K_lds + SHM_K, qr, r32, hi);
        finishSM(pA0, pA1, alA, l_reg, pa0, pa1, pa2, pa3); SBAR();
        SLOAD(SO, (j + 2) * KVBLK); SBAR();
        pv_d0(o, vb0, pa0, pa1, pa2, pa3); mask_tile(pB0, pB1, j, lim); partialSM(pB0, pB1, m_reg, mnB, alB);
        __syncthreads(); SWAIT(); SWRITE(0, SE);
        RESC(alB); __syncthreads();
        SBAR(); qkt(pA0, pA1, K_lds, qr, r32, hi);
        finishSM(pB0, pB1, alB, l_reg, pa0, pa1, pa2, pa3); SBAR();
        if (j + 3 < NT) SLOAD(SE, (j + 3) * KVBLK); SBAR();
        pv_d0(o, vb0 + SHM_V, pa0, pa1, pa2, pa3); mask_tile(pA0, pA1, j + 1, lim); partialSM(pA0, pA1, m_reg, mnA, alA);
        __syncthreads(); SWAIT(); SWRITE(1, SO);
        RESC(alA); __syncthreads();
    }
    SBAR(); qkt(pB0, pB1, K_lds + SHM_K, qr, r32, hi);
    finishSM(pA0, pA1, alA, l_reg, pa0, pa1, pa2, pa3); SBAR();
    pv_d0(o, vb0, pa0, pa1, pa2, pa3); mask_tile(pB0, pB1, NT - 1, lim); partialSM(pB0, pB1, m_reg, mnB, alB);
    __syncthreads(); RESC(alB);
    finishSM(pB0, pB1, alB, l_reg, pa0, pa1, pa2, pa3); SBAR();
    pv_d0(o, vb0 + SHM_V, pa0, pa1, pa2, pa3);
    if (hi == 0) li_l[r32] = l_reg; asm volatile("s_waitcnt lgkmcnt(0)" ::: "memory");
    float rli[16];
#pragma unroll
    for (int r = 0; r < 16; ++r) rli[r] = __builtin_amdgcn_rcpf(li_l[crow(r, hi)]);
    bf16_t* Ow = Ob + (long)(wid * QBLK) * LDO;
#pragma unroll
    for (int r = 0; r < 16; ++r) { const int orow = crow(r, hi);
#pragma unroll
        for (int d0 = 0; d0 < 4; ++d0) Ow[(long)orow * LDO + d0 * 32 + r32] = f2bf(o[d0][r] * rli[r]); }
    __syncthreads();
#undef SLOAD
#undef SWRITE
#undef SWAIT
#undef RESC
}
}


namespace att2 {
using namespace att;
constexpr int KB = 16384, VB = 32768, OFF_V = 3 * KB, OFF_W = OFF_V + 3 * VB, SHM2 = OFF_W + NW * 64 * 4;
constexpr int v2_rd_off(int d0, int ks, int half) { return d0 * 512 + ks * 8192 + half * 4096; }
template <int D0> __device__ __forceinline__ void pv2_one(f32x16& od, int vb, bf16x8 pa0, bf16x8 pa1, bf16x8 pa2, bf16x8 pa3) {
    const s16x4 l0 = tr_read<v2_rd_off(D0, 0, 0)>(vb), h0 = tr_read<v2_rd_off(D0, 0, 1)>(vb), l1 = tr_read<v2_rd_off(D0, 1, 0)>(vb), h1 = tr_read<v2_rd_off(D0, 1, 1)>(vb);
    const s16x4 l2 = tr_read<v2_rd_off(D0, 2, 0)>(vb), h2 = tr_read<v2_rd_off(D0, 2, 1)>(vb), l3 = tr_read<v2_rd_off(D0, 3, 0)>(vb), h3 = tr_read<v2_rd_off(D0, 3, 1)>(vb);
    asm volatile("s_waitcnt lgkmcnt(0)" ::: "memory"); SBAR();
#define PK(Lo, Hi) (bf16x8){Lo[0], Lo[1], Lo[2], Lo[3], Hi[0], Hi[1], Hi[2], Hi[3]}
    od = __builtin_amdgcn_mfma_f32_32x32x16_bf16(pa0, PK(l0, h0), od, 0, 0, 0);
    od = __builtin_amdgcn_mfma_f32_32x32x16_bf16(pa1, PK(l1, h1), od, 0, 0, 0);
    od = __builtin_amdgcn_mfma_f32_32x32x16_bf16(pa2, PK(l2, h2), od, 0, 0, 0);
    od = __builtin_amdgcn_mfma_f32_32x32x16_bf16(pa3, PK(l3, h3), od, 0, 0, 0);
#undef PK
}
struct VFrag { s16x4 l0, h0, l1, h1, l2, h2, l3, h3; };
template <int D0> __device__ __forceinline__ void v2_load(VFrag& f, int vb) {
    f.l0 = tr_read<v2_rd_off(D0, 0, 0)>(vb); f.h0 = tr_read<v2_rd_off(D0, 0, 1)>(vb); f.l1 = tr_read<v2_rd_off(D0, 1, 0)>(vb); f.h1 = tr_read<v2_rd_off(D0, 1, 1)>(vb);
    f.l2 = tr_read<v2_rd_off(D0, 2, 0)>(vb); f.h2 = tr_read<v2_rd_off(D0, 2, 1)>(vb); f.l3 = tr_read<v2_rd_off(D0, 3, 0)>(vb); f.h3 = tr_read<v2_rd_off(D0, 3, 1)>(vb);
}
__device__ __forceinline__ void v2_mma(f32x16& od, const VFrag& f, bf16x8 pa0, bf16x8 pa1, bf16x8 pa2, bf16x8 pa3) {
#define PK(Lo, Hi) (bf16x8){Lo[0], Lo[1], Lo[2], Lo[3], Hi[0], Hi[1], Hi[2], Hi[3]}
    od = __builtin_amdgcn_mfma_f32_32x32x16_bf16(pa0, PK(f.l0, f.h0), od, 0, 0, 0);
    od = __builtin_amdgcn_mfma_f32_32x32x16_bf16(pa1, PK(f.l1, f.h1), od, 0, 0, 0);
    od = __builtin_amdgcn_mfma_f32_32x32x16_bf16(pa2, PK(f.l2, f.h2), od, 0, 0, 0);
    od = __builtin_amdgcn_mfma_f32_32x32x16_bf16(pa3, PK(f.l3, f.h3), od, 0, 0, 0);
#undef PK
}
struct VSet { s16x4 l0, h0, l1, h1, l2, h2, l3, h3; };
template <int G, int KS> __device__ __forceinline__ void vs_load(VSet& f, int vb) {
    f.l0 = tr_read<v2_rd_off(4 * G + 0, KS, 0)>(vb); f.h0 = tr_read<v2_rd_off(4 * G + 0, KS, 1)>(vb); f.l1 = tr_read<v2_rd_off(4 * G + 1, KS, 0)>(vb); f.h1 = tr_read<v2_rd_off(4 * G + 1, KS, 1)>(vb);
    f.l2 = tr_read<v2_rd_off(4 * G + 2, KS, 0)>(vb); f.h2 = tr_read<v2_rd_off(4 * G + 2, KS, 1)>(vb); f.l3 = tr_read<v2_rd_off(4 * G + 3, KS, 0)>(vb); f.h3 = tr_read<v2_rd_off(4 * G + 3, KS, 1)>(vb);
}
template <int G> __device__ __forceinline__ void vs_mma(f32x16* o, const VSet& f, bf16x8 pa) {
#define PK(Lo, Hi) (bf16x8){Lo[0], Lo[1], Lo[2], Lo[3], Hi[0], Hi[1], Hi[2], Hi[3]}
    o[4 * G + 0] = __builtin_amdgcn_mfma_f32_32x32x16_bf16(pa, PK(f.l0, f.h0), o[4 * G + 0], 0, 0, 0);
    o[4 * G + 1] = __builtin_amdgcn_mfma_f32_32x32x16_bf16(pa, PK(f.l1, f.h1), o[4 * G + 1], 0, 0, 0);
    o[4 * G + 2] = __builtin_amdgcn_mfma_f32_32x32x16_bf16(pa, PK(f.l2, f.h2), o[4 * G + 2], 0, 0, 0);
    o[4 * G + 3] = __builtin_amdgcn_mfma_f32_32x32x16_bf16(pa, PK(f.l3, f.h3), o[4 * G + 3], 0, 0, 0);
#undef PK
}
__device__ __forceinline__ void pv2_all(f32x16* o, int vb, bf16x8 pa0, bf16x8 pa1, bf16x8 pa2, bf16x8 pa3) {
    VSet A, B;
#define W8() do { asm volatile("s_waitcnt lgkmcnt(8)" ::: "memory"); SBAR(); } while (0)
    vs_load<0, 0>(A, vb);
    vs_load<0, 1>(B, vb); W8(); vs_mma<0>(o, A, pa0); SBAR();
    vs_load<0, 2>(A, vb); W8(); vs_mma<0>(o, B, pa1); SBAR();
    vs_load<0, 3>(B, vb); W8(); vs_mma<0>(o, A, pa2); SBAR();
    vs_load<1, 0>(A, vb); W8(); vs_mma<0>(o, B, pa3); SBAR();
    vs_load<1, 1>(B, vb); W8(); vs_mma<1>(o, A, pa0); SBAR();
    vs_load<1, 2>(A, vb); W8(); vs_mma<1>(o, B, pa1); SBAR();
    vs_load<1, 3>(B, vb); W8(); vs_mma<1>(o, A, pa2); SBAR();
    asm volatile("s_waitcnt lgkmcnt(0)" ::: "memory"); SBAR(); vs_mma<1>(o, B, pa3);
#undef W8
}
__device__ __forceinline__ void unit2(const bf16_t* __restrict__ Qb, const bf16_t* __restrict__ Kh, const bf16_t* __restrict__ Vh, bf16_t* __restrict__ Ob, int NT, int lim, unsigned char* ldsg, LAS unsigned char* lds) {
    int tid_ = threadIdx.x; asm volatile("" : "+v"(tid_));
    const int tid = tid_, wid = __builtin_amdgcn_readfirstlane(tid >> 6), lane = tid & 63, r32 = lane & 31, hi = lane >> 5;
    LAS float* wsf = (LAS float*)(lds + OFF_W) + wid * 64; LAS float* li_l = wsf; LAS float* al_l = wsf + 32;
    float m_reg = -1e30f, l_reg = 0; f32x16 o[8] = {}; bf16x8 qr[8];
    const bf16_t* Qw = Qb + (long)(wid * QBLK + r32) * LDQ + hi * 8;
#pragma unroll
    for (int d0 = 0; d0 < 8; ++d0) qr[d0] = *reinterpret_cast<const bf16x8*>(Qw + d0 * 16);
    const int vb0 = (int)(uintptr_t)(ldsg + OFF_V) + v_rd_base(lane);
#define DMA_K(t_, b_) do { const char* gk = (const char*)Kh + (size_t)(t_) * (KVBLK * LDQ * 2); int ln_ = lane; asm volatile("" : "+v"(ln_)); _Pragma("unroll") for (int i = 0; i < 2; ++i) { \
        const int row = wid * 4 + i * 32 + (ln_ >> 4); const unsigned ko = (unsigned)(row * LDQ * 2 + (((ln_ & 15) * 16) ^ ((row & 7) << 4))); \
        __builtin_amdgcn_global_load_lds((const unsigned*)(gk + ko), (LAS unsigned*)(lds + (b_) * KB + wid * 1024 + i * 8192), 16, 0, 0); } } while (0)
#define DMA_V(t_, b_) do { const char* gv = (const char*)Vh + (size_t)(t_) * (KVBLK * LDQ * 2); int ln_ = lane; asm volatile("" : "+v"(ln_)); _Pragma("unroll") for (int i = 0; i < 4; ++i) { \
        const int st = wid * 2 + i * 16 + (ln_ >> 5), q = ln_ & 31; const int kk = (st >> 3) * 8 + (q >> 2); const int k = (kk & ~0xC) | ((kk & 4) << 1) | ((kk & 8) >> 1); \
        const unsigned vo = (unsigned)(k * LDQ * 2 + ((st & 7) * 32 + (q & 3) * 8) * 2); \
        __builtin_amdgcn_global_load_lds((const unsigned*)(gv + vo), (LAS unsigned*)(lds + OFF_V + (b_) * VB + wid * 1024 + i * 8192), 16, 0, 0); } } while (0)
    DMA_K(0, 0); DMA_V(0, 0); if (1 < NT) { DMA_K(1, 1); DMA_V(1, 1); }
    asm volatile("s_waitcnt vmcnt(0)" ::: "memory"); __builtin_amdgcn_s_barrier(); asm volatile("" ::: "memory");
    int kb = 0;
    for (int j = 0; j < NT; ++j) {
        const int kb2 = kb == 0 ? 2 : kb - 1;
        if (j + 2 < NT) DMA_V(j + 2, kb2);
        asm volatile("" ::: "memory");
        if (j + 2 < NT) DMA_K(j + 2, kb2);
        asm volatile("" ::: "memory");
        f32x16 p0, p1; float mn, alpha; bf16x8 pa0, pa1, pa2, pa3;
        qkt(p0, p1, (const char*)ldsg + kb * KB, qr, r32, hi);
#if MK_PROBE_QK2
        asm volatile("" : "+v"(p0), "+v"(p1)); qkt(p0, p1, (const char*)ldsg + kb * KB, qr, r32, hi);
#endif
        mask_tile(p0, p1, j, lim);
        partialSM(p0, p1, m_reg, mn, alpha);
        if (__any(alpha < 1.f)) { if (hi == 0) al_l[r32] = alpha; asm volatile("s_waitcnt lgkmcnt(0)" ::: "memory");
#pragma unroll
            for (int d = 0; d < 8; ++d)
#pragma unroll
                for (int r = 0; r < 16; ++r) o[d][r] *= al_l[crow(r, hi)]; }
        finishSM(p0, p1, alpha, l_reg, pa0, pa1, pa2, pa3); SBAR();
        const int vb = vb0 + kb * VB;
        pv2_all(o, vb, pa0, pa1, pa2, pa3);
        if (j + 2 < NT) asm volatile("s_waitcnt vmcnt(6)" ::: "memory"); else asm volatile("s_waitcnt vmcnt(0)" ::: "memory");
        __builtin_amdgcn_s_barrier(); asm volatile("" ::: "memory");
        kb = kb == 2 ? 0 : kb + 1;
    }
    if (hi == 0) li_l[r32] = l_reg; asm volatile("s_waitcnt lgkmcnt(0)" ::: "memory");
    float rli[16];
#pragma unroll
    for (int r = 0; r < 16; ++r) rli[r] = __builtin_amdgcn_rcpf(li_l[crow(r, hi)]);
    bf16_t* Ow = Ob + (long)(wid * QBLK) * LDO;
#pragma unroll
    for (int r = 0; r < 16; ++r) { const int orow = crow(r, hi);
#pragma unroll
        for (int d0 = 0; d0 < 8; ++d0) Ow[(long)orow * LDO + d0 * 32 + r32] = f2bf(o[d0][r] * rli[r]); }
    asm volatile("s_waitcnt vmcnt(0) lgkmcnt(0)" ::: "memory"); __builtin_amdgcn_s_barrier(); asm volatile("" ::: "memory");
#undef DMA_K
#undef DMA_V
}

__device__ __forceinline__ void unit3(const bf16_t* __restrict__ Qb, const bf16_t* __restrict__ Kh, const bf16_t* __restrict__ Vh, bf16_t* __restrict__ Ob, int NT, int lim, unsigned char* ldsg, LAS unsigned char* lds) {
    int tid_ = threadIdx.x; asm volatile("" : "+v"(tid_));
    const int tid = tid_, wid = __builtin_amdgcn_readfirstlane(tid >> 6), lane = tid & 63, r32 = lane & 31, hi = lane >> 5, hb = wid >> 2;
    LAS float* wsf = (LAS float*)(lds + OFF_W) + wid * 64; LAS float* li_l = wsf; LAS float* al_l = wsf + 32;
    float m_reg = -1e30f, l_reg = 0; f32x16 o[8] = {}; bf16x8 qr[8];
    const bf16_t* Qw = Qb + (long)(wid * QBLK + r32) * LDQ + hi * 8;
#pragma unroll
    for (int d0 = 0; d0 < 8; ++d0) qr[d0] = *reinterpret_cast<const bf16x8*>(Qw + d0 * 16);
#define DMA_K(t_, b_) do { const char* gk = (const char*)Kh + (size_t)(t_) * (KVBLK * LDQ * 2); int ln_ = lane; asm volatile("" : "+v"(ln_)); _Pragma("unroll") for (int i = 0; i < 2; ++i) { \
        const int row = wid * 4 + i * 32 + (ln_ >> 4); const unsigned ko = (unsigned)(row * LDQ * 2 + (((ln_ & 15) * 16) ^ ((row & 7) << 4))); \
        __builtin_amdgcn_global_load_lds((const unsigned*)(gk + ko), (LAS unsigned*)(lds + (b_) * KB + wid * 1024 + i * 8192), 16, 0, 0); } } while (0)
#define DMA_V(t_, b_) do { const char* gv = (const char*)Vh + (size_t)(t_) * (KVBLK * LDQ * 2); int ln_ = lane; asm volatile("" : "+v"(ln_)); _Pragma("unroll") for (int i = 0; i < 4; ++i) { \
        const int st = wid * 2 + i * 16 + (ln_ >> 5), q = ln_ & 31; const int kk = (st >> 3) * 8 + (q >> 2); const int k = (kk & ~0xC) | ((kk & 4) << 1) | ((kk & 8) >> 1); \
        const unsigned vo = (unsigned)(k * LDQ * 2 + ((st & 7) * 32 + (q & 3) * 8) * 2); \
        __builtin_amdgcn_global_load_lds((const unsigned*)(gv + vo), (LAS unsigned*)(lds + OFF_V + (b_) * VB + wid * 1024 + i * 8192), 16, 0, 0); } } while (0)
    DMA_K(0, 0); DMA_V(0, 0); if (1 < NT) { DMA_K(1, 1); DMA_V(1, 1); }
    asm volatile("s_waitcnt vmcnt(0)" ::: "memory"); __builtin_amdgcn_s_barrier(); asm volatile("" ::: "memory");
    bf16x8 pa0, pa1, pa2, pa3;
    int kq = 0, ki = 2;
    int vq = 0, vi = 2;
#define U3_QS(j_) do { f32x16 p0, p1; float mn, alpha; int lq_ = lane; asm volatile("" : "+v"(lq_)); const int r32 = lq_ & 31, hi = lq_ >> 5; \
        qkt(p0, p1, (const char*)ldsg + kq * KB, qr, r32, hi); kq = kq == 2 ? 0 : kq + 1; \
        mask_tile(p0, p1, (j_), lim); \
        partialSM(p0, p1, m_reg, mn, alpha); \
        if (__any(alpha < 1.f)) { if (hi == 0) al_l[r32] = alpha; asm volatile("s_waitcnt lgkmcnt(0)" ::: "memory"); \
            _Pragma("unroll") for (int d = 0; d < 8; ++d) _Pragma("unroll") for (int r = 0; r < 16; ++r) o[d][r] *= al_l[crow(r, hi)]; } \
        finishSM(p0, p1, alpha, l_reg, pa0, pa1, pa2, pa3); } while (0)
#define U3_PV(j_) do { int lp_ = lane; asm volatile("" : "+v"(lp_)); const int vb = (int)(uintptr_t)(ldsg + OFF_V) + v_rd_base(lp_) + vq * VB; vq = vq == 2 ? 0 : vq + 1; \
        pv2_one<0>(o[0], vb, pa0, pa1, pa2, pa3); pv2_one<1>(o[1], vb, pa0, pa1, pa2, pa3); pv2_one<2>(o[2], vb, pa0, pa1, pa2, pa3); pv2_one<3>(o[3], vb, pa0, pa1, pa2, pa3); \
        pv2_one<4>(o[4], vb, pa0, pa1, pa2, pa3); pv2_one<5>(o[5], vb, pa0, pa1, pa2, pa3); pv2_one<6>(o[6], vb, pa0, pa1, pa2, pa3); pv2_one<7>(o[7], vb, pa0, pa1, pa2, pa3); } while (0)
#define U3_EVEN_ISSUE(jj_) do { if ((jj_) + 2 < NT) DMA_K((jj_) + 2, ki); ki = ki == 2 ? 0 : ki + 1; asm volatile("" ::: "memory"); } while (0)
#define U3_ODD_ISSUE(jj_) do { if ((jj_) + 2 < NT) DMA_V((jj_) + 2, vi); vi = vi == 2 ? 0 : vi + 1; asm volatile("" ::: "memory"); } while (0)
#define U3_EVEN_END(jj_) do { if ((jj_) + 2 < NT) asm volatile("s_waitcnt vmcnt(6)" ::: "memory"); else if ((jj_) + 1 < NT) asm volatile("s_waitcnt vmcnt(4)" ::: "memory"); else asm volatile("s_waitcnt vmcnt(0)" ::: "memory");   \
        asm volatile("s_waitcnt lgkmcnt(0)" ::: "memory"); __builtin_amdgcn_s_barrier(); asm volatile("" ::: "memory"); } while (0)
#define U3_ODD_END() do { asm volatile("s_waitcnt lgkmcnt(0)" ::: "memory"); __builtin_amdgcn_s_barrier(); asm volatile("" ::: "memory"); } while (0)
    if (hb == 0) {
#pragma unroll 1
        for (int jj = 0; jj < NT; ++jj) {
            U3_EVEN_ISSUE(jj); U3_QS(jj); U3_EVEN_END(jj);
            U3_ODD_ISSUE(jj); U3_PV(jj); U3_ODD_END();
        }
        U3_EVEN_ISSUE(NT); U3_EVEN_END(NT);
    } else {
        U3_EVEN_ISSUE(0); U3_EVEN_END(0);
#pragma unroll 1
        for (int jj = 0; jj < NT; ++jj) {
            U3_ODD_ISSUE(jj); U3_QS(jj); U3_ODD_END();
            U3_EVEN_ISSUE(jj + 1); U3_PV(jj); U3_EVEN_END(jj + 1);
        }
    }
#undef U3_QS
#undef U3_PV
#undef U3_EVEN_ISSUE
#undef U3_ODD_ISSUE
#undef U3_EVEN_END
#undef U3_ODD_END
    if (hi == 0) li_l[r32] = l_reg; asm volatile("s_waitcnt lgkmcnt(0)" ::: "memory");
    float rli[16];
#pragma unroll
    for (int r = 0; r < 16; ++r) rli[r] = __builtin_amdgcn_rcpf(li_l[crow(r, hi)]);
    bf16_t* Ow = Ob + (long)(wid * QBLK) * LDO;
#pragma unroll
    for (int r = 0; r < 16; ++r) { const int orow = crow(r, hi);
#pragma unroll
        for (int d0 = 0; d0 < 8; ++d0) Ow[(long)orow * LDO + d0 * 32 + r32] = f2bf(o[d0][r] * rli[r]); }
    asm volatile("s_waitcnt vmcnt(0) lgkmcnt(0)" ::: "memory"); __builtin_amdgcn_s_barrier(); asm volatile("" ::: "memory");
#undef DMA_K
#undef DMA_V
}

__device__ __forceinline__ void unit4(const bf16_t* __restrict__ Qb, const bf16_t* __restrict__ Kh, const bf16_t* __restrict__ Vh, bf16_t* __restrict__ Ob, int NT, int lim, unsigned char* ldsg, LAS unsigned char* lds) {
    int tid_ = threadIdx.x; asm volatile("" : "+v"(tid_));
    const int tid = tid_, wid = __builtin_amdgcn_readfirstlane(tid >> 6), lane = tid & 63, hb = wid >> 2;
    LAS float* wsf = (LAS float*)(lds + OFF_W) + wid * 64; LAS float* li_l = wsf; LAS float* al_l = wsf + 32;
    float m_reg = -1e30f, l_reg = 0; f32x16 o[8] = {}; bf16x8 qr[8];
    { const int r32 = lane & 31, hi = lane >> 5; const bf16_t* Qw = Qb + (long)(wid * QBLK + r32) * LDQ + hi * 8;
#pragma unroll
      for (int d0 = 0; d0 < 8; ++d0) qr[d0] = *reinterpret_cast<const bf16x8*>(Qw + d0 * 16); }
#define DMA_K(t_, b_) do { const char* gk = (const char*)Kh + (size_t)(t_) * (KVBLK * LDQ * 2); int ln_ = lane; asm volatile("" : "+v"(ln_)); _Pragma("unroll") for (int i = 0; i < 2; ++i) { \
        const int row = wid * 4 + i * 32 + (ln_ >> 4); const unsigned ko = (unsigned)(row * LDQ * 2 + (((ln_ & 15) * 16) ^ ((row & 7) << 4))); \
        __builtin_amdgcn_global_load_lds((const unsigned*)(gk + ko), (LAS unsigned*)(lds + (b_) * KB + wid * 1024 + i * 8192), 16, 0, 0); } } while (0)
#define DMA_V(t_, b_) do { const char* gv = (const char*)Vh + (size_t)(t_) * (KVBLK * LDQ * 2); int ln_ = lane; asm volatile("" : "+v"(ln_)); _Pragma("unroll") for (int i = 0; i < 4; ++i) { \
        const int st = wid * 2 + i * 16 + (ln_ >> 5), q = ln_ & 31; const int kk = (st >> 3) * 8 + (q >> 2); const int k = (kk & ~0xC) | ((kk & 4) << 1) | ((kk & 8) >> 1); \
        const unsigned vo = (unsigned)(k * LDQ * 2 + ((st & 7) * 32 + (q & 3) * 8) * 2); \
        __builtin_amdgcn_global_load_lds((const unsigned*)(gv + vo), (LAS unsigned*)(lds + OFF_V + (b_) * VB + wid * 1024 + i * 8192), 16, 0, 0); } } while (0)
    DMA_K(0, 0); DMA_V(0, 0); if (1 < NT) { DMA_K(1, 1); DMA_V(1, 1); } if (2 < NT) DMA_K(2, 2);
    asm volatile("s_waitcnt vmcnt(0)" ::: "memory"); __builtin_amdgcn_s_barrier(); asm volatile("" ::: "memory");
    f32x16 p0, p1; bf16x8 pa0, pa1, pa2, pa3;
    int kq = 0, ki = 0, vq = 0, vi = 2;
#define U4_QK() do { int lq_ = lane; asm volatile("" : "+v"(lq_)); qkt(p0, p1, (const char*)ldsg + kq * KB, qr, lq_ & 31, lq_ >> 5); kq = kq == 2 ? 0 : kq + 1; } while (0)
#define U4_SM(j_) do { float mn, alpha; int lq_ = lane; asm volatile("" : "+v"(lq_)); const int r32 = lq_ & 31, hi = lq_ >> 5; \
        mask_tile(p0, p1, (j_), lim); \
        partialSM(p0, p1, m_reg, mn, alpha); \
        if (__any(alpha < 1.f)) { if (hi == 0) al_l[r32] = alpha; asm volatile("s_waitcnt lgkmcnt(0)" ::: "memory"); \
            _Pragma("unroll") for (int d = 0; d < 8; ++d) _Pragma("unroll") for (int r = 0; r < 16; ++r) o[d][r] *= al_l[crow(r, hi)]; } \
        finishSM(p0, p1, alpha, l_reg, pa0, pa1, pa2, pa3); } while (0)
#define U4_PV() do { int lp_ = lane; asm volatile("" : "+v"(lp_)); const int vb = (int)(uintptr_t)(ldsg + OFF_V) + v_rd_base(lp_) + vq * VB; vq = vq == 2 ? 0 : vq + 1; \
        pv2_all(o, vb, pa0, pa1, pa2, pa3); } while (0)
#define U4_ISSUE(s_) do { if (((s_) & 1) == 0) { if ((s_) >= 2) { if ((s_) / 2 + 2 < NT) DMA_K((s_) / 2 + 2, ki); ki = ki == 2 ? 0 : ki + 1; } } \
        else { if ((s_) >= 3) { if (((s_) + 1) / 2 < NT) DMA_V(((s_) + 1) / 2, vi); vi = vi == 2 ? 0 : vi + 1; } } asm volatile("" ::: "memory"); } while (0)
#define U4_END(s_) do { if ((s_) & 1) { const int kt = ((s_) + 1) / 2 + 1, vt = ((s_) + 1) / 2;     \
            if ((s_) >= 3 && kt < NT && vt < NT) asm volatile("s_waitcnt vmcnt(6)" ::: "memory"); \
            else if ((s_) >= 3 && vt < NT) asm volatile("s_waitcnt vmcnt(4)" ::: "memory"); \
            else asm volatile("s_waitcnt vmcnt(0)" ::: "memory"); } \
        asm volatile("s_waitcnt lgkmcnt(0)" ::: "memory"); __builtin_amdgcn_s_barrier(); asm volatile("" ::: "memory"); } while (0)
    if (hb == 0) {
        U4_ISSUE(0); U4_QK(); U4_END(0);
#pragma unroll 1
        for (int m = 0; m < NT; ++m) {
            U4_ISSUE(2 * m + 1); U4_SM(m); U4_END(2 * m + 1);
            U4_ISSUE(2 * m + 2); U4_PV(); if (m + 1 < NT) U4_QK(); U4_END(2 * m + 2);
        }
        U4_ISSUE(2 * NT + 1); U4_END(2 * NT + 1);
    } else {
        U4_ISSUE(0); U4_END(0);
        U4_ISSUE(1); U4_QK(); U4_END(1);
#pragma unroll 1
        for (int m = 0; m < NT; ++m) {
            U4_ISSUE(2 * m + 2); U4_SM(m); U4_END(2 * m + 2);
            U4_ISSUE(2 * m + 3); U4_PV(); if (m + 1 < NT) U4_QK(); U4_END(2 * m + 3);
        }
    }
#undef U4_QK
#undef U4_SM
#undef U4_PV
#undef U4_ISSUE
#undef U4_END
    const int r32 = lane & 31, hi = lane >> 5;
    if (hi == 0) li_l[r32] = l_reg; asm volatile("s_waitcnt lgkmcnt(0)" ::: "memory");
    float rli[16];
#pragma unroll
    for (int r = 0; r < 16; ++r) rli[r] = __builtin_amdgcn_rcpf(li_l[crow(r, hi)]);
    bf16_t* Ow = Ob + (long)(wid * QBLK) * LDO;
#pragma unroll
    for (int r = 0; r < 16; ++r) { const int orow = crow(r, hi);
#pragma unroll
        for (int d0 = 0; d0 < 8; ++d0) Ow[(long)orow * LDO + d0 * 32 + r32] = f2bf(o[d0][r] * rli[r]); }
    asm volatile("s_waitcnt vmcnt(0) lgkmcnt(0)" ::: "memory"); __builtin_amdgcn_s_barrier(); asm volatile("" ::: "memory");
#undef DMA_K
#undef DMA_V
}
}

#ifndef MK_ATT2
#define MK_ATT2 1
#endif
#ifndef MK_PROBE_QK2
#define MK_PROBE_QK2 0
#endif
#ifndef MK_PROBE_DMA2
#define MK_PROBE_DMA2 0
#endif
#ifndef MK_ATT_UNIT
#define MK_ATT_UNIT unit2
#endif
#if MK_ATT2
__device__ __forceinline__ void attn_phase(const Fr& F) {
    const bf16_t* Q = slotY(F, 0); const bf16_t* K = slotY(F, 1); const bf16_t* V = slotY(F, 2);
    bf16_t* AO = slotU(F, 1);
    const int x = F.bid & 7, j = (F.bid >> 3) & 31;
#pragma unroll 1
    for (int k = 0; k < 4; ++k) {
        if (F.bid >= 256) break;
        const int sub = 4 * x + k, head = sub >> 1, c = sub & 1;
        const bf16_t* Kp = K + head * 256 + c * 128; const bf16_t* Vp = V + head * 256;
#pragma unroll 1
        for (int u = 0; u < 2; ++u) {
            const int t = u == 0 ? 63 - j : j;
            const int row0 = 256 * t + 128;
            att2::MK_ATT_UNIT(Q + (size_t)row0 * D + head * 256 + c * 128, Kp, Vp, AO + (size_t)row0 * 8192 + head * 512 + c * 256, 4 * t + 6, 4 * t + 2 + (F.wave >> 1), F.ldsg, F.lds);
        }
        if (j == 8 * k) att2::MK_ATT_UNIT(Q + head * 256 + c * 128, Kp, Vp, AO + head * 512 + c * 256, 4, F.wave >> 1, F.ldsg, F.lds);
    }
}
#else
__device__ __forceinline__ void attn_phase(const Fr& F) {
    const bf16_t* Q = slotY(F, 0); const bf16_t* K = slotY(F, 1); const bf16_t* V = slotY(F, 2);
    bf16_t* AO = slotU(F, 1);
    const int x = F.bid & 7, j = (F.bid >> 3) & 31;
#pragma unroll 1
    for (int k = 0; k < 8; ++k) {
        if (F.bid >= 256) break;
        const int sub = 8 * x + k, head = sub >> 2, c = (sub >> 1) & 1, half = sub & 1;
        const bf16_t* Kp = K + head * 256 + c * 128; const bf16_t* Vp = V + head * 256 + half * 128;
#pragma unroll 1
        for (int u = 0; u < 2; ++u) {
            const int t = u == 0 ? 63 - j : j;
            const int row0 = 256 * t + 128;
            att::unit(Q + (size_t)row0 * D + head * 256 + c * 128, Kp, Vp, AO + (size_t)row0 * 8192 + head * 512 + c * 256 + half * 128, 4 * t + 6, 4 * t + 2 + (F.wave >> 1), (char*)F.ldsg);
        }
        if (j == 4 * k) att::unit(Q + head * 256 + c * 128, Kp, Vp, AO + head * 512 + c * 256 + half * 128, 4, F.wave >> 1, (char*)F.ldsg);
    }
}
#endif
__device__ __forceinline__ void attn_post(const Fr& F) {
    const bf16_t* AO = slotU(F, 1); const bf16_t* GT = slotY(F, 3); bf16_t* Z = slotU(F, 0);
    const float* sg = F.in(13);
    constexpr float LINIT = 0.35550906759096934f;
    float lam;
    { const float* q1 = F.in(9); const float* k1 = F.in(10); const float* q2 = F.in(11); const float* k2 = F.in(12);
      const float d1 = wave_sum(q1[F.lane] * k1[F.lane] + q1[F.lane + 64] * k1[F.lane + 64]), d2 = wave_sum(q2[F.lane] * k2[F.lane] + q2[F.lane + 64] * k2[F.lane + 64]);
      lam = expf(d1) - expf(d2) + LINIT; }
    const f32x4 g4 = ((const f32x4*)sg)[F.lane];
    for (int r = F.gw; r < R; r += F.NGW) {
        const bool real = (r >= NPAD && r < NREAL);
        u32x2* zr = (u32x2*)(Z + (size_t)r * D) + F.lane;
        if (!real) { const u32x2 z = {0u, 0u};
#pragma unroll
            for (int hd = 0; hd < 16; ++hd) zr[64 * hd] = z;
            continue; }
#pragma unroll 4
        for (int hd = 0; hd < 16; ++hd) {
            const u32x2 a0 = ((const u32x2*)(AO + (size_t)r * 8192 + hd * 512))[F.lane], a1 = ((const u32x2*)(AO + (size_t)r * 8192 + hd * 512 + 256))[F.lane];
            const u32x2 gt = ((const u32x2*)(GT + (size_t)r * D + hd * 256))[F.lane];
            const float o0 = bflo(a0.x) - lam * bflo(a1.x), o1 = bfhi(a0.x) - lam * bfhi(a1.x), o2 = bflo(a0.y) - lam * bflo(a1.y), o3 = bfhi(a0.y) - lam * bfhi(a1.y);
            const float ss = wave_sum((o0 * o0 + o1 * o1) + (o2 * o2 + o3 * o3));
            const float rs = __builtin_amdgcn_rsqf(ss * (1.f / 256.f) + 1e-5f) * (1.f - LINIT);
            u32x2 w; w.x = cvt_pk_bf16(o0 * rs * g4.x * silu_f(bflo(gt.x)), o1 * rs * g4.y * silu_f(bfhi(gt.x))); w.y = cvt_pk_bf16(o2 * rs * g4.z * silu_f(bflo(gt.y)), o3 * rs * g4.w * silu_f(bfhi(gt.y)));
            zr[64 * hd] = w;
        }
    }
}

constexpr int RW_TT = 32, RW_TOKF = 384, RW_TILEF = RW_TT * RW_TOKF, RW_NTILE = 513;
__device__ __forceinline__ void rwkv_scan_seq(const Fr& F) {
    const bf16_t* Rr = slotY(F, 0); const bf16_t* K = slotY(F, 1); const bf16_t* V = slotY(F, 2); const bf16_t* W = slotY(F, 4); const bf16_t* A = slotY(F, 5);
    float* O32 = (float*)slotU(F, 1);
    LAS float* ring = (LAS float*)F.lds; LAS float* otile = ring + 2 * RW_TILEF;
    const int tid = F.tid, lane = F.lane, wid = F.wave;
    for (int unit = F.bid; unit < 256; unit += F.G) {
        const int h = unit >> 2, rg = unit & 3;
        const int ptid = tid - 256, ptt = ptid >> 3, dg = ptid & 7;
        float kkc[8], kac[8];
        if (wid >= 4) {
#pragma unroll
            for (int i = 0; i < 8; ++i) { kkc[i] = F.in(23)[h * 64 + 8 * dg + i]; kac[i] = F.in(24)[h * 64 + 8 * dg + i]; }
        }
        float S0 = 0.f, S1 = 0.f, S2 = 0.f, S3 = 0.f;
        const int cg = lane & 15, irow = 4 * wid + (lane >> 4);
#define RW_PRODUCE(m, buf) do { const int row = NPAD + 32 * (m) + ptt; const size_t off = (size_t)row * D + h * 64 + 8 * dg; \
        const u32x4 r8 = *(const u32x4*)(Rr + off), k8 = *(const u32x4*)(K + off), v8 = *(const u32x4*)(V + off), w8 = *(const u32x4*)(W + off), a8 = *(const u32x4*)(A + off); \
        const unsigned rw[4] = {r8.x, r8.y, r8.z, r8.w}, kw[4] = {k8.x, k8.y, k8.z, k8.w}, vw[4] = {v8.x, v8.y, v8.z, v8.w}, ww[4] = {w8.x, w8.y, w8.z, w8.w}, aw[4] = {a8.x, a8.y, a8.z, a8.w}; \
        float rf[8], kf[8], vf[8], wf[8], af[8], kk[8]; float ssq = 0.f; \
        _Pragma("unroll") for (int i = 0; i < 4; ++i) { rf[2 * i] = bflo(rw[i]); rf[2 * i + 1] = bfhi(rw[i]); kf[2 * i] = bflo(kw[i]); kf[2 * i + 1] = bfhi(kw[i]); vf[2 * i] = bflo(vw[i]); vf[2 * i + 1] = bfhi(vw[i]); \
            wf[2 * i] = bflo(ww[i]); wf[2 * i + 1] = bfhi(ww[i]); af[2 * i] = bflo(aw[i]); af[2 * i + 1] = bfhi(aw[i]); } \
        _Pragma("unroll") for (int i = 0; i < 8; ++i) { kk[i] = kf[i] * kkc[i]; ssq += kk[i] * kk[i]; } \
        ssq = red8(ssq); const float inv = 1.f / fmaxf(sqrtf(ssq), 1e-12f); \
        LAS float* tb = ring + (buf) * RW_TILEF + ptt * RW_TOKF; \
        _Pragma("unroll") for (int q = 0; q < 2; ++q) { LAS f32x4* p = (LAS f32x4*)(tb + (2 * dg + q) * 20); \
            f32x4 t0, t1, t2, t3, t4; \
            _Pragma("unroll") for (int e = 0; e < 4; ++e) { const int i = 4 * q + e; const float kn = kk[i] * inv; t0[e] = wf[i]; t1[e] = -kn; t2[e] = kn * af[i]; t3[e] = kf[i] * (1.f + (af[i] - 1.f) * kac[i]); t4[e] = rf[i]; } \
            p[0] = t0; p[1] = t1; p[2] = t2; p[3] = t3; p[4] = t4; } \
        LAS f32x4* pv = (LAS f32x4*)(tb + 320 + 8 * dg); pv[0] = (f32x4){vf[0], vf[1], vf[2], vf[3]}; pv[1] = (f32x4){vf[4], vf[5], vf[6], vf[7]}; } while (0)
#define RW_FLUSH(m, buf) do { const int row = NPAD + 32 * (m) + ptt; if (row < NREAL) { const LAS float* ot = otile + (buf) * 512 + ptt * 16 + 2 * dg; \
        *(float2*)(O32 + (size_t)row * D + h * 64 + 16 * rg + 2 * dg) = make_float2(ot[0], ot[1]); } } while (0)
        if (wid >= 4) RW_PRODUCE(0, 0);
        __syncthreads();
        for (int n = 0; n < RW_NTILE; ++n) {
            if (wid < 4) {
                const LAS float* tb = ring + (n & 1) * RW_TILEF; LAS float* ot = otile + (n & 1) * 512;
#pragma unroll 4
                for (int tt = 0; tt < RW_TT; ++tt) {
                    const LAS float* p = tb + tt * RW_TOKF + cg * 20;
                    const f32x4 w4 = *(const LAS f32x4*)p, nk = *(const LAS f32x4*)(p + 4), ka = *(const LAS f32x4*)(p + 8), kp = *(const LAS f32x4*)(p + 12), r4 = *(const LAS f32x4*)(p + 16);
                    const float v = tb[tt * RW_TOKF + 320 + 16 * rg + irow];
                    float sa = (S0 * nk.x + S1 * nk.y) + (S2 * nk.z + S3 * nk.w);
                    sa = red16(sa);
                    S0 = S0 * w4.x + (sa * ka.x + v * kp.x); S1 = S1 * w4.y + (sa * ka.y + v * kp.y); S2 = S2 * w4.z + (sa * ka.z + v * kp.z); S3 = S3 * w4.w + (sa * ka.w + v * kp.w);
                    float o = (S0 * r4.x + S1 * r4.y) + (S2 * r4.z + S3 * r4.w);
                    o = red16(o);
                    if (cg == 0) ot[tt * 16 + irow] = o;
                }
            } else {
                if (n + 1 < RW_NTILE) RW_PRODUCE(n + 1, (n + 1) & 1);
                if (n > 0) RW_FLUSH(n - 1, (n - 1) & 1);
            }
            __syncthreads();
        }
        if (wid >= 4) RW_FLUSH(RW_NTILE - 1, (RW_NTILE - 1) & 1);
        __syncthreads();
#undef RW_PRODUCE
#undef RW_FLUSH
    }
}

#ifndef RC_SYNC
#define RC_SYNC 0
#endif
constexpr int RC_SLOT = 13312, RC_NSLOT = 8, RC_SCR0 = RC_NSLOT * RC_SLOT, RC_SCR = 5632, RC_FLAGS = RC_SCR0 + 7 * RC_SCR, RC_NCH = 1025;
constexpr int RC_AT = 0, RC_RT = 2176, RC_BTT = 4352, RC_KTT = 6912, RC_TT = 9472, RC_G3F = 9984, RC_VTF = 10496, RC_P1 = 11008, RC_P2 = 12032, RC_WC = 13056;
static_assert(RC_FLAGS + 64 <= 147456 - 256, "rwkv LDS map");
typedef short s16x4v __attribute__((ext_vector_type(4)));
__device__ __forceinline__ void rwkv_kknorm(const Fr& F) {
    const bf16_t* K = slotY(F, 1); const float* k_k = F.in(23); float* INV = (float*)(F.ws + WS_HE);
    for (int r = F.gw; r < R; r += F.NGW) {
#pragma unroll 4
        for (int it = 0; it < 16; ++it) {
            const size_t ci = (size_t)it * 64 + F.lane;
            const u32x2 kk = ((const u32x2*)(K + (size_t)r * D))[ci]; const f32x4 c4 = ((const f32x4*)k_k)[ci];
            const float a = bflo(kk.x) * c4.x, b = bfhi(kk.x) * c4.y, c = bflo(kk.y) * c4.z, d = bfhi(kk.y) * c4.w;
            const float ss = red16((a * a + b * b) + (c * c + d * d));
            if ((F.lane & 15) == 0) INV[(size_t)r * 64 + it * 4 + (F.lane >> 4)] = 1.f / fmaxf(sqrtf(ss), 1e-12f);
        }
    }
}
__device__ __forceinline__ unsigned lds_poll(volatile LAS unsigned* p) { return *p; }
__device__ __forceinline__ void rwkv_scan(const Fr& F) {
    const bf16_t* Rr = slotY(F, 0); const bf16_t* K = slotY(F, 1); const bf16_t* V = slotY(F, 2); const bf16_t* W = slotY(F, 4); const bf16_t* A = slotY(F, 5);
    const float* INV = (const float*)(F.ws + WS_HE);
    float* O32 = (float*)slotU(F, 1);
    LAS unsigned char* L = F.lds;
    volatile LAS unsigned* flags = (volatile LAS unsigned*)(L + RC_FLAGS);
    const int lane = F.lane, wid = F.wave, l15 = lane & 15, kg = lane >> 4;
    for (int unit = F.bid; unit < 256; unit += F.G) {
        const int h = unit >> 2, rgw = unit & 3;
        if (F.tid < 16) flags[F.tid] = 0u;
        __syncthreads();
        if (wid == 0) {
            __builtin_amdgcn_s_setprio(3);
            f32x4 S0 = {0.f, 0.f, 0.f, 0.f}, S1 = S0, S2 = S0, S3 = S0;
            struct SlotRegs { u32x2 a0l, a0h, a1l, a1h, r0l, r0h, r1l, r1h; f32x4 P1, P2; s16x4v ttf, g3f, vtf, b0, b1, b2, b3, k0, k1, k2, k3; f32x4 w0, w1, w2, w3; };
#if RC_SYNC
#define CH_WAIT(n_) do { if ((n_) % 7 == 0) { __builtin_amdgcn_s_barrier(); __builtin_amdgcn_s_barrier(); } } while (0)
#else
#define CH_WAIT(n_) do { unsigned sp = 0; while (lds_poll(flags + ((n_) & 7)) != (unsigned)((n_) + 1)) { __builtin_amdgcn_s_sleep(1); if (++sp > (1u << 22)) break; } } while (0)
#endif
#define CH_LOAD(R_, n_) do { CH_WAIT(n_); asm volatile("s_waitcnt lgkmcnt(0)" ::: "memory"); const LAS unsigned char* SL = L + ((n_) & 7) * RC_SLOT; \
                const LAS unsigned char* ap = SL + RC_AT + l15 * 136 + kg * 8; const LAS unsigned char* rp = SL + RC_RT + l15 * 136 + kg * 8; \
                R_.a0l = *(const LAS u32x2*)(ap); R_.a0h = *(const LAS u32x2*)(ap + 32); R_.a1l = *(const LAS u32x2*)(ap + 64); R_.a1h = *(const LAS u32x2*)(ap + 96); \
                R_.r0l = *(const LAS u32x2*)(rp); R_.r0h = *(const LAS u32x2*)(rp + 32); R_.r1l = *(const LAS u32x2*)(rp + 64); R_.r1h = *(const LAS u32x2*)(rp + 96); \
                R_.P1 = *(const LAS f32x4*)(SL + RC_P1 + lane * 16); R_.P2 = *(const LAS f32x4*)(SL + RC_P2 + lane * 16); \
                R_.ttf = *(const LAS s16x4v*)(SL + RC_TT + lane * 8); R_.g3f = *(const LAS s16x4v*)(SL + RC_G3F + lane * 8); R_.vtf = *(const LAS s16x4v*)(SL + RC_VTF + lane * 8); \
                const LAS unsigned char* bp = SL + RC_BTT + l15 * 40 + kg * 8; const LAS unsigned char* kp = SL + RC_KTT + l15 * 40 + kg * 8; \
                R_.b0 = *(const LAS s16x4v*)(bp); R_.b1 = *(const LAS s16x4v*)(bp + 640); R_.b2 = *(const LAS s16x4v*)(bp + 1280); R_.b3 = *(const LAS s16x4v*)(bp + 1920); \
                R_.k0 = *(const LAS s16x4v*)(kp); R_.k1 = *(const LAS s16x4v*)(kp + 640); R_.k2 = *(const LAS s16x4v*)(kp + 1280); R_.k3 = *(const LAS s16x4v*)(kp + 1920); \
                const LAS f32x4* wc = (const LAS f32x4*)(SL + RC_WC + kg * 16); R_.w0 = wc[0]; R_.w1 = wc[4]; R_.w2 = wc[8]; R_.w3 = wc[12]; \
                asm volatile("s_waitcnt lgkmcnt(0)" ::: "memory"); \
                if (lane == 0) flags[8] = (unsigned)((n_) + 1); } while (0)
#define CH_COMPUTE(R_, n_, NEXT_) do { \
                u32x4 sb0, sb1; sb0.x = cvt_pk_bf16(S0.x, S0.y); sb0.y = cvt_pk_bf16(S0.z, S0.w); sb0.z = cvt_pk_bf16(S1.x, S1.y); sb0.w = cvt_pk_bf16(S1.z, S1.w); \
                sb1.x = cvt_pk_bf16(S2.x, S2.y); sb1.y = cvt_pk_bf16(S2.z, S2.w); sb1.z = cvt_pk_bf16(S3.x, S3.y); sb1.w = cvt_pk_bf16(S3.z, S3.w); \
                const bf16x8 Sb0 = *reinterpret_cast<bf16x8*>(&sb0), Sb1 = *reinterpret_cast<bf16x8*>(&sb1); \
                u32x4 t4; \
                t4 = (u32x4){R_.a0l.x, R_.a0l.y, R_.a0h.x, R_.a0h.y}; const bf16x8 Aq0 = *reinterpret_cast<bf16x8*>(&t4); \
                t4 = (u32x4){R_.a1l.x, R_.a1l.y, R_.a1h.x, R_.a1h.y}; const bf16x8 Aq1 = *reinterpret_cast<bf16x8*>(&t4); \
                t4 = (u32x4){R_.r0l.x, R_.r0l.y, R_.r0h.x, R_.r0h.y}; const bf16x8 Rq0 = *reinterpret_cast<bf16x8*>(&t4); \
                t4 = (u32x4){R_.r1l.x, R_.r1l.y, R_.r1h.x, R_.r1h.y}; const bf16x8 Rq1 = *reinterpret_cast<bf16x8*>(&t4); \
                f32x4 X = R_.P1, O = R_.P2; \
                X = __builtin_amdgcn_mfma_f32_16x16x32_bf16(Aq0, Sb0, X, 0, 0, 0); \
                X = __builtin_amdgcn_mfma_f32_16x16x32_bf16(Aq1, Sb1, X, 0, 0, 0);                   \
                O = __builtin_amdgcn_mfma_f32_16x16x32_bf16(Rq0, Sb0, O, 0, 0, 0); \
                O = __builtin_amdgcn_mfma_f32_16x16x32_bf16(Rq1, Sb1, O, 0, 0, 0);                   \
                u32x2 yb; yb.x = cvt_pk_bf16(X.x, X.y); yb.y = cvt_pk_bf16(X.z, X.w); \
                f32x4 U = {0.f, 0.f, 0.f, 0.f}; \
                U = __builtin_amdgcn_mfma_f32_16x16x16bf16_1k(R_.ttf, *reinterpret_cast<s16x4v*>(&yb), U, 0, 0, 0);     \
                u32x2 ub; ub.x = cvt_pk_bf16(U.x, U.y); ub.y = cvt_pk_bf16(U.z, U.w); \
                const s16x4v Ub = *reinterpret_cast<s16x4v*>(&ub); \
                S0 = __builtin_amdgcn_mfma_f32_16x16x16bf16_1k(R_.k0, R_.vtf, S0, 0, 0, 0); S1 = __builtin_amdgcn_mfma_f32_16x16x16bf16_1k(R_.k1, R_.vtf, S1, 0, 0, 0); \
                S2 = __builtin_amdgcn_mfma_f32_16x16x16bf16_1k(R_.k2, R_.vtf, S2, 0, 0, 0); S3 = __builtin_amdgcn_mfma_f32_16x16x16bf16_1k(R_.k3, R_.vtf, S3, 0, 0, 0); \
                S0 = __builtin_amdgcn_mfma_f32_16x16x16bf16_1k(R_.b0, Ub, S0, 0, 0, 0); S1 = __builtin_amdgcn_mfma_f32_16x16x16bf16_1k(R_.b1, Ub, S1, 0, 0, 0); \
                S2 = __builtin_amdgcn_mfma_f32_16x16x16bf16_1k(R_.b2, Ub, S2, 0, 0, 0); S3 = __builtin_amdgcn_mfma_f32_16x16x16bf16_1k(R_.b3, Ub, S3, 0, 0, 0); \
                O = __builtin_amdgcn_mfma_f32_16x16x16bf16_1k(R_.g3f, Ub, O, 0, 0, 0);                   \
                NEXT_; \
                S0 = S0 * R_.w0; S1 = S1 * R_.w1; S2 = S2 * R_.w2; S3 = S3 * R_.w3; \
                float* op = O32 + (size_t)(NPAD + 16 * (n_) + 4 * kg) * D + h * 64 + 16 * rgw + l15;     \
                op[0] = O.x; op[D] = O.y; op[2 * D] = O.z; op[3 * D] = O.w; } while (0)
            SlotRegs RA, RB;
            CH_LOAD(RA, 0);
            for (int n = 0; n + 1 < RC_NCH; n += 2) {
                CH_COMPUTE(RA, n, CH_LOAD(RB, n + 1));
                if (n + 2 < RC_NCH) { CH_COMPUTE(RB, n + 1, CH_LOAD(RA, n + 2)); } else { CH_COMPUTE(RB, n + 1, (void)0); }
            }
            if (RC_NCH & 1) { CH_COMPUTE(RA, RC_NCH - 1, (void)0); }
            __builtin_amdgcn_s_setprio(0);
#undef CH_WAIT
#undef CH_LOAD
#undef CH_COMPUTE
        } else {
            const int p = wid - 1;
            LAS unsigned char* SC = L + RC_SCR0 + p * RC_SCR;
            const float kkc = F.in(23)[h * 64 + lane], kac = F.in(24)[h * 64 + lane];
            unsigned short cr[16], ck[16], cw[16], ca[16], nvq[4]; float civ[16];
#define RC_LOADS(nn) do { const int r0n = NPAD + 16 * (nn); \
                _Pragma("unroll") for (int e = 0; e < 4; ++e) nvq[e] = V[(size_t)(r0n + 4 * kg + e) * D + h * 64 + 16 * rgw + l15]; \
                _Pragma("unroll") for (int s = 0; s < 16; ++s) { const size_t off = (size_t)(r0n + s) * D + h * 64 + lane; cr[s] = Rr[off]; ck[s] = K[off]; cw[s] = W[off]; ca[s] = A[off]; civ[s] = INV[(size_t)(r0n + s) * 64 + h]; } } while (0)
            RC_LOADS(p);
            for (int n = p; n < RC_NCH; n += 7) {
                const int slot = n & 7; LAS unsigned char* SL = L + slot * RC_SLOT;
                unsigned short vq[4];
#pragma unroll
                for (int e = 0; e < 4; ++e) vq[e] = nvq[e];
#if RC_SYNC
                asm volatile("s_waitcnt lgkmcnt(0)" ::: "memory"); __builtin_amdgcn_s_barrier();
#else
                if (n >= 8) { unsigned sp = 0; while (lds_poll(flags + 8) < (unsigned)(n - 7)) { __builtin_amdgcn_s_sleep(2); if (++sp > (1u << 22)) break; } }
#endif
                asm volatile("" ::: "memory");
                float Wp = 1.f; unsigned btp[8], ktp[8];
#pragma unroll
                for (int hb = 0; hb < 2; ++hb) {
                    unsigned short rq[8], kq[8], wq[8], aq[8]; float iv[8];
#pragma unroll
                    for (int s = 0; s < 8; ++s) { rq[s] = cr[8 * hb + s]; kq[s] = ck[8 * hb + s]; wq[s] = cw[8 * hb + s]; aq[s] = ca[8 * hb + s]; iv[s] = civ[8 * hb + s]; }
                    float btv[8], ktv[8];
#pragma unroll
                    for (int s = 0; s < 8; ++s) {
                        const int t = 8 * hb + s;
                        const float rs = bf2f(rq[s]), ks = bf2f(kq[s]), wsv = bf2f(wq[s]), as = bf2f(aq[s]);
                        const float kk = ks * kkc * iv[s];
                        const float Wprev = Wp; Wp *= wsv; const float iW = __builtin_amdgcn_rcpf(Wp);
                        const float at = -kk * Wprev, rt = rs * Wp, bt = kk * as * iW, kt = ks * (1.f + (as - 1.f) * kac) * iW;
                        *(LAS bf16_t*)(SL + RC_AT + t * 136 + lane * 2) = f2bf(at); *(LAS bf16_t*)(SL + RC_RT + t * 136 + lane * 2) = f2bf(rt);
                        *(LAS bf16_t*)(SC + t * 136 + lane * 2) = f2bf(bt); *(LAS bf16_t*)(SC + 2176 + t * 136 + lane * 2) = f2bf(kt);
                        btv[s] = bt; ktv[s] = kt;
                    }
#pragma unroll
                    for (int s = 0; s < 4; ++s) { btp[4 * hb + s] = cvt_pk_bf16(btv[2 * s], btv[2 * s + 1]); ktp[4 * hb + s] = cvt_pk_bf16(ktv[2 * s], ktv[2 * s + 1]); }
                }
                {
                    LAS u32x2* bq = (LAS u32x2*)(SL + RC_BTT + lane * 40); LAS u32x2* kq2 = (LAS u32x2*)(SL + RC_KTT + lane * 40);
#pragma unroll
                    for (int q = 0; q < 4; ++q) { bq[q] = (u32x2){btp[2 * q], btp[2 * q + 1]}; kq2[q] = (u32x2){ktp[2 * q], ktp[2 * q + 1]}; }
                    *(LAS float*)(SL + RC_WC + lane * 4) = Wp;
                    u32x2 vt; vt.x = (unsigned)vq[0] | ((unsigned)vq[1] << 16); vt.y = (unsigned)vq[2] | ((unsigned)vq[3] << 16);
                    *(LAS u32x2*)(SL + RC_VTF + lane * 8) = vt;
                }
                if (n + 7 < RC_NCH) RC_LOADS(n + 7);
                asm volatile("s_waitcnt lgkmcnt(0)" ::: "memory");
                f32x4 G1 = {0.f, 0.f, 0.f, 0.f}, G2 = G1, G3 = G1, G4 = G1, G1t = G1;
#pragma unroll
                for (int ks = 0; ks < 2; ++ks) {
                    const bf16x8 fb = *(const LAS bf16x8*)(SC + l15 * 136 + (32 * ks + 8 * kg) * 2), fk = *(const LAS bf16x8*)(SC + 2176 + l15 * 136 + (32 * ks + 8 * kg) * 2);
                    const bf16x8 fa = *(const LAS bf16x8*)(SL + RC_AT + l15 * 136 + (32 * ks + 8 * kg) * 2), fr_ = *(const LAS bf16x8*)(SL + RC_RT + l15 * 136 + (32 * ks + 8 * kg) * 2);
                    G1 = __builtin_amdgcn_mfma_f32_16x16x32_bf16(fb, fa, G1, 0, 0, 0); G2 = __builtin_amdgcn_mfma_f32_16x16x32_bf16(fk, fa, G2, 0, 0, 0);
                    G1t = __builtin_amdgcn_mfma_f32_16x16x32_bf16(fa, fb, G1t, 0, 0, 0);
                    G3 = __builtin_amdgcn_mfma_f32_16x16x32_bf16(fb, fr_, G3, 0, 0, 0); G4 = __builtin_amdgcn_mfma_f32_16x16x32_bf16(fk, fr_, G4, 0, 0, 0);
                }
                {
#pragma unroll
                    for (int e = 0; e < 4; ++e) { const int s = 4 * kg + e; const bool lt = s < l15, le = s <= l15;
                        G1[e] = lt ? G1[e] : 0.f; G1t[e] = (l15 < s) ? G1t[e] : 0.f; G2[e] = lt ? G2[e] : 0.f; G3[e] = le ? G3[e] : 0.f; G4[e] = le ? G4[e] : 0.f; }
                    u32x2 g2, g3, g4; g2.x = cvt_pk_bf16(G2.x, G2.y); g2.y = cvt_pk_bf16(G2.z, G2.w); g3.x = cvt_pk_bf16(G3.x, G3.y); g3.y = cvt_pk_bf16(G3.z, G3.w); g4.x = cvt_pk_bf16(G4.x, G4.y); g4.y = cvt_pk_bf16(G4.z, G4.w);
                    *(LAS u32x2*)(SL + RC_G3F + lane * 8) = g3;
                    u32x2 vt; vt.x = (unsigned)vq[0] | ((unsigned)vq[1] << 16); vt.y = (unsigned)vq[2] | ((unsigned)vq[3] << 16);
                    const s16x4v vtf = *reinterpret_cast<s16x4v*>(&vt);
                    f32x4 P1 = {0.f, 0.f, 0.f, 0.f}, P2 = P1;
                    P1 = __builtin_amdgcn_mfma_f32_16x16x16bf16_1k(*reinterpret_cast<s16x4v*>(&g2), vtf, P1, 0, 0, 0);
                    P2 = __builtin_amdgcn_mfma_f32_16x16x16bf16_1k(*reinterpret_cast<s16x4v*>(&g4), vtf, P2, 0, 0, 0);
                    *(LAS f32x4*)(SL + RC_P1 + lane * 16) = P1; *(LAS f32x4*)(SL + RC_P2 + lane * 16) = P2;
#define RC_BF(v) ({ u32x2 t_; t_.x = cvt_pk_bf16((v).x, (v).y); t_.y = cvt_pk_bf16((v).z, (v).w); *reinterpret_cast<s16x4v*>(&t_); })
                    const f32x4 Z4 = {0.f, 0.f, 0.f, 0.f};
                    const s16x4v n1 = RC_BF(G1), n1t = RC_BF(G1t);
                    const f32x4 X2 = __builtin_amdgcn_mfma_f32_16x16x16bf16_1k(n1t, n1, Z4, 0, 0, 0), X2t = __builtin_amdgcn_mfma_f32_16x16x16bf16_1k(n1, n1t, Z4, 0, 0, 0);
                    const s16x4v n2 = RC_BF(X2), n2t = RC_BF(X2t);
                    const f32x4 X4 = __builtin_amdgcn_mfma_f32_16x16x16bf16_1k(n2t, n2, Z4, 0, 0, 0), X4t = __builtin_amdgcn_mfma_f32_16x16x16bf16_1k(n2, n2t, Z4, 0, 0, 0);
                    const s16x4v n4 = RC_BF(X4), n4t = RC_BF(X4t);
                    f32x4 Tm = __builtin_amdgcn_mfma_f32_16x16x16bf16_1k(n4t, n4, Z4, 0, 0, 0);
#pragma unroll
                    for (int e = 0; e < 4; ++e) Tm[e] += (4 * kg + e == l15) ? 1.f : 0.f;
                    Tm = __builtin_amdgcn_mfma_f32_16x16x16bf16_1k(n4t, RC_BF(Tm), Tm, 0, 0, 0);
                    Tm = __builtin_amdgcn_mfma_f32_16x16x16bf16_1k(n2t, RC_BF(Tm), Tm, 0, 0, 0);
                    Tm = __builtin_amdgcn_mfma_f32_16x16x16bf16_1k(n1t, RC_BF(Tm), Tm, 0, 0, 0);
                    { u32x2 tt; tt.x = cvt_pk_bf16(Tm.x, Tm.y); tt.y = cvt_pk_bf16(Tm.z, Tm.w); *(LAS u32x2*)(SL + RC_TT + lane * 8) = tt; }
#undef RC_BF
                }
                asm volatile("s_waitcnt lgkmcnt(0)" ::: "memory");
#if RC_SYNC
                __builtin_amdgcn_s_barrier();
#else
                if (lane == 0) flags[slot] = (unsigned)(n + 1);
#endif
            }
#if RC_SYNC
            if (p >= RC_NCH % 7) { __builtin_amdgcn_s_barrier(); __builtin_amdgcn_s_barrier(); }
#endif
        }
#undef RC_LOADS
        __syncthreads();
    }
}
__device__ __forceinline__ void rwkv_post(const Fr& F) {
    const bf16_t* Rr = slotY(F, 0); const bf16_t* K = slotY(F, 1); const bf16_t* V = slotY(F, 2); const bf16_t* GT = slotY(F, 3); const bf16_t* A = slotY(F, 5);
    const float* O32 = (const float*)slotU(F, 1); bf16_t* Z = slotU(F, 0);
    const float* k_a = F.in(24); const float* r_k = F.in(25); const float* lw = F.in(26); const float* lb = F.in(27);
    for (int r = F.gw; r < R; r += F.NGW) {
        const bool real = (r >= NPAD && r < NREAL);
        u32x2* zr = (u32x2*)(Z + (size_t)r * D) + F.lane;
        if (!real) { const u32x2 z = {0u, 0u};
#pragma unroll
            for (int it = 0; it < 16; ++it) zr[64 * it] = z;
            continue; }
#pragma unroll 2
        for (int it = 0; it < 16; ++it) {
            const size_t ci = (size_t)it * 64 + F.lane;
            const f32x4 o4 = ((const f32x4*)(O32 + (size_t)r * D))[ci];
            const u32x2 rr = ((const u32x2*)(Rr + (size_t)r * D))[ci], kk = ((const u32x2*)(K + (size_t)r * D))[ci], vv = ((const u32x2*)(V + (size_t)r * D))[ci], gg = ((const u32x2*)(GT + (size_t)r * D))[ci], aa = ((const u32x2*)(A + (size_t)r * D))[ci];
            const f32x4 ka4 = ((const f32x4*)k_a)[ci], rk4 = ((const f32x4*)r_k)[ci], lw4 = ((const f32x4*)lw)[ci], lb4 = ((const f32x4*)lb)[ci];
            const float mean = red16((o4.x + o4.y) + (o4.z + o4.w)) * (1.f / 64.f);
            const float d0 = o4.x - mean, d1 = o4.y - mean, d2 = o4.z - mean, d3 = o4.w - mean;
            const float var = red16((d0 * d0 + d1 * d1) + (d2 * d2 + d3 * d3)) * (1.f / 64.f);
            const float rs = __builtin_amdgcn_rsqf(var + 64e-5f);
            const float r0 = bflo(rr.x), r1 = bfhi(rr.x), r2 = bflo(rr.y), r3 = bfhi(rr.y);
            const float kp0 = bflo(kk.x) * (1.f + (bflo(aa.x) - 1.f) * ka4.x), kp1 = bfhi(kk.x) * (1.f + (bfhi(aa.x) - 1.f) * ka4.y), kp2 = bflo(kk.y) * (1.f + (bflo(aa.y) - 1.f) * ka4.z), kp3 = bfhi(kk.y) * (1.f + (bfhi(aa.y) - 1.f) * ka4.w);
            const float bs = red16((r0 * kp0 * rk4.x + r1 * kp1 * rk4.y) + (r2 * kp2 * rk4.z + r3 * kp3 * rk4.w));
            const float y0 = d0 * rs * lw4.x + lb4.x + bs * bflo(vv.x), y1 = d1 * rs * lw4.y + lb4.y + bs * bfhi(vv.x), y2 = d2 * rs * lw4.z + lb4.z + bs * bflo(vv.y), y3 = d3 * rs * lw4.w + lb4.w + bs * bfhi(vv.y);
            u32x2 w; w.x = cvt_pk_bf16(y0 * silu_f(bflo(gg.x)), y1 * silu_f(bfhi(gg.x))); w.y = cvt_pk_bf16(y2 * silu_f(bflo(gg.y)), y3 * silu_f(bfhi(gg.y)));
            zr[64 * it] = w;
        }
    }
}
}
namespace mk {
constexpr int LDS_BYTES = 163840;
constexpr int LDS_MISC = LDS_BYTES - 128;
struct Args { const float* in[29]; float* out; unsigned char* ws; };

#define MK_GEMM(EPI, e, Aptr, aps_, Bptr, M_, N_, K_) do { int kk_ = (K_); asm volatile("" : "+s"(kk_));     \
    pg8::Gemm g_{(const bf16_t*)(Aptr), (const bf16_t*)(Bptr), (M_), (N_), kk_, (size_t)(aps_)}; pg8::StaticOrder S_; S_.init((M_), (N_), F.G, F.bid); \
    pg8::gemm_phase<EPI, pg8::StaticOrder, false>(F.lds, g_, S_, e, nullptr); } while (0)

struct TailOrder { int pn;
    __device__ bool next(int i, pg8::Unit& u) const { if (i > 0 || pn < 0) return false; u.pm = 64; u.pn = pn; return true; }
    __device__ __forceinline__ void a_ready(const pg8::Unit&) const {}
    __device__ __forceinline__ void done(const pg8::Unit&) const {}
};
#define MK_GEMM1(EPI, e, aps_, NTOT_, L_) do { MK_GEMM(EPI, e, slotU(F, 0), aps_, wtin_of(F, L_), 16384, NTOT_, D); \
    if (F.bid < (NTOT_) / 256) { int kk_ = D; asm volatile("" : "+s"(kk_)); pg8::Gemm g_{(const bf16_t*)slotU(F, 0), (const bf16_t*)wtin_of(F, L_), R, (NTOT_), kk_, (size_t)(aps_)}; TailOrder St_{F.bid}; \
        pg8::gemm_phase<EPI, TailOrder, false, true>(F.lds, g_, St_, e, nullptr); } } while (0)
#define MK_GEMM2_NORM(prev, next, udst) do { \
    MK_GEMM(EpiY, ey, slotU(F, 0), 0, wtout, 16384, D, D); \
    GRID_BAR(); \
    if (F.bid < 16) { int kk_ = D; asm volatile("" : "+s"(kk_)); pg8::Gemm g_{(const bf16_t*)slotU(F, 0), (const bf16_t*)wtout, R, D, kk_, (size_t)0}; TailOrder St_{F.bid}; \
        pg8::gemm_phase<EpiY, TailOrder, false, true>(F.lds, g_, St_, ey, nullptr); } \
    else { const Fr P = F.fresh(); norm_phase(P, prev, next, slotY(P, 0), udst, 0, 16384, 16); } \
    GRID_BAR(); \
    { const Fr P = F.fresh(); norm_phase(P, prev, next, slotY(P, 0), udst, 16384, R, 0); if ((next) >= 0) convert_layer(P, next, (next) == 3); } \
    GRID_BAR(); } while (0)

__global__ void __launch_bounds__(512, 2) fwd(Args a) {
    extern __shared__ __attribute__((aligned(16))) unsigned char lds_raw[];
    Fr F;
    F.lds = (LAS unsigned char*)lds_raw; F.ldsg = lds_raw;
    F.tid = threadIdx.x; F.lane = F.tid & 63; F.wave = __builtin_amdgcn_readfirstlane(F.tid >> 6);
    F.G = gridDim.x; F.bid = blockIdx.x; F.gw = F.bid * 8 + F.wave; F.NGW = F.G * 8;
    F.out = a.out; F.ws = a.ws;
    volatile LAS unsigned* misc = (volatile LAS unsigned*)(F.lds + LDS_MISC);
    if (F.tid < 16) misc[F.tid] = 0u;
    __syncthreads();
    XcdBarrier bar = xcd_barrier_post((unsigned*)(F.ws + WS_CTL) + 4096, misc + 8);
#define GRID_BAR() xcd_barrier(bar)
#ifndef MK_DUP
#define MK_DUP 0
#endif
#define DUPN(k, ...) do { __VA_ARGS__; if ((MK_DUP >> (k)) & 1) { GRID_BAR(); __VA_ARGS__; } } while (0)
    bf16_t* wtout = (bf16_t*)(F.ws + WS_WTOUT);
    const EpiY ey{slotY(F, 0)};

    DUPN(11, { const Fr P = F.fresh(); convert_layer(P, 0, true); rope_table(P); norm_phase(P, -1, 0, nullptr, slotU(P, 0)); });
    GRID_BAR();
    { const EpiH1 e{slotY(F, 0), F.in(5), 0}; MK_GEMM1(EpiH1, e, 0, 4 * D, 0); }
    if (F.bid >= 64) { const Fr P = F.fresh(); convert_win(P, 1, 64); }
    GRID_BAR();
    DUPN(1, { const Fr P = F.fresh(); hgrn_phase<false>(P, 0); });
    GRID_BAR();
    DUPN(2, { const Fr P = F.fresh(); hgrn_phase<true>(P, 0); });
    GRID_BAR();
    MK_GEMM2_NORM(0, 1, slotU(F, 0));
    { const EpiB1 e{slotY(F, 0), (const float*)(F.ws + WS_ROPE), (const float*)(F.ws + WS_ROPE) + (size_t)R * 16}; MK_GEMM1(EpiB1, e, 0, 4 * D, 1); }
    if (F.bid >= 64) { const Fr P = F.fresh(); convert_win(P, 2, 64); }
    GRID_BAR();
    DUPN(3, { const Fr P = F.fresh(); attn_phase(P); });
    GRID_BAR();
    DUPN(4, { const Fr P = F.fresh(); attn_post(P); });
    GRID_BAR();
    MK_GEMM2_NORM(1, 2, slotY(F, 1));
    DUPN(7, { const Fr P = F.fresh(); mix_phase(P, slotY(P, 1)); convert_layer2_b(P); });
    GRID_BAR();
    { const EpiC1 e{slotY(F, 0), (bf16_t*)(F.ws + WS_T)}; MK_GEMM(EpiC1, e, slotU(F, 0), (size_t)R * D, wtin_of(F, 2), R, 4 * D + 512, D); }
    GRID_BAR();
    DUPN(9, { const EpiC2 e{slotY(F, 0), F.in(17), F.in(20)}; MK_GEMM(EpiC2, e, F.ws + WS_T, 0, F.ws + WS_W2P, R, 2 * D, 256); });
    { const Fr P = F.fresh(); rwkv_kknorm(P); }
    GRID_BAR();
    DUPN(5, { const Fr P = F.fresh(); rwkv_scan(P); });
    GRID_BAR();
    DUPN(6, { const Fr P = F.fresh(); rwkv_post(P); });
    GRID_BAR();
    MK_GEMM2_NORM(2, 3, slotU(F, 0));
    { const EpiH1 e{slotY(F, 0), F.in(5), 1}; MK_GEMM1(EpiH1, e, 0, 4 * D, 3); }
    GRID_BAR();
    { const Fr P = F.fresh(); hgrn_phase<false>(P, 1); }
    GRID_BAR();
    { const Fr P = F.fresh(); hgrn_phase<true>(P, 1); }
    GRID_BAR();
    MK_GEMM2_NORM(3, -1, (bf16_t*)nullptr);
}
}

extern "C" void kernel_launch(void* const* d_in, const int* in_sizes, int n_in, void* d_out, int out_size, void* d_ws, size_t ws_size, hipStream_t stream) {
    static int grid = 0;
    if (grid == 0) {
        if (n_in != 29 || out_size != 16384 * 4096 || ws_size < mk::WS_END) { fprintf(stderr, "kernel_launch: unexpected shapes (n_in %d out %d ws %zu need %zu)\n", n_in, out_size, ws_size, (size_t)mk::WS_END); grid = -1; return; }
        int dev = 0, cus = 0, per_cu = 0;
        if (hipGetDevice(&dev) != hipSuccess || hipDeviceGetAttribute(&cus, hipDeviceAttributeMultiprocessorCount, dev) != hipSuccess) { grid = -1; return; }
        if (hipFuncSetAttribute((const void*)mk::fwd, hipFuncAttributeMaxDynamicSharedMemorySize, mk::LDS_BYTES) != hipSuccess) { fprintf(stderr, "kernel_launch: hipFuncSetAttribute failed\n"); grid = -1; return; }
        if (hipOccupancyMaxActiveBlocksPerMultiprocessor(&per_cu, (const void*)mk::fwd, 512, mk::LDS_BYTES) != hipSuccess || per_cu < 1) { fprintf(stderr, "kernel_launch: occupancy query says %d\n", per_cu); }
        (void)hipGetLastError();
        grid = cus;
    }
    if (grid < 0) return;
    if (hipMemsetAsync((char*)d_ws + mk::WS_CTL, 0, mk::CTL_BYTES, stream) != hipSuccess) return;
    mk::Args a{};
    for (int i = 0; i < 29; ++i) a.in[i] = (const float*)d_in[i];
    a.out = (float*)d_out; a.ws = (unsigned char*)d_ws;
    hipLaunchKernelGGL(mk::fwd, dim3(grid), dim3(512), mk::LDS_BYTES, stream, a);
}
```

```cpp
#include <hip/hip_runtime.h>
#include <cstdio>
#include <cstdint>

#define LAS __attribute__((address_space(3)))
#define GAS __attribute__((address_space(1)))
typedef unsigned short bf16_t;
typedef short bf16x8 __attribute__((ext_vector_type(8)));
typedef short s16x4 __attribute__((ext_vector_type(4)));
typedef float f32x4 __attribute__((ext_vector_type(4)));
typedef float f32x16 __attribute__((ext_vector_type(16)));
typedef unsigned u32x4 __attribute__((ext_vector_type(4)));
typedef unsigned u32x2 __attribute__((ext_vector_type(2)));

namespace mk {
constexpr int D = 4096, NPAD = 48, NREAL = 16448, R = 16640, NCH = 257;
constexpr size_t MiB = 1u << 20;
constexpr size_t SLOT = (size_t)R * D * 2;
constexpr size_t WS_CTL = 0, CTL_BYTES = 1 * MiB;
constexpr size_t WS_WTIN = 2 * MiB;
constexpr size_t WS_WTOUT = 134 * MiB;
constexpr size_t WS_W2P = 166 * MiB;
constexpr size_t WS_ROPE = 170 * MiB;
constexpr size_t WS_HMETA = 174 * MiB;
constexpr size_t WS_HE = 175 * MiB;
constexpr size_t WS_HLOGD = 191 * MiB;
constexpr size_t WS_U = 192 * MiB;
constexpr size_t WS_Y = WS_U + 6 * SLOT;
constexpr size_t WS_T = WS_Y + 6 * SLOT;
constexpr size_t WS_WTINB = WS_U + 4 * SLOT;
constexpr size_t WS_HB = (WS_T + (size_t)R * 256 * 2 + MiB - 1) / MiB * MiB;
constexpr size_t WS_END = WS_HB + SLOT;
static_assert(WS_END <= 2040 * MiB, "d_ws map");

typedef __bf16 bf16x2n_t __attribute__((ext_vector_type(2)));
typedef float f32x2n_t __attribute__((ext_vector_type(2)));
__device__ __forceinline__ unsigned cvt_pk_bf16(float lo, float hi) { const f32x2n_t v = {lo, hi}; const bf16x2n_t r = __builtin_convertvector(v, bf16x2n_t); return __builtin_bit_cast(unsigned, r); }
__device__ __forceinline__ float bflo(unsigned w) { return __uint_as_float(w << 16); }
__device__ __forceinline__ float bfhi(unsigned w) { return __uint_as_float(w & 0xffff0000u); }
__device__ __forceinline__ float bf2f(bf16_t b) { return __uint_as_float(((unsigned)b) << 16); }
__device__ __forceinline__ bf16_t f2bf(float f) { return (bf16_t)(cvt_pk_bf16(f, f) & 0xffffu); }
__device__ __forceinline__ float sigmoid_f(float x) { return 1.f / (1.f + __expf(-x)); }
__device__ __forceinline__ float silu_f(float x) { return x / (1.f + __expf(-x)); }
__device__ __forceinline__ float wave_sum(float v) {
#pragma unroll
    for (int o = 1; o < 64; o <<= 1) v += __shfl_xor(v, o);
    return v;
}
template <int CTRL> __device__ __forceinline__ float dppf(float v) { return __int_as_float(__builtin_amdgcn_update_dpp(0, __float_as_int(v), CTRL, 0xf, 0xf, true)); }
__device__ __forceinline__ float red4(float v) { v += dppf<0xB1>(v); v += dppf<0x4E>(v); return v; }
__device__ __forceinline__ float red8(float v) { v = red4(v); v += dppf<0x141>(v); return v; }
__device__ __forceinline__ float red16(float v) { v = red8(v); v += dppf<0x140>(v); return v; }
#define LDS_WAIT() asm volatile("s_waitcnt lgkmcnt(0)" ::: "memory")
}
#define XB_TMO      128
#define XB_XCNT(j)  (256  + 64 * (j))
#define XB_XSUB(j)  (1280 + 64 * (j))
#define XB_XGEN(j)  (2304 + 64 * (j))
#define XB_TOP      3328
#define XB_TOPGEN   3392
#define XCD_BAR_WORDS 3456
#define XB_SPIN_CAP (1u << 18)
#define LAS __attribute__((address_space(3)))

__device__ __forceinline__ unsigned xb_ld(unsigned* p)              { return __hip_atomic_load(p, __ATOMIC_RELAXED, __HIP_MEMORY_SCOPE_AGENT); }
__device__ __forceinline__ unsigned xb_add(unsigned* p, unsigned v) { return __hip_atomic_fetch_add(p, v, __ATOMIC_RELAXED, __HIP_MEMORY_SCOPE_AGENT); }
__device__ __forceinline__ unsigned xb_xcc_id() { return (unsigned)__builtin_amdgcn_s_getreg((3 << 11) | 20) & 0xFu; }
#define XB_SPIN(cond, bar) do { unsigned _sp = 0; while (cond) { __builtin_amdgcn_s_sleep(1); \
    if ((++_sp & 255u) == 0u) { if (xb_ld(&(bar)[XB_TMO])) break; if (_sp > XB_SPIN_CAP) { atomicAdd(&(bar)[XB_TMO], 1u); break; } } } } while (0)

struct XcdBarrier {
    unsigned* bar; unsigned x;
    volatile LAS unsigned* st;
};

__device__ __forceinline__ XcdBarrier xcd_barrier_post(unsigned* bar, volatile LAS unsigned* st) {
    XcdBarrier b; b.bar = bar; b.x = xb_xcc_id(); b.st = st;
    if (threadIdx.x == 0) (void)xb_add(&bar[XB_XCNT(b.x)], 1u);
    return b;
}
__device__ __forceinline__ void xcd_barrier_complete(unsigned* bar, unsigned x, unsigned& nloc, unsigned& nx) {
    const unsigned G = gridDim.x * gridDim.y * gridDim.z;
    unsigned sum, cnt, mine, sp = 0u;
    for (;;) {
        sum = 0u; cnt = 0u; mine = 0u;
#pragma unroll
        for (unsigned j = 0; j < 16; ++j) { const unsigned c = xb_ld(&bar[XB_XCNT(j)]); sum += c; cnt += (c > 0u) ? 1u : 0u; mine = (j == x) ? c : mine; }
        if (sum == G) break;
        __builtin_amdgcn_s_sleep(1);
        if ((++sp & 255u) == 0u) { if (xb_ld(&bar[XB_TMO])) break; if (sp > XB_SPIN_CAP) { atomicAdd(&bar[XB_TMO], 1u); break; } }
    }
    nloc = mine > 0u ? mine : 1u; nx = cnt > 0u ? cnt : 1u;
}

__device__ __forceinline__ void xcd_barrier(const XcdBarrier& b) {
    asm volatile("s_waitcnt vmcnt(0)" ::: "memory");
    __syncthreads();
    if (threadIdx.x == 0) {
        unsigned* bar = b.bar;
        __builtin_amdgcn_s_waitcnt(0);
        unsigned nloc = b.st[0], nx = b.st[1];
        if (nloc == 0u) { xcd_barrier_complete(bar, b.x, nloc, nx); b.st[0] = nloc; b.st[1] = nx; }
        const unsigned old = xb_add(&bar[XB_XSUB(b.x)], 1u);
        const unsigned gen = old / nloc;
        if (old + 1u == (gen + 1u) * nloc) {
            __builtin_amdgcn_fence(__ATOMIC_RELEASE, "agent");
            asm volatile("s_waitcnt vmcnt(0)" ::: "memory");
            const unsigned og = xb_add(&bar[XB_TOP], 1u);
            const unsigned tg = og / nx;
            if (og + 1u == (tg + 1u) * nx) xb_add(&bar[XB_TOPGEN], 1u);
            else XB_SPIN(xb_ld(&bar[XB_TOPGEN]) == tg, bar);
            __builtin_amdgcn_fence(__ATOMIC_ACQUIRE, "agent");
            xb_add(&bar[XB_XGEN(b.x)], 1u);
            asm volatile("s_waitcnt vmcnt(0)" ::: "memory");
        } else {
            XB_SPIN(xb_ld(&bar[XB_XGEN(b.x)]) == gen, bar);
            __builtin_amdgcn_fence(__ATOMIC_ACQUIRE, "agent");
            asm volatile("s_waitcnt vmcnt(0)" ::: "memory");
        }
    }
    __syncthreads();
}
namespace pg8 {
#define PG8_LAS __attribute__((address_space(3)))
typedef unsigned short bf16_t;
typedef short bf16x8 __attribute__((ext_vector_type(8)));
typedef float f32x4 __attribute__((ext_vector_type(4)));
typedef unsigned u32x4 __attribute__((ext_vector_type(4)));
constexpr int BM = 256, BK = 64, HALF = 128, HTB = HALF * BK * 2  , STAGE_BYTES = 8 * HTB, NXCD = 8, WGM = 8;

__host__ __device__ __forceinline__ int lds_byte(int r, int c) { const int st = (r >> 4) * 2 + (c >> 5), rr = r & 15, cc = c & 31, ob = rr * 64 + cc * 2; return st * 1024 + (ob ^ (((ob >> 9) & 1) << 5)); }
__host__ __device__ __forceinline__ void stage_rc(int b, int& R, int& C) { const int st = b / 1024, sb = b % 1024, swz = sb ^ (((sb >> 9) & 1) << 5); R = (st >> 1) * 16 + swz / 64; C = (st & 1) * 32 + (swz % 64) / 2; }
__host__ __device__ __forceinline__ int perm32(int rho) { const int n = rho >> 4, i = rho & 15; return 8 * (i >> 2) + 4 * n + (i & 3); }

struct Unit { int pm, pn; };
struct Gemm { const bf16_t* A; const bf16_t* Bt; int M, N, K; size_t aps; };
__device__ __forceinline__ size_t a_part_bytes(const Gemm& g, int pn) { return g.aps ? (size_t)(pn < 64 ? (pn >> 4) : (pn - 60)) * g.aps * 2 : (size_t)0; }

struct StaticOrder {
    int nM, nN, nwg, G, c;
    __host__ __device__ void init(int M, int N, int G_, int c_) { nM = M / BM; nN = N / BM; nwg = nM * nN; G = G_; c = c_; }
    __host__ __device__ bool next(int i, Unit& u) const {
        const long L = (long)i * G + c; if (L >= nwg) return false;
        int wgid = (int)L; { const int q = nwg / NXCD, r = nwg % NXCD, xcd = wgid % NXCD, off = wgid / NXCD; wgid = (xcd < r ? xcd * (q + 1) : r * (q + 1) + (xcd - r) * q) + off; }
        const int nig = WGM * nN, gid = wgid / nig, fm = gid * WGM, gsz = (nM - fm) < WGM ? (nM - fm) : WGM;
        u.pm = fm + ((wgid % nig) % gsz); u.pn = (wgid % nig) / gsz; return true;
    }
    __device__ __forceinline__ void a_ready(const Unit&) const {}
    __device__ __forceinline__ void done(const Unit&) const {}
};
struct CountedOrder : StaticOrder {
    const unsigned* ready; unsigned need; unsigned* tmo;
    __device__ __forceinline__ void a_ready(const Unit& u) const {
        if (threadIdx.x < 64) {
            const unsigned long long t0 = __builtin_amdgcn_s_memrealtime(); unsigned polls = 0;
            while ((unsigned)__builtin_amdgcn_readfirstlane(__hip_atomic_load(ready + 64 * u.pm, __ATOMIC_RELAXED, __HIP_MEMORY_SCOPE_AGENT)) < need) {
                if ((++polls & 255u) == 0u && __builtin_amdgcn_readfirstlane(__hip_atomic_load(tmo, __ATOMIC_RELAXED, __HIP_MEMORY_SCOPE_AGENT)) != 0u) break;
                if (__builtin_amdgcn_s_memrealtime() - t0 > 2000000ull) {
                    if (threadIdx.x == 0) { unsigned expect = 0u; __hip_atomic_compare_exchange_strong(tmo + 1, &expect, 0x600u | (unsigned)(u.pm & 0xff), __ATOMIC_RELAXED, __ATOMIC_RELAXED, __HIP_MEMORY_SCOPE_AGENT); __hip_atomic_store(tmo, 1u, __ATOMIC_RELAXED, __HIP_MEMORY_SCOPE_AGENT); }
                    break; }
                __builtin_amdgcn_s_sleep(2); }
            __builtin_amdgcn_fence(__ATOMIC_ACQUIRE, "agent");
            asm volatile("s_waitcnt vmcnt(0)" ::: "memory");
        }
#if !defined(BROKEN_HOOK_NO_BARRIER)
        asm volatile("" ::: "memory"); __builtin_amdgcn_s_barrier(); asm volatile("" ::: "memory");
#endif
    }
};
template <class Epi, class Sched, bool STAMP = false, bool TOPHALF = false>
__device__ __forceinline__ void gemm_phase(PG8_LAS unsigned char* lds, const Gemm g, const Sched& S, const Epi& E, unsigned long long* stamps) {
    int tid_ = threadIdx.x; asm volatile("" : "+v"(tid_));
    const int tid = tid_, wid = __builtin_amdgcn_readfirstlane(tid >> 6), lane = tid & 63, wr = wid >> 2, wc = wid & 3, fr = lane & 15, fq = lane >> 4;
    const int K = g.K, nt = K / BK;
    int ts_lo = 0, ts_hi = 0, nts = 0; const unsigned long long rt_entry = STAMP ? (unsigned long long)wall_clock64() : 0ull;
#define PG8_STAMP() do { if (STAMP && wid == 0 && nts < 64) { const unsigned long long _c = (unsigned long long)clock64(); \
        ts_lo = (lane == nts) ? (int)(unsigned)_c : ts_lo; ts_hi = (lane == nts) ? (int)(unsigned)(_c >> 32) : ts_hi; ++nts; } } while (0)
    PG8_STAMP();
    unsigned voffA[2], voffB[2];
#pragma unroll
    for (int i = 0; i < 2; ++i) { int R, C; stage_rc(tid * 16 + i * 8192, R, C); const int Rb = Epi::PERM ? ((R & ~31) + perm32(R & 31)) : R;
        voffA[i] = (unsigned)(R * K + C) * 2u; voffB[i] = (unsigned)(Rb * K + C) * 2u; }
    const size_t kstep = (size_t)(BK * 2);
    const size_t hstep = (size_t)HALF * K * 2;
    const size_t tstep = 2 * hstep;
    const unsigned ldsw = (unsigned)wid * 1024u;
    const int aoff = lds_byte(wr * 64 + fr, fq * 8), boff = lds_byte(wc * 32 + fr, fq * 8);
#define PG8_SA(b, h) (((b) * 2 + (h)) * HTB)
#define PG8_SB(b, h) ((4 + (b) * 2 + (h)) * HTB)
#define PG8_STAGE(bufoff, gbase, voff) do { _Pragma("unroll") for (int _i = 0; _i < 2; ++_i) \
        __builtin_amdgcn_global_load_lds((const unsigned*)((const char*)(gbase) + (voff)[_i]), (PG8_LAS unsigned*)(lds + (bufoff) + ldsw + _i * 8192), 16, 0, 0); } while (0)
#define PG8_LDA(dst, b, h) do { _Pragma("unroll") for (int m = 0; m < 4; ++m) _Pragma("unroll") for (int k = 0; k < 2; ++k) dst[m][k] = *(const PG8_LAS bf16x8*)(lds + PG8_SA(b, h) + aoff + m * 2048 + k * 1024); } while (0)
#define PG8_LDB(dst, b, h) do { _Pragma("unroll") for (int n = 0; n < 2; ++n) _Pragma("unroll") for (int k = 0; k < 2; ++k) dst[n][k] = *(const PG8_LAS bf16x8*)(lds + PG8_SB(b, h) + boff + n * 2048 + k * 1024); } while (0)
#define PG8_MMA(ai, bj, At, Bt) do { __builtin_amdgcn_s_setprio(1); _Pragma("unroll") for (int m = 0; m < 4; ++m) _Pragma("unroll") for (int n = 0; n < 2; ++n) _Pragma("unroll") for (int k = 0; k < 2; ++k) \
        acc[ai][bj][m][n] = __builtin_amdgcn_mfma_f32_16x16x32_bf16(Bt[n][k], At[m][k], acc[ai][bj][m][n], 0, 0, 0); __builtin_amdgcn_s_setprio(0); } while (0)
#define PG8_WAIT_V(n) asm volatile("s_waitcnt vmcnt(" #n ")" ::: "memory")
#define PG8_WAIT_L(n) asm volatile("s_waitcnt lgkmcnt(" #n ")" ::: "memory")
#define PG8_BAR __builtin_amdgcn_s_barrier()
#define PG8_SCHED __builtin_amdgcn_sched_barrier(0)
    Unit cur, nxt; int ui = 0;
    if (!S.next(0, cur)) return;
    f32x4 acc[2][2][4][2];
#pragma unroll
    for (int a = 0; a < 2; ++a)
#pragma unroll
        for (int b = 0; b < 2; ++b)
#pragma unroll
            for (int m = 0; m < 4; ++m)
#pragma unroll
                for (int n = 0; n < 2; ++n) acc[a][b][m][n] = (f32x4){0.f, 0.f, 0.f, 0.f};
    bf16x8 At[4][2], B0[2][2], B1[2][2];
    const char* cA = (const char*)g.A + a_part_bytes(g, cur.pn) + (size_t)cur.pm * tstep; const char* cB = (const char*)g.Bt + (size_t)cur.pn * tstep;
    S.a_ready(cur);
    PG8_STAGE(PG8_SB(0, 0), cB, voffB); PG8_STAGE(PG8_SA(0, 0), cA, voffA); PG8_STAGE(PG8_SB(0, 1), cB + hstep, voffB); PG8_STAGE(PG8_SA(0, 1), cA + hstep, voffA);
    if (wr == 1) PG8_BAR;
    PG8_WAIT_V(4); PG8_BAR;
    PG8_STAGE(PG8_SB(1, 0), cB + kstep, voffB); PG8_STAGE(PG8_SA(1, 0), cA + kstep, voffA); PG8_STAGE(PG8_SB(1, 1), cB + hstep + kstep, voffB);
    PG8_WAIT_V(6); PG8_BAR;
    PG8_STAMP();
    for (;;) {
        const bool has_next = S.next(ui + 1, nxt);
        const char* nA = has_next ? (const char*)g.A + a_part_bytes(g, nxt.pn) + (size_t)nxt.pm * tstep : cA; const char* nB = has_next ? (const char*)g.Bt + (size_t)nxt.pn * tstep : cB;
        for (int t = 0; t < nt; t += 2) {
            const bool last = (t == nt - 2);
            const char* a1 = cA + (size_t)(t + 1) * kstep;
            const char* a2 = last ? nA : cA + (size_t)(t + 2) * kstep; const char* b2 = last ? nB : cB + (size_t)(t + 2) * kstep;
            const char* a3 = a2 + kstep; const char* b3 = b2 + kstep;
            if (last && has_next) S.a_ready(nxt);
            PG8_LDB(B0, 0, 0); PG8_SCHED; PG8_LDA(At, 0, 0); PG8_STAGE(PG8_SA(1, 1), a1 + hstep, voffA);
            PG8_WAIT_L(8); PG8_BAR; PG8_WAIT_L(0); PG8_MMA(0, 0, At, B0); PG8_BAR; PG8_SCHED;
            PG8_LDB(B1, 0, 1); PG8_STAGE(PG8_SB(0, 0), b2, voffB);
            PG8_BAR; PG8_WAIT_L(0); PG8_MMA(0, 1, At, B1); PG8_BAR;
            if constexpr (!TOPHALF) PG8_LDA(At, 0, 1); PG8_STAGE(PG8_SA(0, 0), a2, voffA);
            PG8_BAR; PG8_WAIT_L(0); if constexpr (!TOPHALF) PG8_MMA(1, 0, At, B0); PG8_BAR; PG8_SCHED;
            PG8_STAGE(PG8_SB(0, 1), b2 + hstep, voffB);
            PG8_WAIT_V(6); PG8_BAR; if constexpr (!TOPHALF) PG8_MMA(1, 1, At, B1); PG8_BAR;
            PG8_LDB(B0, 1, 0); PG8_SCHED; PG8_LDA(At, 1, 0); PG8_STAGE(PG8_SA(0, 1), a2 + hstep, voffA);
            PG8_WAIT_L(8); PG8_BAR; PG8_WAIT_L(0); PG8_MMA(0, 0, At, B0); PG8_BAR; PG8_SCHED;
            PG8_LDB(B1, 1, 1); PG8_STAGE(PG8_SB(1, 0), b3, voffB);
            PG8_BAR; PG8_WAIT_L(0); PG8_MMA(0, 1, At, B1); PG8_BAR;
            if constexpr (!TOPHALF) PG8_LDA(At, 1, 1); PG8_STAGE(PG8_SA(1, 0), a3, voffA);
            PG8_BAR; PG8_WAIT_L(0); if constexpr (!TOPHALF) PG8_MMA(1, 0, At, B0); PG8_BAR; PG8_SCHED;
            PG8_STAGE(PG8_SB(1, 1), b3 + hstep, voffB);
            PG8_WAIT_V(6); PG8_BAR; if constexpr (!TOPHALF) PG8_MMA(1, 1, At, B1); PG8_BAR;
        }
        PG8_STAMP();
        if constexpr (!Epi::AFTER_DRAIN) { E(acc, cur, wr, wc, fr, fq); S.done(cur); }
        PG8_STAMP();
        if (!has_next) break;
#pragma unroll
        for (int a = 0; a < 2; ++a)
#pragma unroll
            for (int b = 0; b < 2; ++b)
#pragma unroll
                for (int m = 0; m < 4; ++m)
#pragma unroll
                    for (int n = 0; n < 2; ++n) acc[a][b][m][n] = (f32x4){0.f, 0.f, 0.f, 0.f};
        cur = nxt; cA = nA; cB = nB; ++ui;
    }
    PG8_WAIT_V(0);
    if (wr == 0) PG8_BAR;
    PG8_BAR;
    if constexpr (Epi::AFTER_DRAIN) { E.fused(acc, cur, wr, wc, fr, fq, lds, wid, lane); S.done(cur); }
    PG8_STAMP();
    if (STAMP && wid == 0) { stamps[lane] = lane < nts ? (((unsigned long long)(unsigned)ts_hi << 32) | (unsigned)ts_lo) : 0ull;
        if (lane == 62) stamps[62] = rt_entry; if (lane == 63) stamps[63] = (unsigned long long)wall_clock64(); }
#undef PG8_STAMP
#undef PG8_SA
#undef PG8_SB
#undef PG8_STAGE
#undef PG8_LDA
#undef PG8_LDB
#undef PG8_MMA
#undef PG8_WAIT_V
#undef PG8_WAIT_L
#undef PG8_BAR
#undef PG8_SCHED
}
}
namespace mk {
typedef pg8::Unit Unit;
typedef const pg8::f32x4 (&AccRef)[2][2][4][2];

__device__ __forceinline__ void st_bf8(bf16_t* p, pg8::f32x4 v0, pg8::f32x4 v1) {
    u32x4 w; w.x = cvt_pk_bf16(v0[0], v0[1]); w.y = cvt_pk_bf16(v0[2], v0[3]); w.z = cvt_pk_bf16(v1[0], v1[1]); w.w = cvt_pk_bf16(v1[2], v1[3]);
    *(u32x4*)p = w;
}
__device__ __forceinline__ void st_bf4(bf16_t* p, pg8::f32x4 v) { u32x2 w; w.x = cvt_pk_bf16(v[0], v[1]); w.y = cvt_pk_bf16(v[2], v[3]); *(u32x2*)p = w; }

struct EpiY {
    static constexpr bool PERM = true, AFTER_DRAIN = false;
    bf16_t* O;
    __device__ __forceinline__ void operator()(AccRef acc, const Unit& u, int wr, int wc, int fr, int fq) const {
        const int row0 = u.pm * 256 + wr * 64 + fr, col0 = u.pn * 256 + wc * 32 + 8 * fq;
#pragma unroll
        for (int ai = 0; ai < 2; ++ai)
#pragma unroll
            for (int m = 0; m < 4; ++m) { bf16_t* rowp = O + (size_t)(row0 + ai * 128 + m * 16) * D + col0;
#pragma unroll
                for (int bj = 0; bj < 2; ++bj) st_bf8(rowp + bj * 128, acc[ai][bj][m][0], acc[ai][bj][m][1]); }
    }
};
struct EpiH1 {
    static constexpr bool PERM = true, AFTER_DRAIN = false;
    bf16_t* Y; const float* lbl; int jl;
    __device__ __forceinline__ void operator()(AccRef acc, const Unit& u, int wr, int wc, int fr, int fq) const {
        const int part = u.pn >> 4, colt = (u.pn & 15) * 256;
        const int row0 = u.pm * 256 + wr * 64 + fr, col0 = colt + wc * 32 + 8 * fq;
        if (part == 1) {
#pragma unroll
            for (int bj = 0; bj < 2; ++bj) {
                pg8::f32x4 lbv[2] = {{0.f, 0.f, 0.f, 0.f}, {0.f, 0.f, 0.f, 0.f}};
                if (jl) {
#pragma unroll
                    for (int n = 0; n < 2; ++n) { const pg8::f32x4 l0 = *(const pg8::f32x4*)(lbl + col0 + bj * 128 + 4 * n), l1 = *(const pg8::f32x4*)(lbl + D + col0 + bj * 128 + 4 * n);
#pragma unroll
                        for (int j = 0; j < 4; ++j) lbv[n][j] = sigmoid_f(l1[j] - l0[j]); }
                }
#pragma unroll
                for (int ai = 0; ai < 2; ++ai)
#pragma unroll
                    for (int m = 0; m < 4; ++m) {
                        const int row = row0 + ai * 128 + m * 16;
                        pg8::f32x4 o[2];
#pragma unroll
                        for (int n = 0; n < 2; ++n)
#pragma unroll
                            for (int j = 0; j < 4; ++j) {
                                const float x = acc[ai][bj][m][n][j]; float g;
                                if (jl) { const float l = lbv[n][j]; g = __logf(l + (1.f - l) * sigmoid_f(x)); }
                                else g = fminf(x, 0.f) - __logf(1.f + __expf(-fabsf(x)));
                                o[n][j] = (row < NPAD) ? 0.f : g;
                            }
                        float* gp = (float*)(Y + 3 * (SLOT / 2)) + (size_t)row * D + col0 + bj * 128;
                        *(pg8::f32x4*)gp = o[0]; *(pg8::f32x4*)(gp + 4) = o[1];
                    }
            }
        } else {
            bf16_t* dst = Y + (size_t)(part == 0 ? 0 : (part == 2 ? 1 : 2)) * (SLOT / 2);
#pragma unroll
            for (int ai = 0; ai < 2; ++ai)
#pragma unroll
                for (int m = 0; m < 4; ++m) { bf16_t* rowp = dst + (size_t)(row0 + ai * 128 + m * 16) * D + col0;
#pragma unroll
                    for (int bj = 0; bj < 2; ++bj) st_bf8(rowp + bj * 128, acc[ai][bj][m][0], acc[ai][bj][m][1]); }
        }
    }
};
struct EpiB1 {
    static constexpr bool PERM = false, AFTER_DRAIN = false;
    bf16_t* Y; const float* cs; const float* sn;
    __device__ __forceinline__ void operator()(AccRef acc, const Unit& u, int wr, int wc, int fr, int fq) const {
        const int part = u.pn >> 4, colt = (u.pn & 15) * 256;
        const int row0 = u.pm * 256 + wr * 64 + fr, col0 = colt + wc * 32 + 4 * fq;
        bf16_t* dst = Y + (size_t)part * (SLOT / 2);
        const bool rope = (part < 2) && (wc == 0);
#pragma unroll
        for (int ai = 0; ai < 2; ++ai)
#pragma unroll
            for (int m = 0; m < 4; ++m) {
                const int row = row0 + ai * 128 + m * 16;
                pg8::f32x4 c4 = {1.f, 1.f, 1.f, 1.f}, s4 = {0.f, 0.f, 0.f, 0.f};
                if (rope) { c4 = *(const pg8::f32x4*)(cs + (size_t)row * 16 + 4 * fq); s4 = *(const pg8::f32x4*)(sn + (size_t)row * 16 + 4 * fq); }
                bf16_t* rowp = dst + (size_t)row * D + col0;
#pragma unroll
                for (int bj = 0; bj < 2; ++bj) {
                    const pg8::f32x4 x1 = acc[ai][bj][m][0], x2 = acc[ai][bj][m][1];
                    const pg8::f32x4 y1 = x1 * c4 - x2 * s4, y2 = x2 * c4 + x1 * s4;
                    st_bf4(rowp + bj * 128, y1); st_bf4(rowp + bj * 128 + 16, y2);
                }
            }
    }
};
struct EpiC1 {
    static constexpr bool PERM = true, AFTER_DRAIN = false;
    bf16_t *Y, *T;
    __device__ __forceinline__ void operator()(AccRef acc, const Unit& u, int wr, int wc, int fr, int fq) const {
        const int row0 = u.pm * 256 + wr * 64 + fr;
        if (u.pn < 64) {
            const int part = u.pn >> 4, col0 = (u.pn & 15) * 256 + wc * 32 + 8 * fq;
            bf16_t* dst = Y + (size_t)part * (SLOT / 2);
#pragma unroll
            for (int ai = 0; ai < 2; ++ai)
#pragma unroll
                for (int m = 0; m < 4; ++m) { bf16_t* rowp = dst + (size_t)(row0 + ai * 128 + m * 16) * D + col0;
#pragma unroll
                    for (int bj = 0; bj < 2; ++bj) st_bf8(rowp + bj * 128, acc[ai][bj][m][0], acc[ai][bj][m][1]); }
        } else {
            const int which = u.pn - 64, col0 = which * 128 + wc * 32 + 8 * fq;
#pragma unroll
            for (int ai = 0; ai < 2; ++ai)
#pragma unroll
                for (int m = 0; m < 4; ++m) {
                    pg8::f32x4 v0 = acc[ai][0][m][0], v1 = acc[ai][0][m][1];
                    if (which == 0) {
#pragma unroll
                        for (int j = 0; j < 4; ++j) { v0[j] = 1.f - 2.f / (1.f + __expf(2.f * v0[j])); v1[j] = 1.f - 2.f / (1.f + __expf(2.f * v1[j])); }
                    }
                    st_bf8(T + (size_t)(row0 + ai * 128 + m * 16) * 256 + col0, v0, v1);
                }
        }
    }
};
struct EpiC2 {
    static constexpr bool PERM = true, AFTER_DRAIN = false;
    bf16_t* Y; const float* w0; const float* a0;
    __device__ __forceinline__ void operator()(AccRef acc, const Unit& u, int wr, int wc, int fr, int fq) const {
        const int row0 = u.pm * 256 + wr * 64 + fr;
        const bool isw = u.pn < 16;
        const int col0 = (u.pn & 15) * 256 + wc * 32 + 8 * fq;
        bf16_t* dst = Y + (size_t)(isw ? 4 : 5) * (SLOT / 2); const float* bias = isw ? w0 : a0;
#pragma unroll
        for (int bj = 0; bj < 2; ++bj) {
            const pg8::f32x4 b0 = *(const pg8::f32x4*)(bias + col0 + bj * 128), b1 = *(const pg8::f32x4*)(bias + col0 + bj * 128 + 4);
#pragma unroll
            for (int ai = 0; ai < 2; ++ai)
#pragma unroll
                for (int m = 0; m < 4; ++m) {
                    pg8::f32x4 v0 = acc[ai][bj][m][0] + b0, v1 = acc[ai][bj][m][1] + b1;
#pragma unroll
                    for (int j = 0; j < 4; ++j) {
                        float s0 = sigmoid_f(v0[j]), s1 = sigmoid_f(v1[j]);
                        if (isw) { s0 = __expf(-0.606531f * s0); s1 = __expf(-0.606531f * s1); }
                        v0[j] = s0; v1[j] = s1;
                    }
                    st_bf8(dst + (size_t)(row0 + ai * 128 + m * 16) * D + col0 + bj * 128, v0, v1);
                    __builtin_amdgcn_sched_barrier(0);
                }
        }
    }
};

struct Fr {
    LAS unsigned char* lds; unsigned char* ldsg;
    int tid, lane, wave, G, bid, gw, NGW;
    float* out; unsigned char* ws;
    __device__ __forceinline__ Fr fresh() const { Fr P = *this; asm volatile("" : "+v"(P.tid)); P.lane = P.tid & 63; P.wave = __builtin_amdgcn_readfirstlane(P.tid >> 6); P.gw = P.bid * 8 + P.wave; return P; }
    __device__ __forceinline__ const float* in(int i) const {
        const __attribute__((address_space(4))) unsigned long long* ka = (const __attribute__((address_space(4))) unsigned long long*)__builtin_amdgcn_kernarg_segment_ptr();
        asm volatile("" : "+s"(ka));
        return (const float*)ka[i];
    }
};
__device__ __forceinline__ bf16_t* slotU(const Fr& F, int s) { return (bf16_t*)(F.ws + WS_U + (size_t)s * SLOT); }
__device__ __forceinline__ bf16_t* slotY(const Fr& F, int s) { return (bf16_t*)(F.ws + WS_Y + (size_t)s * SLOT); }
__device__ __forceinline__ float* hrow(const Fr& F, int r) { return r < 64 ? (float*)(F.ws + WS_HMETA) + (size_t)r * D : F.out + (size_t)(r - 64) * D; }

__device__ __forceinline__ void transpose_item(const float* W, int ldw, bf16_t* WT, int ldt, int koff, LAS float* scr, int kb, int nb, int lane) {
    const int k0 = 64 * kb, n0 = 32 * nb;
    float wv[32];
#pragma unroll
    for (int i = 0; i < 32; ++i) wv[i] = W[(size_t)(k0 + 2 * i + (lane >> 5)) * ldw + n0 + (lane & 31)];
#pragma unroll
    for (int i = 0; i < 32; ++i) scr[(2 * i + (lane >> 5)) * 33 + (lane & 31)] = wv[i];
    LDS_WAIT(); asm volatile("" ::: "memory");
    const int c = lane & 7;
#pragma unroll
    for (int j = 0; j < 4; ++j) { const int n = (lane >> 3) + 8 * j; const LAS float* s = scr + (8 * c) * 33 + n;
        u32x4 o; o.x = cvt_pk_bf16(s[0 * 33], s[1 * 33]); o.y = cvt_pk_bf16(s[2 * 33], s[3 * 33]); o.z = cvt_pk_bf16(s[4 * 33], s[5 * 33]); o.w = cvt_pk_bf16(s[6 * 33], s[7 * 33]);
        *(u32x4*)(WT + (size_t)(n0 + n) * ldt + koff + k0 + 8 * c) = o; }
    LDS_WAIT(); asm volatile("" ::: "memory");
}
__device__ __forceinline__ void convert_matrix(const Fr& F, const float* W, int K, int N, bf16_t* WT, int ldt, int koff, int wg_skip = 0) {
    LAS float* scr = (LAS float*)(F.lds + F.wave * 8704);
    const int nblk = N / 32, nitems = (K / 64) * nblk;
    for (int it = F.gw - wg_skip * 8; it < nitems; it += F.NGW - wg_skip * 8) transpose_item(W, N, WT, ldt, koff, scr, it / nblk, it % nblk, F.lane);
}
__device__ __forceinline__ void zero_bytes(const Fr& F, void* p, size_t nbytes) {
    u32x4* q = (u32x4*)p; const size_t n = nbytes / 16; const u32x4 z = {0u, 0u, 0u, 0u};
    for (size_t i = (size_t)F.bid * 512 + F.tid; i < n; i += (size_t)F.G * 512) q[i] = z;
}
__device__ __forceinline__ bf16_t* wtin_of(const Fr& F, int L) { return (bf16_t*)(F.ws + ((L & 1) ? WS_WTINB : WS_WTIN)); }
__device__ __forceinline__ void convert_win(const Fr& F, int L, int wg_skip) {
    const float* src = (L == 0 || L == 3) ? F.in(4) + (size_t)(L ? 1 : 0) * D * 4 * D : (L == 1 ? F.in(8) : F.in(16));
    convert_matrix(F, src, D, 4 * D, wtin_of(F, L), D, 0, wg_skip);
}
__device__ __forceinline__ void convert_layer(const Fr& F, int L, bool with_win) {
    bf16_t* wtin = wtin_of(F, L); bf16_t* wtout = (bf16_t*)(F.ws + WS_WTOUT);
    if (with_win) convert_win(F, L, 0);
    if (L == 0 || L == 3) {
        convert_matrix(F, F.in(7) + (size_t)(L ? 1 : 0) * D * D, D, D, wtout, D, 0);
    } else if (L == 1) {
        convert_matrix(F, F.in(14), D, D, wtout, D, 0);
    } else {
        convert_matrix(F, F.in(28), D, D, wtout, D, 0);
        convert_matrix(F, F.in(18), D, 128, wtin + (size_t)16384 * D, D, 0);
        convert_matrix(F, F.in(21), D, 128, wtin + (size_t)16640 * D, D, 0);
        zero_bytes(F, wtin + (size_t)16512 * D, (size_t)128 * D * 2);
        zero_bytes(F, wtin + (size_t)16768 * D, (size_t)128 * D * 2);
        bf16_t* w2p = (bf16_t*)(F.ws + WS_W2P);
        zero_bytes(F, w2p, (size_t)8192 * 256 * 2);
    }
}
__device__ __forceinline__ void convert_layer2_b(const Fr& F) {
    bf16_t* w2p = (bf16_t*)(F.ws + WS_W2P);
    convert_matrix(F, F.in(19), 128, D, w2p, 256, 0);
    convert_matrix(F, F.in(22), 128, D, w2p + (size_t)4096 * 256, 256, 128);
}

__constant__ float c_inv_freq[16] = {1.0f, 0.44036659598350525f, 0.1939227432012558f, 0.08539710193872452f, 0.03760603070259094f, 0.01656043902039528f, 0.007292664609849453f, 0.0032114458736032248f,
    0.0014142135623842478f, 0.000622772378847003f, 0.00027424818836152554f, 0.00012076973507646471f, 5.318296098266728e-05f, 2.34199997066753e-05f, 1.0313386155758053e-05f, 4.541670477919979e-06f};
__device__ __forceinline__ void rope_table(const Fr& F) {
    float* cs = (float*)(F.ws + WS_ROPE); float* sn = cs + (size_t)R * 16;
    for (int i = F.bid * 512 + F.tid; i < R * 16; i += F.G * 512) {
        const int row = i >> 4, j = i & 15; const int pos = row - NPAD;
        const double ang = (double)(float)((float)pos * c_inv_freq[j]);
        const double k = __builtin_rint(ang * 0.15915494309189535);
        double x = ang - k * 6.283185307179586;
        const double q = __builtin_rint(x * 0.6366197723675814);
        x -= q * 1.5707963267948966;
        const int qi = ((int)q) & 3;
        const double x2 = x * x;
        const double s = x * (1.0 + x2 * (-1.0 / 6 + x2 * (1.0 / 120 + x2 * (-1.0 / 5040 + x2 * (1.0 / 362880 + x2 * (-1.0 / 39916800))))));
        const double c = 1.0 + x2 * (-0.5 + x2 * (1.0 / 24 + x2 * (-1.0 / 720 + x2 * (1.0 / 40320 + x2 * (-1.0 / 3628800 + x2 * (1.0 / 479001600))))));
        double sv, cv;
        if (qi == 0) { sv = s; cv = c; } else if (qi == 1) { sv = c; cv = -s; } else if (qi == 2) { sv = -s; cv = -c; } else { sv = -c; cv = s; }
        cs[i] = (float)cv; sn[i] = (float)sv;
    }
}

typedef const GAS char* gcp; typedef GAS char* gp_;
#define ROW_F32(nm, base, lane) gp_ nm##0 = (gp_)(base) + (lane) * 16 + 4096; gp_ nm##1 = nm##0 + 8192; asm volatile("" : "+v"(nm##0), "+v"(nm##1))
#define AT_F32(nm, j) (*(GAS f32x4*)((j) < 8 ? nm##0 + ((j) - 4) * 1024 : nm##1 + ((j) - 12) * 1024))
#define ROW_BF(nm, base, lane) gp_ nm##0 = (gp_)(base) + (lane) * 8 + 4096; asm volatile("" : "+v"(nm##0))
#define AT_BF(nm, j) (*(GAS u32x2*)(nm##0 + (j) * 512 - 4096))
__device__ __forceinline__ void norm_phase(const Fr& F, int prev, int next, const bf16_t* y, bf16_t* udst, int rlo = 0, int rhi = R, int wg_skip = 0) {
    const float* postg = F.in(3) + (size_t)(prev < 0 ? 0 : prev) * D; const float* preg = F.in(2) + (size_t)(next < 0 ? 0 : next) * D;
    const float* xin = F.in(0); const float* meta = F.in(1);
    for (int r = rlo + F.gw - wg_skip * 8; r < rhi; r += F.NGW - wg_skip * 8) {
        if (r < NPAD || r >= NREAL) {
            if (next >= 0) { ROW_BF(uo, udst + (size_t)r * D, F.lane); const u32x2 z = {0u, 0u};
#pragma unroll
                for (int j = 0; j < 16; ++j) AT_BF(uo, j) = z; }
            continue;
        }
        ROW_BF(hp, (bf16_t*)(F.ws + WS_HB) + (size_t)r * D, F.lane);
        f32x4 hv[16];
        if (prev < 0) {
            const float* src = r < 64 ? meta + (size_t)(r - NPAD) * D : xin + (size_t)(r - 64) * D;
            ROW_F32(sp, src, F.lane);
#pragma unroll
            for (int j = 0; j < 16; ++j) hv[j] = AT_F32(sp, j);
        } else {
            ROW_BF(yp, y + (size_t)r * D, F.lane); ROW_F32(gp, postg, F.lane);
            u32x2 yv[16], hb[16]; float ss = 0.f;
#pragma unroll
            for (int j = 0; j < 16; ++j) { yv[j] = AT_BF(yp, j); hb[j] = AT_BF(hp, j); }
#pragma unroll
            for (int j = 0; j < 16; ++j) { const float a = bflo(yv[j].x), b = bfhi(yv[j].x), c = bflo(yv[j].y), d = bfhi(yv[j].y); ss += (a * a + b * b) + (c * c + d * d); }
#pragma unroll
            for (int j = 0; j < 16; ++j) asm volatile("" : "+v"(yv[j].x), "+v"(yv[j].y));
            const float rs = __builtin_amdgcn_rsqf(wave_sum(ss) * (1.f / D) + 1e-6f);
#pragma unroll
            for (int j = 0; j < 16; ++j) { const f32x4 g = AT_F32(gp, j);
                hv[j].x = bflo(hb[j].x) + bflo(yv[j].x) * rs * g.x; hv[j].y = bfhi(hb[j].x) + bfhi(yv[j].x) * rs * g.y; hv[j].z = bflo(hb[j].y) + bflo(yv[j].y) * rs * g.z; hv[j].w = bfhi(hb[j].y) + bfhi(yv[j].y) * rs * g.w; }
        }
        if (next < 0) {
            if (r >= 64) { ROW_F32(op, F.out + (size_t)(r - 64) * D, F.lane);
#pragma unroll
                for (int j = 0; j < 16; ++j) AT_F32(op, j) = hv[j];
            }
            continue;
        }
        float s2 = 0.f;
#pragma unroll
        for (int j = 0; j < 16; ++j) { u32x2 w_; w_.x = cvt_pk_bf16(hv[j].x, hv[j].y); w_.y = cvt_pk_bf16(hv[j].z, hv[j].w); AT_BF(hp, j) = w_; s2 += (hv[j].x * hv[j].x + hv[j].y * hv[j].y) + (hv[j].z * hv[j].z + hv[j].w * hv[j].w); }
        const float rs2 = __builtin_amdgcn_rsqf(wave_sum(s2) * (1.f / D) + 1e-6f);
        ROW_BF(uo, udst + (size_t)r * D, F.lane); ROW_F32(pg, preg, F.lane);
#pragma unroll
        for (int j = 0; j < 16; ++j) { const f32x4 g = AT_F32(pg, j); u32x2 w; w.x = cvt_pk_bf16(hv[j].x * rs2 * g.x, hv[j].y * rs2 * g.y); w.y = cvt_pk_bf16(hv[j].z * rs2 * g.z, hv[j].w * rs2 * g.w); AT_BF(uo, j) = w; }
    }
}
__device__ __forceinline__ void mix_phase(const Fr& F, const bf16_t* u) {
    const float* mu = F.in(15);
    for (int r = F.gw; r < R; r += F.NGW) {
        const bool real = (r >= NPAD && r < NREAL);
        u32x2 cur[16], prv[16];
        const u32x2 z = {0u, 0u};
        { ROW_BF(cp, u + (size_t)r * D, F.lane); ROW_BF(pp, u + (size_t)(r > 0 ? r - 1 : 0) * D, F.lane);
#pragma unroll
          for (int j = 0; j < 16; ++j) { cur[j] = real ? AT_BF(cp, j) : z; prv[j] = (real && r > NPAD) ? AT_BF(pp, j) : z; } }
#pragma unroll 1
        for (int s = 0; s < 6; ++s) {
            ROW_BF(op, slotU(F, s) + (size_t)r * D, F.lane); ROW_F32(mp, mu + (size_t)s * D, F.lane);
#pragma unroll
            for (int j = 0; j < 16; ++j) {
                const f32x4 m = AT_F32(mp, j);
                const float c0 = bflo(cur[j].x), c1 = bfhi(cur[j].x), c2 = bflo(cur[j].y), c3 = bfhi(cur[j].y);
                const float p0 = bflo(prv[j].x), p1 = bfhi(prv[j].x), p2 = bflo(prv[j].y), p3 = bfhi(prv[j].y);
                u32x2 w; w.x = cvt_pk_bf16(c0 + (p0 - c0) * m.x, c1 + (p1 - c1) * m.y); w.y = cvt_pk_bf16(c2 + (p2 - c2) * m.z, c3 + (p3 - c3) * m.w);
                AT_BF(op, j) = real ? w : z;
            }
        }
    }
}
}
namespace mk {
constexpr int H_QE = 0, H_KE = 17408, H_KET = 34816, H_VT = 53248, H_PM = 71680, H_STB = 80896, H_VEC = 115712;
__device__ __forceinline__ bf16x8 ldfrag(const LAS unsigned char* base, int stride_b, int rb, int ks, int lane) {
    return *(const LAS bf16x8*)(base + (16 * rb + (lane & 15)) * stride_b + (32 * ks + 8 * (lane >> 4)) * 2);
}
template <bool OUT>
__device__ __forceinline__ void hgrn_phase(const Fr& F, int jl) {
    const bf16_t* Q = slotY(F, 0); const bf16_t* V = slotY(F, 1); const bf16_t* GT = slotY(F, 2); const float* Gg = (const float*)slotY(F, 3);
    bf16_t* Z = slotU(F, 0);
    float* HE = (float*)(F.ws + WS_HE); float* HLD = (float*)(F.ws + WS_HLOGD);
    const float* gn = F.in(6) + (size_t)jl * 128;
    LAS unsigned char* L = F.lds;
    LAS float* qtot = (LAS float*)(L + H_VEC); LAS float* ebm = qtot + 512; LAS float* ebl = ebm + 128;
    const int tid = F.tid, lane = F.lane, w = F.wave;
    const int d = tid & 127, qt = tid >> 7;
    for (int unit = F.bid; unit < 256; unit += F.G) {
        const int h = unit >> 3, seg = unit & 7;
        if (!OUT && seg == 7) continue;
        const int c0 = seg == 0 ? 0 : 33 + 32 * (seg - 1), c1 = c0 + (seg == 0 ? 33 : 32);
        f32x4 S[8];
#pragma unroll
        for (int i = 0; i < 8; ++i) S[i] = (f32x4){0.f, 0.f, 0.f, 0.f};
        if (OUT) {
            for (int j = 0; j < seg; ++j) {
                const float* ld = HLD + (size_t)(h * 8 + j) * 128; const float* e = HE + ((size_t)(h * 8 + j) * 512 + tid) * 32;
#pragma unroll
                for (int di = 0; di < 8; ++di) { const f32x4 l4 = *(const f32x4*)(ld + 16 * di + 4 * (lane >> 4)); const f32x4 e4 = *(const f32x4*)(e + 4 * di);
                    S[di].x = S[di].x * __expf(l4.x) + e4.x; S[di].y = S[di].y * __expf(l4.y) + e4.y; S[di].z = S[di].z * __expf(l4.z) + e4.z; S[di].w = S[di].w * __expf(l4.w) + e4.w; }
            }
        }
        float logD = 0.f;
        float g[16]; bf16_t qv[16], vv[16]; u32x4 gt0 = {0u, 0u, 0u, 0u}, gt1 = gt0, ngt0 = gt0, ngt1 = gt0;
#define HG_LOAD(cc) do { const int rowb_ = 64 * (cc) + 16 * qt; const size_t colb_ = (size_t)h * 128 + d; \
            _Pragma("unroll") for (int i = 0; i < 16; ++i) { g[i] = Gg[(size_t)(rowb_ + i) * D + colb_]; vv[i] = V[(size_t)(rowb_ + i) * D + colb_]; if (OUT) qv[i] = Q[(size_t)(rowb_ + i) * D + colb_]; } \
            if (OUT) { const bf16_t* gp_ = GT + (size_t)(64 * (cc) + (tid >> 3)) * D + h * 128 + 16 * (tid & 7); ngt0 = *(const u32x4*)gp_; ngt1 = *(const u32x4*)(gp_ + 8); } } while (0)
        HG_LOAD(c0);
        for (int c = c0; c < c1; ++c) {
            if (OUT) { gt0 = ngt0; gt1 = ngt1; }
            float f[16]; float run = 0.f;
#pragma unroll
            for (int i = 0; i < 16; ++i) { run += g[i]; f[i] = __expf(g[i]); }
            qtot[qt * 128 + d] = run;
            __syncthreads();
            const float t0 = qtot[d], t1 = qtot[128 + d], t2 = qtot[256 + d], t3 = qtot[384 + d];
            const float off = qt == 0 ? 0.f : (qt == 1 ? t0 : (qt == 2 ? t0 + t1 : t0 + t1 + t2));
            const float bm = t0 + t1, bl = (t0 + t1) + (t2 + t3);
            if (qt == 0) { ebm[d] = __expf(bm); ebl[d] = __expf(bl); logD += bl; }
            {
                unsigned kt[8], vt[8];
                const float ebd = __expf(bl - bm);
                float y = __expf(bm - (run + off)), kx_hi = 0.f;
#pragma unroll
                for (int i = 15; i >= 0; --i) {
                    const float ky = (1.f - f[i]) * y;
                    if (OUT) *(LAS bf16_t*)(L + H_KE + ((16 * qt + i) * 136 + d) * 2) = f2bf(ky);
                    const float kx = ky * ebd;
                    if (i & 1) kx_hi = kx; else kt[i >> 1] = cvt_pk_bf16(kx, kx_hi);
                    y *= f[i];
                }
                if (OUT) {
                    float e = __expf(off - bm);
#pragma unroll
                    for (int i = 0; i < 16; ++i) { e *= f[i]; *(LAS bf16_t*)(L + H_QE + ((16 * qt + i) * 136 + d) * 2) = f2bf(bf2f(qv[i]) * e); }
                }
#pragma unroll
                for (int i = 0; i < 16; i += 2) vt[i >> 1] = (unsigned)vv[i] | ((unsigned)vv[i + 1] << 16);
                LAS u32x4* kp = (LAS u32x4*)(L + H_KET + (d * 72 + 16 * qt) * 2); kp[0] = (u32x4){kt[0], kt[1], kt[2], kt[3]}; kp[1] = (u32x4){kt[4], kt[5], kt[6], kt[7]};
                LAS u32x4* vp = (LAS u32x4*)(L + H_VT + (d * 72 + 16 * qt) * 2); vp[0] = (u32x4){vt[0], vt[1], vt[2], vt[3]}; vp[1] = (u32x4){vt[4], vt[5], vt[6], vt[7]};
            }
            if (c + 1 < c1) HG_LOAD(c + 1);
            __syncthreads();
            if (OUT) {
#pragma unroll
                for (int di = 0; di < 8; ++di) { const f32x4 m4 = *(const LAS f32x4*)(ebm + 16 * di + 4 * (lane >> 4)); u32x2 o; o.x = cvt_pk_bf16(S[di].x * m4.x, S[di].y * m4.y); o.y = cvt_pk_bf16(S[di].z * m4.z, S[di].w * m4.w);
                    *(LAS u32x2*)(L + H_STB + ((16 * w + (lane & 15)) * 136 + 16 * di + 4 * (lane >> 4)) * 2) = o; }
                const int ti = w >> 1;
#pragma unroll
                for (int s2 = 0; s2 < 2; ++s2) { const int si = 2 * (w & 1) + s2; f32x4 p = {0.f, 0.f, 0.f, 0.f};
                    if (si <= ti) {
#pragma unroll
                        for (int ks = 0; ks < 4; ++ks) p = __builtin_amdgcn_mfma_f32_16x16x32_bf16(ldfrag(L + H_QE, 272, ti, ks, lane), ldfrag(L + H_KE, 272, si, ks, lane), p, 0, 0, 0);
                    }
                    const int sidx = 16 * si + (lane & 15);
#pragma unroll
                    for (int jj = 0; jj < 4; ++jj) { const int tidx = 16 * ti + 4 * (lane >> 4) + jj; *(LAS bf16_t*)(L + H_PM + (tidx * 72 + sidx) * 2) = f2bf(sidx <= tidx ? p[jj] : 0.f); }
                }
                __syncthreads();
            }
            f32x4 O[4];
            if (OUT) {
#pragma unroll
                for (int ti = 0; ti < 4; ++ti) O[ti] = (f32x4){0.f, 0.f, 0.f, 0.f};
#pragma unroll
                for (int ks = 0; ks < 2; ++ks) { const bf16x8 bv = ldfrag(L + H_VT, 144, w, ks, lane);
#pragma unroll
                    for (int ti = 0; ti < 4; ++ti) O[ti] = __builtin_amdgcn_mfma_f32_16x16x32_bf16(ldfrag(L + H_PM, 144, ti, ks, lane), bv, O[ti], 0, 0, 0); }
#pragma unroll
                for (int ks = 0; ks < 4; ++ks) { const bf16x8 bs = ldfrag(L + H_STB, 272, w, ks, lane);
#pragma unroll
                    for (int ti = 0; ti < 4; ++ti) O[ti] = __builtin_amdgcn_mfma_f32_16x16x32_bf16(ldfrag(L + H_QE, 272, ti, ks, lane), bs, O[ti], 0, 0, 0); }
            }
            {
                const bf16x8 bv0 = ldfrag(L + H_VT, 144, w, 0, lane), bv1 = ldfrag(L + H_VT, 144, w, 1, lane);
#pragma unroll
                for (int di = 0; di < 8; ++di) { const f32x4 l4 = *(const LAS f32x4*)(ebl + 16 * di + 4 * (lane >> 4)); S[di] = S[di] * l4;
                    S[di] = __builtin_amdgcn_mfma_f32_16x16x32_bf16(ldfrag(L + H_KET, 144, di, 0, lane), bv0, S[di], 0, 0, 0);
                    S[di] = __builtin_amdgcn_mfma_f32_16x16x32_bf16(ldfrag(L + H_KET, 144, di, 1, lane), bv1, S[di], 0, 0, 0); }
            }
            if (OUT) {
                __syncthreads();
                LAS float* Ot = (LAS float*)(L + H_STB);
#pragma unroll
                for (int ti = 0; ti < 4; ++ti)
#pragma unroll
                    for (int jj = 0; jj < 4; ++jj) Ot[(16 * ti + 4 * (lane >> 4) + jj) * 132 + 16 * w + (lane & 15)] = O[ti][jj];
                __syncthreads();
                const int t = tid >> 3, eg = tid & 7;
                f32x4 o4[4]; float ss = 0.f;
#pragma unroll
                for (int i = 0; i < 4; ++i) { o4[i] = *(const LAS f32x4*)(Ot + t * 132 + 16 * eg + 4 * i); ss += (o4[i].x * o4[i].x + o4[i].y * o4[i].y) + (o4[i].z * o4[i].z + o4[i].w * o4[i].w); }
                ss = red8(ss);
                const float rs = __builtin_amdgcn_rsqf(ss * (1.f / 128.f) + 1e-6f);
                const unsigned gw_[8] = {gt0.x, gt0.y, gt0.z, gt0.w, gt1.x, gt1.y, gt1.z, gt1.w};
                unsigned zo[8];
#pragma unroll
                for (int i = 0; i < 4; ++i) { const f32x4 g4 = *(const f32x4*)(gn + 16 * eg + 4 * i);
                    const float a0 = o4[i].x * rs * g4.x * silu_f(bflo(gw_[2 * i])), a1 = o4[i].y * rs * g4.y * silu_f(bfhi(gw_[2 * i]));
                    const float a2 = o4[i].z * rs * g4.z * silu_f(bflo(gw_[2 * i + 1])), a3 = o4[i].w * rs * g4.w * silu_f(bfhi(gw_[2 * i + 1]));
                    zo[2 * i] = cvt_pk_bf16(a0, a1); zo[2 * i + 1] = cvt_pk_bf16(a2, a3); }
                bf16_t* zp = Z + (size_t)(64 * c + t) * D + h * 128 + 16 * eg;
                *(u32x4*)zp = (u32x4){zo[0], zo[1], zo[2], zo[3]}; *(u32x4*)(zp + 8) = (u32x4){zo[4], zo[5], zo[6], zo[7]};
            } else {
                __syncthreads();
            }
        }
        if (!OUT) {
            float* e = HE + ((size_t)(h * 8 + seg) * 512 + tid) * 32;
#pragma unroll
            for (int di = 0; di < 8; ++di) *(f32x4*)(e + 4 * di) = S[di];
            if (qt == 0) HLD[(size_t)(h * 8 + seg) * 128 + d] = logD;
        }
        __syncthreads();
    }
#undef HG_LOAD
}

namespace att {
constexpr int NW = 8, QBLK = 32, KVBLK = 64, LDQ = 4096, LDO = 8192;
constexpr float SCALE = 0.088388347648318440f, THR = 8.f;
constexpr int SHM_V = 16384, SHM_K = 16384, SHM = 2 * SHM_V + 2 * SHM_K + NW * 64 * 4;
#define KSWZ(row, colB) ((row) * 256 + ((colB) ^ (((row) & 7) << 4)))
#define SBAR() __builtin_amdgcn_sched_barrier(0)
__device__ __forceinline__ int crow(int r, int hi) { return (r & 3) + 8 * (r >> 2) + 4 * hi; }
__device__ __forceinline__ void partialSM(f32x16& p0, f32x16& p1, float& m_reg, float& mn, float& alpha) {
    constexpr float C = SCALE * 1.4426950408889634f;
    float pmax = p0[0];
#pragma unroll
    for (int r = 1; r < 16; ++r) pmax = fmaxf(pmax, p0[r]);
#pragma unroll
    for (int r = 0; r < 16; ++r) pmax = fmaxf(pmax, p1[r]);
    { auto rr = __builtin_amdgcn_permlane32_swap(__float_as_uint(pmax), __float_as_uint(pmax), false, false);
      pmax = fmaxf(__uint_as_float(rr[0]), __uint_as_float(rr[1])); }
    if (__builtin_expect(__all(pmax - m_reg <= THR / SCALE), 1)) { mn = m_reg; alpha = 1.f; }
    else { mn = fmaxf(m_reg, pmax); alpha = __builtin_amdgcn_exp2f((m_reg - mn) * C); m_reg = mn; }
    const float mnC = -mn * C;
#pragma unroll
    for (int r = 0; r < 16; ++r) p0[r] = fmaf(p0[r], C, mnC);
#pragma unroll
    for (int r = 0; r < 16; ++r) p1[r] = fmaf(p1[r], C, mnC);
#pragma unroll
    for (int r = 0; r < 16; ++r) p0[r] = __builtin_amdgcn_exp2f(p0[r]);
}
__device__ __forceinline__ void finishSM(f32x16& p0, f32x16& p1, float alpha, float& l_reg, bf16x8& pa0, bf16x8& pa1, bf16x8& pa2, bf16x8& pa3) {
#pragma unroll
    for (int r = 0; r < 16; ++r) p1[r] = __builtin_amdgcn_exp2f(p1[r]);
    float ps = 0;
#pragma unroll
    for (int r = 0; r < 16; ++r) ps += p0[r];
#pragma unroll
    for (int r = 0; r < 16; ++r) ps += p1[r];
    { auto rr = __builtin_amdgcn_permlane32_swap(__float_as_uint(ps), __float_as_uint(ps), false, false);
      ps = __uint_as_float(rr[0]) + __uint_as_float(rr[1]); }
    l_reg = l_reg * alpha + ps;
#define PK4(P, BASE, OUT) do { unsigned a0 = cvt_pk_bf16(P[BASE + 0], P[BASE + 1]), a1 = cvt_pk_bf16(P[BASE + 2], P[BASE + 3]);   \
    unsigned b0 = cvt_pk_bf16(P[BASE + 4], P[BASE + 5]), b1 = cvt_pk_bf16(P[BASE + 6], P[BASE + 7]);                              \
    auto r0 = __builtin_amdgcn_permlane32_swap(a0, b0, false, false); auto r1 = __builtin_amdgcn_permlane32_swap(a1, b1, false, false); \
    u32x4 w = {r0[0], r1[0], r0[1], r1[1]}; OUT = *reinterpret_cast<bf16x8*>(&w); } while (0)
    PK4(p0, 0, pa0); PK4(p0, 8, pa1); PK4(p1, 0, pa2); PK4(p1, 8, pa3);
#undef PK4
}
__device__ __forceinline__ void qkt(f32x16& p0, f32x16& p1, const char* Ks, const bf16x8* qr, int r32, int hi) {
    p0 = f32x16{}; p1 = f32x16{};
#pragma unroll
    for (int d0 = 0; d0 < 8; ++d0) { const int cb = (d0 * 16 + hi * 8) * 2;
        const bf16x8 b0 = *reinterpret_cast<const bf16x8*>(Ks + KSWZ(r32, cb));
        const bf16x8 b1 = *reinterpret_cast<const bf16x8*>(Ks + KSWZ(32 + r32, cb));
        p0 = __builtin_amdgcn_mfma_f32_32x32x16_bf16(b0, qr[d0], p0, 0, 0, 0);
        p1 = __builtin_amdgcn_mfma_f32_32x32x16_bf16(b1, qr[d0], p1, 0, 0, 0); }
}
__device__ __forceinline__ int v_st(int k, int c) { const int kk = (k & ~0xC) | ((k & 4) << 1) | ((k & 8) >> 1); return ((kk >> 3) * 4 + (c >> 5)) * 512 + ((kk & 7) * 32 + (c & 31)) * 2; }
__device__ __forceinline__ int v_rd_base(int lane) { return ((lane & 3) << 3) | (((lane >> 2) & 3) << 6) | (((lane >> 4) & 1) << 5) | (((lane >> 5) & 1) << 8); }
constexpr int v_rd_off(int d0, int ks, int half) { return d0 * 512 + ks * 4096 + half * 2048; }
template <int OFF> __device__ __forceinline__ s16x4 tr_read(int vb) {
    s16x4 r; asm volatile("ds_read_b64_tr_b16 %0, %1 offset:%2" : "=&v"(r) : "v"(vb), "i"(OFF) : "memory"); return r;
}
template <int D0> __device__ __forceinline__ void pv_one(f32x16& od, int vb, bf16x8 pa0, bf16x8 pa1, bf16x8 pa2, bf16x8 pa3) {
    const s16x4 l0 = tr_read<v_rd_off(D0, 0, 0)>(vb), h0 = tr_read<v_rd_off(D0, 0, 1)>(vb), l1 = tr_read<v_rd_off(D0, 1, 0)>(vb), h1 = tr_read<v_rd_off(D0, 1, 1)>(vb);
    const s16x4 l2 = tr_read<v_rd_off(D0, 2, 0)>(vb), h2 = tr_read<v_rd_off(D0, 2, 1)>(vb), l3 = tr_read<v_rd_off(D0, 3, 0)>(vb), h3 = tr_read<v_rd_off(D0, 3, 1)>(vb);
    asm volatile("s_waitcnt lgkmcnt(0)" ::: "memory"); SBAR();
#define PK(Lo, Hi) (bf16x8){Lo[0], Lo[1], Lo[2], Lo[3], Hi[0], Hi[1], Hi[2], Hi[3]}
    od = __builtin_amdgcn_mfma_f32_32x32x16_bf16(pa0, PK(l0, h0), od, 0, 0, 0);
    od = __builtin_amdgcn_mfma_f32_32x32x16_bf16(pa1, PK(l1, h1), od, 0, 0, 0);
    od = __builtin_amdgcn_mfma_f32_32x32x16_bf16(pa2, PK(l2, h2), od, 0, 0, 0);
    od = __builtin_amdgcn_mfma_f32_32x32x16_bf16(pa3, PK(l3, h3), od, 0, 0, 0);
#undef PK
}
__device__ __forceinline__ void pv_d0(f32x16* o, int vb, bf16x8 pa0, bf16x8 pa1, bf16x8 pa2, bf16x8 pa3) {
    pv_one<0>(o[0], vb, pa0, pa1, pa2, pa3); pv_one<1>(o[1], vb, pa0, pa1, pa2, pa3); pv_one<2>(o[2], vb, pa0, pa1, pa2, pa3); pv_one<3>(o[3], vb, pa0, pa1, pa2, pa3);
}
__device__ __forceinline__ void mask_tile(f32x16& p0, f32x16& p1, int j, int lim) {
    if (j > lim) {
#pragma unroll
        for (int r = 0; r < 16; ++r) { p0[r] = -1e30f; p1[r] = -1e30f; }
    } else if (j == 0) {
#pragma unroll
        for (int r = 0; r < 16; ++r) p0[r] = -1e30f;
#pragma unroll
        for (int r = 0; r < 8; ++r) p1[r] = -1e30f;
    }
}
__device__ __forceinline__ void unit(const bf16_t* __restrict__ Qb, const bf16_t* __restrict__ Kh, const bf16_t* __restrict__ Vh, bf16_t* __restrict__ Ob, int NT, int lim, char* lds) {
    int tid_ = threadIdx.x; asm volatile("" : "+v"(tid_));
    const int tid = tid_, wid = tid >> 6, lane = tid & 63, r32 = lane & 31, hi = lane >> 5;
    char* V_lds = lds; char* K_lds = lds + 2 * SHM_V;
    float* wsf = (float*)(lds + 2 * SHM_V + 2 * SHM_K) + wid * 64; float* li_l = wsf; float* al_l = wsf + 32;
    float m_reg = -1e30f, l_reg = 0; f32x16 o[4] = {}; bf16x8 qr[8];
    const bf16_t* Qw = Qb + (long)(wid * QBLK + r32) * LDQ + hi * 8;
#pragma unroll
    for (int d0 = 0; d0 < 8; ++d0) qr[d0] = *reinterpret_cast<const bf16x8*>(Qw + d0 * 16);
    const int sr = tid >> 4, sc = (tid & 15) * 8, vst0 = v_st(sr, sc), vst1 = v_st(32 + sr, sc);
    const int vb0 = (int)(uintptr_t)V_lds + v_rd_base(lane);
    struct { bf16x8 vs0, vs1, ks0, ks1; } sr_[2];
#define SLOAD(i, k0) do { sr_[i].vs0 = *reinterpret_cast<const bf16x8*>(&Vh[(long)((k0) + sr) * LDQ + sc]); sr_[i].vs1 = *reinterpret_cast<const bf16x8*>(&Vh[(long)((k0) + 32 + sr) * LDQ + sc]); \
    sr_[i].ks0 = *reinterpret_cast<const bf16x8*>(&Kh[(long)((k0) + sr) * LDQ + sc]); sr_[i].ks1 = *reinterpret_cast<const bf16x8*>(&Kh[(long)((k0) + 32 + sr) * LDQ + sc]); } while (0)
#define SWRITE(b, i) do { *(bf16x8*)(V_lds + (b) * SHM_V + vst0) = sr_[i].vs0;          \
    *(bf16x8*)(V_lds + (b) * SHM_V + vst1) = sr_[i].vs1; int kc = sc * 2;               \
    *(bf16x8*)(K_lds + (b) * SHM_K + KSWZ(sr, kc)) = sr_[i].ks0;                       \
    *(bf16x8*)(K_lds + (b) * SHM_K + KSWZ(32 + sr, kc)) = sr_[i].ks1; } while (0)
#define SWAIT() asm volatile("s_waitcnt vmcnt(4)" ::: "memory")
#define RESC(a) do { if (__any((a) < 1.f)) { if (hi == 0) al_l[r32] = (a); asm volatile("s_waitcnt lgkmcnt(0)" ::: "memory"); \
    _Pragma("unroll") for (int d = 0; d < 4; ++d) _Pragma("unroll") for (int r = 0; r < 16; ++r) o[d][r] *= al_l[crow(r, hi)]; } } while (0)
    f32x16 pA0, pA1, pB0, pB1; float mnA, mnB, alA, alB; bf16x8 pa0, pa1, pa2, pa3;
    constexpr int SE = 0, SO = 1;
    SLOAD(SE, 0); asm volatile("s_waitcnt vmcnt(0)" ::: "memory"); SWRITE(0, SE); __syncthreads();
    qkt(pA0, pA1, K_lds, qr, r32, hi); mask_tile(pA0, pA1, 0, lim); partialSM(pA0, pA1, m_reg, mnA, alA);
    SLOAD(SO, KVBLK); if (2 < NT) SLOAD(SE, 2 * KVBLK);
    SWAIT(); SWRITE(1, SO); __syncthreads();
    for (int j = 1; j + 1 < NT; j += 2) {
        SBAR(); qkt(pB0, pB1, K_lds + SHM_K, qr, r32, hi);
        finishSM(pA0, pA1, alA, l_reg, pa0, pa1, pa2, pa3); SBAR();
        SLOAD(SO, (j + 2) * KVBLK); SBAR();
        pv_d0(o, vb0, pa0, pa1, pa2, pa3); mask_tile(pB0, pB1, j, lim); partialSM(pB0, pB1, m_reg, mnB, alB);
        __syncthreads(); SWAIT(); SWRITE(0, SE);
        RESC(alB); __syncthreads();
        SBAR(); qkt(pA0, pA1, K_lds, qr, r32, hi);
        finishSM(pB0, pB1, alB, l_reg, pa0, pa1, pa2, pa3); SBAR();
        if (j + 3 < NT) SLOAD(SE, (j + 3) * KVBLK); SBAR();
        pv_d0(o, vb0 + SHM_V, pa0, pa1, pa2, pa3); mask_tile(pA0, pA1, j + 1, lim); partialSM(pA0, pA1, m_reg, mnA, alA);
        __syncthreads(); SWAIT(); SWRITE(1, SO);
        RESC(alA); __syncthreads();
    }
    SBAR(); qkt(pB0, pB1, K_lds + SHM_K, qr, r32, hi);
    finishSM(pA0, pA1, alA, l_reg, pa0, pa1, pa2, pa3); SBAR();
    pv_d0(o, vb0, pa0, pa1, pa2, pa3); mask_tile(pB0, pB1, NT - 1, lim); partialSM(pB0, pB1, m_reg, mnB, alB);
    __syncthreads(); RESC(alB);
    finishSM(pB0, pB1, alB, l_reg, pa0, pa1, pa2, pa3); SBAR();
    pv_d0(o, vb0 + SHM_V, pa0, pa1, pa2, pa3);
    if (hi == 0) li_l[r32] = l_reg; asm volatile("s_waitcnt lgkmcnt(0)" ::: "memory");
    float rli[16];
#pragma unroll
    for (int r = 0; r < 16; ++r) rli[r] = __builtin_amdgcn_rcpf(li_l[crow(r, hi)]);
    bf16_t* Ow = Ob + (long)(wid * QBLK) * LDO;
#pragma unroll
    for (int r = 0; r < 16; ++r) { const int orow = crow(r, hi);
#pragma unroll
        for (int d0 = 0; d0 < 4; ++d0) Ow[(long)orow * LDO + d0 * 32 + r32] = f2bf(o[d0][r] * rli[r]); }
    __syncthreads();
#undef SLOAD
#undef SWRITE
#undef SWAIT
#undef RESC
}
}


namespace att2 {
using namespace att;
constexpr int KB = 16384, VB = 32768, OFF_V = 3 * KB, OFF_W = OFF_V + 3 * VB, SHM2 = OFF_W + NW * 64 * 4;
constexpr int v2_rd_off(int d0, int ks, int half) { return d0 * 512 + ks * 8192 + half * 4096; }
template <int D0> __device__ __forceinline__ void pv2_one(f32x16& od, int vb, bf16x8 pa0, bf16x8 pa1, bf16x8 pa2, bf16x8 pa3) {
    const s16x4 l0 = tr_read<v2_rd_off(D0, 0, 0)>(vb), h0 = tr_read<v2_rd_off(D0, 0, 1)>(vb), l1 = tr_read<v2_rd_off(D0, 1, 0)>(vb), h1 = tr_read<v2_rd_off(D0, 1, 1)>(vb);
    const s16x4 l2 = tr_read<v2_rd_off(D0, 2, 0)>(vb), h2 = tr_read<v2_rd_off(D0, 2, 1)>(vb), l3 = tr_read<v2_rd_off(D0, 3, 0)>(vb), h3 = tr_read<v2_rd_off(D0, 3, 1)>(vb);
    asm volatile("s_waitcnt lgkmcnt(0)" ::: "memory"); SBAR();
#define PK(Lo, Hi) (bf16x8){Lo[0], Lo[1], Lo[2], Lo[3], Hi[0], Hi[1], Hi[2], Hi[3]}
    od = __builtin_amdgcn_mfma_f32_32x32x16_bf16(pa0, PK(l0, h0), od, 0, 0, 0);
    od = __builtin_amdgcn_mfma_f32_32x32x16_bf16(pa1, PK(l1, h1), od, 0, 0, 0);
    od = __builtin_amdgcn_mfma_f32_32x32x16_bf16(pa2, PK(l2, h2), od, 0, 0, 0);
    od = __builtin_amdgcn_mfma_f32_32x32x16_bf16(pa3, PK(l3, h3), od, 0, 0, 0);
#undef PK
}
struct VFrag { s16x4 l0, h0, l1, h1, l2, h2, l3, h3; };
template <int D0> __device__ __forceinline__ void v2_load(VFrag& f, int vb) {
    f.l0 = tr_read<v2_rd_off(D0, 0, 0)>(vb); f.h0 = tr_read<v2_rd_off(D0, 0, 1)>(vb); f.l1 = tr_read<v2_rd_off(D0, 1, 0)>(vb); f.h1 = tr_read<v2_rd_off(D0, 1, 1)>(vb);
    f.l2 = tr_read<v2_rd_off(D0, 2, 0)>(vb); f.h2 = tr_read<v2_rd_off(D0, 2, 1)>(vb); f.l3 = tr_read<v2_rd_off(D0, 3, 0)>(vb); f.h3 = tr_read<v2_rd_off(D0, 3, 1)>(vb);
}
__device__ __forceinline__ void v2_mma(f32x16& od, const VFrag& f, bf16x8 pa0, bf16x8 pa1, bf16x8 pa2, bf16x8 pa3) {
#define PK(Lo, Hi) (bf16x8){Lo[0], Lo[1], Lo[2], Lo[3], Hi[0], Hi[1], Hi[2], Hi[3]}
    od = __builtin_amdgcn_mfma_f32_32x32x16_bf16(pa0, PK(f.l0, f.h0), od, 0, 0, 0);
    od = __builtin_amdgcn_mfma_f32_32x32x16_bf16(pa1, PK(f.l1, f.h1), od, 0, 0, 0);
    od = __builtin_amdgcn_mfma_f32_32x32x16_bf16(pa2, PK(f.l2, f.h2), od, 0, 0, 0);
    od = __builtin_amdgcn_mfma_f32_32x32x16_bf16(pa3, PK(f.l3, f.h3), od, 0, 0, 0);
#undef PK
}
struct VSet { s16x4 l0, h0, l1, h1, l2, h2, l3, h3; };
template <int G, int KS> __device__ __forceinline__ void vs_load(VSet& f, int vb) {
    f.l0 = tr_read<v2_rd_off(4 * G + 0, KS, 0)>(vb); f.h0 = tr_read<v2_rd_off(4 * G + 0, KS, 1)>(vb); f.l1 = tr_read<v2_rd_off(4 * G + 1, KS, 0)>(vb); f.h1 = tr_read<v2_rd_off(4 * G + 1, KS, 1)>(vb);
    f.l2 = tr_read<v2_rd_off(4 * G + 2, KS, 0)>(vb); f.h2 = tr_read<v2_rd_off(4 * G + 2, KS, 1)>(vb); f.l3 = tr_read<v2_rd_off(4 * G + 3, KS, 0)>(vb); f.h3 = tr_read<v2_rd_off(4 * G + 3, KS, 1)>(vb);
}
template <int G> __device__ __forceinline__ void vs_mma(f32x16* o, const VSet& f, bf16x8 pa) {
#define PK(Lo, Hi) (bf16x8){Lo[0], Lo[1], Lo[2], Lo[3], Hi[0], Hi[1], Hi[2], Hi[3]}
    o[4 * G + 0] = __builtin_amdgcn_mfma_f32_32x32x16_bf16(pa, PK(f.l0, f.h0), o[4 * G + 0], 0, 0, 0);
    o[4 * G + 1] = __builtin_amdgcn_mfma_f32_32x32x16_bf16(pa, PK(f.l1, f.h1), o[4 * G + 1], 0, 0, 0);
    o[4 * G + 2] = __builtin_amdgcn_mfma_f32_32x32x16_bf16(pa, PK(f.l2, f.h2), o[4 * G + 2], 0, 0, 0);
    o[4 * G + 3] = __builtin_amdgcn_mfma_f32_32x32x16_bf16(pa, PK(f.l3, f.h3), o[4 * G + 3], 0, 0, 0);
#undef PK
}
__device__ __forceinline__ void pv2_all(f32x16* o, int vb, bf16x8 pa0, bf16x8 pa1, bf16x8 pa2, bf16x8 pa3) {
    VSet A, B;
#define W8() do { asm volatile("s_waitcnt lgkmcnt(8)" ::: "memory"); SBAR(); } while (0)
    vs_load<0, 0>(A, vb);
    vs_load<0, 1>(B, vb); W8(); vs_mma<0>(o, A, pa0); SBAR();
    vs_load<0, 2>(A, vb); W8(); vs_mma<0>(o, B, pa1); SBAR();
    vs_load<0, 3>(B, vb); W8(); vs_mma<0>(o, A, pa2); SBAR();
    vs_load<1, 0>(A, vb); W8(); vs_mma<0>(o, B, pa3); SBAR();
    vs_load<1, 1>(B, vb); W8(); vs_mma<1>(o, A, pa0); SBAR();
    vs_load<1, 2>(A, vb); W8(); vs_mma<1>(o, B, pa1); SBAR();
    vs_load<1, 3>(B, vb); W8(); vs_mma<1>(o, A, pa2); SBAR();
    asm volatile("s_waitcnt lgkmcnt(0)" ::: "memory"); SBAR(); vs_mma<1>(o, B, pa3);
#undef W8
}
__device__ __forceinline__ void unit2(const bf16_t* __restrict__ Qb, const bf16_t* __restrict__ Kh, const bf16_t* __restrict__ Vh, bf16_t* __restrict__ Ob, int NT, int lim, unsigned char* ldsg, LAS unsigned char* lds) {
    int tid_ = threadIdx.x; asm volatile("" : "+v"(tid_));
    const int tid = tid_, wid = __builtin_amdgcn_readfirstlane(tid >> 6), lane = tid & 63, r32 = lane & 31, hi = lane >> 5;
    LAS float* wsf = (LAS float*)(lds + OFF_W) + wid * 64; LAS float* li_l = wsf; LAS float* al_l = wsf + 32;
    float m_reg = -1e30f, l_reg = 0; f32x16 o[8] = {}; bf16x8 qr[8];
    const bf16_t* Qw = Qb + (long)(wid * QBLK + r32) * LDQ + hi * 8;
#pragma unroll
    for (int d0 = 0; d0 < 8; ++d0) qr[d0] = *reinterpret_cast<const bf16x8*>(Qw + d0 * 16);
    const int vb0 = (int)(uintptr_t)(ldsg + OFF_V) + v_rd_base(lane);
#define DMA_K(t_, b_) do { const char* gk = (const char*)Kh + (size_t)(t_) * (KVBLK * LDQ * 2); int ln_ = lane; asm volatile("" : "+v"(ln_)); _Pragma("unroll") for (int i = 0; i < 2; ++i) { \
        const int row = wid * 4 + i * 32 + (ln_ >> 4); const unsigned ko = (unsigned)(row * LDQ * 2 + (((ln_ & 15) * 16) ^ ((row & 7) << 4))); \
        __builtin_amdgcn_global_load_lds((const unsigned*)(gk + ko), (LAS unsigned*)(lds + (b_) * KB + wid * 1024 + i * 8192), 16, 0, 0); } } while (0)
#define DMA_V(t_, b_) do { const char* gv = (const char*)Vh + (size_t)(t_) * (KVBLK * LDQ * 2); int ln_ = lane; asm volatile("" : "+v"(ln_)); _Pragma("unroll") for (int i = 0; i < 4; ++i) { \
        const int st = wid * 2 + i * 16 + (ln_ >> 5), q = ln_ & 31; const int kk = (st >> 3) * 8 + (q >> 2); const int k = (kk & ~0xC) | ((kk & 4) << 1) | ((kk & 8) >> 1); \
        const unsigned vo = (unsigned)(k * LDQ * 2 + ((st & 7) * 32 + (q & 3) * 8) * 2); \
        __builtin_amdgcn_global_load_lds((const unsigned*)(gv + vo), (LAS unsigned*)(lds + OFF_V + (b_) * VB + wid * 1024 + i * 8192), 16, 0, 0); } } while (0)
    DMA_K(0, 0); DMA_V(0, 0); if (1 < NT) { DMA_K(1, 1); DMA_V(1, 1); }
    asm volatile("s_waitcnt vmcnt(0)" ::: "memory"); __builtin_amdgcn_s_barrier(); asm volatile("" ::: "memory");
    int kb = 0;
    for (int j = 0; j < NT; ++j) {
        const int kb2 = kb == 0 ? 2 : kb - 1;
        if (j + 2 < NT) DMA_V(j + 2, kb2);
        asm volatile("" ::: "memory");
        if (j + 2 < NT) DMA_K(j + 2, kb2);
        asm volatile("" ::: "memory");
        f32x16 p0, p1; float mn, alpha; bf16x8 pa0, pa1, pa2, pa3;
        qkt(p0, p1, (const char*)ldsg + kb * KB, qr, r32, hi);
#if MK_PROBE_QK2
        asm volatile("" : "+v"(p0), "+v"(p1)); qkt(p0, p1, (const char*)ldsg + kb * KB, qr, r32, hi);
#endif
        mask_tile(p0, p1, j, lim);
        partialSM(p0, p1, m_reg, mn, alpha);
        if (__any(alpha < 1.f)) { if (hi == 0) al_l[r32] = alpha; asm volatile("s_waitcnt lgkmcnt(0)" ::: "memory");
#pragma unroll
            for (int d = 0; d < 8; ++d)
#pragma unroll
                for (int r = 0; r < 16; ++r) o[d][r] *= al_l[crow(r, hi)]; }
        finishSM(p0, p1, alpha, l_reg, pa0, pa1, pa2, pa3); SBAR();
        const int vb = vb0 + kb * VB;
        pv2_all(o, vb, pa0, pa1, pa2, pa3);
        if (j + 2 < NT) asm volatile("s_waitcnt vmcnt(6)" ::: "memory"); else asm volatile("s_waitcnt vmcnt(0)" ::: "memory");
        __builtin_amdgcn_s_barrier(); asm volatile("" ::: "memory");
        kb = kb == 2 ? 0 : kb + 1;
    }
    if (hi == 0) li_l[r32] = l_reg; asm volatile("s_waitcnt lgkmcnt(0)" ::: "memory");
    float rli[16];
#pragma unroll
    for (int r = 0; r < 16; ++r) rli[r] = __builtin_amdgcn_rcpf(li_l[crow(r, hi)]);
    bf16_t* Ow = Ob + (long)(wid * QBLK) * LDO;
#pragma unroll
    for (int r = 0; r < 16; ++r) { const int orow = crow(r, hi);
#pragma unroll
        for (int d0 = 0; d0 < 8; ++d0) Ow[(long)orow * LDO + d0 * 32 + r32] = f2bf(o[d0][r] * rli[r]); }
    asm volatile("s_waitcnt vmcnt(0) lgkmcnt(0)" ::: "memory"); __builtin_amdgcn_s_barrier(); asm volatile("" ::: "memory");
#undef DMA_K
#undef DMA_V
}

__device__ __forceinline__ void unit3(const bf16_t* __restrict__ Qb, const bf16_t* __restrict__ Kh, const bf16_t* __restrict__ Vh, bf16_t* __restrict__ Ob, int NT, int lim, unsigned char* ldsg, LAS unsigned char* lds) {
    int tid_ = threadIdx.x; asm volatile("" : "+v"(tid_));
    const int tid = tid_, wid = __builtin_amdgcn_readfirstlane(tid >> 6), lane = tid & 63, r32 = lane & 31, hi = lane >> 5, hb = wid >> 2;
    LAS float* wsf = (LAS float*)(lds + OFF_W) + wid * 64; LAS float* li_l = wsf; LAS float* al_l = wsf + 32;
    float m_reg = -1e30f, l_reg = 0; f32x16 o[8] = {}; bf16x8 qr[8];
    const bf16_t* Qw = Qb + (long)(wid * QBLK + r32) * LDQ + hi * 8;
#pragma unroll
    for (int d0 = 0; d0 < 8; ++d0) qr[d0] = *reinterpret_cast<const bf16x8*>(Qw + d0 * 16);
#define DMA_K(t_, b_) do { const char* gk = (const char*)Kh + (size_t)(t_) * (KVBLK * LDQ * 2); int ln_ = lane; asm volatile("" : "+v"(ln_)); _Pragma("unroll") for (int i = 0; i < 2; ++i) { \
        const int row = wid * 4 + i * 32 + (ln_ >> 4); const unsigned ko = (unsigned)(row * LDQ * 2 + (((ln_ & 15) * 16) ^ ((row & 7) << 4))); \
        __builtin_amdgcn_global_load_lds((const unsigned*)(gk + ko), (LAS unsigned*)(lds + (b_) * KB + wid * 1024 + i * 8192), 16, 0, 0); } } while (0)
#define DMA_V(t_, b_) do { const char* gv = (const char*)Vh + (size_t)(t_) * (KVBLK * LDQ * 2); int ln_ = lane; asm volatile("" : "+v"(ln_)); _Pragma("unroll") for (int i = 0; i < 4; ++i) { \
        const int st = wid * 2 + i * 16 + (ln_ >> 5), q = ln_ & 31; const int kk = (st >> 3) * 8 + (q >> 2); const int k = (kk & ~0xC) | ((kk & 4) << 1) | ((kk & 8) >> 1); \
        const unsigned vo = (unsigned)(k * LDQ * 2 + ((st & 7) * 32 + (q & 3) * 8) * 2); \
        __builtin_amdgcn_global_load_lds((const unsigned*)(gv + vo), (LAS unsigned*)(lds + OFF_V + (b_) * VB + wid * 1024 + i * 8192), 16, 0, 0); } } while (0)
    DMA_K(0, 0); DMA_V(0, 0); if (1 < NT) { DMA_K(1, 1); DMA_V(1, 1); }
    asm volatile("s_waitcnt vmcnt(0)" ::: "memory"); __builtin_amdgcn_s_barrier(); asm volatile("" ::: "memory");
    bf16x8 pa0, pa1, pa2, pa3;
    int kq = 0, ki = 2;
    int vq = 0, vi = 2;
#define U3_QS(j_) do { f32x16 p0, p1; float mn, alpha; int lq_ = lane; asm volatile("" : "+v"(lq_)); const int r32 = lq_ & 31, hi = lq_ >> 5; \
        qkt(p0, p1, (const char*)ldsg + kq * KB, qr, r32, hi); kq = kq == 2 ? 0 : kq + 1; \
        mask_tile(p0, p1, (j_), lim); \
        partialSM(p0, p1, m_reg, mn, alpha); \
        if (__any(alpha < 1.f)) { if (hi == 0) al_l[r32] = alpha; asm volatile("s_waitcnt lgkmcnt(0)" ::: "memory"); \
            _Pragma("unroll") for (int d = 0; d < 8; ++d) _Pragma("unroll") for (int r = 0; r < 16; ++r) o[d][r] *= al_l[crow(r, hi)]; } \
        finishSM(p0, p1, alpha, l_reg, pa0, pa1, pa2, pa3); } while (0)
#define U3_PV(j_) do { int lp_ = lane; asm volatile("" : "+v"(lp_)); const int vb = (int)(uintptr_t)(ldsg + OFF_V) + v_rd_base(lp_) + vq * VB; vq = vq == 2 ? 0 : vq + 1; \
        pv2_one<0>(o[0], vb, pa0, pa1, pa2, pa3); pv2_one<1>(o[1], vb, pa0, pa1, pa2, pa3); pv2_one<2>(o[2], vb, pa0, pa1, pa2, pa3); pv2_one<3>(o[3], vb, pa0, pa1, pa2, pa3); \
        pv2_one<4>(o[4], vb, pa0, pa1, pa2, pa3); pv2_one<5>(o[5], vb, pa0, pa1, pa2, pa3); pv2_one<6>(o[6], vb, pa0, pa1, pa2, pa3); pv2_one<7>(o[7], vb, pa0, pa1, pa2, pa3); } while (0)
#define U3_EVEN_ISSUE(jj_) do { if ((jj_) + 2 < NT) DMA_K((jj_) + 2, ki); ki = ki == 2 ? 0 : ki + 1; asm volatile("" ::: "memory"); } while (0)
#define U3_ODD_ISSUE(jj_) do { if ((jj_) + 2 < NT) DMA_V((jj_) + 2, vi); vi = vi == 2 ? 0 : vi + 1; asm volatile("" ::: "memory"); } while (0)
#define U3_EVEN_END(jj_) do { if ((jj_) + 2 < NT) asm volatile("s_waitcnt vmcnt(6)" ::: "memory"); else if ((jj_) + 1 < NT) asm volatile("s_waitcnt vmcnt(4)" ::: "memory"); else asm volatile("s_waitcnt vmcnt(0)" ::: "memory");   \
        asm volatile("s_waitcnt lgkmcnt(0)" ::: "memory"); __builtin_amdgcn_s_barrier(); asm volatile("" ::: "memory"); } while (0)
#define U3_ODD_END() do { asm volatile("s_waitcnt lgkmcnt(0)" ::: "memory"); __builtin_amdgcn_s_barrier(); asm volatile("" ::: "memory"); } while (0)
    if (hb == 0) {
#pragma unroll 1
        for (int jj = 0; jj < NT; ++jj) {
            U3_EVEN_ISSUE(jj); U3_QS(jj); U3_EVEN_END(jj);
            U3_ODD_ISSUE(jj); U3_PV(jj); U3_ODD_END();
        }
        U3_EVEN_ISSUE(NT); U3_EVEN_END(NT);
    } else {
        U3_EVEN_ISSUE(0); U3_EVEN_END(0);
#pragma unroll 1
        for (int jj = 0; jj < NT; ++jj) {
            U3_ODD_ISSUE(jj); U3_QS(jj); U3_ODD_END();
            U3_EVEN_ISSUE(jj + 1); U3_PV(jj); U3_EVEN_END(jj + 1);
        }
    }
#undef U3_QS
#undef U3_PV
#undef U3_EVEN_ISSUE
#undef U3_ODD_ISSUE
#undef U3_EVEN_END
#undef U3_ODD_END
    if (hi == 0) li_l[r32] = l_reg; asm volatile("s_waitcnt lgkmcnt(0)" ::: "memory");
    float rli[16];
#pragma unroll
    for (int r = 0; r < 16; ++r) rli[r] = __builtin_amdgcn_rcpf(li_l[crow(r, hi)]);
    bf16_t* Ow = Ob + (long)(wid * QBLK) * LDO;
#pragma unroll
    for (int r = 0; r < 16; ++r) { const int orow = crow(r, hi);
#pragma unroll
        for (int d0 = 0; d0 < 8; ++d0) Ow[(long)orow * LDO + d0 * 32 + r32] = f2bf(o[d0][r] * rli[r]); }
    asm volatile("s_waitcnt vmcnt(0) lgkmcnt(0)" ::: "memory"); __builtin_amdgcn_s_barrier(); asm volatile("" ::: "memory");
#undef DMA_K
#undef DMA_V
}

__device__ __forceinline__ void unit4(const bf16_t* __restrict__ Qb, const bf16_t* __restrict__ Kh, const bf16_t* __restrict__ Vh, bf16_t* __restrict__ Ob, int NT, int lim, unsigned char* ldsg, LAS unsigned char* lds) {
    int tid_ = threadIdx.x; asm volatile("" : "+v"(tid_));
    const int tid = tid_, wid = __builtin_amdgcn_readfirstlane(tid >> 6), lane = tid & 63, hb = wid >> 2;
    LAS float* wsf = (LAS float*)(lds + OFF_W) + wid * 64; LAS float* li_l = wsf; LAS float* al_l = wsf + 32;
    float m_reg = -1e30f, l_reg = 0; f32x16 o[8] = {}; bf16x8 qr[8];
    { const int r32 = lane & 31, hi = lane >> 5; const bf16_t* Qw = Qb + (long)(wid * QBLK + r32) * LDQ + hi * 8;
#pragma unroll
      for (int d0 = 0; d0 < 8; ++d0) qr[d0] = *reinterpret_cast<const bf16x8*>(Qw + d0 * 16); }
#define DMA_K(t_, b_) do { const char* gk = (const char*)Kh + (size_t)(t_) * (KVBLK * LDQ * 2); int ln_ = lane; asm volatile("" : "+v"(ln_)); _Pragma("unroll") for (int i = 0; i < 2; ++i) { \
        const int row = wid * 4 + i * 32 + (ln_ >> 4); const unsigned ko = (unsigned)(row * LDQ * 2 + (((ln_ & 15) * 16) ^ ((row & 7) << 4))); \
        __builtin_amdgcn_global_load_lds((const unsigned*)(gk + ko), (LAS unsigned*)(lds + (b_) * KB + wid * 1024 + i * 8192), 16, 0, 0); } } while (0)
#define DMA_V(t_, b_) do { const char* gv = (const char*)Vh + (size_t)(t_) * (KVBLK * LDQ * 2); int ln_ = lane; asm volatile("" : "+v"(ln_)); _Pragma("unroll") for (int i = 0; i < 4; ++i) { \
        const int st = wid * 2 + i * 16 + (ln_ >> 5), q = ln_ & 31; const int kk = (st >> 3) * 8 + (q >> 2); const int k = (kk & ~0xC) | ((kk & 4) << 1) | ((kk & 8) >> 1); \
        const unsigned vo = (unsigned)(k * LDQ * 2 + ((st & 7) * 32 + (q & 3) * 8) * 2); \
        __builtin_amdgcn_global_load_lds((const unsigned*)(gv + vo), (LAS unsigned*)(lds + OFF_V + (b_) * VB + wid * 1024 + i * 8192), 16, 0, 0); } } while (0)
    DMA_K(0, 0); DMA_V(0, 0); if (1 < NT) { DMA_K(1, 1); DMA_V(1, 1); } if (2 < NT) DMA_K(2, 2);
    asm volatile("s_waitcnt vmcnt(0)" ::: "memory"); __builtin_amdgcn_s_barrier(); asm volatile("" ::: "memory");
    f32x16 p0, p1; bf16x8 pa0, pa1, pa2, pa3;
    int kq = 0, ki = 0, vq = 0, vi = 2;
#define U4_QK() do { int lq_ = lane; asm volatile("" : "+v"(lq_)); qkt(p0, p1, (const char*)ldsg + kq * KB, qr, lq_ & 31, lq_ >> 5); kq = kq == 2 ? 0 : kq + 1; } while (0)
#define U4_SM(j_) do { float mn, alpha; int lq_ = lane; asm volatile("" : "+v"(lq_)); const int r32 = lq_ & 31, hi = lq_ >> 5; \
        mask_tile(p0, p1, (j_), lim); \
        partialSM(p0, p1, m_reg, mn, alpha); \
        if (__any(alpha < 1.f)) { if (hi == 0) al_l[r32] = alpha; asm volatile("s_waitcnt lgkmcnt(0)" ::: "memory"); \
            _Pragma("unroll") for (int d = 0; d < 8; ++d) _Pragma("unroll") for (int r = 0; r < 16; ++r) o[d][r] *= al_l[crow(r, hi)]; } \
        finishSM(p0, p1, alpha, l_reg, pa0, pa1, pa2, pa3); } while (0)
#define U4_PV() do { int lp_ = lane; asm volatile("" : "+v"(lp_)); const int vb = (int)(uintptr_t)(ldsg + OFF_V) + v_rd_base(lp_) + vq * VB; vq = vq == 2 ? 0 : vq + 1; \
        pv2_all(o, vb, pa0, pa1, pa2, pa3); } while (0)
#define U4_ISSUE(s_) do { if (((s_) & 1) == 0) { if ((s_) >= 2) { if ((s_) / 2 + 2 < NT) DMA_K((s_) / 2 + 2, ki); ki = ki == 2 ? 0 : ki + 1; } } \
        else { if ((s_) >= 3) { if (((s_) + 1) / 2 < NT) DMA_V(((s_) + 1) / 2, vi); vi = vi == 2 ? 0 : vi + 1; } } asm volatile("" ::: "memory"); } while (0)
#define U4_END(s_) do { if ((s_) & 1) { const int kt = ((s_) + 1) / 2 + 1, vt = ((s_) + 1) / 2;     \
            if ((s_) >= 3 && kt < NT && vt < NT) asm volatile("s_waitcnt vmcnt(6)" ::: "memory"); \
            else if ((s_) >= 3 && vt < NT) asm volatile("s_waitcnt vmcnt(4)" ::: "memory"); \
            else asm volatile("s_waitcnt vmcnt(0)" ::: "memory"); } \
        asm volatile("s_waitcnt lgkmcnt(0)" ::: "memory"); __builtin_amdgcn_s_barrier(); asm volatile("" ::: "memory"); } while (0)
    if (hb == 0) {
        U4_ISSUE(0); U4_QK(); U4_END(0);
#pragma unroll 1
        for (int m = 0; m < NT; ++m) {
            U4_ISSUE(2 * m + 1); U4_SM(m); U4_END(2 * m + 1);
            U4_ISSUE(2 * m + 2); U4_PV(); if (m + 1 < NT) U4_QK(); U4_END(2 * m + 2);
        }
        U4_ISSUE(2 * NT + 1); U4_END(2 * NT + 1);
    } else {
        U4_ISSUE(0); U4_END(0);
        U4_ISSUE(1); U4_QK(); U4_END(1);
#pragma unroll 1
        for (int m = 0; m < NT; ++m) {
            U4_ISSUE(2 * m + 2); U4_SM(m); U4_END(2 * m + 2);
            U4_ISSUE(2 * m + 3); U4_PV(); if (m + 1 < NT) U4_QK(); U4_END(2 * m + 3);
        }
    }
#undef U4_QK
#undef U4_SM
#undef U4_PV
#undef U4_ISSUE
#undef U4_END
    const int r32 = lane & 31, hi = lane >> 5;
    if (hi == 0) li_l[r32] = l_reg; asm volatile("s_waitcnt lgkmcnt(0)" ::: "memory");
    float rli[16];
#pragma unroll
    for (int r = 0; r < 16; ++r) rli[r] = __builtin_amdgcn_rcpf(li_l[crow(r, hi)]);
    bf16_t* Ow = Ob + (long)(wid * QBLK) * LDO;
#pragma unroll
    for (int r = 0; r < 16; ++r) { const int orow = crow(r, hi);
#pragma unroll
        for (int d0 = 0; d0 < 8; ++d0) Ow[(long)orow * LDO + d0 * 32 + r32] = f2bf(o[d0][r] * rli[r]); }
    asm volatile("s_waitcnt vmcnt(0) lgkmcnt(0)" ::: "memory"); __builtin_amdgcn_s_barrier(); asm volatile("" ::: "memory");
#undef DMA_K
#undef DMA_V
}

__device__ __forceinline__ void unit5(const bf16_t* __restrict__ Qb, const bf16_t* __restrict__ Kh, const bf16_t* __restrict__ Vh, bf16_t* __restrict__ Ob, int NT, int lim, unsigned char* ldsg, LAS unsigned char* lds) {
    int tid_ = threadIdx.x; asm volatile("" : "+v"(tid_));
    const int tid = tid_, wid = __builtin_amdgcn_readfirstlane(tid >> 6), lane = tid & 63, hb = wid >> 2;
    LAS float* wsf = (LAS float*)(lds + OFF_W) + wid * 64; LAS float* li_l = wsf; LAS float* al_l = wsf + 32;
    float m_reg = -1e30f, l_reg = 0; f32x16 o[8] = {}; bf16x8 qr[8];
    { const int r32 = lane & 31, hi = lane >> 5; const bf16_t* Qw = Qb + (long)(wid * QBLK + r32) * LDQ + hi * 8;
#pragma unroll
      for (int d0 = 0; d0 < 8; ++d0) qr[d0] = *reinterpret_cast<const bf16x8*>(Qw + d0 * 16); }
#define DMA_K(t_, b_) do { const char* gk = (const char*)Kh + (size_t)(t_) * (KVBLK * LDQ * 2); int ln_ = lane; asm volatile("" : "+v"(ln_)); _Pragma("unroll") for (int i = 0; i < 2; ++i) { \
        const int row = wid * 4 + i * 32 + (ln_ >> 4); const unsigned ko = (unsigned)(row * LDQ * 2 + (((ln_ & 15) * 16) ^ ((row & 7) << 4))); \
        __builtin_amdgcn_global_load_lds((const unsigned*)(gk + ko), (LAS unsigned*)(lds + (b_) * KB + wid * 1024 + i * 8192), 16, 0, 0); } } while (0)
#define DMA_V(t_, b_) do { const char* gv = (const char*)Vh + (size_t)(t_) * (KVBLK * LDQ * 2); int ln_ = lane; asm volatile("" : "+v"(ln_)); _Pragma("unroll") for (int i = 0; i < 4; ++i) { \
        const int st = wid * 2 + i * 16 + (ln_ >> 5), q = ln_ & 31; const int kk = (st >> 3) * 8 + (q >> 2); const int k = (kk & ~0xC) | ((kk & 4) << 1) | ((kk & 8) >> 1); \
        const unsigned vo = (unsigned)(k * LDQ * 2 + ((st & 7) * 32 + (q & 3) * 8) * 2); \
        __builtin_amdgcn_global_load_lds((const unsigned*)(gv + vo), (LAS unsigned*)(lds + OFF_V + (b_) * VB + wid * 1024 + i * 8192), 16, 0, 0); } } while (0)
    DMA_K(0, 0); DMA_V(0, 0); if (1 < NT) DMA_K(1, 1);
    asm volatile("s_waitcnt vmcnt(0)" ::: "memory"); __builtin_amdgcn_s_barrier(); asm volatile("" ::: "memory");
    bf16x8 pa0, pa1, pa2, pa3;
    int kb = 0, kb1 = 1, kb2 = 2;
#define U5_ISSUE(j_) do { if ((j_) + 1 < NT) DMA_V((j_) + 1, kb1); asm volatile("" ::: "memory"); if ((j_) + 2 < NT) DMA_K((j_) + 2, kb2); asm volatile("" ::: "memory"); } while (0)
#define U5_QS(j_) do { f32x16 p0, p1; float mn, alpha; int lq_ = lane; asm volatile("" : "+v"(lq_)); const int r32 = lq_ & 31, hi = lq_ >> 5; \
        qkt(p0, p1, (const char*)ldsg + kb * KB, qr, r32, hi); \
        mask_tile(p0, p1, (j_), lim); \
        partialSM(p0, p1, m_reg, mn, alpha); \
        if (__any(alpha < 1.f)) { if (hi == 0) al_l[r32] = alpha; asm volatile("s_waitcnt lgkmcnt(0)" ::: "memory"); \
            _Pragma("unroll") for (int d = 0; d < 8; ++d) _Pragma("unroll") for (int r = 0; r < 16; ++r) o[d][r] *= al_l[crow(r, hi)]; } \
        finishSM(p0, p1, alpha, l_reg, pa0, pa1, pa2, pa3); } while (0)
#define U5_PV(vbuf_) do { int lp_ = lane; asm volatile("" : "+v"(lp_)); const int vb = (int)(uintptr_t)(ldsg + OFF_V) + v_rd_base(lp_) + (vbuf_) * VB; pv2_all(o, vb, pa0, pa1, pa2, pa3); } while (0)
#define U5_END(j_) do { if ((j_) + 2 < NT) asm volatile("s_waitcnt vmcnt(2)" ::: "memory"); else asm volatile("s_waitcnt vmcnt(0)" ::: "memory"); \
        asm volatile("s_waitcnt lgkmcnt(0)" ::: "memory"); __builtin_amdgcn_s_barrier(); asm volatile("" ::: "memory"); \
        { const int t_ = kb; kb = kb1; kb1 = kb2; kb2 = t_; } } while (0)
    if (hb == 0) {
#pragma unroll 1
        for (int j = 0; j < NT; ++j) { U5_ISSUE(j); U5_QS(j); U5_PV(kb); U5_END(j); }
    } else {
#pragma unroll 1
        for (int j = 0; j < NT; ++j) { U5_ISSUE(j); if (j > 0) U5_PV(kb2); U5_QS(j); U5_END(j); }
        U5_PV(kb2);
    }
#undef U5_ISSUE
#undef U5_QS
#undef U5_PV
#undef U5_END
    const int r32 = lane & 31, hi = lane >> 5;
    if (hi == 0) li_l[r32] = l_reg; asm volatile("s_waitcnt lgkmcnt(0)" ::: "memory");
    float rli[16];
#pragma unroll
    for (int r = 0; r < 16; ++r) rli[r] = __builtin_amdgcn_rcpf(li_l[crow(r, hi)]);
    bf16_t* Ow = Ob + (long)(wid * QBLK) * LDO;
#pragma unroll
    for (int r = 0; r < 16; ++r) { const int orow = crow(r, hi);
#pragma unroll
        for (int d0 = 0; d0 < 8; ++d0) Ow[(long)orow * LDO + d0 * 32 + r32] = f2bf(o[d0][r] * rli[r]); }
    asm volatile("s_waitcnt vmcnt(0) lgkmcnt(0)" ::: "memory"); __builtin_amdgcn_s_barrier(); asm volatile("" ::: "memory");
#undef DMA_K
#undef DMA_V
}
}

#ifndef MK_ATT2
#define MK_ATT2 1
#endif
#ifndef MK_PROBE_QK2
#define MK_PROBE_QK2 0
#endif
#ifndef MK_PROBE_DMA2
#define MK_PROBE_DMA2 0
#endif
#ifndef MK_ATT_UNIT
#define MK_ATT_UNIT unit2
#endif
#if MK_ATT2
__device__ __forceinline__ void attn_phase(const Fr& F) {
    const bf16_t* Q = slotY(F, 0); const bf16_t* K = slotY(F, 1); const bf16_t* V = slotY(F, 2);
    bf16_t* AO = slotU(F, 1);
    const int x = F.bid & 7, j = (F.bid >> 3) & 31;
#pragma unroll 1
    for (int k = 0; k < 4; ++k) {
        if (F.bid >= 256) break;
        const int sub = 4 * x + k, head = sub >> 1, c = sub & 1;
        const bf16_t* Kp = K + head * 256 + c * 128; const bf16_t* Vp = V + head * 256;
#pragma unroll 1
        for (int u = 0; u < 2; ++u) {
            const int t = u == 0 ? 63 - j : j;
            const int row0 = 256 * t + 128;
            att2::MK_ATT_UNIT(Q + (size_t)row0 * D + head * 256 + c * 128, Kp, Vp, AO + (size_t)row0 * 8192 + head * 512 + c * 256, 4 * t + 6, 4 * t + 2 + (F.wave >> 1), F.ldsg, F.lds);
        }
        if (j == 8 * k) att2::MK_ATT_UNIT(Q + head * 256 + c * 128, Kp, Vp, AO + head * 512 + c * 256, 4, F.wave >> 1, F.ldsg, F.lds);
    }
}
#else
__device__ __forceinline__ void attn_phase(const Fr& F) {
    const bf16_t* Q = slotY(F, 0); const bf16_t* K = slotY(F, 1); const bf16_t* V = slotY(F, 2);
    bf16_t* AO = slotU(F, 1);
    const int x = F.bid & 7, j = (F.bid >> 3) & 31;
#pragma unroll 1
    for (int k = 0; k < 8; ++k) {
        if (F.bid >= 256) break;
        const int sub = 8 * x + k, head = sub >> 2, c = (sub >> 1) & 1, half = sub & 1;
        const bf16_t* Kp = K + head * 256 + c * 128; const bf16_t* Vp = V + head * 256 + half * 128;
#pragma unroll 1
        for (int u = 0; u < 2; ++u) {
            const int t = u == 0 ? 63 - j : j;
            const int row0 = 256 * t + 128;
            att::unit(Q + (size_t)row0 * D + head * 256 + c * 128, Kp, Vp, AO + (size_t)row0 * 8192 + head * 512 + c * 256 + half * 128, 4 * t + 6, 4 * t + 2 + (F.wave >> 1), (char*)F.ldsg);
        }
        if (j == 4 * k) att::unit(Q + head * 256 + c * 128, Kp, Vp, AO + head * 512 + c * 256 + half * 128, 4, F.wave >> 1, (char*)F.ldsg);
    }
}
#endif
__device__ __forceinline__ void attn_post(const Fr& F) {
    const bf16_t* AO = slotU(F, 1); const bf16_t* GT = slotY(F, 3); bf16_t* Z = slotU(F, 0);
    const float* sg = F.in(13);
    constexpr float LINIT = 0.35550906759096934f;
    float lam;
    { const float* q1 = F.in(9); const float* k1 = F.in(10); const float* q2 = F.in(11); const float* k2 = F.in(12);
      const float d1 = wave_sum(q1[F.lane] * k1[F.lane] + q1[F.lane + 64] * k1[F.lane + 64]), d2 = wave_sum(q2[F.lane] * k2[F.lane] + q2[F.lane + 64] * k2[F.lane + 64]);
      lam = expf(d1) - expf(d2) + LINIT; }
    const f32x4 g4 = ((const f32x4*)sg)[F.lane];
    for (int r = F.gw; r < R; r += F.NGW) {
        const bool real = (r >= NPAD && r < NREAL);
        u32x2* zr = (u32x2*)(Z + (size_t)r * D) + F.lane;
        if (!real) { const u32x2 z = {0u, 0u};
#pragma unroll
            for (int hd = 0; hd < 16; ++hd) zr[64 * hd] = z;
            continue; }
        gp_ ao0 = (gp_)(AO + (size_t)r * 8192) + F.lane * 8 + 4096; gp_ ao1 = ao0 + 8192; asm volatile("" : "+v"(ao0), "+v"(ao1));
        ROW_BF(gq, GT + (size_t)r * D, F.lane); ROW_BF(zq, Z + (size_t)r * D, F.lane);
        u32x2 a0v[16], a1v[16], gtv[16];
#pragma unroll
        for (int hd = 0; hd < 16; ++hd) {
            a0v[hd] = *(GAS u32x2*)(hd < 8 ? ao0 + (2 * hd) * 512 - 4096 : ao1 + (2 * hd - 16) * 512 - 4096);
            a1v[hd] = *(GAS u32x2*)(hd < 8 ? ao0 + (2 * hd + 1) * 512 - 4096 : ao1 + (2 * hd - 15) * 512 - 4096);
            gtv[hd] = AT_BF(gq, hd);
        }
#pragma unroll
        for (int hd = 0; hd < 16; ++hd) {
            const u32x2 a0 = a0v[hd], a1 = a1v[hd], gt = gtv[hd];
            const float o0 = bflo(a0.x) - lam * bflo(a1.x), o1 = bfhi(a0.x) - lam * bfhi(a1.x), o2 = bflo(a0.y) - lam * bflo(a1.y), o3 = bfhi(a0.y) - lam * bfhi(a1.y);
            const float ss = wave_sum((o0 * o0 + o1 * o1) + (o2 * o2 + o3 * o3));
            const float rs = __builtin_amdgcn_rsqf(ss * (1.f / 256.f) + 1e-5f) * (1.f - LINIT);
            u32x2 w; w.x = cvt_pk_bf16(o0 * rs * g4.x * silu_f(bflo(gt.x)), o1 * rs * g4.y * silu_f(bfhi(gt.x))); w.y = cvt_pk_bf16(o2 * rs * g4.z * silu_f(bflo(gt.y)), o3 * rs * g4.w * silu_f(bfhi(gt.y)));
            AT_BF(zq, hd) = w;
        }
    }
}

constexpr int RW_TT = 32, RW_TOKF = 384, RW_TILEF = RW_TT * RW_TOKF, RW_NTILE = 513;
__device__ __forceinline__ void rwkv_scan_seq(const Fr& F) {
    const bf16_t* Rr = slotY(F, 0); const bf16_t* K = slotY(F, 1); const bf16_t* V = slotY(F, 2); const bf16_t* W = slotY(F, 4); const bf16_t* A = slotY(F, 5);
    float* O32 = (float*)slotU(F, 1);
    LAS float* ring = (LAS float*)F.lds; LAS float* otile = ring + 2 * RW_TILEF;
    const int tid = F.tid, lane = F.lane, wid = F.wave;
    for (int unit = F.bid; unit < 256; unit += F.G) {
        const int h = unit >> 2, rg = unit & 3;
        const int ptid = tid - 256, ptt = ptid >> 3, dg = ptid & 7;
        float kkc[8], kac[8];
        if (wid >= 4) {
#pragma unroll
            for (int i = 0; i < 8; ++i) { kkc[i] = F.in(23)[h * 64 + 8 * dg + i]; kac[i] = F.in(24)[h * 64 + 8 * dg + i]; }
        }
        float S0 = 0.f, S1 = 0.f, S2 = 0.f, S3 = 0.f;
        const int cg = lane & 15, irow = 4 * wid + (lane >> 4);
#define RW_PRODUCE(m, buf) do { const int row = NPAD + 32 * (m) + ptt; const size_t off = (size_t)row * D + h * 64 + 8 * dg; \
        const u32x4 r8 = *(const u32x4*)(Rr + off), k8 = *(const u32x4*)(K + off), v8 = *(const u32x4*)(V + off), w8 = *(const u32x4*)(W + off), a8 = *(const u32x4*)(A + off); \
        const unsigned rw[4] = {r8.x, r8.y, r8.z, r8.w}, kw[4] = {k8.x, k8.y, k8.z, k8.w}, vw[4] = {v8.x, v8.y, v8.z, v8.w}, ww[4] = {w8.x, w8.y, w8.z, w8.w}, aw[4] = {a8.x, a8.y, a8.z, a8.w}; \
        float rf[8], kf[8], vf[8], wf[8], af[8], kk[8]; float ssq = 0.f; \
        _Pragma("unroll") for (int i = 0; i < 4; ++i) { rf[2 * i] = bflo(rw[i]); rf[2 * i + 1] = bfhi(rw[i]); kf[2 * i] = bflo(kw[i]); kf[2 * i + 1] = bfhi(kw[i]); vf[2 * i] = bflo(vw[i]); vf[2 * i + 1] = bfhi(vw[i]); \
            wf[2 * i] = bflo(ww[i]); wf[2 * i + 1] = bfhi(ww[i]); af[2 * i] = bflo(aw[i]); af[2 * i + 1] = bfhi(aw[i]); } \
        _Pragma("unroll") for (int i = 0; i < 8; ++i) { kk[i] = kf[i] * kkc[i]; ssq += kk[i] * kk[i]; } \
        ssq = red8(ssq); const float inv = 1.f / fmaxf(sqrtf(ssq), 1e-12f); \
        LAS float* tb = ring + (buf) * RW_TILEF + ptt * RW_TOKF; \
        _Pragma("unroll") for (int q = 0; q < 2; ++q) { LAS f32x4* p = (LAS f32x4*)(tb + (2 * dg + q) * 20); \
            f32x4 t0, t1, t2, t3, t4; \
            _Pragma("unroll") for (int e = 0; e < 4; ++e) { const int i = 4 * q + e; const float kn = kk[i] * inv; t0[e] = wf[i]; t1[e] = -kn; t2[e] = kn * af[i]; t3[e] = kf[i] * (1.f + (af[i] - 1.f) * kac[i]); t4[e] = rf[i]; } \
            p[0] = t0; p[1] = t1; p[2] = t2; p[3] = t3; p[4] = t4; } \
        LAS f32x4* pv = (LAS f32x4*)(tb + 320 + 8 * dg); pv[0] = (f32x4){vf[0], vf[1], vf[2], vf[3]}; pv[1] = (f32x4){vf[4], vf[5], vf[6], vf[7]}; } while (0)
#define RW_FLUSH(m, buf) do { const int row = NPAD + 32 * (m) + ptt; if (row < NREAL) { const LAS float* ot = otile + (buf) * 512 + ptt * 16 + 2 * dg; \
        *(float2*)(O32 + (size_t)row * D + h * 64 + 16 * rg + 2 * dg) = make_float2(ot[0], ot[1]); } } while (0)
        if (wid >= 4) RW_PRODUCE(0, 0);
        __syncthreads();
        for (int n = 0; n < RW_NTILE; ++n) {
            if (wid < 4) {
                const LAS float* tb = ring + (n & 1) * RW_TILEF; LAS float* ot = otile + (n & 1) * 512;
#pragma unroll 4
                for (int tt = 0; tt < RW_TT; ++tt) {
                    const LAS float* p = tb + tt * RW_TOKF + cg * 20;
                    const f32x4 w4 = *(const LAS f32x4*)p, nk = *(const LAS f32x4*)(p + 4), ka = *(const LAS f32x4*)(p + 8), kp = *(const LAS f32x4*)(p + 12), r4 = *(const LAS f32x4*)(p + 16);
                    const float v = tb[tt * RW_TOKF + 320 + 16 * rg + irow];
                    float sa = (S0 * nk.x + S1 * nk.y) + (S2 * nk.z + S3 * nk.w);
                    sa = red16(sa);
                    S0 = S0 * w4.x + (sa * ka.x + v * kp.x); S1 = S1 * w4.y + (sa * ka.y + v * kp.y); S2 = S2 * w4.z + (sa * ka.z + v * kp.z); S3 = S3 * w4.w + (sa * ka.w + v * kp.w);
                    float o = (S0 * r4.x + S1 * r4.y) + (S2 * r4.z + S3 * r4.w);
                    o = red16(o);
                    if (cg == 0) ot[tt * 16 + irow] = o;
                }
            } else {
                if (n + 1 < RW_NTILE) RW_PRODUCE(n + 1, (n + 1) & 1);
                if (n > 0) RW_FLUSH(n - 1, (n - 1) & 1);
            }
            __syncthreads();
        }
        if (wid >= 4) RW_FLUSH(RW_NTILE - 1, (RW_NTILE - 1) & 1);
        __syncthreads();
#undef RW_PRODUCE
#undef RW_FLUSH
    }
}

#ifndef RC_SYNC
#define RC_SYNC 0
#endif
constexpr int RC_SLOT = 13312, RC_NSLOT = 8, RC_SCR0 = RC_NSLOT * RC_SLOT, RC_SCR = 5632, RC_FLAGS = RC_SCR0 + 7 * RC_SCR, RC_NCH = 1025;
constexpr int RC_AT = 0, RC_RT = 2176, RC_BTT = 4352, RC_KTT = 6912, RC_TT = 9472, RC_G3F = 9984, RC_VTF = 10496, RC_P1 = 11008, RC_P2 = 12032, RC_WC = 13056;
static_assert(RC_FLAGS + 64 <= 147456 - 256, "rwkv LDS map");
typedef short s16x4v __attribute__((ext_vector_type(4)));
__device__ __forceinline__ void rwkv_kknorm(const Fr& F) {
    const bf16_t* K = slotY(F, 1); const float* k_k = F.in(23); float* INV = (float*)(F.ws + WS_HE);
    f32x4 c4v[16];
    { ROW_F32(cq, k_k, F.lane);
#pragma unroll
      for (int it = 0; it < 16; ++it) c4v[it] = AT_F32(cq, it); }
    for (int r = F.gw; r < R; r += F.NGW) {
        ROW_BF(kq_, K + (size_t)r * D, F.lane);
        u32x2 kv[16];
#pragma unroll
        for (int it = 0; it < 16; ++it) kv[it] = AT_BF(kq_, it);
#pragma unroll
        for (int it = 0; it < 16; ++it) {
            const u32x2 kk = kv[it]; const f32x4 c4 = c4v[it];
            const float a = bflo(kk.x) * c4.x, b = bfhi(kk.x) * c4.y, c = bflo(kk.y) * c4.z, d = bfhi(kk.y) * c4.w;
            const float ss = red16((a * a + b * b) + (c * c + d * d));
            if ((F.lane & 15) == 0) INV[(size_t)r * 64 + it * 4 + (F.lane >> 4)] = 1.f / fmaxf(sqrtf(ss), 1e-12f);
        }
    }
}
__device__ __forceinline__ unsigned lds_poll(volatile LAS unsigned* p) { return *p; }
__device__ __forceinline__ void rwkv_scan(const Fr& F) {
    const bf16_t* Rr = slotY(F, 0); const bf16_t* K = slotY(F, 1); const bf16_t* V = slotY(F, 2); const bf16_t* W = slotY(F, 4); const bf16_t* A = slotY(F, 5);
    const float* INV = (const float*)(F.ws + WS_HE);
    float* O32 = (float*)slotU(F, 1);
    LAS unsigned char* L = F.lds;
    volatile LAS unsigned* flags = (volatile LAS unsigned*)(L + RC_FLAGS);
    const int lane = F.lane, wid = F.wave, l15 = lane & 15, kg = lane >> 4;
    for (int unit = F.bid; unit < 256; unit += F.G) {
        const int h = unit >> 2, rgw = unit & 3;
        if (F.tid < 16) flags[F.tid] = 0u;
        __syncthreads();
        if (wid == 0) {
            __builtin_amdgcn_s_setprio(3);
            f32x4 S0 = {0.f, 0.f, 0.f, 0.f}, S1 = S0, S2 = S0, S3 = S0;
            struct SlotRegs { u32x2 a0l, a0h, a1l, a1h, r0l, r0h, r1l, r1h; f32x4 P1, P2; s16x4v ttf, g3f, vtf, b0, b1, b2, b3, k0, k1, k2, k3; f32x4 w0, w1, w2, w3; };
#if RC_SYNC
#define CH_WAIT(n_) do { if ((n_) % 7 == 0) { __builtin_amdgcn_s_barrier(); __builtin_amdgcn_s_barrier(); } } while (0)
#else
#define CH_WAIT(n_) do { unsigned sp = 0; while (lds_poll(flags + ((n_) & 7)) != (unsigned)((n_) + 1)) { __builtin_amdgcn_s_sleep(1); if (++sp > (1u << 22)) break; } } while (0)
#endif
#define CH_LOAD(R_, n_) do { CH_WAIT(n_); asm volatile("s_waitcnt lgkmcnt(0)" ::: "memory"); const LAS unsigned char* SL = L + ((n_) & 7) * RC_SLOT; \
                const LAS unsigned char* ap = SL + RC_AT + l15 * 136 + kg * 8; const LAS unsigned char* rp = SL + RC_RT + l15 * 136 + kg * 8; \
                R_.a0l = *(const LAS u32x2*)(ap); R_.a0h = *(const LAS u32x2*)(ap + 32); R_.a1l = *(const LAS u32x2*)(ap + 64); R_.a1h = *(const LAS u32x2*)(ap + 96); \
                R_.r0l = *(const LAS u32x2*)(rp); R_.r0h = *(const LAS u32x2*)(rp + 32); R_.r1l = *(const LAS u32x2*)(rp + 64); R_.r1h = *(const LAS u32x2*)(rp + 96); \
                R_.P1 = *(const LAS f32x4*)(SL + RC_P1 + lane * 16); R_.P2 = *(const LAS f32x4*)(SL + RC_P2 + lane * 16); \
                R_.ttf = *(const LAS s16x4v*)(SL + RC_TT + lane * 8); R_.g3f = *(const LAS s16x4v*)(SL + RC_G3F + lane * 8); R_.vtf = *(const LAS s16x4v*)(SL + RC_VTF + lane * 8); \
                const LAS unsigned char* bp = SL + RC_BTT + l15 * 40 + kg * 8; const LAS unsigned char* kp = SL + RC_KTT + l15 * 40 + kg * 8; \
                R_.b0 = *(const LAS s16x4v*)(bp); R_.b1 = *(const LAS s16x4v*)(bp + 640); R_.b2 = *(const LAS s16x4v*)(bp + 1280); R_.b3 = *(const LAS s16x4v*)(bp + 1920); \
                R_.k0 = *(const LAS s16x4v*)(kp); R_.k1 = *(const LAS s16x4v*)(kp + 640); R_.k2 = *(const LAS s16x4v*)(kp + 1280); R_.k3 = *(const LAS s16x4v*)(kp + 1920); \
                const LAS f32x4* wc = (const LAS f32x4*)(SL + RC_WC + kg * 16); R_.w0 = wc[0]; R_.w1 = wc[4]; R_.w2 = wc[8]; R_.w3 = wc[12]; \
                asm volatile("s_waitcnt lgkmcnt(0)" ::: "memory"); \
                if (lane == 0) flags[8] = (unsigned)((n_) + 1); } while (0)
#define CH_COMPUTE(R_, n_, NEXT_) do { \
                u32x4 sb0, sb1; sb0.x = cvt_pk_bf16(S0.x, S0.y); sb0.y = cvt_pk_bf16(S0.z, S0.w); sb0.z = cvt_pk_bf16(S1.x, S1.y); sb0.w = cvt_pk_bf16(S1.z, S1.w); \
                sb1.x = cvt_pk_bf16(S2.x, S2.y); sb1.y = cvt_pk_bf16(S2.z, S2.w); sb1.z = cvt_pk_bf16(S3.x, S3.y); sb1.w = cvt_pk_bf16(S3.z, S3.w); \
                const bf16x8 Sb0 = *reinterpret_cast<bf16x8*>(&sb0), Sb1 = *reinterpret_cast<bf16x8*>(&sb1); \
                u32x4 t4; \
                t4 = (u32x4){R_.a0l.x, R_.a0l.y, R_.a0h.x, R_.a0h.y}; const bf16x8 Aq0 = *reinterpret_cast<bf16x8*>(&t4); \
                t4 = (u32x4){R_.a1l.x, R_.a1l.y, R_.a1h.x, R_.a1h.y}; const bf16x8 Aq1 = *reinterpret_cast<bf16x8*>(&t4); \
                t4 = (u32x4){R_.r0l.x, R_.r0l.y, R_.r0h.x, R_.r0h.y}; const bf16x8 Rq0 = *reinterpret_cast<bf16x8*>(&t4); \
                t4 = (u32x4){R_.r1l.x, R_.r1l.y, R_.r1h.x, R_.r1h.y}; const bf16x8 Rq1 = *reinterpret_cast<bf16x8*>(&t4); \
                f32x4 X = R_.P1, O = R_.P2; \
                X = __builtin_amdgcn_mfma_f32_16x16x32_bf16(Aq0, Sb0, X, 0, 0, 0); \
                X = __builtin_amdgcn_mfma_f32_16x16x32_bf16(Aq1, Sb1, X, 0, 0, 0);                   \
                O = __builtin_amdgcn_mfma_f32_16x16x32_bf16(Rq0, Sb0, O, 0, 0, 0); \
                O = __builtin_amdgcn_mfma_f32_16x16x32_bf16(Rq1, Sb1, O, 0, 0, 0);                   \
                u32x2 yb; yb.x = cvt_pk_bf16(X.x, X.y); yb.y = cvt_pk_bf16(X.z, X.w); \
                f32x4 U = {0.f, 0.f, 0.f, 0.f}; \
                U = __builtin_amdgcn_mfma_f32_16x16x16bf16_1k(R_.ttf, *reinterpret_cast<s16x4v*>(&yb), U, 0, 0, 0);     \
                u32x2 ub; ub.x = cvt_pk_bf16(U.x, U.y); ub.y = cvt_pk_bf16(U.z, U.w); \
                const s16x4v Ub = *reinterpret_cast<s16x4v*>(&ub); \
                S0 = __builtin_amdgcn_mfma_f32_16x16x16bf16_1k(R_.k0, R_.vtf, S0, 0, 0, 0); S1 = __builtin_amdgcn_mfma_f32_16x16x16bf16_1k(R_.k1, R_.vtf, S1, 0, 0, 0); \
                S2 = __builtin_amdgcn_mfma_f32_16x16x16bf16_1k(R_.k2, R_.vtf, S2, 0, 0, 0); S3 = __builtin_amdgcn_mfma_f32_16x16x16bf16_1k(R_.k3, R_.vtf, S3, 0, 0, 0); \
                S0 = __builtin_amdgcn_mfma_f32_16x16x16bf16_1k(R_.b0, Ub, S0, 0, 0, 0); S1 = __builtin_amdgcn_mfma_f32_16x16x16bf16_1k(R_.b1, Ub, S1, 0, 0, 0); \
                S2 = __builtin_amdgcn_mfma_f32_16x16x16bf16_1k(R_.b2, Ub, S2, 0, 0, 0); S3 = __builtin_amdgcn_mfma_f32_16x16x16bf16_1k(R_.b3, Ub, S3, 0, 0, 0); \
                O = __builtin_amdgcn_mfma_f32_16x16x16bf16_1k(R_.g3f, Ub, O, 0, 0, 0);                   \
                NEXT_; \
                S0 = S0 * R_.w0; S1 = S1 * R_.w1; S2 = S2 * R_.w2; S3 = S3 * R_.w3; \
                float* op = O32 + (size_t)(NPAD + 16 * (n_) + 4 * kg) * D + h * 64 + 16 * rgw + l15;     \
                op[0] = O.x; op[D] = O.y; op[2 * D] = O.z; op[3 * D] = O.w; } while (0)
            SlotRegs RA, RB;
            CH_LOAD(RA, 0);
            for (int n = 0; n + 1 < RC_NCH; n += 2) {
                CH_COMPUTE(RA, n, CH_LOAD(RB, n + 1));
                if (n + 2 < RC_NCH) { CH_COMPUTE(RB, n + 1, CH_LOAD(RA, n + 2)); } else { CH_COMPUTE(RB, n + 1, (void)0); }
            }
            if (RC_NCH & 1) { CH_COMPUTE(RA, RC_NCH - 1, (void)0); }
            __builtin_amdgcn_s_setprio(0);
#undef CH_WAIT
#undef CH_LOAD
#undef CH_COMPUTE
        } else {
            const int p = wid - 1;
            LAS unsigned char* SC = L + RC_SCR0 + p * RC_SCR;
            const float kkc = F.in(23)[h * 64 + lane], kac = F.in(24)[h * 64 + lane];
            unsigned short cr[16], ck[16], cw[16], ca[16], nvq[4]; float civ[16];
#define RC_LOADS(nn) do { const int r0n = NPAD + 16 * (nn); \
                _Pragma("unroll") for (int e = 0; e < 4; ++e) nvq[e] = V[(size_t)(r0n + 4 * kg + e) * D + h * 64 + 16 * rgw + l15]; \
                _Pragma("unroll") for (int s = 0; s < 16; ++s) { const size_t off = (size_t)(r0n + s) * D + h * 64 + lane; cr[s] = Rr[off]; ck[s] = K[off]; cw[s] = W[off]; ca[s] = A[off]; civ[s] = INV[(size_t)(r0n + s) * 64 + h]; } } while (0)
            RC_LOADS(p);
            for (int n = p; n < RC_NCH; n += 7) {
                const int slot = n & 7; LAS unsigned char* SL = L + slot * RC_SLOT;
                unsigned short vq[4];
#pragma unroll
                for (int e = 0; e < 4; ++e) vq[e] = nvq[e];
#if RC_SYNC
                asm volatile("s_waitcnt lgkmcnt(0)" ::: "memory"); __builtin_amdgcn_s_barrier();
#else
                if (n >= 8) { unsigned sp = 0; while (lds_poll(flags + 8) < (unsigned)(n - 7)) { __builtin_amdgcn_s_sleep(2); if (++sp > (1u << 22)) break; } }
#endif
                asm volatile("" ::: "memory");
                float Wp = 1.f; unsigned btp[8], ktp[8];
#pragma unroll
                for (int hb = 0; hb < 2; ++hb) {
                    unsigned short rq[8], kq[8], wq[8], aq[8]; float iv[8];
#pragma unroll
                    for (int s = 0; s < 8; ++s) { rq[s] = cr[8 * hb + s]; kq[s] = ck[8 * hb + s]; wq[s] = cw[8 * hb + s]; aq[s] = ca[8 * hb + s]; iv[s] = civ[8 * hb + s]; }
                    float btv[8], ktv[8];
#pragma unroll
                    for (int s = 0; s < 8; ++s) {
                        const int t = 8 * hb + s;
                        const float rs = bf2f(rq[s]), ks = bf2f(kq[s]), wsv = bf2f(wq[s]), as = bf2f(aq[s]);
                        const float kk = ks * kkc * iv[s];
                        const float Wprev = Wp; Wp *= wsv; const float iW = __builtin_amdgcn_rcpf(Wp);
                        const float at = -kk * Wprev, rt = rs * Wp, bt = kk * as * iW, kt = ks * (1.f + (as - 1.f) * kac) * iW;
                        *(LAS bf16_t*)(SL + RC_AT + t * 136 + lane * 2) = f2bf(at); *(LAS bf16_t*)(SL + RC_RT + t * 136 + lane * 2) = f2bf(rt);
                        *(LAS bf16_t*)(SC + t * 136 + lane * 2) = f2bf(bt); *(LAS bf16_t*)(SC + 2176 + t * 136 + lane * 2) = f2bf(kt);
                        btv[s] = bt; ktv[s] = kt;
                    }
#pragma unroll
                    for (int s = 0; s < 4; ++s) { btp[4 * hb + s] = cvt_pk_bf16(btv[2 * s], btv[2 * s + 1]); ktp[4 * hb + s] = cvt_pk_bf16(ktv[2 * s], ktv[2 * s + 1]); }
                }
                {
                    LAS u32x2* bq = (LAS u32x2*)(SL + RC_BTT + lane * 40); LAS u32x2* kq2 = (LAS u32x2*)(SL + RC_KTT + lane * 40);
#pragma unroll
                    for (int q = 0; q < 4; ++q) { bq[q] = (u32x2){btp[2 * q], btp[2 * q + 1]}; kq2[q] = (u32x2){ktp[2 * q], ktp[2 * q + 1]}; }
                    *(LAS float*)(SL + RC_WC + lane * 4) = Wp;
                    u32x2 vt; vt.x = (unsigned)vq[0] | ((unsigned)vq[1] << 16); vt.y = (unsigned)vq[2] | ((unsigned)vq[3] << 16);
                    *(LAS u32x2*)(SL + RC_VTF + lane * 8) = vt;
                }
                if (n + 7 < RC_NCH) RC_LOADS(n + 7);
                asm volatile("s_waitcnt lgkmcnt(0)" ::: "memory");
                f32x4 G1 = {0.f, 0.f, 0.f, 0.f}, G2 = G1, G3 = G1, G4 = G1, G1t = G1;
#pragma unroll
                for (int ks = 0; ks < 2; ++ks) {
                    const bf16x8 fb = *(const LAS bf16x8*)(SC + l15 * 136 + (32 * ks + 8 * kg) * 2), fk = *(const LAS bf16x8*)(SC + 2176 + l15 * 136 + (32 * ks + 8 * kg) * 2);
                    const bf16x8 fa = *(const LAS bf16x8*)(SL + RC_AT + l15 * 136 + (32 * ks + 8 * kg) * 2), fr_ = *(const LAS bf16x8*)(SL + RC_RT + l15 * 136 + (32 * ks + 8 * kg) * 2);
                    G1 = __builtin_amdgcn_mfma_f32_16x16x32_bf16(fb, fa, G1, 0, 0, 0); G2 = __builtin_amdgcn_mfma_f32_16x16x32_bf16(fk, fa, G2, 0, 0, 0);
                    G1t = __builtin_amdgcn_mfma_f32_16x16x32_bf16(fa, fb, G1t, 0, 0, 0);
                    G3 = __builtin_amdgcn_mfma_f32_16x16x32_bf16(fb, fr_, G3, 0, 0, 0); G4 = __builtin_amdgcn_mfma_f32_16x16x32_bf16(fk, fr_, G4, 0, 0, 0);
                }
                {
#pragma unroll
                    for (int e = 0; e < 4; ++e) { const int s = 4 * kg + e; const bool lt = s < l15, le = s <= l15;
                        G1[e] = lt ? G1[e] : 0.f; G1t[e] = (l15 < s) ? G1t[e] : 0.f; G2[e] = lt ? G2[e] : 0.f; G3[e] = le ? G3[e] : 0.f; G4[e] = le ? G4[e] : 0.f; }
                    u32x2 g2, g3, g4; g2.x = cvt_pk_bf16(G2.x, G2.y); g2.y = cvt_pk_bf16(G2.z, G2.w); g3.x = cvt_pk_bf16(G3.x, G3.y); g3.y = cvt_pk_bf16(G3.z, G3.w); g4.x = cvt_pk_bf16(G4.x, G4.y); g4.y = cvt_pk_bf16(G4.z, G4.w);
                    *(LAS u32x2*)(SL + RC_G3F + lane * 8) = g3;
                    u32x2 vt; vt.x = (unsigned)vq[0] | ((unsigned)vq[1] << 16); vt.y = (unsigned)vq[2] | ((unsigned)vq[3] << 16);
                    const s16x4v vtf = *reinterpret_cast<s16x4v*>(&vt);
                    f32x4 P1 = {0.f, 0.f, 0.f, 0.f}, P2 = P1;
                    P1 = __builtin_amdgcn_mfma_f32_16x16x16bf16_1k(*reinterpret_cast<s16x4v*>(&g2), vtf, P1, 0, 0, 0);
                    P2 = __builtin_amdgcn_mfma_f32_16x16x16bf16_1k(*reinterpret_cast<s16x4v*>(&g4), vtf, P2, 0, 0, 0);
                    *(LAS f32x4*)(SL + RC_P1 + lane * 16) = P1; *(LAS f32x4*)(SL + RC_P2 + lane * 16) = P2;
#define RC_BF(v) ({ u32x2 t_; t_.x = cvt_pk_bf16((v).x, (v).y); t_.y = cvt_pk_bf16((v).z, (v).w); *reinterpret_cast<s16x4v*>(&t_); })
                    const f32x4 Z4 = {0.f, 0.f, 0.f, 0.f};
                    const s16x4v n1 = RC_BF(G1), n1t = RC_BF(G1t);
                    const f32x4 X2 = __builtin_amdgcn_mfma_f32_16x16x16bf16_1k(n1t, n1, Z4, 0, 0, 0), X2t = __builtin_amdgcn_mfma_f32_16x16x16bf16_1k(n1, n1t, Z4, 0, 0, 0);
                    const s16x4v n2 = RC_BF(X2), n2t = RC_BF(X2t);
                    const f32x4 X4 = __builtin_amdgcn_mfma_f32_16x16x16bf16_1k(n2t, n2, Z4, 0, 0, 0), X4t = __builtin_amdgcn_mfma_f32_16x16x16bf16_1k(n2, n2t, Z4, 0, 0, 0);
                    const s16x4v n4 = RC_BF(X4), n4t = RC_BF(X4t);
                    f32x4 Tm = __builtin_amdgcn_mfma_f32_16x16x16bf16_1k(n4t, n4, Z4, 0, 0, 0);
#pragma unroll
                    for (int e = 0; e < 4; ++e) Tm[e] += (4 * kg + e == l15) ? 1.f : 0.f;
                    Tm = __builtin_amdgcn_mfma_f32_16x16x16bf16_1k(n4t, RC_BF(Tm), Tm, 0, 0, 0);
                    Tm = __builtin_amdgcn_mfma_f32_16x16x16bf16_1k(n2t, RC_BF(Tm), Tm, 0, 0, 0);
                    Tm = __builtin_amdgcn_mfma_f32_16x16x16bf16_1k(n1t, RC_BF(Tm), Tm, 0, 0, 0);
                    { u32x2 tt; tt.x = cvt_pk_bf16(Tm.x, Tm.y); tt.y = cvt_pk_bf16(Tm.z, Tm.w); *(LAS u32x2*)(SL + RC_TT + lane * 8) = tt; }
#undef RC_BF
                }
                asm volatile("s_waitcnt lgkmcnt(0)" ::: "memory");
#if RC_SYNC
                __builtin_amdgcn_s_barrier();
#else
                if (lane == 0) flags[slot] = (unsigned)(n + 1);
#endif
            }
#if RC_SYNC
            if (p >= RC_NCH % 7) { __builtin_amdgcn_s_barrier(); __builtin_amdgcn_s_barrier(); }
#endif
        }
#undef RC_LOADS
        __syncthreads();
    }
}
__device__ __forceinline__ void rwkv_post(const Fr& F) {
    const bf16_t* Rr = slotY(F, 0); const bf16_t* K = slotY(F, 1); const bf16_t* V = slotY(F, 2); const bf16_t* GT = slotY(F, 3); const bf16_t* A = slotY(F, 5);
    const float* O32 = (const float*)slotU(F, 1); bf16_t* Z = slotU(F, 0);
    const float* k_a = F.in(24); const float* r_k = F.in(25); const float* lw = F.in(26); const float* lb = F.in(27);
    for (int r = F.gw; r < R; r += F.NGW) {
        const bool real = (r >= NPAD && r < NREAL);
        u32x2* zr = (u32x2*)(Z + (size_t)r * D) + F.lane;
        if (!real) { const u32x2 z = {0u, 0u};
#pragma unroll
            for (int it = 0; it < 16; ++it) zr[64 * it] = z;
            continue; }
        ROW_F32(oq, O32 + (size_t)r * D, F.lane); ROW_BF(rq_, Rr + (size_t)r * D, F.lane); ROW_BF(kq_, K + (size_t)r * D, F.lane); ROW_BF(vq_, V + (size_t)r * D, F.lane);
        ROW_BF(gq_, GT + (size_t)r * D, F.lane); ROW_BF(aq_, A + (size_t)r * D, F.lane); ROW_BF(zq_, Z + (size_t)r * D, F.lane);
        ROW_F32(kap, k_a, F.lane); ROW_F32(rkp, r_k, F.lane); ROW_F32(lwp, lw, F.lane); ROW_F32(lbp, lb, F.lane);
#pragma unroll
        for (int hh = 0; hh < 2; ++hh) {
            f32x4 o4v[8]; u32x2 rrv[8], kkv[8], vvv[8], ggv[8], aav[8];
#pragma unroll
            for (int i8 = 0; i8 < 8; ++i8) { const int it = 8 * hh + i8; o4v[i8] = AT_F32(oq, it); rrv[i8] = AT_BF(rq_, it); kkv[i8] = AT_BF(kq_, it); vvv[i8] = AT_BF(vq_, it); ggv[i8] = AT_BF(gq_, it); aav[i8] = AT_BF(aq_, it); }
#pragma unroll
            for (int i8 = 0; i8 < 8; ++i8) { const int it = 8 * hh + i8;
                const f32x4 o4 = o4v[i8]; const u32x2 rr = rrv[i8], kk = kkv[i8], vv = vvv[i8], gg = ggv[i8], aa = aav[i8];
                const f32x4 ka4 = AT_F32(kap, it), rk4 = AT_F32(rkp, it), lw4 = AT_F32(lwp, it), lb4 = AT_F32(lbp, it);
                const float mean = red16((o4.x + o4.y) + (o4.z + o4.w)) * (1.f / 64.f);
                const float d0 = o4.x - mean, d1 = o4.y - mean, d2 = o4.z - mean, d3 = o4.w - mean;
                const float var = red16((d0 * d0 + d1 * d1) + (d2 * d2 + d3 * d3)) * (1.f / 64.f);
                const float rs = __builtin_amdgcn_rsqf(var + 64e-5f);
                const float r0 = bflo(rr.x), r1 = bfhi(rr.x), r2 = bflo(rr.y), r3 = bfhi(rr.y);
                const float kp0 = bflo(kk.x) * (1.f + (bflo(aa.x) - 1.f) * ka4.x), kp1 = bfhi(kk.x) * (1.f + (bfhi(aa.x) - 1.f) * ka4.y), kp2 = bflo(kk.y) * (1.f + (bflo(aa.y) - 1.f) * ka4.z), kp3 = bfhi(kk.y) * (1.f + (bfhi(aa.y) - 1.f) * ka4.w);
                const float bs = red16((r0 * kp0 * rk4.x + r1 * kp1 * rk4.y) + (r2 * kp2 * rk4.z + r3 * kp3 * rk4.w));
                const float y0 = d0 * rs * lw4.x + lb4.x + bs * bflo(vv.x), y1 = d1 * rs * lw4.y + lb4.y + bs * bfhi(vv.x), y2 = d2 * rs * lw4.z + lb4.z + bs * bflo(vv.y), y3 = d3 * rs * lw4.w + lb4.w + bs * bfhi(vv.y);
                u32x2 w; w.x = cvt_pk_bf16(y0 * silu_f(bflo(gg.x)), y1 * silu_f(bfhi(gg.x))); w.y = cvt_pk_bf16(y2 * silu_f(bflo(gg.y)), y3 * silu_f(bfhi(gg.y)));
                AT_BF(zq_, it) = w;
            }
        }
    }
}
}
namespace mk {
constexpr int LDS_BYTES = 163840;
constexpr int LDS_MISC = LDS_BYTES - 128;
struct Args { const float* in[29]; float* out; unsigned char* ws; };

#define MK_GEMM(EPI, e, Aptr, aps_, Bptr, M_, N_, K_) do { int kk_ = (K_); asm volatile("" : "+s"(kk_));     \
    pg8::Gemm g_{(const bf16_t*)(Aptr), (const bf16_t*)(Bptr), (M_), (N_), kk_, (size_t)(aps_)}; pg8::StaticOrder S_; S_.init((M_), (N_), F.G, F.bid); \
    pg8::gemm_phase<EPI, pg8::StaticOrder, false>(F.lds, g_, S_, e, nullptr); } while (0)

struct TailOrder { int pn;
    __device__ bool next(int i, pg8::Unit& u) const { if (i > 0 || pn < 0) return false; u.pm = 64; u.pn = pn; return true; }
    __device__ __forceinline__ void a_ready(const pg8::Unit&) const {}
    __device__ __forceinline__ void done(const pg8::Unit&) const {}
};
#define MK_GEMM1(EPI, e, aps_, NTOT_, L_) do { MK_GEMM(EPI, e, slotU(F, 0), aps_, wtin_of(F, L_), 16384, NTOT_, D); \
    if (F.bid < (NTOT_) / 256) { int kk_ = D; asm volatile("" : "+s"(kk_)); pg8::Gemm g_{(const bf16_t*)slotU(F, 0), (const bf16_t*)wtin_of(F, L_), R, (NTOT_), kk_, (size_t)(aps_)}; TailOrder St_{F.bid}; \
        pg8::gemm_phase<EPI, TailOrder, false, true>(F.lds, g_, St_, e, nullptr); } } while (0)
#define MK_GEMM2_NORM(prev, next, udst) do { \
    MK_GEMM(EpiY, ey, slotU(F, 0), 0, wtout, 16384, D, D); \
    GRID_BAR(); \
    if (F.bid < 16) { int kk_ = D; asm volatile("" : "+s"(kk_)); pg8::Gemm g_{(const bf16_t*)slotU(F, 0), (const bf16_t*)wtout, R, D, kk_, (size_t)0}; TailOrder St_{F.bid}; \
        pg8::gemm_phase<EpiY, TailOrder, false, true>(F.lds, g_, St_, ey, nullptr); } \
    else { const Fr P = F.fresh(); norm_phase(P, prev, next, slotY(P, 0), udst, 0, 16384, 16); } \
    GRID_BAR(); \
    { const Fr P = F.fresh(); norm_phase(P, prev, next, slotY(P, 0), udst, 16384, R, 0); if ((next) >= 0) convert_layer(P, next, (next) == 3); } \
    GRID_BAR(); } while (0)

__global__ void __launch_bounds__(512, 2) fwd(Args a) {
    extern __shared__ __attribute__((aligned(16))) unsigned char lds_raw[];
    Fr F;
    F.lds = (LAS unsigned char*)lds_raw; F.ldsg = lds_raw;
    F.tid = threadIdx.x; F.lane = F.tid & 63; F.wave = __builtin_amdgcn_readfirstlane(F.tid >> 6);
    F.G = gridDim.x; F.bid = blockIdx.x; F.gw = F.bid * 8 + F.wave; F.NGW = F.G * 8;
    F.out = a.out; F.ws = a.ws;
    volatile LAS unsigned* misc = (volatile LAS unsigned*)(F.lds + LDS_MISC);
    if (F.tid < 16) misc[F.tid] = 0u;
    __syncthreads();
    XcdBarrier bar = xcd_barrier_post((unsigned*)(F.ws + WS_CTL) + 4096, misc + 8);
#define GRID_BAR() xcd_barrier(bar)
#ifndef MK_DUP
#define MK_DUP 0
#endif
#define DUPN(k, ...) do { __VA_ARGS__; if ((MK_DUP >> (k)) & 1) { GRID_BAR(); __VA_ARGS__; } } while (0)
    bf16_t* wtout = (bf16_t*)(F.ws + WS_WTOUT);
    const EpiY ey{slotY(F, 0)};

    DUPN(11, { const Fr P = F.fresh(); convert_layer(P, 0, true); rope_table(P); norm_phase(P, -1, 0, nullptr, slotU(P, 0)); });
    GRID_BAR();
    { const EpiH1 e{slotY(F, 0), F.in(5), 0}; MK_GEMM1(EpiH1, e, 0, 4 * D, 0); }
    if (F.bid >= 64) { const Fr P = F.fresh(); convert_win(P, 1, 64); }
    GRID_BAR();
    DUPN(1, { const Fr P = F.fresh(); hgrn_phase<false>(P, 0); });
    GRID_BAR();
    DUPN(2, { const Fr P = F.fresh(); hgrn_phase<true>(P, 0); });
    GRID_BAR();
    MK_GEMM2_NORM(0, 1, slotU(F, 0));
    { const EpiB1 e{slotY(F, 0), (const float*)(F.ws + WS_ROPE), (const float*)(F.ws + WS_ROPE) + (size_t)R * 16}; MK_GEMM1(EpiB1, e, 0, 4 * D, 1); }
    if (F.bid >= 64) { const Fr P = F.fresh(); convert_win(P, 2, 64); }
    GRID_BAR();
    DUPN(3, { const Fr P = F.fresh(); attn_phase(P); });
    GRID_BAR();
    DUPN(4, { const Fr P = F.fresh(); attn_post(P); });
    GRID_BAR();
    MK_GEMM2_NORM(1, 2, slotY(F, 1));
    DUPN(7, { const Fr P = F.fresh(); mix_phase(P, slotY(P, 1)); convert_layer2_b(P); });
    GRID_BAR();
    { const EpiC1 e{slotY(F, 0), (bf16_t*)(F.ws + WS_T)}; MK_GEMM(EpiC1, e, slotU(F, 0), (size_t)R * D, wtin_of(F, 2), R, 4 * D + 512, D); }
    GRID_BAR();
    DUPN(9, { const EpiC2 e{slotY(F, 0), F.in(17), F.in(20)}; MK_GEMM(EpiC2, e, F.ws + WS_T, 0, F.ws + WS_W2P, R, 2 * D, 256); });
    { const Fr P = F.fresh(); rwkv_kknorm(P); }
    GRID_BAR();
    DUPN(5, { const Fr P = F.fresh(); rwkv_scan(P); });
    GRID_BAR();
    DUPN(6, { const Fr P = F.fresh(); rwkv_post(P); });
    GRID_BAR();
    MK_GEMM2_NORM(2, 3, slotU(F, 0));
    { const EpiH1 e{slotY(F, 0), F.in(5), 1}; MK_GEMM1(EpiH1, e, 0, 4 * D, 3); }
    GRID_BAR();
    { const Fr P = F.fresh(); hgrn_phase<false>(P, 1); }
    GRID_BAR();
    { const Fr P = F.fresh(); hgrn_phase<true>(P, 1); }
    GRID_BAR();
    MK_GEMM2_NORM(3, -1, (bf16_t*)nullptr);
}
}

extern "C" void kernel_launch(void* const* d_in, const int* in_sizes, int n_in, void* d_out, int out_size, void* d_ws, size_t ws_size, hipStream_t stream) {
    static int grid = 0;
    if (grid == 0) {
        if (n_in != 29 || out_size != 16384 * 4096 || ws_size < mk::WS_END) { fprintf(stderr, "kernel_launch: unexpected shapes (n_in %d out %d ws %zu need %zu)\n", n_in, out_size, ws_size, (size_t)mk::WS_END); grid = -1; return; }
        int dev = 0, cus = 0, per_cu = 0;
        if (hipGetDevice(&dev) != hipSuccess || hipDeviceGetAttribute(&cus, hipDeviceAttributeMultiprocessorCount, dev) != hipSuccess) { grid = -1; return; }
        if (hipFuncSetAttribute((const void*)mk::fwd, hipFuncAttributeMaxDynamicSharedMemorySize, mk::LDS_BYTES) != hipSuccess) { fprintf(stderr, "kernel_launch: hipFuncSetAttribute failed\n"); grid = -1; return; }
        if (hipOccupancyMaxActiveBlocksPerMultiprocessor(&per_cu, (const void*)mk::fwd, 512, mk::LDS_BYTES) != hipSuccess || per_cu < 1) { fprintf(stderr, "kernel_launch: occupancy query says %d\n", per_cu); }
        (void)hipGetLastError();
        grid = cus;
    }
    if (grid < 0) return;
    if (hipMemsetAsync((char*)d_ws + mk::WS_CTL, 0, mk::CTL_BYTES, stream) != hipSuccess) return;
    mk::Args a{};
    for (int i = 0; i < 29; ++i) a.in[i] = (const float*)d_in[i];
    a.out = (float*)d_out; a.ws = (unsigned char*)d_ws;
    hipLaunchKernelGGL(mk::fwd, dim3(grid), dim3(512), mk::LDS_BYTES, stream, a);
}
```

```cpp
#include <hip/hip_runtime.h>
#include <cstdio>
#include <cstdint>

#define LAS __attribute__((address_space(3)))
#define GAS __attribute__((address_space(1)))
typedef unsigned short bf16_t;
typedef short bf16x8 __attribute__((ext_vector_type(8)));
typedef short s16x4 __attribute__((ext_vector_type(4)));
typedef float f32x4 __attribute__((ext_vector_type(4)));
typedef float f32x16 __attribute__((ext_vector_type(16)));
typedef unsigned u32x4 __attribute__((ext_vector_type(4)));
typedef unsigned u32x2 __attribute__((ext_vector_type(2)));

namespace mk {
constexpr int D = 4096, NPAD = 48, NREAL = 16448, R = 16640, NCH = 257;
constexpr size_t MiB = 1u << 20;
constexpr size_t SLOT = (size_t)R * D * 2;
constexpr size_t WS_CTL = 0, CTL_BYTES = 1 * MiB;
constexpr size_t WS_WTIN = 2 * MiB;
constexpr size_t WS_WTOUT = 134 * MiB;
constexpr size_t WS_W2P = 166 * MiB;
constexpr size_t WS_ROPE = 170 * MiB;
constexpr size_t WS_HMETA = 174 * MiB;
constexpr size_t WS_HE = 175 * MiB;
constexpr size_t WS_HLOGD = 191 * MiB;
constexpr size_t WS_U = 192 * MiB;
constexpr size_t WS_Y = WS_U + 6 * SLOT;
constexpr size_t WS_T = WS_Y + 6 * SLOT;
constexpr size_t WS_WTINB = WS_U + 4 * SLOT;
constexpr size_t WS_HB = (WS_T + (size_t)R * 256 * 2 + MiB - 1) / MiB * MiB;
constexpr size_t WS_END = WS_HB + SLOT;
static_assert(WS_END <= 2040 * MiB, "d_ws map");

typedef __bf16 bf16x2n_t __attribute__((ext_vector_type(2)));
typedef float f32x2n_t __attribute__((ext_vector_type(2)));
__device__ __forceinline__ unsigned cvt_pk_bf16(float lo, float hi) { const f32x2n_t v = {lo, hi}; const bf16x2n_t r = __builtin_convertvector(v, bf16x2n_t); return __builtin_bit_cast(unsigned, r); }
__device__ __forceinline__ float bflo(unsigned w) { return __uint_as_float(w << 16); }
__device__ __forceinline__ float bfhi(unsigned w) { return __uint_as_float(w & 0xffff0000u); }
__device__ __forceinline__ float bf2f(bf16_t b) { return __uint_as_float(((unsigned)b) << 16); }
__device__ __forceinline__ bf16_t f2bf(float f) { return (bf16_t)(cvt_pk_bf16(f, f) & 0xffffu); }
__device__ __forceinline__ float sigmoid_f(float x) { return 1.f / (1.f + __expf(-x)); }
__device__ __forceinline__ float silu_f(float x) { return x / (1.f + __expf(-x)); }
__device__ __forceinline__ float wave_sum(float v) {
#pragma unroll
    for (int o = 1; o < 64; o <<= 1) v += __shfl_xor(v, o);
    return v;
}
template <int CTRL> __device__ __forceinline__ float dppf(float v) { return __int_as_float(__builtin_amdgcn_update_dpp(0, __float_as_int(v), CTRL, 0xf, 0xf, true)); }
__device__ __forceinline__ float red4(float v) { v += dppf<0xB1>(v); v += dppf<0x4E>(v); return v; }
__device__ __forceinline__ float red8(float v) { v = red4(v); v += dppf<0x141>(v); return v; }
__device__ __forceinline__ float red16(float v) { v = red8(v); v += dppf<0x140>(v); return v; }
#define LDS_WAIT() asm volatile("s_waitcnt lgkmcnt(0)" ::: "memory")
}
#define XB_TMO      128
#define XB_XCNT(j)  (256  + 64 * (j))
#define XB_XSUB(j)  (1280 + 64 * (j))
#define XB_XGEN(j)  (2304 + 64 * (j))
#define XB_TOP      3328
#define XB_TOPGEN   3392
#define XCD_BAR_WORDS 3456
#define XB_SPIN_CAP (1u << 18)
#define LAS __attribute__((address_space(3)))

__device__ __forceinline__ unsigned xb_ld(unsigned* p)              { return __hip_atomic_load(p, __ATOMIC_RELAXED, __HIP_MEMORY_SCOPE_AGENT); }
__device__ __forceinline__ unsigned xb_add(unsigned* p, unsigned v) { return __hip_atomic_fetch_add(p, v, __ATOMIC_RELAXED, __HIP_MEMORY_SCOPE_AGENT); }
__device__ __forceinline__ unsigned xb_xcc_id() { return (unsigned)__builtin_amdgcn_s_getreg((3 << 11) | 20) & 0xFu; }
#define XB_SPIN(cond, bar) do { unsigned _sp = 0; while (cond) { __builtin_amdgcn_s_sleep(1); \
    if ((++_sp & 255u) == 0u) { if (xb_ld(&(bar)[XB_TMO])) break; if (_sp > XB_SPIN_CAP) { atomicAdd(&(bar)[XB_TMO], 1u); break; } } } } while (0)

struct XcdBarrier {
    unsigned* bar; unsigned x;
    volatile LAS unsigned* st;
};

__device__ __forceinline__ XcdBarrier xcd_barrier_post(unsigned* bar, volatile LAS unsigned* st) {
    XcdBarrier b; b.bar = bar; b.x = xb_xcc_id(); b.st = st;
    if (threadIdx.x == 0) (void)xb_add(&bar[XB_XCNT(b.x)], 1u);
    return b;
}
__device__ __forceinline__ void xcd_barrier_complete(unsigned* bar, unsigned x, unsigned& nloc, unsigned& nx) {
    const unsigned G = gridDim.x * gridDim.y * gridDim.z;
    unsigned sum, cnt, mine, sp = 0u;
    for (;;) {
        sum = 0u; cnt = 0u; mine = 0u;
#pragma unroll
        for (unsigned j = 0; j < 16; ++j) { const unsigned c = xb_ld(&bar[XB_XCNT(j)]); sum += c; cnt += (c > 0u) ? 1u : 0u; mine = (j == x) ? c : mine; }
        if (sum == G) break;
        __builtin_amdgcn_s_sleep(1);
        if ((++sp & 255u) == 0u) { if (xb_ld(&bar[XB_TMO])) break; if (sp > XB_SPIN_CAP) { atomicAdd(&bar[XB_TMO], 1u); break; } }
    }
    nloc = mine > 0u ? mine : 1u; nx = cnt > 0u ? cnt : 1u;
}

__device__ __forceinline__ void xcd_barrier(const XcdBarrier& b) {
    asm volatile("s_waitcnt vmcnt(0)" ::: "memory");
    __syncthreads();
    if (threadIdx.x == 0) {
        unsigned* bar = b.bar;
        __builtin_amdgcn_s_waitcnt(0);
        unsigned nloc = b.st[0], nx = b.st[1];
        if (nloc == 0u) { xcd_barrier_complete(bar, b.x, nloc, nx); b.st[0] = nloc; b.st[1] = nx; }
        const unsigned old = xb_add(&bar[XB_XSUB(b.x)], 1u);
        const unsigned gen = old / nloc;
        if (old + 1u == (gen + 1u) * nloc) {
            __builtin_amdgcn_fence(__ATOMIC_RELEASE, "agent");
            asm volatile("s_waitcnt vmcnt(0)" ::: "memory");
            const unsigned og = xb_add(&bar[XB_TOP], 1u);
            const unsigned tg = og / nx;
            if (og + 1u == (tg + 1u) * nx) xb_add(&bar[XB_TOPGEN], 1u);
            else XB_SPIN(xb_ld(&bar[XB_TOPGEN]) == tg, bar);
            __builtin_amdgcn_fence(__ATOMIC_ACQUIRE, "agent");
            xb_add(&bar[XB_XGEN(b.x)], 1u);
            asm volatile("s_waitcnt vmcnt(0)" ::: "memory");
        } else {
            XB_SPIN(xb_ld(&bar[XB_XGEN(b.x)]) == gen, bar);
            __builtin_amdgcn_fence(__ATOMIC_ACQUIRE, "agent");
            asm volatile("s_waitcnt vmcnt(0)" ::: "memory");
        }
    }
    __syncthreads();
}
namespace pg8 {
#define PG8_LAS __attribute__((address_space(3)))
typedef unsigned short bf16_t;
typedef short bf16x8 __attribute__((ext_vector_type(8)));
typedef float f32x4 __attribute__((ext_vector_type(4)));
typedef unsigned u32x4 __attribute__((ext_vector_type(4)));
constexpr int BM = 256, BK = 64, HALF = 128, HTB = HALF * BK * 2  , STAGE_BYTES = 8 * HTB, NXCD = 8, WGM = 8;

__host__ __device__ __forceinline__ int lds_byte(int r, int c) { const int st = (r >> 4) * 2 + (c >> 5), rr = r & 15, cc = c & 31, ob = rr * 64 + cc * 2; return st * 1024 + (ob ^ (((ob >> 9) & 1) << 5)); }
__host__ __device__ __forceinline__ void stage_rc(int b, int& R, int& C) { const int st = b / 1024, sb = b % 1024, swz = sb ^ (((sb >> 9) & 1) << 5); R = (st >> 1) * 16 + swz / 64; C = (st & 1) * 32 + (swz % 64) / 2; }
__host__ __device__ __forceinline__ int perm32(int rho) { const int n = rho >> 4, i = rho & 15; return 8 * (i >> 2) + 4 * n + (i & 3); }

struct Unit { int pm, pn; };
struct Gemm { const bf16_t* A; const bf16_t* Bt; int M, N, K; size_t aps; };
__device__ __forceinline__ size_t a_part_bytes(const Gemm& g, int pn) { return g.aps ? (size_t)(pn < 64 ? (pn >> 4) : (pn - 60)) * g.aps * 2 : (size_t)0; }

struct StaticOrder {
    int nM, nN, nwg, G, c;
    __host__ __device__ void init(int M, int N, int G_, int c_) { nM = M / BM; nN = N / BM; nwg = nM * nN; G = G_; c = c_; }
    __host__ __device__ bool next(int i, Unit& u) const {
        const long L = (long)i * G + c; if (L >= nwg) return false;
        int wgid = (int)L; { const int q = nwg / NXCD, r = nwg % NXCD, xcd = wgid % NXCD, off = wgid / NXCD; wgid = (xcd < r ? xcd * (q + 1) : r * (q + 1) + (xcd - r) * q) + off; }
        const int nig = WGM * nN, gid = wgid / nig, fm = gid * WGM, gsz = (nM - fm) < WGM ? (nM - fm) : WGM;
        u.pm = fm + ((wgid % nig) % gsz); u.pn = (wgid % nig) / gsz; return true;
    }
    __device__ __forceinline__ void a_ready(const Unit&) const {}
    __device__ __forceinline__ void done(const Unit&) const {}
};
struct CountedOrder : StaticOrder {
    const unsigned* ready; unsigned need; unsigned* tmo;
    __device__ __forceinline__ void a_ready(const Unit& u) const {
        if (threadIdx.x < 64) {
            const unsigned long long t0 = __builtin_amdgcn_s_memrealtime(); unsigned polls = 0;
            while ((unsigned)__builtin_amdgcn_readfirstlane(__hip_atomic_load(ready + 64 * u.pm, __ATOMIC_RELAXED, __HIP_MEMORY_SCOPE_AGENT)) < need) {
                if ((++polls & 255u) == 0u && __builtin_amdgcn_readfirstlane(__hip_atomic_load(tmo, __ATOMIC_RELAXED, __HIP_MEMORY_SCOPE_AGENT)) != 0u) break;
                if (__builtin_amdgcn_s_memrealtime() - t0 > 2000000ull) {
                    if (threadIdx.x == 0) { unsigned expect = 0u; __hip_atomic_compare_exchange_strong(tmo + 1, &expect, 0x600u | (unsigned)(u.pm & 0xff), __ATOMIC_RELAXED, __ATOMIC_RELAXED, __HIP_MEMORY_SCOPE_AGENT); __hip_atomic_store(tmo, 1u, __ATOMIC_RELAXED, __HIP_MEMORY_SCOPE_AGENT); }
                    break; }
                __builtin_amdgcn_s_sleep(2); }
            __builtin_amdgcn_fence(__ATOMIC_ACQUIRE, "agent");
            asm volatile("s_waitcnt vmcnt(0)" ::: "memory");
        }
#if !defined(BROKEN_HOOK_NO_BARRIER)
        asm volatile("" ::: "memory"); __builtin_amdgcn_s_barrier(); asm volatile("" ::: "memory");
#endif
    }
};
template <class Epi, class Sched, bool STAMP = false, bool TOPHALF = false>
__device__ __forceinline__ void gemm_phase(PG8_LAS unsigned char* lds, const Gemm g, const Sched& S, const Epi& E, unsigned long long* stamps) {
    int tid_ = threadIdx.x; asm volatile("" : "+v"(tid_));
    const int tid = tid_, wid = __builtin_amdgcn_readfirstlane(tid >> 6), lane = tid & 63, wr = wid >> 2, wc = wid & 3, fr = lane & 15, fq = lane >> 4;
    const int K = g.K, nt = K / BK;
    int ts_lo = 0, ts_hi = 0, nts = 0; const unsigned long long rt_entry = STAMP ? (unsigned long long)wall_clock64() : 0ull;
#define PG8_STAMP() do { if (STAMP && wid == 0 && nts < 64) { const unsigned long long _c = (unsigned long long)clock64(); \
        ts_lo = (lane == nts) ? (int)(unsigned)_c : ts_lo; ts_hi = (lane == nts) ? (int)(unsigned)(_c >> 32) : ts_hi; ++nts; } } while (0)
    PG8_STAMP();
    unsigned voffA[2], voffB[2];
#pragma unroll
    for (int i = 0; i < 2; ++i) { int R, C; stage_rc(tid * 16 + i * 8192, R, C); const int Rb = Epi::PERM ? ((R & ~31) + perm32(R & 31)) : R;
        voffA[i] = (unsigned)(R * K + C) * 2u; voffB[i] = (unsigned)(Rb * K + C) * 2u; }
    const size_t kstep = (size_t)(BK * 2);
    const size_t hstep = (size_t)HALF * K * 2;
    const size_t tstep = 2 * hstep;
    const unsigned ldsw = (unsigned)wid * 1024u;
    const int aoff = lds_byte(wr * 64 + fr, fq * 8), boff = lds_byte(wc * 32 + fr, fq * 8);
#define PG8_SA(b, h) (((b) * 2 + (h)) * HTB)
#define PG8_SB(b, h) ((4 + (b) * 2 + (h)) * HTB)
#define PG8_STAGE(bufoff, gbase, voff) do { _Pragma("unroll") for (int _i = 0; _i < 2; ++_i) \
        __builtin_amdgcn_global_load_lds((const unsigned*)((const char*)(gbase) + (voff)[_i]), (PG8_LAS unsigned*)(lds + (bufoff) + ldsw + _i * 8192), 16, 0, 0); } while (0)
#define PG8_LDA(dst, b, h) do { _Pragma("unroll") for (int m = 0; m < 4; ++m) _Pragma("unroll") for (int k = 0; k < 2; ++k) dst[m][k] = *(const PG8_LAS bf16x8*)(lds + PG8_SA(b, h) + aoff + m * 2048 + k * 1024); } while (0)
#define PG8_LDB(dst, b, h) do { _Pragma("unroll") for (int n = 0; n < 2; ++n) _Pragma("unroll") for (int k = 0; k < 2; ++k) dst[n][k] = *(const PG8_LAS bf16x8*)(lds + PG8_SB(b, h) + boff + n * 2048 + k * 1024); } while (0)
#define PG8_MMA(ai, bj, At, Bt) do { __builtin_amdgcn_s_setprio(1); _Pragma("unroll") for (int m = 0; m < 4; ++m) _Pragma("unroll") for (int n = 0; n < 2; ++n) _Pragma("unroll") for (int k = 0; k < 2; ++k) \
        acc[ai][bj][m][n] = __builtin_amdgcn_mfma_f32_16x16x32_bf16(Bt[n][k], At[m][k], acc[ai][bj][m][n], 0, 0, 0); __builtin_amdgcn_s_setprio(0); } while (0)
#define PG8_WAIT_V(n) asm volatile("s_waitcnt vmcnt(" #n ")" ::: "memory")
#define PG8_WAIT_L(n) asm volatile("s_waitcnt lgkmcnt(" #n ")" ::: "memory")
#define PG8_BAR __builtin_amdgcn_s_barrier()
#define PG8_SCHED __builtin_amdgcn_sched_barrier(0)
    Unit cur, nxt; int ui = 0;
    if (!S.next(0, cur)) return;
    f32x4 acc[2][2][4][2];
#pragma unroll
    for (int a = 0; a < 2; ++a)
#pragma unroll
        for (int b = 0; b < 2; ++b)
#pragma unroll
            for (int m = 0; m < 4; ++m)
#pragma unroll
                for (int n = 0; n < 2; ++n) acc[a][b][m][n] = (f32x4){0.f, 0.f, 0.f, 0.f};
    bf16x8 At[4][2], B0[2][2], B1[2][2];
    const char* cA = (const char*)g.A + a_part_bytes(g, cur.pn) + (size_t)cur.pm * tstep; const char* cB = (const char*)g.Bt + (size_t)cur.pn * tstep;
    S.a_ready(cur);
    PG8_STAGE(PG8_SB(0, 0), cB, voffB); PG8_STAGE(PG8_SA(0, 0), cA, voffA); PG8_STAGE(PG8_SB(0, 1), cB + hstep, voffB); PG8_STAGE(PG8_SA(0, 1), cA + hstep, voffA);
    if (wr == 1) PG8_BAR;
    PG8_WAIT_V(4); PG8_BAR;
    PG8_STAGE(PG8_SB(1, 0), cB + kstep, voffB); PG8_STAGE(PG8_SA(1, 0), cA + kstep, voffA); PG8_STAGE(PG8_SB(1, 1), cB + hstep + kstep, voffB);
    PG8_WAIT_V(6); PG8_BAR;
    PG8_STAMP();
    for (;;) {
        const bool has_next = S.next(ui + 1, nxt);
        const char* nA = has_next ? (const char*)g.A + a_part_bytes(g, nxt.pn) + (size_t)nxt.pm * tstep : cA; const char* nB = has_next ? (const char*)g.Bt + (size_t)nxt.pn * tstep : cB;
        for (int t = 0; t < nt; t += 2) {
            const bool last = (t == nt - 2);
            const char* a1 = cA + (size_t)(t + 1) * kstep;
            const char* a2 = last ? nA : cA + (size_t)(t + 2) * kstep; const char* b2 = last ? nB : cB + (size_t)(t + 2) * kstep;
            const char* a3 = a2 + kstep; const char* b3 = b2 + kstep;
            if (last && has_next) S.a_ready(nxt);
            PG8_LDB(B0, 0, 0); PG8_SCHED; PG8_LDA(At, 0, 0); PG8_STAGE(PG8_SA(1, 1), a1 + hstep, voffA);
            PG8_WAIT_L(8); PG8_BAR; PG8_WAIT_L(0); PG8_MMA(0, 0, At, B0); PG8_BAR; PG8_SCHED;
            PG8_LDB(B1, 0, 1); PG8_STAGE(PG8_SB(0, 0), b2, voffB);
            PG8_BAR; PG8_WAIT_L(0); PG8_MMA(0, 1, At, B1); PG8_BAR;
            if constexpr (!TOPHALF) PG8_LDA(At, 0, 1); PG8_STAGE(PG8_SA(0, 0), a2, voffA);
            PG8_BAR; PG8_WAIT_L(0); if constexpr (!TOPHALF) PG8_MMA(1, 0, At, B0); PG8_BAR; PG8_SCHED;
            PG8_STAGE(PG8_SB(0, 1), b2 + hstep, voffB);
            PG8_WAIT_V(6); PG8_BAR; if constexpr (!TOPHALF) PG8_MMA(1, 1, At, B1); PG8_BAR;
            PG8_LDB(B0, 1, 0); PG8_SCHED; PG8_LDA(At, 1, 0); PG8_STAGE(PG8_SA(0, 1), a2 + hstep, voffA);
            PG8_WAIT_L(8); PG8_BAR; PG8_WAIT_L(0); PG8_MMA(0, 0, At, B0); PG8_BAR; PG8_SCHED;
            PG8_LDB(B1, 1, 1); PG8_STAGE(PG8_SB(1, 0), b3, voffB);
            PG8_BAR; PG8_WAIT_L(0); PG8_MMA(0, 1, At, B1); PG8_BAR;
            if constexpr (!TOPHALF) PG8_LDA(At, 1, 1); PG8_STAGE(PG8_SA(1, 0), a3, voffA);
            PG8_BAR; PG8_WAIT_L(0); if constexpr (!TOPHALF) PG8_MMA(1, 0, At, B0); PG8_BAR; PG8_SCHED;
            PG8_STAGE(PG8_SB(1, 1), b3 + hstep, voffB);
            PG8_WAIT_V(6); PG8_BAR; if constexpr (!TOPHALF) PG8_MMA(1, 1, At, B1); PG8_BAR;
        }
        PG8_STAMP();
        if constexpr (!Epi::AFTER_DRAIN) { E(acc, cur, wr, wc, fr, fq); S.done(cur); }
        PG8_STAMP();
        if (!has_next) break;
#pragma unroll
        for (int a = 0; a < 2; ++a)
#pragma unroll
            for (int b = 0; b < 2; ++b)
#pragma unroll
                for (int m = 0; m < 4; ++m)
#pragma unroll
                    for (int n = 0; n < 2; ++n) acc[a][b][m][n] = (f32x4){0.f, 0.f, 0.f, 0.f};
        cur = nxt; cA = nA; cB = nB; ++ui;
    }
    PG8_WAIT_V(0);
    if (wr == 0) PG8_BAR;
    PG8_BAR;
    if constexpr (Epi::AFTER_DRAIN) { E.fused(acc, cur, wr, wc, fr, fq, lds, wid, lane); S.done(cur); }
    PG8_STAMP();
    if (STAMP && wid == 0) { stamps[lane] = lane < nts ? (((unsigned long long)(unsigned)ts_hi << 32) | (unsigned)ts_lo) : 0ull;
        if (lane == 62) stamps[62] = rt_entry; if (lane == 63) stamps[63] = (unsigned long long)wall_clock64(); }
#undef PG8_STAMP
#undef PG8_SA
#undef PG8_SB
#undef PG8_STAGE
#undef PG8_LDA
#undef PG8_LDB
#undef PG8_MMA
#undef PG8_WAIT_V
#undef PG8_WAIT_L
#undef PG8_BAR
#undef PG8_SCHED
}
}
namespace mk {
typedef pg8::Unit Unit;
typedef const pg8::f32x4 (&AccRef)[2][2][4][2];

__device__ __forceinline__ void st_bf8(bf16_t* p, pg8::f32x4 v0, pg8::f32x4 v1) {
    u32x4 w; w.x = cvt_pk_bf16(v0[0], v0[1]); w.y = cvt_pk_bf16(v0[2], v0[3]); w.z = cvt_pk_bf16(v1[0], v1[1]); w.w = cvt_pk_bf16(v1[2], v1[3]);
    *(u32x4*)p = w;
}
__device__ __forceinline__ void st_bf4(bf16_t* p, pg8::f32x4 v) { u32x2 w; w.x = cvt_pk_bf16(v[0], v[1]); w.y = cvt_pk_bf16(v[2], v[3]); *(u32x2*)p = w; }

struct EpiY {
    static constexpr bool PERM = true, AFTER_DRAIN = false;
    bf16_t* O;
    __device__ __forceinline__ void operator()(AccRef acc, const Unit& u, int wr, int wc, int fr, int fq) const {
        const int row0 = u.pm * 256 + wr * 64 + fr, col0 = u.pn * 256 + wc * 32 + 8 * fq;
#pragma unroll
        for (int ai = 0; ai < 2; ++ai)
#pragma unroll
            for (int m = 0; m < 4; ++m) { bf16_t* rowp = O + (size_t)(row0 + ai * 128 + m * 16) * D + col0;
#pragma unroll
                for (int bj = 0; bj < 2; ++bj) st_bf8(rowp + bj * 128, acc[ai][bj][m][0], acc[ai][bj][m][1]); }
    }
};
struct EpiH1 {
    static constexpr bool PERM = true, AFTER_DRAIN = false;
    bf16_t* Y; const float* lbl; int jl;
    __device__ __forceinline__ void operator()(AccRef acc, const Unit& u, int wr, int wc, int fr, int fq) const {
        const int part = u.pn >> 4, colt = (u.pn & 15) * 256;
        const int row0 = u.pm * 256 + wr * 64 + fr, col0 = colt + wc * 32 + 8 * fq;
        if (part == 1) {
#pragma unroll
            for (int bj = 0; bj < 2; ++bj) {
                pg8::f32x4 lbv[2] = {{0.f, 0.f, 0.f, 0.f}, {0.f, 0.f, 0.f, 0.f}};
                if (jl) {
#pragma unroll
                    for (int n = 0; n < 2; ++n) { const pg8::f32x4 l0 = *(const pg8::f32x4*)(lbl + col0 + bj * 128 + 4 * n), l1 = *(const pg8::f32x4*)(lbl + D + col0 + bj * 128 + 4 * n);
#pragma unroll
                        for (int j = 0; j < 4; ++j) lbv[n][j] = sigmoid_f(l1[j] - l0[j]); }
                }
#pragma unroll
                for (int ai = 0; ai < 2; ++ai)
#pragma unroll
                    for (int m = 0; m < 4; ++m) {
                        const int row = row0 + ai * 128 + m * 16;
                        pg8::f32x4 o[2];
#pragma unroll
                        for (int n = 0; n < 2; ++n)
#pragma unroll
                            for (int j = 0; j < 4; ++j) {
                                const float x = acc[ai][bj][m][n][j]; float g;
                                if (jl) { const float l = lbv[n][j]; g = __logf(l + (1.f - l) * sigmoid_f(x)); }
                                else g = fminf(x, 0.f) - __logf(1.f + __expf(-fabsf(x)));
                                o[n][j] = (row < NPAD) ? 0.f : g;
                            }
                        float* gp = (float*)(Y + 3 * (SLOT / 2)) + (size_t)row * D + col0 + bj * 128;
                        *(pg8::f32x4*)gp = o[0]; *(pg8::f32x4*)(gp + 4) = o[1];
                    }
            }
        } else {
            bf16_t* dst = Y + (size_t)(part == 0 ? 0 : (part == 2 ? 1 : 2)) * (SLOT / 2);
#pragma unroll
            for (int ai = 0; ai < 2; ++ai)
#pragma unroll
                for (int m = 0; m < 4; ++m) { bf16_t* rowp = dst + (size_t)(row0 + ai * 128 + m * 16) * D + col0;
#pragma unroll
                    for (int bj = 0; bj < 2; ++bj) st_bf8(rowp + bj * 128, acc[ai][bj][m][0], acc[ai][bj][m][1]); }
        }
    }
};
struct EpiB1 {
    static constexpr bool PERM = false, AFTER_DRAIN = false;
    bf16_t* Y; const float* cs; const float* sn;
    __device__ __forceinline__ void operator()(AccRef acc, const Unit& u, int wr, int wc, int fr, int fq) const {
        const int part = u.pn >> 4, colt = (u.pn & 15) * 256;
        const int row0 = u.pm * 256 + wr * 64 + fr, col0 = colt + wc * 32 + 4 * fq;
        bf16_t* dst = Y + (size_t)part * (SLOT / 2);
        const bool rope = (part < 2) && (wc == 0);
#pragma unroll
        for (int ai = 0; ai < 2; ++ai)
#pragma unroll
            for (int m = 0; m < 4; ++m) {
                const int row = row0 + ai * 128 + m * 16;
                pg8::f32x4 c4 = {1.f, 1.f, 1.f, 1.f}, s4 = {0.f, 0.f, 0.f, 0.f};
                if (rope) { c4 = *(const pg8::f32x4*)(cs + (size_t)row * 16 + 4 * fq); s4 = *(const pg8::f32x4*)(sn + (size_t)row * 16 + 4 * fq); }
                bf16_t* rowp = dst + (size_t)row * D + col0;
#pragma unroll
                for (int bj = 0; bj < 2; ++bj) {
                    const pg8::f32x4 x1 = acc[ai][bj][m][0], x2 = acc[ai][bj][m][1];
                    const pg8::f32x4 y1 = x1 * c4 - x2 * s4, y2 = x2 * c4 + x1 * s4;
                    st_bf4(rowp + bj * 128, y1); st_bf4(rowp + bj * 128 + 16, y2);
                }
            }
    }
};
struct EpiC1 {
    static constexpr bool PERM = true, AFTER_DRAIN = false;
    bf16_t *Y, *T;
    __device__ __forceinline__ void operator()(AccRef acc, const Unit& u, int wr, int wc, int fr, int fq) const {
        const int row0 = u.pm * 256 + wr * 64 + fr;
        if (u.pn < 64) {
            const int part = u.pn >> 4, col0 = (u.pn & 15) * 256 + wc * 32 + 8 * fq;
            bf16_t* dst = Y + (size_t)part * (SLOT / 2);
#pragma unroll
            for (int ai = 0; ai < 2; ++ai)
#pragma unroll
                for (int m = 0; m < 4; ++m) { bf16_t* rowp = dst + (size_t)(row0 + ai * 128 + m * 16) * D + col0;
#pragma unroll
                    for (int bj = 0; bj < 2; ++bj) st_bf8(rowp + bj * 128, acc[ai][bj][m][0], acc[ai][bj][m][1]); }
        } else {
            const int which = u.pn - 64, col0 = which * 128 + wc * 32 + 8 * fq;
#pragma unroll
            for (int ai = 0; ai < 2; ++ai)
#pragma unroll
                for (int m = 0; m < 4; ++m) {
                    pg8::f32x4 v0 = acc[ai][0][m][0], v1 = acc[ai][0][m][1];
                    if (which == 0) {
#pragma unroll
                        for (int j = 0; j < 4; ++j) { v0[j] = 1.f - 2.f / (1.f + __expf(2.f * v0[j])); v1[j] = 1.f - 2.f / (1.f + __expf(2.f * v1[j])); }
                    }
                    st_bf8(T + (size_t)(row0 + ai * 128 + m * 16) * 256 + col0, v0, v1);
                }
        }
    }
};
struct EpiC2 {
    static constexpr bool PERM = true, AFTER_DRAIN = false;
    bf16_t* Y; const float* w0; const float* a0;
    __device__ __forceinline__ void operator()(AccRef acc, const Unit& u, int wr, int wc, int fr, int fq) const {
        const int row0 = u.pm * 256 + wr * 64 + fr;
        const bool isw = u.pn < 16;
        const int col0 = (u.pn & 15) * 256 + wc * 32 + 8 * fq;
        bf16_t* dst = Y + (size_t)(isw ? 4 : 5) * (SLOT / 2); const float* bias = isw ? w0 : a0;
#pragma unroll
        for (int bj = 0; bj < 2; ++bj) {
            const pg8::f32x4 b0 = *(const pg8::f32x4*)(bias + col0 + bj * 128), b1 = *(const pg8::f32x4*)(bias + col0 + bj * 128 + 4);
#pragma unroll
            for (int ai = 0; ai < 2; ++ai)
#pragma unroll
                for (int m = 0; m < 4; ++m) {
                    pg8::f32x4 v0 = acc[ai][bj][m][0] + b0, v1 = acc[ai][bj][m][1] + b1;
#pragma unroll
                    for (int j = 0; j < 4; ++j) {
                        float s0 = sigmoid_f(v0[j]), s1 = sigmoid_f(v1[j]);
                        if (isw) { s0 = __expf(-0.606531f * s0); s1 = __expf(-0.606531f * s1); }
                        v0[j] = s0; v1[j] = s1;
                    }
                    st_bf8(dst + (size_t)(row0 + ai * 128 + m * 16) * D + col0 + bj * 128, v0, v1);
                    __builtin_amdgcn_sched_barrier(0);
                }
        }
    }
};

struct Fr {
    LAS unsigned char* lds; unsigned char* ldsg;
    int tid, lane, wave, G, bid, gw, NGW;
    float* out; unsigned char* ws;
    __device__ __forceinline__ Fr fresh() const { Fr P = *this; asm volatile("" : "+v"(P.tid)); P.lane = P.tid & 63; P.wave = __builtin_amdgcn_readfirstlane(P.tid >> 6); P.gw = P.bid * 8 + P.wave; return P; }
    __device__ __forceinline__ const float* in(int i) const {
        const __attribute__((address_space(4))) unsigned long long* ka = (const __attribute__((address_space(4))) unsigned long long*)__builtin_amdgcn_kernarg_segment_ptr();
        asm volatile("" : "+s"(ka));
        return (const float*)ka[i];
    }
};
__device__ __forceinline__ bf16_t* slotU(const Fr& F, int s) { return (bf16_t*)(F.ws + WS_U + (size_t)s * SLOT); }
__device__ __forceinline__ bf16_t* slotY(const Fr& F, int s) { return (bf16_t*)(F.ws + WS_Y + (size_t)s * SLOT); }
__device__ __forceinline__ float* hrow(const Fr& F, int r) { return r < 64 ? (float*)(F.ws + WS_HMETA) + (size_t)r * D : F.out + (size_t)(r - 64) * D; }

__device__ __forceinline__ void transpose_item(const float* W, int ldw, bf16_t* WT, int ldt, int koff, LAS float* scr, int kb, int nb, int lane) {
    const int k0 = 64 * kb, n0 = 32 * nb;
    float wv[32];
#pragma unroll
    for (int i = 0; i < 32; ++i) wv[i] = W[(size_t)(k0 + 2 * i + (lane >> 5)) * ldw + n0 + (lane & 31)];
#pragma unroll
    for (int i = 0; i < 32; ++i) scr[(2 * i + (lane >> 5)) * 33 + (lane & 31)] = wv[i];
    LDS_WAIT(); asm volatile("" ::: "memory");
    const int c = lane & 7;
#pragma unroll
    for (int j = 0; j < 4; ++j) { const int n = (lane >> 3) + 8 * j; const LAS float* s = scr + (8 * c) * 33 + n;
        u32x4 o; o.x = cvt_pk_bf16(s[0 * 33], s[1 * 33]); o.y = cvt_pk_bf16(s[2 * 33], s[3 * 33]); o.z = cvt_pk_bf16(s[4 * 33], s[5 * 33]); o.w = cvt_pk_bf16(s[6 * 33], s[7 * 33]);
        *(u32x4*)(WT + (size_t)(n0 + n) * ldt + koff + k0 + 8 * c) = o; }
    LDS_WAIT(); asm volatile("" ::: "memory");
}
__device__ __forceinline__ void convert_matrix(const Fr& F, const float* W, int K, int N, bf16_t* WT, int ldt, int koff, int wg_skip = 0) {
    LAS float* scr = (LAS float*)(F.lds + F.wave * 8704);
    const int nblk = N / 32, nitems = (K / 64) * nblk;
    for (int it = F.gw - wg_skip * 8; it < nitems; it += F.NGW - wg_skip * 8) transpose_item(W, N, WT, ldt, koff, scr, it / nblk, it % nblk, F.lane);
}
__device__ __forceinline__ void zero_bytes(const Fr& F, void* p, size_t nbytes) {
    u32x4* q = (u32x4*)p; const size_t n = nbytes / 16; const u32x4 z = {0u, 0u, 0u, 0u};
    for (size_t i = (size_t)F.bid * 512 + F.tid; i < n; i += (size_t)F.G * 512) q[i] = z;
}
__device__ __forceinline__ bf16_t* wtin_of(const Fr& F, int L) { return (bf16_t*)(F.ws + ((L & 1) ? WS_WTINB : WS_WTIN)); }
__device__ __forceinline__ void convert_win(const Fr& F, int L, int wg_skip) {
    const float* src = (L == 0 || L == 3) ? F.in(4) + (size_t)(L ? 1 : 0) * D * 4 * D : (L == 1 ? F.in(8) : F.in(16));
    convert_matrix(F, src, D, 4 * D, wtin_of(F, L), D, 0, wg_skip);
}
__device__ __forceinline__ void convert_layer(const Fr& F, int L, bool with_win) {
    bf16_t* wtin = wtin_of(F, L); bf16_t* wtout = (bf16_t*)(F.ws + WS_WTOUT);
    if (with_win) convert_win(F, L, 0);
    if (L == 0 || L == 3) {
        convert_matrix(F, F.in(7) + (size_t)(L ? 1 : 0) * D * D, D, D, wtout, D, 0);
    } else if (L == 1) {
        convert_matrix(F, F.in(14), D, D, wtout, D, 0);
    } else {
        convert_matrix(F, F.in(28), D, D, wtout, D, 0);
        convert_matrix(F, F.in(18), D, 128, wtin + (size_t)16384 * D, D, 0);
        convert_matrix(F, F.in(21), D, 128, wtin + (size_t)16640 * D, D, 0);
        zero_bytes(F, wtin + (size_t)16512 * D, (size_t)128 * D * 2);
        zero_bytes(F, wtin + (size_t)16768 * D, (size_t)128 * D * 2);
        bf16_t* w2p = (bf16_t*)(F.ws + WS_W2P);
        zero_bytes(F, w2p, (size_t)8192 * 256 * 2);
    }
}
__device__ __forceinline__ void convert_layer2_b(const Fr& F) {
    bf16_t* w2p = (bf16_t*)(F.ws + WS_W2P);
    convert_matrix(F, F.in(19), 128, D, w2p, 256, 0);
    convert_matrix(F, F.in(22), 128, D, w2p + (size_t)4096 * 256, 256, 128);
}

__constant__ float c_inv_freq[16] = {1.0f, 0.44036659598350525f, 0.1939227432012558f, 0.08539710193872452f, 0.03760603070259094f, 0.01656043902039528f, 0.007292664609849453f, 0.0032114458736032248f,
    0.0014142135623842478f, 0.000622772378847003f, 0.00027424818836152554f, 0.00012076973507646471f, 5.318296098266728e-05f, 2.34199997066753e-05f, 1.0313386155758053e-05f, 4.541670477919979e-06f};
__device__ __forceinline__ void rope_table(const Fr& F) {
    float* cs = (float*)(F.ws + WS_ROPE); float* sn = cs + (size_t)R * 16;
    for (int i = F.bid * 512 + F.tid; i < R * 16; i += F.G * 512) {
        const int row = i >> 4, j = i & 15; const int pos = row - NPAD;
        const double ang = (double)(float)((float)pos * c_inv_freq[j]);
        const double k = __builtin_rint(ang * 0.15915494309189535);
        double x = ang - k * 6.283185307179586;
        const double q = __builtin_rint(x * 0.6366197723675814);
        x -= q * 1.5707963267948966;
        const int qi = ((int)q) & 3;
        const double x2 = x * x;
        const double s = x * (1.0 + x2 * (-1.0 / 6 + x2 * (1.0 / 120 + x2 * (-1.0 / 5040 + x2 * (1.0 / 362880 + x2 * (-1.0 / 39916800))))));
        const double c = 1.0 + x2 * (-0.5 + x2 * (1.0 / 24 + x2 * (-1.0 / 720 + x2 * (1.0 / 40320 + x2 * (-1.0 / 3628800 + x2 * (1.0 / 479001600))))));
        double sv, cv;
        if (qi == 0) { sv = s; cv = c; } else if (qi == 1) { sv = c; cv = -s; } else if (qi == 2) { sv = -s; cv = -c; } else { sv = -c; cv = s; }
        cs[i] = (float)cv; sn[i] = (float)sv;
    }
}

typedef const GAS char* gcp; typedef GAS char* gp_;
#define ROW_F32(nm, base, lane) gp_ nm##0 = (gp_)(base) + (lane) * 16 + 4096; gp_ nm##1 = nm##0 + 8192; asm volatile("" : "+v"(nm##0), "+v"(nm##1))
#define AT_F32(nm, j) (*(GAS f32x4*)((j) < 8 ? nm##0 + ((j) - 4) * 1024 : nm##1 + ((j) - 12) * 1024))
#define ROW_BF(nm, base, lane) gp_ nm##0 = (gp_)(base) + (lane) * 8 + 4096; asm volatile("" : "+v"(nm##0))
#define AT_BF(nm, j) (*(GAS u32x2*)(nm##0 + (j) * 512 - 4096))
__device__ __forceinline__ void norm_phase(const Fr& F, int prev, int next, const bf16_t* y, bf16_t* udst, int rlo = 0, int rhi = R, int wg_skip = 0) {
    const float* postg = F.in(3) + (size_t)(prev < 0 ? 0 : prev) * D; const float* preg = F.in(2) + (size_t)(next < 0 ? 0 : next) * D;
    const float* xin = F.in(0); const float* meta = F.in(1);
    for (int r = rlo + F.gw - wg_skip * 8; r < rhi; r += F.NGW - wg_skip * 8) {
        if (r < NPAD || r >= NREAL) {
            if (next >= 0) { ROW_BF(uo, udst + (size_t)r * D, F.lane); const u32x2 z = {0u, 0u};
#pragma unroll
                for (int j = 0; j < 16; ++j) AT_BF(uo, j) = z; }
            continue;
        }
        ROW_BF(hp, (bf16_t*)(F.ws + WS_HB) + (size_t)r * D, F.lane);
        f32x4 hv[16];
        if (prev < 0) {
            const float* src = r < 64 ? meta + (size_t)(r - NPAD) * D : xin + (size_t)(r - 64) * D;
            ROW_F32(sp, src, F.lane);
#pragma unroll
            for (int j = 0; j < 16; ++j) hv[j] = AT_F32(sp, j);
        } else {
            ROW_BF(yp, y + (size_t)r * D, F.lane); ROW_F32(gp, postg, F.lane);
            u32x2 yv[16], hb[16]; float ss = 0.f;
#pragma unroll
            for (int j = 0; j < 16; ++j) { yv[j] = AT_BF(yp, j); hb[j] = AT_BF(hp, j); }
#pragma unroll
            for (int j = 0; j < 16; ++j) { const float a = bflo(yv[j].x), b = bfhi(yv[j].x), c = bflo(yv[j].y), d = bfhi(yv[j].y); ss += (a * a + b * b) + (c * c + d * d); }
#pragma unroll
            for (int j = 0; j < 16; ++j) asm volatile("" : "+v"(yv[j].x), "+v"(yv[j].y));
            const float rs = __builtin_amdgcn_rsqf(wave_sum(ss) * (1.f / D) + 1e-6f);
#pragma unroll
            for (int j = 0; j < 16; ++j) { const f32x4 g = AT_F32(gp, j);
                hv[j].x = bflo(hb[j].x) + bflo(yv[j].x) * rs * g.x; hv[j].y = bfhi(hb[j].x) + bfhi(yv[j].x) * rs * g.y; hv[j].z = bflo(hb[j].y) + bflo(yv[j].y) * rs * g.z; hv[j].w = bfhi(hb[j].y) + bfhi(yv[j].y) * rs * g.w; }
        }
        if (next < 0) {
            if (r >= 64) { ROW_F32(op, F.out + (size_t)(r - 64) * D, F.lane);
#pragma unroll
                for (int j = 0; j < 16; ++j) AT_F32(op, j) = hv[j];
            }
            continue;
        }
        float s2 = 0.f;
#pragma unroll
        for (int j = 0; j < 16; ++j) { u32x2 w_; w_.x = cvt_pk_bf16(hv[j].x, hv[j].y); w_.y = cvt_pk_bf16(hv[j].z, hv[j].w); AT_BF(hp, j) = w_; s2 += (hv[j].x * hv[j].x + hv[j].y * hv[j].y) + (hv[j].z * hv[j].z + hv[j].w * hv[j].w); }
        const float rs2 = __builtin_amdgcn_rsqf(wave_sum(s2) * (1.f / D) + 1e-6f);
        ROW_BF(uo, udst + (size_t)r * D, F.lane); ROW_F32(pg, preg, F.lane);
#pragma unroll
        for (int j = 0; j < 16; ++j) { const f32x4 g = AT_F32(pg, j); u32x2 w; w.x = cvt_pk_bf16(hv[j].x * rs2 * g.x, hv[j].y * rs2 * g.y); w.y = cvt_pk_bf16(hv[j].z * rs2 * g.z, hv[j].w * rs2 * g.w); AT_BF(uo, j) = w; }
    }
}
__device__ __forceinline__ void mix_phase(const Fr& F, const bf16_t* u) {
    const float* mu = F.in(15);
    for (int r = F.gw; r < R; r += F.NGW) {
        const bool real = (r >= NPAD && r < NREAL);
        u32x2 cur[16], prv[16];
        const u32x2 z = {0u, 0u};
        { ROW_BF(cp, u + (size_t)r * D, F.lane); ROW_BF(pp, u + (size_t)(r > 0 ? r - 1 : 0) * D, F.lane);
#pragma unroll
          for (int j = 0; j < 16; ++j) { cur[j] = real ? AT_BF(cp, j) : z; prv[j] = (real && r > NPAD) ? AT_BF(pp, j) : z; } }
#pragma unroll 1
        for (int s = 0; s < 6; ++s) {
            ROW_BF(op, slotU(F, s) + (size_t)r * D, F.lane); ROW_F32(mp, mu + (size_t)s * D, F.lane);
#pragma unroll
            for (int j = 0; j < 16; ++j) {
                const f32x4 m = AT_F32(mp, j);
                const float c0 = bflo(cur[j].x), c1 = bfhi(cur[j].x), c2 = bflo(cur[j].y), c3 = bfhi(cur[j].y);
                const float p0 = bflo(prv[j].x), p1 = bfhi(prv[j].x), p2 = bflo(prv[j].y), p3 = bfhi(prv[j].y);
                u32x2 w; w.x = cvt_pk_bf16(c0 + (p0 - c0) * m.x, c1 + (p1 - c1) * m.y); w.y = cvt_pk_bf16(c2 + (p2 - c2) * m.z, c3 + (p3 - c3) * m.w);
                AT_BF(op, j) = real ? w : z;
            }
        }
    }
}
}
namespace mk {
constexpr int H_QE = 0, H_KE = 17408, H_KET = 34816, H_VT = 53248, H_PM = 71680, H_STB = 80896, H_VEC = 115712;
__device__ __forceinline__ bf16x8 ldfrag(const LAS unsigned char* base, int stride_b, int rb, int ks, int lane) {
    return *(const LAS bf16x8*)(base + (16 * rb + (lane & 15)) * stride_b + (32 * ks + 8 * (lane >> 4)) * 2);
}
template <bool OUT>
__device__ __forceinline__ void hgrn_phase(const Fr& F, int jl) {
    const bf16_t* Q = slotY(F, 0); const bf16_t* V = slotY(F, 1); const bf16_t* GT = slotY(F, 2); const float* Gg = (const float*)slotY(F, 3);
    bf16_t* Z = slotU(F, 0);
    float* HE = (float*)(F.ws + WS_HE); float* HLD = (float*)(F.ws + WS_HLOGD);
    const float* gn = F.in(6) + (size_t)jl * 128;
    LAS unsigned char* L = F.lds;
    LAS float* qtot = (LAS float*)(L + H_VEC); LAS float* ebm = qtot + 512; LAS float* ebl = ebm + 128;
    const int tid = F.tid, lane = F.lane, w = F.wave;
    const int d = tid & 127, qt = tid >> 7;
    for (int unit = F.bid; unit < 256; unit += F.G) {
        const int h = unit >> 3, seg = unit & 7;
        if (!OUT && seg == 7) continue;
        const int c0 = seg == 0 ? 0 : 33 + 32 * (seg - 1), c1 = c0 + (seg == 0 ? 33 : 32);
        f32x4 S[8];
#pragma unroll
        for (int i = 0; i < 8; ++i) S[i] = (f32x4){0.f, 0.f, 0.f, 0.f};
        if (OUT) {
            for (int j = 0; j < seg; ++j) {
                const float* ld = HLD + (size_t)(h * 8 + j) * 128; const float* e = HE + ((size_t)(h * 8 + j) * 512 + tid) * 32;
#pragma unroll
                for (int di = 0; di < 8; ++di) { const f32x4 l4 = *(const f32x4*)(ld + 16 * di + 4 * (lane >> 4)); const f32x4 e4 = *(const f32x4*)(e + 4 * di);
                    S[di].x = S[di].x * __expf(l4.x) + e4.x; S[di].y = S[di].y * __expf(l4.y) + e4.y; S[di].z = S[di].z * __expf(l4.z) + e4.z; S[di].w = S[di].w * __expf(l4.w) + e4.w; }
            }
        }
        float logD = 0.f;
        float g[16]; bf16_t qv[16], vv[16]; u32x4 gt0 = {0u, 0u, 0u, 0u}, gt1 = gt0, ngt0 = gt0, ngt1 = gt0;
#define HG_LOAD(cc) do { const int rowb_ = 64 * (cc) + 16 * qt; const size_t colb_ = (size_t)h * 128 + d; \
            _Pragma("unroll") for (int i = 0; i < 16; ++i) { g[i] = Gg[(size_t)(rowb_ + i) * D + colb_]; vv[i] = V[(size_t)(rowb_ + i) * D + colb_]; if (OUT) qv[i] = Q[(size_t)(rowb_ + i) * D + colb_]; } \
            if (OUT) { const bf16_t* gp_ = GT + (size_t)(64 * (cc) + (tid >> 3)) * D + h * 128 + 16 * (tid & 7); ngt0 = *(const u32x4*)gp_; ngt1 = *(const u32x4*)(gp_ + 8); } } while (0)
        HG_LOAD(c0);
        for (int c = c0; c < c1; ++c) {
            if (OUT) { gt0 = ngt0; gt1 = ngt1; }
            float f[16]; float run = 0.f;
#pragma unroll
            for (int i = 0; i < 16; ++i) { run += g[i]; f[i] = __expf(g[i]); }
            qtot[qt * 128 + d] = run;
            __syncthreads();
            const float t0 = qtot[d], t1 = qtot[128 + d], t2 = qtot[256 + d], t3 = qtot[384 + d];
            const float off = qt == 0 ? 0.f : (qt == 1 ? t0 : (qt == 2 ? t0 + t1 : t0 + t1 + t2));
            const float bm = t0 + t1, bl = (t0 + t1) + (t2 + t3);
            if (qt == 0) { ebm[d] = __expf(bm); ebl[d] = __expf(bl); logD += bl; }
            {
                unsigned kt[8], vt[8];
                const float ebd = __expf(bl - bm);
                float y = __expf(bm - (run + off)), kx_hi = 0.f;
#pragma unroll
                for (int i = 15; i >= 0; --i) {
                    const float ky = (1.f - f[i]) * y;
                    if (OUT) *(LAS bf16_t*)(L + H_KE + ((16 * qt + i) * 136 + d) * 2) = f2bf(ky);
                    const float kx = ky * ebd;
                    if (i & 1) kx_hi = kx; else kt[i >> 1] = cvt_pk_bf16(kx, kx_hi);
                    y *= f[i];
                }
                if (OUT) {
                    float e = __expf(off - bm);
#pragma unroll
                    for (int i = 0; i < 16; ++i) { e *= f[i]; *(LAS bf16_t*)(L + H_QE + ((16 * qt + i) * 136 + d) * 2) = f2bf(bf2f(qv[i]) * e); }
                }
#pragma unroll
                for (int i = 0; i < 16; i += 2) vt[i >> 1] = (unsigned)vv[i] | ((unsigned)vv[i + 1] << 16);
                LAS u32x4* kp = (LAS u32x4*)(L + H_KET + (d * 72 + 16 * qt) * 2); kp[0] = (u32x4){kt[0], kt[1], kt[2], kt[3]}; kp[1] = (u32x4){kt[4], kt[5], kt[6], kt[7]};
                LAS u32x4* vp = (LAS u32x4*)(L + H_VT + (d * 72 + 16 * qt) * 2); vp[0] = (u32x4){vt[0], vt[1], vt[2], vt[3]}; vp[1] = (u32x4){vt[4], vt[5], vt[6], vt[7]};
            }
            if (c + 1 < c1) HG_LOAD(c + 1);
            __syncthreads();
            if (OUT) {
#pragma unroll
                for (int di = 0; di < 8; ++di) { const f32x4 m4 = *(const LAS f32x4*)(ebm + 16 * di + 4 * (lane >> 4)); u32x2 o; o.x = cvt_pk_bf16(S[di].x * m4.x, S[di].y * m4.y); o.y = cvt_pk_bf16(S[di].z * m4.z, S[di].w * m4.w);
                    *(LAS u32x2*)(L + H_STB + ((16 * w + (lane & 15)) * 136 + 16 * di + 4 * (lane >> 4)) * 2) = o; }
                const int ti = w >> 1;
#pragma unroll
                for (int s2 = 0; s2 < 2; ++s2) { const int si = 2 * (w & 1) + s2; f32x4 p = {0.f, 0.f, 0.f, 0.f};
                    if (si <= ti) {
#pragma unroll
                        for (int ks = 0; ks < 4; ++ks) p = __builtin_amdgcn_mfma_f32_16x16x32_bf16(ldfrag(L + H_QE, 272, ti, ks, lane), ldfrag(L + H_KE, 272, si, ks, lane), p, 0, 0, 0);
                    }
                    const int sidx = 16 * si + (lane & 15);
#pragma unroll
                    for (int jj = 0; jj < 4; ++jj) { const int tidx = 16 * ti + 4 * (lane >> 4) + jj; *(LAS bf16_t*)(L + H_PM + (tidx * 72 + sidx) * 2) = f2bf(sidx <= tidx ? p[jj] : 0.f); }
                }
                __syncthreads();
            }
            f32x4 O[4];
            if (OUT) {
#pragma unroll
                for (int ti = 0; ti < 4; ++ti) O[ti] = (f32x4){0.f, 0.f, 0.f, 0.f};
#pragma unroll
                for (int ks = 0; ks < 2; ++ks) { const bf16x8 bv = ldfrag(L + H_VT, 144, w, ks, lane);
#pragma unroll
                    for (int ti = 0; ti < 4; ++ti) O[ti] = __builtin_amdgcn_mfma_f32_16x16x32_bf16(ldfrag(L + H_PM, 144, ti, ks, lane), bv, O[ti], 0, 0, 0); }
#pragma unroll
                for (int ks = 0; ks < 4; ++ks) { const bf16x8 bs = ldfrag(L + H_STB, 272, w, ks, lane);
#pragma unroll
                    for (int ti = 0; ti < 4; ++ti) O[ti] = __builtin_amdgcn_mfma_f32_16x16x32_bf16(ldfrag(L + H_QE, 272, ti, ks, lane), bs, O[ti], 0, 0, 0); }
            }
            {
                const bf16x8 bv0 = ldfrag(L + H_VT, 144, w, 0, lane), bv1 = ldfrag(L + H_VT, 144, w, 1, lane);
#pragma unroll
                for (int di = 0; di < 8; ++di) { const f32x4 l4 = *(const LAS f32x4*)(ebl + 16 * di + 4 * (lane >> 4)); S[di] = S[di] * l4;
                    S[di] = __builtin_amdgcn_mfma_f32_16x16x32_bf16(ldfrag(L + H_KET, 144, di, 0, lane), bv0, S[di], 0, 0, 0);
                    S[di] = __builtin_amdgcn_mfma_f32_16x16x32_bf16(ldfrag(L + H_KET, 144, di, 1, lane), bv1, S[di], 0, 0, 0); }
            }
            if (OUT) {
                __syncthreads();
                LAS float* Ot = (LAS float*)(L + H_STB);
#pragma unroll
                for (int ti = 0; ti < 4; ++ti)
#pragma unroll
                    for (int jj = 0; jj < 4; ++jj) Ot[(16 * ti + 4 * (lane >> 4) + jj) * 132 + 16 * w + (lane & 15)] = O[ti][jj];
                __syncthreads();
                const int t = tid >> 3, eg = tid & 7;
                f32x4 o4[4]; float ss = 0.f;
#pragma unroll
                for (int i = 0; i < 4; ++i) { o4[i] = *(const LAS f32x4*)(Ot + t * 132 + 16 * eg + 4 * i); ss += (o4[i].x * o4[i].x + o4[i].y * o4[i].y) + (o4[i].z * o4[i].z + o4[i].w * o4[i].w); }
                ss = red8(ss);
                const float rs = __builtin_amdgcn_rsqf(ss * (1.f / 128.f) + 1e-6f);
                const unsigned gw_[8] = {gt0.x, gt0.y, gt0.z, gt0.w, gt1.x, gt1.y, gt1.z, gt1.w};
                unsigned zo[8];
#pragma unroll
                for (int i = 0; i < 4; ++i) { const f32x4 g4 = *(const f32x4*)(gn + 16 * eg + 4 * i);
                    const float a0 = o4[i].x * rs * g4.x * silu_f(bflo(gw_[2 * i])), a1 = o4[i].y * rs * g4.y * silu_f(bfhi(gw_[2 * i]));
                    const float a2 = o4[i].z * rs * g4.z * silu_f(bflo(gw_[2 * i + 1])), a3 = o4[i].w * rs * g4.w * silu_f(bfhi(gw_[2 * i + 1]));
                    zo[2 * i] = cvt_pk_bf16(a0, a1); zo[2 * i + 1] = cvt_pk_bf16(a2, a3); }
                bf16_t* zp = Z + (size_t)(64 * c + t) * D + h * 128 + 16 * eg;
                *(u32x4*)zp = (u32x4){zo[0], zo[1], zo[2], zo[3]}; *(u32x4*)(zp + 8) = (u32x4){zo[4], zo[5], zo[6], zo[7]};
            } else {
                __syncthreads();
            }
        }
        if (!OUT) {
            float* e = HE + ((size_t)(h * 8 + seg) * 512 + tid) * 32;
#pragma unroll
            for (int di = 0; di < 8; ++di) *(f32x4*)(e + 4 * di) = S[di];
            if (qt == 0) HLD[(size_t)(h * 8 + seg) * 128 + d] = logD;
        }
        __syncthreads();
    }
#undef HG_LOAD
}

#ifndef MK_PRIO
#define MK_PRIO 0
#endif
#define PRIO_HI() do { if (MK_PRIO) { __builtin_amdgcn_s_setprio(MK_PRIO); } } while (0)
#define PRIO_LO() do { if (MK_PRIO) { __builtin_amdgcn_s_setprio(0); } } while (0)
namespace att {
constexpr int NW = 8, QBLK = 32, KVBLK = 64, LDQ = 4096, LDO = 8192;
constexpr float SCALE = 0.088388347648318440f, THR = 8.f;
constexpr int SHM_V = 16384, SHM_K = 16384, SHM = 2 * SHM_V + 2 * SHM_K + NW * 64 * 4;
#ifndef MK_KSWM
#define MK_KSWM 15
#endif
#define KSWZ(row, colB) ((row) * 256 + ((colB) ^ (((row) & MK_KSWM) << 4)))
#define SBAR() __builtin_amdgcn_sched_barrier(0)
__device__ __forceinline__ int crow(int r, int hi) { return (r & 3) + 8 * (r >> 2) + 4 * hi; }
__device__ __forceinline__ void partialSM(f32x16& p0, f32x16& p1, float& m_reg, float& mn, float& alpha) {
    constexpr float C = SCALE * 1.4426950408889634f;
    float pmax = p0[0];
#pragma unroll
    for (int r = 1; r < 16; ++r) pmax = fmaxf(pmax, p0[r]);
#pragma unroll
    for (int r = 0; r < 16; ++r) pmax = fmaxf(pmax, p1[r]);
    { auto rr = __builtin_amdgcn_permlane32_swap(__float_as_uint(pmax), __float_as_uint(pmax), false, false);
      pmax = fmaxf(__uint_as_float(rr[0]), __uint_as_float(rr[1])); }
    if (__builtin_expect(__all(pmax - m_reg <= THR / SCALE), 1)) { mn = m_reg; alpha = 1.f; }
    else { mn = fmaxf(m_reg, pmax); alpha = __builtin_amdgcn_exp2f((m_reg - mn) * C); m_reg = mn; }
    const float mnC = -mn * C;
#pragma unroll
    for (int r = 0; r < 16; ++r) p0[r] = fmaf(p0[r], C, mnC);
#pragma unroll
    for (int r = 0; r < 16; ++r) p1[r] = fmaf(p1[r], C, mnC);
#pragma unroll
    for (int r = 0; r < 16; ++r) p0[r] = __builtin_amdgcn_exp2f(p0[r]);
}
__device__ __forceinline__ void finishSM(f32x16& p0, f32x16& p1, float alpha, float& l_reg, bf16x8& pa0, bf16x8& pa1, bf16x8& pa2, bf16x8& pa3) {
#pragma unroll
    for (int r = 0; r < 16; ++r) p1[r] = __builtin_amdgcn_exp2f(p1[r]);
    float ps = 0;
#pragma unroll
    for (int r = 0; r < 16; ++r) ps += p0[r];
#pragma unroll
    for (int r = 0; r < 16; ++r) ps += p1[r];
    { auto rr = __builtin_amdgcn_permlane32_swap(__float_as_uint(ps), __float_as_uint(ps), false, false);
      ps = __uint_as_float(rr[0]) + __uint_as_float(rr[1]); }
    l_reg = l_reg * alpha + ps;
#define PK4(P, BASE, OUT) do { unsigned a0 = cvt_pk_bf16(P[BASE + 0], P[BASE + 1]), a1 = cvt_pk_bf16(P[BASE + 2], P[BASE + 3]);   \
    unsigned b0 = cvt_pk_bf16(P[BASE + 4], P[BASE + 5]), b1 = cvt_pk_bf16(P[BASE + 6], P[BASE + 7]);                              \
    auto r0 = __builtin_amdgcn_permlane32_swap(a0, b0, false, false); auto r1 = __builtin_amdgcn_permlane32_swap(a1, b1, false, false); \
    u32x4 w = {r0[0], r1[0], r0[1], r1[1]}; OUT = *reinterpret_cast<bf16x8*>(&w); } while (0)
    PK4(p0, 0, pa0); PK4(p0, 8, pa1); PK4(p1, 0, pa2); PK4(p1, 8, pa3);
#undef PK4
}
__device__ __forceinline__ void qkt(f32x16& p0, f32x16& p1, const char* Ks, const bf16x8* qr, int r32, int hi) {
    p0 = f32x16{}; p1 = f32x16{};
    PRIO_HI();
#pragma unroll
    for (int d0 = 0; d0 < 8; ++d0) { const int cb = (d0 * 16 + hi * 8) * 2;
        const bf16x8 b0 = *reinterpret_cast<const bf16x8*>(Ks + KSWZ(r32, cb));
        const bf16x8 b1 = *reinterpret_cast<const bf16x8*>(Ks + KSWZ(32 + r32, cb));
        p0 = __builtin_amdgcn_mfma_f32_32x32x16_bf16(b0, qr[d0], p0, 0, 0, 0);
        p1 = __builtin_amdgcn_mfma_f32_32x32x16_bf16(b1, qr[d0], p1, 0, 0, 0); }
    PRIO_LO();
}
__device__ __forceinline__ int v_st(int k, int c) { const int kk = (k & ~0xC) | ((k & 4) << 1) | ((k & 8) >> 1); return ((kk >> 3) * 4 + (c >> 5)) * 512 + ((kk & 7) * 32 + (c & 31)) * 2; }
__device__ __forceinline__ int v_rd_base(int lane) { return ((lane & 3) << 3) | (((lane >> 2) & 3) << 6) | (((lane >> 4) & 1) << 5) | (((lane >> 5) & 1) << 8); }
constexpr int v_rd_off(int d0, int ks, int half) { return d0 * 512 + ks * 4096 + half * 2048; }
template <int OFF> __device__ __forceinline__ s16x4 tr_read(int vb) {
    s16x4 r; asm volatile("ds_read_b64_tr_b16 %0, %1 offset:%2" : "=&v"(r) : "v"(vb), "i"(OFF) : "memory"); return r;
}
template <int D0> __device__ __forceinline__ void pv_one(f32x16& od, int vb, bf16x8 pa0, bf16x8 pa1, bf16x8 pa2, bf16x8 pa3) {
    const s16x4 l0 = tr_read<v_rd_off(D0, 0, 0)>(vb), h0 = tr_read<v_rd_off(D0, 0, 1)>(vb), l1 = tr_read<v_rd_off(D0, 1, 0)>(vb), h1 = tr_read<v_rd_off(D0, 1, 1)>(vb);
    const s16x4 l2 = tr_read<v_rd_off(D0, 2, 0)>(vb), h2 = tr_read<v_rd_off(D0, 2, 1)>(vb), l3 = tr_read<v_rd_off(D0, 3, 0)>(vb), h3 = tr_read<v_rd_off(D0, 3, 1)>(vb);
    asm volatile("s_waitcnt lgkmcnt(0)" ::: "memory"); SBAR();
#define PK(Lo, Hi) (bf16x8){Lo[0], Lo[1], Lo[2], Lo[3], Hi[0], Hi[1], Hi[2], Hi[3]}
    od = __builtin_amdgcn_mfma_f32_32x32x16_bf16(pa0, PK(l0, h0), od, 0, 0, 0);
    od = __builtin_amdgcn_mfma_f32_32x32x16_bf16(pa1, PK(l1, h1), od, 0, 0, 0);
    od = __builtin_amdgcn_mfma_f32_32x32x16_bf16(pa2, PK(l2, h2), od, 0, 0, 0);
    od = __builtin_amdgcn_mfma_f32_32x32x16_bf16(pa3, PK(l3, h3), od, 0, 0, 0);
#undef PK
}
__device__ __forceinline__ void pv_d0(f32x16* o, int vb, bf16x8 pa0, bf16x8 pa1, bf16x8 pa2, bf16x8 pa3) {
    pv_one<0>(o[0], vb, pa0, pa1, pa2, pa3); pv_one<1>(o[1], vb, pa0, pa1, pa2, pa3); pv_one<2>(o[2], vb, pa0, pa1, pa2, pa3); pv_one<3>(o[3], vb, pa0, pa1, pa2, pa3);
}
__device__ __forceinline__ void mask_tile(f32x16& p0, f32x16& p1, int j, int lim) {
    if (j > lim) {
#pragma unroll
        for (int r = 0; r < 16; ++r) { p0[r] = -1e30f; p1[r] = -1e30f; }
    } else if (j == 0) {
#pragma unroll
        for (int r = 0; r < 16; ++r) p0[r] = -1e30f;
#pragma unroll
        for (int r = 0; r < 8; ++r) p1[r] = -1e30f;
    }
}
__device__ __forceinline__ void unit(const bf16_t* __restrict__ Qb, const bf16_t* __restrict__ Kh, const bf16_t* __restrict__ Vh, bf16_t* __restrict__ Ob, int NT, int lim, char* lds) {
    int tid_ = threadIdx.x; asm volatile("" : "+v"(tid_));
    const int tid = tid_, wid = tid >> 6, lane = tid & 63, r32 = lane & 31, hi = lane >> 5;
    char* V_lds = lds; char* K_lds = lds + 2 * SHM_V;
    float* wsf = (float*)(lds + 2 * SHM_V + 2 * SHM_K) + wid * 64; float* li_l = wsf; float* al_l = wsf + 32;
    float m_reg = -1e30f, l_reg = 0; f32x16 o[4] = {}; bf16x8 qr[8];
    const bf16_t* Qw = Qb + (long)(wid * QBLK + r32) * LDQ + hi * 8;
#pragma unroll
    for (int d0 = 0; d0 < 8; ++d0) qr[d0] = *reinterpret_cast<const bf16x8*>(Qw + d0 * 16);
    const int sr = tid >> 4, sc = (tid & 15) * 8, vst0 = v_st(sr, sc), vst1 = v_st(32 + sr, sc);
    const int vb0 = (int)(uintptr_t)V_lds + v_rd_base(lane);
    struct { bf16x8 vs0, vs1, ks0, ks1; } sr_[2];
#define SLOAD(i, k0) do { sr_[i].vs0 = *reinterpret_cast<const bf16x8*>(&Vh[(long)((k0) + sr) * LDQ + sc]); sr_[i].vs1 = *reinterpret_cast<const bf16x8*>(&Vh[(long)((k0) + 32 + sr) * LDQ + sc]); \
    sr_[i].ks0 = *reinterpret_cast<const bf16x8*>(&Kh[(long)((k0) + sr) * LDQ + sc]); sr_[i].ks1 = *reinterpret_cast<const bf16x8*>(&Kh[(long)((k0) + 32 + sr) * LDQ + sc]); } while (0)
#define SWRITE(b, i) do { *(bf16x8*)(V_lds + (b) * SHM_V + vst0) = sr_[i].vs0;          \
    *(bf16x8*)(V_lds + (b) * SHM_V + vst1) = sr_[i].vs1; int kc = sc * 2;               \
    *(bf16x8*)(K_lds + (b) * SHM_K + KSWZ(sr, kc)) = sr_[i].ks0;                       \
    *(bf16x8*)(K_lds + (b) * SHM_K + KSWZ(32 + sr, kc)) = sr_[i].ks1; } while (0)
#define SWAIT() asm volatile("s_waitcnt vmcnt(4)" ::: "memory")
#define RESC(a) do { if (__any((a) < 1.f)) { if (hi == 0) al_l[r32] = (a); asm volatile("s_waitcnt lgkmcnt(0)" ::: "memory"); \
    _Pragma("unroll") for (int d = 0; d < 4; ++d) _Pragma("unroll") for (int r = 0; r < 16; ++r) o[d][r] *= al_l[crow(r, hi)]; } } while (0)
    f32x16 pA0, pA1, pB0, pB1; float mnA, mnB, alA, alB; bf16x8 pa0, pa1, pa2, pa3;
    constexpr int SE = 0, SO = 1;
    SLOAD(SE, 0); asm volatile("s_waitcnt vmcnt(0)" ::: "memory"); SWRITE(0, SE); __syncthreads();
    qkt(pA0, pA1, K_lds, qr, r32, hi); mask_tile(pA0, pA1, 0, lim); partialSM(pA0, pA1, m_reg, mnA, alA);
    SLOAD(SO, KVBLK); if (2 < NT) SLOAD(SE, 2 * KVBLK);
    SWAIT(); SWRITE(1, SO); __syncthreads();
    for (int j = 1; j + 1 < NT; j += 2) {
        SBAR(); qkt(pB0, pB1, K_lds + SHM_K, qr, r32, hi);
        finishSM(pA0, pA1, alA, l_reg, pa0, pa1, pa2, pa3); SBAR();
        SLOAD(SO, (j + 2) * KVBLK); SBAR();
        pv_d0(o, vb0, pa0, pa1, pa2, pa3); mask_tile(pB0, pB1, j, lim); partialSM(pB0, pB1, m_reg, mnB, alB);
        __syncthreads(); SWAIT(); SWRITE(0, SE);
        RESC(alB); __syncthreads();
        SBAR(); qkt(pA0, pA1, K_lds, qr, r32, hi);
        finishSM(pB0, pB1, alB, l_reg, pa0, pa1, pa2, pa3); SBAR();
        if (j + 3 < NT) SLOAD(SE, (j + 3) * KVBLK); SBAR();
        pv_d0(o, vb0 + SHM_V, pa0, pa1, pa2, pa3); mask_tile(pA0, pA1, j + 1, lim); partialSM(pA0, pA1, m_reg, mnA, alA);
        __syncthreads(); SWAIT(); SWRITE(1, SO);
        RESC(alA); __syncthreads();
    }
    SBAR(); qkt(pB0, pB1, K_lds + SHM_K, qr, r32, hi);
    finishSM(pA0, pA1, alA, l_reg, pa0, pa1, pa2, pa3); SBAR();
    pv_d0(o, vb0, pa0, pa1, pa2, pa3); mask_tile(pB0, pB1, NT - 1, lim); partialSM(pB0, pB1, m_reg, mnB, alB);
    __syncthreads(); RESC(alB);
    finishSM(pB0, pB1, alB, l_reg, pa0, pa1, pa2, pa3); SBAR();
    pv_d0(o, vb0 + SHM_V, pa0, pa1, pa2, pa3);
    if (hi == 0) li_l[r32] = l_reg; asm volatile("s_waitcnt lgkmcnt(0)" ::: "memory");
    float rli[16];
#pragma unroll
    for (int r = 0; r < 16; ++r) rli[r] = __builtin_amdgcn_rcpf(li_l[crow(r, hi)]);
    bf16_t* Ow = Ob + (long)(wid * QBLK) * LDO;
#pragma unroll
    for (int r = 0; r < 16; ++r) { const int orow = crow(r, hi);
#pragma unroll
        for (int d0 = 0; d0 < 4; ++d0) Ow[(long)orow * LDO + d0 * 32 + r32] = f2bf(o[d0][r] * rli[r]); }
    __syncthreads();
#undef SLOAD
#undef SWRITE
#undef SWAIT
#undef RESC
}
}


#ifndef MK_HB
#define MK_HB(w) ((w) >> 2)
#endif
namespace att2 {
using namespace att;
constexpr int KB = 16384, VB = 32768, OFF_V = 3 * KB, OFF_W = OFF_V + 3 * VB, SHM2 = OFF_W + NW * 64 * 4;
constexpr int v2_rd_off(int d0, int ks, int half) { return d0 * 512 + ks * 8192 + half * 4096; }
template <int D0> __device__ __forceinline__ void pv2_one(f32x16& od, int vb, bf16x8 pa0, bf16x8 pa1, bf16x8 pa2, bf16x8 pa3) {
    const s16x4 l0 = tr_read<v2_rd_off(D0, 0, 0)>(vb), h0 = tr_read<v2_rd_off(D0, 0, 1)>(vb), l1 = tr_read<v2_rd_off(D0, 1, 0)>(vb), h1 = tr_read<v2_rd_off(D0, 1, 1)>(vb);
    const s16x4 l2 = tr_read<v2_rd_off(D0, 2, 0)>(vb), h2 = tr_read<v2_rd_off(D0, 2, 1)>(vb), l3 = tr_read<v2_rd_off(D0, 3, 0)>(vb), h3 = tr_read<v2_rd_off(D0, 3, 1)>(vb);
    asm volatile("s_waitcnt lgkmcnt(0)" ::: "memory"); SBAR();
#define PK(Lo, Hi) (bf16x8){Lo[0], Lo[1], Lo[2], Lo[3], Hi[0], Hi[1], Hi[2], Hi[3]}
    od = __builtin_amdgcn_mfma_f32_32x32x16_bf16(pa0, PK(l0, h0), od, 0, 0, 0);
    od = __builtin_amdgcn_mfma_f32_32x32x16_bf16(pa1, PK(l1, h1), od, 0, 0, 0);
    od = __builtin_amdgcn_mfma_f32_32x32x16_bf16(pa2, PK(l2, h2), od, 0, 0, 0);
    od = __builtin_amdgcn_mfma_f32_32x32x16_bf16(pa3, PK(l3, h3), od, 0, 0, 0);
#undef PK
}
struct VFrag { s16x4 l0, h0, l1, h1, l2, h2, l3, h3; };
template <int D0> __device__ __forceinline__ void v2_load(VFrag& f, int vb) {
    f.l0 = tr_read<v2_rd_off(D0, 0, 0)>(vb); f.h0 = tr_read<v2_rd_off(D0, 0, 1)>(vb); f.l1 = tr_read<v2_rd_off(D0, 1, 0)>(vb); f.h1 = tr_read<v2_rd_off(D0, 1, 1)>(vb);
    f.l2 = tr_read<v2_rd_off(D0, 2, 0)>(vb); f.h2 = tr_read<v2_rd_off(D0, 2, 1)>(vb); f.l3 = tr_read<v2_rd_off(D0, 3, 0)>(vb); f.h3 = tr_read<v2_rd_off(D0, 3, 1)>(vb);
}
__device__ __forceinline__ void v2_mma(f32x16& od, const VFrag& f, bf16x8 pa0, bf16x8 pa1, bf16x8 pa2, bf16x8 pa3) {
#define PK(Lo, Hi) (bf16x8){Lo[0], Lo[1], Lo[2], Lo[3], Hi[0], Hi[1], Hi[2], Hi[3]}
    od = __builtin_amdgcn_mfma_f32_32x32x16_bf16(pa0, PK(f.l0, f.h0), od, 0, 0, 0);
    od = __builtin_amdgcn_mfma_f32_32x32x16_bf16(pa1, PK(f.l1, f.h1), od, 0, 0, 0);
    od = __builtin_amdgcn_mfma_f32_32x32x16_bf16(pa2, PK(f.l2, f.h2), od, 0, 0, 0);
    od = __builtin_amdgcn_mfma_f32_32x32x16_bf16(pa3, PK(f.l3, f.h3), od, 0, 0, 0);
#undef PK
}
struct VSet { s16x4 l0, h0, l1, h1, l2, h2, l3, h3; };
template <int G, int KS> __device__ __forceinline__ void vs_load(VSet& f, int vb) {
    f.l0 = tr_read<v2_rd_off(4 * G + 0, KS, 0)>(vb); f.h0 = tr_read<v2_rd_off(4 * G + 0, KS, 1)>(vb); f.l1 = tr_read<v2_rd_off(4 * G + 1, KS, 0)>(vb); f.h1 = tr_read<v2_rd_off(4 * G + 1, KS, 1)>(vb);
    f.l2 = tr_read<v2_rd_off(4 * G + 2, KS, 0)>(vb); f.h2 = tr_read<v2_rd_off(4 * G + 2, KS, 1)>(vb); f.l3 = tr_read<v2_rd_off(4 * G + 3, KS, 0)>(vb); f.h3 = tr_read<v2_rd_off(4 * G + 3, KS, 1)>(vb);
}
template <int G> __device__ __forceinline__ void vs_mma(f32x16* o, const VSet& f, bf16x8 pa) {
#define PK(Lo, Hi) (bf16x8){Lo[0], Lo[1], Lo[2], Lo[3], Hi[0], Hi[1], Hi[2], Hi[3]}
    o[4 * G + 0] = __builtin_amdgcn_mfma_f32_32x32x16_bf16(pa, PK(f.l0, f.h0), o[4 * G + 0], 0, 0, 0);
    o[4 * G + 1] = __builtin_amdgcn_mfma_f32_32x32x16_bf16(pa, PK(f.l1, f.h1), o[4 * G + 1], 0, 0, 0);
    o[4 * G + 2] = __builtin_amdgcn_mfma_f32_32x32x16_bf16(pa, PK(f.l2, f.h2), o[4 * G + 2], 0, 0, 0);
    o[4 * G + 3] = __builtin_amdgcn_mfma_f32_32x32x16_bf16(pa, PK(f.l3, f.h3), o[4 * G + 3], 0, 0, 0);
#undef PK
}
__device__ __forceinline__ void pv2_all(f32x16* o, int vb, bf16x8 pa0, bf16x8 pa1, bf16x8 pa2, bf16x8 pa3) {
    VSet A, B;
#define W8() do { asm volatile("s_waitcnt lgkmcnt(8)" ::: "memory"); SBAR(); } while (0)
    PRIO_HI();
    vs_load<0, 0>(A, vb);
    vs_load<0, 1>(B, vb); W8(); vs_mma<0>(o, A, pa0); SBAR();
    vs_load<0, 2>(A, vb); W8(); vs_mma<0>(o, B, pa1); SBAR();
    vs_load<0, 3>(B, vb); W8(); vs_mma<0>(o, A, pa2); SBAR();
    vs_load<1, 0>(A, vb); W8(); vs_mma<0>(o, B, pa3); SBAR();
    vs_load<1, 1>(B, vb); W8(); vs_mma<1>(o, A, pa0); SBAR();
    vs_load<1, 2>(A, vb); W8(); vs_mma<1>(o, B, pa1); SBAR();
    vs_load<1, 3>(B, vb); W8(); vs_mma<1>(o, A, pa2); SBAR();
    asm volatile("s_waitcnt lgkmcnt(0)" ::: "memory"); SBAR(); vs_mma<1>(o, B, pa3); SBAR();
    PRIO_LO();
#undef W8
}
__device__ __forceinline__ void unit2(const bf16_t* __restrict__ Qb, const bf16_t* __restrict__ Kh, const bf16_t* __restrict__ Vh, bf16_t* __restrict__ Ob, int NT, int lim, unsigned char* ldsg, LAS unsigned char* lds) {
    int tid_ = threadIdx.x; asm volatile("" : "+v"(tid_));
    const int tid = tid_, wid = __builtin_amdgcn_readfirstlane(tid >> 6), lane = tid & 63, r32 = lane & 31, hi = lane >> 5;
    LAS float* wsf = (LAS float*)(lds + OFF_W) + wid * 64; LAS float* li_l = wsf; LAS float* al_l = wsf + 32;
    float m_reg = -1e30f, l_reg = 0; f32x16 o[8] = {}; bf16x8 qr[8];
    const bf16_t* Qw = Qb + (long)(wid * QBLK + r32) * LDQ + hi * 8;
#pragma unroll
    for (int d0 = 0; d0 < 8; ++d0) qr[d0] = *reinterpret_cast<const bf16x8*>(Qw + d0 * 16);
    const int vb0 = (int)(uintptr_t)(ldsg + OFF_V) + v_rd_base(lane);
#define DMA_K(t_, b_) do { const char* gk = (const char*)Kh + (size_t)(t_) * (KVBLK * LDQ * 2); int ln_ = lane; asm volatile("" : "+v"(ln_)); _Pragma("unroll") for (int i = 0; i < 2; ++i) { \
        const int row = wid * 4 + i * 32 + (ln_ >> 4); const unsigned ko = (unsigned)(row * LDQ * 2 + (((ln_ & 15) * 16) ^ ((row & MK_KSWM) << 4))); \
        __builtin_amdgcn_global_load_lds((const unsigned*)(gk + ko), (LAS unsigned*)(lds + (b_) * KB + wid * 1024 + i * 8192), 16, 0, 0); } } while (0)
#define DMA_V(t_, b_) do { const char* gv = (const char*)Vh + (size_t)(t_) * (KVBLK * LDQ * 2); int ln_ = lane; asm volatile("" : "+v"(ln_)); _Pragma("unroll") for (int i = 0; i < 4; ++i) { \
        const int st = wid * 2 + i * 16 + (ln_ >> 5), q = ln_ & 31; const int kk = (st >> 3) * 8 + (q >> 2); const int k = (kk & ~0xC) | ((kk & 4) << 1) | ((kk & 8) >> 1); \
        const unsigned vo = (unsigned)(k * LDQ * 2 + ((st & 7) * 32 + (q & 3) * 8) * 2); \
        __builtin_amdgcn_global_load_lds((const unsigned*)(gv + vo), (LAS unsigned*)(lds + OFF_V + (b_) * VB + wid * 1024 + i * 8192), 16, 0, 0); } } while (0)
    DMA_K(0, 0); DMA_V(0, 0); if (1 < NT) { DMA_K(1, 1); DMA_V(1, 1); }
    asm volatile("s_waitcnt vmcnt(0)" ::: "memory"); __builtin_amdgcn_s_barrier(); asm volatile("" ::: "memory");
    int kb = 0;
    for (int j = 0; j < NT; ++j) {
        const int kb2 = kb == 0 ? 2 : kb - 1;
        if (j + 2 < NT) DMA_V(j + 2, kb2);
        asm volatile("" ::: "memory");
        if (j + 2 < NT) DMA_K(j + 2, kb2);
        asm volatile("" ::: "memory");
        if (j <= lim) {
        f32x16 p0, p1; float mn, alpha; bf16x8 pa0, pa1, pa2, pa3;
        qkt(p0, p1, (const char*)ldsg + kb * KB, qr, r32, hi);
#if MK_PROBE_QK2
        asm volatile("" : "+v"(p0), "+v"(p1)); qkt(p0, p1, (const char*)ldsg + kb * KB, qr, r32, hi);
#endif
        if (j == 0) {
            asm volatile("; tile-0 mask" ::: "memory");
#pragma unroll
            for (int r = 0; r < 16; ++r) p0[r] = -1e30f;
#pragma unroll
            for (int r = 0; r < 8; ++r) p1[r] = -1e30f;
        }
        partialSM(p0, p1, m_reg, mn, alpha);
        if (__any(alpha < 1.f)) { if (hi == 0) al_l[r32] = alpha; asm volatile("s_waitcnt lgkmcnt(0)" ::: "memory");
#pragma unroll
            for (int d = 0; d < 8; ++d)
#pragma unroll
                for (int r = 0; r < 16; ++r) o[d][r] *= al_l[crow(r, hi)]; }
        finishSM(p0, p1, alpha, l_reg, pa0, pa1, pa2, pa3); SBAR();
        const int vb = vb0 + kb * VB;
        pv2_all(o, vb, pa0, pa1, pa2, pa3);
        }
        if (j + 2 < NT) asm volatile("s_waitcnt vmcnt(6)" ::: "memory"); else asm volatile("s_waitcnt vmcnt(0)" ::: "memory");
        __builtin_amdgcn_s_barrier(); asm volatile("" ::: "memory");
        kb = kb == 2 ? 0 : kb + 1;
    }
    if (hi == 0) li_l[r32] = l_reg; asm volatile("s_waitcnt lgkmcnt(0)" ::: "memory");
    float rli[16];
#pragma unroll
    for (int r = 0; r < 16; ++r) rli[r] = __builtin_amdgcn_rcpf(li_l[crow(r, hi)]);
    bf16_t* Ow = Ob + (long)(wid * QBLK) * LDO;
#pragma unroll
    for (int r = 0; r < 16; ++r) { const int orow = crow(r, hi);
#pragma unroll
        for (int d0 = 0; d0 < 8; ++d0) Ow[(long)orow * LDO + d0 * 32 + r32] = f2bf(o[d0][r] * rli[r]); }
    asm volatile("s_waitcnt vmcnt(0) lgkmcnt(0)" ::: "memory"); __builtin_amdgcn_s_barrier(); asm volatile("" ::: "memory");
#undef DMA_K
#undef DMA_V
}

__device__ __forceinline__ void unit3(const bf16_t* __restrict__ Qb, const bf16_t* __restrict__ Kh, const bf16_t* __restrict__ Vh, bf16_t* __restrict__ Ob, int NT, int lim, unsigned char* ldsg, LAS unsigned char* lds) {
    int tid_ = threadIdx.x; asm volatile("" : "+v"(tid_));
    const int tid = tid_, wid = __builtin_amdgcn_readfirstlane(tid >> 6), lane = tid & 63, r32 = lane & 31, hi = lane >> 5, hb = MK_HB(wid);
    LAS float* wsf = (LAS float*)(lds + OFF_W) + wid * 64; LAS float* li_l = wsf; LAS float* al_l = wsf + 32;
    float m_reg = -1e30f, l_reg = 0; f32x16 o[8] = {}; bf16x8 qr[8];
    const bf16_t* Qw = Qb + (long)(wid * QBLK + r32) * LDQ + hi * 8;
#pragma unroll
    for (int d0 = 0; d0 < 8; ++d0) qr[d0] = *reinterpret_cast<const bf16x8*>(Qw + d0 * 16);
#define DMA_K(t_, b_) do { const char* gk = (const char*)Kh + (size_t)(t_) * (KVBLK * LDQ * 2); int ln_ = lane; asm volatile("" : "+v"(ln_)); _Pragma("unroll") for (int i = 0; i < 2; ++i) { \
        const int row = wid * 4 + i * 32 + (ln_ >> 4); const unsigned ko = (unsigned)(row * LDQ * 2 + (((ln_ & 15) * 16) ^ ((row & MK_KSWM) << 4))); \
        __builtin_amdgcn_global_load_lds((const unsigned*)(gk + ko), (LAS unsigned*)(lds + (b_) * KB + wid * 1024 + i * 8192), 16, 0, 0); } } while (0)
#define DMA_V(t_, b_) do { const char* gv = (const char*)Vh + (size_t)(t_) * (KVBLK * LDQ * 2); int ln_ = lane; asm volatile("" : "+v"(ln_)); _Pragma("unroll") for (int i = 0; i < 4; ++i) { \
        const int st = wid * 2 + i * 16 + (ln_ >> 5), q = ln_ & 31; const int kk = (st >> 3) * 8 + (q >> 2); const int k = (kk & ~0xC) | ((kk & 4) << 1) | ((kk & 8) >> 1); \
        const unsigned vo = (unsigned)(k * LDQ * 2 + ((st & 7) * 32 + (q & 3) * 8) * 2); \
        __builtin_amdgcn_global_load_lds((const unsigned*)(gv + vo), (LAS unsigned*)(lds + OFF_V + (b_) * VB + wid * 1024 + i * 8192), 16, 0, 0); } } while (0)
    DMA_K(0, 0); DMA_V(0, 0); if (1 < NT) { DMA_K(1, 1); DMA_V(1, 1); }
    asm volatile("s_waitcnt vmcnt(0)" ::: "memory"); __builtin_amdgcn_s_barrier(); asm volatile("" ::: "memory");
    bf16x8 pa0, pa1, pa2, pa3;
    int kq = 0, ki = 2;
    int vq = 0, vi = 2;
#define U3_QS(j_) do { f32x16 p0, p1; float mn, alpha; int lq_ = lane; asm volatile("" : "+v"(lq_)); const int r32 = lq_ & 31, hi = lq_ >> 5; \
        qkt(p0, p1, (const char*)ldsg + kq * KB, qr, r32, hi); kq = kq == 2 ? 0 : kq + 1; \
        mask_tile(p0, p1, (j_), lim); \
        partialSM(p0, p1, m_reg, mn, alpha); \
        if (__any(alpha < 1.f)) { if (hi == 0) al_l[r32] = alpha; asm volatile("s_waitcnt lgkmcnt(0)" ::: "memory"); \
            _Pragma("unroll") for (int d = 0; d < 8; ++d) _Pragma("unroll") for (int r = 0; r < 16; ++r) o[d][r] *= al_l[crow(r, hi)]; } \
        finishSM(p0, p1, alpha, l_reg, pa0, pa1, pa2, pa3); } while (0)
#define U3_PV(j_) do { int lp_ = lane; asm volatile("" : "+v"(lp_)); const int vb = (int)(uintptr_t)(ldsg + OFF_V) + v_rd_base(lp_) + vq * VB; vq = vq == 2 ? 0 : vq + 1; \
        pv2_one<0>(o[0], vb, pa0, pa1, pa2, pa3); pv2_one<1>(o[1], vb, pa0, pa1, pa2, pa3); pv2_one<2>(o[2], vb, pa0, pa1, pa2, pa3); pv2_one<3>(o[3], vb, pa0, pa1, pa2, pa3); \
        pv2_one<4>(o[4], vb, pa0, pa1, pa2, pa3); pv2_one<5>(o[5], vb, pa0, pa1, pa2, pa3); pv2_one<6>(o[6], vb, pa0, pa1, pa2, pa3); pv2_one<7>(o[7], vb, pa0, pa1, pa2, pa3); } while (0)
#define U3_EVEN_ISSUE(jj_) do { if ((jj_) + 2 < NT) DMA_K((jj_) + 2, ki); ki = ki == 2 ? 0 : ki + 1; asm volatile("" ::: "memory"); } while (0)
#define U3_ODD_ISSUE(jj_) do { if ((jj_) + 2 < NT) DMA_V((jj_) + 2, vi); vi = vi == 2 ? 0 : vi + 1; asm volatile("" ::: "memory"); } while (0)
#define U3_EVEN_END(jj_) do { if ((jj_) + 2 < NT) asm volatile("s_waitcnt vmcnt(6)" ::: "memory"); else if ((jj_) + 1 < NT) asm volatile("s_waitcnt vmcnt(4)" ::: "memory"); else asm volatile("s_waitcnt vmcnt(0)" ::: "memory");   \
        asm volatile("s_waitcnt lgkmcnt(0)" ::: "memory"); __builtin_amdgcn_s_barrier(); asm volatile("" ::: "memory"); } while (0)
#define U3_ODD_END() do { asm volatile("s_waitcnt lgkmcnt(0)" ::: "memory"); __builtin_amdgcn_s_barrier(); asm volatile("" ::: "memory"); } while (0)
    if (hb == 0) {
#pragma unroll 1
        for (int jj = 0; jj < NT; ++jj) {
            U3_EVEN_ISSUE(jj); U3_QS(jj); U3_EVEN_END(jj);
            U3_ODD_ISSUE(jj); U3_PV(jj); U3_ODD_END();
        }
        U3_EVEN_ISSUE(NT); U3_EVEN_END(NT);
    } else {
        U3_EVEN_ISSUE(0); U3_EVEN_END(0);
#pragma unroll 1
        for (int jj = 0; jj < NT; ++jj) {
            U3_ODD_ISSUE(jj); U3_QS(jj); U3_ODD_END();
            U3_EVEN_ISSUE(jj + 1); U3_PV(jj); U3_EVEN_END(jj + 1);
        }
    }
#undef U3_QS
#undef U3_PV
#undef U3_EVEN_ISSUE
#undef U3_ODD_ISSUE
#undef U3_EVEN_END
#undef U3_ODD_END
    if (hi == 0) li_l[r32] = l_reg; asm volatile("s_waitcnt lgkmcnt(0)" ::: "memory");
    float rli[16];
#pragma unroll
    for (int r = 0; r < 16; ++r) rli[r] = __builtin_amdgcn_rcpf(li_l[crow(r, hi)]);
    bf16_t* Ow = Ob + (long)(wid * QBLK) * LDO;
#pragma unroll
    for (int r = 0; r < 16; ++r) { const int orow = crow(r, hi);
#pragma unroll
        for (int d0 = 0; d0 < 8; ++d0) Ow[(long)orow * LDO + d0 * 32 + r32] = f2bf(o[d0][r] * rli[r]); }
    asm volatile("s_waitcnt vmcnt(0) lgkmcnt(0)" ::: "memory"); __builtin_amdgcn_s_barrier(); asm volatile("" ::: "memory");
#undef DMA_K
#undef DMA_V
}

__device__ __forceinline__ void unit4(const bf16_t* __restrict__ Qb, const bf16_t* __restrict__ Kh, const bf16_t* __restrict__ Vh, bf16_t* __restrict__ Ob, int NT, int lim, unsigned char* ldsg, LAS unsigned char* lds) {
    int tid_ = threadIdx.x; asm volatile("" : "+v"(tid_));
    const int tid = tid_, wid = __builtin_amdgcn_readfirstlane(tid >> 6), lane = tid & 63, hb = MK_HB(wid);
    LAS float* wsf = (LAS float*)(lds + OFF_W) + wid * 64; LAS float* li_l = wsf; LAS float* al_l = wsf + 32;
    float m_reg = -1e30f, l_reg = 0; f32x16 o[8] = {}; bf16x8 qr[8];
    { const int r32 = lane & 31, hi = lane >> 5; const bf16_t* Qw = Qb + (long)(wid * QBLK + r32) * LDQ + hi * 8;
#pragma unroll
      for (int d0 = 0; d0 < 8; ++d0) qr[d0] = *reinterpret_cast<const bf16x8*>(Qw + d0 * 16); }
#define DMA_K(t_, b_) do { const char* gk = (const char*)Kh + (size_t)(t_) * (KVBLK * LDQ * 2); int ln_ = lane; asm volatile("" : "+v"(ln_)); _Pragma("unroll") for (int i = 0; i < 2; ++i) { \
        const int row = wid * 4 + i * 32 + (ln_ >> 4); const unsigned ko = (unsigned)(row * LDQ * 2 + (((ln_ & 15) * 16) ^ ((row & MK_KSWM) << 4))); \
        __builtin_amdgcn_global_load_lds((const unsigned*)(gk + ko), (LAS unsigned*)(lds + (b_) * KB + wid * 1024 + i * 8192), 16, 0, 0); } } while (0)
#define DMA_V(t_, b_) do { const char* gv = (const char*)Vh + (size_t)(t_) * (KVBLK * LDQ * 2); int ln_ = lane; asm volatile("" : "+v"(ln_)); _Pragma("unroll") for (int i = 0; i < 4; ++i) { \
        const int st = wid * 2 + i * 16 + (ln_ >> 5), q = ln_ & 31; const int kk = (st >> 3) * 8 + (q >> 2); const int k = (kk & ~0xC) | ((kk & 4) << 1) | ((kk & 8) >> 1); \
        const unsigned vo = (unsigned)(k * LDQ * 2 + ((st & 7) * 32 + (q & 3) * 8) * 2); \
        __builtin_amdgcn_global_load_lds((const unsigned*)(gv + vo), (LAS unsigned*)(lds + OFF_V + (b_) * VB + wid * 1024 + i * 8192), 16, 0, 0); } } while (0)
    DMA_K(0, 0); DMA_V(0, 0); if (1 < NT) { DMA_K(1, 1); DMA_V(1, 1); } if (2 < NT) DMA_K(2, 2);
    asm volatile("s_waitcnt vmcnt(0)" ::: "memory"); __builtin_amdgcn_s_barrier(); asm volatile("" ::: "memory");
    f32x16 p0, p1; bf16x8 pa0, pa1, pa2, pa3;
    int kq = 0, ki = 0, vq = 0, vi = 2;
#define U4_QK() do { int lq_ = lane; asm volatile("" : "+v"(lq_)); qkt(p0, p1, (const char*)ldsg + kq * KB, qr, lq_ & 31, lq_ >> 5); kq = kq == 2 ? 0 : kq + 1; } while (0)
#define U4_SM(j_) do { float mn, alpha; int lq_ = lane; asm volatile("" : "+v"(lq_)); const int r32 = lq_ & 31, hi = lq_ >> 5; \
        mask_tile(p0, p1, (j_), lim); \
        partialSM(p0, p1, m_reg, mn, alpha); \
        if (__any(alpha < 1.f)) { if (hi == 0) al_l[r32] = alpha; asm volatile("s_waitcnt lgkmcnt(0)" ::: "memory"); \
            _Pragma("unroll") for (int d = 0; d < 8; ++d) _Pragma("unroll") for (int r = 0; r < 16; ++r) o[d][r] *= al_l[crow(r, hi)]; } \
        finishSM(p0, p1, alpha, l_reg, pa0, pa1, pa2, pa3); } while (0)
#define U4_PV() do { int lp_ = lane; asm volatile("" : "+v"(lp_)); const int vb = (int)(uintptr_t)(ldsg + OFF_V) + v_rd_base(lp_) + vq * VB; vq = vq == 2 ? 0 : vq + 1; \
        pv2_all(o, vb, pa0, pa1, pa2, pa3); } while (0)
#define U4_ISSUE(s_) do { if (((s_) & 1) == 0) { if ((s_) >= 2) { if ((s_) / 2 + 2 < NT) DMA_K((s_) / 2 + 2, ki); ki = ki == 2 ? 0 : ki + 1; } } \
        else { if ((s_) >= 3) { if (((s_) + 1) / 2 < NT) DMA_V(((s_) + 1) / 2, vi); vi = vi == 2 ? 0 : vi + 1; } } asm volatile("" ::: "memory"); } while (0)
#define U4_END(s_) do { if ((s_) & 1) { const int kt = ((s_) + 1) / 2 + 1, vt = ((s_) + 1) / 2;     \
            if ((s_) >= 3 && kt < NT && vt < NT) asm volatile("s_waitcnt vmcnt(6)" ::: "memory"); \
            else if ((s_) >= 3 && vt < NT) asm volatile("s_waitcnt vmcnt(4)" ::: "memory"); \
            else asm volatile("s_waitcnt vmcnt(0)" ::: "memory"); } \
        asm volatile("s_waitcnt lgkmcnt(0)" ::: "memory"); __builtin_amdgcn_s_barrier(); asm volatile("" ::: "memory"); } while (0)
    if (hb == 0) {
        U4_ISSUE(0); U4_QK(); U4_END(0);
#pragma unroll 1
        for (int m = 0; m < NT; ++m) {
            U4_ISSUE(2 * m + 1); U4_SM(m); U4_END(2 * m + 1);
            U4_ISSUE(2 * m + 2); U4_PV(); if (m + 1 < NT) U4_QK(); U4_END(2 * m + 2);
        }
        U4_ISSUE(2 * NT + 1); U4_END(2 * NT + 1);
    } else {
        U4_ISSUE(0); U4_END(0);
        U4_ISSUE(1); U4_QK(); U4_END(1);
#pragma unroll 1
        for (int m = 0; m < NT; ++m) {
            U4_ISSUE(2 * m + 2); U4_SM(m); U4_END(2 * m + 2);
            U4_ISSUE(2 * m + 3); U4_PV(); if (m + 1 < NT) U4_QK(); U4_END(2 * m + 3);
        }
    }
#undef U4_QK
#undef U4_SM
#undef U4_PV
#undef U4_ISSUE
#undef U4_END
    const int r32 = lane & 31, hi = lane >> 5;
    if (hi == 0) li_l[r32] = l_reg; asm volatile("s_waitcnt lgkmcnt(0)" ::: "memory");
    float rli[16];
#pragma unroll
    for (int r = 0; r < 16; ++r) rli[r] = __builtin_amdgcn_rcpf(li_l[crow(r, hi)]);
    bf16_t* Ow = Ob + (long)(wid * QBLK) * LDO;
#pragma unroll
    for (int r = 0; r < 16; ++r) { const int orow = crow(r, hi);
#pragma unroll
        for (int d0 = 0; d0 < 8; ++d0) Ow[(long)orow * LDO + d0 * 32 + r32] = f2bf(o[d0][r] * rli[r]); }
    asm volatile("s_waitcnt vmcnt(0) lgkmcnt(0)" ::: "memory"); __builtin_amdgcn_s_barrier(); asm volatile("" ::: "memory");
#undef DMA_K
#undef DMA_V
}

__device__ __forceinline__ void unit5(const bf16_t* __restrict__ Qb, const bf16_t* __restrict__ Kh, const bf16_t* __restrict__ Vh, bf16_t* __restrict__ Ob, int NT, int lim, unsigned char* ldsg, LAS unsigned char* lds) {
    int tid_ = threadIdx.x; asm volatile("" : "+v"(tid_));
    const int tid = tid_, wid = __builtin_amdgcn_readfirstlane(tid >> 6), lane = tid & 63, hb = MK_HB(wid);
    LAS float* wsf = (LAS float*)(lds + OFF_W) + wid * 64; LAS float* li_l = wsf; LAS float* al_l = wsf + 32;
    float m_reg = -1e30f, l_reg = 0; f32x16 o[8] = {}; bf16x8 qr[8];
    { const int r32 = lane & 31, hi = lane >> 5; const bf16_t* Qw = Qb + (long)(wid * QBLK + r32) * LDQ + hi * 8;
#pragma unroll
      for (int d0 = 0; d0 < 8; ++d0) qr[d0] = *reinterpret_cast<const bf16x8*>(Qw + d0 * 16); }
#define DMA_K(t_, b_) do { const char* gk = (const char*)Kh + (size_t)(t_) * (KVBLK * LDQ * 2); int ln_ = lane; asm volatile("" : "+v"(ln_)); _Pragma("unroll") for (int i = 0; i < 2; ++i) { \
        const int row = wid * 4 + i * 32 + (ln_ >> 4); const unsigned ko = (unsigned)(row * LDQ * 2 + (((ln_ & 15) * 16) ^ ((row & MK_KSWM) << 4))); \
        __builtin_amdgcn_global_load_lds((const unsigned*)(gk + ko), (LAS unsigned*)(lds + (b_) * KB + wid * 1024 + i * 8192), 16, 0, 0); } } while (0)
#define DMA_V(t_, b_) do { const char* gv = (const char*)Vh + (size_t)(t_) * (KVBLK * LDQ * 2); int ln_ = lane; asm volatile("" : "+v"(ln_)); _Pragma("unroll") for (int i = 0; i < 4; ++i) { \
        const int st = wid * 2 + i * 16 + (ln_ >> 5), q = ln_ & 31; const int kk = (st >> 3) * 8 + (q >> 2); const int k = (kk & ~0xC) | ((kk & 4) << 1) | ((kk & 8) >> 1); \
        const unsigned vo = (unsigned)(k * LDQ * 2 + ((st & 7) * 32 + (q & 3) * 8) * 2); \
        __builtin_amdgcn_global_load_lds((const unsigned*)(gv + vo), (LAS unsigned*)(lds + OFF_V + (b_) * VB + wid * 1024 + i * 8192), 16, 0, 0); } } while (0)
    DMA_K(0, 0); DMA_V(0, 0); if (1 < NT) DMA_K(1, 1);
    asm volatile("s_waitcnt vmcnt(0)" ::: "memory"); __builtin_amdgcn_s_barrier(); asm volatile("" ::: "memory");
    bf16x8 pa0, pa1, pa2, pa3;
    int kb = 0, kb1 = 1, kb2 = 2;
#define U5_ISSUE(j_) do { if ((j_) + 1 < NT) DMA_V((j_) + 1, kb1); asm volatile("" ::: "memory"); if ((j_) + 2 < NT) DMA_K((j_) + 2, kb2); asm volatile("" ::: "memory"); } while (0)
#define U5_QS(j_) do { f32x16 p0, p1; float mn, alpha; int lq_ = lane; asm volatile("" : "+v"(lq_)); const int r32 = lq_ & 31, hi = lq_ >> 5; \
        qkt(p0, p1, (const char*)ldsg + kb * KB, qr, r32, hi); \
        mask_tile(p0, p1, (j_), lim); \
        partialSM(p0, p1, m_reg, mn, alpha); \
        if (__any(alpha < 1.f)) { if (hi == 0) al_l[r32] = alpha; asm volatile("s_waitcnt lgkmcnt(0)" ::: "memory"); \
            _Pragma("unroll") for (int d = 0; d < 8; ++d) _Pragma("unroll") for (int r = 0; r < 16; ++r) o[d][r] *= al_l[crow(r, hi)]; } \
        finishSM(p0, p1, alpha, l_reg, pa0, pa1, pa2, pa3); } while (0)
#define U5_PV(vbuf_) do { int lp_ = lane; asm volatile("" : "+v"(lp_)); const int vb = (int)(uintptr_t)(ldsg + OFF_V) + v_rd_base(lp_) + (vbuf_) * VB; pv2_all(o, vb, pa0, pa1, pa2, pa3); } while (0)
#define U5_END(j_) do { if ((j_) + 2 < NT) asm volatile("s_waitcnt vmcnt(2)" ::: "memory"); else asm volatile("s_waitcnt vmcnt(0)" ::: "memory"); \
        asm volatile("s_waitcnt lgkmcnt(0)" ::: "memory"); __builtin_amdgcn_s_barrier(); asm volatile("" ::: "memory"); \
        { const int t_ = kb; kb = kb1; kb1 = kb2; kb2 = t_; } } while (0)
    if (hb == 0) {
#pragma unroll 1
        for (int j = 0; j < NT; ++j) { U5_ISSUE(j); U5_QS(j); U5_PV(kb); U5_END(j); }
    } else {
#pragma unroll 1
        for (int j = 0; j < NT; ++j) { U5_ISSUE(j); if (j > 0) U5_PV(kb2); U5_QS(j); U5_END(j); }
        U5_PV(kb2);
    }
#undef U5_ISSUE
#undef U5_QS
#undef U5_PV
#undef U5_END
    const int r32 = lane & 31, hi = lane >> 5;
    if (hi == 0) li_l[r32] = l_reg; asm volatile("s_waitcnt lgkmcnt(0)" ::: "memory");
    float rli[16];
#pragma unroll
    for (int r = 0; r < 16; ++r) rli[r] = __builtin_amdgcn_rcpf(li_l[crow(r, hi)]);
    bf16_t* Ow = Ob + (long)(wid * QBLK) * LDO;
#pragma unroll
    for (int r = 0; r < 16; ++r) { const int orow = crow(r, hi);
#pragma unroll
        for (int d0 = 0; d0 < 8; ++d0) Ow[(long)orow * LDO + d0 * 32 + r32] = f2bf(o[d0][r] * rli[r]); }
    asm volatile("s_waitcnt vmcnt(0) lgkmcnt(0)" ::: "memory"); __builtin_amdgcn_s_barrier(); asm volatile("" ::: "memory");
#undef DMA_K
#undef DMA_V
}
}

#ifndef MK_ATT2
#define MK_ATT2 1
#endif
#ifndef MK_PROBE_QK2
#define MK_PROBE_QK2 0
#endif
#ifndef MK_PROBE_DMA2
#define MK_PROBE_DMA2 0
#endif
#ifndef MK_ATT_UNIT
#define MK_ATT_UNIT unit2
#endif
#if MK_ATT2
__device__ __forceinline__ void attn_phase(const Fr& F) {
    const bf16_t* Q = slotY(F, 0); const bf16_t* K = slotY(F, 1); const bf16_t* V = slotY(F, 2);
    bf16_t* AO = slotU(F, 1);
    const int x = F.bid & 7, j = (F.bid >> 3) & 31;
#pragma unroll 1
    for (int k = 0; k < 4; ++k) {
        if (F.bid >= 256) break;
        const int sub = 4 * x + k, head = sub >> 1, c = sub & 1;
        const bf16_t* Kp = K + head * 256 + c * 128; const bf16_t* Vp = V + head * 256;
#pragma unroll 1
        for (int u = 0; u < 2; ++u) {
            const int t = u == 0 ? 63 - j : j;
            const int row0 = 256 * t + 128;
            att2::MK_ATT_UNIT(Q + (size_t)row0 * D + head * 256 + c * 128, Kp, Vp, AO + (size_t)row0 * 8192 + head * 512 + c * 256, 4 * t + 6, 4 * t + 2 + (F.wave >> 1), F.ldsg, F.lds);
        }
        if (j == 8 * k) att2::MK_ATT_UNIT(Q + head * 256 + c * 128, Kp, Vp, AO + head * 512 + c * 256, 4, F.wave >> 1, F.ldsg, F.lds);
    }
}
#else
__device__ __forceinline__ void attn_phase(const Fr& F) {
    const bf16_t* Q = slotY(F, 0); const bf16_t* K = slotY(F, 1); const bf16_t* V = slotY(F, 2);
    bf16_t* AO = slotU(F, 1);
    const int x = F.bid & 7, j = (F.bid >> 3) & 31;
#pragma unroll 1
    for (int k = 0; k < 8; ++k) {
        if (F.bid >= 256) break;
        const int sub = 8 * x + k, head = sub >> 2, c = (sub >> 1) & 1, half = sub & 1;
        const bf16_t* Kp = K + head * 256 + c * 128; const bf16_t* Vp = V + head * 256 + half * 128;
#pragma unroll 1
        for (int u = 0; u < 2; ++u) {
            const int t = u == 0 ? 63 - j : j;
            const int row0 = 256 * t + 128;
            att::unit(Q + (size_t)row0 * D + head * 256 + c * 128, Kp, Vp, AO + (size_t)row0 * 8192 + head * 512 + c * 256 + half * 128, 4 * t + 6, 4 * t + 2 + (F.wave >> 1), (char*)F.ldsg);
        }
        if (j == 4 * k) att::unit(Q + head * 256 + c * 128, Kp, Vp, AO + head * 512 + c * 256 + half * 128, 4, F.wave >> 1, (char*)F.ldsg);
    }
}
#endif
__device__ __forceinline__ void attn_post(const Fr& F) {
    const bf16_t* AO = slotU(F, 1); const bf16_t* GT = slotY(F, 3); bf16_t* Z = slotU(F, 0);
    const float* sg = F.in(13);
    constexpr float LINIT = 0.35550906759096934f;
    float lam;
    { const float* q1 = F.in(9); const float* k1 = F.in(10); const float* q2 = F.in(11); const float* k2 = F.in(12);
      const float d1 = wave_sum(q1[F.lane] * k1[F.lane] + q1[F.lane + 64] * k1[F.lane + 64]), d2 = wave_sum(q2[F.lane] * k2[F.lane] + q2[F.lane + 64] * k2[F.lane + 64]);
      lam = expf(d1) - expf(d2) + LINIT; }
    const f32x4 g4 = ((const f32x4*)sg)[F.lane];
    for (int r = F.gw; r < R; r += F.NGW) {
        const bool real = (r >= NPAD && r < NREAL);
        u32x2* zr = (u32x2*)(Z + (size_t)r * D) + F.lane;
        if (!real) { const u32x2 z = {0u, 0u};
#pragma unroll
            for (int hd = 0; hd < 16; ++hd) zr[64 * hd] = z;
            continue; }
        gp_ ao0 = (gp_)(AO + (size_t)r * 8192) + F.lane * 8 + 4096; gp_ ao1 = ao0 + 8192; asm volatile("" : "+v"(ao0), "+v"(ao1));
        ROW_BF(gq, GT + (size_t)r * D, F.lane); ROW_BF(zq, Z + (size_t)r * D, F.lane);
        u32x2 a0v[16], a1v[16], gtv[16];
#pragma unroll
        for (int hd = 0; hd < 16; ++hd) {
            a0v[hd] = *(GAS u32x2*)(hd < 8 ? ao0 + (2 * hd) * 512 - 4096 : ao1 + (2 * hd - 16) * 512 - 4096);
            a1v[hd] = *(GAS u32x2*)(hd < 8 ? ao0 + (2 * hd + 1) * 512 - 4096 : ao1 + (2 * hd - 15) * 512 - 4096);
            gtv[hd] = AT_BF(gq, hd);
        }
#pragma unroll
        for (int hd = 0; hd < 16; ++hd) {
            const u32x2 a0 = a0v[hd], a1 = a1v[hd], gt = gtv[hd];
            const float o0 = bflo(a0.x) - lam * bflo(a1.x), o1 = bfhi(a0.x) - lam * bfhi(a1.x), o2 = bflo(a0.y) - lam * bflo(a1.y), o3 = bfhi(a0.y) - lam * bfhi(a1.y);
            const float ss = wave_sum((o0 * o0 + o1 * o1) + (o2 * o2 + o3 * o3));
            const float rs = __builtin_amdgcn_rsqf(ss * (1.f / 256.f) + 1e-5f) * (1.f - LINIT);
            u32x2 w; w.x = cvt_pk_bf16(o0 * rs * g4.x * silu_f(bflo(gt.x)), o1 * rs * g4.y * silu_f(bfhi(gt.x))); w.y = cvt_pk_bf16(o2 * rs * g4.z * silu_f(bflo(gt.y)), o3 * rs * g4.w * silu_f(bfhi(gt.y)));
            AT_BF(zq, hd) = w;
        }
    }
}

constexpr int RW_TT = 32, RW_TOKF = 384, RW_TILEF = RW_TT * RW_TOKF, RW_NTILE = 513;
__device__ __forceinline__ void rwkv_scan_seq(const Fr& F) {
    const bf16_t* Rr = slotY(F, 0); const bf16_t* K = slotY(F, 1); const bf16_t* V = slotY(F, 2); const bf16_t* W = slotY(F, 4); const bf16_t* A = slotY(F, 5);
    float* O32 = (float*)slotU(F, 1);
    LAS float* ring = (LAS float*)F.lds; LAS float* otile = ring + 2 * RW_TILEF;
    const int tid = F.tid, lane = F.lane, wid = F.wave;
    for (int unit = F.bid; unit < 256; unit += F.G) {
        const int h = unit >> 2, rg = unit & 3;
        const int ptid = tid - 256, ptt = ptid >> 3, dg = ptid & 7;
        float kkc[8], kac[8];
        if (wid >= 4) {
#pragma unroll
            for (int i = 0; i < 8; ++i) { kkc[i] = F.in(23)[h * 64 + 8 * dg + i]; kac[i] = F.in(24)[h * 64 + 8 * dg + i]; }
        }
        float S0 = 0.f, S1 = 0.f, S2 = 0.f, S3 = 0.f;
        const int cg = lane & 15, irow = 4 * wid + (lane >> 4);
#define RW_PRODUCE(m, buf) do { const int row = NPAD + 32 * (m) + ptt; const size_t off = (size_t)row * D + h * 64 + 8 * dg; \
        const u32x4 r8 = *(const u32x4*)(Rr + off), k8 = *(const u32x4*)(K + off), v8 = *(const u32x4*)(V + off), w8 = *(const u32x4*)(W + off), a8 = *(const u32x4*)(A + off); \
        const unsigned rw[4] = {r8.x, r8.y, r8.z, r8.w}, kw[4] = {k8.x, k8.y, k8.z, k8.w}, vw[4] = {v8.x, v8.y, v8.z, v8.w}, ww[4] = {w8.x, w8.y, w8.z, w8.w}, aw[4] = {a8.x, a8.y, a8.z, a8.w}; \
        float rf[8], kf[8], vf[8], wf[8], af[8], kk[8]; float ssq = 0.f; \
        _Pragma("unroll") for (int i = 0; i < 4; ++i) { rf[2 * i] = bflo(rw[i]); rf[2 * i + 1] = bfhi(rw[i]); kf[2 * i] = bflo(kw[i]); kf[2 * i + 1] = bfhi(kw[i]); vf[2 * i] = bflo(vw[i]); vf[2 * i + 1] = bfhi(vw[i]); \
            wf[2 * i] = bflo(ww[i]); wf[2 * i + 1] = bfhi(ww[i]); af[2 * i] = bflo(aw[i]); af[2 * i + 1] = bfhi(aw[i]); } \
        _Pragma("unroll") for (int i = 0; i < 8; ++i) { kk[i] = kf[i] * kkc[i]; ssq += kk[i] * kk[i]; } \
        ssq = red8(ssq); const float inv = 1.f / fmaxf(sqrtf(ssq), 1e-12f); \
        LAS float* tb = ring + (buf) * RW_TILEF + ptt * RW_TOKF; \
        _Pragma("unroll") for (int q = 0; q < 2; ++q) { LAS f32x4* p = (LAS f32x4*)(tb + (2 * dg + q) * 20); \
            f32x4 t0, t1, t2, t3, t4; \
            _Pragma("unroll") for (int e = 0; e < 4; ++e) { const int i = 4 * q + e; const float kn = kk[i] * inv; t0[e] = wf[i]; t1[e] = -kn; t2[e] = kn * af[i]; t3[e] = kf[i] * (1.f + (af[i] - 1.f) * kac[i]); t4[e] = rf[i]; } \
            p[0] = t0; p[1] = t1; p[2] = t2; p[3] = t3; p[4] = t4; } \
        LAS f32x4* pv = (LAS f32x4*)(tb + 320 + 8 * dg); pv[0] = (f32x4){vf[0], vf[1], vf[2], vf[3]}; pv[1] = (f32x4){vf[4], vf[5], vf[6], vf[7]}; } while (0)
#define RW_FLUSH(m, buf) do { const int row = NPAD + 32 * (m) + ptt; if (row < NREAL) { const LAS float* ot = otile + (buf) * 512 + ptt * 16 + 2 * dg; \
        *(float2*)(O32 + (size_t)row * D + h * 64 + 16 * rg + 2 * dg) = make_float2(ot[0], ot[1]); } } while (0)
        if (wid >= 4) RW_PRODUCE(0, 0);
        __syncthreads();
        for (int n = 0; n < RW_NTILE; ++n) {
            if (wid < 4) {
                const LAS float* tb = ring + (n & 1) * RW_TILEF; LAS float* ot = otile + (n & 1) * 512;
#pragma unroll 4
                for (int tt = 0; tt < RW_TT; ++tt) {
                    const LAS float* p = tb + tt * RW_TOKF + cg * 20;
                    const f32x4 w4 = *(const LAS f32x4*)p, nk = *(const LAS f32x4*)(p + 4), ka = *(const LAS f32x4*)(p + 8), kp = *(const LAS f32x4*)(p + 12), r4 = *(const LAS f32x4*)(p + 16);
                    const float v = tb[tt * RW_TOKF + 320 + 16 * rg + irow];
                    float sa = (S0 * nk.x + S1 * nk.y) + (S2 * nk.z + S3 * nk.w);
                    sa = red16(sa);
                    S0 = S0 * w4.x + (sa * ka.x + v * kp.x); S1 = S1 * w4.y + (sa * ka.y + v * kp.y); S2 = S2 * w4.z + (sa * ka.z + v * kp.z); S3 = S3 * w4.w + (sa * ka.w + v * kp.w);
                    float o = (S0 * r4.x + S1 * r4.y) + (S2 * r4.z + S3 * r4.w);
                    o = red16(o);
                    if (cg == 0) ot[tt * 16 + irow] = o;
                }
            } else {
                if (n + 1 < RW_NTILE) RW_PRODUCE(n + 1, (n + 1) & 1);
                if (n > 0) RW_FLUSH(n - 1, (n - 1) & 1);
            }
            __syncthreads();
        }
        if (wid >= 4) RW_FLUSH(RW_NTILE - 1, (RW_NTILE - 1) & 1);
        __syncthreads();
#undef RW_PRODUCE
#undef RW_FLUSH
    }
}

#ifndef RC_SYNC
#define RC_SYNC 0
#endif
constexpr int RC_SLOT = 13312, RC_NSLOT = 8, RC_SCR0 = RC_NSLOT * RC_SLOT, RC_SCR = 5632, RC_FLAGS = RC_SCR0 + 7 * RC_SCR, RC_NCH = 1025;
constexpr int RC_AT = 0, RC_RT = 2176, RC_BTT = 4352, RC_KTT = 6912, RC_TT = 9472, RC_G3F = 9984, RC_VTF = 10496, RC_P1 = 11008, RC_P2 = 12032, RC_WC = 13056;
static_assert(RC_FLAGS + 64 <= 147456 - 256, "rwkv LDS map");
typedef short s16x4v __attribute__((ext_vector_type(4)));
__device__ __forceinline__ void rwkv_kknorm(const Fr& F) {
    const bf16_t* K = slotY(F, 1); const float* k_k = F.in(23); float* INV = (float*)(F.ws + WS_HE);
    f32x4 c4v[16];
    { ROW_F32(cq, k_k, F.lane);
#pragma unroll
      for (int it = 0; it < 16; ++it) c4v[it] = AT_F32(cq, it); }
    for (int r = F.gw; r < R; r += F.NGW) {
        ROW_BF(kq_, K + (size_t)r * D, F.lane);
        u32x2 kv[16];
#pragma unroll
        for (int it = 0; it < 16; ++it) kv[it] = AT_BF(kq_, it);
#pragma unroll
        for (int it = 0; it < 16; ++it) {
            const u32x2 kk = kv[it]; const f32x4 c4 = c4v[it];
            const float a = bflo(kk.x) * c4.x, b = bfhi(kk.x) * c4.y, c = bflo(kk.y) * c4.z, d = bfhi(kk.y) * c4.w;
            const float ss = red16((a * a + b * b) + (c * c + d * d));
            if ((F.lane & 15) == 0) INV[(size_t)r * 64 + it * 4 + (F.lane >> 4)] = 1.f / fmaxf(sqrtf(ss), 1e-12f);
        }
    }
}
__device__ __forceinline__ unsigned lds_poll(volatile LAS unsigned* p) { return *p; }
__device__ __forceinline__ void rwkv_scan(const Fr& F) {
    const bf16_t* Rr = slotY(F, 0); const bf16_t* K = slotY(F, 1); const bf16_t* V = slotY(F, 2); const bf16_t* W = slotY(F, 4); const bf16_t* A = slotY(F, 5);
    const float* INV = (const float*)(F.ws + WS_HE);
    float* O32 = (float*)slotU(F, 1);
    LAS unsigned char* L = F.lds;
    volatile LAS unsigned* flags = (volatile LAS unsigned*)(L + RC_FLAGS);
    const int lane = F.lane, wid = F.wave, l15 = lane & 15, kg = lane >> 4;
    for (int unit = F.bid; unit < 256; unit += F.G) {
        const int h = unit >> 2, rgw = unit & 3;
        if (F.tid < 16) flags[F.tid] = 0u;
        __syncthreads();
        if (wid == 0) {
            __builtin_amdgcn_s_setprio(3);
            f32x4 S0 = {0.f, 0.f, 0.f, 0.f}, S1 = S0, S2 = S0, S3 = S0;
            struct SlotRegs { u32x2 a0l, a0h, a1l, a1h, r0l, r0h, r1l, r1h; f32x4 P1, P2; s16x4v ttf, g3f, vtf, b0, b1, b2, b3, k0, k1, k2, k3; f32x4 w0, w1, w2, w3; };
#if RC_SYNC
#define CH_WAIT(n_) do { if ((n_) % 7 == 0) { __builtin_amdgcn_s_barrier(); __builtin_amdgcn_s_barrier(); } } while (0)
#else
#define CH_WAIT(n_) do { unsigned sp = 0; while (lds_poll(flags + ((n_) & 7)) != (unsigned)((n_) + 1)) { __builtin_amdgcn_s_sleep(1); if (++sp > (1u << 22)) break; } } while (0)
#endif
#define CH_LOAD(R_, n_) do { CH_WAIT(n_); asm volatile("s_waitcnt lgkmcnt(0)" ::: "memory"); const LAS unsigned char* SL = L + ((n_) & 7) * RC_SLOT; \
                const LAS unsigned char* ap = SL + RC_AT + l15 * 136 + kg * 8; const LAS unsigned char* rp = SL + RC_RT + l15 * 136 + kg * 8; \
                R_.a0l = *(const LAS u32x2*)(ap); R_.a0h = *(const LAS u32x2*)(ap + 32); R_.a1l = *(const LAS u32x2*)(ap + 64); R_.a1h = *(const LAS u32x2*)(ap + 96); \
                R_.r0l = *(const LAS u32x2*)(rp); R_.r0h = *(const LAS u32x2*)(rp + 32); R_.r1l = *(const LAS u32x2*)(rp + 64); R_.r1h = *(const LAS u32x2*)(rp + 96); \
                R_.P1 = *(const LAS f32x4*)(SL + RC_P1 + lane * 16); R_.P2 = *(const LAS f32x4*)(SL + RC_P2 + lane * 16); \
                R_.ttf = *(const LAS s16x4v*)(SL + RC_TT + lane * 8); R_.g3f = *(const LAS s16x4v*)(SL + RC_G3F + lane * 8); R_.vtf = *(const LAS s16x4v*)(SL + RC_VTF + lane * 8); \
                const LAS unsigned char* bp = SL + RC_BTT + l15 * 40 + kg * 8; const LAS unsigned char* kp = SL + RC_KTT + l15 * 40 + kg * 8; \
                R_.b0 = *(const LAS s16x4v*)(bp); R_.b1 = *(const LAS s16x4v*)(bp + 640); R_.b2 = *(const LAS s16x4v*)(bp + 1280); R_.b3 = *(const LAS s16x4v*)(bp + 1920); \
                R_.k0 = *(const LAS s16x4v*)(kp); R_.k1 = *(const LAS s16x4v*)(kp + 640); R_.k2 = *(const LAS s16x4v*)(kp + 1280); R_.k3 = *(const LAS s16x4v*)(kp + 1920); \
                const LAS f32x4* wc = (const LAS f32x4*)(SL + RC_WC + kg * 16); R_.w0 = wc[0]; R_.w1 = wc[4]; R_.w2 = wc[8]; R_.w3 = wc[12]; \
                asm volatile("s_waitcnt lgkmcnt(0)" ::: "memory"); \
                if (lane == 0) flags[8] = (unsigned)((n_) + 1); } while (0)
#define CH_COMPUTE(R_, n_, NEXT_) do { \
                u32x4 sb0, sb1; sb0.x = cvt_pk_bf16(S0.x, S0.y); sb0.y = cvt_pk_bf16(S0.z, S0.w); sb0.z = cvt_pk_bf16(S1.x, S1.y); sb0.w = cvt_pk_bf16(S1.z, S1.w); \
                sb1.x = cvt_pk_bf16(S2.x, S2.y); sb1.y = cvt_pk_bf16(S2.z, S2.w); sb1.z = cvt_pk_bf16(S3.x, S3.y); sb1.w = cvt_pk_bf16(S3.z, S3.w); \
                const bf16x8 Sb0 = *reinterpret_cast<bf16x8*>(&sb0), Sb1 = *reinterpret_cast<bf16x8*>(&sb1); \
                u32x4 t4; \
                t4 = (u32x4){R_.a0l.x, R_.a0l.y, R_.a0h.x, R_.a0h.y}; const bf16x8 Aq0 = *reinterpret_cast<bf16x8*>(&t4); \
                t4 = (u32x4){R_.a1l.x, R_.a1l.y, R_.a1h.x, R_.a1h.y}; const bf16x8 Aq1 = *reinterpret_cast<bf16x8*>(&t4); \
                t4 = (u32x4){R_.r0l.x, R_.r0l.y, R_.r0h.x, R_.r0h.y}; const bf16x8 Rq0 = *reinterpret_cast<bf16x8*>(&t4); \
                t4 = (u32x4){R_.r1l.x, R_.r1l.y, R_.r1h.x, R_.r1h.y}; const bf16x8 Rq1 = *reinterpret_cast<bf16x8*>(&t4); \
                f32x4 X = R_.P1, O = R_.P2; \
                X = __builtin_amdgcn_mfma_f32_16x16x32_bf16(Aq0, Sb0, X, 0, 0, 0); \
                X = __builtin_amdgcn_mfma_f32_16x16x32_bf16(Aq1, Sb1, X, 0, 0, 0);                   \
                O = __builtin_amdgcn_mfma_f32_16x16x32_bf16(Rq0, Sb0, O, 0, 0, 0); \
                O = __builtin_amdgcn_mfma_f32_16x16x32_bf16(Rq1, Sb1, O, 0, 0, 0);                   \
                u32x2 yb; yb.x = cvt_pk_bf16(X.x, X.y); yb.y = cvt_pk_bf16(X.z, X.w); \
                f32x4 U = {0.f, 0.f, 0.f, 0.f}; \
                U = __builtin_amdgcn_mfma_f32_16x16x16bf16_1k(R_.ttf, *reinterpret_cast<s16x4v*>(&yb), U, 0, 0, 0);     \
                u32x2 ub; ub.x = cvt_pk_bf16(U.x, U.y); ub.y = cvt_pk_bf16(U.z, U.w); \
                const s16x4v Ub = *reinterpret_cast<s16x4v*>(&ub); \
                S0 = __builtin_amdgcn_mfma_f32_16x16x16bf16_1k(R_.k0, R_.vtf, S0, 0, 0, 0); S1 = __builtin_amdgcn_mfma_f32_16x16x16bf16_1k(R_.k1, R_.vtf, S1, 0, 0, 0); \
                S2 = __builtin_amdgcn_mfma_f32_16x16x16bf16_1k(R_.k2, R_.vtf, S2, 0, 0, 0); S3 = __builtin_amdgcn_mfma_f32_16x16x16bf16_1k(R_.k3, R_.vtf, S3, 0, 0, 0); \
                S0 = __builtin_amdgcn_mfma_f32_16x16x16bf16_1k(R_.b0, Ub, S0, 0, 0, 0); S1 = __builtin_amdgcn_mfma_f32_16x16x16bf16_1k(R_.b1, Ub, S1, 0, 0, 0); \
                S2 = __builtin_amdgcn_mfma_f32_16x16x16bf16_1k(R_.b2, Ub, S2, 0, 0, 0); S3 = __builtin_amdgcn_mfma_f32_16x16x16bf16_1k(R_.b3, Ub, S3, 0, 0, 0); \
                O = __builtin_amdgcn_mfma_f32_16x16x16bf16_1k(R_.g3f, Ub, O, 0, 0, 0);                   \
                NEXT_; \
                S0 = S0 * R_.w0; S1 = S1 * R_.w1; S2 = S2 * R_.w2; S3 = S3 * R_.w3; \
                float* op = O32 + (size_t)(NPAD + 16 * (n_) + 4 * kg) * D + h * 64 + 16 * rgw + l15;     \
                op[0] = O.x; op[D] = O.y; op[2 * D] = O.z; op[3 * D] = O.w; } while (0)
            SlotRegs RA, RB;
            CH_LOAD(RA, 0);
            for (int n = 0; n + 1 < RC_NCH; n += 2) {
                CH_COMPUTE(RA, n, CH_LOAD(RB, n + 1));
                if (n + 2 < RC_NCH) { CH_COMPUTE(RB, n + 1, CH_LOAD(RA, n + 2)); } else { CH_COMPUTE(RB, n + 1, (void)0); }
            }
            if (RC_NCH & 1) { CH_COMPUTE(RA, RC_NCH - 1, (void)0); }
            __builtin_amdgcn_s_setprio(0);
#undef CH_WAIT
#undef CH_LOAD
#undef CH_COMPUTE
        } else {
            const int p = wid - 1;
            LAS unsigned char* SC = L + RC_SCR0 + p * RC_SCR;
            const float kkc = F.in(23)[h * 64 + lane], kac = F.in(24)[h * 64 + lane];
            unsigned short cr[16], ck[16], cw[16], ca[16], nvq[4]; float civ[16];
#define RC_LOADS(nn) do { const int r0n = NPAD + 16 * (nn); \
                _Pragma("unroll") for (int e = 0; e < 4; ++e) nvq[e] = V[(size_t)(r0n + 4 * kg + e) * D + h * 64 + 16 * rgw + l15]; \
                _Pragma("unroll") for (int s = 0; s < 16; ++s) { const size_t off = (size_t)(r0n + s) * D + h * 64 + lane; cr[s] = Rr[off]; ck[s] = K[off]; cw[s] = W[off]; ca[s] = A[off]; civ[s] = INV[(size_t)(r0n + s) * 64 + h]; } } while (0)
            RC_LOADS(p);
            for (int n = p; n < RC_NCH; n += 7) {
                const int slot = n & 7; LAS unsigned char* SL = L + slot * RC_SLOT;
                unsigned short vq[4];
#pragma unroll
                for (int e = 0; e < 4; ++e) vq[e] = nvq[e];
#if RC_SYNC
                asm volatile("s_waitcnt lgkmcnt(0)" ::: "memory"); __builtin_amdgcn_s_barrier();
#else
                if (n >= 8) { unsigned sp = 0; while (lds_poll(flags + 8) < (unsigned)(n - 7)) { __builtin_amdgcn_s_sleep(2); if (++sp > (1u << 22)) break; } }
#endif
                asm volatile("" ::: "memory");
                float Wp = 1.f; unsigned btp[8], ktp[8];
#pragma unroll
                for (int hb = 0; hb < 2; ++hb) {
                    unsigned short rq[8], kq[8], wq[8], aq[8]; float iv[8];
#pragma unroll
                    for (int s = 0; s < 8; ++s) { rq[s] = cr[8 * hb + s]; kq[s] = ck[8 * hb + s]; wq[s] = cw[8 * hb + s]; aq[s] = ca[8 * hb + s]; iv[s] = civ[8 * hb + s]; }
                    float btv[8], ktv[8];
#pragma unroll
                    for (int s = 0; s < 8; ++s) {
                        const int t = 8 * hb + s;
                        const float rs = bf2f(rq[s]), ks = bf2f(kq[s]), wsv = bf2f(wq[s]), as = bf2f(aq[s]);
                        const float kk = ks * kkc * iv[s];
                        const float Wprev = Wp; Wp *= wsv; const float iW = __builtin_amdgcn_rcpf(Wp);
                        const float at = -kk * Wprev, rt = rs * Wp, bt = kk * as * iW, kt = ks * (1.f + (as - 1.f) * kac) * iW;
                        *(LAS bf16_t*)(SL + RC_AT + t * 136 + lane * 2) = f2bf(at); *(LAS bf16_t*)(SL + RC_RT + t * 136 + lane * 2) = f2bf(rt);
                        *(LAS bf16_t*)(SC + t * 136 + lane * 2) = f2bf(bt); *(LAS bf16_t*)(SC + 2176 + t * 136 + lane * 2) = f2bf(kt);
                        btv[s] = bt; ktv[s] = kt;
                    }
#pragma unroll
                    for (int s = 0; s < 4; ++s) { btp[4 * hb + s] = cvt_pk_bf16(btv[2 * s], btv[2 * s + 1]); ktp[4 * hb + s] = cvt_pk_bf16(ktv[2 * s], ktv[2 * s + 1]); }
                }
                {
                    LAS u32x2* bq = (LAS u32x2*)(SL + RC_BTT + lane * 40); LAS u32x2* kq2 = (LAS u32x2*)(SL + RC_KTT + lane * 40);
#pragma unroll
                    for (int q = 0; q < 4; ++q) { bq[q] = (u32x2){btp[2 * q], btp[2 * q + 1]}; kq2[q] = (u32x2){ktp[2 * q], ktp[2 * q + 1]}; }
                    *(LAS float*)(SL + RC_WC + lane * 4) = Wp;
                    u32x2 vt; vt.x = (unsigned)vq[0] | ((unsigned)vq[1] << 16); vt.y = (unsigned)vq[2] | ((unsigned)vq[3] << 16);
                    *(LAS u32x2*)(SL + RC_VTF + lane * 8) = vt;
                }
                if (n + 7 < RC_NCH) RC_LOADS(n + 7);
                asm volatile("s_waitcnt lgkmcnt(0)" ::: "memory");
                f32x4 G1 = {0.f, 0.f, 0.f, 0.f}, G2 = G1, G3 = G1, G4 = G1, G1t = G1;
#pragma unroll
                for (int ks = 0; ks < 2; ++ks) {
                    const bf16x8 fb = *(const LAS bf16x8*)(SC + l15 * 136 + (32 * ks + 8 * kg) * 2), fk = *(const LAS bf16x8*)(SC + 2176 + l15 * 136 + (32 * ks + 8 * kg) * 2);
                    const bf16x8 fa = *(const LAS bf16x8*)(SL + RC_AT + l15 * 136 + (32 * ks + 8 * kg) * 2), fr_ = *(const LAS bf16x8*)(SL + RC_RT + l15 * 136 + (32 * ks + 8 * kg) * 2);
                    G1 = __builtin_amdgcn_mfma_f32_16x16x32_bf16(fb, fa, G1, 0, 0, 0); G2 = __builtin_amdgcn_mfma_f32_16x16x32_bf16(fk, fa, G2, 0, 0, 0);
                    G1t = __builtin_amdgcn_mfma_f32_16x16x32_bf16(fa, fb, G1t, 0, 0, 0);
                    G3 = __builtin_amdgcn_mfma_f32_16x16x32_bf16(fb, fr_, G3, 0, 0, 0); G4 = __builtin_amdgcn_mfma_f32_16x16x32_bf16(fk, fr_, G4, 0, 0, 0);
                }
                {
#pragma unroll
                    for (int e = 0; e < 4; ++e) { const int s = 4 * kg + e; const bool lt = s < l15, le = s <= l15;
                        G1[e] = lt ? G1[e] : 0.f; G1t[e] = (l15 < s) ? G1t[e] : 0.f; G2[e] = lt ? G2[e] : 0.f; G3[e] = le ? G3[e] : 0.f; G4[e] = le ? G4[e] : 0.f; }
                    u32x2 g2, g3, g4; g2.x = cvt_pk_bf16(G2.x, G2.y); g2.y = cvt_pk_bf16(G2.z, G2.w); g3.x = cvt_pk_bf16(G3.x, G3.y); g3.y = cvt_pk_bf16(G3.z, G3.w); g4.x = cvt_pk_bf16(G4.x, G4.y); g4.y = cvt_pk_bf16(G4.z, G4.w);
                    *(LAS u32x2*)(SL + RC_G3F + lane * 8) = g3;
                    u32x2 vt; vt.x = (unsigned)vq[0] | ((unsigned)vq[1] << 16); vt.y = (unsigned)vq[2] | ((unsigned)vq[3] << 16);
                    const s16x4v vtf = *reinterpret_cast<s16x4v*>(&vt);
                    f32x4 P1 = {0.f, 0.f, 0.f, 0.f}, P2 = P1;
                    P1 = __builtin_amdgcn_mfma_f32_16x16x16bf16_1k(*reinterpret_cast<s16x4v*>(&g2), vtf, P1, 0, 0, 0);
                    P2 = __builtin_amdgcn_mfma_f32_16x16x16bf16_1k(*reinterpret_cast<s16x4v*>(&g4), vtf, P2, 0, 0, 0);
                    *(LAS f32x4*)(SL + RC_P1 + lane * 16) = P1; *(LAS f32x4*)(SL + RC_P2 + lane * 16) = P2;
#define RC_BF(v) ({ u32x2 t_; t_.x = cvt_pk_bf16((v).x, (v).y); t_.y = cvt_pk_bf16((v).z, (v).w); *reinterpret_cast<s16x4v*>(&t_); })
                    const f32x4 Z4 = {0.f, 0.f, 0.f, 0.f};
                    const s16x4v n1 = RC_BF(G1), n1t = RC_BF(G1t);
                    const f32x4 X2 = __builtin_amdgcn_mfma_f32_16x16x16bf16_1k(n1t, n1, Z4, 0, 0, 0), X2t = __builtin_amdgcn_mfma_f32_16x16x16bf16_1k(n1, n1t, Z4, 0, 0, 0);
                    const s16x4v n2 = RC_BF(X2), n2t = RC_BF(X2t);
                    const f32x4 X4 = __builtin_amdgcn_mfma_f32_16x16x16bf16_1k(n2t, n2, Z4, 0, 0, 0), X4t = __builtin_amdgcn_mfma_f32_16x16x16bf16_1k(n2, n2t, Z4, 0, 0, 0);
                    const s16x4v n4 = RC_BF(X4), n4t = RC_BF(X4t);
                    f32x4 Tm = __builtin_amdgcn_mfma_f32_16x16x16bf16_1k(n4t, n4, Z4, 0, 0, 0);
#pragma unroll
                    for (int e = 0; e < 4; ++e) Tm[e] += (4 * kg + e == l15) ? 1.f : 0.f;
                    Tm = __builtin_amdgcn_mfma_f32_16x16x16bf16_1k(n4t, RC_BF(Tm), Tm, 0, 0, 0);
                    Tm = __builtin_amdgcn_mfma_f32_16x16x16bf16_1k(n2t, RC_BF(Tm), Tm, 0, 0, 0);
                    Tm = __builtin_amdgcn_mfma_f32_16x16x16bf16_1k(n1t, RC_BF(Tm), Tm, 0, 0, 0);
                    { u32x2 tt; tt.x = cvt_pk_bf16(Tm.x, Tm.y); tt.y = cvt_pk_bf16(Tm.z, Tm.w); *(LAS u32x2*)(SL + RC_TT + lane * 8) = tt; }
#undef RC_BF
                }
                asm volatile("s_waitcnt lgkmcnt(0)" ::: "memory");
#if RC_SYNC
                __builtin_amdgcn_s_barrier();
#else
                if (lane == 0) flags[slot] = (unsigned)(n + 1);
#endif
            }
#if RC_SYNC
            if (p >= RC_NCH % 7) { __builtin_amdgcn_s_barrier(); __builtin_amdgcn_s_barrier(); }
#endif
        }
#undef RC_LOADS
        __syncthreads();
    }
}
__device__ __forceinline__ void rwkv_post(const Fr& F) {
    const bf16_t* Rr = slotY(F, 0); const bf16_t* K = slotY(F, 1); const bf16_t* V = slotY(F, 2); const bf16_t* GT = slotY(F, 3); const bf16_t* A = slotY(F, 5);
    const float* O32 = (const float*)slotU(F, 1); bf16_t* Z = slotU(F, 0);
    const float* k_a = F.in(24); const float* r_k = F.in(25); const float* lw = F.in(26); const float* lb = F.in(27);
    for (int r = F.gw; r < R; r += F.NGW) {
        const bool real = (r >= NPAD && r < NREAL);
        u32x2* zr = (u32x2*)(Z + (size_t)r * D) + F.lane;
        if (!real) { const u32x2 z = {0u, 0u};
#pragma unroll
            for (int it = 0; it < 16; ++it) zr[64 * it] = z;
            continue; }
        ROW_F32(oq, O32 + (size_t)r * D, F.lane); ROW_BF(rq_, Rr + (size_t)r * D, F.lane); ROW_BF(kq_, K + (size_t)r * D, F.lane); ROW_BF(vq_, V + (size_t)r * D, F.lane);
        ROW_BF(gq_, GT + (size_t)r * D, F.lane); ROW_BF(aq_, A + (size_t)r * D, F.lane); ROW_BF(zq_, Z + (size_t)r * D, F.lane);
        ROW_F32(kap, k_a, F.lane); ROW_F32(rkp, r_k, F.lane); ROW_F32(lwp, lw, F.lane); ROW_F32(lbp, lb, F.lane);
#pragma unroll
        for (int hh = 0; hh < 2; ++hh) {
            f32x4 o4v[8]; u32x2 rrv[8], kkv[8], vvv[8], ggv[8], aav[8];
#pragma unroll
            for (int i8 = 0; i8 < 8; ++i8) { const int it = 8 * hh + i8; o4v[i8] = AT_F32(oq, it); rrv[i8] = AT_BF(rq_, it); kkv[i8] = AT_BF(kq_, it); vvv[i8] = AT_BF(vq_, it); ggv[i8] = AT_BF(gq_, it); aav[i8] = AT_BF(aq_, it); }
#pragma unroll
            for (int i8 = 0; i8 < 8; ++i8) { const int it = 8 * hh + i8;
                const f32x4 o4 = o4v[i8]; const u32x2 rr = rrv[i8], kk = kkv[i8], vv = vvv[i8], gg = ggv[i8], aa = aav[i8];
                const f32x4 ka4 = AT_F32(kap, it), rk4 = AT_F32(rkp, it), lw4 = AT_F32(lwp, it), lb4 = AT_F32(lbp, it);
                const float mean = red16((o4.x + o4.y) + (o4.z + o4.w)) * (1.f / 64.f);
                const float d0 = o4.x - mean, d1 = o4.y - mean, d2 = o4.z - mean, d3 = o4.w - mean;
                const float var = red16((d0 * d0 + d1 * d1) + (d2 * d2 + d3 * d3)) * (1.f / 64.f);
                const float rs = __builtin_amdgcn_rsqf(var + 64e-5f);
                const float r0 = bflo(rr.x), r1 = bfhi(rr.x), r2 = bflo(rr.y), r3 = bfhi(rr.y);
                const float kp0 = bflo(kk.x) * (1.f + (bflo(aa.x) - 1.f) * ka4.x), kp1 = bfhi(kk.x) * (1.f + (bfhi(aa.x) - 1.f) * ka4.y), kp2 = bflo(kk.y) * (1.f + (bflo(aa.y) - 1.f) * ka4.z), kp3 = bfhi(kk.y) * (1.f + (bfhi(aa.y) - 1.f) * ka4.w);
                const float bs = red16((r0 * kp0 * rk4.x + r1 * kp1 * rk4.y) + (r2 * kp2 * rk4.z + r3 * kp3 * rk4.w));
                const float y0 = d0 * rs * lw4.x + lb4.x + bs * bflo(vv.x), y1 = d1 * rs * lw4.y + lb4.y + bs * bfhi(vv.x), y2 = d2 * rs * lw4.z + lb4.z + bs * bflo(vv.y), y3 = d3 * rs * lw4.w + lb4.w + bs * bfhi(vv.y);
                u32x2 w; w.x = cvt_pk_bf16(y0 * silu_f(bflo(gg.x)), y1 * silu_f(bfhi(gg.x))); w.y = cvt_pk_bf16(y2 * silu_f(bflo(gg.y)), y3 * silu_f(bfhi(gg.y)));
                AT_BF(zq_, it) = w;
            }
        }
    }
}
}
namespace mk {
constexpr int LDS_BYTES = 163840;
constexpr int LDS_MISC = LDS_BYTES - 128;
struct Args { const float* in[29]; float* out; unsigned char* ws; };

#define MK_GEMM(EPI, e, Aptr, aps_, Bptr, M_, N_, K_) do { int kk_ = (K_); asm volatile("" : "+s"(kk_));     \
    pg8::Gemm g_{(const bf16_t*)(Aptr), (const bf16_t*)(Bptr), (M_), (N_), kk_, (size_t)(aps_)}; pg8::StaticOrder S_; S_.init((M_), (N_), F.G, F.bid); \
    pg8::gemm_phase<EPI, pg8::StaticOrder, false>(F.lds, g_, S_, e, nullptr); } while (0)

struct TailOrder { int pn;
    __device__ bool next(int i, pg8::Unit& u) const { if (i > 0 || pn < 0) return false; u.pm = 64; u.pn = pn; return true; }
    __device__ __forceinline__ void a_ready(const pg8::Unit&) const {}
    __device__ __forceinline__ void done(const pg8::Unit&) const {}
};
#define MK_GEMM1(EPI, e, aps_, NTOT_, L_) do { MK_GEMM(EPI, e, slotU(F, 0), aps_, wtin_of(F, L_), 16384, NTOT_, D); \
    if (F.bid < (NTOT_) / 256) { int kk_ = D; asm volatile("" : "+s"(kk_)); pg8::Gemm g_{(const bf16_t*)slotU(F, 0), (const bf16_t*)wtin_of(F, L_), R, (NTOT_), kk_, (size_t)(aps_)}; TailOrder St_{F.bid}; \
        pg8::gemm_phase<EPI, TailOrder, false, true>(F.lds, g_, St_, e, nullptr); } } while (0)
#define MK_GEMM2_NORM(prev, next, udst) do { \
    MK_GEMM(EpiY, ey, slotU(F, 0), 0, wtout, 16384, D, D); \
    GRID_BAR(); \
    if (F.bid < 16) { int kk_ = D; asm volatile("" : "+s"(kk_)); pg8::Gemm g_{(const bf16_t*)slotU(F, 0), (const bf16_t*)wtout, R, D, kk_, (size_t)0}; TailOrder St_{F.bid}; \
        pg8::gemm_phase<EpiY, TailOrder, false, true>(F.lds, g_, St_, ey, nullptr); } \
    else { const Fr P = F.fresh(); norm_phase(P, prev, next, slotY(P, 0), udst, 0, 16384, 16); } \
    GRID_BAR(); \
    { const Fr P = F.fresh(); norm_phase(P, prev, next, slotY(P, 0), udst, 16384, R, 0); if ((next) >= 0) convert_layer(P, next, (next) == 3); } \
    GRID_BAR(); } while (0)

__global__ void __launch_bounds__(512, 2) fwd(Args a) {
    extern __shared__ __attribute__((aligned(16))) unsigned char lds_raw[];
    Fr F;
    F.lds = (LAS unsigned char*)lds_raw; F.ldsg = lds_raw;
    F.tid = threadIdx.x; F.lane = F.tid & 63; F.wave = __builtin_amdgcn_readfirstlane(F.tid >> 6);
    F.G = gridDim.x; F.bid = blockIdx.x; F.gw = F.bid * 8 + F.wave; F.NGW = F.G * 8;
    F.out = a.out; F.ws = a.ws;
    volatile LAS unsigned* misc = (volatile LAS unsigned*)(F.lds + LDS_MISC);
    if (F.tid < 16) misc[F.tid] = 0u;
    __syncthreads();
    XcdBarrier bar = xcd_barrier_post((unsigned*)(F.ws + WS_CTL) + 4096, misc + 8);
#define GRID_BAR() xcd_barrier(bar)
#ifndef MK_DUP
#define MK_DUP 0
#endif
#define DUPN(k, ...) do { __VA_ARGS__; if ((MK_DUP >> (k)) & 1) { GRID_BAR(); __VA_ARGS__; } } while (0)
    bf16_t* wtout = (bf16_t*)(F.ws + WS_WTOUT);
    const EpiY ey{slotY(F, 0)};

    DUPN(11, { const Fr P = F.fresh(); convert_layer(P, 0, true); rope_table(P); norm_phase(P, -1, 0, nullptr, slotU(P, 0)); });
    GRID_BAR();
    { const EpiH1 e{slotY(F, 0), F.in(5), 0}; MK_GEMM1(EpiH1, e, 0, 4 * D, 0); }
    if (F.bid >= 64) { const Fr P = F.fresh(); convert_win(P, 1, 64); }
    GRID_BAR();
    DUPN(1, { const Fr P = F.fresh(); hgrn_phase<false>(P, 0); });
    GRID_BAR();
    DUPN(2, { const Fr P = F.fresh(); hgrn_phase<true>(P, 0); });
    GRID_BAR();
    MK_GEMM2_NORM(0, 1, slotU(F, 0));
    { const EpiB1 e{slotY(F, 0), (const float*)(F.ws + WS_ROPE), (const float*)(F.ws + WS_ROPE) + (size_t)R * 16}; MK_GEMM1(EpiB1, e, 0, 4 * D, 1); }
    if (F.bid >= 64) { const Fr P = F.fresh(); convert_win(P, 2, 64); }
    GRID_BAR();
    DUPN(3, { const Fr P = F.fresh(); attn_phase(P); });
    GRID_BAR();
    DUPN(4, { const Fr P = F.fresh(); attn_post(P); });
    GRID_BAR();
    MK_GEMM2_NORM(1, 2, slotY(F, 1));
    DUPN(7, { const Fr P = F.fresh(); mix_phase(P, slotY(P, 1)); convert_layer2_b(P); });
    GRID_BAR();
    { const EpiC1 e{slotY(F, 0), (bf16_t*)(F.ws + WS_T)}; MK_GEMM(EpiC1, e, slotU(F, 0), (size_t)R * D, wtin_of(F, 2), R, 4 * D + 512, D); }
    GRID_BAR();
    DUPN(9, { const EpiC2 e{slotY(F, 0), F.in(17), F.in(20)}; MK_GEMM(EpiC2, e, F.ws + WS_T, 0, F.ws + WS_W2P, R, 2 * D, 256); });
    { const Fr P = F.fresh(); rwkv_kknorm(P); }
    GRID_BAR();
    DUPN(5, { const Fr P = F.fresh(); rwkv_scan(P); });
    GRID_BAR();
    DUPN(6, { const Fr P = F.fresh(); rwkv_post(P); });
    GRID_BAR();
    MK_GEMM2_NORM(2, 3, slotU(F, 0));
    { const EpiH1 e{slotY(F, 0), F.in(5), 1}; MK_GEMM1(EpiH1, e, 0, 4 * D, 3); }
    GRID_BAR();
    { const Fr P = F.fresh(); hgrn_phase<false>(P, 1); }
    GRID_BAR();
    { const Fr P = F.fresh(); hgrn_phase<true>(P, 1); }
    GRID_BAR();
    MK_GEMM2_NORM(3, -1, (bf16_t*)nullptr);
}
}

extern "C" void kernel_launch(void* const* d_in, const int* in_sizes, int n_in, void* d_out, int out_size, void* d_ws, size_t ws_size, hipStream_t stream) {
    static int grid = 0;
    if (grid == 0) {
        if (n_in != 29 || out_size != 16384 * 4096 || ws_size < mk::WS_END) { fprintf(stderr, "kernel_launch: unexpected shapes (n_in %d out %d ws %zu need %zu)\n", n_in, out_size, ws_size, (size_t)mk::WS_END); grid = -1; return; }
        int dev = 0, cus = 0, per_cu = 0;
        if (hipGetDevice(&dev) != hipSuccess || hipDeviceGetAttribute(&cus, hipDeviceAttributeMultiprocessorCount, dev) != hipSuccess) { grid = -1; return; }
        if (hipFuncSetAttribute((const void*)mk::fwd, hipFuncAttributeMaxDynamicSharedMemorySize, mk::LDS_BYTES) != hipSuccess) { fprintf(stderr, "kernel_launch: hipFuncSetAttribute failed\n"); grid = -1; return; }
        if (hipOccupancyMaxActiveBlocksPerMultiprocessor(&per_cu, (const void*)mk::fwd, 512, mk::LDS_BYTES) != hipSuccess || per_cu < 1) { fprintf(stderr, "kernel_launch: occupancy query says %d\n", per_cu); }
        (void)hipGetLastError();
        grid = cus;
    }
    if (grid < 0) return;
    if (hipMemsetAsync((char*)d_ws + mk::WS_CTL, 0, mk::CTL_BYTES, stream) != hipSuccess) return;
    mk::Args a{};
    for (int i = 0; i < 29; ++i) a.in[i] = (const float*)d_in[i];
    a.out = (float*)d_out; a.ws = (unsigned char*)d_ws;
    hipLaunchKernelGGL(mk::fwd, dim3(grid), dim3(512), mk::LDS_BYTES, stream, a);
}
```

```cpp
#include <hip/hip_runtime.h>
#include <cstdio>
#include <cstdint>

#define LAS __attribute__((address_space(3)))
#define GAS __attribute__((address_space(1)))
typedef unsigned short bf16_t;
typedef short bf16x8 __attribute__((ext_vector_type(8)));
typedef short s16x4 __attribute__((ext_vector_type(4)));
typedef float f32x4 __attribute__((ext_vector_type(4)));
typedef float f32x16 __attribute__((ext_vector_type(16)));
typedef unsigned u32x4 __attribute__((ext_vector_type(4)));
typedef unsigned u32x2 __attribute__((ext_vector_type(2)));

namespace mk {
constexpr int D = 4096, NPAD = 48, NREAL = 16448, R = 16640, NCH = 257;
constexpr size_t MiB = 1u << 20;
constexpr size_t SLOT = (size_t)R * D * 2;
constexpr size_t WS_CTL = 0, CTL_BYTES = 1 * MiB;
constexpr size_t WS_WTIN = 2 * MiB;
constexpr size_t WS_WTOUT = 134 * MiB;
constexpr size_t WS_W2P = 166 * MiB;
constexpr size_t WS_ROPE = 170 * MiB;
constexpr size_t WS_HMETA = 174 * MiB;
constexpr size_t WS_HE = 175 * MiB;
constexpr size_t WS_HLOGD = 191 * MiB;
constexpr size_t WS_U = 192 * MiB;
constexpr size_t WS_Y = WS_U + 6 * SLOT;
constexpr size_t WS_T = WS_Y + 6 * SLOT;
constexpr size_t WS_WTINB = WS_U + 4 * SLOT;
constexpr size_t WS_HB = (WS_T + (size_t)R * 256 * 2 + MiB - 1) / MiB * MiB;
constexpr size_t WS_END = WS_HB + SLOT;
static_assert(WS_END <= 2040 * MiB, "d_ws map");

typedef __bf16 bf16x2n_t __attribute__((ext_vector_type(2)));
typedef float f32x2n_t __attribute__((ext_vector_type(2)));
__device__ __forceinline__ unsigned cvt_pk_bf16(float lo, float hi) { const f32x2n_t v = {lo, hi}; const bf16x2n_t r = __builtin_convertvector(v, bf16x2n_t); return __builtin_bit_cast(unsigned, r); }
__device__ __forceinline__ float bflo(unsigned w) { return __uint_as_float(w << 16); }
__device__ __forceinline__ float bfhi(unsigned w) { return __uint_as_float(w & 0xffff0000u); }
__device__ __forceinline__ float bf2f(bf16_t b) { return __uint_as_float(((unsigned)b) << 16); }
__device__ __forceinline__ bf16_t f2bf(float f) { return (bf16_t)(cvt_pk_bf16(f, f) & 0xffffu); }
__device__ __forceinline__ float sigmoid_f(float x) { return 1.f / (1.f + __expf(-x)); }
__device__ __forceinline__ float silu_f(float x) { return x / (1.f + __expf(-x)); }
__device__ __forceinline__ float wave_sum(float v) {
#pragma unroll
    for (int o = 1; o < 64; o <<= 1) v += __shfl_xor(v, o);
    return v;
}
template <int CTRL> __device__ __forceinline__ float dppf(float v) { return __int_as_float(__builtin_amdgcn_update_dpp(0, __float_as_int(v), CTRL, 0xf, 0xf, true)); }
__device__ __forceinline__ float red4(float v) { v += dppf<0xB1>(v); v += dppf<0x4E>(v); return v; }
__device__ __forceinline__ float red8(float v) { v = red4(v); v += dppf<0x141>(v); return v; }
__device__ __forceinline__ float red16(float v) { v = red8(v); v += dppf<0x140>(v); return v; }
#define LDS_WAIT() asm volatile("s_waitcnt lgkmcnt(0)" ::: "memory")
}
#define XB_TMO      128
#define XB_XCNT(j)  (256  + 64 * (j))
#define XB_XSUB(j)  (1280 + 64 * (j))
#define XB_XGEN(j)  (2304 + 64 * (j))
#define XB_TOP      3328
#define XB_TOPGEN   3392
#define XCD_BAR_WORDS 3456
#define XB_SPIN_CAP (1u << 18)
#define LAS __attribute__((address_space(3)))

__device__ __forceinline__ unsigned xb_ld(unsigned* p)              { return __hip_atomic_load(p, __ATOMIC_RELAXED, __HIP_MEMORY_SCOPE_AGENT); }
__device__ __forceinline__ unsigned xb_add(unsigned* p, unsigned v) { return __hip_atomic_fetch_add(p, v, __ATOMIC_RELAXED, __HIP_MEMORY_SCOPE_AGENT); }
__device__ __forceinline__ unsigned xb_xcc_id() { return (unsigned)__builtin_amdgcn_s_getreg((3 << 11) | 20) & 0xFu; }
#define XB_SPIN(cond, bar) do { unsigned _sp = 0; while (cond) { __builtin_amdgcn_s_sleep(1); \
    if ((++_sp & 255u) == 0u) { if (xb_ld(&(bar)[XB_TMO])) break; if (_sp > XB_SPIN_CAP) { atomicAdd(&(bar)[XB_TMO], 1u); break; } } } } while (0)

struct XcdBarrier {
    unsigned* bar; unsigned x;
    volatile LAS unsigned* st;
};

__device__ __forceinline__ XcdBarrier xcd_barrier_post(unsigned* bar, volatile LAS unsigned* st) {
    XcdBarrier b; b.bar = bar; b.x = xb_xcc_id(); b.st = st;
    if (threadIdx.x == 0) (void)xb_add(&bar[XB_XCNT(b.x)], 1u);
    return b;
}
__device__ __forceinline__ void xcd_barrier_complete(unsigned* bar, unsigned x, unsigned& nloc, unsigned& nx) {
    const unsigned G = gridDim.x * gridDim.y * gridDim.z;
    unsigned sum, cnt, mine, sp = 0u;
    for (;;) {
        sum = 0u; cnt = 0u; mine = 0u;
#pragma unroll
        for (unsigned j = 0; j < 16; ++j) { const unsigned c = xb_ld(&bar[XB_XCNT(j)]); sum += c; cnt += (c > 0u) ? 1u : 0u; mine = (j == x) ? c : mine; }
        if (sum == G) break;
        __builtin_amdgcn_s_sleep(1);
        if ((++sp & 255u) == 0u) { if (xb_ld(&bar[XB_TMO])) break; if (sp > XB_SPIN_CAP) { atomicAdd(&bar[XB_TMO], 1u); break; } }
    }
    nloc = mine > 0u ? mine : 1u; nx = cnt > 0u ? cnt : 1u;
}

__device__ __forceinline__ void xcd_barrier(const XcdBarrier& b) {
    asm volatile("s_waitcnt vmcnt(0)" ::: "memory");
    __syncthreads();
    if (threadIdx.x == 0) {
        unsigned* bar = b.bar;
        __builtin_amdgcn_s_waitcnt(0);
        unsigned nloc = b.st[0], nx = b.st[1];
        if (nloc == 0u) { xcd_barrier_complete(bar, b.x, nloc, nx); b.st[0] = nloc; b.st[1] = nx; }
        const unsigned old = xb_add(&bar[XB_XSUB(b.x)], 1u);
        const unsigned gen = old / nloc;
        if (old + 1u == (gen + 1u) * nloc) {
            __builtin_amdgcn_fence(__ATOMIC_RELEASE, "agent");
            asm volatile("s_waitcnt vmcnt(0)" ::: "memory");
            const unsigned og = xb_add(&bar[XB_TOP], 1u);
            const unsigned tg = og / nx;
            if (og + 1u == (tg + 1u) * nx) xb_add(&bar[XB_TOPGEN], 1u);
            else XB_SPIN(xb_ld(&bar[XB_TOPGEN]) == tg, bar);
            __builtin_amdgcn_fence(__ATOMIC_ACQUIRE, "agent");
            xb_add(&bar[XB_XGEN(b.x)], 1u);
            asm volatile("s_waitcnt vmcnt(0)" ::: "memory");
        } else {
            XB_SPIN(xb_ld(&bar[XB_XGEN(b.x)]) == gen, bar);
            __builtin_amdgcn_fence(__ATOMIC_ACQUIRE, "agent");
            asm volatile("s_waitcnt vmcnt(0)" ::: "memory");
        }
    }
    __syncthreads();
}
namespace pg8 {
#define PG8_LAS __attribute__((address_space(3)))
typedef unsigned short bf16_t;
typedef short bf16x8 __attribute__((ext_vector_type(8)));
typedef float f32x4 __attribute__((ext_vector_type(4)));
typedef unsigned u32x4 __attribute__((ext_vector_type(4)));
constexpr int BM = 256, BK = 64, HALF = 128, HTB = HALF * BK * 2  , STAGE_BYTES = 8 * HTB, NXCD = 8, WGM = 8;

__host__ __device__ __forceinline__ int lds_byte(int r, int c) { const int st = (r >> 4) * 2 + (c >> 5), rr = r & 15, cc = c & 31, ob = rr * 64 + cc * 2; return st * 1024 + (ob ^ (((ob >> 9) & 1) << 5)); }
__host__ __device__ __forceinline__ void stage_rc(int b, int& R, int& C) { const int st = b / 1024, sb = b % 1024, swz = sb ^ (((sb >> 9) & 1) << 5); R = (st >> 1) * 16 + swz / 64; C = (st & 1) * 32 + (swz % 64) / 2; }
__host__ __device__ __forceinline__ int perm32(int rho) { const int n = rho >> 4, i = rho & 15; return 8 * (i >> 2) + 4 * n + (i & 3); }

struct Unit { int pm, pn; };
struct Gemm { const bf16_t* A; const bf16_t* Bt; int M, N, K; size_t aps; };
__device__ __forceinline__ size_t a_part_bytes(const Gemm& g, int pn) { return g.aps ? (size_t)(pn < 64 ? (pn >> 4) : (pn - 60)) * g.aps * 2 : (size_t)0; }

struct StaticOrder {
    int nM, nN, nwg, G, c;
    __host__ __device__ void init(int M, int N, int G_, int c_) { nM = M / BM; nN = N / BM; nwg = nM * nN; G = G_; c = c_; }
    __host__ __device__ bool next(int i, Unit& u) const {
        const long L = (long)i * G + c; if (L >= nwg) return false;
        int wgid = (int)L; { const int q = nwg / NXCD, r = nwg % NXCD, xcd = wgid % NXCD, off = wgid / NXCD; wgid = (xcd < r ? xcd * (q + 1) : r * (q + 1) + (xcd - r) * q) + off; }
        const int nig = WGM * nN, gid = wgid / nig, fm = gid * WGM, gsz = (nM - fm) < WGM ? (nM - fm) : WGM;
        u.pm = fm + ((wgid % nig) % gsz); u.pn = (wgid % nig) / gsz; return true;
    }
    __device__ __forceinline__ void a_ready(const Unit&) const {}
    __device__ __forceinline__ void done(const Unit&) const {}
};
struct CountedOrder : StaticOrder {
    const unsigned* ready; unsigned need; unsigned* tmo;
    __device__ __forceinline__ void a_ready(const Unit& u) const {
        if (threadIdx.x < 64) {
            const unsigned long long t0 = __builtin_amdgcn_s_memrealtime(); unsigned polls = 0;
            while ((unsigned)__builtin_amdgcn_readfirstlane(__hip_atomic_load(ready + 64 * u.pm, __ATOMIC_RELAXED, __HIP_MEMORY_SCOPE_AGENT)) < need) {
                if ((++polls & 255u) == 0u && __builtin_amdgcn_readfirstlane(__hip_atomic_load(tmo, __ATOMIC_RELAXED, __HIP_MEMORY_SCOPE_AGENT)) != 0u) break;
                if (__builtin_amdgcn_s_memrealtime() - t0 > 2000000ull) {
                    if (threadIdx.x == 0) { unsigned expect = 0u; __hip_atomic_compare_exchange_strong(tmo + 1, &expect, 0x600u | (unsigned)(u.pm & 0xff), __ATOMIC_RELAXED, __ATOMIC_RELAXED, __HIP_MEMORY_SCOPE_AGENT); __hip_atomic_store(tmo, 1u, __ATOMIC_RELAXED, __HIP_MEMORY_SCOPE_AGENT); }
                    break; }
                __builtin_amdgcn_s_sleep(2); }
            __builtin_amdgcn_fence(__ATOMIC_ACQUIRE, "agent");
            asm volatile("s_waitcnt vmcnt(0)" ::: "memory");
        }
#if !defined(BROKEN_HOOK_NO_BARRIER)
        asm volatile("" ::: "memory"); __builtin_amdgcn_s_barrier(); asm volatile("" ::: "memory");
#endif
    }
};
template <class Epi, class Sched, bool STAMP = false, bool TOPHALF = false>
__device__ __forceinline__ void gemm_phase(PG8_LAS unsigned char* lds, const Gemm g, const Sched& S, const Epi& E, unsigned long long* stamps) {
    int tid_ = threadIdx.x; asm volatile("" : "+v"(tid_));
    const int tid = tid_, wid = __builtin_amdgcn_readfirstlane(tid >> 6), lane = tid & 63, wr = wid >> 2, wc = wid & 3, fr = lane & 15, fq = lane >> 4;
    const int K = g.K, nt = K / BK;
    int ts_lo = 0, ts_hi = 0, nts = 0; const unsigned long long rt_entry = STAMP ? (unsigned long long)wall_clock64() : 0ull;
#define PG8_STAMP() do { if (STAMP && wid == 0 && nts < 64) { const unsigned long long _c = (unsigned long long)clock64(); \
        ts_lo = (lane == nts) ? (int)(unsigned)_c : ts_lo; ts_hi = (lane == nts) ? (int)(unsigned)(_c >> 32) : ts_hi; ++nts; } } while (0)
    PG8_STAMP();
    unsigned voffA[2], voffB[2];
#pragma unroll
    for (int i = 0; i < 2; ++i) { int R, C; stage_rc(tid * 16 + i * 8192, R, C); const int Rb = Epi::PERM ? ((R & ~31) + perm32(R & 31)) : R;
        voffA[i] = (unsigned)(R * K + C) * 2u; voffB[i] = (unsigned)(Rb * K + C) * 2u; }
    const size_t kstep = (size_t)(BK * 2);
    const size_t hstep = (size_t)HALF * K * 2;
    const size_t tstep = 2 * hstep;
    const unsigned ldsw = (unsigned)wid * 1024u;
    const int aoff = lds_byte(wr * 64 + fr, fq * 8), boff = lds_byte(wc * 32 + fr, fq * 8);
#define PG8_SA(b, h) (((b) * 2 + (h)) * HTB)
#define PG8_SB(b, h) ((4 + (b) * 2 + (h)) * HTB)
#define PG8_STAGE(bufoff, gbase, voff) do { _Pragma("unroll") for (int _i = 0; _i < 2; ++_i) \
        __builtin_amdgcn_global_load_lds((const unsigned*)((const char*)(gbase) + (voff)[_i]), (PG8_LAS unsigned*)(lds + (bufoff) + ldsw + _i * 8192), 16, 0, 0); } while (0)
#define PG8_LDA(dst, b, h) do { _Pragma("unroll") for (int m = 0; m < 4; ++m) _Pragma("unroll") for (int k = 0; k < 2; ++k) dst[m][k] = *(const PG8_LAS bf16x8*)(lds + PG8_SA(b, h) + aoff + m * 2048 + k * 1024); } while (0)
#define PG8_LDB(dst, b, h) do { _Pragma("unroll") for (int n = 0; n < 2; ++n) _Pragma("unroll") for (int k = 0; k < 2; ++k) dst[n][k] = *(const PG8_LAS bf16x8*)(lds + PG8_SB(b, h) + boff + n * 2048 + k * 1024); } while (0)
#define PG8_MMA(ai, bj, At, Bt) do { __builtin_amdgcn_s_setprio(1); _Pragma("unroll") for (int m = 0; m < 4; ++m) _Pragma("unroll") for (int n = 0; n < 2; ++n) _Pragma("unroll") for (int k = 0; k < 2; ++k) \
        acc[ai][bj][m][n] = __builtin_amdgcn_mfma_f32_16x16x32_bf16(Bt[n][k], At[m][k], acc[ai][bj][m][n], 0, 0, 0); __builtin_amdgcn_s_setprio(0); } while (0)
#define PG8_WAIT_V(n) asm volatile("s_waitcnt vmcnt(" #n ")" ::: "memory")
#define PG8_WAIT_L(n) asm volatile("s_waitcnt lgkmcnt(" #n ")" ::: "memory")
#define PG8_BAR __builtin_amdgcn_s_barrier()
#define PG8_SCHED __builtin_amdgcn_sched_barrier(0)
    Unit cur, nxt; int ui = 0;
    if (!S.next(0, cur)) return;
    f32x4 acc[2][2][4][2];
#pragma unroll
    for (int a = 0; a < 2; ++a)
#pragma unroll
        for (int b = 0; b < 2; ++b)
#pragma unroll
            for (int m = 0; m < 4; ++m)
#pragma unroll
                for (int n = 0; n < 2; ++n) acc[a][b][m][n] = (f32x4){0.f, 0.f, 0.f, 0.f};
    bf16x8 At[4][2], B0[2][2], B1[2][2];
    const char* cA = (const char*)g.A + a_part_bytes(g, cur.pn) + (size_t)cur.pm * tstep; const char* cB = (const char*)g.Bt + (size_t)cur.pn * tstep;
    S.a_ready(cur);
    PG8_STAGE(PG8_SB(0, 0), cB, voffB); PG8_STAGE(PG8_SA(0, 0), cA, voffA); PG8_STAGE(PG8_SB(0, 1), cB + hstep, voffB); PG8_STAGE(PG8_SA(0, 1), cA + hstep, voffA);
    if (wr == 1) PG8_BAR;
    PG8_WAIT_V(4); PG8_BAR;
    PG8_STAGE(PG8_SB(1, 0), cB + kstep, voffB); PG8_STAGE(PG8_SA(1, 0), cA + kstep, voffA); PG8_STAGE(PG8_SB(1, 1), cB + hstep + kstep, voffB);
    PG8_WAIT_V(6); PG8_BAR;
    PG8_STAMP();
    for (;;) {
        const bool has_next = S.next(ui + 1, nxt);
        const char* nA = has_next ? (const char*)g.A + a_part_bytes(g, nxt.pn) + (size_t)nxt.pm * tstep : cA; const char* nB = has_next ? (const char*)g.Bt + (size_t)nxt.pn * tstep : cB;
        for (int t = 0; t < nt; t += 2) {
            const bool last = (t == nt - 2);
            const char* a1 = cA + (size_t)(t + 1) * kstep;
            const char* a2 = last ? nA : cA + (size_t)(t + 2) * kstep; const char* b2 = last ? nB : cB + (size_t)(t + 2) * kstep;
            const char* a3 = a2 + kstep; const char* b3 = b2 + kstep;
            if (last && has_next) S.a_ready(nxt);
            PG8_LDB(B0, 0, 0); PG8_SCHED; PG8_LDA(At, 0, 0); PG8_STAGE(PG8_SA(1, 1), a1 + hstep, voffA);
            PG8_WAIT_L(8); PG8_BAR; PG8_WAIT_L(0); PG8_MMA(0, 0, At, B0); PG8_BAR; PG8_SCHED;
            PG8_LDB(B1, 0, 1); PG8_STAGE(PG8_SB(0, 0), b2, voffB);
            PG8_BAR; PG8_WAIT_L(0); PG8_MMA(0, 1, At, B1); PG8_BAR;
            if constexpr (!TOPHALF) PG8_LDA(At, 0, 1); PG8_STAGE(PG8_SA(0, 0), a2, voffA);
            PG8_BAR; PG8_WAIT_L(0); if constexpr (!TOPHALF) PG8_MMA(1, 0, At, B0); PG8_BAR; PG8_SCHED;
            PG8_STAGE(PG8_SB(0, 1), b2 + hstep, voffB);
            PG8_WAIT_V(6); PG8_BAR; if constexpr (!TOPHALF) PG8_MMA(1, 1, At, B1); PG8_BAR;
            PG8_LDB(B0, 1, 0); PG8_SCHED; PG8_LDA(At, 1, 0); PG8_STAGE(PG8_SA(0, 1), a2 + hstep, voffA);
            PG8_WAIT_L(8); PG8_BAR; PG8_WAIT_L(0); PG8_MMA(0, 0, At, B0); PG8_BAR; PG8_SCHED;
            PG8_LDB(B1, 1, 1); PG8_STAGE(PG8_SB(1, 0), b3, voffB);
            PG8_BAR; PG8_WAIT_L(0); PG8_MMA(0, 1, At, B1); PG8_BAR;
            if constexpr (!TOPHALF) PG8_LDA(At, 1, 1); PG8_STAGE(PG8_SA(1, 0), a3, voffA);
            PG8_BAR; PG8_WAIT_L(0); if constexpr (!TOPHALF) PG8_MMA(1, 0, At, B0); PG8_BAR; PG8_SCHED;
            PG8_STAGE(PG8_SB(1, 1), b3 + hstep, voffB);
            PG8_WAIT_V(6); PG8_BAR; if constexpr (!TOPHALF) PG8_MMA(1, 1, At, B1); PG8_BAR;
        }
        PG8_STAMP();
        if constexpr (!Epi::AFTER_DRAIN) { E(acc, cur, wr, wc, fr, fq); S.done(cur); }
        PG8_STAMP();
        if (!has_next) break;
#pragma unroll
        for (int a = 0; a < 2; ++a)
#pragma unroll
            for (int b = 0; b < 2; ++b)
#pragma unroll
                for (int m = 0; m < 4; ++m)
#pragma unroll
                    for (int n = 0; n < 2; ++n) acc[a][b][m][n] = (f32x4){0.f, 0.f, 0.f, 0.f};
        cur = nxt; cA = nA; cB = nB; ++ui;
    }
    PG8_WAIT_V(0);
    if (wr == 0) PG8_BAR;
    PG8_BAR;
    if constexpr (Epi::AFTER_DRAIN) { E.fused(acc, cur, wr, wc, fr, fq, lds, wid, lane); S.done(cur); }
    PG8_STAMP();
    if (STAMP && wid == 0) { stamps[lane] = lane < nts ? (((unsigned long long)(unsigned)ts_hi << 32) | (unsigned)ts_lo) : 0ull;
        if (lane == 62) stamps[62] = rt_entry; if (lane == 63) stamps[63] = (unsigned long long)wall_clock64(); }
#undef PG8_STAMP
#undef PG8_SA
#undef PG8_SB
#undef PG8_STAGE
#undef PG8_LDA
#undef PG8_LDB
#undef PG8_MMA
#undef PG8_WAIT_V
#undef PG8_WAIT_L
#undef PG8_BAR
#undef PG8_SCHED
}
}
namespace mk {
typedef pg8::Unit Unit;
typedef const pg8::f32x4 (&AccRef)[2][2][4][2];

__device__ __forceinline__ void st_bf8(bf16_t* p, pg8::f32x4 v0, pg8::f32x4 v1) {
    u32x4 w; w.x = cvt_pk_bf16(v0[0], v0[1]); w.y = cvt_pk_bf16(v0[2], v0[3]); w.z = cvt_pk_bf16(v1[0], v1[1]); w.w = cvt_pk_bf16(v1[2], v1[3]);
    *(u32x4*)p = w;
}
__device__ __forceinline__ void st_bf4(bf16_t* p, pg8::f32x4 v) { u32x2 w; w.x = cvt_pk_bf16(v[0], v[1]); w.y = cvt_pk_bf16(v[2], v[3]); *(u32x2*)p = w; }

struct EpiY {
    static constexpr bool PERM = true, AFTER_DRAIN = false;
    bf16_t* O;
    __device__ __forceinline__ void operator()(AccRef acc, const Unit& u, int wr, int wc, int fr, int fq) const {
        const int row0 = u.pm * 256 + wr * 64 + fr, col0 = u.pn * 256 + wc * 32 + 8 * fq;
#pragma unroll
        for (int ai = 0; ai < 2; ++ai)
#pragma unroll
            for (int m = 0; m < 4; ++m) { bf16_t* rowp = O + (size_t)(row0 + ai * 128 + m * 16) * D + col0;
#pragma unroll
                for (int bj = 0; bj < 2; ++bj) st_bf8(rowp + bj * 128, acc[ai][bj][m][0], acc[ai][bj][m][1]); }
    }
};
struct EpiH1 {
    static constexpr bool PERM = true, AFTER_DRAIN = false;
    bf16_t* Y; const float* lbl; int jl;
    __device__ __forceinline__ void operator()(AccRef acc, const Unit& u, int wr, int wc, int fr, int fq) const {
        const int part = u.pn >> 4, colt = (u.pn & 15) * 256;
        const int row0 = u.pm * 256 + wr * 64 + fr, col0 = colt + wc * 32 + 8 * fq;
        if (part == 1) {
#pragma unroll
            for (int bj = 0; bj < 2; ++bj) {
                pg8::f32x4 lbv[2] = {{0.f, 0.f, 0.f, 0.f}, {0.f, 0.f, 0.f, 0.f}};
                if (jl) {
#pragma unroll
                    for (int n = 0; n < 2; ++n) { const pg8::f32x4 l0 = *(const pg8::f32x4*)(lbl + col0 + bj * 128 + 4 * n), l1 = *(const pg8::f32x4*)(lbl + D + col0 + bj * 128 + 4 * n);
#pragma unroll
                        for (int j = 0; j < 4; ++j) lbv[n][j] = sigmoid_f(l1[j] - l0[j]); }
                }
#pragma unroll
                for (int ai = 0; ai < 2; ++ai)
#pragma unroll
                    for (int m = 0; m < 4; ++m) {
                        const int row = row0 + ai * 128 + m * 16;
                        pg8::f32x4 o[2];
#pragma unroll
                        for (int n = 0; n < 2; ++n)
#pragma unroll
                            for (int j = 0; j < 4; ++j) {
                                const float x = acc[ai][bj][m][n][j]; float g;
                                if (jl) { const float l = lbv[n][j]; g = __logf(l + (1.f - l) * sigmoid_f(x)); }
                                else g = fminf(x, 0.f) - __logf(1.f + __expf(-fabsf(x)));
                                o[n][j] = (row < NPAD) ? 0.f : g;
                            }
                        float* gp = (float*)(Y + 3 * (SLOT / 2)) + (size_t)row * D + col0 + bj * 128;
                        *(pg8::f32x4*)gp = o[0]; *(pg8::f32x4*)(gp + 4) = o[1];
                    }
            }
        } else {
            bf16_t* dst = Y + (size_t)(part == 0 ? 0 : (part == 2 ? 1 : 2)) * (SLOT / 2);
#pragma unroll
            for (int ai = 0; ai < 2; ++ai)
#pragma unroll
                for (int m = 0; m < 4; ++m) { bf16_t* rowp = dst + (size_t)(row0 + ai * 128 + m * 16) * D + col0;
#pragma unroll
                    for (int bj = 0; bj < 2; ++bj) st_bf8(rowp + bj * 128, acc[ai][bj][m][0], acc[ai][bj][m][1]); }
        }
    }
};
struct EpiB1 {
    static constexpr bool PERM = false, AFTER_DRAIN = false;
    bf16_t* Y; const float* cs; const float* sn;
    __device__ __forceinline__ void operator()(AccRef acc, const Unit& u, int wr, int wc, int fr, int fq) const {
        const int part = u.pn >> 4, colt = (u.pn & 15) * 256;
        const int row0 = u.pm * 256 + wr * 64 + fr, col0 = colt + wc * 32 + 4 * fq;
        bf16_t* dst = Y + (size_t)part * (SLOT / 2);
        const bool rope = (part < 2) && (wc == 0);
#pragma unroll
        for (int ai = 0; ai < 2; ++ai)
#pragma unroll
            for (int m = 0; m < 4; ++m) {
                const int row = row0 + ai * 128 + m * 16;
                pg8::f32x4 c4 = {1.f, 1.f, 1.f, 1.f}, s4 = {0.f, 0.f, 0.f, 0.f};
                if (rope) { c4 = *(const pg8::f32x4*)(cs + (size_t)row * 16 + 4 * fq); s4 = *(const pg8::f32x4*)(sn + (size_t)row * 16 + 4 * fq); }
                bf16_t* rowp = dst + (size_t)row * D + col0;
#pragma unroll
                for (int bj = 0; bj < 2; ++bj) {
                    const pg8::f32x4 x1 = acc[ai][bj][m][0], x2 = acc[ai][bj][m][1];
                    const pg8::f32x4 y1 = x1 * c4 - x2 * s4, y2 = x2 * c4 + x1 * s4;
                    st_bf4(rowp + bj * 128, y1); st_bf4(rowp + bj * 128 + 16, y2);
                }
            }
    }
};
struct EpiC1 {
    static constexpr bool PERM = true, AFTER_DRAIN = false;
    bf16_t *Y, *T;
    __device__ __forceinline__ void operator()(AccRef acc, const Unit& u, int wr, int wc, int fr, int fq) const {
        const int row0 = u.pm * 256 + wr * 64 + fr;
        if (u.pn < 64) {
            const int part = u.pn >> 4, col0 = (u.pn & 15) * 256 + wc * 32 + 8 * fq;
            bf16_t* dst = Y + (size_t)part * (SLOT / 2);
#pragma unroll
            for (int ai = 0; ai < 2; ++ai)
#pragma unroll
                for (int m = 0; m < 4; ++m) { bf16_t* rowp = dst + (size_t)(row0 + ai * 128 + m * 16) * D + col0;
#pragma unroll
                    for (int bj = 0; bj < 2; ++bj) st_bf8(rowp + bj * 128, acc[ai][bj][m][0], acc[ai][bj][m][1]); }
        } else {
            const int which = u.pn - 64, col0 = which * 128 + wc * 32 + 8 * fq;
#pragma unroll
            for (int ai = 0; ai < 2; ++ai)
#pragma unroll
                for (int m = 0; m < 4; ++m) {
                    pg8::f32x4 v0 = acc[ai][0][m][0], v1 = acc[ai][0][m][1];
                    if (which == 0) {
#pragma unroll
                        for (int j = 0; j < 4; ++j) { v0[j] = 1.f - 2.f / (1.f + __expf(2.f * v0[j])); v1[j] = 1.f - 2.f / (1.f + __expf(2.f * v1[j])); }
                    }
                    st_bf8(T + (size_t)(row0 + ai * 128 + m * 16) * 256 + col0, v0, v1);
                }
        }
    }
};
struct EpiC2 {
    static constexpr bool PERM = true, AFTER_DRAIN = false;
    bf16_t* Y; const float* w0; const float* a0;
    __device__ __forceinline__ void operator()(AccRef acc, const Unit& u, int wr, int wc, int fr, int fq) const {
        const int row0 = u.pm * 256 + wr * 64 + fr;
        const bool isw = u.pn < 16;
        const int col0 = (u.pn & 15) * 256 + wc * 32 + 8 * fq;
        bf16_t* dst = Y + (size_t)(isw ? 4 : 5) * (SLOT / 2); const float* bias = isw ? w0 : a0;
#pragma unroll
        for (int bj = 0; bj < 2; ++bj) {
            const pg8::f32x4 b0 = *(const pg8::f32x4*)(bias + col0 + bj * 128), b1 = *(const pg8::f32x4*)(bias + col0 + bj * 128 + 4);
#pragma unroll
            for (int ai = 0; ai < 2; ++ai)
#pragma unroll
                for (int m = 0; m < 4; ++m) {
                    pg8::f32x4 v0 = acc[ai][bj][m][0] + b0, v1 = acc[ai][bj][m][1] + b1;
#pragma unroll
                    for (int j = 0; j < 4; ++j) {
                        float s0 = sigmoid_f(v0[j]), s1 = sigmoid_f(v1[j]);
                        if (isw) { s0 = __expf(-0.606531f * s0); s1 = __expf(-0.606531f * s1); }
                        v0[j] = s0; v1[j] = s1;
                    }
                    st_bf8(dst + (size_t)(row0 + ai * 128 + m * 16) * D + col0 + bj * 128, v0, v1);
                    __builtin_amdgcn_sched_barrier(0);
                }
        }
    }
};

struct Fr {
    LAS unsigned char* lds; unsigned char* ldsg;
    int tid, lane, wave, G, bid, gw, NGW;
    float* out; unsigned char* ws;
    __device__ __forceinline__ Fr fresh() const { Fr P = *this; asm volatile("" : "+v"(P.tid)); P.lane = P.tid & 63; P.wave = __builtin_amdgcn_readfirstlane(P.tid >> 6); P.gw = P.bid * 8 + P.wave; return P; }
    __device__ __forceinline__ const float* in(int i) const {
        const __attribute__((address_space(4))) unsigned long long* ka = (const __attribute__((address_space(4))) unsigned long long*)__builtin_amdgcn_kernarg_segment_ptr();
        asm volatile("" : "+s"(ka));
        return (const float*)ka[i];
    }
};
__device__ __forceinline__ bf16_t* slotU(const Fr& F, int s) { return (bf16_t*)(F.ws + WS_U + (size_t)s * SLOT); }
__device__ __forceinline__ bf16_t* slotY(const Fr& F, int s) { return (bf16_t*)(F.ws + WS_Y + (size_t)s * SLOT); }
__device__ __forceinline__ float* hrow(const Fr& F, int r) { return r < 64 ? (float*)(F.ws + WS_HMETA) + (size_t)r * D : F.out + (size_t)(r - 64) * D; }

__device__ __forceinline__ void transpose_item(const float* W, int ldw, bf16_t* WT, int ldt, int koff, LAS float* scr, int kb, int nb, int lane) {
    const int k0 = 64 * kb, n0 = 32 * nb;
    float wv[32];
#pragma unroll
    for (int i = 0; i < 32; ++i) wv[i] = W[(size_t)(k0 + 2 * i + (lane >> 5)) * ldw + n0 + (lane & 31)];
#pragma unroll
    for (int i = 0; i < 32; ++i) scr[(2 * i + (lane >> 5)) * 33 + (lane & 31)] = wv[i];
    LDS_WAIT(); asm volatile("" ::: "memory");
    const int c = lane & 7;
#pragma unroll
    for (int j = 0; j < 4; ++j) { const int n = (lane >> 3) + 8 * j; const LAS float* s = scr + (8 * c) * 33 + n;
        u32x4 o; o.x = cvt_pk_bf16(s[0 * 33], s[1 * 33]); o.y = cvt_pk_bf16(s[2 * 33], s[3 * 33]); o.z = cvt_pk_bf16(s[4 * 33], s[5 * 33]); o.w = cvt_pk_bf16(s[6 * 33], s[7 * 33]);
        *(u32x4*)(WT + (size_t)(n0 + n) * ldt + koff + k0 + 8 * c) = o; }
    LDS_WAIT(); asm volatile("" ::: "memory");
}
__device__ __forceinline__ void convert_matrix(const Fr& F, const float* W, int K, int N, bf16_t* WT, int ldt, int koff, int wg_skip = 0) {
    LAS float* scr = (LAS float*)(F.lds + F.wave * 8704);
    const int nblk = N / 32, nitems = (K / 64) * nblk;
    for (int it = F.gw - wg_skip * 8; it < nitems; it += F.NGW - wg_skip * 8) transpose_item(W, N, WT, ldt, koff, scr, it / nblk, it % nblk, F.lane);
}
__device__ __forceinline__ void zero_bytes(const Fr& F, void* p, size_t nbytes) {
    u32x4* q = (u32x4*)p; const size_t n = nbytes / 16; const u32x4 z = {0u, 0u, 0u, 0u};
    for (size_t i = (size_t)F.bid * 512 + F.tid; i < n; i += (size_t)F.G * 512) q[i] = z;
}
__device__ __forceinline__ bf16_t* wtin_of(const Fr& F, int L) { return (bf16_t*)(F.ws + ((L & 1) ? WS_WTINB : WS_WTIN)); }
__device__ __forceinline__ void convert_win(const Fr& F, int L, int wg_skip) {
    const float* src = (L == 0 || L == 3) ? F.in(4) + (size_t)(L ? 1 : 0) * D * 4 * D : (L == 1 ? F.in(8) : F.in(16));
    convert_matrix(F, src, D, 4 * D, wtin_of(F, L), D, 0, wg_skip);
}
__device__ __forceinline__ void convert_layer(const Fr& F, int L, bool with_win) {
    bf16_t* wtin = wtin_of(F, L); bf16_t* wtout = (bf16_t*)(F.ws + WS_WTOUT);
    if (with_win) convert_win(F, L, 0);
    if (L == 0 || L == 3) {
        convert_matrix(F, F.in(7) + (size_t)(L ? 1 : 0) * D * D, D, D, wtout, D, 0);
    } else if (L == 1) {
        convert_matrix(F, F.in(14), D, D, wtout, D, 0);
    } else {
        convert_matrix(F, F.in(28), D, D, wtout, D, 0);
        convert_matrix(F, F.in(18), D, 128, wtin + (size_t)16384 * D, D, 0);
        convert_matrix(F, F.in(21), D, 128, wtin + (size_t)16640 * D, D, 0);
        zero_bytes(F, wtin + (size_t)16512 * D, (size_t)128 * D * 2);
        zero_bytes(F, wtin + (size_t)16768 * D, (size_t)128 * D * 2);
        bf16_t* w2p = (bf16_t*)(F.ws + WS_W2P);
        zero_bytes(F, w2p, (size_t)8192 * 256 * 2);
    }
}
__device__ __forceinline__ void convert_layer2_b(const Fr& F) {
    bf16_t* w2p = (bf16_t*)(F.ws + WS_W2P);
    convert_matrix(F, F.in(19), 128, D, w2p, 256, 0);
    convert_matrix(F, F.in(22), 128, D, w2p + (size_t)4096 * 256, 256, 128);
}

__constant__ float c_inv_freq[16] = {1.0f, 0.44036659598350525f, 0.1939227432012558f, 0.08539710193872452f, 0.03760603070259094f, 0.01656043902039528f, 0.007292664609849453f, 0.0032114458736032248f,
    0.0014142135623842478f, 0.000622772378847003f, 0.00027424818836152554f, 0.00012076973507646471f, 5.318296098266728e-05f, 2.34199997066753e-05f, 1.0313386155758053e-05f, 4.541670477919979e-06f};
__device__ __forceinline__ void rope_table(const Fr& F) {
    float* cs = (float*)(F.ws + WS_ROPE); float* sn = cs + (size_t)R * 16;
    for (int i = F.bid * 512 + F.tid; i < R * 16; i += F.G * 512) {
        const int row = i >> 4, j = i & 15; const int pos = row - NPAD;
        const double ang = (double)(float)((float)pos * c_inv_freq[j]);
        const double k = __builtin_rint(ang * 0.15915494309189535);
        double x = ang - k * 6.283185307179586;
        const double q = __builtin_rint(x * 0.6366197723675814);
        x -= q * 1.5707963267948966;
        const int qi = ((int)q) & 3;
        const double x2 = x * x;
        const double s = x * (1.0 + x2 * (-1.0 / 6 + x2 * (1.0 / 120 + x2 * (-1.0 / 5040 + x2 * (1.0 / 362880 + x2 * (-1.0 / 39916800))))));
        const double c = 1.0 + x2 * (-0.5 + x2 * (1.0 / 24 + x2 * (-1.0 / 720 + x2 * (1.0 / 40320 + x2 * (-1.0 / 3628800 + x2 * (1.0 / 479001600))))));
        double sv, cv;
        if (qi == 0) { sv = s; cv = c; } else if (qi == 1) { sv = c; cv = -s; } else if (qi == 2) { sv = -s; cv = -c; } else { sv = -c; cv = s; }
        cs[i] = (float)cv; sn[i] = (float)sv;
    }
}

typedef const GAS char* gcp; typedef GAS char* gp_;
#define ROW_F32(nm, base, lane) gp_ nm##0 = (gp_)(base) + (lane) * 16 + 4096; gp_ nm##1 = nm##0 + 8192; asm volatile("" : "+v"(nm##0), "+v"(nm##1))
#define AT_F32(nm, j) (*(GAS f32x4*)((j) < 8 ? nm##0 + ((j) - 4) * 1024 : nm##1 + ((j) - 12) * 1024))
#define ROW_BF(nm, base, lane) gp_ nm##0 = (gp_)(base) + (lane) * 8 + 4096; asm volatile("" : "+v"(nm##0))
#define AT_BF(nm, j) (*(GAS u32x2*)(nm##0 + (j) * 512 - 4096))
__device__ __forceinline__ void norm_phase(const Fr& F, int prev, int next, const bf16_t* y, bf16_t* udst, int rlo = 0, int rhi = R, int wg_skip = 0) {
    const float* postg = F.in(3) + (size_t)(prev < 0 ? 0 : prev) * D; const float* preg = F.in(2) + (size_t)(next < 0 ? 0 : next) * D;
    const float* xin = F.in(0); const float* meta = F.in(1);
    for (int r = rlo + F.gw - wg_skip * 8; r < rhi; r += F.NGW - wg_skip * 8) {
        if (r < NPAD || r >= NREAL) {
            if (next >= 0) { ROW_BF(uo, udst + (size_t)r * D, F.lane); const u32x2 z = {0u, 0u};
#pragma unroll
                for (int j = 0; j < 16; ++j) AT_BF(uo, j) = z; }
            continue;
        }
        ROW_BF(hp, (bf16_t*)(F.ws + WS_HB) + (size_t)r * D, F.lane);
        f32x4 hv[16];
        if (prev < 0) {
            const float* src = r < 64 ? meta + (size_t)(r - NPAD) * D : xin + (size_t)(r - 64) * D;
            ROW_F32(sp, src, F.lane);
#pragma unroll
            for (int j = 0; j < 16; ++j) hv[j] = AT_F32(sp, j);
        } else {
            ROW_BF(yp, y + (size_t)r * D, F.lane); ROW_F32(gp, postg, F.lane);
            u32x2 yv[16], hb[16]; float ss = 0.f;
#pragma unroll
            for (int j = 0; j < 16; ++j) { yv[j] = AT_BF(yp, j); hb[j] = AT_BF(hp, j); }
#pragma unroll
            for (int j = 0; j < 16; ++j) { const float a = bflo(yv[j].x), b = bfhi(yv[j].x), c = bflo(yv[j].y), d = bfhi(yv[j].y); ss += (a * a + b * b) + (c * c + d * d); }
#pragma unroll
            for (int j = 0; j < 16; ++j) asm volatile("" : "+v"(yv[j].x), "+v"(yv[j].y));
            const float rs = __builtin_amdgcn_rsqf(wave_sum(ss) * (1.f / D) + 1e-6f);
#pragma unroll
            for (int j = 0; j < 16; ++j) { const f32x4 g = AT_F32(gp, j);
                hv[j].x = bflo(hb[j].x) + bflo(yv[j].x) * rs * g.x; hv[j].y = bfhi(hb[j].x) + bfhi(yv[j].x) * rs * g.y; hv[j].z = bflo(hb[j].y) + bflo(yv[j].y) * rs * g.z; hv[j].w = bfhi(hb[j].y) + bfhi(yv[j].y) * rs * g.w; }
        }
        if (next < 0) {
            if (r >= 64) { ROW_F32(op, F.out + (size_t)(r - 64) * D, F.lane);
#pragma unroll
                for (int j = 0; j < 16; ++j) AT_F32(op, j) = hv[j];
            }
            continue;
        }
        float s2 = 0.f;
#pragma unroll
        for (int j = 0; j < 16; ++j) { u32x2 w_; w_.x = cvt_pk_bf16(hv[j].x, hv[j].y); w_.y = cvt_pk_bf16(hv[j].z, hv[j].w); AT_BF(hp, j) = w_; s2 += (hv[j].x * hv[j].x + hv[j].y * hv[j].y) + (hv[j].z * hv[j].z + hv[j].w * hv[j].w); }
        const float rs2 = __builtin_amdgcn_rsqf(wave_sum(s2) * (1.f / D) + 1e-6f);
        ROW_BF(uo, udst + (size_t)r * D, F.lane); ROW_F32(pg, preg, F.lane);
#pragma unroll
        for (int j = 0; j < 16; ++j) { const f32x4 g = AT_F32(pg, j); u32x2 w; w.x = cvt_pk_bf16(hv[j].x * rs2 * g.x, hv[j].y * rs2 * g.y); w.y = cvt_pk_bf16(hv[j].z * rs2 * g.z, hv[j].w * rs2 * g.w); AT_BF(uo, j) = w; }
    }
}
__device__ __forceinline__ void mix_phase(const Fr& F, const bf16_t* u) {
    const float* mu = F.in(15);
    for (int r = F.gw; r < R; r += F.NGW) {
        const bool real = (r >= NPAD && r < NREAL);
        u32x2 cur[16], prv[16];
        const u32x2 z = {0u, 0u};
        { ROW_BF(cp, u + (size_t)r * D, F.lane); ROW_BF(pp, u + (size_t)(r > 0 ? r - 1 : 0) * D, F.lane);
#pragma unroll
          for (int j = 0; j < 16; ++j) { cur[j] = real ? AT_BF(cp, j) : z; prv[j] = (real && r > NPAD) ? AT_BF(pp, j) : z; } }
#pragma unroll 1
        for (int s = 0; s < 6; ++s) {
            ROW_BF(op, slotU(F, s) + (size_t)r * D, F.lane); ROW_F32(mp, mu + (size_t)s * D, F.lane);
#pragma unroll
            for (int j = 0; j < 16; ++j) {
                const f32x4 m = AT_F32(mp, j);
                const float c0 = bflo(cur[j].x), c1 = bfhi(cur[j].x), c2 = bflo(cur[j].y), c3 = bfhi(cur[j].y);
                const float p0 = bflo(prv[j].x), p1 = bfhi(prv[j].x), p2 = bflo(prv[j].y), p3 = bfhi(prv[j].y);
                u32x2 w; w.x = cvt_pk_bf16(c0 + (p0 - c0) * m.x, c1 + (p1 - c1) * m.y); w.y = cvt_pk_bf16(c2 + (p2 - c2) * m.z, c3 + (p3 - c3) * m.w);
                AT_BF(op, j) = real ? w : z;
            }
        }
    }
}
}
namespace mk {
constexpr int H_QE = 0, H_KE = 17408, H_KET = 34816, H_VT = 53248, H_PM = 71680, H_STB = 80896, H_VEC = 115712;
__device__ __forceinline__ bf16x8 ldfrag(const LAS unsigned char* base, int stride_b, int rb, int ks, int lane) {
    return *(const LAS bf16x8*)(base + (16 * rb + (lane & 15)) * stride_b + (32 * ks + 8 * (lane >> 4)) * 2);
}
template <bool OUT>
__device__ __forceinline__ void hgrn_phase(const Fr& F, int jl) {
    const bf16_t* Q = slotY(F, 0); const bf16_t* V = slotY(F, 1); const bf16_t* GT = slotY(F, 2); const float* Gg = (const float*)slotY(F, 3);
    bf16_t* Z = slotU(F, 0);
    float* HE = (float*)(F.ws + WS_HE); float* HLD = (float*)(F.ws + WS_HLOGD);
    const float* gn = F.in(6) + (size_t)jl * 128;
    LAS unsigned char* L = F.lds;
    LAS float* qtot = (LAS float*)(L + H_VEC); LAS float* ebm = qtot + 512; LAS float* ebl = ebm + 128;
    const int tid = F.tid, lane = F.lane, w = F.wave;
    const int d = tid & 127, qt = tid >> 7;
    for (int unit = F.bid; unit < 256; unit += F.G) {
        const int h = unit >> 3, seg = unit & 7;
        if (!OUT && seg == 7) continue;
        const int c0 = seg == 0 ? 0 : 33 + 32 * (seg - 1), c1 = c0 + (seg == 0 ? 33 : 32);
        f32x4 S[8];
#pragma unroll
        for (int i = 0; i < 8; ++i) S[i] = (f32x4){0.f, 0.f, 0.f, 0.f};
        if (OUT) {
            for (int j = 0; j < seg; ++j) {
                const float* ld = HLD + (size_t)(h * 8 + j) * 128; const float* e = HE + ((size_t)(h * 8 + j) * 512 + tid) * 32;
#pragma unroll
                for (int di = 0; di < 8; ++di) { const f32x4 l4 = *(const f32x4*)(ld + 16 * di + 4 * (lane >> 4)); const f32x4 e4 = *(const f32x4*)(e + 4 * di);
                    S[di].x = S[di].x * __expf(l4.x) + e4.x; S[di].y = S[di].y * __expf(l4.y) + e4.y; S[di].z = S[di].z * __expf(l4.z) + e4.z; S[di].w = S[di].w * __expf(l4.w) + e4.w; }
            }
        }
        float logD = 0.f;
        float g[16]; bf16_t qv[16], vv[16]; u32x4 gt0 = {0u, 0u, 0u, 0u}, gt1 = gt0, ngt0 = gt0, ngt1 = gt0;
#define HG_LOAD(cc) do { const int rowb_ = 64 * (cc) + 16 * qt; const size_t colb_ = (size_t)h * 128 + d; \
            _Pragma("unroll") for (int i = 0; i < 16; ++i) { g[i] = Gg[(size_t)(rowb_ + i) * D + colb_]; vv[i] = V[(size_t)(rowb_ + i) * D + colb_]; if (OUT) qv[i] = Q[(size_t)(rowb_ + i) * D + colb_]; } \
            if (OUT) { const bf16_t* gp_ = GT + (size_t)(64 * (cc) + (tid >> 3)) * D + h * 128 + 16 * (tid & 7); ngt0 = *(const u32x4*)gp_; ngt1 = *(const u32x4*)(gp_ + 8); } } while (0)
        HG_LOAD(c0);
        for (int c = c0; c < c1; ++c) {
            if (OUT) { gt0 = ngt0; gt1 = ngt1; }
            float f[16]; float run = 0.f;
#pragma unroll
            for (int i = 0; i < 16; ++i) { run += g[i]; f[i] = __expf(g[i]); }
            qtot[qt * 128 + d] = run;
            __syncthreads();
            const float t0 = qtot[d], t1 = qtot[128 + d], t2 = qtot[256 + d], t3 = qtot[384 + d];
            const float off = qt == 0 ? 0.f : (qt == 1 ? t0 : (qt == 2 ? t0 + t1 : t0 + t1 + t2));
            const float bm = t0 + t1, bl = (t0 + t1) + (t2 + t3);
            if (qt == 0) { ebm[d] = __expf(bm); ebl[d] = __expf(bl); logD += bl; }
            {
                unsigned kt[8], vt[8];
                const float ebd = __expf(bl - bm);
                float y = __expf(bm - (run + off)), kx_hi = 0.f;
#pragma unroll
                for (int i = 15; i >= 0; --i) {
                    const float ky = (1.f - f[i]) * y;
                    if (OUT) *(LAS bf16_t*)(L + H_KE + ((16 * qt + i) * 136 + d) * 2) = f2bf(ky);
                    const float kx = ky * ebd;
                    if (i & 1) kx_hi = kx; else kt[i >> 1] = cvt_pk_bf16(kx, kx_hi);
                    y *= f[i];
                }
                if (OUT) {
                    float e = __expf(off - bm);
#pragma unroll
                    for (int i = 0; i < 16; ++i) { e *= f[i]; *(LAS bf16_t*)(L + H_QE + ((16 * qt + i) * 136 + d) * 2) = f2bf(bf2f(qv[i]) * e); }
                }
#pragma unroll
                for (int i = 0; i < 16; i += 2) vt[i >> 1] = (unsigned)vv[i] | ((unsigned)vv[i + 1] << 16);
                LAS u32x4* kp = (LAS u32x4*)(L + H_KET + (d * 72 + 16 * qt) * 2); kp[0] = (u32x4){kt[0], kt[1], kt[2], kt[3]}; kp[1] = (u32x4){kt[4], kt[5], kt[6], kt[7]};
                LAS u32x4* vp = (LAS u32x4*)(L + H_VT + (d * 72 + 16 * qt) * 2); vp[0] = (u32x4){vt[0], vt[1], vt[2], vt[3]}; vp[1] = (u32x4){vt[4], vt[5], vt[6], vt[7]};
            }
            if (c + 1 < c1) HG_LOAD(c + 1);
            __syncthreads();
            if (OUT) {
#pragma unroll
                for (int di = 0; di < 8; ++di) { const f32x4 m4 = *(const LAS f32x4*)(ebm + 16 * di + 4 * (lane >> 4)); u32x2 o; o.x = cvt_pk_bf16(S[di].x * m4.x, S[di].y * m4.y); o.y = cvt_pk_bf16(S[di].z * m4.z, S[di].w * m4.w);
                    *(LAS u32x2*)(L + H_STB + ((16 * w + (lane & 15)) * 136 + 16 * di + 4 * (lane >> 4)) * 2) = o; }
                const int ti = w >> 1;
#pragma unroll
                for (int s2 = 0; s2 < 2; ++s2) { const int si = 2 * (w & 1) + s2; f32x4 p = {0.f, 0.f, 0.f, 0.f};
                    if (si <= ti) {
#pragma unroll
                        for (int ks = 0; ks < 4; ++ks) p = __builtin_amdgcn_mfma_f32_16x16x32_bf16(ldfrag(L + H_QE, 272, ti, ks, lane), ldfrag(L + H_KE, 272, si, ks, lane), p, 0, 0, 0);
                    }
                    const int sidx = 16 * si + (lane & 15);
#pragma unroll
                    for (int jj = 0; jj < 4; ++jj) { const int tidx = 16 * ti + 4 * (lane >> 4) + jj; *(LAS bf16_t*)(L + H_PM + (tidx * 72 + sidx) * 2) = f2bf(sidx <= tidx ? p[jj] : 0.f); }
                }
                __syncthreads();
            }
            f32x4 O[4];
            if (OUT) {
#pragma unroll
                for (int ti = 0; ti < 4; ++ti) O[ti] = (f32x4){0.f, 0.f, 0.f, 0.f};
#pragma unroll
                for (int ks = 0; ks < 2; ++ks) { const bf16x8 bv = ldfrag(L + H_VT, 144, w, ks, lane);
#pragma unroll
                    for (int ti = 0; ti < 4; ++ti) O[ti] = __builtin_amdgcn_mfma_f32_16x16x32_bf16(ldfrag(L + H_PM, 144, ti, ks, lane), bv, O[ti], 0, 0, 0); }
#pragma unroll
                for (int ks = 0; ks < 4; ++ks) { const bf16x8 bs = ldfrag(L + H_STB, 272, w, ks, lane);
#pragma unroll
                    for (int ti = 0; ti < 4; ++ti) O[ti] = __builtin_amdgcn_mfma_f32_16x16x32_bf16(ldfrag(L + H_QE, 272, ti, ks, lane), bs, O[ti], 0, 0, 0); }
            }
            {
                const bf16x8 bv0 = ldfrag(L + H_VT, 144, w, 0, lane), bv1 = ldfrag(L + H_VT, 144, w, 1, lane);
#pragma unroll
                for (int di = 0; di < 8; ++di) { const f32x4 l4 = *(const LAS f32x4*)(ebl + 16 * di + 4 * (lane >> 4)); S[di] = S[di] * l4;
                    S[di] = __builtin_amdgcn_mfma_f32_16x16x32_bf16(ldfrag(L + H_KET, 144, di, 0, lane), bv0, S[di], 0, 0, 0);
                    S[di] = __builtin_amdgcn_mfma_f32_16x16x32_bf16(ldfrag(L + H_KET, 144, di, 1, lane), bv1, S[di], 0, 0, 0); }
            }
            if (OUT) {
                __syncthreads();
                LAS float* Ot = (LAS float*)(L + H_STB);
#pragma unroll
                for (int ti = 0; ti < 4; ++ti)
#pragma unroll
                    for (int jj = 0; jj < 4; ++jj) Ot[(16 * ti + 4 * (lane >> 4) + jj) * 132 + 16 * w + (lane & 15)] = O[ti][jj];
                __syncthreads();
                const int t = tid >> 3, eg = tid & 7;
                f32x4 o4[4]; float ss = 0.f;
#pragma unroll
                for (int i = 0; i < 4; ++i) { o4[i] = *(const LAS f32x4*)(Ot + t * 132 + 16 * eg + 4 * i); ss += (o4[i].x * o4[i].x + o4[i].y * o4[i].y) + (o4[i].z * o4[i].z + o4[i].w * o4[i].w); }
                ss = red8(ss);
                const float rs = __builtin_amdgcn_rsqf(ss * (1.f / 128.f) + 1e-6f);
                const unsigned gw_[8] = {gt0.x, gt0.y, gt0.z, gt0.w, gt1.x, gt1.y, gt1.z, gt1.w};
                unsigned zo[8];
#pragma unroll
                for (int i = 0; i < 4; ++i) { const f32x4 g4 = *(const f32x4*)(gn + 16 * eg + 4 * i);
                    const float a0 = o4[i].x * rs * g4.x * silu_f(bflo(gw_[2 * i])), a1 = o4[i].y * rs * g4.y * silu_f(bfhi(gw_[2 * i]));
                    const float a2 = o4[i].z * rs * g4.z * silu_f(bflo(gw_[2 * i + 1])), a3 = o4[i].w * rs * g4.w * silu_f(bfhi(gw_[2 * i + 1]));
                    zo[2 * i] = cvt_pk_bf16(a0, a1); zo[2 * i + 1] = cvt_pk_bf16(a2, a3); }
                bf16_t* zp = Z + (size_t)(64 * c + t) * D + h * 128 + 16 * eg;
                *(u32x4*)zp = (u32x4){zo[0], zo[1], zo[2], zo[3]}; *(u32x4*)(zp + 8) = (u32x4){zo[4], zo[5], zo[6], zo[7]};
            } else {
                __syncthreads();
            }
        }
        if (!OUT) {
            float* e = HE + ((size_t)(h * 8 + seg) * 512 + tid) * 32;
#pragma unroll
            for (int di = 0; di < 8; ++di) *(f32x4*)(e + 4 * di) = S[di];
            if (qt == 0) HLD[(size_t)(h * 8 + seg) * 128 + d] = logD;
        }
        __syncthreads();
    }
#undef HG_LOAD
}

#ifndef MK_PRIO
#define MK_PRIO 0
#endif
#define PRIO_HI() do { if (MK_PRIO) { __builtin_amdgcn_s_setprio(MK_PRIO); } } while (0)
#define PRIO_LO() do { if (MK_PRIO) { __builtin_amdgcn_s_setprio(0); } } while (0)
namespace att {
constexpr int NW = 8, QBLK = 32, KVBLK = 64, LDQ = 4096, LDO = 8192;
constexpr float SCALE = 0.088388347648318440f, THR = 8.f;
constexpr int SHM_V = 16384, SHM_K = 16384, SHM = 2 * SHM_V + 2 * SHM_K + NW * 64 * 4;
#ifndef MK_KSWM
#define MK_KSWM 15
#endif
#define KSWZ(row, colB) ((row) * 256 + ((colB) ^ (((row) & MK_KSWM) << 4)))
#define SBAR() __builtin_amdgcn_sched_barrier(0)
__device__ __forceinline__ int crow(int r, int hi) { return (r & 3) + 8 * (r >> 2) + 4 * hi; }
__device__ __forceinline__ void partialSM(f32x16& p0, f32x16& p1, float& m_reg, float& mn, float& alpha) {
    constexpr float C = SCALE * 1.4426950408889634f;
    float pmax = p0[0];
#pragma unroll
    for (int r = 1; r < 16; ++r) pmax = fmaxf(pmax, p0[r]);
#pragma unroll
    for (int r = 0; r < 16; ++r) pmax = fmaxf(pmax, p1[r]);
    { auto rr = __builtin_amdgcn_permlane32_swap(__float_as_uint(pmax), __float_as_uint(pmax), false, false);
      pmax = fmaxf(__uint_as_float(rr[0]), __uint_as_float(rr[1])); }
    if (__builtin_expect(__all(pmax - m_reg <= THR / SCALE), 1)) { mn = m_reg; alpha = 1.f; }
    else { mn = fmaxf(m_reg, pmax); alpha = __builtin_amdgcn_exp2f((m_reg - mn) * C); m_reg = mn; }
    const float mnC = -mn * C;
#pragma unroll
    for (int r = 0; r < 16; ++r) p0[r] = fmaf(p0[r], C, mnC);
#pragma unroll
    for (int r = 0; r < 16; ++r) p1[r] = fmaf(p1[r], C, mnC);
#pragma unroll
    for (int r = 0; r < 16; ++r) p0[r] = __builtin_amdgcn_exp2f(p0[r]);
}
__device__ __forceinline__ void finishSM(f32x16& p0, f32x16& p1, float alpha, float& l_reg, bf16x8& pa0, bf16x8& pa1, bf16x8& pa2, bf16x8& pa3) {
#pragma unroll
    for (int r = 0; r < 16; ++r) p1[r] = __builtin_amdgcn_exp2f(p1[r]);
    float ps = 0;
#pragma unroll
    for (int r = 0; r < 16; ++r) ps += p0[r];
#pragma unroll
    for (int r = 0; r < 16; ++r) ps += p1[r];
    { auto rr = __builtin_amdgcn_permlane32_swap(__float_as_uint(ps), __float_as_uint(ps), false, false);
      ps = __uint_as_float(rr[0]) + __uint_as_float(rr[1]); }
    l_reg = l_reg * alpha + ps;
#define PK4(P, BASE, OUT) do { unsigned a0 = cvt_pk_bf16(P[BASE + 0], P[BASE + 1]), a1 = cvt_pk_bf16(P[BASE + 2], P[BASE + 3]);   \
    unsigned b0 = cvt_pk_bf16(P[BASE + 4], P[BASE + 5]), b1 = cvt_pk_bf16(P[BASE + 6], P[BASE + 7]);                              \
    auto r0 = __builtin_amdgcn_permlane32_swap(a0, b0, false, false); auto r1 = __builtin_amdgcn_permlane32_swap(a1, b1, false, false); \
    u32x4 w = {r0[0], r1[0], r0[1], r1[1]}; OUT = *reinterpret_cast<bf16x8*>(&w); } while (0)
    PK4(p0, 0, pa0); PK4(p0, 8, pa1); PK4(p1, 0, pa2); PK4(p1, 8, pa3);
#undef PK4
}
__device__ __forceinline__ void qkt(f32x16& p0, f32x16& p1, const char* Ks, const bf16x8* qr, int r32, int hi) {
    p0 = f32x16{}; p1 = f32x16{};
    PRIO_HI();
#pragma unroll
    for (int d0 = 0; d0 < 8; ++d0) { const int cb = (d0 * 16 + hi * 8) * 2;
        const bf16x8 b0 = *reinterpret_cast<const bf16x8*>(Ks + KSWZ(r32, cb));
        const bf16x8 b1 = *reinterpret_cast<const bf16x8*>(Ks + KSWZ(32 + r32, cb));
        p0 = __builtin_amdgcn_mfma_f32_32x32x16_bf16(b0, qr[d0], p0, 0, 0, 0);
        p1 = __builtin_amdgcn_mfma_f32_32x32x16_bf16(b1, qr[d0], p1, 0, 0, 0); }
    PRIO_LO();
}
__device__ __forceinline__ int v_st(int k, int c) { const int kk = (k & ~0xC) | ((k & 4) << 1) | ((k & 8) >> 1); return ((kk >> 3) * 4 + (c >> 5)) * 512 + ((kk & 7) * 32 + (c & 31)) * 2; }
__device__ __forceinline__ int v_rd_base(int lane) { return ((lane & 3) << 3) | (((lane >> 2) & 3) << 6) | (((lane >> 4) & 1) << 5) | (((lane >> 5) & 1) << 8); }
constexpr int v_rd_off(int d0, int ks, int half) { return d0 * 512 + ks * 4096 + half * 2048; }
template <int OFF> __device__ __forceinline__ s16x4 tr_read(int vb) {
    s16x4 r; asm volatile("ds_read_b64_tr_b16 %0, %1 offset:%2" : "=&v"(r) : "v"(vb), "i"(OFF) : "memory"); return r;
}
template <int D0> __device__ __forceinline__ void pv_one(f32x16& od, int vb, bf16x8 pa0, bf16x8 pa1, bf16x8 pa2, bf16x8 pa3) {
    const s16x4 l0 = tr_read<v_rd_off(D0, 0, 0)>(vb), h0 = tr_read<v_rd_off(D0, 0, 1)>(vb), l1 = tr_read<v_rd_off(D0, 1, 0)>(vb), h1 = tr_read<v_rd_off(D0, 1, 1)>(vb);
    const s16x4 l2 = tr_read<v_rd_off(D0, 2, 0)>(vb), h2 = tr_read<v_rd_off(D0, 2, 1)>(vb), l3 = tr_read<v_rd_off(D0, 3, 0)>(vb), h3 = tr_read<v_rd_off(D0, 3, 1)>(vb);
    asm volatile("s_waitcnt lgkmcnt(0)" ::: "memory"); SBAR();
#define PK(Lo, Hi) (bf16x8){Lo[0], Lo[1], Lo[2], Lo[3], Hi[0], Hi[1], Hi[2], Hi[3]}
    od = __builtin_amdgcn_mfma_f32_32x32x16_bf16(pa0, PK(l0, h0), od, 0, 0, 0);
    od = __builtin_amdgcn_mfma_f32_32x32x16_bf16(pa1, PK(l1, h1), od, 0, 0, 0);
    od = __builtin_amdgcn_mfma_f32_32x32x16_bf16(pa2, PK(l2, h2), od, 0, 0, 0);
    od = __builtin_amdgcn_mfma_f32_32x32x16_bf16(pa3, PK(l3, h3), od, 0, 0, 0);
#undef PK
}
__device__ __forceinline__ void pv_d0(f32x16* o, int vb, bf16x8 pa0, bf16x8 pa1, bf16x8 pa2, bf16x8 pa3) {
    pv_one<0>(o[0], vb, pa0, pa1, pa2, pa3); pv_one<1>(o[1], vb, pa0, pa1, pa2, pa3); pv_one<2>(o[2], vb, pa0, pa1, pa2, pa3); pv_one<3>(o[3], vb, pa0, pa1, pa2, pa3);
}
__device__ __forceinline__ void mask_tile(f32x16& p0, f32x16& p1, int j, int lim) {
    if (j > lim) {
#pragma unroll
        for (int r = 0; r < 16; ++r) { p0[r] = -1e30f; p1[r] = -1e30f; }
    } else if (j == 0) {
#pragma unroll
        for (int r = 0; r < 16; ++r) p0[r] = -1e30f;
#pragma unroll
        for (int r = 0; r < 8; ++r) p1[r] = -1e30f;
    }
}
__device__ __forceinline__ void unit(const bf16_t* __restrict__ Qb, const bf16_t* __restrict__ Kh, const bf16_t* __restrict__ Vh, bf16_t* __restrict__ Ob, int NT, int lim, char* lds) {
    int tid_ = threadIdx.x; asm volatile("" : "+v"(tid_));
    const int tid = tid_, wid = tid >> 6, lane = tid & 63, r32 = lane & 31, hi = lane >> 5;
    char* V_lds = lds; char* K_lds = lds + 2 * SHM_V;
    float* wsf = (float*)(lds + 2 * SHM_V + 2 * SHM_K) + wid * 64; float* li_l = wsf; float* al_l = wsf + 32;
    float m_reg = -1e30f, l_reg = 0; f32x16 o[4] = {}; bf16x8 qr[8];
    const bf16_t* Qw = Qb + (long)(wid * QBLK + r32) * LDQ + hi * 8;
#pragma unroll
    for (int d0 = 0; d0 < 8; ++d0) qr[d0] = *reinterpret_cast<const bf16x8*>(Qw + d0 * 16);
    const int sr = tid >> 4, sc = (tid & 15) * 8, vst0 = v_st(sr, sc), vst1 = v_st(32 + sr, sc);
    const int vb0 = (int)(uintptr_t)V_lds + v_rd_base(lane);
    struct { bf16x8 vs0, vs1, ks0, ks1; } sr_[2];
#define SLOAD(i, k0) do { sr_[i].vs0 = *reinterpret_cast<const bf16x8*>(&Vh[(long)((k0) + sr) * LDQ + sc]); sr_[i].vs1 = *reinterpret_cast<const bf16x8*>(&Vh[(long)((k0) + 32 + sr) * LDQ + sc]); \
    sr_[i].ks0 = *reinterpret_cast<const bf16x8*>(&Kh[(long)((k0) + sr) * LDQ + sc]); sr_[i].ks1 = *reinterpret_cast<const bf16x8*>(&Kh[(long)((k0) + 32 + sr) * LDQ + sc]); } while (0)
#define SWRITE(b, i) do { *(bf16x8*)(V_lds + (b) * SHM_V + vst0) = sr_[i].vs0;          \
    *(bf16x8*)(V_lds + (b) * SHM_V + vst1) = sr_[i].vs1; int kc = sc * 2;               \
    *(bf16x8*)(K_lds + (b) * SHM_K + KSWZ(sr, kc)) = sr_[i].ks0;                       \
    *(bf16x8*)(K_lds + (b) * SHM_K + KSWZ(32 + sr, kc)) = sr_[i].ks1; } while (0)
#define SWAIT() asm volatile("s_waitcnt vmcnt(4)" ::: "memory")
#define RESC(a) do { if (__any((a) < 1.f)) { if (hi == 0) al_l[r32] = (a); asm volatile("s_waitcnt lgkmcnt(0)" ::: "memory"); \
    _Pragma("unroll") for (int d = 0; d < 4; ++d) _Pragma("unroll") for (int r = 0; r < 16; ++r) o[d][r] *= al_l[crow(r, hi)]; } } while (0)
    f32x16 pA0, pA1, pB0, pB1; float mnA, mnB, alA, alB; bf16x8 pa0, pa1, pa2, pa3;
    constexpr int SE = 0, SO = 1;
    SLOAD(SE, 0); asm volatile("s_waitcnt vmcnt(0)" ::: "memory"); SWRITE(0, SE); __syncthreads();
    qkt(pA0, pA1, K_lds, qr, r32, hi); mask_tile(pA0, pA1, 0, lim); partialSM(pA0, pA1, m_reg, mnA, alA);
    SLOAD(SO, KVBLK); if (2 < NT) SLOAD(SE, 2 * KVBLK);
    SWAIT(); SWRITE(1, SO); __syncthreads();
    for (int j = 1; j + 1 < NT; j += 2) {
        SBAR(); qkt(pB0, pB1, K_lds + SHM_K, qr, r32, hi);
        finishSM(pA0, pA1, alA, l_reg, pa0, pa1, pa2, pa3); SBAR();
        SLOAD(SO, (j + 2) * KVBLK); SBAR();
        pv_d0(o, vb0, pa0, pa1, pa2, pa3); mask_tile(pB0, pB1, j, lim); partialSM(pB0, pB1, m_reg, mnB, alB);
        __syncthreads(); SWAIT(); SWRITE(0, SE);
        RESC(alB); __syncthreads();
        SBAR(); qkt(pA0, pA1, K_lds, qr, r32, hi);
        finishSM(pB0, pB1, alB, l_reg, pa0, pa1, pa2, pa3); SBAR();
        if (j + 3 < NT) SLOAD(SE, (j + 3) * KVBLK); SBAR();
        pv_d0(o, vb0 + SHM_V, pa0, pa1, pa2, pa3); mask_tile(pA0, pA1, j + 1, lim); partialSM(pA0, pA1, m_reg, mnA, alA);
        __syncthreads(); SWAIT(); SWRITE(1, SO);
        RESC(alA); __syncthreads();
    }
    SBAR(); qkt(pB0, pB1, K_lds + SHM_K, qr, r32, hi);
    finishSM(pA0, pA1, alA, l_reg, pa0, pa1, pa2, pa3); SBAR();
    pv_d0(o, vb0, pa0, pa1, pa2, pa3); mask_tile(pB0, pB1, NT - 1, lim); partialSM(pB0, pB1, m_reg, mnB, alB);
    __syncthreads(); RESC(alB);
    finishSM(pB0, pB1, alB, l_reg, pa0, pa1, pa2, pa3); SBAR();
    pv_d0(o, vb0 + SHM_V, pa0, pa1, pa2, pa3);
    if (hi == 0) li_l[r32] = l_reg; asm volatile("s_waitcnt lgkmcnt(0)" ::: "memory");
    float rli[16];
#pragma unroll
    for (int r = 0; r < 16; ++r) rli[r] = __builtin_amdgcn_rcpf(li_l[crow(r, hi)]);
    bf16_t* Ow = Ob + (long)(wid * QBLK) * LDO;
#pragma unroll
    for (int r = 0; r < 16; ++r) { const int orow = crow(r, hi);
#pragma unroll
        for (int d0 = 0; d0 < 4; ++d0) Ow[(long)orow * LDO + d0 * 32 + r32] = f2bf(o[d0][r] * rli[r]); }
    __syncthreads();
#undef SLOAD
#undef SWRITE
#undef SWAIT
#undef RESC
}
}


#ifndef MK_HB
#define MK_HB(w) ((w) >> 2)
#endif
namespace att2 {
using namespace att;
constexpr int KB = 16384, VB = 32768, OFF_V = 3 * KB, OFF_W = OFF_V + 3 * VB, SHM2 = OFF_W + NW * 64 * 4;
constexpr int v2_rd_off(int d0, int ks, int half) { return d0 * 512 + ks * 8192 + half * 4096; }
template <int D0> __device__ __forceinline__ void pv2_one(f32x16& od, int vb, bf16x8 pa0, bf16x8 pa1, bf16x8 pa2, bf16x8 pa3) {
    const s16x4 l0 = tr_read<v2_rd_off(D0, 0, 0)>(vb), h0 = tr_read<v2_rd_off(D0, 0, 1)>(vb), l1 = tr_read<v2_rd_off(D0, 1, 0)>(vb), h1 = tr_read<v2_rd_off(D0, 1, 1)>(vb);
    const s16x4 l2 = tr_read<v2_rd_off(D0, 2, 0)>(vb), h2 = tr_read<v2_rd_off(D0, 2, 1)>(vb), l3 = tr_read<v2_rd_off(D0, 3, 0)>(vb), h3 = tr_read<v2_rd_off(D0, 3, 1)>(vb);
    asm volatile("s_waitcnt lgkmcnt(0)" ::: "memory"); SBAR();
#define PK(Lo, Hi) (bf16x8){Lo[0], Lo[1], Lo[2], Lo[3], Hi[0], Hi[1], Hi[2], Hi[3]}
    od = __builtin_amdgcn_mfma_f32_32x32x16_bf16(pa0, PK(l0, h0), od, 0, 0, 0);
    od = __builtin_amdgcn_mfma_f32_32x32x16_bf16(pa1, PK(l1, h1), od, 0, 0, 0);
    od = __builtin_amdgcn_mfma_f32_32x32x16_bf16(pa2, PK(l2, h2), od, 0, 0, 0);
    od = __builtin_amdgcn_mfma_f32_32x32x16_bf16(pa3, PK(l3, h3), od, 0, 0, 0);
#undef PK
}
struct VFrag { s16x4 l0, h0, l1, h1, l2, h2, l3, h3; };
template <int D0> __device__ __forceinline__ void v2_load(VFrag& f, int vb) {
    f.l0 = tr_read<v2_rd_off(D0, 0, 0)>(vb); f.h0 = tr_read<v2_rd_off(D0, 0, 1)>(vb); f.l1 = tr_read<v2_rd_off(D0, 1, 0)>(vb); f.h1 = tr_read<v2_rd_off(D0, 1, 1)>(vb);
    f.l2 = tr_read<v2_rd_off(D0, 2, 0)>(vb); f.h2 = tr_read<v2_rd_off(D0, 2, 1)>(vb); f.l3 = tr_read<v2_rd_off(D0, 3, 0)>(vb); f.h3 = tr_read<v2_rd_off(D0, 3, 1)>(vb);
}
__device__ __forceinline__ void v2_mma(f32x16& od, const VFrag& f, bf16x8 pa0, bf16x8 pa1, bf16x8 pa2, bf16x8 pa3) {
#define PK(Lo, Hi) (bf16x8){Lo[0], Lo[1], Lo[2], Lo[3], Hi[0], Hi[1], Hi[2], Hi[3]}
    od = __builtin_amdgcn_mfma_f32_32x32x16_bf16(pa0, PK(f.l0, f.h0), od, 0, 0, 0);
    od = __builtin_amdgcn_mfma_f32_32x32x16_bf16(pa1, PK(f.l1, f.h1), od, 0, 0, 0);
    od = __builtin_amdgcn_mfma_f32_32x32x16_bf16(pa2, PK(f.l2, f.h2), od, 0, 0, 0);
    od = __builtin_amdgcn_mfma_f32_32x32x16_bf16(pa3, PK(f.l3, f.h3), od, 0, 0, 0);
#undef PK
}
struct VSet { s16x4 l0, h0, l1, h1, l2, h2, l3, h3; };
template <int G, int KS> __device__ __forceinline__ void vs_load(VSet& f, int vb) {
    f.l0 = tr_read<v2_rd_off(4 * G + 0, KS, 0)>(vb); f.h0 = tr_read<v2_rd_off(4 * G + 0, KS, 1)>(vb); f.l1 = tr_read<v2_rd_off(4 * G + 1, KS, 0)>(vb); f.h1 = tr_read<v2_rd_off(4 * G + 1, KS, 1)>(vb);
    f.l2 = tr_read<v2_rd_off(4 * G + 2, KS, 0)>(vb); f.h2 = tr_read<v2_rd_off(4 * G + 2, KS, 1)>(vb); f.l3 = tr_read<v2_rd_off(4 * G + 3, KS, 0)>(vb); f.h3 = tr_read<v2_rd_off(4 * G + 3, KS, 1)>(vb);
}
template <int G> __device__ __forceinline__ void vs_mma(f32x16* o, const VSet& f, bf16x8 pa) {
#define PK(Lo, Hi) (bf16x8){Lo[0], Lo[1], Lo[2], Lo[3], Hi[0], Hi[1], Hi[2], Hi[3]}
    o[4 * G + 0] = __builtin_amdgcn_mfma_f32_32x32x16_bf16(pa, PK(f.l0, f.h0), o[4 * G + 0], 0, 0, 0);
    o[4 * G + 1] = __builtin_amdgcn_mfma_f32_32x32x16_bf16(pa, PK(f.l1, f.h1), o[4 * G + 1], 0, 0, 0);
    o[4 * G + 2] = __builtin_amdgcn_mfma_f32_32x32x16_bf16(pa, PK(f.l2, f.h2), o[4 * G + 2], 0, 0, 0);
    o[4 * G + 3] = __builtin_amdgcn_mfma_f32_32x32x16_bf16(pa, PK(f.l3, f.h3), o[4 * G + 3], 0, 0, 0);
#undef PK
}
__device__ __forceinline__ void pv2_all(f32x16* o, int vb, bf16x8 pa0, bf16x8 pa1, bf16x8 pa2, bf16x8 pa3) {
    VSet A, B;
#define W8() do { asm volatile("s_waitcnt lgkmcnt(8)" ::: "memory"); SBAR(); } while (0)
    PRIO_HI();
    vs_load<0, 0>(A, vb);
    vs_load<0, 1>(B, vb); W8(); vs_mma<0>(o, A, pa0); SBAR();
    vs_load<0, 2>(A, vb); W8(); vs_mma<0>(o, B, pa1); SBAR();
    vs_load<0, 3>(B, vb); W8(); vs_mma<0>(o, A, pa2); SBAR();
    vs_load<1, 0>(A, vb); W8(); vs_mma<0>(o, B, pa3); SBAR();
    vs_load<1, 1>(B, vb); W8(); vs_mma<1>(o, A, pa0); SBAR();
    vs_load<1, 2>(A, vb); W8(); vs_mma<1>(o, B, pa1); SBAR();
    vs_load<1, 3>(B, vb); W8(); vs_mma<1>(o, A, pa2); SBAR();
    asm volatile("s_waitcnt lgkmcnt(0)" ::: "memory"); SBAR(); vs_mma<1>(o, B, pa3); SBAR();
    PRIO_LO();
#undef W8
}
__device__ __forceinline__ void unit2(const bf16_t* __restrict__ Qb, const bf16_t* __restrict__ Kh, const bf16_t* __restrict__ Vh, bf16_t* __restrict__ Ob, int NT, int lim, unsigned char* ldsg, LAS unsigned char* lds) {
    int tid_ = threadIdx.x; asm volatile("" : "+v"(tid_));
    const int tid = tid_, wid = __builtin_amdgcn_readfirstlane(tid >> 6), lane = tid & 63, r32 = lane & 31, hi = lane >> 5;
    LAS float* wsf = (LAS float*)(lds + OFF_W) + wid * 64; LAS float* li_l = wsf; LAS float* al_l = wsf + 32;
    float m_reg = -1e30f, l_reg = 0; f32x16 o[8] = {}; bf16x8 qr[8];
    const bf16_t* Qw = Qb + (long)(wid * QBLK + r32) * LDQ + hi * 8;
#pragma unroll
    for (int d0 = 0; d0 < 8; ++d0) qr[d0] = *reinterpret_cast<const bf16x8*>(Qw + d0 * 16);
    const int vb0 = (int)(uintptr_t)(ldsg + OFF_V) + v_rd_base(lane);
    unsigned ko0, vo0;
    { const int row = wid * 4 + (lane >> 4); ko0 = (unsigned)(row * LDQ * 2 + (((lane & 15) * 16) ^ ((row & MK_KSWM) << 4)));
      const int st = wid * 2 + (lane >> 5), q = lane & 31; const int kk = (st >> 3) * 8 + (q >> 2); const int k = (kk & ~0xC) | ((kk & 4) << 1) | ((kk & 8) >> 1);
      vo0 = (unsigned)(k * LDQ * 2 + ((st & 7) * 32 + (q & 3) * 8) * 2); }
#define DMA_K(t_, b_) do { const char* gk = (const char*)Kh + (size_t)(t_) * (KVBLK * LDQ * 2); _Pragma("unroll") for (int i = 0; i < 2; ++i) { \
        __builtin_amdgcn_global_load_lds((const unsigned*)(gk + (size_t)i * (32 * LDQ * 2) + ko0), (LAS unsigned*)(lds + (b_) * KB + wid * 1024 + i * 8192), 16, 0, 0); } } while (0)
#define DMA_V(t_, b_) do { const char* gv = (const char*)Vh + (size_t)(t_) * (KVBLK * LDQ * 2); _Pragma("unroll") for (int i = 0; i < 4; ++i) { \
        __builtin_amdgcn_global_load_lds((const unsigned*)(gv + (size_t)i * (16 * LDQ * 2) + vo0), (LAS unsigned*)(lds + OFF_V + (b_) * VB + wid * 1024 + i * 8192), 16, 0, 0); } } while (0)
    DMA_K(0, 0); DMA_V(0, 0); if (1 < NT) { DMA_K(1, 1); DMA_V(1, 1); }
    asm volatile("s_waitcnt vmcnt(0)" ::: "memory"); __builtin_amdgcn_s_barrier(); asm volatile("" ::: "memory");
    int kb = 0;
    for (int j = 0; j < NT; ++j) {
        const int kb2 = kb == 0 ? 2 : kb - 1;
        if (j + 2 < NT) DMA_V(j + 2, kb2);
        asm volatile("" ::: "memory");
        if (j + 2 < NT) DMA_K(j + 2, kb2);
        asm volatile("" ::: "memory");
        if (j <= lim) {
        f32x16 p0, p1; float mn, alpha; bf16x8 pa0, pa1, pa2, pa3;
        qkt(p0, p1, (const char*)ldsg + kb * KB, qr, r32, hi);
#if MK_PROBE_QK2
        asm volatile("" : "+v"(p0), "+v"(p1)); qkt(p0, p1, (const char*)ldsg + kb * KB, qr, r32, hi);
#endif
        if (j == 0) {
            asm volatile("; tile-0 mask" ::: "memory");
#pragma unroll
            for (int r = 0; r < 16; ++r) p0[r] = -1e30f;
#pragma unroll
            for (int r = 0; r < 8; ++r) p1[r] = -1e30f;
        }
        partialSM(p0, p1, m_reg, mn, alpha);
        if (__any(alpha < 1.f)) { if (hi == 0) al_l[r32] = alpha; asm volatile("s_waitcnt lgkmcnt(0)" ::: "memory");
#pragma unroll
            for (int d = 0; d < 8; ++d)
#pragma unroll
                for (int r = 0; r < 16; ++r) o[d][r] *= al_l[crow(r, hi)]; }
        finishSM(p0, p1, alpha, l_reg, pa0, pa1, pa2, pa3); SBAR();
        const int vb = vb0 + kb * VB;
        pv2_all(o, vb, pa0, pa1, pa2, pa3);
        }
        if (j + 2 < NT) asm volatile("s_waitcnt vmcnt(6)" ::: "memory"); else asm volatile("s_waitcnt vmcnt(0)" ::: "memory");
        __builtin_amdgcn_s_barrier(); asm volatile("" ::: "memory");
        kb = kb == 2 ? 0 : kb + 1;
    }
    if (hi == 0) li_l[r32] = l_reg; asm volatile("s_waitcnt lgkmcnt(0)" ::: "memory");
    float rli[16];
#pragma unroll
    for (int r = 0; r < 16; ++r) rli[r] = __builtin_amdgcn_rcpf(li_l[crow(r, hi)]);
    bf16_t* Ow = Ob + (long)(wid * QBLK) * LDO;
#pragma unroll
    for (int r = 0; r < 16; ++r) { const int orow = crow(r, hi);
#pragma unroll
        for (int d0 = 0; d0 < 8; ++d0) Ow[(long)orow * LDO + d0 * 32 + r32] = f2bf(o[d0][r] * rli[r]); }
    asm volatile("s_waitcnt vmcnt(0) lgkmcnt(0)" ::: "memory"); __builtin_amdgcn_s_barrier(); asm volatile("" ::: "memory");
#undef DMA_K
#undef DMA_V
}

__device__ __forceinline__ void unit3(const bf16_t* __restrict__ Qb, const bf16_t* __restrict__ Kh, const bf16_t* __restrict__ Vh, bf16_t* __restrict__ Ob, int NT, int lim, unsigned char* ldsg, LAS unsigned char* lds) {
    int tid_ = threadIdx.x; asm volatile("" : "+v"(tid_));
    const int tid = tid_, wid = __builtin_amdgcn_readfirstlane(tid >> 6), lane = tid & 63, r32 = lane & 31, hi = lane >> 5, hb = MK_HB(wid);
    LAS float* wsf = (LAS float*)(lds + OFF_W) + wid * 64; LAS float* li_l = wsf; LAS float* al_l = wsf + 32;
    float m_reg = -1e30f, l_reg = 0; f32x16 o[8] = {}; bf16x8 qr[8];
    const bf16_t* Qw = Qb + (long)(wid * QBLK + r32) * LDQ + hi * 8;
#pragma unroll
    for (int d0 = 0; d0 < 8; ++d0) qr[d0] = *reinterpret_cast<const bf16x8*>(Qw + d0 * 16);
#define DMA_K(t_, b_) do { const char* gk = (const char*)Kh + (size_t)(t_) * (KVBLK * LDQ * 2); int ln_ = lane; asm volatile("" : "+v"(ln_)); _Pragma("unroll") for (int i = 0; i < 2; ++i) { \
        const int row = wid * 4 + i * 32 + (ln_ >> 4); const unsigned ko = (unsigned)(row * LDQ * 2 + (((ln_ & 15) * 16) ^ ((row & MK_KSWM) << 4))); \
        __builtin_amdgcn_global_load_lds((const unsigned*)(gk + ko), (LAS unsigned*)(lds + (b_) * KB + wid * 1024 + i * 8192), 16, 0, 0); } } while (0)
#define DMA_V(t_, b_) do { const char* gv = (const char*)Vh + (size_t)(t_) * (KVBLK * LDQ * 2); int ln_ = lane; asm volatile("" : "+v"(ln_)); _Pragma("unroll") for (int i = 0; i < 4; ++i) { \
        const int st = wid * 2 + i * 16 + (ln_ >> 5), q = ln_ & 31; const int kk = (st >> 3) * 8 + (q >> 2); const int k = (kk & ~0xC) | ((kk & 4) << 1) | ((kk & 8) >> 1); \
        const unsigned vo = (unsigned)(k * LDQ * 2 + ((st & 7) * 32 + (q & 3) * 8) * 2); \
        __builtin_amdgcn_global_load_lds((const unsigned*)(gv + vo), (LAS unsigned*)(lds + OFF_V + (b_) * VB + wid * 1024 + i * 8192), 16, 0, 0); } } while (0)
    DMA_K(0, 0); DMA_V(0, 0); if (1 < NT) { DMA_K(1, 1); DMA_V(1, 1); }
    asm volatile("s_waitcnt vmcnt(0)" ::: "memory"); __builtin_amdgcn_s_barrier(); asm volatile("" ::: "memory");
    bf16x8 pa0, pa1, pa2, pa3;
    int kq = 0, ki = 2;
    int vq = 0, vi = 2;
#define U3_QS(j_) do { f32x16 p0, p1; float mn, alpha; int lq_ = lane; asm volatile("" : "+v"(lq_)); const int r32 = lq_ & 31, hi = lq_ >> 5; \
        qkt(p0, p1, (const char*)ldsg + kq * KB, qr, r32, hi); kq = kq == 2 ? 0 : kq + 1; \
        mask_tile(p0, p1, (j_), lim); \
        partialSM(p0, p1, m_reg, mn, alpha); \
        if (__any(alpha < 1.f)) { if (hi == 0) al_l[r32] = alpha; asm volatile("s_waitcnt lgkmcnt(0)" ::: "memory"); \
            _Pragma("unroll") for (int d = 0; d < 8; ++d) _Pragma("unroll") for (int r = 0; r < 16; ++r) o[d][r] *= al_l[crow(r, hi)]; } \
        finishSM(p0, p1, alpha, l_reg, pa0, pa1, pa2, pa3); } while (0)
#define U3_PV(j_) do { int lp_ = lane; asm volatile("" : "+v"(lp_)); const int vb = (int)(uintptr_t)(ldsg + OFF_V) + v_rd_base(lp_) + vq * VB; vq = vq == 2 ? 0 : vq + 1; \
        pv2_one<0>(o[0], vb, pa0, pa1, pa2, pa3); pv2_one<1>(o[1], vb, pa0, pa1, pa2, pa3); pv2_one<2>(o[2], vb, pa0, pa1, pa2, pa3); pv2_one<3>(o[3], vb, pa0, pa1, pa2, pa3); \
        pv2_one<4>(o[4], vb, pa0, pa1, pa2, pa3); pv2_one<5>(o[5], vb, pa0, pa1, pa2, pa3); pv2_one<6>(o[6], vb, pa0, pa1, pa2, pa3); pv2_one<7>(o[7], vb, pa0, pa1, pa2, pa3); } while (0)
#define U3_EVEN_ISSUE(jj_) do { if ((jj_) + 2 < NT) DMA_K((jj_) + 2, ki); ki = ki == 2 ? 0 : ki + 1; asm volatile("" ::: "memory"); } while (0)
#define U3_ODD_ISSUE(jj_) do { if ((jj_) + 2 < NT) DMA_V((jj_) + 2, vi); vi = vi == 2 ? 0 : vi + 1; asm volatile("" ::: "memory"); } while (0)
#define U3_EVEN_END(jj_) do { if ((jj_) + 2 < NT) asm volatile("s_waitcnt vmcnt(6)" ::: "memory"); else if ((jj_) + 1 < NT) asm volatile("s_waitcnt vmcnt(4)" ::: "memory"); else asm volatile("s_waitcnt vmcnt(0)" ::: "memory");   \
        asm volatile("s_waitcnt lgkmcnt(0)" ::: "memory"); __builtin_amdgcn_s_barrier(); asm volatile("" ::: "memory"); } while (0)
#define U3_ODD_END() do { asm volatile("s_waitcnt lgkmcnt(0)" ::: "memory"); __builtin_amdgcn_s_barrier(); asm volatile("" ::: "memory"); } while (0)
    if (hb == 0) {
#pragma unroll 1
        for (int jj = 0; jj < NT; ++jj) {
            U3_EVEN_ISSUE(jj); U3_QS(jj); U3_EVEN_END(jj);
            U3_ODD_ISSUE(jj); U3_PV(jj); U3_ODD_END();
        }
        U3_EVEN_ISSUE(NT); U3_EVEN_END(NT);
    } else {
        U3_EVEN_ISSUE(0); U3_EVEN_END(0);
#pragma unroll 1
        for (int jj = 0; jj < NT; ++jj) {
            U3_ODD_ISSUE(jj); U3_QS(jj); U3_ODD_END();
            U3_EVEN_ISSUE(jj + 1); U3_PV(jj); U3_EVEN_END(jj + 1);
        }
    }
#undef U3_QS
#undef U3_PV
#undef U3_EVEN_ISSUE
#undef U3_ODD_ISSUE
#undef U3_EVEN_END
#undef U3_ODD_END
    if (hi == 0) li_l[r32] = l_reg; asm volatile("s_waitcnt lgkmcnt(0)" ::: "memory");
    float rli[16];
#pragma unroll
    for (int r = 0; r < 16; ++r) rli[r] = __builtin_amdgcn_rcpf(li_l[crow(r, hi)]);
    bf16_t* Ow = Ob + (long)(wid * QBLK) * LDO;
#pragma unroll
    for (int r = 0; r < 16; ++r) { const int orow = crow(r, hi);
#pragma unroll
        for (int d0 = 0; d0 < 8; ++d0) Ow[(long)orow * LDO + d0 * 32 + r32] = f2bf(o[d0][r] * rli[r]); }
    asm volatile("s_waitcnt vmcnt(0) lgkmcnt(0)" ::: "memory"); __builtin_amdgcn_s_barrier(); asm volatile("" ::: "memory");
#undef DMA_K
#undef DMA_V
}

__device__ __forceinline__ void unit4(const bf16_t* __restrict__ Qb, const bf16_t* __restrict__ Kh, const bf16_t* __restrict__ Vh, bf16_t* __restrict__ Ob, int NT, int lim, unsigned char* ldsg, LAS unsigned char* lds) {
    int tid_ = threadIdx.x; asm volatile("" : "+v"(tid_));
    const int tid = tid_, wid = __builtin_amdgcn_readfirstlane(tid >> 6), lane = tid & 63, hb = MK_HB(wid);
    LAS float* wsf = (LAS float*)(lds + OFF_W) + wid * 64; LAS float* li_l = wsf; LAS float* al_l = wsf + 32;
    float m_reg = -1e30f, l_reg = 0; f32x16 o[8] = {}; bf16x8 qr[8];
    { const int r32 = lane & 31, hi = lane >> 5; const bf16_t* Qw = Qb + (long)(wid * QBLK + r32) * LDQ + hi * 8;
#pragma unroll
      for (int d0 = 0; d0 < 8; ++d0) qr[d0] = *reinterpret_cast<const bf16x8*>(Qw + d0 * 16); }
#define DMA_K(t_, b_) do { const char* gk = (const char*)Kh + (size_t)(t_) * (KVBLK * LDQ * 2); int ln_ = lane; asm volatile("" : "+v"(ln_)); _Pragma("unroll") for (int i = 0; i < 2; ++i) { \
        const int row = wid * 4 + i * 32 + (ln_ >> 4); const unsigned ko = (unsigned)(row * LDQ * 2 + (((ln_ & 15) * 16) ^ ((row & MK_KSWM) << 4))); \
        __builtin_amdgcn_global_load_lds((const unsigned*)(gk + ko), (LAS unsigned*)(lds + (b_) * KB + wid * 1024 + i * 8192), 16, 0, 0); } } while (0)
#define DMA_V(t_, b_) do { const char* gv = (const char*)Vh + (size_t)(t_) * (KVBLK * LDQ * 2); int ln_ = lane; asm volatile("" : "+v"(ln_)); _Pragma("unroll") for (int i = 0; i < 4; ++i) { \
        const int st = wid * 2 + i * 16 + (ln_ >> 5), q = ln_ & 31; const int kk = (st >> 3) * 8 + (q >> 2); const int k = (kk & ~0xC) | ((kk & 4) << 1) | ((kk & 8) >> 1); \
        const unsigned vo = (unsigned)(k * LDQ * 2 + ((st & 7) * 32 + (q & 3) * 8) * 2); \
        __builtin_amdgcn_global_load_lds((const unsigned*)(gv + vo), (LAS unsigned*)(lds + OFF_V + (b_) * VB + wid * 1024 + i * 8192), 16, 0, 0); } } while (0)
    DMA_K(0, 0); DMA_V(0, 0); if (1 < NT) { DMA_K(1, 1); DMA_V(1, 1); } if (2 < NT) DMA_K(2, 2);
    asm volatile("s_waitcnt vmcnt(0)" ::: "memory"); __builtin_amdgcn_s_barrier(); asm volatile("" ::: "memory");
    f32x16 p0, p1; bf16x8 pa0, pa1, pa2, pa3;
    int kq = 0, ki = 0, vq = 0, vi = 2;
#define U4_QK() do { int lq_ = lane; asm volatile("" : "+v"(lq_)); qkt(p0, p1, (const char*)ldsg + kq * KB, qr, lq_ & 31, lq_ >> 5); kq = kq == 2 ? 0 : kq + 1; } while (0)
#define U4_SM(j_) do { float mn, alpha; int lq_ = lane; asm volatile("" : "+v"(lq_)); const int r32 = lq_ & 31, hi = lq_ >> 5; \
        mask_tile(p0, p1, (j_), lim); \
        partialSM(p0, p1, m_reg, mn, alpha); \
        if (__any(alpha < 1.f)) { if (hi == 0) al_l[r32] = alpha; asm volatile("s_waitcnt lgkmcnt(0)" ::: "memory"); \
            _Pragma("unroll") for (int d = 0; d < 8; ++d) _Pragma("unroll") for (int r = 0; r < 16; ++r) o[d][r] *= al_l[crow(r, hi)]; } \
        finishSM(p0, p1, alpha, l_reg, pa0, pa1, pa2, pa3); } while (0)
#define U4_PV() do { int lp_ = lane; asm volatile("" : "+v"(lp_)); const int vb = (int)(uintptr_t)(ldsg + OFF_V) + v_rd_base(lp_) + vq * VB; vq = vq == 2 ? 0 : vq + 1; \
        pv2_all(o, vb, pa0, pa1, pa2, pa3); } while (0)
#define U4_ISSUE(s_) do { if (((s_) & 1) == 0) { if ((s_) >= 2) { if ((s_) / 2 + 2 < NT) DMA_K((s_) / 2 + 2, ki); ki = ki == 2 ? 0 : ki + 1; } } \
        else { if ((s_) >= 3) { if (((s_) + 1) / 2 < NT) DMA_V(((s_) + 1) / 2, vi); vi = vi == 2 ? 0 : vi + 1; } } asm volatile("" ::: "memory"); } while (0)
#define U4_END(s_) do { if ((s_) & 1) { const int kt = ((s_) + 1) / 2 + 1, vt = ((s_) + 1) / 2;     \
            if ((s_) >= 3 && kt < NT && vt < NT) asm volatile("s_waitcnt vmcnt(6)" ::: "memory"); \
            else if ((s_) >= 3 && vt < NT) asm volatile("s_waitcnt vmcnt(4)" ::: "memory"); \
            else asm volatile("s_waitcnt vmcnt(0)" ::: "memory"); } \
        asm volatile("s_waitcnt lgkmcnt(0)" ::: "memory"); __builtin_amdgcn_s_barrier(); asm volatile("" ::: "memory"); } while (0)
    if (hb == 0) {
        U4_ISSUE(0); U4_QK(); U4_END(0);
#pragma unroll 1
        for (int m = 0; m < NT; ++m) {
            U4_ISSUE(2 * m + 1); U4_SM(m); U4_END(2 * m + 1);
            U4_ISSUE(2 * m + 2); U4_PV(); if (m + 1 < NT) U4_QK(); U4_END(2 * m + 2);
        }
        U4_ISSUE(2 * NT + 1); U4_END(2 * NT + 1);
    } else {
        U4_ISSUE(0); U4_END(0);
        U4_ISSUE(1); U4_QK(); U4_END(1);
#pragma unroll 1
        for (int m = 0; m < NT; ++m) {
            U4_ISSUE(2 * m + 2); U4_SM(m); U4_END(2 * m + 2);
            U4_ISSUE(2 * m + 3); U4_PV(); if (m + 1 < NT) U4_QK(); U4_END(2 * m + 3);
        }
    }
#undef U4_QK
#undef U4_SM
#undef U4_PV
#undef U4_ISSUE
#undef U4_END
    const int r32 = lane & 31, hi = lane >> 5;
    if (hi == 0) li_l[r32] = l_reg; asm volatile("s_waitcnt lgkmcnt(0)" ::: "memory");
    float rli[16];
#pragma unroll
    for (int r = 0; r < 16; ++r) rli[r] = __builtin_amdgcn_rcpf(li_l[crow(r, hi)]);
    bf16_t* Ow = Ob + (long)(wid * QBLK) * LDO;
#pragma unroll
    for (int r = 0; r < 16; ++r) { const int orow = crow(r, hi);
#pragma unroll
        for (int d0 = 0; d0 < 8; ++d0) Ow[(long)orow * LDO + d0 * 32 + r32] = f2bf(o[d0][r] * rli[r]); }
    asm volatile("s_waitcnt vmcnt(0) lgkmcnt(0)" ::: "memory"); __builtin_amdgcn_s_barrier(); asm volatile("" ::: "memory");
#undef DMA_K
#undef DMA_V
}

__device__ __forceinline__ void unit5(const bf16_t* __restrict__ Qb, const bf16_t* __restrict__ Kh, const bf16_t* __restrict__ Vh, bf16_t* __restrict__ Ob, int NT, int lim, unsigned char* ldsg, LAS unsigned char* lds) {
    int tid_ = threadIdx.x; asm volatile("" : "+v"(tid_));
    const int tid = tid_, wid = __builtin_amdgcn_readfirstlane(tid >> 6), lane = tid & 63, hb = MK_HB(wid);
    LAS float* wsf = (LAS float*)(lds + OFF_W) + wid * 64; LAS float* li_l = wsf; LAS float* al_l = wsf + 32;
    float m_reg = -1e30f, l_reg = 0; f32x16 o[8] = {}; bf16x8 qr[8];
    { const int r32 = lane & 31, hi = lane >> 5; const bf16_t* Qw = Qb + (long)(wid * QBLK + r32) * LDQ + hi * 8;
#pragma unroll
      for (int d0 = 0; d0 < 8; ++d0) qr[d0] = *reinterpret_cast<const bf16x8*>(Qw + d0 * 16); }
#define DMA_K(t_, b_) do { const char* gk = (const char*)Kh + (size_t)(t_) * (KVBLK * LDQ * 2); int ln_ = lane; asm volatile("" : "+v"(ln_)); _Pragma("unroll") for (int i = 0; i < 2; ++i) { \
        const int row = wid * 4 + i * 32 + (ln_ >> 4); const unsigned ko = (unsigned)(row * LDQ * 2 + (((ln_ & 15) * 16) ^ ((row & MK_KSWM) << 4))); \
        __builtin_amdgcn_global_load_lds((const unsigned*)(gk + ko), (LAS unsigned*)(lds + (b_) * KB + wid * 1024 + i * 8192), 16, 0, 0); } } while (0)
#define DMA_V(t_, b_) do { const char* gv = (const char*)Vh + (size_t)(t_) * (KVBLK * LDQ * 2); int ln_ = lane; asm volatile("" : "+v"(ln_)); _Pragma("unroll") for (int i = 0; i < 4; ++i) { \
        const int st = wid * 2 + i * 16 + (ln_ >> 5), q = ln_ & 31; const int kk = (st >> 3) * 8 + (q >> 2); const int k = (kk & ~0xC) | ((kk & 4) << 1) | ((kk & 8) >> 1); \
        const unsigned vo = (unsigned)(k * LDQ * 2 + ((st & 7) * 32 + (q & 3) * 8) * 2); \
        __builtin_amdgcn_global_load_lds((const unsigned*)(gv + vo), (LAS unsigned*)(lds + OFF_V + (b_) * VB + wid * 1024 + i * 8192), 16, 0, 0); } } while (0)
    DMA_K(0, 0); DMA_V(0, 0); if (1 < NT) DMA_K(1, 1);
    asm volatile("s_waitcnt vmcnt(0)" ::: "memory"); __builtin_amdgcn_s_barrier(); asm volatile("" ::: "memory");
    bf16x8 pa0, pa1, pa2, pa3;
    int kb = 0, kb1 = 1, kb2 = 2;
#define U5_ISSUE(j_) do { if ((j_) + 1 < NT) DMA_V((j_) + 1, kb1); asm volatile("" ::: "memory"); if ((j_) + 2 < NT) DMA_K((j_) + 2, kb2); asm volatile("" ::: "memory"); } while (0)
#define U5_QS(j_) do { f32x16 p0, p1; float mn, alpha; int lq_ = lane; asm volatile("" : "+v"(lq_)); const int r32 = lq_ & 31, hi = lq_ >> 5; \
        qkt(p0, p1, (const char*)ldsg + kb * KB, qr, r32, hi); \
        mask_tile(p0, p1, (j_), lim); \
        partialSM(p0, p1, m_reg, mn, alpha); \
        if (__any(alpha < 1.f)) { if (hi == 0) al_l[r32] = alpha; asm volatile("s_waitcnt lgkmcnt(0)" ::: "memory"); \
            _Pragma("unroll") for (int d = 0; d < 8; ++d) _Pragma("unroll") for (int r = 0; r < 16; ++r) o[d][r] *= al_l[crow(r, hi)]; } \
        finishSM(p0, p1, alpha, l_reg, pa0, pa1, pa2, pa3); } while (0)
#define U5_PV(vbuf_) do { int lp_ = lane; asm volatile("" : "+v"(lp_)); const int vb = (int)(uintptr_t)(ldsg + OFF_V) + v_rd_base(lp_) + (vbuf_) * VB; pv2_all(o, vb, pa0, pa1, pa2, pa3); } while (0)
#define U5_END(j_) do { if ((j_) + 2 < NT) asm volatile("s_waitcnt vmcnt(2)" ::: "memory"); else asm volatile("s_waitcnt vmcnt(0)" ::: "memory"); \
        asm volatile("s_waitcnt lgkmcnt(0)" ::: "memory"); __builtin_amdgcn_s_barrier(); asm volatile("" ::: "memory"); \
        { const int t_ = kb; kb = kb1; kb1 = kb2; kb2 = t_; } } while (0)
    if (hb == 0) {
#pragma unroll 1
        for (int j = 0; j < NT; ++j) { U5_ISSUE(j); U5_QS(j); U5_PV(kb); U5_END(j); }
    } else {
#pragma unroll 1
        for (int j = 0; j < NT; ++j) { U5_ISSUE(j); if (j > 0) U5_PV(kb2); U5_QS(j); U5_END(j); }
        U5_PV(kb2);
    }
#undef U5_ISSUE
#undef U5_QS
#undef U5_PV
#undef U5_END
    const int r32 = lane & 31, hi = lane >> 5;
    if (hi == 0) li_l[r32] = l_reg; asm volatile("s_waitcnt lgkmcnt(0)" ::: "memory");
    float rli[16];
#pragma unroll
    for (int r = 0; r < 16; ++r) rli[r] = __builtin_amdgcn_rcpf(li_l[crow(r, hi)]);
    bf16_t* Ow = Ob + (long)(wid * QBLK) * LDO;
#pragma unroll
    for (int r = 0; r < 16; ++r) { const int orow = crow(r, hi);
#pragma unroll
        for (int d0 = 0; d0 < 8; ++d0) Ow[(long)orow * LDO + d0 * 32 + r32] = f2bf(o[d0][r] * rli[r]); }
    asm volatile("s_waitcnt vmcnt(0) lgkmcnt(0)" ::: "memory"); __builtin_amdgcn_s_barrier(); asm volatile("" ::: "memory");
#undef DMA_K
#undef DMA_V
}
}

#ifndef MK_ATT2
#define MK_ATT2 1
#endif
#ifndef MK_PROBE_QK2
#define MK_PROBE_QK2 0
#endif
#ifndef MK_PROBE_DMA2
#define MK_PROBE_DMA2 0
#endif
#ifndef MK_ATT_UNIT
#define MK_ATT_UNIT unit2
#endif
#if MK_ATT2
__device__ __forceinline__ void attn_phase(const Fr& F) {
    const bf16_t* Q = slotY(F, 0); const bf16_t* K = slotY(F, 1); const bf16_t* V = slotY(F, 2);
    bf16_t* AO = slotU(F, 1);
    const int x = F.bid & 7, j = (F.bid >> 3) & 31;
#pragma unroll 1
    for (int k = 0; k < 4; ++k) {
        if (F.bid >= 256) break;
        const int sub = 4 * x + k, head = sub >> 1, c = sub & 1;
        const bf16_t* Kp = K + head * 256 + c * 128; const bf16_t* Vp = V + head * 256;
#pragma unroll 1
        for (int u = 0; u < 2; ++u) {
            const int t = u == 0 ? 63 - j : j;
            const int row0 = 256 * t + 128;
            att2::MK_ATT_UNIT(Q + (size_t)row0 * D + head * 256 + c * 128, Kp, Vp, AO + (size_t)row0 * 8192 + head * 512 + c * 256, 4 * t + 6, 4 * t + 2 + (F.wave >> 1), F.ldsg, F.lds);
        }
        if (j == 8 * k) att2::MK_ATT_UNIT(Q + head * 256 + c * 128, Kp, Vp, AO + head * 512 + c * 256, 4, F.wave >> 1, F.ldsg, F.lds);
    }
}
#else
__device__ __forceinline__ void attn_phase(const Fr& F) {
    const bf16_t* Q = slotY(F, 0); const bf16_t* K = slotY(F, 1); const bf16_t* V = slotY(F, 2);
    bf16_t* AO = slotU(F, 1);
    const int x = F.bid & 7, j = (F.bid >> 3) & 31;
#pragma unroll 1
    for (int k = 0; k < 8; ++k) {
        if (F.bid >= 256) break;
        const int sub = 8 * x + k, head = sub >> 2, c = (sub >> 1) & 1, half = sub & 1;
        const bf16_t* Kp = K + head * 256 + c * 128; const bf16_t* Vp = V + head * 256 + half * 128;
#pragma unroll 1
        for (int u = 0; u < 2; ++u) {
            const int t = u == 0 ? 63 - j : j;
            const int row0 = 256 * t + 128;
            att::unit(Q + (size_t)row0 * D + head * 256 + c * 128, Kp, Vp, AO + (size_t)row0 * 8192 + head * 512 + c * 256 + half * 128, 4 * t + 6, 4 * t + 2 + (F.wave >> 1), (char*)F.ldsg);
        }
        if (j == 4 * k) att::unit(Q + head * 256 + c * 128, Kp, Vp, AO + head * 512 + c * 256 + half * 128, 4, F.wave >> 1, (char*)F.ldsg);
    }
}
#endif
__device__ __forceinline__ void attn_post(const Fr& F) {
    const bf16_t* AO = slotU(F, 1); const bf16_t* GT = slotY(F, 3); bf16_t* Z = slotU(F, 0);
    const float* sg = F.in(13);
    constexpr float LINIT = 0.35550906759096934f;
    float lam;
    { const float* q1 = F.in(9); const float* k1 = F.in(10); const float* q2 = F.in(11); const float* k2 = F.in(12);
      const float d1 = wave_sum(q1[F.lane] * k1[F.lane] + q1[F.lane + 64] * k1[F.lane + 64]), d2 = wave_sum(q2[F.lane] * k2[F.lane] + q2[F.lane + 64] * k2[F.lane + 64]);
      lam = expf(d1) - expf(d2) + LINIT; }
    const f32x4 g4 = ((const f32x4*)sg)[F.lane];
    for (int r = F.gw; r < R; r += F.NGW) {
        const bool real = (r >= NPAD && r < NREAL);
        u32x2* zr = (u32x2*)(Z + (size_t)r * D) + F.lane;
        if (!real) { const u32x2 z = {0u, 0u};
#pragma unroll
            for (int hd = 0; hd < 16; ++hd) zr[64 * hd] = z;
            continue; }
        gp_ ao0 = (gp_)(AO + (size_t)r * 8192) + F.lane * 8 + 4096; gp_ ao1 = ao0 + 8192; asm volatile("" : "+v"(ao0), "+v"(ao1));
        ROW_BF(gq, GT + (size_t)r * D, F.lane); ROW_BF(zq, Z + (size_t)r * D, F.lane);
        u32x2 a0v[16], a1v[16], gtv[16];
#pragma unroll
        for (int hd = 0; hd < 16; ++hd) {
            a0v[hd] = *(GAS u32x2*)(hd < 8 ? ao0 + (2 * hd) * 512 - 4096 : ao1 + (2 * hd - 16) * 512 - 4096);
            a1v[hd] = *(GAS u32x2*)(hd < 8 ? ao0 + (2 * hd + 1) * 512 - 4096 : ao1 + (2 * hd - 15) * 512 - 4096);
            gtv[hd] = AT_BF(gq, hd);
        }
#pragma unroll
        for (int hd = 0; hd < 16; ++hd) {
            const u32x2 a0 = a0v[hd], a1 = a1v[hd], gt = gtv[hd];
            const float o0 = bflo(a0.x) - lam * bflo(a1.x), o1 = bfhi(a0.x) - lam * bfhi(a1.x), o2 = bflo(a0.y) - lam * bflo(a1.y), o3 = bfhi(a0.y) - lam * bfhi(a1.y);
            const float ss = wave_sum((o0 * o0 + o1 * o1) + (o2 * o2 + o3 * o3));
            const float rs = __builtin_amdgcn_rsqf(ss * (1.f / 256.f) + 1e-5f) * (1.f - LINIT);
            u32x2 w; w.x = cvt_pk_bf16(o0 * rs * g4.x * silu_f(bflo(gt.x)), o1 * rs * g4.y * silu_f(bfhi(gt.x))); w.y = cvt_pk_bf16(o2 * rs * g4.z * silu_f(bflo(gt.y)), o3 * rs * g4.w * silu_f(bfhi(gt.y)));
            AT_BF(zq, hd) = w;
        }
    }
}

constexpr int RW_TT = 32, RW_TOKF = 384, RW_TILEF = RW_TT * RW_TOKF, RW_NTILE = 513;
__device__ __forceinline__ void rwkv_scan_seq(const Fr& F) {
    const bf16_t* Rr = slotY(F, 0); const bf16_t* K = slotY(F, 1); const bf16_t* V = slotY(F, 2); const bf16_t* W = slotY(F, 4); const bf16_t* A = slotY(F, 5);
    float* O32 = (float*)slotU(F, 1);
    LAS float* ring = (LAS float*)F.lds; LAS float* otile = ring + 2 * RW_TILEF;
    const int tid = F.tid, lane = F.lane, wid = F.wave;
    for (int unit = F.bid; unit < 256; unit += F.G) {
        const int h = unit >> 2, rg = unit & 3;
        const int ptid = tid - 256, ptt = ptid >> 3, dg = ptid & 7;
        float kkc[8], kac[8];
        if (wid >= 4) {
#pragma unroll
            for (int i = 0; i < 8; ++i) { kkc[i] = F.in(23)[h * 64 + 8 * dg + i]; kac[i] = F.in(24)[h * 64 + 8 * dg + i]; }
        }
        float S0 = 0.f, S1 = 0.f, S2 = 0.f, S3 = 0.f;
        const int cg = lane & 15, irow = 4 * wid + (lane >> 4);
#define RW_PRODUCE(m, buf) do { const int row = NPAD + 32 * (m) + ptt; const size_t off = (size_t)row * D + h * 64 + 8 * dg; \
        const u32x4 r8 = *(const u32x4*)(Rr + off), k8 = *(const u32x4*)(K + off), v8 = *(const u32x4*)(V + off), w8 = *(const u32x4*)(W + off), a8 = *(const u32x4*)(A + off); \
        const unsigned rw[4] = {r8.x, r8.y, r8.z, r8.w}, kw[4] = {k8.x, k8.y, k8.z, k8.w}, vw[4] = {v8.x, v8.y, v8.z, v8.w}, ww[4] = {w8.x, w8.y, w8.z, w8.w}, aw[4] = {a8.x, a8.y, a8.z, a8.w}; \
        float rf[8], kf[8], vf[8], wf[8], af[8], kk[8]; float ssq = 0.f; \
        _Pragma("unroll") for (int i = 0; i < 4; ++i) { rf[2 * i] = bflo(rw[i]); rf[2 * i + 1] = bfhi(rw[i]); kf[2 * i] = bflo(kw[i]); kf[2 * i + 1] = bfhi(kw[i]); vf[2 * i] = bflo(vw[i]); vf[2 * i + 1] = bfhi(vw[i]); \
            wf[2 * i] = bflo(ww[i]); wf[2 * i + 1] = bfhi(ww[i]); af[2 * i] = bflo(aw[i]); af[2 * i + 1] = bfhi(aw[i]); } \
        _Pragma("unroll") for (int i = 0; i < 8; ++i) { kk[i] = kf[i] * kkc[i]; ssq += kk[i] * kk[i]; } \
        ssq = red8(ssq); const float inv = 1.f / fmaxf(sqrtf(ssq), 1e-12f); \
        LAS float* tb = ring + (buf) * RW_TILEF + ptt * RW_TOKF; \
        _Pragma("unroll") for (int q = 0; q < 2; ++q) { LAS f32x4* p = (LAS f32x4*)(tb + (2 * dg + q) * 20); \
            f32x4 t0, t1, t2, t3, t4; \
            _Pragma("unroll") for (int e = 0; e < 4; ++e) { const int i = 4 * q + e; const float kn = kk[i] * inv; t0[e] = wf[i]; t1[e] = -kn; t2[e] = kn * af[i]; t3[e] = kf[i] * (1.f + (af[i] - 1.f) * kac[i]); t4[e] = rf[i]; } \
            p[0] = t0; p[1] = t1; p[2] = t2; p[3] = t3; p[4] = t4; } \
        LAS f32x4* pv = (LAS f32x4*)(tb + 320 + 8 * dg); pv[0] = (f32x4){vf[0], vf[1], vf[2], vf[3]}; pv[1] = (f32x4){vf[4], vf[5], vf[6], vf[7]}; } while (0)
#define RW_FLUSH(m, buf) do { const int row = NPAD + 32 * (m) + ptt; if (row < NREAL) { const LAS float* ot = otile + (buf) * 512 + ptt * 16 + 2 * dg; \
        *(float2*)(O32 + (size_t)row * D + h * 64 + 16 * rg + 2 * dg) = make_float2(ot[0], ot[1]); } } while (0)
        if (wid >= 4) RW_PRODUCE(0, 0);
        __syncthreads();
        for (int n = 0; n < RW_NTILE; ++n) {
            if (wid < 4) {
                const LAS float* tb = ring + (n & 1) * RW_TILEF; LAS float* ot = otile + (n & 1) * 512;
#pragma unroll 4
                for (int tt = 0; tt < RW_TT; ++tt) {
                    const LAS float* p = tb + tt * RW_TOKF + cg * 20;
                    const f32x4 w4 = *(const LAS f32x4*)p, nk = *(const LAS f32x4*)(p + 4), ka = *(const LAS f32x4*)(p + 8), kp = *(const LAS f32x4*)(p + 12), r4 = *(const LAS f32x4*)(p + 16);
                    const float v = tb[tt * RW_TOKF + 320 + 16 * rg + irow];
                    float sa = (S0 * nk.x + S1 * nk.y) + (S2 * nk.z + S3 * nk.w);
                    sa = red16(sa);
                    S0 = S0 * w4.x + (sa * ka.x + v * kp.x); S1 = S1 * w4.y + (sa * ka.y + v * kp.y); S2 = S2 * w4.z + (sa * ka.z + v * kp.z); S3 = S3 * w4.w + (sa * ka.w + v * kp.w);
                    float o = (S0 * r4.x + S1 * r4.y) + (S2 * r4.z + S3 * r4.w);
                    o = red16(o);
                    if (cg == 0) ot[tt * 16 + irow] = o;
                }
            } else {
                if (n + 1 < RW_NTILE) RW_PRODUCE(n + 1, (n + 1) & 1);
                if (n > 0) RW_FLUSH(n - 1, (n - 1) & 1);
            }
            __syncthreads();
        }
        if (wid >= 4) RW_FLUSH(RW_NTILE - 1, (RW_NTILE - 1) & 1);
        __syncthreads();
#undef RW_PRODUCE
#undef RW_FLUSH
    }
}

#ifndef RC_SYNC
#define RC_SYNC 0
#endif
constexpr int RC_SLOT = 13312, RC_NSLOT = 8, RC_SCR0 = RC_NSLOT * RC_SLOT, RC_SCR = 5632, RC_FLAGS = RC_SCR0 + 7 * RC_SCR, RC_NCH = 1025;
constexpr int RC_AT = 0, RC_RT = 2176, RC_BTT = 4352, RC_KTT = 6912, RC_TT = 9472, RC_G3F = 9984, RC_VTF = 10496, RC_P1 = 11008, RC_P2 = 12032, RC_WC = 13056;
static_assert(RC_FLAGS + 64 <= 147456 - 256, "rwkv LDS map");
typedef short s16x4v __attribute__((ext_vector_type(4)));
__device__ __forceinline__ void rwkv_kknorm(const Fr& F) {
    const bf16_t* K = slotY(F, 1); const float* k_k = F.in(23); float* INV = (float*)(F.ws + WS_HE);
    f32x4 c4v[16];
    { ROW_F32(cq, k_k, F.lane);
#pragma unroll
      for (int it = 0; it < 16; ++it) c4v[it] = AT_F32(cq, it); }
    for (int r = F.gw; r < R; r += F.NGW) {
        ROW_BF(kq_, K + (size_t)r * D, F.lane);
        u32x2 kv[16];
#pragma unroll
        for (int it = 0; it < 16; ++it) kv[it] = AT_BF(kq_, it);
#pragma unroll
        for (int it = 0; it < 16; ++it) {
            const u32x2 kk = kv[it]; const f32x4 c4 = c4v[it];
            const float a = bflo(kk.x) * c4.x, b = bfhi(kk.x) * c4.y, c = bflo(kk.y) * c4.z, d = bfhi(kk.y) * c4.w;
            const float ss = red16((a * a + b * b) + (c * c + d * d));
            if ((F.lane & 15) == 0) INV[(size_t)r * 64 + it * 4 + (F.lane >> 4)] = 1.f / fmaxf(sqrtf(ss), 1e-12f);
        }
    }
}
__device__ __forceinline__ unsigned lds_poll(volatile LAS unsigned* p) { return *p; }
__device__ __forceinline__ void rwkv_scan(const Fr& F) {
    const bf16_t* Rr = slotY(F, 0); const bf16_t* K = slotY(F, 1); const bf16_t* V = slotY(F, 2); const bf16_t* W = slotY(F, 4); const bf16_t* A = slotY(F, 5);
    const float* INV = (const float*)(F.ws + WS_HE);
    float* O32 = (float*)slotU(F, 1);
    LAS unsigned char* L = F.lds;
    volatile LAS unsigned* flags = (volatile LAS unsigned*)(L + RC_FLAGS);
    const int lane = F.lane, wid = F.wave, l15 = lane & 15, kg = lane >> 4;
    for (int unit = F.bid; unit < 256; unit += F.G) {
        const int h = unit >> 2, rgw = unit & 3;
        if (F.tid < 16) flags[F.tid] = 0u;
        __syncthreads();
        if (wid == 0) {
            __builtin_amdgcn_s_setprio(3);
            f32x4 S0 = {0.f, 0.f, 0.f, 0.f}, S1 = S0, S2 = S0, S3 = S0;
            struct SlotRegs { u32x2 a0l, a0h, a1l, a1h, r0l, r0h, r1l, r1h; f32x4 P1, P2; s16x4v ttf, g3f, vtf, b0, b1, b2, b3, k0, k1, k2, k3; f32x4 w0, w1, w2, w3; };
#if RC_SYNC
#define CH_WAIT(n_) do { if ((n_) % 7 == 0) { __builtin_amdgcn_s_barrier(); __builtin_amdgcn_s_barrier(); } } while (0)
#else
#define CH_WAIT(n_) do { unsigned sp = 0; while (lds_poll(flags + ((n_) & 7)) != (unsigned)((n_) + 1)) { __builtin_amdgcn_s_sleep(1); if (++sp > (1u << 22)) break; } } while (0)
#endif
#define CH_LOAD(R_, n_) do { CH_WAIT(n_); asm volatile("s_waitcnt lgkmcnt(0)" ::: "memory"); const LAS unsigned char* SL = L + ((n_) & 7) * RC_SLOT; \
                const LAS unsigned char* ap = SL + RC_AT + l15 * 136 + kg * 8; const LAS unsigned char* rp = SL + RC_RT + l15 * 136 + kg * 8; \
                R_.a0l = *(const LAS u32x2*)(ap); R_.a0h = *(const LAS u32x2*)(ap + 32); R_.a1l = *(const LAS u32x2*)(ap + 64); R_.a1h = *(const LAS u32x2*)(ap + 96); \
                R_.r0l = *(const LAS u32x2*)(rp); R_.r0h = *(const LAS u32x2*)(rp + 32); R_.r1l = *(const LAS u32x2*)(rp + 64); R_.r1h = *(const LAS u32x2*)(rp + 96); \
                R_.P1 = *(const LAS f32x4*)(SL + RC_P1 + lane * 16); R_.P2 = *(const LAS f32x4*)(SL + RC_P2 + lane * 16); \
                R_.ttf = *(const LAS s16x4v*)(SL + RC_TT + lane * 8); R_.g3f = *(const LAS s16x4v*)(SL + RC_G3F + lane * 8); R_.vtf = *(const LAS s16x4v*)(SL + RC_VTF + lane * 8); \
                const LAS unsigned char* bp = SL + RC_BTT + l15 * 40 + kg * 8; const LAS unsigned char* kp = SL + RC_KTT + l15 * 40 + kg * 8; \
                R_.b0 = *(const LAS s16x4v*)(bp); R_.b1 = *(const LAS s16x4v*)(bp + 640); R_.b2 = *(const LAS s16x4v*)(bp + 1280); R_.b3 = *(const LAS s16x4v*)(bp + 1920); \
                R_.k0 = *(const LAS s16x4v*)(kp); R_.k1 = *(const LAS s16x4v*)(kp + 640); R_.k2 = *(const LAS s16x4v*)(kp + 1280); R_.k3 = *(const LAS s16x4v*)(kp + 1920); \
                const LAS f32x4* wc = (const LAS f32x4*)(SL + RC_WC + kg * 16); R_.w0 = wc[0]; R_.w1 = wc[4]; R_.w2 = wc[8]; R_.w3 = wc[12]; \
                asm volatile("s_waitcnt lgkmcnt(0)" ::: "memory"); \
                if (lane == 0) flags[8] = (unsigned)((n_) + 1); } while (0)
#define CH_COMPUTE(R_, n_, NEXT_) do { \
                u32x4 sb0, sb1; sb0.x = cvt_pk_bf16(S0.x, S0.y); sb0.y = cvt_pk_bf16(S0.z, S0.w); sb0.z = cvt_pk_bf16(S1.x, S1.y); sb0.w = cvt_pk_bf16(S1.z, S1.w); \
                sb1.x = cvt_pk_bf16(S2.x, S2.y); sb1.y = cvt_pk_bf16(S2.z, S2.w); sb1.z = cvt_pk_bf16(S3.x, S3.y); sb1.w = cvt_pk_bf16(S3.z, S3.w); \
                const bf16x8 Sb0 = *reinterpret_cast<bf16x8*>(&sb0), Sb1 = *reinterpret_cast<bf16x8*>(&sb1); \
                u32x4 t4; \
                t4 = (u32x4){R_.a0l.x, R_.a0l.y, R_.a0h.x, R_.a0h.y}; const bf16x8 Aq0 = *reinterpret_cast<bf16x8*>(&t4); \
                t4 = (u32x4){R_.a1l.x, R_.a1l.y, R_.a1h.x, R_.a1h.y}; const bf16x8 Aq1 = *reinterpret_cast<bf16x8*>(&t4); \
                t4 = (u32x4){R_.r0l.x, R_.r0l.y, R_.r0h.x, R_.r0h.y}; const bf16x8 Rq0 = *reinterpret_cast<bf16x8*>(&t4); \
                t4 = (u32x4){R_.r1l.x, R_.r1l.y, R_.r1h.x, R_.r1h.y}; const bf16x8 Rq1 = *reinterpret_cast<bf16x8*>(&t4); \
                f32x4 X = R_.P1, O = R_.P2; \
                X = __builtin_amdgcn_mfma_f32_16x16x32_bf16(Aq0, Sb0, X, 0, 0, 0); \
                X = __builtin_amdgcn_mfma_f32_16x16x32_bf16(Aq1, Sb1, X, 0, 0, 0);                   \
                O = __builtin_amdgcn_mfma_f32_16x16x32_bf16(Rq0, Sb0, O, 0, 0, 0); \
                O = __builtin_amdgcn_mfma_f32_16x16x32_bf16(Rq1, Sb1, O, 0, 0, 0);                   \
                u32x2 yb; yb.x = cvt_pk_bf16(X.x, X.y); yb.y = cvt_pk_bf16(X.z, X.w); \
                f32x4 U = {0.f, 0.f, 0.f, 0.f}; \
                U = __builtin_amdgcn_mfma_f32_16x16x16bf16_1k(R_.ttf, *reinterpret_cast<s16x4v*>(&yb), U, 0, 0, 0);     \
                u32x2 ub; ub.x = cvt_pk_bf16(U.x, U.y); ub.y = cvt_pk_bf16(U.z, U.w); \
                const s16x4v Ub = *reinterpret_cast<s16x4v*>(&ub); \
                S0 = __builtin_amdgcn_mfma_f32_16x16x16bf16_1k(R_.k0, R_.vtf, S0, 0, 0, 0); S1 = __builtin_amdgcn_mfma_f32_16x16x16bf16_1k(R_.k1, R_.vtf, S1, 0, 0, 0); \
                S2 = __builtin_amdgcn_mfma_f32_16x16x16bf16_1k(R_.k2, R_.vtf, S2, 0, 0, 0); S3 = __builtin_amdgcn_mfma_f32_16x16x16bf16_1k(R_.k3, R_.vtf, S3, 0, 0, 0); \
                S0 = __builtin_amdgcn_mfma_f32_16x16x16bf16_1k(R_.b0, Ub, S0, 0, 0, 0); S1 = __builtin_amdgcn_mfma_f32_16x16x16bf16_1k(R_.b1, Ub, S1, 0, 0, 0); \
                S2 = __builtin_amdgcn_mfma_f32_16x16x16bf16_1k(R_.b2, Ub, S2, 0, 0, 0); S3 = __builtin_amdgcn_mfma_f32_16x16x16bf16_1k(R_.b3, Ub, S3, 0, 0, 0); \
                O = __builtin_amdgcn_mfma_f32_16x16x16bf16_1k(R_.g3f, Ub, O, 0, 0, 0);                   \
                NEXT_; \
                S0 = S0 * R_.w0; S1 = S1 * R_.w1; S2 = S2 * R_.w2; S3 = S3 * R_.w3; \
                float* op = O32 + (size_t)(NPAD + 16 * (n_) + 4 * kg) * D + h * 64 + 16 * rgw + l15;     \
                op[0] = O.x; op[D] = O.y; op[2 * D] = O.z; op[3 * D] = O.w; } while (0)
            SlotRegs RA, RB;
            CH_LOAD(RA, 0);
            for (int n = 0; n + 1 < RC_NCH; n += 2) {
                CH_COMPUTE(RA, n, CH_LOAD(RB, n + 1));
                if (n + 2 < RC_NCH) { CH_COMPUTE(RB, n + 1, CH_LOAD(RA, n + 2)); } else { CH_COMPUTE(RB, n + 1, (void)0); }
            }
            if (RC_NCH & 1) { CH_COMPUTE(RA, RC_NCH - 1, (void)0); }
            __builtin_amdgcn_s_setprio(0);
#undef CH_WAIT
#undef CH_LOAD
#undef CH_COMPUTE
        } else {
            const int p = wid - 1;
            LAS unsigned char* SC = L + RC_SCR0 + p * RC_SCR;
            const float kkc = F.in(23)[h * 64 + lane], kac = F.in(24)[h * 64 + lane];
            unsigned short cr[16], ck[16], cw[16], ca[16], nvq[4]; float civ[16];
#define RC_LOADS(nn) do { const int r0n = NPAD + 16 * (nn); \
                _Pragma("unroll") for (int e = 0; e < 4; ++e) nvq[e] = V[(size_t)(r0n + 4 * kg + e) * D + h * 64 + 16 * rgw + l15]; \
                _Pragma("unroll") for (int s = 0; s < 16; ++s) { const size_t off = (size_t)(r0n + s) * D + h * 64 + lane; cr[s] = Rr[off]; ck[s] = K[off]; cw[s] = W[off]; ca[s] = A[off]; civ[s] = INV[(size_t)(r0n + s) * 64 + h]; } } while (0)
            RC_LOADS(p);
            for (int n = p; n < RC_NCH; n += 7) {
                const int slot = n & 7; LAS unsigned char* SL = L + slot * RC_SLOT;
                unsigned short vq[4];
#pragma unroll
                for (int e = 0; e < 4; ++e) vq[e] = nvq[e];
#if RC_SYNC
                asm volatile("s_waitcnt lgkmcnt(0)" ::: "memory"); __builtin_amdgcn_s_barrier();
#else
                if (n >= 8) { unsigned sp = 0; while (lds_poll(flags + 8) < (unsigned)(n - 7)) { __builtin_amdgcn_s_sleep(2); if (++sp > (1u << 22)) break; } }
#endif
                asm volatile("" ::: "memory");
                float Wp = 1.f; unsigned btp[8], ktp[8];
#pragma unroll
                for (int hb = 0; hb < 2; ++hb) {
                    unsigned short rq[8], kq[8], wq[8], aq[8]; float iv[8];
#pragma unroll
                    for (int s = 0; s < 8; ++s) { rq[s] = cr[8 * hb + s]; kq[s] = ck[8 * hb + s]; wq[s] = cw[8 * hb + s]; aq[s] = ca[8 * hb + s]; iv[s] = civ[8 * hb + s]; }
                    float btv[8], ktv[8];
#pragma unroll
                    for (int s = 0; s < 8; ++s) {
                        const int t = 8 * hb + s;
                        const float rs = bf2f(rq[s]), ks = bf2f(kq[s]), wsv = bf2f(wq[s]), as = bf2f(aq[s]);
                        const float kk = ks * kkc * iv[s];
                        const float Wprev = Wp; Wp *= wsv; const float iW = __builtin_amdgcn_rcpf(Wp);
                        const float at = -kk * Wprev, rt = rs * Wp, bt = kk * as * iW, kt = ks * (1.f + (as - 1.f) * kac) * iW;
                        *(LAS bf16_t*)(SL + RC_AT + t * 136 + lane * 2) = f2bf(at); *(LAS bf16_t*)(SL + RC_RT + t * 136 + lane * 2) = f2bf(rt);
                        *(LAS bf16_t*)(SC + t * 136 + lane * 2) = f2bf(bt); *(LAS bf16_t*)(SC + 2176 + t * 136 + lane * 2) = f2bf(kt);
                        btv[s] = bt; ktv[s] = kt;
                    }
#pragma unroll
                    for (int s = 0; s < 4; ++s) { btp[4 * hb + s] = cvt_pk_bf16(btv[2 * s], btv[2 * s + 1]); ktp[4 * hb + s] = cvt_pk_bf16(ktv[2 * s], ktv[2 * s + 1]); }
                }
                {
                    LAS u32x2* bq = (LAS u32x2*)(SL + RC_BTT + lane * 40); LAS u32x2* kq2 = (LAS u32x2*)(SL + RC_KTT + lane * 40);
#pragma unroll
                    for (int q = 0; q < 4; ++q) { bq[q] = (u32x2){btp[2 * q], btp[2 * q + 1]}; kq2[q] = (u32x2){ktp[2 * q], ktp[2 * q + 1]}; }
                    *(LAS float*)(SL + RC_WC + lane * 4) = Wp;
                    u32x2 vt; vt.x = (unsigned)vq[0] | ((unsigned)vq[1] << 16); vt.y = (unsigned)vq[2] | ((unsigned)vq[3] << 16);
                    *(LAS u32x2*)(SL + RC_VTF + lane * 8) = vt;
                }
                if (n + 7 < RC_NCH) RC_LOADS(n + 7);
                asm volatile("s_waitcnt lgkmcnt(0)" ::: "memory");
                f32x4 G1 = {0.f, 0.f, 0.f, 0.f}, G2 = G1, G3 = G1, G4 = G1, G1t = G1;
#pragma unroll
                for (int ks = 0; ks < 2; ++ks) {
                    const bf16x8 fb = *(const LAS bf16x8*)(SC + l15 * 136 + (32 * ks + 8 * kg) * 2), fk = *(const LAS bf16x8*)(SC + 2176 + l15 * 136 + (32 * ks + 8 * kg) * 2);
                    const bf16x8 fa = *(const LAS bf16x8*)(SL + RC_AT + l15 * 136 + (32 * ks + 8 * kg) * 2), fr_ = *(const LAS bf16x8*)(SL + RC_RT + l15 * 136 + (32 * ks + 8 * kg) * 2);
                    G1 = __builtin_amdgcn_mfma_f32_16x16x32_bf16(fb, fa, G1, 0, 0, 0); G2 = __builtin_amdgcn_mfma_f32_16x16x32_bf16(fk, fa, G2, 0, 0, 0);
                    G1t = __builtin_amdgcn_mfma_f32_16x16x32_bf16(fa, fb, G1t, 0, 0, 0);
                    G3 = __builtin_amdgcn_mfma_f32_16x16x32_bf16(fb, fr_, G3, 0, 0, 0); G4 = __builtin_amdgcn_mfma_f32_16x16x32_bf16(fk, fr_, G4, 0, 0, 0);
                }
                {
#pragma unroll
                    for (int e = 0; e < 4; ++e) { const int s = 4 * kg + e; const bool lt = s < l15, le = s <= l15;
                        G1[e] = lt ? G1[e] : 0.f; G1t[e] = (l15 < s) ? G1t[e] : 0.f; G2[e] = lt ? G2[e] : 0.f; G3[e] = le ? G3[e] : 0.f; G4[e] = le ? G4[e] : 0.f; }
                    u32x2 g2, g3, g4; g2.x = cvt_pk_bf16(G2.x, G2.y); g2.y = cvt_pk_bf16(G2.z, G2.w); g3.x = cvt_pk_bf16(G3.x, G3.y); g3.y = cvt_pk_bf16(G3.z, G3.w); g4.x = cvt_pk_bf16(G4.x, G4.y); g4.y = cvt_pk_bf16(G4.z, G4.w);
                    *(LAS u32x2*)(SL + RC_G3F + lane * 8) = g3;
                    u32x2 vt; vt.x = (unsigned)vq[0] | ((unsigned)vq[1] << 16); vt.y = (unsigned)vq[2] | ((unsigned)vq[3] << 16);
                    const s16x4v vtf = *reinterpret_cast<s16x4v*>(&vt);
                    f32x4 P1 = {0.f, 0.f, 0.f, 0.f}, P2 = P1;
                    P1 = __builtin_amdgcn_mfma_f32_16x16x16bf16_1k(*reinterpret_cast<s16x4v*>(&g2), vtf, P1, 0, 0, 0);
                    P2 = __builtin_amdgcn_mfma_f32_16x16x16bf16_1k(*reinterpret_cast<s16x4v*>(&g4), vtf, P2, 0, 0, 0);
                    *(LAS f32x4*)(SL + RC_P1 + lane * 16) = P1; *(LAS f32x4*)(SL + RC_P2 + lane * 16) = P2;
#define RC_BF(v) ({ u32x2 t_; t_.x = cvt_pk_bf16((v).x, (v).y); t_.y = cvt_pk_bf16((v).z, (v).w); *reinterpret_cast<s16x4v*>(&t_); })
                    const f32x4 Z4 = {0.f, 0.f, 0.f, 0.f};
                    const s16x4v n1 = RC_BF(G1), n1t = RC_BF(G1t);
                    const f32x4 X2 = __builtin_amdgcn_mfma_f32_16x16x16bf16_1k(n1t, n1, Z4, 0, 0, 0), X2t = __builtin_amdgcn_mfma_f32_16x16x16bf16_1k(n1, n1t, Z4, 0, 0, 0);
                    const s16x4v n2 = RC_BF(X2), n2t = RC_BF(X2t);
                    const f32x4 X4 = __builtin_amdgcn_mfma_f32_16x16x16bf16_1k(n2t, n2, Z4, 0, 0, 0), X4t = __builtin_amdgcn_mfma_f32_16x16x16bf16_1k(n2, n2t, Z4, 0, 0, 0);
                    const s16x4v n4 = RC_BF(X4), n4t = RC_BF(X4t);
                    f32x4 Tm = __builtin_amdgcn_mfma_f32_16x16x16bf16_1k(n4t, n4, Z4, 0, 0, 0);
#pragma unroll
                    for (int e = 0; e < 4; ++e) Tm[e] += (4 * kg + e == l15) ? 1.f : 0.f;
                    Tm = __builtin_amdgcn_mfma_f32_16x16x16bf16_1k(n4t, RC_BF(Tm), Tm, 0, 0, 0);
                    Tm = __builtin_amdgcn_mfma_f32_16x16x16bf16_1k(n2t, RC_BF(Tm), Tm, 0, 0, 0);
                    Tm = __builtin_amdgcn_mfma_f32_16x16x16bf16_1k(n1t, RC_BF(Tm), Tm, 0, 0, 0);
                    { u32x2 tt; tt.x = cvt_pk_bf16(Tm.x, Tm.y); tt.y = cvt_pk_bf16(Tm.z, Tm.w); *(LAS u32x2*)(SL + RC_TT + lane * 8) = tt; }
#undef RC_BF
                }
                asm volatile("s_waitcnt lgkmcnt(0)" ::: "memory");
#if RC_SYNC
                __builtin_amdgcn_s_barrier();
#else
                if (lane == 0) flags[slot] = (unsigned)(n + 1);
#endif
            }
#if RC_SYNC
            if (p >= RC_NCH % 7) { __builtin_amdgcn_s_barrier(); __builtin_amdgcn_s_barrier(); }
#endif
        }
#undef RC_LOADS
        __syncthreads();
    }
}
__device__ __forceinline__ void rwkv_post(const Fr& F) {
    const bf16_t* Rr = slotY(F, 0); const bf16_t* K = slotY(F, 1); const bf16_t* V = slotY(F, 2); const bf16_t* GT = slotY(F, 3); const bf16_t* A = slotY(F, 5);
    const float* O32 = (const float*)slotU(F, 1); bf16_t* Z = slotU(F, 0);
    const float* k_a = F.in(24); const float* r_k = F.in(25); const float* lw = F.in(26); const float* lb = F.in(27);
    for (int r = F.gw; r < R; r += F.NGW) {
        const bool real = (r >= NPAD && r < NREAL);
        u32x2* zr = (u32x2*)(Z + (size_t)r * D) + F.lane;
        if (!real) { const u32x2 z = {0u, 0u};
#pragma unroll
            for (int it = 0; it < 16; ++it) zr[64 * it] = z;
            continue; }
        ROW_F32(oq, O32 + (size_t)r * D, F.lane); ROW_BF(rq_, Rr + (size_t)r * D, F.lane); ROW_BF(kq_, K + (size_t)r * D, F.lane); ROW_BF(vq_, V + (size_t)r * D, F.lane);
        ROW_BF(gq_, GT + (size_t)r * D, F.lane); ROW_BF(aq_, A + (size_t)r * D, F.lane); ROW_BF(zq_, Z + (size_t)r * D, F.lane);
        ROW_F32(kap, k_a, F.lane); ROW_F32(rkp, r_k, F.lane); ROW_F32(lwp, lw, F.lane); ROW_F32(lbp, lb, F.lane);
#pragma unroll
        for (int hh = 0; hh < 2; ++hh) {
            f32x4 o4v[8]; u32x2 rrv[8], kkv[8], vvv[8], ggv[8], aav[8];
#pragma unroll
            for (int i8 = 0; i8 < 8; ++i8) { const int it = 8 * hh + i8; o4v[i8] = AT_F32(oq, it); rrv[i8] = AT_BF(rq_, it); kkv[i8] = AT_BF(kq_, it); vvv[i8] = AT_BF(vq_, it); ggv[i8] = AT_BF(gq_, it); aav[i8] = AT_BF(aq_, it); }
#pragma unroll
            for (int i8 = 0; i8 < 8; ++i8) { const int it = 8 * hh + i8;
                const f32x4 o4 = o4v[i8]; const u32x2 rr = rrv[i8], kk = kkv[i8], vv = vvv[i8], gg = ggv[i8], aa = aav[i8];
                const f32x4 ka4 = AT_F32(kap, it), rk4 = AT_F32(rkp, it), lw4 = AT_F32(lwp, it), lb4 = AT_F32(lbp, it);
                const float mean = red16((o4.x + o4.y) + (o4.z + o4.w)) * (1.f / 64.f);
                const float d0 = o4.x - mean, d1 = o4.y - mean, d2 = o4.z - mean, d3 = o4.w - mean;
                const float var = red16((d0 * d0 + d1 * d1) + (d2 * d2 + d3 * d3)) * (1.f / 64.f);
                const float rs = __builtin_amdgcn_rsqf(var + 64e-5f);
                const float r0 = bflo(rr.x), r1 = bfhi(rr.x), r2 = bflo(rr.y), r3 = bfhi(rr.y);
                const float kp0 = bflo(kk.x) * (1.f + (bflo(aa.x) - 1.f) * ka4.x), kp1 = bfhi(kk.x) * (1.f + (bfhi(aa.x) - 1.f) * ka4.y), kp2 = bflo(kk.y) * (1.f + (bflo(aa.y) - 1.f) * ka4.z), kp3 = bfhi(kk.y) * (1.f + (bfhi(aa.y) - 1.f) * ka4.w);
                const float bs = red16((r0 * kp0 * rk4.x + r1 * kp1 * rk4.y) + (r2 * kp2 * rk4.z + r3 * kp3 * rk4.w));
                const float y0 = d0 * rs * lw4.x + lb4.x + bs * bflo(vv.x), y1 = d1 * rs * lw4.y + lb4.y + bs * bfhi(vv.x), y2 = d2 * rs * lw4.z + lb4.z + bs * bflo(vv.y), y3 = d3 * rs * lw4.w + lb4.w + bs * bfhi(vv.y);
                u32x2 w; w.x = cvt_pk_bf16(y0 * silu_f(bflo(gg.x)), y1 * silu_f(bfhi(gg.x))); w.y = cvt_pk_bf16(y2 * silu_f(bflo(gg.y)), y3 * silu_f(bfhi(gg.y)));
                AT_BF(zq_, it) = w;
            }
        }
    }
}
}
namespace mk {
constexpr int LDS_BYTES = 163840;
constexpr int LDS_MISC = LDS_BYTES - 128;
struct Args { const float* in[29]; float* out; unsigned char* ws; };

#define MK_GEMM(EPI, e, Aptr, aps_, Bptr, M_, N_, K_) do { int kk_ = (K_); asm volatile("" : "+s"(kk_));     \
    pg8::Gemm g_{(const bf16_t*)(Aptr), (const bf16_t*)(Bptr), (M_), (N_), kk_, (size_t)(aps_)}; pg8::StaticOrder S_; S_.init((M_), (N_), F.G, F.bid); \
    pg8::gemm_phase<EPI, pg8::StaticOrder, false>(F.lds, g_, S_, e, nullptr); } while (0)

struct TailOrder { int pn;
    __device__ bool next(int i, pg8::Unit& u) const { if (i > 0 || pn < 0) return false; u.pm = 64; u.pn = pn; return true; }
    __device__ __forceinline__ void a_ready(const pg8::Unit&) const {}
    __device__ __forceinline__ void done(const pg8::Unit&) const {}
};
#define MK_GEMM1(EPI, e, aps_, NTOT_, L_) do { MK_GEMM(EPI, e, slotU(F, 0), aps_, wtin_of(F, L_), 16384, NTOT_, D); \
    if (F.bid < (NTOT_) / 256) { int kk_ = D; asm volatile("" : "+s"(kk_)); pg8::Gemm g_{(const bf16_t*)slotU(F, 0), (const bf16_t*)wtin_of(F, L_), R, (NTOT_), kk_, (size_t)(aps_)}; TailOrder St_{F.bid}; \
        pg8::gemm_phase<EPI, TailOrder, false, true>(F.lds, g_, St_, e, nullptr); } } while (0)
#define MK_GEMM2_NORM(prev, next, udst) do { \
    MK_GEMM(EpiY, ey, slotU(F, 0), 0, wtout, 16384, D, D); \
    GRID_BAR(); \
    if (F.bid < 16) { int kk_ = D; asm volatile("" : "+s"(kk_)); pg8::Gemm g_{(const bf16_t*)slotU(F, 0), (const bf16_t*)wtout, R, D, kk_, (size_t)0}; TailOrder St_{F.bid}; \
        pg8::gemm_phase<EpiY, TailOrder, false, true>(F.lds, g_, St_, ey, nullptr); } \
    else { const Fr P = F.fresh(); norm_phase(P, prev, next, slotY(P, 0), udst, 0, 16384, 16); } \
    GRID_BAR(); \
    { const Fr P = F.fresh(); norm_phase(P, prev, next, slotY(P, 0), udst, 16384, R, 0); if ((next) >= 0) convert_layer(P, next, (next) == 3); } \
    GRID_BAR(); } while (0)

__global__ void __launch_bounds__(512, 2) fwd(Args a) {
    extern __shared__ __attribute__((aligned(16))) unsigned char lds_raw[];
    Fr F;
    F.lds = (LAS unsigned char*)lds_raw; F.ldsg = lds_raw;
    F.tid = threadIdx.x; F.lane = F.tid & 63; F.wave = __builtin_amdgcn_readfirstlane(F.tid >> 6);
    F.G = gridDim.x; F.bid = blockIdx.x; F.gw = F.bid * 8 + F.wave; F.NGW = F.G * 8;
    F.out = a.out; F.ws = a.ws;
    volatile LAS unsigned* misc = (volatile LAS unsigned*)(F.lds + LDS_MISC);
    if (F.tid < 16) misc[F.tid] = 0u;
    __syncthreads();
    XcdBarrier bar = xcd_barrier_post((unsigned*)(F.ws + WS_CTL) + 4096, misc + 8);
#define GRID_BAR() xcd_barrier(bar)
#ifndef MK_DUP
#define MK_DUP 0
#endif
#define DUPN(k, ...) do { __VA_ARGS__; if ((MK_DUP >> (k)) & 1) { GRID_BAR(); __VA_ARGS__; } } while (0)
    bf16_t* wtout = (bf16_t*)(F.ws + WS_WTOUT);
    const EpiY ey{slotY(F, 0)};

    DUPN(11, { const Fr P = F.fresh(); convert_layer(P, 0, true); rope_table(P); norm_phase(P, -1, 0, nullptr, slotU(P, 0)); });
    GRID_BAR();
    { const EpiH1 e{slotY(F, 0), F.in(5), 0}; MK_GEMM1(EpiH1, e, 0, 4 * D, 0); }
    if (F.bid >= 64) { const Fr P = F.fresh(); convert_win(P, 1, 64); }
    GRID_BAR();
    DUPN(1, { const Fr P = F.fresh(); hgrn_phase<false>(P, 0); });
    GRID_BAR();
    DUPN(2, { const Fr P = F.fresh(); hgrn_phase<true>(P, 0); });
    GRID_BAR();
    MK_GEMM2_NORM(0, 1, slotU(F, 0));
    { const EpiB1 e{slotY(F, 0), (const float*)(F.ws + WS_ROPE), (const float*)(F.ws + WS_ROPE) + (size_t)R * 16}; MK_GEMM1(EpiB1, e, 0, 4 * D, 1); }
    if (F.bid >= 64) { const Fr P = F.fresh(); convert_win(P, 2, 64); }
    GRID_BAR();
    DUPN(3, { const Fr P = F.fresh(); attn_phase(P); });
    GRID_BAR();
    DUPN(4, { const Fr P = F.fresh(); attn_post(P); });
    GRID_BAR();
    MK_GEMM2_NORM(1, 2, slotY(F, 1));
    DUPN(7, { const Fr P = F.fresh(); mix_phase(P, slotY(P, 1)); convert_layer2_b(P); });
    GRID_BAR();
    { const EpiC1 e{slotY(F, 0), (bf16_t*)(F.ws + WS_T)}; MK_GEMM(EpiC1, e, slotU(F, 0), (size_t)R * D, wtin_of(F, 2), R, 4 * D + 512, D); }
    GRID_BAR();
    DUPN(9, { const EpiC2 e{slotY(F, 0), F.in(17), F.in(20)}; MK_GEMM(EpiC2, e, F.ws + WS_T, 0, F.ws + WS_W2P, R, 2 * D, 256); });
    { const Fr P = F.fresh(); rwkv_kknorm(P); }
    GRID_BAR();
    DUPN(5, { const Fr P = F.fresh(); rwkv_scan(P); });
    GRID_BAR();
    DUPN(6, { const Fr P = F.fresh(); rwkv_post(P); });
    GRID_BAR();
    MK_GEMM2_NORM(2, 3, slotU(F, 0));
    { const EpiH1 e{slotY(F, 0), F.in(5), 1}; MK_GEMM1(EpiH1, e, 0, 4 * D, 3); }
    GRID_BAR();
    { const Fr P = F.fresh(); hgrn_phase<false>(P, 1); }
    GRID_BAR();
    { const Fr P = F.fresh(); hgrn_phase<true>(P, 1); }
    GRID_BAR();
    MK_GEMM2_NORM(3, -1, (bf16_t*)nullptr);
}
}

extern "C" void kernel_launch(void* const* d_in, const int* in_sizes, int n_in, void* d_out, int out_size, void* d_ws, size_t ws_size, hipStream_t stream) {
    static int grid = 0;
    if (grid == 0) {
        if (n_in != 29 || out_size != 16384 * 4096 || ws_size < mk::WS_END) { fprintf(stderr, "kernel_launch: unexpected shapes (n_in %d out %d ws %zu need %zu)\n", n_in, out_size, ws_size, (size_t)mk::WS_END); grid = -1; return; }
        int dev = 0, cus = 0, per_cu = 0;
        if (hipGetDevice(&dev) != hipSuccess || hipDeviceGetAttribute(&cus, hipDeviceAttributeMultiprocessorCount, dev) != hipSuccess) { grid = -1; return; }
        if (hipFuncSetAttribute((const void*)mk::fwd, hipFuncAttributeMaxDynamicSharedMemorySize, mk::LDS_BYTES) != hipSuccess) { fprintf(stderr, "kernel_launch: hipFuncSetAttribute failed\n"); grid = -1; return; }
        if (hipOccupancyMaxActiveBlocksPerMultiprocessor(&per_cu, (const void*)mk::fwd, 512, mk::LDS_BYTES) != hipSuccess || per_cu < 1) { fprintf(stderr, "kernel_launch: occupancy query says %d\n", per_cu); }
        (void)hipGetLastError();
        grid = cus;
    }
    if (grid < 0) return;
    if (hipMemsetAsync((char*)d_ws + mk::WS_CTL, 0, mk::CTL_BYTES, stream) != hipSuccess) return;
    mk::Args a{};
    for (int i = 0; i < 29; ++i) a.in[i] = (const float*)d_in[i];
    a.out = (float*)d_out; a.ws = (unsigned char*)d_ws;
    hipLaunchKernelGGL(mk::fwd, dim3(grid), dim3(512), mk::LDS_BYTES, stream, a);
}
```

```cpp
#include <hip/hip_runtime.h>
#include <cstdio>
#include <cstdint>

#define LAS __attribute__((address_space(3)))
#define GAS __attribute__((address_space(1)))
typedef unsigned short bf16_t;
typedef short bf16x8 __attribute__((ext_vector_type(8)));
typedef short s16x4 __attribute__((ext_vector_type(4)));
typedef float f32x4 __attribute__((ext_vector_type(4)));
typedef float f32x16 __attribute__((ext_vector_type(16)));
typedef unsigned u32x4 __attribute__((ext_vector_type(4)));
typedef unsigned u32x2 __attribute__((ext_vector_type(2)));

namespace mk {
constexpr int D = 4096, NPAD = 48, NREAL = 16448, R = 16640, NCH = 257;
constexpr size_t MiB = 1u << 20;
constexpr size_t SLOT = (size_t)R * D * 2;
constexpr size_t WS_CTL = 0, CTL_BYTES = 1 * MiB;
constexpr size_t WS_WTIN = 2 * MiB;
constexpr size_t WS_WTOUT = 134 * MiB;
constexpr size_t WS_W2P = 166 * MiB;
constexpr size_t WS_ROPE = 170 * MiB;
constexpr size_t WS_HMETA = 174 * MiB;
constexpr size_t WS_HE = 175 * MiB;
constexpr size_t WS_HLOGD = 191 * MiB;
constexpr size_t WS_U = 192 * MiB;
constexpr size_t WS_Y = WS_U + 6 * SLOT;
constexpr size_t WS_T = WS_Y + 6 * SLOT;
constexpr size_t WS_WTINB = WS_U + 4 * SLOT;
constexpr size_t WS_HB = (WS_T + (size_t)R * 256 * 2 + MiB - 1) / MiB * MiB;
constexpr size_t WS_END = WS_HB + SLOT;
static_assert(WS_END <= 2040 * MiB, "d_ws map");

typedef __bf16 bf16x2n_t __attribute__((ext_vector_type(2)));
typedef float f32x2n_t __attribute__((ext_vector_type(2)));
__device__ __forceinline__ unsigned cvt_pk_bf16(float lo, float hi) { const f32x2n_t v = {lo, hi}; const bf16x2n_t r = __builtin_convertvector(v, bf16x2n_t); return __builtin_bit_cast(unsigned, r); }
__device__ __forceinline__ float bflo(unsigned w) { return __uint_as_float(w << 16); }
__device__ __forceinline__ float bfhi(unsigned w) { return __uint_as_float(w & 0xffff0000u); }
__device__ __forceinline__ float bf2f(bf16_t b) { return __uint_as_float(((unsigned)b) << 16); }
__device__ __forceinline__ bf16_t f2bf(float f) { return (bf16_t)(cvt_pk_bf16(f, f) & 0xffffu); }
__device__ __forceinline__ float sigmoid_f(float x) { return 1.f / (1.f + __expf(-x)); }
__device__ __forceinline__ float silu_f(float x) { return x / (1.f + __expf(-x)); }
__device__ __forceinline__ float wave_sum(float v) {
#pragma unroll
    for (int o = 1; o < 64; o <<= 1) v += __shfl_xor(v, o);
    return v;
}
template <int CTRL> __device__ __forceinline__ float dppf(float v) { return __int_as_float(__builtin_amdgcn_update_dpp(0, __float_as_int(v), CTRL, 0xf, 0xf, true)); }
__device__ __forceinline__ float red4(float v) { v += dppf<0xB1>(v); v += dppf<0x4E>(v); return v; }
__device__ __forceinline__ float red8(float v) { v = red4(v); v += dppf<0x141>(v); return v; }
__device__ __forceinline__ float red16(float v) { v = red8(v); v += dppf<0x140>(v); return v; }
#define LDS_WAIT() asm volatile("s_waitcnt lgkmcnt(0)" ::: "memory")
}
#define XB_TMO      128
#define XB_XCNT(j)  (256  + 64 * (j))
#define XB_XSUB(j)  (1280 + 64 * (j))
#define XB_XGEN(j)  (2304 + 64 * (j))
#define XB_TOP      3328
#define XB_TOPGEN   3392
#define XCD_BAR_WORDS 3456
#define XB_SPIN_CAP (1u << 18)
#define LAS __attribute__((address_space(3)))

__device__ __forceinline__ unsigned xb_ld(unsigned* p)              { return __hip_atomic_load(p, __ATOMIC_RELAXED, __HIP_MEMORY_SCOPE_AGENT); }
__device__ __forceinline__ unsigned xb_add(unsigned* p, unsigned v) { return __hip_atomic_fetch_add(p, v, __ATOMIC_RELAXED, __HIP_MEMORY_SCOPE_AGENT); }
__device__ __forceinline__ unsigned xb_xcc_id() { return (unsigned)__builtin_amdgcn_s_getreg((3 << 11) | 20) & 0xFu; }
#define XB_SPIN(cond, bar) do { unsigned _sp = 0; while (cond) { __builtin_amdgcn_s_sleep(1); \
    if ((++_sp & 255u) == 0u) { if (xb_ld(&(bar)[XB_TMO])) break; if (_sp > XB_SPIN_CAP) { atomicAdd(&(bar)[XB_TMO], 1u); break; } } } } while (0)

struct XcdBarrier {
    unsigned* bar; unsigned x;
    volatile LAS unsigned* st;
};

__device__ __forceinline__ XcdBarrier xcd_barrier_post(unsigned* bar, volatile LAS unsigned* st) {
    XcdBarrier b; b.bar = bar; b.x = xb_xcc_id(); b.st = st;
    if (threadIdx.x == 0) (void)xb_add(&bar[XB_XCNT(b.x)], 1u);
    return b;
}
__device__ __forceinline__ void xcd_barrier_complete(unsigned* bar, unsigned x, unsigned& nloc, unsigned& nx) {
    const unsigned G = gridDim.x * gridDim.y * gridDim.z;
    unsigned sum, cnt, mine, sp = 0u;
    for (;;) {
        sum = 0u; cnt = 0u; mine = 0u;
#pragma unroll
        for (unsigned j = 0; j < 16; ++j) { const unsigned c = xb_ld(&bar[XB_XCNT(j)]); sum += c; cnt += (c > 0u) ? 1u : 0u; mine = (j == x) ? c : mine; }
        if (sum == G) break;
        __builtin_amdgcn_s_sleep(1);
        if ((++sp & 255u) == 0u) { if (xb_ld(&bar[XB_TMO])) break; if (sp > XB_SPIN_CAP) { atomicAdd(&bar[XB_TMO], 1u); break; } }
    }
    nloc = mine > 0u ? mine : 1u; nx = cnt > 0u ? cnt : 1u;
}

__device__ __forceinline__ void xcd_barrier(const XcdBarrier& b) {
    asm volatile("s_waitcnt vmcnt(0)" ::: "memory");
    __syncthreads();
    if (threadIdx.x == 0) {
        unsigned* bar = b.bar;
        __builtin_amdgcn_s_waitcnt(0);
        unsigned nloc = b.st[0], nx = b.st[1];
        if (nloc == 0u) { xcd_barrier_complete(bar, b.x, nloc, nx); b.st[0] = nloc; b.st[1] = nx; }
        const unsigned old = xb_add(&bar[XB_XSUB(b.x)], 1u);
        const unsigned gen = old / nloc;
        if (old + 1u == (gen + 1u) * nloc) {
            __builtin_amdgcn_fence(__ATOMIC_RELEASE, "agent");
            asm volatile("s_waitcnt vmcnt(0)" ::: "memory");
            const unsigned og = xb_add(&bar[XB_TOP], 1u);
            const unsigned tg = og / nx;
            if (og + 1u == (tg + 1u) * nx) xb_add(&bar[XB_TOPGEN], 1u);
            else XB_SPIN(xb_ld(&bar[XB_TOPGEN]) == tg, bar);
            __builtin_amdgcn_fence(__ATOMIC_ACQUIRE, "agent");
            xb_add(&bar[XB_XGEN(b.x)], 1u);
            asm volatile("s_waitcnt vmcnt(0)" ::: "memory");
        } else {
            XB_SPIN(xb_ld(&bar[XB_XGEN(b.x)]) == gen, bar);
            __builtin_amdgcn_fence(__ATOMIC_ACQUIRE, "agent");
            asm volatile("s_waitcnt vmcnt(0)" ::: "memory");
        }
    }
    __syncthreads();
}
namespace pg8 {
#define PG8_LAS __attribute__((address_space(3)))
typedef unsigned short bf16_t;
typedef short bf16x8 __attribute__((ext_vector_type(8)));
typedef float f32x4 __attribute__((ext_vector_type(4)));
typedef unsigned u32x4 __attribute__((ext_vector_type(4)));
constexpr int BM = 256, BK = 64, HALF = 128, HTB = HALF * BK * 2  , STAGE_BYTES = 8 * HTB, NXCD = 8, WGM = 8;

__host__ __device__ __forceinline__ int lds_byte(int r, int c) { const int st = (r >> 4) * 2 + (c >> 5), rr = r & 15, cc = c & 31, ob = rr * 64 + cc * 2; return st * 1024 + (ob ^ (((ob >> 9) & 1) << 5)); }
__host__ __device__ __forceinline__ void stage_rc(int b, int& R, int& C) { const int st = b / 1024, sb = b % 1024, swz = sb ^ (((sb >> 9) & 1) << 5); R = (st >> 1) * 16 + swz / 64; C = (st & 1) * 32 + (swz % 64) / 2; }
__host__ __device__ __forceinline__ int perm32(int rho) { const int n = rho >> 4, i = rho & 15; return 8 * (i >> 2) + 4 * n + (i & 3); }

struct Unit { int pm, pn; };
struct Gemm { const bf16_t* A; const bf16_t* Bt; int M, N, K; size_t aps; };
__device__ __forceinline__ size_t a_part_bytes(const Gemm& g, int pn) { return g.aps ? (size_t)(pn < 64 ? (pn >> 4) : (pn - 60)) * g.aps * 2 : (size_t)0; }

struct StaticOrder {
    int nM, nN, nwg, G, c;
    __host__ __device__ void init(int M, int N, int G_, int c_) { nM = M / BM; nN = N / BM; nwg = nM * nN; G = G_; c = c_; }
    __host__ __device__ bool next(int i, Unit& u) const {
        const long L = (long)i * G + c; if (L >= nwg) return false;
        int wgid = (int)L; { const int q = nwg / NXCD, r = nwg % NXCD, xcd = wgid % NXCD, off = wgid / NXCD; wgid = (xcd < r ? xcd * (q + 1) : r * (q + 1) + (xcd - r) * q) + off; }
        const int nig = WGM * nN, gid = wgid / nig, fm = gid * WGM, gsz = (nM - fm) < WGM ? (nM - fm) : WGM;
        u.pm = fm + ((wgid % nig) % gsz); u.pn = (wgid % nig) / gsz; return true;
    }
    __device__ __forceinline__ void a_ready(const Unit&) const {}
    __device__ __forceinline__ void done(const Unit&) const {}
};
struct CountedOrder : StaticOrder {
    const unsigned* ready; unsigned need; unsigned* tmo;
    __device__ __forceinline__ void a_ready(const Unit& u) const {
        if (threadIdx.x < 64) {
            const unsigned long long t0 = __builtin_amdgcn_s_memrealtime(); unsigned polls = 0;
            while ((unsigned)__builtin_amdgcn_readfirstlane(__hip_atomic_load(ready + 64 * u.pm, __ATOMIC_RELAXED, __HIP_MEMORY_SCOPE_AGENT)) < need) {
                if ((++polls & 255u) == 0u && __builtin_amdgcn_readfirstlane(__hip_atomic_load(tmo, __ATOMIC_RELAXED, __HIP_MEMORY_SCOPE_AGENT)) != 0u) break;
                if (__builtin_amdgcn_s_memrealtime() - t0 > 2000000ull) {
                    if (threadIdx.x == 0) { unsigned expect = 0u; __hip_atomic_compare_exchange_strong(tmo + 1, &expect, 0x600u | (unsigned)(u.pm & 0xff), __ATOMIC_RELAXED, __ATOMIC_RELAXED, __HIP_MEMORY_SCOPE_AGENT); __hip_atomic_store(tmo, 1u, __ATOMIC_RELAXED, __HIP_MEMORY_SCOPE_AGENT); }
                    break; }
                __builtin_amdgcn_s_sleep(2); }
            __builtin_amdgcn_fence(__ATOMIC_ACQUIRE, "agent");
            asm volatile("s_waitcnt vmcnt(0)" ::: "memory");
        }
#if !defined(BROKEN_HOOK_NO_BARRIER)
        asm volatile("" ::: "memory"); __builtin_amdgcn_s_barrier(); asm volatile("" ::: "memory");
#endif
    }
};
template <class Epi, class Sched, bool STAMP = false, bool TOPHALF = false>
__device__ __forceinline__ void gemm_phase(PG8_LAS unsigned char* lds, const Gemm g, const Sched& S, const Epi& E, unsigned long long* stamps) {
    int tid_ = threadIdx.x; asm volatile("" : "+v"(tid_));
    const int tid = tid_, wid = __builtin_amdgcn_readfirstlane(tid >> 6), lane = tid & 63, wr = wid >> 2, wc = wid & 3, fr = lane & 15, fq = lane >> 4;
    const int K = g.K, nt = K / BK;
    int ts_lo = 0, ts_hi = 0, nts = 0; const unsigned long long rt_entry = STAMP ? (unsigned long long)wall_clock64() : 0ull;
#define PG8_STAMP() do { if (STAMP && wid == 0 && nts < 64) { const unsigned long long _c = (unsigned long long)clock64(); \
        ts_lo = (lane == nts) ? (int)(unsigned)_c : ts_lo; ts_hi = (lane == nts) ? (int)(unsigned)(_c >> 32) : ts_hi; ++nts; } } while (0)
    PG8_STAMP();
    unsigned voffA[2], voffB[2];
#pragma unroll
    for (int i = 0; i < 2; ++i) { int R, C; stage_rc(tid * 16 + i * 8192, R, C); const int Rb = Epi::PERM ? ((R & ~31) + perm32(R & 31)) : R;
        voffA[i] = (unsigned)(R * K + C) * 2u; voffB[i] = (unsigned)(Rb * K + C) * 2u; }
    const size_t kstep = (size_t)(BK * 2);
    const size_t hstep = (size_t)HALF * K * 2;
    const size_t tstep = 2 * hstep;
    const unsigned ldsw = (unsigned)wid * 1024u;
    const int aoff = lds_byte(wr * 64 + fr, fq * 8), boff = lds_byte(wc * 32 + fr, fq * 8);
#define PG8_SA(b, h) (((b) * 2 + (h)) * HTB)
#define PG8_SB(b, h) ((4 + (b) * 2 + (h)) * HTB)
#define PG8_STAGE(bufoff, gbase, voff) do { _Pragma("unroll") for (int _i = 0; _i < 2; ++_i) \
        __builtin_amdgcn_global_load_lds((const unsigned*)((const char*)(gbase) + (voff)[_i]), (PG8_LAS unsigned*)(lds + (bufoff) + ldsw + _i * 8192), 16, 0, 0); } while (0)
#define PG8_LDA(dst, b, h) do { _Pragma("unroll") for (int m = 0; m < 4; ++m) _Pragma("unroll") for (int k = 0; k < 2; ++k) dst[m][k] = *(const PG8_LAS bf16x8*)(lds + PG8_SA(b, h) + aoff + m * 2048 + k * 1024); } while (0)
#define PG8_LDB(dst, b, h) do { _Pragma("unroll") for (int n = 0; n < 2; ++n) _Pragma("unroll") for (int k = 0; k < 2; ++k) dst[n][k] = *(const PG8_LAS bf16x8*)(lds + PG8_SB(b, h) + boff + n * 2048 + k * 1024); } while (0)
#define PG8_MMA(ai, bj, At, Bt) do { __builtin_amdgcn_s_setprio(1); _Pragma("unroll") for (int m = 0; m < 4; ++m) _Pragma("unroll") for (int n = 0; n < 2; ++n) _Pragma("unroll") for (int k = 0; k < 2; ++k) \
        acc[ai][bj][m][n] = __builtin_amdgcn_mfma_f32_16x16x32_bf16(Bt[n][k], At[m][k], acc[ai][bj][m][n], 0, 0, 0); __builtin_amdgcn_s_setprio(0); } while (0)
#define PG8_WAIT_V(n) asm volatile("s_waitcnt vmcnt(" #n ")" ::: "memory")
#define PG8_WAIT_L(n) asm volatile("s_waitcnt lgkmcnt(" #n ")" ::: "memory")
#define PG8_BAR __builtin_amdgcn_s_barrier()
#define PG8_SCHED __builtin_amdgcn_sched_barrier(0)
    Unit cur, nxt; int ui = 0;
    if (!S.next(0, cur)) return;
    f32x4 acc[2][2][4][2];
#pragma unroll
    for (int a = 0; a < 2; ++a)
#pragma unroll
        for (int b = 0; b < 2; ++b)
#pragma unroll
            for (int m = 0; m < 4; ++m)
#pragma unroll
                for (int n = 0; n < 2; ++n) acc[a][b][m][n] = (f32x4){0.f, 0.f, 0.f, 0.f};
    bf16x8 At[4][2], B0[2][2], B1[2][2];
    const char* cA = (const char*)g.A + a_part_bytes(g, cur.pn) + (size_t)cur.pm * tstep; const char* cB = (const char*)g.Bt + (size_t)cur.pn * tstep;
    S.a_ready(cur);
    PG8_STAGE(PG8_SB(0, 0), cB, voffB); PG8_STAGE(PG8_SA(0, 0), cA, voffA); PG8_STAGE(PG8_SB(0, 1), cB + hstep, voffB); PG8_STAGE(PG8_SA(0, 1), cA + hstep, voffA);
    if (wr == 1) PG8_BAR;
    PG8_WAIT_V(4); PG8_BAR;
    PG8_STAGE(PG8_SB(1, 0), cB + kstep, voffB); PG8_STAGE(PG8_SA(1, 0), cA + kstep, voffA); PG8_STAGE(PG8_SB(1, 1), cB + hstep + kstep, voffB);
    PG8_WAIT_V(6); PG8_BAR;
    PG8_STAMP();
#ifdef MK_KPROBE
    unsigned long long kp_a_ = 0ull, kp_prev_ = 0ull;
#endif
    for (;;) {
#ifdef MK_KPROBE
        if (MK_KPROBE == 1 && ui == 2) kp_a_ = clock64();
#endif
        const bool has_next = S.next(ui + 1, nxt);
        const char* nA = has_next ? (const char*)g.A + a_part_bytes(g, nxt.pn) + (size_t)nxt.pm * tstep : cA; const char* nB = has_next ? (const char*)g.Bt + (size_t)nxt.pn * tstep : cB;
        for (int t = 0; t < nt; t += 2) {
            const bool last = (t == nt - 2);
            const char* a1 = cA + (size_t)(t + 1) * kstep;
            const char* a2 = last ? nA : cA + (size_t)(t + 2) * kstep; const char* b2 = last ? nB : cB + (size_t)(t + 2) * kstep;
            const char* a3 = a2 + kstep; const char* b3 = b2 + kstep;
            if (last && has_next) S.a_ready(nxt);
            PG8_LDB(B0, 0, 0); PG8_SCHED; PG8_LDA(At, 0, 0); PG8_STAGE(PG8_SA(1, 1), a1 + hstep, voffA);
            PG8_WAIT_L(8); PG8_BAR; PG8_WAIT_L(0); PG8_MMA(0, 0, At, B0); PG8_BAR; PG8_SCHED;
            PG8_LDB(B1, 0, 1); PG8_STAGE(PG8_SB(0, 0), b2, voffB);
            PG8_BAR; PG8_WAIT_L(0); PG8_MMA(0, 1, At, B1); PG8_BAR;
            if constexpr (!TOPHALF) PG8_LDA(At, 0, 1); PG8_STAGE(PG8_SA(0, 0), a2, voffA);
            PG8_BAR; PG8_WAIT_L(0); if constexpr (!TOPHALF) PG8_MMA(1, 0, At, B0); PG8_BAR; PG8_SCHED;
            PG8_STAGE(PG8_SB(0, 1), b2 + hstep, voffB);
            PG8_WAIT_V(6); PG8_BAR; if constexpr (!TOPHALF) PG8_MMA(1, 1, At, B1); PG8_BAR;
            PG8_LDB(B0, 1, 0); PG8_SCHED; PG8_LDA(At, 1, 0); PG8_STAGE(PG8_SA(0, 1), a2 + hstep, voffA);
            PG8_WAIT_L(8); PG8_BAR; PG8_WAIT_L(0); PG8_MMA(0, 0, At, B0); PG8_BAR; PG8_SCHED;
            PG8_LDB(B1, 1, 1); PG8_STAGE(PG8_SB(1, 0), b3, voffB);
            PG8_BAR; PG8_WAIT_L(0); PG8_MMA(0, 1, At, B1); PG8_BAR;
            if constexpr (!TOPHALF) PG8_LDA(At, 1, 1); PG8_STAGE(PG8_SA(1, 0), a3, voffA);
            PG8_BAR; PG8_WAIT_L(0); if constexpr (!TOPHALF) PG8_MMA(1, 0, At, B0); PG8_BAR; PG8_SCHED;
            PG8_STAGE(PG8_SB(1, 1), b3 + hstep, voffB);
            PG8_WAIT_V(6); PG8_BAR; if constexpr (!TOPHALF) PG8_MMA(1, 1, At, B1); PG8_BAR;
        }
        PG8_STAMP();
#ifdef MK_KPROBE
        { const unsigned long long now_ = clock64();
          if (ui == 2 && tid == 0) *(volatile PG8_LAS unsigned*)(lds + 163712 + 80) = (unsigned)(now_ - (MK_KPROBE == 1 ? kp_a_ : kp_prev_));
          kp_prev_ = now_; }
#endif
        if constexpr (!Epi::AFTER_DRAIN) { E(acc, cur, wr, wc, fr, fq); S.done(cur); }
        PG8_STAMP();
        if (!has_next) break;
#pragma unroll
        for (int a = 0; a < 2; ++a)
#pragma unroll
            for (int b = 0; b < 2; ++b)
#pragma unroll
                for (int m = 0; m < 4; ++m)
#pragma unroll
                    for (int n = 0; n < 2; ++n) acc[a][b][m][n] = (f32x4){0.f, 0.f, 0.f, 0.f};
        cur = nxt; cA = nA; cB = nB; ++ui;
    }
    PG8_WAIT_V(0);
    if (wr == 0) PG8_BAR;
    PG8_BAR;
    if constexpr (Epi::AFTER_DRAIN) { E.fused(acc, cur, wr, wc, fr, fq, lds, wid, lane); S.done(cur); }
    PG8_STAMP();
    if (STAMP && wid == 0) { stamps[lane] = lane < nts ? (((unsigned long long)(unsigned)ts_hi << 32) | (unsigned)ts_lo) : 0ull;
        if (lane == 62) stamps[62] = rt_entry; if (lane == 63) stamps[63] = (unsigned long long)wall_clock64(); }
#undef PG8_STAMP
#undef PG8_SA
#undef PG8_SB
#undef PG8_STAGE
#undef PG8_LDA
#undef PG8_LDB
#undef PG8_MMA
#undef PG8_WAIT_V
#undef PG8_WAIT_L
#undef PG8_BAR
#undef PG8_SCHED
}
}
namespace mk {
typedef pg8::Unit Unit;
typedef const pg8::f32x4 (&AccRef)[2][2][4][2];

__device__ __forceinline__ void st_bf8(bf16_t* p, pg8::f32x4 v0, pg8::f32x4 v1) {
    u32x4 w; w.x = cvt_pk_bf16(v0[0], v0[1]); w.y = cvt_pk_bf16(v0[2], v0[3]); w.z = cvt_pk_bf16(v1[0], v1[1]); w.w = cvt_pk_bf16(v1[2], v1[3]);
    *(u32x4*)p = w;
#ifdef MK_ST2
    asm volatile("" ::: "memory"); *(u32x4*)p = w; asm volatile("" ::: "memory");
#endif
}
__device__ __forceinline__ void st_bf4(bf16_t* p, pg8::f32x4 v) { u32x2 w; w.x = cvt_pk_bf16(v[0], v[1]); w.y = cvt_pk_bf16(v[2], v[3]); *(u32x2*)p = w; }

struct EpiY {
    static constexpr bool PERM = true, AFTER_DRAIN = false;
    bf16_t* O;
    __device__ __forceinline__ void operator()(AccRef acc, const Unit& u, int wr, int wc, int fr, int fq) const {
        const int row0 = u.pm * 256 + wr * 64 + fr, col0 = u.pn * 256 + wc * 32 + 8 * fq;
#pragma unroll
        for (int ai = 0; ai < 2; ++ai)
#pragma unroll
            for (int m = 0; m < 4; ++m) { bf16_t* rowp = O + (size_t)(row0 + ai * 128 + m * 16) * D + col0;
#pragma unroll
                for (int bj = 0; bj < 2; ++bj) st_bf8(rowp + bj * 128, acc[ai][bj][m][0], acc[ai][bj][m][1]); }
    }
};
struct EpiH1 {
    static constexpr bool PERM = true, AFTER_DRAIN = false;
    bf16_t* Y; const float* lbl; int jl;
    __device__ __forceinline__ void operator()(AccRef acc, const Unit& u, int wr, int wc, int fr, int fq) const {
        const int part = u.pn >> 4, colt = (u.pn & 15) * 256;
        const int row0 = u.pm * 256 + wr * 64 + fr, col0 = colt + wc * 32 + 8 * fq;
        if (part == 1) {
#pragma unroll
            for (int bj = 0; bj < 2; ++bj) {
                pg8::f32x4 lbv[2] = {{0.f, 0.f, 0.f, 0.f}, {0.f, 0.f, 0.f, 0.f}};
                if (jl) {
#pragma unroll
                    for (int n = 0; n < 2; ++n) { const pg8::f32x4 l0 = *(const pg8::f32x4*)(lbl + col0 + bj * 128 + 4 * n), l1 = *(const pg8::f32x4*)(lbl + D + col0 + bj * 128 + 4 * n);
#pragma unroll
                        for (int j = 0; j < 4; ++j) lbv[n][j] = sigmoid_f(l1[j] - l0[j]); }
                }
#pragma unroll
                for (int ai = 0; ai < 2; ++ai)
#pragma unroll
                    for (int m = 0; m < 4; ++m) {
                        const int row = row0 + ai * 128 + m * 16;
                        pg8::f32x4 o[2];
#pragma unroll
                        for (int n = 0; n < 2; ++n)
#pragma unroll
                            for (int j = 0; j < 4; ++j) {
                                const float x = acc[ai][bj][m][n][j]; float g;
                                if (jl) { const float l = lbv[n][j]; g = __logf(l + (1.f - l) * sigmoid_f(x)); }
                                else g = fminf(x, 0.f) - __logf(1.f + __expf(-fabsf(x)));
                                o[n][j] = (row < NPAD) ? 0.f : g;
                            }
                        float* gp = (float*)(Y + 3 * (SLOT / 2)) + (size_t)row * D + col0 + bj * 128;
                        *(pg8::f32x4*)gp = o[0]; *(pg8::f32x4*)(gp + 4) = o[1];
                    }
            }
        } else {
            bf16_t* dst = Y + (size_t)(part == 0 ? 0 : (part == 2 ? 1 : 2)) * (SLOT / 2);
#pragma unroll
            for (int ai = 0; ai < 2; ++ai)
#pragma unroll
                for (int m = 0; m < 4; ++m) { bf16_t* rowp = dst + (size_t)(row0 + ai * 128 + m * 16) * D + col0;
#pragma unroll
                    for (int bj = 0; bj < 2; ++bj) st_bf8(rowp + bj * 128, acc[ai][bj][m][0], acc[ai][bj][m][1]); }
        }
    }
};
struct EpiB1 {
    static constexpr bool PERM = false, AFTER_DRAIN = false;
    bf16_t* Y; const float* cs; const float* sn;
    __device__ __forceinline__ void operator()(AccRef acc, const Unit& u, int wr, int wc, int fr, int fq) const {
        const int part = u.pn >> 4, colt = (u.pn & 15) * 256;
        const int row0 = u.pm * 256 + wr * 64 + fr, col0 = colt + wc * 32 + 4 * fq;
        bf16_t* dst = Y + (size_t)part * (SLOT / 2);
        const bool rope = (part < 2) && (wc == 0);
        pg8::f32x4 c4a[2][4], s4a[2][4];
#pragma unroll
        for (int ai = 0; ai < 2; ++ai)
#pragma unroll
            for (int m = 0; m < 4; ++m) { c4a[ai][m] = (pg8::f32x4){1.f, 1.f, 1.f, 1.f}; s4a[ai][m] = (pg8::f32x4){0.f, 0.f, 0.f, 0.f}; }
        if (rope) {
#pragma unroll
            for (int ai = 0; ai < 2; ++ai)
#pragma unroll
                for (int m = 0; m < 4; ++m) { const int row = row0 + ai * 128 + m * 16;
                    c4a[ai][m] = *(const pg8::f32x4*)(cs + (size_t)row * 16 + 4 * fq); s4a[ai][m] = *(const pg8::f32x4*)(sn + (size_t)row * 16 + 4 * fq); }
        }
#pragma unroll
        for (int ai = 0; ai < 2; ++ai)
#pragma unroll
            for (int m = 0; m < 4; ++m) {
                const int row = row0 + ai * 128 + m * 16;
                const pg8::f32x4 c4 = c4a[ai][m], s4 = s4a[ai][m];
                bf16_t* rowp = dst + (size_t)row * D + (col0 - 4 * fq) + ((fq & 1) ? 12 + 4 * fq : 4 * fq);
#pragma unroll
                for (int bj = 0; bj < 2; ++bj) {
                    const pg8::f32x4 x1 = acc[ai][bj][m][0], x2 = acc[ai][bj][m][1];
                    const pg8::f32x4 y1 = x1 * c4 - x2 * s4, y2 = x2 * c4 + x1 * s4;
                    const unsigned a0 = cvt_pk_bf16(y1[0], y1[1]), a1 = cvt_pk_bf16(y1[2], y1[3]), b0 = cvt_pk_bf16(y2[0], y2[1]), b1 = cvt_pk_bf16(y2[2], y2[3]);
                    const auto r0 = __builtin_amdgcn_permlane16_swap(a0, b0, false, false); const auto r1 = __builtin_amdgcn_permlane16_swap(a1, b1, false, false);
                    const u32x4 w = {r0[0], r1[0], r0[1], r1[1]};
                    *(u32x4*)(rowp + bj * 128) = w;
                }
            }
    }
};
struct EpiC1 {
    static constexpr bool PERM = true, AFTER_DRAIN = false;
    bf16_t *Y, *T;
    __device__ __forceinline__ void operator()(AccRef acc, const Unit& u, int wr, int wc, int fr, int fq) const {
        const int row0 = u.pm * 256 + wr * 64 + fr;
        if (u.pn < 64) {
            const int part = u.pn >> 4, col0 = (u.pn & 15) * 256 + wc * 32 + 8 * fq;
            bf16_t* dst = Y + (size_t)part * (SLOT / 2);
#pragma unroll
            for (int ai = 0; ai < 2; ++ai)
#pragma unroll
                for (int m = 0; m < 4; ++m) { bf16_t* rowp = dst + (size_t)(row0 + ai * 128 + m * 16) * D + col0;
#pragma unroll
                    for (int bj = 0; bj < 2; ++bj) st_bf8(rowp + bj * 128, acc[ai][bj][m][0], acc[ai][bj][m][1]); }
        } else {
            const int which = u.pn - 64, col0 = which * 128 + wc * 32 + 8 * fq;
#pragma unroll
            for (int ai = 0; ai < 2; ++ai)
#pragma unroll
                for (int m = 0; m < 4; ++m) {
                    pg8::f32x4 v0 = acc[ai][0][m][0], v1 = acc[ai][0][m][1];
                    if (which == 0) {
#pragma unroll
                        for (int j = 0; j < 4; ++j) { v0[j] = 1.f - 2.f / (1.f + __expf(2.f * v0[j])); v1[j] = 1.f - 2.f / (1.f + __expf(2.f * v1[j])); }
                    }
                    st_bf8(T + (size_t)(row0 + ai * 128 + m * 16) * 256 + col0, v0, v1);
                }
        }
    }
};
struct EpiC2 {
    static constexpr bool PERM = true, AFTER_DRAIN = false;
    bf16_t* Y; const float* w0; const float* a0;
    __device__ __forceinline__ void operator()(AccRef acc, const Unit& u, int wr, int wc, int fr, int fq) const {
        const int row0 = u.pm * 256 + wr * 64 + fr;
        const bool isw = u.pn < 16;
        const int col0 = (u.pn & 15) * 256 + wc * 32 + 8 * fq;
        bf16_t* dst = Y + (size_t)(isw ? 4 : 5) * (SLOT / 2); const float* bias = isw ? w0 : a0;
#pragma unroll
        for (int bj = 0; bj < 2; ++bj) {
            const pg8::f32x4 b0 = *(const pg8::f32x4*)(bias + col0 + bj * 128), b1 = *(const pg8::f32x4*)(bias + col0 + bj * 128 + 4);
#pragma unroll
            for (int ai = 0; ai < 2; ++ai)
#pragma unroll
                for (int m = 0; m < 4; ++m) {
                    pg8::f32x4 v0 = acc[ai][bj][m][0] + b0, v1 = acc[ai][bj][m][1] + b1;
#pragma unroll
                    for (int j = 0; j < 4; ++j) {
                        float s0 = sigmoid_f(v0[j]), s1 = sigmoid_f(v1[j]);
                        if (isw) { s0 = __expf(-0.606531f * s0); s1 = __expf(-0.606531f * s1); }
                        v0[j] = s0; v1[j] = s1;
                    }
                    st_bf8(dst + (size_t)(row0 + ai * 128 + m * 16) * D + col0 + bj * 128, v0, v1);
                    __builtin_amdgcn_sched_barrier(0);
                }
        }
    }
};

struct Fr {
    LAS unsigned char* lds; unsigned char* ldsg;
    int tid, lane, wave, G, bid, gw, NGW;
    float* out; unsigned char* ws;
    __device__ __forceinline__ Fr fresh() const { Fr P = *this; asm volatile("" : "+v"(P.tid)); P.lane = P.tid & 63; P.wave = __builtin_amdgcn_readfirstlane(P.tid >> 6); P.gw = P.bid * 8 + P.wave; return P; }
    __device__ __forceinline__ const float* in(int i) const {
        const __attribute__((address_space(4))) unsigned long long* ka = (const __attribute__((address_space(4))) unsigned long long*)__builtin_amdgcn_kernarg_segment_ptr();
        asm volatile("" : "+s"(ka));
        return (const float*)ka[i];
    }
};
__device__ __forceinline__ bf16_t* slotU(const Fr& F, int s) { return (bf16_t*)(F.ws + WS_U + (size_t)s * SLOT); }
__device__ __forceinline__ bf16_t* slotY(const Fr& F, int s) { return (bf16_t*)(F.ws + WS_Y + (size_t)s * SLOT); }
__device__ __forceinline__ float* hrow(const Fr& F, int r) { return r < 64 ? (float*)(F.ws + WS_HMETA) + (size_t)r * D : F.out + (size_t)(r - 64) * D; }

__device__ __forceinline__ void transpose_item(const float* W, int ldw, bf16_t* WT, int ldt, int koff, LAS float* scr, int kb, int nb, int lane) {
    const int k0 = 64 * kb, n0 = 32 * nb;
    float wv[32];
#pragma unroll
    for (int i = 0; i < 32; ++i) wv[i] = W[(size_t)(k0 + 2 * i + (lane >> 5)) * ldw + n0 + (lane & 31)];
#pragma unroll
    for (int i = 0; i < 32; ++i) scr[(2 * i + (lane >> 5)) * 33 + (lane & 31)] = wv[i];
    LDS_WAIT(); asm volatile("" ::: "memory");
    const int c = lane & 7;
#pragma unroll
    for (int j = 0; j < 4; ++j) { const int n = (lane >> 3) + 8 * j; const LAS float* s = scr + (8 * c) * 33 + n;
        u32x4 o; o.x = cvt_pk_bf16(s[0 * 33], s[1 * 33]); o.y = cvt_pk_bf16(s[2 * 33], s[3 * 33]); o.z = cvt_pk_bf16(s[4 * 33], s[5 * 33]); o.w = cvt_pk_bf16(s[6 * 33], s[7 * 33]);
        *(u32x4*)(WT + (size_t)(n0 + n) * ldt + koff + k0 + 8 * c) = o; }
    LDS_WAIT(); asm volatile("" ::: "memory");
}
__device__ __forceinline__ void convert_matrix(const Fr& F, const float* W, int K, int N, bf16_t* WT, int ldt, int koff, int wg_skip = 0) {
    LAS float* scr = (LAS float*)(F.lds + F.wave * 8704);
    const int nblk = N / 32, nitems = (K / 64) * nblk;
    for (int it = F.gw - wg_skip * 8; it < nitems; it += F.NGW - wg_skip * 8) transpose_item(W, N, WT, ldt, koff, scr, it / nblk, it % nblk, F.lane);
}
__device__ __forceinline__ void zero_bytes(const Fr& F, void* p, size_t nbytes) {
    u32x4* q = (u32x4*)p; const size_t n = nbytes / 16; const u32x4 z = {0u, 0u, 0u, 0u};
    for (size_t i = (size_t)F.bid * 512 + F.tid; i < n; i += (size_t)F.G * 512) q[i] = z;
}
__device__ __forceinline__ bf16_t* wtin_of(const Fr& F, int L) { return (bf16_t*)(F.ws + ((L & 1) ? WS_WTINB : WS_WTIN)); }
__device__ __forceinline__ void convert_win(const Fr& F, int L, int wg_skip) {
    const float* src = (L == 0 || L == 3) ? F.in(4) + (size_t)(L ? 1 : 0) * D * 4 * D : (L == 1 ? F.in(8) : F.in(16));
    convert_matrix(F, src, D, 4 * D, wtin_of(F, L), D, 0, wg_skip);
}
__device__ __forceinline__ void convert_layer(const Fr& F, int L, bool with_win) {
    bf16_t* wtin = wtin_of(F, L); bf16_t* wtout = (bf16_t*)(F.ws + WS_WTOUT);
    if (with_win) convert_win(F, L, 0);
    if (L == 0 || L == 3) {
        convert_matrix(F, F.in(7) + (size_t)(L ? 1 : 0) * D * D, D, D, wtout, D, 0);
    } else if (L == 1) {
        convert_matrix(F, F.in(14), D, D, wtout, D, 0);
    } else {
        convert_matrix(F, F.in(28), D, D, wtout, D, 0);
        convert_matrix(F, F.in(18), D, 128, wtin + (size_t)16384 * D, D, 0);
        convert_matrix(F, F.in(21), D, 128, wtin + (size_t)16640 * D, D, 0);
        zero_bytes(F, wtin + (size_t)16512 * D, (size_t)128 * D * 2);
        zero_bytes(F, wtin + (size_t)16768 * D, (size_t)128 * D * 2);
    }
}
__device__ __forceinline__ void convert_layer2_b(const Fr& F) {
    bf16_t* w2t = (bf16_t*)(F.ws + WS_W2P);
    convert_matrix(F, F.in(19), 128, D, w2t, 128, 0);
    convert_matrix(F, F.in(22), 128, D, w2t + (size_t)4096 * 128, 128, 0);
}

__constant__ float c_inv_freq[16] = {1.0f, 0.44036659598350525f, 0.1939227432012558f, 0.08539710193872452f, 0.03760603070259094f, 0.01656043902039528f, 0.007292664609849453f, 0.0032114458736032248f,
    0.0014142135623842478f, 0.000622772378847003f, 0.00027424818836152554f, 0.00012076973507646471f, 5.318296098266728e-05f, 2.34199997066753e-05f, 1.0313386155758053e-05f, 4.541670477919979e-06f};
__device__ __forceinline__ void rope_table(const Fr& F) {
    float* cs = (float*)(F.ws + WS_ROPE); float* sn = cs + (size_t)R * 16;
    for (int i = F.bid * 512 + F.tid; i < R * 16; i += F.G * 512) {
        const int row = i >> 4, j = i & 15; const int pos = row - NPAD;
        const double ang = (double)(float)((float)pos * c_inv_freq[j]);
        const double k = __builtin_rint(ang * 0.15915494309189535);
        double x = ang - k * 6.283185307179586;
        const double q = __builtin_rint(x * 0.6366197723675814);
        x -= q * 1.5707963267948966;
        const int qi = ((int)q) & 3;
        const double x2 = x * x;
        const double s = x * (1.0 + x2 * (-1.0 / 6 + x2 * (1.0 / 120 + x2 * (-1.0 / 5040 + x2 * (1.0 / 362880 + x2 * (-1.0 / 39916800))))));
        const double c = 1.0 + x2 * (-0.5 + x2 * (1.0 / 24 + x2 * (-1.0 / 720 + x2 * (1.0 / 40320 + x2 * (-1.0 / 3628800 + x2 * (1.0 / 479001600))))));
        double sv, cv;
        if (qi == 0) { sv = s; cv = c; } else if (qi == 1) { sv = c; cv = -s; } else if (qi == 2) { sv = -s; cv = -c; } else { sv = -c; cv = s; }
        cs[i] = (float)cv; sn[i] = (float)sv;
    }
}

typedef const GAS char* gcp; typedef GAS char* gp_;
#define ROW_F32(nm, base, lane) gp_ nm##0 = (gp_)(base) + (lane) * 16 + 4096; gp_ nm##1 = nm##0 + 8192; asm volatile("" : "+v"(nm##0), "+v"(nm##1))
#define AT_F32(nm, j) (*(GAS f32x4*)((j) < 8 ? nm##0 + ((j) - 4) * 1024 : nm##1 + ((j) - 12) * 1024))
#define ROW_BF(nm, base, lane) gp_ nm##0 = (gp_)(base) + (lane) * 8 + 4096; asm volatile("" : "+v"(nm##0))
#define AT_BF(nm, j) (*(GAS u32x2*)(nm##0 + (j) * 512 - 4096))
__device__ __forceinline__ void norm_phase(const Fr& F, int prev, int next, const bf16_t* y, bf16_t* udst, int rlo = 0, int rhi = R, int wg_skip = 0) {
    const float* postg = F.in(3) + (size_t)(prev < 0 ? 0 : prev) * D; const float* preg = F.in(2) + (size_t)(next < 0 ? 0 : next) * D;
    const float* xin = F.in(0); const float* meta = F.in(1);
    for (int r = rlo + F.gw - wg_skip * 8; r < rhi; r += F.NGW - wg_skip * 8) {
        if (r < NPAD || r >= NREAL) {
            if (next >= 0) { ROW_BF(uo, udst + (size_t)r * D, F.lane); const u32x2 z = {0u, 0u};
#pragma unroll
                for (int j = 0; j < 16; ++j) AT_BF(uo, j) = z; }
            continue;
        }
        ROW_BF(hp, (bf16_t*)(F.ws + WS_HB) + (size_t)r * D, F.lane);
        f32x4 hv[16];
        if (prev < 0) {
            const float* src = r < 64 ? meta + (size_t)(r - NPAD) * D : xin + (size_t)(r - 64) * D;
            ROW_F32(sp, src, F.lane);
#pragma unroll
            for (int j = 0; j < 16; ++j) hv[j] = AT_F32(sp, j);
        } else {
            ROW_BF(yp, y + (size_t)r * D, F.lane); ROW_F32(gp, postg, F.lane);
            u32x2 yv[16], hb[16]; float ss = 0.f;
#pragma unroll
            for (int j = 0; j < 16; ++j) { yv[j] = AT_BF(yp, j); hb[j] = AT_BF(hp, j); }
#pragma unroll
            for (int j = 0; j < 16; ++j) { const float a = bflo(yv[j].x), b = bfhi(yv[j].x), c = bflo(yv[j].y), d = bfhi(yv[j].y); ss += (a * a + b * b) + (c * c + d * d); }
#pragma unroll
            for (int j = 0; j < 16; ++j) asm volatile("" : "+v"(yv[j].x), "+v"(yv[j].y));
            const float rs = __builtin_amdgcn_rsqf(wave_sum(ss) * (1.f / D) + 1e-6f);
#pragma unroll
            for (int j = 0; j < 16; ++j) { const f32x4 g = AT_F32(gp, j);
                hv[j].x = bflo(hb[j].x) + bflo(yv[j].x) * rs * g.x; hv[j].y = bfhi(hb[j].x) + bfhi(yv[j].x) * rs * g.y; hv[j].z = bflo(hb[j].y) + bflo(yv[j].y) * rs * g.z; hv[j].w = bfhi(hb[j].y) + bfhi(yv[j].y) * rs * g.w; }
        }
        if (next < 0) {
            if (r >= 64) { ROW_F32(op, F.out + (size_t)(r - 64) * D, F.lane);
#pragma unroll
                for (int j = 0; j < 16; ++j) AT_F32(op, j) = hv[j];
            }
            continue;
        }
        float s2 = 0.f;
#pragma unroll
        for (int j = 0; j < 16; ++j) { u32x2 w_; w_.x = cvt_pk_bf16(hv[j].x, hv[j].y); w_.y = cvt_pk_bf16(hv[j].z, hv[j].w); AT_BF(hp, j) = w_; s2 += (hv[j].x * hv[j].x + hv[j].y * hv[j].y) + (hv[j].z * hv[j].z + hv[j].w * hv[j].w); }
        const float rs2 = __builtin_amdgcn_rsqf(wave_sum(s2) * (1.f / D) + 1e-6f);
        ROW_BF(uo, udst + (size_t)r * D, F.lane); ROW_F32(pg, preg, F.lane);
#pragma unroll
        for (int j = 0; j < 16; ++j) { const f32x4 g = AT_F32(pg, j); u32x2 w; w.x = cvt_pk_bf16(hv[j].x * rs2 * g.x, hv[j].y * rs2 * g.y); w.y = cvt_pk_bf16(hv[j].z * rs2 * g.z, hv[j].w * rs2 * g.w); AT_BF(uo, j) = w; }
    }
}
__device__ __forceinline__ void mix_phase(const Fr& F, const bf16_t* u) {
    const float* mu = F.in(15);
    for (int r = F.gw; r < R; r += F.NGW) {
        const bool real = (r >= NPAD && r < NREAL);
        u32x2 cur[16], prv[16];
        const u32x2 z = {0u, 0u};
        { ROW_BF(cp, u + (size_t)r * D, F.lane); ROW_BF(pp, u + (size_t)(r > 0 ? r - 1 : 0) * D, F.lane);
#pragma unroll
          for (int j = 0; j < 16; ++j) { cur[j] = real ? AT_BF(cp, j) : z; prv[j] = (real && r > NPAD) ? AT_BF(pp, j) : z; } }
#pragma unroll 1
        for (int s = 0; s < 6; ++s) {
            ROW_BF(op, slotU(F, s) + (size_t)r * D, F.lane); ROW_F32(mp, mu + (size_t)s * D, F.lane);
#pragma unroll
            for (int j = 0; j < 16; ++j) {
                const f32x4 m = AT_F32(mp, j);
                const float c0 = bflo(cur[j].x), c1 = bfhi(cur[j].x), c2 = bflo(cur[j].y), c3 = bfhi(cur[j].y);
                const float p0 = bflo(prv[j].x), p1 = bfhi(prv[j].x), p2 = bflo(prv[j].y), p3 = bfhi(prv[j].y);
                u32x2 w; w.x = cvt_pk_bf16(c0 + (p0 - c0) * m.x, c1 + (p1 - c1) * m.y); w.y = cvt_pk_bf16(c2 + (p2 - c2) * m.z, c3 + (p3 - c3) * m.w);
                AT_BF(op, j) = real ? w : z;
            }
        }
    }
}
}
namespace mk {
constexpr int H_QE = 0, H_KE = 17408, H_KET = 34816, H_VT = 53248, H_PM = 71680, H_STB = 80896, H_VEC = 115712;
__device__ __forceinline__ bf16x8 ldfrag(const LAS unsigned char* base, int stride_b, int rb, int ks, int lane) {
    return *(const LAS bf16x8*)(base + (16 * rb + (lane & 15)) * stride_b + (32 * ks + 8 * (lane >> 4)) * 2);
}
template <bool OUT>
__device__ __forceinline__ void hgrn_phase(const Fr& F, int jl) {
    const bf16_t* Q = slotY(F, 0); const bf16_t* V = slotY(F, 1); const bf16_t* GT = slotY(F, 2); const float* Gg = (const float*)slotY(F, 3);
    bf16_t* Z = slotU(F, 0);
    float* HE = (float*)(F.ws + WS_HE); float* HLD = (float*)(F.ws + WS_HLOGD);
    const float* gn = F.in(6) + (size_t)jl * 128;
    LAS unsigned char* L = F.lds;
    LAS float* qtot = (LAS float*)(L + H_VEC); LAS float* ebm = qtot + 512; LAS float* ebl = ebm + 128;
    const int tid = F.tid, lane = F.lane, w = F.wave;
    const int d = tid & 127, qt = tid >> 7;
    for (int unit = F.bid; unit < 256; unit += F.G) {
        const int h = unit >> 3, seg = unit & 7;
        if (!OUT && seg == 7) continue;
        const int c0 = seg == 0 ? 0 : 33 + 32 * (seg - 1), c1 = c0 + (seg == 0 ? 33 : 32);
        f32x4 S[8];
#pragma unroll
        for (int i = 0; i < 8; ++i) S[i] = (f32x4){0.f, 0.f, 0.f, 0.f};
        if (OUT) {
            for (int j = 0; j < seg; ++j) {
                const float* ld = HLD + (size_t)(h * 8 + j) * 128; const float* e = HE + ((size_t)(h * 8 + j) * 512 + tid) * 32;
#pragma unroll
                for (int di = 0; di < 8; ++di) { const f32x4 l4 = *(const f32x4*)(ld + 16 * di + 4 * (lane >> 4)); const f32x4 e4 = *(const f32x4*)(e + 4 * di);
                    S[di].x = S[di].x * __expf(l4.x) + e4.x; S[di].y = S[di].y * __expf(l4.y) + e4.y; S[di].z = S[di].z * __expf(l4.z) + e4.z; S[di].w = S[di].w * __expf(l4.w) + e4.w; }
            }
        }
        float logD = 0.f;
        float g[16]; bf16_t qv[16], vv[16]; u32x4 gt0 = {0u, 0u, 0u, 0u}, gt1 = gt0, ngt0 = gt0, ngt1 = gt0;
#define HG_LOAD(cc) do { const int rowb_ = 64 * (cc) + 16 * qt; const size_t colb_ = (size_t)h * 128 + d; \
            _Pragma("unroll") for (int i = 0; i < 16; ++i) { g[i] = Gg[(size_t)(rowb_ + i) * D + colb_]; vv[i] = V[(size_t)(rowb_ + i) * D + colb_]; if (OUT) qv[i] = Q[(size_t)(rowb_ + i) * D + colb_]; } \
            if (OUT) { const bf16_t* gp_ = GT + (size_t)(64 * (cc) + (tid >> 3)) * D + h * 128 + 16 * (tid & 7); ngt0 = *(const u32x4*)gp_; ngt1 = *(const u32x4*)(gp_ + 8); } } while (0)
        HG_LOAD(c0);
        for (int c = c0; c < c1; ++c) {
            if (OUT) { gt0 = ngt0; gt1 = ngt1; }
            float f[16]; float run = 0.f;
#pragma unroll
            for (int i = 0; i < 16; ++i) { run += g[i]; f[i] = __expf(g[i]); }
            qtot[qt * 128 + d] = run;
            __syncthreads();
            const float t0 = qtot[d], t1 = qtot[128 + d], t2 = qtot[256 + d], t3 = qtot[384 + d];
            const float off = qt == 0 ? 0.f : (qt == 1 ? t0 : (qt == 2 ? t0 + t1 : t0 + t1 + t2));
            const float bm = t0 + t1, bl = (t0 + t1) + (t2 + t3);
            if (qt == 0) { ebm[d] = __expf(bm); ebl[d] = __expf(bl); logD += bl; }
            {
                unsigned kt[8], vt[8];
                const float ebd = __expf(bl - bm);
                float y = __expf(bm - (run + off)), kx_hi = 0.f;
#pragma unroll
                for (int i = 15; i >= 0; --i) {
                    const float ky = (1.f - f[i]) * y;
                    if (OUT) *(LAS bf16_t*)(L + H_KE + ((16 * qt + i) * 136 + d) * 2) = f2bf(ky);
                    const float kx = ky * ebd;
                    if (i & 1) kx_hi = kx; else kt[i >> 1] = cvt_pk_bf16(kx, kx_hi);
                    y *= f[i];
                }
                if (OUT) {
                    float e = __expf(off - bm);
#pragma unroll
                    for (int i = 0; i < 16; ++i) { e *= f[i]; *(LAS bf16_t*)(L + H_QE + ((16 * qt + i) * 136 + d) * 2) = f2bf(bf2f(qv[i]) * e); }
                }
#pragma unroll
                for (int i = 0; i < 16; i += 2) vt[i >> 1] = (unsigned)vv[i] | ((unsigned)vv[i + 1] << 16);
                LAS u32x4* kp = (LAS u32x4*)(L + H_KET + (d * 72 + 16 * qt) * 2); kp[0] = (u32x4){kt[0], kt[1], kt[2], kt[3]}; kp[1] = (u32x4){kt[4], kt[5], kt[6], kt[7]};
                LAS u32x4* vp = (LAS u32x4*)(L + H_VT + (d * 72 + 16 * qt) * 2); vp[0] = (u32x4){vt[0], vt[1], vt[2], vt[3]}; vp[1] = (u32x4){vt[4], vt[5], vt[6], vt[7]};
            }
            if (c + 1 < c1) HG_LOAD(c + 1);
            __syncthreads();
            if (OUT) {
#pragma unroll
                for (int di = 0; di < 8; ++di) { const f32x4 m4 = *(const LAS f32x4*)(ebm + 16 * di + 4 * (lane >> 4)); u32x2 o; o.x = cvt_pk_bf16(S[di].x * m4.x, S[di].y * m4.y); o.y = cvt_pk_bf16(S[di].z * m4.z, S[di].w * m4.w);
                    *(LAS u32x2*)(L + H_STB + ((16 * w + (lane & 15)) * 136 + 16 * di + 4 * (lane >> 4)) * 2) = o; }
                const int ti = w >> 1;
#pragma unroll
                for (int s2 = 0; s2 < 2; ++s2) { const int si = 2 * (w & 1) + s2; f32x4 p = {0.f, 0.f, 0.f, 0.f};
                    if (si <= ti) {
#pragma unroll
                        for (int ks = 0; ks < 4; ++ks) p = __builtin_amdgcn_mfma_f32_16x16x32_bf16(ldfrag(L + H_QE, 272, ti, ks, lane), ldfrag(L + H_KE, 272, si, ks, lane), p, 0, 0, 0);
                    }
                    const int sidx = 16 * si + (lane & 15);
#pragma unroll
                    for (int jj = 0; jj < 4; ++jj) { const int tidx = 16 * ti + 4 * (lane >> 4) + jj; *(LAS bf16_t*)(L + H_PM + (tidx * 72 + sidx) * 2) = f2bf(sidx <= tidx ? p[jj] : 0.f); }
                }
                __syncthreads();
            }
            f32x4 O[4];
            if (OUT) {
#pragma unroll
                for (int ti = 0; ti < 4; ++ti) O[ti] = (f32x4){0.f, 0.f, 0.f, 0.f};
#pragma unroll
                for (int ks = 0; ks < 2; ++ks) { const bf16x8 bv = ldfrag(L + H_VT, 144, w, ks, lane);
#pragma unroll
                    for (int ti = 0; ti < 4; ++ti) O[ti] = __builtin_amdgcn_mfma_f32_16x16x32_bf16(ldfrag(L + H_PM, 144, ti, ks, lane), bv, O[ti], 0, 0, 0); }
#pragma unroll
                for (int ks = 0; ks < 4; ++ks) { const bf16x8 bs = ldfrag(L + H_STB, 272, w, ks, lane);
#pragma unroll
                    for (int ti = 0; ti < 4; ++ti) O[ti] = __builtin_amdgcn_mfma_f32_16x16x32_bf16(ldfrag(L + H_QE, 272, ti, ks, lane), bs, O[ti], 0, 0, 0); }
            }
            {
                const bf16x8 bv0 = ldfrag(L + H_VT, 144, w, 0, lane), bv1 = ldfrag(L + H_VT, 144, w, 1, lane);
#pragma unroll
                for (int di = 0; di < 8; ++di) { const f32x4 l4 = *(const LAS f32x4*)(ebl + 16 * di + 4 * (lane >> 4)); S[di] = S[di] * l4;
                    S[di] = __builtin_amdgcn_mfma_f32_16x16x32_bf16(ldfrag(L + H_KET, 144, di, 0, lane), bv0, S[di], 0, 0, 0);
                    S[di] = __builtin_amdgcn_mfma_f32_16x16x32_bf16(ldfrag(L + H_KET, 144, di, 1, lane), bv1, S[di], 0, 0, 0); }
            }
            if (OUT) {
                __syncthreads();
                LAS float* Ot = (LAS float*)(L + H_STB);
#pragma unroll
                for (int ti = 0; ti < 4; ++ti)
#pragma unroll
                    for (int jj = 0; jj < 4; ++jj) Ot[(16 * ti + 4 * (lane >> 4) + jj) * 132 + 16 * w + (lane & 15)] = O[ti][jj];
                __syncthreads();
                const int t = tid >> 3, eg = tid & 7;
                f32x4 o4[4]; float ss = 0.f;
#pragma unroll
                for (int i = 0; i < 4; ++i) { o4[i] = *(const LAS f32x4*)(Ot + t * 132 + 16 * eg + 4 * i); ss += (o4[i].x * o4[i].x + o4[i].y * o4[i].y) + (o4[i].z * o4[i].z + o4[i].w * o4[i].w); }
                ss = red8(ss);
                const float rs = __builtin_amdgcn_rsqf(ss * (1.f / 128.f) + 1e-6f);
                const unsigned gw_[8] = {gt0.x, gt0.y, gt0.z, gt0.w, gt1.x, gt1.y, gt1.z, gt1.w};
                unsigned zo[8];
#pragma unroll
                for (int i = 0; i < 4; ++i) { const f32x4 g4 = *(const f32x4*)(gn + 16 * eg + 4 * i);
                    const float a0 = o4[i].x * rs * g4.x * silu_f(bflo(gw_[2 * i])), a1 = o4[i].y * rs * g4.y * silu_f(bfhi(gw_[2 * i]));
                    const float a2 = o4[i].z * rs * g4.z * silu_f(bflo(gw_[2 * i + 1])), a3 = o4[i].w * rs * g4.w * silu_f(bfhi(gw_[2 * i + 1]));
                    zo[2 * i] = cvt_pk_bf16(a0, a1); zo[2 * i + 1] = cvt_pk_bf16(a2, a3); }
                bf16_t* zp = Z + (size_t)(64 * c + t) * D + h * 128 + 16 * eg;
                *(u32x4*)zp = (u32x4){zo[0], zo[1], zo[2], zo[3]}; *(u32x4*)(zp + 8) = (u32x4){zo[4], zo[5], zo[6], zo[7]};
            } else {
                __syncthreads();
            }
        }
        if (!OUT) {
            float* e = HE + ((size_t)(h * 8 + seg) * 512 + tid) * 32;
#pragma unroll
            for (int di = 0; di < 8; ++di) *(f32x4*)(e + 4 * di) = S[di];
            if (qt == 0) HLD[(size_t)(h * 8 + seg) * 128 + d] = logD;
        }
        __syncthreads();
    }
#undef HG_LOAD
}

#ifndef MK_PRIO
#define MK_PRIO 0
#endif
#define PRIO_HI() do { if (MK_PRIO) { __builtin_amdgcn_s_setprio(MK_PRIO); } } while (0)
#define PRIO_LO() do { if (MK_PRIO) { __builtin_amdgcn_s_setprio(0); } } while (0)
namespace att {
constexpr int NW = 8, QBLK = 32, KVBLK = 64, LDQ = 4096, LDO = 8192;
constexpr float SCALE = 0.088388347648318440f, THR = 8.f;
constexpr int SHM_V = 16384, SHM_K = 16384, SHM = 2 * SHM_V + 2 * SHM_K + NW * 64 * 4;
#ifndef MK_KSWM
#define MK_KSWM 15
#endif
#define KSWZ(row, colB) ((row) * 256 + ((colB) ^ (((row) & MK_KSWM) << 4)))
#define SBAR() __builtin_amdgcn_sched_barrier(0)
__device__ __forceinline__ int crow(int r, int hi) { return (r & 3) + 8 * (r >> 2) + 4 * hi; }
__device__ __forceinline__ void partialSM(f32x16& p0, f32x16& p1, float& m_reg, float& mn, float& alpha) {
    constexpr float C = SCALE * 1.4426950408889634f;
    float pmax = p0[0];
#pragma unroll
    for (int r = 1; r < 16; ++r) pmax = fmaxf(pmax, p0[r]);
#pragma unroll
    for (int r = 0; r < 16; ++r) pmax = fmaxf(pmax, p1[r]);
    { auto rr = __builtin_amdgcn_permlane32_swap(__float_as_uint(pmax), __float_as_uint(pmax), false, false);
      pmax = fmaxf(__uint_as_float(rr[0]), __uint_as_float(rr[1])); }
    if (__builtin_expect(__all(pmax - m_reg <= THR / SCALE), 1)) { mn = m_reg; alpha = 1.f; }
    else { mn = fmaxf(m_reg, pmax); alpha = __builtin_amdgcn_exp2f((m_reg - mn) * C); m_reg = mn; }
    const float mnC = -mn * C;
#pragma unroll
    for (int r = 0; r < 16; ++r) p0[r] = fmaf(p0[r], C, mnC);
#pragma unroll
    for (int r = 0; r < 16; ++r) p1[r] = fmaf(p1[r], C, mnC);
#pragma unroll
    for (int r = 0; r < 16; ++r) p0[r] = __builtin_amdgcn_exp2f(p0[r]);
}
__device__ __forceinline__ void finishSM(f32x16& p0, f32x16& p1, float alpha, float& l_reg, bf16x8& pa0, bf16x8& pa1, bf16x8& pa2, bf16x8& pa3) {
#pragma unroll
    for (int r = 0; r < 16; ++r) p1[r] = __builtin_amdgcn_exp2f(p1[r]);
    float ps = 0;
#pragma unroll
    for (int r = 0; r < 16; ++r) ps += p0[r];
#pragma unroll
    for (int r = 0; r < 16; ++r) ps += p1[r];
    { auto rr = __builtin_amdgcn_permlane32_swap(__float_as_uint(ps), __float_as_uint(ps), false, false);
      ps = __uint_as_float(rr[0]) + __uint_as_float(rr[1]); }
    l_reg = l_reg * alpha + ps;
#define PK4(P, BASE, OUT) do { unsigned a0 = cvt_pk_bf16(P[BASE + 0], P[BASE + 1]), a1 = cvt_pk_bf16(P[BASE + 2], P[BASE + 3]);   \
    unsigned b0 = cvt_pk_bf16(P[BASE + 4], P[BASE + 5]), b1 = cvt_pk_bf16(P[BASE + 6], P[BASE + 7]);                              \
    auto r0 = __builtin_amdgcn_permlane32_swap(a0, b0, false, false); auto r1 = __builtin_amdgcn_permlane32_swap(a1, b1, false, false); \
    u32x4 w = {r0[0], r1[0], r0[1], r1[1]}; OUT = *reinterpret_cast<bf16x8*>(&w); } while (0)
    PK4(p0, 0, pa0); PK4(p0, 8, pa1); PK4(p1, 0, pa2); PK4(p1, 8, pa3);
#undef PK4
}
__device__ __forceinline__ void qkt(f32x16& p0, f32x16& p1, const char* Ks, const bf16x8* qr, int r32, int hi) {
    p0 = f32x16{}; p1 = f32x16{};
    PRIO_HI();
#pragma unroll
    for (int d0 = 0; d0 < 8; ++d0) { const int cb = (d0 * 16 + hi * 8) * 2;
        const bf16x8 b0 = *reinterpret_cast<const bf16x8*>(Ks + KSWZ(r32, cb));
        const bf16x8 b1 = *reinterpret_cast<const bf16x8*>(Ks + KSWZ(32 + r32, cb));
        p0 = __builtin_amdgcn_mfma_f32_32x32x16_bf16(b0, qr[d0], p0, 0, 0, 0);
        p1 = __builtin_amdgcn_mfma_f32_32x32x16_bf16(b1, qr[d0], p1, 0, 0, 0); }
    PRIO_LO();
}
__device__ __forceinline__ int v_st(int k, int c) { const int kk = (k & ~0xC) | ((k & 4) << 1) | ((k & 8) >> 1); return ((kk >> 3) * 4 + (c >> 5)) * 512 + ((kk & 7) * 32 + (c & 31)) * 2; }
__device__ __forceinline__ int v_rd_base(int lane) { return ((lane & 3) << 3) | (((lane >> 2) & 3) << 6) | (((lane >> 4) & 1) << 5) | (((lane >> 5) & 1) << 8); }
constexpr int v_rd_off(int d0, int ks, int half) { return d0 * 512 + ks * 4096 + half * 2048; }
template <int OFF> __device__ __forceinline__ s16x4 tr_read(int vb) {
    s16x4 r; asm volatile("ds_read_b64_tr_b16 %0, %1 offset:%2" : "=&v"(r) : "v"(vb), "i"(OFF) : "memory"); return r;
}
template <int D0> __device__ __forceinline__ void pv_one(f32x16& od, int vb, bf16x8 pa0, bf16x8 pa1, bf16x8 pa2, bf16x8 pa3) {
    const s16x4 l0 = tr_read<v_rd_off(D0, 0, 0)>(vb), h0 = tr_read<v_rd_off(D0, 0, 1)>(vb), l1 = tr_read<v_rd_off(D0, 1, 0)>(vb), h1 = tr_read<v_rd_off(D0, 1, 1)>(vb);
    const s16x4 l2 = tr_read<v_rd_off(D0, 2, 0)>(vb), h2 = tr_read<v_rd_off(D0, 2, 1)>(vb), l3 = tr_read<v_rd_off(D0, 3, 0)>(vb), h3 = tr_read<v_rd_off(D0, 3, 1)>(vb);
    asm volatile("s_waitcnt lgkmcnt(0)" ::: "memory"); SBAR();
#define PK(Lo, Hi) (bf16x8){Lo[0], Lo[1], Lo[2], Lo[3], Hi[0], Hi[1], Hi[2], Hi[3]}
    od = __builtin_amdgcn_mfma_f32_32x32x16_bf16(pa0, PK(l0, h0), od, 0, 0, 0);
    od = __builtin_amdgcn_mfma_f32_32x32x16_bf16(pa1, PK(l1, h1), od, 0, 0, 0);
    od = __builtin_amdgcn_mfma_f32_32x32x16_bf16(pa2, PK(l2, h2), od, 0, 0, 0);
    od = __builtin_amdgcn_mfma_f32_32x32x16_bf16(pa3, PK(l3, h3), od, 0, 0, 0);
#undef PK
}
__device__ __forceinline__ void pv_d0(f32x16* o, int vb, bf16x8 pa0, bf16x8 pa1, bf16x8 pa2, bf16x8 pa3) {
    pv_one<0>(o[0], vb, pa0, pa1, pa2, pa3); pv_one<1>(o[1], vb, pa0, pa1, pa2, pa3); pv_one<2>(o[2], vb, pa0, pa1, pa2, pa3); pv_one<3>(o[3], vb, pa0, pa1, pa2, pa3);
}
__device__ __forceinline__ void mask_tile(f32x16& p0, f32x16& p1, int j, int lim) {
    if (j > lim) {
#pragma unroll
        for (int r = 0; r < 16; ++r) { p0[r] = -1e30f; p1[r] = -1e30f; }
    } else if (j == 0) {
#pragma unroll
        for (int r = 0; r < 16; ++r) p0[r] = -1e30f;
#pragma unroll
        for (int r = 0; r < 8; ++r) p1[r] = -1e30f;
    }
}
__device__ __forceinline__ void unit(const bf16_t* __restrict__ Qb, const bf16_t* __restrict__ Kh, const bf16_t* __restrict__ Vh, bf16_t* __restrict__ Ob, int NT, int lim, char* lds) {
    int tid_ = threadIdx.x; asm volatile("" : "+v"(tid_));
    const int tid = tid_, wid = tid >> 6, lane = tid & 63, r32 = lane & 31, hi = lane >> 5;
    char* V_lds = lds; char* K_lds = lds + 2 * SHM_V;
    float* wsf = (float*)(lds + 2 * SHM_V + 2 * SHM_K) + wid * 64; float* li_l = wsf; float* al_l = wsf + 32;
    float m_reg = -1e30f, l_reg = 0; f32x16 o[4] = {}; bf16x8 qr[8];
    const bf16_t* Qw = Qb + (long)(wid * QBLK + r32) * LDQ + hi * 8;
#pragma unroll
    for (int d0 = 0; d0 < 8; ++d0) qr[d0] = *reinterpret_cast<const bf16x8*>(Qw + d0 * 16);
    const int sr = tid >> 4, sc = (tid & 15) * 8, vst0 = v_st(sr, sc), vst1 = v_st(32 + sr, sc);
    const int vb0 = (int)(uintptr_t)V_lds + v_rd_base(lane);
    struct { bf16x8 vs0, vs1, ks0, ks1; } sr_[2];
#define SLOAD(i, k0) do { sr_[i].vs0 = *reinterpret_cast<const bf16x8*>(&Vh[(long)((k0) + sr) * LDQ + sc]); sr_[i].vs1 = *reinterpret_cast<const bf16x8*>(&Vh[(long)((k0) + 32 + sr) * LDQ + sc]); \
    sr_[i].ks0 = *reinterpret_cast<const bf16x8*>(&Kh[(long)((k0) + sr) * LDQ + sc]); sr_[i].ks1 = *reinterpret_cast<const bf16x8*>(&Kh[(long)((k0) + 32 + sr) * LDQ + sc]); } while (0)
#define SWRITE(b, i) do { *(bf16x8*)(V_lds + (b) * SHM_V + vst0) = sr_[i].vs0;          \
    *(bf16x8*)(V_lds + (b) * SHM_V + vst1) = sr_[i].vs1; int kc = sc * 2;               \
    *(bf16x8*)(K_lds + (b) * SHM_K + KSWZ(sr, kc)) = sr_[i].ks0;                       \
    *(bf16x8*)(K_lds + (b) * SHM_K + KSWZ(32 + sr, kc)) = sr_[i].ks1; } while (0)
#define SWAIT() asm volatile("s_waitcnt vmcnt(4)" ::: "memory")
#define RESC(a) do { if (__any((a) < 1.f)) { if (hi == 0) al_l[r32] = (a); asm volatile("s_waitcnt lgkmcnt(0)" ::: "memory"); \
    _Pragma("unroll") for (int d = 0; d < 4; ++d) _Pragma("unroll") for (int r = 0; r < 16; ++r) o[d][r] *= al_l[crow(r, hi)]; } } while (0)
    f32x16 pA0, pA1, pB0, pB1; float mnA, mnB, alA, alB; bf16x8 pa0, pa1, pa2, pa3;
    constexpr int SE = 0, SO = 1;
    SLOAD(SE, 0); asm volatile("s_waitcnt vmcnt(0)" ::: "memory"); SWRITE(0, SE); __syncthreads();
    qkt(pA0, pA1, K_lds, qr, r32, hi); mask_tile(pA0, pA1, 0, lim); partialSM(pA0, pA1, m_reg, mnA, alA);
    SLOAD(SO, KVBLK); if (2 < NT) SLOAD(SE, 2 * KVBLK);
    SWAIT(); SWRITE(1, SO); __syncthreads();
    for (int j = 1; j + 1 < NT; j += 2) {
        SBAR(); qkt(pB0, pB1, K_lds + SHM_K, qr, r32, hi);
        finishSM(pA0, pA1, alA, l_reg, pa0, pa1, pa2, pa3); SBAR();
        SLOAD(SO, (j + 2) * KVBLK); SBAR();
        pv_d0(o, vb0, pa0, pa1, pa2, pa3); mask_tile(pB0, pB1, j, lim); partialSM(pB0, pB1, m_reg, mnB, alB);
        __syncthreads(); SWAIT(); SWRITE(0, SE);
        RESC(alB); __syncthreads();
        SBAR(); qkt(pA0, pA1, K_lds, qr, r32, hi);
        finishSM(pB0, pB1, alB, l_reg, pa0, pa1, pa2, pa3); SBAR();
        if (j + 3 < NT) SLOAD(SE, (j + 3) * KVBLK); SBAR();
        pv_d0(o, vb0 + SHM_V, pa0, pa1, pa2, pa3); mask_tile(pA0, pA1, j + 1, lim); partialSM(pA0, pA1, m_reg, mnA, alA);
        __syncthreads(); SWAIT(); SWRITE(1, SO);
        RESC(alA); __syncthreads();
    }
    SBAR(); qkt(pB0, pB1, K_lds + SHM_K, qr, r32, hi);
    finishSM(pA0, pA1, alA, l_reg, pa0, pa1, pa2, pa3); SBAR();
    pv_d0(o, vb0, pa0, pa1, pa2, pa3); mask_tile(pB0, pB1, NT - 1, lim); partialSM(pB0, pB1, m_reg, mnB, alB);
    __syncthreads(); RESC(alB);
    finishSM(pB0, pB1, alB, l_reg, pa0, pa1, pa2, pa3); SBAR();
    pv_d0(o, vb0 + SHM_V, pa0, pa1, pa2, pa3);
    if (hi == 0) li_l[r32] = l_reg; asm volatile("s_waitcnt lgkmcnt(0)" ::: "memory");
    float rli[16];
#pragma unroll
    for (int r = 0; r < 16; ++r) rli[r] = __builtin_amdgcn_rcpf(li_l[crow(r, hi)]);
    bf16_t* Ow = Ob + (long)(wid * QBLK) * LDO;
#pragma unroll
    for (int r = 0; r < 16; ++r) { const int orow = crow(r, hi);
#pragma unroll
        for (int d0 = 0; d0 < 4; ++d0) Ow[(long)orow * LDO + d0 * 32 + r32] = f2bf(o[d0][r] * rli[r]); }
    __syncthreads();
#undef SLOAD
#undef SWRITE
#undef SWAIT
#undef RESC
}
}


#ifndef MK_HB
#define MK_HB(w) ((w) >> 2)
#endif
namespace att2 {
using namespace att;
constexpr int KB = 16384, VB = 32768, OFF_V = 3 * KB, OFF_W = OFF_V + 3 * VB, SHM2 = OFF_W + NW * 64 * 4;
constexpr int v2_rd_off(int d0, int ks, int half) { return d0 * 512 + ks * 8192 + half * 4096; }
template <int D0> __device__ __forceinline__ void pv2_one(f32x16& od, int vb, bf16x8 pa0, bf16x8 pa1, bf16x8 pa2, bf16x8 pa3) {
    const s16x4 l0 = tr_read<v2_rd_off(D0, 0, 0)>(vb), h0 = tr_read<v2_rd_off(D0, 0, 1)>(vb), l1 = tr_read<v2_rd_off(D0, 1, 0)>(vb), h1 = tr_read<v2_rd_off(D0, 1, 1)>(vb);
    const s16x4 l2 = tr_read<v2_rd_off(D0, 2, 0)>(vb), h2 = tr_read<v2_rd_off(D0, 2, 1)>(vb), l3 = tr_read<v2_rd_off(D0, 3, 0)>(vb), h3 = tr_read<v2_rd_off(D0, 3, 1)>(vb);
    asm volatile("s_waitcnt lgkmcnt(0)" ::: "memory"); SBAR();
#define PK(Lo, Hi) (bf16x8){Lo[0], Lo[1], Lo[2], Lo[3], Hi[0], Hi[1], Hi[2], Hi[3]}
    od = __builtin_amdgcn_mfma_f32_32x32x16_bf16(pa0, PK(l0, h0), od, 0, 0, 0);
    od = __builtin_amdgcn_mfma_f32_32x32x16_bf16(pa1, PK(l1, h1), od, 0, 0, 0);
    od = __builtin_amdgcn_mfma_f32_32x32x16_bf16(pa2, PK(l2, h2), od, 0, 0, 0);
    od = __builtin_amdgcn_mfma_f32_32x32x16_bf16(pa3, PK(l3, h3), od, 0, 0, 0);
#undef PK
}
struct VFrag { s16x4 l0, h0, l1, h1, l2, h2, l3, h3; };
template <int D0> __device__ __forceinline__ void v2_load(VFrag& f, int vb) {
    f.l0 = tr_read<v2_rd_off(D0, 0, 0)>(vb); f.h0 = tr_read<v2_rd_off(D0, 0, 1)>(vb); f.l1 = tr_read<v2_rd_off(D0, 1, 0)>(vb); f.h1 = tr_read<v2_rd_off(D0, 1, 1)>(vb);
    f.l2 = tr_read<v2_rd_off(D0, 2, 0)>(vb); f.h2 = tr_read<v2_rd_off(D0, 2, 1)>(vb); f.l3 = tr_read<v2_rd_off(D0, 3, 0)>(vb); f.h3 = tr_read<v2_rd_off(D0, 3, 1)>(vb);
}
__device__ __forceinline__ void v2_mma(f32x16& od, const VFrag& f, bf16x8 pa0, bf16x8 pa1, bf16x8 pa2, bf16x8 pa3) {
#define PK(Lo, Hi) (bf16x8){Lo[0], Lo[1], Lo[2], Lo[3], Hi[0], Hi[1], Hi[2], Hi[3]}
    od = __builtin_amdgcn_mfma_f32_32x32x16_bf16(pa0, PK(f.l0, f.h0), od, 0, 0, 0);
    od = __builtin_amdgcn_mfma_f32_32x32x16_bf16(pa1, PK(f.l1, f.h1), od, 0, 0, 0);
    od = __builtin_amdgcn_mfma_f32_32x32x16_bf16(pa2, PK(f.l2, f.h2), od, 0, 0, 0);
    od = __builtin_amdgcn_mfma_f32_32x32x16_bf16(pa3, PK(f.l3, f.h3), od, 0, 0, 0);
#undef PK
}
struct VSet { s16x4 l0, h0, l1, h1, l2, h2, l3, h3; };
template <int G, int KS> __device__ __forceinline__ void vs_load(VSet& f, int vb) {
    f.l0 = tr_read<v2_rd_off(4 * G + 0, KS, 0)>(vb); f.h0 = tr_read<v2_rd_off(4 * G + 0, KS, 1)>(vb); f.l1 = tr_read<v2_rd_off(4 * G + 1, KS, 0)>(vb); f.h1 = tr_read<v2_rd_off(4 * G + 1, KS, 1)>(vb);
    f.l2 = tr_read<v2_rd_off(4 * G + 2, KS, 0)>(vb); f.h2 = tr_read<v2_rd_off(4 * G + 2, KS, 1)>(vb); f.l3 = tr_read<v2_rd_off(4 * G + 3, KS, 0)>(vb); f.h3 = tr_read<v2_rd_off(4 * G + 3, KS, 1)>(vb);
}
template <int G> __device__ __forceinline__ void vs_mma(f32x16* o, const VSet& f, bf16x8 pa) {
#define PK(Lo, Hi) (bf16x8){Lo[0], Lo[1], Lo[2], Lo[3], Hi[0], Hi[1], Hi[2], Hi[3]}
    o[4 * G + 0] = __builtin_amdgcn_mfma_f32_32x32x16_bf16(pa, PK(f.l0, f.h0), o[4 * G + 0], 0, 0, 0);
    o[4 * G + 1] = __builtin_amdgcn_mfma_f32_32x32x16_bf16(pa, PK(f.l1, f.h1), o[4 * G + 1], 0, 0, 0);
    o[4 * G + 2] = __builtin_amdgcn_mfma_f32_32x32x16_bf16(pa, PK(f.l2, f.h2), o[4 * G + 2], 0, 0, 0);
    o[4 * G + 3] = __builtin_amdgcn_mfma_f32_32x32x16_bf16(pa, PK(f.l3, f.h3), o[4 * G + 3], 0, 0, 0);
#undef PK
}
__device__ __forceinline__ void pv2_all(f32x16* o, int vb, bf16x8 pa0, bf16x8 pa1, bf16x8 pa2, bf16x8 pa3) {
    VSet A, B;
#define W8() do { asm volatile("s_waitcnt lgkmcnt(8)" ::: "memory"); SBAR(); } while (0)
    PRIO_HI();
    vs_load<0, 0>(A, vb);
    vs_load<0, 1>(B, vb); W8(); vs_mma<0>(o, A, pa0); SBAR();
    vs_load<0, 2>(A, vb); W8(); vs_mma<0>(o, B, pa1); SBAR();
    vs_load<0, 3>(B, vb); W8(); vs_mma<0>(o, A, pa2); SBAR();
    vs_load<1, 0>(A, vb); W8(); vs_mma<0>(o, B, pa3); SBAR();
    vs_load<1, 1>(B, vb); W8(); vs_mma<1>(o, A, pa0); SBAR();
    vs_load<1, 2>(A, vb); W8(); vs_mma<1>(o, B, pa1); SBAR();
    vs_load<1, 3>(B, vb); W8(); vs_mma<1>(o, A, pa2); SBAR();
    asm volatile("s_waitcnt lgkmcnt(0)" ::: "memory"); SBAR(); vs_mma<1>(o, B, pa3); SBAR();
    PRIO_LO();
#undef W8
}
__device__ __forceinline__ void unit2(const bf16_t* __restrict__ Qb, const bf16_t* __restrict__ Kh, const bf16_t* __restrict__ Vh, bf16_t* __restrict__ Ob, int NT, int lim, unsigned char* ldsg, LAS unsigned char* lds) {
    int tid_ = threadIdx.x; asm volatile("" : "+v"(tid_));
    const int tid = tid_, wid = __builtin_amdgcn_readfirstlane(tid >> 6), lane = tid & 63, r32 = lane & 31, hi = lane >> 5;
    LAS float* wsf = (LAS float*)(lds + OFF_W) + wid * 64; LAS float* li_l = wsf; LAS float* al_l = wsf + 32;
    float m_reg = -1e30f, l_reg = 0; f32x16 o[8] = {}; bf16x8 qr[8];
    const bf16_t* Qw = Qb + (long)(wid * QBLK + r32) * LDQ + hi * 8;
#pragma unroll
    for (int d0 = 0; d0 < 8; ++d0) qr[d0] = *reinterpret_cast<const bf16x8*>(Qw + d0 * 16);
    const int vb0 = (int)(uintptr_t)(ldsg + OFF_V) + v_rd_base(lane);
    unsigned ko0, vo0;
    { const int row = wid * 4 + (lane >> 4); ko0 = (unsigned)(row * LDQ * 2 + (((lane & 15) * 16) ^ ((row & MK_KSWM) << 4)));
      const int st = wid * 2 + (lane >> 5), q = lane & 31; const int kk = (st >> 3) * 8 + (q >> 2); const int k = (kk & ~0xC) | ((kk & 4) << 1) | ((kk & 8) >> 1);
      vo0 = (unsigned)(k * LDQ * 2 + ((st & 7) * 32 + (q & 3) * 8) * 2); }
#define DMA_K(t_, b_) do { const char* gk = (const char*)Kh + (size_t)(t_) * (KVBLK * LDQ * 2); _Pragma("unroll") for (int i = 0; i < 2; ++i) { \
        __builtin_amdgcn_global_load_lds((const unsigned*)(gk + (size_t)i * (32 * LDQ * 2) + ko0), (LAS unsigned*)(lds + (b_) * KB + wid * 1024 + i * 8192), 16, 0, 0); } } while (0)
#define DMA_V(t_, b_) do { const char* gv = (const char*)Vh + (size_t)(t_) * (KVBLK * LDQ * 2); _Pragma("unroll") for (int i = 0; i < 4; ++i) { \
        __builtin_amdgcn_global_load_lds((const unsigned*)(gv + (size_t)i * (16 * LDQ * 2) + vo0), (LAS unsigned*)(lds + OFF_V + (b_) * VB + wid * 1024 + i * 8192), 16, 0, 0); } } while (0)
    DMA_K(0, 0); DMA_V(0, 0); if (1 < NT) { DMA_K(1, 1); DMA_V(1, 1); }
    asm volatile("s_waitcnt vmcnt(0)" ::: "memory"); __builtin_amdgcn_s_barrier(); asm volatile("" ::: "memory");
    int kb = 0;
    for (int j = 0; j < NT; ++j) {
        const int kb2 = kb == 0 ? 2 : kb - 1;
        if (j + 2 < NT) DMA_V(j + 2, kb2);
        asm volatile("" ::: "memory");
        if (j + 2 < NT) DMA_K(j + 2, kb2);
        asm volatile("" ::: "memory");
        if (j <= lim) {
        f32x16 p0, p1; float mn, alpha; bf16x8 pa0, pa1, pa2, pa3;
        qkt(p0, p1, (const char*)ldsg + kb * KB, qr, r32, hi);
#if MK_PROBE_QK2
        asm volatile("" : "+v"(p0), "+v"(p1)); qkt(p0, p1, (const char*)ldsg + kb * KB, qr, r32, hi);
#endif
        if (j == 0) {
            asm volatile("; tile-0 mask" ::: "memory");
#pragma unroll
            for (int r = 0; r < 16; ++r) p0[r] = -1e30f;
#pragma unroll
            for (int r = 0; r < 8; ++r) p1[r] = -1e30f;
        }
        partialSM(p0, p1, m_reg, mn, alpha);
        if (__any(alpha < 1.f)) { if (hi == 0) al_l[r32] = alpha; asm volatile("s_waitcnt lgkmcnt(0)" ::: "memory");
#pragma unroll
            for (int d = 0; d < 8; ++d)
#pragma unroll
                for (int r = 0; r < 16; ++r) o[d][r] *= al_l[crow(r, hi)]; }
        finishSM(p0, p1, alpha, l_reg, pa0, pa1, pa2, pa3); SBAR();
        const int vb = vb0 + kb * VB;
        pv2_all(o, vb, pa0, pa1, pa2, pa3);
        }
        if (j + 2 < NT) asm volatile("s_waitcnt vmcnt(6)" ::: "memory"); else asm volatile("s_waitcnt vmcnt(0)" ::: "memory");
        __builtin_amdgcn_s_barrier(); asm volatile("" ::: "memory");
        kb = kb == 2 ? 0 : kb + 1;
    }
    if (hi == 0) li_l[r32] = l_reg; asm volatile("s_waitcnt lgkmcnt(0)" ::: "memory");
    float rli[16];
#pragma unroll
    for (int r = 0; r < 16; ++r) rli[r] = __builtin_amdgcn_rcpf(li_l[crow(r, hi)]);
    bf16_t* Ow = Ob + (long)(wid * QBLK) * LDO;
#pragma unroll
    for (int r = 0; r < 16; ++r) { const int orow = crow(r, hi);
#pragma unroll
        for (int d0 = 0; d0 < 8; ++d0) Ow[(long)orow * LDO + d0 * 32 + r32] = f2bf(o[d0][r] * rli[r]); }
    asm volatile("s_waitcnt vmcnt(0) lgkmcnt(0)" ::: "memory"); __builtin_amdgcn_s_barrier(); asm volatile("" ::: "memory");
#undef DMA_K
#undef DMA_V
}

__device__ __forceinline__ void unit3(const bf16_t* __restrict__ Qb, const bf16_t* __restrict__ Kh, const bf16_t* __restrict__ Vh, bf16_t* __restrict__ Ob, int NT, int lim, unsigned char* ldsg, LAS unsigned char* lds) {
    int tid_ = threadIdx.x; asm volatile("" : "+v"(tid_));
    const int tid = tid_, wid = __builtin_amdgcn_readfirstlane(tid >> 6), lane = tid & 63, r32 = lane & 31, hi = lane >> 5, hb = MK_HB(wid);
    LAS float* wsf = (LAS float*)(lds + OFF_W) + wid * 64; LAS float* li_l = wsf; LAS float* al_l = wsf + 32;
    float m_reg = -1e30f, l_reg = 0; f32x16 o[8] = {}; bf16x8 qr[8];
    const bf16_t* Qw = Qb + (long)(wid * QBLK + r32) * LDQ + hi * 8;
#pragma unroll
    for (int d0 = 0; d0 < 8; ++d0) qr[d0] = *reinterpret_cast<const bf16x8*>(Qw + d0 * 16);
#define DMA_K(t_, b_) do { const char* gk = (const char*)Kh + (size_t)(t_) * (KVBLK * LDQ * 2); int ln_ = lane; asm volatile("" : "+v"(ln_)); _Pragma("unroll") for (int i = 0; i < 2; ++i) { \
        const int row = wid * 4 + i * 32 + (ln_ >> 4); const unsigned ko = (unsigned)(row * LDQ * 2 + (((ln_ & 15) * 16) ^ ((row & MK_KSWM) << 4))); \
        __builtin_amdgcn_global_load_lds((const unsigned*)(gk + ko), (LAS unsigned*)(lds + (b_) * KB + wid * 1024 + i * 8192), 16, 0, 0); } } while (0)
#define DMA_V(t_, b_) do { const char* gv = (const char*)Vh + (size_t)(t_) * (KVBLK * LDQ * 2); int ln_ = lane; asm volatile("" : "+v"(ln_)); _Pragma("unroll") for (int i = 0; i < 4; ++i) { \
        const int st = wid * 2 + i * 16 + (ln_ >> 5), q = ln_ & 31; const int kk = (st >> 3) * 8 + (q >> 2); const int k = (kk & ~0xC) | ((kk & 4) << 1) | ((kk & 8) >> 1); \
        const unsigned vo = (unsigned)(k * LDQ * 2 + ((st & 7) * 32 + (q & 3) * 8) * 2); \
        __builtin_amdgcn_global_load_lds((const unsigned*)(gv + vo), (LAS unsigned*)(lds + OFF_V + (b_) * VB + wid * 1024 + i * 8192), 16, 0, 0); } } while (0)
    DMA_K(0, 0); DMA_V(0, 0); if (1 < NT) { DMA_K(1, 1); DMA_V(1, 1); }
    asm volatile("s_waitcnt vmcnt(0)" ::: "memory"); __builtin_amdgcn_s_barrier(); asm volatile("" ::: "memory");
    bf16x8 pa0, pa1, pa2, pa3;
    int kq = 0, ki = 2;
    int vq = 0, vi = 2;
#define U3_QS(j_) do { f32x16 p0, p1; float mn, alpha; int lq_ = lane; asm volatile("" : "+v"(lq_)); const int r32 = lq_ & 31, hi = lq_ >> 5; \
        qkt(p0, p1, (const char*)ldsg + kq * KB, qr, r32, hi); kq = kq == 2 ? 0 : kq + 1; \
        mask_tile(p0, p1, (j_), lim); \
        partialSM(p0, p1, m_reg, mn, alpha); \
        if (__any(alpha < 1.f)) { if (hi == 0) al_l[r32] = alpha; asm volatile("s_waitcnt lgkmcnt(0)" ::: "memory"); \
            _Pragma("unroll") for (int d = 0; d < 8; ++d) _Pragma("unroll") for (int r = 0; r < 16; ++r) o[d][r] *= al_l[crow(r, hi)]; } \
        finishSM(p0, p1, alpha, l_reg, pa0, pa1, pa2, pa3); } while (0)
#define U3_PV(j_) do { int lp_ = lane; asm volatile("" : "+v"(lp_)); const int vb = (int)(uintptr_t)(ldsg + OFF_V) + v_rd_base(lp_) + vq * VB; vq = vq == 2 ? 0 : vq + 1; \
        pv2_one<0>(o[0], vb, pa0, pa1, pa2, pa3); pv2_one<1>(o[1], vb, pa0, pa1, pa2, pa3); pv2_one<2>(o[2], vb, pa0, pa1, pa2, pa3); pv2_one<3>(o[3], vb, pa0, pa1, pa2, pa3); \
        pv2_one<4>(o[4], vb, pa0, pa1, pa2, pa3); pv2_one<5>(o[5], vb, pa0, pa1, pa2, pa3); pv2_one<6>(o[6], vb, pa0, pa1, pa2, pa3); pv2_one<7>(o[7], vb, pa0, pa1, pa2, pa3); } while (0)
#define U3_EVEN_ISSUE(jj_) do { if ((jj_) + 2 < NT) DMA_K((jj_) + 2, ki); ki = ki == 2 ? 0 : ki + 1; asm volatile("" ::: "memory"); } while (0)
#define U3_ODD_ISSUE(jj_) do { if ((jj_) + 2 < NT) DMA_V((jj_) + 2, vi); vi = vi == 2 ? 0 : vi + 1; asm volatile("" ::: "memory"); } while (0)
#define U3_EVEN_END(jj_) do { if ((jj_) + 2 < NT) asm volatile("s_waitcnt vmcnt(6)" ::: "memory"); else if ((jj_) + 1 < NT) asm volatile("s_waitcnt vmcnt(4)" ::: "memory"); else asm volatile("s_waitcnt vmcnt(0)" ::: "memory");   \
        asm volatile("s_waitcnt lgkmcnt(0)" ::: "memory"); __builtin_amdgcn_s_barrier(); asm volatile("" ::: "memory"); } while (0)
#define U3_ODD_END() do { asm volatile("s_waitcnt lgkmcnt(0)" ::: "memory"); __builtin_amdgcn_s_barrier(); asm volatile("" ::: "memory"); } while (0)
    if (hb == 0) {
#pragma unroll 1
        for (int jj = 0; jj < NT; ++jj) {
            U3_EVEN_ISSUE(jj); U3_QS(jj); U3_EVEN_END(jj);
            U3_ODD_ISSUE(jj); U3_PV(jj); U3_ODD_END();
        }
        U3_EVEN_ISSUE(NT); U3_EVEN_END(NT);
    } else {
        U3_EVEN_ISSUE(0); U3_EVEN_END(0);
#pragma unroll 1
        for (int jj = 0; jj < NT; ++jj) {
            U3_ODD_ISSUE(jj); U3_QS(jj); U3_ODD_END();
            U3_EVEN_ISSUE(jj + 1); U3_PV(jj); U3_EVEN_END(jj + 1);
        }
    }
#undef U3_QS
#undef U3_PV
#undef U3_EVEN_ISSUE
#undef U3_ODD_ISSUE
#undef U3_EVEN_END
#undef U3_ODD_END
    if (hi == 0) li_l[r32] = l_reg; asm volatile("s_waitcnt lgkmcnt(0)" ::: "memory");
    float rli[16];
#pragma unroll
    for (int r = 0; r < 16; ++r) rli[r] = __builtin_amdgcn_rcpf(li_l[crow(r, hi)]);
    bf16_t* Ow = Ob + (long)(wid * QBLK) * LDO;
#pragma unroll
    for (int r = 0; r < 16; ++r) { const int orow = crow(r, hi);
#pragma unroll
        for (int d0 = 0; d0 < 8; ++d0) Ow[(long)orow * LDO + d0 * 32 + r32] = f2bf(o[d0][r] * rli[r]); }
    asm volatile("s_waitcnt vmcnt(0) lgkmcnt(0)" ::: "memory"); __builtin_amdgcn_s_barrier(); asm volatile("" ::: "memory");
#undef DMA_K
#undef DMA_V
}

__device__ __forceinline__ void unit4(const bf16_t* __restrict__ Qb, const bf16_t* __restrict__ Kh, const bf16_t* __restrict__ Vh, bf16_t* __restrict__ Ob, int NT, int lim, unsigned char* ldsg, LAS unsigned char* lds) {
    int tid_ = threadIdx.x; asm volatile("" : "+v"(tid_));
    const int tid = tid_, wid = __builtin_amdgcn_readfirstlane(tid >> 6), lane = tid & 63, hb = MK_HB(wid);
    LAS float* wsf = (LAS float*)(lds + OFF_W) + wid * 64; LAS float* li_l = wsf; LAS float* al_l = wsf + 32;
    float m_reg = -1e30f, l_reg = 0; f32x16 o[8] = {}; bf16x8 qr[8];
    { const int r32 = lane & 31, hi = lane >> 5; const bf16_t* Qw = Qb + (long)(wid * QBLK + r32) * LDQ + hi * 8;
#pragma unroll
      for (int d0 = 0; d0 < 8; ++d0) qr[d0] = *reinterpret_cast<const bf16x8*>(Qw + d0 * 16); }
#define DMA_K(t_, b_) do { const char* gk = (const char*)Kh + (size_t)(t_) * (KVBLK * LDQ * 2); int ln_ = lane; asm volatile("" : "+v"(ln_)); _Pragma("unroll") for (int i = 0; i < 2; ++i) { \
        const int row = wid * 4 + i * 32 + (ln_ >> 4); const unsigned ko = (unsigned)(row * LDQ * 2 + (((ln_ & 15) * 16) ^ ((row & MK_KSWM) << 4))); \
        __builtin_amdgcn_global_load_lds((const unsigned*)(gk + ko), (LAS unsigned*)(lds + (b_) * KB + wid * 1024 + i * 8192), 16, 0, 0); } } while (0)
#define DMA_V(t_, b_) do { const char* gv = (const char*)Vh + (size_t)(t_) * (KVBLK * LDQ * 2); int ln_ = lane; asm volatile("" : "+v"(ln_)); _Pragma("unroll") for (int i = 0; i < 4; ++i) { \
        const int st = wid * 2 + i * 16 + (ln_ >> 5), q = ln_ & 31; const int kk = (st >> 3) * 8 + (q >> 2); const int k = (kk & ~0xC) | ((kk & 4) << 1) | ((kk & 8) >> 1); \
        const unsigned vo = (unsigned)(k * LDQ * 2 + ((st & 7) * 32 + (q & 3) * 8) * 2); \
        __builtin_amdgcn_global_load_lds((const unsigned*)(gv + vo), (LAS unsigned*)(lds + OFF_V + (b_) * VB + wid * 1024 + i * 8192), 16, 0, 0); } } while (0)
    DMA_K(0, 0); DMA_V(0, 0); if (1 < NT) { DMA_K(1, 1); DMA_V(1, 1); } if (2 < NT) DMA_K(2, 2);
    asm volatile("s_waitcnt vmcnt(0)" ::: "memory"); __builtin_amdgcn_s_barrier(); asm volatile("" ::: "memory");
    f32x16 p0, p1; bf16x8 pa0, pa1, pa2, pa3;
    int kq = 0, ki = 0, vq = 0, vi = 2;
#define U4_QK() do { int lq_ = lane; asm volatile("" : "+v"(lq_)); qkt(p0, p1, (const char*)ldsg + kq * KB, qr, lq_ & 31, lq_ >> 5); kq = kq == 2 ? 0 : kq + 1; } while (0)
#define U4_SM(j_) do { float mn, alpha; int lq_ = lane; asm volatile("" : "+v"(lq_)); const int r32 = lq_ & 31, hi = lq_ >> 5; \
        mask_tile(p0, p1, (j_), lim); \
        partialSM(p0, p1, m_reg, mn, alpha); \
        if (__any(alpha < 1.f)) { if (hi == 0) al_l[r32] = alpha; asm volatile("s_waitcnt lgkmcnt(0)" ::: "memory"); \
            _Pragma("unroll") for (int d = 0; d < 8; ++d) _Pragma("unroll") for (int r = 0; r < 16; ++r) o[d][r] *= al_l[crow(r, hi)]; } \
        finishSM(p0, p1, alpha, l_reg, pa0, pa1, pa2, pa3); } while (0)
#define U4_PV() do { int lp_ = lane; asm volatile("" : "+v"(lp_)); const int vb = (int)(uintptr_t)(ldsg + OFF_V) + v_rd_base(lp_) + vq * VB; vq = vq == 2 ? 0 : vq + 1; \
        pv2_all(o, vb, pa0, pa1, pa2, pa3); } while (0)
#define U4_ISSUE(s_) do { if (((s_) & 1) == 0) { if ((s_) >= 2) { if ((s_) / 2 + 2 < NT) DMA_K((s_) / 2 + 2, ki); ki = ki == 2 ? 0 : ki + 1; } } \
        else { if ((s_) >= 3) { if (((s_) + 1) / 2 < NT) DMA_V(((s_) + 1) / 2, vi); vi = vi == 2 ? 0 : vi + 1; } } asm volatile("" ::: "memory"); } while (0)
#define U4_END(s_) do { if ((s_) & 1) { const int kt = ((s_) + 1) / 2 + 1, vt = ((s_) + 1) / 2;     \
            if ((s_) >= 3 && kt < NT && vt < NT) asm volatile("s_waitcnt vmcnt(6)" ::: "memory"); \
            else if ((s_) >= 3 && vt < NT) asm volatile("s_waitcnt vmcnt(4)" ::: "memory"); \
            else asm volatile("s_waitcnt vmcnt(0)" ::: "memory"); } \
        asm volatile("s_waitcnt lgkmcnt(0)" ::: "memory"); __builtin_amdgcn_s_barrier(); asm volatile("" ::: "memory"); } while (0)
    if (hb == 0) {
        U4_ISSUE(0); U4_QK(); U4_END(0);
#pragma unroll 1
        for (int m = 0; m < NT; ++m) {
            U4_ISSUE(2 * m + 1); U4_SM(m); U4_END(2 * m + 1);
            U4_ISSUE(2 * m + 2); U4_PV(); if (m + 1 < NT) U4_QK(); U4_END(2 * m + 2);
        }
        U4_ISSUE(2 * NT + 1); U4_END(2 * NT + 1);
    } else {
        U4_ISSUE(0); U4_END(0);
        U4_ISSUE(1); U4_QK(); U4_END(1);
#pragma unroll 1
        for (int m = 0; m < NT; ++m) {
            U4_ISSUE(2 * m + 2); U4_SM(m); U4_END(2 * m + 2);
            U4_ISSUE(2 * m + 3); U4_PV(); if (m + 1 < NT) U4_QK(); U4_END(2 * m + 3);
        }
    }
#undef U4_QK
#undef U4_SM
#undef U4_PV
#undef U4_ISSUE
#undef U4_END
    const int r32 = lane & 31, hi = lane >> 5;
    if (hi == 0) li_l[r32] = l_reg; asm volatile("s_waitcnt lgkmcnt(0)" ::: "memory");
    float rli[16];
#pragma unroll
    for (int r = 0; r < 16; ++r) rli[r] = __builtin_amdgcn_rcpf(li_l[crow(r, hi)]);
    bf16_t* Ow = Ob + (long)(wid * QBLK) * LDO;
#pragma unroll
    for (int r = 0; r < 16; ++r) { const int orow = crow(r, hi);
#pragma unroll
        for (int d0 = 0; d0 < 8; ++d0) Ow[(long)orow * LDO + d0 * 32 + r32] = f2bf(o[d0][r] * rli[r]); }
    asm volatile("s_waitcnt vmcnt(0) lgkmcnt(0)" ::: "memory"); __builtin_amdgcn_s_barrier(); asm volatile("" ::: "memory");
#undef DMA_K
#undef DMA_V
}

__device__ __forceinline__ void unit5(const bf16_t* __restrict__ Qb, const bf16_t* __restrict__ Kh, const bf16_t* __restrict__ Vh, bf16_t* __restrict__ Ob, int NT, int lim, unsigned char* ldsg, LAS unsigned char* lds) {
    int tid_ = threadIdx.x; asm volatile("" : "+v"(tid_));
    const int tid = tid_, wid = __builtin_amdgcn_readfirstlane(tid >> 6), lane = tid & 63, hb = MK_HB(wid);
    LAS float* wsf = (LAS float*)(lds + OFF_W) + wid * 64; LAS float* li_l = wsf; LAS float* al_l = wsf + 32;
    float m_reg = -1e30f, l_reg = 0; f32x16 o[8] = {}; bf16x8 qr[8];
    { const int r32 = lane & 31, hi = lane >> 5; const bf16_t* Qw = Qb + (long)(wid * QBLK + r32) * LDQ + hi * 8;
#pragma unroll
      for (int d0 = 0; d0 < 8; ++d0) qr[d0] = *reinterpret_cast<const bf16x8*>(Qw + d0 * 16); }
#define DMA_K(t_, b_) do { const char* gk = (const char*)Kh + (size_t)(t_) * (KVBLK * LDQ * 2); int ln_ = lane; asm volatile("" : "+v"(ln_)); _Pragma("unroll") for (int i = 0; i < 2; ++i) { \
        const int row = wid * 4 + i * 32 + (ln_ >> 4); const unsigned ko = (unsigned)(row * LDQ * 2 + (((ln_ & 15) * 16) ^ ((row & MK_KSWM) << 4))); \
        __builtin_amdgcn_global_load_lds((const unsigned*)(gk + ko), (LAS unsigned*)(lds + (b_) * KB + wid * 1024 + i * 8192), 16, 0, 0); } } while (0)
#define DMA_V(t_, b_) do { const char* gv = (const char*)Vh + (size_t)(t_) * (KVBLK * LDQ * 2); int ln_ = lane; asm volatile("" : "+v"(ln_)); _Pragma("unroll") for (int i = 0; i < 4; ++i) { \
        const int st = wid * 2 + i * 16 + (ln_ >> 5), q = ln_ & 31; const int kk = (st >> 3) * 8 + (q >> 2); const int k = (kk & ~0xC) | ((kk & 4) << 1) | ((kk & 8) >> 1); \
        const unsigned vo = (unsigned)(k * LDQ * 2 + ((st & 7) * 32 + (q & 3) * 8) * 2); \
        __builtin_amdgcn_global_load_lds((const unsigned*)(gv + vo), (LAS unsigned*)(lds + OFF_V + (b_) * VB + wid * 1024 + i * 8192), 16, 0, 0); } } while (0)
    DMA_K(0, 0); DMA_V(0, 0); if (1 < NT) DMA_K(1, 1);
    asm volatile("s_waitcnt vmcnt(0)" ::: "memory"); __builtin_amdgcn_s_barrier(); asm volatile("" ::: "memory");
    bf16x8 pa0, pa1, pa2, pa3;
    int kb = 0, kb1 = 1, kb2 = 2;
#define U5_ISSUE(j_) do { if ((j_) + 1 < NT) DMA_V((j_) + 1, kb1); asm volatile("" ::: "memory"); if ((j_) + 2 < NT) DMA_K((j_) + 2, kb2); asm volatile("" ::: "memory"); } while (0)
#define U5_QS(j_) do { f32x16 p0, p1; float mn, alpha; int lq_ = lane; asm volatile("" : "+v"(lq_)); const int r32 = lq_ & 31, hi = lq_ >> 5; \
        qkt(p0, p1, (const char*)ldsg + kb * KB, qr, r32, hi); \
        mask_tile(p0, p1, (j_), lim); \
        partialSM(p0, p1, m_reg, mn, alpha); \
        if (__any(alpha < 1.f)) { if (hi == 0) al_l[r32] = alpha; asm volatile("s_waitcnt lgkmcnt(0)" ::: "memory"); \
            _Pragma("unroll") for (int d = 0; d < 8; ++d) _Pragma("unroll") for (int r = 0; r < 16; ++r) o[d][r] *= al_l[crow(r, hi)]; } \
        finishSM(p0, p1, alpha, l_reg, pa0, pa1, pa2, pa3); } while (0)
#define U5_PV(vbuf_) do { int lp_ = lane; asm volatile("" : "+v"(lp_)); const int vb = (int)(uintptr_t)(ldsg + OFF_V) + v_rd_base(lp_) + (vbuf_) * VB; pv2_all(o, vb, pa0, pa1, pa2, pa3); } while (0)
#define U5_END(j_) do { if ((j_) + 2 < NT) asm volatile("s_waitcnt vmcnt(2)" ::: "memory"); else asm volatile("s_waitcnt vmcnt(0)" ::: "memory"); \
        asm volatile("s_waitcnt lgkmcnt(0)" ::: "memory"); __builtin_amdgcn_s_barrier(); asm volatile("" ::: "memory"); \
        { const int t_ = kb; kb = kb1; kb1 = kb2; kb2 = t_; } } while (0)
    if (hb == 0) {
#pragma unroll 1
        for (int j = 0; j < NT; ++j) { U5_ISSUE(j); U5_QS(j); U5_PV(kb); U5_END(j); }
    } else {
#pragma unroll 1
        for (int j = 0; j < NT; ++j) { U5_ISSUE(j); if (j > 0) U5_PV(kb2); U5_QS(j); U5_END(j); }
        U5_PV(kb2);
    }
#undef U5_ISSUE
#undef U5_QS
#undef U5_PV
#undef U5_END
    const int r32 = lane & 31, hi = lane >> 5;
    if (hi == 0) li_l[r32] = l_reg; asm volatile("s_waitcnt lgkmcnt(0)" ::: "memory");
    float rli[16];
#pragma unroll
    for (int r = 0; r < 16; ++r) rli[r] = __builtin_amdgcn_rcpf(li_l[crow(r, hi)]);
    bf16_t* Ow = Ob + (long)(wid * QBLK) * LDO;
#pragma unroll
    for (int r = 0; r < 16; ++r) { const int orow = crow(r, hi);
#pragma unroll
        for (int d0 = 0; d0 < 8; ++d0) Ow[(long)orow * LDO + d0 * 32 + r32] = f2bf(o[d0][r] * rli[r]); }
    asm volatile("s_waitcnt vmcnt(0) lgkmcnt(0)" ::: "memory"); __builtin_amdgcn_s_barrier(); asm volatile("" ::: "memory");
#undef DMA_K
#undef DMA_V
}

constexpr int v6_off(int c, int cb, int h) { return c * 16384 + h * 8192 + cb * 256; }
struct V6Set { s16x4 l0, h0, l1, h1, l2, h2, l3, h3; };
template <int C, int G> __device__ __forceinline__ void v6_load(V6Set& f, int vb) {
    f.l0 = tr_read<v6_off(C, 4 * G + 0, 0)>(vb); f.h0 = tr_read<v6_off(C, 4 * G + 0, 1)>(vb); f.l1 = tr_read<v6_off(C, 4 * G + 1, 0)>(vb); f.h1 = tr_read<v6_off(C, 4 * G + 1, 1)>(vb);
    f.l2 = tr_read<v6_off(C, 4 * G + 2, 0)>(vb); f.h2 = tr_read<v6_off(C, 4 * G + 2, 1)>(vb); f.l3 = tr_read<v6_off(C, 4 * G + 3, 0)>(vb); f.h3 = tr_read<v6_off(C, 4 * G + 3, 1)>(vb);
}
template <int G> __device__ __forceinline__ void v6_mma(f32x4 (&o)[2][16], const V6Set& f, bf16x8 pa0, bf16x8 pa1) {
#define PK(Lo, Hi) (bf16x8){Lo[0], Lo[1], Lo[2], Lo[3], Hi[0], Hi[1], Hi[2], Hi[3]}
    o[0][4 * G + 0] = __builtin_amdgcn_mfma_f32_16x16x32_bf16(pa0, PK(f.l0, f.h0), o[0][4 * G + 0], 0, 0, 0);
    o[1][4 * G + 0] = __builtin_amdgcn_mfma_f32_16x16x32_bf16(pa1, PK(f.l0, f.h0), o[1][4 * G + 0], 0, 0, 0);
    o[0][4 * G + 1] = __builtin_amdgcn_mfma_f32_16x16x32_bf16(pa0, PK(f.l1, f.h1), o[0][4 * G + 1], 0, 0, 0);
    o[1][4 * G + 1] = __builtin_amdgcn_mfma_f32_16x16x32_bf16(pa1, PK(f.l1, f.h1), o[1][4 * G + 1], 0, 0, 0);
    o[0][4 * G + 2] = __builtin_amdgcn_mfma_f32_16x16x32_bf16(pa0, PK(f.l2, f.h2), o[0][4 * G + 2], 0, 0, 0);
    o[1][4 * G + 2] = __builtin_amdgcn_mfma_f32_16x16x32_bf16(pa1, PK(f.l2, f.h2), o[1][4 * G + 2], 0, 0, 0);
    o[0][4 * G + 3] = __builtin_amdgcn_mfma_f32_16x16x32_bf16(pa0, PK(f.l3, f.h3), o[0][4 * G + 3], 0, 0, 0);
    o[1][4 * G + 3] = __builtin_amdgcn_mfma_f32_16x16x32_bf16(pa1, PK(f.l3, f.h3), o[1][4 * G + 3], 0, 0, 0);
#undef PK
}
__device__ __forceinline__ void pv6_all(f32x4 (&o)[2][16], int vb, bf16x8 pa00, bf16x8 pa01, bf16x8 pa10, bf16x8 pa11) {
    V6Set A, B;
#define W8() do { asm volatile("s_waitcnt lgkmcnt(8)" ::: "memory"); SBAR(); } while (0)
    v6_load<0, 0>(A, vb);
    v6_load<0, 1>(B, vb); W8(); v6_mma<0>(o, A, pa00, pa10); SBAR();
    v6_load<0, 2>(A, vb); W8(); v6_mma<1>(o, B, pa00, pa10); SBAR();
    v6_load<0, 3>(B, vb); W8(); v6_mma<2>(o, A, pa00, pa10); SBAR();
    v6_load<1, 0>(A, vb); W8(); v6_mma<3>(o, B, pa00, pa10); SBAR();
    v6_load<1, 1>(B, vb); W8(); v6_mma<0>(o, A, pa01, pa11); SBAR();
    v6_load<1, 2>(A, vb); W8(); v6_mma<1>(o, B, pa01, pa11); SBAR();
    v6_load<1, 3>(B, vb); W8(); v6_mma<2>(o, A, pa01, pa11); SBAR();
    asm volatile("s_waitcnt lgkmcnt(0)" ::: "memory"); SBAR(); v6_mma<3>(o, B, pa01, pa11); SBAR();
#undef W8
}
#ifndef MK_X16SWAP
#define MK_X16SWAP 0
#endif
__device__ __forceinline__ float grp_max(float v) {
#if MK_X16SWAP
    { auto rr = __builtin_amdgcn_permlane16_swap(__float_as_uint(v), __float_as_uint(v), false, false); v = fmaxf(__uint_as_float(rr[0]), __uint_as_float(rr[1])); }
#else
    v = fmaxf(v, __shfl_xor(v, 16));
#endif
    { auto rr = __builtin_amdgcn_permlane32_swap(__float_as_uint(v), __float_as_uint(v), false, false); v = fmaxf(__uint_as_float(rr[0]), __uint_as_float(rr[1])); }
    return v;
}
__device__ __forceinline__ float grp_sum(float v) {
#if MK_X16SWAP
    { auto rr = __builtin_amdgcn_permlane16_swap(__float_as_uint(v), __float_as_uint(v), false, false); v = __uint_as_float(rr[0]) + __uint_as_float(rr[1]); }
#else
    v += __shfl_xor(v, 16);
#endif
    { auto rr = __builtin_amdgcn_permlane32_swap(__float_as_uint(v), __float_as_uint(v), false, false); v = __uint_as_float(rr[0]) + __uint_as_float(rr[1]); }
    return v;
}
__device__ __forceinline__ void unit6(const bf16_t* __restrict__ Qb, const bf16_t* __restrict__ Kh, const bf16_t* __restrict__ Vh, bf16_t* __restrict__ Ob, int NT, int lim, unsigned char* ldsg, LAS unsigned char* lds) {
    int tid_ = threadIdx.x; asm volatile("" : "+v"(tid_));
    const int tid = tid_, wid = __builtin_amdgcn_readfirstlane(tid >> 6), lane = tid & 63, c16 = lane & 15, g = lane >> 4;
    LAS float* wsf = (LAS float*)(lds + OFF_W) + wid * 64; LAS float* li_l = wsf; LAS float* al_l = wsf + 32;
    float m0 = -1e30f, m1 = -1e30f, l0 = 0.f, l1 = 0.f;
    f32x4 o[2][16];
#pragma unroll
    for (int qb = 0; qb < 2; ++qb)
#pragma unroll
        for (int cb = 0; cb < 16; ++cb) o[qb][cb] = (f32x4){0.f, 0.f, 0.f, 0.f};
    bf16x8 qr[2][4];
    { const bf16_t* Qw = Qb + (long)(wid * QBLK + c16) * LDQ + g * 8;
#pragma unroll
      for (int qb = 0; qb < 2; ++qb)
#pragma unroll
          for (int ds = 0; ds < 4; ++ds) qr[qb][ds] = *reinterpret_cast<const bf16x8*>(Qw + (long)qb * 16 * LDQ + ds * 32); }
    const int ka0 = c16 * 256 + ((g * 16) ^ (c16 << 4));
    const int vb0 = (int)(uintptr_t)(ldsg + OFF_V) + (g >> 1) * 4096 + (g & 1) * 128 + (c16 >> 2) * 32 + (c16 & 3) * 8;
    unsigned ko0, vo0;
    { const int row = wid * 4 + (lane >> 4); ko0 = (unsigned)(row * LDQ * 2 + (((lane & 15) * 16) ^ ((row & 15) << 4)));
      const int key = (wid >> 2) * 8 + ((lane & 15) >> 1), col = (4 * (wid & 3) + (lane >> 4)) * 16 + (lane & 1) * 8;
      vo0 = (unsigned)(key * LDQ * 2 + col * 2); }
#define DMA_K(t_, b_) do { const char* gk = (const char*)Kh + (size_t)(t_) * (KVBLK * LDQ * 2); _Pragma("unroll") for (int i = 0; i < 2; ++i) { \
        __builtin_amdgcn_global_load_lds((const unsigned*)(gk + (size_t)i * (32 * LDQ * 2) + ko0), (LAS unsigned*)(lds + (b_) * KB + wid * 1024 + i * 8192), 16, 0, 0); } } while (0)
#define DMA_V(t_, b_) do { const char* gv = (const char*)Vh + (size_t)(t_) * (KVBLK * LDQ * 2); _Pragma("unroll") for (int i = 0; i < 4; ++i) { \
        __builtin_amdgcn_global_load_lds((const unsigned*)(gv + (size_t)i * (16 * LDQ * 2) + vo0), (LAS unsigned*)(lds + OFF_V + (b_) * VB + wid * 1024 + i * 8192), 16, 0, 0); } } while (0)
    DMA_K(0, 0); DMA_V(0, 0); if (1 < NT) { DMA_K(1, 1); DMA_V(1, 1); }
    asm volatile("s_waitcnt vmcnt(0)" ::: "memory"); __builtin_amdgcn_s_barrier(); asm volatile("" ::: "memory");
    int kb3 = 0;
    for (int j = 0; j < NT; ++j) {
        const int kb2 = kb3 == 0 ? 2 : kb3 - 1;
        if (j + 2 < NT) DMA_V(j + 2, kb2);
        asm volatile("" ::: "memory");
        if (j + 2 < NT) DMA_K(j + 2, kb2);
        asm volatile("" ::: "memory");
        if (j <= lim) {
        constexpr float C = SCALE * 1.4426950408889634f;
        f32x4 s[4][2];
#pragma unroll
        for (int kb = 0; kb < 4; ++kb) { s[kb][0] = (f32x4){0.f, 0.f, 0.f, 0.f}; s[kb][1] = (f32x4){0.f, 0.f, 0.f, 0.f}; }
        { const char* Ks = (const char*)ldsg + kb3 * KB;
#pragma unroll
          for (int ds = 0; ds < 4; ++ds) {
              bf16x8 kf[4];
#pragma unroll
              for (int kb = 0; kb < 4; ++kb) kf[kb] = *reinterpret_cast<const bf16x8*>(Ks + kb * 4096 + (ka0 ^ (ds << 6)));
#pragma unroll
              for (int kb = 0; kb < 4; ++kb) { s[kb][0] = __builtin_amdgcn_mfma_f32_16x16x32_bf16(kf[kb], qr[0][ds], s[kb][0], 0, 0, 0);
                                               s[kb][1] = __builtin_amdgcn_mfma_f32_16x16x32_bf16(kf[kb], qr[1][ds], s[kb][1], 0, 0, 0); } } }
        int jz = j; asm volatile("" : "+s"(jz));
        if (jz == 0) {
            asm volatile("; tile-0 mask" ::: "memory");
#pragma unroll
            for (int kb = 0; kb < 3; ++kb)
#pragma unroll
                for (int r = 0; r < 4; ++r) { s[kb][0][r] = -1e30f; s[kb][1][r] = -1e30f; }
        }
        float pm0 = s[0][0][0], pm1 = s[0][1][0];
#pragma unroll
        for (int kb = 0; kb < 4; ++kb)
#pragma unroll
            for (int r = 0; r < 4; ++r) { pm0 = fmaxf(pm0, s[kb][0][r]); pm1 = fmaxf(pm1, s[kb][1][r]); }
        pm0 = grp_max(pm0); pm1 = grp_max(pm1);
        float a0, a1;
        if (__builtin_expect(__all(fmaxf(pm0 - m0, pm1 - m1) <= THR / SCALE), 1)) { a0 = 1.f; a1 = 1.f; }
        else { const float n0 = fmaxf(m0, pm0), n1 = fmaxf(m1, pm1); a0 = __builtin_amdgcn_exp2f((m0 - n0) * C); a1 = __builtin_amdgcn_exp2f((m1 - n1) * C); m0 = n0; m1 = n1; }
        if (__any(a0 < 1.f || a1 < 1.f)) {
            if (g == 0) { al_l[c16] = a0; al_l[16 + c16] = a1; } asm volatile("s_waitcnt lgkmcnt(0)" ::: "memory");
            const f32x4 q0 = *(const LAS f32x4*)(al_l + 4 * g), q1 = *(const LAS f32x4*)(al_l + 16 + 4 * g);
            asm volatile("s_waitcnt lgkmcnt(0)" ::: "memory");
#pragma unroll
            for (int cb = 0; cb < 16; ++cb)
#pragma unroll
                for (int r = 0; r < 4; ++r) { o[0][cb][r] *= q0[r]; o[1][cb][r] *= q1[r]; }
        }
        const float mc0 = -m0 * C, mc1 = -m1 * C;
        float ps0 = 0.f, ps1 = 0.f;
#pragma unroll
        for (int kb = 0; kb < 4; ++kb)
#pragma unroll
            for (int r = 0; r < 4; ++r) { s[kb][0][r] = __builtin_amdgcn_exp2f(fmaf(s[kb][0][r], C, mc0)); s[kb][1][r] = __builtin_amdgcn_exp2f(fmaf(s[kb][1][r], C, mc1)); }
#pragma unroll
        for (int kb = 0; kb < 4; ++kb)
#pragma unroll
            for (int r = 0; r < 4; ++r) { ps0 += s[kb][0][r]; ps1 += s[kb][1][r]; }
        ps0 = grp_sum(ps0); ps1 = grp_sum(ps1);
        l0 = l0 * a0 + ps0; l1 = l1 * a1 + ps1;
        bf16x8 pa00, pa01, pa10, pa11;
#define PK6(QB, CH, OUT) do { u32x4 w_ = {cvt_pk_bf16(s[2 * CH][QB][0], s[2 * CH][QB][1]), cvt_pk_bf16(s[2 * CH][QB][2], s[2 * CH][QB][3]), \
                                          cvt_pk_bf16(s[2 * CH + 1][QB][0], s[2 * CH + 1][QB][1]), cvt_pk_bf16(s[2 * CH + 1][QB][2], s[2 * CH + 1][QB][3])}; OUT = *reinterpret_cast<bf16x8*>(&w_); } while (0)
        PK6(0, 0, pa00); PK6(0, 1, pa01); PK6(1, 0, pa10); PK6(1, 1, pa11);
#undef PK6
        SBAR();
        pv6_all(o, vb0 + kb3 * VB, pa00, pa01, pa10, pa11);
        }
        if (j + 2 < NT) asm volatile("s_waitcnt vmcnt(6)" ::: "memory"); else asm volatile("s_waitcnt vmcnt(0)" ::: "memory");
        __builtin_amdgcn_s_barrier(); asm volatile("" ::: "memory");
        kb3 = kb3 == 2 ? 0 : kb3 + 1;
    }
    if (g == 0) { li_l[c16] = l0; li_l[16 + c16] = l1; } asm volatile("s_waitcnt lgkmcnt(0)" ::: "memory");
    f32x4 r0 = *(const LAS f32x4*)(li_l + 4 * g), r1 = *(const LAS f32x4*)(li_l + 16 + 4 * g);
#pragma unroll
    for (int r = 0; r < 4; ++r) { r0[r] = __builtin_amdgcn_rcpf(r0[r]); r1[r] = __builtin_amdgcn_rcpf(r1[r]); }
    bf16_t* Ow = Ob + (long)(wid * QBLK + 4 * g) * LDO + c16;
#pragma unroll
    for (int r = 0; r < 4; ++r)
#pragma unroll
        for (int cb = 0; cb < 16; ++cb) { Ow[(long)r * LDO + cb * 16] = f2bf(o[0][cb][r] * r0[r]); Ow[(long)(16 + r) * LDO + cb * 16] = f2bf(o[1][cb][r] * r1[r]); }
    asm volatile("s_waitcnt vmcnt(0) lgkmcnt(0)" ::: "memory"); __builtin_amdgcn_s_barrier(); asm volatile("" ::: "memory");
#undef DMA_K
#undef DMA_V
}
}

#ifndef MK_ATT2
#define MK_ATT2 1
#endif
#ifndef MK_PROBE_QK2
#define MK_PROBE_QK2 0
#endif
#ifndef MK_PROBE_DMA2
#define MK_PROBE_DMA2 0
#endif
#ifndef MK_ATT_UNIT
#define MK_ATT_UNIT unit2
#endif
#if MK_ATT2
__device__ __forceinline__ void attn_phase(const Fr& F) {
    const bf16_t* Q = slotY(F, 0); const bf16_t* K = slotY(F, 1); const bf16_t* V = slotY(F, 2);
    bf16_t* AO = slotU(F, 1);
    const int x = F.bid & 7, j = (F.bid >> 3) & 31;
#pragma unroll 1
    for (int k = 0; k < 4; ++k) {
        if (F.bid >= 256) break;
        const int sub = 4 * x + k, head = sub >> 1, c = sub & 1;
        const bf16_t* Kp = K + head * 256 + c * 128; const bf16_t* Vp = V + head * 256;
#pragma unroll 1
        for (int u = 0; u < 2; ++u) {
            const int t = u == 0 ? 63 - j : j;
            const int row0 = 256 * t + 128;
            att2::MK_ATT_UNIT(Q + (size_t)row0 * D + head * 256 + c * 128, Kp, Vp, AO + (size_t)row0 * 8192 + head * 512 + c * 256, 4 * t + 6, 4 * t + 2 + (F.wave >> 1), F.ldsg, F.lds);
        }
        if (j == 8 * k) att2::MK_ATT_UNIT(Q + head * 256 + c * 128, Kp, Vp, AO + head * 512 + c * 256, 4, F.wave >> 1, F.ldsg, F.lds);
    }
}
#else
__device__ __forceinline__ void attn_phase(const Fr& F) {
    const bf16_t* Q = slotY(F, 0); const bf16_t* K = slotY(F, 1); const bf16_t* V = slotY(F, 2);
    bf16_t* AO = slotU(F, 1);
    const int x = F.bid & 7, j = (F.bid >> 3) & 31;
#pragma unroll 1
    for (int k = 0; k < 8; ++k) {
        if (F.bid >= 256) break;
        const int sub = 8 * x + k, head = sub >> 2, c = (sub >> 1) & 1, half = sub & 1;
        const bf16_t* Kp = K + head * 256 + c * 128; const bf16_t* Vp = V + head * 256 + half * 128;
#pragma unroll 1
        for (int u = 0; u < 2; ++u) {
            const int t = u == 0 ? 63 - j : j;
            const int row0 = 256 * t + 128;
            att::unit(Q + (size_t)row0 * D + head * 256 + c * 128, Kp, Vp, AO + (size_t)row0 * 8192 + head * 512 + c * 256 + half * 128, 4 * t + 6, 4 * t + 2 + (F.wave >> 1), (char*)F.ldsg);
        }
        if (j == 4 * k) att::unit(Q + head * 256 + c * 128, Kp, Vp, AO + head * 512 + c * 256 + half * 128, 4, F.wave >> 1, (char*)F.ldsg);
    }
}
#endif
__device__ __forceinline__ void attn_post(const Fr& F) {
    const bf16_t* AO = slotU(F, 1); const bf16_t* GT = slotY(F, 3); bf16_t* Z = slotU(F, 0);
    const float* sg = F.in(13);
    constexpr float LINIT = 0.35550906759096934f;
    float lam;
    { const float* q1 = F.in(9); const float* k1 = F.in(10); const float* q2 = F.in(11); const float* k2 = F.in(12);
      const float d1 = wave_sum(q1[F.lane] * k1[F.lane] + q1[F.lane + 64] * k1[F.lane + 64]), d2 = wave_sum(q2[F.lane] * k2[F.lane] + q2[F.lane + 64] * k2[F.lane + 64]);
      lam = expf(d1) - expf(d2) + LINIT; }
    const f32x4 g4 = ((const f32x4*)sg)[F.lane];
    for (int r = F.gw; r < R; r += F.NGW) {
        const bool real = (r >= NPAD && r < NREAL);
        u32x2* zr = (u32x2*)(Z + (size_t)r * D) + F.lane;
        if (!real) { const u32x2 z = {0u, 0u};
#pragma unroll
            for (int hd = 0; hd < 16; ++hd) zr[64 * hd] = z;
            continue; }
        gp_ ao0 = (gp_)(AO + (size_t)r * 8192) + F.lane * 8 + 4096; gp_ ao1 = ao0 + 8192; asm volatile("" : "+v"(ao0), "+v"(ao1));
        ROW_BF(gq, GT + (size_t)r * D, F.lane); ROW_BF(zq, Z + (size_t)r * D, F.lane);
        u32x2 a0v[16], a1v[16], gtv[16];
#pragma unroll
        for (int hd = 0; hd < 16; ++hd) {
            a0v[hd] = *(GAS u32x2*)(hd < 8 ? ao0 + (2 * hd) * 512 - 4096 : ao1 + (2 * hd - 16) * 512 - 4096);
            a1v[hd] = *(GAS u32x2*)(hd < 8 ? ao0 + (2 * hd + 1) * 512 - 4096 : ao1 + (2 * hd - 15) * 512 - 4096);
            gtv[hd] = AT_BF(gq, hd);
        }
#pragma unroll
        for (int hd = 0; hd < 16; ++hd) {
            const u32x2 a0 = a0v[hd], a1 = a1v[hd], gt = gtv[hd];
            const float o0 = bflo(a0.x) - lam * bflo(a1.x), o1 = bfhi(a0.x) - lam * bfhi(a1.x), o2 = bflo(a0.y) - lam * bflo(a1.y), o3 = bfhi(a0.y) - lam * bfhi(a1.y);
            const float ss = wave_sum((o0 * o0 + o1 * o1) + (o2 * o2 + o3 * o3));
            const float rs = __builtin_amdgcn_rsqf(ss * (1.f / 256.f) + 1e-5f) * (1.f - LINIT);
            u32x2 w; w.x = cvt_pk_bf16(o0 * rs * g4.x * silu_f(bflo(gt.x)), o1 * rs * g4.y * silu_f(bfhi(gt.x))); w.y = cvt_pk_bf16(o2 * rs * g4.z * silu_f(bflo(gt.y)), o3 * rs * g4.w * silu_f(bfhi(gt.y)));
            AT_BF(zq, hd) = w;
        }
    }
}

constexpr int RW_TT = 32, RW_TOKF = 384, RW_TILEF = RW_TT * RW_TOKF, RW_NTILE = 513;
__device__ __forceinline__ void rwkv_scan_seq(const Fr& F) {
    const bf16_t* Rr = slotY(F, 0); const bf16_t* K = slotY(F, 1); const bf16_t* V = slotY(F, 2); const bf16_t* W = slotY(F, 4); const bf16_t* A = slotY(F, 5);
    float* O32 = (float*)slotU(F, 1);
    LAS float* ring = (LAS float*)F.lds; LAS float* otile = ring + 2 * RW_TILEF;
    const int tid = F.tid, lane = F.lane, wid = F.wave;
    for (int unit = F.bid; unit < 256; unit += F.G) {
        const int h = unit >> 2, rg = unit & 3;
        const int ptid = tid - 256, ptt = ptid >> 3, dg = ptid & 7;
        float kkc[8], kac[8];
        if (wid >= 4) {
#pragma unroll
            for (int i = 0; i < 8; ++i) { kkc[i] = F.in(23)[h * 64 + 8 * dg + i]; kac[i] = F.in(24)[h * 64 + 8 * dg + i]; }
        }
        float S0 = 0.f, S1 = 0.f, S2 = 0.f, S3 = 0.f;
        const int cg = lane & 15, irow = 4 * wid + (lane >> 4);
#define RW_PRODUCE(m, buf) do { const int row = NPAD + 32 * (m) + ptt; const size_t off = (size_t)row * D + h * 64 + 8 * dg; \
        const u32x4 r8 = *(const u32x4*)(Rr + off), k8 = *(const u32x4*)(K + off), v8 = *(const u32x4*)(V + off), w8 = *(const u32x4*)(W + off), a8 = *(const u32x4*)(A + off); \
        const unsigned rw[4] = {r8.x, r8.y, r8.z, r8.w}, kw[4] = {k8.x, k8.y, k8.z, k8.w}, vw[4] = {v8.x, v8.y, v8.z, v8.w}, ww[4] = {w8.x, w8.y, w8.z, w8.w}, aw[4] = {a8.x, a8.y, a8.z, a8.w}; \
        float rf[8], kf[8], vf[8], wf[8], af[8], kk[8]; float ssq = 0.f; \
        _Pragma("unroll") for (int i = 0; i < 4; ++i) { rf[2 * i] = bflo(rw[i]); rf[2 * i + 1] = bfhi(rw[i]); kf[2 * i] = bflo(kw[i]); kf[2 * i + 1] = bfhi(kw[i]); vf[2 * i] = bflo(vw[i]); vf[2 * i + 1] = bfhi(vw[i]); \
            wf[2 * i] = bflo(ww[i]); wf[2 * i + 1] = bfhi(ww[i]); af[2 * i] = bflo(aw[i]); af[2 * i + 1] = bfhi(aw[i]); } \
        _Pragma("unroll") for (int i = 0; i < 8; ++i) { kk[i] = kf[i] * kkc[i]; ssq += kk[i] * kk[i]; } \
        ssq = red8(ssq); const float inv = 1.f / fmaxf(sqrtf(ssq), 1e-12f); \
        LAS float* tb = ring + (buf) * RW_TILEF + ptt * RW_TOKF; \
        _Pragma("unroll") for (int q = 0; q < 2; ++q) { LAS f32x4* p = (LAS f32x4*)(tb + (2 * dg + q) * 20); \
            f32x4 t0, t1, t2, t3, t4; \
            _Pragma("unroll") for (int e = 0; e < 4; ++e) { const int i = 4 * q + e; const float kn = kk[i] * inv; t0[e] = wf[i]; t1[e] = -kn; t2[e] = kn * af[i]; t3[e] = kf[i] * (1.f + (af[i] - 1.f) * kac[i]); t4[e] = rf[i]; } \
            p[0] = t0; p[1] = t1; p[2] = t2; p[3] = t3; p[4] = t4; } \
        LAS f32x4* pv = (LAS f32x4*)(tb + 320 + 8 * dg); pv[0] = (f32x4){vf[0], vf[1], vf[2], vf[3]}; pv[1] = (f32x4){vf[4], vf[5], vf[6], vf[7]}; } while (0)
#define RW_FLUSH(m, buf) do { const int row = NPAD + 32 * (m) + ptt; if (row < NREAL) { const LAS float* ot = otile + (buf) * 512 + ptt * 16 + 2 * dg; \
        *(float2*)(O32 + (size_t)row * D + h * 64 + 16 * rg + 2 * dg) = make_float2(ot[0], ot[1]); } } while (0)
        if (wid >= 4) RW_PRODUCE(0, 0);
        __syncthreads();
        for (int n = 0; n < RW_NTILE; ++n) {
            if (wid < 4) {
                const LAS float* tb = ring + (n & 1) * RW_TILEF; LAS float* ot = otile + (n & 1) * 512;
#pragma unroll 4
                for (int tt = 0; tt < RW_TT; ++tt) {
                    const LAS float* p = tb + tt * RW_TOKF + cg * 20;
                    const f32x4 w4 = *(const LAS f32x4*)p, nk = *(const LAS f32x4*)(p + 4), ka = *(const LAS f32x4*)(p + 8), kp = *(const LAS f32x4*)(p + 12), r4 = *(const LAS f32x4*)(p + 16);
                    const float v = tb[tt * RW_TOKF + 320 + 16 * rg + irow];
                    float sa = (S0 * nk.x + S1 * nk.y) + (S2 * nk.z + S3 * nk.w);
                    sa = red16(sa);
                    S0 = S0 * w4.x + (sa * ka.x + v * kp.x); S1 = S1 * w4.y + (sa * ka.y + v * kp.y); S2 = S2 * w4.z + (sa * ka.z + v * kp.z); S3 = S3 * w4.w + (sa * ka.w + v * kp.w);
                    float o = (S0 * r4.x + S1 * r4.y) + (S2 * r4.z + S3 * r4.w);
                    o = red16(o);
                    if (cg == 0) ot[tt * 16 + irow] = o;
                }
            } else {
                if (n + 1 < RW_NTILE) RW_PRODUCE(n + 1, (n + 1) & 1);
                if (n > 0) RW_FLUSH(n - 1, (n - 1) & 1);
            }
            __syncthreads();
        }
        if (wid >= 4) RW_FLUSH(RW_NTILE - 1, (RW_NTILE - 1) & 1);
        __syncthreads();
#undef RW_PRODUCE
#undef RW_FLUSH
    }
}

#ifndef RC_SYNC
#define RC_SYNC 0
#endif
constexpr int RC_SLOT = 13312, RC_NSLOT = 8, RC_SCR0 = RC_NSLOT * RC_SLOT, RC_SCR = 5632, RC_FLAGS = RC_SCR0 + 7 * RC_SCR, RC_NCH = 1025;
constexpr int RC_AT = 0, RC_RT = 2176, RC_BTT = 4352, RC_KTT = 6912, RC_TT = 9472, RC_G3F = 9984, RC_VTF = 10496, RC_P1 = 11008, RC_P2 = 12032, RC_WC = 13056;
static_assert(RC_FLAGS + 64 <= 147456 - 256, "rwkv LDS map");
typedef short s16x4v __attribute__((ext_vector_type(4)));
__device__ __forceinline__ void lora2_phase(const Fr& F) {
    const bf16_t* T = (const bf16_t*)(F.ws + WS_T); const bf16_t* W2T = (const bf16_t*)(F.ws + WS_W2P);
    const int c16 = F.lane & 15, g = F.lane >> 4;
    struct BSet { bf16x8 f[2][4]; f32x4 b0, b1; };
#define L2_LOAD(S_, grp_) do { _Pragma("unroll") for (int b = 0; b < 2; ++b) _Pragma("unroll") for (int ks = 0; ks < 4; ++ks) S_.f[b][ks] = *reinterpret_cast<const bf16x8*>(wb + (size_t)((grp_) * 32 + 4 * b) * 128 + ks * 32); \
        S_.b0 = *(const GAS f32x4*)(bias + (grp_) * 32); S_.b1 = *(const GAS f32x4*)(bias + (grp_) * 32 + 4); } while (0)
#define L2_COMP(S_, grp_) do { f32x4 acc[2][4]; \
        _Pragma("unroll") for (int b = 0; b < 2; ++b) _Pragma("unroll") for (int rb = 0; rb < 4; ++rb) acc[b][rb] = (f32x4){0.f, 0.f, 0.f, 0.f}; \
        _Pragma("unroll") for (int ks = 0; ks < 4; ++ks) _Pragma("unroll") for (int b = 0; b < 2; ++b) _Pragma("unroll") for (int rb = 0; rb < 4; ++rb) \
            acc[b][rb] = __builtin_amdgcn_mfma_f32_16x16x32_bf16(S_.f[b][ks], af[rb][ks], acc[b][rb], 0, 0, 0); \
        _Pragma("unroll") for (int rb = 0; rb < 4; ++rb) { f32x4 v0 = acc[0][rb] + S_.b0, v1 = acc[1][rb] + S_.b1; \
            _Pragma("unroll") for (int jj = 0; jj < 4; ++jj) { float s0 = __builtin_amdgcn_rcpf(1.f + __expf(-v0[jj])), s1 = __builtin_amdgcn_rcpf(1.f + __expf(-v1[jj])); \
                if (!sel) { s0 = __expf(-0.606531f * s0); s1 = __expf(-0.606531f * s1); } L2_PROBE_MATH(v0[jj], v1[jj]); v0[jj] = s0; v1[jj] = s1; } \
            st_bf8(dst + (size_t)rb * 16 * D + (grp_) * 32, v0, v1); } } while (0)
#ifdef MK_L2MATH2
#define L2_PROBE_MATH(x0_, x1_) do { float t0_ = (x0_), t1_ = (x1_); asm volatile("" : "+v"(t0_), "+v"(t1_)); t0_ = __builtin_amdgcn_rcpf(1.f + __expf(-t0_)); t1_ = __builtin_amdgcn_rcpf(1.f + __expf(-t1_)); \
        if (!sel) { t0_ = __expf(-0.606531f * t0_); t1_ = __expf(-0.606531f * t1_); } asm volatile("" :: "v"(t0_), "v"(t1_)); } while (0)
#else
#define L2_PROBE_MATH(x0_, x1_) do { } while (0)
#endif
#define L2_WAIT(n_) do { SBAR(); asm volatile("s_waitcnt vmcnt(" #n_ ")" ::: "memory"); SBAR(); } while (0)
#pragma unroll 1
    for (int it = F.bid; it < (R / 64) * 8; it += F.G) {
        const int panel = it >> 3, sel = (it >> 2) & 1, q = it & 3;
        const int row0 = panel * 64, colw = q * 1024 + F.wave * 128;
        const GAS float* bias = (const GAS float*)(sel ? F.in(20) : F.in(17)) + colw + 8 * g;
        bf16_t* dst = slotY(F, sel ? 5 : 4) + (size_t)(row0 + c16) * D + colw + 8 * g;
        const bf16_t* ta = T + (size_t)(row0 + c16) * 256 + sel * 128 + 8 * g;
        const bf16_t* wb = W2T + (size_t)(sel * 4096 + colw + 8 * (c16 >> 2) + (c16 & 3)) * 128 + 8 * g;
        bf16x8 af[4][4]; BSet A, B;
#pragma unroll
        for (int rb = 0; rb < 4; ++rb)
#pragma unroll
            for (int ks = 0; ks < 4; ++ks) af[rb][ks] = *reinterpret_cast<const bf16x8*>(ta + (size_t)rb * 16 * 256 + ks * 32);
        L2_LOAD(A, 0); SBAR();
        L2_LOAD(B, 1); L2_WAIT(10); L2_COMP(A, 0); SBAR();
        L2_LOAD(A, 2); L2_WAIT(14); L2_COMP(B, 1); SBAR();
        L2_LOAD(B, 3); L2_WAIT(14); L2_COMP(A, 2); SBAR();
        L2_WAIT(4); L2_COMP(B, 3); SBAR();
    }
#undef L2_LOAD
#undef L2_COMP
#undef L2_WAIT
}
__device__ __forceinline__ void rwkv_kknorm(const Fr& F) {
    const bf16_t* K = slotY(F, 1); const float* k_k = F.in(23); float* INV = (float*)(F.ws + WS_HE);
    f32x4 c4v[16];
    { ROW_F32(cq, k_k, F.lane);
#pragma unroll
      for (int it = 0; it < 16; ++it) c4v[it] = AT_F32(cq, it); }
    for (int r = F.gw; r < R; r += F.NGW) {
        ROW_BF(kq_, K + (size_t)r * D, F.lane);
        u32x2 kv[16];
#pragma unroll
        for (int it = 0; it < 16; ++it) kv[it] = AT_BF(kq_, it);
#pragma unroll
        for (int it = 0; it < 16; ++it) {
            const u32x2 kk = kv[it]; const f32x4 c4 = c4v[it];
            const float a = bflo(kk.x) * c4.x, b = bfhi(kk.x) * c4.y, c = bflo(kk.y) * c4.z, d = bfhi(kk.y) * c4.w;
            const float ss = red16((a * a + b * b) + (c * c + d * d));
            if ((F.lane & 15) == 0) INV[(size_t)r * 64 + it * 4 + (F.lane >> 4)] = 1.f / fmaxf(sqrtf(ss), 1e-12f);
        }
    }
}
__device__ __forceinline__ unsigned lds_poll(volatile LAS unsigned* p) { return *p; }
__device__ __forceinline__ void rwkv_scan(const Fr& F) {
    const bf16_t* Rr = slotY(F, 0); const bf16_t* K = slotY(F, 1); const bf16_t* V = slotY(F, 2); const bf16_t* W = slotY(F, 4); const bf16_t* A = slotY(F, 5);
    const float* INV = (const float*)(F.ws + WS_HE);
    float* O32 = (float*)slotU(F, 1);
    LAS unsigned char* L = F.lds;
    volatile LAS unsigned* flags = (volatile LAS unsigned*)(L + RC_FLAGS);
    const int lane = F.lane, wid = F.wave, l15 = lane & 15, kg = lane >> 4;
    for (int unit = F.bid; unit < 256; unit += F.G) {
        const int h = unit >> 2, rgw = unit & 3;
        if (F.tid < 16) flags[F.tid] = 0u;
        __syncthreads();
        if (wid == 0) {
            __builtin_amdgcn_s_setprio(3);
            f32x4 S0 = {0.f, 0.f, 0.f, 0.f}, S1 = S0, S2 = S0, S3 = S0;
            struct SlotRegs { u32x2 a0l, a0h, a1l, a1h, r0l, r0h, r1l, r1h; f32x4 P1, P2; s16x4v ttf, g3f, vtf, b0, b1, b2, b3, k0, k1, k2, k3; f32x4 w0, w1, w2, w3; };
#if RC_SYNC
#define CH_WAIT(n_) do { if ((n_) % 7 == 0) { __builtin_amdgcn_s_barrier(); __builtin_amdgcn_s_barrier(); } } while (0)
#else
#define CH_WAIT(n_) do { unsigned sp = 0; while (lds_poll(flags + ((n_) & 7)) != (unsigned)((n_) + 1)) { __builtin_amdgcn_s_sleep(1); if (++sp > (1u << 22)) break; } } while (0)
#endif
#define CH_LOAD(R_, n_) do { CH_WAIT(n_); asm volatile("s_waitcnt lgkmcnt(0)" ::: "memory"); const LAS unsigned char* SL = L + ((n_) & 7) * RC_SLOT; \
                const LAS unsigned char* ap = SL + RC_AT + l15 * 136 + kg * 8; const LAS unsigned char* rp = SL + RC_RT + l15 * 136 + kg * 8; \
                R_.a0l = *(const LAS u32x2*)(ap); R_.a0h = *(const LAS u32x2*)(ap + 32); R_.a1l = *(const LAS u32x2*)(ap + 64); R_.a1h = *(const LAS u32x2*)(ap + 96); \
                R_.r0l = *(const LAS u32x2*)(rp); R_.r0h = *(const LAS u32x2*)(rp + 32); R_.r1l = *(const LAS u32x2*)(rp + 64); R_.r1h = *(const LAS u32x2*)(rp + 96); \
                R_.P1 = *(const LAS f32x4*)(SL + RC_P1 + lane * 16); R_.P2 = *(const LAS f32x4*)(SL + RC_P2 + lane * 16); \
                R_.ttf = *(const LAS s16x4v*)(SL + RC_TT + lane * 8); R_.g3f = *(const LAS s16x4v*)(SL + RC_G3F + lane * 8); R_.vtf = *(const LAS s16x4v*)(SL + RC_VTF + lane * 8); \
                const LAS unsigned char* bp = SL + RC_BTT + l15 * 40 + kg * 8; const LAS unsigned char* kp = SL + RC_KTT + l15 * 40 + kg * 8; \
                R_.b0 = *(const LAS s16x4v*)(bp); R_.b1 = *(const LAS s16x4v*)(bp + 640); R_.b2 = *(const LAS s16x4v*)(bp + 1280); R_.b3 = *(const LAS s16x4v*)(bp + 1920); \
                R_.k0 = *(const LAS s16x4v*)(kp); R_.k1 = *(const LAS s16x4v*)(kp + 640); R_.k2 = *(const LAS s16x4v*)(kp + 1280); R_.k3 = *(const LAS s16x4v*)(kp + 1920); \
                const LAS f32x4* wc = (const LAS f32x4*)(SL + RC_WC + kg * 16); R_.w0 = wc[0]; R_.w1 = wc[4]; R_.w2 = wc[8]; R_.w3 = wc[12]; \
                asm volatile("s_waitcnt lgkmcnt(0)" ::: "memory"); \
                if (lane == 0) flags[8] = (unsigned)((n_) + 1); } while (0)
#define CH_COMPUTE(R_, n_, NEXT_) do { \
                u32x4 sb0, sb1; sb0.x = cvt_pk_bf16(S0.x, S0.y); sb0.y = cvt_pk_bf16(S0.z, S0.w); sb0.z = cvt_pk_bf16(S1.x, S1.y); sb0.w = cvt_pk_bf16(S1.z, S1.w); \
                sb1.x = cvt_pk_bf16(S2.x, S2.y); sb1.y = cvt_pk_bf16(S2.z, S2.w); sb1.z = cvt_pk_bf16(S3.x, S3.y); sb1.w = cvt_pk_bf16(S3.z, S3.w); \
                const bf16x8 Sb0 = *reinterpret_cast<bf16x8*>(&sb0), Sb1 = *reinterpret_cast<bf16x8*>(&sb1); \
                u32x4 t4; \
                t4 = (u32x4){R_.a0l.x, R_.a0l.y, R_.a0h.x, R_.a0h.y}; const bf16x8 Aq0 = *reinterpret_cast<bf16x8*>(&t4); \
                t4 = (u32x4){R_.a1l.x, R_.a1l.y, R_.a1h.x, R_.a1h.y}; const bf16x8 Aq1 = *reinterpret_cast<bf16x8*>(&t4); \
                t4 = (u32x4){R_.r0l.x, R_.r0l.y, R_.r0h.x, R_.r0h.y}; const bf16x8 Rq0 = *reinterpret_cast<bf16x8*>(&t4); \
                t4 = (u32x4){R_.r1l.x, R_.r1l.y, R_.r1h.x, R_.r1h.y}; const bf16x8 Rq1 = *reinterpret_cast<bf16x8*>(&t4); \
                f32x4 X = R_.P1, O = R_.P2; \
                X = __builtin_amdgcn_mfma_f32_16x16x32_bf16(Aq0, Sb0, X, 0, 0, 0); \
                X = __builtin_amdgcn_mfma_f32_16x16x32_bf16(Aq1, Sb1, X, 0, 0, 0);                   \
                O = __builtin_amdgcn_mfma_f32_16x16x32_bf16(Rq0, Sb0, O, 0, 0, 0); \
                O = __builtin_amdgcn_mfma_f32_16x16x32_bf16(Rq1, Sb1, O, 0, 0, 0);                   \
                u32x2 yb; yb.x = cvt_pk_bf16(X.x, X.y); yb.y = cvt_pk_bf16(X.z, X.w); \
                f32x4 U = {0.f, 0.f, 0.f, 0.f}; \
                U = __builtin_amdgcn_mfma_f32_16x16x16bf16_1k(R_.ttf, *reinterpret_cast<s16x4v*>(&yb), U, 0, 0, 0);     \
                u32x2 ub; ub.x = cvt_pk_bf16(U.x, U.y); ub.y = cvt_pk_bf16(U.z, U.w); \
                const s16x4v Ub = *reinterpret_cast<s16x4v*>(&ub); \
                S0 = __builtin_amdgcn_mfma_f32_16x16x16bf16_1k(R_.k0, R_.vtf, S0, 0, 0, 0); S1 = __builtin_amdgcn_mfma_f32_16x16x16bf16_1k(R_.k1, R_.vtf, S1, 0, 0, 0); \
                S2 = __builtin_amdgcn_mfma_f32_16x16x16bf16_1k(R_.k2, R_.vtf, S2, 0, 0, 0); S3 = __builtin_amdgcn_mfma_f32_16x16x16bf16_1k(R_.k3, R_.vtf, S3, 0, 0, 0); \
                S0 = __builtin_amdgcn_mfma_f32_16x16x16bf16_1k(R_.b0, Ub, S0, 0, 0, 0); S1 = __builtin_amdgcn_mfma_f32_16x16x16bf16_1k(R_.b1, Ub, S1, 0, 0, 0); \
                S2 = __builtin_amdgcn_mfma_f32_16x16x16bf16_1k(R_.b2, Ub, S2, 0, 0, 0); S3 = __builtin_amdgcn_mfma_f32_16x16x16bf16_1k(R_.b3, Ub, S3, 0, 0, 0); \
                O = __builtin_amdgcn_mfma_f32_16x16x16bf16_1k(R_.g3f, Ub, O, 0, 0, 0);                   \
                NEXT_; \
                S0 = S0 * R_.w0; S1 = S1 * R_.w1; S2 = S2 * R_.w2; S3 = S3 * R_.w3; \
                float* op = O32 + (size_t)(NPAD + 16 * (n_) + 4 * kg) * D + h * 64 + 16 * rgw + l15;     \
                op[0] = O.x; op[D] = O.y; op[2 * D] = O.z; op[3 * D] = O.w; } while (0)
            SlotRegs RA, RB;
            CH_LOAD(RA, 0);
            for (int n = 0; n + 1 < RC_NCH; n += 2) {
                CH_COMPUTE(RA, n, CH_LOAD(RB, n + 1));
                if (n + 2 < RC_NCH) { CH_COMPUTE(RB, n + 1, CH_LOAD(RA, n + 2)); } else { CH_COMPUTE(RB, n + 1, (void)0); }
            }
            if (RC_NCH & 1) { CH_COMPUTE(RA, RC_NCH - 1, (void)0); }
            __builtin_amdgcn_s_setprio(0);
#undef CH_WAIT
#undef CH_LOAD
#undef CH_COMPUTE
        } else {
            const int p = wid - 1;
            LAS unsigned char* SC = L + RC_SCR0 + p * RC_SCR;
            const float kkc = F.in(23)[h * 64 + lane], kac = F.in(24)[h * 64 + lane];
            unsigned short cr[16], ck[16], cw[16], ca[16], nvq[4]; float civ[16];
#define RC_LOADS(nn) do { const int r0n = NPAD + 16 * (nn); \
                _Pragma("unroll") for (int e = 0; e < 4; ++e) nvq[e] = V[(size_t)(r0n + 4 * kg + e) * D + h * 64 + 16 * rgw + l15]; \
                _Pragma("unroll") for (int s = 0; s < 16; ++s) { const size_t off = (size_t)(r0n + s) * D + h * 64 + lane; cr[s] = Rr[off]; ck[s] = K[off]; cw[s] = W[off]; ca[s] = A[off]; civ[s] = INV[(size_t)(r0n + s) * 64 + h]; } } while (0)
            RC_LOADS(p);
            for (int n = p; n < RC_NCH; n += 7) {
                const int slot = n & 7; LAS unsigned char* SL = L + slot * RC_SLOT;
                unsigned short vq[4];
#pragma unroll
                for (int e = 0; e < 4; ++e) vq[e] = nvq[e];
#if RC_SYNC
                asm volatile("s_waitcnt lgkmcnt(0)" ::: "memory"); __builtin_amdgcn_s_barrier();
#else
                if (n >= 8) { unsigned sp = 0; while (lds_poll(flags + 8) < (unsigned)(n - 7)) { __builtin_amdgcn_s_sleep(2); if (++sp > (1u << 22)) break; } }
#endif
                asm volatile("" ::: "memory");
                float Wp = 1.f; unsigned btp[8], ktp[8];
#pragma unroll
                for (int hb = 0; hb < 2; ++hb) {
                    unsigned short rq[8], kq[8], wq[8], aq[8]; float iv[8];
#pragma unroll
                    for (int s = 0; s < 8; ++s) { rq[s] = cr[8 * hb + s]; kq[s] = ck[8 * hb + s]; wq[s] = cw[8 * hb + s]; aq[s] = ca[8 * hb + s]; iv[s] = civ[8 * hb + s]; }
                    float btv[8], ktv[8];
#pragma unroll
                    for (int s = 0; s < 8; ++s) {
                        const int t = 8 * hb + s;
                        const float rs = bf2f(rq[s]), ks = bf2f(kq[s]), wsv = bf2f(wq[s]), as = bf2f(aq[s]);
                        const float kk = ks * kkc * iv[s];
                        const float Wprev = Wp; Wp *= wsv; const float iW = __builtin_amdgcn_rcpf(Wp);
                        const float at = -kk * Wprev, rt = rs * Wp, bt = kk * as * iW, kt = ks * (1.f + (as - 1.f) * kac) * iW;
                        *(LAS bf16_t*)(SL + RC_AT + t * 136 + lane * 2) = f2bf(at); *(LAS bf16_t*)(SL + RC_RT + t * 136 + lane * 2) = f2bf(rt);
                        *(LAS bf16_t*)(SC + t * 136 + lane * 2) = f2bf(bt); *(LAS bf16_t*)(SC + 2176 + t * 136 + lane * 2) = f2bf(kt);
                        btv[s] = bt; ktv[s] = kt;
                    }
#pragma unroll
                    for (int s = 0; s < 4; ++s) { btp[4 * hb + s] = cvt_pk_bf16(btv[2 * s], btv[2 * s + 1]); ktp[4 * hb + s] = cvt_pk_bf16(ktv[2 * s], ktv[2 * s + 1]); }
                }
                {
                    LAS u32x2* bq = (LAS u32x2*)(SL + RC_BTT + lane * 40); LAS u32x2* kq2 = (LAS u32x2*)(SL + RC_KTT + lane * 40);
#pragma unroll
                    for (int q = 0; q < 4; ++q) { bq[q] = (u32x2){btp[2 * q], btp[2 * q + 1]}; kq2[q] = (u32x2){ktp[2 * q], ktp[2 * q + 1]}; }
                    *(LAS float*)(SL + RC_WC + lane * 4) = Wp;
                    u32x2 vt; vt.x = (unsigned)vq[0] | ((unsigned)vq[1] << 16); vt.y = (unsigned)vq[2] | ((unsigned)vq[3] << 16);
                    *(LAS u32x2*)(SL + RC_VTF + lane * 8) = vt;
                }
                if (n + 7 < RC_NCH) RC_LOADS(n + 7);
                asm volatile("s_waitcnt lgkmcnt(0)" ::: "memory");
                f32x4 G1 = {0.f, 0.f, 0.f, 0.f}, G2 = G1, G3 = G1, G4 = G1, G1t = G1;
#pragma unroll
                for (int ks = 0; ks < 2; ++ks) {
                    const bf16x8 fb = *(const LAS bf16x8*)(SC + l15 * 136 + (32 * ks + 8 * kg) * 2), fk = *(const LAS bf16x8*)(SC + 2176 + l15 * 136 + (32 * ks + 8 * kg) * 2);
                    const bf16x8 fa = *(const LAS bf16x8*)(SL + RC_AT + l15 * 136 + (32 * ks + 8 * kg) * 2), fr_ = *(const LAS bf16x8*)(SL + RC_RT + l15 * 136 + (32 * ks + 8 * kg) * 2);
                    G1 = __builtin_amdgcn_mfma_f32_16x16x32_bf16(fb, fa, G1, 0, 0, 0); G2 = __builtin_amdgcn_mfma_f32_16x16x32_bf16(fk, fa, G2, 0, 0, 0);
                    G1t = __builtin_amdgcn_mfma_f32_16x16x32_bf16(fa, fb, G1t, 0, 0, 0);
                    G3 = __builtin_amdgcn_mfma_f32_16x16x32_bf16(fb, fr_, G3, 0, 0, 0); G4 = __builtin_amdgcn_mfma_f32_16x16x32_bf16(fk, fr_, G4, 0, 0, 0);
                }
                {
#pragma unroll
                    for (int e = 0; e < 4; ++e) { const int s = 4 * kg + e; const bool lt = s < l15, le = s <= l15;
                        G1[e] = lt ? G1[e] : 0.f; G1t[e] = (l15 < s) ? G1t[e] : 0.f; G2[e] = lt ? G2[e] : 0.f; G3[e] = le ? G3[e] : 0.f; G4[e] = le ? G4[e] : 0.f; }
                    u32x2 g2, g3, g4; g2.x = cvt_pk_bf16(G2.x, G2.y); g2.y = cvt_pk_bf16(G2.z, G2.w); g3.x = cvt_pk_bf16(G3.x, G3.y); g3.y = cvt_pk_bf16(G3.z, G3.w); g4.x = cvt_pk_bf16(G4.x, G4.y); g4.y = cvt_pk_bf16(G4.z, G4.w);
                    *(LAS u32x2*)(SL + RC_G3F + lane * 8) = g3;
                    u32x2 vt; vt.x = (unsigned)vq[0] | ((unsigned)vq[1] << 16); vt.y = (unsigned)vq[2] | ((unsigned)vq[3] << 16);
                    const s16x4v vtf = *reinterpret_cast<s16x4v*>(&vt);
                    f32x4 P1 = {0.f, 0.f, 0.f, 0.f}, P2 = P1;
                    P1 = __builtin_amdgcn_mfma_f32_16x16x16bf16_1k(*reinterpret_cast<s16x4v*>(&g2), vtf, P1, 0, 0, 0);
                    P2 = __builtin_amdgcn_mfma_f32_16x16x16bf16_1k(*reinterpret_cast<s16x4v*>(&g4), vtf, P2, 0, 0, 0);
                    *(LAS f32x4*)(SL + RC_P1 + lane * 16) = P1; *(LAS f32x4*)(SL + RC_P2 + lane * 16) = P2;
#define RC_BF(v) ({ u32x2 t_; t_.x = cvt_pk_bf16((v).x, (v).y); t_.y = cvt_pk_bf16((v).z, (v).w); *reinterpret_cast<s16x4v*>(&t_); })
                    const f32x4 Z4 = {0.f, 0.f, 0.f, 0.f};
                    const s16x4v n1 = RC_BF(G1), n1t = RC_BF(G1t);
                    const f32x4 X2 = __builtin_amdgcn_mfma_f32_16x16x16bf16_1k(n1t, n1, Z4, 0, 0, 0), X2t = __builtin_amdgcn_mfma_f32_16x16x16bf16_1k(n1, n1t, Z4, 0, 0, 0);
                    const s16x4v n2 = RC_BF(X2), n2t = RC_BF(X2t);
                    const f32x4 X4 = __builtin_amdgcn_mfma_f32_16x16x16bf16_1k(n2t, n2, Z4, 0, 0, 0), X4t = __builtin_amdgcn_mfma_f32_16x16x16bf16_1k(n2, n2t, Z4, 0, 0, 0);
                    const s16x4v n4 = RC_BF(X4), n4t = RC_BF(X4t);
                    f32x4 Tm = __builtin_amdgcn_mfma_f32_16x16x16bf16_1k(n4t, n4, Z4, 0, 0, 0);
#pragma unroll
                    for (int e = 0; e < 4; ++e) Tm[e] += (4 * kg + e == l15) ? 1.f : 0.f;
                    Tm = __builtin_amdgcn_mfma_f32_16x16x16bf16_1k(n4t, RC_BF(Tm), Tm, 0, 0, 0);
                    Tm = __builtin_amdgcn_mfma_f32_16x16x16bf16_1k(n2t, RC_BF(Tm), Tm, 0, 0, 0);
                    Tm = __builtin_amdgcn_mfma_f32_16x16x16bf16_1k(n1t, RC_BF(Tm), Tm, 0, 0, 0);
                    { u32x2 tt; tt.x = cvt_pk_bf16(Tm.x, Tm.y); tt.y = cvt_pk_bf16(Tm.z, Tm.w); *(LAS u32x2*)(SL + RC_TT + lane * 8) = tt; }
#undef RC_BF
                }
                asm volatile("s_waitcnt lgkmcnt(0)" ::: "memory");
#if RC_SYNC
                __builtin_amdgcn_s_barrier();
#else
                if (lane == 0) flags[slot] = (unsigned)(n + 1);
#endif
            }
#if RC_SYNC
            if (p >= RC_NCH % 7) { __builtin_amdgcn_s_barrier(); __builtin_amdgcn_s_barrier(); }
#endif
        }
#undef RC_LOADS
        __syncthreads();
    }
}
__device__ __forceinline__ void rwkv_post(const Fr& F) {
    const bf16_t* Rr = slotY(F, 0); const bf16_t* K = slotY(F, 1); const bf16_t* V = slotY(F, 2); const bf16_t* GT = slotY(F, 3); const bf16_t* A = slotY(F, 5);
    const float* O32 = (const float*)slotU(F, 1); bf16_t* Z = slotU(F, 0);
    const float* k_a = F.in(24); const float* r_k = F.in(25); const float* lw = F.in(26); const float* lb = F.in(27);
    for (int r = F.gw; r < R; r += F.NGW) {
        const bool real = (r >= NPAD && r < NREAL);
        u32x2* zr = (u32x2*)(Z + (size_t)r * D) + F.lane;
        if (!real) { const u32x2 z = {0u, 0u};
#pragma unroll
            for (int it = 0; it < 16; ++it) zr[64 * it] = z;
            continue; }
        ROW_F32(oq, O32 + (size_t)r * D, F.lane); ROW_BF(rq_, Rr + (size_t)r * D, F.lane); ROW_BF(kq_, K + (size_t)r * D, F.lane); ROW_BF(vq_, V + (size_t)r * D, F.lane);
        ROW_BF(gq_, GT + (size_t)r * D, F.lane); ROW_BF(aq_, A + (size_t)r * D, F.lane); ROW_BF(zq_, Z + (size_t)r * D, F.lane);
        ROW_F32(kap, k_a, F.lane); ROW_F32(rkp, r_k, F.lane); ROW_F32(lwp, lw, F.lane); ROW_F32(lbp, lb, F.lane);
#pragma unroll
        for (int hh = 0; hh < 2; ++hh) {
            f32x4 o4v[8]; u32x2 rrv[8], kkv[8], vvv[8], ggv[8], aav[8];
#pragma unroll
            for (int i8 = 0; i8 < 8; ++i8) { const int it = 8 * hh + i8; o4v[i8] = AT_F32(oq, it); rrv[i8] = AT_BF(rq_, it); kkv[i8] = AT_BF(kq_, it); vvv[i8] = AT_BF(vq_, it); ggv[i8] = AT_BF(gq_, it); aav[i8] = AT_BF(aq_, it); }
#pragma unroll
            for (int i8 = 0; i8 < 8; ++i8) { const int it = 8 * hh + i8;
                const f32x4 o4 = o4v[i8]; const u32x2 rr = rrv[i8], kk = kkv[i8], vv = vvv[i8], gg = ggv[i8], aa = aav[i8];
                const f32x4 ka4 = AT_F32(kap, it), rk4 = AT_F32(rkp, it), lw4 = AT_F32(lwp, it), lb4 = AT_F32(lbp, it);
                const float mean = red16((o4.x + o4.y) + (o4.z + o4.w)) * (1.f / 64.f);
                const float d0 = o4.x - mean, d1 = o4.y - mean, d2 = o4.z - mean, d3 = o4.w - mean;
                const float var = red16((d0 * d0 + d1 * d1) + (d2 * d2 + d3 * d3)) * (1.f / 64.f);
                const float rs = __builtin_amdgcn_rsqf(var + 64e-5f);
                const float r0 = bflo(rr.x), r1 = bfhi(rr.x), r2 = bflo(rr.y), r3 = bfhi(rr.y);
                const float kp0 = bflo(kk.x) * (1.f + (bflo(aa.x) - 1.f) * ka4.x), kp1 = bfhi(kk.x) * (1.f + (bfhi(aa.x) - 1.f) * ka4.y), kp2 = bflo(kk.y) * (1.f + (bflo(aa.y) - 1.f) * ka4.z), kp3 = bfhi(kk.y) * (1.f + (bfhi(aa.y) - 1.f) * ka4.w);
                const float bs = red16((r0 * kp0 * rk4.x + r1 * kp1 * rk4.y) + (r2 * kp2 * rk4.z + r3 * kp3 * rk4.w));
                const float y0 = d0 * rs * lw4.x + lb4.x + bs * bflo(vv.x), y1 = d1 * rs * lw4.y + lb4.y + bs * bfhi(vv.x), y2 = d2 * rs * lw4.z + lb4.z + bs * bflo(vv.y), y3 = d3 * rs * lw4.w + lb4.w + bs * bfhi(vv.y);
                u32x2 w; w.x = cvt_pk_bf16(y0 * silu_f(bflo(gg.x)), y1 * silu_f(bfhi(gg.x))); w.y = cvt_pk_bf16(y2 * silu_f(bflo(gg.y)), y3 * silu_f(bfhi(gg.y)));
                AT_BF(zq_, it) = w;
            }
        }
    }
}
}
namespace mk {
constexpr int LDS_BYTES = 163840;
constexpr int LDS_MISC = LDS_BYTES - 128;
struct Args { const float* in[29]; float* out; unsigned char* ws; };

#define MK_GEMM(EPI, e, Aptr, aps_, Bptr, M_, N_, K_) do { int kk_ = (K_); asm volatile("" : "+s"(kk_));     \
    pg8::Gemm g_{(const bf16_t*)(Aptr), (const bf16_t*)(Bptr), (M_), (N_), kk_, (size_t)(aps_)}; pg8::StaticOrder S_; S_.init((M_), (N_), F.G, F.bid); \
    pg8::gemm_phase<EPI, pg8::StaticOrder, false>(F.lds, g_, S_, e, nullptr); } while (0)

struct TailOrder { int pn;
    __device__ bool next(int i, pg8::Unit& u) const { if (i > 0 || pn < 0) return false; u.pm = 64; u.pn = pn; return true; }
    __device__ __forceinline__ void a_ready(const pg8::Unit&) const {}
    __device__ __forceinline__ void done(const pg8::Unit&) const {}
};
#define MK_GEMM1(EPI, e, aps_, NTOT_, L_) do { MK_GEMM(EPI, e, slotU(F, 0), aps_, wtin_of(F, L_), 16384, NTOT_, D); \
    if (F.bid < (NTOT_) / 256) { int kk_ = D; asm volatile("" : "+s"(kk_)); pg8::Gemm g_{(const bf16_t*)slotU(F, 0), (const bf16_t*)wtin_of(F, L_), R, (NTOT_), kk_, (size_t)(aps_)}; TailOrder St_{F.bid}; \
        pg8::gemm_phase<EPI, TailOrder, false, true>(F.lds, g_, St_, e, nullptr); } } while (0)
#define MK_GEMM2_NORM(prev, next, udst) do { \
    MK_GEMM(EpiY, ey, slotU(F, 0), 0, wtout, 16384, D, D); \
    GRID_BAR(); \
    if (F.bid < 16) { int kk_ = D; asm volatile("" : "+s"(kk_)); pg8::Gemm g_{(const bf16_t*)slotU(F, 0), (const bf16_t*)wtout, R, D, kk_, (size_t)0}; TailOrder St_{F.bid}; \
        pg8::gemm_phase<EpiY, TailOrder, false, true>(F.lds, g_, St_, ey, nullptr); } \
    else { const Fr P = F.fresh(); norm_phase(P, prev, next, slotY(P, 0), udst, 0, 16384, 16); } \
    GRID_BAR(); \
    { const Fr P = F.fresh(); norm_phase(P, prev, next, slotY(P, 0), udst, 16384, R, 0); if ((next) >= 0) convert_layer(P, next, (next) == 3); } \
    GRID_BAR(); } while (0)

__global__ void __launch_bounds__(512, 2) fwd(Args a) {
    extern __shared__ __attribute__((aligned(16))) unsigned char lds_raw[];
    Fr F;
    F.lds = (LAS unsigned char*)lds_raw; F.ldsg = lds_raw;
    F.tid = threadIdx.x; F.lane = F.tid & 63; F.wave = __builtin_amdgcn_readfirstlane(F.tid >> 6);
    F.G = gridDim.x; F.bid = blockIdx.x; F.gw = F.bid * 8 + F.wave; F.NGW = F.G * 8;
    F.out = a.out; F.ws = a.ws;
    volatile LAS unsigned* misc = (volatile LAS unsigned*)(F.lds + LDS_MISC);
    if (F.tid < 16) misc[F.tid] = 0u;
    __syncthreads();
    XcdBarrier bar = xcd_barrier_post((unsigned*)(F.ws + WS_CTL) + 4096, misc + 8);
#ifdef MK_BAR2
#define GRID_BAR() do { xcd_barrier(bar); xcd_barrier(bar); } while (0)
#else
#define GRID_BAR() xcd_barrier(bar)
#endif
#ifndef MK_DUP
#define MK_DUP 0
#endif
#ifndef MK_CLK
#define MK_CLK 0
#endif
#define CLK_SPIN() do { const unsigned long long dc_ = clock64() - clk_c0, dr_ = wall_clock64() - clk_r0; const long mhz_ = (long)(dc_ * 100ull / (dr_ ? dr_ : 1ull)); \
        const long ticks_ = (2400 - mhz_) * 200; const unsigned long long r1_ = wall_clock64(); while ((long)(wall_clock64() - r1_) < ticks_) __builtin_amdgcn_s_sleep(8); } while (0)
#ifndef MK_PH
#define MK_PH 0
#endif
    unsigned long long ph_r0_ = 0ull;
#define PH_BEGIN(id) do { if ((MK_PH >> (id)) & 1) ph_r0_ = wall_clock64(); } while (0)
#define PH_END(id) do { if ((MK_PH >> (id)) & 1) { const unsigned long long dr_ = wall_clock64() - ph_r0_, r1_ = wall_clock64(); while ((unsigned long long)(wall_clock64() - r1_) < dr_) __builtin_amdgcn_s_sleep(8); } } while (0)
#define DUPN(k, ...) do { __VA_ARGS__; if ((MK_DUP >> (k)) & 1) { GRID_BAR(); __VA_ARGS__; } } while (0)
    bf16_t* wtout = (bf16_t*)(F.ws + WS_WTOUT);
    const EpiY ey{slotY(F, 0)};

    PH_BEGIN(1);
    DUPN(11, { const Fr P = F.fresh(); convert_layer(P, 0, true); rope_table(P); norm_phase(P, -1, 0, nullptr, slotU(P, 0)); });
    PH_END(1);
    GRID_BAR();
#if MK_CLK == 1 || MK_CLK == 11
    const unsigned long long clk_c0 = clock64(), clk_r0 = wall_clock64();
#endif
    PH_BEGIN(15);
    { const EpiH1 e{slotY(F, 0), F.in(5), 0}; MK_GEMM1(EpiH1, e, 0, 4 * D, 0); }
#if MK_CLK == 1
    CLK_SPIN();
#endif
#if MK_CLK == 11
    { const unsigned long long dr_ = wall_clock64() - clk_r0, r1_ = wall_clock64(); while ((unsigned long long)(wall_clock64() - r1_) < dr_) __builtin_amdgcn_s_sleep(8); }
#endif
#ifdef MK_KPROBE
    { __syncthreads(); const unsigned kc_ = misc[20]; const unsigned long long r1_ = wall_clock64(); while ((unsigned long long)(wall_clock64() - r1_) < (unsigned long long)kc_) __builtin_amdgcn_s_sleep(8); }
#endif
    if (F.bid >= 64) { const Fr P = F.fresh(); convert_win(P, 1, 64); }
    PH_END(15);
    GRID_BAR();
    PH_BEGIN(13);
    DUPN(1, { const Fr P = F.fresh(); hgrn_phase<false>(P, 0); });
    PH_END(13);
    GRID_BAR();
    PH_BEGIN(14);
    DUPN(2, { const Fr P = F.fresh(); hgrn_phase<true>(P, 0); });
    PH_END(14);
    GRID_BAR();
    PH_BEGIN(2);
    MK_GEMM2_NORM(0, 1, slotU(F, 0));
    PH_END(2);
    PH_BEGIN(16);
    { const EpiB1 e{slotY(F, 0), (const float*)(F.ws + WS_ROPE), (const float*)(F.ws + WS_ROPE) + (size_t)R * 16}; PH_BEGIN(20); MK_GEMM1(EpiB1, e, 0, 4 * D, 1); PH_END(20); }
    PH_BEGIN(21);
    if (F.bid >= 64) { const Fr P = F.fresh(); convert_win(P, 2, 64); }
    PH_END(21);
    PH_END(16);
    GRID_BAR();
#if MK_CLK == 3
    const unsigned long long clk_c0 = clock64(), clk_r0 = wall_clock64();
#endif
    PH_BEGIN(6);
    DUPN(3, { const Fr P = F.fresh(); attn_phase(P); });
    PH_END(6);
#if MK_CLK == 3
    CLK_SPIN();
#endif
    GRID_BAR();
    PH_BEGIN(7);
    DUPN(4, { const Fr P = F.fresh(); attn_post(P); });
    PH_END(7);
    GRID_BAR();
    PH_BEGIN(3);
    MK_GEMM2_NORM(1, 2, slotY(F, 1));
    PH_END(3);
    PH_BEGIN(8);
    DUPN(7, { const Fr P = F.fresh(); mix_phase(P, slotY(P, 1)); convert_layer2_b(P); });
    PH_END(8);
    GRID_BAR();
    PH_BEGIN(9);
    { const EpiC1 e{slotY(F, 0), (bf16_t*)(F.ws + WS_T)}; MK_GEMM(EpiC1, e, slotU(F, 0), (size_t)R * D, wtin_of(F, 2), R, 4 * D + 512, D); }
    PH_END(9);
    GRID_BAR();
    PH_BEGIN(10);
    DUPN(9, { const Fr P = F.fresh(); lora2_phase(P); });
    { const Fr P = F.fresh(); rwkv_kknorm(P); }
    PH_END(10);
    GRID_BAR();
    PH_BEGIN(11);
    DUPN(5, { const Fr P = F.fresh(); rwkv_scan(P); });
    PH_END(11);
    GRID_BAR();
    PH_BEGIN(12);
    DUPN(6, { const Fr P = F.fresh(); rwkv_post(P); });
    PH_END(12);
    GRID_BAR();
    PH_BEGIN(4);
    MK_GEMM2_NORM(2, 3, slotU(F, 0));
    PH_END(4);
    PH_BEGIN(17);
    { const EpiH1 e{slotY(F, 0), F.in(5), 1}; MK_GEMM1(EpiH1, e, 0, 4 * D, 3); }
    PH_END(17);
    GRID_BAR();
    PH_BEGIN(18);
    { const Fr P = F.fresh(); hgrn_phase<false>(P, 1); }
    PH_END(18);
    GRID_BAR();
    PH_BEGIN(19);
    { const Fr P = F.fresh(); hgrn_phase<true>(P, 1); }
    PH_END(19);
    GRID_BAR();
    PH_BEGIN(5);
    MK_GEMM2_NORM(3, -1, (bf16_t*)nullptr);
    PH_END(5);
}
}

extern "C" void kernel_launch(void* const* d_in, const int* in_sizes, int n_in, void* d_out, int out_size, void* d_ws, size_t ws_size, hipStream_t stream) {
    static int grid = 0;
    if (grid == 0) {
        if (n_in != 29 || out_size != 16384 * 4096 || ws_size < mk::WS_END) { fprintf(stderr, "kernel_launch: unexpected shapes (n_in %d out %d ws %zu need %zu)\n", n_in, out_size, ws_size, (size_t)mk::WS_END); grid = -1; return; }
        int dev = 0, cus = 0, per_cu = 0;
        if (hipGetDevice(&dev) != hipSuccess || hipDeviceGetAttribute(&cus, hipDeviceAttributeMultiprocessorCount, dev) != hipSuccess) { grid = -1; return; }
        if (hipFuncSetAttribute((const void*)mk::fwd, hipFuncAttributeMaxDynamicSharedMemorySize, mk::LDS_BYTES) != hipSuccess) { fprintf(stderr, "kernel_launch: hipFuncSetAttribute failed\n"); grid = -1; return; }
        if (hipOccupancyMaxActiveBlocksPerMultiprocessor(&per_cu, (const void*)mk::fwd, 512, mk::LDS_BYTES) != hipSuccess || per_cu < 1) { fprintf(stderr, "kernel_launch: occupancy query says %d\n", per_cu); }
        (void)hipGetLastError();
        grid = cus;
    }
    if (grid < 0) return;
    if (hipMemsetAsync((char*)d_ws + mk::WS_CTL, 0, mk::CTL_BYTES, stream) != hipSuccess) return;
    mk::Args a{};
    for (int i = 0; i < 29; ++i) a.in[i] = (const float*)d_in[i];
    a.out = (float*)d_out; a.ws = (unsigned char*)d_ws;
    hipLaunchKernelGGL(mk::fwd, dim3(grid), dim3(512), mk::LDS_BYTES, stream, a);
}
```

```cpp
#include <hip/hip_runtime.h>
#include <cstdio>
#include <cstdint>

#define LAS __attribute__((address_space(3)))
#define GAS __attribute__((address_space(1)))
typedef unsigned short bf16_t;
typedef short bf16x8 __attribute__((ext_vector_type(8)));
typedef short s16x4 __attribute__((ext_vector_type(4)));
typedef float f32x4 __attribute__((ext_vector_type(4)));
typedef float f32x16 __attribute__((ext_vector_type(16)));
typedef unsigned u32x4 __attribute__((ext_vector_type(4)));
typedef unsigned u32x2 __attribute__((ext_vector_type(2)));

namespace mk {
constexpr int D = 4096, NPAD = 48, NREAL = 16448, R = 16640, NCH = 257;
constexpr size_t MiB = 1u << 20;
constexpr size_t SLOT = (size_t)R * D * 2;
constexpr size_t WS_CTL = 0, CTL_BYTES = 1 * MiB;
constexpr size_t WS_WTIN = 2 * MiB;
constexpr size_t WS_WTOUT = 134 * MiB;
constexpr size_t WS_W2P = 166 * MiB;
constexpr size_t WS_ROPE = 170 * MiB;
constexpr size_t WS_HMETA = 174 * MiB;
constexpr size_t WS_HE = 175 * MiB;
constexpr size_t WS_HLOGD = 191 * MiB;
constexpr size_t WS_U = 192 * MiB;
constexpr size_t WS_Y = WS_U + 6 * SLOT;
constexpr size_t WS_T = WS_Y + 6 * SLOT;
constexpr size_t WS_WTINB = WS_U + 4 * SLOT;
constexpr size_t WS_HB = (WS_T + (size_t)R * 256 * 2 + MiB - 1) / MiB * MiB;
constexpr size_t WS_END = WS_HB + SLOT;
static_assert(WS_END <= 2040 * MiB, "d_ws map");

typedef __bf16 bf16x2n_t __attribute__((ext_vector_type(2)));
typedef float f32x2n_t __attribute__((ext_vector_type(2)));
__device__ __forceinline__ unsigned cvt_pk_bf16(float lo, float hi) { const f32x2n_t v = {lo, hi}; const bf16x2n_t r = __builtin_convertvector(v, bf16x2n_t); return __builtin_bit_cast(unsigned, r); }
__device__ __forceinline__ float bflo(unsigned w) { return __uint_as_float(w << 16); }
__device__ __forceinline__ float bfhi(unsigned w) { return __uint_as_float(w & 0xffff0000u); }
__device__ __forceinline__ float bf2f(bf16_t b) { return __uint_as_float(((unsigned)b) << 16); }
__device__ __forceinline__ bf16_t f2bf(float f) { return (bf16_t)(cvt_pk_bf16(f, f) & 0xffffu); }
__device__ __forceinline__ float sigmoid_f(float x) { return 1.f / (1.f + __expf(-x)); }
__device__ __forceinline__ float silu_f(float x) { return x / (1.f + __expf(-x)); }
__device__ __forceinline__ float wave_sum(float v) {
#pragma unroll
    for (int o = 1; o < 64; o <<= 1) v += __shfl_xor(v, o);
    return v;
}
template <int CTRL> __device__ __forceinline__ float dppf(float v) { return __int_as_float(__builtin_amdgcn_update_dpp(0, __float_as_int(v), CTRL, 0xf, 0xf, true)); }
__device__ __forceinline__ float red4(float v) { v += dppf<0xB1>(v); v += dppf<0x4E>(v); return v; }
__device__ __forceinline__ float red8(float v) { v = red4(v); v += dppf<0x141>(v); return v; }
__device__ __forceinline__ float red16(float v) { v = red8(v); v += dppf<0x140>(v); return v; }
#define LDS_WAIT() asm volatile("s_waitcnt lgkmcnt(0)" ::: "memory")
}
#define XB_TMO      128
#define XB_XCNT(j)  (256  + 64 * (j))
#define XB_XSUB(j)  (1280 + 64 * (j))
#define XB_XGEN(j)  (2304 + 64 * (j))
#define XB_TOP      3328
#define XB_TOPGEN   3392
#define XCD_BAR_WORDS 3456
#define XB_SPIN_CAP (1u << 18)
#define LAS __attribute__((address_space(3)))

__device__ __forceinline__ unsigned xb_ld(unsigned* p)              { return __hip_atomic_load(p, __ATOMIC_RELAXED, __HIP_MEMORY_SCOPE_AGENT); }
__device__ __forceinline__ unsigned xb_add(unsigned* p, unsigned v) { return __hip_atomic_fetch_add(p, v, __ATOMIC_RELAXED, __HIP_MEMORY_SCOPE_AGENT); }
__device__ __forceinline__ unsigned xb_xcc_id() { return (unsigned)__builtin_amdgcn_s_getreg((3 << 11) | 20) & 0xFu; }
#define XB_SPIN(cond, bar) do { unsigned _sp = 0; while (cond) { __builtin_amdgcn_s_sleep(1); \
    if ((++_sp & 255u) == 0u) { if (xb_ld(&(bar)[XB_TMO])) break; if (_sp > XB_SPIN_CAP) { atomicAdd(&(bar)[XB_TMO], 1u); break; } } } } while (0)

struct XcdBarrier {
    unsigned* bar; unsigned x;
    volatile LAS unsigned* st;
};

__device__ __forceinline__ XcdBarrier xcd_barrier_post(unsigned* bar, volatile LAS unsigned* st) {
    XcdBarrier b; b.bar = bar; b.x = xb_xcc_id(); b.st = st;
    if (threadIdx.x == 0) (void)xb_add(&bar[XB_XCNT(b.x)], 1u);
    return b;
}
__device__ __forceinline__ void xcd_barrier_complete(unsigned* bar, unsigned x, unsigned& nloc, unsigned& nx) {
    const unsigned G = gridDim.x * gridDim.y * gridDim.z;
    unsigned sum, cnt, mine, sp = 0u;
    for (;;) {
        sum = 0u; cnt = 0u; mine = 0u;
#pragma unroll
        for (unsigned j = 0; j < 16; ++j) { const unsigned c = xb_ld(&bar[XB_XCNT(j)]); sum += c; cnt += (c > 0u) ? 1u : 0u; mine = (j == x) ? c : mine; }
        if (sum == G) break;
        __builtin_amdgcn_s_sleep(1);
        if ((++sp & 255u) == 0u) { if (xb_ld(&bar[XB_TMO])) break; if (sp > XB_SPIN_CAP) { atomicAdd(&bar[XB_TMO], 1u); break; } }
    }
    nloc = mine > 0u ? mine : 1u; nx = cnt > 0u ? cnt : 1u;
}

__device__ __forceinline__ void xcd_barrier(const XcdBarrier& b) {
    asm volatile("s_waitcnt vmcnt(0)" ::: "memory");
    __syncthreads();
    if (threadIdx.x == 0) {
        unsigned* bar = b.bar;
        __builtin_amdgcn_s_waitcnt(0);
        unsigned nloc = b.st[0], nx = b.st[1];
        if (nloc == 0u) { xcd_barrier_complete(bar, b.x, nloc, nx); b.st[0] = nloc; b.st[1] = nx; }
        const unsigned old = xb_add(&bar[XB_XSUB(b.x)], 1u);
        const unsigned gen = old / nloc;
        if (old + 1u == (gen + 1u) * nloc) {
            __builtin_amdgcn_fence(__ATOMIC_RELEASE, "agent");
            asm volatile("s_waitcnt vmcnt(0)" ::: "memory");
            const unsigned og = xb_add(&bar[XB_TOP], 1u);
            const unsigned tg = og / nx;
            if (og + 1u == (tg + 1u) * nx) xb_add(&bar[XB_TOPGEN], 1u);
            else XB_SPIN(xb_ld(&bar[XB_TOPGEN]) == tg, bar);
            __builtin_amdgcn_fence(__ATOMIC_ACQUIRE, "agent");
            xb_add(&bar[XB_XGEN(b.x)], 1u);
            asm volatile("s_waitcnt vmcnt(0)" ::: "memory");
        } else {
            XB_SPIN(xb_ld(&bar[XB_XGEN(b.x)]) == gen, bar);
            __builtin_amdgcn_fence(__ATOMIC_ACQUIRE, "agent");
            asm volatile("s_waitcnt vmcnt(0)" ::: "memory");
        }
    }
    __syncthreads();
}
#ifndef MK_WGM
#define MK_WGM 8
#endif
namespace pg8 {
#define PG8_LAS __attribute__((address_space(3)))
typedef unsigned short bf16_t;
typedef short bf16x8 __attribute__((ext_vector_type(8)));
typedef float f32x4 __attribute__((ext_vector_type(4)));
typedef unsigned u32x4 __attribute__((ext_vector_type(4)));
constexpr int BM = 256, BK = 64, HALF = 128, HTB = HALF * BK * 2  , STAGE_BYTES = 8 * HTB, NXCD = 8, WGM = 8;

__host__ __device__ __forceinline__ int lds_byte(int r, int c) { const int st = (r >> 4) * 2 + (c >> 5), rr = r & 15, cc = c & 31, ob = rr * 64 + cc * 2; return st * 1024 + (ob ^ (((ob >> 9) & 1) << 5)); }
__host__ __device__ __forceinline__ void stage_rc(int b, int& R, int& C) { const int st = b / 1024, sb = b % 1024, swz = sb ^ (((sb >> 9) & 1) << 5); R = (st >> 1) * 16 + swz / 64; C = (st & 1) * 32 + (swz % 64) / 2; }
__host__ __device__ __forceinline__ int perm32(int rho) { const int n = rho >> 4, i = rho & 15; return 8 * (i >> 2) + 4 * n + (i & 3); }

struct Unit { int pm, pn; };
struct Gemm { const bf16_t* A; const bf16_t* Bt; int M, N, K; size_t aps; };
__device__ __forceinline__ size_t a_part_bytes(const Gemm& g, int pn) { return g.aps ? (size_t)(pn < 64 ? (pn >> 4) : (pn - 60)) * g.aps * 2 : (size_t)0; }

struct StaticOrder {
    int nM, nN, nwg, G, c;
    __host__ __device__ void init(int M, int N, int G_, int c_) { nM = M / BM; nN = N / BM; nwg = nM * nN; G = G_; c = c_; }
    __host__ __device__ bool next(int i, Unit& u) const {
        const long L = (long)i * G + c; if (L >= nwg) return false;
        int wgid = (int)L; { const int q = nwg / NXCD, r = nwg % NXCD, xcd = wgid % NXCD, off = wgid / NXCD; wgid = (xcd < r ? xcd * (q + 1) : r * (q + 1) + (xcd - r) * q) + off; }
        const int nig = WGM * nN, gid = wgid / nig, fm = gid * WGM, gsz = (nM - fm) < WGM ? (nM - fm) : WGM;
        u.pm = fm + ((wgid % nig) % gsz); u.pn = (wgid % nig) / gsz; return true;
    }
    __device__ __forceinline__ void a_ready(const Unit&) const {}
    __device__ __forceinline__ void done(const Unit&) const {}
};
struct CountedOrder : StaticOrder {
    const unsigned* ready; unsigned need; unsigned* tmo;
    __device__ __forceinline__ void a_ready(const Unit& u) const {
        if (threadIdx.x < 64) {
            const unsigned long long t0 = __builtin_amdgcn_s_memrealtime(); unsigned polls = 0;
            while ((unsigned)__builtin_amdgcn_readfirstlane(__hip_atomic_load(ready + 64 * u.pm, __ATOMIC_RELAXED, __HIP_MEMORY_SCOPE_AGENT)) < need) {
                if ((++polls & 255u) == 0u && __builtin_amdgcn_readfirstlane(__hip_atomic_load(tmo, __ATOMIC_RELAXED, __HIP_MEMORY_SCOPE_AGENT)) != 0u) break;
                if (__builtin_amdgcn_s_memrealtime() - t0 > 2000000ull) {
                    if (threadIdx.x == 0) { unsigned expect = 0u; __hip_atomic_compare_exchange_strong(tmo + 1, &expect, 0x600u | (unsigned)(u.pm & 0xff), __ATOMIC_RELAXED, __ATOMIC_RELAXED, __HIP_MEMORY_SCOPE_AGENT); __hip_atomic_store(tmo, 1u, __ATOMIC_RELAXED, __HIP_MEMORY_SCOPE_AGENT); }
                    break; }
                __builtin_amdgcn_s_sleep(2); }
            __builtin_amdgcn_fence(__ATOMIC_ACQUIRE, "agent");
            asm volatile("s_waitcnt vmcnt(0)" ::: "memory");
        }
#if !defined(BROKEN_HOOK_NO_BARRIER)
        asm volatile("" ::: "memory"); __builtin_amdgcn_s_barrier(); asm volatile("" ::: "memory");
#endif
    }
};
template <class Epi, class Sched, bool STAMP = false, bool TOPHALF = false, bool LEFTHALF = false>
__device__ __forceinline__ void gemm_phase(PG8_LAS unsigned char* lds, const Gemm g, const Sched& S, const Epi& E, unsigned long long* stamps) {
    int tid_ = threadIdx.x; asm volatile("" : "+v"(tid_));
    const int tid = tid_, wid = __builtin_amdgcn_readfirstlane(tid >> 6), lane = tid & 63, wr = wid >> 2, wc = wid & 3, fr = lane & 15, fq = lane >> 4;
    const int K = g.K, nt = K / BK;
    int ts_lo = 0, ts_hi = 0, nts = 0; const unsigned long long rt_entry = STAMP ? (unsigned long long)wall_clock64() : 0ull;
#define PG8_STAMP() do { if (STAMP && wid == 0 && nts < 64) { const unsigned long long _c = (unsigned long long)clock64(); \
        ts_lo = (lane == nts) ? (int)(unsigned)_c : ts_lo; ts_hi = (lane == nts) ? (int)(unsigned)(_c >> 32) : ts_hi; ++nts; } } while (0)
    PG8_STAMP();
    unsigned voffA[2], voffB[2];
#pragma unroll
    for (int i = 0; i < 2; ++i) { int R, C; stage_rc(tid * 16 + i * 8192, R, C); const int Rb = Epi::PERM ? ((R & ~31) + perm32(R & 31)) : R;
        voffA[i] = (unsigned)(R * K + C) * 2u; voffB[i] = (unsigned)(Rb * K + C) * 2u; }
    const size_t kstep = (size_t)(BK * 2);
    const size_t hstep = (size_t)HALF * K * 2;
    const size_t tstep = 2 * hstep;
    const unsigned ldsw = (unsigned)wid * 1024u;
    const int aoff = lds_byte(wr * 64 + fr, fq * 8), boff = lds_byte(wc * 32 + fr, fq * 8);
#define PG8_SA(b, h) (((b) * 2 + (h)) * HTB)
#define PG8_SB(b, h) ((4 + (b) * 2 + (h)) * HTB)
#define PG8_STAGE(bufoff, gbase, voff) do { _Pragma("unroll") for (int _i = 0; _i < 2; ++_i) \
        __builtin_amdgcn_global_load_lds((const unsigned*)((const char*)(gbase) + (voff)[_i]), (PG8_LAS unsigned*)(lds + (bufoff) + ldsw + _i * 8192), 16, 0, 0); } while (0)
#define PG8_LDA(dst, b, h) do { _Pragma("unroll") for (int m = 0; m < 4; ++m) _Pragma("unroll") for (int k = 0; k < 2; ++k) dst[m][k] = *(const PG8_LAS bf16x8*)(lds + PG8_SA(b, h) + aoff + m * 2048 + k * 1024); } while (0)
#define PG8_LDB(dst, b, h) do { _Pragma("unroll") for (int n = 0; n < 2; ++n) _Pragma("unroll") for (int k = 0; k < 2; ++k) dst[n][k] = *(const PG8_LAS bf16x8*)(lds + PG8_SB(b, h) + boff + n * 2048 + k * 1024); } while (0)
#define PG8_MMA(ai, bj, At, Bt) do { __builtin_amdgcn_s_setprio(1); _Pragma("unroll") for (int m = 0; m < 4; ++m) _Pragma("unroll") for (int n = 0; n < 2; ++n) _Pragma("unroll") for (int k = 0; k < 2; ++k) \
        acc[ai][bj][m][n] = __builtin_amdgcn_mfma_f32_16x16x32_bf16(Bt[n][k], At[m][k], acc[ai][bj][m][n], 0, 0, 0); __builtin_amdgcn_s_setprio(0); } while (0)
#define PG8_WAIT_V(n) asm volatile("s_waitcnt vmcnt(" #n ")" ::: "memory")
#define PG8_WAIT_L(n) asm volatile("s_waitcnt lgkmcnt(" #n ")" ::: "memory")
#define PG8_BAR __builtin_amdgcn_s_barrier()
#define PG8_SCHED __builtin_amdgcn_sched_barrier(0)
    Unit cur, nxt; int ui = 0;
    if (!S.next(0, cur)) return;
    f32x4 acc[2][2][4][2];
#pragma unroll
    for (int a = 0; a < 2; ++a)
#pragma unroll
        for (int b = 0; b < 2; ++b)
#pragma unroll
            for (int m = 0; m < 4; ++m)
#pragma unroll
                for (int n = 0; n < 2; ++n) acc[a][b][m][n] = (f32x4){0.f, 0.f, 0.f, 0.f};
    bf16x8 At[4][2], B0[2][2], B1[2][2];
    const char* cA = (const char*)g.A + a_part_bytes(g, cur.pn) + (size_t)cur.pm * tstep; const char* cB = (const char*)g.Bt + (size_t)cur.pn * tstep;
    S.a_ready(cur);
    PG8_STAGE(PG8_SB(0, 0), cB, voffB); PG8_STAGE(PG8_SA(0, 0), cA, voffA); PG8_STAGE(PG8_SB(0, 1), cB + hstep, voffB); PG8_STAGE(PG8_SA(0, 1), cA + hstep, voffA);
    if (wr == 1) PG8_BAR;
    PG8_WAIT_V(4); PG8_BAR;
    PG8_STAGE(PG8_SB(1, 0), cB + kstep, voffB); PG8_STAGE(PG8_SA(1, 0), cA + kstep, voffA); PG8_STAGE(PG8_SB(1, 1), cB + hstep + kstep, voffB);
    PG8_WAIT_V(6); PG8_BAR;
    PG8_STAMP();
#ifdef MK_KPROBE
    unsigned long long kp_a_ = 0ull, kp_prev_ = 0ull;
#endif
    for (;;) {
#ifdef MK_KPROBE
        if (MK_KPROBE == 1 && ui == 2) kp_a_ = clock64();
#endif
        const bool has_next = S.next(ui + 1, nxt);
        const char* nA = has_next ? (const char*)g.A + a_part_bytes(g, nxt.pn) + (size_t)nxt.pm * tstep : cA; const char* nB = has_next ? (const char*)g.Bt + (size_t)nxt.pn * tstep : cB;
        for (int t = 0; t < nt; t += 2) {
            const bool last = (t == nt - 2);
            const char* a1 = cA + (size_t)(t + 1) * kstep;
            const char* a2 = last ? nA : cA + (size_t)(t + 2) * kstep; const char* b2 = last ? nB : cB + (size_t)(t + 2) * kstep;
            const char* a3 = a2 + kstep; const char* b3 = b2 + kstep;
            if (last && has_next) S.a_ready(nxt);
            PG8_LDB(B0, 0, 0); PG8_SCHED; PG8_LDA(At, 0, 0); PG8_STAGE(PG8_SA(1, 1), a1 + hstep, voffA);
            PG8_WAIT_L(8); PG8_BAR; PG8_WAIT_L(0); PG8_MMA(0, 0, At, B0); PG8_BAR; PG8_SCHED;
            if constexpr (!LEFTHALF) PG8_LDB(B1, 0, 1); PG8_STAGE(PG8_SB(0, 0), b2, voffB);
            PG8_BAR; PG8_WAIT_L(0); if constexpr (!LEFTHALF) PG8_MMA(0, 1, At, B1); PG8_BAR;
            if constexpr (!TOPHALF) PG8_LDA(At, 0, 1); PG8_STAGE(PG8_SA(0, 0), a2, voffA);
            PG8_BAR; PG8_WAIT_L(0); if constexpr (!TOPHALF) PG8_MMA(1, 0, At, B0); PG8_BAR; PG8_SCHED;
            PG8_STAGE(PG8_SB(0, 1), b2 + hstep, voffB);
            PG8_WAIT_V(6); PG8_BAR; if constexpr (!TOPHALF && !LEFTHALF) PG8_MMA(1, 1, At, B1); PG8_BAR;
            PG8_LDB(B0, 1, 0); PG8_SCHED; PG8_LDA(At, 1, 0); PG8_STAGE(PG8_SA(0, 1), a2 + hstep, voffA);
            PG8_WAIT_L(8); PG8_BAR; PG8_WAIT_L(0); PG8_MMA(0, 0, At, B0); PG8_BAR; PG8_SCHED;
            if constexpr (!LEFTHALF) PG8_LDB(B1, 1, 1); PG8_STAGE(PG8_SB(1, 0), b3, voffB);
            PG8_BAR; PG8_WAIT_L(0); if constexpr (!LEFTHALF) PG8_MMA(0, 1, At, B1); PG8_BAR;
            if constexpr (!TOPHALF) PG8_LDA(At, 1, 1); PG8_STAGE(PG8_SA(1, 0), a3, voffA);
            PG8_BAR; PG8_WAIT_L(0); if constexpr (!TOPHALF) PG8_MMA(1, 0, At, B0); PG8_BAR; PG8_SCHED;
            PG8_STAGE(PG8_SB(1, 1), b3 + hstep, voffB);
            PG8_WAIT_V(6); PG8_BAR; if constexpr (!TOPHALF && !LEFTHALF) PG8_MMA(1, 1, At, B1); PG8_BAR;
        }
        PG8_STAMP();
#ifdef MK_KPROBE
        { const unsigned long long now_ = clock64();
          if (ui == 2 && tid == 0) *(volatile PG8_LAS unsigned*)(lds + 163712 + 80) = (unsigned)(now_ - (MK_KPROBE == 1 ? kp_a_ : kp_prev_));
          kp_prev_ = now_; }
#endif
        if constexpr (!Epi::AFTER_DRAIN) { E(acc, cur, wr, wc, fr, fq); S.done(cur); }
        PG8_STAMP();
        if (!has_next) break;
#pragma unroll
        for (int a = 0; a < 2; ++a)
#pragma unroll
            for (int b = 0; b < 2; ++b)
#pragma unroll
                for (int m = 0; m < 4; ++m)
#pragma unroll
                    for (int n = 0; n < 2; ++n) acc[a][b][m][n] = (f32x4){0.f, 0.f, 0.f, 0.f};
        cur = nxt; cA = nA; cB = nB; ++ui;
    }
    PG8_WAIT_V(0);
    if (wr == 0) PG8_BAR;
    PG8_BAR;
    if constexpr (Epi::AFTER_DRAIN) { E.fused(acc, cur, wr, wc, fr, fq, lds, wid, lane); S.done(cur); }
    PG8_STAMP();
    if (STAMP && wid == 0) { stamps[lane] = lane < nts ? (((unsigned long long)(unsigned)ts_hi << 32) | (unsigned)ts_lo) : 0ull;
        if (lane == 62) stamps[62] = rt_entry; if (lane == 63) stamps[63] = (unsigned long long)wall_clock64(); }
#undef PG8_STAMP
#undef PG8_SA
#undef PG8_SB
#undef PG8_STAGE
#undef PG8_LDA
#undef PG8_LDB
#undef PG8_MMA
#undef PG8_WAIT_V
#undef PG8_WAIT_L
#undef PG8_BAR
#undef PG8_SCHED
}
}
namespace mk {
typedef pg8::Unit Unit;
typedef const pg8::f32x4 (&AccRef)[2][2][4][2];

__device__ __forceinline__ void st_bf8(bf16_t* p, pg8::f32x4 v0, pg8::f32x4 v1) {
    u32x4 w; w.x = cvt_pk_bf16(v0[0], v0[1]); w.y = cvt_pk_bf16(v0[2], v0[3]); w.z = cvt_pk_bf16(v1[0], v1[1]); w.w = cvt_pk_bf16(v1[2], v1[3]);
    *(u32x4*)p = w;
#ifdef MK_ST2
    asm volatile("" ::: "memory"); *(u32x4*)p = w; asm volatile("" ::: "memory");
#endif
}
__device__ __forceinline__ void st_bf4(bf16_t* p, pg8::f32x4 v) { u32x2 w; w.x = cvt_pk_bf16(v[0], v[1]); w.y = cvt_pk_bf16(v[2], v[3]); *(u32x2*)p = w; }

struct EpiY {
    static constexpr bool PERM = true, AFTER_DRAIN = false;
    bf16_t* O;
    __device__ __forceinline__ void operator()(AccRef acc, const Unit& u, int wr, int wc, int fr, int fq) const {
        const int row0 = u.pm * 256 + wr * 64 + fr, col0 = u.pn * 256 + wc * 32 + 8 * fq;
#pragma unroll
        for (int ai = 0; ai < 2; ++ai)
#pragma unroll
            for (int m = 0; m < 4; ++m) { bf16_t* rowp = O + (size_t)(row0 + ai * 128 + m * 16) * D + col0;
#pragma unroll
                for (int bj = 0; bj < 2; ++bj) st_bf8(rowp + bj * 128, acc[ai][bj][m][0], acc[ai][bj][m][1]); }
    }
};
struct EpiH1 {
    static constexpr bool PERM = true, AFTER_DRAIN = false;
    bf16_t* Y; const float* lbl; int jl;
    __device__ __forceinline__ void operator()(AccRef acc, const Unit& u, int wr, int wc, int fr, int fq) const {
        const int part = u.pn >> 4, colt = (u.pn & 15) * 256;
        const int row0 = u.pm * 256 + wr * 64 + fr, col0 = colt + wc * 32 + 8 * fq;
        if (part == 1) {
            pg8::f32x4 lba[2][2] = {{{0.f, 0.f, 0.f, 0.f}, {0.f, 0.f, 0.f, 0.f}}, {{0.f, 0.f, 0.f, 0.f}, {0.f, 0.f, 0.f, 0.f}}};
            if (jl) {
#pragma unroll
                for (int bj = 0; bj < 2; ++bj)
#pragma unroll
                    for (int n = 0; n < 2; ++n) { const pg8::f32x4 l0 = *(const pg8::f32x4*)(lbl + col0 + bj * 128 + 4 * n), l1 = *(const pg8::f32x4*)(lbl + D + col0 + bj * 128 + 4 * n);
#pragma unroll
                        for (int j = 0; j < 4; ++j) lba[bj][n][j] = sigmoid_f(l1[j] - l0[j]); }
            }
#pragma unroll
            for (int bj = 0; bj < 2; ++bj) {
                const pg8::f32x4 lbv[2] = {lba[bj][0], lba[bj][1]};
#pragma unroll
                for (int ai = 0; ai < 2; ++ai)
#pragma unroll
                    for (int m = 0; m < 4; ++m) {
                        const int row = row0 + ai * 128 + m * 16;
                        pg8::f32x4 o[2];
#pragma unroll
                        for (int n = 0; n < 2; ++n)
#pragma unroll
                            for (int j = 0; j < 4; ++j) {
                                const float x = acc[ai][bj][m][n][j]; float g;
                                if (jl) { const float l = lbv[n][j]; g = __logf(l + (1.f - l) * sigmoid_f(x)); }
                                else g = fminf(x, 0.f) - __logf(1.f + __expf(-fabsf(x)));
                                o[n][j] = (row < NPAD) ? 0.f : g;
                            }
                        st_bf8(Y + 3 * (SLOT / 2) + (size_t)row * D + col0 + bj * 128, o[0], o[1]);
                    }
            }
        } else {
            bf16_t* dst = Y + (size_t)(part == 0 ? 0 : (part == 2 ? 1 : 2)) * (SLOT / 2);
#pragma unroll
            for (int ai = 0; ai < 2; ++ai)
#pragma unroll
                for (int m = 0; m < 4; ++m) { bf16_t* rowp = dst + (size_t)(row0 + ai * 128 + m * 16) * D + col0;
#pragma unroll
                    for (int bj = 0; bj < 2; ++bj) st_bf8(rowp + bj * 128, acc[ai][bj][m][0], acc[ai][bj][m][1]); }
        }
    }
};
struct EpiB1 {
    static constexpr bool PERM = false, AFTER_DRAIN = false;
    bf16_t* Y; const float* cs; const float* sn;
    __device__ __forceinline__ void operator()(AccRef acc, const Unit& u, int wr, int wc, int fr, int fq) const {
        const int part = u.pn >> 4, colt = (u.pn & 15) * 256;
        const int row0 = u.pm * 256 + wr * 64 + fr, col0 = colt + wc * 32 + 4 * fq;
        bf16_t* dst = Y + (size_t)part * (SLOT / 2);
        const bool rope = (part < 2) && (wc == 0);
        pg8::f32x4 c4a[2][4], s4a[2][4];
#pragma unroll
        for (int ai = 0; ai < 2; ++ai)
#pragma unroll
            for (int m = 0; m < 4; ++m) { c4a[ai][m] = (pg8::f32x4){1.f, 1.f, 1.f, 1.f}; s4a[ai][m] = (pg8::f32x4){0.f, 0.f, 0.f, 0.f}; }
        if (rope) {
#pragma unroll
            for (int ai = 0; ai < 2; ++ai)
#pragma unroll
                for (int m = 0; m < 4; ++m) { const int row = row0 + ai * 128 + m * 16;
                    c4a[ai][m] = *(const pg8::f32x4*)(cs + (size_t)row * 16 + 4 * fq); s4a[ai][m] = *(const pg8::f32x4*)(sn + (size_t)row * 16 + 4 * fq); }
        }
#pragma unroll
        for (int ai = 0; ai < 2; ++ai)
#pragma unroll
            for (int m = 0; m < 4; ++m) {
                const int row = row0 + ai * 128 + m * 16;
                const pg8::f32x4 c4 = c4a[ai][m], s4 = s4a[ai][m];
                bf16_t* rowp = dst + (size_t)row * D + (col0 - 4 * fq) + ((fq & 1) ? 12 + 4 * fq : 4 * fq);
#pragma unroll
                for (int bj = 0; bj < 2; ++bj) {
                    const pg8::f32x4 x1 = acc[ai][bj][m][0], x2 = acc[ai][bj][m][1];
                    const pg8::f32x4 y1 = x1 * c4 - x2 * s4, y2 = x2 * c4 + x1 * s4;
                    const unsigned a0 = cvt_pk_bf16(y1[0], y1[1]), a1 = cvt_pk_bf16(y1[2], y1[3]), b0 = cvt_pk_bf16(y2[0], y2[1]), b1 = cvt_pk_bf16(y2[2], y2[3]);
                    const auto r0 = __builtin_amdgcn_permlane16_swap(a0, b0, false, false); const auto r1 = __builtin_amdgcn_permlane16_swap(a1, b1, false, false);
                    const u32x4 w = {r0[0], r1[0], r0[1], r1[1]};
                    *(u32x4*)(rowp + bj * 128) = w;
                }
            }
    }
};
struct EpiC1 {
    static constexpr bool PERM = true, AFTER_DRAIN = false;
    bf16_t *Y, *T;
    __device__ __forceinline__ void operator()(AccRef acc, const Unit& u, int wr, int wc, int fr, int fq) const {
        const int row0 = u.pm * 256 + wr * 64 + fr;
        if (u.pn < 64) {
            const int part = u.pn >> 4, col0 = (u.pn & 15) * 256 + wc * 32 + 8 * fq;
            bf16_t* dst = Y + (size_t)part * (SLOT / 2);
#pragma unroll
            for (int ai = 0; ai < 2; ++ai)
#pragma unroll
                for (int m = 0; m < 4; ++m) { bf16_t* rowp = dst + (size_t)(row0 + ai * 128 + m * 16) * D + col0;
#pragma unroll
                    for (int bj = 0; bj < 2; ++bj) st_bf8(rowp + bj * 128, acc[ai][bj][m][0], acc[ai][bj][m][1]); }
        } else {
            const int which = u.pn - 64, col0 = which * 128 + wc * 32 + 8 * fq;
#pragma unroll
            for (int ai = 0; ai < 2; ++ai)
#pragma unroll
                for (int m = 0; m < 4; ++m) {
                    pg8::f32x4 v0 = acc[ai][0][m][0], v1 = acc[ai][0][m][1];
                    if (which == 0) {
#pragma unroll
                        for (int j = 0; j < 4; ++j) { v0[j] = 1.f - 2.f / (1.f + __expf(2.f * v0[j])); v1[j] = 1.f - 2.f / (1.f + __expf(2.f * v1[j])); }
                    }
                    st_bf8(T + (size_t)(row0 + ai * 128 + m * 16) * 256 + col0, v0, v1);
                }
        }
    }
};
struct EpiC2 {
    static constexpr bool PERM = true, AFTER_DRAIN = false;
    bf16_t* Y; const float* w0; const float* a0;
    __device__ __forceinline__ void operator()(AccRef acc, const Unit& u, int wr, int wc, int fr, int fq) const {
        const int row0 = u.pm * 256 + wr * 64 + fr;
        const bool isw = u.pn < 16;
        const int col0 = (u.pn & 15) * 256 + wc * 32 + 8 * fq;
        bf16_t* dst = Y + (size_t)(isw ? 4 : 5) * (SLOT / 2); const float* bias = isw ? w0 : a0;
#pragma unroll
        for (int bj = 0; bj < 2; ++bj) {
            const pg8::f32x4 b0 = *(const pg8::f32x4*)(bias + col0 + bj * 128), b1 = *(const pg8::f32x4*)(bias + col0 + bj * 128 + 4);
#pragma unroll
            for (int ai = 0; ai < 2; ++ai)
#pragma unroll
                for (int m = 0; m < 4; ++m) {
                    pg8::f32x4 v0 = acc[ai][bj][m][0] + b0, v1 = acc[ai][bj][m][1] + b1;
#pragma unroll
                    for (int j = 0; j < 4; ++j) {
                        float s0 = sigmoid_f(v0[j]), s1 = sigmoid_f(v1[j]);
                        if (isw) { s0 = __expf(-0.606531f * s0); s1 = __expf(-0.606531f * s1); }
                        v0[j] = s0; v1[j] = s1;
                    }
                    st_bf8(dst + (size_t)(row0 + ai * 128 + m * 16) * D + col0 + bj * 128, v0, v1);
                    __builtin_amdgcn_sched_barrier(0);
                }
        }
    }
};

struct Fr {
    LAS unsigned char* lds; unsigned char* ldsg;
    int tid, lane, wave, G, bid, gw, NGW;
    float* out; unsigned char* ws;
    __device__ __forceinline__ Fr fresh() const { Fr P = *this; asm volatile("" : "+v"(P.tid)); P.lane = P.tid & 63; P.wave = __builtin_amdgcn_readfirstlane(P.tid >> 6); P.gw = P.bid * 8 + P.wave; return P; }
    __device__ __forceinline__ const float* in(int i) const {
        const __attribute__((address_space(4))) unsigned long long* ka = (const __attribute__((address_space(4))) unsigned long long*)__builtin_amdgcn_kernarg_segment_ptr();
        asm volatile("" : "+s"(ka));
        return (const float*)ka[i];
    }
};
__device__ __forceinline__ bf16_t* slotU(const Fr& F, int s) { return (bf16_t*)(F.ws + WS_U + (size_t)s * SLOT); }
__device__ __forceinline__ bf16_t* slotY(const Fr& F, int s) { return (bf16_t*)(F.ws + WS_Y + (size_t)s * SLOT); }
__device__ __forceinline__ float* hrow(const Fr& F, int r) { return r < 64 ? (float*)(F.ws + WS_HMETA) + (size_t)r * D : F.out + (size_t)(r - 64) * D; }

__device__ __forceinline__ void transpose_item(const float* W, int ldw, bf16_t* WT, int ldt, int koff, LAS float* scr, int kb, int nb, int lane) {
    const int k0 = 64 * kb, n0 = 32 * nb;
    float wv[32];
#pragma unroll
    for (int i = 0; i < 32; ++i) wv[i] = W[(size_t)(k0 + 2 * i + (lane >> 5)) * ldw + n0 + (lane & 31)];
#pragma unroll
    for (int i = 0; i < 32; ++i) scr[(2 * i + (lane >> 5)) * 33 + (lane & 31)] = wv[i];
    LDS_WAIT(); asm volatile("" ::: "memory");
    const int c = lane & 7;
#pragma unroll
    for (int j = 0; j < 4; ++j) { const int n = (lane >> 3) + 8 * j; const LAS float* s = scr + (8 * c) * 33 + n;
        u32x4 o; o.x = cvt_pk_bf16(s[0 * 33], s[1 * 33]); o.y = cvt_pk_bf16(s[2 * 33], s[3 * 33]); o.z = cvt_pk_bf16(s[4 * 33], s[5 * 33]); o.w = cvt_pk_bf16(s[6 * 33], s[7 * 33]);
        *(u32x4*)(WT + (size_t)(n0 + n) * ldt + koff + k0 + 8 * c) = o; }
    LDS_WAIT(); asm volatile("" ::: "memory");
}
__device__ __forceinline__ void convert_matrix(const Fr& F, const float* W, int K, int N, bf16_t* WT, int ldt, int koff, int wg_skip = 0) {
    LAS float* scr = (LAS float*)(F.lds + F.wave * 8704);
    const int nblk = N / 32, nitems = (K / 64) * nblk;
    for (int it = F.gw - wg_skip * 8; it < nitems; it += F.NGW - wg_skip * 8) transpose_item(W, N, WT, ldt, koff, scr, it / nblk, it % nblk, F.lane);
}
__device__ __forceinline__ void convert_matrix_split(const Fr& F, const float* W, int K, int N, bf16_t* WT, int ldt, int wg_split, int nsplit) {
    LAS float* scr = (LAS float*)(F.lds + F.wave * 8704);
    const int nblk = N / 32, nitems = (K / 64) * nblk;
    if (F.bid >= wg_split) { for (int it = F.gw - wg_split * 8; it < nsplit; it += F.NGW - wg_split * 8) transpose_item(W, N, WT, ldt, 0, scr, it / nblk, it % nblk, F.lane); }
    else { for (int it = nsplit + F.gw; it < nitems; it += wg_split * 8) transpose_item(W, N, WT, ldt, 0, scr, it / nblk, it % nblk, F.lane); }
}
__device__ __forceinline__ void zero_bytes(const Fr& F, void* p, size_t nbytes) {
    u32x4* q = (u32x4*)p; const size_t n = nbytes / 16; const u32x4 z = {0u, 0u, 0u, 0u};
    for (size_t i = (size_t)F.bid * 512 + F.tid; i < n; i += (size_t)F.G * 512) q[i] = z;
}
__device__ __forceinline__ bf16_t* wtin_of(const Fr& F, int L) { return (bf16_t*)(F.ws + ((L & 1) ? WS_WTINB : WS_WTIN)); }
__device__ __forceinline__ const float* win_src(const Fr& F, int L) { return (L == 0 || L == 3) ? F.in(4) + (size_t)(L ? 1 : 0) * D * 4 * D : (L == 1 ? F.in(8) : F.in(16)); }
__device__ __forceinline__ void convert_win_tail(const Fr& F, int L) { convert_matrix_split(F, win_src(F, L), D, 4 * D, wtin_of(F, L), D, 64, 26624); }
__device__ __forceinline__ void convert_win(const Fr& F, int L, int wg_skip) {
    const float* src = (L == 0 || L == 3) ? F.in(4) + (size_t)(L ? 1 : 0) * D * 4 * D : (L == 1 ? F.in(8) : F.in(16));
    convert_matrix(F, src, D, 4 * D, wtin_of(F, L), D, 0, wg_skip);
}
__device__ __forceinline__ void convert_layer(const Fr& F, int L, bool with_win) {
    bf16_t* wtin = wtin_of(F, L); bf16_t* wtout = (bf16_t*)(F.ws + WS_WTOUT);
    if (with_win) convert_win(F, L, 0);
    if (L == 0) {
        convert_matrix(F, F.in(7), D, D, wtout, D, 0);
    } else if (L == 3) {
    } else if (L == 1) {
        convert_matrix(F, F.in(14), D, D, wtout, D, 0);
    } else {
        convert_matrix(F, F.in(28), D, D, wtout, D, 0);
        convert_matrix(F, F.in(18), D, 128, wtin + (size_t)16384 * D, D, 0);
        convert_matrix(F, F.in(21), D, 128, wtin + (size_t)16640 * D, D, 0);
        zero_bytes(F, wtin + (size_t)16512 * D, (size_t)128 * D * 2);
        zero_bytes(F, wtin + (size_t)16768 * D, (size_t)128 * D * 2);
    }
}
__device__ __forceinline__ void convert_wout2(const Fr& F, int wg_skip) { convert_matrix(F, F.in(28), D, D, (bf16_t*)(F.ws + WS_WTOUT), D, 0, wg_skip); }
__device__ __forceinline__ void convert_wout3(const Fr& F, int wg_skip) { convert_matrix(F, F.in(7) + (size_t)D * D, D, D, (bf16_t*)(F.ws + WS_WTOUT), D, 0, wg_skip); }
__device__ __forceinline__ void convert_layer2_b(const Fr& F) {
    bf16_t* w2t = (bf16_t*)(F.ws + WS_W2P);
    convert_matrix(F, F.in(19), 128, D, w2t, 128, 0);
    convert_matrix(F, F.in(22), 128, D, w2t + (size_t)4096 * 128, 128, 0);
}

__constant__ float c_inv_freq[16] = {1.0f, 0.44036659598350525f, 0.1939227432012558f, 0.08539710193872452f, 0.03760603070259094f, 0.01656043902039528f, 0.007292664609849453f, 0.0032114458736032248f,
    0.0014142135623842478f, 0.000622772378847003f, 0.00027424818836152554f, 0.00012076973507646471f, 5.318296098266728e-05f, 2.34199997066753e-05f, 1.0313386155758053e-05f, 4.541670477919979e-06f};
__device__ __forceinline__ void rope_table(const Fr& F) {
    float* cs = (float*)(F.ws + WS_ROPE); float* sn = cs + (size_t)R * 16;
    for (int i = F.bid * 512 + F.tid; i < R * 16; i += F.G * 512) {
        const int row = i >> 4, j = i & 15; const int pos = row - NPAD;
        const double ang = (double)(float)((float)pos * c_inv_freq[j]);
        const double k = __builtin_rint(ang * 0.15915494309189535);
        double x = ang - k * 6.283185307179586;
        const double q = __builtin_rint(x * 0.6366197723675814);
        x -= q * 1.5707963267948966;
        const int qi = ((int)q) & 3;
        const double x2 = x * x;
        const double s = x * (1.0 + x2 * (-1.0 / 6 + x2 * (1.0 / 120 + x2 * (-1.0 / 5040 + x2 * (1.0 / 362880 + x2 * (-1.0 / 39916800))))));
        const double c = 1.0 + x2 * (-0.5 + x2 * (1.0 / 24 + x2 * (-1.0 / 720 + x2 * (1.0 / 40320 + x2 * (-1.0 / 3628800 + x2 * (1.0 / 479001600))))));
        double sv, cv;
        if (qi == 0) { sv = s; cv = c; } else if (qi == 1) { sv = c; cv = -s; } else if (qi == 2) { sv = -s; cv = -c; } else { sv = -c; cv = s; }
        cs[i] = (float)cv; sn[i] = (float)sv;
    }
}

typedef const GAS char* gcp; typedef GAS char* gp_;
#define ROW_F32(nm, base, lane) gp_ nm##0 = (gp_)(base) + (lane) * 16 + 4096; gp_ nm##1 = nm##0 + 8192; asm volatile("" : "+v"(nm##0), "+v"(nm##1))
#define AT_F32(nm, j) (*(GAS f32x4*)((j) < 8 ? nm##0 + ((j) - 4) * 1024 : nm##1 + ((j) - 12) * 1024))
#define ROW_BF(nm, base, lane) gp_ nm##0 = (gp_)(base) + (lane) * 8 + 4096; asm volatile("" : "+v"(nm##0))
#define AT_BF(nm, j) (*(GAS u32x2*)(nm##0 + (j) * 512 - 4096))
__device__ __forceinline__ void norm_phase(const Fr& F, int prev, int next, const bf16_t* y, bf16_t* udst, int rlo = 0, int rhi = R, int wg_skip = 0) {
    const float* postg = F.in(3) + (size_t)(prev < 0 ? 0 : prev) * D; const float* preg = F.in(2) + (size_t)(next < 0 ? 0 : next) * D;
    const float* xin = F.in(0); const float* meta = F.in(1);
    for (int r = rlo + F.gw - wg_skip * 8; r < rhi; r += F.NGW - wg_skip * 8) {
        if (r < NPAD || r >= NREAL) {
            if (next >= 0) { ROW_BF(uo, udst + (size_t)r * D, F.lane); const u32x2 z = {0u, 0u};
#pragma unroll
                for (int j = 0; j < 16; ++j) AT_BF(uo, j) = z; }
            continue;
        }
        ROW_BF(hp, (bf16_t*)(F.ws + WS_HB) + (size_t)r * D, F.lane);
        f32x4 hv[16];
        if (prev < 0) {
            const float* src = r < 64 ? meta + (size_t)(r - NPAD) * D : xin + (size_t)(r - 64) * D;
            ROW_F32(sp, src, F.lane);
#pragma unroll
            for (int j = 0; j < 16; ++j) hv[j] = AT_F32(sp, j);
        } else {
            ROW_BF(yp, y + (size_t)r * D, F.lane); ROW_F32(gp, postg, F.lane);
            u32x2 yv[16], hb[16]; float ss = 0.f;
#pragma unroll
            for (int j = 0; j < 16; ++j) { yv[j] = AT_BF(yp, j); hb[j] = AT_BF(hp, j); }
#pragma unroll
            for (int j = 0; j < 16; ++j) { const float a = bflo(yv[j].x), b = bfhi(yv[j].x), c = bflo(yv[j].y), d = bfhi(yv[j].y); ss += (a * a + b * b) + (c * c + d * d); }
#pragma unroll
            for (int j = 0; j < 16; ++j) asm volatile("" : "+v"(yv[j].x), "+v"(yv[j].y));
            const float rs = __builtin_amdgcn_rsqf(wave_sum(ss) * (1.f / D) + 1e-6f);
#pragma unroll
            for (int j = 0; j < 16; ++j) { const f32x4 g = AT_F32(gp, j);
                hv[j].x = bflo(hb[j].x) + bflo(yv[j].x) * rs * g.x; hv[j].y = bfhi(hb[j].x) + bfhi(yv[j].x) * rs * g.y; hv[j].z = bflo(hb[j].y) + bflo(yv[j].y) * rs * g.z; hv[j].w = bfhi(hb[j].y) + bfhi(yv[j].y) * rs * g.w; }
        }
        if (next < 0) {
            if (r >= 64) { ROW_F32(op, F.out + (size_t)(r - 64) * D, F.lane);
#pragma unroll
                for (int j = 0; j < 16; ++j) AT_F32(op, j) = hv[j];
            }
            continue;
        }
        float s2 = 0.f;
#pragma unroll
        for (int j = 0; j < 16; ++j) { u32x2 w_; w_.x = cvt_pk_bf16(hv[j].x, hv[j].y); w_.y = cvt_pk_bf16(hv[j].z, hv[j].w); AT_BF(hp, j) = w_; s2 += (hv[j].x * hv[j].x + hv[j].y * hv[j].y) + (hv[j].z * hv[j].z + hv[j].w * hv[j].w); }
        const float rs2 = __builtin_amdgcn_rsqf(wave_sum(s2) * (1.f / D) + 1e-6f);
        ROW_BF(uo, udst + (size_t)r * D, F.lane); ROW_F32(pg, preg, F.lane);
#pragma unroll
        for (int j = 0; j < 16; ++j) { const f32x4 g = AT_F32(pg, j); u32x2 w; w.x = cvt_pk_bf16(hv[j].x * rs2 * g.x, hv[j].y * rs2 * g.y); w.y = cvt_pk_bf16(hv[j].z * rs2 * g.z, hv[j].w * rs2 * g.w); AT_BF(uo, j) = w; }
    }
}
__device__ __forceinline__ void mix_phase(const Fr& F, const bf16_t* u) {
    const float* mu = F.in(15);
    for (int r = F.gw; r < R; r += F.NGW) {
        const bool real = (r >= NPAD && r < NREAL);
        u32x2 cur[16], prv[16];
        const u32x2 z = {0u, 0u};
        { ROW_BF(cp, u + (size_t)r * D, F.lane); ROW_BF(pp, u + (size_t)(r > 0 ? r - 1 : 0) * D, F.lane);
#pragma unroll
          for (int j = 0; j < 16; ++j) { cur[j] = real ? AT_BF(cp, j) : z; prv[j] = (real && r > NPAD) ? AT_BF(pp, j) : z; } }
#pragma unroll 1
        for (int s = 0; s < 6; ++s) {
            ROW_BF(op, slotU(F, s) + (size_t)r * D, F.lane); ROW_F32(mp, mu + (size_t)s * D, F.lane);
#pragma unroll
            for (int j = 0; j < 16; ++j) {
                const f32x4 m = AT_F32(mp, j);
                const float c0 = bflo(cur[j].x), c1 = bfhi(cur[j].x), c2 = bflo(cur[j].y), c3 = bfhi(cur[j].y);
                const float p0 = bflo(prv[j].x), p1 = bfhi(prv[j].x), p2 = bflo(prv[j].y), p3 = bfhi(prv[j].y);
                u32x2 w; w.x = cvt_pk_bf16(c0 + (p0 - c0) * m.x, c1 + (p1 - c1) * m.y); w.y = cvt_pk_bf16(c2 + (p2 - c2) * m.z, c3 + (p3 - c3) * m.w);
                AT_BF(op, j) = real ? w : z;
            }
        }
    }
}
}
namespace mk {
constexpr int H_QE = 0, H_KE = 17408, H_KET = 34816, H_VT = 53248, H_PM = 71680, H_STB = 80896, H_VEC = 115712, H_OT = 118784;
__device__ __forceinline__ bf16x8 ldfrag(const LAS unsigned char* base, int stride_b, int rb, int ks, int lane) {
    return *(const LAS bf16x8*)(base + (16 * rb + (lane & 15)) * stride_b + (32 * ks + 8 * (lane >> 4)) * 2);
}
template <bool OUT>
__device__ __forceinline__ void hgrn_phase(const Fr& F, int jl) {
    const bf16_t* Q = slotY(F, 0); const bf16_t* V = slotY(F, 1); const bf16_t* GT = slotY(F, 2); const bf16_t* Gg = slotY(F, 3);
    bf16_t* Z = slotU(F, 0);
    float* HE = (float*)(F.ws + WS_HE); float* HLD = (float*)(F.ws + WS_HLOGD);
    const float* gn = F.in(6) + (size_t)jl * 128;
    LAS unsigned char* L = F.lds;
    LAS float* qtot = (LAS float*)(L + H_VEC); LAS float* ebm = qtot + 512; LAS float* ebl = ebm + 128;
    const int tid = F.tid, lane = F.lane, w = F.wave;
    const int d = tid & 127, qt = tid >> 7;
    for (int unit = F.bid; unit < 256; unit += F.G) {
        const int h = unit >> 3, seg = unit & 7;
        if (!OUT && seg == 7) continue;
        const int c0 = seg == 0 ? 0 : 33 + 32 * (seg - 1), c1 = c0 + (seg == 0 ? 33 : 32);
        f32x4 S[8];
#pragma unroll
        for (int i = 0; i < 8; ++i) S[i] = (f32x4){0.f, 0.f, 0.f, 0.f};
        if (OUT) {
            for (int j = 0; j < seg; ++j) {
                const float* ld = HLD + (size_t)(h * 8 + j) * 128; const float* e = HE + ((size_t)(h * 8 + j) * 512 + tid) * 32;
#pragma unroll
                for (int di = 0; di < 8; ++di) { const f32x4 l4 = *(const f32x4*)(ld + 16 * di + 4 * (lane >> 4)); const f32x4 e4 = *(const f32x4*)(e + 4 * di);
                    S[di].x = S[di].x * __expf(l4.x) + e4.x; S[di].y = S[di].y * __expf(l4.y) + e4.y; S[di].z = S[di].z * __expf(l4.z) + e4.z; S[di].w = S[di].w * __expf(l4.w) + e4.w; }
            }
        }
        float logD = 0.f;
        bf16_t g[16], qv[16], vv[16]; u32x4 gt0 = {0u, 0u, 0u, 0u}, gt1 = gt0, ngt0 = gt0, ngt1 = gt0;
#define HG_LOAD(cc) do { const int rowb_ = 64 * (cc) + 16 * qt; const size_t colb_ = (size_t)h * 128 + d; \
            _Pragma("unroll") for (int i = 0; i < 16; ++i) { g[i] = Gg[(size_t)(rowb_ + i) * D + colb_]; vv[i] = V[(size_t)(rowb_ + i) * D + colb_]; if (OUT) qv[i] = Q[(size_t)(rowb_ + i) * D + colb_]; } \
            if (OUT) { const bf16_t* gp_ = GT + (size_t)(64 * (cc) + (tid >> 3)) * D + h * 128 + 16 * (tid & 7); ngt0 = *(const u32x4*)gp_; ngt1 = *(const u32x4*)(gp_ + 8); } } while (0)
        HG_LOAD(c0);
        for (int c = c0; c < c1; ++c) {
            if (OUT) { gt0 = ngt0; gt1 = ngt1; }
            float f[16]; float run = 0.f;
#pragma unroll
            for (int i = 0; i < 16; ++i) { const float gi = bf2f(g[i]); run += gi; f[i] = __expf(gi); }
            qtot[qt * 128 + d] = run;
            __syncthreads();
            const float t0 = qtot[d], t1 = qtot[128 + d], t2 = qtot[256 + d], t3 = qtot[384 + d];
            const float off = qt == 0 ? 0.f : (qt == 1 ? t0 : (qt == 2 ? t0 + t1 : t0 + t1 + t2));
            const float bm = t0 + t1, bl = (t0 + t1) + (t2 + t3);
            if (qt == 0) { ebm[d] = __expf(bm); ebl[d] = __expf(bl); logD += bl; }
            {
                unsigned kt[8], vt[8];
                const float ebd = __expf(bl - bm);
                float y = __expf(bm - (run + off)), kx_hi = 0.f;
#pragma unroll
                for (int i = 15; i >= 0; --i) {
                    const float ky = (1.f - f[i]) * y;
                    if (OUT) *(LAS bf16_t*)(L + H_KE + ((16 * qt + i) * 136 + d) * 2) = f2bf(ky);
                    const float kx = ky * ebd;
                    if (i & 1) kx_hi = kx; else kt[i >> 1] = cvt_pk_bf16(kx, kx_hi);
                    y *= f[i];
                }
                if (OUT) {
                    float e = __expf(off - bm);
#pragma unroll
                    for (int i = 0; i < 16; ++i) { e *= f[i]; *(LAS bf16_t*)(L + H_QE + ((16 * qt + i) * 136 + d) * 2) = f2bf(bf2f(qv[i]) * e); }
                }
#pragma unroll
                for (int i = 0; i < 16; i += 2) vt[i >> 1] = (unsigned)vv[i] | ((unsigned)vv[i + 1] << 16);
                LAS u32x4* kp = (LAS u32x4*)(L + H_KET + (d * 72 + 16 * qt) * 2); kp[0] = (u32x4){kt[0], kt[1], kt[2], kt[3]}; kp[1] = (u32x4){kt[4], kt[5], kt[6], kt[7]};
                LAS u32x4* vp = (LAS u32x4*)(L + H_VT + (d * 72 + 16 * qt) * 2); vp[0] = (u32x4){vt[0], vt[1], vt[2], vt[3]}; vp[1] = (u32x4){vt[4], vt[5], vt[6], vt[7]};
            }
            if (c + 1 < c1) HG_LOAD(c + 1);
            __syncthreads();
            if (OUT) {
#pragma unroll
                for (int di = 0; di < 8; ++di) { const f32x4 m4 = *(const LAS f32x4*)(ebm + 16 * di + 4 * (lane >> 4)); u32x2 o; o.x = cvt_pk_bf16(S[di].x * m4.x, S[di].y * m4.y); o.y = cvt_pk_bf16(S[di].z * m4.z, S[di].w * m4.w);
                    *(LAS u32x2*)(L + H_STB + ((16 * w + (lane & 15)) * 136 + 16 * di + 4 * (lane >> 4)) * 2) = o; }
                const int ti = w >> 1;
#pragma unroll
                for (int s2 = 0; s2 < 2; ++s2) { const int si = 2 * (w & 1) + s2; f32x4 p = {0.f, 0.f, 0.f, 0.f};
                    if (si <= ti) {
#pragma unroll
                        for (int ks = 0; ks < 4; ++ks) p = __builtin_amdgcn_mfma_f32_16x16x32_bf16(ldfrag(L + H_QE, 272, ti, ks, lane), ldfrag(L + H_KE, 272, si, ks, lane), p, 0, 0, 0);
                    }
                    const int sidx = 16 * si + (lane & 15);
#pragma unroll
                    for (int jj = 0; jj < 4; ++jj) { const int tidx = 16 * ti + 4 * (lane >> 4) + jj; *(LAS bf16_t*)(L + H_PM + (tidx * 72 + sidx) * 2) = f2bf(sidx <= tidx ? p[jj] : 0.f); }
                }
                __syncthreads();
            }
            f32x4 O[4];
            if (OUT) {
#pragma unroll
                for (int ti = 0; ti < 4; ++ti) O[ti] = (f32x4){0.f, 0.f, 0.f, 0.f};
#pragma unroll
                for (int ks = 0; ks < 2; ++ks) { const bf16x8 bv = ldfrag(L + H_VT, 144, w, ks, lane);
#pragma unroll
                    for (int ti = 0; ti < 4; ++ti) O[ti] = __builtin_amdgcn_mfma_f32_16x16x32_bf16(ldfrag(L + H_PM, 144, ti, ks, lane), bv, O[ti], 0, 0, 0); }
#pragma unroll
                for (int ks = 0; ks < 4; ++ks) { const bf16x8 bs = ldfrag(L + H_STB, 272, w, ks, lane);
#pragma unroll
                    for (int ti = 0; ti < 4; ++ti) O[ti] = __builtin_amdgcn_mfma_f32_16x16x32_bf16(ldfrag(L + H_QE, 272, ti, ks, lane), bs, O[ti], 0, 0, 0); }
            }
            {
                const bf16x8 bv0 = ldfrag(L + H_VT, 144, w, 0, lane), bv1 = ldfrag(L + H_VT, 144, w, 1, lane);
#pragma unroll
                for (int di = 0; di < 8; ++di) { const f32x4 l4 = *(const LAS f32x4*)(ebl + 16 * di + 4 * (lane >> 4)); S[di] = S[di] * l4;
                    S[di] = __builtin_amdgcn_mfma_f32_16x16x32_bf16(ldfrag(L + H_KET, 144, di, 0, lane), bv0, S[di], 0, 0, 0);
                    S[di] = __builtin_amdgcn_mfma_f32_16x16x32_bf16(ldfrag(L + H_KET, 144, di, 1, lane), bv1, S[di], 0, 0, 0); }
            }
            if (OUT) {
                LAS float* Ot = (LAS float*)(L + H_OT);
#pragma unroll
                for (int ti = 0; ti < 4; ++ti)
#pragma unroll
                    for (int jj = 0; jj < 4; ++jj) Ot[(16 * ti + 4 * (lane >> 4) + jj) * 132 + 16 * w + (lane & 15)] = O[ti][jj];
                __syncthreads();
                const int t = tid >> 3, eg = tid & 7;
                f32x4 o4[4]; float ss = 0.f;
#pragma unroll
                for (int i = 0; i < 4; ++i) { o4[i] = *(const LAS f32x4*)(Ot + t * 132 + 16 * eg + 4 * i); ss += (o4[i].x * o4[i].x + o4[i].y * o4[i].y) + (o4[i].z * o4[i].z + o4[i].w * o4[i].w); }
                ss = red8(ss);
                const float rs = __builtin_amdgcn_rsqf(ss * (1.f / 128.f) + 1e-6f);
                const unsigned gw_[8] = {gt0.x, gt0.y, gt0.z, gt0.w, gt1.x, gt1.y, gt1.z, gt1.w};
                unsigned zo[8];
#pragma unroll
                for (int i = 0; i < 4; ++i) { const f32x4 g4 = *(const f32x4*)(gn + 16 * eg + 4 * i);
                    const float a0 = o4[i].x * rs * g4.x * silu_f(bflo(gw_[2 * i])), a1 = o4[i].y * rs * g4.y * silu_f(bfhi(gw_[2 * i]));
                    const float a2 = o4[i].z * rs * g4.z * silu_f(bflo(gw_[2 * i + 1])), a3 = o4[i].w * rs * g4.w * silu_f(bfhi(gw_[2 * i + 1]));
                    zo[2 * i] = cvt_pk_bf16(a0, a1); zo[2 * i + 1] = cvt_pk_bf16(a2, a3); }
                bf16_t* zp = Z + (size_t)(64 * c + t) * D + h * 128 + 16 * eg;
                *(u32x4*)zp = (u32x4){zo[0], zo[1], zo[2], zo[3]}; *(u32x4*)(zp + 8) = (u32x4){zo[4], zo[5], zo[6], zo[7]};
            } else {
                __syncthreads();
            }
        }
        if (!OUT) {
            float* e = HE + ((size_t)(h * 8 + seg) * 512 + tid) * 32;
#pragma unroll
            for (int di = 0; di < 8; ++di) *(f32x4*)(e + 4 * di) = S[di];
            if (qt == 0) HLD[(size_t)(h * 8 + seg) * 128 + d] = logD;
        }
        __syncthreads();
    }
#undef HG_LOAD
}

#ifndef MK_PRIO
#define MK_PRIO 0
#endif
#define PRIO_HI() do { if (MK_PRIO) { __builtin_amdgcn_s_setprio(MK_PRIO); } } while (0)
#define PRIO_LO() do { if (MK_PRIO) { __builtin_amdgcn_s_setprio(0); } } while (0)
namespace att {
constexpr int NW = 8, QBLK = 32, KVBLK = 64, LDQ = 4096, LDO = 8192;
constexpr float SCALE = 0.088388347648318440f, THR = 8.f;
constexpr int SHM_V = 16384, SHM_K = 16384, SHM = 2 * SHM_V + 2 * SHM_K + NW * 64 * 4;
#ifndef MK_KSWM
#define MK_KSWM 15
#endif
#define KSWZ(row, colB) ((row) * 256 + ((colB) ^ (((row) & MK_KSWM) << 4)))
#define SBAR() __builtin_amdgcn_sched_barrier(0)
__device__ __forceinline__ int crow(int r, int hi) { return (r & 3) + 8 * (r >> 2) + 4 * hi; }
__device__ __forceinline__ void partialSM(f32x16& p0, f32x16& p1, float& m_reg, float& mn, float& alpha) {
    constexpr float C = SCALE * 1.4426950408889634f;
    float pmax = p0[0];
#pragma unroll
    for (int r = 1; r < 16; ++r) pmax = fmaxf(pmax, p0[r]);
#pragma unroll
    for (int r = 0; r < 16; ++r) pmax = fmaxf(pmax, p1[r]);
    { auto rr = __builtin_amdgcn_permlane32_swap(__float_as_uint(pmax), __float_as_uint(pmax), false, false);
      pmax = fmaxf(__uint_as_float(rr[0]), __uint_as_float(rr[1])); }
    if (__builtin_expect(__all(pmax - m_reg <= THR / SCALE), 1)) { mn = m_reg; alpha = 1.f; }
    else { mn = fmaxf(m_reg, pmax); alpha = __builtin_amdgcn_exp2f((m_reg - mn) * C); m_reg = mn; }
    const float mnC = -mn * C;
#pragma unroll
    for (int r = 0; r < 16; ++r) p0[r] = fmaf(p0[r], C, mnC);
#pragma unroll
    for (int r = 0; r < 16; ++r) p1[r] = fmaf(p1[r], C, mnC);
#pragma unroll
    for (int r = 0; r < 16; ++r) p0[r] = __builtin_amdgcn_exp2f(p0[r]);
}
__device__ __forceinline__ void finishSM(f32x16& p0, f32x16& p1, float alpha, float& l_reg, bf16x8& pa0, bf16x8& pa1, bf16x8& pa2, bf16x8& pa3) {
#pragma unroll
    for (int r = 0; r < 16; ++r) p1[r] = __builtin_amdgcn_exp2f(p1[r]);
    float ps = 0;
#pragma unroll
    for (int r = 0; r < 16; ++r) ps += p0[r];
#pragma unroll
    for (int r = 0; r < 16; ++r) ps += p1[r];
    { auto rr = __builtin_amdgcn_permlane32_swap(__float_as_uint(ps), __float_as_uint(ps), false, false);
      ps = __uint_as_float(rr[0]) + __uint_as_float(rr[1]); }
    l_reg = l_reg * alpha + ps;
#define PK4(P, BASE, OUT) do { unsigned a0 = cvt_pk_bf16(P[BASE + 0], P[BASE + 1]), a1 = cvt_pk_bf16(P[BASE + 2], P[BASE + 3]);   \
    unsigned b0 = cvt_pk_bf16(P[BASE + 4], P[BASE + 5]), b1 = cvt_pk_bf16(P[BASE + 6], P[BASE + 7]);                              \
    auto r0 = __builtin_amdgcn_permlane32_swap(a0, b0, false, false); auto r1 = __builtin_amdgcn_permlane32_swap(a1, b1, false, false); \
    u32x4 w = {r0[0], r1[0], r0[1], r1[1]}; OUT = *reinterpret_cast<bf16x8*>(&w); } while (0)
    PK4(p0, 0, pa0); PK4(p0, 8, pa1); PK4(p1, 0, pa2); PK4(p1, 8, pa3);
#undef PK4
}
__device__ __forceinline__ void qkt(f32x16& p0, f32x16& p1, const char* Ks, const bf16x8* qr, int r32, int hi) {
    p0 = f32x16{}; p1 = f32x16{};
    PRIO_HI();
#pragma unroll
    for (int d0 = 0; d0 < 8; ++d0) { const int cb = (d0 * 16 + hi * 8) * 2;
        const bf16x8 b0 = *reinterpret_cast<const bf16x8*>(Ks + KSWZ(r32, cb));
        const bf16x8 b1 = *reinterpret_cast<const bf16x8*>(Ks + KSWZ(32 + r32, cb));
        p0 = __builtin_amdgcn_mfma_f32_32x32x16_bf16(b0, qr[d0], p0, 0, 0, 0);
        p1 = __builtin_amdgcn_mfma_f32_32x32x16_bf16(b1, qr[d0], p1, 0, 0, 0); }
    PRIO_LO();
}
__device__ __forceinline__ int v_st(int k, int c) { const int kk = (k & ~0xC) | ((k & 4) << 1) | ((k & 8) >> 1); return ((kk >> 3) * 4 + (c >> 5)) * 512 + ((kk & 7) * 32 + (c & 31)) * 2; }
__device__ __forceinline__ int v_rd_base(int lane) { return ((lane & 3) << 3) | (((lane >> 2) & 3) << 6) | (((lane >> 4) & 1) << 5) | (((lane >> 5) & 1) << 8); }
constexpr int v_rd_off(int d0, int ks, int half) { return d0 * 512 + ks * 4096 + half * 2048; }
template <int OFF> __device__ __forceinline__ s16x4 tr_read(int vb) {
    s16x4 r; asm volatile("ds_read_b64_tr_b16 %0, %1 offset:%2" : "=&v"(r) : "v"(vb), "i"(OFF) : "memory"); return r;
}
template <int D0> __device__ __forceinline__ void pv_one(f32x16& od, int vb, bf16x8 pa0, bf16x8 pa1, bf16x8 pa2, bf16x8 pa3) {
    const s16x4 l0 = tr_read<v_rd_off(D0, 0, 0)>(vb), h0 = tr_read<v_rd_off(D0, 0, 1)>(vb), l1 = tr_read<v_rd_off(D0, 1, 0)>(vb), h1 = tr_read<v_rd_off(D0, 1, 1)>(vb);
    const s16x4 l2 = tr_read<v_rd_off(D0, 2, 0)>(vb), h2 = tr_read<v_rd_off(D0, 2, 1)>(vb), l3 = tr_read<v_rd_off(D0, 3, 0)>(vb), h3 = tr_read<v_rd_off(D0, 3, 1)>(vb);
    asm volatile("s_waitcnt lgkmcnt(0)" ::: "memory"); SBAR();
#define PK(Lo, Hi) (bf16x8){Lo[0], Lo[1], Lo[2], Lo[3], Hi[0], Hi[1], Hi[2], Hi[3]}
    od = __builtin_amdgcn_mfma_f32_32x32x16_bf16(pa0, PK(l0, h0), od, 0, 0, 0);
    od = __builtin_amdgcn_mfma_f32_32x32x16_bf16(pa1, PK(l1, h1), od, 0, 0, 0);
    od = __builtin_amdgcn_mfma_f32_32x32x16_bf16(pa2, PK(l2, h2), od, 0, 0, 0);
    od = __builtin_amdgcn_mfma_f32_32x32x16_bf16(pa3, PK(l3, h3), od, 0, 0, 0);
#undef PK
}
__device__ __forceinline__ void pv_d0(f32x16* o, int vb, bf16x8 pa0, bf16x8 pa1, bf16x8 pa2, bf16x8 pa3) {
    pv_one<0>(o[0], vb, pa0, pa1, pa2, pa3); pv_one<1>(o[1], vb, pa0, pa1, pa2, pa3); pv_one<2>(o[2], vb, pa0, pa1, pa2, pa3); pv_one<3>(o[3], vb, pa0, pa1, pa2, pa3);
}
__device__ __forceinline__ void mask_tile(f32x16& p0, f32x16& p1, int j, int lim) {
    if (j > lim) {
#pragma unroll
        for (int r = 0; r < 16; ++r) { p0[r] = -1e30f; p1[r] = -1e30f; }
    } else if (j == 0) {
#pragma unroll
        for (int r = 0; r < 16; ++r) p0[r] = -1e30f;
#pragma unroll
        for (int r = 0; r < 8; ++r) p1[r] = -1e30f;
    }
}
__device__ __forceinline__ void unit(const bf16_t* __restrict__ Qb, const bf16_t* __restrict__ Kh, const bf16_t* __restrict__ Vh, bf16_t* __restrict__ Ob, int NT, int lim, char* lds) {
    int tid_ = threadIdx.x; asm volatile("" : "+v"(tid_));
    const int tid = tid_, wid = tid >> 6, lane = tid & 63, r32 = lane & 31, hi = lane >> 5;
    char* V_lds = lds; char* K_lds = lds + 2 * SHM_V;
    float* wsf = (float*)(lds + 2 * SHM_V + 2 * SHM_K) + wid * 64; float* li_l = wsf; float* al_l = wsf + 32;
    float m_reg = -1e30f, l_reg = 0; f32x16 o[4] = {}; bf16x8 qr[8];
    const bf16_t* Qw = Qb + (long)(wid * QBLK + r32) * LDQ + hi * 8;
#pragma unroll
    for (int d0 = 0; d0 < 8; ++d0) qr[d0] = *reinterpret_cast<const bf16x8*>(Qw + d0 * 16);
    const int sr = tid >> 4, sc = (tid & 15) * 8, vst0 = v_st(sr, sc), vst1 = v_st(32 + sr, sc);
    const int vb0 = (int)(uintptr_t)V_lds + v_rd_base(lane);
    struct { bf16x8 vs0, vs1, ks0, ks1; } sr_[2];
#define SLOAD(i, k0) do { sr_[i].vs0 = *reinterpret_cast<const bf16x8*>(&Vh[(long)((k0) + sr) * LDQ + sc]); sr_[i].vs1 = *reinterpret_cast<const bf16x8*>(&Vh[(long)((k0) + 32 + sr) * LDQ + sc]); \
    sr_[i].ks0 = *reinterpret_cast<const bf16x8*>(&Kh[(long)((k0) + sr) * LDQ + sc]); sr_[i].ks1 = *reinterpret_cast<const bf16x8*>(&Kh[(long)((k0) + 32 + sr) * LDQ + sc]); } while (0)
#define SWRITE(b, i) do { *(bf16x8*)(V_lds + (b) * SHM_V + vst0) = sr_[i].vs0;          \
    *(bf16x8*)(V_lds + (b) * SHM_V + vst1) = sr_[i].vs1; int kc = sc * 2;               \
    *(bf16x8*)(K_lds + (b) * SHM_K + KSWZ(sr, kc)) = sr_[i].ks0;                       \
    *(bf16x8*)(K_lds + (b) * SHM_K + KSWZ(32 + sr, kc)) = sr_[i].ks1; } while (0)
#define SWAIT() asm volatile("s_waitcnt vmcnt(4)" ::: "memory")
#define RESC(a) do { if (__any((a) < 1.f)) { if (hi == 0) al_l[r32] = (a); asm volatile("s_waitcnt lgkmcnt(0)" ::: "memory"); \
    _Pragma("unroll") for (int d = 0; d < 4; ++d) _Pragma("unroll") for (int r = 0; r < 16; ++r) o[d][r] *= al_l[crow(r, hi)]; } } while (0)
    f32x16 pA0, pA1, pB0, pB1; float mnA, mnB, alA, alB; bf16x8 pa0, pa1, pa2, pa3;
    constexpr int SE = 0, SO = 1;
    SLOAD(SE, 0); asm volatile("s_waitcnt vmcnt(0)" ::: "memory"); SWRITE(0, SE); __syncthreads();
    qkt(pA0, pA1, K_lds, qr, r32, hi); mask_tile(pA0, pA1, 0, lim); partialSM(pA0, pA1, m_reg, mnA, alA);
    SLOAD(SO, KVBLK); if (2 < NT) SLOAD(SE, 2 * KVBLK);
    SWAIT(); SWRITE(1, SO); __syncthreads();
    for (int j = 1; j + 1 < NT; j += 2) {
        SBAR(); qkt(pB0, pB1, K_lds + SHM_K, qr, r32, hi);
        finishSM(pA0, pA1, alA, l_reg, pa0, pa1, pa2, pa3); SBAR();
        SLOAD(SO, (j + 2) * KVBLK); SBAR();
        pv_d0(o, vb0, pa0, pa1, pa2, pa3); mask_tile(pB0, pB1, j, lim); partialSM(pB0, pB1, m_reg, mnB, alB);
        __syncthreads(); SWAIT(); SWRITE(0, SE);
        RESC(alB); __syncthreads();
        SBAR(); qkt(pA0, pA1, K_lds, qr, r32, hi);
        finishSM(pB0, pB1, alB, l_reg, pa0, pa1, pa2, pa3); SBAR();
        if (j + 3 < NT) SLOAD(SE, (j + 3) * KVBLK); SBAR();
        pv_d0(o, vb0 + SHM_V, pa0, pa1, pa2, pa3); mask_tile(pA0, pA1, j + 1, lim); partialSM(pA0, pA1, m_reg, mnA, alA);
        __syncthreads(); SWAIT(); SWRITE(1, SO);
        RESC(alA); __syncthreads();
    }
    SBAR(); qkt(pB0, pB1, K_lds + SHM_K, qr, r32, hi);
    finishSM(pA0, pA1, alA, l_reg, pa0, pa1, pa2, pa3); SBAR();
    pv_d0(o, vb0, pa0, pa1, pa2, pa3); mask_tile(pB0, pB1, NT - 1, lim); partialSM(pB0, pB1, m_reg, mnB, alB);
    __syncthreads(); RESC(alB);
    finishSM(pB0, pB1, alB, l_reg, pa0, pa1, pa2, pa3); SBAR();
    pv_d0(o, vb0 + SHM_V, pa0, pa1, pa2, pa3);
    if (hi == 0) li_l[r32] = l_reg; asm volatile("s_waitcnt lgkmcnt(0)" ::: "memory");
    float rli[16];
#pragma unroll
    for (int r = 0; r < 16; ++r) rli[r] = __builtin_amdgcn_rcpf(li_l[crow(r, hi)]);
    bf16_t* Ow = Ob + (long)(wid * QBLK) * LDO;
#pragma unroll
    for (int r = 0; r < 16; ++r) { const int orow = crow(r, hi);
#pragma unroll
        for (int d0 = 0; d0 < 4; ++d0) Ow[(long)orow * LDO + d0 * 32 + r32] = f2bf(o[d0][r] * rli[r]); }
    __syncthreads();
#undef SLOAD
#undef SWRITE
#undef SWAIT
#undef RESC
}
}


#ifndef MK_HB
#define MK_HB(w) ((w) >> 2)
#endif
namespace att2 {
using namespace att;
constexpr int KB = 16384, VB = 32768, OFF_V = 3 * KB, OFF_W = OFF_V + 3 * VB, SHM2 = OFF_W + NW * 64 * 4;
constexpr int v2_rd_off(int d0, int ks, int half) { return d0 * 512 + ks * 8192 + half * 4096; }
template <int D0> __device__ __forceinline__ void pv2_one(f32x16& od, int vb, bf16x8 pa0, bf16x8 pa1, bf16x8 pa2, bf16x8 pa3) {
    const s16x4 l0 = tr_read<v2_rd_off(D0, 0, 0)>(vb), h0 = tr_read<v2_rd_off(D0, 0, 1)>(vb), l1 = tr_read<v2_rd_off(D0, 1, 0)>(vb), h1 = tr_read<v2_rd_off(D0, 1, 1)>(vb);
    const s16x4 l2 = tr_read<v2_rd_off(D0, 2, 0)>(vb), h2 = tr_read<v2_rd_off(D0, 2, 1)>(vb), l3 = tr_read<v2_rd_off(D0, 3, 0)>(vb), h3 = tr_read<v2_rd_off(D0, 3, 1)>(vb);
    asm volatile("s_waitcnt lgkmcnt(0)" ::: "memory"); SBAR();
#define PK(Lo, Hi) (bf16x8){Lo[0], Lo[1], Lo[2], Lo[3], Hi[0], Hi[1], Hi[2], Hi[3]}
    od = __builtin_amdgcn_mfma_f32_32x32x16_bf16(pa0, PK(l0, h0), od, 0, 0, 0);
    od = __builtin_amdgcn_mfma_f32_32x32x16_bf16(pa1, PK(l1, h1), od, 0, 0, 0);
    od = __builtin_amdgcn_mfma_f32_32x32x16_bf16(pa2, PK(l2, h2), od, 0, 0, 0);
    od = __builtin_amdgcn_mfma_f32_32x32x16_bf16(pa3, PK(l3, h3), od, 0, 0, 0);
#undef PK
}
struct VFrag { s16x4 l0, h0, l1, h1, l2, h2, l3, h3; };
template <int D0> __device__ __forceinline__ void v2_load(VFrag& f, int vb) {
    f.l0 = tr_read<v2_rd_off(D0, 0, 0)>(vb); f.h0 = tr_read<v2_rd_off(D0, 0, 1)>(vb); f.l1 = tr_read<v2_rd_off(D0, 1, 0)>(vb); f.h1 = tr_read<v2_rd_off(D0, 1, 1)>(vb);
    f.l2 = tr_read<v2_rd_off(D0, 2, 0)>(vb); f.h2 = tr_read<v2_rd_off(D0, 2, 1)>(vb); f.l3 = tr_read<v2_rd_off(D0, 3, 0)>(vb); f.h3 = tr_read<v2_rd_off(D0, 3, 1)>(vb);
}
__device__ __forceinline__ void v2_mma(f32x16& od, const VFrag& f, bf16x8 pa0, bf16x8 pa1, bf16x8 pa2, bf16x8 pa3) {
#define PK(Lo, Hi) (bf16x8){Lo[0], Lo[1], Lo[2], Lo[3], Hi[0], Hi[1], Hi[2], Hi[3]}
    od = __builtin_amdgcn_mfma_f32_32x32x16_bf16(pa0, PK(f.l0, f.h0), od, 0, 0, 0);
    od = __builtin_amdgcn_mfma_f32_32x32x16_bf16(pa1, PK(f.l1, f.h1), od, 0, 0, 0);
    od = __builtin_amdgcn_mfma_f32_32x32x16_bf16(pa2, PK(f.l2, f.h2), od, 0, 0, 0);
    od = __builtin_amdgcn_mfma_f32_32x32x16_bf16(pa3, PK(f.l3, f.h3), od, 0, 0, 0);
#undef PK
}
struct VSet { s16x4 l0, h0, l1, h1, l2, h2, l3, h3; };
template <int G, int KS> __device__ __forceinline__ void vs_load(VSet& f, int vb) {
    f.l0 = tr_read<v2_rd_off(4 * G + 0, KS, 0)>(vb); f.h0 = tr_read<v2_rd_off(4 * G + 0, KS, 1)>(vb); f.l1 = tr_read<v2_rd_off(4 * G + 1, KS, 0)>(vb); f.h1 = tr_read<v2_rd_off(4 * G + 1, KS, 1)>(vb);
    f.l2 = tr_read<v2_rd_off(4 * G + 2, KS, 0)>(vb); f.h2 = tr_read<v2_rd_off(4 * G + 2, KS, 1)>(vb); f.l3 = tr_read<v2_rd_off(4 * G + 3, KS, 0)>(vb); f.h3 = tr_read<v2_rd_off(4 * G + 3, KS, 1)>(vb);
}
template <int G> __device__ __forceinline__ void vs_mma(f32x16* o, const VSet& f, bf16x8 pa) {
#define PK(Lo, Hi) (bf16x8){Lo[0], Lo[1], Lo[2], Lo[3], Hi[0], Hi[1], Hi[2], Hi[3]}
    o[4 * G + 0] = __builtin_amdgcn_mfma_f32_32x32x16_bf16(pa, PK(f.l0, f.h0), o[4 * G + 0], 0, 0, 0);
    o[4 * G + 1] = __builtin_amdgcn_mfma_f32_32x32x16_bf16(pa, PK(f.l1, f.h1), o[4 * G + 1], 0, 0, 0);
    o[4 * G + 2] = __builtin_amdgcn_mfma_f32_32x32x16_bf16(pa, PK(f.l2, f.h2), o[4 * G + 2], 0, 0, 0);
    o[4 * G + 3] = __builtin_amdgcn_mfma_f32_32x32x16_bf16(pa, PK(f.l3, f.h3), o[4 * G + 3], 0, 0, 0);
#undef PK
}
__device__ __forceinline__ void pv2_all(f32x16* o, int vb, bf16x8 pa0, bf16x8 pa1, bf16x8 pa2, bf16x8 pa3) {
    VSet A, B;
#define W8() do { asm volatile("s_waitcnt lgkmcnt(8)" ::: "memory"); SBAR(); } while (0)
    PRIO_HI();
    vs_load<0, 0>(A, vb);
    vs_load<0, 1>(B, vb); W8(); vs_mma<0>(o, A, pa0); SBAR();
    vs_load<0, 2>(A, vb); W8(); vs_mma<0>(o, B, pa1); SBAR();
    vs_load<0, 3>(B, vb); W8(); vs_mma<0>(o, A, pa2); SBAR();
    vs_load<1, 0>(A, vb); W8(); vs_mma<0>(o, B, pa3); SBAR();
    vs_load<1, 1>(B, vb); W8(); vs_mma<1>(o, A, pa0); SBAR();
    vs_load<1, 2>(A, vb); W8(); vs_mma<1>(o, B, pa1); SBAR();
    vs_load<1, 3>(B, vb); W8(); vs_mma<1>(o, A, pa2); SBAR();
    asm volatile("s_waitcnt lgkmcnt(0)" ::: "memory"); SBAR(); vs_mma<1>(o, B, pa3); SBAR();
    PRIO_LO();
#undef W8
}
__device__ __forceinline__ void unit2(const bf16_t* __restrict__ Qb, const bf16_t* __restrict__ Kh, const bf16_t* __restrict__ Vh, bf16_t* __restrict__ Ob, int NT, int lim, unsigned char* ldsg, LAS unsigned char* lds, int rev = 0) {
#define TILE(s_) (rev ? NT - 1 - (s_) : (s_))
    int tid_ = threadIdx.x; asm volatile("" : "+v"(tid_));
    const int tid = tid_, wid = __builtin_amdgcn_readfirstlane(tid >> 6), lane = tid & 63, r32 = lane & 31, hi = lane >> 5;
    LAS float* wsf = (LAS float*)(lds + OFF_W) + wid * 64; LAS float* li_l = wsf; LAS float* al_l = wsf + 32;
    float m_reg = -1e30f, l_reg = 0; f32x16 o[8] = {}; bf16x8 qr[8];
    const bf16_t* Qw = Qb + (long)(wid * QBLK + r32) * LDQ + hi * 8;
#pragma unroll
    for (int d0 = 0; d0 < 8; ++d0) qr[d0] = *reinterpret_cast<const bf16x8*>(Qw + d0 * 16);
    const int vb0 = (int)(uintptr_t)(ldsg + OFF_V) + v_rd_base(lane);
    unsigned ko0, vo0;
    { const int row = wid * 4 + (lane >> 4); ko0 = (unsigned)(row * LDQ * 2 + (((lane & 15) * 16) ^ ((row & MK_KSWM) << 4)));
      const int st = wid * 2 + (lane >> 5), q = lane & 31; const int kk = (st >> 3) * 8 + (q >> 2); const int k = (kk & ~0xC) | ((kk & 4) << 1) | ((kk & 8) >> 1);
      vo0 = (unsigned)(k * LDQ * 2 + ((st & 7) * 32 + (q & 3) * 8) * 2); }
#define DMA_K(t_, b_) do { const char* gk = (const char*)Kh + (size_t)(t_) * (KVBLK * LDQ * 2); _Pragma("unroll") for (int i = 0; i < 2; ++i) { \
        __builtin_amdgcn_global_load_lds((const unsigned*)(gk + (size_t)i * (32 * LDQ * 2) + ko0), (LAS unsigned*)(lds + (b_) * KB + wid * 1024 + i * 8192), 16, 0, 0); } } while (0)
#define DMA_V(t_, b_) do { const char* gv = (const char*)Vh + (size_t)(t_) * (KVBLK * LDQ * 2); _Pragma("unroll") for (int i = 0; i < 4; ++i) { \
        __builtin_amdgcn_global_load_lds((const unsigned*)(gv + (size_t)i * (16 * LDQ * 2) + vo0), (LAS unsigned*)(lds + OFF_V + (b_) * VB + wid * 1024 + i * 8192), 16, 0, 0); } } while (0)
    DMA_K(TILE(0), 0); DMA_V(TILE(0), 0); if (1 < NT) { DMA_K(TILE(1), 1); DMA_V(TILE(1), 1); }
    asm volatile("s_waitcnt vmcnt(0)" ::: "memory"); __builtin_amdgcn_s_barrier(); asm volatile("" ::: "memory");
    int kb = 0;
    for (int j = 0; j < NT; ++j) {
        const int kb2 = kb == 0 ? 2 : kb - 1;
        const int tl = TILE(j);
        if (j + 2 < NT) DMA_V(TILE(j + 2), kb2);
        asm volatile("" ::: "memory");
        if (j + 2 < NT) DMA_K(TILE(j + 2), kb2);
        asm volatile("" ::: "memory");
        if (tl <= lim) {
        f32x16 p0, p1; float mn, alpha; bf16x8 pa0, pa1, pa2, pa3;
        qkt(p0, p1, (const char*)ldsg + kb * KB, qr, r32, hi);
#if MK_PROBE_QK2
        asm volatile("" : "+v"(p0), "+v"(p1)); qkt(p0, p1, (const char*)ldsg + kb * KB, qr, r32, hi);
#endif
        if (tl == 0) {
            asm volatile("; tile-0 mask" ::: "memory");
#pragma unroll
            for (int r = 0; r < 16; ++r) p0[r] = -1e30f;
#pragma unroll
            for (int r = 0; r < 8; ++r) p1[r] = -1e30f;
        }
        partialSM(p0, p1, m_reg, mn, alpha);
        if (__any(alpha < 1.f)) { if (hi == 0) al_l[r32] = alpha; asm volatile("s_waitcnt lgkmcnt(0)" ::: "memory");
#pragma unroll
            for (int d = 0; d < 8; ++d)
#pragma unroll
                for (int r = 0; r < 16; ++r) o[d][r] *= al_l[crow(r, hi)]; }
        finishSM(p0, p1, alpha, l_reg, pa0, pa1, pa2, pa3); SBAR();
        const int vb = vb0 + kb * VB;
        pv2_all(o, vb, pa0, pa1, pa2, pa3);
        }
        if (j + 2 < NT) asm volatile("s_waitcnt vmcnt(6)" ::: "memory"); else asm volatile("s_waitcnt vmcnt(0)" ::: "memory");
        __builtin_amdgcn_s_barrier(); asm volatile("" ::: "memory");
        kb = kb == 2 ? 0 : kb + 1;
    }
    if (hi == 0) li_l[r32] = l_reg; asm volatile("s_waitcnt lgkmcnt(0)" ::: "memory");
    float rli[16];
#pragma unroll
    for (int r = 0; r < 16; ++r) rli[r] = __builtin_amdgcn_rcpf(li_l[crow(r, hi)]);
    bf16_t* Ow = Ob + (long)(wid * QBLK) * LDO;
#pragma unroll
    for (int r = 0; r < 16; ++r) { const int orow = crow(r, hi);
#pragma unroll
        for (int d0 = 0; d0 < 8; ++d0) Ow[(long)orow * LDO + d0 * 32 + r32] = f2bf(o[d0][r] * rli[r]); }
    asm volatile("s_waitcnt lgkmcnt(0)" ::: "memory"); __builtin_amdgcn_s_barrier(); asm volatile("" ::: "memory");
#undef DMA_K
#undef DMA_V
#undef TILE
}

__device__ __forceinline__ void unit3(const bf16_t* __restrict__ Qb, const bf16_t* __restrict__ Kh, const bf16_t* __restrict__ Vh, bf16_t* __restrict__ Ob, int NT, int lim, unsigned char* ldsg, LAS unsigned char* lds) {
    int tid_ = threadIdx.x; asm volatile("" : "+v"(tid_));
    const int tid = tid_, wid = __builtin_amdgcn_readfirstlane(tid >> 6), lane = tid & 63, r32 = lane & 31, hi = lane >> 5, hb = MK_HB(wid);
    LAS float* wsf = (LAS float*)(lds + OFF_W) + wid * 64; LAS float* li_l = wsf; LAS float* al_l = wsf + 32;
    float m_reg = -1e30f, l_reg = 0; f32x16 o[8] = {}; bf16x8 qr[8];
    const bf16_t* Qw = Qb + (long)(wid * QBLK + r32) * LDQ + hi * 8;
#pragma unroll
    for (int d0 = 0; d0 < 8; ++d0) qr[d0] = *reinterpret_cast<const bf16x8*>(Qw + d0 * 16);
#define DMA_K(t_, b_) do { const char* gk = (const char*)Kh + (size_t)(t_) * (KVBLK * LDQ * 2); int ln_ = lane; asm volatile("" : "+v"(ln_)); _Pragma("unroll") for (int i = 0; i < 2; ++i) { \
        const int row = wid * 4 + i * 32 + (ln_ >> 4); const unsigned ko = (unsigned)(row * LDQ * 2 + (((ln_ & 15) * 16) ^ ((row & MK_KSWM) << 4))); \
        __builtin_amdgcn_global_load_lds((const unsigned*)(gk + ko), (LAS unsigned*)(lds + (b_) * KB + wid * 1024 + i * 8192), 16, 0, 0); } } while (0)
#define DMA_V(t_, b_) do { const char* gv = (const char*)Vh + (size_t)(t_) * (KVBLK * LDQ * 2); int ln_ = lane; asm volatile("" : "+v"(ln_)); _Pragma("unroll") for (int i = 0; i < 4; ++i) { \
        const int st = wid * 2 + i * 16 + (ln_ >> 5), q = ln_ & 31; const int kk = (st >> 3) * 8 + (q >> 2); const int k = (kk & ~0xC) | ((kk & 4) << 1) | ((kk & 8) >> 1); \
        const unsigned vo = (unsigned)(k * LDQ * 2 + ((st & 7) * 32 + (q & 3) * 8) * 2); \
        __builtin_amdgcn_global_load_lds((const unsigned*)(gv + vo), (LAS unsigned*)(lds + OFF_V + (b_) * VB + wid * 1024 + i * 8192), 16, 0, 0); } } while (0)
    DMA_K(0, 0); DMA_V(0, 0); if (1 < NT) { DMA_K(1, 1); DMA_V(1, 1); }
    asm volatile("s_waitcnt vmcnt(0)" ::: "memory"); __builtin_amdgcn_s_barrier(); asm volatile("" ::: "memory");
    bf16x8 pa0, pa1, pa2, pa3;
    int kq = 0, ki = 2;
    int vq = 0, vi = 2;
#define U3_QS(j_) do { f32x16 p0, p1; float mn, alpha; int lq_ = lane; asm volatile("" : "+v"(lq_)); const int r32 = lq_ & 31, hi = lq_ >> 5; \
        qkt(p0, p1, (const char*)ldsg + kq * KB, qr, r32, hi); kq = kq == 2 ? 0 : kq + 1; \
        mask_tile(p0, p1, (j_), lim); \
        partialSM(p0, p1, m_reg, mn, alpha); \
        if (__any(alpha < 1.f)) { if (hi == 0) al_l[r32] = alpha; asm volatile("s_waitcnt lgkmcnt(0)" ::: "memory"); \
            _Pragma("unroll") for (int d = 0; d < 8; ++d) _Pragma("unroll") for (int r = 0; r < 16; ++r) o[d][r] *= al_l[crow(r, hi)]; } \
        finishSM(p0, p1, alpha, l_reg, pa0, pa1, pa2, pa3); } while (0)
#define U3_PV(j_) do { int lp_ = lane; asm volatile("" : "+v"(lp_)); const int vb = (int)(uintptr_t)(ldsg + OFF_V) + v_rd_base(lp_) + vq * VB; vq = vq == 2 ? 0 : vq + 1; \
        pv2_one<0>(o[0], vb, pa0, pa1, pa2, pa3); pv2_one<1>(o[1], vb, pa0, pa1, pa2, pa3); pv2_one<2>(o[2], vb, pa0, pa1, pa2, pa3); pv2_one<3>(o[3], vb, pa0, pa1, pa2, pa3); \
        pv2_one<4>(o[4], vb, pa0, pa1, pa2, pa3); pv2_one<5>(o[5], vb, pa0, pa1, pa2, pa3); pv2_one<6>(o[6], vb, pa0, pa1, pa2, pa3); pv2_one<7>(o[7], vb, pa0, pa1, pa2, pa3); } while (0)
#define U3_EVEN_ISSUE(jj_) do { if ((jj_) + 2 < NT) DMA_K((jj_) + 2, ki); ki = ki == 2 ? 0 : ki + 1; asm volatile("" ::: "memory"); } while (0)
#define U3_ODD_ISSUE(jj_) do { if ((jj_) + 2 < NT) DMA_V((jj_) + 2, vi); vi = vi == 2 ? 0 : vi + 1; asm volatile("" ::: "memory"); } while (0)
#define U3_EVEN_END(jj_) do { if ((jj_) + 2 < NT) asm volatile("s_waitcnt vmcnt(6)" ::: "memory"); else if ((jj_) + 1 < NT) asm volatile("s_waitcnt vmcnt(4)" ::: "memory"); else asm volatile("s_waitcnt vmcnt(0)" ::: "memory");   \
        asm volatile("s_waitcnt lgkmcnt(0)" ::: "memory"); __builtin_amdgcn_s_barrier(); asm volatile("" ::: "memory"); } while (0)
#define U3_ODD_END() do { asm volatile("s_waitcnt lgkmcnt(0)" ::: "memory"); __builtin_amdgcn_s_barrier(); asm volatile("" ::: "memory"); } while (0)
    if (hb == 0) {
#pragma unroll 1
        for (int jj = 0; jj < NT; ++jj) {
            U3_EVEN_ISSUE(jj); U3_QS(jj); U3_EVEN_END(jj);
            U3_ODD_ISSUE(jj); U3_PV(jj); U3_ODD_END();
        }
        U3_EVEN_ISSUE(NT); U3_EVEN_END(NT);
    } else {
        U3_EVEN_ISSUE(0); U3_EVEN_END(0);
#pragma unroll 1
        for (int jj = 0; jj < NT; ++jj) {
            U3_ODD_ISSUE(jj); U3_QS(jj); U3_ODD_END();
            U3_EVEN_ISSUE(jj + 1); U3_PV(jj); U3_EVEN_END(jj + 1);
        }
    }
#undef U3_QS
#undef U3_PV
#undef U3_EVEN_ISSUE
#undef U3_ODD_ISSUE
#undef U3_EVEN_END
#undef U3_ODD_END
    if (hi == 0) li_l[r32] = l_reg; asm volatile("s_waitcnt lgkmcnt(0)" ::: "memory");
    float rli[16];
#pragma unroll
    for (int r = 0; r < 16; ++r) rli[r] = __builtin_amdgcn_rcpf(li_l[crow(r, hi)]);
    bf16_t* Ow = Ob + (long)(wid * QBLK) * LDO;
#pragma unroll
    for (int r = 0; r < 16; ++r) { const int orow = crow(r, hi);
#pragma unroll
        for (int d0 = 0; d0 < 8; ++d0) Ow[(long)orow * LDO + d0 * 32 + r32] = f2bf(o[d0][r] * rli[r]); }
    asm volatile("s_waitcnt vmcnt(0) lgkmcnt(0)" ::: "memory"); __builtin_amdgcn_s_barrier(); asm volatile("" ::: "memory");
#undef DMA_K
#undef DMA_V
}

__device__ __forceinline__ void unit4(const bf16_t* __restrict__ Qb, const bf16_t* __restrict__ Kh, const bf16_t* __restrict__ Vh, bf16_t* __restrict__ Ob, int NT, int lim, unsigned char* ldsg, LAS unsigned char* lds) {
    int tid_ = threadIdx.x; asm volatile("" : "+v"(tid_));
    const int tid = tid_, wid = __builtin_amdgcn_readfirstlane(tid >> 6), lane = tid & 63, hb = MK_HB(wid);
    LAS float* wsf = (LAS float*)(lds + OFF_W) + wid * 64; LAS float* li_l = wsf; LAS float* al_l = wsf + 32;
    float m_reg = -1e30f, l_reg = 0; f32x16 o[8] = {}; bf16x8 qr[8];
    { const int r32 = lane & 31, hi = lane >> 5; const bf16_t* Qw = Qb + (long)(wid * QBLK + r32) * LDQ + hi * 8;
#pragma unroll
      for (int d0 = 0; d0 < 8; ++d0) qr[d0] = *reinterpret_cast<const bf16x8*>(Qw + d0 * 16); }
#define DMA_K(t_, b_) do { const char* gk = (const char*)Kh + (size_t)(t_) * (KVBLK * LDQ * 2); int ln_ = lane; asm volatile("" : "+v"(ln_)); _Pragma("unroll") for (int i = 0; i < 2; ++i) { \
        const int row = wid * 4 + i * 32 + (ln_ >> 4); const unsigned ko = (unsigned)(row * LDQ * 2 + (((ln_ & 15) * 16) ^ ((row & MK_KSWM) << 4))); \
        __builtin_amdgcn_global_load_lds((const unsigned*)(gk + ko), (LAS unsigned*)(lds + (b_) * KB + wid * 1024 + i * 8192), 16, 0, 0); } } while (0)
#define DMA_V(t_, b_) do { const char* gv = (const char*)Vh + (size_t)(t_) * (KVBLK * LDQ * 2); int ln_ = lane; asm volatile("" : "+v"(ln_)); _Pragma("unroll") for (int i = 0; i < 4; ++i) { \
        const int st = wid * 2 + i * 16 + (ln_ >> 5), q = ln_ & 31; const int kk = (st >> 3) * 8 + (q >> 2); const int k = (kk & ~0xC) | ((kk & 4) << 1) | ((kk & 8) >> 1); \
        const unsigned vo = (unsigned)(k * LDQ * 2 + ((st & 7) * 32 + (q & 3) * 8) * 2); \
        __builtin_amdgcn_global_load_lds((const unsigned*)(gv + vo), (LAS unsigned*)(lds + OFF_V + (b_) * VB + wid * 1024 + i * 8192), 16, 0, 0); } } while (0)
    DMA_K(0, 0); DMA_V(0, 0); if (1 < NT) { DMA_K(1, 1); DMA_V(1, 1); } if (2 < NT) DMA_K(2, 2);
    asm volatile("s_waitcnt vmcnt(0)" ::: "memory"); __builtin_amdgcn_s_barrier(); asm volatile("" ::: "memory");
    f32x16 p0, p1; bf16x8 pa0, pa1, pa2, pa3;
    int kq = 0, ki = 0, vq = 0, vi = 2;
#define U4_QK() do { int lq_ = lane; asm volatile("" : "+v"(lq_)); qkt(p0, p1, (const char*)ldsg + kq * KB, qr, lq_ & 31, lq_ >> 5); kq = kq == 2 ? 0 : kq + 1; } while (0)
#define U4_SM(j_) do { float mn, alpha; int lq_ = lane; asm volatile("" : "+v"(lq_)); const int r32 = lq_ & 31, hi = lq_ >> 5; \
        mask_tile(p0, p1, (j_), lim); \
        partialSM(p0, p1, m_reg, mn, alpha); \
        if (__any(alpha < 1.f)) { if (hi == 0) al_l[r32] = alpha; asm volatile("s_waitcnt lgkmcnt(0)" ::: "memory"); \
            _Pragma("unroll") for (int d = 0; d < 8; ++d) _Pragma("unroll") for (int r = 0; r < 16; ++r) o[d][r] *= al_l[crow(r, hi)]; } \
        finishSM(p0, p1, alpha, l_reg, pa0, pa1, pa2, pa3); } while (0)
#define U4_PV() do { int lp_ = lane; asm volatile("" : "+v"(lp_)); const int vb = (int)(uintptr_t)(ldsg + OFF_V) + v_rd_base(lp_) + vq * VB; vq = vq == 2 ? 0 : vq + 1; \
        pv2_all(o, vb, pa0, pa1, pa2, pa3); } while (0)
#define U4_ISSUE(s_) do { if (((s_) & 1) == 0) { if ((s_) >= 2) { if ((s_) / 2 + 2 < NT) DMA_K((s_) / 2 + 2, ki); ki = ki == 2 ? 0 : ki + 1; } } \
        else { if ((s_) >= 3) { if (((s_) + 1) / 2 < NT) DMA_V(((s_) + 1) / 2, vi); vi = vi == 2 ? 0 : vi + 1; } } asm volatile("" ::: "memory"); } while (0)
#define U4_END(s_) do { if ((s_) & 1) { const int kt = ((s_) + 1) / 2 + 1, vt = ((s_) + 1) / 2;     \
            if ((s_) >= 3 && kt < NT && vt < NT) asm volatile("s_waitcnt vmcnt(6)" ::: "memory"); \
            else if ((s_) >= 3 && vt < NT) asm volatile("s_waitcnt vmcnt(4)" ::: "memory"); \
            else asm volatile("s_waitcnt vmcnt(0)" ::: "memory"); } \
        asm volatile("s_waitcnt lgkmcnt(0)" ::: "memory"); __builtin_amdgcn_s_barrier(); asm volatile("" ::: "memory"); } while (0)
    if (hb == 0) {
        U4_ISSUE(0); U4_QK(); U4_END(0);
#pragma unroll 1
        for (int m = 0; m < NT; ++m) {
            U4_ISSUE(2 * m + 1); U4_SM(m); U4_END(2 * m + 1);
            U4_ISSUE(2 * m + 2); U4_PV(); if (m + 1 < NT) U4_QK(); U4_END(2 * m + 2);
        }
        U4_ISSUE(2 * NT + 1); U4_END(2 * NT + 1);
    } else {
        U4_ISSUE(0); U4_END(0);
        U4_ISSUE(1); U4_QK(); U4_END(1);
#pragma unroll 1
        for (int m = 0; m < NT; ++m) {
            U4_ISSUE(2 * m + 2); U4_SM(m); U4_END(2 * m + 2);
            U4_ISSUE(2 * m + 3); U4_PV(); if (m + 1 < NT) U4_QK(); U4_END(2 * m + 3);
        }
    }
#undef U4_QK
#undef U4_SM
#undef U4_PV
#undef U4_ISSUE
#undef U4_END
    const int r32 = lane & 31, hi = lane >> 5;
    if (hi == 0) li_l[r32] = l_reg; asm volatile("s_waitcnt lgkmcnt(0)" ::: "memory");
    float rli[16];
#pragma unroll
    for (int r = 0; r < 16; ++r) rli[r] = __builtin_amdgcn_rcpf(li_l[crow(r, hi)]);
    bf16_t* Ow = Ob + (long)(wid * QBLK) * LDO;
#pragma unroll
    for (int r = 0; r < 16; ++r) { const int orow = crow(r, hi);
#pragma unroll
        for (int d0 = 0; d0 < 8; ++d0) Ow[(long)orow * LDO + d0 * 32 + r32] = f2bf(o[d0][r] * rli[r]); }
    asm volatile("s_waitcnt vmcnt(0) lgkmcnt(0)" ::: "memory"); __builtin_amdgcn_s_barrier(); asm volatile("" ::: "memory");
#undef DMA_K
#undef DMA_V
}

__device__ __forceinline__ void unit5(const bf16_t* __restrict__ Qb, const bf16_t* __restrict__ Kh, const bf16_t* __restrict__ Vh, bf16_t* __restrict__ Ob, int NT, int lim, unsigned char* ldsg, LAS unsigned char* lds) {
    int tid_ = threadIdx.x; asm volatile("" : "+v"(tid_));
    const int tid = tid_, wid = __builtin_amdgcn_readfirstlane(tid >> 6), lane = tid & 63, hb = MK_HB(wid);
    LAS float* wsf = (LAS float*)(lds + OFF_W) + wid * 64; LAS float* li_l = wsf; LAS float* al_l = wsf + 32;
    float m_reg = -1e30f, l_reg = 0; f32x16 o[8] = {}; bf16x8 qr[8];
    { const int r32 = lane & 31, hi = lane >> 5; const bf16_t* Qw = Qb + (long)(wid * QBLK + r32) * LDQ + hi * 8;
#pragma unroll
      for (int d0 = 0; d0 < 8; ++d0) qr[d0] = *reinterpret_cast<const bf16x8*>(Qw + d0 * 16); }
#define DMA_K(t_, b_) do { const char* gk = (const char*)Kh + (size_t)(t_) * (KVBLK * LDQ * 2); int ln_ = lane; asm volatile("" : "+v"(ln_)); _Pragma("unroll") for (int i = 0; i < 2; ++i) { \
        const int row = wid * 4 + i * 32 + (ln_ >> 4); const unsigned ko = (unsigned)(row * LDQ * 2 + (((ln_ & 15) * 16) ^ ((row & MK_KSWM) << 4))); \
        __builtin_amdgcn_global_load_lds((const unsigned*)(gk + ko), (LAS unsigned*)(lds + (b_) * KB + wid * 1024 + i * 8192), 16, 0, 0); } } while (0)
#define DMA_V(t_, b_) do { const char* gv = (const char*)Vh + (size_t)(t_) * (KVBLK * LDQ * 2); int ln_ = lane; asm volatile("" : "+v"(ln_)); _Pragma("unroll") for (int i = 0; i < 4; ++i) { \
        const int st = wid * 2 + i * 16 + (ln_ >> 5), q = ln_ & 31; const int kk = (st >> 3) * 8 + (q >> 2); const int k = (kk & ~0xC) | ((kk & 4) << 1) | ((kk & 8) >> 1); \
        const unsigned vo = (unsigned)(k * LDQ * 2 + ((st & 7) * 32 + (q & 3) * 8) * 2); \
        __builtin_amdgcn_global_load_lds((const unsigned*)(gv + vo), (LAS unsigned*)(lds + OFF_V + (b_) * VB + wid * 1024 + i * 8192), 16, 0, 0); } } while (0)
    DMA_K(0, 0); DMA_V(0, 0); if (1 < NT) DMA_K(1, 1);
    asm volatile("s_waitcnt vmcnt(0)" ::: "memory"); __builtin_amdgcn_s_barrier(); asm volatile("" ::: "memory");
    bf16x8 pa0, pa1, pa2, pa3;
    int kb = 0, kb1 = 1, kb2 = 2;
#define U5_ISSUE(j_) do { if ((j_) + 1 < NT) DMA_V((j_) + 1, kb1); asm volatile("" ::: "memory"); if ((j_) + 2 < NT) DMA_K((j_) + 2, kb2); asm volatile("" ::: "memory"); } while (0)
#define U5_QS(j_) do { f32x16 p0, p1; float mn, alpha; int lq_ = lane; asm volatile("" : "+v"(lq_)); const int r32 = lq_ & 31, hi = lq_ >> 5; \
        qkt(p0, p1, (const char*)ldsg + kb * KB, qr, r32, hi); \
        mask_tile(p0, p1, (j_), lim); \
        partialSM(p0, p1, m_reg, mn, alpha); \
        if (__any(alpha < 1.f)) { if (hi == 0) al_l[r32] = alpha; asm volatile("s_waitcnt lgkmcnt(0)" ::: "memory"); \
            _Pragma("unroll") for (int d = 0; d < 8; ++d) _Pragma("unroll") for (int r = 0; r < 16; ++r) o[d][r] *= al_l[crow(r, hi)]; } \
        finishSM(p0, p1, alpha, l_reg, pa0, pa1, pa2, pa3); } while (0)
#define U5_PV(vbuf_) do { int lp_ = lane; asm volatile("" : "+v"(lp_)); const int vb = (int)(uintptr_t)(ldsg + OFF_V) + v_rd_base(lp_) + (vbuf_) * VB; pv2_all(o, vb, pa0, pa1, pa2, pa3); } while (0)
#define U5_END(j_) do { if ((j_) + 2 < NT) asm volatile("s_waitcnt vmcnt(2)" ::: "memory"); else asm volatile("s_waitcnt vmcnt(0)" ::: "memory"); \
        asm volatile("s_waitcnt lgkmcnt(0)" ::: "memory"); __builtin_amdgcn_s_barrier(); asm volatile("" ::: "memory"); \
        { const int t_ = kb; kb = kb1; kb1 = kb2; kb2 = t_; } } while (0)
    if (hb == 0) {
#pragma unroll 1
        for (int j = 0; j < NT; ++j) { U5_ISSUE(j); U5_QS(j); U5_PV(kb); U5_END(j); }
    } else {
#pragma unroll 1
        for (int j = 0; j < NT; ++j) { U5_ISSUE(j); if (j > 0) U5_PV(kb2); U5_QS(j); U5_END(j); }
        U5_PV(kb2);
    }
#undef U5_ISSUE
#undef U5_QS
#undef U5_PV
#undef U5_END
    const int r32 = lane & 31, hi = lane >> 5;
    if (hi == 0) li_l[r32] = l_reg; asm volatile("s_waitcnt lgkmcnt(0)" ::: "memory");
    float rli[16];
#pragma unroll
    for (int r = 0; r < 16; ++r) rli[r] = __builtin_amdgcn_rcpf(li_l[crow(r, hi)]);
    bf16_t* Ow = Ob + (long)(wid * QBLK) * LDO;
#pragma unroll
    for (int r = 0; r < 16; ++r) { const int orow = crow(r, hi);
#pragma unroll
        for (int d0 = 0; d0 < 8; ++d0) Ow[(long)orow * LDO + d0 * 32 + r32] = f2bf(o[d0][r] * rli[r]); }
    asm volatile("s_waitcnt vmcnt(0) lgkmcnt(0)" ::: "memory"); __builtin_amdgcn_s_barrier(); asm volatile("" ::: "memory");
#undef DMA_K
#undef DMA_V
}

constexpr int v6_off(int c, int cb, int h) { return c * 16384 + h * 8192 + cb * 256; }
struct V6Set { s16x4 l0, h0, l1, h1, l2, h2, l3, h3; };
template <int C, int G> __device__ __forceinline__ void v6_load(V6Set& f, int vb) {
    f.l0 = tr_read<v6_off(C, 4 * G + 0, 0)>(vb); f.h0 = tr_read<v6_off(C, 4 * G + 0, 1)>(vb); f.l1 = tr_read<v6_off(C, 4 * G + 1, 0)>(vb); f.h1 = tr_read<v6_off(C, 4 * G + 1, 1)>(vb);
    f.l2 = tr_read<v6_off(C, 4 * G + 2, 0)>(vb); f.h2 = tr_read<v6_off(C, 4 * G + 2, 1)>(vb); f.l3 = tr_read<v6_off(C, 4 * G + 3, 0)>(vb); f.h3 = tr_read<v6_off(C, 4 * G + 3, 1)>(vb);
}
template <int G> __device__ __forceinline__ void v6_mma(f32x4 (&o)[2][16], const V6Set& f, bf16x8 pa0, bf16x8 pa1) {
#define PK(Lo, Hi) (bf16x8){Lo[0], Lo[1], Lo[2], Lo[3], Hi[0], Hi[1], Hi[2], Hi[3]}
    o[0][4 * G + 0] = __builtin_amdgcn_mfma_f32_16x16x32_bf16(pa0, PK(f.l0, f.h0), o[0][4 * G + 0], 0, 0, 0);
    o[1][4 * G + 0] = __builtin_amdgcn_mfma_f32_16x16x32_bf16(pa1, PK(f.l0, f.h0), o[1][4 * G + 0], 0, 0, 0);
    o[0][4 * G + 1] = __builtin_amdgcn_mfma_f32_16x16x32_bf16(pa0, PK(f.l1, f.h1), o[0][4 * G + 1], 0, 0, 0);
    o[1][4 * G + 1] = __builtin_amdgcn_mfma_f32_16x16x32_bf16(pa1, PK(f.l1, f.h1), o[1][4 * G + 1], 0, 0, 0);
    o[0][4 * G + 2] = __builtin_amdgcn_mfma_f32_16x16x32_bf16(pa0, PK(f.l2, f.h2), o[0][4 * G + 2], 0, 0, 0);
    o[1][4 * G + 2] = __builtin_amdgcn_mfma_f32_16x16x32_bf16(pa1, PK(f.l2, f.h2), o[1][4 * G + 2], 0, 0, 0);
    o[0][4 * G + 3] = __builtin_amdgcn_mfma_f32_16x16x32_bf16(pa0, PK(f.l3, f.h3), o[0][4 * G + 3], 0, 0, 0);
    o[1][4 * G + 3] = __builtin_amdgcn_mfma_f32_16x16x32_bf16(pa1, PK(f.l3, f.h3), o[1][4 * G + 3], 0, 0, 0);
#undef PK
}
__device__ __forceinline__ void pv6_all(f32x4 (&o)[2][16], int vb, bf16x8 pa00, bf16x8 pa01, bf16x8 pa10, bf16x8 pa11) {
    V6Set A, B;
#define W8() do { asm volatile("s_waitcnt lgkmcnt(8)" ::: "memory"); SBAR(); } while (0)
    v6_load<0, 0>(A, vb);
    v6_load<0, 1>(B, vb); W8(); v6_mma<0>(o, A, pa00, pa10); SBAR();
    v6_load<0, 2>(A, vb); W8(); v6_mma<1>(o, B, pa00, pa10); SBAR();
    v6_load<0, 3>(B, vb); W8(); v6_mma<2>(o, A, pa00, pa10); SBAR();
    v6_load<1, 0>(A, vb); W8(); v6_mma<3>(o, B, pa00, pa10); SBAR();
    v6_load<1, 1>(B, vb); W8(); v6_mma<0>(o, A, pa01, pa11); SBAR();
    v6_load<1, 2>(A, vb); W8(); v6_mma<1>(o, B, pa01, pa11); SBAR();
    v6_load<1, 3>(B, vb); W8(); v6_mma<2>(o, A, pa01, pa11); SBAR();
    asm volatile("s_waitcnt lgkmcnt(0)" ::: "memory"); SBAR(); v6_mma<3>(o, B, pa01, pa11); SBAR();
#undef W8
}
#ifndef MK_X16SWAP
#define MK_X16SWAP 0
#endif
__device__ __forceinline__ float grp_max(float v) {
#if MK_X16SWAP
    { auto rr = __builtin_amdgcn_permlane16_swap(__float_as_uint(v), __float_as_uint(v), false, false); v = fmaxf(__uint_as_float(rr[0]), __uint_as_float(rr[1])); }
#else
    v = fmaxf(v, __shfl_xor(v, 16));
#endif
    { auto rr = __builtin_amdgcn_permlane32_swap(__float_as_uint(v), __float_as_uint(v), false, false); v = fmaxf(__uint_as_float(rr[0]), __uint_as_float(rr[1])); }
    return v;
}
__device__ __forceinline__ float grp_sum(float v) {
#if MK_X16SWAP
    { auto rr = __builtin_amdgcn_permlane16_swap(__float_as_uint(v), __float_as_uint(v), false, false); v = __uint_as_float(rr[0]) + __uint_as_float(rr[1]); }
#else
    v += __shfl_xor(v, 16);
#endif
    { auto rr = __builtin_amdgcn_permlane32_swap(__float_as_uint(v), __float_as_uint(v), false, false); v = __uint_as_float(rr[0]) + __uint_as_float(rr[1]); }
    return v;
}
__device__ __forceinline__ void unit6(const bf16_t* __restrict__ Qb, const bf16_t* __restrict__ Kh, const bf16_t* __restrict__ Vh, bf16_t* __restrict__ Ob, int NT, int lim, unsigned char* ldsg, LAS unsigned char* lds) {
    int tid_ = threadIdx.x; asm volatile("" : "+v"(tid_));
    const int tid = tid_, wid = __builtin_amdgcn_readfirstlane(tid >> 6), lane = tid & 63, c16 = lane & 15, g = lane >> 4;
    LAS float* wsf = (LAS float*)(lds + OFF_W) + wid * 64; LAS float* li_l = wsf; LAS float* al_l = wsf + 32;
    float m0 = -1e30f, m1 = -1e30f, l0 = 0.f, l1 = 0.f;
    f32x4 o[2][16];
#pragma unroll
    for (int qb = 0; qb < 2; ++qb)
#pragma unroll
        for (int cb = 0; cb < 16; ++cb) o[qb][cb] = (f32x4){0.f, 0.f, 0.f, 0.f};
    bf16x8 qr[2][4];
    { const bf16_t* Qw = Qb + (long)(wid * QBLK + c16) * LDQ + g * 8;
#pragma unroll
      for (int qb = 0; qb < 2; ++qb)
#pragma unroll
          for (int ds = 0; ds < 4; ++ds) qr[qb][ds] = *reinterpret_cast<const bf16x8*>(Qw + (long)qb * 16 * LDQ + ds * 32); }
    const int ka0 = c16 * 256 + ((g * 16) ^ (c16 << 4));
    const int vb0 = (int)(uintptr_t)(ldsg + OFF_V) + (g >> 1) * 4096 + (g & 1) * 128 + (c16 >> 2) * 32 + (c16 & 3) * 8;
    unsigned ko0, vo0;
    { const int row = wid * 4 + (lane >> 4); ko0 = (unsigned)(row * LDQ * 2 + (((lane & 15) * 16) ^ ((row & 15) << 4)));
      const int key = (wid >> 2) * 8 + ((lane & 15) >> 1), col = (4 * (wid & 3) + (lane >> 4)) * 16 + (lane & 1) * 8;
      vo0 = (unsigned)(key * LDQ * 2 + col * 2); }
#define DMA_K(t_, b_) do { const char* gk = (const char*)Kh + (size_t)(t_) * (KVBLK * LDQ * 2); _Pragma("unroll") for (int i = 0; i < 2; ++i) { \
        __builtin_amdgcn_global_load_lds((const unsigned*)(gk + (size_t)i * (32 * LDQ * 2) + ko0), (LAS unsigned*)(lds + (b_) * KB + wid * 1024 + i * 8192), 16, 0, 0); } } while (0)
#define DMA_V(t_, b_) do { const char* gv = (const char*)Vh + (size_t)(t_) * (KVBLK * LDQ * 2); _Pragma("unroll") for (int i = 0; i < 4; ++i) { \
        __builtin_amdgcn_global_load_lds((const unsigned*)(gv + (size_t)i * (16 * LDQ * 2) + vo0), (LAS unsigned*)(lds + OFF_V + (b_) * VB + wid * 1024 + i * 8192), 16, 0, 0); } } while (0)
    DMA_K(0, 0); DMA_V(0, 0); if (1 < NT) { DMA_K(1, 1); DMA_V(1, 1); }
    asm volatile("s_waitcnt vmcnt(0)" ::: "memory"); __builtin_amdgcn_s_barrier(); asm volatile("" ::: "memory");
    int kb3 = 0;
    for (int j = 0; j < NT; ++j) {
        const int kb2 = kb3 == 0 ? 2 : kb3 - 1;
        if (j + 2 < NT) DMA_V(j + 2, kb2);
        asm volatile("" ::: "memory");
        if (j + 2 < NT) DMA_K(j + 2, kb2);
        asm volatile("" ::: "memory");
        if (j <= lim) {
        constexpr float C = SCALE * 1.4426950408889634f;
        f32x4 s[4][2];
#pragma unroll
        for (int kb = 0; kb < 4; ++kb) { s[kb][0] = (f32x4){0.f, 0.f, 0.f, 0.f}; s[kb][1] = (f32x4){0.f, 0.f, 0.f, 0.f}; }
        { const char* Ks = (const char*)ldsg + kb3 * KB;
#pragma unroll
          for (int ds = 0; ds < 4; ++ds) {
              bf16x8 kf[4];
#pragma unroll
              for (int kb = 0; kb < 4; ++kb) kf[kb] = *reinterpret_cast<const bf16x8*>(Ks + kb * 4096 + (ka0 ^ (ds << 6)));
#pragma unroll
              for (int kb = 0; kb < 4; ++kb) { s[kb][0] = __builtin_amdgcn_mfma_f32_16x16x32_bf16(kf[kb], qr[0][ds], s[kb][0], 0, 0, 0);
                                               s[kb][1] = __builtin_amdgcn_mfma_f32_16x16x32_bf16(kf[kb], qr[1][ds], s[kb][1], 0, 0, 0); } } }
        int jz = j; asm volatile("" : "+s"(jz));
        if (jz == 0) {
            asm volatile("; tile-0 mask" ::: "memory");
#pragma unroll
            for (int kb = 0; kb < 3; ++kb)
#pragma unroll
                for (int r = 0; r < 4; ++r) { s[kb][0][r] = -1e30f; s[kb][1][r] = -1e30f; }
        }
        float pm0 = s[0][0][0], pm1 = s[0][1][0];
#pragma unroll
        for (int kb = 0; kb < 4; ++kb)
#pragma unroll
            for (int r = 0; r < 4; ++r) { pm0 = fmaxf(pm0, s[kb][0][r]); pm1 = fmaxf(pm1, s[kb][1][r]); }
        pm0 = grp_max(pm0); pm1 = grp_max(pm1);
        float a0, a1;
        if (__builtin_expect(__all(fmaxf(pm0 - m0, pm1 - m1) <= THR / SCALE), 1)) { a0 = 1.f; a1 = 1.f; }
        else { const float n0 = fmaxf(m0, pm0), n1 = fmaxf(m1, pm1); a0 = __builtin_amdgcn_exp2f((m0 - n0) * C); a1 = __builtin_amdgcn_exp2f((m1 - n1) * C); m0 = n0; m1 = n1; }
        if (__any(a0 < 1.f || a1 < 1.f)) {
            if (g == 0) { al_l[c16] = a0; al_l[16 + c16] = a1; } asm volatile("s_waitcnt lgkmcnt(0)" ::: "memory");
            const f32x4 q0 = *(const LAS f32x4*)(al_l + 4 * g), q1 = *(const LAS f32x4*)(al_l + 16 + 4 * g);
            asm volatile("s_waitcnt lgkmcnt(0)" ::: "memory");
#pragma unroll
            for (int cb = 0; cb < 16; ++cb)
#pragma unroll
                for (int r = 0; r < 4; ++r) { o[0][cb][r] *= q0[r]; o[1][cb][r] *= q1[r]; }
        }
        const float mc0 = -m0 * C, mc1 = -m1 * C;
        float ps0 = 0.f, ps1 = 0.f;
#pragma unroll
        for (int kb = 0; kb < 4; ++kb)
#pragma unroll
            for (int r = 0; r < 4; ++r) { s[kb][0][r] = __builtin_amdgcn_exp2f(fmaf(s[kb][0][r], C, mc0)); s[kb][1][r] = __builtin_amdgcn_exp2f(fmaf(s[kb][1][r], C, mc1)); }
#pragma unroll
        for (int kb = 0; kb < 4; ++kb)
#pragma unroll
            for (int r = 0; r < 4; ++r) { ps0 += s[kb][0][r]; ps1 += s[kb][1][r]; }
        ps0 = grp_sum(ps0); ps1 = grp_sum(ps1);
        l0 = l0 * a0 + ps0; l1 = l1 * a1 + ps1;
        bf16x8 pa00, pa01, pa10, pa11;
#define PK6(QB, CH, OUT) do { u32x4 w_ = {cvt_pk_bf16(s[2 * CH][QB][0], s[2 * CH][QB][1]), cvt_pk_bf16(s[2 * CH][QB][2], s[2 * CH][QB][3]), \
                                          cvt_pk_bf16(s[2 * CH + 1][QB][0], s[2 * CH + 1][QB][1]), cvt_pk_bf16(s[2 * CH + 1][QB][2], s[2 * CH + 1][QB][3])}; OUT = *reinterpret_cast<bf16x8*>(&w_); } while (0)
        PK6(0, 0, pa00); PK6(0, 1, pa01); PK6(1, 0, pa10); PK6(1, 1, pa11);
#undef PK6
        SBAR();
        pv6_all(o, vb0 + kb3 * VB, pa00, pa01, pa10, pa11);
        }
        if (j + 2 < NT) asm volatile("s_waitcnt vmcnt(6)" ::: "memory"); else asm volatile("s_waitcnt vmcnt(0)" ::: "memory");
        __builtin_amdgcn_s_barrier(); asm volatile("" ::: "memory");
        kb3 = kb3 == 2 ? 0 : kb3 + 1;
    }
    if (g == 0) { li_l[c16] = l0; li_l[16 + c16] = l1; } asm volatile("s_waitcnt lgkmcnt(0)" ::: "memory");
    f32x4 r0 = *(const LAS f32x4*)(li_l + 4 * g), r1 = *(const LAS f32x4*)(li_l + 16 + 4 * g);
#pragma unroll
    for (int r = 0; r < 4; ++r) { r0[r] = __builtin_amdgcn_rcpf(r0[r]); r1[r] = __builtin_amdgcn_rcpf(r1[r]); }
    bf16_t* Ow = Ob + (long)(wid * QBLK + 4 * g) * LDO + c16;
#pragma unroll
    for (int r = 0; r < 4; ++r)
#pragma unroll
        for (int cb = 0; cb < 16; ++cb) { Ow[(long)r * LDO + cb * 16] = f2bf(o[0][cb][r] * r0[r]); Ow[(long)(16 + r) * LDO + cb * 16] = f2bf(o[1][cb][r] * r1[r]); }
    asm volatile("s_waitcnt vmcnt(0) lgkmcnt(0)" ::: "memory"); __builtin_amdgcn_s_barrier(); asm volatile("" ::: "memory");
#undef DMA_K
#undef DMA_V
}
}

#ifndef MK_ATT2
#define MK_ATT2 1
#endif
#ifndef MK_PROBE_QK2
#define MK_PROBE_QK2 0
#endif
#ifndef MK_PROBE_DMA2
#define MK_PROBE_DMA2 0
#endif
#ifndef MK_ATT_UNIT
#define MK_ATT_UNIT unit2
#endif
#ifndef MK_ATT_REV
#define MK_ATT_REV 0
#endif
#if MK_ATT2
__device__ __forceinline__ void attn_phase(const Fr& F) {
    const bf16_t* Q = slotY(F, 0); const bf16_t* K = slotY(F, 1); const bf16_t* V = slotY(F, 2);
    bf16_t* AO = slotU(F, 1);
    const int x = F.bid & 7, j = (F.bid >> 3) & 31;
#pragma unroll 1
    for (int k = 0; k < 4; ++k) {
        if (F.bid >= 256) break;
        const int sub = 4 * x + k, head = sub >> 1, c = sub & 1;
        const bf16_t* Kp = K + head * 256 + c * 128; const bf16_t* Vp = V + head * 256;
#pragma unroll 1
        for (int u = 0; u < 2; ++u) {
            const int t = u == 0 ? 63 - j : j;
            const int row0 = 256 * t + 128;
            att2::MK_ATT_UNIT(Q + (size_t)row0 * D + head * 256 + c * 128, Kp, Vp, AO + (size_t)row0 * 8192 + head * 512 + c * 256, 4 * t + 6, 4 * t + 2 + (F.wave >> 1), F.ldsg, F.lds, MK_ATT_REV ? u : 0);
        }
        if (j == 8 * k) att2::MK_ATT_UNIT(Q + head * 256 + c * 128, Kp, Vp, AO + head * 512 + c * 256, 4, F.wave >> 1, F.ldsg, F.lds);
    }
}
#else
__device__ __forceinline__ void attn_phase(const Fr& F) {
    const bf16_t* Q = slotY(F, 0); const bf16_t* K = slotY(F, 1); const bf16_t* V = slotY(F, 2);
    bf16_t* AO = slotU(F, 1);
    const int x = F.bid & 7, j = (F.bid >> 3) & 31;
#pragma unroll 1
    for (int k = 0; k < 8; ++k) {
        if (F.bid >= 256) break;
        const int sub = 8 * x + k, head = sub >> 2, c = (sub >> 1) & 1, half = sub & 1;
        const bf16_t* Kp = K + head * 256 + c * 128; const bf16_t* Vp = V + head * 256 + half * 128;
#pragma unroll 1
        for (int u = 0; u < 2; ++u) {
            const int t = u == 0 ? 63 - j : j;
            const int row0 = 256 * t + 128;
            att::unit(Q + (size_t)row0 * D + head * 256 + c * 128, Kp, Vp, AO + (size_t)row0 * 8192 + head * 512 + c * 256 + half * 128, 4 * t + 6, 4 * t + 2 + (F.wave >> 1), (char*)F.ldsg);
        }
        if (j == 4 * k) att::unit(Q + head * 256 + c * 128, Kp, Vp, AO + head * 512 + c * 256 + half * 128, 4, F.wave >> 1, (char*)F.ldsg);
    }
}
#endif
__device__ __forceinline__ void attn_post(const Fr& F) {
    const bf16_t* AO = slotU(F, 1); const bf16_t* GT = slotY(F, 3); bf16_t* Z = slotU(F, 0);
    const float* sg = F.in(13);
    constexpr float LINIT = 0.35550906759096934f;
    float lam;
    { const float* q1 = F.in(9); const float* k1 = F.in(10); const float* q2 = F.in(11); const float* k2 = F.in(12);
      const float d1 = wave_sum(q1[F.lane] * k1[F.lane] + q1[F.lane + 64] * k1[F.lane + 64]), d2 = wave_sum(q2[F.lane] * k2[F.lane] + q2[F.lane + 64] * k2[F.lane + 64]);
      lam = expf(d1) - expf(d2) + LINIT; }
    const f32x4 g4 = ((const f32x4*)sg)[F.lane];
    for (int r = F.gw; r < R; r += F.NGW) {
        const bool real = (r >= NPAD && r < NREAL);
        u32x2* zr = (u32x2*)(Z + (size_t)r * D) + F.lane;
        if (!real) { const u32x2 z = {0u, 0u};
#pragma unroll
            for (int hd = 0; hd < 16; ++hd) zr[64 * hd] = z;
            continue; }
        gp_ ao0 = (gp_)(AO + (size_t)r * 8192) + F.lane * 8 + 4096; gp_ ao1 = ao0 + 8192; asm volatile("" : "+v"(ao0), "+v"(ao1));
        ROW_BF(gq, GT + (size_t)r * D, F.lane); ROW_BF(zq, Z + (size_t)r * D, F.lane);
        u32x2 a0v[16], a1v[16], gtv[16];
#pragma unroll
        for (int hd = 0; hd < 16; ++hd) {
            a0v[hd] = *(GAS u32x2*)(hd < 8 ? ao0 + (2 * hd) * 512 - 4096 : ao1 + (2 * hd - 16) * 512 - 4096);
            a1v[hd] = *(GAS u32x2*)(hd < 8 ? ao0 + (2 * hd + 1) * 512 - 4096 : ao1 + (2 * hd - 15) * 512 - 4096);
            gtv[hd] = AT_BF(gq, hd);
        }
#pragma unroll
        for (int hd = 0; hd < 16; ++hd) {
            const u32x2 a0 = a0v[hd], a1 = a1v[hd], gt = gtv[hd];
            const float o0 = bflo(a0.x) - lam * bflo(a1.x), o1 = bfhi(a0.x) - lam * bfhi(a1.x), o2 = bflo(a0.y) - lam * bflo(a1.y), o3 = bfhi(a0.y) - lam * bfhi(a1.y);
            const float ss = wave_sum((o0 * o0 + o1 * o1) + (o2 * o2 + o3 * o3));
            const float rs = __builtin_amdgcn_rsqf(ss * (1.f / 256.f) + 1e-5f) * (1.f - LINIT);
            u32x2 w; w.x = cvt_pk_bf16(o0 * rs * g4.x * silu_f(bflo(gt.x)), o1 * rs * g4.y * silu_f(bfhi(gt.x))); w.y = cvt_pk_bf16(o2 * rs * g4.z * silu_f(bflo(gt.y)), o3 * rs * g4.w * silu_f(bfhi(gt.y)));
            AT_BF(zq, hd) = w;
        }
    }
}

constexpr int RW_TT = 32, RW_TOKF = 384, RW_TILEF = RW_TT * RW_TOKF, RW_NTILE = 513;
__device__ __forceinline__ void rwkv_scan_seq(const Fr& F) {
    const bf16_t* Rr = slotY(F, 0); const bf16_t* K = slotY(F, 1); const bf16_t* V = slotY(F, 2); const bf16_t* W = slotY(F, 4); const bf16_t* A = slotY(F, 5);
    float* O32 = (float*)slotU(F, 1);
    LAS float* ring = (LAS float*)F.lds; LAS float* otile = ring + 2 * RW_TILEF;
    const int tid = F.tid, lane = F.lane, wid = F.wave;
    for (int unit = F.bid; unit < 256; unit += F.G) {
        const int h = unit >> 2, rg = unit & 3;
        const int ptid = tid - 256, ptt = ptid >> 3, dg = ptid & 7;
        float kkc[8], kac[8];
        if (wid >= 4) {
#pragma unroll
            for (int i = 0; i < 8; ++i) { kkc[i] = F.in(23)[h * 64 + 8 * dg + i]; kac[i] = F.in(24)[h * 64 + 8 * dg + i]; }
        }
        float S0 = 0.f, S1 = 0.f, S2 = 0.f, S3 = 0.f;
        const int cg = lane & 15, irow = 4 * wid + (lane >> 4);
#define RW_PRODUCE(m, buf) do { const int row = NPAD + 32 * (m) + ptt; const size_t off = (size_t)row * D + h * 64 + 8 * dg; \
        const u32x4 r8 = *(const u32x4*)(Rr + off), k8 = *(const u32x4*)(K + off), v8 = *(const u32x4*)(V + off), w8 = *(const u32x4*)(W + off), a8 = *(const u32x4*)(A + off); \
        const unsigned rw[4] = {r8.x, r8.y, r8.z, r8.w}, kw[4] = {k8.x, k8.y, k8.z, k8.w}, vw[4] = {v8.x, v8.y, v8.z, v8.w}, ww[4] = {w8.x, w8.y, w8.z, w8.w}, aw[4] = {a8.x, a8.y, a8.z, a8.w}; \
        float rf[8], kf[8], vf[8], wf[8], af[8], kk[8]; float ssq = 0.f; \
        _Pragma("unroll") for (int i = 0; i < 4; ++i) { rf[2 * i] = bflo(rw[i]); rf[2 * i + 1] = bfhi(rw[i]); kf[2 * i] = bflo(kw[i]); kf[2 * i + 1] = bfhi(kw[i]); vf[2 * i] = bflo(vw[i]); vf[2 * i + 1] = bfhi(vw[i]); \
            wf[2 * i] = bflo(ww[i]); wf[2 * i + 1] = bfhi(ww[i]); af[2 * i] = bflo(aw[i]); af[2 * i + 1] = bfhi(aw[i]); } \
        _Pragma("unroll") for (int i = 0; i < 8; ++i) { kk[i] = kf[i] * kkc[i]; ssq += kk[i] * kk[i]; } \
        ssq = red8(ssq); const float inv = 1.f / fmaxf(sqrtf(ssq), 1e-12f); \
        LAS float* tb = ring + (buf) * RW_TILEF + ptt * RW_TOKF; \
        _Pragma("unroll") for (int q = 0; q < 2; ++q) { LAS f32x4* p = (LAS f32x4*)(tb + (2 * dg + q) * 20); \
            f32x4 t0, t1, t2, t3, t4; \
            _Pragma("unroll") for (int e = 0; e < 4; ++e) { const int i = 4 * q + e; const float kn = kk[i] * inv; t0[e] = wf[i]; t1[e] = -kn; t2[e] = kn * af[i]; t3[e] = kf[i] * (1.f + (af[i] - 1.f) * kac[i]); t4[e] = rf[i]; } \
            p[0] = t0; p[1] = t1; p[2] = t2; p[3] = t3; p[4] = t4; } \
        LAS f32x4* pv = (LAS f32x4*)(tb + 320 + 8 * dg); pv[0] = (f32x4){vf[0], vf[1], vf[2], vf[3]}; pv[1] = (f32x4){vf[4], vf[5], vf[6], vf[7]}; } while (0)
#define RW_FLUSH(m, buf) do { const int row = NPAD + 32 * (m) + ptt; if (row < NREAL) { const LAS float* ot = otile + (buf) * 512 + ptt * 16 + 2 * dg; \
        *(float2*)(O32 + (size_t)row * D + h * 64 + 16 * rg + 2 * dg) = make_float2(ot[0], ot[1]); } } while (0)
        if (wid >= 4) RW_PRODUCE(0, 0);
        __syncthreads();
        for (int n = 0; n < RW_NTILE; ++n) {
            if (wid < 4) {
                const LAS float* tb = ring + (n & 1) * RW_TILEF; LAS float* ot = otile + (n & 1) * 512;
#pragma unroll 4
                for (int tt = 0; tt < RW_TT; ++tt) {
                    const LAS float* p = tb + tt * RW_TOKF + cg * 20;
                    const f32x4 w4 = *(const LAS f32x4*)p, nk = *(const LAS f32x4*)(p + 4), ka = *(const LAS f32x4*)(p + 8), kp = *(const LAS f32x4*)(p + 12), r4 = *(const LAS f32x4*)(p + 16);
                    const float v = tb[tt * RW_TOKF + 320 + 16 * rg + irow];
                    float sa = (S0 * nk.x + S1 * nk.y) + (S2 * nk.z + S3 * nk.w);
                    sa = red16(sa);
                    S0 = S0 * w4.x + (sa * ka.x + v * kp.x); S1 = S1 * w4.y + (sa * ka.y + v * kp.y); S2 = S2 * w4.z + (sa * ka.z + v * kp.z); S3 = S3 * w4.w + (sa * ka.w + v * kp.w);
                    float o = (S0 * r4.x + S1 * r4.y) + (S2 * r4.z + S3 * r4.w);
                    o = red16(o);
                    if (cg == 0) ot[tt * 16 + irow] = o;
                }
            } else {
                if (n + 1 < RW_NTILE) RW_PRODUCE(n + 1, (n + 1) & 1);
                if (n > 0) RW_FLUSH(n - 1, (n - 1) & 1);
            }
            __syncthreads();
        }
        if (wid >= 4) RW_FLUSH(RW_NTILE - 1, (RW_NTILE - 1) & 1);
        __syncthreads();
#undef RW_PRODUCE
#undef RW_FLUSH
    }
}

#ifndef RC_SYNC
#define RC_SYNC 0
#endif
constexpr int RC_SLOT = 13312, RC_NSLOT = 8, RC_SCR0 = RC_NSLOT * RC_SLOT, RC_SCR = 5632, RC_FLAGS = RC_SCR0 + 7 * RC_SCR, RC_NCH = 1025;
constexpr int RC_AT = 0, RC_RT = 2176, RC_BTT = 4352, RC_KTT = 6912, RC_TT = 9472, RC_G3F = 9984, RC_VTF = 10496, RC_P1 = 11008, RC_P2 = 12032, RC_WC = 13056;
static_assert(RC_FLAGS + 64 <= 147456 - 256, "rwkv LDS map");
typedef short s16x4v __attribute__((ext_vector_type(4)));
__device__ __forceinline__ void lora2_phase(const Fr& F) {
    const bf16_t* T = (const bf16_t*)(F.ws + WS_T); const bf16_t* W2T = (const bf16_t*)(F.ws + WS_W2P);
    const int c16 = F.lane & 15, g = F.lane >> 4;
    struct BSet { bf16x8 f[2][4]; f32x4 b0, b1; };
#define L2_LOAD(S_, grp_) do { _Pragma("unroll") for (int b = 0; b < 2; ++b) _Pragma("unroll") for (int ks = 0; ks < 4; ++ks) S_.f[b][ks] = *reinterpret_cast<const bf16x8*>(wb + (size_t)((grp_) * 32 + 4 * b) * 128 + ks * 32); \
        S_.b0 = *(const GAS f32x4*)(bias + (grp_) * 32); S_.b1 = *(const GAS f32x4*)(bias + (grp_) * 32 + 4); } while (0)
#define L2_COMP(S_, grp_) do { f32x4 acc[2][4]; \
        _Pragma("unroll") for (int b = 0; b < 2; ++b) _Pragma("unroll") for (int rb = 0; rb < 4; ++rb) acc[b][rb] = (f32x4){0.f, 0.f, 0.f, 0.f}; \
        _Pragma("unroll") for (int ks = 0; ks < 4; ++ks) _Pragma("unroll") for (int b = 0; b < 2; ++b) _Pragma("unroll") for (int rb = 0; rb < 4; ++rb) \
            acc[b][rb] = __builtin_amdgcn_mfma_f32_16x16x32_bf16(S_.f[b][ks], af[rb][ks], acc[b][rb], 0, 0, 0); \
        _Pragma("unroll") for (int rb = 0; rb < 4; ++rb) { f32x4 v0 = acc[0][rb] + S_.b0, v1 = acc[1][rb] + S_.b1; \
            _Pragma("unroll") for (int jj = 0; jj < 4; ++jj) { float s0 = __builtin_amdgcn_rcpf(1.f + __expf(-v0[jj])), s1 = __builtin_amdgcn_rcpf(1.f + __expf(-v1[jj])); \
                if (!sel) { s0 = __expf(-0.606531f * s0); s1 = __expf(-0.606531f * s1); } L2_PROBE_MATH(v0[jj], v1[jj]); v0[jj] = s0; v1[jj] = s1; } \
            st_bf8(dst + (size_t)rb * 16 * D + (grp_) * 32, v0, v1); } } while (0)
#ifdef MK_L2MATH2
#define L2_PROBE_MATH(x0_, x1_) do { float t0_ = (x0_), t1_ = (x1_); asm volatile("" : "+v"(t0_), "+v"(t1_)); t0_ = __builtin_amdgcn_rcpf(1.f + __expf(-t0_)); t1_ = __builtin_amdgcn_rcpf(1.f + __expf(-t1_)); \
        if (!sel) { t0_ = __expf(-0.606531f * t0_); t1_ = __expf(-0.606531f * t1_); } asm volatile("" :: "v"(t0_), "v"(t1_)); } while (0)
#else
#define L2_PROBE_MATH(x0_, x1_) do { } while (0)
#endif
#define L2_WAIT(n_) do { SBAR(); asm volatile("s_waitcnt vmcnt(" #n_ ")" ::: "memory"); SBAR(); } while (0)
#pragma unroll 1
    for (int it = F.bid; it < (R / 64) * 8; it += F.G) {
        const int panel = it >> 3, sel = (it >> 2) & 1, q = it & 3;
        const int row0 = panel * 64, colw = q * 1024 + F.wave * 128;
        const GAS float* bias = (const GAS float*)(sel ? F.in(20) : F.in(17)) + colw + 8 * g;
        bf16_t* dst = slotY(F, sel ? 5 : 4) + (size_t)(row0 + c16) * D + colw + 8 * g;
        const bf16_t* ta = T + (size_t)(row0 + c16) * 256 + sel * 128 + 8 * g;
        const bf16_t* wb = W2T + (size_t)(sel * 4096 + colw + 8 * (c16 >> 2) + (c16 & 3)) * 128 + 8 * g;
        bf16x8 af[4][4]; BSet A, B;
#pragma unroll
        for (int rb = 0; rb < 4; ++rb)
#pragma unroll
            for (int ks = 0; ks < 4; ++ks) af[rb][ks] = *reinterpret_cast<const bf16x8*>(ta + (size_t)rb * 16 * 256 + ks * 32);
        L2_LOAD(A, 0); SBAR();
        L2_LOAD(B, 1); L2_WAIT(10); L2_COMP(A, 0); SBAR();
        L2_LOAD(A, 2); L2_WAIT(14); L2_COMP(B, 1); SBAR();
        L2_LOAD(B, 3); L2_WAIT(14); L2_COMP(A, 2); SBAR();
        L2_WAIT(4); L2_COMP(B, 3); SBAR();
    }
#undef L2_LOAD
#undef L2_COMP
#undef L2_WAIT
}
__device__ __forceinline__ void rwkv_kknorm(const Fr& F) {
    const bf16_t* K = slotY(F, 1); const float* k_k = F.in(23); float* INV = (float*)(F.ws + WS_HE);
    f32x4 c4v[16];
    { ROW_F32(cq, k_k, F.lane);
#pragma unroll
      for (int it = 0; it < 16; ++it) c4v[it] = AT_F32(cq, it); }
    for (int r = F.gw; r < R; r += F.NGW) {
        ROW_BF(kq_, K + (size_t)r * D, F.lane);
        u32x2 kv[16];
#pragma unroll
        for (int it = 0; it < 16; ++it) kv[it] = AT_BF(kq_, it);
#pragma unroll
        for (int it = 0; it < 16; ++it) {
            const u32x2 kk = kv[it]; const f32x4 c4 = c4v[it];
            const float a = bflo(kk.x) * c4.x, b = bfhi(kk.x) * c4.y, c = bflo(kk.y) * c4.z, d = bfhi(kk.y) * c4.w;
            const float ss = red16((a * a + b * b) + (c * c + d * d));
            if ((F.lane & 15) == 0) INV[(size_t)r * 64 + it * 4 + (F.lane >> 4)] = 1.f / fmaxf(sqrtf(ss), 1e-12f);
        }
    }
}
__device__ __forceinline__ unsigned lds_poll(volatile LAS unsigned* p) { return *p; }
__device__ __forceinline__ void rwkv_scan(const Fr& F) {
    const bf16_t* Rr = slotY(F, 0); const bf16_t* K = slotY(F, 1); const bf16_t* V = slotY(F, 2); const bf16_t* W = slotY(F, 4); const bf16_t* A = slotY(F, 5);
    const float* INV = (const float*)(F.ws + WS_HE);
    float* O32 = (float*)slotU(F, 1);
    LAS unsigned char* L = F.lds;
    volatile LAS unsigned* flags = (volatile LAS unsigned*)(L + RC_FLAGS);
    const int lane = F.lane, wid = F.wave, l15 = lane & 15, kg = lane >> 4;
    for (int unit = F.bid; unit < 256; unit += F.G) {
        const int h = unit >> 2, rgw = unit & 3;
        if (F.tid < 16) flags[F.tid] = 0u;
        __syncthreads();
        if (wid == 0) {
            __builtin_amdgcn_s_setprio(3);
            f32x4 S0 = {0.f, 0.f, 0.f, 0.f}, S1 = S0, S2 = S0, S3 = S0;
            struct SlotRegs { u32x2 a0l, a0h, a1l, a1h, r0l, r0h, r1l, r1h; f32x4 P1, P2; s16x4v ttf, g3f, vtf, b0, b1, b2, b3, k0, k1, k2, k3; f32x4 w0, w1, w2, w3; };
#if RC_SYNC
#define CH_WAIT(n_) do { if ((n_) % 7 == 0) { __builtin_amdgcn_s_barrier(); __builtin_amdgcn_s_barrier(); } } while (0)
#else
#define CH_WAIT(n_) do { unsigned sp = 0; while (lds_poll(flags + ((n_) & 7)) != (unsigned)((n_) + 1)) { __builtin_amdgcn_s_sleep(1); if (++sp > (1u << 22)) break; } } while (0)
#endif
#define CH_LOAD(R_, n_) do { CH_WAIT(n_); asm volatile("s_waitcnt lgkmcnt(0)" ::: "memory"); const LAS unsigned char* SL = L + ((n_) & 7) * RC_SLOT; \
                const LAS unsigned char* ap = SL + RC_AT + l15 * 136 + kg * 8; const LAS unsigned char* rp = SL + RC_RT + l15 * 136 + kg * 8; \
                R_.a0l = *(const LAS u32x2*)(ap); R_.a0h = *(const LAS u32x2*)(ap + 32); R_.a1l = *(const LAS u32x2*)(ap + 64); R_.a1h = *(const LAS u32x2*)(ap + 96); \
                R_.r0l = *(const LAS u32x2*)(rp); R_.r0h = *(const LAS u32x2*)(rp + 32); R_.r1l = *(const LAS u32x2*)(rp + 64); R_.r1h = *(const LAS u32x2*)(rp + 96); \
                R_.P1 = *(const LAS f32x4*)(SL + RC_P1 + lane * 16); R_.P2 = *(const LAS f32x4*)(SL + RC_P2 + lane * 16); \
                R_.ttf = *(const LAS s16x4v*)(SL + RC_TT + lane * 8); R_.g3f = *(const LAS s16x4v*)(SL + RC_G3F + lane * 8); R_.vtf = *(const LAS s16x4v*)(SL + RC_VTF + lane * 8); \
                const LAS unsigned char* bp = SL + RC_BTT + l15 * 40 + kg * 8; const LAS unsigned char* kp = SL + RC_KTT + l15 * 40 + kg * 8; \
                R_.b0 = *(const LAS s16x4v*)(bp); R_.b1 = *(const LAS s16x4v*)(bp + 640); R_.b2 = *(const LAS s16x4v*)(bp + 1280); R_.b3 = *(const LAS s16x4v*)(bp + 1920); \
                R_.k0 = *(const LAS s16x4v*)(kp); R_.k1 = *(const LAS s16x4v*)(kp + 640); R_.k2 = *(const LAS s16x4v*)(kp + 1280); R_.k3 = *(const LAS s16x4v*)(kp + 1920); \
                const LAS f32x4* wc = (const LAS f32x4*)(SL + RC_WC + kg * 16); R_.w0 = wc[0]; R_.w1 = wc[4]; R_.w2 = wc[8]; R_.w3 = wc[12]; \
                asm volatile("s_waitcnt lgkmcnt(0)" ::: "memory"); \
                if (lane == 0) flags[8] = (unsigned)((n_) + 1); } while (0)
#define CH_COMPUTE(R_, n_, NEXT_) do { \
                u32x4 sb0, sb1; sb0.x = cvt_pk_bf16(S0.x, S0.y); sb0.y = cvt_pk_bf16(S0.z, S0.w); sb0.z = cvt_pk_bf16(S1.x, S1.y); sb0.w = cvt_pk_bf16(S1.z, S1.w); \
                sb1.x = cvt_pk_bf16(S2.x, S2.y); sb1.y = cvt_pk_bf16(S2.z, S2.w); sb1.z = cvt_pk_bf16(S3.x, S3.y); sb1.w = cvt_pk_bf16(S3.z, S3.w); \
                const bf16x8 Sb0 = *reinterpret_cast<bf16x8*>(&sb0), Sb1 = *reinterpret_cast<bf16x8*>(&sb1); \
                u32x4 t4; \
                t4 = (u32x4){R_.a0l.x, R_.a0l.y, R_.a0h.x, R_.a0h.y}; const bf16x8 Aq0 = *reinterpret_cast<bf16x8*>(&t4); \
                t4 = (u32x4){R_.a1l.x, R_.a1l.y, R_.a1h.x, R_.a1h.y}; const bf16x8 Aq1 = *reinterpret_cast<bf16x8*>(&t4); \
                t4 = (u32x4){R_.r0l.x, R_.r0l.y, R_.r0h.x, R_.r0h.y}; const bf16x8 Rq0 = *reinterpret_cast<bf16x8*>(&t4); \
                t4 = (u32x4){R_.r1l.x, R_.r1l.y, R_.r1h.x, R_.r1h.y}; const bf16x8 Rq1 = *reinterpret_cast<bf16x8*>(&t4); \
                f32x4 X = R_.P1, O = R_.P2; \
                X = __builtin_amdgcn_mfma_f32_16x16x32_bf16(Aq0, Sb0, X, 0, 0, 0); \
                X = __builtin_amdgcn_mfma_f32_16x16x32_bf16(Aq1, Sb1, X, 0, 0, 0);                   \
                O = __builtin_amdgcn_mfma_f32_16x16x32_bf16(Rq0, Sb0, O, 0, 0, 0); \
                O = __builtin_amdgcn_mfma_f32_16x16x32_bf16(Rq1, Sb1, O, 0, 0, 0);                   \
                u32x2 yb; yb.x = cvt_pk_bf16(X.x, X.y); yb.y = cvt_pk_bf16(X.z, X.w); \
                f32x4 U = {0.f, 0.f, 0.f, 0.f}; \
                U = __builtin_amdgcn_mfma_f32_16x16x16bf16_1k(R_.ttf, *reinterpret_cast<s16x4v*>(&yb), U, 0, 0, 0);     \
                u32x2 ub; ub.x = cvt_pk_bf16(U.x, U.y); ub.y = cvt_pk_bf16(U.z, U.w); \
                const s16x4v Ub = *reinterpret_cast<s16x4v*>(&ub); \
                S0 = __builtin_amdgcn_mfma_f32_16x16x16bf16_1k(R_.k0, R_.vtf, S0, 0, 0, 0); S1 = __builtin_amdgcn_mfma_f32_16x16x16bf16_1k(R_.k1, R_.vtf, S1, 0, 0, 0); \
                S2 = __builtin_amdgcn_mfma_f32_16x16x16bf16_1k(R_.k2, R_.vtf, S2, 0, 0, 0); S3 = __builtin_amdgcn_mfma_f32_16x16x16bf16_1k(R_.k3, R_.vtf, S3, 0, 0, 0); \
                S0 = __builtin_amdgcn_mfma_f32_16x16x16bf16_1k(R_.b0, Ub, S0, 0, 0, 0); S1 = __builtin_amdgcn_mfma_f32_16x16x16bf16_1k(R_.b1, Ub, S1, 0, 0, 0); \
                S2 = __builtin_amdgcn_mfma_f32_16x16x16bf16_1k(R_.b2, Ub, S2, 0, 0, 0); S3 = __builtin_amdgcn_mfma_f32_16x16x16bf16_1k(R_.b3, Ub, S3, 0, 0, 0); \
                O = __builtin_amdgcn_mfma_f32_16x16x16bf16_1k(R_.g3f, Ub, O, 0, 0, 0);                   \
                NEXT_; \
                S0 = S0 * R_.w0; S1 = S1 * R_.w1; S2 = S2 * R_.w2; S3 = S3 * R_.w3; \
                float* op = O32 + (size_t)(NPAD + 16 * (n_) + 4 * kg) * D + h * 64 + 16 * rgw + l15;     \
                op[0] = O.x; op[D] = O.y; op[2 * D] = O.z; op[3 * D] = O.w; } while (0)
            SlotRegs RA, RB;
            CH_LOAD(RA, 0);
            for (int n = 0; n + 1 < RC_NCH; n += 2) {
#ifdef MK_RC_CHAIN_SLEEP
                __builtin_amdgcn_s_sleep(MK_RC_CHAIN_SLEEP);
#endif
                CH_COMPUTE(RA, n, CH_LOAD(RB, n + 1));
                if (n + 2 < RC_NCH) { CH_COMPUTE(RB, n + 1, CH_LOAD(RA, n + 2)); } else { CH_COMPUTE(RB, n + 1, (void)0); }
            }
            if (RC_NCH & 1) { CH_COMPUTE(RA, RC_NCH - 1, (void)0); }
            __builtin_amdgcn_s_setprio(0);
#undef CH_WAIT
#undef CH_LOAD
#undef CH_COMPUTE
        } else {
            const int p = wid - 1;
            LAS unsigned char* SC = L + RC_SCR0 + p * RC_SCR;
            const float kkc = F.in(23)[h * 64 + lane], kac = F.in(24)[h * 64 + lane];
            unsigned short cr[16], ck[16], cw[16], ca[16], nvq[4]; float civ[16];
#define RC_LOADS(nn) do { const int r0n = NPAD + 16 * (nn); \
                _Pragma("unroll") for (int e = 0; e < 4; ++e) nvq[e] = V[(size_t)(r0n + 4 * kg + e) * D + h * 64 + 16 * rgw + l15]; \
                _Pragma("unroll") for (int s = 0; s < 16; ++s) { const size_t off = (size_t)(r0n + s) * D + h * 64 + lane; cr[s] = Rr[off]; ck[s] = K[off]; cw[s] = W[off]; ca[s] = A[off]; civ[s] = INV[(size_t)(r0n + s) * 64 + h]; } } while (0)
            RC_LOADS(p);
            for (int n = p; n < RC_NCH; n += 7) {
#ifdef MK_RC_PREP_SLEEP
                __builtin_amdgcn_s_sleep(MK_RC_PREP_SLEEP);
#endif
                const int slot = n & 7; LAS unsigned char* SL = L + slot * RC_SLOT;
                unsigned short vq[4];
#pragma unroll
                for (int e = 0; e < 4; ++e) vq[e] = nvq[e];
#if RC_SYNC
                asm volatile("s_waitcnt lgkmcnt(0)" ::: "memory"); __builtin_amdgcn_s_barrier();
#else
                if (n >= 8) { unsigned sp = 0; while (lds_poll(flags + 8) < (unsigned)(n - 7)) { __builtin_amdgcn_s_sleep(2); if (++sp > (1u << 22)) break; } }
#endif
                asm volatile("" ::: "memory");
                float Wp = 1.f; unsigned btp[8], ktp[8];
#pragma unroll
                for (int hb = 0; hb < 2; ++hb) {
                    unsigned short rq[8], kq[8], wq[8], aq[8]; float iv[8];
#pragma unroll
                    for (int s = 0; s < 8; ++s) { rq[s] = cr[8 * hb + s]; kq[s] = ck[8 * hb + s]; wq[s] = cw[8 * hb + s]; aq[s] = ca[8 * hb + s]; iv[s] = civ[8 * hb + s]; }
                    float btv[8], ktv[8];
#pragma unroll
                    for (int s = 0; s < 8; ++s) {
                        const int t = 8 * hb + s;
                        const float rs = bf2f(rq[s]), ks = bf2f(kq[s]), wsv = bf2f(wq[s]), as = bf2f(aq[s]);
                        const float kk = ks * kkc * iv[s];
                        const float Wprev = Wp; Wp *= wsv; const float iW = __builtin_amdgcn_rcpf(Wp);
                        const float at = -kk * Wprev, rt = rs * Wp, bt = kk * as * iW, kt = ks * (1.f + (as - 1.f) * kac) * iW;
                        *(LAS bf16_t*)(SL + RC_AT + t * 136 + lane * 2) = f2bf(at); *(LAS bf16_t*)(SL + RC_RT + t * 136 + lane * 2) = f2bf(rt);
                        *(LAS bf16_t*)(SC + t * 136 + lane * 2) = f2bf(bt); *(LAS bf16_t*)(SC + 2176 + t * 136 + lane * 2) = f2bf(kt);
                        btv[s] = bt; ktv[s] = kt;
                    }
#pragma unroll
                    for (int s = 0; s < 4; ++s) { btp[4 * hb + s] = cvt_pk_bf16(btv[2 * s], btv[2 * s + 1]); ktp[4 * hb + s] = cvt_pk_bf16(ktv[2 * s], ktv[2 * s + 1]); }
                }
                {
                    LAS u32x2* bq = (LAS u32x2*)(SL + RC_BTT + lane * 40); LAS u32x2* kq2 = (LAS u32x2*)(SL + RC_KTT + lane * 40);
#pragma unroll
                    for (int q = 0; q < 4; ++q) { bq[q] = (u32x2){btp[2 * q], btp[2 * q + 1]}; kq2[q] = (u32x2){ktp[2 * q], ktp[2 * q + 1]}; }
                    *(LAS float*)(SL + RC_WC + lane * 4) = Wp;
                    u32x2 vt; vt.x = (unsigned)vq[0] | ((unsigned)vq[1] << 16); vt.y = (unsigned)vq[2] | ((unsigned)vq[3] << 16);
                    *(LAS u32x2*)(SL + RC_VTF + lane * 8) = vt;
                }
                if (n + 7 < RC_NCH) RC_LOADS(n + 7);
                asm volatile("s_waitcnt lgkmcnt(0)" ::: "memory");
                f32x4 G1 = {0.f, 0.f, 0.f, 0.f}, G2 = G1, G3 = G1, G4 = G1, G1t = G1;
#pragma unroll
                for (int ks = 0; ks < 2; ++ks) {
                    const bf16x8 fb = *(const LAS bf16x8*)(SC + l15 * 136 + (32 * ks + 8 * kg) * 2), fk = *(const LAS bf16x8*)(SC + 2176 + l15 * 136 + (32 * ks + 8 * kg) * 2);
                    const bf16x8 fa = *(const LAS bf16x8*)(SL + RC_AT + l15 * 136 + (32 * ks + 8 * kg) * 2), fr_ = *(const LAS bf16x8*)(SL + RC_RT + l15 * 136 + (32 * ks + 8 * kg) * 2);
                    G1 = __builtin_amdgcn_mfma_f32_16x16x32_bf16(fb, fa, G1, 0, 0, 0); G2 = __builtin_amdgcn_mfma_f32_16x16x32_bf16(fk, fa, G2, 0, 0, 0);
                    G1t = __builtin_amdgcn_mfma_f32_16x16x32_bf16(fa, fb, G1t, 0, 0, 0);
                    G3 = __builtin_amdgcn_mfma_f32_16x16x32_bf16(fb, fr_, G3, 0, 0, 0); G4 = __builtin_amdgcn_mfma_f32_16x16x32_bf16(fk, fr_, G4, 0, 0, 0);
                }
                {
#pragma unroll
                    for (int e = 0; e < 4; ++e) { const int s = 4 * kg + e; const bool lt = s < l15, le = s <= l15;
                        G1[e] = lt ? G1[e] : 0.f; G1t[e] = (l15 < s) ? G1t[e] : 0.f; G2[e] = lt ? G2[e] : 0.f; G3[e] = le ? G3[e] : 0.f; G4[e] = le ? G4[e] : 0.f; }
                    u32x2 g2, g3, g4; g2.x = cvt_pk_bf16(G2.x, G2.y); g2.y = cvt_pk_bf16(G2.z, G2.w); g3.x = cvt_pk_bf16(G3.x, G3.y); g3.y = cvt_pk_bf16(G3.z, G3.w); g4.x = cvt_pk_bf16(G4.x, G4.y); g4.y = cvt_pk_bf16(G4.z, G4.w);
                    *(LAS u32x2*)(SL + RC_G3F + lane * 8) = g3;
                    u32x2 vt; vt.x = (unsigned)vq[0] | ((unsigned)vq[1] << 16); vt.y = (unsigned)vq[2] | ((unsigned)vq[3] << 16);
                    const s16x4v vtf = *reinterpret_cast<s16x4v*>(&vt);
                    f32x4 P1 = {0.f, 0.f, 0.f, 0.f}, P2 = P1;
                    P1 = __builtin_amdgcn_mfma_f32_16x16x16bf16_1k(*reinterpret_cast<s16x4v*>(&g2), vtf, P1, 0, 0, 0);
                    P2 = __builtin_amdgcn_mfma_f32_16x16x16bf16_1k(*reinterpret_cast<s16x4v*>(&g4), vtf, P2, 0, 0, 0);
                    *(LAS f32x4*)(SL + RC_P1 + lane * 16) = P1; *(LAS f32x4*)(SL + RC_P2 + lane * 16) = P2;
#define RC_BF(v) ({ u32x2 t_; t_.x = cvt_pk_bf16((v).x, (v).y); t_.y = cvt_pk_bf16((v).z, (v).w); *reinterpret_cast<s16x4v*>(&t_); })
                    const f32x4 Z4 = {0.f, 0.f, 0.f, 0.f};
                    const s16x4v n1 = RC_BF(G1), n1t = RC_BF(G1t);
                    const f32x4 X2 = __builtin_amdgcn_mfma_f32_16x16x16bf16_1k(n1t, n1, Z4, 0, 0, 0), X2t = __builtin_amdgcn_mfma_f32_16x16x16bf16_1k(n1, n1t, Z4, 0, 0, 0);
                    const s16x4v n2 = RC_BF(X2), n2t = RC_BF(X2t);
                    const f32x4 X4 = __builtin_amdgcn_mfma_f32_16x16x16bf16_1k(n2t, n2, Z4, 0, 0, 0), X4t = __builtin_amdgcn_mfma_f32_16x16x16bf16_1k(n2, n2t, Z4, 0, 0, 0);
                    const s16x4v n4 = RC_BF(X4), n4t = RC_BF(X4t);
                    f32x4 Tm = __builtin_amdgcn_mfma_f32_16x16x16bf16_1k(n4t, n4, Z4, 0, 0, 0);
#pragma unroll
                    for (int e = 0; e < 4; ++e) Tm[e] += (4 * kg + e == l15) ? 1.f : 0.f;
                    Tm = __builtin_amdgcn_mfma_f32_16x16x16bf16_1k(n4t, RC_BF(Tm), Tm, 0, 0, 0);
                    Tm = __builtin_amdgcn_mfma_f32_16x16x16bf16_1k(n2t, RC_BF(Tm), Tm, 0, 0, 0);
                    Tm = __builtin_amdgcn_mfma_f32_16x16x16bf16_1k(n1t, RC_BF(Tm), Tm, 0, 0, 0);
                    { u32x2 tt; tt.x = cvt_pk_bf16(Tm.x, Tm.y); tt.y = cvt_pk_bf16(Tm.z, Tm.w); *(LAS u32x2*)(SL + RC_TT + lane * 8) = tt; }
#undef RC_BF
                }
                asm volatile("s_waitcnt lgkmcnt(0)" ::: "memory");
#if RC_SYNC
                __builtin_amdgcn_s_barrier();
#else
                if (lane == 0) flags[slot] = (unsigned)(n + 1);
#endif
            }
#if RC_SYNC
            if (p >= RC_NCH % 7) { __builtin_amdgcn_s_barrier(); __builtin_amdgcn_s_barrier(); }
#endif
        }
#undef RC_LOADS
        __syncthreads();
    }
}
__device__ __forceinline__ void rwkv_post(const Fr& F) {
    const bf16_t* Rr = slotY(F, 0); const bf16_t* K = slotY(F, 1); const bf16_t* V = slotY(F, 2); const bf16_t* GT = slotY(F, 3); const bf16_t* A = slotY(F, 5);
    const float* O32 = (const float*)slotU(F, 1); bf16_t* Z = slotU(F, 0);
    const float* k_a = F.in(24); const float* r_k = F.in(25); const float* lw = F.in(26); const float* lb = F.in(27);
    for (int r = F.gw; r < R; r += F.NGW) {
        const bool real = (r >= NPAD && r < NREAL);
        u32x2* zr = (u32x2*)(Z + (size_t)r * D) + F.lane;
        if (!real) { const u32x2 z = {0u, 0u};
#pragma unroll
            for (int it = 0; it < 16; ++it) zr[64 * it] = z;
            continue; }
        ROW_F32(oq, O32 + (size_t)r * D, F.lane); ROW_BF(rq_, Rr + (size_t)r * D, F.lane); ROW_BF(kq_, K + (size_t)r * D, F.lane); ROW_BF(vq_, V + (size_t)r * D, F.lane);
        ROW_BF(gq_, GT + (size_t)r * D, F.lane); ROW_BF(aq_, A + (size_t)r * D, F.lane); ROW_BF(zq_, Z + (size_t)r * D, F.lane);
        ROW_F32(kap, k_a, F.lane); ROW_F32(rkp, r_k, F.lane); ROW_F32(lwp, lw, F.lane); ROW_F32(lbp, lb, F.lane);
#pragma unroll
        for (int hh = 0; hh < 2; ++hh) {
            f32x4 o4v[8]; u32x2 rrv[8], kkv[8], vvv[8], ggv[8], aav[8];
#pragma unroll
            for (int i8 = 0; i8 < 8; ++i8) { const int it = 8 * hh + i8; o4v[i8] = AT_F32(oq, it); rrv[i8] = AT_BF(rq_, it); kkv[i8] = AT_BF(kq_, it); vvv[i8] = AT_BF(vq_, it); ggv[i8] = AT_BF(gq_, it); aav[i8] = AT_BF(aq_, it); }
#pragma unroll
            for (int i8 = 0; i8 < 8; ++i8) { const int it = 8 * hh + i8;
                const f32x4 o4 = o4v[i8]; const u32x2 rr = rrv[i8], kk = kkv[i8], vv = vvv[i8], gg = ggv[i8], aa = aav[i8];
                const f32x4 ka4 = AT_F32(kap, it), rk4 = AT_F32(rkp, it), lw4 = AT_F32(lwp, it), lb4 = AT_F32(lbp, it);
                const float mean = red16((o4.x + o4.y) + (o4.z + o4.w)) * (1.f / 64.f);
                const float d0 = o4.x - mean, d1 = o4.y - mean, d2 = o4.z - mean, d3 = o4.w - mean;
                const float var = red16((d0 * d0 + d1 * d1) + (d2 * d2 + d3 * d3)) * (1.f / 64.f);
                const float rs = __builtin_amdgcn_rsqf(var + 64e-5f);
                const float r0 = bflo(rr.x), r1 = bfhi(rr.x), r2 = bflo(rr.y), r3 = bfhi(rr.y);
                const float kp0 = bflo(kk.x) * (1.f + (bflo(aa.x) - 1.f) * ka4.x), kp1 = bfhi(kk.x) * (1.f + (bfhi(aa.x) - 1.f) * ka4.y), kp2 = bflo(kk.y) * (1.f + (bflo(aa.y) - 1.f) * ka4.z), kp3 = bfhi(kk.y) * (1.f + (bfhi(aa.y) - 1.f) * ka4.w);
                const float bs = red16((r0 * kp0 * rk4.x + r1 * kp1 * rk4.y) + (r2 * kp2 * rk4.z + r3 * kp3 * rk4.w));
                const float y0 = d0 * rs * lw4.x + lb4.x + bs * bflo(vv.x), y1 = d1 * rs * lw4.y + lb4.y + bs * bfhi(vv.x), y2 = d2 * rs * lw4.z + lb4.z + bs * bflo(vv.y), y3 = d3 * rs * lw4.w + lb4.w + bs * bfhi(vv.y);
                u32x2 w; w.x = cvt_pk_bf16(y0 * silu_f(bflo(gg.x)), y1 * silu_f(bfhi(gg.x))); w.y = cvt_pk_bf16(y2 * silu_f(bflo(gg.y)), y3 * silu_f(bfhi(gg.y)));
                AT_BF(zq_, it) = w;
            }
        }
    }
}
}
namespace mk {
constexpr int LDS_BYTES = 163840;
constexpr int LDS_MISC = LDS_BYTES - 128;
struct Args { const float* in[29]; float* out; unsigned char* ws; };

#define MK_GEMM(EPI, e, Aptr, aps_, Bptr, M_, N_, K_) do { int kk_ = (K_); asm volatile("" : "+s"(kk_));     \
    pg8::Gemm g_{(const bf16_t*)(Aptr), (const bf16_t*)(Bptr), (M_), (N_), kk_, (size_t)(aps_)}; pg8::StaticOrder S_; S_.init((M_), (N_), F.G, F.bid); \
    pg8::gemm_phase<EPI, pg8::StaticOrder, false>(F.lds, g_, S_, e, nullptr); } while (0)

struct TailOrder { int pn;
    __device__ bool next(int i, pg8::Unit& u) const { if (i > 0 || pn < 0) return false; u.pm = 64; u.pn = pn; return true; }
    __device__ __forceinline__ void a_ready(const pg8::Unit&) const {}
    __device__ __forceinline__ void done(const pg8::Unit&) const {}
};
struct RwTail { int pm, pn;
    __device__ bool next(int i, pg8::Unit& u) const { if (i > 0) return false; u.pm = pm; u.pn = pn; return true; }
    __device__ __forceinline__ void a_ready(const pg8::Unit&) const {}
    __device__ __forceinline__ void done(const pg8::Unit&) const {}
};
#define MK_GEMM1(EPI, e, aps_, NTOT_, L_) do { MK_GEMM(EPI, e, slotU(F, 0), aps_, wtin_of(F, L_), 16384, NTOT_, D); \
    if (F.bid < (NTOT_) / 256) { int kk_ = D; asm volatile("" : "+s"(kk_)); pg8::Gemm g_{(const bf16_t*)slotU(F, 0), (const bf16_t*)wtin_of(F, L_), R, (NTOT_), kk_, (size_t)(aps_)}; TailOrder St_{F.bid}; \
        pg8::gemm_phase<EPI, TailOrder, false, true>(F.lds, g_, St_, e, nullptr); } } while (0)
#define MK_GEMM2_NORM(prev, next, udst) do { \
    MK_GEMM(EpiY, ey, slotU(F, 0), 0, wtout, 16384, D, D); \
    GRID_BAR(); \
    if (F.bid < 16) { int kk_ = D; asm volatile("" : "+s"(kk_)); pg8::Gemm g_{(const bf16_t*)slotU(F, 0), (const bf16_t*)wtout, R, D, kk_, (size_t)0}; TailOrder St_{F.bid}; \
        pg8::gemm_phase<EpiY, TailOrder, false, true>(F.lds, g_, St_, ey, nullptr); } \
    else { const Fr P = F.fresh(); norm_phase(P, prev, next, slotY(P, 0), udst, 0, 16384, 16); } \
    GRID_BAR(); \
    { const Fr P = F.fresh(); norm_phase(P, prev, next, slotY(P, 0), udst, 16384, R, 0); if ((next) >= 0) convert_layer(P, next, (next) == 3); } \
    GRID_BAR(); } while (0)

__global__ void __launch_bounds__(512, 2) fwd(Args a) {
    extern __shared__ __attribute__((aligned(16))) unsigned char lds_raw[];
    Fr F;
    F.lds = (LAS unsigned char*)lds_raw; F.ldsg = lds_raw;
    F.tid = threadIdx.x; F.lane = F.tid & 63; F.wave = __builtin_amdgcn_readfirstlane(F.tid >> 6);
    F.G = gridDim.x; F.bid = blockIdx.x; F.gw = F.bid * 8 + F.wave; F.NGW = F.G * 8;
    F.out = a.out; F.ws = a.ws;
    volatile LAS unsigned* misc = (volatile LAS unsigned*)(F.lds + LDS_MISC);
    if (F.tid < 16) misc[F.tid] = 0u;
    __syncthreads();
    XcdBarrier bar = xcd_barrier_post((unsigned*)(F.ws + WS_CTL) + 4096, misc + 8);
#ifdef MK_BAR2
#define GRID_BAR() do { xcd_barrier(bar); xcd_barrier(bar); } while (0)
#else
#define GRID_BAR() xcd_barrier(bar)
#endif
#ifndef MK_DUP
#define MK_DUP 0
#endif
#ifndef MK_CLK
#define MK_CLK 0
#endif
#define CLK_SPIN() do { const unsigned long long dc_ = clock64() - clk_c0, dr_ = wall_clock64() - clk_r0; const long mhz_ = (long)(dc_ * 100ull / (dr_ ? dr_ : 1ull)); \
        const long ticks_ = (2400 - mhz_) * 200; const unsigned long long r1_ = wall_clock64(); while ((long)(wall_clock64() - r1_) < ticks_) __builtin_amdgcn_s_sleep(8); } while (0)
#ifndef MK_PH
#define MK_PH 0
#endif
    unsigned long long ph_r0_ = 0ull;
#define PH_BEGIN(id) do { if ((MK_PH >> (id)) & 1) ph_r0_ = wall_clock64(); } while (0)
#define PH_END(id) do { if ((MK_PH >> (id)) & 1) { const unsigned long long dr_ = wall_clock64() - ph_r0_, r1_ = wall_clock64(); while ((unsigned long long)(wall_clock64() - r1_) < dr_) __builtin_amdgcn_s_sleep(8); } } while (0)
#define DUPN(k, ...) do { __VA_ARGS__; if ((MK_DUP >> (k)) & 1) { GRID_BAR(); __VA_ARGS__; } } while (0)
    bf16_t* wtout = (bf16_t*)(F.ws + WS_WTOUT);
    const EpiY ey{slotY(F, 0)};

    PH_BEGIN(1);
    DUPN(11, { const Fr P = F.fresh(); convert_layer(P, 0, true); rope_table(P); norm_phase(P, -1, 0, nullptr, slotU(P, 0)); });
    PH_END(1);
    GRID_BAR();
#if MK_CLK == 1 || MK_CLK == 11
    const unsigned long long clk_c0 = clock64(), clk_r0 = wall_clock64();
#endif
    PH_BEGIN(15);
    { const EpiH1 e{slotY(F, 0), F.in(5), 0}; MK_GEMM1(EpiH1, e, 0, 4 * D, 0); }
#if MK_CLK == 1
    CLK_SPIN();
#endif
#if MK_CLK == 11
    { const unsigned long long dr_ = wall_clock64() - clk_r0, r1_ = wall_clock64(); while ((unsigned long long)(wall_clock64() - r1_) < dr_) __builtin_amdgcn_s_sleep(8); }
#endif
#if defined(MK_KPROBE) && !defined(MK_KPROBE_L1)
    { __syncthreads(); const unsigned kc_ = misc[20]; const unsigned long long r1_ = wall_clock64(); while ((unsigned long long)(wall_clock64() - r1_) < (unsigned long long)kc_) __builtin_amdgcn_s_sleep(8); }
#endif
    if (F.bid >= 64) { const Fr P = F.fresh(); convert_win(P, 1, 64); }
    PH_END(15);
    GRID_BAR();
    PH_BEGIN(13);
    DUPN(1, { const Fr P = F.fresh(); hgrn_phase<false>(P, 0); });
    PH_END(13);
    GRID_BAR();
    PH_BEGIN(14);
    DUPN(2, { const Fr P = F.fresh(); hgrn_phase<true>(P, 0); });
    PH_END(14);
    GRID_BAR();
    PH_BEGIN(2);
    MK_GEMM2_NORM(0, 1, slotU(F, 0));
    PH_END(2);
    PH_BEGIN(16);
    { const EpiB1 e{slotY(F, 0), (const float*)(F.ws + WS_ROPE), (const float*)(F.ws + WS_ROPE) + (size_t)R * 16}; PH_BEGIN(20); MK_GEMM1(EpiB1, e, 0, 4 * D, 1); PH_END(20); }
    PH_BEGIN(21);
#ifdef MK_KPROBE_L1
    { __syncthreads(); const unsigned kc_ = misc[20]; const unsigned long long r1_ = wall_clock64(); while ((unsigned long long)(wall_clock64() - r1_) < (unsigned long long)kc_) __builtin_amdgcn_s_sleep(8); }
#endif
    if (F.bid >= 64) { const Fr P = F.fresh(); convert_win(P, 2, 64); }
    PH_END(21);
    PH_END(16);
    GRID_BAR();
#if MK_CLK == 3
    const unsigned long long clk_c0 = clock64(), clk_r0 = wall_clock64();
#endif
    PH_BEGIN(6);
    DUPN(3, { const Fr P = F.fresh(); attn_phase(P); });
    PH_END(6);
#if MK_CLK == 3
    CLK_SPIN();
#endif
    GRID_BAR();
    PH_BEGIN(7);
    DUPN(4, { const Fr P = F.fresh(); attn_post(P); });
    PH_END(7);
    GRID_BAR();
    PH_BEGIN(3);
    MK_GEMM2_NORM(1, 2, slotY(F, 1));
    PH_END(3);
    PH_BEGIN(8);
    DUPN(7, { const Fr P = F.fresh(); mix_phase(P, slotY(P, 1)); convert_layer2_b(P); });
    PH_END(8);
    GRID_BAR();
    PH_BEGIN(9);
    { const EpiC1 e{slotY(F, 0), (bf16_t*)(F.ws + WS_T)}; MK_GEMM(EpiC1, e, slotU(F, 0), (size_t)R * D, wtin_of(F, 2), 16384, 4 * D, D);
      if (F.bid < 194) { int kk_ = D; asm volatile("" : "+s"(kk_)); pg8::Gemm g_{(const bf16_t*)slotU(F, 0), (const bf16_t*)wtin_of(F, 2), R, 4 * D + 512, kk_, (size_t)R * D};
          if (F.bid < 64) { RwTail St_{64, F.bid}; pg8::gemm_phase<EpiC1, RwTail, false, true, false>(F.lds, g_, St_, e, nullptr); }
          else if (F.bid < 192) { RwTail St_{(F.bid - 64) >> 1, 64 + ((F.bid - 64) & 1)}; pg8::gemm_phase<EpiC1, RwTail, false, false, true>(F.lds, g_, St_, e, nullptr); }
          else { RwTail St_{64, 64 + (F.bid - 192)}; pg8::gemm_phase<EpiC1, RwTail, false, true, true>(F.lds, g_, St_, e, nullptr); } } }
    PH_END(9);
    GRID_BAR();
    PH_BEGIN(10);
    DUPN(9, { const Fr P = F.fresh(); lora2_phase(P); });
    { const Fr P = F.fresh(); rwkv_kknorm(P); }
    PH_END(10);
    GRID_BAR();
    PH_BEGIN(11);
    DUPN(5, { const Fr P = F.fresh(); rwkv_scan(P); });
    PH_END(11);
    GRID_BAR();
    PH_BEGIN(12);
    DUPN(6, { const Fr P = F.fresh(); rwkv_post(P); });
    PH_END(12);
    GRID_BAR();
    PH_BEGIN(4);
    MK_GEMM2_NORM(2, 3, slotU(F, 0));
    PH_END(4);
    PH_BEGIN(17);
    { const EpiH1 e{slotY(F, 0), F.in(5), 1}; MK_GEMM1(EpiH1, e, 0, 4 * D, 3); }
    if (F.bid >= 64) { const Fr P = F.fresh(); convert_wout3(P, 64); }
    PH_END(17);
    GRID_BAR();
    PH_BEGIN(18);
    { const Fr P = F.fresh(); hgrn_phase<false>(P, 1); }
    PH_END(18);
    GRID_BAR();
    PH_BEGIN(19);
    { const Fr P = F.fresh(); hgrn_phase<true>(P, 1); }
    PH_END(19);
    GRID_BAR();
    PH_BEGIN(5);
    MK_GEMM2_NORM(3, -1, (bf16_t*)nullptr);
    PH_END(5);
}
}

extern "C" void kernel_launch(void* const* d_in, const int* in_sizes, int n_in, void* d_out, int out_size, void* d_ws, size_t ws_size, hipStream_t stream) {
    static int grid = 0;
    if (grid == 0) {
        if (n_in != 29 || out_size != 16384 * 4096 || ws_size < mk::WS_END) { fprintf(stderr, "kernel_launch: unexpected shapes (n_in %d out %d ws %zu need %zu)\n", n_in, out_size, ws_size, (size_t)mk::WS_END); grid = -1; return; }
        int dev = 0, cus = 0, per_cu = 0;
        if (hipGetDevice(&dev) != hipSuccess || hipDeviceGetAttribute(&cus, hipDeviceAttributeMultiprocessorCount, dev) != hipSuccess) { grid = -1; return; }
        if (hipFuncSetAttribute((const void*)mk::fwd, hipFuncAttributeMaxDynamicSharedMemorySize, mk::LDS_BYTES) != hipSuccess) { fprintf(stderr, "kernel_launch: hipFuncSetAttribute failed\n"); grid = -1; return; }
        if (hipOccupancyMaxActiveBlocksPerMultiprocessor(&per_cu, (const void*)mk::fwd, 512, mk::LDS_BYTES) != hipSuccess || per_cu < 1) { fprintf(stderr, "kernel_launch: occupancy query says %d\n", per_cu); }
        (void)hipGetLastError();
        grid = cus;
    }
    if (grid < 0) return;
    if (hipMemsetAsync((char*)d_ws + mk::WS_CTL, 0, mk::CTL_BYTES, stream) != hipSuccess) return;
    mk::Args a{};
    for (int i = 0; i < 29; ++i) a.in[i] = (const float*)d_in[i];
    a.out = (float*)d_out; a.ws = (unsigned char*)d_ws;
    hipLaunchKernelGGL(mk::fwd, dim3(grid), dim3(512), mk::LDS_BYTES, stream, a);
}
```

```cpp
#include <hip/hip_runtime.h>
#include <cstdio>
#include <cstdint>

#define LAS __attribute__((address_space(3)))
#define GAS __attribute__((address_space(1)))
typedef unsigned short bf16_t;
typedef short bf16x8 __attribute__((ext_vector_type(8)));
typedef short s16x4 __attribute__((ext_vector_type(4)));
typedef float f32x4 __attribute__((ext_vector_type(4)));
typedef float f32x16 __attribute__((ext_vector_type(16)));
typedef unsigned u32x4 __attribute__((ext_vector_type(4)));
typedef unsigned u32x2 __attribute__((ext_vector_type(2)));

namespace mk {
constexpr int D = 4096, NPAD = 48, NREAL = 16448, R = 16640, NCH = 257;
constexpr size_t MiB = 1u << 20;
constexpr size_t SLOT = (size_t)R * D * 2;
constexpr size_t WS_CTL = 0, CTL_BYTES = 1 * MiB;
constexpr size_t WS_WTIN = 2 * MiB;
constexpr size_t WS_WTOUT = 134 * MiB;
constexpr size_t WS_W2P = 166 * MiB;
constexpr size_t WS_ROPE = 170 * MiB;
constexpr size_t WS_HMETA = 174 * MiB;
constexpr size_t WS_HE = 175 * MiB;
constexpr size_t WS_HLOGD = 191 * MiB;
constexpr size_t WS_U = 192 * MiB;
constexpr size_t WS_Y = WS_U + 6 * SLOT;
constexpr size_t WS_T = WS_Y + 6 * SLOT;
constexpr size_t WS_WTINB = WS_U + 4 * SLOT;
constexpr size_t WS_HB = (WS_T + (size_t)R * 256 * 2 + MiB - 1) / MiB * MiB;
constexpr size_t WS_END = WS_HB + SLOT;
static_assert(WS_END <= 2040 * MiB, "d_ws map");

typedef __bf16 bf16x2n_t __attribute__((ext_vector_type(2)));
typedef float f32x2n_t __attribute__((ext_vector_type(2)));
__device__ __forceinline__ unsigned cvt_pk_bf16(float lo, float hi) { const f32x2n_t v = {lo, hi}; const bf16x2n_t r = __builtin_convertvector(v, bf16x2n_t); return __builtin_bit_cast(unsigned, r); }
__device__ __forceinline__ float bflo(unsigned w) { return __uint_as_float(w << 16); }
__device__ __forceinline__ float bfhi(unsigned w) { return __uint_as_float(w & 0xffff0000u); }
__device__ __forceinline__ float bf2f(bf16_t b) { return __uint_as_float(((unsigned)b) << 16); }
__device__ __forceinline__ bf16_t f2bf(float f) { return (bf16_t)(cvt_pk_bf16(f, f) & 0xffffu); }
__device__ __forceinline__ float sigmoid_f(float x) { return 1.f / (1.f + __expf(-x)); }
__device__ __forceinline__ float silu_f(float x) { return x / (1.f + __expf(-x)); }
__device__ __forceinline__ float wave_sum(float v) {
#pragma unroll
    for (int o = 1; o < 64; o <<= 1) v += __shfl_xor(v, o);
    return v;
}
template <int CTRL> __device__ __forceinline__ float dppf(float v) { return __int_as_float(__builtin_amdgcn_update_dpp(0, __float_as_int(v), CTRL, 0xf, 0xf, true)); }
__device__ __forceinline__ float red4(float v) { v += dppf<0xB1>(v); v += dppf<0x4E>(v); return v; }
__device__ __forceinline__ float red8(float v) { v = red4(v); v += dppf<0x141>(v); return v; }
__device__ __forceinline__ float red16(float v) { v = red8(v); v += dppf<0x140>(v); return v; }
#define LDS_WAIT() asm volatile("s_waitcnt lgkmcnt(0)" ::: "memory")
}
#define XB_TMO      128
#define XB_XCNT(j)  (256  + 64 * (j))
#define XB_XSUB(j)  (1280 + 64 * (j))
#define XB_XGEN(j)  (2304 + 64 * (j))
#define XB_TOP      3328
#define XB_TOPGEN   3392
#define XCD_BAR_WORDS 3456
#define XB_SPIN_CAP (1u << 18)
#define LAS __attribute__((address_space(3)))

__device__ __forceinline__ unsigned xb_ld(unsigned* p)              { return __hip_atomic_load(p, __ATOMIC_RELAXED, __HIP_MEMORY_SCOPE_AGENT); }
__device__ __forceinline__ unsigned xb_add(unsigned* p, unsigned v) { return __hip_atomic_fetch_add(p, v, __ATOMIC_RELAXED, __HIP_MEMORY_SCOPE_AGENT); }
__device__ __forceinline__ unsigned xb_xcc_id() { return (unsigned)__builtin_amdgcn_s_getreg((3 << 11) | 20) & 0xFu; }
#define XB_SPIN(cond, bar) do { unsigned _sp = 0; while (cond) { __builtin_amdgcn_s_sleep(1); \
    if ((++_sp & 255u) == 0u) { if (xb_ld(&(bar)[XB_TMO])) break; if (_sp > XB_SPIN_CAP) { atomicAdd(&(bar)[XB_TMO], 1u); break; } } } } while (0)

struct XcdBarrier {
    unsigned* bar; unsigned x;
    volatile LAS unsigned* st;
};

__device__ __forceinline__ XcdBarrier xcd_barrier_post(unsigned* bar, volatile LAS unsigned* st) {
    XcdBarrier b; b.bar = bar; b.x = xb_xcc_id(); b.st = st;
    if (threadIdx.x == 0) (void)xb_add(&bar[XB_XCNT(b.x)], 1u);
    return b;
}
__device__ __forceinline__ void xcd_barrier_complete(unsigned* bar, unsigned x, unsigned& nloc, unsigned& nx) {
    const unsigned G = gridDim.x * gridDim.y * gridDim.z;
    unsigned sum, cnt, mine, sp = 0u;
    for (;;) {
        sum = 0u; cnt = 0u; mine = 0u;
#pragma unroll
        for (unsigned j = 0; j < 16; ++j) { const unsigned c = xb_ld(&bar[XB_XCNT(j)]); sum += c; cnt += (c > 0u) ? 1u : 0u; mine = (j == x) ? c : mine; }
        if (sum == G) break;
        __builtin_amdgcn_s_sleep(1);
        if ((++sp & 255u) == 0u) { if (xb_ld(&bar[XB_TMO])) break; if (sp > XB_SPIN_CAP) { atomicAdd(&bar[XB_TMO], 1u); break; } }
    }
    nloc = mine > 0u ? mine : 1u; nx = cnt > 0u ? cnt : 1u;
}

__device__ __forceinline__ void xcd_barrier(const XcdBarrier& b) {
    asm volatile("s_waitcnt vmcnt(0)" ::: "memory");
    __syncthreads();
    if (threadIdx.x == 0) {
        unsigned* bar = b.bar;
        __builtin_amdgcn_s_waitcnt(0);
        unsigned nloc = b.st[0], nx = b.st[1];
        if (nloc == 0u) { xcd_barrier_complete(bar, b.x, nloc, nx); b.st[0] = nloc; b.st[1] = nx; }
        const unsigned old = xb_add(&bar[XB_XSUB(b.x)], 1u);
        const unsigned gen = old / nloc;
        if (old + 1u == (gen + 1u) * nloc) {
            __builtin_amdgcn_fence(__ATOMIC_RELEASE, "agent");
            asm volatile("s_waitcnt vmcnt(0)" ::: "memory");
            const unsigned og = xb_add(&bar[XB_TOP], 1u);
            const unsigned tg = og / nx;
            if (og + 1u == (tg + 1u) * nx) xb_add(&bar[XB_TOPGEN], 1u);
            else XB_SPIN(xb_ld(&bar[XB_TOPGEN]) == tg, bar);
            __builtin_amdgcn_fence(__ATOMIC_ACQUIRE, "agent");
            xb_add(&bar[XB_XGEN(b.x)], 1u);
            asm volatile("s_waitcnt vmcnt(0)" ::: "memory");
        } else {
            XB_SPIN(xb_ld(&bar[XB_XGEN(b.x)]) == gen, bar);
            __builtin_amdgcn_fence(__ATOMIC_ACQUIRE, "agent");
            asm volatile("s_waitcnt vmcnt(0)" ::: "memory");
        }
    }
    __syncthreads();
}
#ifndef MK_WGM
#define MK_WGM 8
#endif
namespace pg8 {
#define PG8_LAS __attribute__((address_space(3)))
typedef unsigned short bf16_t;
typedef short bf16x8 __attribute__((ext_vector_type(8)));
typedef float f32x4 __attribute__((ext_vector_type(4)));
typedef unsigned u32x4 __attribute__((ext_vector_type(4)));
constexpr int BM = 256, BK = 64, HALF = 128, HTB = HALF * BK * 2  , STAGE_BYTES = 8 * HTB, NXCD = 8, WGM = 8;

__host__ __device__ __forceinline__ int lds_byte(int r, int c) { const int st = (r >> 4) * 2 + (c >> 5), rr = r & 15, cc = c & 31, ob = rr * 64 + cc * 2; return st * 1024 + (ob ^ (((ob >> 9) & 1) << 5)); }
__host__ __device__ __forceinline__ void stage_rc(int b, int& R, int& C) { const int st = b / 1024, sb = b % 1024, swz = sb ^ (((sb >> 9) & 1) << 5); R = (st >> 1) * 16 + swz / 64; C = (st & 1) * 32 + (swz % 64) / 2; }
__host__ __device__ __forceinline__ int perm32(int rho) { const int n = rho >> 4, i = rho & 15; return 8 * (i >> 2) + 4 * n + (i & 3); }

struct Unit { int pm, pn; };
struct Gemm { const bf16_t* A; const bf16_t* Bt; int M, N, K; size_t aps; };
__device__ __forceinline__ size_t a_part_bytes(const Gemm& g, int pn) { return g.aps ? (size_t)(pn < 64 ? (pn >> 4) : (pn - 60)) * g.aps * 2 : (size_t)0; }

struct StaticOrder {
    int nM, nN, nwg, G, c;
    __host__ __device__ void init(int M, int N, int G_, int c_) { nM = M / BM; nN = N / BM; nwg = nM * nN; G = G_; c = c_; }
    __host__ __device__ bool next(int i, Unit& u) const {
        const long L = (long)i * G + c; if (L >= nwg) return false;
        int wgid = (int)L; { const int q = nwg / NXCD, r = nwg % NXCD, xcd = wgid % NXCD, off = wgid / NXCD; wgid = (xcd < r ? xcd * (q + 1) : r * (q + 1) + (xcd - r) * q) + off; }
        const int nig = WGM * nN, gid = wgid / nig, fm = gid * WGM, gsz = (nM - fm) < WGM ? (nM - fm) : WGM;
        u.pm = fm + ((wgid % nig) % gsz); u.pn = (wgid % nig) / gsz; return true;
    }
    __device__ __forceinline__ void a_ready(const Unit&) const {}
    __device__ __forceinline__ void done(const Unit&) const {}
};
struct CountedOrder : StaticOrder {
    const unsigned* ready; unsigned need; unsigned* tmo;
    __device__ __forceinline__ void a_ready(const Unit& u) const {
        if (threadIdx.x < 64) {
            const unsigned long long t0 = __builtin_amdgcn_s_memrealtime(); unsigned polls = 0;
            while ((unsigned)__builtin_amdgcn_readfirstlane(__hip_atomic_load(ready + 64 * u.pm, __ATOMIC_RELAXED, __HIP_MEMORY_SCOPE_AGENT)) < need) {
                if ((++polls & 255u) == 0u && __builtin_amdgcn_readfirstlane(__hip_atomic_load(tmo, __ATOMIC_RELAXED, __HIP_MEMORY_SCOPE_AGENT)) != 0u) break;
                if (__builtin_amdgcn_s_memrealtime() - t0 > 2000000ull) {
                    if (threadIdx.x == 0) { unsigned expect = 0u; __hip_atomic_compare_exchange_strong(tmo + 1, &expect, 0x600u | (unsigned)(u.pm & 0xff), __ATOMIC_RELAXED, __ATOMIC_RELAXED, __HIP_MEMORY_SCOPE_AGENT); __hip_atomic_store(tmo, 1u, __ATOMIC_RELAXED, __HIP_MEMORY_SCOPE_AGENT); }
                    break; }
                __builtin_amdgcn_s_sleep(2); }
            __builtin_amdgcn_fence(__ATOMIC_ACQUIRE, "agent");
            asm volatile("s_waitcnt vmcnt(0)" ::: "memory");
        }
#if !defined(BROKEN_HOOK_NO_BARRIER)
        asm volatile("" ::: "memory"); __builtin_amdgcn_s_barrier(); asm volatile("" ::: "memory");
#endif
    }
};
template <class Epi, class Sched, bool STAMP = false, bool TOPHALF = false, bool LEFTHALF = false>
__device__ __forceinline__ void gemm_phase(PG8_LAS unsigned char* lds, const Gemm g, const Sched& S, const Epi& E, unsigned long long* stamps) {
    int tid_ = threadIdx.x; asm volatile("" : "+v"(tid_));
    const int tid = tid_, wid = __builtin_amdgcn_readfirstlane(tid >> 6), lane = tid & 63, wr = wid >> 2, wc = wid & 3, fr = lane & 15, fq = lane >> 4;
    const int K = g.K, nt = K / BK;
    int ts_lo = 0, ts_hi = 0, nts = 0; const unsigned long long rt_entry = STAMP ? (unsigned long long)wall_clock64() : 0ull;
#define PG8_STAMP() do { if (STAMP && wid == 0 && nts < 64) { const unsigned long long _c = (unsigned long long)clock64(); \
        ts_lo = (lane == nts) ? (int)(unsigned)_c : ts_lo; ts_hi = (lane == nts) ? (int)(unsigned)(_c >> 32) : ts_hi; ++nts; } } while (0)
    PG8_STAMP();
    unsigned voffA[2], voffB[2];
#pragma unroll
    for (int i = 0; i < 2; ++i) { int R, C; stage_rc(tid * 16 + i * 8192, R, C); const int Rb = Epi::PERM ? ((R & ~31) + perm32(R & 31)) : R;
        voffA[i] = (unsigned)(R * K + C) * 2u; voffB[i] = (unsigned)(Rb * K + C) * 2u; }
    const size_t kstep = (size_t)(BK * 2);
    const size_t hstep = (size_t)HALF * K * 2;
    const size_t tstep = 2 * hstep;
    const unsigned ldsw = (unsigned)wid * 1024u;
    const int aoff = lds_byte(wr * 64 + fr, fq * 8), boff = lds_byte(wc * 32 + fr, fq * 8);
#define PG8_SA(b, h) (((b) * 2 + (h)) * HTB)
#define PG8_SB(b, h) ((4 + (b) * 2 + (h)) * HTB)
#define PG8_STAGE(bufoff, gbase, voff) do { _Pragma("unroll") for (int _i = 0; _i < 2; ++_i) \
        __builtin_amdgcn_global_load_lds((const unsigned*)((const char*)(gbase) + (voff)[_i]), (PG8_LAS unsigned*)(lds + (bufoff) + ldsw + _i * 8192), 16, 0, 0); } while (0)
#define PG8_LDA(dst, b, h) do { _Pragma("unroll") for (int m = 0; m < 4; ++m) _Pragma("unroll") for (int k = 0; k < 2; ++k) dst[m][k] = *(const PG8_LAS bf16x8*)(lds + PG8_SA(b, h) + aoff + m * 2048 + k * 1024); } while (0)
#define PG8_LDB(dst, b, h) do { _Pragma("unroll") for (int n = 0; n < 2; ++n) _Pragma("unroll") for (int k = 0; k < 2; ++k) dst[n][k] = *(const PG8_LAS bf16x8*)(lds + PG8_SB(b, h) + boff + n * 2048 + k * 1024); } while (0)
#define PG8_MMA(ai, bj, At, Bt) do { __builtin_amdgcn_s_setprio(1); _Pragma("unroll") for (int m = 0; m < 4; ++m) _Pragma("unroll") for (int n = 0; n < 2; ++n) _Pragma("unroll") for (int k = 0; k < 2; ++k) \
        acc[ai][bj][m][n] = __builtin_amdgcn_mfma_f32_16x16x32_bf16(Bt[n][k], At[m][k], acc[ai][bj][m][n], 0, 0, 0); __builtin_amdgcn_s_setprio(0); } while (0)
#define PG8_WAIT_V(n) asm volatile("s_waitcnt vmcnt(" #n ")" ::: "memory")
#define PG8_WAIT_L(n) asm volatile("s_waitcnt lgkmcnt(" #n ")" ::: "memory")
#define PG8_BAR __builtin_amdgcn_s_barrier()
#define PG8_SCHED __builtin_amdgcn_sched_barrier(0)
    Unit cur, nxt; int ui = 0;
    if (!S.next(0, cur)) return;
    f32x4 acc[2][2][4][2];
#pragma unroll
    for (int a = 0; a < 2; ++a)
#pragma unroll
        for (int b = 0; b < 2; ++b)
#pragma unroll
            for (int m = 0; m < 4; ++m)
#pragma unroll
                for (int n = 0; n < 2; ++n) acc[a][b][m][n] = (f32x4){0.f, 0.f, 0.f, 0.f};
    bf16x8 At[4][2], B0[2][2], B1[2][2];
    const char* cA = (const char*)g.A + a_part_bytes(g, cur.pn) + (size_t)cur.pm * tstep; const char* cB = (const char*)g.Bt + (size_t)cur.pn * tstep;
    S.a_ready(cur);
    PG8_STAGE(PG8_SB(0, 0), cB, voffB); PG8_STAGE(PG8_SA(0, 0), cA, voffA); PG8_STAGE(PG8_SB(0, 1), cB + hstep, voffB); PG8_STAGE(PG8_SA(0, 1), cA + hstep, voffA);
    if (wr == 1) PG8_BAR;
    PG8_WAIT_V(4); PG8_BAR;
    PG8_STAGE(PG8_SB(1, 0), cB + kstep, voffB); PG8_STAGE(PG8_SA(1, 0), cA + kstep, voffA); PG8_STAGE(PG8_SB(1, 1), cB + hstep + kstep, voffB);
    PG8_WAIT_V(6); PG8_BAR;
    PG8_STAMP();
#ifdef MK_KPROBE
    unsigned long long kp_a_ = 0ull, kp_prev_ = 0ull;
#endif
    for (;;) {
#ifdef MK_KPROBE
        if (MK_KPROBE == 1 && ui == 2) kp_a_ = clock64();
#endif
        const bool has_next = S.next(ui + 1, nxt);
        const char* nA = has_next ? (const char*)g.A + a_part_bytes(g, nxt.pn) + (size_t)nxt.pm * tstep : cA; const char* nB = has_next ? (const char*)g.Bt + (size_t)nxt.pn * tstep : cB;
        for (int t = 0; t < nt; t += 2) {
            const bool last = (t == nt - 2);
            const char* a1 = cA + (size_t)(t + 1) * kstep;
            const char* a2 = last ? nA : cA + (size_t)(t + 2) * kstep; const char* b2 = last ? nB : cB + (size_t)(t + 2) * kstep;
            const char* a3 = a2 + kstep; const char* b3 = b2 + kstep;
            if (last && has_next) S.a_ready(nxt);
            PG8_LDB(B0, 0, 0); PG8_SCHED; PG8_LDA(At, 0, 0); PG8_STAGE(PG8_SA(1, 1), a1 + hstep, voffA);
            PG8_WAIT_L(8); PG8_BAR; PG8_WAIT_L(0); PG8_MMA(0, 0, At, B0); PG8_BAR; PG8_SCHED;
            if constexpr (!LEFTHALF) PG8_LDB(B1, 0, 1); PG8_STAGE(PG8_SB(0, 0), b2, voffB);
            PG8_BAR; PG8_WAIT_L(0); if constexpr (!LEFTHALF) PG8_MMA(0, 1, At, B1); PG8_BAR;
            if constexpr (!TOPHALF) PG8_LDA(At, 0, 1); PG8_STAGE(PG8_SA(0, 0), a2, voffA);
            PG8_BAR; PG8_WAIT_L(0); if constexpr (!TOPHALF) PG8_MMA(1, 0, At, B0); PG8_BAR; PG8_SCHED;
            PG8_STAGE(PG8_SB(0, 1), b2 + hstep, voffB);
            PG8_WAIT_V(6); PG8_BAR; if constexpr (!TOPHALF && !LEFTHALF) PG8_MMA(1, 1, At, B1); PG8_BAR;
            PG8_LDB(B0, 1, 0); PG8_SCHED; PG8_LDA(At, 1, 0); PG8_STAGE(PG8_SA(0, 1), a2 + hstep, voffA);
            PG8_WAIT_L(8); PG8_BAR; PG8_WAIT_L(0); PG8_MMA(0, 0, At, B0); PG8_BAR; PG8_SCHED;
            if constexpr (!LEFTHALF) PG8_LDB(B1, 1, 1); PG8_STAGE(PG8_SB(1, 0), b3, voffB);
            PG8_BAR; PG8_WAIT_L(0); if constexpr (!LEFTHALF) PG8_MMA(0, 1, At, B1); PG8_BAR;
            if constexpr (!TOPHALF) PG8_LDA(At, 1, 1); PG8_STAGE(PG8_SA(1, 0), a3, voffA);
            PG8_BAR; PG8_WAIT_L(0); if constexpr (!TOPHALF) PG8_MMA(1, 0, At, B0); PG8_BAR; PG8_SCHED;
            PG8_STAGE(PG8_SB(1, 1), b3 + hstep, voffB);
            PG8_WAIT_V(6); PG8_BAR; if constexpr (!TOPHALF && !LEFTHALF) PG8_MMA(1, 1, At, B1); PG8_BAR;
        }
        PG8_STAMP();
#ifdef MK_KPROBE
        { const unsigned long long now_ = clock64();
          if (ui == 2 && tid == 0) *(volatile PG8_LAS unsigned*)(lds + 163712 + 80) = (unsigned)(now_ - (MK_KPROBE == 1 ? kp_a_ : kp_prev_));
          kp_prev_ = now_; }
#endif
        if constexpr (!Epi::AFTER_DRAIN) { E(acc, cur, wr, wc, fr, fq); S.done(cur); }
        PG8_STAMP();
        if (!has_next) break;
#pragma unroll
        for (int a = 0; a < 2; ++a)
#pragma unroll
            for (int b = 0; b < 2; ++b)
#pragma unroll
                for (int m = 0; m < 4; ++m)
#pragma unroll
                    for (int n = 0; n < 2; ++n) acc[a][b][m][n] = (f32x4){0.f, 0.f, 0.f, 0.f};
        cur = nxt; cA = nA; cB = nB; ++ui;
    }
    PG8_WAIT_V(0);
    if (wr == 0) PG8_BAR;
    PG8_BAR;
    if constexpr (Epi::AFTER_DRAIN) { E.fused(acc, cur, wr, wc, fr, fq, lds, wid, lane); S.done(cur); }
    PG8_STAMP();
    if (STAMP && wid == 0) { stamps[lane] = lane < nts ? (((unsigned long long)(unsigned)ts_hi << 32) | (unsigned)ts_lo) : 0ull;
        if (lane == 62) stamps[62] = rt_entry; if (lane == 63) stamps[63] = (unsigned long long)wall_clock64(); }
#undef PG8_STAMP
#undef PG8_SA
#undef PG8_SB
#undef PG8_STAGE
#undef PG8_LDA
#undef PG8_LDB
#undef PG8_MMA
#undef PG8_WAIT_V
#undef PG8_WAIT_L
#undef PG8_BAR
#undef PG8_SCHED
}
}
namespace mk {
typedef pg8::Unit Unit;
typedef const pg8::f32x4 (&AccRef)[2][2][4][2];

__device__ __forceinline__ void st_bf8(bf16_t* p, pg8::f32x4 v0, pg8::f32x4 v1) {
    u32x4 w; w.x = cvt_pk_bf16(v0[0], v0[1]); w.y = cvt_pk_bf16(v0[2], v0[3]); w.z = cvt_pk_bf16(v1[0], v1[1]); w.w = cvt_pk_bf16(v1[2], v1[3]);
    *(u32x4*)p = w;
#ifdef MK_ST2
    asm volatile("" ::: "memory"); *(u32x4*)p = w; asm volatile("" ::: "memory");
#endif
}
__device__ __forceinline__ void st_bf4(bf16_t* p, pg8::f32x4 v) { u32x2 w; w.x = cvt_pk_bf16(v[0], v[1]); w.y = cvt_pk_bf16(v[2], v[3]); *(u32x2*)p = w; }

struct EpiY {
    static constexpr bool PERM = true, AFTER_DRAIN = false;
    bf16_t* O;
    __device__ __forceinline__ void operator()(AccRef acc, const Unit& u, int wr, int wc, int fr, int fq) const {
        const int row0 = u.pm * 256 + wr * 64 + fr, col0 = u.pn * 256 + wc * 32 + 8 * fq;
#pragma unroll
        for (int ai = 0; ai < 2; ++ai)
#pragma unroll
            for (int m = 0; m < 4; ++m) { bf16_t* rowp = O + (size_t)(row0 + ai * 128 + m * 16) * D + col0;
#pragma unroll
                for (int bj = 0; bj < 2; ++bj) st_bf8(rowp + bj * 128, acc[ai][bj][m][0], acc[ai][bj][m][1]); }
    }
};
struct EpiH1 {
    static constexpr bool PERM = true, AFTER_DRAIN = false;
    bf16_t* Y; const float* lbl; int jl;
    __device__ __forceinline__ void operator()(AccRef acc, const Unit& u, int wr, int wc, int fr, int fq) const {
        const int part = u.pn >> 4, colt = (u.pn & 15) * 256;
        const int row0 = u.pm * 256 + wr * 64 + fr, col0 = colt + wc * 32 + 8 * fq;
        if (part == 1) {
            pg8::f32x4 lba[2][2] = {{{0.f, 0.f, 0.f, 0.f}, {0.f, 0.f, 0.f, 0.f}}, {{0.f, 0.f, 0.f, 0.f}, {0.f, 0.f, 0.f, 0.f}}};
            if (jl) {
#pragma unroll
                for (int bj = 0; bj < 2; ++bj)
#pragma unroll
                    for (int n = 0; n < 2; ++n) { const pg8::f32x4 l0 = *(const pg8::f32x4*)(lbl + col0 + bj * 128 + 4 * n), l1 = *(const pg8::f32x4*)(lbl + D + col0 + bj * 128 + 4 * n);
#pragma unroll
                        for (int j = 0; j < 4; ++j) lba[bj][n][j] = sigmoid_f(l1[j] - l0[j]); }
            }
#pragma unroll
            for (int bj = 0; bj < 2; ++bj) {
                const pg8::f32x4 lbv[2] = {lba[bj][0], lba[bj][1]};
#pragma unroll
                for (int ai = 0; ai < 2; ++ai)
#pragma unroll
                    for (int m = 0; m < 4; ++m) {
                        const int row = row0 + ai * 128 + m * 16;
                        pg8::f32x4 o[2];
#pragma unroll
                        for (int n = 0; n < 2; ++n)
#pragma unroll
                            for (int j = 0; j < 4; ++j) {
                                const float x = acc[ai][bj][m][n][j]; float g;
                                if (jl) { const float l = lbv[n][j]; g = __logf(l + (1.f - l) * sigmoid_f(x)); }
                                else g = fminf(x, 0.f) - __logf(1.f + __expf(-fabsf(x)));
                                o[n][j] = (row < NPAD) ? 0.f : g;
                            }
                        st_bf8(Y + 3 * (SLOT / 2) + (size_t)row * D + col0 + bj * 128, o[0], o[1]);
                    }
            }
        } else {
            bf16_t* dst = Y + (size_t)(part == 0 ? 0 : (part == 2 ? 1 : 2)) * (SLOT / 2);
#pragma unroll
            for (int ai = 0; ai < 2; ++ai)
#pragma unroll
                for (int m = 0; m < 4; ++m) { bf16_t* rowp = dst + (size_t)(row0 + ai * 128 + m * 16) * D + col0;
#pragma unroll
                    for (int bj = 0; bj < 2; ++bj) st_bf8(rowp + bj * 128, acc[ai][bj][m][0], acc[ai][bj][m][1]); }
        }
    }
};
struct EpiB1 {
    static constexpr bool PERM = false, AFTER_DRAIN = false;
    bf16_t* Y; const float* cs; const float* sn;
    __device__ __forceinline__ void operator()(AccRef acc, const Unit& u, int wr, int wc, int fr, int fq) const {
        const int part = u.pn >> 4, colt = (u.pn & 15) * 256;
        const int row0 = u.pm * 256 + wr * 64 + fr, col0 = colt + wc * 32 + 4 * fq;
        bf16_t* dst = Y + (size_t)part * (SLOT / 2);
        const bool rope = (part < 2) && (wc == 0);
        pg8::f32x4 c4a[2][4], s4a[2][4];
#pragma unroll
        for (int ai = 0; ai < 2; ++ai)
#pragma unroll
            for (int m = 0; m < 4; ++m) { c4a[ai][m] = (pg8::f32x4){1.f, 1.f, 1.f, 1.f}; s4a[ai][m] = (pg8::f32x4){0.f, 0.f, 0.f, 0.f}; }
        if (rope) {
#pragma unroll
            for (int ai = 0; ai < 2; ++ai)
#pragma unroll
                for (int m = 0; m < 4; ++m) { const int row = row0 + ai * 128 + m * 16;
                    c4a[ai][m] = *(const pg8::f32x4*)(cs + (size_t)row * 16 + 4 * fq); s4a[ai][m] = *(const pg8::f32x4*)(sn + (size_t)row * 16 + 4 * fq); }
        }
#pragma unroll
        for (int ai = 0; ai < 2; ++ai)
#pragma unroll
            for (int m = 0; m < 4; ++m) {
                const int row = row0 + ai * 128 + m * 16;
                const pg8::f32x4 c4 = c4a[ai][m], s4 = s4a[ai][m];
                bf16_t* rowp = dst + (size_t)row * D + (col0 - 4 * fq) + ((fq & 1) ? 12 + 4 * fq : 4 * fq);
#pragma unroll
                for (int bj = 0; bj < 2; ++bj) {
                    const pg8::f32x4 x1 = acc[ai][bj][m][0], x2 = acc[ai][bj][m][1];
                    const pg8::f32x4 y1 = x1 * c4 - x2 * s4, y2 = x2 * c4 + x1 * s4;
                    const unsigned a0 = cvt_pk_bf16(y1[0], y1[1]), a1 = cvt_pk_bf16(y1[2], y1[3]), b0 = cvt_pk_bf16(y2[0], y2[1]), b1 = cvt_pk_bf16(y2[2], y2[3]);
                    const auto r0 = __builtin_amdgcn_permlane16_swap(a0, b0, false, false); const auto r1 = __builtin_amdgcn_permlane16_swap(a1, b1, false, false);
                    const u32x4 w = {r0[0], r1[0], r0[1], r1[1]};
                    *(u32x4*)(rowp + bj * 128) = w;
                }
            }
    }
};
struct EpiC1 {
    static constexpr bool PERM = true, AFTER_DRAIN = false;
    bf16_t *Y, *T;
    __device__ __forceinline__ void operator()(AccRef acc, const Unit& u, int wr, int wc, int fr, int fq) const {
        const int row0 = u.pm * 256 + wr * 64 + fr;
        if (u.pn < 64) {
            const int part = u.pn >> 4, col0 = (u.pn & 15) * 256 + wc * 32 + 8 * fq;
            bf16_t* dst = Y + (size_t)part * (SLOT / 2);
#pragma unroll
            for (int ai = 0; ai < 2; ++ai)
#pragma unroll
                for (int m = 0; m < 4; ++m) { bf16_t* rowp = dst + (size_t)(row0 + ai * 128 + m * 16) * D + col0;
#pragma unroll
                    for (int bj = 0; bj < 2; ++bj) st_bf8(rowp + bj * 128, acc[ai][bj][m][0], acc[ai][bj][m][1]); }
        } else {
            const int which = u.pn - 64, col0 = which * 128 + wc * 32 + 8 * fq;
#pragma unroll
            for (int ai = 0; ai < 2; ++ai)
#pragma unroll
                for (int m = 0; m < 4; ++m) {
                    pg8::f32x4 v0 = acc[ai][0][m][0], v1 = acc[ai][0][m][1];
                    if (which == 0) {
#pragma unroll
                        for (int j = 0; j < 4; ++j) { v0[j] = 1.f - 2.f / (1.f + __expf(2.f * v0[j])); v1[j] = 1.f - 2.f / (1.f + __expf(2.f * v1[j])); }
                    }
                    st_bf8(T + (size_t)(row0 + ai * 128 + m * 16) * 256 + col0, v0, v1);
                }
        }
    }
};
struct EpiC2 {
    static constexpr bool PERM = true, AFTER_DRAIN = false;
    bf16_t* Y; const float* w0; const float* a0;
    __device__ __forceinline__ void operator()(AccRef acc, const Unit& u, int wr, int wc, int fr, int fq) const {
        const int row0 = u.pm * 256 + wr * 64 + fr;
        const bool isw = u.pn < 16;
        const int col0 = (u.pn & 15) * 256 + wc * 32 + 8 * fq;
        bf16_t* dst = Y + (size_t)(isw ? 4 : 5) * (SLOT / 2); const float* bias = isw ? w0 : a0;
#pragma unroll
        for (int bj = 0; bj < 2; ++bj) {
            const pg8::f32x4 b0 = *(const pg8::f32x4*)(bias + col0 + bj * 128), b1 = *(const pg8::f32x4*)(bias + col0 + bj * 128 + 4);
#pragma unroll
            for (int ai = 0; ai < 2; ++ai)
#pragma unroll
                for (int m = 0; m < 4; ++m) {
                    pg8::f32x4 v0 = acc[ai][bj][m][0] + b0, v1 = acc[ai][bj][m][1] + b1;
#pragma unroll
                    for (int j = 0; j < 4; ++j) {
                        float s0 = sigmoid_f(v0[j]), s1 = sigmoid_f(v1[j]);
                        if (isw) { s0 = __expf(-0.606531f * s0); s1 = __expf(-0.606531f * s1); }
                        v0[j] = s0; v1[j] = s1;
                    }
                    st_bf8(dst + (size_t)(row0 + ai * 128 + m * 16) * D + col0 + bj * 128, v0, v1);
                    __builtin_amdgcn_sched_barrier(0);
                }
        }
    }
};

struct Fr {
    LAS unsigned char* lds; unsigned char* ldsg;
    int tid, lane, wave, G, bid, gw, NGW;
    float* out; unsigned char* ws;
    __device__ __forceinline__ Fr fresh() const { Fr P = *this; asm volatile("" : "+v"(P.tid)); P.lane = P.tid & 63; P.wave = __builtin_amdgcn_readfirstlane(P.tid >> 6); P.gw = P.bid * 8 + P.wave; return P; }
    __device__ __forceinline__ const float* in(int i) const {
        const __attribute__((address_space(4))) unsigned long long* ka = (const __attribute__((address_space(4))) unsigned long long*)__builtin_amdgcn_kernarg_segment_ptr();
        asm volatile("" : "+s"(ka));
        return (const float*)ka[i];
    }
};
__device__ __forceinline__ bf16_t* slotU(const Fr& F, int s) { return (bf16_t*)(F.ws + WS_U + (size_t)s * SLOT); }
__device__ __forceinline__ bf16_t* slotY(const Fr& F, int s) { return (bf16_t*)(F.ws + WS_Y + (size_t)s * SLOT); }
__device__ __forceinline__ float* hrow(const Fr& F, int r) { return r < 64 ? (float*)(F.ws + WS_HMETA) + (size_t)r * D : F.out + (size_t)(r - 64) * D; }

__device__ __forceinline__ void transpose_item(const float* W, int ldw, bf16_t* WT, int ldt, int koff, LAS float* scr, int kb, int nb, int lane) {
    const int k0 = 64 * kb, n0 = 32 * nb;
    float wv[32];
#pragma unroll
    for (int i = 0; i < 32; ++i) wv[i] = W[(size_t)(k0 + 2 * i + (lane >> 5)) * ldw + n0 + (lane & 31)];
#pragma unroll
    for (int i = 0; i < 32; ++i) scr[(2 * i + (lane >> 5)) * 33 + (lane & 31)] = wv[i];
    LDS_WAIT(); asm volatile("" ::: "memory");
    const int c = lane & 7;
#pragma unroll
    for (int j = 0; j < 4; ++j) { const int n = (lane >> 3) + 8 * j; const LAS float* s = scr + (8 * c) * 33 + n;
        u32x4 o; o.x = cvt_pk_bf16(s[0 * 33], s[1 * 33]); o.y = cvt_pk_bf16(s[2 * 33], s[3 * 33]); o.z = cvt_pk_bf16(s[4 * 33], s[5 * 33]); o.w = cvt_pk_bf16(s[6 * 33], s[7 * 33]);
        *(u32x4*)(WT + (size_t)(n0 + n) * ldt + koff + k0 + 8 * c) = o; }
    LDS_WAIT(); asm volatile("" ::: "memory");
}
__device__ __forceinline__ void convert_matrix(const Fr& F, const float* W, int K, int N, bf16_t* WT, int ldt, int koff, int wg_skip = 0) {
    LAS float* scr = (LAS float*)(F.lds + F.wave * 8704);
    const int nblk = N / 32, nitems = (K / 64) * nblk;
    for (int it = F.gw - wg_skip * 8; it < nitems; it += F.NGW - wg_skip * 8) transpose_item(W, N, WT, ldt, koff, scr, it / nblk, it % nblk, F.lane);
}
__device__ __forceinline__ void convert_matrix_split(const Fr& F, const float* W, int K, int N, bf16_t* WT, int ldt, int wg_split, int nsplit) {
    LAS float* scr = (LAS float*)(F.lds + F.wave * 8704);
    const int nblk = N / 32, nitems = (K / 64) * nblk;
    if (F.bid >= wg_split) { for (int it = F.gw - wg_split * 8; it < nsplit; it += F.NGW - wg_split * 8) transpose_item(W, N, WT, ldt, 0, scr, it / nblk, it % nblk, F.lane); }
    else { for (int it = nsplit + F.gw; it < nitems; it += wg_split * 8) transpose_item(W, N, WT, ldt, 0, scr, it / nblk, it % nblk, F.lane); }
}
__device__ __forceinline__ void zero_bytes(const Fr& F, void* p, size_t nbytes) {
    u32x4* q = (u32x4*)p; const size_t n = nbytes / 16; const u32x4 z = {0u, 0u, 0u, 0u};
    for (size_t i = (size_t)F.bid * 512 + F.tid; i < n; i += (size_t)F.G * 512) q[i] = z;
}
__device__ __forceinline__ bf16_t* wtin_of(const Fr& F, int L) { return (bf16_t*)(F.ws + ((L & 1) ? WS_WTINB : WS_WTIN)); }
__device__ __forceinline__ const float* win_src(const Fr& F, int L) { return (L == 0 || L == 3) ? F.in(4) + (size_t)(L ? 1 : 0) * D * 4 * D : (L == 1 ? F.in(8) : F.in(16)); }
__device__ __forceinline__ void convert_win_tail(const Fr& F, int L) { convert_matrix_split(F, win_src(F, L), D, 4 * D, wtin_of(F, L), D, 64, 26624); }
__device__ __forceinline__ void convert_win(const Fr& F, int L, int wg_skip) {
    const float* src = (L == 0 || L == 3) ? F.in(4) + (size_t)(L ? 1 : 0) * D * 4 * D : (L == 1 ? F.in(8) : F.in(16));
    convert_matrix(F, src, D, 4 * D, wtin_of(F, L), D, 0, wg_skip);
}
__device__ __forceinline__ void convert_layer(const Fr& F, int L, bool with_win) {
    bf16_t* wtin = wtin_of(F, L); bf16_t* wtout = (bf16_t*)(F.ws + WS_WTOUT);
    if (with_win) convert_win(F, L, 0);
    if (L == 0) {
        convert_matrix(F, F.in(7), D, D, wtout, D, 0);
    } else if (L == 3) {
    } else if (L == 1) {
        convert_matrix(F, F.in(14), D, D, wtout, D, 0);
    } else {
        convert_matrix(F, F.in(28), D, D, wtout, D, 0);
        convert_matrix(F, F.in(18), D, 128, wtin + (size_t)16384 * D, D, 0);
        convert_matrix(F, F.in(21), D, 128, wtin + (size_t)16640 * D, D, 0);
        zero_bytes(F, wtin + (size_t)16512 * D, (size_t)128 * D * 2);
        zero_bytes(F, wtin + (size_t)16768 * D, (size_t)128 * D * 2);
    }
}
__device__ __forceinline__ void convert_wout2(const Fr& F, int wg_skip) { convert_matrix(F, F.in(28), D, D, (bf16_t*)(F.ws + WS_WTOUT), D, 0, wg_skip); }
__device__ __forceinline__ void convert_wout3(const Fr& F, int wg_skip) { convert_matrix(F, F.in(7) + (size_t)D * D, D, D, (bf16_t*)(F.ws + WS_WTOUT), D, 0, wg_skip); }
__device__ __forceinline__ void convert_layer2_b(const Fr& F) {
    bf16_t* w2t = (bf16_t*)(F.ws + WS_W2P);
    convert_matrix(F, F.in(19), 128, D, w2t, 128, 0);
    convert_matrix(F, F.in(22), 128, D, w2t + (size_t)4096 * 128, 128, 0);
}

__constant__ float c_inv_freq[16] = {1.0f, 0.44036659598350525f, 0.1939227432012558f, 0.08539710193872452f, 0.03760603070259094f, 0.01656043902039528f, 0.007292664609849453f, 0.0032114458736032248f,
    0.0014142135623842478f, 0.000622772378847003f, 0.00027424818836152554f, 0.00012076973507646471f, 5.318296098266728e-05f, 2.34199997066753e-05f, 1.0313386155758053e-05f, 4.541670477919979e-06f};
__device__ __forceinline__ void rope_table(const Fr& F) {
    float* cs = (float*)(F.ws + WS_ROPE); float* sn = cs + (size_t)R * 16;
    for (int i = F.bid * 512 + F.tid; i < R * 16; i += F.G * 512) {
        const int row = i >> 4, j = i & 15; const int pos = row - NPAD;
        const double ang = (double)(float)((float)pos * c_inv_freq[j]);
        const double k = __builtin_rint(ang * 0.15915494309189535);
        double x = ang - k * 6.283185307179586;
        const double q = __builtin_rint(x * 0.6366197723675814);
        x -= q * 1.5707963267948966;
        const int qi = ((int)q) & 3;
        const double x2 = x * x;
        const double s = x * (1.0 + x2 * (-1.0 / 6 + x2 * (1.0 / 120 + x2 * (-1.0 / 5040 + x2 * (1.0 / 362880 + x2 * (-1.0 / 39916800))))));
        const double c = 1.0 + x2 * (-0.5 + x2 * (1.0 / 24 + x2 * (-1.0 / 720 + x2 * (1.0 / 40320 + x2 * (-1.0 / 3628800 + x2 * (1.0 / 479001600))))));
        double sv, cv;
        if (qi == 0) { sv = s; cv = c; } else if (qi == 1) { sv = c; cv = -s; } else if (qi == 2) { sv = -s; cv = -c; } else { sv = -c; cv = s; }
        cs[i] = (float)cv; sn[i] = (float)sv;
    }
}

typedef const GAS char* gcp; typedef GAS char* gp_;
#define ROW_F32(nm, base, lane) gp_ nm##0 = (gp_)(base) + (lane) * 16 + 4096; gp_ nm##1 = nm##0 + 8192; asm volatile("" : "+v"(nm##0), "+v"(nm##1))
#define AT_F32(nm, j) (*(GAS f32x4*)((j) < 8 ? nm##0 + ((j) - 4) * 1024 : nm##1 + ((j) - 12) * 1024))
#define ROW_BF(nm, base, lane) gp_ nm##0 = (gp_)(base) + (lane) * 8 + 4096; asm volatile("" : "+v"(nm##0))
#define AT_BF(nm, j) (*(GAS u32x2*)(nm##0 + (j) * 512 - 4096))
__device__ __forceinline__ void norm_phase(const Fr& F, int prev, int next, const bf16_t* y, bf16_t* udst, int rlo = 0, int rhi = R, int wg_skip = 0) {
    const float* postg = F.in(3) + (size_t)(prev < 0 ? 0 : prev) * D; const float* preg = F.in(2) + (size_t)(next < 0 ? 0 : next) * D;
    const float* xin = F.in(0); const float* meta = F.in(1);
    for (int r = rlo + F.gw - wg_skip * 8; r < rhi; r += F.NGW - wg_skip * 8) {
        if (r < NPAD || r >= NREAL) {
            if (next >= 0) { ROW_BF(uo, udst + (size_t)r * D, F.lane); const u32x2 z = {0u, 0u};
#pragma unroll
                for (int j = 0; j < 16; ++j) AT_BF(uo, j) = z; }
            continue;
        }
        ROW_BF(hp, (bf16_t*)(F.ws + WS_HB) + (size_t)r * D, F.lane);
        f32x4 hv[16];
        if (prev < 0) {
            const float* src = r < 64 ? meta + (size_t)(r - NPAD) * D : xin + (size_t)(r - 64) * D;
            ROW_F32(sp, src, F.lane);
#pragma unroll
            for (int j = 0; j < 16; ++j) hv[j] = AT_F32(sp, j);
        } else {
            ROW_BF(yp, y + (size_t)r * D, F.lane); ROW_F32(gp, postg, F.lane);
            u32x2 yv[16], hb[16]; float ss = 0.f;
#pragma unroll
            for (int j = 0; j < 16; ++j) { yv[j] = AT_BF(yp, j); hb[j] = AT_BF(hp, j); }
#pragma unroll
            for (int j = 0; j < 16; ++j) { const float a = bflo(yv[j].x), b = bfhi(yv[j].x), c = bflo(yv[j].y), d = bfhi(yv[j].y); ss += (a * a + b * b) + (c * c + d * d); }
#pragma unroll
            for (int j = 0; j < 16; ++j) asm volatile("" : "+v"(yv[j].x), "+v"(yv[j].y));
            const float rs = __builtin_amdgcn_rsqf(wave_sum(ss) * (1.f / D) + 1e-6f);
#pragma unroll
            for (int j = 0; j < 16; ++j) { const f32x4 g = AT_F32(gp, j);
                hv[j].x = bflo(hb[j].x) + bflo(yv[j].x) * rs * g.x; hv[j].y = bfhi(hb[j].x) + bfhi(yv[j].x) * rs * g.y; hv[j].z = bflo(hb[j].y) + bflo(yv[j].y) * rs * g.z; hv[j].w = bfhi(hb[j].y) + bfhi(yv[j].y) * rs * g.w; }
        }
        if (next < 0) {
            if (r >= 64) { ROW_F32(op, F.out + (size_t)(r - 64) * D, F.lane);
#pragma unroll
                for (int j = 0; j < 16; ++j) AT_F32(op, j) = hv[j];
            }
            continue;
        }
        float s2 = 0.f;
#pragma unroll
        for (int j = 0; j < 16; ++j) { u32x2 w_; w_.x = cvt_pk_bf16(hv[j].x, hv[j].y); w_.y = cvt_pk_bf16(hv[j].z, hv[j].w); AT_BF(hp, j) = w_; s2 += (hv[j].x * hv[j].x + hv[j].y * hv[j].y) + (hv[j].z * hv[j].z + hv[j].w * hv[j].w); }
        const float rs2 = __builtin_amdgcn_rsqf(wave_sum(s2) * (1.f / D) + 1e-6f);
        ROW_BF(uo, udst + (size_t)r * D, F.lane); ROW_F32(pg, preg, F.lane);
#pragma unroll
        for (int j = 0; j < 16; ++j) { const f32x4 g = AT_F32(pg, j); u32x2 w; w.x = cvt_pk_bf16(hv[j].x * rs2 * g.x, hv[j].y * rs2 * g.y); w.y = cvt_pk_bf16(hv[j].z * rs2 * g.z, hv[j].w * rs2 * g.w); AT_BF(uo, j) = w; }
    }
}
__device__ __forceinline__ void mix_phase(const Fr& F, const bf16_t* u) {
    const float* mu = F.in(15);
    for (int r = F.gw; r < R; r += F.NGW) {
        const bool real = (r >= NPAD && r < NREAL);
        u32x2 cur[16], prv[16];
        const u32x2 z = {0u, 0u};
        { ROW_BF(cp, u + (size_t)r * D, F.lane); ROW_BF(pp, u + (size_t)(r > 0 ? r - 1 : 0) * D, F.lane);
#pragma unroll
          for (int j = 0; j < 16; ++j) { cur[j] = real ? AT_BF(cp, j) : z; prv[j] = (real && r > NPAD) ? AT_BF(pp, j) : z; } }
#pragma unroll 1
        for (int s = 0; s < 6; ++s) {
            ROW_BF(op, slotU(F, s) + (size_t)r * D, F.lane); ROW_F32(mp, mu + (size_t)s * D, F.lane);
#pragma unroll
            for (int j = 0; j < 16; ++j) {
                const f32x4 m = AT_F32(mp, j);
                const float c0 = bflo(cur[j].x), c1 = bfhi(cur[j].x), c2 = bflo(cur[j].y), c3 = bfhi(cur[j].y);
                const float p0 = bflo(prv[j].x), p1 = bfhi(prv[j].x), p2 = bflo(prv[j].y), p3 = bfhi(prv[j].y);
                u32x2 w; w.x = cvt_pk_bf16(c0 + (p0 - c0) * m.x, c1 + (p1 - c1) * m.y); w.y = cvt_pk_bf16(c2 + (p2 - c2) * m.z, c3 + (p3 - c3) * m.w);
                AT_BF(op, j) = real ? w : z;
            }
        }
    }
}
}
namespace mk {
constexpr int H_WS = 144, H_TS = 80, H_QE = 0, H_KE = H_QE + 64 * H_WS * 2, H_KET = H_KE + 64 * H_WS * 2, H_VT = H_KET + 128 * H_TS * 2, H_PM = H_VT + 128 * H_TS * 2, H_STB = H_PM + 64 * H_TS * 2,
              H_VEC = H_STB + 128 * H_WS * 2, H_OT = H_VEC + 3072;
static_assert(H_OT + 33792 <= 163712, "hgrn LDS map");
__device__ __forceinline__ bf16x8 ldfrag(const LAS unsigned char* base, int stride_b, int rb, int ks, int lane) {
    return *(const LAS bf16x8*)(base + (16 * rb + (lane & 15)) * stride_b + (32 * ks + 8 * (lane >> 4)) * 2);
}
template <bool OUT>
__device__ __forceinline__ void hgrn_phase(const Fr& F, int jl) {
    const bf16_t* Q = slotY(F, 0); const bf16_t* V = slotY(F, 1); const bf16_t* GT = slotY(F, 2); const bf16_t* Gg = slotY(F, 3);
    bf16_t* Z = slotU(F, 0);
    float* HE = (float*)(F.ws + WS_HE); float* HLD = (float*)(F.ws + WS_HLOGD);
    const float* gn = F.in(6) + (size_t)jl * 128;
    LAS unsigned char* L = F.lds;
    LAS float* qtot = (LAS float*)(L + H_VEC); LAS float* ebm = qtot + 512; LAS float* ebl = ebm + 128;
    const int tid = F.tid, lane = F.lane, w = F.wave;
    const int d = tid & 127, qt = tid >> 7;
    for (int unit = F.bid; unit < 256; unit += F.G) {
        const int h = unit >> 3, seg = unit & 7;
        if (!OUT && seg == 7) continue;
        const int c0 = seg == 0 ? 0 : 33 + 32 * (seg - 1), c1 = c0 + (seg == 0 ? 33 : 32);
        f32x4 S[8];
#pragma unroll
        for (int i = 0; i < 8; ++i) S[i] = (f32x4){0.f, 0.f, 0.f, 0.f};
        if (OUT) {
            for (int j = 0; j < seg; ++j) {
                const float* ld = HLD + (size_t)(h * 8 + j) * 128; const float* e = HE + ((size_t)(h * 8 + j) * 512 + tid) * 32;
#pragma unroll
                for (int di = 0; di < 8; ++di) { const f32x4 l4 = *(const f32x4*)(ld + 16 * di + 4 * (lane >> 4)); const f32x4 e4 = *(const f32x4*)(e + 4 * di);
                    S[di].x = S[di].x * __expf(l4.x) + e4.x; S[di].y = S[di].y * __expf(l4.y) + e4.y; S[di].z = S[di].z * __expf(l4.z) + e4.z; S[di].w = S[di].w * __expf(l4.w) + e4.w; }
            }
        }
        float logD = 0.f;
        bf16_t g[16], qv[16], vv[16]; u32x4 gt0 = {0u, 0u, 0u, 0u}, gt1 = gt0, ngt0 = gt0, ngt1 = gt0;
#define HG_LOAD(cc) do { const int rowb_ = 64 * (cc) + 16 * qt; const size_t colb_ = (size_t)h * 128 + d; \
            _Pragma("unroll") for (int i = 0; i < 16; ++i) { g[i] = Gg[(size_t)(rowb_ + i) * D + colb_]; vv[i] = V[(size_t)(rowb_ + i) * D + colb_]; if (OUT) qv[i] = Q[(size_t)(rowb_ + i) * D + colb_]; } \
            if (OUT) { const bf16_t* gp_ = GT + (size_t)(64 * (cc) + (tid >> 3)) * D + h * 128 + 16 * (tid & 7); ngt0 = *(const u32x4*)gp_; ngt1 = *(const u32x4*)(gp_ + 8); } } while (0)
        HG_LOAD(c0);
        for (int c = c0; c < c1; ++c) {
            if (OUT) { gt0 = ngt0; gt1 = ngt1; }
            float f[16]; float run = 0.f;
#pragma unroll
            for (int i = 0; i < 16; ++i) { const float gi = bf2f(g[i]); run += gi; f[i] = __expf(gi); }
            qtot[qt * 128 + d] = run;
            __syncthreads();
            const float t0 = qtot[d], t1 = qtot[128 + d], t2 = qtot[256 + d], t3 = qtot[384 + d];
            const float off = qt == 0 ? 0.f : (qt == 1 ? t0 : (qt == 2 ? t0 + t1 : t0 + t1 + t2));
            const float bm = t0 + t1, bl = (t0 + t1) + (t2 + t3);
            if (qt == 0) { ebm[d] = __expf(bm); ebl[d] = __expf(bl); logD += bl; }
            {
                unsigned kt[8], vt[8];
                const float ebd = __expf(bl - bm);
                float y = __expf(bm - (run + off)), kx_hi = 0.f;
#pragma unroll
                for (int i = 15; i >= 0; --i) {
                    const float ky = (1.f - f[i]) * y;
                    if (OUT) *(LAS bf16_t*)(L + H_KE + ((16 * qt + i) * H_WS + d) * 2) = f2bf(ky);
                    const float kx = ky * ebd;
                    if (i & 1) kx_hi = kx; else kt[i >> 1] = cvt_pk_bf16(kx, kx_hi);
                    y *= f[i];
                }
                if (OUT) {
                    float e = __expf(off - bm);
#pragma unroll
                    for (int i = 0; i < 16; ++i) { e *= f[i]; *(LAS bf16_t*)(L + H_QE + ((16 * qt + i) * H_WS + d) * 2) = f2bf(bf2f(qv[i]) * e); }
                }
#pragma unroll
                for (int i = 0; i < 16; i += 2) vt[i >> 1] = (unsigned)vv[i] | ((unsigned)vv[i + 1] << 16);
                LAS u32x4* kp = (LAS u32x4*)(L + H_KET + (d * H_TS + 16 * qt) * 2); kp[0] = (u32x4){kt[0], kt[1], kt[2], kt[3]}; kp[1] = (u32x4){kt[4], kt[5], kt[6], kt[7]};
                LAS u32x4* vp = (LAS u32x4*)(L + H_VT + (d * H_TS + 16 * qt) * 2); vp[0] = (u32x4){vt[0], vt[1], vt[2], vt[3]}; vp[1] = (u32x4){vt[4], vt[5], vt[6], vt[7]};
            }
            if (c + 1 < c1) HG_LOAD(c + 1);
            __syncthreads();
            if (OUT) {
#pragma unroll
                for (int di = 0; di < 8; ++di) { const f32x4 m4 = *(const LAS f32x4*)(ebm + 16 * di + 4 * (lane >> 4)); u32x2 o; o.x = cvt_pk_bf16(S[di].x * m4.x, S[di].y * m4.y); o.y = cvt_pk_bf16(S[di].z * m4.z, S[di].w * m4.w);
                    *(LAS u32x2*)(L + H_STB + ((16 * w + (lane & 15)) * H_WS + 16 * di + 4 * (lane >> 4)) * 2) = o; }
                const int ti = w >> 1;
#pragma unroll
                for (int s2 = 0; s2 < 2; ++s2) { const int si = 2 * (w & 1) + s2; f32x4 p = {0.f, 0.f, 0.f, 0.f};
                    if (si <= ti) {
#pragma unroll
                        for (int ks = 0; ks < 4; ++ks) p = __builtin_amdgcn_mfma_f32_16x16x32_bf16(ldfrag(L + H_QE, 2 * H_WS, ti, ks, lane), ldfrag(L + H_KE, 2 * H_WS, si, ks, lane), p, 0, 0, 0);
                    }
                    const int sidx = 16 * si + (lane & 15);
#pragma unroll
                    for (int jj = 0; jj < 4; ++jj) { const int tidx = 16 * ti + 4 * (lane >> 4) + jj; *(LAS bf16_t*)(L + H_PM + (tidx * H_TS + sidx) * 2) = f2bf(sidx <= tidx ? p[jj] : 0.f); }
                }
                __syncthreads();
            }
            f32x4 O[4];
            if (OUT) {
#pragma unroll
                for (int ti = 0; ti < 4; ++ti) O[ti] = (f32x4){0.f, 0.f, 0.f, 0.f};
#pragma unroll
                for (int ks = 0; ks < 2; ++ks) { const bf16x8 bv = ldfrag(L + H_VT, 2 * H_TS, w, ks, lane);
#pragma unroll
                    for (int ti = 0; ti < 4; ++ti) O[ti] = __builtin_amdgcn_mfma_f32_16x16x32_bf16(ldfrag(L + H_PM, 2 * H_TS, ti, ks, lane), bv, O[ti], 0, 0, 0); }
#pragma unroll
                for (int ks = 0; ks < 4; ++ks) { const bf16x8 bs = ldfrag(L + H_STB, 2 * H_WS, w, ks, lane);
#pragma unroll
                    for (int ti = 0; ti < 4; ++ti) O[ti] = __builtin_amdgcn_mfma_f32_16x16x32_bf16(ldfrag(L + H_QE, 2 * H_WS, ti, ks, lane), bs, O[ti], 0, 0, 0); }
            }
            {
                const bf16x8 bv0 = ldfrag(L + H_VT, 2 * H_TS, w, 0, lane), bv1 = ldfrag(L + H_VT, 2 * H_TS, w, 1, lane);
#pragma unroll
                for (int di = 0; di < 8; ++di) { const f32x4 l4 = *(const LAS f32x4*)(ebl + 16 * di + 4 * (lane >> 4)); S[di] = S[di] * l4;
                    S[di] = __builtin_amdgcn_mfma_f32_16x16x32_bf16(ldfrag(L + H_KET, 2 * H_TS, di, 0, lane), bv0, S[di], 0, 0, 0);
                    S[di] = __builtin_amdgcn_mfma_f32_16x16x32_bf16(ldfrag(L + H_KET, 2 * H_TS, di, 1, lane), bv1, S[di], 0, 0, 0); }
            }
            if (OUT) {
                LAS float* Ot = (LAS float*)(L + H_OT);
#pragma unroll
                for (int ti = 0; ti < 4; ++ti)
#pragma unroll
                    for (int jj = 0; jj < 4; ++jj) Ot[(16 * ti + 4 * (lane >> 4) + jj) * 132 + 16 * w + (lane & 15)] = O[ti][jj];
                __syncthreads();
                const int t = tid >> 3, eg = tid & 7;
                f32x4 o4[4]; float ss = 0.f;
#pragma unroll
                for (int i = 0; i < 4; ++i) { o4[i] = *(const LAS f32x4*)(Ot + t * 132 + 16 * eg + 4 * i); ss += (o4[i].x * o4[i].x + o4[i].y * o4[i].y) + (o4[i].z * o4[i].z + o4[i].w * o4[i].w); }
                ss = red8(ss);
                const float rs = __builtin_amdgcn_rsqf(ss * (1.f / 128.f) + 1e-6f);
                const unsigned gw_[8] = {gt0.x, gt0.y, gt0.z, gt0.w, gt1.x, gt1.y, gt1.z, gt1.w};
                unsigned zo[8];
#pragma unroll
                for (int i = 0; i < 4; ++i) { const f32x4 g4 = *(const f32x4*)(gn + 16 * eg + 4 * i);
                    const float a0 = o4[i].x * rs * g4.x * silu_f(bflo(gw_[2 * i])), a1 = o4[i].y * rs * g4.y * silu_f(bfhi(gw_[2 * i]));
                    const float a2 = o4[i].z * rs * g4.z * silu_f(bflo(gw_[2 * i + 1])), a3 = o4[i].w * rs * g4.w * silu_f(bfhi(gw_[2 * i + 1]));
                    zo[2 * i] = cvt_pk_bf16(a0, a1); zo[2 * i + 1] = cvt_pk_bf16(a2, a3); }
                bf16_t* zp = Z + (size_t)(64 * c + t) * D + h * 128 + 16 * eg;
                *(u32x4*)zp = (u32x4){zo[0], zo[1], zo[2], zo[3]}; *(u32x4*)(zp + 8) = (u32x4){zo[4], zo[5], zo[6], zo[7]};
            } else {
                __syncthreads();
            }
        }
        if (!OUT) {
            float* e = HE + ((size_t)(h * 8 + seg) * 512 + tid) * 32;
#pragma unroll
            for (int di = 0; di < 8; ++di) *(f32x4*)(e + 4 * di) = S[di];
            if (qt == 0) HLD[(size_t)(h * 8 + seg) * 128 + d] = logD;
        }
        __syncthreads();
    }
#undef HG_LOAD
}

#ifndef MK_PRIO
#define MK_PRIO 0
#endif
#define PRIO_HI() do { if (MK_PRIO) { __builtin_amdgcn_s_setprio(MK_PRIO); } } while (0)
#define PRIO_LO() do { if (MK_PRIO) { __builtin_amdgcn_s_setprio(0); } } while (0)
namespace att {
constexpr int NW = 8, QBLK = 32, KVBLK = 64, LDQ = 4096, LDO = 8192;
constexpr float SCALE = 0.088388347648318440f, THR = 8.f;
constexpr int SHM_V = 16384, SHM_K = 16384, SHM = 2 * SHM_V + 2 * SHM_K + NW * 64 * 4;
#ifndef MK_KSWM
#define MK_KSWM 15
#endif
#define KSWZ(row, colB) ((row) * 256 + ((colB) ^ (((row) & MK_KSWM) << 4)))
#define SBAR() __builtin_amdgcn_sched_barrier(0)
__device__ __forceinline__ int crow(int r, int hi) { return (r & 3) + 8 * (r >> 2) + 4 * hi; }
__device__ __forceinline__ void partialSM(f32x16& p0, f32x16& p1, float& m_reg, float& mn, float& alpha) {
    constexpr float C = SCALE * 1.4426950408889634f;
    float pmax = p0[0];
#pragma unroll
    for (int r = 1; r < 16; ++r) pmax = fmaxf(pmax, p0[r]);
#pragma unroll
    for (int r = 0; r < 16; ++r) pmax = fmaxf(pmax, p1[r]);
    { auto rr = __builtin_amdgcn_permlane32_swap(__float_as_uint(pmax), __float_as_uint(pmax), false, false);
      pmax = fmaxf(__uint_as_float(rr[0]), __uint_as_float(rr[1])); }
    if (__builtin_expect(__all(pmax - m_reg <= THR / SCALE), 1)) { mn = m_reg; alpha = 1.f; }
    else { mn = fmaxf(m_reg, pmax); alpha = __builtin_amdgcn_exp2f((m_reg - mn) * C); m_reg = mn; }
    const float mnC = -mn * C;
#pragma unroll
    for (int r = 0; r < 16; ++r) p0[r] = fmaf(p0[r], C, mnC);
#pragma unroll
    for (int r = 0; r < 16; ++r) p1[r] = fmaf(p1[r], C, mnC);
#pragma unroll
    for (int r = 0; r < 16; ++r) p0[r] = __builtin_amdgcn_exp2f(p0[r]);
}
__device__ __forceinline__ void finishSM(f32x16& p0, f32x16& p1, float alpha, float& l_reg, bf16x8& pa0, bf16x8& pa1, bf16x8& pa2, bf16x8& pa3) {
#pragma unroll
    for (int r = 0; r < 16; ++r) p1[r] = __builtin_amdgcn_exp2f(p1[r]);
    float ps = 0;
#pragma unroll
    for (int r = 0; r < 16; ++r) ps += p0[r];
#pragma unroll
    for (int r = 0; r < 16; ++r) ps += p1[r];
    { auto rr = __builtin_amdgcn_permlane32_swap(__float_as_uint(ps), __float_as_uint(ps), false, false);
      ps = __uint_as_float(rr[0]) + __uint_as_float(rr[1]); }
    l_reg = l_reg * alpha + ps;
#define PK4(P, BASE, OUT) do { unsigned a0 = cvt_pk_bf16(P[BASE + 0], P[BASE + 1]), a1 = cvt_pk_bf16(P[BASE + 2], P[BASE + 3]);   \
    unsigned b0 = cvt_pk_bf16(P[BASE + 4], P[BASE + 5]), b1 = cvt_pk_bf16(P[BASE + 6], P[BASE + 7]);                              \
    auto r0 = __builtin_amdgcn_permlane32_swap(a0, b0, false, false); auto r1 = __builtin_amdgcn_permlane32_swap(a1, b1, false, false); \
    u32x4 w = {r0[0], r1[0], r0[1], r1[1]}; OUT = *reinterpret_cast<bf16x8*>(&w); } while (0)
    PK4(p0, 0, pa0); PK4(p0, 8, pa1); PK4(p1, 0, pa2); PK4(p1, 8, pa3);
#undef PK4
}
__device__ __forceinline__ void qkt(f32x16& p0, f32x16& p1, const char* Ks, const bf16x8* qr, int r32, int hi) {
    p0 = f32x16{}; p1 = f32x16{};
    PRIO_HI();
#pragma unroll
    for (int d0 = 0; d0 < 8; ++d0) { const int cb = (d0 * 16 + hi * 8) * 2;
        const bf16x8 b0 = *reinterpret_cast<const bf16x8*>(Ks + KSWZ(r32, cb));
        const bf16x8 b1 = *reinterpret_cast<const bf16x8*>(Ks + KSWZ(32 + r32, cb));
        p0 = __builtin_amdgcn_mfma_f32_32x32x16_bf16(b0, qr[d0], p0, 0, 0, 0);
        p1 = __builtin_amdgcn_mfma_f32_32x32x16_bf16(b1, qr[d0], p1, 0, 0, 0); }
    PRIO_LO();
}
__device__ __forceinline__ int v_st(int k, int c) { const int kk = (k & ~0xC) | ((k & 4) << 1) | ((k & 8) >> 1); return ((kk >> 3) * 4 + (c >> 5)) * 512 + ((kk & 7) * 32 + (c & 31)) * 2; }
__device__ __forceinline__ int v_rd_base(int lane) { return ((lane & 3) << 3) | (((lane >> 2) & 3) << 6) | (((lane >> 4) & 1) << 5) | (((lane >> 5) & 1) << 8); }
constexpr int v_rd_off(int d0, int ks, int half) { return d0 * 512 + ks * 4096 + half * 2048; }
template <int OFF> __device__ __forceinline__ s16x4 tr_read(int vb) {
    s16x4 r; asm volatile("ds_read_b64_tr_b16 %0, %1 offset:%2" : "=&v"(r) : "v"(vb), "i"(OFF) : "memory"); return r;
}
template <int D0> __device__ __forceinline__ void pv_one(f32x16& od, int vb, bf16x8 pa0, bf16x8 pa1, bf16x8 pa2, bf16x8 pa3) {
    const s16x4 l0 = tr_read<v_rd_off(D0, 0, 0)>(vb), h0 = tr_read<v_rd_off(D0, 0, 1)>(vb), l1 = tr_read<v_rd_off(D0, 1, 0)>(vb), h1 = tr_read<v_rd_off(D0, 1, 1)>(vb);
    const s16x4 l2 = tr_read<v_rd_off(D0, 2, 0)>(vb), h2 = tr_read<v_rd_off(D0, 2, 1)>(vb), l3 = tr_read<v_rd_off(D0, 3, 0)>(vb), h3 = tr_read<v_rd_off(D0, 3, 1)>(vb);
    asm volatile("s_waitcnt lgkmcnt(0)" ::: "memory"); SBAR();
#define PK(Lo, Hi) (bf16x8){Lo[0], Lo[1], Lo[2], Lo[3], Hi[0], Hi[1], Hi[2], Hi[3]}
    od = __builtin_amdgcn_mfma_f32_32x32x16_bf16(pa0, PK(l0, h0), od, 0, 0, 0);
    od = __builtin_amdgcn_mfma_f32_32x32x16_bf16(pa1, PK(l1, h1), od, 0, 0, 0);
    od = __builtin_amdgcn_mfma_f32_32x32x16_bf16(pa2, PK(l2, h2), od, 0, 0, 0);
    od = __builtin_amdgcn_mfma_f32_32x32x16_bf16(pa3, PK(l3, h3), od, 0, 0, 0);
#undef PK
}
__device__ __forceinline__ void pv_d0(f32x16* o, int vb, bf16x8 pa0, bf16x8 pa1, bf16x8 pa2, bf16x8 pa3) {
    pv_one<0>(o[0], vb, pa0, pa1, pa2, pa3); pv_one<1>(o[1], vb, pa0, pa1, pa2, pa3); pv_one<2>(o[2], vb, pa0, pa1, pa2, pa3); pv_one<3>(o[3], vb, pa0, pa1, pa2, pa3);
}
__device__ __forceinline__ void mask_tile(f32x16& p0, f32x16& p1, int j, int lim) {
    if (j > lim) {
#pragma unroll
        for (int r = 0; r < 16; ++r) { p0[r] = -1e30f; p1[r] = -1e30f; }
    } else if (j == 0) {
#pragma unroll
        for (int r = 0; r < 16; ++r) p0[r] = -1e30f;
#pragma unroll
        for (int r = 0; r < 8; ++r) p1[r] = -1e30f;
    }
}
__device__ __forceinline__ void unit(const bf16_t* __restrict__ Qb, const bf16_t* __restrict__ Kh, const bf16_t* __restrict__ Vh, bf16_t* __restrict__ Ob, int NT, int lim, char* lds) {
    int tid_ = threadIdx.x; asm volatile("" : "+v"(tid_));
    const int tid = tid_, wid = tid >> 6, lane = tid & 63, r32 = lane & 31, hi = lane >> 5;
    char* V_lds = lds; char* K_lds = lds + 2 * SHM_V;
    float* wsf = (float*)(lds + 2 * SHM_V + 2 * SHM_K) + wid * 64; float* li_l = wsf; float* al_l = wsf + 32;
    float m_reg = -1e30f, l_reg = 0; f32x16 o[4] = {}; bf16x8 qr[8];
    const bf16_t* Qw = Qb + (long)(wid * QBLK + r32) * LDQ + hi * 8;
#pragma unroll
    for (int d0 = 0; d0 < 8; ++d0) qr[d0] = *reinterpret_cast<const bf16x8*>(Qw + d0 * 16);
    const int sr = tid >> 4, sc = (tid & 15) * 8, vst0 = v_st(sr, sc), vst1 = v_st(32 + sr, sc);
    const int vb0 = (int)(uintptr_t)V_lds + v_rd_base(lane);
    struct { bf16x8 vs0, vs1, ks0, ks1; } sr_[2];
#define SLOAD(i, k0) do { sr_[i].vs0 = *reinterpret_cast<const bf16x8*>(&Vh[(long)((k0) + sr) * LDQ + sc]); sr_[i].vs1 = *reinterpret_cast<const bf16x8*>(&Vh[(long)((k0) + 32 + sr) * LDQ + sc]); \
    sr_[i].ks0 = *reinterpret_cast<const bf16x8*>(&Kh[(long)((k0) + sr) * LDQ + sc]); sr_[i].ks1 = *reinterpret_cast<const bf16x8*>(&Kh[(long)((k0) + 32 + sr) * LDQ + sc]); } while (0)
#define SWRITE(b, i) do { *(bf16x8*)(V_lds + (b) * SHM_V + vst0) = sr_[i].vs0;          \
    *(bf16x8*)(V_lds + (b) * SHM_V + vst1) = sr_[i].vs1; int kc = sc * 2;               \
    *(bf16x8*)(K_lds + (b) * SHM_K + KSWZ(sr, kc)) = sr_[i].ks0;                       \
    *(bf16x8*)(K_lds + (b) * SHM_K + KSWZ(32 + sr, kc)) = sr_[i].ks1; } while (0)
#define SWAIT() asm volatile("s_waitcnt vmcnt(4)" ::: "memory")
#define RESC(a) do { if (__any((a) < 1.f)) { if (hi == 0) al_l[r32] = (a); asm volatile("s_waitcnt lgkmcnt(0)" ::: "memory"); \
    _Pragma("unroll") for (int d = 0; d < 4; ++d) _Pragma("unroll") for (int r = 0; r < 16; ++r) o[d][r] *= al_l[crow(r, hi)]; } } while (0)
    f32x16 pA0, pA1, pB0, pB1; float mnA, mnB, alA, alB; bf16x8 pa0, pa1, pa2, pa3;
    constexpr int SE = 0, SO = 1;
    SLOAD(SE, 0); asm volatile("s_waitcnt vmcnt(0)" ::: "memory"); SWRITE(0, SE); __syncthreads();
    qkt(pA0, pA1, K_lds, qr, r32, hi); mask_tile(pA0, pA1, 0, lim); partialSM(pA0, pA1, m_reg, mnA, alA);
    SLOAD(SO, KVBLK); if (2 < NT) SLOAD(SE, 2 * KVBLK);
    SWAIT(); SWRITE(1, SO); __syncthreads();
    for (int j = 1; j + 1 < NT; j += 2) {
        SBAR(); qkt(pB0, pB1, K_lds + SHM_K, qr, r32, hi);
        finishSM(pA0, pA1, alA, l_reg, pa0, pa1, pa2, pa3); SBAR();
        SLOAD(SO, (j + 2) * KVBLK); SBAR();
        pv_d0(o, vb0, pa0, pa1, pa2, pa3); mask_tile(pB0, pB1, j, lim); partialSM(pB0, pB1, m_reg, mnB, alB);
        __syncthreads(); SWAIT(); SWRITE(0, SE);
        RESC(alB); __syncthreads();
        SBAR(); qkt(pA0, pA1, K_lds, qr, r32, hi);
        finishSM(pB0, pB1, alB, l_reg, pa0, pa1, pa2, pa3); SBAR();
        if (j + 3 < NT) SLOAD(SE, (j + 3) * KVBLK); SBAR();
        pv_d0(o, vb0 + SHM_V, pa0, pa1, pa2, pa3); mask_tile(pA0, pA1, j + 1, lim); partialSM(pA0, pA1, m_reg, mnA, alA);
        __syncthreads(); SWAIT(); SWRITE(1, SO);
        RESC(alA); __syncthreads();
    }
    SBAR(); qkt(pB0, pB1, K_lds + SHM_K, qr, r32, hi);
    finishSM(pA0, pA1, alA, l_reg, pa0, pa1, pa2, pa3); SBAR();
    pv_d0(o, vb0, pa0, pa1, pa2, pa3); mask_tile(pB0, pB1, NT - 1, lim); partialSM(pB0, pB1, m_reg, mnB, alB);
    __syncthreads(); RESC(alB);
    finishSM(pB0, pB1, alB, l_reg, pa0, pa1, pa2, pa3); SBAR();
    pv_d0(o, vb0 + SHM_V, pa0, pa1, pa2, pa3);
    if (hi == 0) li_l[r32] = l_reg; asm volatile("s_waitcnt lgkmcnt(0)" ::: "memory");
    float rli[16];
#pragma unroll
    for (int r = 0; r < 16; ++r) rli[r] = __builtin_amdgcn_rcpf(li_l[crow(r, hi)]);
    bf16_t* Ow = Ob + (long)(wid * QBLK) * LDO;
#pragma unroll
    for (int r = 0; r < 16; ++r) { const int orow = crow(r, hi);
#pragma unroll
        for (int d0 = 0; d0 < 4; ++d0) Ow[(long)orow * LDO + d0 * 32 + r32] = f2bf(o[d0][r] * rli[r]); }
    __syncthreads();
#undef SLOAD
#undef SWRITE
#undef SWAIT
#undef RESC
}
}


#ifndef MK_HB
#define MK_HB(w) ((w) >> 2)
#endif
namespace att2 {
using namespace att;
constexpr int KB = 16384, VB = 32768, OFF_V = 3 * KB, OFF_W = OFF_V + 3 * VB, SHM2 = OFF_W + NW * 64 * 4;
constexpr int v2_rd_off(int d0, int ks, int half) { return d0 * 512 + ks * 8192 + half * 4096; }
template <int D0> __device__ __forceinline__ void pv2_one(f32x16& od, int vb, bf16x8 pa0, bf16x8 pa1, bf16x8 pa2, bf16x8 pa3) {
    const s16x4 l0 = tr_read<v2_rd_off(D0, 0, 0)>(vb), h0 = tr_read<v2_rd_off(D0, 0, 1)>(vb), l1 = tr_read<v2_rd_off(D0, 1, 0)>(vb), h1 = tr_read<v2_rd_off(D0, 1, 1)>(vb);
    const s16x4 l2 = tr_read<v2_rd_off(D0, 2, 0)>(vb), h2 = tr_read<v2_rd_off(D0, 2, 1)>(vb), l3 = tr_read<v2_rd_off(D0, 3, 0)>(vb), h3 = tr_read<v2_rd_off(D0, 3, 1)>(vb);
    asm volatile("s_waitcnt lgkmcnt(0)" ::: "memory"); SBAR();
#define PK(Lo, Hi) (bf16x8){Lo[0], Lo[1], Lo[2], Lo[3], Hi[0], Hi[1], Hi[2], Hi[3]}
    od = __builtin_amdgcn_mfma_f32_32x32x16_bf16(pa0, PK(l0, h0), od, 0, 0, 0);
    od = __builtin_amdgcn_mfma_f32_32x32x16_bf16(pa1, PK(l1, h1), od, 0, 0, 0);
    od = __builtin_amdgcn_mfma_f32_32x32x16_bf16(pa2, PK(l2, h2), od, 0, 0, 0);
    od = __builtin_amdgcn_mfma_f32_32x32x16_bf16(pa3, PK(l3, h3), od, 0, 0, 0);
#undef PK
}
struct VFrag { s16x4 l0, h0, l1, h1, l2, h2, l3, h3; };
template <int D0> __device__ __forceinline__ void v2_load(VFrag& f, int vb) {
    f.l0 = tr_read<v2_rd_off(D0, 0, 0)>(vb); f.h0 = tr_read<v2_rd_off(D0, 0, 1)>(vb); f.l1 = tr_read<v2_rd_off(D0, 1, 0)>(vb); f.h1 = tr_read<v2_rd_off(D0, 1, 1)>(vb);
    f.l2 = tr_read<v2_rd_off(D0, 2, 0)>(vb); f.h2 = tr_read<v2_rd_off(D0, 2, 1)>(vb); f.l3 = tr_read<v2_rd_off(D0, 3, 0)>(vb); f.h3 = tr_read<v2_rd_off(D0, 3, 1)>(vb);
}
__device__ __forceinline__ void v2_mma(f32x16& od, const VFrag& f, bf16x8 pa0, bf16x8 pa1, bf16x8 pa2, bf16x8 pa3) {
#define PK(Lo, Hi) (bf16x8){Lo[0], Lo[1], Lo[2], Lo[3], Hi[0], Hi[1], Hi[2], Hi[3]}
    od = __builtin_amdgcn_mfma_f32_32x32x16_bf16(pa0, PK(f.l0, f.h0), od, 0, 0, 0);
    od = __builtin_amdgcn_mfma_f32_32x32x16_bf16(pa1, PK(f.l1, f.h1), od, 0, 0, 0);
    od = __builtin_amdgcn_mfma_f32_32x32x16_bf16(pa2, PK(f.l2, f.h2), od, 0, 0, 0);
    od = __builtin_amdgcn_mfma_f32_32x32x16_bf16(pa3, PK(f.l3, f.h3), od, 0, 0, 0);
#undef PK
}
struct VSet { s16x4 l0, h0, l1, h1, l2, h2, l3, h3; };
template <int G, int KS> __device__ __forceinline__ void vs_load(VSet& f, int vb) {
    f.l0 = tr_read<v2_rd_off(4 * G + 0, KS, 0)>(vb); f.h0 = tr_read<v2_rd_off(4 * G + 0, KS, 1)>(vb); f.l1 = tr_read<v2_rd_off(4 * G + 1, KS, 0)>(vb); f.h1 = tr_read<v2_rd_off(4 * G + 1, KS, 1)>(vb);
    f.l2 = tr_read<v2_rd_off(4 * G + 2, KS, 0)>(vb); f.h2 = tr_read<v2_rd_off(4 * G + 2, KS, 1)>(vb); f.l3 = tr_read<v2_rd_off(4 * G + 3, KS, 0)>(vb); f.h3 = tr_read<v2_rd_off(4 * G + 3, KS, 1)>(vb);
}
template <int G> __device__ __forceinline__ void vs_mma(f32x16* o, const VSet& f, bf16x8 pa) {
#define PK(Lo, Hi) (bf16x8){Lo[0], Lo[1], Lo[2], Lo[3], Hi[0], Hi[1], Hi[2], Hi[3]}
    o[4 * G + 0] = __builtin_amdgcn_mfma_f32_32x32x16_bf16(pa, PK(f.l0, f.h0), o[4 * G + 0], 0, 0, 0);
    o[4 * G + 1] = __builtin_amdgcn_mfma_f32_32x32x16_bf16(pa, PK(f.l1, f.h1), o[4 * G + 1], 0, 0, 0);
    o[4 * G + 2] = __builtin_amdgcn_mfma_f32_32x32x16_bf16(pa, PK(f.l2, f.h2), o[4 * G + 2], 0, 0, 0);
    o[4 * G + 3] = __builtin_amdgcn_mfma_f32_32x32x16_bf16(pa, PK(f.l3, f.h3), o[4 * G + 3], 0, 0, 0);
#undef PK
}
__device__ __forceinline__ void pv2_all(f32x16* o, int vb, bf16x8 pa0, bf16x8 pa1, bf16x8 pa2, bf16x8 pa3) {
    VSet A, B;
#define W8() do { asm volatile("s_waitcnt lgkmcnt(8)" ::: "memory"); SBAR(); } while (0)
    PRIO_HI();
    vs_load<0, 0>(A, vb);
    vs_load<0, 1>(B, vb); W8(); vs_mma<0>(o, A, pa0); SBAR();
    vs_load<0, 2>(A, vb); W8(); vs_mma<0>(o, B, pa1); SBAR();
    vs_load<0, 3>(B, vb); W8(); vs_mma<0>(o, A, pa2); SBAR();
    vs_load<1, 0>(A, vb); W8(); vs_mma<0>(o, B, pa3); SBAR();
    vs_load<1, 1>(B, vb); W8(); vs_mma<1>(o, A, pa0); SBAR();
    vs_load<1, 2>(A, vb); W8(); vs_mma<1>(o, B, pa1); SBAR();
    vs_load<1, 3>(B, vb); W8(); vs_mma<1>(o, A, pa2); SBAR();
    asm volatile("s_waitcnt lgkmcnt(0)" ::: "memory"); SBAR(); vs_mma<1>(o, B, pa3); SBAR();
    PRIO_LO();
#undef W8
}
__device__ __forceinline__ void unit2(const bf16_t* __restrict__ Qb, const bf16_t* __restrict__ Kh, const bf16_t* __restrict__ Vh, bf16_t* __restrict__ Ob, int NT, int lim, unsigned char* ldsg, LAS unsigned char* lds, int rev = 0) {
#define TILE(s_) (rev ? NT - 1 - (s_) : (s_))
    int tid_ = threadIdx.x; asm volatile("" : "+v"(tid_));
    const int tid = tid_, wid = __builtin_amdgcn_readfirstlane(tid >> 6), lane = tid & 63, r32 = lane & 31, hi = lane >> 5;
    LAS float* wsf = (LAS float*)(lds + OFF_W) + wid * 64; LAS float* li_l = wsf; LAS float* al_l = wsf + 32;
    float m_reg = -1e30f, l_reg = 0; f32x16 o[8] = {}; bf16x8 qr[8];
    const bf16_t* Qw = Qb + (long)(wid * QBLK + r32) * LDQ + hi * 8;
#pragma unroll
    for (int d0 = 0; d0 < 8; ++d0) qr[d0] = *reinterpret_cast<const bf16x8*>(Qw + d0 * 16);
    const int vb0 = (int)(uintptr_t)(ldsg + OFF_V) + v_rd_base(lane);
    unsigned ko0, vo0;
    { const int row = wid * 4 + (lane >> 4); ko0 = (unsigned)(row * LDQ * 2 + (((lane & 15) * 16) ^ ((row & MK_KSWM) << 4)));
      const int st = wid * 2 + (lane >> 5), q = lane & 31; const int kk = (st >> 3) * 8 + (q >> 2); const int k = (kk & ~0xC) | ((kk & 4) << 1) | ((kk & 8) >> 1);
      vo0 = (unsigned)(k * LDQ * 2 + ((st & 7) * 32 + (q & 3) * 8) * 2); }
#define DMA_K(t_, b_) do { const char* gk = (const char*)Kh + (size_t)(t_) * (KVBLK * LDQ * 2); _Pragma("unroll") for (int i = 0; i < 2; ++i) { \
        __builtin_amdgcn_global_load_lds((const unsigned*)(gk + (size_t)i * (32 * LDQ * 2) + ko0), (LAS unsigned*)(lds + (b_) * KB + wid * 1024 + i * 8192), 16, 0, 0); } } while (0)
#define DMA_V(t_, b_) do { const char* gv = (const char*)Vh + (size_t)(t_) * (KVBLK * LDQ * 2); _Pragma("unroll") for (int i = 0; i < 4; ++i) { \
        __builtin_amdgcn_global_load_lds((const unsigned*)(gv + (size_t)i * (16 * LDQ * 2) + vo0), (LAS unsigned*)(lds + OFF_V + (b_) * VB + wid * 1024 + i * 8192), 16, 0, 0); } } while (0)
    DMA_K(TILE(0), 0); DMA_V(TILE(0), 0); if (1 < NT) { DMA_K(TILE(1), 1); DMA_V(TILE(1), 1); }
    asm volatile("s_waitcnt vmcnt(0)" ::: "memory"); __builtin_amdgcn_s_barrier(); asm volatile("" ::: "memory");
    int kb = 0;
    for (int j = 0; j < NT; ++j) {
        const int kb2 = kb == 0 ? 2 : kb - 1;
        const int tl = TILE(j);
        if (j + 2 < NT) DMA_V(TILE(j + 2), kb2);
        asm volatile("" ::: "memory");
        if (j + 2 < NT) DMA_K(TILE(j + 2), kb2);
        asm volatile("" ::: "memory");
        if (tl <= lim) {
        f32x16 p0, p1; float mn, alpha; bf16x8 pa0, pa1, pa2, pa3;
        qkt(p0, p1, (const char*)ldsg + kb * KB, qr, r32, hi);
#if MK_PROBE_QK2
        asm volatile("" : "+v"(p0), "+v"(p1)); qkt(p0, p1, (const char*)ldsg + kb * KB, qr, r32, hi);
#endif
        if (tl == 0) {
            asm volatile("; tile-0 mask" ::: "memory");
#pragma unroll
            for (int r = 0; r < 16; ++r) p0[r] = -1e30f;
#pragma unroll
            for (int r = 0; r < 8; ++r) p1[r] = -1e30f;
        }
        partialSM(p0, p1, m_reg, mn, alpha);
        if (__any(alpha < 1.f)) { if (hi == 0) al_l[r32] = alpha; asm volatile("s_waitcnt lgkmcnt(0)" ::: "memory");
#pragma unroll
            for (int d = 0; d < 8; ++d)
#pragma unroll
                for (int r = 0; r < 16; ++r) o[d][r] *= al_l[crow(r, hi)]; }
        finishSM(p0, p1, alpha, l_reg, pa0, pa1, pa2, pa3); SBAR();
        const int vb = vb0 + kb * VB;
        pv2_all(o, vb, pa0, pa1, pa2, pa3);
        }
        if (j + 2 < NT) asm volatile("s_waitcnt vmcnt(6)" ::: "memory"); else asm volatile("s_waitcnt vmcnt(0)" ::: "memory");
        __builtin_amdgcn_s_barrier(); asm volatile("" ::: "memory");
        kb = kb == 2 ? 0 : kb + 1;
    }
    if (hi == 0) li_l[r32] = l_reg; asm volatile("s_waitcnt lgkmcnt(0)" ::: "memory");
    float rli[16];
#pragma unroll
    for (int r = 0; r < 16; ++r) rli[r] = __builtin_amdgcn_rcpf(li_l[crow(r, hi)]);
    bf16_t* Ow = Ob + (long)(wid * QBLK) * LDO;
#pragma unroll
    for (int r = 0; r < 16; ++r) { const int orow = crow(r, hi);
#pragma unroll
        for (int d0 = 0; d0 < 8; ++d0) Ow[(long)orow * LDO + d0 * 32 + r32] = f2bf(o[d0][r] * rli[r]); }
    asm volatile("s_waitcnt lgkmcnt(0)" ::: "memory"); __builtin_amdgcn_s_barrier(); asm volatile("" ::: "memory");
#undef DMA_K
#undef DMA_V
#undef TILE
}

__device__ __forceinline__ void unit3(const bf16_t* __restrict__ Qb, const bf16_t* __restrict__ Kh, const bf16_t* __restrict__ Vh, bf16_t* __restrict__ Ob, int NT, int lim, unsigned char* ldsg, LAS unsigned char* lds) {
    int tid_ = threadIdx.x; asm volatile("" : "+v"(tid_));
    const int tid = tid_, wid = __builtin_amdgcn_readfirstlane(tid >> 6), lane = tid & 63, r32 = lane & 31, hi = lane >> 5, hb = MK_HB(wid);
    LAS float* wsf = (LAS float*)(lds + OFF_W) + wid * 64; LAS float* li_l = wsf; LAS float* al_l = wsf + 32;
    float m_reg = -1e30f, l_reg = 0; f32x16 o[8] = {}; bf16x8 qr[8];
    const bf16_t* Qw = Qb + (long)(wid * QBLK + r32) * LDQ + hi * 8;
#pragma unroll
    for (int d0 = 0; d0 < 8; ++d0) qr[d0] = *reinterpret_cast<const bf16x8*>(Qw + d0 * 16);
#define DMA_K(t_, b_) do { const char* gk = (const char*)Kh + (size_t)(t_) * (KVBLK * LDQ * 2); int ln_ = lane; asm volatile("" : "+v"(ln_)); _Pragma("unroll") for (int i = 0; i < 2; ++i) { \
        const int row = wid * 4 + i * 32 + (ln_ >> 4); const unsigned ko = (unsigned)(row * LDQ * 2 + (((ln_ & 15) * 16) ^ ((row & MK_KSWM) << 4))); \
        __builtin_amdgcn_global_load_lds((const unsigned*)(gk + ko), (LAS unsigned*)(lds + (b_) * KB + wid * 1024 + i * 8192), 16, 0, 0); } } while (0)
#define DMA_V(t_, b_) do { const char* gv = (const char*)Vh + (size_t)(t_) * (KVBLK * LDQ * 2); int ln_ = lane; asm volatile("" : "+v"(ln_)); _Pragma("unroll") for (int i = 0; i < 4; ++i) { \
        const int st = wid * 2 + i * 16 + (ln_ >> 5), q = ln_ & 31; const int kk = (st >> 3) * 8 + (q >> 2); const int k = (kk & ~0xC) | ((kk & 4) << 1) | ((kk & 8) >> 1); \
        const unsigned vo = (unsigned)(k * LDQ * 2 + ((st & 7) * 32 + (q & 3) * 8) * 2); \
        __builtin_amdgcn_global_load_lds((const unsigned*)(gv + vo), (LAS unsigned*)(lds + OFF_V + (b_) * VB + wid * 1024 + i * 8192), 16, 0, 0); } } while (0)
    DMA_K(0, 0); DMA_V(0, 0); if (1 < NT) { DMA_K(1, 1); DMA_V(1, 1); }
    asm volatile("s_waitcnt vmcnt(0)" ::: "memory"); __builtin_amdgcn_s_barrier(); asm volatile("" ::: "memory");
    bf16x8 pa0, pa1, pa2, pa3;
    int kq = 0, ki = 2;
    int vq = 0, vi = 2;
#define U3_QS(j_) do { f32x16 p0, p1; float mn, alpha; int lq_ = lane; asm volatile("" : "+v"(lq_)); const int r32 = lq_ & 31, hi = lq_ >> 5; \
        qkt(p0, p1, (const char*)ldsg + kq * KB, qr, r32, hi); kq = kq == 2 ? 0 : kq + 1; \
        mask_tile(p0, p1, (j_), lim); \
        partialSM(p0, p1, m_reg, mn, alpha); \
        if (__any(alpha < 1.f)) { if (hi == 0) al_l[r32] = alpha; asm volatile("s_waitcnt lgkmcnt(0)" ::: "memory"); \
            _Pragma("unroll") for (int d = 0; d < 8; ++d) _Pragma("unroll") for (int r = 0; r < 16; ++r) o[d][r] *= al_l[crow(r, hi)]; } \
        finishSM(p0, p1, alpha, l_reg, pa0, pa1, pa2, pa3); } while (0)
#define U3_PV(j_) do { int lp_ = lane; asm volatile("" : "+v"(lp_)); const int vb = (int)(uintptr_t)(ldsg + OFF_V) + v_rd_base(lp_) + vq * VB; vq = vq == 2 ? 0 : vq + 1; \
        pv2_one<0>(o[0], vb, pa0, pa1, pa2, pa3); pv2_one<1>(o[1], vb, pa0, pa1, pa2, pa3); pv2_one<2>(o[2], vb, pa0, pa1, pa2, pa3); pv2_one<3>(o[3], vb, pa0, pa1, pa2, pa3); \
        pv2_one<4>(o[4], vb, pa0, pa1, pa2, pa3); pv2_one<5>(o[5], vb, pa0, pa1, pa2, pa3); pv2_one<6>(o[6], vb, pa0, pa1, pa2, pa3); pv2_one<7>(o[7], vb, pa0, pa1, pa2, pa3); } while (0)
#define U3_EVEN_ISSUE(jj_) do { if ((jj_) + 2 < NT) DMA_K((jj_) + 2, ki); ki = ki == 2 ? 0 : ki + 1; asm volatile("" ::: "memory"); } while (0)
#define U3_ODD_ISSUE(jj_) do { if ((jj_) + 2 < NT) DMA_V((jj_) + 2, vi); vi = vi == 2 ? 0 : vi + 1; asm volatile("" ::: "memory"); } while (0)
#define U3_EVEN_END(jj_) do { if ((jj_) + 2 < NT) asm volatile("s_waitcnt vmcnt(6)" ::: "memory"); else if ((jj_) + 1 < NT) asm volatile("s_waitcnt vmcnt(4)" ::: "memory"); else asm volatile("s_waitcnt vmcnt(0)" ::: "memory");   \
        asm volatile("s_waitcnt lgkmcnt(0)" ::: "memory"); __builtin_amdgcn_s_barrier(); asm volatile("" ::: "memory"); } while (0)
#define U3_ODD_END() do { asm volatile("s_waitcnt lgkmcnt(0)" ::: "memory"); __builtin_amdgcn_s_barrier(); asm volatile("" ::: "memory"); } while (0)
    if (hb == 0) {
#pragma unroll 1
        for (int jj = 0; jj < NT; ++jj) {
            U3_EVEN_ISSUE(jj); U3_QS(jj); U3_EVEN_END(jj);
            U3_ODD_ISSUE(jj); U3_PV(jj); U3_ODD_END();
        }
        U3_EVEN_ISSUE(NT); U3_EVEN_END(NT);
    } else {
        U3_EVEN_ISSUE(0); U3_EVEN_END(0);
#pragma unroll 1
        for (int jj = 0; jj < NT; ++jj) {
            U3_ODD_ISSUE(jj); U3_QS(jj); U3_ODD_END();
            U3_EVEN_ISSUE(jj + 1); U3_PV(jj); U3_EVEN_END(jj + 1);
        }
    }
#undef U3_QS
#undef U3_PV
#undef U3_EVEN_ISSUE
#undef U3_ODD_ISSUE
#undef U3_EVEN_END
#undef U3_ODD_END
    if (hi == 0) li_l[r32] = l_reg; asm volatile("s_waitcnt lgkmcnt(0)" ::: "memory");
    float rli[16];
#pragma unroll
    for (int r = 0; r < 16; ++r) rli[r] = __builtin_amdgcn_rcpf(li_l[crow(r, hi)]);
    bf16_t* Ow = Ob + (long)(wid * QBLK) * LDO;
#pragma unroll
    for (int r = 0; r < 16; ++r) { const int orow = crow(r, hi);
#pragma unroll
        for (int d0 = 0; d0 < 8; ++d0) Ow[(long)orow * LDO + d0 * 32 + r32] = f2bf(o[d0][r] * rli[r]); }
    asm volatile("s_waitcnt vmcnt(0) lgkmcnt(0)" ::: "memory"); __builtin_amdgcn_s_barrier(); asm volatile("" ::: "memory");
#undef DMA_K
#undef DMA_V
}

__device__ __forceinline__ void unit4(const bf16_t* __restrict__ Qb, const bf16_t* __restrict__ Kh, const bf16_t* __restrict__ Vh, bf16_t* __restrict__ Ob, int NT, int lim, unsigned char* ldsg, LAS unsigned char* lds) {
    int tid_ = threadIdx.x; asm volatile("" : "+v"(tid_));
    const int tid = tid_, wid = __builtin_amdgcn_readfirstlane(tid >> 6), lane = tid & 63, hb = MK_HB(wid);
    LAS float* wsf = (LAS float*)(lds + OFF_W) + wid * 64; LAS float* li_l = wsf; LAS float* al_l = wsf + 32;
    float m_reg = -1e30f, l_reg = 0; f32x16 o[8] = {}; bf16x8 qr[8];
    { const int r32 = lane & 31, hi = lane >> 5; const bf16_t* Qw = Qb + (long)(wid * QBLK + r32) * LDQ + hi * 8;
#pragma unroll
      for (int d0 = 0; d0 < 8; ++d0) qr[d0] = *reinterpret_cast<const bf16x8*>(Qw + d0 * 16); }
#define DMA_K(t_, b_) do { const char* gk = (const char*)Kh + (size_t)(t_) * (KVBLK * LDQ * 2); int ln_ = lane; asm volatile("" : "+v"(ln_)); _Pragma("unroll") for (int i = 0; i < 2; ++i) { \
        const int row = wid * 4 + i * 32 + (ln_ >> 4); const unsigned ko = (unsigned)(row * LDQ * 2 + (((ln_ & 15) * 16) ^ ((row & MK_KSWM) << 4))); \
        __builtin_amdgcn_global_load_lds((const unsigned*)(gk + ko), (LAS unsigned*)(lds + (b_) * KB + wid * 1024 + i * 8192), 16, 0, 0); } } while (0)
#define DMA_V(t_, b_) do { const char* gv = (const char*)Vh + (size_t)(t_) * (KVBLK * LDQ * 2); int ln_ = lane; asm volatile("" : "+v"(ln_)); _Pragma("unroll") for (int i = 0; i < 4; ++i) { \
        const int st = wid * 2 + i * 16 + (ln_ >> 5), q = ln_ & 31; const int kk = (st >> 3) * 8 + (q >> 2); const int k = (kk & ~0xC) | ((kk & 4) << 1) | ((kk & 8) >> 1); \
        const unsigned vo = (unsigned)(k * LDQ * 2 + ((st & 7) * 32 + (q & 3) * 8) * 2); \
        __builtin_amdgcn_global_load_lds((const unsigned*)(gv + vo), (LAS unsigned*)(lds + OFF_V + (b_) * VB + wid * 1024 + i * 8192), 16, 0, 0); } } while (0)
    DMA_K(0, 0); DMA_V(0, 0); if (1 < NT) { DMA_K(1, 1); DMA_V(1, 1); } if (2 < NT) DMA_K(2, 2);
    asm volatile("s_waitcnt vmcnt(0)" ::: "memory"); __builtin_amdgcn_s_barrier(); asm volatile("" ::: "memory");
    f32x16 p0, p1; bf16x8 pa0, pa1, pa2, pa3;
    int kq = 0, ki = 0, vq = 0, vi = 2;
#define U4_QK() do { int lq_ = lane; asm volatile("" : "+v"(lq_)); qkt(p0, p1, (const char*)ldsg + kq * KB, qr, lq_ & 31, lq_ >> 5); kq = kq == 2 ? 0 : kq + 1; } while (0)
#define U4_SM(j_) do { float mn, alpha; int lq_ = lane; asm volatile("" : "+v"(lq_)); const int r32 = lq_ & 31, hi = lq_ >> 5; \
        mask_tile(p0, p1, (j_), lim); \
        partialSM(p0, p1, m_reg, mn, alpha); \
        if (__any(alpha < 1.f)) { if (hi == 0) al_l[r32] = alpha; asm volatile("s_waitcnt lgkmcnt(0)" ::: "memory"); \
            _Pragma("unroll") for (int d = 0; d < 8; ++d) _Pragma("unroll") for (int r = 0; r < 16; ++r) o[d][r] *= al_l[crow(r, hi)]; } \
        finishSM(p0, p1, alpha, l_reg, pa0, pa1, pa2, pa3); } while (0)
#define U4_PV() do { int lp_ = lane; asm volatile("" : "+v"(lp_)); const int vb = (int)(uintptr_t)(ldsg + OFF_V) + v_rd_base(lp_) + vq * VB; vq = vq == 2 ? 0 : vq + 1; \
        pv2_all(o, vb, pa0, pa1, pa2, pa3); } while (0)
#define U4_ISSUE(s_) do { if (((s_) & 1) == 0) { if ((s_) >= 2) { if ((s_) / 2 + 2 < NT) DMA_K((s_) / 2 + 2, ki); ki = ki == 2 ? 0 : ki + 1; } } \
        else { if ((s_) >= 3) { if (((s_) + 1) / 2 < NT) DMA_V(((s_) + 1) / 2, vi); vi = vi == 2 ? 0 : vi + 1; } } asm volatile("" ::: "memory"); } while (0)
#define U4_END(s_) do { if ((s_) & 1) { const int kt = ((s_) + 1) / 2 + 1, vt = ((s_) + 1) / 2;     \
            if ((s_) >= 3 && kt < NT && vt < NT) asm volatile("s_waitcnt vmcnt(6)" ::: "memory"); \
            else if ((s_) >= 3 && vt < NT) asm volatile("s_waitcnt vmcnt(4)" ::: "memory"); \
            else asm volatile("s_waitcnt vmcnt(0)" ::: "memory"); } \
        asm volatile("s_waitcnt lgkmcnt(0)" ::: "memory"); __builtin_amdgcn_s_barrier(); asm volatile("" ::: "memory"); } while (0)
    if (hb == 0) {
        U4_ISSUE(0); U4_QK(); U4_END(0);
#pragma unroll 1
        for (int m = 0; m < NT; ++m) {
            U4_ISSUE(2 * m + 1); U4_SM(m); U4_END(2 * m + 1);
            U4_ISSUE(2 * m + 2); U4_PV(); if (m + 1 < NT) U4_QK(); U4_END(2 * m + 2);
        }
        U4_ISSUE(2 * NT + 1); U4_END(2 * NT + 1);
    } else {
        U4_ISSUE(0); U4_END(0);
        U4_ISSUE(1); U4_QK(); U4_END(1);
#pragma unroll 1
        for (int m = 0; m < NT; ++m) {
            U4_ISSUE(2 * m + 2); U4_SM(m); U4_END(2 * m + 2);
            U4_ISSUE(2 * m + 3); U4_PV(); if (m + 1 < NT) U4_QK(); U4_END(2 * m + 3);
        }
    }
#undef U4_QK
#undef U4_SM
#undef U4_PV
#undef U4_ISSUE
#undef U4_END
    const int r32 = lane & 31, hi = lane >> 5;
    if (hi == 0) li_l[r32] = l_reg; asm volatile("s_waitcnt lgkmcnt(0)" ::: "memory");
    float rli[16];
#pragma unroll
    for (int r = 0; r < 16; ++r) rli[r] = __builtin_amdgcn_rcpf(li_l[crow(r, hi)]);
    bf16_t* Ow = Ob + (long)(wid * QBLK) * LDO;
#pragma unroll
    for (int r = 0; r < 16; ++r) { const int orow = crow(r, hi);
#pragma unroll
        for (int d0 = 0; d0 < 8; ++d0) Ow[(long)orow * LDO + d0 * 32 + r32] = f2bf(o[d0][r] * rli[r]); }
    asm volatile("s_waitcnt vmcnt(0) lgkmcnt(0)" ::: "memory"); __builtin_amdgcn_s_barrier(); asm volatile("" ::: "memory");
#undef DMA_K
#undef DMA_V
}

__device__ __forceinline__ void unit5(const bf16_t* __restrict__ Qb, const bf16_t* __restrict__ Kh, const bf16_t* __restrict__ Vh, bf16_t* __restrict__ Ob, int NT, int lim, unsigned char* ldsg, LAS unsigned char* lds) {
    int tid_ = threadIdx.x; asm volatile("" : "+v"(tid_));
    const int tid = tid_, wid = __builtin_amdgcn_readfirstlane(tid >> 6), lane = tid & 63, hb = MK_HB(wid);
    LAS float* wsf = (LAS float*)(lds + OFF_W) + wid * 64; LAS float* li_l = wsf; LAS float* al_l = wsf + 32;
    float m_reg = -1e30f, l_reg = 0; f32x16 o[8] = {}; bf16x8 qr[8];
    { const int r32 = lane & 31, hi = lane >> 5; const bf16_t* Qw = Qb + (long)(wid * QBLK + r32) * LDQ + hi * 8;
#pragma unroll
      for (int d0 = 0; d0 < 8; ++d0) qr[d0] = *reinterpret_cast<const bf16x8*>(Qw + d0 * 16); }
#define DMA_K(t_, b_) do { const char* gk = (const char*)Kh + (size_t)(t_) * (KVBLK * LDQ * 2); int ln_ = lane; asm volatile("" : "+v"(ln_)); _Pragma("unroll") for (int i = 0; i < 2; ++i) { \
        const int row = wid * 4 + i * 32 + (ln_ >> 4); const unsigned ko = (unsigned)(row * LDQ * 2 + (((ln_ & 15) * 16) ^ ((row & MK_KSWM) << 4))); \
        __builtin_amdgcn_global_load_lds((const unsigned*)(gk + ko), (LAS unsigned*)(lds + (b_) * KB + wid * 1024 + i * 8192), 16, 0, 0); } } while (0)
#define DMA_V(t_, b_) do { const char* gv = (const char*)Vh + (size_t)(t_) * (KVBLK * LDQ * 2); int ln_ = lane; asm volatile("" : "+v"(ln_)); _Pragma("unroll") for (int i = 0; i < 4; ++i) { \
        const int st = wid * 2 + i * 16 + (ln_ >> 5), q = ln_ & 31; const int kk = (st >> 3) * 8 + (q >> 2); const int k = (kk & ~0xC) | ((kk & 4) << 1) | ((kk & 8) >> 1); \
        const unsigned vo = (unsigned)(k * LDQ * 2 + ((st & 7) * 32 + (q & 3) * 8) * 2); \
        __builtin_amdgcn_global_load_lds((const unsigned*)(gv + vo), (LAS unsigned*)(lds + OFF_V + (b_) * VB + wid * 1024 + i * 8192), 16, 0, 0); } } while (0)
    DMA_K(0, 0); DMA_V(0, 0); if (1 < NT) DMA_K(1, 1);
    asm volatile("s_waitcnt vmcnt(0)" ::: "memory"); __builtin_amdgcn_s_barrier(); asm volatile("" ::: "memory");
    bf16x8 pa0, pa1, pa2, pa3;
    int kb = 0, kb1 = 1, kb2 = 2;
#define U5_ISSUE(j_) do { if ((j_) + 1 < NT) DMA_V((j_) + 1, kb1); asm volatile("" ::: "memory"); if ((j_) + 2 < NT) DMA_K((j_) + 2, kb2); asm volatile("" ::: "memory"); } while (0)
#define U5_QS(j_) do { f32x16 p0, p1; float mn, alpha; int lq_ = lane; asm volatile("" : "+v"(lq_)); const int r32 = lq_ & 31, hi = lq_ >> 5; \
        qkt(p0, p1, (const char*)ldsg + kb * KB, qr, r32, hi); \
        mask_tile(p0, p1, (j_), lim); \
        partialSM(p0, p1, m_reg, mn, alpha); \
        if (__any(alpha < 1.f)) { if (hi == 0) al_l[r32] = alpha; asm volatile("s_waitcnt lgkmcnt(0)" ::: "memory"); \
            _Pragma("unroll") for (int d = 0; d < 8; ++d) _Pragma("unroll") for (int r = 0; r < 16; ++r) o[d][r] *= al_l[crow(r, hi)]; } \
        finishSM(p0, p1, alpha, l_reg, pa0, pa1, pa2, pa3); } while (0)
#define U5_PV(vbuf_) do { int lp_ = lane; asm volatile("" : "+v"(lp_)); const int vb = (int)(uintptr_t)(ldsg + OFF_V) + v_rd_base(lp_) + (vbuf_) * VB; pv2_all(o, vb, pa0, pa1, pa2, pa3); } while (0)
#define U5_END(j_) do { if ((j_) + 2 < NT) asm volatile("s_waitcnt vmcnt(2)" ::: "memory"); else asm volatile("s_waitcnt vmcnt(0)" ::: "memory"); \
        asm volatile("s_waitcnt lgkmcnt(0)" ::: "memory"); __builtin_amdgcn_s_barrier(); asm volatile("" ::: "memory"); \
        { const int t_ = kb; kb = kb1; kb1 = kb2; kb2 = t_; } } while (0)
    if (hb == 0) {
#pragma unroll 1
        for (int j = 0; j < NT; ++j) { U5_ISSUE(j); U5_QS(j); U5_PV(kb); U5_END(j); }
    } else {
#pragma unroll 1
        for (int j = 0; j < NT; ++j) { U5_ISSUE(j); if (j > 0) U5_PV(kb2); U5_QS(j); U5_END(j); }
        U5_PV(kb2);
    }
#undef U5_ISSUE
#undef U5_QS
#undef U5_PV
#undef U5_END
    const int r32 = lane & 31, hi = lane >> 5;
    if (hi == 0) li_l[r32] = l_reg; asm volatile("s_waitcnt lgkmcnt(0)" ::: "memory");
    float rli[16];
#pragma unroll
    for (int r = 0; r < 16; ++r) rli[r] = __builtin_amdgcn_rcpf(li_l[crow(r, hi)]);
    bf16_t* Ow = Ob + (long)(wid * QBLK) * LDO;
#pragma unroll
    for (int r = 0; r < 16; ++r) { const int orow = crow(r, hi);
#pragma unroll
        for (int d0 = 0; d0 < 8; ++d0) Ow[(long)orow * LDO + d0 * 32 + r32] = f2bf(o[d0][r] * rli[r]); }
    asm volatile("s_waitcnt vmcnt(0) lgkmcnt(0)" ::: "memory"); __builtin_amdgcn_s_barrier(); asm volatile("" ::: "memory");
#undef DMA_K
#undef DMA_V
}

constexpr int v6_off(int c, int cb, int h) { return c * 16384 + h * 8192 + cb * 256; }
struct V6Set { s16x4 l0, h0, l1, h1, l2, h2, l3, h3; };
template <int C, int G> __device__ __forceinline__ void v6_load(V6Set& f, int vb) {
    f.l0 = tr_read<v6_off(C, 4 * G + 0, 0)>(vb); f.h0 = tr_read<v6_off(C, 4 * G + 0, 1)>(vb); f.l1 = tr_read<v6_off(C, 4 * G + 1, 0)>(vb); f.h1 = tr_read<v6_off(C, 4 * G + 1, 1)>(vb);
    f.l2 = tr_read<v6_off(C, 4 * G + 2, 0)>(vb); f.h2 = tr_read<v6_off(C, 4 * G + 2, 1)>(vb); f.l3 = tr_read<v6_off(C, 4 * G + 3, 0)>(vb); f.h3 = tr_read<v6_off(C, 4 * G + 3, 1)>(vb);
}
template <int G> __device__ __forceinline__ void v6_mma(f32x4 (&o)[2][16], const V6Set& f, bf16x8 pa0, bf16x8 pa1) {
#define PK(Lo, Hi) (bf16x8){Lo[0], Lo[1], Lo[2], Lo[3], Hi[0], Hi[1], Hi[2], Hi[3]}
    o[0][4 * G + 0] = __builtin_amdgcn_mfma_f32_16x16x32_bf16(pa0, PK(f.l0, f.h0), o[0][4 * G + 0], 0, 0, 0);
    o[1][4 * G + 0] = __builtin_amdgcn_mfma_f32_16x16x32_bf16(pa1, PK(f.l0, f.h0), o[1][4 * G + 0], 0, 0, 0);
    o[0][4 * G + 1] = __builtin_amdgcn_mfma_f32_16x16x32_bf16(pa0, PK(f.l1, f.h1), o[0][4 * G + 1], 0, 0, 0);
    o[1][4 * G + 1] = __builtin_amdgcn_mfma_f32_16x16x32_bf16(pa1, PK(f.l1, f.h1), o[1][4 * G + 1], 0, 0, 0);
    o[0][4 * G + 2] = __builtin_amdgcn_mfma_f32_16x16x32_bf16(pa0, PK(f.l2, f.h2), o[0][4 * G + 2], 0, 0, 0);
    o[1][4 * G + 2] = __builtin_amdgcn_mfma_f32_16x16x32_bf16(pa1, PK(f.l2, f.h2), o[1][4 * G + 2], 0, 0, 0);
    o[0][4 * G + 3] = __builtin_amdgcn_mfma_f32_16x16x32_bf16(pa0, PK(f.l3, f.h3), o[0][4 * G + 3], 0, 0, 0);
    o[1][4 * G + 3] = __builtin_amdgcn_mfma_f32_16x16x32_bf16(pa1, PK(f.l3, f.h3), o[1][4 * G + 3], 0, 0, 0);
#undef PK
}
__device__ __forceinline__ void pv6_all(f32x4 (&o)[2][16], int vb, bf16x8 pa00, bf16x8 pa01, bf16x8 pa10, bf16x8 pa11) {
    V6Set A, B;
#define W8() do { asm volatile("s_waitcnt lgkmcnt(8)" ::: "memory"); SBAR(); } while (0)
    v6_load<0, 0>(A, vb);
    v6_load<0, 1>(B, vb); W8(); v6_mma<0>(o, A, pa00, pa10); SBAR();
    v6_load<0, 2>(A, vb); W8(); v6_mma<1>(o, B, pa00, pa10); SBAR();
    v6_load<0, 3>(B, vb); W8(); v6_mma<2>(o, A, pa00, pa10); SBAR();
    v6_load<1, 0>(A, vb); W8(); v6_mma<3>(o, B, pa00, pa10); SBAR();
    v6_load<1, 1>(B, vb); W8(); v6_mma<0>(o, A, pa01, pa11); SBAR();
    v6_load<1, 2>(A, vb); W8(); v6_mma<1>(o, B, pa01, pa11); SBAR();
    v6_load<1, 3>(B, vb); W8(); v6_mma<2>(o, A, pa01, pa11); SBAR();
    asm volatile("s_waitcnt lgkmcnt(0)" ::: "memory"); SBAR(); v6_mma<3>(o, B, pa01, pa11); SBAR();
#undef W8
}
#ifndef MK_X16SWAP
#define MK_X16SWAP 0
#endif
__device__ __forceinline__ float grp_max(float v) {
#if MK_X16SWAP
    { auto rr = __builtin_amdgcn_permlane16_swap(__float_as_uint(v), __float_as_uint(v), false, false); v = fmaxf(__uint_as_float(rr[0]), __uint_as_float(rr[1])); }
#else
    v = fmaxf(v, __shfl_xor(v, 16));
#endif
    { auto rr = __builtin_amdgcn_permlane32_swap(__float_as_uint(v), __float_as_uint(v), false, false); v = fmaxf(__uint_as_float(rr[0]), __uint_as_float(rr[1])); }
    return v;
}
__device__ __forceinline__ float grp_sum(float v) {
#if MK_X16SWAP
    { auto rr = __builtin_amdgcn_permlane16_swap(__float_as_uint(v), __float_as_uint(v), false, false); v = __uint_as_float(rr[0]) + __uint_as_float(rr[1]); }
#else
    v += __shfl_xor(v, 16);
#endif
    { auto rr = __builtin_amdgcn_permlane32_swap(__float_as_uint(v), __float_as_uint(v), false, false); v = __uint_as_float(rr[0]) + __uint_as_float(rr[1]); }
    return v;
}
__device__ __forceinline__ void unit6(const bf16_t* __restrict__ Qb, const bf16_t* __restrict__ Kh, const bf16_t* __restrict__ Vh, bf16_t* __restrict__ Ob, int NT, int lim, unsigned char* ldsg, LAS unsigned char* lds) {
    int tid_ = threadIdx.x; asm volatile("" : "+v"(tid_));
    const int tid = tid_, wid = __builtin_amdgcn_readfirstlane(tid >> 6), lane = tid & 63, c16 = lane & 15, g = lane >> 4;
    LAS float* wsf = (LAS float*)(lds + OFF_W) + wid * 64; LAS float* li_l = wsf; LAS float* al_l = wsf + 32;
    float m0 = -1e30f, m1 = -1e30f, l0 = 0.f, l1 = 0.f;
    f32x4 o[2][16];
#pragma unroll
    for (int qb = 0; qb < 2; ++qb)
#pragma unroll
        for (int cb = 0; cb < 16; ++cb) o[qb][cb] = (f32x4){0.f, 0.f, 0.f, 0.f};
    bf16x8 qr[2][4];
    { const bf16_t* Qw = Qb + (long)(wid * QBLK + c16) * LDQ + g * 8;
#pragma unroll
      for (int qb = 0; qb < 2; ++qb)
#pragma unroll
          for (int ds = 0; ds < 4; ++ds) qr[qb][ds] = *reinterpret_cast<const bf16x8*>(Qw + (long)qb * 16 * LDQ + ds * 32); }
    const int ka0 = c16 * 256 + ((g * 16) ^ (c16 << 4));
    const int vb0 = (int)(uintptr_t)(ldsg + OFF_V) + (g >> 1) * 4096 + (g & 1) * 128 + (c16 >> 2) * 32 + (c16 & 3) * 8;
    unsigned ko0, vo0;
    { const int row = wid * 4 + (lane >> 4); ko0 = (unsigned)(row * LDQ * 2 + (((lane & 15) * 16) ^ ((row & 15) << 4)));
      const int key = (wid >> 2) * 8 + ((lane & 15) >> 1), col = (4 * (wid & 3) + (lane >> 4)) * 16 + (lane & 1) * 8;
      vo0 = (unsigned)(key * LDQ * 2 + col * 2); }
#define DMA_K(t_, b_) do { const char* gk = (const char*)Kh + (size_t)(t_) * (KVBLK * LDQ * 2); _Pragma("unroll") for (int i = 0; i < 2; ++i) { \
        __builtin_amdgcn_global_load_lds((const unsigned*)(gk + (size_t)i * (32 * LDQ * 2) + ko0), (LAS unsigned*)(lds + (b_) * KB + wid * 1024 + i * 8192), 16, 0, 0); } } while (0)
#define DMA_V(t_, b_) do { const char* gv = (const char*)Vh + (size_t)(t_) * (KVBLK * LDQ * 2); _Pragma("unroll") for (int i = 0; i < 4; ++i) { \
        __builtin_amdgcn_global_load_lds((const unsigned*)(gv + (size_t)i * (16 * LDQ * 2) + vo0), (LAS unsigned*)(lds + OFF_V + (b_) * VB + wid * 1024 + i * 8192), 16, 0, 0); } } while (0)
    DMA_K(0, 0); DMA_V(0, 0); if (1 < NT) { DMA_K(1, 1); DMA_V(1, 1); }
    asm volatile("s_waitcnt vmcnt(0)" ::: "memory"); __builtin_amdgcn_s_barrier(); asm volatile("" ::: "memory");
    int kb3 = 0;
    for (int j = 0; j < NT; ++j) {
        const int kb2 = kb3 == 0 ? 2 : kb3 - 1;
        if (j + 2 < NT) DMA_V(j + 2, kb2);
        asm volatile("" ::: "memory");
        if (j + 2 < NT) DMA_K(j + 2, kb2);
        asm volatile("" ::: "memory");
        if (j <= lim) {
        constexpr float C = SCALE * 1.4426950408889634f;
        f32x4 s[4][2];
#pragma unroll
        for (int kb = 0; kb < 4; ++kb) { s[kb][0] = (f32x4){0.f, 0.f, 0.f, 0.f}; s[kb][1] = (f32x4){0.f, 0.f, 0.f, 0.f}; }
        { const char* Ks = (const char*)ldsg + kb3 * KB;
#pragma unroll
          for (int ds = 0; ds < 4; ++ds) {
              bf16x8 kf[4];
#pragma unroll
              for (int kb = 0; kb < 4; ++kb) kf[kb] = *reinterpret_cast<const bf16x8*>(Ks + kb * 4096 + (ka0 ^ (ds << 6)));
#pragma unroll
              for (int kb = 0; kb < 4; ++kb) { s[kb][0] = __builtin_amdgcn_mfma_f32_16x16x32_bf16(kf[kb], qr[0][ds], s[kb][0], 0, 0, 0);
                                               s[kb][1] = __builtin_amdgcn_mfma_f32_16x16x32_bf16(kf[kb], qr[1][ds], s[kb][1], 0, 0, 0); } } }
        int jz = j; asm volatile("" : "+s"(jz));
        if (jz == 0) {
            asm volatile("; tile-0 mask" ::: "memory");
#pragma unroll
            for (int kb = 0; kb < 3; ++kb)
#pragma unroll
                for (int r = 0; r < 4; ++r) { s[kb][0][r] = -1e30f; s[kb][1][r] = -1e30f; }
        }
        float pm0 = s[0][0][0], pm1 = s[0][1][0];
#pragma unroll
        for (int kb = 0; kb < 4; ++kb)
#pragma unroll
            for (int r = 0; r < 4; ++r) { pm0 = fmaxf(pm0, s[kb][0][r]); pm1 = fmaxf(pm1, s[kb][1][r]); }
        pm0 = grp_max(pm0); pm1 = grp_max(pm1);
        float a0, a1;
        if (__builtin_expect(__all(fmaxf(pm0 - m0, pm1 - m1) <= THR / SCALE), 1)) { a0 = 1.f; a1 = 1.f; }
        else { const float n0 = fmaxf(m0, pm0), n1 = fmaxf(m1, pm1); a0 = __builtin_amdgcn_exp2f((m0 - n0) * C); a1 = __builtin_amdgcn_exp2f((m1 - n1) * C); m0 = n0; m1 = n1; }
        if (__any(a0 < 1.f || a1 < 1.f)) {
            if (g == 0) { al_l[c16] = a0; al_l[16 + c16] = a1; } asm volatile("s_waitcnt lgkmcnt(0)" ::: "memory");
            const f32x4 q0 = *(const LAS f32x4*)(al_l + 4 * g), q1 = *(const LAS f32x4*)(al_l + 16 + 4 * g);
            asm volatile("s_waitcnt lgkmcnt(0)" ::: "memory");
#pragma unroll
            for (int cb = 0; cb < 16; ++cb)
#pragma unroll
                for (int r = 0; r < 4; ++r) { o[0][cb][r] *= q0[r]; o[1][cb][r] *= q1[r]; }
        }
        const float mc0 = -m0 * C, mc1 = -m1 * C;
        float ps0 = 0.f, ps1 = 0.f;
#pragma unroll
        for (int kb = 0; kb < 4; ++kb)
#pragma unroll
            for (int r = 0; r < 4; ++r) { s[kb][0][r] = __builtin_amdgcn_exp2f(fmaf(s[kb][0][r], C, mc0)); s[kb][1][r] = __builtin_amdgcn_exp2f(fmaf(s[kb][1][r], C, mc1)); }
#pragma unroll
        for (int kb = 0; kb < 4; ++kb)
#pragma unroll
            for (int r = 0; r < 4; ++r) { ps0 += s[kb][0][r]; ps1 += s[kb][1][r]; }
        ps0 = grp_sum(ps0); ps1 = grp_sum(ps1);
        l0 = l0 * a0 + ps0; l1 = l1 * a1 + ps1;
        bf16x8 pa00, pa01, pa10, pa11;
#define PK6(QB, CH, OUT) do { u32x4 w_ = {cvt_pk_bf16(s[2 * CH][QB][0], s[2 * CH][QB][1]), cvt_pk_bf16(s[2 * CH][QB][2], s[2 * CH][QB][3]), \
                                          cvt_pk_bf16(s[2 * CH + 1][QB][0], s[2 * CH + 1][QB][1]), cvt_pk_bf16(s[2 * CH + 1][QB][2], s[2 * CH + 1][QB][3])}; OUT = *reinterpret_cast<bf16x8*>(&w_); } while (0)
        PK6(0, 0, pa00); PK6(0, 1, pa01); PK6(1, 0, pa10); PK6(1, 1, pa11);
#undef PK6
        SBAR();
        pv6_all(o, vb0 + kb3 * VB, pa00, pa01, pa10, pa11);
        }
        if (j + 2 < NT) asm volatile("s_waitcnt vmcnt(6)" ::: "memory"); else asm volatile("s_waitcnt vmcnt(0)" ::: "memory");
        __builtin_amdgcn_s_barrier(); asm volatile("" ::: "memory");
        kb3 = kb3 == 2 ? 0 : kb3 + 1;
    }
    if (g == 0) { li_l[c16] = l0; li_l[16 + c16] = l1; } asm volatile("s_waitcnt lgkmcnt(0)" ::: "memory");
    f32x4 r0 = *(const LAS f32x4*)(li_l + 4 * g), r1 = *(const LAS f32x4*)(li_l + 16 + 4 * g);
#pragma unroll
    for (int r = 0; r < 4; ++r) { r0[r] = __builtin_amdgcn_rcpf(r0[r]); r1[r] = __builtin_amdgcn_rcpf(r1[r]); }
    bf16_t* Ow = Ob + (long)(wid * QBLK + 4 * g) * LDO + c16;
#pragma unroll
    for (int r = 0; r < 4; ++r)
#pragma unroll
        for (int cb = 0; cb < 16; ++cb) { Ow[(long)r * LDO + cb * 16] = f2bf(o[0][cb][r] * r0[r]); Ow[(long)(16 + r) * LDO + cb * 16] = f2bf(o[1][cb][r] * r1[r]); }
    asm volatile("s_waitcnt vmcnt(0) lgkmcnt(0)" ::: "memory"); __builtin_amdgcn_s_barrier(); asm volatile("" ::: "memory");
#undef DMA_K
#undef DMA_V
}
}

#ifndef MK_ATT2
#define MK_ATT2 1
#endif
#ifndef MK_PROBE_QK2
#define MK_PROBE_QK2 0
#endif
#ifndef MK_PROBE_DMA2
#define MK_PROBE_DMA2 0
#endif
#ifndef MK_ATT_UNIT
#define MK_ATT_UNIT unit2
#endif
#ifndef MK_ATT_REV
#define MK_ATT_REV 0
#endif
#if MK_ATT2
__device__ __forceinline__ void attn_phase(const Fr& F) {
    const bf16_t* Q = slotY(F, 0); const bf16_t* K = slotY(F, 1); const bf16_t* V = slotY(F, 2);
    bf16_t* AO = slotU(F, 1);
    const int x = F.bid & 7, j = (F.bid >> 3) & 31;
#pragma unroll 1
    for (int k = 0; k < 4; ++k) {
        if (F.bid >= 256) break;
        const int sub = 4 * x + k, head = sub >> 1, c = sub & 1;
        const bf16_t* Kp = K + head * 256 + c * 128; const bf16_t* Vp = V + head * 256;
#pragma unroll 1
        for (int u = 0; u < 2; ++u) {
            const int t = u == 0 ? 63 - j : j;
            const int row0 = 256 * t + 128;
            att2::MK_ATT_UNIT(Q + (size_t)row0 * D + head * 256 + c * 128, Kp, Vp, AO + (size_t)row0 * 8192 + head * 512 + c * 256, 4 * t + 6, 4 * t + 2 + (F.wave >> 1), F.ldsg, F.lds, MK_ATT_REV ? u : 0);
        }
        if (j == 8 * k) att2::MK_ATT_UNIT(Q + head * 256 + c * 128, Kp, Vp, AO + head * 512 + c * 256, 4, F.wave >> 1, F.ldsg, F.lds);
    }
}
#else
__device__ __forceinline__ void attn_phase(const Fr& F) {
    const bf16_t* Q = slotY(F, 0); const bf16_t* K = slotY(F, 1); const bf16_t* V = slotY(F, 2);
    bf16_t* AO = slotU(F, 1);
    const int x = F.bid & 7, j = (F.bid >> 3) & 31;
#pragma unroll 1
    for (int k = 0; k < 8; ++k) {
        if (F.bid >= 256) break;
        const int sub = 8 * x + k, head = sub >> 2, c = (sub >> 1) & 1, half = sub & 1;
        const bf16_t* Kp = K + head * 256 + c * 128; const bf16_t* Vp = V + head * 256 + half * 128;
#pragma unroll 1
        for (int u = 0; u < 2; ++u) {
            const int t = u == 0 ? 63 - j : j;
            const int row0 = 256 * t + 128;
            att::unit(Q + (size_t)row0 * D + head * 256 + c * 128, Kp, Vp, AO + (size_t)row0 * 8192 + head * 512 + c * 256 + half * 128, 4 * t + 6, 4 * t + 2 + (F.wave >> 1), (char*)F.ldsg);
        }
        if (j == 4 * k) att::unit(Q + head * 256 + c * 128, Kp, Vp, AO + head * 512 + c * 256 + half * 128, 4, F.wave >> 1, (char*)F.ldsg);
    }
}
#endif
__device__ __forceinline__ void attn_post(const Fr& F) {
    const bf16_t* AO = slotU(F, 1); const bf16_t* GT = slotY(F, 3); bf16_t* Z = slotU(F, 0);
    const float* sg = F.in(13);
    constexpr float LINIT = 0.35550906759096934f;
    float lam;
    { const float* q1 = F.in(9); const float* k1 = F.in(10); const float* q2 = F.in(11); const float* k2 = F.in(12);
      const float d1 = wave_sum(q1[F.lane] * k1[F.lane] + q1[F.lane + 64] * k1[F.lane + 64]), d2 = wave_sum(q2[F.lane] * k2[F.lane] + q2[F.lane + 64] * k2[F.lane + 64]);
      lam = expf(d1) - expf(d2) + LINIT; }
    const f32x4 g4 = ((const f32x4*)sg)[F.lane];
    for (int r = F.gw; r < R; r += F.NGW) {
        const bool real = (r >= NPAD && r < NREAL);
        u32x2* zr = (u32x2*)(Z + (size_t)r * D) + F.lane;
        if (!real) { const u32x2 z = {0u, 0u};
#pragma unroll
            for (int hd = 0; hd < 16; ++hd) zr[64 * hd] = z;
            continue; }
        gp_ ao0 = (gp_)(AO + (size_t)r * 8192) + F.lane * 8 + 4096; gp_ ao1 = ao0 + 8192; asm volatile("" : "+v"(ao0), "+v"(ao1));
        ROW_BF(gq, GT + (size_t)r * D, F.lane); ROW_BF(zq, Z + (size_t)r * D, F.lane);
        u32x2 a0v[16], a1v[16], gtv[16];
#pragma unroll
        for (int hd = 0; hd < 16; ++hd) {
            a0v[hd] = *(GAS u32x2*)(hd < 8 ? ao0 + (2 * hd) * 512 - 4096 : ao1 + (2 * hd - 16) * 512 - 4096);
            a1v[hd] = *(GAS u32x2*)(hd < 8 ? ao0 + (2 * hd + 1) * 512 - 4096 : ao1 + (2 * hd - 15) * 512 - 4096);
            gtv[hd] = AT_BF(gq, hd);
        }
#pragma unroll
        for (int hd = 0; hd < 16; ++hd) {
            const u32x2 a0 = a0v[hd], a1 = a1v[hd], gt = gtv[hd];
            const float o0 = bflo(a0.x) - lam * bflo(a1.x), o1 = bfhi(a0.x) - lam * bfhi(a1.x), o2 = bflo(a0.y) - lam * bflo(a1.y), o3 = bfhi(a0.y) - lam * bfhi(a1.y);
            const float ss = wave_sum((o0 * o0 + o1 * o1) + (o2 * o2 + o3 * o3));
            const float rs = __builtin_amdgcn_rsqf(ss * (1.f / 256.f) + 1e-5f) * (1.f - LINIT);
            u32x2 w; w.x = cvt_pk_bf16(o0 * rs * g4.x * silu_f(bflo(gt.x)), o1 * rs * g4.y * silu_f(bfhi(gt.x))); w.y = cvt_pk_bf16(o2 * rs * g4.z * silu_f(bflo(gt.y)), o3 * rs * g4.w * silu_f(bfhi(gt.y)));
            AT_BF(zq, hd) = w;
        }
    }
}

constexpr int RW_TT = 32, RW_TOKF = 384, RW_TILEF = RW_TT * RW_TOKF, RW_NTILE = 513;
__device__ __forceinline__ void rwkv_scan_seq(const Fr& F) {
    const bf16_t* Rr = slotY(F, 0); const bf16_t* K = slotY(F, 1); const bf16_t* V = slotY(F, 2); const bf16_t* W = slotY(F, 4); const bf16_t* A = slotY(F, 5);
    float* O32 = (float*)slotU(F, 1);
    LAS float* ring = (LAS float*)F.lds; LAS float* otile = ring + 2 * RW_TILEF;
    const int tid = F.tid, lane = F.lane, wid = F.wave;
    for (int unit = F.bid; unit < 256; unit += F.G) {
        const int h = unit >> 2, rg = unit & 3;
        const int ptid = tid - 256, ptt = ptid >> 3, dg = ptid & 7;
        float kkc[8], kac[8];
        if (wid >= 4) {
#pragma unroll
            for (int i = 0; i < 8; ++i) { kkc[i] = F.in(23)[h * 64 + 8 * dg + i]; kac[i] = F.in(24)[h * 64 + 8 * dg + i]; }
        }
        float S0 = 0.f, S1 = 0.f, S2 = 0.f, S3 = 0.f;
        const int cg = lane & 15, irow = 4 * wid + (lane >> 4);
#define RW_PRODUCE(m, buf) do { const int row = NPAD + 32 * (m) + ptt; const size_t off = (size_t)row * D + h * 64 + 8 * dg; \
        const u32x4 r8 = *(const u32x4*)(Rr + off), k8 = *(const u32x4*)(K + off), v8 = *(const u32x4*)(V + off), w8 = *(const u32x4*)(W + off), a8 = *(const u32x4*)(A + off); \
        const unsigned rw[4] = {r8.x, r8.y, r8.z, r8.w}, kw[4] = {k8.x, k8.y, k8.z, k8.w}, vw[4] = {v8.x, v8.y, v8.z, v8.w}, ww[4] = {w8.x, w8.y, w8.z, w8.w}, aw[4] = {a8.x, a8.y, a8.z, a8.w}; \
        float rf[8], kf[8], vf[8], wf[8], af[8], kk[8]; float ssq = 0.f; \
        _Pragma("unroll") for (int i = 0; i < 4; ++i) { rf[2 * i] = bflo(rw[i]); rf[2 * i + 1] = bfhi(rw[i]); kf[2 * i] = bflo(kw[i]); kf[2 * i + 1] = bfhi(kw[i]); vf[2 * i] = bflo(vw[i]); vf[2 * i + 1] = bfhi(vw[i]); \
            wf[2 * i] = bflo(ww[i]); wf[2 * i + 1] = bfhi(ww[i]); af[2 * i] = bflo(aw[i]); af[2 * i + 1] = bfhi(aw[i]); } \
        _Pragma("unroll") for (int i = 0; i < 8; ++i) { kk[i] = kf[i] * kkc[i]; ssq += kk[i] * kk[i]; } \
        ssq = red8(ssq); const float inv = 1.f / fmaxf(sqrtf(ssq), 1e-12f); \
        LAS float* tb = ring + (buf) * RW_TILEF + ptt * RW_TOKF; \
        _Pragma("unroll") for (int q = 0; q < 2; ++q) { LAS f32x4* p = (LAS f32x4*)(tb + (2 * dg + q) * 20); \
            f32x4 t0, t1, t2, t3, t4; \
            _Pragma("unroll") for (int e = 0; e < 4; ++e) { const int i = 4 * q + e; const float kn = kk[i] * inv; t0[e] = wf[i]; t1[e] = -kn; t2[e] = kn * af[i]; t3[e] = kf[i] * (1.f + (af[i] - 1.f) * kac[i]); t4[e] = rf[i]; } \
            p[0] = t0; p[1] = t1; p[2] = t2; p[3] = t3; p[4] = t4; } \
        LAS f32x4* pv = (LAS f32x4*)(tb + 320 + 8 * dg); pv[0] = (f32x4){vf[0], vf[1], vf[2], vf[3]}; pv[1] = (f32x4){vf[4], vf[5], vf[6], vf[7]}; } while (0)
#define RW_FLUSH(m, buf) do { const int row = NPAD + 32 * (m) + ptt; if (row < NREAL) { const LAS float* ot = otile + (buf) * 512 + ptt * 16 + 2 * dg; \
        *(float2*)(O32 + (size_t)row * D + h * 64 + 16 * rg + 2 * dg) = make_float2(ot[0], ot[1]); } } while (0)
        if (wid >= 4) RW_PRODUCE(0, 0);
        __syncthreads();
        for (int n = 0; n < RW_NTILE; ++n) {
            if (wid < 4) {
                const LAS float* tb = ring + (n & 1) * RW_TILEF; LAS float* ot = otile + (n & 1) * 512;
#pragma unroll 4
                for (int tt = 0; tt < RW_TT; ++tt) {
                    const LAS float* p = tb + tt * RW_TOKF + cg * 20;
                    const f32x4 w4 = *(const LAS f32x4*)p, nk = *(const LAS f32x4*)(p + 4), ka = *(const LAS f32x4*)(p + 8), kp = *(const LAS f32x4*)(p + 12), r4 = *(const LAS f32x4*)(p + 16);
                    const float v = tb[tt * RW_TOKF + 320 + 16 * rg + irow];
                    float sa = (S0 * nk.x + S1 * nk.y) + (S2 * nk.z + S3 * nk.w);
                    sa = red16(sa);
                    S0 = S0 * w4.x + (sa * ka.x + v * kp.x); S1 = S1 * w4.y + (sa * ka.y + v * kp.y); S2 = S2 * w4.z + (sa * ka.z + v * kp.z); S3 = S3 * w4.w + (sa * ka.w + v * kp.w);
                    float o = (S0 * r4.x + S1 * r4.y) + (S2 * r4.z + S3 * r4.w);
                    o = red16(o);
                    if (cg == 0) ot[tt * 16 + irow] = o;
                }
            } else {
                if (n + 1 < RW_NTILE) RW_PRODUCE(n + 1, (n + 1) & 1);
                if (n > 0) RW_FLUSH(n - 1, (n - 1) & 1);
            }
            __syncthreads();
        }
        if (wid >= 4) RW_FLUSH(RW_NTILE - 1, (RW_NTILE - 1) & 1);
        __syncthreads();
#undef RW_PRODUCE
#undef RW_FLUSH
    }
}

#ifndef RC_SYNC
#define RC_SYNC 0
#endif
constexpr int RC_SLOT = 13312, RC_NSLOT = 8, RC_SCR0 = RC_NSLOT * RC_SLOT, RC_SCR = 5632, RC_FLAGS = RC_SCR0 + 7 * RC_SCR, RC_NCH = 1025;
constexpr int RC_AT = 0, RC_RT = 2176, RC_BTT = 4352, RC_KTT = 6912, RC_TT = 9472, RC_G3F = 9984, RC_VTF = 10496, RC_P1 = 11008, RC_P2 = 12032, RC_WC = 13056;
static_assert(RC_FLAGS + 64 <= 147456 - 256, "rwkv LDS map");
typedef short s16x4v __attribute__((ext_vector_type(4)));
__device__ __forceinline__ void lora2_phase(const Fr& F) {
    const bf16_t* T = (const bf16_t*)(F.ws + WS_T); const bf16_t* W2T = (const bf16_t*)(F.ws + WS_W2P);
    const int c16 = F.lane & 15, g = F.lane >> 4;
    struct BSet { bf16x8 f[2][4]; f32x4 b0, b1; };
#define L2_LOAD(S_, grp_) do { _Pragma("unroll") for (int b = 0; b < 2; ++b) _Pragma("unroll") for (int ks = 0; ks < 4; ++ks) S_.f[b][ks] = *reinterpret_cast<const bf16x8*>(wb + (size_t)((grp_) * 32 + 4 * b) * 128 + ks * 32); \
        S_.b0 = *(const GAS f32x4*)(bias + (grp_) * 32); S_.b1 = *(const GAS f32x4*)(bias + (grp_) * 32 + 4); } while (0)
#define L2_COMP(S_, grp_) do { f32x4 acc[2][4]; \
        _Pragma("unroll") for (int b = 0; b < 2; ++b) _Pragma("unroll") for (int rb = 0; rb < 4; ++rb) acc[b][rb] = (f32x4){0.f, 0.f, 0.f, 0.f}; \
        _Pragma("unroll") for (int ks = 0; ks < 4; ++ks) _Pragma("unroll") for (int b = 0; b < 2; ++b) _Pragma("unroll") for (int rb = 0; rb < 4; ++rb) \
            acc[b][rb] = __builtin_amdgcn_mfma_f32_16x16x32_bf16(S_.f[b][ks], af[rb][ks], acc[b][rb], 0, 0, 0); \
        _Pragma("unroll") for (int rb = 0; rb < 4; ++rb) { f32x4 v0 = acc[0][rb] + S_.b0, v1 = acc[1][rb] + S_.b1; \
            _Pragma("unroll") for (int jj = 0; jj < 4; ++jj) { float s0 = __builtin_amdgcn_rcpf(1.f + __expf(-v0[jj])), s1 = __builtin_amdgcn_rcpf(1.f + __expf(-v1[jj])); \
                if (!sel) { s0 = __expf(-0.606531f * s0); s1 = __expf(-0.606531f * s1); } L2_PROBE_MATH(v0[jj], v1[jj]); v0[jj] = s0; v1[jj] = s1; } \
            st_bf8(dst + (size_t)rb * 16 * D + (grp_) * 32, v0, v1); } } while (0)
#ifdef MK_L2MATH2
#define L2_PROBE_MATH(x0_, x1_) do { float t0_ = (x0_), t1_ = (x1_); asm volatile("" : "+v"(t0_), "+v"(t1_)); t0_ = __builtin_amdgcn_rcpf(1.f + __expf(-t0_)); t1_ = __builtin_amdgcn_rcpf(1.f + __expf(-t1_)); \
        if (!sel) { t0_ = __expf(-0.606531f * t0_); t1_ = __expf(-0.606531f * t1_); } asm volatile("" :: "v"(t0_), "v"(t1_)); } while (0)
#else
#define L2_PROBE_MATH(x0_, x1_) do { } while (0)
#endif
#define L2_WAIT(n_) do { SBAR(); asm volatile("s_waitcnt vmcnt(" #n_ ")" ::: "memory"); SBAR(); } while (0)
#pragma unroll 1
    for (int it = F.bid; it < (R / 64) * 8; it += F.G) {
        const int panel = it >> 3, sel = (it >> 2) & 1, q = it & 3;
        const int row0 = panel * 64, colw = q * 1024 + F.wave * 128;
        const GAS float* bias = (const GAS float*)(sel ? F.in(20) : F.in(17)) + colw + 8 * g;
        bf16_t* dst = slotY(F, sel ? 5 : 4) + (size_t)(row0 + c16) * D + colw + 8 * g;
        const bf16_t* ta = T + (size_t)(row0 + c16) * 256 + sel * 128 + 8 * g;
        const bf16_t* wb = W2T + (size_t)(sel * 4096 + colw + 8 * (c16 >> 2) + (c16 & 3)) * 128 + 8 * g;
        bf16x8 af[4][4]; BSet A, B;
#pragma unroll
        for (int rb = 0; rb < 4; ++rb)
#pragma unroll
            for (int ks = 0; ks < 4; ++ks) af[rb][ks] = *reinterpret_cast<const bf16x8*>(ta + (size_t)rb * 16 * 256 + ks * 32);
        L2_LOAD(A, 0); SBAR();
        L2_LOAD(B, 1); L2_WAIT(10); L2_COMP(A, 0); SBAR();
        L2_LOAD(A, 2); L2_WAIT(14); L2_COMP(B, 1); SBAR();
        L2_LOAD(B, 3); L2_WAIT(14); L2_COMP(A, 2); SBAR();
        L2_WAIT(4); L2_COMP(B, 3); SBAR();
    }
#undef L2_LOAD
#undef L2_COMP
#undef L2_WAIT
}
__device__ __forceinline__ void rwkv_kknorm(const Fr& F) {
    const bf16_t* K = slotY(F, 1); const float* k_k = F.in(23); float* INV = (float*)(F.ws + WS_HE);
    f32x4 c4v[16];
    { ROW_F32(cq, k_k, F.lane);
#pragma unroll
      for (int it = 0; it < 16; ++it) c4v[it] = AT_F32(cq, it); }
    for (int r = F.gw; r < R; r += F.NGW) {
        ROW_BF(kq_, K + (size_t)r * D, F.lane);
        u32x2 kv[16];
#pragma unroll
        for (int it = 0; it < 16; ++it) kv[it] = AT_BF(kq_, it);
#pragma unroll
        for (int it = 0; it < 16; ++it) {
            const u32x2 kk = kv[it]; const f32x4 c4 = c4v[it];
            const float a = bflo(kk.x) * c4.x, b = bfhi(kk.x) * c4.y, c = bflo(kk.y) * c4.z, d = bfhi(kk.y) * c4.w;
            const float ss = red16((a * a + b * b) + (c * c + d * d));
            if ((F.lane & 15) == 0) INV[(size_t)r * 64 + it * 4 + (F.lane >> 4)] = 1.f / fmaxf(sqrtf(ss), 1e-12f);
        }
    }
}
__device__ __forceinline__ unsigned lds_poll(volatile LAS unsigned* p) { return *p; }
__device__ __forceinline__ void rwkv_scan(const Fr& F) {
    const bf16_t* Rr = slotY(F, 0); const bf16_t* K = slotY(F, 1); const bf16_t* V = slotY(F, 2); const bf16_t* W = slotY(F, 4); const bf16_t* A = slotY(F, 5);
    const float* INV = (const float*)(F.ws + WS_HE);
    float* O32 = (float*)slotU(F, 1);
    LAS unsigned char* L = F.lds;
    volatile LAS unsigned* flags = (volatile LAS unsigned*)(L + RC_FLAGS);
    const int lane = F.lane, wid = F.wave, l15 = lane & 15, kg = lane >> 4;
    for (int unit = F.bid; unit < 256; unit += F.G) {
        const int h = unit >> 2, rgw = unit & 3;
        if (F.tid < 16) flags[F.tid] = 0u;
        __syncthreads();
        if (wid == 0) {
            __builtin_amdgcn_s_setprio(3);
            f32x4 S0 = {0.f, 0.f, 0.f, 0.f}, S1 = S0, S2 = S0, S3 = S0;
            struct SlotRegs { u32x2 a0l, a0h, a1l, a1h, r0l, r0h, r1l, r1h; f32x4 P1, P2; s16x4v ttf, g3f, vtf, b0, b1, b2, b3, k0, k1, k2, k3; f32x4 w0, w1, w2, w3; };
#if RC_SYNC
#define CH_WAIT(n_) do { if ((n_) % 7 == 0) { __builtin_amdgcn_s_barrier(); __builtin_amdgcn_s_barrier(); } } while (0)
#else
#define CH_WAIT(n_) do { unsigned sp = 0; while (lds_poll(flags + ((n_) & 7)) != (unsigned)((n_) + 1)) { __builtin_amdgcn_s_sleep(1); if (++sp > (1u << 22)) break; } } while (0)
#endif
#define CH_LOAD(R_, n_) do { CH_WAIT(n_); asm volatile("s_waitcnt lgkmcnt(0)" ::: "memory"); const LAS unsigned char* SL = L + ((n_) & 7) * RC_SLOT; \
                const LAS unsigned char* ap = SL + RC_AT + l15 * 136 + kg * 8; const LAS unsigned char* rp = SL + RC_RT + l15 * 136 + kg * 8; \
                R_.a0l = *(const LAS u32x2*)(ap); R_.a0h = *(const LAS u32x2*)(ap + 32); R_.a1l = *(const LAS u32x2*)(ap + 64); R_.a1h = *(const LAS u32x2*)(ap + 96); \
                R_.r0l = *(const LAS u32x2*)(rp); R_.r0h = *(const LAS u32x2*)(rp + 32); R_.r1l = *(const LAS u32x2*)(rp + 64); R_.r1h = *(const LAS u32x2*)(rp + 96); \
                R_.P1 = *(const LAS f32x4*)(SL + RC_P1 + lane * 16); R_.P2 = *(const LAS f32x4*)(SL + RC_P2 + lane * 16); \
                R_.ttf = *(const LAS s16x4v*)(SL + RC_TT + lane * 8); R_.g3f = *(const LAS s16x4v*)(SL + RC_G3F + lane * 8); R_.vtf = *(const LAS s16x4v*)(SL + RC_VTF + lane * 8); \
                const LAS unsigned char* bp = SL + RC_BTT + l15 * 40 + kg * 8; const LAS unsigned char* kp = SL + RC_KTT + l15 * 40 + kg * 8; \
                R_.b0 = *(const LAS s16x4v*)(bp); R_.b1 = *(const LAS s16x4v*)(bp + 640); R_.b2 = *(const LAS s16x4v*)(bp + 1280); R_.b3 = *(const LAS s16x4v*)(bp + 1920); \
                R_.k0 = *(const LAS s16x4v*)(kp); R_.k1 = *(const LAS s16x4v*)(kp + 640); R_.k2 = *(const LAS s16x4v*)(kp + 1280); R_.k3 = *(const LAS s16x4v*)(kp + 1920); \
                const LAS f32x4* wc = (const LAS f32x4*)(SL + RC_WC + kg * 16); R_.w0 = wc[0]; R_.w1 = wc[4]; R_.w2 = wc[8]; R_.w3 = wc[12]; \
                asm volatile("s_waitcnt lgkmcnt(0)" ::: "memory"); \
                if (lane == 0) flags[8] = (unsigned)((n_) + 1); } while (0)
#define CH_COMPUTE(R_, n_, NEXT_) do { \
                u32x4 sb0, sb1; sb0.x = cvt_pk_bf16(S0.x, S0.y); sb0.y = cvt_pk_bf16(S0.z, S0.w); sb0.z = cvt_pk_bf16(S1.x, S1.y); sb0.w = cvt_pk_bf16(S1.z, S1.w); \
                sb1.x = cvt_pk_bf16(S2.x, S2.y); sb1.y = cvt_pk_bf16(S2.z, S2.w); sb1.z = cvt_pk_bf16(S3.x, S3.y); sb1.w = cvt_pk_bf16(S3.z, S3.w); \
                const bf16x8 Sb0 = *reinterpret_cast<bf16x8*>(&sb0), Sb1 = *reinterpret_cast<bf16x8*>(&sb1); \
                u32x4 t4; \
                t4 = (u32x4){R_.a0l.x, R_.a0l.y, R_.a0h.x, R_.a0h.y}; const bf16x8 Aq0 = *reinterpret_cast<bf16x8*>(&t4); \
                t4 = (u32x4){R_.a1l.x, R_.a1l.y, R_.a1h.x, R_.a1h.y}; const bf16x8 Aq1 = *reinterpret_cast<bf16x8*>(&t4); \
                t4 = (u32x4){R_.r0l.x, R_.r0l.y, R_.r0h.x, R_.r0h.y}; const bf16x8 Rq0 = *reinterpret_cast<bf16x8*>(&t4); \
                t4 = (u32x4){R_.r1l.x, R_.r1l.y, R_.r1h.x, R_.r1h.y}; const bf16x8 Rq1 = *reinterpret_cast<bf16x8*>(&t4); \
                f32x4 X = R_.P1, O = R_.P2; \
                X = __builtin_amdgcn_mfma_f32_16x16x32_bf16(Aq0, Sb0, X, 0, 0, 0); \
                X = __builtin_amdgcn_mfma_f32_16x16x32_bf16(Aq1, Sb1, X, 0, 0, 0);                   \
                O = __builtin_amdgcn_mfma_f32_16x16x32_bf16(Rq0, Sb0, O, 0, 0, 0); \
                O = __builtin_amdgcn_mfma_f32_16x16x32_bf16(Rq1, Sb1, O, 0, 0, 0);                   \
                u32x2 yb; yb.x = cvt_pk_bf16(X.x, X.y); yb.y = cvt_pk_bf16(X.z, X.w); \
                f32x4 U = {0.f, 0.f, 0.f, 0.f}; \
                U = __builtin_amdgcn_mfma_f32_16x16x16bf16_1k(R_.ttf, *reinterpret_cast<s16x4v*>(&yb), U, 0, 0, 0);     \
                u32x2 ub; ub.x = cvt_pk_bf16(U.x, U.y); ub.y = cvt_pk_bf16(U.z, U.w); \
                const s16x4v Ub = *reinterpret_cast<s16x4v*>(&ub); \
                S0 = __builtin_amdgcn_mfma_f32_16x16x16bf16_1k(R_.k0, R_.vtf, S0, 0, 0, 0); S1 = __builtin_amdgcn_mfma_f32_16x16x16bf16_1k(R_.k1, R_.vtf, S1, 0, 0, 0); \
                S2 = __builtin_amdgcn_mfma_f32_16x16x16bf16_1k(R_.k2, R_.vtf, S2, 0, 0, 0); S3 = __builtin_amdgcn_mfma_f32_16x16x16bf16_1k(R_.k3, R_.vtf, S3, 0, 0, 0); \
                S0 = __builtin_amdgcn_mfma_f32_16x16x16bf16_1k(R_.b0, Ub, S0, 0, 0, 0); S1 = __builtin_amdgcn_mfma_f32_16x16x16bf16_1k(R_.b1, Ub, S1, 0, 0, 0); \
                S2 = __builtin_amdgcn_mfma_f32_16x16x16bf16_1k(R_.b2, Ub, S2, 0, 0, 0); S3 = __builtin_amdgcn_mfma_f32_16x16x16bf16_1k(R_.b3, Ub, S3, 0, 0, 0); \
                O = __builtin_amdgcn_mfma_f32_16x16x16bf16_1k(R_.g3f, Ub, O, 0, 0, 0);                   \
                NEXT_; \
                S0 = S0 * R_.w0; S1 = S1 * R_.w1; S2 = S2 * R_.w2; S3 = S3 * R_.w3; \
                float* op = O32 + (size_t)(NPAD + 16 * (n_) + 4 * kg) * D + h * 64 + 16 * rgw + l15;     \
                op[0] = O.x; op[D] = O.y; op[2 * D] = O.z; op[3 * D] = O.w; } while (0)
            SlotRegs RA, RB;
            CH_LOAD(RA, 0);
            for (int n = 0; n + 1 < RC_NCH; n += 2) {
#ifdef MK_RC_CHAIN_SLEEP
                __builtin_amdgcn_s_sleep(MK_RC_CHAIN_SLEEP);
#endif
                CH_COMPUTE(RA, n, CH_LOAD(RB, n + 1));
                if (n + 2 < RC_NCH) { CH_COMPUTE(RB, n + 1, CH_LOAD(RA, n + 2)); } else { CH_COMPUTE(RB, n + 1, (void)0); }
            }
            if (RC_NCH & 1) { CH_COMPUTE(RA, RC_NCH - 1, (void)0); }
            __builtin_amdgcn_s_setprio(0);
#undef CH_WAIT
#undef CH_LOAD
#undef CH_COMPUTE
        } else {
            const int p = wid - 1;
            LAS unsigned char* SC = L + RC_SCR0 + p * RC_SCR;
            const float kkc = F.in(23)[h * 64 + lane], kac = F.in(24)[h * 64 + lane];
            unsigned short cr[16], ck[16], cw[16], ca[16], nvq[4]; float civ[16];
#define RC_LOADS(nn) do { const int r0n = NPAD + 16 * (nn); \
                _Pragma("unroll") for (int e = 0; e < 4; ++e) nvq[e] = V[(size_t)(r0n + 4 * kg + e) * D + h * 64 + 16 * rgw + l15]; \
                _Pragma("unroll") for (int s = 0; s < 16; ++s) { const size_t off = (size_t)(r0n + s) * D + h * 64 + lane; cr[s] = Rr[off]; ck[s] = K[off]; cw[s] = W[off]; ca[s] = A[off]; civ[s] = INV[(size_t)(r0n + s) * 64 + h]; } } while (0)
            RC_LOADS(p);
            for (int n = p; n < RC_NCH; n += 7) {
#ifdef MK_RC_PREP_SLEEP
                __builtin_amdgcn_s_sleep(MK_RC_PREP_SLEEP);
#endif
                const int slot = n & 7; LAS unsigned char* SL = L + slot * RC_SLOT;
                unsigned short vq[4];
#pragma unroll
                for (int e = 0; e < 4; ++e) vq[e] = nvq[e];
#if RC_SYNC
                asm volatile("s_waitcnt lgkmcnt(0)" ::: "memory"); __builtin_amdgcn_s_barrier();
#else
                if (n >= 8) { unsigned sp = 0; while (lds_poll(flags + 8) < (unsigned)(n - 7)) { __builtin_amdgcn_s_sleep(2); if (++sp > (1u << 22)) break; } }
#endif
                asm volatile("" ::: "memory");
                float Wp = 1.f; unsigned btp[8], ktp[8];
#pragma unroll
                for (int hb = 0; hb < 2; ++hb) {
                    unsigned short rq[8], kq[8], wq[8], aq[8]; float iv[8];
#pragma unroll
                    for (int s = 0; s < 8; ++s) { rq[s] = cr[8 * hb + s]; kq[s] = ck[8 * hb + s]; wq[s] = cw[8 * hb + s]; aq[s] = ca[8 * hb + s]; iv[s] = civ[8 * hb + s]; }
                    float btv[8], ktv[8];
#pragma unroll
                    for (int s = 0; s < 8; ++s) {
                        const int t = 8 * hb + s;
                        const float rs = bf2f(rq[s]), ks = bf2f(kq[s]), wsv = bf2f(wq[s]), as = bf2f(aq[s]);
                        const float kk = ks * kkc * iv[s];
                        const float Wprev = Wp; Wp *= wsv; const float iW = __builtin_amdgcn_rcpf(Wp);
                        const float at = -kk * Wprev, rt = rs * Wp, bt = kk * as * iW, kt = ks * (1.f + (as - 1.f) * kac) * iW;
                        *(LAS bf16_t*)(SL + RC_AT + t * 136 + lane * 2) = f2bf(at); *(LAS bf16_t*)(SL + RC_RT + t * 136 + lane * 2) = f2bf(rt);
                        *(LAS bf16_t*)(SC + t * 136 + lane * 2) = f2bf(bt); *(LAS bf16_t*)(SC + 2176 + t * 136 + lane * 2) = f2bf(kt);
                        btv[s] = bt; ktv[s] = kt;
                    }
#pragma unroll
                    for (int s = 0; s < 4; ++s) { btp[4 * hb + s] = cvt_pk_bf16(btv[2 * s], btv[2 * s + 1]); ktp[4 * hb + s] = cvt_pk_bf16(ktv[2 * s], ktv[2 * s + 1]); }
                }
                {
                    LAS u32x2* bq = (LAS u32x2*)(SL + RC_BTT + lane * 40); LAS u32x2* kq2 = (LAS u32x2*)(SL + RC_KTT + lane * 40);
#pragma unroll
                    for (int q = 0; q < 4; ++q) { bq[q] = (u32x2){btp[2 * q], btp[2 * q + 1]}; kq2[q] = (u32x2){ktp[2 * q], ktp[2 * q + 1]}; }
                    *(LAS float*)(SL + RC_WC + lane * 4) = Wp;
                    u32x2 vt; vt.x = (unsigned)vq[0] | ((unsigned)vq[1] << 16); vt.y = (unsigned)vq[2] | ((unsigned)vq[3] << 16);
                    *(LAS u32x2*)(SL + RC_VTF + lane * 8) = vt;
                }
                if (n + 7 < RC_NCH) RC_LOADS(n + 7);
                asm volatile("s_waitcnt lgkmcnt(0)" ::: "memory");
                f32x4 G1 = {0.f, 0.f, 0.f, 0.f}, G2 = G1, G3 = G1, G4 = G1, G1t = G1;
#pragma unroll
                for (int ks = 0; ks < 2; ++ks) {
                    const bf16x8 fb = *(const LAS bf16x8*)(SC + l15 * 136 + (32 * ks + 8 * kg) * 2), fk = *(const LAS bf16x8*)(SC + 2176 + l15 * 136 + (32 * ks + 8 * kg) * 2);
                    const bf16x8 fa = *(const LAS bf16x8*)(SL + RC_AT + l15 * 136 + (32 * ks + 8 * kg) * 2), fr_ = *(const LAS bf16x8*)(SL + RC_RT + l15 * 136 + (32 * ks + 8 * kg) * 2);
                    G1 = __builtin_amdgcn_mfma_f32_16x16x32_bf16(fb, fa, G1, 0, 0, 0); G2 = __builtin_amdgcn_mfma_f32_16x16x32_bf16(fk, fa, G2, 0, 0, 0);
                    G1t = __builtin_amdgcn_mfma_f32_16x16x32_bf16(fa, fb, G1t, 0, 0, 0);
                    G3 = __builtin_amdgcn_mfma_f32_16x16x32_bf16(fb, fr_, G3, 0, 0, 0); G4 = __builtin_amdgcn_mfma_f32_16x16x32_bf16(fk, fr_, G4, 0, 0, 0);
                }
                {
#pragma unroll
                    for (int e = 0; e < 4; ++e) { const int s = 4 * kg + e; const bool lt = s < l15, le = s <= l15;
                        G1[e] = lt ? G1[e] : 0.f; G1t[e] = (l15 < s) ? G1t[e] : 0.f; G2[e] = lt ? G2[e] : 0.f; G3[e] = le ? G3[e] : 0.f; G4[e] = le ? G4[e] : 0.f; }
                    u32x2 g2, g3, g4; g2.x = cvt_pk_bf16(G2.x, G2.y); g2.y = cvt_pk_bf16(G2.z, G2.w); g3.x = cvt_pk_bf16(G3.x, G3.y); g3.y = cvt_pk_bf16(G3.z, G3.w); g4.x = cvt_pk_bf16(G4.x, G4.y); g4.y = cvt_pk_bf16(G4.z, G4.w);
                    *(LAS u32x2*)(SL + RC_G3F + lane * 8) = g3;
                    u32x2 vt; vt.x = (unsigned)vq[0] | ((unsigned)vq[1] << 16); vt.y = (unsigned)vq[2] | ((unsigned)vq[3] << 16);
                    const s16x4v vtf = *reinterpret_cast<s16x4v*>(&vt);
                    f32x4 P1 = {0.f, 0.f, 0.f, 0.f}, P2 = P1;
                    P1 = __builtin_amdgcn_mfma_f32_16x16x16bf16_1k(*reinterpret_cast<s16x4v*>(&g2), vtf, P1, 0, 0, 0);
                    P2 = __builtin_amdgcn_mfma_f32_16x16x16bf16_1k(*reinterpret_cast<s16x4v*>(&g4), vtf, P2, 0, 0, 0);
                    *(LAS f32x4*)(SL + RC_P1 + lane * 16) = P1; *(LAS f32x4*)(SL + RC_P2 + lane * 16) = P2;
#define RC_BF(v) ({ u32x2 t_; t_.x = cvt_pk_bf16((v).x, (v).y); t_.y = cvt_pk_bf16((v).z, (v).w); *reinterpret_cast<s16x4v*>(&t_); })
                    const f32x4 Z4 = {0.f, 0.f, 0.f, 0.f};
                    const s16x4v n1 = RC_BF(G1), n1t = RC_BF(G1t);
                    const f32x4 X2 = __builtin_amdgcn_mfma_f32_16x16x16bf16_1k(n1t, n1, Z4, 0, 0, 0), X2t = __builtin_amdgcn_mfma_f32_16x16x16bf16_1k(n1, n1t, Z4, 0, 0, 0);
                    const s16x4v n2 = RC_BF(X2), n2t = RC_BF(X2t);
                    const f32x4 X4 = __builtin_amdgcn_mfma_f32_16x16x16bf16_1k(n2t, n2, Z4, 0, 0, 0), X4t = __builtin_amdgcn_mfma_f32_16x16x16bf16_1k(n2, n2t, Z4, 0, 0, 0);
                    const s16x4v n4 = RC_BF(X4), n4t = RC_BF(X4t);
                    f32x4 Tm = __builtin_amdgcn_mfma_f32_16x16x16bf16_1k(n4t, n4, Z4, 0, 0, 0);
#pragma unroll
                    for (int e = 0; e < 4; ++e) Tm[e] += (4 * kg + e == l15) ? 1.f : 0.f;
                    Tm = __builtin_amdgcn_mfma_f32_16x16x16bf16_1k(n4t, RC_BF(Tm), Tm, 0, 0, 0);
                    Tm = __builtin_amdgcn_mfma_f32_16x16x16bf16_1k(n2t, RC_BF(Tm), Tm, 0, 0, 0);
                    Tm = __builtin_amdgcn_mfma_f32_16x16x16bf16_1k(n1t, RC_BF(Tm), Tm, 0, 0, 0);
                    { u32x2 tt; tt.x = cvt_pk_bf16(Tm.x, Tm.y); tt.y = cvt_pk_bf16(Tm.z, Tm.w); *(LAS u32x2*)(SL + RC_TT + lane * 8) = tt; }
#undef RC_BF
                }
                asm volatile("s_waitcnt lgkmcnt(0)" ::: "memory");
#if RC_SYNC
                __builtin_amdgcn_s_barrier();
#else
                if (lane == 0) flags[slot] = (unsigned)(n + 1);
#endif
            }
#if RC_SYNC
            if (p >= RC_NCH % 7) { __builtin_amdgcn_s_barrier(); __builtin_amdgcn_s_barrier(); }
#endif
        }
#undef RC_LOADS
        __syncthreads();
    }
}
__device__ __forceinline__ void rwkv_post(const Fr& F) {
    const bf16_t* Rr = slotY(F, 0); const bf16_t* K = slotY(F, 1); const bf16_t* V = slotY(F, 2); const bf16_t* GT = slotY(F, 3); const bf16_t* A = slotY(F, 5);
    const float* O32 = (const float*)slotU(F, 1); bf16_t* Z = slotU(F, 0);
    const float* k_a = F.in(24); const float* r_k = F.in(25); const float* lw = F.in(26); const float* lb = F.in(27);
    for (int r = F.gw; r < R; r += F.NGW) {
        const bool real = (r >= NPAD && r < NREAL);
        u32x2* zr = (u32x2*)(Z + (size_t)r * D) + F.lane;
        if (!real) { const u32x2 z = {0u, 0u};
#pragma unroll
            for (int it = 0; it < 16; ++it) zr[64 * it] = z;
            continue; }
        ROW_F32(oq, O32 + (size_t)r * D, F.lane); ROW_BF(rq_, Rr + (size_t)r * D, F.lane); ROW_BF(kq_, K + (size_t)r * D, F.lane); ROW_BF(vq_, V + (size_t)r * D, F.lane);
        ROW_BF(gq_, GT + (size_t)r * D, F.lane); ROW_BF(aq_, A + (size_t)r * D, F.lane); ROW_BF(zq_, Z + (size_t)r * D, F.lane);
        ROW_F32(kap, k_a, F.lane); ROW_F32(rkp, r_k, F.lane); ROW_F32(lwp, lw, F.lane); ROW_F32(lbp, lb, F.lane);
#pragma unroll
        for (int hh = 0; hh < 2; ++hh) {
            f32x4 o4v[8]; u32x2 rrv[8], kkv[8], vvv[8], ggv[8], aav[8];
#pragma unroll
            for (int i8 = 0; i8 < 8; ++i8) { const int it = 8 * hh + i8; o4v[i8] = AT_F32(oq, it); rrv[i8] = AT_BF(rq_, it); kkv[i8] = AT_BF(kq_, it); vvv[i8] = AT_BF(vq_, it); ggv[i8] = AT_BF(gq_, it); aav[i8] = AT_BF(aq_, it); }
#pragma unroll
            for (int i8 = 0; i8 < 8; ++i8) { const int it = 8 * hh + i8;
                const f32x4 o4 = o4v[i8]; const u32x2 rr = rrv[i8], kk = kkv[i8], vv = vvv[i8], gg = ggv[i8], aa = aav[i8];
                const f32x4 ka4 = AT_F32(kap, it), rk4 = AT_F32(rkp, it), lw4 = AT_F32(lwp, it), lb4 = AT_F32(lbp, it);
                const float mean = red16((o4.x + o4.y) + (o4.z + o4.w)) * (1.f / 64.f);
                const float d0 = o4.x - mean, d1 = o4.y - mean, d2 = o4.z - mean, d3 = o4.w - mean;
                const float var = red16((d0 * d0 + d1 * d1) + (d2 * d2 + d3 * d3)) * (1.f / 64.f);
                const float rs = __builtin_amdgcn_rsqf(var + 64e-5f);
                const float r0 = bflo(rr.x), r1 = bfhi(rr.x), r2 = bflo(rr.y), r3 = bfhi(rr.y);
                const float kp0 = bflo(kk.x) * (1.f + (bflo(aa.x) - 1.f) * ka4.x), kp1 = bfhi(kk.x) * (1.f + (bfhi(aa.x) - 1.f) * ka4.y), kp2 = bflo(kk.y) * (1.f + (bflo(aa.y) - 1.f) * ka4.z), kp3 = bfhi(kk.y) * (1.f + (bfhi(aa.y) - 1.f) * ka4.w);
                const float bs = red16((r0 * kp0 * rk4.x + r1 * kp1 * rk4.y) + (r2 * kp2 * rk4.z + r3 * kp3 * rk4.w));
                const float y0 = d0 * rs * lw4.x + lb4.x + bs * bflo(vv.x), y1 = d1 * rs * lw4.y + lb4.y + bs * bfhi(vv.x), y2 = d2 * rs * lw4.z + lb4.z + bs * bflo(vv.y), y3 = d3 * rs * lw4.w + lb4.w + bs * bfhi(vv.y);
                u32x2 w; w.x = cvt_pk_bf16(y0 * silu_f(bflo(gg.x)), y1 * silu_f(bfhi(gg.x))); w.y = cvt_pk_bf16(y2 * silu_f(bflo(gg.y)), y3 * silu_f(bfhi(gg.y)));
                AT_BF(zq_, it) = w;
            }
        }
    }
}
}
namespace mk {
constexpr int LDS_BYTES = 163840;
constexpr int LDS_MISC = LDS_BYTES - 128;
struct Args { const float* in[29]; float* out; unsigned char* ws; };

#define MK_GEMM(EPI, e, Aptr, aps_, Bptr, M_, N_, K_) do { int kk_ = (K_); asm volatile("" : "+s"(kk_));     \
    pg8::Gemm g_{(const bf16_t*)(Aptr), (const bf16_t*)(Bptr), (M_), (N_), kk_, (size_t)(aps_)}; pg8::StaticOrder S_; S_.init((M_), (N_), F.G, F.bid); \
    pg8::gemm_phase<EPI, pg8::StaticOrder, false>(F.lds, g_, S_, e, nullptr); } while (0)

struct TailOrder { int pn;
    __device__ bool next(int i, pg8::Unit& u) const { if (i > 0 || pn < 0) return false; u.pm = 64; u.pn = pn; return true; }
    __device__ __forceinline__ void a_ready(const pg8::Unit&) const {}
    __device__ __forceinline__ void done(const pg8::Unit&) const {}
};
struct RwTail { int pm, pn;
    __device__ bool next(int i, pg8::Unit& u) const { if (i > 0) return false; u.pm = pm; u.pn = pn; return true; }
    __device__ __forceinline__ void a_ready(const pg8::Unit&) const {}
    __device__ __forceinline__ void done(const pg8::Unit&) const {}
};
#define MK_GEMM1(EPI, e, aps_, NTOT_, L_) do { MK_GEMM(EPI, e, slotU(F, 0), aps_, wtin_of(F, L_), 16384, NTOT_, D); \
    if (F.bid < (NTOT_) / 256) { int kk_ = D; asm volatile("" : "+s"(kk_)); pg8::Gemm g_{(const bf16_t*)slotU(F, 0), (const bf16_t*)wtin_of(F, L_), R, (NTOT_), kk_, (size_t)(aps_)}; TailOrder St_{F.bid}; \
        pg8::gemm_phase<EPI, TailOrder, false, true>(F.lds, g_, St_, e, nullptr); } } while (0)
#define MK_GEMM2_NORM(prev, next, udst) do { \
    MK_GEMM(EpiY, ey, slotU(F, 0), 0, wtout, 16384, D, D); \
    GRID_BAR(); \
    if (F.bid < 16) { int kk_ = D; asm volatile("" : "+s"(kk_)); pg8::Gemm g_{(const bf16_t*)slotU(F, 0), (const bf16_t*)wtout, R, D, kk_, (size_t)0}; TailOrder St_{F.bid}; \
        pg8::gemm_phase<EpiY, TailOrder, false, true>(F.lds, g_, St_, ey, nullptr); } \
    else { const Fr P = F.fresh(); norm_phase(P, prev, next, slotY(P, 0), udst, 0, 16384, 16); } \
    GRID_BAR(); \
    { const Fr P = F.fresh(); norm_phase(P, prev, next, slotY(P, 0), udst, 16384, R, 0); if ((next) >= 0) convert_layer(P, next, (next) == 3); } \
    GRID_BAR(); } while (0)

__global__ void __launch_bounds__(512, 2) fwd(Args a) {
    extern __shared__ __attribute__((aligned(16))) unsigned char lds_raw[];
    Fr F;
    F.lds = (LAS unsigned char*)lds_raw; F.ldsg = lds_raw;
    F.tid = threadIdx.x; F.lane = F.tid & 63; F.wave = __builtin_amdgcn_readfirstlane(F.tid >> 6);
    F.G = gridDim.x; F.bid = blockIdx.x; F.gw = F.bid * 8 + F.wave; F.NGW = F.G * 8;
    F.out = a.out; F.ws = a.ws;
    volatile LAS unsigned* misc = (volatile LAS unsigned*)(F.lds + LDS_MISC);
    if (F.tid < 16) misc[F.tid] = 0u;
    __syncthreads();
    XcdBarrier bar = xcd_barrier_post((unsigned*)(F.ws + WS_CTL) + 4096, misc + 8);
#ifdef MK_BAR2
#define GRID_BAR() do { xcd_barrier(bar); xcd_barrier(bar); } while (0)
#else
#define GRID_BAR() xcd_barrier(bar)
#endif
#ifndef MK_DUP
#define MK_DUP 0
#endif
#ifndef MK_CLK
#define MK_CLK 0
#endif
#define CLK_SPIN() do { const unsigned long long dc_ = clock64() - clk_c0, dr_ = wall_clock64() - clk_r0; const long mhz_ = (long)(dc_ * 100ull / (dr_ ? dr_ : 1ull)); \
        const long ticks_ = (2400 - mhz_) * 200; const unsigned long long r1_ = wall_clock64(); while ((long)(wall_clock64() - r1_) < ticks_) __builtin_amdgcn_s_sleep(8); } while (0)
#ifndef MK_PH
#define MK_PH 0
#endif
    unsigned long long ph_r0_ = 0ull;
#define PH_BEGIN(id) do { if ((MK_PH >> (id)) & 1) ph_r0_ = wall_clock64(); } while (0)
#define PH_END(id) do { if ((MK_PH >> (id)) & 1) { const unsigned long long dr_ = wall_clock64() - ph_r0_, r1_ = wall_clock64(); while ((unsigned long long)(wall_clock64() - r1_) < dr_) __builtin_amdgcn_s_sleep(8); } } while (0)
#define DUPN(k, ...) do { __VA_ARGS__; if ((MK_DUP >> (k)) & 1) { GRID_BAR(); __VA_ARGS__; } } while (0)
    bf16_t* wtout = (bf16_t*)(F.ws + WS_WTOUT);
    const EpiY ey{slotY(F, 0)};

    PH_BEGIN(1);
    DUPN(11, { const Fr P = F.fresh(); convert_layer(P, 0, true); rope_table(P); norm_phase(P, -1, 0, nullptr, slotU(P, 0)); });
    PH_END(1);
    GRID_BAR();
#if MK_CLK == 1 || MK_CLK == 11
    const unsigned long long clk_c0 = clock64(), clk_r0 = wall_clock64();
#endif
    PH_BEGIN(15);
    { const EpiH1 e{slotY(F, 0), F.in(5), 0}; MK_GEMM1(EpiH1, e, 0, 4 * D, 0); }
#if MK_CLK == 1
    CLK_SPIN();
#endif
#if MK_CLK == 11
    { const unsigned long long dr_ = wall_clock64() - clk_r0, r1_ = wall_clock64(); while ((unsigned long long)(wall_clock64() - r1_) < dr_) __builtin_amdgcn_s_sleep(8); }
#endif
#if defined(MK_KPROBE) && !defined(MK_KPROBE_L1)
    { __syncthreads(); const unsigned kc_ = misc[20]; const unsigned long long r1_ = wall_clock64(); while ((unsigned long long)(wall_clock64() - r1_) < (unsigned long long)kc_) __builtin_amdgcn_s_sleep(8); }
#endif
    if (F.bid >= 64) { const Fr P = F.fresh(); convert_win(P, 1, 64); }
    PH_END(15);
    GRID_BAR();
    PH_BEGIN(13);
    DUPN(1, { const Fr P = F.fresh(); hgrn_phase<false>(P, 0); });
    PH_END(13);
    GRID_BAR();
    PH_BEGIN(14);
    DUPN(2, { const Fr P = F.fresh(); hgrn_phase<true>(P, 0); });
    PH_END(14);
    GRID_BAR();
    PH_BEGIN(2);
    MK_GEMM2_NORM(0, 1, slotU(F, 0));
    PH_END(2);
    PH_BEGIN(16);
    { const EpiB1 e{slotY(F, 0), (const float*)(F.ws + WS_ROPE), (const float*)(F.ws + WS_ROPE) + (size_t)R * 16}; PH_BEGIN(20); MK_GEMM1(EpiB1, e, 0, 4 * D, 1); PH_END(20); }
    PH_BEGIN(21);
#ifdef MK_KPROBE_L1
    { __syncthreads(); const unsigned kc_ = misc[20]; const unsigned long long r1_ = wall_clock64(); while ((unsigned long long)(wall_clock64() - r1_) < (unsigned long long)kc_) __builtin_amdgcn_s_sleep(8); }
#endif
    if (F.bid >= 64) { const Fr P = F.fresh(); convert_win(P, 2, 64); }
    PH_END(21);
    PH_END(16);
    GRID_BAR();
#if MK_CLK == 3
    const unsigned long long clk_c0 = clock64(), clk_r0 = wall_clock64();
#endif
    PH_BEGIN(6);
    DUPN(3, { const Fr P = F.fresh(); attn_phase(P); });
    PH_END(6);
#if MK_CLK == 3
    CLK_SPIN();
#endif
    GRID_BAR();
    PH_BEGIN(7);
    DUPN(4, { const Fr P = F.fresh(); attn_post(P); });
    PH_END(7);
    GRID_BAR();
    PH_BEGIN(3);
    MK_GEMM2_NORM(1, 2, slotY(F, 1));
    PH_END(3);
    PH_BEGIN(8);
    DUPN(7, { const Fr P = F.fresh(); mix_phase(P, slotY(P, 1)); convert_layer2_b(P); });
    PH_END(8);
    GRID_BAR();
    PH_BEGIN(9);
    { const EpiC1 e{slotY(F, 0), (bf16_t*)(F.ws + WS_T)}; MK_GEMM(EpiC1, e, slotU(F, 0), (size_t)R * D, wtin_of(F, 2), 16384, 4 * D, D);
      if (F.bid < 194) { int kk_ = D; asm volatile("" : "+s"(kk_)); pg8::Gemm g_{(const bf16_t*)slotU(F, 0), (const bf16_t*)wtin_of(F, 2), R, 4 * D + 512, kk_, (size_t)R * D};
          if (F.bid < 64) { RwTail St_{64, F.bid}; pg8::gemm_phase<EpiC1, RwTail, false, true, false>(F.lds, g_, St_, e, nullptr); }
          else if (F.bid < 192) { RwTail St_{(F.bid - 64) >> 1, 64 + ((F.bid - 64) & 1)}; pg8::gemm_phase<EpiC1, RwTail, false, false, true>(F.lds, g_, St_, e, nullptr); }
          else { RwTail St_{64, 64 + (F.bid - 192)}; pg8::gemm_phase<EpiC1, RwTail, false, true, true>(F.lds, g_, St_, e, nullptr); } } }
    PH_END(9);
    GRID_BAR();
    PH_BEGIN(10);
    DUPN(9, { const Fr P = F.fresh(); lora2_phase(P); });
    { const Fr P = F.fresh(); rwkv_kknorm(P); }
    PH_END(10);
    GRID_BAR();
    PH_BEGIN(11);
    DUPN(5, { const Fr P = F.fresh(); rwkv_scan(P); });
    PH_END(11);
    GRID_BAR();
    PH_BEGIN(12);
    DUPN(6, { const Fr P = F.fresh(); rwkv_post(P); });
    PH_END(12);
    GRID_BAR();
    PH_BEGIN(4);
    MK_GEMM2_NORM(2, 3, slotU(F, 0));
    PH_END(4);
    PH_BEGIN(17);
    { const EpiH1 e{slotY(F, 0), F.in(5), 1}; MK_GEMM1(EpiH1, e, 0, 4 * D, 3); }
    if (F.bid >= 64) { const Fr P = F.fresh(); convert_wout3(P, 64); }
    PH_END(17);
    GRID_BAR();
    PH_BEGIN(18);
    { const Fr P = F.fresh(); hgrn_phase<false>(P, 1); }
    PH_END(18);
    GRID_BAR();
    PH_BEGIN(19);
    { const Fr P = F.fresh(); hgrn_phase<true>(P, 1); }
    PH_END(19);
    GRID_BAR();
    PH_BEGIN(5);
    MK_GEMM2_NORM(3, -1, (bf16_t*)nullptr);
    PH_END(5);
}
}

extern "C" void kernel_launch(void* const* d_in, const int* in_sizes, int n_in, void* d_out, int out_size, void* d_ws, size_t ws_size, hipStream_t stream) {
    static int grid = 0;
    if (grid == 0) {
        if (n_in != 29 || out_size != 16384 * 4096 || ws_size < mk::WS_END) { fprintf(stderr, "kernel_launch: unexpected shapes (n_in %d out %d ws %zu need %zu)\n", n_in, out_size, ws_size, (size_t)mk::WS_END); grid = -1; return; }
        int dev = 0, cus = 0, per_cu = 0;
        if (hipGetDevice(&dev) != hipSuccess || hipDeviceGetAttribute(&cus, hipDeviceAttributeMultiprocessorCount, dev) != hipSuccess) { grid = -1; return; }
        if (hipFuncSetAttribute((const void*)mk::fwd, hipFuncAttributeMaxDynamicSharedMemorySize, mk::LDS_BYTES) != hipSuccess) { fprintf(stderr, "kernel_launch: hipFuncSetAttribute failed\n"); grid = -1; return; }
        if (hipOccupancyMaxActiveBlocksPerMultiprocessor(&per_cu, (const void*)mk::fwd, 512, mk::LDS_BYTES) != hipSuccess || per_cu < 1) { fprintf(stderr, "kernel_launch: occupancy query says %d\n", per_cu); }
        (void)hipGetLastError();
        grid = cus;
    }
    if (grid < 0) return;
    if (hipMemsetAsync((char*)d_ws + mk::WS_CTL, 0, mk::CTL_BYTES, stream) != hipSuccess) return;
    mk::Args a{};
    for (int i = 0; i < 29; ++i) a.in[i] = (const float*)d_in[i];
    a.out = (float*)d_out; a.ws = (unsigned char*)d_ws;
    hipLaunchKernelGGL(mk::fwd, dim3(grid), dim3(512), mk::LDS_BYTES, stream, a);
}
```

```cpp
#include <hip/hip_runtime.h>
#include <cstdio>
#include <cstdint>

#define LAS __attribute__((address_space(3)))
#define GAS __attribute__((address_space(1)))
typedef unsigned short bf16_t;
typedef short bf16x8 __attribute__((ext_vector_type(8)));
typedef short s16x4 __attribute__((ext_vector_type(4)));
typedef float f32x4 __attribute__((ext_vector_type(4)));
typedef float f32x16 __attribute__((ext_vector_type(16)));
typedef unsigned u32x4 __attribute__((ext_vector_type(4)));
typedef unsigned u32x2 __attribute__((ext_vector_type(2)));

namespace mk {
constexpr int D = 4096, NPAD = 48, NREAL = 16448, R = 16640, NCH = 257;
constexpr size_t MiB = 1u << 20;
constexpr size_t SLOT = (size_t)R * D * 2;
constexpr size_t WS_CTL = 0, CTL_BYTES = 1 * MiB;
constexpr size_t WS_WTIN = 2 * MiB;
constexpr size_t WS_WTOUT = 134 * MiB;
constexpr size_t WS_W2P = 166 * MiB;
constexpr size_t WS_ROPE = 170 * MiB;
constexpr size_t WS_HMETA = 174 * MiB;
constexpr size_t WS_HE = 175 * MiB;
constexpr size_t WS_HLOGD = 191 * MiB;
constexpr size_t WS_U = 192 * MiB;
constexpr size_t WS_Y = WS_U + 6 * SLOT;
constexpr size_t WS_T = WS_Y + 6 * SLOT;
constexpr size_t WS_WTINB = WS_U + 4 * SLOT;
constexpr size_t WS_HB = (WS_T + (size_t)R * 256 * 2 + MiB - 1) / MiB * MiB;
constexpr size_t WS_END = WS_HB + SLOT;
static_assert(WS_END <= 2040 * MiB, "d_ws map");

typedef __bf16 bf16x2n_t __attribute__((ext_vector_type(2)));
typedef float f32x2n_t __attribute__((ext_vector_type(2)));
__device__ __forceinline__ unsigned cvt_pk_bf16(float lo, float hi) { const f32x2n_t v = {lo, hi}; const bf16x2n_t r = __builtin_convertvector(v, bf16x2n_t); return __builtin_bit_cast(unsigned, r); }
__device__ __forceinline__ float bflo(unsigned w) { return __uint_as_float(w << 16); }
__device__ __forceinline__ float bfhi(unsigned w) { return __uint_as_float(w & 0xffff0000u); }
__device__ __forceinline__ float bf2f(bf16_t b) { return __uint_as_float(((unsigned)b) << 16); }
__device__ __forceinline__ bf16_t f2bf(float f) { return (bf16_t)(cvt_pk_bf16(f, f) & 0xffffu); }
__device__ __forceinline__ float sigmoid_f(float x) { return __builtin_amdgcn_rcpf(1.f + __expf(-x)); }
__device__ __forceinline__ float silu_f(float x) { return x * __builtin_amdgcn_rcpf(1.f + __expf(-x)); }
__device__ __forceinline__ float wave_sum(float v) {
#pragma unroll
    for (int o = 1; o < 64; o <<= 1) v += __shfl_xor(v, o);
    return v;
}
template <int CTRL> __device__ __forceinline__ float dppf(float v) { return __int_as_float(__builtin_amdgcn_update_dpp(0, __float_as_int(v), CTRL, 0xf, 0xf, true)); }
__device__ __forceinline__ float red4(float v) { v += dppf<0xB1>(v); v += dppf<0x4E>(v); return v; }
__device__ __forceinline__ float red8(float v) { v = red4(v); v += dppf<0x141>(v); return v; }
__device__ __forceinline__ float red16(float v) { v = red8(v); v += dppf<0x140>(v); return v; }
#define LDS_WAIT() asm volatile("s_waitcnt lgkmcnt(0)" ::: "memory")
}
#define XB_TMO      128
#define XB_XCNT(j)  (256  + 64 * (j))
#define XB_XSUB(j)  (1280 + 64 * (j))
#define XB_XGEN(j)  (2304 + 64 * (j))
#define XB_TOP      3328
#define XB_TOPGEN   3392
#define XCD_BAR_WORDS 3456
#define XB_SPIN_CAP (1u << 18)
#define LAS __attribute__((address_space(3)))

__device__ __forceinline__ unsigned xb_ld(unsigned* p)              { return __hip_atomic_load(p, __ATOMIC_RELAXED, __HIP_MEMORY_SCOPE_AGENT); }
__device__ __forceinline__ unsigned xb_add(unsigned* p, unsigned v) { return __hip_atomic_fetch_add(p, v, __ATOMIC_RELAXED, __HIP_MEMORY_SCOPE_AGENT); }
__device__ __forceinline__ unsigned xb_xcc_id() { return (unsigned)__builtin_amdgcn_s_getreg((3 << 11) | 20) & 0xFu; }
#define XB_SPIN(cond, bar) do { unsigned _sp = 0; while (cond) { __builtin_amdgcn_s_sleep(1); \
    if ((++_sp & 255u) == 0u) { if (xb_ld(&(bar)[XB_TMO])) break; if (_sp > XB_SPIN_CAP) { atomicAdd(&(bar)[XB_TMO], 1u); break; } } } } while (0)

struct XcdBarrier {
    unsigned* bar; unsigned x;
    volatile LAS unsigned* st;
};

__device__ __forceinline__ XcdBarrier xcd_barrier_post(unsigned* bar, volatile LAS unsigned* st) {
    XcdBarrier b; b.bar = bar; b.x = xb_xcc_id(); b.st = st;
    if (threadIdx.x == 0) (void)xb_add(&bar[XB_XCNT(b.x)], 1u);
    return b;
}
__device__ __forceinline__ void xcd_barrier_complete(unsigned* bar, unsigned x, unsigned& nloc, unsigned& nx) {
    const unsigned G = gridDim.x * gridDim.y * gridDim.z;
    unsigned sum, cnt, mine, sp = 0u;
    for (;;) {
        sum = 0u; cnt = 0u; mine = 0u;
#pragma unroll
        for (unsigned j = 0; j < 16; ++j) { const unsigned c = xb_ld(&bar[XB_XCNT(j)]); sum += c; cnt += (c > 0u) ? 1u : 0u; mine = (j == x) ? c : mine; }
        if (sum == G) break;
        __builtin_amdgcn_s_sleep(1);
        if ((++sp & 255u) == 0u) { if (xb_ld(&bar[XB_TMO])) break; if (sp > XB_SPIN_CAP) { atomicAdd(&bar[XB_TMO], 1u); break; } }
    }
    nloc = mine > 0u ? mine : 1u; nx = cnt > 0u ? cnt : 1u;
}

__device__ __forceinline__ void xcd_barrier(const XcdBarrier& b) {
    asm volatile("s_waitcnt vmcnt(0)" ::: "memory");
    __syncthreads();
    if (threadIdx.x == 0) {
        unsigned* bar = b.bar;
        __builtin_amdgcn_s_waitcnt(0);
        unsigned nloc = b.st[0], nx = b.st[1];
        if (nloc == 0u) { xcd_barrier_complete(bar, b.x, nloc, nx); b.st[0] = nloc; b.st[1] = nx; }
        const unsigned old = xb_add(&bar[XB_XSUB(b.x)], 1u);
        const unsigned gen = old / nloc;
        if (old + 1u == (gen + 1u) * nloc) {
            __builtin_amdgcn_fence(__ATOMIC_RELEASE, "agent");
            asm volatile("s_waitcnt vmcnt(0)" ::: "memory");
            const unsigned og = xb_add(&bar[XB_TOP], 1u);
            const unsigned tg = og / nx;
            if (og + 1u == (tg + 1u) * nx) xb_add(&bar[XB_TOPGEN], 1u);
            else XB_SPIN(xb_ld(&bar[XB_TOPGEN]) == tg, bar);
            __builtin_amdgcn_fence(__ATOMIC_ACQUIRE, "agent");
            xb_add(&bar[XB_XGEN(b.x)], 1u);
            asm volatile("s_waitcnt vmcnt(0)" ::: "memory");
        } else {
            XB_SPIN(xb_ld(&bar[XB_XGEN(b.x)]) == gen, bar);
            __builtin_amdgcn_fence(__ATOMIC_ACQUIRE, "agent");
            asm volatile("s_waitcnt vmcnt(0)" ::: "memory");
        }
    }
    __syncthreads();
}
#ifndef MK_WGM
#define MK_WGM 8
#endif
namespace pg8 {
#define PG8_LAS __attribute__((address_space(3)))
typedef unsigned short bf16_t;
typedef short bf16x8 __attribute__((ext_vector_type(8)));
typedef float f32x4 __attribute__((ext_vector_type(4)));
typedef unsigned u32x4 __attribute__((ext_vector_type(4)));
constexpr int BM = 256, BK = 64, HALF = 128, HTB = HALF * BK * 2  , STAGE_BYTES = 8 * HTB, NXCD = 8, WGM = 8;

__host__ __device__ __forceinline__ int lds_byte(int r, int c) { const int st = (r >> 4) * 2 + (c >> 5), rr = r & 15, cc = c & 31, ob = rr * 64 + cc * 2; return st * 1024 + (ob ^ (((ob >> 9) & 1) << 5)); }
__host__ __device__ __forceinline__ void stage_rc(int b, int& R, int& C) { const int st = b / 1024, sb = b % 1024, swz = sb ^ (((sb >> 9) & 1) << 5); R = (st >> 1) * 16 + swz / 64; C = (st & 1) * 32 + (swz % 64) / 2; }
__host__ __device__ __forceinline__ int perm32(int rho) { const int n = rho >> 4, i = rho & 15; return 8 * (i >> 2) + 4 * n + (i & 3); }

struct Unit { int pm, pn; };
struct Gemm { const bf16_t* A; const bf16_t* Bt; int M, N, K; size_t aps; };
__device__ __forceinline__ size_t a_part_bytes(const Gemm& g, int pn) { return g.aps ? (size_t)(pn < 64 ? (pn >> 4) : (pn - 60)) * g.aps * 2 : (size_t)0; }

struct StaticOrder {
    int nM, nN, nwg, G, c;
    __host__ __device__ void init(int M, int N, int G_, int c_) { nM = M / BM; nN = N / BM; nwg = nM * nN; G = G_; c = c_; }
    __host__ __device__ bool next(int i, Unit& u) const {
        const long L = (long)i * G + c; if (L >= nwg) return false;
        int wgid = (int)L; { const int q = nwg / NXCD, r = nwg % NXCD, xcd = wgid % NXCD, off = wgid / NXCD; wgid = (xcd < r ? xcd * (q + 1) : r * (q + 1) + (xcd - r) * q) + off; }
        const int nig = WGM * nN, gid = wgid / nig, fm = gid * WGM, gsz = (nM - fm) < WGM ? (nM - fm) : WGM;
        u.pm = fm + ((wgid % nig) % gsz); u.pn = (wgid % nig) / gsz; return true;
    }
    __device__ __forceinline__ void a_ready(const Unit&) const {}
    __device__ __forceinline__ void done(const Unit&) const {}
};
struct CountedOrder : StaticOrder {
    const unsigned* ready; unsigned need; unsigned* tmo;
    __device__ __forceinline__ void a_ready(const Unit& u) const {
        if (threadIdx.x < 64) {
            const unsigned long long t0 = __builtin_amdgcn_s_memrealtime(); unsigned polls = 0;
            while ((unsigned)__builtin_amdgcn_readfirstlane(__hip_atomic_load(ready + 64 * u.pm, __ATOMIC_RELAXED, __HIP_MEMORY_SCOPE_AGENT)) < need) {
                if ((++polls & 255u) == 0u && __builtin_amdgcn_readfirstlane(__hip_atomic_load(tmo, __ATOMIC_RELAXED, __HIP_MEMORY_SCOPE_AGENT)) != 0u) break;
                if (__builtin_amdgcn_s_memrealtime() - t0 > 2000000ull) {
                    if (threadIdx.x == 0) { unsigned expect = 0u; __hip_atomic_compare_exchange_strong(tmo + 1, &expect, 0x600u | (unsigned)(u.pm & 0xff), __ATOMIC_RELAXED, __ATOMIC_RELAXED, __HIP_MEMORY_SCOPE_AGENT); __hip_atomic_store(tmo, 1u, __ATOMIC_RELAXED, __HIP_MEMORY_SCOPE_AGENT); }
                    break; }
                __builtin_amdgcn_s_sleep(2); }
            __builtin_amdgcn_fence(__ATOMIC_ACQUIRE, "agent");
            asm volatile("s_waitcnt vmcnt(0)" ::: "memory");
        }
#if !defined(BROKEN_HOOK_NO_BARRIER)
        asm volatile("" ::: "memory"); __builtin_amdgcn_s_barrier(); asm volatile("" ::: "memory");
#endif
    }
};
template <class Epi, class Sched, bool STAMP = false, bool TOPHALF = false, bool LEFTHALF = false>
__device__ __forceinline__ void gemm_phase(PG8_LAS unsigned char* lds, const Gemm g, const Sched& S, const Epi& E, unsigned long long* stamps) {
    int tid_ = threadIdx.x; asm volatile("" : "+v"(tid_));
    const int tid = tid_, wid = __builtin_amdgcn_readfirstlane(tid >> 6), lane = tid & 63, wr = wid >> 2, wc = wid & 3, fr = lane & 15, fq = lane >> 4;
    const int K = g.K, nt = K / BK;
    int ts_lo = 0, ts_hi = 0, nts = 0; const unsigned long long rt_entry = STAMP ? (unsigned long long)wall_clock64() : 0ull;
#define PG8_STAMP() do { if (STAMP && wid == 0 && nts < 64) { const unsigned long long _c = (unsigned long long)clock64(); \
        ts_lo = (lane == nts) ? (int)(unsigned)_c : ts_lo; ts_hi = (lane == nts) ? (int)(unsigned)(_c >> 32) : ts_hi; ++nts; } } while (0)
    PG8_STAMP();
    unsigned voffA[2], voffB[2];
#pragma unroll
    for (int i = 0; i < 2; ++i) { int R, C; stage_rc(tid * 16 + i * 8192, R, C); const int Rb = Epi::PERM ? ((R & ~31) + perm32(R & 31)) : R;
        voffA[i] = (unsigned)(R * K + C) * 2u; voffB[i] = (unsigned)(Rb * K + C) * 2u; }
    const size_t kstep = (size_t)(BK * 2);
    const size_t hstep = (size_t)HALF * K * 2;
    const size_t tstep = 2 * hstep;
    const unsigned ldsw = (unsigned)wid * 1024u;
    const int aoff = lds_byte(wr * 64 + fr, fq * 8), boff = lds_byte(wc * 32 + fr, fq * 8);
#define PG8_SA(b, h) (((b) * 2 + (h)) * HTB)
#define PG8_SB(b, h) ((4 + (b) * 2 + (h)) * HTB)
#define PG8_STAGE(bufoff, gbase, voff) do { _Pragma("unroll") for (int _i = 0; _i < 2; ++_i) \
        __builtin_amdgcn_global_load_lds((const unsigned*)((const char*)(gbase) + (voff)[_i]), (PG8_LAS unsigned*)(lds + (bufoff) + ldsw + _i * 8192), 16, 0, 0); } while (0)
#define PG8_LDA(dst, b, h) do { _Pragma("unroll") for (int m = 0; m < 4; ++m) _Pragma("unroll") for (int k = 0; k < 2; ++k) dst[m][k] = *(const PG8_LAS bf16x8*)(lds + PG8_SA(b, h) + aoff + m * 2048 + k * 1024); } while (0)
#define PG8_LDB(dst, b, h) do { _Pragma("unroll") for (int n = 0; n < 2; ++n) _Pragma("unroll") for (int k = 0; k < 2; ++k) dst[n][k] = *(const PG8_LAS bf16x8*)(lds + PG8_SB(b, h) + boff + n * 2048 + k * 1024); } while (0)
#define PG8_MMA(ai, bj, At, Bt) do { __builtin_amdgcn_s_setprio(1); _Pragma("unroll") for (int m = 0; m < 4; ++m) _Pragma("unroll") for (int n = 0; n < 2; ++n) _Pragma("unroll") for (int k = 0; k < 2; ++k) \
        acc[ai][bj][m][n] = __builtin_amdgcn_mfma_f32_16x16x32_bf16(Bt[n][k], At[m][k], acc[ai][bj][m][n], 0, 0, 0); __builtin_amdgcn_s_setprio(0); } while (0)
#define PG8_WAIT_V(n) asm volatile("s_waitcnt vmcnt(" #n ")" ::: "memory")
#define PG8_WAIT_L(n) asm volatile("s_waitcnt lgkmcnt(" #n ")" ::: "memory")
#define PG8_BAR __builtin_amdgcn_s_barrier()
#define PG8_SCHED __builtin_amdgcn_sched_barrier(0)
    Unit cur, nxt; int ui = 0;
    if (!S.next(0, cur)) return;
    f32x4 acc[2][2][4][2];
#pragma unroll
    for (int a = 0; a < 2; ++a)
#pragma unroll
        for (int b = 0; b < 2; ++b)
#pragma unroll
            for (int m = 0; m < 4; ++m)
#pragma unroll
                for (int n = 0; n < 2; ++n) acc[a][b][m][n] = (f32x4){0.f, 0.f, 0.f, 0.f};
    bf16x8 At[4][2], B0[2][2], B1[2][2];
    const char* cA = (const char*)g.A + a_part_bytes(g, cur.pn) + (size_t)cur.pm * tstep; const char* cB = (const char*)g.Bt + (size_t)cur.pn * tstep;
    S.a_ready(cur);
    PG8_STAGE(PG8_SB(0, 0), cB, voffB); PG8_STAGE(PG8_SA(0, 0), cA, voffA); PG8_STAGE(PG8_SB(0, 1), cB + hstep, voffB); PG8_STAGE(PG8_SA(0, 1), cA + hstep, voffA);
    if (wr == 1) PG8_BAR;
    PG8_WAIT_V(4); PG8_BAR;
    PG8_STAGE(PG8_SB(1, 0), cB + kstep, voffB); PG8_STAGE(PG8_SA(1, 0), cA + kstep, voffA); PG8_STAGE(PG8_SB(1, 1), cB + hstep + kstep, voffB);
    PG8_WAIT_V(6); PG8_BAR;
    PG8_STAMP();
#ifdef MK_KPROBE
    unsigned long long kp_a_ = 0ull, kp_prev_ = 0ull;
#endif
    for (;;) {
#ifdef MK_KPROBE
        if (MK_KPROBE == 1 && ui == 2) kp_a_ = clock64();
#endif
        const bool has_next = S.next(ui + 1, nxt);
        const char* nA = has_next ? (const char*)g.A + a_part_bytes(g, nxt.pn) + (size_t)nxt.pm * tstep : cA; const char* nB = has_next ? (const char*)g.Bt + (size_t)nxt.pn * tstep : cB;
        for (int t = 0; t < nt; t += 2) {
            const bool last = (t == nt - 2);
            const char* a1 = cA + (size_t)(t + 1) * kstep;
            const char* a2 = last ? nA : cA + (size_t)(t + 2) * kstep; const char* b2 = last ? nB : cB + (size_t)(t + 2) * kstep;
            const char* a3 = a2 + kstep; const char* b3 = b2 + kstep;
            if (last && has_next) S.a_ready(nxt);
            PG8_LDB(B0, 0, 0); PG8_SCHED; PG8_LDA(At, 0, 0); PG8_STAGE(PG8_SA(1, 1), a1 + hstep, voffA);
            PG8_WAIT_L(8); PG8_BAR; PG8_WAIT_L(0); PG8_MMA(0, 0, At, B0); PG8_BAR; PG8_SCHED;
            if constexpr (!LEFTHALF) PG8_LDB(B1, 0, 1); PG8_STAGE(PG8_SB(0, 0), b2, voffB);
            PG8_BAR; PG8_WAIT_L(0); if constexpr (!LEFTHALF) PG8_MMA(0, 1, At, B1); PG8_BAR;
            if constexpr (!TOPHALF) PG8_LDA(At, 0, 1); PG8_STAGE(PG8_SA(0, 0), a2, voffA);
            PG8_BAR; PG8_WAIT_L(0); if constexpr (!TOPHALF) PG8_MMA(1, 0, At, B0); PG8_BAR; PG8_SCHED;
            PG8_STAGE(PG8_SB(0, 1), b2 + hstep, voffB);
            PG8_WAIT_V(6); PG8_BAR; if constexpr (!TOPHALF && !LEFTHALF) PG8_MMA(1, 1, At, B1); PG8_BAR;
            PG8_LDB(B0, 1, 0); PG8_SCHED; PG8_LDA(At, 1, 0); PG8_STAGE(PG8_SA(0, 1), a2 + hstep, voffA);
            PG8_WAIT_L(8); PG8_BAR; PG8_WAIT_L(0); PG8_MMA(0, 0, At, B0); PG8_BAR; PG8_SCHED;
            if constexpr (!LEFTHALF) PG8_LDB(B1, 1, 1); PG8_STAGE(PG8_SB(1, 0), b3, voffB);
            PG8_BAR; PG8_WAIT_L(0); if constexpr (!LEFTHALF) PG8_MMA(0, 1, At, B1); PG8_BAR;
            if constexpr (!TOPHALF) PG8_LDA(At, 1, 1); PG8_STAGE(PG8_SA(1, 0), a3, voffA);
            PG8_BAR; PG8_WAIT_L(0); if constexpr (!TOPHALF) PG8_MMA(1, 0, At, B0); PG8_BAR; PG8_SCHED;
            PG8_STAGE(PG8_SB(1, 1), b3 + hstep, voffB);
            PG8_WAIT_V(6); PG8_BAR; if constexpr (!TOPHALF && !LEFTHALF) PG8_MMA(1, 1, At, B1); PG8_BAR;
        }
        PG8_STAMP();
#ifdef MK_KPROBE
        { const unsigned long long now_ = clock64();
          if (ui == 2 && tid == 0) *(volatile PG8_LAS unsigned*)(lds + 163712 + 80) = (unsigned)(now_ - (MK_KPROBE == 1 ? kp_a_ : kp_prev_));
          kp_prev_ = now_; }
#endif
        if constexpr (!Epi::AFTER_DRAIN) { E(acc, cur, wr, wc, fr, fq); S.done(cur); }
        PG8_STAMP();
        if (!has_next) break;
#pragma unroll
        for (int a = 0; a < 2; ++a)
#pragma unroll
            for (int b = 0; b < 2; ++b)
#pragma unroll
                for (int m = 0; m < 4; ++m)
#pragma unroll
                    for (int n = 0; n < 2; ++n) acc[a][b][m][n] = (f32x4){0.f, 0.f, 0.f, 0.f};
        cur = nxt; cA = nA; cB = nB; ++ui;
    }
    PG8_WAIT_V(0);
    if (wr == 0) PG8_BAR;
    PG8_BAR;
    if constexpr (Epi::AFTER_DRAIN) { E.fused(acc, cur, wr, wc, fr, fq, lds, wid, lane); S.done(cur); }
    PG8_STAMP();
    if (STAMP && wid == 0) { stamps[lane] = lane < nts ? (((unsigned long long)(unsigned)ts_hi << 32) | (unsigned)ts_lo) : 0ull;
        if (lane == 62) stamps[62] = rt_entry; if (lane == 63) stamps[63] = (unsigned long long)wall_clock64(); }
#undef PG8_STAMP
#undef PG8_SA
#undef PG8_SB
#undef PG8_STAGE
#undef PG8_LDA
#undef PG8_LDB
#undef PG8_MMA
#undef PG8_WAIT_V
#undef PG8_WAIT_L
#undef PG8_BAR
#undef PG8_SCHED
}
}
namespace mk {
typedef pg8::Unit Unit;
typedef const pg8::f32x4 (&AccRef)[2][2][4][2];

__device__ __forceinline__ void st_bf8(bf16_t* p, pg8::f32x4 v0, pg8::f32x4 v1) {
    u32x4 w; w.x = cvt_pk_bf16(v0[0], v0[1]); w.y = cvt_pk_bf16(v0[2], v0[3]); w.z = cvt_pk_bf16(v1[0], v1[1]); w.w = cvt_pk_bf16(v1[2], v1[3]);
    *(u32x4*)p = w;
#ifdef MK_ST2
    asm volatile("" ::: "memory"); *(u32x4*)p = w; asm volatile("" ::: "memory");
#endif
}
__device__ __forceinline__ void st_bf4(bf16_t* p, pg8::f32x4 v) { u32x2 w; w.x = cvt_pk_bf16(v[0], v[1]); w.y = cvt_pk_bf16(v[2], v[3]); *(u32x2*)p = w; }

struct EpiY {
    static constexpr bool PERM = true, AFTER_DRAIN = false;
    bf16_t* O;
    __device__ __forceinline__ void operator()(AccRef acc, const Unit& u, int wr, int wc, int fr, int fq) const {
        const int row0 = u.pm * 256 + wr * 64 + fr, col0 = u.pn * 256 + wc * 32 + 8 * fq;
#pragma unroll
        for (int ai = 0; ai < 2; ++ai)
#pragma unroll
            for (int m = 0; m < 4; ++m) { bf16_t* rowp = O + (size_t)(row0 + ai * 128 + m * 16) * D + col0;
#pragma unroll
                for (int bj = 0; bj < 2; ++bj) st_bf8(rowp + bj * 128, acc[ai][bj][m][0], acc[ai][bj][m][1]); }
    }
};
struct EpiH1 {
    static constexpr bool PERM = true, AFTER_DRAIN = false;
    bf16_t* Y; const float* lbl; int jl;
    __device__ __forceinline__ void operator()(AccRef acc, const Unit& u, int wr, int wc, int fr, int fq) const {
        const int part = u.pn >> 4, colt = (u.pn & 15) * 256;
        const int row0 = u.pm * 256 + wr * 64 + fr, col0 = colt + wc * 32 + 8 * fq;
        if (part == 1) {
            pg8::f32x4 lba[2][2] = {{{0.f, 0.f, 0.f, 0.f}, {0.f, 0.f, 0.f, 0.f}}, {{0.f, 0.f, 0.f, 0.f}, {0.f, 0.f, 0.f, 0.f}}};
            if (jl) {
#pragma unroll
                for (int bj = 0; bj < 2; ++bj)
#pragma unroll
                    for (int n = 0; n < 2; ++n) { const pg8::f32x4 l0 = *(const pg8::f32x4*)(lbl + col0 + bj * 128 + 4 * n), l1 = *(const pg8::f32x4*)(lbl + D + col0 + bj * 128 + 4 * n);
#pragma unroll
                        for (int j = 0; j < 4; ++j) lba[bj][n][j] = sigmoid_f(l1[j] - l0[j]); }
            }
#pragma unroll
            for (int bj = 0; bj < 2; ++bj) {
                const pg8::f32x4 lbv[2] = {lba[bj][0], lba[bj][1]};
#pragma unroll
                for (int ai = 0; ai < 2; ++ai)
#pragma unroll
                    for (int m = 0; m < 4; ++m) {
                        const int row = row0 + ai * 128 + m * 16;
                        pg8::f32x4 o[2];
#pragma unroll
                        for (int n = 0; n < 2; ++n)
#pragma unroll
                            for (int j = 0; j < 4; ++j) {
                                const float x = acc[ai][bj][m][n][j]; float g;
                                if (jl) { const float l = lbv[n][j]; g = __logf(l + (1.f - l) * sigmoid_f(x)); }
                                else g = fminf(x, 0.f) - __logf(1.f + __expf(-fabsf(x)));
                                o[n][j] = (row < NPAD) ? 0.f : g;
                            }
                        st_bf8(Y + 3 * (SLOT / 2) + (size_t)row * D + col0 + bj * 128, o[0], o[1]);
                    }
            }
        } else {
            bf16_t* dst = Y + (size_t)(part == 0 ? 0 : (part == 2 ? 1 : 2)) * (SLOT / 2);
#pragma unroll
            for (int ai = 0; ai < 2; ++ai)
#pragma unroll
                for (int m = 0; m < 4; ++m) { bf16_t* rowp = dst + (size_t)(row0 + ai * 128 + m * 16) * D + col0;
#pragma unroll
                    for (int bj = 0; bj < 2; ++bj) st_bf8(rowp + bj * 128, acc[ai][bj][m][0], acc[ai][bj][m][1]); }
        }
    }
};
struct EpiB1 {
    static constexpr bool PERM = false, AFTER_DRAIN = false;
    bf16_t* Y; const float* cs; const float* sn;
    __device__ __forceinline__ void operator()(AccRef acc, const Unit& u, int wr, int wc, int fr, int fq) const {
        const int part = u.pn >> 4, colt = (u.pn & 15) * 256;
        const int row0 = u.pm * 256 + wr * 64 + fr, col0 = colt + wc * 32 + 4 * fq;
        bf16_t* dst = Y + (size_t)part * (SLOT / 2);
        const bool rope = (part < 2) && (wc == 0);
        pg8::f32x4 c4a[2][4], s4a[2][4];
#pragma unroll
        for (int ai = 0; ai < 2; ++ai)
#pragma unroll
            for (int m = 0; m < 4; ++m) { c4a[ai][m] = (pg8::f32x4){1.f, 1.f, 1.f, 1.f}; s4a[ai][m] = (pg8::f32x4){0.f, 0.f, 0.f, 0.f}; }
        if (rope) {
#pragma unroll
            for (int ai = 0; ai < 2; ++ai)
#pragma unroll
                for (int m = 0; m < 4; ++m) { const int row = row0 + ai * 128 + m * 16;
                    c4a[ai][m] = *(const pg8::f32x4*)(cs + (size_t)row * 16 + 4 * fq); s4a[ai][m] = *(const pg8::f32x4*)(sn + (size_t)row * 16 + 4 * fq); }
        }
#pragma unroll
        for (int ai = 0; ai < 2; ++ai)
#pragma unroll
            for (int m = 0; m < 4; ++m) {
                const int row = row0 + ai * 128 + m * 16;
                const pg8::f32x4 c4 = c4a[ai][m], s4 = s4a[ai][m];
                bf16_t* rowp = dst + (size_t)row * D + (col0 - 4 * fq) + ((fq & 1) ? 12 + 4 * fq : 4 * fq);
#pragma unroll
                for (int bj = 0; bj < 2; ++bj) {
                    const pg8::f32x4 x1 = acc[ai][bj][m][0], x2 = acc[ai][bj][m][1];
                    const pg8::f32x4 y1 = x1 * c4 - x2 * s4, y2 = x2 * c4 + x1 * s4;
                    const unsigned a0 = cvt_pk_bf16(y1[0], y1[1]), a1 = cvt_pk_bf16(y1[2], y1[3]), b0 = cvt_pk_bf16(y2[0], y2[1]), b1 = cvt_pk_bf16(y2[2], y2[3]);
                    const auto r0 = __builtin_amdgcn_permlane16_swap(a0, b0, false, false); const auto r1 = __builtin_amdgcn_permlane16_swap(a1, b1, false, false);
                    const u32x4 w = {r0[0], r1[0], r0[1], r1[1]};
                    *(u32x4*)(rowp + bj * 128) = w;
                }
            }
    }
};
struct EpiC1 {
    static constexpr bool PERM = true, AFTER_DRAIN = false;
    bf16_t *Y, *T;
    __device__ __forceinline__ void operator()(AccRef acc, const Unit& u, int wr, int wc, int fr, int fq) const {
        const int row0 = u.pm * 256 + wr * 64 + fr;
        if (u.pn < 64) {
            const int part = u.pn >> 4, col0 = (u.pn & 15) * 256 + wc * 32 + 8 * fq;
            bf16_t* dst = Y + (size_t)part * (SLOT / 2);
#pragma unroll
            for (int ai = 0; ai < 2; ++ai)
#pragma unroll
                for (int m = 0; m < 4; ++m) { bf16_t* rowp = dst + (size_t)(row0 + ai * 128 + m * 16) * D + col0;
#pragma unroll
                    for (int bj = 0; bj < 2; ++bj) st_bf8(rowp + bj * 128, acc[ai][bj][m][0], acc[ai][bj][m][1]); }
        } else {
            const int which = u.pn - 64, col0 = which * 128 + wc * 32 + 8 * fq;
#pragma unroll
            for (int ai = 0; ai < 2; ++ai)
#pragma unroll
                for (int m = 0; m < 4; ++m) {
                    pg8::f32x4 v0 = acc[ai][0][m][0], v1 = acc[ai][0][m][1];
                    if (which == 0) {
#pragma unroll
                        for (int j = 0; j < 4; ++j) { v0[j] = 1.f - 2.f * __builtin_amdgcn_rcpf(1.f + __expf(2.f * v0[j])); v1[j] = 1.f - 2.f * __builtin_amdgcn_rcpf(1.f + __expf(2.f * v1[j])); }
                    }
                    st_bf8(T + (size_t)(row0 + ai * 128 + m * 16) * 256 + col0, v0, v1);
                }
        }
    }
};
struct EpiC2 {
    static constexpr bool PERM = true, AFTER_DRAIN = false;
    bf16_t* Y; const float* w0; const float* a0;
    __device__ __forceinline__ void operator()(AccRef acc, const Unit& u, int wr, int wc, int fr, int fq) const {
        const int row0 = u.pm * 256 + wr * 64 + fr;
        const bool isw = u.pn < 16;
        const int col0 = (u.pn & 15) * 256 + wc * 32 + 8 * fq;
        bf16_t* dst = Y + (size_t)(isw ? 4 : 5) * (SLOT / 2); const float* bias = isw ? w0 : a0;
#pragma unroll
        for (int bj = 0; bj < 2; ++bj) {
            const pg8::f32x4 b0 = *(const pg8::f32x4*)(bias + col0 + bj * 128), b1 = *(const pg8::f32x4*)(bias + col0 + bj * 128 + 4);
#pragma unroll
            for (int ai = 0; ai < 2; ++ai)
#pragma unroll
                for (int m = 0; m < 4; ++m) {
                    pg8::f32x4 v0 = acc[ai][bj][m][0] + b0, v1 = acc[ai][bj][m][1] + b1;
#pragma unroll
                    for (int j = 0; j < 4; ++j) {
                        float s0 = sigmoid_f(v0[j]), s1 = sigmoid_f(v1[j]);
                        if (isw) { s0 = __expf(-0.606531f * s0); s1 = __expf(-0.606531f * s1); }
                        v0[j] = s0; v1[j] = s1;
                    }
                    st_bf8(dst + (size_t)(row0 + ai * 128 + m * 16) * D + col0 + bj * 128, v0, v1);
                    __builtin_amdgcn_sched_barrier(0);
                }
        }
    }
};

struct Fr {
    LAS unsigned char* lds; unsigned char* ldsg;
    int tid, lane, wave, G, bid, gw, NGW;
    float* out; unsigned char* ws;
    __device__ __forceinline__ Fr fresh() const { Fr P = *this; asm volatile("" : "+v"(P.tid)); P.lane = P.tid & 63; P.wave = __builtin_amdgcn_readfirstlane(P.tid >> 6); P.gw = P.bid * 8 + P.wave; return P; }
    __device__ __forceinline__ const float* in(int i) const {
        const __attribute__((address_space(4))) unsigned long long* ka = (const __attribute__((address_space(4))) unsigned long long*)__builtin_amdgcn_kernarg_segment_ptr();
        asm volatile("" : "+s"(ka));
        return (const float*)ka[i];
    }
};
__device__ __forceinline__ bf16_t* slotU(const Fr& F, int s) { return (bf16_t*)(F.ws + WS_U + (size_t)s * SLOT); }
__device__ __forceinline__ bf16_t* slotY(const Fr& F, int s) { return (bf16_t*)(F.ws + WS_Y + (size_t)s * SLOT); }
__device__ __forceinline__ float* hrow(const Fr& F, int r) { return r < 64 ? (float*)(F.ws + WS_HMETA) + (size_t)r * D : F.out + (size_t)(r - 64) * D; }

__device__ __forceinline__ void transpose_item(const float* W, int ldw, bf16_t* WT, int ldt, int koff, LAS float* scr, int kb, int nb, int lane) {
    const int k0 = 64 * kb, n0 = 32 * nb;
    float wv[32];
#pragma unroll
    for (int i = 0; i < 32; ++i) wv[i] = W[(size_t)(k0 + 2 * i + (lane >> 5)) * ldw + n0 + (lane & 31)];
#pragma unroll
    for (int i = 0; i < 32; ++i) scr[(2 * i + (lane >> 5)) * 33 + (lane & 31)] = wv[i];
    LDS_WAIT(); asm volatile("" ::: "memory");
    const int c = lane & 7;
#pragma unroll
    for (int j = 0; j < 4; ++j) { const int n = (lane >> 3) + 8 * j; const LAS float* s = scr + (8 * c) * 33 + n;
        u32x4 o; o.x = cvt_pk_bf16(s[0 * 33], s[1 * 33]); o.y = cvt_pk_bf16(s[2 * 33], s[3 * 33]); o.z = cvt_pk_bf16(s[4 * 33], s[5 * 33]); o.w = cvt_pk_bf16(s[6 * 33], s[7 * 33]);
        *(u32x4*)(WT + (size_t)(n0 + n) * ldt + koff + k0 + 8 * c) = o; }
    LDS_WAIT(); asm volatile("" ::: "memory");
}
__device__ __forceinline__ void convert_matrix(const Fr& F, const float* W, int K, int N, bf16_t* WT, int ldt, int koff, int wg_skip = 0) {
    LAS float* scr = (LAS float*)(F.lds + F.wave * 8704);
    const int nblk = N / 32, nitems = (K / 64) * nblk;
    for (int it = F.gw - wg_skip * 8; it < nitems; it += F.NGW - wg_skip * 8) transpose_item(W, N, WT, ldt, koff, scr, it / nblk, it % nblk, F.lane);
}
__device__ __forceinline__ void convert_matrix_split(const Fr& F, const float* W, int K, int N, bf16_t* WT, int ldt, int wg_split, int nsplit) {
    LAS float* scr = (LAS float*)(F.lds + F.wave * 8704);
    const int nblk = N / 32, nitems = (K / 64) * nblk;
    if (F.bid >= wg_split) { for (int it = F.gw - wg_split * 8; it < nsplit; it += F.NGW - wg_split * 8) transpose_item(W, N, WT, ldt, 0, scr, it / nblk, it % nblk, F.lane); }
    else { for (int it = nsplit + F.gw; it < nitems; it += wg_split * 8) transpose_item(W, N, WT, ldt, 0, scr, it / nblk, it % nblk, F.lane); }
}
__device__ __forceinline__ void zero_bytes(const Fr& F, void* p, size_t nbytes) {
    u32x4* q = (u32x4*)p; const size_t n = nbytes / 16; const u32x4 z = {0u, 0u, 0u, 0u};
    for (size_t i = (size_t)F.bid * 512 + F.tid; i < n; i += (size_t)F.G * 512) q[i] = z;
}
__device__ __forceinline__ bf16_t* wtin_of(const Fr& F, int L) { return (bf16_t*)(F.ws + ((L & 1) ? WS_WTINB : WS_WTIN)); }
__device__ __forceinline__ const float* win_src(const Fr& F, int L) { return (L == 0 || L == 3) ? F.in(4) + (size_t)(L ? 1 : 0) * D * 4 * D : (L == 1 ? F.in(8) : F.in(16)); }
__device__ __forceinline__ void convert_win_tail(const Fr& F, int L) { convert_matrix_split(F, win_src(F, L), D, 4 * D, wtin_of(F, L), D, 64, 26624); }
__device__ __forceinline__ void convert_win(const Fr& F, int L, int wg_skip) {
    const float* src = (L == 0 || L == 3) ? F.in(4) + (size_t)(L ? 1 : 0) * D * 4 * D : (L == 1 ? F.in(8) : F.in(16));
    convert_matrix(F, src, D, 4 * D, wtin_of(F, L), D, 0, wg_skip);
}
__device__ __forceinline__ void convert_layer(const Fr& F, int L, bool with_win) {
    bf16_t* wtin = wtin_of(F, L); bf16_t* wtout = (bf16_t*)(F.ws + WS_WTOUT);
    if (with_win) convert_win(F, L, 0);
    if (L == 0) {
        convert_matrix(F, F.in(7), D, D, wtout, D, 0);
    } else if (L == 3) {
    } else if (L == 1) {
        convert_matrix(F, F.in(14), D, D, wtout, D, 0);
    } else {
        convert_matrix(F, F.in(28), D, D, wtout, D, 0);
        convert_matrix(F, F.in(18), D, 128, wtin + (size_t)16384 * D, D, 0);
        convert_matrix(F, F.in(21), D, 128, wtin + (size_t)16640 * D, D, 0);
        zero_bytes(F, wtin + (size_t)16512 * D, (size_t)128 * D * 2);
        zero_bytes(F, wtin + (size_t)16768 * D, (size_t)128 * D * 2);
    }
}
__device__ __forceinline__ void convert_wout2(const Fr& F, int wg_skip) { convert_matrix(F, F.in(28), D, D, (bf16_t*)(F.ws + WS_WTOUT), D, 0, wg_skip); }
__device__ __forceinline__ void convert_wout3(const Fr& F, int wg_skip) { convert_matrix(F, F.in(7) + (size_t)D * D, D, D, (bf16_t*)(F.ws + WS_WTOUT), D, 0, wg_skip); }
__device__ __forceinline__ void convert_layer2_b(const Fr& F) {
    bf16_t* w2t = (bf16_t*)(F.ws + WS_W2P);
    convert_matrix(F, F.in(19), 128, D, w2t, 128, 0);
    convert_matrix(F, F.in(22), 128, D, w2t + (size_t)4096 * 128, 128, 0);
}

__constant__ float c_inv_freq[16] = {1.0f, 0.44036659598350525f, 0.1939227432012558f, 0.08539710193872452f, 0.03760603070259094f, 0.01656043902039528f, 0.007292664609849453f, 0.0032114458736032248f,
    0.0014142135623842478f, 0.000622772378847003f, 0.00027424818836152554f, 0.00012076973507646471f, 5.318296098266728e-05f, 2.34199997066753e-05f, 1.0313386155758053e-05f, 4.541670477919979e-06f};
__device__ __forceinline__ void rope_table(const Fr& F) {
    float* cs = (float*)(F.ws + WS_ROPE); float* sn = cs + (size_t)R * 16;
    for (int i = F.bid * 512 + F.tid; i < R * 16; i += F.G * 512) {
        const int row = i >> 4, j = i & 15; const int pos = row - NPAD;
        const double ang = (double)(float)((float)pos * c_inv_freq[j]);
        const double k = __builtin_rint(ang * 0.15915494309189535);
        double x = ang - k * 6.283185307179586;
        const double q = __builtin_rint(x * 0.6366197723675814);
        x -= q * 1.5707963267948966;
        const int qi = ((int)q) & 3;
        const double x2 = x * x;
        const double s = x * (1.0 + x2 * (-1.0 / 6 + x2 * (1.0 / 120 + x2 * (-1.0 / 5040 + x2 * (1.0 / 362880 + x2 * (-1.0 / 39916800))))));
        const double c = 1.0 + x2 * (-0.5 + x2 * (1.0 / 24 + x2 * (-1.0 / 720 + x2 * (1.0 / 40320 + x2 * (-1.0 / 3628800 + x2 * (1.0 / 479001600))))));
        double sv, cv;
        if (qi == 0) { sv = s; cv = c; } else if (qi == 1) { sv = c; cv = -s; } else if (qi == 2) { sv = -s; cv = -c; } else { sv = -c; cv = s; }
        cs[i] = (float)cv; sn[i] = (float)sv;
    }
}

typedef const GAS char* gcp; typedef GAS char* gp_;
#define ROW_F32(nm, base, lane) gp_ nm##0 = (gp_)(base) + (lane) * 16 + 4096; gp_ nm##1 = nm##0 + 8192; asm volatile("" : "+v"(nm##0), "+v"(nm##1))
#define AT_F32(nm, j) (*(GAS f32x4*)((j) < 8 ? nm##0 + ((j) - 4) * 1024 : nm##1 + ((j) - 12) * 1024))
#define ROW_BF(nm, base, lane) gp_ nm##0 = (gp_)(base) + (lane) * 8 + 4096; asm volatile("" : "+v"(nm##0))
#define AT_BF(nm, j) (*(GAS u32x2*)(nm##0 + (j) * 512 - 4096))
__device__ __forceinline__ void norm_phase(const Fr& F, int prev, int next, const bf16_t* y, bf16_t* udst, int rlo = 0, int rhi = R, int wg_skip = 0) {
    const float* postg = F.in(3) + (size_t)(prev < 0 ? 0 : prev) * D; const float* preg = F.in(2) + (size_t)(next < 0 ? 0 : next) * D;
    const float* xin = F.in(0); const float* meta = F.in(1);
    for (int r = rlo + F.gw - wg_skip * 8; r < rhi; r += F.NGW - wg_skip * 8) {
        if (r < NPAD || r >= NREAL) {
            if (next >= 0) { ROW_BF(uo, udst + (size_t)r * D, F.lane); const u32x2 z = {0u, 0u};
#pragma unroll
                for (int j = 0; j < 16; ++j) AT_BF(uo, j) = z; }
            continue;
        }
        ROW_BF(hp, (bf16_t*)(F.ws + WS_HB) + (size_t)r * D, F.lane);
        f32x4 hv[16];
        if (prev < 0) {
            const float* src = r < 64 ? meta + (size_t)(r - NPAD) * D : xin + (size_t)(r - 64) * D;
            ROW_F32(sp, src, F.lane);
#pragma unroll
            for (int j = 0; j < 16; ++j) hv[j] = AT_F32(sp, j);
        } else {
            ROW_BF(yp, y + (size_t)r * D, F.lane); ROW_F32(gp, postg, F.lane);
            u32x2 yv[16], hb[16]; float ss = 0.f;
#pragma unroll
            for (int j = 0; j < 16; ++j) { yv[j] = AT_BF(yp, j); hb[j] = AT_BF(hp, j); }
#pragma unroll
            for (int j = 0; j < 16; ++j) { const float a = bflo(yv[j].x), b = bfhi(yv[j].x), c = bflo(yv[j].y), d = bfhi(yv[j].y); ss += (a * a + b * b) + (c * c + d * d); }
#pragma unroll
            for (int j = 0; j < 16; ++j) asm volatile("" : "+v"(yv[j].x), "+v"(yv[j].y));
            const float rs = __builtin_amdgcn_rsqf(wave_sum(ss) * (1.f / D) + 1e-6f);
#pragma unroll
            for (int j = 0; j < 16; ++j) { const f32x4 g = AT_F32(gp, j);
                hv[j].x = bflo(hb[j].x) + bflo(yv[j].x) * rs * g.x; hv[j].y = bfhi(hb[j].x) + bfhi(yv[j].x) * rs * g.y; hv[j].z = bflo(hb[j].y) + bflo(yv[j].y) * rs * g.z; hv[j].w = bfhi(hb[j].y) + bfhi(yv[j].y) * rs * g.w; }
        }
        if (next < 0) {
            if (r >= 64) { ROW_F32(op, F.out + (size_t)(r - 64) * D, F.lane);
#pragma unroll
                for (int j = 0; j < 16; ++j) AT_F32(op, j) = hv[j];
            }
            continue;
        }
        float s2 = 0.f;
#pragma unroll
        for (int j = 0; j < 16; ++j) { u32x2 w_; w_.x = cvt_pk_bf16(hv[j].x, hv[j].y); w_.y = cvt_pk_bf16(hv[j].z, hv[j].w); AT_BF(hp, j) = w_; s2 += (hv[j].x * hv[j].x + hv[j].y * hv[j].y) + (hv[j].z * hv[j].z + hv[j].w * hv[j].w); }
        const float rs2 = __builtin_amdgcn_rsqf(wave_sum(s2) * (1.f / D) + 1e-6f);
        ROW_BF(uo, udst + (size_t)r * D, F.lane); ROW_F32(pg, preg, F.lane);
#pragma unroll
        for (int j = 0; j < 16; ++j) { const f32x4 g = AT_F32(pg, j); u32x2 w; w.x = cvt_pk_bf16(hv[j].x * rs2 * g.x, hv[j].y * rs2 * g.y); w.y = cvt_pk_bf16(hv[j].z * rs2 * g.z, hv[j].w * rs2 * g.w); AT_BF(uo, j) = w; }
    }
}
__device__ __forceinline__ void mix_phase(const Fr& F, const bf16_t* u) {
    const float* mu = F.in(15);
    for (int r = F.gw; r < R; r += F.NGW) {
        const bool real = (r >= NPAD && r < NREAL);
        u32x2 cur[16], prv[16];
        const u32x2 z = {0u, 0u};
        { ROW_BF(cp, u + (size_t)r * D, F.lane); ROW_BF(pp, u + (size_t)(r > 0 ? r - 1 : 0) * D, F.lane);
#pragma unroll
          for (int j = 0; j < 16; ++j) { cur[j] = real ? AT_BF(cp, j) : z; prv[j] = (real && r > NPAD) ? AT_BF(pp, j) : z; } }
#pragma unroll 1
        for (int s = 0; s < 6; ++s) {
            ROW_BF(op, slotU(F, s) + (size_t)r * D, F.lane); ROW_F32(mp, mu + (size_t)s * D, F.lane);
#pragma unroll
            for (int j = 0; j < 16; ++j) {
                const f32x4 m = AT_F32(mp, j);
                const float c0 = bflo(cur[j].x), c1 = bfhi(cur[j].x), c2 = bflo(cur[j].y), c3 = bfhi(cur[j].y);
                const float p0 = bflo(prv[j].x), p1 = bfhi(prv[j].x), p2 = bflo(prv[j].y), p3 = bfhi(prv[j].y);
                u32x2 w; w.x = cvt_pk_bf16(c0 + (p0 - c0) * m.x, c1 + (p1 - c1) * m.y); w.y = cvt_pk_bf16(c2 + (p2 - c2) * m.z, c3 + (p3 - c3) * m.w);
                AT_BF(op, j) = real ? w : z;
            }
        }
    }
}
}
namespace mk {
constexpr int H_WS = 144, H_TS = 80, H_QE = 0, H_KE = H_QE + 64 * H_WS * 2, H_KET = H_KE + 64 * H_WS * 2, H_VT = H_KET + 128 * H_TS * 2, H_PM = H_VT + 128 * H_TS * 2, H_STB = H_PM + 64 * H_TS * 2,
              H_VEC = H_STB + 128 * H_WS * 2, H_OT = H_VEC + 3072;
static_assert(H_OT + 33792 <= 163712, "hgrn LDS map");
__device__ __forceinline__ bf16x8 ldfrag(const LAS unsigned char* base, int stride_b, int rb, int ks, int lane) {
    return *(const LAS bf16x8*)(base + (16 * rb + (lane & 15)) * stride_b + (32 * ks + 8 * (lane >> 4)) * 2);
}
template <bool OUT>
__device__ __forceinline__ void hgrn_phase(const Fr& F, int jl) {
    const bf16_t* Q = slotY(F, 0); const bf16_t* V = slotY(F, 1); const bf16_t* GT = slotY(F, 2); const bf16_t* Gg = slotY(F, 3);
    bf16_t* Z = slotU(F, 0);
    float* HE = (float*)(F.ws + WS_HE); float* HLD = (float*)(F.ws + WS_HLOGD);
    const float* gn = F.in(6) + (size_t)jl * 128;
    LAS unsigned char* L = F.lds;
    LAS float* qtot = (LAS float*)(L + H_VEC); LAS float* ebm = qtot + 512; LAS float* ebl = ebm + 128;
    const int tid = F.tid, lane = F.lane, w = F.wave;
    const int d = tid & 127, qt = tid >> 7;
    for (int unit = F.bid; unit < 256; unit += F.G) {
        const int h = unit >> 3, seg = unit & 7;
        if (!OUT && seg == 7) continue;
        const int c0 = seg == 0 ? 0 : 33 + 32 * (seg - 1), c1 = c0 + (seg == 0 ? 33 : 32);
        f32x4 S[8];
#pragma unroll
        for (int i = 0; i < 8; ++i) S[i] = (f32x4){0.f, 0.f, 0.f, 0.f};
        if (OUT) {
            for (int j = 0; j < seg; ++j) {
                const float* ld = HLD + (size_t)(h * 8 + j) * 128; const float* e = HE + ((size_t)(h * 8 + j) * 512 + tid) * 32;
#pragma unroll
                for (int di = 0; di < 8; ++di) { const f32x4 l4 = *(const f32x4*)(ld + 16 * di + 4 * (lane >> 4)); const f32x4 e4 = *(const f32x4*)(e + 4 * di);
                    S[di].x = S[di].x * __expf(l4.x) + e4.x; S[di].y = S[di].y * __expf(l4.y) + e4.y; S[di].z = S[di].z * __expf(l4.z) + e4.z; S[di].w = S[di].w * __expf(l4.w) + e4.w; }
            }
        }
        float logD = 0.f;
        bf16_t g[16], qv[16], vv[16]; u32x4 gt0 = {0u, 0u, 0u, 0u}, gt1 = gt0, ngt0 = gt0, ngt1 = gt0;
#define HG_LOAD(cc) do { const int rowb_ = 64 * (cc) + 16 * qt; const size_t colb_ = (size_t)h * 128 + d; \
            _Pragma("unroll") for (int i = 0; i < 16; ++i) { g[i] = Gg[(size_t)(rowb_ + i) * D + colb_]; vv[i] = V[(size_t)(rowb_ + i) * D + colb_]; if (OUT) qv[i] = Q[(size_t)(rowb_ + i) * D + colb_]; } \
            if (OUT) { const bf16_t* gp_ = GT + (size_t)(64 * (cc) + (tid >> 3)) * D + h * 128 + 16 * (tid & 7); ngt0 = *(const u32x4*)gp_; ngt1 = *(const u32x4*)(gp_ + 8); } } while (0)
        HG_LOAD(c0);
        for (int c = c0; c < c1; ++c) {
            if (OUT) { gt0 = ngt0; gt1 = ngt1; }
            float f[16]; float run = 0.f;
#pragma unroll
            for (int i = 0; i < 16; ++i) { const float gi = bf2f(g[i]); run += gi; f[i] = __expf(gi); }
            qtot[qt * 128 + d] = run;
            __syncthreads();
            const float t0 = qtot[d], t1 = qtot[128 + d], t2 = qtot[256 + d], t3 = qtot[384 + d];
            const float off = qt == 0 ? 0.f : (qt == 1 ? t0 : (qt == 2 ? t0 + t1 : t0 + t1 + t2));
            const float bm = t0 + t1, bl = (t0 + t1) + (t2 + t3);
            if (qt == 0) { ebm[d] = __expf(bm); ebl[d] = __expf(bl); logD += bl; }
            {
                unsigned kt[8], vt[8];
                const float ebd = __expf(bl - bm);
                float y = __expf(bm - (run + off)), kx_hi = 0.f;
#pragma unroll
                for (int i = 15; i >= 0; --i) {
                    const float ky = (1.f - f[i]) * y;
                    if (OUT) *(LAS bf16_t*)(L + H_KE + ((16 * qt + i) * H_WS + d) * 2) = f2bf(ky);
                    const float kx = ky * ebd;
                    if (i & 1) kx_hi = kx; else kt[i >> 1] = cvt_pk_bf16(kx, kx_hi);
                    y *= f[i];
                }
                if (OUT) {
                    float e = __expf(off - bm);
#pragma unroll
                    for (int i = 0; i < 16; ++i) { e *= f[i]; *(LAS bf16_t*)(L + H_QE + ((16 * qt + i) * H_WS + d) * 2) = f2bf(bf2f(qv[i]) * e); }
                }
#pragma unroll
                for (int i = 0; i < 16; i += 2) vt[i >> 1] = (unsigned)vv[i] | ((unsigned)vv[i + 1] << 16);
                LAS u32x4* kp = (LAS u32x4*)(L + H_KET + (d * H_TS + 16 * qt) * 2); kp[0] = (u32x4){kt[0], kt[1], kt[2], kt[3]}; kp[1] = (u32x4){kt[4], kt[5], kt[6], kt[7]};
                LAS u32x4* vp = (LAS u32x4*)(L + H_VT + (d * H_TS + 16 * qt) * 2); vp[0] = (u32x4){vt[0], vt[1], vt[2], vt[3]}; vp[1] = (u32x4){vt[4], vt[5], vt[6], vt[7]};
            }
            if (c + 1 < c1) HG_LOAD(c + 1);
            __syncthreads();
            if (OUT) {
#pragma unroll
                for (int di = 0; di < 8; ++di) { const f32x4 m4 = *(const LAS f32x4*)(ebm + 16 * di + 4 * (lane >> 4)); u32x2 o; o.x = cvt_pk_bf16(S[di].x * m4.x, S[di].y * m4.y); o.y = cvt_pk_bf16(S[di].z * m4.z, S[di].w * m4.w);
                    *(LAS u32x2*)(L + H_STB + ((16 * w + (lane & 15)) * H_WS + 16 * di + 4 * (lane >> 4)) * 2) = o; }
                const int ti = w >> 1;
#pragma unroll
                for (int s2 = 0; s2 < 2; ++s2) { const int si = 2 * (w & 1) + s2; f32x4 p = {0.f, 0.f, 0.f, 0.f};
                    if (si <= ti) {
#pragma unroll
                        for (int ks = 0; ks < 4; ++ks) p = __builtin_amdgcn_mfma_f32_16x16x32_bf16(ldfrag(L + H_QE, 2 * H_WS, ti, ks, lane), ldfrag(L + H_KE, 2 * H_WS, si, ks, lane), p, 0, 0, 0);
                    }
                    const int sidx = 16 * si + (lane & 15);
#pragma unroll
                    for (int jj = 0; jj < 4; ++jj) { const int tidx = 16 * ti + 4 * (lane >> 4) + jj; *(LAS bf16_t*)(L + H_PM + (tidx * H_TS + sidx) * 2) = f2bf(sidx <= tidx ? p[jj] : 0.f); }
                }
                __syncthreads();
            }
            f32x4 O[4];
            if (OUT) {
#pragma unroll
                for (int ti = 0; ti < 4; ++ti) O[ti] = (f32x4){0.f, 0.f, 0.f, 0.f};
#pragma unroll
                for (int ks = 0; ks < 2; ++ks) { const bf16x8 bv = ldfrag(L + H_VT, 2 * H_TS, w, ks, lane);
#pragma unroll
                    for (int ti = 0; ti < 4; ++ti) O[ti] = __builtin_amdgcn_mfma_f32_16x16x32_bf16(ldfrag(L + H_PM, 2 * H_TS, ti, ks, lane), bv, O[ti], 0, 0, 0); }
#pragma unroll
                for (int ks = 0; ks < 4; ++ks) { const bf16x8 bs = ldfrag(L + H_STB, 2 * H_WS, w, ks, lane);
#pragma unroll
                    for (int ti = 0; ti < 4; ++ti) O[ti] = __builtin_amdgcn_mfma_f32_16x16x32_bf16(ldfrag(L + H_QE, 2 * H_WS, ti, ks, lane), bs, O[ti], 0, 0, 0); }
            }
            {
                const bf16x8 bv0 = ldfrag(L + H_VT, 2 * H_TS, w, 0, lane), bv1 = ldfrag(L + H_VT, 2 * H_TS, w, 1, lane);
#pragma unroll
                for (int di = 0; di < 8; ++di) { const f32x4 l4 = *(const LAS f32x4*)(ebl + 16 * di + 4 * (lane >> 4)); S[di] = S[di] * l4;
                    S[di] = __builtin_amdgcn_mfma_f32_16x16x32_bf16(ldfrag(L + H_KET, 2 * H_TS, di, 0, lane), bv0, S[di], 0, 0, 0);
                    S[di] = __builtin_amdgcn_mfma_f32_16x16x32_bf16(ldfrag(L + H_KET, 2 * H_TS, di, 1, lane), bv1, S[di], 0, 0, 0); }
            }
            if (OUT) {
                LAS float* Ot = (LAS float*)(L + H_OT);
#pragma unroll
                for (int ti = 0; ti < 4; ++ti)
#pragma unroll
                    for (int jj = 0; jj < 4; ++jj) Ot[(16 * ti + 4 * (lane >> 4) + jj) * 132 + 16 * w + (lane & 15)] = O[ti][jj];
                __syncthreads();
                const int t = tid >> 3, eg = tid & 7;
                f32x4 o4[4]; float ss = 0.f;
#pragma unroll
                for (int i = 0; i < 4; ++i) { o4[i] = *(const LAS f32x4*)(Ot + t * 132 + 16 * eg + 4 * i); ss += (o4[i].x * o4[i].x + o4[i].y * o4[i].y) + (o4[i].z * o4[i].z + o4[i].w * o4[i].w); }
                ss = red8(ss);
                const float rs = __builtin_amdgcn_rsqf(ss * (1.f / 128.f) + 1e-6f);
                const unsigned gw_[8] = {gt0.x, gt0.y, gt0.z, gt0.w, gt1.x, gt1.y, gt1.z, gt1.w};
                unsigned zo[8];
#pragma unroll
                for (int i = 0; i < 4; ++i) { const f32x4 g4 = *(const f32x4*)(gn + 16 * eg + 4 * i);
                    const float a0 = o4[i].x * rs * g4.x * silu_f(bflo(gw_[2 * i])), a1 = o4[i].y * rs * g4.y * silu_f(bfhi(gw_[2 * i]));
                    const float a2 = o4[i].z * rs * g4.z * silu_f(bflo(gw_[2 * i + 1])), a3 = o4[i].w * rs * g4.w * silu_f(bfhi(gw_[2 * i + 1]));
                    zo[2 * i] = cvt_pk_bf16(a0, a1); zo[2 * i + 1] = cvt_pk_bf16(a2, a3); }
                bf16_t* zp = Z + (size_t)(64 * c + t) * D + h * 128 + 16 * eg;
                *(u32x4*)zp = (u32x4){zo[0], zo[1], zo[2], zo[3]}; *(u32x4*)(zp + 8) = (u32x4){zo[4], zo[5], zo[6], zo[7]};
            } else {
                __syncthreads();
            }
        }
        if (!OUT) {
            float* e = HE + ((size_t)(h * 8 + seg) * 512 + tid) * 32;
#pragma unroll
            for (int di = 0; di < 8; ++di) *(f32x4*)(e + 4 * di) = S[di];
            if (qt == 0) HLD[(size_t)(h * 8 + seg) * 128 + d] = logD;
        }
        __syncthreads();
    }
#undef HG_LOAD
}

#ifndef MK_PRIO
#define MK_PRIO 0
#endif
#define PRIO_HI() do { if (MK_PRIO) { __builtin_amdgcn_s_setprio(MK_PRIO); } } while (0)
#define PRIO_LO() do { if (MK_PRIO) { __builtin_amdgcn_s_setprio(0); } } while (0)
namespace att {
constexpr int NW = 8, QBLK = 32, KVBLK = 64, LDQ = 4096, LDO = 8192;
constexpr float SCALE = 0.088388347648318440f, THR = 8.f;
constexpr int SHM_V = 16384, SHM_K = 16384, SHM = 2 * SHM_V + 2 * SHM_K + NW * 64 * 4;
#ifndef MK_KSWM
#define MK_KSWM 15
#endif
#define KSWZ(row, colB) ((row) * 256 + ((colB) ^ (((row) & MK_KSWM) << 4)))
#define SBAR() __builtin_amdgcn_sched_barrier(0)
__device__ __forceinline__ int crow(int r, int hi) { return (r & 3) + 8 * (r >> 2) + 4 * hi; }
__device__ __forceinline__ void partialSM(f32x16& p0, f32x16& p1, float& m_reg, float& mn, float& alpha) {
    constexpr float C = SCALE * 1.4426950408889634f;
    float pmax = p0[0];
#pragma unroll
    for (int r = 1; r < 16; ++r) pmax = fmaxf(pmax, p0[r]);
#pragma unroll
    for (int r = 0; r < 16; ++r) pmax = fmaxf(pmax, p1[r]);
    { auto rr = __builtin_amdgcn_permlane32_swap(__float_as_uint(pmax), __float_as_uint(pmax), false, false);
      pmax = fmaxf(__uint_as_float(rr[0]), __uint_as_float(rr[1])); }
    if (__builtin_expect(__all(pmax - m_reg <= THR / SCALE), 1)) { mn = m_reg; alpha = 1.f; }
    else { mn = fmaxf(m_reg, pmax); alpha = __builtin_amdgcn_exp2f((m_reg - mn) * C); m_reg = mn; }
    const float mnC = -mn * C;
#pragma unroll
    for (int r = 0; r < 16; ++r) p0[r] = fmaf(p0[r], C, mnC);
#pragma unroll
    for (int r = 0; r < 16; ++r) p1[r] = fmaf(p1[r], C, mnC);
#pragma unroll
    for (int r = 0; r < 16; ++r) p0[r] = __builtin_amdgcn_exp2f(p0[r]);
}
__device__ __forceinline__ void finishSM(f32x16& p0, f32x16& p1, float alpha, float& l_reg, bf16x8& pa0, bf16x8& pa1, bf16x8& pa2, bf16x8& pa3) {
#pragma unroll
    for (int r = 0; r < 16; ++r) p1[r] = __builtin_amdgcn_exp2f(p1[r]);
    float ps = 0;
#pragma unroll
    for (int r = 0; r < 16; ++r) ps += p0[r];
#pragma unroll
    for (int r = 0; r < 16; ++r) ps += p1[r];
    { auto rr = __builtin_amdgcn_permlane32_swap(__float_as_uint(ps), __float_as_uint(ps), false, false);
      ps = __uint_as_float(rr[0]) + __uint_as_float(rr[1]); }
    l_reg = l_reg * alpha + ps;
#define PK4(P, BASE, OUT) do { unsigned a0 = cvt_pk_bf16(P[BASE + 0], P[BASE + 1]), a1 = cvt_pk_bf16(P[BASE + 2], P[BASE + 3]);   \
    unsigned b0 = cvt_pk_bf16(P[BASE + 4], P[BASE + 5]), b1 = cvt_pk_bf16(P[BASE + 6], P[BASE + 7]);                              \
    auto r0 = __builtin_amdgcn_permlane32_swap(a0, b0, false, false); auto r1 = __builtin_amdgcn_permlane32_swap(a1, b1, false, false); \
    u32x4 w = {r0[0], r1[0], r0[1], r1[1]}; OUT = *reinterpret_cast<bf16x8*>(&w); } while (0)
    PK4(p0, 0, pa0); PK4(p0, 8, pa1); PK4(p1, 0, pa2); PK4(p1, 8, pa3);
#undef PK4
}
__device__ __forceinline__ void qkt(f32x16& p0, f32x16& p1, const char* Ks, const bf16x8* qr, int r32, int hi) {
    p0 = f32x16{}; p1 = f32x16{};
    PRIO_HI();
#pragma unroll
    for (int d0 = 0; d0 < 8; ++d0) { const int cb = (d0 * 16 + hi * 8) * 2;
        const bf16x8 b0 = *reinterpret_cast<const bf16x8*>(Ks + KSWZ(r32, cb));
        const bf16x8 b1 = *reinterpret_cast<const bf16x8*>(Ks + KSWZ(32 + r32, cb));
        p0 = __builtin_amdgcn_mfma_f32_32x32x16_bf16(b0, qr[d0], p0, 0, 0, 0);
        p1 = __builtin_amdgcn_mfma_f32_32x32x16_bf16(b1, qr[d0], p1, 0, 0, 0); }
    PRIO_LO();
}
__device__ __forceinline__ int v_st(int k, int c) { const int kk = (k & ~0xC) | ((k & 4) << 1) | ((k & 8) >> 1); return ((kk >> 3) * 4 + (c >> 5)) * 512 + ((kk & 7) * 32 + (c & 31)) * 2; }
__device__ __forceinline__ int v_rd_base(int lane) { return ((lane & 3) << 3) | (((lane >> 2) & 3) << 6) | (((lane >> 4) & 1) << 5) | (((lane >> 5) & 1) << 8); }
constexpr int v_rd_off(int d0, int ks, int half) { return d0 * 512 + ks * 4096 + half * 2048; }
template <int OFF> __device__ __forceinline__ s16x4 tr_read(int vb) {
    s16x4 r; asm volatile("ds_read_b64_tr_b16 %0, %1 offset:%2" : "=&v"(r) : "v"(vb), "i"(OFF) : "memory"); return r;
}
template <int D0> __device__ __forceinline__ void pv_one(f32x16& od, int vb, bf16x8 pa0, bf16x8 pa1, bf16x8 pa2, bf16x8 pa3) {
    const s16x4 l0 = tr_read<v_rd_off(D0, 0, 0)>(vb), h0 = tr_read<v_rd_off(D0, 0, 1)>(vb), l1 = tr_read<v_rd_off(D0, 1, 0)>(vb), h1 = tr_read<v_rd_off(D0, 1, 1)>(vb);
    const s16x4 l2 = tr_read<v_rd_off(D0, 2, 0)>(vb), h2 = tr_read<v_rd_off(D0, 2, 1)>(vb), l3 = tr_read<v_rd_off(D0, 3, 0)>(vb), h3 = tr_read<v_rd_off(D0, 3, 1)>(vb);
    asm volatile("s_waitcnt lgkmcnt(0)" ::: "memory"); SBAR();
#define PK(Lo, Hi) (bf16x8){Lo[0], Lo[1], Lo[2], Lo[3], Hi[0], Hi[1], Hi[2], Hi[3]}
    od = __builtin_amdgcn_mfma_f32_32x32x16_bf16(pa0, PK(l0, h0), od, 0, 0, 0);
    od = __builtin_amdgcn_mfma_f32_32x32x16_bf16(pa1, PK(l1, h1), od, 0, 0, 0);
    od = __builtin_amdgcn_mfma_f32_32x32x16_bf16(pa2, PK(l2, h2), od, 0, 0, 0);
    od = __builtin_amdgcn_mfma_f32_32x32x16_bf16(pa3, PK(l3, h3), od, 0, 0, 0);
#undef PK
}
__device__ __forceinline__ void pv_d0(f32x16* o, int vb, bf16x8 pa0, bf16x8 pa1, bf16x8 pa2, bf16x8 pa3) {
    pv_one<0>(o[0], vb, pa0, pa1, pa2, pa3); pv_one<1>(o[1], vb, pa0, pa1, pa2, pa3); pv_one<2>(o[2], vb, pa0, pa1, pa2, pa3); pv_one<3>(o[3], vb, pa0, pa1, pa2, pa3);
}
__device__ __forceinline__ void mask_tile(f32x16& p0, f32x16& p1, int j, int lim) {
    if (j > lim) {
#pragma unroll
        for (int r = 0; r < 16; ++r) { p0[r] = -1e30f; p1[r] = -1e30f; }
    } else if (j == 0) {
#pragma unroll
        for (int r = 0; r < 16; ++r) p0[r] = -1e30f;
#pragma unroll
        for (int r = 0; r < 8; ++r) p1[r] = -1e30f;
    }
}
__device__ __forceinline__ void unit(const bf16_t* __restrict__ Qb, const bf16_t* __restrict__ Kh, const bf16_t* __restrict__ Vh, bf16_t* __restrict__ Ob, int NT, int lim, char* lds) {
    int tid_ = threadIdx.x; asm volatile("" : "+v"(tid_));
    const int tid = tid_, wid = tid >> 6, lane = tid & 63, r32 = lane & 31, hi = lane >> 5;
    char* V_lds = lds; char* K_lds = lds + 2 * SHM_V;
    float* wsf = (float*)(lds + 2 * SHM_V + 2 * SHM_K) + wid * 64; float* li_l = wsf; float* al_l = wsf + 32;
    float m_reg = -1e30f, l_reg = 0; f32x16 o[4] = {}; bf16x8 qr[8];
    const bf16_t* Qw = Qb + (long)(wid * QBLK + r32) * LDQ + hi * 8;
#pragma unroll
    for (int d0 = 0; d0 < 8; ++d0) qr[d0] = *reinterpret_cast<const bf16x8*>(Qw + d0 * 16);
    const int sr = tid >> 4, sc = (tid & 15) * 8, vst0 = v_st(sr, sc), vst1 = v_st(32 + sr, sc);
    const int vb0 = (int)(uintptr_t)V_lds + v_rd_base(lane);
    struct { bf16x8 vs0, vs1, ks0, ks1; } sr_[2];
#define SLOAD(i, k0) do { sr_[i].vs0 = *reinterpret_cast<const bf16x8*>(&Vh[(long)((k0) + sr) * LDQ + sc]); sr_[i].vs1 = *reinterpret_cast<const bf16x8*>(&Vh[(long)((k0) + 32 + sr) * LDQ + sc]); \
    sr_[i].ks0 = *reinterpret_cast<const bf16x8*>(&Kh[(long)((k0) + sr) * LDQ + sc]); sr_[i].ks1 = *reinterpret_cast<const bf16x8*>(&Kh[(long)((k0) + 32 + sr) * LDQ + sc]); } while (0)
#define SWRITE(b, i) do { *(bf16x8*)(V_lds + (b) * SHM_V + vst0) = sr_[i].vs0;          \
    *(bf16x8*)(V_lds + (b) * SHM_V + vst1) = sr_[i].vs1; int kc = sc * 2;               \
    *(bf16x8*)(K_lds + (b) * SHM_K + KSWZ(sr, kc)) = sr_[i].ks0;                       \
    *(bf16x8*)(K_lds + (b) * SHM_K + KSWZ(32 + sr, kc)) = sr_[i].ks1; } while (0)
#define SWAIT() asm volatile("s_waitcnt vmcnt(4)" ::: "memory")
#define RESC(a) do { if (__any((a) < 1.f)) { if (hi == 0) al_l[r32] = (a); asm volatile("s_waitcnt lgkmcnt(0)" ::: "memory"); \
    _Pragma("unroll") for (int d = 0; d < 4; ++d) _Pragma("unroll") for (int r = 0; r < 16; ++r) o[d][r] *= al_l[crow(r, hi)]; } } while (0)
    f32x16 pA0, pA1, pB0, pB1; float mnA, mnB, alA, alB; bf16x8 pa0, pa1, pa2, pa3;
    constexpr int SE = 0, SO = 1;
    SLOAD(SE, 0); asm volatile("s_waitcnt vmcnt(0)" ::: "memory"); SWRITE(0, SE); __syncthreads();
    qkt(pA0, pA1, K_lds, qr, r32, hi); mask_tile(pA0, pA1, 0, lim); partialSM(pA0, pA1, m_reg, mnA, alA);
    SLOAD(SO, KVBLK); if (2 < NT) SLOAD(SE, 2 * KVBLK);
    SWAIT(); SWRITE(1, SO); __syncthreads();
    for (int j = 1; j + 1 < NT; j += 2) {
        SBAR(); qkt(pB0, pB1, K_lds + SHM_K, qr, r32, hi);
        finishSM(pA0, pA1, alA, l_reg, pa0, pa1, pa2, pa3); SBAR();
        SLOAD(SO, (j + 2) * KVBLK); SBAR();
        pv_d0(o, vb0, pa0, pa1, pa2, pa3); mask_tile(pB0, pB1, j, lim); partialSM(pB0, pB1, m_reg, mnB, alB);
        __syncthreads(); SWAIT(); SWRITE(0, SE);
        RESC(alB); __syncthreads();
        SBAR(); qkt(pA0, pA1, K_lds, qr, r32, hi);
        finishSM(pB0, pB1, alB, l_reg, pa0, pa1, pa2, pa3); SBAR();
        if (j + 3 < NT) SLOAD(SE, (j + 3) * KVBLK); SBAR();
        pv_d0(o, vb0 + SHM_V, pa0, pa1, pa2, pa3); mask_tile(pA0, pA1, j + 1, lim); partialSM(pA0, pA1, m_reg, mnA, alA);
        __syncthreads(); SWAIT(); SWRITE(1, SO);
        RESC(alA); __syncthreads();
    }
    SBAR(); qkt(pB0, pB1, K_lds + SHM_K, qr, r32, hi);
    finishSM(pA0, pA1, alA, l_reg, pa0, pa1, pa2, pa3); SBAR();
    pv_d0(o, vb0, pa0, pa1, pa2, pa3); mask_tile(pB0, pB1, NT - 1, lim); partialSM(pB0, pB1, m_reg, mnB, alB);
    __syncthreads(); RESC(alB);
    finishSM(pB0, pB1, alB, l_reg, pa0, pa1, pa2, pa3); SBAR();
    pv_d0(o, vb0 + SHM_V, pa0, pa1, pa2, pa3);
    if (hi == 0) li_l[r32] = l_reg; asm volatile("s_waitcnt lgkmcnt(0)" ::: "memory");
    float rli[16];
#pragma unroll
    for (int r = 0; r < 16; ++r) rli[r] = __builtin_amdgcn_rcpf(li_l[crow(r, hi)]);
    bf16_t* Ow = Ob + (long)(wid * QBLK) * LDO;
#pragma unroll
    for (int r = 0; r < 16; ++r) { const int orow = crow(r, hi);
#pragma unroll
        for (int d0 = 0; d0 < 4; ++d0) Ow[(long)orow * LDO + d0 * 32 + r32] = f2bf(o[d0][r] * rli[r]); }
    __syncthreads();
#undef SLOAD
#undef SWRITE
#undef SWAIT
#undef RESC
}
}


#ifndef MK_HB
#define MK_HB(w) ((w) >> 2)
#endif
namespace att2 {
using namespace att;
constexpr int KB = 16384, VB = 32768, OFF_V = 3 * KB, OFF_W = OFF_V + 3 * VB, SHM2 = OFF_W + NW * 64 * 4;
constexpr int v2_rd_off(int d0, int ks, int half) { return d0 * 512 + ks * 8192 + half * 4096; }
template <int D0> __device__ __forceinline__ void pv2_one(f32x16& od, int vb, bf16x8 pa0, bf16x8 pa1, bf16x8 pa2, bf16x8 pa3) {
    const s16x4 l0 = tr_read<v2_rd_off(D0, 0, 0)>(vb), h0 = tr_read<v2_rd_off(D0, 0, 1)>(vb), l1 = tr_read<v2_rd_off(D0, 1, 0)>(vb), h1 = tr_read<v2_rd_off(D0, 1, 1)>(vb);
    const s16x4 l2 = tr_read<v2_rd_off(D0, 2, 0)>(vb), h2 = tr_read<v2_rd_off(D0, 2, 1)>(vb), l3 = tr_read<v2_rd_off(D0, 3, 0)>(vb), h3 = tr_read<v2_rd_off(D0, 3, 1)>(vb);
    asm volatile("s_waitcnt lgkmcnt(0)" ::: "memory"); SBAR();
#define PK(Lo, Hi) (bf16x8){Lo[0], Lo[1], Lo[2], Lo[3], Hi[0], Hi[1], Hi[2], Hi[3]}
    od = __builtin_amdgcn_mfma_f32_32x32x16_bf16(pa0, PK(l0, h0), od, 0, 0, 0);
    od = __builtin_amdgcn_mfma_f32_32x32x16_bf16(pa1, PK(l1, h1), od, 0, 0, 0);
    od = __builtin_amdgcn_mfma_f32_32x32x16_bf16(pa2, PK(l2, h2), od, 0, 0, 0);
    od = __builtin_amdgcn_mfma_f32_32x32x16_bf16(pa3, PK(l3, h3), od, 0, 0, 0);
#undef PK
}
struct VFrag { s16x4 l0, h0, l1, h1, l2, h2, l3, h3; };
template <int D0> __device__ __forceinline__ void v2_load(VFrag& f, int vb) {
    f.l0 = tr_read<v2_rd_off(D0, 0, 0)>(vb); f.h0 = tr_read<v2_rd_off(D0, 0, 1)>(vb); f.l1 = tr_read<v2_rd_off(D0, 1, 0)>(vb); f.h1 = tr_read<v2_rd_off(D0, 1, 1)>(vb);
    f.l2 = tr_read<v2_rd_off(D0, 2, 0)>(vb); f.h2 = tr_read<v2_rd_off(D0, 2, 1)>(vb); f.l3 = tr_read<v2_rd_off(D0, 3, 0)>(vb); f.h3 = tr_read<v2_rd_off(D0, 3, 1)>(vb);
}
__device__ __forceinline__ void v2_mma(f32x16& od, const VFrag& f, bf16x8 pa0, bf16x8 pa1, bf16x8 pa2, bf16x8 pa3) {
#define PK(Lo, Hi) (bf16x8){Lo[0], Lo[1], Lo[2], Lo[3], Hi[0], Hi[1], Hi[2], Hi[3]}
    od = __builtin_amdgcn_mfma_f32_32x32x16_bf16(pa0, PK(f.l0, f.h0), od, 0, 0, 0);
    od = __builtin_amdgcn_mfma_f32_32x32x16_bf16(pa1, PK(f.l1, f.h1), od, 0, 0, 0);
    od = __builtin_amdgcn_mfma_f32_32x32x16_bf16(pa2, PK(f.l2, f.h2), od, 0, 0, 0);
    od = __builtin_amdgcn_mfma_f32_32x32x16_bf16(pa3, PK(f.l3, f.h3), od, 0, 0, 0);
#undef PK
}
struct VSet { s16x4 l0, h0, l1, h1, l2, h2, l3, h3; };
template <int G, int KS> __device__ __forceinline__ void vs_load(VSet& f, int vb) {
    f.l0 = tr_read<v2_rd_off(4 * G + 0, KS, 0)>(vb); f.h0 = tr_read<v2_rd_off(4 * G + 0, KS, 1)>(vb); f.l1 = tr_read<v2_rd_off(4 * G + 1, KS, 0)>(vb); f.h1 = tr_read<v2_rd_off(4 * G + 1, KS, 1)>(vb);
    f.l2 = tr_read<v2_rd_off(4 * G + 2, KS, 0)>(vb); f.h2 = tr_read<v2_rd_off(4 * G + 2, KS, 1)>(vb); f.l3 = tr_read<v2_rd_off(4 * G + 3, KS, 0)>(vb); f.h3 = tr_read<v2_rd_off(4 * G + 3, KS, 1)>(vb);
}
template <int G> __device__ __forceinline__ void vs_mma(f32x16* o, const VSet& f, bf16x8 pa) {
#define PK(Lo, Hi) (bf16x8){Lo[0], Lo[1], Lo[2], Lo[3], Hi[0], Hi[1], Hi[2], Hi[3]}
    o[4 * G + 0] = __builtin_amdgcn_mfma_f32_32x32x16_bf16(pa, PK(f.l0, f.h0), o[4 * G + 0], 0, 0, 0);
    o[4 * G + 1] = __builtin_amdgcn_mfma_f32_32x32x16_bf16(pa, PK(f.l1, f.h1), o[4 * G + 1], 0, 0, 0);
    o[4 * G + 2] = __builtin_amdgcn_mfma_f32_32x32x16_bf16(pa, PK(f.l2, f.h2), o[4 * G + 2], 0, 0, 0);
    o[4 * G + 3] = __builtin_amdgcn_mfma_f32_32x32x16_bf16(pa, PK(f.l3, f.h3), o[4 * G + 3], 0, 0, 0);
#undef PK
}
__device__ __forceinline__ void pv2_all(f32x16* o, int vb, bf16x8 pa0, bf16x8 pa1, bf16x8 pa2, bf16x8 pa3) {
    VSet A, B;
#define W8() do { asm volatile("s_waitcnt lgkmcnt(8)" ::: "memory"); SBAR(); } while (0)
    PRIO_HI();
    vs_load<0, 0>(A, vb);
    vs_load<0, 1>(B, vb); W8(); vs_mma<0>(o, A, pa0); SBAR();
    vs_load<0, 2>(A, vb); W8(); vs_mma<0>(o, B, pa1); SBAR();
    vs_load<0, 3>(B, vb); W8(); vs_mma<0>(o, A, pa2); SBAR();
    vs_load<1, 0>(A, vb); W8(); vs_mma<0>(o, B, pa3); SBAR();
    vs_load<1, 1>(B, vb); W8(); vs_mma<1>(o, A, pa0); SBAR();
    vs_load<1, 2>(A, vb); W8(); vs_mma<1>(o, B, pa1); SBAR();
    vs_load<1, 3>(B, vb); W8(); vs_mma<1>(o, A, pa2); SBAR();
    asm volatile("s_waitcnt lgkmcnt(0)" ::: "memory"); SBAR(); vs_mma<1>(o, B, pa3); SBAR();
    PRIO_LO();
#undef W8
}
__device__ __forceinline__ void unit2(const bf16_t* __restrict__ Qb, const bf16_t* __restrict__ Kh, const bf16_t* __restrict__ Vh, bf16_t* __restrict__ Ob, int NT, int lim, unsigned char* ldsg, LAS unsigned char* lds, int rev = 0) {
#define TILE(s_) (rev ? NT - 1 - (s_) : (s_))
    int tid_ = threadIdx.x; asm volatile("" : "+v"(tid_));
    const int tid = tid_, wid = __builtin_amdgcn_readfirstlane(tid >> 6), lane = tid & 63, r32 = lane & 31, hi = lane >> 5;
    LAS float* wsf = (LAS float*)(lds + OFF_W) + wid * 64; LAS float* li_l = wsf; LAS float* al_l = wsf + 32;
    float m_reg = -1e30f, l_reg = 0; f32x16 o[8] = {}; bf16x8 qr[8];
    const bf16_t* Qw = Qb + (long)(wid * QBLK + r32) * LDQ + hi * 8;
#pragma unroll
    for (int d0 = 0; d0 < 8; ++d0) qr[d0] = *reinterpret_cast<const bf16x8*>(Qw + d0 * 16);
    const int vb0 = (int)(uintptr_t)(ldsg + OFF_V) + v_rd_base(lane);
    unsigned ko0, vo0;
    { const int row = wid * 4 + (lane >> 4); ko0 = (unsigned)(row * LDQ * 2 + (((lane & 15) * 16) ^ ((row & MK_KSWM) << 4)));
      const int st = wid * 2 + (lane >> 5), q = lane & 31; const int kk = (st >> 3) * 8 + (q >> 2); const int k = (kk & ~0xC) | ((kk & 4) << 1) | ((kk & 8) >> 1);
      vo0 = (unsigned)(k * LDQ * 2 + ((st & 7) * 32 + (q & 3) * 8) * 2); }
#define DMA_K(t_, b_) do { const char* gk = (const char*)Kh + (size_t)(t_) * (KVBLK * LDQ * 2); _Pragma("unroll") for (int i = 0; i < 2; ++i) { \
        __builtin_amdgcn_global_load_lds((const unsigned*)(gk + (size_t)i * (32 * LDQ * 2) + ko0), (LAS unsigned*)(lds + (b_) * KB + wid * 1024 + i * 8192), 16, 0, 0); } } while (0)
#define DMA_V(t_, b_) do { const char* gv = (const char*)Vh + (size_t)(t_) * (KVBLK * LDQ * 2); _Pragma("unroll") for (int i = 0; i < 4; ++i) { \
        __builtin_amdgcn_global_load_lds((const unsigned*)(gv + (size_t)i * (16 * LDQ * 2) + vo0), (LAS unsigned*)(lds + OFF_V + (b_) * VB + wid * 1024 + i * 8192), 16, 0, 0); } } while (0)
    DMA_K(TILE(0), 0); DMA_V(TILE(0), 0); if (1 < NT) { DMA_K(TILE(1), 1); DMA_V(TILE(1), 1); }
    asm volatile("s_waitcnt vmcnt(0)" ::: "memory"); __builtin_amdgcn_s_barrier(); asm volatile("" ::: "memory");
    int kb = 0;
    for (int j = 0; j < NT; ++j) {
        const int kb2 = kb == 0 ? 2 : kb - 1;
        const int tl = TILE(j);
        if (j + 2 < NT) DMA_V(TILE(j + 2), kb2);
        asm volatile("" ::: "memory");
        if (j + 2 < NT) DMA_K(TILE(j + 2), kb2);
        asm volatile("" ::: "memory");
        if (tl <= lim) {
        f32x16 p0, p1; float mn, alpha; bf16x8 pa0, pa1, pa2, pa3;
        qkt(p0, p1, (const char*)ldsg + kb * KB, qr, r32, hi);
#if MK_PROBE_QK2
        asm volatile("" : "+v"(p0), "+v"(p1)); qkt(p0, p1, (const char*)ldsg + kb * KB, qr, r32, hi);
#endif
        if (tl == 0) {
            asm volatile("; tile-0 mask" ::: "memory");
#pragma unroll
            for (int r = 0; r < 16; ++r) p0[r] = -1e30f;
#pragma unroll
            for (int r = 0; r < 8; ++r) p1[r] = -1e30f;
        }
        partialSM(p0, p1, m_reg, mn, alpha);
        if (__any(alpha < 1.f)) { if (hi == 0) al_l[r32] = alpha; asm volatile("s_waitcnt lgkmcnt(0)" ::: "memory");
#pragma unroll
            for (int d = 0; d < 8; ++d)
#pragma unroll
                for (int r = 0; r < 16; ++r) o[d][r] *= al_l[crow(r, hi)]; }
        finishSM(p0, p1, alpha, l_reg, pa0, pa1, pa2, pa3); SBAR();
        const int vb = vb0 + kb * VB;
        pv2_all(o, vb, pa0, pa1, pa2, pa3);
        }
        if (j + 2 < NT) asm volatile("s_waitcnt vmcnt(6)" ::: "memory"); else asm volatile("s_waitcnt vmcnt(0)" ::: "memory");
        __builtin_amdgcn_s_barrier(); asm volatile("" ::: "memory");
        kb = kb == 2 ? 0 : kb + 1;
    }
    if (hi == 0) li_l[r32] = l_reg; asm volatile("s_waitcnt lgkmcnt(0)" ::: "memory");
    float rli[16];
#pragma unroll
    for (int r = 0; r < 16; ++r) rli[r] = __builtin_amdgcn_rcpf(li_l[crow(r, hi)]);
    bf16_t* Ow = Ob + (long)(wid * QBLK) * LDO;
#pragma unroll
    for (int r = 0; r < 16; ++r) { const int orow = crow(r, hi);
#pragma unroll
        for (int d0 = 0; d0 < 8; ++d0) Ow[(long)orow * LDO + d0 * 32 + r32] = f2bf(o[d0][r] * rli[r]); }
    asm volatile("s_waitcnt lgkmcnt(0)" ::: "memory"); __builtin_amdgcn_s_barrier(); asm volatile("" ::: "memory");
#undef DMA_K
#undef DMA_V
#undef TILE
}

__device__ __forceinline__ void unit3(const bf16_t* __restrict__ Qb, const bf16_t* __restrict__ Kh, const bf16_t* __restrict__ Vh, bf16_t* __restrict__ Ob, int NT, int lim, unsigned char* ldsg, LAS unsigned char* lds) {
    int tid_ = threadIdx.x; asm volatile("" : "+v"(tid_));
    const int tid = tid_, wid = __builtin_amdgcn_readfirstlane(tid >> 6), lane = tid & 63, r32 = lane & 31, hi = lane >> 5, hb = MK_HB(wid);
    LAS float* wsf = (LAS float*)(lds + OFF_W) + wid * 64; LAS float* li_l = wsf; LAS float* al_l = wsf + 32;
    float m_reg = -1e30f, l_reg = 0; f32x16 o[8] = {}; bf16x8 qr[8];
    const bf16_t* Qw = Qb + (long)(wid * QBLK + r32) * LDQ + hi * 8;
#pragma unroll
    for (int d0 = 0; d0 < 8; ++d0) qr[d0] = *reinterpret_cast<const bf16x8*>(Qw + d0 * 16);
#define DMA_K(t_, b_) do { const char* gk = (const char*)Kh + (size_t)(t_) * (KVBLK * LDQ * 2); int ln_ = lane; asm volatile("" : "+v"(ln_)); _Pragma("unroll") for (int i = 0; i < 2; ++i) { \
        const int row = wid * 4 + i * 32 + (ln_ >> 4); const unsigned ko = (unsigned)(row * LDQ * 2 + (((ln_ & 15) * 16) ^ ((row & MK_KSWM) << 4))); \
        __builtin_amdgcn_global_load_lds((const unsigned*)(gk + ko), (LAS unsigned*)(lds + (b_) * KB + wid * 1024 + i * 8192), 16, 0, 0); } } while (0)
#define DMA_V(t_, b_) do { const char* gv = (const char*)Vh + (size_t)(t_) * (KVBLK * LDQ * 2); int ln_ = lane; asm volatile("" : "+v"(ln_)); _Pragma("unroll") for (int i = 0; i < 4; ++i) { \
        const int st = wid * 2 + i * 16 + (ln_ >> 5), q = ln_ & 31; const int kk = (st >> 3) * 8 + (q >> 2); const int k = (kk & ~0xC) | ((kk & 4) << 1) | ((kk & 8) >> 1); \
        const unsigned vo = (unsigned)(k * LDQ * 2 + ((st & 7) * 32 + (q & 3) * 8) * 2); \
        __builtin_amdgcn_global_load_lds((const unsigned*)(gv + vo), (LAS unsigned*)(lds + OFF_V + (b_) * VB + wid * 1024 + i * 8192), 16, 0, 0); } } while (0)
    DMA_K(0, 0); DMA_V(0, 0); if (1 < NT) { DMA_K(1, 1); DMA_V(1, 1); }
    asm volatile("s_waitcnt vmcnt(0)" ::: "memory"); __builtin_amdgcn_s_barrier(); asm volatile("" ::: "memory");
    bf16x8 pa0, pa1, pa2, pa3;
    int kq = 0, ki = 2;
    int vq = 0, vi = 2;
#define U3_QS(j_) do { f32x16 p0, p1; float mn, alpha; int lq_ = lane; asm volatile("" : "+v"(lq_)); const int r32 = lq_ & 31, hi = lq_ >> 5; \
        qkt(p0, p1, (const char*)ldsg + kq * KB, qr, r32, hi); kq = kq == 2 ? 0 : kq + 1; \
        mask_tile(p0, p1, (j_), lim); \
        partialSM(p0, p1, m_reg, mn, alpha); \
        if (__any(alpha < 1.f)) { if (hi == 0) al_l[r32] = alpha; asm volatile("s_waitcnt lgkmcnt(0)" ::: "memory"); \
            _Pragma("unroll") for (int d = 0; d < 8; ++d) _Pragma("unroll") for (int r = 0; r < 16; ++r) o[d][r] *= al_l[crow(r, hi)]; } \
        finishSM(p0, p1, alpha, l_reg, pa0, pa1, pa2, pa3); } while (0)
#define U3_PV(j_) do { int lp_ = lane; asm volatile("" : "+v"(lp_)); const int vb = (int)(uintptr_t)(ldsg + OFF_V) + v_rd_base(lp_) + vq * VB; vq = vq == 2 ? 0 : vq + 1; \
        pv2_one<0>(o[0], vb, pa0, pa1, pa2, pa3); pv2_one<1>(o[1], vb, pa0, pa1, pa2, pa3); pv2_one<2>(o[2], vb, pa0, pa1, pa2, pa3); pv2_one<3>(o[3], vb, pa0, pa1, pa2, pa3); \
        pv2_one<4>(o[4], vb, pa0, pa1, pa2, pa3); pv2_one<5>(o[5], vb, pa0, pa1, pa2, pa3); pv2_one<6>(o[6], vb, pa0, pa1, pa2, pa3); pv2_one<7>(o[7], vb, pa0, pa1, pa2, pa3); } while (0)
#define U3_EVEN_ISSUE(jj_) do { if ((jj_) + 2 < NT) DMA_K((jj_) + 2, ki); ki = ki == 2 ? 0 : ki + 1; asm volatile("" ::: "memory"); } while (0)
#define U3_ODD_ISSUE(jj_) do { if ((jj_) + 2 < NT) DMA_V((jj_) + 2, vi); vi = vi == 2 ? 0 : vi + 1; asm volatile("" ::: "memory"); } while (0)
#define U3_EVEN_END(jj_) do { if ((jj_) + 2 < NT) asm volatile("s_waitcnt vmcnt(6)" ::: "memory"); else if ((jj_) + 1 < NT) asm volatile("s_waitcnt vmcnt(4)" ::: "memory"); else asm volatile("s_waitcnt vmcnt(0)" ::: "memory");   \
        asm volatile("s_waitcnt lgkmcnt(0)" ::: "memory"); __builtin_amdgcn_s_barrier(); asm volatile("" ::: "memory"); } while (0)
#define U3_ODD_END() do { asm volatile("s_waitcnt lgkmcnt(0)" ::: "memory"); __builtin_amdgcn_s_barrier(); asm volatile("" ::: "memory"); } while (0)
    if (hb == 0) {
#pragma unroll 1
        for (int jj = 0; jj < NT; ++jj) {
            U3_EVEN_ISSUE(jj); U3_QS(jj); U3_EVEN_END(jj);
            U3_ODD_ISSUE(jj); U3_PV(jj); U3_ODD_END();
        }
        U3_EVEN_ISSUE(NT); U3_EVEN_END(NT);
    } else {
        U3_EVEN_ISSUE(0); U3_EVEN_END(0);
#pragma unroll 1
        for (int jj = 0; jj < NT; ++jj) {
            U3_ODD_ISSUE(jj); U3_QS(jj); U3_ODD_END();
            U3_EVEN_ISSUE(jj + 1); U3_PV(jj); U3_EVEN_END(jj + 1);
        }
    }
#undef U3_QS
#undef U3_PV
#undef U3_EVEN_ISSUE
#undef U3_ODD_ISSUE
#undef U3_EVEN_END
#undef U3_ODD_END
    if (hi == 0) li_l[r32] = l_reg; asm volatile("s_waitcnt lgkmcnt(0)" ::: "memory");
    float rli[16];
#pragma unroll
    for (int r = 0; r < 16; ++r) rli[r] = __builtin_amdgcn_rcpf(li_l[crow(r, hi)]);
    bf16_t* Ow = Ob + (long)(wid * QBLK) * LDO;
#pragma unroll
    for (int r = 0; r < 16; ++r) { const int orow = crow(r, hi);
#pragma unroll
        for (int d0 = 0; d0 < 8; ++d0) Ow[(long)orow * LDO + d0 * 32 + r32] = f2bf(o[d0][r] * rli[r]); }
    asm volatile("s_waitcnt vmcnt(0) lgkmcnt(0)" ::: "memory"); __builtin_amdgcn_s_barrier(); asm volatile("" ::: "memory");
#undef DMA_K
#undef DMA_V
}

__device__ __forceinline__ void unit4(const bf16_t* __restrict__ Qb, const bf16_t* __restrict__ Kh, const bf16_t* __restrict__ Vh, bf16_t* __restrict__ Ob, int NT, int lim, unsigned char* ldsg, LAS unsigned char* lds) {
    int tid_ = threadIdx.x; asm volatile("" : "+v"(tid_));
    const int tid = tid_, wid = __builtin_amdgcn_readfirstlane(tid >> 6), lane = tid & 63, hb = MK_HB(wid);
    LAS float* wsf = (LAS float*)(lds + OFF_W) + wid * 64; LAS float* li_l = wsf; LAS float* al_l = wsf + 32;
    float m_reg = -1e30f, l_reg = 0; f32x16 o[8] = {}; bf16x8 qr[8];
    { const int r32 = lane & 31, hi = lane >> 5; const bf16_t* Qw = Qb + (long)(wid * QBLK + r32) * LDQ + hi * 8;
#pragma unroll
      for (int d0 = 0; d0 < 8; ++d0) qr[d0] = *reinterpret_cast<const bf16x8*>(Qw + d0 * 16); }
#define DMA_K(t_, b_) do { const char* gk = (const char*)Kh + (size_t)(t_) * (KVBLK * LDQ * 2); int ln_ = lane; asm volatile("" : "+v"(ln_)); _Pragma("unroll") for (int i = 0; i < 2; ++i) { \
        const int row = wid * 4 + i * 32 + (ln_ >> 4); const unsigned ko = (unsigned)(row * LDQ * 2 + (((ln_ & 15) * 16) ^ ((row & MK_KSWM) << 4))); \
        __builtin_amdgcn_global_load_lds((const unsigned*)(gk + ko), (LAS unsigned*)(lds + (b_) * KB + wid * 1024 + i * 8192), 16, 0, 0); } } while (0)
#define DMA_V(t_, b_) do { const char* gv = (const char*)Vh + (size_t)(t_) * (KVBLK * LDQ * 2); int ln_ = lane; asm volatile("" : "+v"(ln_)); _Pragma("unroll") for (int i = 0; i < 4; ++i) { \
        const int st = wid * 2 + i * 16 + (ln_ >> 5), q = ln_ & 31; const int kk = (st >> 3) * 8 + (q >> 2); const int k = (kk & ~0xC) | ((kk & 4) << 1) | ((kk & 8) >> 1); \
        const unsigned vo = (unsigned)(k * LDQ * 2 + ((st & 7) * 32 + (q & 3) * 8) * 2); \
        __builtin_amdgcn_global_load_lds((const unsigned*)(gv + vo), (LAS unsigned*)(lds + OFF_V + (b_) * VB + wid * 1024 + i * 8192), 16, 0, 0); } } while (0)
    DMA_K(0, 0); DMA_V(0, 0); if (1 < NT) { DMA_K(1, 1); DMA_V(1, 1); } if (2 < NT) DMA_K(2, 2);
    asm volatile("s_waitcnt vmcnt(0)" ::: "memory"); __builtin_amdgcn_s_barrier(); asm volatile("" ::: "memory");
    f32x16 p0, p1; bf16x8 pa0, pa1, pa2, pa3;
    int kq = 0, ki = 0, vq = 0, vi = 2;
#define U4_QK() do { int lq_ = lane; asm volatile("" : "+v"(lq_)); qkt(p0, p1, (const char*)ldsg + kq * KB, qr, lq_ & 31, lq_ >> 5); kq = kq == 2 ? 0 : kq + 1; } while (0)
#define U4_SM(j_) do { float mn, alpha; int lq_ = lane; asm volatile("" : "+v"(lq_)); const int r32 = lq_ & 31, hi = lq_ >> 5; \
        mask_tile(p0, p1, (j_), lim); \
        partialSM(p0, p1, m_reg, mn, alpha); \
        if (__any(alpha < 1.f)) { if (hi == 0) al_l[r32] = alpha; asm volatile("s_waitcnt lgkmcnt(0)" ::: "memory"); \
            _Pragma("unroll") for (int d = 0; d < 8; ++d) _Pragma("unroll") for (int r = 0; r < 16; ++r) o[d][r] *= al_l[crow(r, hi)]; } \
        finishSM(p0, p1, alpha, l_reg, pa0, pa1, pa2, pa3); } while (0)
#define U4_PV() do { int lp_ = lane; asm volatile("" : "+v"(lp_)); const int vb = (int)(uintptr_t)(ldsg + OFF_V) + v_rd_base(lp_) + vq * VB; vq = vq == 2 ? 0 : vq + 1; \
        pv2_all(o, vb, pa0, pa1, pa2, pa3); } while (0)
#define U4_ISSUE(s_) do { if (((s_) & 1) == 0) { if ((s_) >= 2) { if ((s_) / 2 + 2 < NT) DMA_K((s_) / 2 + 2, ki); ki = ki == 2 ? 0 : ki + 1; } } \
        else { if ((s_) >= 3) { if (((s_) + 1) / 2 < NT) DMA_V(((s_) + 1) / 2, vi); vi = vi == 2 ? 0 : vi + 1; } } asm volatile("" ::: "memory"); } while (0)
#define U4_END(s_) do { if ((s_) & 1) { const int kt = ((s_) + 1) / 2 + 1, vt = ((s_) + 1) / 2;     \
            if ((s_) >= 3 && kt < NT && vt < NT) asm volatile("s_waitcnt vmcnt(6)" ::: "memory"); \
            else if ((s_) >= 3 && vt < NT) asm volatile("s_waitcnt vmcnt(4)" ::: "memory"); \
            else asm volatile("s_waitcnt vmcnt(0)" ::: "memory"); } \
        asm volatile("s_waitcnt lgkmcnt(0)" ::: "memory"); __builtin_amdgcn_s_barrier(); asm volatile("" ::: "memory"); } while (0)
    if (hb == 0) {
        U4_ISSUE(0); U4_QK(); U4_END(0);
#pragma unroll 1
        for (int m = 0; m < NT; ++m) {
            U4_ISSUE(2 * m + 1); U4_SM(m); U4_END(2 * m + 1);
            U4_ISSUE(2 * m + 2); U4_PV(); if (m + 1 < NT) U4_QK(); U4_END(2 * m + 2);
        }
        U4_ISSUE(2 * NT + 1); U4_END(2 * NT + 1);
    } else {
        U4_ISSUE(0); U4_END(0);
        U4_ISSUE(1); U4_QK(); U4_END(1);
#pragma unroll 1
        for (int m = 0; m < NT; ++m) {
            U4_ISSUE(2 * m + 2); U4_SM(m); U4_END(2 * m + 2);
            U4_ISSUE(2 * m + 3); U4_PV(); if (m + 1 < NT) U4_QK(); U4_END(2 * m + 3);
        }
    }
#undef U4_QK
#undef U4_SM
#undef U4_PV
#undef U4_ISSUE
#undef U4_END
    const int r32 = lane & 31, hi = lane >> 5;
    if (hi == 0) li_l[r32] = l_reg; asm volatile("s_waitcnt lgkmcnt(0)" ::: "memory");
    float rli[16];
#pragma unroll
    for (int r = 0; r < 16; ++r) rli[r] = __builtin_amdgcn_rcpf(li_l[crow(r, hi)]);
    bf16_t* Ow = Ob + (long)(wid * QBLK) * LDO;
#pragma unroll
    for (int r = 0; r < 16; ++r) { const int orow = crow(r, hi);
#pragma unroll
        for (int d0 = 0; d0 < 8; ++d0) Ow[(long)orow * LDO + d0 * 32 + r32] = f2bf(o[d0][r] * rli[r]); }
    asm volatile("s_waitcnt vmcnt(0) lgkmcnt(0)" ::: "memory"); __builtin_amdgcn_s_barrier(); asm volatile("" ::: "memory");
#undef DMA_K
#undef DMA_V
}

__device__ __forceinline__ void unit5(const bf16_t* __restrict__ Qb, const bf16_t* __restrict__ Kh, const bf16_t* __restrict__ Vh, bf16_t* __restrict__ Ob, int NT, int lim, unsigned char* ldsg, LAS unsigned char* lds) {
    int tid_ = threadIdx.x; asm volatile("" : "+v"(tid_));
    const int tid = tid_, wid = __builtin_amdgcn_readfirstlane(tid >> 6), lane = tid & 63, hb = MK_HB(wid);
    LAS float* wsf = (LAS float*)(lds + OFF_W) + wid * 64; LAS float* li_l = wsf; LAS float* al_l = wsf + 32;
    float m_reg = -1e30f, l_reg = 0; f32x16 o[8] = {}; bf16x8 qr[8];
    { const int r32 = lane & 31, hi = lane >> 5; const bf16_t* Qw = Qb + (long)(wid * QBLK + r32) * LDQ + hi * 8;
#pragma unroll
      for (int d0 = 0; d0 < 8; ++d0) qr[d0] = *reinterpret_cast<const bf16x8*>(Qw + d0 * 16); }
#define DMA_K(t_, b_) do { const char* gk = (const char*)Kh + (size_t)(t_) * (KVBLK * LDQ * 2); int ln_ = lane; asm volatile("" : "+v"(ln_)); _Pragma("unroll") for (int i = 0; i < 2; ++i) { \
        const int row = wid * 4 + i * 32 + (ln_ >> 4); const unsigned ko = (unsigned)(row * LDQ * 2 + (((ln_ & 15) * 16) ^ ((row & MK_KSWM) << 4))); \
        __builtin_amdgcn_global_load_lds((const unsigned*)(gk + ko), (LAS unsigned*)(lds + (b_) * KB + wid * 1024 + i * 8192), 16, 0, 0); } } while (0)
#define DMA_V(t_, b_) do { const char* gv = (const char*)Vh + (size_t)(t_) * (KVBLK * LDQ * 2); int ln_ = lane; asm volatile("" : "+v"(ln_)); _Pragma("unroll") for (int i = 0; i < 4; ++i) { \
        const int st = wid * 2 + i * 16 + (ln_ >> 5), q = ln_ & 31; const int kk = (st >> 3) * 8 + (q >> 2); const int k = (kk & ~0xC) | ((kk & 4) << 1) | ((kk & 8) >> 1); \
        const unsigned vo = (unsigned)(k * LDQ * 2 + ((st & 7) * 32 + (q & 3) * 8) * 2); \
        __builtin_amdgcn_global_load_lds((const unsigned*)(gv + vo), (LAS unsigned*)(lds + OFF_V + (b_) * VB + wid * 1024 + i * 8192), 16, 0, 0); } } while (0)
    DMA_K(0, 0); DMA_V(0, 0); if (1 < NT) DMA_K(1, 1);
    asm volatile("s_waitcnt vmcnt(0)" ::: "memory"); __builtin_amdgcn_s_barrier(); asm volatile("" ::: "memory");
    bf16x8 pa0, pa1, pa2, pa3;
    int kb = 0, kb1 = 1, kb2 = 2;
#define U5_ISSUE(j_) do { if ((j_) + 1 < NT) DMA_V((j_) + 1, kb1); asm volatile("" ::: "memory"); if ((j_) + 2 < NT) DMA_K((j_) + 2, kb2); asm volatile("" ::: "memory"); } while (0)
#define U5_QS(j_) do { f32x16 p0, p1; float mn, alpha; int lq_ = lane; asm volatile("" : "+v"(lq_)); const int r32 = lq_ & 31, hi = lq_ >> 5; \
        qkt(p0, p1, (const char*)ldsg + kb * KB, qr, r32, hi); \
        mask_tile(p0, p1, (j_), lim); \
        partialSM(p0, p1, m_reg, mn, alpha); \
        if (__any(alpha < 1.f)) { if (hi == 0) al_l[r32] = alpha; asm volatile("s_waitcnt lgkmcnt(0)" ::: "memory"); \
            _Pragma("unroll") for (int d = 0; d < 8; ++d) _Pragma("unroll") for (int r = 0; r < 16; ++r) o[d][r] *= al_l[crow(r, hi)]; } \
        finishSM(p0, p1, alpha, l_reg, pa0, pa1, pa2, pa3); } while (0)
#define U5_PV(vbuf_) do { int lp_ = lane; asm volatile("" : "+v"(lp_)); const int vb = (int)(uintptr_t)(ldsg + OFF_V) + v_rd_base(lp_) + (vbuf_) * VB; pv2_all(o, vb, pa0, pa1, pa2, pa3); } while (0)
#define U5_END(j_) do { if ((j_) + 2 < NT) asm volatile("s_waitcnt vmcnt(2)" ::: "memory"); else asm volatile("s_waitcnt vmcnt(0)" ::: "memory"); \
        asm volatile("s_waitcnt lgkmcnt(0)" ::: "memory"); __builtin_amdgcn_s_barrier(); asm volatile("" ::: "memory"); \
        { const int t_ = kb; kb = kb1; kb1 = kb2; kb2 = t_; } } while (0)
    if (hb == 0) {
#pragma unroll 1
        for (int j = 0; j < NT; ++j) { U5_ISSUE(j); U5_QS(j); U5_PV(kb); U5_END(j); }
    } else {
#pragma unroll 1
        for (int j = 0; j < NT; ++j) { U5_ISSUE(j); if (j > 0) U5_PV(kb2); U5_QS(j); U5_END(j); }
        U5_PV(kb2);
    }
#undef U5_ISSUE
#undef U5_QS
#undef U5_PV
#undef U5_END
    const int r32 = lane & 31, hi = lane >> 5;
    if (hi == 0) li_l[r32] = l_reg; asm volatile("s_waitcnt lgkmcnt(0)" ::: "memory");
    float rli[16];
#pragma unroll
    for (int r = 0; r < 16; ++r) rli[r] = __builtin_amdgcn_rcpf(li_l[crow(r, hi)]);
    bf16_t* Ow = Ob + (long)(wid * QBLK) * LDO;
#pragma unroll
    for (int r = 0; r < 16; ++r) { const int orow = crow(r, hi);
#pragma unroll
        for (int d0 = 0; d0 < 8; ++d0) Ow[(long)orow * LDO + d0 * 32 + r32] = f2bf(o[d0][r] * rli[r]); }
    asm volatile("s_waitcnt vmcnt(0) lgkmcnt(0)" ::: "memory"); __builtin_amdgcn_s_barrier(); asm volatile("" ::: "memory");
#undef DMA_K
#undef DMA_V
}

constexpr int v6_off(int c, int cb, int h) { return c * 16384 + h * 8192 + cb * 256; }
struct V6Set { s16x4 l0, h0, l1, h1, l2, h2, l3, h3; };
template <int C, int G> __device__ __forceinline__ void v6_load(V6Set& f, int vb) {
    f.l0 = tr_read<v6_off(C, 4 * G + 0, 0)>(vb); f.h0 = tr_read<v6_off(C, 4 * G + 0, 1)>(vb); f.l1 = tr_read<v6_off(C, 4 * G + 1, 0)>(vb); f.h1 = tr_read<v6_off(C, 4 * G + 1, 1)>(vb);
    f.l2 = tr_read<v6_off(C, 4 * G + 2, 0)>(vb); f.h2 = tr_read<v6_off(C, 4 * G + 2, 1)>(vb); f.l3 = tr_read<v6_off(C, 4 * G + 3, 0)>(vb); f.h3 = tr_read<v6_off(C, 4 * G + 3, 1)>(vb);
}
template <int G> __device__ __forceinline__ void v6_mma(f32x4 (&o)[2][16], const V6Set& f, bf16x8 pa0, bf16x8 pa1) {
#define PK(Lo, Hi) (bf16x8){Lo[0], Lo[1], Lo[2], Lo[3], Hi[0], Hi[1], Hi[2], Hi[3]}
    o[0][4 * G + 0] = __builtin_amdgcn_mfma_f32_16x16x32_bf16(pa0, PK(f.l0, f.h0), o[0][4 * G + 0], 0, 0, 0);
    o[1][4 * G + 0] = __builtin_amdgcn_mfma_f32_16x16x32_bf16(pa1, PK(f.l0, f.h0), o[1][4 * G + 0], 0, 0, 0);
    o[0][4 * G + 1] = __builtin_amdgcn_mfma_f32_16x16x32_bf16(pa0, PK(f.l1, f.h1), o[0][4 * G + 1], 0, 0, 0);
    o[1][4 * G + 1] = __builtin_amdgcn_mfma_f32_16x16x32_bf16(pa1, PK(f.l1, f.h1), o[1][4 * G + 1], 0, 0, 0);
    o[0][4 * G + 2] = __builtin_amdgcn_mfma_f32_16x16x32_bf16(pa0, PK(f.l2, f.h2), o[0][4 * G + 2], 0, 0, 0);
    o[1][4 * G + 2] = __builtin_amdgcn_mfma_f32_16x16x32_bf16(pa1, PK(f.l2, f.h2), o[1][4 * G + 2], 0, 0, 0);
    o[0][4 * G + 3] = __builtin_amdgcn_mfma_f32_16x16x32_bf16(pa0, PK(f.l3, f.h3), o[0][4 * G + 3], 0, 0, 0);
    o[1][4 * G + 3] = __builtin_amdgcn_mfma_f32_16x16x32_bf16(pa1, PK(f.l3, f.h3), o[1][4 * G + 3], 0, 0, 0);
#undef PK
}
__device__ __forceinline__ void pv6_all(f32x4 (&o)[2][16], int vb, bf16x8 pa00, bf16x8 pa01, bf16x8 pa10, bf16x8 pa11) {
    V6Set A, B;
#define W8() do { asm volatile("s_waitcnt lgkmcnt(8)" ::: "memory"); SBAR(); } while (0)
    v6_load<0, 0>(A, vb);
    v6_load<0, 1>(B, vb); W8(); v6_mma<0>(o, A, pa00, pa10); SBAR();
    v6_load<0, 2>(A, vb); W8(); v6_mma<1>(o, B, pa00, pa10); SBAR();
    v6_load<0, 3>(B, vb); W8(); v6_mma<2>(o, A, pa00, pa10); SBAR();
    v6_load<1, 0>(A, vb); W8(); v6_mma<3>(o, B, pa00, pa10); SBAR();
    v6_load<1, 1>(B, vb); W8(); v6_mma<0>(o, A, pa01, pa11); SBAR();
    v6_load<1, 2>(A, vb); W8(); v6_mma<1>(o, B, pa01, pa11); SBAR();
    v6_load<1, 3>(B, vb); W8(); v6_mma<2>(o, A, pa01, pa11); SBAR();
    asm volatile("s_waitcnt lgkmcnt(0)" ::: "memory"); SBAR(); v6_mma<3>(o, B, pa01, pa11); SBAR();
#undef W8
}
#ifndef MK_X16SWAP
#define MK_X16SWAP 0
#endif
__device__ __forceinline__ float grp_max(float v) {
#if MK_X16SWAP
    { auto rr = __builtin_amdgcn_permlane16_swap(__float_as_uint(v), __float_as_uint(v), false, false); v = fmaxf(__uint_as_float(rr[0]), __uint_as_float(rr[1])); }
#else
    v = fmaxf(v, __shfl_xor(v, 16));
#endif
    { auto rr = __builtin_amdgcn_permlane32_swap(__float_as_uint(v), __float_as_uint(v), false, false); v = fmaxf(__uint_as_float(rr[0]), __uint_as_float(rr[1])); }
    return v;
}
__device__ __forceinline__ float grp_sum(float v) {
#if MK_X16SWAP
    { auto rr = __builtin_amdgcn_permlane16_swap(__float_as_uint(v), __float_as_uint(v), false, false); v = __uint_as_float(rr[0]) + __uint_as_float(rr[1]); }
#else
    v += __shfl_xor(v, 16);
#endif
    { auto rr = __builtin_amdgcn_permlane32_swap(__float_as_uint(v), __float_as_uint(v), false, false); v = __uint_as_float(rr[0]) + __uint_as_float(rr[1]); }
    return v;
}
__device__ __forceinline__ void unit6(const bf16_t* __restrict__ Qb, const bf16_t* __restrict__ Kh, const bf16_t* __restrict__ Vh, bf16_t* __restrict__ Ob, int NT, int lim, unsigned char* ldsg, LAS unsigned char* lds) {
    int tid_ = threadIdx.x; asm volatile("" : "+v"(tid_));
    const int tid = tid_, wid = __builtin_amdgcn_readfirstlane(tid >> 6), lane = tid & 63, c16 = lane & 15, g = lane >> 4;
    LAS float* wsf = (LAS float*)(lds + OFF_W) + wid * 64; LAS float* li_l = wsf; LAS float* al_l = wsf + 32;
    float m0 = -1e30f, m1 = -1e30f, l0 = 0.f, l1 = 0.f;
    f32x4 o[2][16];
#pragma unroll
    for (int qb = 0; qb < 2; ++qb)
#pragma unroll
        for (int cb = 0; cb < 16; ++cb) o[qb][cb] = (f32x4){0.f, 0.f, 0.f, 0.f};
    bf16x8 qr[2][4];
    { const bf16_t* Qw = Qb + (long)(wid * QBLK + c16) * LDQ + g * 8;
#pragma unroll
      for (int qb = 0; qb < 2; ++qb)
#pragma unroll
          for (int ds = 0; ds < 4; ++ds) qr[qb][ds] = *reinterpret_cast<const bf16x8*>(Qw + (long)qb * 16 * LDQ + ds * 32); }
    const int ka0 = c16 * 256 + ((g * 16) ^ (c16 << 4));
    const int vb0 = (int)(uintptr_t)(ldsg + OFF_V) + (g >> 1) * 4096 + (g & 1) * 128 + (c16 >> 2) * 32 + (c16 & 3) * 8;
    unsigned ko0, vo0;
    { const int row = wid * 4 + (lane >> 4); ko0 = (unsigned)(row * LDQ * 2 + (((lane & 15) * 16) ^ ((row & 15) << 4)));
      const int key = (wid >> 2) * 8 + ((lane & 15) >> 1), col = (4 * (wid & 3) + (lane >> 4)) * 16 + (lane & 1) * 8;
      vo0 = (unsigned)(key * LDQ * 2 + col * 2); }
#define DMA_K(t_, b_) do { const char* gk = (const char*)Kh + (size_t)(t_) * (KVBLK * LDQ * 2); _Pragma("unroll") for (int i = 0; i < 2; ++i) { \
        __builtin_amdgcn_global_load_lds((const unsigned*)(gk + (size_t)i * (32 * LDQ * 2) + ko0), (LAS unsigned*)(lds + (b_) * KB + wid * 1024 + i * 8192), 16, 0, 0); } } while (0)
#define DMA_V(t_, b_) do { const char* gv = (const char*)Vh + (size_t)(t_) * (KVBLK * LDQ * 2); _Pragma("unroll") for (int i = 0; i < 4; ++i) { \
        __builtin_amdgcn_global_load_lds((const unsigned*)(gv + (size_t)i * (16 * LDQ * 2) + vo0), (LAS unsigned*)(lds + OFF_V + (b_) * VB + wid * 1024 + i * 8192), 16, 0, 0); } } while (0)
    DMA_K(0, 0); DMA_V(0, 0); if (1 < NT) { DMA_K(1, 1); DMA_V(1, 1); }
    asm volatile("s_waitcnt vmcnt(0)" ::: "memory"); __builtin_amdgcn_s_barrier(); asm volatile("" ::: "memory");
    int kb3 = 0;
    for (int j = 0; j < NT; ++j) {
        const int kb2 = kb3 == 0 ? 2 : kb3 - 1;
        if (j + 2 < NT) DMA_V(j + 2, kb2);
        asm volatile("" ::: "memory");
        if (j + 2 < NT) DMA_K(j + 2, kb2);
        asm volatile("" ::: "memory");
        if (j <= lim) {
        constexpr float C = SCALE * 1.4426950408889634f;
        f32x4 s[4][2];
#pragma unroll
        for (int kb = 0; kb < 4; ++kb) { s[kb][0] = (f32x4){0.f, 0.f, 0.f, 0.f}; s[kb][1] = (f32x4){0.f, 0.f, 0.f, 0.f}; }
        { const char* Ks = (const char*)ldsg + kb3 * KB;
#pragma unroll
          for (int ds = 0; ds < 4; ++ds) {
              bf16x8 kf[4];
#pragma unroll
              for (int kb = 0; kb < 4; ++kb) kf[kb] = *reinterpret_cast<const bf16x8*>(Ks + kb * 4096 + (ka0 ^ (ds << 6)));
#pragma unroll
              for (int kb = 0; kb < 4; ++kb) { s[kb][0] = __builtin_amdgcn_mfma_f32_16x16x32_bf16(kf[kb], qr[0][ds], s[kb][0], 0, 0, 0);
                                               s[kb][1] = __builtin_amdgcn_mfma_f32_16x16x32_bf16(kf[kb], qr[1][ds], s[kb][1], 0, 0, 0); } } }
        int jz = j; asm volatile("" : "+s"(jz));
        if (jz == 0) {
            asm volatile("; tile-0 mask" ::: "memory");
#pragma unroll
            for (int kb = 0; kb < 3; ++kb)
#pragma unroll
                for (int r = 0; r < 4; ++r) { s[kb][0][r] = -1e30f; s[kb][1][r] = -1e30f; }
        }
        float pm0 = s[0][0][0], pm1 = s[0][1][0];
#pragma unroll
        for (int kb = 0; kb < 4; ++kb)
#pragma unroll
            for (int r = 0; r < 4; ++r) { pm0 = fmaxf(pm0, s[kb][0][r]); pm1 = fmaxf(pm1, s[kb][1][r]); }
        pm0 = grp_max(pm0); pm1 = grp_max(pm1);
        float a0, a1;
        if (__builtin_expect(__all(fmaxf(pm0 - m0, pm1 - m1) <= THR / SCALE), 1)) { a0 = 1.f; a1 = 1.f; }
        else { const float n0 = fmaxf(m0, pm0), n1 = fmaxf(m1, pm1); a0 = __builtin_amdgcn_exp2f((m0 - n0) * C); a1 = __builtin_amdgcn_exp2f((m1 - n1) * C); m0 = n0; m1 = n1; }
        if (__any(a0 < 1.f || a1 < 1.f)) {
            if (g == 0) { al_l[c16] = a0; al_l[16 + c16] = a1; } asm volatile("s_waitcnt lgkmcnt(0)" ::: "memory");
            const f32x4 q0 = *(const LAS f32x4*)(al_l + 4 * g), q1 = *(const LAS f32x4*)(al_l + 16 + 4 * g);
            asm volatile("s_waitcnt lgkmcnt(0)" ::: "memory");
#pragma unroll
            for (int cb = 0; cb < 16; ++cb)
#pragma unroll
                for (int r = 0; r < 4; ++r) { o[0][cb][r] *= q0[r]; o[1][cb][r] *= q1[r]; }
        }
        const float mc0 = -m0 * C, mc1 = -m1 * C;
        float ps0 = 0.f, ps1 = 0.f;
#pragma unroll
        for (int kb = 0; kb < 4; ++kb)
#pragma unroll
            for (int r = 0; r < 4; ++r) { s[kb][0][r] = __builtin_amdgcn_exp2f(fmaf(s[kb][0][r], C, mc0)); s[kb][1][r] = __builtin_amdgcn_exp2f(fmaf(s[kb][1][r], C, mc1)); }
#pragma unroll
        for (int kb = 0; kb < 4; ++kb)
#pragma unroll
            for (int r = 0; r < 4; ++r) { ps0 += s[kb][0][r]; ps1 += s[kb][1][r]; }
        ps0 = grp_sum(ps0); ps1 = grp_sum(ps1);
        l0 = l0 * a0 + ps0; l1 = l1 * a1 + ps1;
        bf16x8 pa00, pa01, pa10, pa11;
#define PK6(QB, CH, OUT) do { u32x4 w_ = {cvt_pk_bf16(s[2 * CH][QB][0], s[2 * CH][QB][1]), cvt_pk_bf16(s[2 * CH][QB][2], s[2 * CH][QB][3]), \
                                          cvt_pk_bf16(s[2 * CH + 1][QB][0], s[2 * CH + 1][QB][1]), cvt_pk_bf16(s[2 * CH + 1][QB][2], s[2 * CH + 1][QB][3])}; OUT = *reinterpret_cast<bf16x8*>(&w_); } while (0)
        PK6(0, 0, pa00); PK6(0, 1, pa01); PK6(1, 0, pa10); PK6(1, 1, pa11);
#undef PK6
        SBAR();
        pv6_all(o, vb0 + kb3 * VB, pa00, pa01, pa10, pa11);
        }
        if (j + 2 < NT) asm volatile("s_waitcnt vmcnt(6)" ::: "memory"); else asm volatile("s_waitcnt vmcnt(0)" ::: "memory");
        __builtin_amdgcn_s_barrier(); asm volatile("" ::: "memory");
        kb3 = kb3 == 2 ? 0 : kb3 + 1;
    }
    if (g == 0) { li_l[c16] = l0; li_l[16 + c16] = l1; } asm volatile("s_waitcnt lgkmcnt(0)" ::: "memory");
    f32x4 r0 = *(const LAS f32x4*)(li_l + 4 * g), r1 = *(const LAS f32x4*)(li_l + 16 + 4 * g);
#pragma unroll
    for (int r = 0; r < 4; ++r) { r0[r] = __builtin_amdgcn_rcpf(r0[r]); r1[r] = __builtin_amdgcn_rcpf(r1[r]); }
    bf16_t* Ow = Ob + (long)(wid * QBLK + 4 * g) * LDO + c16;
#pragma unroll
    for (int r = 0; r < 4; ++r)
#pragma unroll
        for (int cb = 0; cb < 16; ++cb) { Ow[(long)r * LDO + cb * 16] = f2bf(o[0][cb][r] * r0[r]); Ow[(long)(16 + r) * LDO + cb * 16] = f2bf(o[1][cb][r] * r1[r]); }
    asm volatile("s_waitcnt vmcnt(0) lgkmcnt(0)" ::: "memory"); __builtin_amdgcn_s_barrier(); asm volatile("" ::: "memory");
#undef DMA_K
#undef DMA_V
}
}

#ifndef MK_ATT2
#define MK_ATT2 1
#endif
#ifndef MK_PROBE_QK2
#define MK_PROBE_QK2 0
#endif
#ifndef MK_PROBE_DMA2
#define MK_PROBE_DMA2 0
#endif
#ifndef MK_ATT_UNIT
#define MK_ATT_UNIT unit2
#endif
#ifndef MK_ATT_REV
#define MK_ATT_REV 0
#endif
#if MK_ATT2
__device__ __forceinline__ void attn_phase(const Fr& F) {
    const bf16_t* Q = slotY(F, 0); const bf16_t* K = slotY(F, 1); const bf16_t* V = slotY(F, 2);
    bf16_t* AO = slotU(F, 1);
    const int x = F.bid & 7, j = (F.bid >> 3) & 31;
#pragma unroll 1
    for (int k = 0; k < 4; ++k) {
        if (F.bid >= 256) break;
        const int sub = 4 * x + k, head = sub >> 1, c = sub & 1;
        const bf16_t* Kp = K + head * 256 + c * 128; const bf16_t* Vp = V + head * 256;
#pragma unroll 1
        for (int u = 0; u < 2; ++u) {
            const int t = u == 0 ? 63 - j : j;
            const int row0 = 256 * t + 128;
            att2::MK_ATT_UNIT(Q + (size_t)row0 * D + head * 256 + c * 128, Kp, Vp, AO + (size_t)row0 * 8192 + head * 512 + c * 256, 4 * t + 6, 4 * t + 2 + (F.wave >> 1), F.ldsg, F.lds, MK_ATT_REV ? u : 0);
        }
        if (j == 8 * k) att2::MK_ATT_UNIT(Q + head * 256 + c * 128, Kp, Vp, AO + head * 512 + c * 256, 4, F.wave >> 1, F.ldsg, F.lds);
    }
}
#else
__device__ __forceinline__ void attn_phase(const Fr& F) {
    const bf16_t* Q = slotY(F, 0); const bf16_t* K = slotY(F, 1); const bf16_t* V = slotY(F, 2);
    bf16_t* AO = slotU(F, 1);
    const int x = F.bid & 7, j = (F.bid >> 3) & 31;
#pragma unroll 1
    for (int k = 0; k < 8; ++k) {
        if (F.bid >= 256) break;
        const int sub = 8 * x + k, head = sub >> 2, c = (sub >> 1) & 1, half = sub & 1;
        const bf16_t* Kp = K + head * 256 + c * 128; const bf16_t* Vp = V + head * 256 + half * 128;
#pragma unroll 1
        for (int u = 0; u < 2; ++u) {
            const int t = u == 0 ? 63 - j : j;
            const int row0 = 256 * t + 128;
            att::unit(Q + (size_t)row0 * D + head * 256 + c * 128, Kp, Vp, AO + (size_t)row0 * 8192 + head * 512 + c * 256 + half * 128, 4 * t + 6, 4 * t + 2 + (F.wave >> 1), (char*)F.ldsg);
        }
        if (j == 4 * k) att::unit(Q + head * 256 + c * 128, Kp, Vp, AO + head * 512 + c * 256 + half * 128, 4, F.wave >> 1, (char*)F.ldsg);
    }
}
#endif
__device__ __forceinline__ void attn_post(const Fr& F) {
    const bf16_t* AO = slotU(F, 1); const bf16_t* GT = slotY(F, 3); bf16_t* Z = slotU(F, 0);
    const float* sg = F.in(13);
    constexpr float LINIT = 0.35550906759096934f;
    float lam;
    { const float* q1 = F.in(9); const float* k1 = F.in(10); const float* q2 = F.in(11); const float* k2 = F.in(12);
      const float d1 = wave_sum(q1[F.lane] * k1[F.lane] + q1[F.lane + 64] * k1[F.lane + 64]), d2 = wave_sum(q2[F.lane] * k2[F.lane] + q2[F.lane + 64] * k2[F.lane + 64]);
      lam = expf(d1) - expf(d2) + LINIT; }
    const f32x4 g4 = ((const f32x4*)sg)[F.lane];
    for (int r = F.gw; r < R; r += F.NGW) {
        const bool real = (r >= NPAD && r < NREAL);
        u32x2* zr = (u32x2*)(Z + (size_t)r * D) + F.lane;
        if (!real) { const u32x2 z = {0u, 0u};
#pragma unroll
            for (int hd = 0; hd < 16; ++hd) zr[64 * hd] = z;
            continue; }
        gp_ ao0 = (gp_)(AO + (size_t)r * 8192) + F.lane * 8 + 4096; gp_ ao1 = ao0 + 8192; asm volatile("" : "+v"(ao0), "+v"(ao1));
        ROW_BF(gq, GT + (size_t)r * D, F.lane); ROW_BF(zq, Z + (size_t)r * D, F.lane);
        u32x2 a0v[16], a1v[16], gtv[16];
#pragma unroll
        for (int hd = 0; hd < 16; ++hd) {
            a0v[hd] = *(GAS u32x2*)(hd < 8 ? ao0 + (2 * hd) * 512 - 4096 : ao1 + (2 * hd - 16) * 512 - 4096);
            a1v[hd] = *(GAS u32x2*)(hd < 8 ? ao0 + (2 * hd + 1) * 512 - 4096 : ao1 + (2 * hd - 15) * 512 - 4096);
            gtv[hd] = AT_BF(gq, hd);
        }
#pragma unroll
        for (int hd = 0; hd < 16; ++hd) {
            const u32x2 a0 = a0v[hd], a1 = a1v[hd], gt = gtv[hd];
            const float o0 = bflo(a0.x) - lam * bflo(a1.x), o1 = bfhi(a0.x) - lam * bfhi(a1.x), o2 = bflo(a0.y) - lam * bflo(a1.y), o3 = bfhi(a0.y) - lam * bfhi(a1.y);
            const float ss = wave_sum((o0 * o0 + o1 * o1) + (o2 * o2 + o3 * o3));
            const float rs = __builtin_amdgcn_rsqf(ss * (1.f / 256.f) + 1e-5f) * (1.f - LINIT);
            u32x2 w; w.x = cvt_pk_bf16(o0 * rs * g4.x * silu_f(bflo(gt.x)), o1 * rs * g4.y * silu_f(bfhi(gt.x))); w.y = cvt_pk_bf16(o2 * rs * g4.z * silu_f(bflo(gt.y)), o3 * rs * g4.w * silu_f(bfhi(gt.y)));
            AT_BF(zq, hd) = w;
        }
    }
}

constexpr int RW_TT = 32, RW_TOKF = 384, RW_TILEF = RW_TT * RW_TOKF, RW_NTILE = 513;
__device__ __forceinline__ void rwkv_scan_seq(const Fr& F) {
    const bf16_t* Rr = slotY(F, 0); const bf16_t* K = slotY(F, 1); const bf16_t* V = slotY(F, 2); const bf16_t* W = slotY(F, 4); const bf16_t* A = slotY(F, 5);
    float* O32 = (float*)slotU(F, 1);
    LAS float* ring = (LAS float*)F.lds; LAS float* otile = ring + 2 * RW_TILEF;
    const int tid = F.tid, lane = F.lane, wid = F.wave;
    for (int unit = F.bid; unit < 256; unit += F.G) {
        const int h = unit >> 2, rg = unit & 3;
        const int ptid = tid - 256, ptt = ptid >> 3, dg = ptid & 7;
        float kkc[8], kac[8];
        if (wid >= 4) {
#pragma unroll
            for (int i = 0; i < 8; ++i) { kkc[i] = F.in(23)[h * 64 + 8 * dg + i]; kac[i] = F.in(24)[h * 64 + 8 * dg + i]; }
        }
        float S0 = 0.f, S1 = 0.f, S2 = 0.f, S3 = 0.f;
        const int cg = lane & 15, irow = 4 * wid + (lane >> 4);
#define RW_PRODUCE(m, buf) do { const int row = NPAD + 32 * (m) + ptt; const size_t off = (size_t)row * D + h * 64 + 8 * dg; \
        const u32x4 r8 = *(const u32x4*)(Rr + off), k8 = *(const u32x4*)(K + off), v8 = *(const u32x4*)(V + off), w8 = *(const u32x4*)(W + off), a8 = *(const u32x4*)(A + off); \
        const unsigned rw[4] = {r8.x, r8.y, r8.z, r8.w}, kw[4] = {k8.x, k8.y, k8.z, k8.w}, vw[4] = {v8.x, v8.y, v8.z, v8.w}, ww[4] = {w8.x, w8.y, w8.z, w8.w}, aw[4] = {a8.x, a8.y, a8.z, a8.w}; \
        float rf[8], kf[8], vf[8], wf[8], af[8], kk[8]; float ssq = 0.f; \
        _Pragma("unroll") for (int i = 0; i < 4; ++i) { rf[2 * i] = bflo(rw[i]); rf[2 * i + 1] = bfhi(rw[i]); kf[2 * i] = bflo(kw[i]); kf[2 * i + 1] = bfhi(kw[i]); vf[2 * i] = bflo(vw[i]); vf[2 * i + 1] = bfhi(vw[i]); \
            wf[2 * i] = bflo(ww[i]); wf[2 * i + 1] = bfhi(ww[i]); af[2 * i] = bflo(aw[i]); af[2 * i + 1] = bfhi(aw[i]); } \
        _Pragma("unroll") for (int i = 0; i < 8; ++i) { kk[i] = kf[i] * kkc[i]; ssq += kk[i] * kk[i]; } \
        ssq = red8(ssq); const float inv = 1.f / fmaxf(sqrtf(ssq), 1e-12f); \
        LAS float* tb = ring + (buf) * RW_TILEF + ptt * RW_TOKF; \
        _Pragma("unroll") for (int q = 0; q < 2; ++q) { LAS f32x4* p = (LAS f32x4*)(tb + (2 * dg + q) * 20); \
            f32x4 t0, t1, t2, t3, t4; \
            _Pragma("unroll") for (int e = 0; e < 4; ++e) { const int i = 4 * q + e; const float kn = kk[i] * inv; t0[e] = wf[i]; t1[e] = -kn; t2[e] = kn * af[i]; t3[e] = kf[i] * (1.f + (af[i] - 1.f) * kac[i]); t4[e] = rf[i]; } \
            p[0] = t0; p[1] = t1; p[2] = t2; p[3] = t3; p[4] = t4; } \
        LAS f32x4* pv = (LAS f32x4*)(tb + 320 + 8 * dg); pv[0] = (f32x4){vf[0], vf[1], vf[2], vf[3]}; pv[1] = (f32x4){vf[4], vf[5], vf[6], vf[7]}; } while (0)
#define RW_FLUSH(m, buf) do { const int row = NPAD + 32 * (m) + ptt; if (row < NREAL) { const LAS float* ot = otile + (buf) * 512 + ptt * 16 + 2 * dg; \
        *(float2*)(O32 + (size_t)row * D + h * 64 + 16 * rg + 2 * dg) = make_float2(ot[0], ot[1]); } } while (0)
        if (wid >= 4) RW_PRODUCE(0, 0);
        __syncthreads();
        for (int n = 0; n < RW_NTILE; ++n) {
            if (wid < 4) {
                const LAS float* tb = ring + (n & 1) * RW_TILEF; LAS float* ot = otile + (n & 1) * 512;
#pragma unroll 4
                for (int tt = 0; tt < RW_TT; ++tt) {
                    const LAS float* p = tb + tt * RW_TOKF + cg * 20;
                    const f32x4 w4 = *(const LAS f32x4*)p, nk = *(const LAS f32x4*)(p + 4), ka = *(const LAS f32x4*)(p + 8), kp = *(const LAS f32x4*)(p + 12), r4 = *(const LAS f32x4*)(p + 16);
                    const float v = tb[tt * RW_TOKF + 320 + 16 * rg + irow];
                    float sa = (S0 * nk.x + S1 * nk.y) + (S2 * nk.z + S3 * nk.w);
                    sa = red16(sa);
                    S0 = S0 * w4.x + (sa * ka.x + v * kp.x); S1 = S1 * w4.y + (sa * ka.y + v * kp.y); S2 = S2 * w4.z + (sa * ka.z + v * kp.z); S3 = S3 * w4.w + (sa * ka.w + v * kp.w);
                    float o = (S0 * r4.x + S1 * r4.y) + (S2 * r4.z + S3 * r4.w);
                    o = red16(o);
                    if (cg == 0) ot[tt * 16 + irow] = o;
                }
            } else {
                if (n + 1 < RW_NTILE) RW_PRODUCE(n + 1, (n + 1) & 1);
                if (n > 0) RW_FLUSH(n - 1, (n - 1) & 1);
            }
            __syncthreads();
        }
        if (wid >= 4) RW_FLUSH(RW_NTILE - 1, (RW_NTILE - 1) & 1);
        __syncthreads();
#undef RW_PRODUCE
#undef RW_FLUSH
    }
}

#ifndef RC_SYNC
#define RC_SYNC 0
#endif
constexpr int RC_SLOT = 13312, RC_NSLOT = 8, RC_SCR0 = RC_NSLOT * RC_SLOT, RC_SCR = 5632, RC_FLAGS = RC_SCR0 + 7 * RC_SCR, RC_NCH = 1025;
constexpr int RC_AT = 0, RC_RT = 2176, RC_BTT = 4352, RC_KTT = 6912, RC_TT = 9472, RC_G3F = 9984, RC_VTF = 10496, RC_P1 = 11008, RC_P2 = 12032, RC_WC = 13056;
static_assert(RC_FLAGS + 64 <= 147456 - 256, "rwkv LDS map");
typedef short s16x4v __attribute__((ext_vector_type(4)));
__device__ __forceinline__ void lora2_phase(const Fr& F) {
    const bf16_t* T = (const bf16_t*)(F.ws + WS_T); const bf16_t* W2T = (const bf16_t*)(F.ws + WS_W2P);
    const int c16 = F.lane & 15, g = F.lane >> 4;
    struct BSet { bf16x8 f[2][4]; f32x4 b0, b1; };
#define L2_LOAD(S_, grp_) do { _Pragma("unroll") for (int b = 0; b < 2; ++b) _Pragma("unroll") for (int ks = 0; ks < 4; ++ks) S_.f[b][ks] = *reinterpret_cast<const bf16x8*>(wb + (size_t)((grp_) * 32 + 4 * b) * 128 + ks * 32); \
        S_.b0 = *(const GAS f32x4*)(bias + (grp_) * 32); S_.b1 = *(const GAS f32x4*)(bias + (grp_) * 32 + 4); } while (0)
#define L2_COMP(S_, grp_) do { f32x4 acc[2][4]; \
        _Pragma("unroll") for (int b = 0; b < 2; ++b) _Pragma("unroll") for (int rb = 0; rb < 4; ++rb) acc[b][rb] = (f32x4){0.f, 0.f, 0.f, 0.f}; \
        _Pragma("unroll") for (int ks = 0; ks < 4; ++ks) _Pragma("unroll") for (int b = 0; b < 2; ++b) _Pragma("unroll") for (int rb = 0; rb < 4; ++rb) \
            acc[b][rb] = __builtin_amdgcn_mfma_f32_16x16x32_bf16(S_.f[b][ks], af[rb][ks], acc[b][rb], 0, 0, 0); \
        _Pragma("unroll") for (int rb = 0; rb < 4; ++rb) { f32x4 v0 = acc[0][rb] + S_.b0, v1 = acc[1][rb] + S_.b1; \
            _Pragma("unroll") for (int jj = 0; jj < 4; ++jj) { float s0 = __builtin_amdgcn_rcpf(1.f + __expf(-v0[jj])), s1 = __builtin_amdgcn_rcpf(1.f + __expf(-v1[jj])); \
                if (!sel) { s0 = __expf(-0.606531f * s0); s1 = __expf(-0.606531f * s1); } L2_PROBE_MATH(v0[jj], v1[jj]); v0[jj] = s0; v1[jj] = s1; } \
            st_bf8(dst + (size_t)rb * 16 * D + (grp_) * 32, v0, v1); } } while (0)
#ifdef MK_L2MATH2
#define L2_PROBE_MATH(x0_, x1_) do { float t0_ = (x0_), t1_ = (x1_); asm volatile("" : "+v"(t0_), "+v"(t1_)); t0_ = __builtin_amdgcn_rcpf(1.f + __expf(-t0_)); t1_ = __builtin_amdgcn_rcpf(1.f + __expf(-t1_)); \
        if (!sel) { t0_ = __expf(-0.606531f * t0_); t1_ = __expf(-0.606531f * t1_); } asm volatile("" :: "v"(t0_), "v"(t1_)); } while (0)
#else
#define L2_PROBE_MATH(x0_, x1_) do { } while (0)
#endif
#define L2_WAIT(n_) do { SBAR(); asm volatile("s_waitcnt vmcnt(" #n_ ")" ::: "memory"); SBAR(); } while (0)
#pragma unroll 1
    for (int it = F.bid; it < (R / 64) * 8; it += F.G) {
        const int panel = it >> 3, sel = (it >> 2) & 1, q = it & 3;
        const int row0 = panel * 64, colw = q * 1024 + F.wave * 128;
        const GAS float* bias = (const GAS float*)(sel ? F.in(20) : F.in(17)) + colw + 8 * g;
        bf16_t* dst = slotY(F, sel ? 5 : 4) + (size_t)(row0 + c16) * D + colw + 8 * g;
        const bf16_t* ta = T + (size_t)(row0 + c16) * 256 + sel * 128 + 8 * g;
        const bf16_t* wb = W2T + (size_t)(sel * 4096 + colw + 8 * (c16 >> 2) + (c16 & 3)) * 128 + 8 * g;
        bf16x8 af[4][4]; BSet A, B;
#pragma unroll
        for (int rb = 0; rb < 4; ++rb)
#pragma unroll
            for (int ks = 0; ks < 4; ++ks) af[rb][ks] = *reinterpret_cast<const bf16x8*>(ta + (size_t)rb * 16 * 256 + ks * 32);
        L2_LOAD(A, 0); SBAR();
        L2_LOAD(B, 1); L2_WAIT(10); L2_COMP(A, 0); SBAR();
        L2_LOAD(A, 2); L2_WAIT(14); L2_COMP(B, 1); SBAR();
        L2_LOAD(B, 3); L2_WAIT(14); L2_COMP(A, 2); SBAR();
        L2_WAIT(4); L2_COMP(B, 3); SBAR();
    }
#undef L2_LOAD
#undef L2_COMP
#undef L2_WAIT
}
__device__ __forceinline__ void rwkv_kknorm(const Fr& F) {
    const bf16_t* K = slotY(F, 1); const float* k_k = F.in(23); float* INV = (float*)(F.ws + WS_HE);
    f32x4 c4v[16];
    { ROW_F32(cq, k_k, F.lane);
#pragma unroll
      for (int it = 0; it < 16; ++it) c4v[it] = AT_F32(cq, it); }
    for (int r = F.gw; r < R; r += F.NGW) {
        ROW_BF(kq_, K + (size_t)r * D, F.lane);
        u32x2 kv[16];
#pragma unroll
        for (int it = 0; it < 16; ++it) kv[it] = AT_BF(kq_, it);
#pragma unroll
        for (int it = 0; it < 16; ++it) {
            const u32x2 kk = kv[it]; const f32x4 c4 = c4v[it];
            const float a = bflo(kk.x) * c4.x, b = bfhi(kk.x) * c4.y, c = bflo(kk.y) * c4.z, d = bfhi(kk.y) * c4.w;
            const float ss = red16((a * a + b * b) + (c * c + d * d));
            if ((F.lane & 15) == 0) INV[(size_t)r * 64 + it * 4 + (F.lane >> 4)] = 1.f / fmaxf(sqrtf(ss), 1e-12f);
        }
    }
}
__device__ __forceinline__ unsigned lds_poll(volatile LAS unsigned* p) { return *p; }
__device__ __forceinline__ void rwkv_scan(const Fr& F) {
    const bf16_t* Rr = slotY(F, 0); const bf16_t* K = slotY(F, 1); const bf16_t* V = slotY(F, 2); const bf16_t* W = slotY(F, 4); const bf16_t* A = slotY(F, 5);
    const float* INV = (const float*)(F.ws + WS_HE);
    float* O32 = (float*)slotU(F, 1);
    LAS unsigned char* L = F.lds;
    volatile LAS unsigned* flags = (volatile LAS unsigned*)(L + RC_FLAGS);
    const int lane = F.lane, wid = F.wave, l15 = lane & 15, kg = lane >> 4;
    for (int unit = F.bid; unit < 256; unit += F.G) {
        const int h = unit >> 2, rgw = unit & 3;
        if (F.tid < 16) flags[F.tid] = 0u;
        __syncthreads();
        if (wid == 0) {
            __builtin_amdgcn_s_setprio(3);
            f32x4 S0 = {0.f, 0.f, 0.f, 0.f}, S1 = S0, S2 = S0, S3 = S0;
            struct SlotRegs { u32x2 a0l, a0h, a1l, a1h, r0l, r0h, r1l, r1h; f32x4 P1, P2; s16x4v ttf, g3f, vtf, b0, b1, b2, b3, k0, k1, k2, k3; f32x4 w0, w1, w2, w3; };
#if RC_SYNC
#define CH_WAIT(n_) do { if ((n_) % 7 == 0) { __builtin_amdgcn_s_barrier(); __builtin_amdgcn_s_barrier(); } } while (0)
#else
#define CH_WAIT(n_) do { unsigned sp = 0; while (lds_poll(flags + ((n_) & 7)) != (unsigned)((n_) + 1)) { __builtin_amdgcn_s_sleep(1); if (++sp > (1u << 22)) break; } } while (0)
#endif
#define CH_LOAD(R_, n_) do { CH_WAIT(n_); asm volatile("s_waitcnt lgkmcnt(0)" ::: "memory"); const LAS unsigned char* SL = L + ((n_) & 7) * RC_SLOT; \
                const LAS unsigned char* ap = SL + RC_AT + l15 * 136 + kg * 8; const LAS unsigned char* rp = SL + RC_RT + l15 * 136 + kg * 8; \
                R_.a0l = *(const LAS u32x2*)(ap); R_.a0h = *(const LAS u32x2*)(ap + 32); R_.a1l = *(const LAS u32x2*)(ap + 64); R_.a1h = *(const LAS u32x2*)(ap + 96); \
                R_.r0l = *(const LAS u32x2*)(rp); R_.r0h = *(const LAS u32x2*)(rp + 32); R_.r1l = *(const LAS u32x2*)(rp + 64); R_.r1h = *(const LAS u32x2*)(rp + 96); \
                R_.P1 = *(const LAS f32x4*)(SL + RC_P1 + lane * 16); R_.P2 = *(const LAS f32x4*)(SL + RC_P2 + lane * 16); \
                R_.ttf = *(const LAS s16x4v*)(SL + RC_TT + lane * 8); R_.g3f = *(const LAS s16x4v*)(SL + RC_G3F + lane * 8); R_.vtf = *(const LAS s16x4v*)(SL + RC_VTF + lane * 8); \
                const LAS unsigned char* bp = SL + RC_BTT + l15 * 40 + kg * 8; const LAS unsigned char* kp = SL + RC_KTT + l15 * 40 + kg * 8; \
                R_.b0 = *(const LAS s16x4v*)(bp); R_.b1 = *(const LAS s16x4v*)(bp + 640); R_.b2 = *(const LAS s16x4v*)(bp + 1280); R_.b3 = *(const LAS s16x4v*)(bp + 1920); \
                R_.k0 = *(const LAS s16x4v*)(kp); R_.k1 = *(const LAS s16x4v*)(kp + 640); R_.k2 = *(const LAS s16x4v*)(kp + 1280); R_.k3 = *(const LAS s16x4v*)(kp + 1920); \
                const LAS f32x4* wc = (const LAS f32x4*)(SL + RC_WC + kg * 16); R_.w0 = wc[0]; R_.w1 = wc[4]; R_.w2 = wc[8]; R_.w3 = wc[12]; \
                asm volatile("s_waitcnt lgkmcnt(0)" ::: "memory"); \
                if (lane == 0) flags[8] = (unsigned)((n_) + 1); } while (0)
#define CH_COMPUTE(R_, n_, NEXT_) do { \
                u32x4 sb0, sb1; sb0.x = cvt_pk_bf16(S0.x, S0.y); sb0.y = cvt_pk_bf16(S0.z, S0.w); sb0.z = cvt_pk_bf16(S1.x, S1.y); sb0.w = cvt_pk_bf16(S1.z, S1.w); \
                sb1.x = cvt_pk_bf16(S2.x, S2.y); sb1.y = cvt_pk_bf16(S2.z, S2.w); sb1.z = cvt_pk_bf16(S3.x, S3.y); sb1.w = cvt_pk_bf16(S3.z, S3.w); \
                const bf16x8 Sb0 = *reinterpret_cast<bf16x8*>(&sb0), Sb1 = *reinterpret_cast<bf16x8*>(&sb1); \
                u32x4 t4; \
                t4 = (u32x4){R_.a0l.x, R_.a0l.y, R_.a0h.x, R_.a0h.y}; const bf16x8 Aq0 = *reinterpret_cast<bf16x8*>(&t4); \
                t4 = (u32x4){R_.a1l.x, R_.a1l.y, R_.a1h.x, R_.a1h.y}; const bf16x8 Aq1 = *reinterpret_cast<bf16x8*>(&t4); \
                t4 = (u32x4){R_.r0l.x, R_.r0l.y, R_.r0h.x, R_.r0h.y}; const bf16x8 Rq0 = *reinterpret_cast<bf16x8*>(&t4); \
                t4 = (u32x4){R_.r1l.x, R_.r1l.y, R_.r1h.x, R_.r1h.y}; const bf16x8 Rq1 = *reinterpret_cast<bf16x8*>(&t4); \
                f32x4 X = R_.P1, O = R_.P2; \
                X = __builtin_amdgcn_mfma_f32_16x16x32_bf16(Aq0, Sb0, X, 0, 0, 0); \
                X = __builtin_amdgcn_mfma_f32_16x16x32_bf16(Aq1, Sb1, X, 0, 0, 0);                   \
                O = __builtin_amdgcn_mfma_f32_16x16x32_bf16(Rq0, Sb0, O, 0, 0, 0); \
                O = __builtin_amdgcn_mfma_f32_16x16x32_bf16(Rq1, Sb1, O, 0, 0, 0);                   \
                u32x2 yb; yb.x = cvt_pk_bf16(X.x, X.y); yb.y = cvt_pk_bf16(X.z, X.w); \
                f32x4 U = {0.f, 0.f, 0.f, 0.f}; \
                U = __builtin_amdgcn_mfma_f32_16x16x16bf16_1k(R_.ttf, *reinterpret_cast<s16x4v*>(&yb), U, 0, 0, 0);     \
                u32x2 ub; ub.x = cvt_pk_bf16(U.x, U.y); ub.y = cvt_pk_bf16(U.z, U.w); \
                const s16x4v Ub = *reinterpret_cast<s16x4v*>(&ub); \
                S0 = __builtin_amdgcn_mfma_f32_16x16x16bf16_1k(R_.k0, R_.vtf, S0, 0, 0, 0); S1 = __builtin_amdgcn_mfma_f32_16x16x16bf16_1k(R_.k1, R_.vtf, S1, 0, 0, 0); \
                S2 = __builtin_amdgcn_mfma_f32_16x16x16bf16_1k(R_.k2, R_.vtf, S2, 0, 0, 0); S3 = __builtin_amdgcn_mfma_f32_16x16x16bf16_1k(R_.k3, R_.vtf, S3, 0, 0, 0); \
                S0 = __builtin_amdgcn_mfma_f32_16x16x16bf16_1k(R_.b0, Ub, S0, 0, 0, 0); S1 = __builtin_amdgcn_mfma_f32_16x16x16bf16_1k(R_.b1, Ub, S1, 0, 0, 0); \
                S2 = __builtin_amdgcn_mfma_f32_16x16x16bf16_1k(R_.b2, Ub, S2, 0, 0, 0); S3 = __builtin_amdgcn_mfma_f32_16x16x16bf16_1k(R_.b3, Ub, S3, 0, 0, 0); \
                O = __builtin_amdgcn_mfma_f32_16x16x16bf16_1k(R_.g3f, Ub, O, 0, 0, 0);                   \
                NEXT_; \
                S0 = S0 * R_.w0; S1 = S1 * R_.w1; S2 = S2 * R_.w2; S3 = S3 * R_.w3; \
                float* op = O32 + (size_t)(NPAD + 16 * (n_) + 4 * kg) * D + h * 64 + 16 * rgw + l15;     \
                op[0] = O.x; op[D] = O.y; op[2 * D] = O.z; op[3 * D] = O.w; } while (0)
            SlotRegs RA, RB;
            CH_LOAD(RA, 0);
            for (int n = 0; n + 1 < RC_NCH; n += 2) {
#ifdef MK_RC_CHAIN_SLEEP
                __builtin_amdgcn_s_sleep(MK_RC_CHAIN_SLEEP);
#endif
                CH_COMPUTE(RA, n, CH_LOAD(RB, n + 1));
                if (n + 2 < RC_NCH) { CH_COMPUTE(RB, n + 1, CH_LOAD(RA, n + 2)); } else { CH_COMPUTE(RB, n + 1, (void)0); }
            }
            if (RC_NCH & 1) { CH_COMPUTE(RA, RC_NCH - 1, (void)0); }
            __builtin_amdgcn_s_setprio(0);
#undef CH_WAIT
#undef CH_LOAD
#undef CH_COMPUTE
        } else {
            const int p = wid - 1;
            LAS unsigned char* SC = L + RC_SCR0 + p * RC_SCR;
            const float kkc = F.in(23)[h * 64 + lane], kac = F.in(24)[h * 64 + lane];
            unsigned short cr[16], ck[16], cw[16], ca[16], nvq[4]; float civ[16];
#define RC_LOADS(nn) do { const int r0n = NPAD + 16 * (nn); \
                _Pragma("unroll") for (int e = 0; e < 4; ++e) nvq[e] = V[(size_t)(r0n + 4 * kg + e) * D + h * 64 + 16 * rgw + l15]; \
                _Pragma("unroll") for (int s = 0; s < 16; ++s) { const size_t off = (size_t)(r0n + s) * D + h * 64 + lane; cr[s] = Rr[off]; ck[s] = K[off]; cw[s] = W[off]; ca[s] = A[off]; civ[s] = INV[(size_t)(r0n + s) * 64 + h]; } } while (0)
            RC_LOADS(p);
            for (int n = p; n < RC_NCH; n += 7) {
#ifdef MK_RC_PREP_SLEEP
                __builtin_amdgcn_s_sleep(MK_RC_PREP_SLEEP);
#endif
                const int slot = n & 7; LAS unsigned char* SL = L + slot * RC_SLOT;
                unsigned short vq[4];
#pragma unroll
                for (int e = 0; e < 4; ++e) vq[e] = nvq[e];
#if RC_SYNC
                asm volatile("s_waitcnt lgkmcnt(0)" ::: "memory"); __builtin_amdgcn_s_barrier();
#else
                if (n >= 8) { unsigned sp = 0; while (lds_poll(flags + 8) < (unsigned)(n - 7)) { __builtin_amdgcn_s_sleep(2); if (++sp > (1u << 22)) break; } }
#endif
                asm volatile("" ::: "memory");
                float Wp = 1.f; unsigned btp[8], ktp[8];
#pragma unroll
                for (int hb = 0; hb < 2; ++hb) {
                    unsigned short rq[8], kq[8], wq[8], aq[8]; float iv[8];
#pragma unroll
                    for (int s = 0; s < 8; ++s) { rq[s] = cr[8 * hb + s]; kq[s] = ck[8 * hb + s]; wq[s] = cw[8 * hb + s]; aq[s] = ca[8 * hb + s]; iv[s] = civ[8 * hb + s]; }
                    float btv[8], ktv[8];
#pragma unroll
                    for (int s = 0; s < 8; ++s) {
                        const int t = 8 * hb + s;
                        const float rs = bf2f(rq[s]), ks = bf2f(kq[s]), wsv = bf2f(wq[s]), as = bf2f(aq[s]);
                        const float kk = ks * kkc * iv[s];
                        const float Wprev = Wp; Wp *= wsv; const float iW = __builtin_amdgcn_rcpf(Wp);
                        const float at = -kk * Wprev, rt = rs * Wp, bt = kk * as * iW, kt = ks * (1.f + (as - 1.f) * kac) * iW;
                        *(LAS bf16_t*)(SL + RC_AT + t * 136 + lane * 2) = f2bf(at); *(LAS bf16_t*)(SL + RC_RT + t * 136 + lane * 2) = f2bf(rt);
                        *(LAS bf16_t*)(SC + t * 136 + lane * 2) = f2bf(bt); *(LAS bf16_t*)(SC + 2176 + t * 136 + lane * 2) = f2bf(kt);
                        btv[s] = bt; ktv[s] = kt;
                    }
#pragma unroll
                    for (int s = 0; s < 4; ++s) { btp[4 * hb + s] = cvt_pk_bf16(btv[2 * s], btv[2 * s + 1]); ktp[4 * hb + s] = cvt_pk_bf16(ktv[2 * s], ktv[2 * s + 1]); }
                }
                {
                    LAS u32x2* bq = (LAS u32x2*)(SL + RC_BTT + lane * 40); LAS u32x2* kq2 = (LAS u32x2*)(SL + RC_KTT + lane * 40);
#pragma unroll
                    for (int q = 0; q < 4; ++q) { bq[q] = (u32x2){btp[2 * q], btp[2 * q + 1]}; kq2[q] = (u32x2){ktp[2 * q], ktp[2 * q + 1]}; }
                    *(LAS float*)(SL + RC_WC + lane * 4) = Wp;
                    u32x2 vt; vt.x = (unsigned)vq[0] | ((unsigned)vq[1] << 16); vt.y = (unsigned)vq[2] | ((unsigned)vq[3] << 16);
                    *(LAS u32x2*)(SL + RC_VTF + lane * 8) = vt;
                }
                if (n + 7 < RC_NCH) RC_LOADS(n + 7);
                asm volatile("s_waitcnt lgkmcnt(0)" ::: "memory");
                f32x4 G1 = {0.f, 0.f, 0.f, 0.f}, G2 = G1, G3 = G1, G4 = G1, G1t = G1;
#pragma unroll
                for (int ks = 0; ks < 2; ++ks) {
                    const bf16x8 fb = *(const LAS bf16x8*)(SC + l15 * 136 + (32 * ks + 8 * kg) * 2), fk = *(const LAS bf16x8*)(SC + 2176 + l15 * 136 + (32 * ks + 8 * kg) * 2);
                    const bf16x8 fa = *(const LAS bf16x8*)(SL + RC_AT + l15 * 136 + (32 * ks + 8 * kg) * 2), fr_ = *(const LAS bf16x8*)(SL + RC_RT + l15 * 136 + (32 * ks + 8 * kg) * 2);
                    G1 = __builtin_amdgcn_mfma_f32_16x16x32_bf16(fb, fa, G1, 0, 0, 0); G2 = __builtin_amdgcn_mfma_f32_16x16x32_bf16(fk, fa, G2, 0, 0, 0);
                    G1t = __builtin_amdgcn_mfma_f32_16x16x32_bf16(fa, fb, G1t, 0, 0, 0);
                    G3 = __builtin_amdgcn_mfma_f32_16x16x32_bf16(fb, fr_, G3, 0, 0, 0); G4 = __builtin_amdgcn_mfma_f32_16x16x32_bf16(fk, fr_, G4, 0, 0, 0);
                }
                {
#pragma unroll
                    for (int e = 0; e < 4; ++e) { const int s = 4 * kg + e; const bool lt = s < l15, le = s <= l15;
                        G1[e] = lt ? G1[e] : 0.f; G1t[e] = (l15 < s) ? G1t[e] : 0.f; G2[e] = lt ? G2[e] : 0.f; G3[e] = le ? G3[e] : 0.f; G4[e] = le ? G4[e] : 0.f; }
                    u32x2 g2, g3, g4; g2.x = cvt_pk_bf16(G2.x, G2.y); g2.y = cvt_pk_bf16(G2.z, G2.w); g3.x = cvt_pk_bf16(G3.x, G3.y); g3.y = cvt_pk_bf16(G3.z, G3.w); g4.x = cvt_pk_bf16(G4.x, G4.y); g4.y = cvt_pk_bf16(G4.z, G4.w);
                    *(LAS u32x2*)(SL + RC_G3F + lane * 8) = g3;
                    u32x2 vt; vt.x = (unsigned)vq[0] | ((unsigned)vq[1] << 16); vt.y = (unsigned)vq[2] | ((unsigned)vq[3] << 16);
                    const s16x4v vtf = *reinterpret_cast<s16x4v*>(&vt);
                    f32x4 P1 = {0.f, 0.f, 0.f, 0.f}, P2 = P1;
                    P1 = __builtin_amdgcn_mfma_f32_16x16x16bf16_1k(*reinterpret_cast<s16x4v*>(&g2), vtf, P1, 0, 0, 0);
                    P2 = __builtin_amdgcn_mfma_f32_16x16x16bf16_1k(*reinterpret_cast<s16x4v*>(&g4), vtf, P2, 0, 0, 0);
                    *(LAS f32x4*)(SL + RC_P1 + lane * 16) = P1; *(LAS f32x4*)(SL + RC_P2 + lane * 16) = P2;
#define RC_BF(v) ({ u32x2 t_; t_.x = cvt_pk_bf16((v).x, (v).y); t_.y = cvt_pk_bf16((v).z, (v).w); *reinterpret_cast<s16x4v*>(&t_); })
                    const f32x4 Z4 = {0.f, 0.f, 0.f, 0.f};
                    const s16x4v n1 = RC_BF(G1), n1t = RC_BF(G1t);
                    const f32x4 X2 = __builtin_amdgcn_mfma_f32_16x16x16bf16_1k(n1t, n1, Z4, 0, 0, 0), X2t = __builtin_amdgcn_mfma_f32_16x16x16bf16_1k(n1, n1t, Z4, 0, 0, 0);
                    const s16x4v n2 = RC_BF(X2), n2t = RC_BF(X2t);
                    const f32x4 X4 = __builtin_amdgcn_mfma_f32_16x16x16bf16_1k(n2t, n2, Z4, 0, 0, 0), X4t = __builtin_amdgcn_mfma_f32_16x16x16bf16_1k(n2, n2t, Z4, 0, 0, 0);
                    const s16x4v n4 = RC_BF(X4), n4t = RC_BF(X4t);
                    f32x4 Tm = __builtin_amdgcn_mfma_f32_16x16x16bf16_1k(n4t, n4, Z4, 0, 0, 0);
#pragma unroll
                    for (int e = 0; e < 4; ++e) Tm[e] += (4 * kg + e == l15) ? 1.f : 0.f;
                    Tm = __builtin_amdgcn_mfma_f32_16x16x16bf16_1k(n4t, RC_BF(Tm), Tm, 0, 0, 0);
                    Tm = __builtin_amdgcn_mfma_f32_16x16x16bf16_1k(n2t, RC_BF(Tm), Tm, 0, 0, 0);
                    Tm = __builtin_amdgcn_mfma_f32_16x16x16bf16_1k(n1t, RC_BF(Tm), Tm, 0, 0, 0);
                    { u32x2 tt; tt.x = cvt_pk_bf16(Tm.x, Tm.y); tt.y = cvt_pk_bf16(Tm.z, Tm.w); *(LAS u32x2*)(SL + RC_TT + lane * 8) = tt; }
#undef RC_BF
                }
                asm volatile("s_waitcnt lgkmcnt(0)" ::: "memory");
#if RC_SYNC
                __builtin_amdgcn_s_barrier();
#else
                if (lane == 0) flags[slot] = (unsigned)(n + 1);
#endif
            }
#if RC_SYNC
            if (p >= RC_NCH % 7) { __builtin_amdgcn_s_barrier(); __builtin_amdgcn_s_barrier(); }
#endif
        }
#undef RC_LOADS
        __syncthreads();
    }
}
__device__ __forceinline__ void rwkv_post(const Fr& F) {
    const bf16_t* Rr = slotY(F, 0); const bf16_t* K = slotY(F, 1); const bf16_t* V = slotY(F, 2); const bf16_t* GT = slotY(F, 3); const bf16_t* A = slotY(F, 5);
    const float* O32 = (const float*)slotU(F, 1); bf16_t* Z = slotU(F, 0);
    const float* k_a = F.in(24); const float* r_k = F.in(25); const float* lw = F.in(26); const float* lb = F.in(27);
    for (int r = F.gw; r < R; r += F.NGW) {
        const bool real = (r >= NPAD && r < NREAL);
        u32x2* zr = (u32x2*)(Z + (size_t)r * D) + F.lane;
        if (!real) { const u32x2 z = {0u, 0u};
#pragma unroll
            for (int it = 0; it < 16; ++it) zr[64 * it] = z;
            continue; }
        ROW_F32(oq, O32 + (size_t)r * D, F.lane); ROW_BF(rq_, Rr + (size_t)r * D, F.lane); ROW_BF(kq_, K + (size_t)r * D, F.lane); ROW_BF(vq_, V + (size_t)r * D, F.lane);
        ROW_BF(gq_, GT + (size_t)r * D, F.lane); ROW_BF(aq_, A + (size_t)r * D, F.lane); ROW_BF(zq_, Z + (size_t)r * D, F.lane);
        ROW_F32(kap, k_a, F.lane); ROW_F32(rkp, r_k, F.lane); ROW_F32(lwp, lw, F.lane); ROW_F32(lbp, lb, F.lane);
#pragma unroll
        for (int hh = 0; hh < 2; ++hh) {
            f32x4 o4v[8]; u32x2 rrv[8], kkv[8], vvv[8], ggv[8], aav[8];
#pragma unroll
            for (int i8 = 0; i8 < 8; ++i8) { const int it = 8 * hh + i8; o4v[i8] = AT_F32(oq, it); rrv[i8] = AT_BF(rq_, it); kkv[i8] = AT_BF(kq_, it); vvv[i8] = AT_BF(vq_, it); ggv[i8] = AT_BF(gq_, it); aav[i8] = AT_BF(aq_, it); }
#pragma unroll
            for (int i8 = 0; i8 < 8; ++i8) { const int it = 8 * hh + i8;
                const f32x4 o4 = o4v[i8]; const u32x2 rr = rrv[i8], kk = kkv[i8], vv = vvv[i8], gg = ggv[i8], aa = aav[i8];
                const f32x4 ka4 = AT_F32(kap, it), rk4 = AT_F32(rkp, it), lw4 = AT_F32(lwp, it), lb4 = AT_F32(lbp, it);
                const float mean = red16((o4.x + o4.y) + (o4.z + o4.w)) * (1.f / 64.f);
                const float d0 = o4.x - mean, d1 = o4.y - mean, d2 = o4.z - mean, d3 = o4.w - mean;
                const float var = red16((d0 * d0 + d1 * d1) + (d2 * d2 + d3 * d3)) * (1.f / 64.f);
                const float rs = __builtin_amdgcn_rsqf(var + 64e-5f);
                const float r0 = bflo(rr.x), r1 = bfhi(rr.x), r2 = bflo(rr.y), r3 = bfhi(rr.y);
                const float kp0 = bflo(kk.x) * (1.f + (bflo(aa.x) - 1.f) * ka4.x), kp1 = bfhi(kk.x) * (1.f + (bfhi(aa.x) - 1.f) * ka4.y), kp2 = bflo(kk.y) * (1.f + (bflo(aa.y) - 1.f) * ka4.z), kp3 = bfhi(kk.y) * (1.f + (bfhi(aa.y) - 1.f) * ka4.w);
                const float bs = red16((r0 * kp0 * rk4.x + r1 * kp1 * rk4.y) + (r2 * kp2 * rk4.z + r3 * kp3 * rk4.w));
                const float y0 = d0 * rs * lw4.x + lb4.x + bs * bflo(vv.x), y1 = d1 * rs * lw4.y + lb4.y + bs * bfhi(vv.x), y2 = d2 * rs * lw4.z + lb4.z + bs * bflo(vv.y), y3 = d3 * rs * lw4.w + lb4.w + bs * bfhi(vv.y);
                u32x2 w; w.x = cvt_pk_bf16(y0 * silu_f(bflo(gg.x)), y1 * silu_f(bfhi(gg.x))); w.y = cvt_pk_bf16(y2 * silu_f(bflo(gg.y)), y3 * silu_f(bfhi(gg.y)));
                AT_BF(zq_, it) = w;
            }
        }
    }
}
}
namespace mk {
constexpr int LDS_BYTES = 163840;
constexpr int LDS_MISC = LDS_BYTES - 128;
struct Args { const float* in[29]; float* out; unsigned char* ws; };

#define MK_GEMM(EPI, e, Aptr, aps_, Bptr, M_, N_, K_) do { int kk_ = (K_); asm volatile("" : "+s"(kk_));     \
    pg8::Gemm g_{(const bf16_t*)(Aptr), (const bf16_t*)(Bptr), (M_), (N_), kk_, (size_t)(aps_)}; pg8::StaticOrder S_; S_.init((M_), (N_), F.G, F.bid); \
    pg8::gemm_phase<EPI, pg8::StaticOrder, false>(F.lds, g_, S_, e, nullptr); } while (0)

struct TailOrder { int pn;
    __device__ bool next(int i, pg8::Unit& u) const { if (i > 0 || pn < 0) return false; u.pm = 64; u.pn = pn; return true; }
    __device__ __forceinline__ void a_ready(const pg8::Unit&) const {}
    __device__ __forceinline__ void done(const pg8::Unit&) const {}
};
struct RwTail { int pm, pn;
    __device__ bool next(int i, pg8::Unit& u) const { if (i > 0) return false; u.pm = pm; u.pn = pn; return true; }
    __device__ __forceinline__ void a_ready(const pg8::Unit&) const {}
    __device__ __forceinline__ void done(const pg8::Unit&) const {}
};
#define MK_GEMM1(EPI, e, aps_, NTOT_, L_) do { MK_GEMM(EPI, e, slotU(F, 0), aps_, wtin_of(F, L_), 16384, NTOT_, D); \
    if (F.bid < (NTOT_) / 256) { int kk_ = D; asm volatile("" : "+s"(kk_)); pg8::Gemm g_{(const bf16_t*)slotU(F, 0), (const bf16_t*)wtin_of(F, L_), R, (NTOT_), kk_, (size_t)(aps_)}; TailOrder St_{F.bid}; \
        pg8::gemm_phase<EPI, TailOrder, false, true>(F.lds, g_, St_, e, nullptr); } } while (0)
#define MK_GEMM2_NORM(prev, next, udst) do { \
    MK_GEMM(EpiY, ey, slotU(F, 0), 0, wtout, 16384, D, D); \
    GRID_BAR(); \
    if (F.bid < 16) { int kk_ = D; asm volatile("" : "+s"(kk_)); pg8::Gemm g_{(const bf16_t*)slotU(F, 0), (const bf16_t*)wtout, R, D, kk_, (size_t)0}; TailOrder St_{F.bid}; \
        pg8::gemm_phase<EpiY, TailOrder, false, true>(F.lds, g_, St_, ey, nullptr); } \
    else { const Fr P = F.fresh(); norm_phase(P, prev, next, slotY(P, 0), udst, 0, 16384, 16); } \
    GRID_BAR(); \
    { const Fr P = F.fresh(); norm_phase(P, prev, next, slotY(P, 0), udst, 16384, R, 0); if ((next) >= 0) convert_layer(P, next, (next) == 3); } \
    GRID_BAR(); } while (0)

__global__ void __launch_bounds__(512, 2) fwd(Args a) {
    extern __shared__ __attribute__((aligned(16))) unsigned char lds_raw[];
    Fr F;
    F.lds = (LAS unsigned char*)lds_raw; F.ldsg = lds_raw;
    F.tid = threadIdx.x; F.lane = F.tid & 63; F.wave = __builtin_amdgcn_readfirstlane(F.tid >> 6);
    F.G = gridDim.x; F.bid = blockIdx.x; F.gw = F.bid * 8 + F.wave; F.NGW = F.G * 8;
    F.out = a.out; F.ws = a.ws;
    volatile LAS unsigned* misc = (volatile LAS unsigned*)(F.lds + LDS_MISC);
    if (F.tid < 16) misc[F.tid] = 0u;
    __syncthreads();
    XcdBarrier bar = xcd_barrier_post((unsigned*)(F.ws + WS_CTL) + 4096, misc + 8);
#ifdef MK_BAR2
#define GRID_BAR() do { xcd_barrier(bar); xcd_barrier(bar); } while (0)
#else
#define GRID_BAR() xcd_barrier(bar)
#endif
#ifndef MK_DUP
#define MK_DUP 0
#endif
#ifndef MK_CLK
#define MK_CLK 0
#endif
#define CLK_SPIN() do { const unsigned long long dc_ = clock64() - clk_c0, dr_ = wall_clock64() - clk_r0; const long mhz_ = (long)(dc_ * 100ull / (dr_ ? dr_ : 1ull)); \
        const long ticks_ = (2400 - mhz_) * 200; const unsigned long long r1_ = wall_clock64(); while ((long)(wall_clock64() - r1_) < ticks_) __builtin_amdgcn_s_sleep(8); } while (0)
#ifndef MK_PH
#define MK_PH 0
#endif
    unsigned long long ph_r0_ = 0ull;
#define PH_BEGIN(id) do { if ((MK_PH >> (id)) & 1) ph_r0_ = wall_clock64(); } while (0)
#define PH_END(id) do { if ((MK_PH >> (id)) & 1) { const unsigned long long dr_ = wall_clock64() - ph_r0_, r1_ = wall_clock64(); while ((unsigned long long)(wall_clock64() - r1_) < dr_) __builtin_amdgcn_s_sleep(8); } } while (0)
#define DUPN(k, ...) do { __VA_ARGS__; if ((MK_DUP >> (k)) & 1) { GRID_BAR(); __VA_ARGS__; } } while (0)
    bf16_t* wtout = (bf16_t*)(F.ws + WS_WTOUT);
    const EpiY ey{slotY(F, 0)};

    PH_BEGIN(1);
    DUPN(11, { const Fr P = F.fresh(); convert_layer(P, 0, true); rope_table(P); norm_phase(P, -1, 0, nullptr, slotU(P, 0)); });
    PH_END(1);
    GRID_BAR();
#if MK_CLK == 1 || MK_CLK == 11
    const unsigned long long clk_c0 = clock64(), clk_r0 = wall_clock64();
#endif
    PH_BEGIN(15);
    { const EpiH1 e{slotY(F, 0), F.in(5), 0}; MK_GEMM1(EpiH1, e, 0, 4 * D, 0); }
#if MK_CLK == 1
    CLK_SPIN();
#endif
#if MK_CLK == 11
    { const unsigned long long dr_ = wall_clock64() - clk_r0, r1_ = wall_clock64(); while ((unsigned long long)(wall_clock64() - r1_) < dr_) __builtin_amdgcn_s_sleep(8); }
#endif
#if defined(MK_KPROBE) && !defined(MK_KPROBE_L1)
    { __syncthreads(); const unsigned kc_ = misc[20]; const unsigned long long r1_ = wall_clock64(); while ((unsigned long long)(wall_clock64() - r1_) < (unsigned long long)kc_) __builtin_amdgcn_s_sleep(8); }
#endif
    if (F.bid >= 64) { const Fr P = F.fresh(); convert_win(P, 1, 64); }
    PH_END(15);
    GRID_BAR();
    PH_BEGIN(13);
    DUPN(1, { const Fr P = F.fresh(); hgrn_phase<false>(P, 0); });
    PH_END(13);
    GRID_BAR();
    PH_BEGIN(14);
    DUPN(2, { const Fr P = F.fresh(); hgrn_phase<true>(P, 0); });
    PH_END(14);
    GRID_BAR();
    PH_BEGIN(2);
    MK_GEMM2_NORM(0, 1, slotU(F, 0));
    PH_END(2);
    PH_BEGIN(16);
    { const EpiB1 e{slotY(F, 0), (const float*)(F.ws + WS_ROPE), (const float*)(F.ws + WS_ROPE) + (size_t)R * 16}; PH_BEGIN(20); MK_GEMM1(EpiB1, e, 0, 4 * D, 1); PH_END(20); }
    PH_BEGIN(21);
#ifdef MK_KPROBE_L1
    { __syncthreads(); const unsigned kc_ = misc[20]; const unsigned long long r1_ = wall_clock64(); while ((unsigned long long)(wall_clock64() - r1_) < (unsigned long long)kc_) __builtin_amdgcn_s_sleep(8); }
#endif
    if (F.bid >= 64) { const Fr P = F.fresh(); convert_win(P, 2, 64); }
    PH_END(21);
    PH_END(16);
    GRID_BAR();
#if MK_CLK == 3
    const unsigned long long clk_c0 = clock64(), clk_r0 = wall_clock64();
#endif
    PH_BEGIN(6);
    DUPN(3, { const Fr P = F.fresh(); attn_phase(P); });
    PH_END(6);
#if MK_CLK == 3
    CLK_SPIN();
#endif
    GRID_BAR();
    PH_BEGIN(7);
    DUPN(4, { const Fr P = F.fresh(); attn_post(P); });
    PH_END(7);
    GRID_BAR();
    PH_BEGIN(3);
    MK_GEMM2_NORM(1, 2, slotY(F, 1));
    PH_END(3);
    PH_BEGIN(8);
    DUPN(7, { const Fr P = F.fresh(); mix_phase(P, slotY(P, 1)); convert_layer2_b(P); });
    PH_END(8);
    GRID_BAR();
    PH_BEGIN(9);
    { const EpiC1 e{slotY(F, 0), (bf16_t*)(F.ws + WS_T)}; MK_GEMM(EpiC1, e, slotU(F, 0), (size_t)R * D, wtin_of(F, 2), 16384, 4 * D, D);
      if (F.bid < 194) { int kk_ = D; asm volatile("" : "+s"(kk_)); pg8::Gemm g_{(const bf16_t*)slotU(F, 0), (const bf16_t*)wtin_of(F, 2), R, 4 * D + 512, kk_, (size_t)R * D};
          if (F.bid < 64) { RwTail St_{64, F.bid}; pg8::gemm_phase<EpiC1, RwTail, false, true, false>(F.lds, g_, St_, e, nullptr); }
          else if (F.bid < 192) { RwTail St_{(F.bid - 64) >> 1, 64 + ((F.bid - 64) & 1)}; pg8::gemm_phase<EpiC1, RwTail, false, false, true>(F.lds, g_, St_, e, nullptr); }
          else { RwTail St_{64, 64 + (F.bid - 192)}; pg8::gemm_phase<EpiC1, RwTail, false, true, true>(F.lds, g_, St_, e, nullptr); } } }
    PH_END(9);
    GRID_BAR();
    PH_BEGIN(10);
    DUPN(9, { const Fr P = F.fresh(); lora2_phase(P); });
    { const Fr P = F.fresh(); rwkv_kknorm(P); }
    PH_END(10);
    GRID_BAR();
    PH_BEGIN(11);
    DUPN(5, { const Fr P = F.fresh(); rwkv_scan(P); });
    PH_END(11);
    GRID_BAR();
    PH_BEGIN(12);
    DUPN(6, { const Fr P = F.fresh(); rwkv_post(P); });
    PH_END(12);
    GRID_BAR();
    PH_BEGIN(4);
    MK_GEMM2_NORM(2, 3, slotU(F, 0));
    PH_END(4);
    PH_BEGIN(17);
    { const EpiH1 e{slotY(F, 0), F.in(5), 1}; MK_GEMM1(EpiH1, e, 0, 4 * D, 3); }
    if (F.bid >= 64) { const Fr P = F.fresh(); convert_wout3(P, 64); }
    PH_END(17);
    GRID_BAR();
    PH_BEGIN(18);
    { const Fr P = F.fresh(); hgrn_phase<false>(P, 1); }
    PH_END(18);
    GRID_BAR();
    PH_BEGIN(19);
    { const Fr P = F.fresh(); hgrn_phase<true>(P, 1); }
    PH_END(19);
    GRID_BAR();
    PH_BEGIN(5);
    MK_GEMM2_NORM(3, -1, (bf16_t*)nullptr);
    PH_END(5);
}
}

extern "C" void kernel_launch(void* const* d_in, const int* in_sizes, int n_in, void* d_out, int out_size, void* d_ws, size_t ws_size, hipStream_t stream) {
    static int grid = 0;
    if (grid == 0) {
        if (n_in != 29 || out_size != 16384 * 4096 || ws_size < mk::WS_END) { fprintf(stderr, "kernel_launch: unexpected shapes (n_in %d out %d ws %zu need %zu)\n", n_in, out_size, ws_size, (size_t)mk::WS_END); grid = -1; return; }
        int dev = 0, cus = 0, per_cu = 0;
        if (hipGetDevice(&dev) != hipSuccess || hipDeviceGetAttribute(&cus, hipDeviceAttributeMultiprocessorCount, dev) != hipSuccess) { grid = -1; return; }
        if (hipFuncSetAttribute((const void*)mk::fwd, hipFuncAttributeMaxDynamicSharedMemorySize, mk::LDS_BYTES) != hipSuccess) { fprintf(stderr, "kernel_launch: hipFuncSetAttribute failed\n"); grid = -1; return; }
        if (hipOccupancyMaxActiveBlocksPerMultiprocessor(&per_cu, (const void*)mk::fwd, 512, mk::LDS_BYTES) != hipSuccess || per_cu < 1) { fprintf(stderr, "kernel_launch: occupancy query says %d\n", per_cu); }
        (void)hipGetLastError();
        grid = cus;
    }
    if (grid < 0) return;
    if (hipMemsetAsync((char*)d_ws + mk::WS_CTL, 0, mk::CTL_BYTES, stream) != hipSuccess) return;
    mk::Args a{};
    for (int i = 0; i < 29; ++i) a.in[i] = (const float*)d_in[i];
    a.out = (float*)d_out; a.ws = (unsigned char*)d_ws;
    hipLaunchKernelGGL(mk::fwd, dim3(grid), dim3(512), mk::LDS_BYTES, stream, a);
}
```

```cpp
#include <hip/hip_runtime.h>
#include <cstdio>
#include <cstdint>

#define LAS __attribute__((address_space(3)))
#define GAS __attribute__((address_space(1)))
typedef unsigned short bf16_t;
typedef short bf16x8 __attribute__((ext_vector_type(8)));
typedef short s16x4 __attribute__((ext_vector_type(4)));
typedef float f32x4 __attribute__((ext_vector_type(4)));
typedef float f32x16 __attribute__((ext_vector_type(16)));
typedef unsigned u32x4 __attribute__((ext_vector_type(4)));
typedef unsigned u32x2 __attribute__((ext_vector_type(2)));

namespace mk {
constexpr int D = 4096, NPAD = 48, NREAL = 16448, R = 16640, NCH = 257;
constexpr size_t MiB = 1u << 20;
constexpr size_t SLOT = (size_t)R * D * 2;
constexpr size_t WS_CTL = 0, CTL_BYTES = 1 * MiB;
constexpr size_t WS_WTIN = 2 * MiB;
constexpr size_t WS_WTOUT = 134 * MiB;
constexpr size_t WS_W2P = 166 * MiB;
constexpr size_t WS_ROPE = 170 * MiB;
constexpr size_t WS_HMETA = 174 * MiB;
constexpr size_t WS_HE = 175 * MiB;
constexpr size_t WS_HLOGD = 191 * MiB;
constexpr size_t WS_U = 192 * MiB;
constexpr size_t WS_Y = WS_U + 6 * SLOT;
constexpr size_t WS_T = WS_Y + 6 * SLOT;
constexpr size_t WS_WTINB = WS_U + 4 * SLOT;
constexpr size_t WS_HB = (WS_T + (size_t)R * 256 * 2 + MiB - 1) / MiB * MiB;
constexpr size_t WS_END = WS_HB + SLOT;
static_assert(WS_END <= 2040 * MiB, "d_ws map");

typedef __bf16 bf16x2n_t __attribute__((ext_vector_type(2)));
typedef float f32x2n_t __attribute__((ext_vector_type(2)));
__device__ __forceinline__ unsigned cvt_pk_bf16(float lo, float hi) { const f32x2n_t v = {lo, hi}; const bf16x2n_t r = __builtin_convertvector(v, bf16x2n_t); return __builtin_bit_cast(unsigned, r); }
__device__ __forceinline__ float bflo(unsigned w) { return __uint_as_float(w << 16); }
__device__ __forceinline__ float bfhi(unsigned w) { return __uint_as_float(w & 0xffff0000u); }
__device__ __forceinline__ float bf2f(bf16_t b) { return __uint_as_float(((unsigned)b) << 16); }
__device__ __forceinline__ bf16_t f2bf(float f) { return (bf16_t)(cvt_pk_bf16(f, f) & 0xffffu); }
__device__ __forceinline__ float sigmoid_f(float x) { return __builtin_amdgcn_rcpf(1.f + __expf(-x)); }
__device__ __forceinline__ float silu_f(float x) { return x * __builtin_amdgcn_rcpf(1.f + __expf(-x)); }

template <int CTRL> __device__ __forceinline__ float dppf(float v) { return __int_as_float(__builtin_amdgcn_update_dpp(0, __float_as_int(v), CTRL, 0xf, 0xf, true)); }
__device__ __forceinline__ float red4(float v) { v += dppf<0xB1>(v); v += dppf<0x4E>(v); return v; }
__device__ __forceinline__ float red8(float v) { v = red4(v); v += dppf<0x141>(v); return v; }
__device__ __forceinline__ float red16(float v) { v = red8(v); v += dppf<0x140>(v); return v; }
__device__ __forceinline__ float wave_sum(float v) {
    v = red16(v);
    { const auto rr = __builtin_amdgcn_permlane16_swap(__float_as_uint(v), __float_as_uint(v), false, false); v = __uint_as_float(rr[0]) + __uint_as_float(rr[1]); }
    { const auto rr = __builtin_amdgcn_permlane32_swap(__float_as_uint(v), __float_as_uint(v), false, false); v = __uint_as_float(rr[0]) + __uint_as_float(rr[1]); }
    return v;
}
#define LDS_WAIT() asm volatile("s_waitcnt lgkmcnt(0)" ::: "memory")
}
#define XB_TMO      128
#define XB_XCNT(j)  (256  + 64 * (j))
#define XB_XSUB(j)  (1280 + 64 * (j))
#define XB_XGEN(j)  (2304 + 64 * (j))
#define XB_TOP      3328
#define XB_TOPGEN   3392
#define XCD_BAR_WORDS 3456
#define XB_SPIN_CAP (1u << 18)
#define LAS __attribute__((address_space(3)))

__device__ __forceinline__ unsigned xb_ld(unsigned* p)              { return __hip_atomic_load(p, __ATOMIC_RELAXED, __HIP_MEMORY_SCOPE_AGENT); }
__device__ __forceinline__ unsigned xb_add(unsigned* p, unsigned v) { return __hip_atomic_fetch_add(p, v, __ATOMIC_RELAXED, __HIP_MEMORY_SCOPE_AGENT); }
__device__ __forceinline__ unsigned xb_xcc_id() { return (unsigned)__builtin_amdgcn_s_getreg((3 << 11) | 20) & 0xFu; }
#define XB_SPIN(cond, bar) do { unsigned _sp = 0; while (cond) { __builtin_amdgcn_s_sleep(1); \
    if ((++_sp & 255u) == 0u) { if (xb_ld(&(bar)[XB_TMO])) break; if (_sp > XB_SPIN_CAP) { atomicAdd(&(bar)[XB_TMO], 1u); break; } } } } while (0)

struct XcdBarrier {
    unsigned* bar; unsigned x;
    volatile LAS unsigned* st;
};

__device__ __forceinline__ XcdBarrier xcd_barrier_post(unsigned* bar, volatile LAS unsigned* st) {
    XcdBarrier b; b.bar = bar; b.x = xb_xcc_id(); b.st = st;
    if (threadIdx.x == 0) (void)xb_add(&bar[XB_XCNT(b.x)], 1u);
    return b;
}
__device__ __forceinline__ void xcd_barrier_complete(unsigned* bar, unsigned x, unsigned& nloc, unsigned& nx) {
    const unsigned G = gridDim.x * gridDim.y * gridDim.z;
    unsigned sum, cnt, mine, sp = 0u;
    for (;;) {
        sum = 0u; cnt = 0u; mine = 0u;
#pragma unroll
        for (unsigned j = 0; j < 16; ++j) { const unsigned c = xb_ld(&bar[XB_XCNT(j)]); sum += c; cnt += (c > 0u) ? 1u : 0u; mine = (j == x) ? c : mine; }
        if (sum == G) break;
        __builtin_amdgcn_s_sleep(1);
        if ((++sp & 255u) == 0u) { if (xb_ld(&bar[XB_TMO])) break; if (sp > XB_SPIN_CAP) { atomicAdd(&bar[XB_TMO], 1u); break; } }
    }
    nloc = mine > 0u ? mine : 1u; nx = cnt > 0u ? cnt : 1u;
}

__device__ __forceinline__ void xcd_barrier(const XcdBarrier& b) {
    asm volatile("s_waitcnt vmcnt(0)" ::: "memory");
    __syncthreads();
    if (threadIdx.x == 0) {
        unsigned* bar = b.bar;
        __builtin_amdgcn_s_waitcnt(0);
        unsigned nloc = b.st[0], nx = b.st[1];
        if (nloc == 0u) { xcd_barrier_complete(bar, b.x, nloc, nx); b.st[0] = nloc; b.st[1] = nx; }
        const unsigned old = xb_add(&bar[XB_XSUB(b.x)], 1u);
        const unsigned gen = old / nloc;
        if (old + 1u == (gen + 1u) * nloc) {
            __builtin_amdgcn_fence(__ATOMIC_RELEASE, "agent");
            asm volatile("s_waitcnt vmcnt(0)" ::: "memory");
            const unsigned og = xb_add(&bar[XB_TOP], 1u);
            const unsigned tg = og / nx;
            if (og + 1u == (tg + 1u) * nx) xb_add(&bar[XB_TOPGEN], 1u);
            else XB_SPIN(xb_ld(&bar[XB_TOPGEN]) == tg, bar);
            __builtin_amdgcn_fence(__ATOMIC_ACQUIRE, "agent");
            xb_add(&bar[XB_XGEN(b.x)], 1u);
            asm volatile("s_waitcnt vmcnt(0)" ::: "memory");
        } else {
            XB_SPIN(xb_ld(&bar[XB_XGEN(b.x)]) == gen, bar);
            __builtin_amdgcn_fence(__ATOMIC_ACQUIRE, "agent");
            asm volatile("s_waitcnt vmcnt(0)" ::: "memory");
        }
    }
    __syncthreads();
}
#ifndef MK_WGM
#define MK_WGM 8
#endif
namespace pg8 {
#define PG8_LAS __attribute__((address_space(3)))
typedef unsigned short bf16_t;
typedef short bf16x8 __attribute__((ext_vector_type(8)));
typedef float f32x4 __attribute__((ext_vector_type(4)));
typedef unsigned u32x4 __attribute__((ext_vector_type(4)));
constexpr int BM = 256, BK = 64, HALF = 128, HTB = HALF * BK * 2  , STAGE_BYTES = 8 * HTB, NXCD = 8, WGM = 8;

__host__ __device__ __forceinline__ int lds_byte(int r, int c) { const int st = (r >> 4) * 2 + (c >> 5), rr = r & 15, cc = c & 31, ob = rr * 64 + cc * 2; return st * 1024 + (ob ^ (((ob >> 9) & 1) << 5)); }
__host__ __device__ __forceinline__ void stage_rc(int b, int& R, int& C) { const int st = b / 1024, sb = b % 1024, swz = sb ^ (((sb >> 9) & 1) << 5); R = (st >> 1) * 16 + swz / 64; C = (st & 1) * 32 + (swz % 64) / 2; }
__host__ __device__ __forceinline__ int perm32(int rho) { const int n = rho >> 4, i = rho & 15; return 8 * (i >> 2) + 4 * n + (i & 3); }

struct Unit { int pm, pn; };
struct Gemm { const bf16_t* A; const bf16_t* Bt; int M, N, K; size_t aps; };
__device__ __forceinline__ size_t a_part_bytes(const Gemm& g, int pn) { return g.aps ? (size_t)(pn < 64 ? (pn >> 4) : (pn - 60)) * g.aps * 2 : (size_t)0; }

struct StaticOrder {
    int nM, nN, nwg, G, c;
    __host__ __device__ void init(int M, int N, int G_, int c_) { nM = M / BM; nN = N / BM; nwg = nM * nN; G = G_; c = c_; }
    __host__ __device__ bool next(int i, Unit& u) const {
        const long L = (long)i * G + c; if (L >= nwg) return false;
        int wgid = (int)L; { const int q = nwg / NXCD, r = nwg % NXCD, xcd = wgid % NXCD, off = wgid / NXCD; wgid = (xcd < r ? xcd * (q + 1) : r * (q + 1) + (xcd - r) * q) + off; }
        const int nig = WGM * nN, gid = wgid / nig, fm = gid * WGM, gsz = (nM - fm) < WGM ? (nM - fm) : WGM;
        u.pm = fm + ((wgid % nig) % gsz); u.pn = (wgid % nig) / gsz; return true;
    }
    __device__ __forceinline__ void a_ready(const Unit&) const {}
    __device__ __forceinline__ void done(const Unit&) const {}
};
struct CountedOrder : StaticOrder {
    const unsigned* ready; unsigned need; unsigned* tmo;
    __device__ __forceinline__ void a_ready(const Unit& u) const {
        if (threadIdx.x < 64) {
            const unsigned long long t0 = __builtin_amdgcn_s_memrealtime(); unsigned polls = 0;
            while ((unsigned)__builtin_amdgcn_readfirstlane(__hip_atomic_load(ready + 64 * u.pm, __ATOMIC_RELAXED, __HIP_MEMORY_SCOPE_AGENT)) < need) {
                if ((++polls & 255u) == 0u && __builtin_amdgcn_readfirstlane(__hip_atomic_load(tmo, __ATOMIC_RELAXED, __HIP_MEMORY_SCOPE_AGENT)) != 0u) break;
                if (__builtin_amdgcn_s_memrealtime() - t0 > 2000000ull) {
                    if (threadIdx.x == 0) { unsigned expect = 0u; __hip_atomic_compare_exchange_strong(tmo + 1, &expect, 0x600u | (unsigned)(u.pm & 0xff), __ATOMIC_RELAXED, __ATOMIC_RELAXED, __HIP_MEMORY_SCOPE_AGENT); __hip_atomic_store(tmo, 1u, __ATOMIC_RELAXED, __HIP_MEMORY_SCOPE_AGENT); }
                    break; }
                __builtin_amdgcn_s_sleep(2); }
            __builtin_amdgcn_fence(__ATOMIC_ACQUIRE, "agent");
            asm volatile("s_waitcnt vmcnt(0)" ::: "memory");
        }
#if !defined(BROKEN_HOOK_NO_BARRIER)
        asm volatile("" ::: "memory"); __builtin_amdgcn_s_barrier(); asm volatile("" ::: "memory");
#endif
    }
};
template <class Epi, class Sched, bool STAMP = false, bool TOPHALF = false, bool LEFTHALF = false>
__device__ __forceinline__ void gemm_phase(PG8_LAS unsigned char* lds, const Gemm g, const Sched& S, const Epi& E, unsigned long long* stamps) {
    int tid_ = threadIdx.x; asm volatile("" : "+v"(tid_));
    const int tid = tid_, wid = __builtin_amdgcn_readfirstlane(tid >> 6), lane = tid & 63, wr = wid >> 2, wc = wid & 3, fr = lane & 15, fq = lane >> 4;
    const int K = g.K, nt = K / BK;
    int ts_lo = 0, ts_hi = 0, nts = 0; const unsigned long long rt_entry = STAMP ? (unsigned long long)wall_clock64() : 0ull;
#define PG8_STAMP() do { if (STAMP && wid == 0 && nts < 64) { const unsigned long long _c = (unsigned long long)clock64(); \
        ts_lo = (lane == nts) ? (int)(unsigned)_c : ts_lo; ts_hi = (lane == nts) ? (int)(unsigned)(_c >> 32) : ts_hi; ++nts; } } while (0)
    PG8_STAMP();
    unsigned voffA[2], voffB[2];
#pragma unroll
    for (int i = 0; i < 2; ++i) { int R, C; stage_rc(tid * 16 + i * 8192, R, C); const int Rb = Epi::PERM ? ((R & ~31) + perm32(R & 31)) : R;
        voffA[i] = (unsigned)(R * K + C) * 2u; voffB[i] = (unsigned)(Rb * K + C) * 2u; }
    const size_t kstep = (size_t)(BK * 2);
    const size_t hstep = (size_t)HALF * K * 2;
    const size_t tstep = 2 * hstep;
    const unsigned ldsw = (unsigned)wid * 1024u;
    const int aoff = lds_byte(wr * 64 + fr, fq * 8), boff = lds_byte(wc * 32 + fr, fq * 8);
#define PG8_SA(b, h) (((b) * 2 + (h)) * HTB)
#define PG8_SB(b, h) ((4 + (b) * 2 + (h)) * HTB)
#define PG8_STAGE(bufoff, gbase, voff) do { _Pragma("unroll") for (int _i = 0; _i < 2; ++_i) \
        __builtin_amdgcn_global_load_lds((const unsigned*)((const char*)(gbase) + (voff)[_i]), (PG8_LAS unsigned*)(lds + (bufoff) + ldsw + _i * 8192), 16, 0, 0); } while (0)
#define PG8_LDA(dst, b, h) do { _Pragma("unroll") for (int m = 0; m < 4; ++m) _Pragma("unroll") for (int k = 0; k < 2; ++k) dst[m][k] = *(const PG8_LAS bf16x8*)(lds + PG8_SA(b, h) + aoff + m * 2048 + k * 1024); } while (0)
#define PG8_LDB(dst, b, h) do { _Pragma("unroll") for (int n = 0; n < 2; ++n) _Pragma("unroll") for (int k = 0; k < 2; ++k) dst[n][k] = *(const PG8_LAS bf16x8*)(lds + PG8_SB(b, h) + boff + n * 2048 + k * 1024); } while (0)
#define PG8_MMA(ai, bj, At, Bt) do { __builtin_amdgcn_s_setprio(1); _Pragma("unroll") for (int m = 0; m < 4; ++m) _Pragma("unroll") for (int n = 0; n < 2; ++n) _Pragma("unroll") for (int k = 0; k < 2; ++k) \
        acc[ai][bj][m][n] = __builtin_amdgcn_mfma_f32_16x16x32_bf16(Bt[n][k], At[m][k], acc[ai][bj][m][n], 0, 0, 0); __builtin_amdgcn_s_setprio(0); } while (0)
#define PG8_WAIT_V(n) asm volatile("s_waitcnt vmcnt(" #n ")" ::: "memory")
#define PG8_WAIT_L(n) asm volatile("s_waitcnt lgkmcnt(" #n ")" ::: "memory")
#define PG8_BAR __builtin_amdgcn_s_barrier()
#define PG8_SCHED __builtin_amdgcn_sched_barrier(0)
    Unit cur, nxt; int ui = 0;
    if (!S.next(0, cur)) return;
    f32x4 acc[2][2][4][2];
#pragma unroll
    for (int a = 0; a < 2; ++a)
#pragma unroll
        for (int b = 0; b < 2; ++b)
#pragma unroll
            for (int m = 0; m < 4; ++m)
#pragma unroll
                for (int n = 0; n < 2; ++n) acc[a][b][m][n] = (f32x4){0.f, 0.f, 0.f, 0.f};
    bf16x8 At[4][2], B0[2][2], B1[2][2];
    const char* cA = (const char*)g.A + a_part_bytes(g, cur.pn) + (size_t)cur.pm * tstep; const char* cB = (const char*)g.Bt + (size_t)cur.pn * tstep;
    S.a_ready(cur);
    PG8_STAGE(PG8_SB(0, 0), cB, voffB); PG8_STAGE(PG8_SA(0, 0), cA, voffA); PG8_STAGE(PG8_SB(0, 1), cB + hstep, voffB); PG8_STAGE(PG8_SA(0, 1), cA + hstep, voffA);
    if (wr == 1) PG8_BAR;
    PG8_WAIT_V(4); PG8_BAR;
    PG8_STAGE(PG8_SB(1, 0), cB + kstep, voffB); PG8_STAGE(PG8_SA(1, 0), cA + kstep, voffA); PG8_STAGE(PG8_SB(1, 1), cB + hstep + kstep, voffB);
    PG8_WAIT_V(6); PG8_BAR;
    PG8_STAMP();
#ifdef MK_KPROBE
    unsigned long long kp_a_ = 0ull, kp_prev_ = 0ull;
#endif
    for (;;) {
#ifdef MK_KPROBE
        if (MK_KPROBE == 1 && ui == 2) kp_a_ = clock64();
#endif
        const bool has_next = S.next(ui + 1, nxt);
        const char* nA = has_next ? (const char*)g.A + a_part_bytes(g, nxt.pn) + (size_t)nxt.pm * tstep : cA; const char* nB = has_next ? (const char*)g.Bt + (size_t)nxt.pn * tstep : cB;
        for (int t = 0; t < nt; t += 2) {
            const bool last = (t == nt - 2);
            const char* a1 = cA + (size_t)(t + 1) * kstep;
            const char* a2 = last ? nA : cA + (size_t)(t + 2) * kstep; const char* b2 = last ? nB : cB + (size_t)(t + 2) * kstep;
            const char* a3 = a2 + kstep; const char* b3 = b2 + kstep;
            if (last && has_next) S.a_ready(nxt);
            PG8_LDB(B0, 0, 0); PG8_SCHED; PG8_LDA(At, 0, 0); PG8_STAGE(PG8_SA(1, 1), a1 + hstep, voffA);
            PG8_WAIT_L(8); PG8_BAR; PG8_WAIT_L(0); PG8_MMA(0, 0, At, B0); PG8_BAR; PG8_SCHED;
            if constexpr (!LEFTHALF) PG8_LDB(B1, 0, 1); PG8_STAGE(PG8_SB(0, 0), b2, voffB);
            PG8_BAR; PG8_WAIT_L(0); if constexpr (!LEFTHALF) PG8_MMA(0, 1, At, B1); PG8_BAR;
            if constexpr (!TOPHALF) PG8_LDA(At, 0, 1); PG8_STAGE(PG8_SA(0, 0), a2, voffA);
            PG8_BAR; PG8_WAIT_L(0); if constexpr (!TOPHALF) PG8_MMA(1, 0, At, B0); PG8_BAR; PG8_SCHED;
            PG8_STAGE(PG8_SB(0, 1), b2 + hstep, voffB);
            PG8_WAIT_V(6); PG8_BAR; if constexpr (!TOPHALF && !LEFTHALF) PG8_MMA(1, 1, At, B1); PG8_BAR;
            PG8_LDB(B0, 1, 0); PG8_SCHED; PG8_LDA(At, 1, 0); PG8_STAGE(PG8_SA(0, 1), a2 + hstep, voffA);
            PG8_WAIT_L(8); PG8_BAR; PG8_WAIT_L(0); PG8_MMA(0, 0, At, B0); PG8_BAR; PG8_SCHED;
            if constexpr (!LEFTHALF) PG8_LDB(B1, 1, 1); PG8_STAGE(PG8_SB(1, 0), b3, voffB);
            PG8_BAR; PG8_WAIT_L(0); if constexpr (!LEFTHALF) PG8_MMA(0, 1, At, B1); PG8_BAR;
            if constexpr (!TOPHALF) PG8_LDA(At, 1, 1); PG8_STAGE(PG8_SA(1, 0), a3, voffA);
            PG8_BAR; PG8_WAIT_L(0); if constexpr (!TOPHALF) PG8_MMA(1, 0, At, B0); PG8_BAR; PG8_SCHED;
            PG8_STAGE(PG8_SB(1, 1), b3 + hstep, voffB);
            PG8_WAIT_V(6); PG8_BAR; if constexpr (!TOPHALF && !LEFTHALF) PG8_MMA(1, 1, At, B1); PG8_BAR;
        }
        PG8_STAMP();
#ifdef MK_KPROBE
        { const unsigned long long now_ = clock64();
          if (ui == 2 && tid == 0) *(volatile PG8_LAS unsigned*)(lds + 163712 + 80) = (unsigned)(now_ - (MK_KPROBE == 1 ? kp_a_ : kp_prev_));
          kp_prev_ = now_; }
#endif
        if constexpr (!Epi::AFTER_DRAIN) { E(acc, cur, wr, wc, fr, fq); S.done(cur); }
        PG8_STAMP();
        if (!has_next) break;
#pragma unroll
        for (int a = 0; a < 2; ++a)
#pragma unroll
            for (int b = 0; b < 2; ++b)
#pragma unroll
                for (int m = 0; m < 4; ++m)
#pragma unroll
                    for (int n = 0; n < 2; ++n) acc[a][b][m][n] = (f32x4){0.f, 0.f, 0.f, 0.f};
        cur = nxt; cA = nA; cB = nB; ++ui;
    }
    PG8_WAIT_V(0);
    if (wr == 0) PG8_BAR;
    PG8_BAR;
    if constexpr (Epi::AFTER_DRAIN) { E.fused(acc, cur, wr, wc, fr, fq, lds, wid, lane); S.done(cur); }
    PG8_STAMP();
    if (STAMP && wid == 0) { stamps[lane] = lane < nts ? (((unsigned long long)(unsigned)ts_hi << 32) | (unsigned)ts_lo) : 0ull;
        if (lane == 62) stamps[62] = rt_entry; if (lane == 63) stamps[63] = (unsigned long long)wall_clock64(); }
#undef PG8_STAMP
#undef PG8_SA
#undef PG8_SB
#undef PG8_STAGE
#undef PG8_LDA
#undef PG8_LDB
#undef PG8_MMA
#undef PG8_WAIT_V
#undef PG8_WAIT_L
#undef PG8_BAR
#undef PG8_SCHED
}
}
namespace mk {
typedef pg8::Unit Unit;
typedef const pg8::f32x4 (&AccRef)[2][2][4][2];

__device__ __forceinline__ void st_bf8(bf16_t* p, pg8::f32x4 v0, pg8::f32x4 v1) {
    u32x4 w; w.x = cvt_pk_bf16(v0[0], v0[1]); w.y = cvt_pk_bf16(v0[2], v0[3]); w.z = cvt_pk_bf16(v1[0], v1[1]); w.w = cvt_pk_bf16(v1[2], v1[3]);
    *(u32x4*)p = w;
#ifdef MK_ST2
    asm volatile("" ::: "memory"); *(u32x4*)p = w; asm volatile("" ::: "memory");
#endif
}
__device__ __forceinline__ void st_bf4(bf16_t* p, pg8::f32x4 v) { u32x2 w; w.x = cvt_pk_bf16(v[0], v[1]); w.y = cvt_pk_bf16(v[2], v[3]); *(u32x2*)p = w; }

struct EpiY {
    static constexpr bool PERM = true, AFTER_DRAIN = false;
    bf16_t* O;
    __device__ __forceinline__ void operator()(AccRef acc, const Unit& u, int wr, int wc, int fr, int fq) const {
        const int row0 = u.pm * 256 + wr * 64 + fr, col0 = u.pn * 256 + wc * 32 + 8 * fq;
#pragma unroll
        for (int ai = 0; ai < 2; ++ai)
#pragma unroll
            for (int m = 0; m < 4; ++m) { bf16_t* rowp = O + (size_t)(row0 + ai * 128 + m * 16) * D + col0;
#pragma unroll
                for (int bj = 0; bj < 2; ++bj) st_bf8(rowp + bj * 128, acc[ai][bj][m][0], acc[ai][bj][m][1]); }
    }
};
struct EpiH1 {
    static constexpr bool PERM = true, AFTER_DRAIN = false;
    bf16_t* Y; const float* lbl; int jl;
    __device__ __forceinline__ void operator()(AccRef acc, const Unit& u, int wr, int wc, int fr, int fq) const {
        const int part = u.pn >> 4, colt = (u.pn & 15) * 256;
        const int row0 = u.pm * 256 + wr * 64 + fr, col0 = colt + wc * 32 + 8 * fq;
        if (part == 1) {
            pg8::f32x4 lba[2][2] = {{{0.f, 0.f, 0.f, 0.f}, {0.f, 0.f, 0.f, 0.f}}, {{0.f, 0.f, 0.f, 0.f}, {0.f, 0.f, 0.f, 0.f}}};
            if (jl) {
#pragma unroll
                for (int bj = 0; bj < 2; ++bj)
#pragma unroll
                    for (int n = 0; n < 2; ++n) { const pg8::f32x4 l0 = *(const pg8::f32x4*)(lbl + col0 + bj * 128 + 4 * n), l1 = *(const pg8::f32x4*)(lbl + D + col0 + bj * 128 + 4 * n);
#pragma unroll
                        for (int j = 0; j < 4; ++j) lba[bj][n][j] = sigmoid_f(l1[j] - l0[j]); }
            }
#pragma unroll
            for (int bj = 0; bj < 2; ++bj) {
                const pg8::f32x4 lbv[2] = {lba[bj][0], lba[bj][1]};
#pragma unroll
                for (int ai = 0; ai < 2; ++ai)
#pragma unroll
                    for (int m = 0; m < 4; ++m) {
                        const int row = row0 + ai * 128 + m * 16;
                        pg8::f32x4 o[2];
#pragma unroll
                        for (int n = 0; n < 2; ++n)
#pragma unroll
                            for (int j = 0; j < 4; ++j) {
                                const float x = acc[ai][bj][m][n][j]; float g;
                                if (jl) { const float l = lbv[n][j]; g = __logf(l + (1.f - l) * sigmoid_f(x)); }
                                else g = fminf(x, 0.f) - __logf(1.f + __expf(-fabsf(x)));
                                o[n][j] = (row < NPAD) ? 0.f : g;
                            }
                        st_bf8(Y + 3 * (SLOT / 2) + (size_t)row * D + col0 + bj * 128, o[0], o[1]);
                    }
            }
        } else {
            bf16_t* dst = Y + (size_t)(part == 0 ? 0 : (part == 2 ? 1 : 2)) * (SLOT / 2);
#pragma unroll
            for (int ai = 0; ai < 2; ++ai)
#pragma unroll
                for (int m = 0; m < 4; ++m) { bf16_t* rowp = dst + (size_t)(row0 + ai * 128 + m * 16) * D + col0;
#pragma unroll
                    for (int bj = 0; bj < 2; ++bj) st_bf8(rowp + bj * 128, acc[ai][bj][m][0], acc[ai][bj][m][1]); }
        }
    }
};
struct EpiB1 {
    static constexpr bool PERM = false, AFTER_DRAIN = false;
    bf16_t* Y; const float* cs; const float* sn;
    __device__ __forceinline__ void operator()(AccRef acc, const Unit& u, int wr, int wc, int fr, int fq) const {
        const int part = u.pn >> 4, colt = (u.pn & 15) * 256;
        const int row0 = u.pm * 256 + wr * 64 + fr, col0 = colt + wc * 32 + 4 * fq;
        bf16_t* dst = Y + (size_t)part * (SLOT / 2);
        const bool rope = (part < 2) && (wc == 0);
        pg8::f32x4 c4a[2][4], s4a[2][4];
#pragma unroll
        for (int ai = 0; ai < 2; ++ai)
#pragma unroll
            for (int m = 0; m < 4; ++m) { c4a[ai][m] = (pg8::f32x4){1.f, 1.f, 1.f, 1.f}; s4a[ai][m] = (pg8::f32x4){0.f, 0.f, 0.f, 0.f}; }
        if (rope) {
#pragma unroll
            for (int ai = 0; ai < 2; ++ai)
#pragma unroll
                for (int m = 0; m < 4; ++m) { const int row = row0 + ai * 128 + m * 16;
                    c4a[ai][m] = *(const pg8::f32x4*)(cs + (size_t)row * 16 + 4 * fq); s4a[ai][m] = *(const pg8::f32x4*)(sn + (size_t)row * 16 + 4 * fq); }
        }
#pragma unroll
        for (int ai = 0; ai < 2; ++ai)
#pragma unroll
            for (int m = 0; m < 4; ++m) {
                const int row = row0 + ai * 128 + m * 16;
                const pg8::f32x4 c4 = c4a[ai][m], s4 = s4a[ai][m];
                bf16_t* rowp = dst + (size_t)row * D + (col0 - 4 * fq) + ((fq & 1) ? 12 + 4 * fq : 4 * fq);
#pragma unroll
                for (int bj = 0; bj < 2; ++bj) {
                    const pg8::f32x4 x1 = acc[ai][bj][m][0], x2 = acc[ai][bj][m][1];
                    const pg8::f32x4 y1 = x1 * c4 - x2 * s4, y2 = x2 * c4 + x1 * s4;
                    const unsigned a0 = cvt_pk_bf16(y1[0], y1[1]), a1 = cvt_pk_bf16(y1[2], y1[3]), b0 = cvt_pk_bf16(y2[0], y2[1]), b1 = cvt_pk_bf16(y2[2], y2[3]);
                    const auto r0 = __builtin_amdgcn_permlane16_swap(a0, b0, false, false); const auto r1 = __builtin_amdgcn_permlane16_swap(a1, b1, false, false);
                    const u32x4 w = {r0[0], r1[0], r0[1], r1[1]};
                    *(u32x4*)(rowp + bj * 128) = w;
                }
            }
    }
};
struct EpiC1 {
    static constexpr bool PERM = true, AFTER_DRAIN = false;
    bf16_t *Y, *T;
    __device__ __forceinline__ void operator()(AccRef acc, const Unit& u, int wr, int wc, int fr, int fq) const {
        const int row0 = u.pm * 256 + wr * 64 + fr;
        if (u.pn < 64) {
            const int part = u.pn >> 4, col0 = (u.pn & 15) * 256 + wc * 32 + 8 * fq;
            bf16_t* dst = Y + (size_t)part * (SLOT / 2);
#pragma unroll
            for (int ai = 0; ai < 2; ++ai)
#pragma unroll
                for (int m = 0; m < 4; ++m) { bf16_t* rowp = dst + (size_t)(row0 + ai * 128 + m * 16) * D + col0;
#pragma unroll
                    for (int bj = 0; bj < 2; ++bj) st_bf8(rowp + bj * 128, acc[ai][bj][m][0], acc[ai][bj][m][1]); }
        } else {
            const int which = u.pn - 64, col0 = which * 128 + wc * 32 + 8 * fq;
#pragma unroll
            for (int ai = 0; ai < 2; ++ai)
#pragma unroll
                for (int m = 0; m < 4; ++m) {
                    pg8::f32x4 v0 = acc[ai][0][m][0], v1 = acc[ai][0][m][1];
                    if (which == 0) {
#pragma unroll
                        for (int j = 0; j < 4; ++j) { v0[j] = 1.f - 2.f * __builtin_amdgcn_rcpf(1.f + __expf(2.f * v0[j])); v1[j] = 1.f - 2.f * __builtin_amdgcn_rcpf(1.f + __expf(2.f * v1[j])); }
                    }
                    st_bf8(T + (size_t)(row0 + ai * 128 + m * 16) * 256 + col0, v0, v1);
                }
        }
    }
};
struct EpiC2 {
    static constexpr bool PERM = true, AFTER_DRAIN = false;
    bf16_t* Y; const float* w0; const float* a0;
    __device__ __forceinline__ void operator()(AccRef acc, const Unit& u, int wr, int wc, int fr, int fq) const {
        const int row0 = u.pm * 256 + wr * 64 + fr;
        const bool isw = u.pn < 16;
        const int col0 = (u.pn & 15) * 256 + wc * 32 + 8 * fq;
        bf16_t* dst = Y + (size_t)(isw ? 4 : 5) * (SLOT / 2); const float* bias = isw ? w0 : a0;
#pragma unroll
        for (int bj = 0; bj < 2; ++bj) {
            const pg8::f32x4 b0 = *(const pg8::f32x4*)(bias + col0 + bj * 128), b1 = *(const pg8::f32x4*)(bias + col0 + bj * 128 + 4);
#pragma unroll
            for (int ai = 0; ai < 2; ++ai)
#pragma unroll
                for (int m = 0; m < 4; ++m) {
                    pg8::f32x4 v0 = acc[ai][bj][m][0] + b0, v1 = acc[ai][bj][m][1] + b1;
#pragma unroll
                    for (int j = 0; j < 4; ++j) {
                        float s0 = sigmoid_f(v0[j]), s1 = sigmoid_f(v1[j]);
                        if (isw) { s0 = __expf(-0.606531f * s0); s1 = __expf(-0.606531f * s1); }
                        v0[j] = s0; v1[j] = s1;
                    }
                    st_bf8(dst + (size_t)(row0 + ai * 128 + m * 16) * D + col0 + bj * 128, v0, v1);
                    __builtin_amdgcn_sched_barrier(0);
                }
        }
    }
};

struct Fr {
    LAS unsigned char* lds; unsigned char* ldsg;
    int tid, lane, wave, G, bid, gw, NGW;
    float* out; unsigned char* ws;
    __device__ __forceinline__ Fr fresh() const { Fr P = *this; asm volatile("" : "+v"(P.tid)); P.lane = P.tid & 63; P.wave = __builtin_amdgcn_readfirstlane(P.tid >> 6); P.gw = P.bid * 8 + P.wave; return P; }
    __device__ __forceinline__ const float* in(int i) const {
        const __attribute__((address_space(4))) unsigned long long* ka = (const __attribute__((address_space(4))) unsigned long long*)__builtin_amdgcn_kernarg_segment_ptr();
        asm volatile("" : "+s"(ka));
        return (const float*)ka[i];
    }
};
__device__ __forceinline__ bf16_t* slotU(const Fr& F, int s) { return (bf16_t*)(F.ws + WS_U + (size_t)s * SLOT); }
__device__ __forceinline__ bf16_t* slotY(const Fr& F, int s) { return (bf16_t*)(F.ws + WS_Y + (size_t)s * SLOT); }
__device__ __forceinline__ float* hrow(const Fr& F, int r) { return r < 64 ? (float*)(F.ws + WS_HMETA) + (size_t)r * D : F.out + (size_t)(r - 64) * D; }

__device__ __forceinline__ void transpose_item(const float* W, int ldw, bf16_t* WT, int ldt, int koff, LAS float* scr, int kb, int nb, int lane) {
    const int k0 = 64 * kb, n0 = 32 * nb;
    float wv[32];
#pragma unroll
    for (int i = 0; i < 32; ++i) wv[i] = W[(size_t)(k0 + 2 * i + (lane >> 5)) * ldw + n0 + (lane & 31)];
#pragma unroll
    for (int i = 0; i < 32; ++i) scr[(2 * i + (lane >> 5)) * 33 + (lane & 31)] = wv[i];
    LDS_WAIT(); asm volatile("" ::: "memory");
    const int c = lane & 7;
#pragma unroll
    for (int j = 0; j < 4; ++j) { const int n = (lane >> 3) + 8 * j; const LAS float* s = scr + (8 * c) * 33 + n;
        u32x4 o; o.x = cvt_pk_bf16(s[0 * 33], s[1 * 33]); o.y = cvt_pk_bf16(s[2 * 33], s[3 * 33]); o.z = cvt_pk_bf16(s[4 * 33], s[5 * 33]); o.w = cvt_pk_bf16(s[6 * 33], s[7 * 33]);
        *(u32x4*)(WT + (size_t)(n0 + n) * ldt + koff + k0 + 8 * c) = o; }
    LDS_WAIT(); asm volatile("" ::: "memory");
}
__device__ __forceinline__ void convert_matrix(const Fr& F, const float* W, int K, int N, bf16_t* WT, int ldt, int koff, int wg_skip = 0) {
    LAS float* scr = (LAS float*)(F.lds + F.wave * 8704);
    const int nblk = N / 32, nitems = (K / 64) * nblk;
    for (int it = F.gw - wg_skip * 8; it < nitems; it += F.NGW - wg_skip * 8) transpose_item(W, N, WT, ldt, koff, scr, it / nblk, it % nblk, F.lane);
}
__device__ __forceinline__ void convert_matrix_split(const Fr& F, const float* W, int K, int N, bf16_t* WT, int ldt, int wg_split, int nsplit) {
    LAS float* scr = (LAS float*)(F.lds + F.wave * 8704);
    const int nblk = N / 32, nitems = (K / 64) * nblk;
    if (F.bid >= wg_split) { for (int it = F.gw - wg_split * 8; it < nsplit; it += F.NGW - wg_split * 8) transpose_item(W, N, WT, ldt, 0, scr, it / nblk, it % nblk, F.lane); }
    else { for (int it = nsplit + F.gw; it < nitems; it += wg_split * 8) transpose_item(W, N, WT, ldt, 0, scr, it / nblk, it % nblk, F.lane); }
}
__device__ __forceinline__ void zero_bytes(const Fr& F, void* p, size_t nbytes) {
    u32x4* q = (u32x4*)p; const size_t n = nbytes / 16; const u32x4 z = {0u, 0u, 0u, 0u};
    for (size_t i = (size_t)F.bid * 512 + F.tid; i < n; i += (size_t)F.G * 512) q[i] = z;
}
__device__ __forceinline__ bf16_t* wtin_of(const Fr& F, int L) { return (bf16_t*)(F.ws + ((L & 1) ? WS_WTINB : WS_WTIN)); }
__device__ __forceinline__ const float* win_src(const Fr& F, int L) { return (L == 0 || L == 3) ? F.in(4) + (size_t)(L ? 1 : 0) * D * 4 * D : (L == 1 ? F.in(8) : F.in(16)); }
__device__ __forceinline__ void convert_win_tail(const Fr& F, int L) { convert_matrix_split(F, win_src(F, L), D, 4 * D, wtin_of(F, L), D, 64, 26624); }
__device__ __forceinline__ void convert_win(const Fr& F, int L, int wg_skip) {
    const float* src = (L == 0 || L == 3) ? F.in(4) + (size_t)(L ? 1 : 0) * D * 4 * D : (L == 1 ? F.in(8) : F.in(16));
    convert_matrix(F, src, D, 4 * D, wtin_of(F, L), D, 0, wg_skip);
}
__device__ __forceinline__ void convert_layer(const Fr& F, int L, bool with_win) {
    bf16_t* wtin = wtin_of(F, L); bf16_t* wtout = (bf16_t*)(F.ws + WS_WTOUT);
    if (with_win) convert_win(F, L, 0);
    if (L == 0) {
        convert_matrix(F, F.in(7), D, D, wtout, D, 0);
    } else if (L == 3) {
    } else if (L == 1) {
        convert_matrix(F, F.in(14), D, D, wtout, D, 0);
    } else {
        convert_matrix(F, F.in(28), D, D, wtout, D, 0);
        convert_matrix(F, F.in(18), D, 128, wtin + (size_t)16384 * D, D, 0);
        convert_matrix(F, F.in(21), D, 128, wtin + (size_t)16640 * D, D, 0);
        zero_bytes(F, wtin + (size_t)16512 * D, (size_t)128 * D * 2);
        zero_bytes(F, wtin + (size_t)16768 * D, (size_t)128 * D * 2);
    }
}
__device__ __forceinline__ void convert_wout2(const Fr& F, int wg_skip) { convert_matrix(F, F.in(28), D, D, (bf16_t*)(F.ws + WS_WTOUT), D, 0, wg_skip); }
__device__ __forceinline__ void convert_wout3(const Fr& F, int wg_skip) { convert_matrix(F, F.in(7) + (size_t)D * D, D, D, (bf16_t*)(F.ws + WS_WTOUT), D, 0, wg_skip); }
__device__ __forceinline__ void convert_layer2_b(const Fr& F) {
    bf16_t* w2t = (bf16_t*)(F.ws + WS_W2P);
    convert_matrix(F, F.in(19), 128, D, w2t, 128, 0);
    convert_matrix(F, F.in(22), 128, D, w2t + (size_t)4096 * 128, 128, 0);
}

__constant__ float c_inv_freq[16] = {1.0f, 0.44036659598350525f, 0.1939227432012558f, 0.08539710193872452f, 0.03760603070259094f, 0.01656043902039528f, 0.007292664609849453f, 0.0032114458736032248f,
    0.0014142135623842478f, 0.000622772378847003f, 0.00027424818836152554f, 0.00012076973507646471f, 5.318296098266728e-05f, 2.34199997066753e-05f, 1.0313386155758053e-05f, 4.541670477919979e-06f};
__device__ __forceinline__ void rope_table(const Fr& F) {
    float* cs = (float*)(F.ws + WS_ROPE); float* sn = cs + (size_t)R * 16;
    for (int i = F.bid * 512 + F.tid; i < R * 16; i += F.G * 512) {
        const int row = i >> 4, j = i & 15; const int pos = row - NPAD;
        const double ang = (double)(float)((float)pos * c_inv_freq[j]);
        const double k = __builtin_rint(ang * 0.15915494309189535);
        double x = ang - k * 6.283185307179586;
        const double q = __builtin_rint(x * 0.6366197723675814);
        x -= q * 1.5707963267948966;
        const int qi = ((int)q) & 3;
        const double x2 = x * x;
        const double s = x * (1.0 + x2 * (-1.0 / 6 + x2 * (1.0 / 120 + x2 * (-1.0 / 5040 + x2 * (1.0 / 362880 + x2 * (-1.0 / 39916800))))));
        const double c = 1.0 + x2 * (-0.5 + x2 * (1.0 / 24 + x2 * (-1.0 / 720 + x2 * (1.0 / 40320 + x2 * (-1.0 / 3628800 + x2 * (1.0 / 479001600))))));
        double sv, cv;
        if (qi == 0) { sv = s; cv = c; } else if (qi == 1) { sv = c; cv = -s; } else if (qi == 2) { sv = -s; cv = -c; } else { sv = -c; cv = s; }
        cs[i] = (float)cv; sn[i] = (float)sv;
    }
}

typedef const GAS char* gcp; typedef GAS char* gp_;
#define ROW_F32(nm, base, lane) gp_ nm##0 = (gp_)(base) + (lane) * 16 + 4096; gp_ nm##1 = nm##0 + 8192; asm volatile("" : "+v"(nm##0), "+v"(nm##1))
#define AT_F32(nm, j) (*(GAS f32x4*)((j) < 8 ? nm##0 + ((j) - 4) * 1024 : nm##1 + ((j) - 12) * 1024))
#define ROW_BF(nm, base, lane) gp_ nm##0 = (gp_)(base) + (lane) * 8 + 4096; asm volatile("" : "+v"(nm##0))
#define AT_BF(nm, j) (*(GAS u32x2*)(nm##0 + (j) * 512 - 4096))
__device__ __forceinline__ void norm_phase(const Fr& F, int prev, int next, const bf16_t* y, bf16_t* udst, int rlo = 0, int rhi = R, int wg_skip = 0) {
    const float* postg = F.in(3) + (size_t)(prev < 0 ? 0 : prev) * D; const float* preg = F.in(2) + (size_t)(next < 0 ? 0 : next) * D;
    const float* xin = F.in(0); const float* meta = F.in(1);
    for (int r = rlo + F.gw - wg_skip * 8; r < rhi; r += F.NGW - wg_skip * 8) {
        if (r < NPAD || r >= NREAL) {
            if (next >= 0) { ROW_BF(uo, udst + (size_t)r * D, F.lane); const u32x2 z = {0u, 0u};
#pragma unroll
                for (int j = 0; j < 16; ++j) AT_BF(uo, j) = z; }
            continue;
        }
        ROW_BF(hp, (bf16_t*)(F.ws + WS_HB) + (size_t)r * D, F.lane);
        f32x4 hv[16];
        if (prev < 0) {
            const float* src = r < 64 ? meta + (size_t)(r - NPAD) * D : xin + (size_t)(r - 64) * D;
            ROW_F32(sp, src, F.lane);
#pragma unroll
            for (int j = 0; j < 16; ++j) hv[j] = AT_F32(sp, j);
        } else {
            ROW_BF(yp, y + (size_t)r * D, F.lane); ROW_F32(gp, postg, F.lane);
            u32x2 yv[16], hb[16]; float ss = 0.f;
#pragma unroll
            for (int j = 0; j < 16; ++j) { yv[j] = AT_BF(yp, j); hb[j] = AT_BF(hp, j); }
#pragma unroll
            for (int j = 0; j < 16; ++j) { const float a = bflo(yv[j].x), b = bfhi(yv[j].x), c = bflo(yv[j].y), d = bfhi(yv[j].y); ss += (a * a + b * b) + (c * c + d * d); }
#pragma unroll
            for (int j = 0; j < 16; ++j) asm volatile("" : "+v"(yv[j].x), "+v"(yv[j].y));
            const float rs = __builtin_amdgcn_rsqf(wave_sum(ss) * (1.f / D) + 1e-6f);
#pragma unroll
            for (int j = 0; j < 16; ++j) { const f32x4 g = AT_F32(gp, j);
                hv[j].x = bflo(hb[j].x) + bflo(yv[j].x) * rs * g.x; hv[j].y = bfhi(hb[j].x) + bfhi(yv[j].x) * rs * g.y; hv[j].z = bflo(hb[j].y) + bflo(yv[j].y) * rs * g.z; hv[j].w = bfhi(hb[j].y) + bfhi(yv[j].y) * rs * g.w; }
        }
        if (next < 0) {
            if (r >= 64) { ROW_F32(op, F.out + (size_t)(r - 64) * D, F.lane);
#pragma unroll
                for (int j = 0; j < 16; ++j) AT_F32(op, j) = hv[j];
            }
            continue;
        }
        float s2 = 0.f;
#pragma unroll
        for (int j = 0; j < 16; ++j) { u32x2 w_; w_.x = cvt_pk_bf16(hv[j].x, hv[j].y); w_.y = cvt_pk_bf16(hv[j].z, hv[j].w); AT_BF(hp, j) = w_; s2 += (hv[j].x * hv[j].x + hv[j].y * hv[j].y) + (hv[j].z * hv[j].z + hv[j].w * hv[j].w); }
        const float rs2 = __builtin_amdgcn_rsqf(wave_sum(s2) * (1.f / D) + 1e-6f);
        ROW_BF(uo, udst + (size_t)r * D, F.lane); ROW_F32(pg, preg, F.lane);
#pragma unroll
        for (int j = 0; j < 16; ++j) { const f32x4 g = AT_F32(pg, j); u32x2 w; w.x = cvt_pk_bf16(hv[j].x * rs2 * g.x, hv[j].y * rs2 * g.y); w.y = cvt_pk_bf16(hv[j].z * rs2 * g.z, hv[j].w * rs2 * g.w); AT_BF(uo, j) = w; }
    }
}
__device__ __forceinline__ void mix_phase(const Fr& F, const bf16_t* u) {
    const float* mu = F.in(15);
    for (int r = F.gw; r < R; r += F.NGW) {
        const bool real = (r >= NPAD && r < NREAL);
        u32x2 cur[16], prv[16];
        const u32x2 z = {0u, 0u};
        { ROW_BF(cp, u + (size_t)r * D, F.lane); ROW_BF(pp, u + (size_t)(r > 0 ? r - 1 : 0) * D, F.lane);
#pragma unroll
          for (int j = 0; j < 16; ++j) { cur[j] = real ? AT_BF(cp, j) : z; prv[j] = (real && r > NPAD) ? AT_BF(pp, j) : z; } }
#pragma unroll 1
        for (int s = 0; s < 6; ++s) {
            ROW_BF(op, slotU(F, s) + (size_t)r * D, F.lane); ROW_F32(mp, mu + (size_t)s * D, F.lane);
#pragma unroll
            for (int j = 0; j < 16; ++j) {
                const f32x4 m = AT_F32(mp, j);
                const float c0 = bflo(cur[j].x), c1 = bfhi(cur[j].x), c2 = bflo(cur[j].y), c3 = bfhi(cur[j].y);
                const float p0 = bflo(prv[j].x), p1 = bfhi(prv[j].x), p2 = bflo(prv[j].y), p3 = bfhi(prv[j].y);
                u32x2 w; w.x = cvt_pk_bf16(c0 + (p0 - c0) * m.x, c1 + (p1 - c1) * m.y); w.y = cvt_pk_bf16(c2 + (p2 - c2) * m.z, c3 + (p3 - c3) * m.w);
                AT_BF(op, j) = real ? w : z;
            }
        }
    }
}
}
namespace mk {
constexpr int H_WS = 144, H_TS = 80, H_QE = 0, H_KE = H_QE + 64 * H_WS * 2, H_KET = H_KE + 64 * H_WS * 2, H_VT = H_KET + 128 * H_TS * 2, H_PM = H_VT + 128 * H_TS * 2, H_STB = H_PM + 64 * H_TS * 2,
              H_VEC = H_STB + 128 * H_WS * 2, H_OT = H_VEC + 3072;
static_assert(H_OT + 33792 <= 163712, "hgrn LDS map");
__device__ __forceinline__ bf16x8 ldfrag(const LAS unsigned char* base, int stride_b, int rb, int ks, int lane) {
    return *(const LAS bf16x8*)(base + (16 * rb + (lane & 15)) * stride_b + (32 * ks + 8 * (lane >> 4)) * 2);
}
template <bool OUT>
__device__ __forceinline__ void hgrn_phase(const Fr& F, int jl) {
    const bf16_t* Q = slotY(F, 0); const bf16_t* V = slotY(F, 1); const bf16_t* GT = slotY(F, 2); const bf16_t* Gg = slotY(F, 3);
    bf16_t* Z = slotU(F, 0);
    float* HE = (float*)(F.ws + WS_HE); float* HLD = (float*)(F.ws + WS_HLOGD);
    const float* gn = F.in(6) + (size_t)jl * 128;
    LAS unsigned char* L = F.lds;
    LAS float* qtot = (LAS float*)(L + H_VEC); LAS float* ebm = qtot + 512; LAS float* ebl = ebm + 128;
    const int tid = F.tid, lane = F.lane, w = F.wave;
    const int d = tid & 127, qt = tid >> 7;
    for (int unit = F.bid; unit < 256; unit += F.G) {
        const int h = unit >> 3, seg = unit & 7;
        if (!OUT && seg == 7) continue;
        const int c0 = seg == 0 ? 0 : 33 + 32 * (seg - 1), c1 = c0 + (seg == 0 ? 33 : 32);
        f32x4 S[8];
#pragma unroll
        for (int i = 0; i < 8; ++i) S[i] = (f32x4){0.f, 0.f, 0.f, 0.f};
        if (OUT) {
            for (int j = 0; j < seg; ++j) {
                const float* ld = HLD + (size_t)(h * 8 + j) * 128; const float* e = HE + ((size_t)(h * 8 + j) * 512 + tid) * 32;
#pragma unroll
                for (int di = 0; di < 8; ++di) { const f32x4 l4 = *(const f32x4*)(ld + 16 * di + 4 * (lane >> 4)); const f32x4 e4 = *(const f32x4*)(e + 4 * di);
                    S[di].x = S[di].x * __expf(l4.x) + e4.x; S[di].y = S[di].y * __expf(l4.y) + e4.y; S[di].z = S[di].z * __expf(l4.z) + e4.z; S[di].w = S[di].w * __expf(l4.w) + e4.w; }
            }
        }
        float logD = 0.f;
        f32x4 gnv[4];
#pragma unroll
        for (int i = 0; i < 4; ++i) gnv[i] = OUT ? *(const f32x4*)(gn + 16 * (tid & 7) + 4 * i) : (f32x4){0.f, 0.f, 0.f, 0.f};
        bf16_t g[16], qv[16], vv[16]; u32x4 gt0 = {0u, 0u, 0u, 0u}, gt1 = gt0, ngt0 = gt0, ngt1 = gt0;
#define HG_LOAD(cc) do { const int rowb_ = 64 * (cc) + 16 * qt; const size_t colb_ = (size_t)h * 128 + d; \
            _Pragma("unroll") for (int i = 0; i < 16; ++i) { g[i] = Gg[(size_t)(rowb_ + i) * D + colb_]; vv[i] = V[(size_t)(rowb_ + i) * D + colb_]; if (OUT) qv[i] = Q[(size_t)(rowb_ + i) * D + colb_]; } \
            if (OUT) { const bf16_t* gp_ = GT + (size_t)(64 * (cc) + (tid >> 3)) * D + h * 128 + 16 * (tid & 7); ngt0 = *(const u32x4*)gp_; ngt1 = *(const u32x4*)(gp_ + 8); } } while (0)
        HG_LOAD(c0);
        for (int c = c0; c < c1; ++c) {
            if (OUT) { gt0 = ngt0; gt1 = ngt1; }
            float f[16]; float run = 0.f;
#pragma unroll
            for (int i = 0; i < 16; ++i) { const float gi = bf2f(g[i]); run += gi; f[i] = __expf(gi); }
            qtot[qt * 128 + d] = run;
            __syncthreads();
            const float t0 = qtot[d], t1 = qtot[128 + d], t2 = qtot[256 + d], t3 = qtot[384 + d];
            const float off = qt == 0 ? 0.f : (qt == 1 ? t0 : (qt == 2 ? t0 + t1 : t0 + t1 + t2));
            const float bm = t0 + t1, bl = (t0 + t1) + (t2 + t3);
            if (qt == 0) { ebm[d] = __expf(bm); ebl[d] = __expf(bl); logD += bl; }
            {
                unsigned kt[8], vt[8];
                const float ebd = __expf(bl - bm);
                float y = __expf(bm - (run + off)), kx_hi = 0.f;
#pragma unroll
                for (int i = 15; i >= 0; --i) {
                    const float ky = (1.f - f[i]) * y;
                    if (OUT) *(LAS bf16_t*)(L + H_KE + ((16 * qt + i) * H_WS + d) * 2) = f2bf(ky);
                    const float kx = ky * ebd;
                    if (i & 1) kx_hi = kx; else kt[i >> 1] = cvt_pk_bf16(kx, kx_hi);
                    y *= f[i];
                }
                if (OUT) {
                    float e = __expf(off - bm);
#pragma unroll
                    for (int i = 0; i < 16; ++i) { e *= f[i]; *(LAS bf16_t*)(L + H_QE + ((16 * qt + i) * H_WS + d) * 2) = f2bf(bf2f(qv[i]) * e); }
                }
#pragma unroll
                for (int i = 0; i < 16; i += 2) vt[i >> 1] = (unsigned)vv[i] | ((unsigned)vv[i + 1] << 16);
                LAS u32x4* kp = (LAS u32x4*)(L + H_KET + (d * H_TS + 16 * qt) * 2); kp[0] = (u32x4){kt[0], kt[1], kt[2], kt[3]}; kp[1] = (u32x4){kt[4], kt[5], kt[6], kt[7]};
                LAS u32x4* vp = (LAS u32x4*)(L + H_VT + (d * H_TS + 16 * qt) * 2); vp[0] = (u32x4){vt[0], vt[1], vt[2], vt[3]}; vp[1] = (u32x4){vt[4], vt[5], vt[6], vt[7]};
            }
            if (c + 1 < c1) HG_LOAD(c + 1);
            __syncthreads();
            if (OUT) {
#pragma unroll
                for (int di = 0; di < 8; ++di) { const f32x4 m4 = *(const LAS f32x4*)(ebm + 16 * di + 4 * (lane >> 4)); u32x2 o; o.x = cvt_pk_bf16(S[di].x * m4.x, S[di].y * m4.y); o.y = cvt_pk_bf16(S[di].z * m4.z, S[di].w * m4.w);
                    *(LAS u32x2*)(L + H_STB + ((16 * w + (lane & 15)) * H_WS + 16 * di + 4 * (lane >> 4)) * 2) = o; }
                const int ti = w >> 1;
#pragma unroll
                for (int s2 = 0; s2 < 2; ++s2) { const int si = 2 * (w & 1) + s2; f32x4 p = {0.f, 0.f, 0.f, 0.f};
                    if (si <= ti) {
#pragma unroll
                        for (int ks = 0; ks < 4; ++ks) p = __builtin_amdgcn_mfma_f32_16x16x32_bf16(ldfrag(L + H_QE, 2 * H_WS, ti, ks, lane), ldfrag(L + H_KE, 2 * H_WS, si, ks, lane), p, 0, 0, 0);
                    }
                    const int sidx = 16 * si + (lane & 15);
#pragma unroll
                    for (int jj = 0; jj < 4; ++jj) { const int tidx = 16 * ti + 4 * (lane >> 4) + jj; *(LAS bf16_t*)(L + H_PM + (tidx * H_TS + sidx) * 2) = f2bf(sidx <= tidx ? p[jj] : 0.f); }
                }
                __syncthreads();
            }
            f32x4 O[4];
            if (OUT) {
#pragma unroll
                for (int ti = 0; ti < 4; ++ti) O[ti] = (f32x4){0.f, 0.f, 0.f, 0.f};
#pragma unroll
                for (int ks = 0; ks < 2; ++ks) { const bf16x8 bv = ldfrag(L + H_VT, 2 * H_TS, w, ks, lane);
#pragma unroll
                    for (int ti = 0; ti < 4; ++ti) O[ti] = __builtin_amdgcn_mfma_f32_16x16x32_bf16(ldfrag(L + H_PM, 2 * H_TS, ti, ks, lane), bv, O[ti], 0, 0, 0); }
#pragma unroll
                for (int ks = 0; ks < 4; ++ks) { const bf16x8 bs = ldfrag(L + H_STB, 2 * H_WS, w, ks, lane);
#pragma unroll
                    for (int ti = 0; ti < 4; ++ti) O[ti] = __builtin_amdgcn_mfma_f32_16x16x32_bf16(ldfrag(L + H_QE, 2 * H_WS, ti, ks, lane), bs, O[ti], 0, 0, 0); }
            }
            {
                const bf16x8 bv0 = ldfrag(L + H_VT, 2 * H_TS, w, 0, lane), bv1 = ldfrag(L + H_VT, 2 * H_TS, w, 1, lane);
#pragma unroll
                for (int di = 0; di < 8; ++di) { const f32x4 l4 = *(const LAS f32x4*)(ebl + 16 * di + 4 * (lane >> 4)); S[di] = S[di] * l4;
                    S[di] = __builtin_amdgcn_mfma_f32_16x16x32_bf16(ldfrag(L + H_KET, 2 * H_TS, di, 0, lane), bv0, S[di], 0, 0, 0);
                    S[di] = __builtin_amdgcn_mfma_f32_16x16x32_bf16(ldfrag(L + H_KET, 2 * H_TS, di, 1, lane), bv1, S[di], 0, 0, 0); }
            }
            if (OUT) {
                LAS float* Ot = (LAS float*)(L + H_OT);
#pragma unroll
                for (int ti = 0; ti < 4; ++ti)
#pragma unroll
                    for (int jj = 0; jj < 4; ++jj) Ot[(16 * ti + 4 * (lane >> 4) + jj) * 132 + 16 * w + (lane & 15)] = O[ti][jj];
                __syncthreads();
                const int t = tid >> 3, eg = tid & 7;
                f32x4 o4[4]; float ss = 0.f;
#pragma unroll
                for (int i = 0; i < 4; ++i) { o4[i] = *(const LAS f32x4*)(Ot + t * 132 + 16 * eg + 4 * i); ss += (o4[i].x * o4[i].x + o4[i].y * o4[i].y) + (o4[i].z * o4[i].z + o4[i].w * o4[i].w); }
                ss = red8(ss);
                const float rs = __builtin_amdgcn_rsqf(ss * (1.f / 128.f) + 1e-6f);
                const unsigned gw_[8] = {gt0.x, gt0.y, gt0.z, gt0.w, gt1.x, gt1.y, gt1.z, gt1.w};
                unsigned zo[8];
#pragma unroll
                for (int i = 0; i < 4; ++i) { const f32x4 g4 = gnv[i];
                    const float a0 = o4[i].x * rs * g4.x * silu_f(bflo(gw_[2 * i])), a1 = o4[i].y * rs * g4.y * silu_f(bfhi(gw_[2 * i]));
                    const float a2 = o4[i].z * rs * g4.z * silu_f(bflo(gw_[2 * i + 1])), a3 = o4[i].w * rs * g4.w * silu_f(bfhi(gw_[2 * i + 1]));
                    zo[2 * i] = cvt_pk_bf16(a0, a1); zo[2 * i + 1] = cvt_pk_bf16(a2, a3); }
                bf16_t* zp = Z + (size_t)(64 * c + t) * D + h * 128 + 16 * eg;
                *(u32x4*)zp = (u32x4){zo[0], zo[1], zo[2], zo[3]}; *(u32x4*)(zp + 8) = (u32x4){zo[4], zo[5], zo[6], zo[7]};
            } else {
                __syncthreads();
            }
        }
        if (!OUT) {
            float* e = HE + ((size_t)(h * 8 + seg) * 512 + tid) * 32;
#pragma unroll
            for (int di = 0; di < 8; ++di) *(f32x4*)(e + 4 * di) = S[di];
            if (qt == 0) HLD[(size_t)(h * 8 + seg) * 128 + d] = logD;
        }
        __syncthreads();
    }
#undef HG_LOAD
}

#ifndef MK_PRIO
#define MK_PRIO 0
#endif
#define PRIO_HI() do { if (MK_PRIO) { __builtin_amdgcn_s_setprio(MK_PRIO); } } while (0)
#define PRIO_LO() do { if (MK_PRIO) { __builtin_amdgcn_s_setprio(0); } } while (0)
namespace att {
constexpr int NW = 8, QBLK = 32, KVBLK = 64, LDQ = 4096, LDO = 8192;
constexpr float SCALE = 0.088388347648318440f, THR = 8.f;
constexpr int SHM_V = 16384, SHM_K = 16384, SHM = 2 * SHM_V + 2 * SHM_K + NW * 64 * 4;
#ifndef MK_KSWM
#define MK_KSWM 15
#endif
#define KSWZ(row, colB) ((row) * 256 + ((colB) ^ (((row) & MK_KSWM) << 4)))
#define SBAR() __builtin_amdgcn_sched_barrier(0)
__device__ __forceinline__ int crow(int r, int hi) { return (r & 3) + 8 * (r >> 2) + 4 * hi; }
__device__ __forceinline__ void partialSM(f32x16& p0, f32x16& p1, float& m_reg, float& mn, float& alpha) {
    constexpr float C = SCALE * 1.4426950408889634f;
    float pmax = p0[0];
#pragma unroll
    for (int r = 1; r < 16; ++r) pmax = fmaxf(pmax, p0[r]);
#pragma unroll
    for (int r = 0; r < 16; ++r) pmax = fmaxf(pmax, p1[r]);
    { auto rr = __builtin_amdgcn_permlane32_swap(__float_as_uint(pmax), __float_as_uint(pmax), false, false);
      pmax = fmaxf(__uint_as_float(rr[0]), __uint_as_float(rr[1])); }
    if (__builtin_expect(__all(pmax - m_reg <= THR / SCALE), 1)) { mn = m_reg; alpha = 1.f; }
    else { mn = fmaxf(m_reg, pmax); alpha = __builtin_amdgcn_exp2f((m_reg - mn) * C); m_reg = mn; }
    const float mnC = -mn * C;
#pragma unroll
    for (int r = 0; r < 16; ++r) p0[r] = fmaf(p0[r], C, mnC);
#pragma unroll
    for (int r = 0; r < 16; ++r) p1[r] = fmaf(p1[r], C, mnC);
#pragma unroll
    for (int r = 0; r < 16; ++r) p0[r] = __builtin_amdgcn_exp2f(p0[r]);
}
__device__ __forceinline__ void finishSM(f32x16& p0, f32x16& p1, float alpha, float& l_reg, bf16x8& pa0, bf16x8& pa1, bf16x8& pa2, bf16x8& pa3) {
#pragma unroll
    for (int r = 0; r < 16; ++r) p1[r] = __builtin_amdgcn_exp2f(p1[r]);
    float ps = 0;
#pragma unroll
    for (int r = 0; r < 16; ++r) ps += p0[r];
#pragma unroll
    for (int r = 0; r < 16; ++r) ps += p1[r];
    { auto rr = __builtin_amdgcn_permlane32_swap(__float_as_uint(ps), __float_as_uint(ps), false, false);
      ps = __uint_as_float(rr[0]) + __uint_as_float(rr[1]); }
    l_reg = l_reg * alpha + ps;
#define PK4(P, BASE, OUT) do { unsigned a0 = cvt_pk_bf16(P[BASE + 0], P[BASE + 1]), a1 = cvt_pk_bf16(P[BASE + 2], P[BASE + 3]);   \
    unsigned b0 = cvt_pk_bf16(P[BASE + 4], P[BASE + 5]), b1 = cvt_pk_bf16(P[BASE + 6], P[BASE + 7]);                              \
    auto r0 = __builtin_amdgcn_permlane32_swap(a0, b0, false, false); auto r1 = __builtin_amdgcn_permlane32_swap(a1, b1, false, false); \
    u32x4 w = {r0[0], r1[0], r0[1], r1[1]}; OUT = *reinterpret_cast<bf16x8*>(&w); } while (0)
    PK4(p0, 0, pa0); PK4(p0, 8, pa1); PK4(p1, 0, pa2); PK4(p1, 8, pa3);
#undef PK4
}
__device__ __forceinline__ void qkt(f32x16& p0, f32x16& p1, const char* Ks, const bf16x8* qr, int r32, int hi) {
    p0 = f32x16{}; p1 = f32x16{};
    PRIO_HI();
#pragma unroll
    for (int d0 = 0; d0 < 8; ++d0) { const int cb = (d0 * 16 + hi * 8) * 2;
        const bf16x8 b0 = *reinterpret_cast<const bf16x8*>(Ks + KSWZ(r32, cb));
        const bf16x8 b1 = *reinterpret_cast<const bf16x8*>(Ks + KSWZ(32 + r32, cb));
        p0 = __builtin_amdgcn_mfma_f32_32x32x16_bf16(b0, qr[d0], p0, 0, 0, 0);
        p1 = __builtin_amdgcn_mfma_f32_32x32x16_bf16(b1, qr[d0], p1, 0, 0, 0); }
    PRIO_LO();
}
__device__ __forceinline__ int v_st(int k, int c) { const int kk = (k & ~0xC) | ((k & 4) << 1) | ((k & 8) >> 1); return ((kk >> 3) * 4 + (c >> 5)) * 512 + ((kk & 7) * 32 + (c & 31)) * 2; }
__device__ __forceinline__ int v_rd_base(int lane) { return ((lane & 3) << 3) | (((lane >> 2) & 3) << 6) | (((lane >> 4) & 1) << 5) | (((lane >> 5) & 1) << 8); }
constexpr int v_rd_off(int d0, int ks, int half) { return d0 * 512 + ks * 4096 + half * 2048; }
template <int OFF> __device__ __forceinline__ s16x4 tr_read(int vb) {
    s16x4 r; asm volatile("ds_read_b64_tr_b16 %0, %1 offset:%2" : "=&v"(r) : "v"(vb), "i"(OFF) : "memory"); return r;
}
template <int D0> __device__ __forceinline__ void pv_one(f32x16& od, int vb, bf16x8 pa0, bf16x8 pa1, bf16x8 pa2, bf16x8 pa3) {
    const s16x4 l0 = tr_read<v_rd_off(D0, 0, 0)>(vb), h0 = tr_read<v_rd_off(D0, 0, 1)>(vb), l1 = tr_read<v_rd_off(D0, 1, 0)>(vb), h1 = tr_read<v_rd_off(D0, 1, 1)>(vb);
    const s16x4 l2 = tr_read<v_rd_off(D0, 2, 0)>(vb), h2 = tr_read<v_rd_off(D0, 2, 1)>(vb), l3 = tr_read<v_rd_off(D0, 3, 0)>(vb), h3 = tr_read<v_rd_off(D0, 3, 1)>(vb);
    asm volatile("s_waitcnt lgkmcnt(0)" ::: "memory"); SBAR();
#define PK(Lo, Hi) (bf16x8){Lo[0], Lo[1], Lo[2], Lo[3], Hi[0], Hi[1], Hi[2], Hi[3]}
    od = __builtin_amdgcn_mfma_f32_32x32x16_bf16(pa0, PK(l0, h0), od, 0, 0, 0);
    od = __builtin_amdgcn_mfma_f32_32x32x16_bf16(pa1, PK(l1, h1), od, 0, 0, 0);
    od = __builtin_amdgcn_mfma_f32_32x32x16_bf16(pa2, PK(l2, h2), od, 0, 0, 0);
    od = __builtin_amdgcn_mfma_f32_32x32x16_bf16(pa3, PK(l3, h3), od, 0, 0, 0);
#undef PK
}
__device__ __forceinline__ void pv_d0(f32x16* o, int vb, bf16x8 pa0, bf16x8 pa1, bf16x8 pa2, bf16x8 pa3) {
    pv_one<0>(o[0], vb, pa0, pa1, pa2, pa3); pv_one<1>(o[1], vb, pa0, pa1, pa2, pa3); pv_one<2>(o[2], vb, pa0, pa1, pa2, pa3); pv_one<3>(o[3], vb, pa0, pa1, pa2, pa3);
}
__device__ __forceinline__ void mask_tile(f32x16& p0, f32x16& p1, int j, int lim) {
    if (j > lim) {
#pragma unroll
        for (int r = 0; r < 16; ++r) { p0[r] = -1e30f; p1[r] = -1e30f; }
    } else if (j == 0) {
#pragma unroll
        for (int r = 0; r < 16; ++r) p0[r] = -1e30f;
#pragma unroll
        for (int r = 0; r < 8; ++r) p1[r] = -1e30f;
    }
}
__device__ __forceinline__ void unit(const bf16_t* __restrict__ Qb, const bf16_t* __restrict__ Kh, const bf16_t* __restrict__ Vh, bf16_t* __restrict__ Ob, int NT, int lim, char* lds) {
    int tid_ = threadIdx.x; asm volatile("" : "+v"(tid_));
    const int tid = tid_, wid = tid >> 6, lane = tid & 63, r32 = lane & 31, hi = lane >> 5;
    char* V_lds = lds; char* K_lds = lds + 2 * SHM_V;
    float* wsf = (float*)(lds + 2 * SHM_V + 2 * SHM_K) + wid * 64; float* li_l = wsf; float* al_l = wsf + 32;
    float m_reg = -1e30f, l_reg = 0; f32x16 o[4] = {}; bf16x8 qr[8];
    const bf16_t* Qw = Qb + (long)(wid * QBLK + r32) * LDQ + hi * 8;
#pragma unroll
    for (int d0 = 0; d0 < 8; ++d0) qr[d0] = *reinterpret_cast<const bf16x8*>(Qw + d0 * 16);
    const int sr = tid >> 4, sc = (tid & 15) * 8, vst0 = v_st(sr, sc), vst1 = v_st(32 + sr, sc);
    const int vb0 = (int)(uintptr_t)V_lds + v_rd_base(lane);
    struct { bf16x8 vs0, vs1, ks0, ks1; } sr_[2];
#define SLOAD(i, k0) do { sr_[i].vs0 = *reinterpret_cast<const bf16x8*>(&Vh[(long)((k0) + sr) * LDQ + sc]); sr_[i].vs1 = *reinterpret_cast<const bf16x8*>(&Vh[(long)((k0) + 32 + sr) * LDQ + sc]); \
    sr_[i].ks0 = *reinterpret_cast<const bf16x8*>(&Kh[(long)((k0) + sr) * LDQ + sc]); sr_[i].ks1 = *reinterpret_cast<const bf16x8*>(&Kh[(long)((k0) + 32 + sr) * LDQ + sc]); } while (0)
#define SWRITE(b, i) do { *(bf16x8*)(V_lds + (b) * SHM_V + vst0) = sr_[i].vs0;          \
    *(bf16x8*)(V_lds + (b) * SHM_V + vst1) = sr_[i].vs1; int kc = sc * 2;               \
    *(bf16x8*)(K_lds + (b) * SHM_K + KSWZ(sr, kc)) = sr_[i].ks0;                       \
    *(bf16x8*)(K_lds + (b) * SHM_K + KSWZ(32 + sr, kc)) = sr_[i].ks1; } while (0)
#define SWAIT() asm volatile("s_waitcnt vmcnt(4)" ::: "memory")
#define RESC(a) do { if (__any((a) < 1.f)) { if (hi == 0) al_l[r32] = (a); asm volatile("s_waitcnt lgkmcnt(0)" ::: "memory"); \
    _Pragma("unroll") for (int d = 0; d < 4; ++d) _Pragma("unroll") for (int r = 0; r < 16; ++r) o[d][r] *= al_l[crow(r, hi)]; } } while (0)
    f32x16 pA0, pA1, pB0, pB1; float mnA, mnB, alA, alB; bf16x8 pa0, pa1, pa2, pa3;
    constexpr int SE = 0, SO = 1;
    SLOAD(SE, 0); asm volatile("s_waitcnt vmcnt(0)" ::: "memory"); SWRITE(0, SE); __syncthreads();
    qkt(pA0, pA1, K_lds, qr, r32, hi); mask_tile(pA0, pA1, 0, lim); partialSM(pA0, pA1, m_reg, mnA, alA);
    SLOAD(SO, KVBLK); if (2 < NT) SLOAD(SE, 2 * KVBLK);
    SWAIT(); SWRITE(1, SO); __syncthreads();
    for (int j = 1; j + 1 < NT; j += 2) {
        SBAR(); qkt(pB0, pB1, K_lds + SHM_K, qr, r32, hi);
        finishSM(pA0, pA1, alA, l_reg, pa0, pa1, pa2, pa3); SBAR();
        SLOAD(SO, (j + 2) * KVBLK); SBAR();
        pv_d0(o, vb0, pa0, pa1, pa2, pa3); mask_tile(pB0, pB1, j, lim); partialSM(pB0, pB1, m_reg, mnB, alB);
        __syncthreads(); SWAIT(); SWRITE(0, SE);
        RESC(alB); __syncthreads();
        SBAR(); qkt(pA0, pA1, K_lds, qr, r32, hi);
        finishSM(pB0, pB1, alB, l_reg, pa0, pa1, pa2, pa3); SBAR();
        if (j + 3 < NT) SLOAD(SE, (j + 3) * KVBLK); SBAR();
        pv_d0(o, vb0 + SHM_V, pa0, pa1, pa2, pa3); mask_tile(pA0, pA1, j + 1, lim); partialSM(pA0, pA1, m_reg, mnA, alA);
        __syncthreads(); SWAIT(); SWRITE(1, SO);
        RESC(alA); __syncthreads();
    }
    SBAR(); qkt(pB0, pB1, K_lds + SHM_K, qr, r32, hi);
    finishSM(pA0, pA1, alA, l_reg, pa0, pa1, pa2, pa3); SBAR();
    pv_d0(o, vb0, pa0, pa1, pa2, pa3); mask_tile(pB0, pB1, NT - 1, lim); partialSM(pB0, pB1, m_reg, mnB, alB);
    __syncthreads(); RESC(alB);
    finishSM(pB0, pB1, alB, l_reg, pa0, pa1, pa2, pa3); SBAR();
    pv_d0(o, vb0 + SHM_V, pa0, pa1, pa2, pa3);
    if (hi == 0) li_l[r32] = l_reg; asm volatile("s_waitcnt lgkmcnt(0)" ::: "memory");
    float rli[16];
#pragma unroll
    for (int r = 0; r < 16; ++r) rli[r] = __builtin_amdgcn_rcpf(li_l[crow(r, hi)]);
    bf16_t* Ow = Ob + (long)(wid * QBLK) * LDO;
#pragma unroll
    for (int r = 0; r < 16; ++r) { const int orow = crow(r, hi);
#pragma unroll
        for (int d0 = 0; d0 < 4; ++d0) Ow[(long)orow * LDO + d0 * 32 + r32] = f2bf(o[d0][r] * rli[r]); }
    __syncthreads();
#undef SLOAD
#undef SWRITE
#undef SWAIT
#undef RESC
}
}


#ifndef MK_HB
#define MK_HB(w) ((w) >> 2)
#endif
namespace att2 {
using namespace att;
constexpr int KB = 16384, VB = 32768, OFF_V = 3 * KB, OFF_W = OFF_V + 3 * VB, SHM2 = OFF_W + NW * 64 * 4;
constexpr int v2_rd_off(int d0, int ks, int half) { return d0 * 512 + ks * 8192 + half * 4096; }
template <int D0> __device__ __forceinline__ void pv2_one(f32x16& od, int vb, bf16x8 pa0, bf16x8 pa1, bf16x8 pa2, bf16x8 pa3) {
    const s16x4 l0 = tr_read<v2_rd_off(D0, 0, 0)>(vb), h0 = tr_read<v2_rd_off(D0, 0, 1)>(vb), l1 = tr_read<v2_rd_off(D0, 1, 0)>(vb), h1 = tr_read<v2_rd_off(D0, 1, 1)>(vb);
    const s16x4 l2 = tr_read<v2_rd_off(D0, 2, 0)>(vb), h2 = tr_read<v2_rd_off(D0, 2, 1)>(vb), l3 = tr_read<v2_rd_off(D0, 3, 0)>(vb), h3 = tr_read<v2_rd_off(D0, 3, 1)>(vb);
    asm volatile("s_waitcnt lgkmcnt(0)" ::: "memory"); SBAR();
#define PK(Lo, Hi) (bf16x8){Lo[0], Lo[1], Lo[2], Lo[3], Hi[0], Hi[1], Hi[2], Hi[3]}
    od = __builtin_amdgcn_mfma_f32_32x32x16_bf16(pa0, PK(l0, h0), od, 0, 0, 0);
    od = __builtin_amdgcn_mfma_f32_32x32x16_bf16(pa1, PK(l1, h1), od, 0, 0, 0);
    od = __builtin_amdgcn_mfma_f32_32x32x16_bf16(pa2, PK(l2, h2), od, 0, 0, 0);
    od = __builtin_amdgcn_mfma_f32_32x32x16_bf16(pa3, PK(l3, h3), od, 0, 0, 0);
#undef PK
}
struct VFrag { s16x4 l0, h0, l1, h1, l2, h2, l3, h3; };
template <int D0> __device__ __forceinline__ void v2_load(VFrag& f, int vb) {
    f.l0 = tr_read<v2_rd_off(D0, 0, 0)>(vb); f.h0 = tr_read<v2_rd_off(D0, 0, 1)>(vb); f.l1 = tr_read<v2_rd_off(D0, 1, 0)>(vb); f.h1 = tr_read<v2_rd_off(D0, 1, 1)>(vb);
    f.l2 = tr_read<v2_rd_off(D0, 2, 0)>(vb); f.h2 = tr_read<v2_rd_off(D0, 2, 1)>(vb); f.l3 = tr_read<v2_rd_off(D0, 3, 0)>(vb); f.h3 = tr_read<v2_rd_off(D0, 3, 1)>(vb);
}
__device__ __forceinline__ void v2_mma(f32x16& od, const VFrag& f, bf16x8 pa0, bf16x8 pa1, bf16x8 pa2, bf16x8 pa3) {
#define PK(Lo, Hi) (bf16x8){Lo[0], Lo[1], Lo[2], Lo[3], Hi[0], Hi[1], Hi[2], Hi[3]}
    od = __builtin_amdgcn_mfma_f32_32x32x16_bf16(pa0, PK(f.l0, f.h0), od, 0, 0, 0);
    od = __builtin_amdgcn_mfma_f32_32x32x16_bf16(pa1, PK(f.l1, f.h1), od, 0, 0, 0);
    od = __builtin_amdgcn_mfma_f32_32x32x16_bf16(pa2, PK(f.l2, f.h2), od, 0, 0, 0);
    od = __builtin_amdgcn_mfma_f32_32x32x16_bf16(pa3, PK(f.l3, f.h3), od, 0, 0, 0);
#undef PK
}
struct VSet { s16x4 l0, h0, l1, h1, l2, h2, l3, h3; };
template <int G, int KS> __device__ __forceinline__ void vs_load(VSet& f, int vb) {
    f.l0 = tr_read<v2_rd_off(4 * G + 0, KS, 0)>(vb); f.h0 = tr_read<v2_rd_off(4 * G + 0, KS, 1)>(vb); f.l1 = tr_read<v2_rd_off(4 * G + 1, KS, 0)>(vb); f.h1 = tr_read<v2_rd_off(4 * G + 1, KS, 1)>(vb);
    f.l2 = tr_read<v2_rd_off(4 * G + 2, KS, 0)>(vb); f.h2 = tr_read<v2_rd_off(4 * G + 2, KS, 1)>(vb); f.l3 = tr_read<v2_rd_off(4 * G + 3, KS, 0)>(vb); f.h3 = tr_read<v2_rd_off(4 * G + 3, KS, 1)>(vb);
}
template <int G> __device__ __forceinline__ void vs_mma(f32x16* o, const VSet& f, bf16x8 pa) {
#define PK(Lo, Hi) (bf16x8){Lo[0], Lo[1], Lo[2], Lo[3], Hi[0], Hi[1], Hi[2], Hi[3]}
    o[4 * G + 0] = __builtin_amdgcn_mfma_f32_32x32x16_bf16(pa, PK(f.l0, f.h0), o[4 * G + 0], 0, 0, 0);
    o[4 * G + 1] = __builtin_amdgcn_mfma_f32_32x32x16_bf16(pa, PK(f.l1, f.h1), o[4 * G + 1], 0, 0, 0);
    o[4 * G + 2] = __builtin_amdgcn_mfma_f32_32x32x16_bf16(pa, PK(f.l2, f.h2), o[4 * G + 2], 0, 0, 0);
    o[4 * G + 3] = __builtin_amdgcn_mfma_f32_32x32x16_bf16(pa, PK(f.l3, f.h3), o[4 * G + 3], 0, 0, 0);
#undef PK
}
__device__ __forceinline__ void pv2_all(f32x16* o, int vb, bf16x8 pa0, bf16x8 pa1, bf16x8 pa2, bf16x8 pa3) {
    VSet A, B;
#define W8() do { asm volatile("s_waitcnt lgkmcnt(8)" ::: "memory"); SBAR(); } while (0)
    PRIO_HI();
    vs_load<0, 0>(A, vb);
    vs_load<0, 1>(B, vb); W8(); vs_mma<0>(o, A, pa0); SBAR();
    vs_load<0, 2>(A, vb); W8(); vs_mma<0>(o, B, pa1); SBAR();
    vs_load<0, 3>(B, vb); W8(); vs_mma<0>(o, A, pa2); SBAR();
    vs_load<1, 0>(A, vb); W8(); vs_mma<0>(o, B, pa3); SBAR();
    vs_load<1, 1>(B, vb); W8(); vs_mma<1>(o, A, pa0); SBAR();
    vs_load<1, 2>(A, vb); W8(); vs_mma<1>(o, B, pa1); SBAR();
    vs_load<1, 3>(B, vb); W8(); vs_mma<1>(o, A, pa2); SBAR();
    asm volatile("s_waitcnt lgkmcnt(0)" ::: "memory"); SBAR(); vs_mma<1>(o, B, pa3); SBAR();
    PRIO_LO();
#undef W8
}
__device__ __forceinline__ void unit2(const bf16_t* __restrict__ Qb, const bf16_t* __restrict__ Kh, const bf16_t* __restrict__ Vh, bf16_t* __restrict__ Ob, int NT, int lim, unsigned char* ldsg, LAS unsigned char* lds, int rev = 0) {
#define TILE(s_) (rev ? NT - 1 - (s_) : (s_))
    int tid_ = threadIdx.x; asm volatile("" : "+v"(tid_));
    const int tid = tid_, wid = __builtin_amdgcn_readfirstlane(tid >> 6), lane = tid & 63, r32 = lane & 31, hi = lane >> 5;
    LAS float* wsf = (LAS float*)(lds + OFF_W) + wid * 64; LAS float* li_l = wsf; LAS float* al_l = wsf + 32;
    float m_reg = -1e30f, l_reg = 0; f32x16 o[8] = {}; bf16x8 qr[8];
    const bf16_t* Qw = Qb + (long)(wid * QBLK + r32) * LDQ + hi * 8;
#pragma unroll
    for (int d0 = 0; d0 < 8; ++d0) qr[d0] = *reinterpret_cast<const bf16x8*>(Qw + d0 * 16);
    const int vb0 = (int)(uintptr_t)(ldsg + OFF_V) + v_rd_base(lane);
    unsigned ko0, vo0;
    { const int row = wid * 4 + (lane >> 4); ko0 = (unsigned)(row * LDQ * 2 + (((lane & 15) * 16) ^ ((row & MK_KSWM) << 4)));
      const int st = wid * 2 + (lane >> 5), q = lane & 31; const int kk = (st >> 3) * 8 + (q >> 2); const int k = (kk & ~0xC) | ((kk & 4) << 1) | ((kk & 8) >> 1);
      vo0 = (unsigned)(k * LDQ * 2 + ((st & 7) * 32 + (q & 3) * 8) * 2); }
#define DMA_K(t_, b_) do { const char* gk = (const char*)Kh + (size_t)(t_) * (KVBLK * LDQ * 2); _Pragma("unroll") for (int i = 0; i < 2; ++i) { \
        __builtin_amdgcn_global_load_lds((const unsigned*)(gk + (size_t)i * (32 * LDQ * 2) + ko0), (LAS unsigned*)(lds + (b_) * KB + wid * 1024 + i * 8192), 16, 0, 0); } } while (0)
#define DMA_V(t_, b_) do { const char* gv = (const char*)Vh + (size_t)(t_) * (KVBLK * LDQ * 2); _Pragma("unroll") for (int i = 0; i < 4; ++i) { \
        __builtin_amdgcn_global_load_lds((const unsigned*)(gv + (size_t)i * (16 * LDQ * 2) + vo0), (LAS unsigned*)(lds + OFF_V + (b_) * VB + wid * 1024 + i * 8192), 16, 0, 0); } } while (0)
    DMA_K(TILE(0), 0); DMA_V(TILE(0), 0); if (1 < NT) { DMA_K(TILE(1), 1); DMA_V(TILE(1), 1); }
    asm volatile("s_waitcnt vmcnt(0)" ::: "memory"); __builtin_amdgcn_s_barrier(); asm volatile("" ::: "memory");
    int kb = 0;
    for (int j = 0; j < NT; ++j) {
        const int kb2 = kb == 0 ? 2 : kb - 1;
        const int tl = TILE(j);
        if (j + 2 < NT) DMA_V(TILE(j + 2), kb2);
        asm volatile("" ::: "memory");
        if (j + 2 < NT) DMA_K(TILE(j + 2), kb2);
        asm volatile("" ::: "memory");
        if (tl <= lim) {
        f32x16 p0, p1; float mn, alpha; bf16x8 pa0, pa1, pa2, pa3;
        qkt(p0, p1, (const char*)ldsg + kb * KB, qr, r32, hi);
#if MK_PROBE_QK2
        asm volatile("" : "+v"(p0), "+v"(p1)); qkt(p0, p1, (const char*)ldsg + kb * KB, qr, r32, hi);
#endif
        if (tl == 0) {
            asm volatile("; tile-0 mask" ::: "memory");
#pragma unroll
            for (int r = 0; r < 16; ++r) p0[r] = -1e30f;
#pragma unroll
            for (int r = 0; r < 8; ++r) p1[r] = -1e30f;
        }
        partialSM(p0, p1, m_reg, mn, alpha);
        if (__any(alpha < 1.f)) { if (hi == 0) al_l[r32] = alpha; asm volatile("s_waitcnt lgkmcnt(0)" ::: "memory");
#pragma unroll
            for (int d = 0; d < 8; ++d)
#pragma unroll
                for (int r = 0; r < 16; ++r) o[d][r] *= al_l[crow(r, hi)]; }
        finishSM(p0, p1, alpha, l_reg, pa0, pa1, pa2, pa3); SBAR();
        const int vb = vb0 + kb * VB;
        pv2_all(o, vb, pa0, pa1, pa2, pa3);
        }
        if (j + 2 < NT) asm volatile("s_waitcnt vmcnt(6)" ::: "memory"); else asm volatile("s_waitcnt vmcnt(0)" ::: "memory");
        __builtin_amdgcn_s_barrier(); asm volatile("" ::: "memory");
        kb = kb == 2 ? 0 : kb + 1;
    }
    if (hi == 0) li_l[r32] = l_reg; asm volatile("s_waitcnt lgkmcnt(0)" ::: "memory");
    float rli[16];
#pragma unroll
    for (int r = 0; r < 16; ++r) rli[r] = __builtin_amdgcn_rcpf(li_l[crow(r, hi)]);
    bf16_t* Ow = Ob + (long)(wid * QBLK) * LDO;
#pragma unroll
    for (int r = 0; r < 16; ++r) { const int orow = crow(r, hi);
#pragma unroll
        for (int d0 = 0; d0 < 8; ++d0) Ow[(long)orow * LDO + d0 * 32 + r32] = f2bf(o[d0][r] * rli[r]); }
    asm volatile("s_waitcnt lgkmcnt(0)" ::: "memory"); __builtin_amdgcn_s_barrier(); asm volatile("" ::: "memory");
#undef DMA_K
#undef DMA_V
#undef TILE
}

__device__ __forceinline__ void unit3(const bf16_t* __restrict__ Qb, const bf16_t* __restrict__ Kh, const bf16_t* __restrict__ Vh, bf16_t* __restrict__ Ob, int NT, int lim, unsigned char* ldsg, LAS unsigned char* lds) {
    int tid_ = threadIdx.x; asm volatile("" : "+v"(tid_));
    const int tid = tid_, wid = __builtin_amdgcn_readfirstlane(tid >> 6), lane = tid & 63, r32 = lane & 31, hi = lane >> 5, hb = MK_HB(wid);
    LAS float* wsf = (LAS float*)(lds + OFF_W) + wid * 64; LAS float* li_l = wsf; LAS float* al_l = wsf + 32;
    float m_reg = -1e30f, l_reg = 0; f32x16 o[8] = {}; bf16x8 qr[8];
    const bf16_t* Qw = Qb + (long)(wid * QBLK + r32) * LDQ + hi * 8;
#pragma unroll
    for (int d0 = 0; d0 < 8; ++d0) qr[d0] = *reinterpret_cast<const bf16x8*>(Qw + d0 * 16);
#define DMA_K(t_, b_) do { const char* gk = (const char*)Kh + (size_t)(t_) * (KVBLK * LDQ * 2); int ln_ = lane; asm volatile("" : "+v"(ln_)); _Pragma("unroll") for (int i = 0; i < 2; ++i) { \
        const int row = wid * 4 + i * 32 + (ln_ >> 4); const unsigned ko = (unsigned)(row * LDQ * 2 + (((ln_ & 15) * 16) ^ ((row & MK_KSWM) << 4))); \
        __builtin_amdgcn_global_load_lds((const unsigned*)(gk + ko), (LAS unsigned*)(lds + (b_) * KB + wid * 1024 + i * 8192), 16, 0, 0); } } while (0)
#define DMA_V(t_, b_) do { const char* gv = (const char*)Vh + (size_t)(t_) * (KVBLK * LDQ * 2); int ln_ = lane; asm volatile("" : "+v"(ln_)); _Pragma("unroll") for (int i = 0; i < 4; ++i) { \
        const int st = wid * 2 + i * 16 + (ln_ >> 5), q = ln_ & 31; const int kk = (st >> 3) * 8 + (q >> 2); const int k = (kk & ~0xC) | ((kk & 4) << 1) | ((kk & 8) >> 1); \
        const unsigned vo = (unsigned)(k * LDQ * 2 + ((st & 7) * 32 + (q & 3) * 8) * 2); \
        __builtin_amdgcn_global_load_lds((const unsigned*)(gv + vo), (LAS unsigned*)(lds + OFF_V + (b_) * VB + wid * 1024 + i * 8192), 16, 0, 0); } } while (0)
    DMA_K(0, 0); DMA_V(0, 0); if (1 < NT) { DMA_K(1, 1); DMA_V(1, 1); }
    asm volatile("s_waitcnt vmcnt(0)" ::: "memory"); __builtin_amdgcn_s_barrier(); asm volatile("" ::: "memory");
    bf16x8 pa0, pa1, pa2, pa3;
    int kq = 0, ki = 2;
    int vq = 0, vi = 2;
#define U3_QS(j_) do { f32x16 p0, p1; float mn, alpha; int lq_ = lane; asm volatile("" : "+v"(lq_)); const int r32 = lq_ & 31, hi = lq_ >> 5; \
        qkt(p0, p1, (const char*)ldsg + kq * KB, qr, r32, hi); kq = kq == 2 ? 0 : kq + 1; \
        mask_tile(p0, p1, (j_), lim); \
        partialSM(p0, p1, m_reg, mn, alpha); \
        if (__any(alpha < 1.f)) { if (hi == 0) al_l[r32] = alpha; asm volatile("s_waitcnt lgkmcnt(0)" ::: "memory"); \
            _Pragma("unroll") for (int d = 0; d < 8; ++d) _Pragma("unroll") for (int r = 0; r < 16; ++r) o[d][r] *= al_l[crow(r, hi)]; } \
        finishSM(p0, p1, alpha, l_reg, pa0, pa1, pa2, pa3); } while (0)
#define U3_PV(j_) do { int lp_ = lane; asm volatile("" : "+v"(lp_)); const int vb = (int)(uintptr_t)(ldsg + OFF_V) + v_rd_base(lp_) + vq * VB; vq = vq == 2 ? 0 : vq + 1; \
        pv2_one<0>(o[0], vb, pa0, pa1, pa2, pa3); pv2_one<1>(o[1], vb, pa0, pa1, pa2, pa3); pv2_one<2>(o[2], vb, pa0, pa1, pa2, pa3); pv2_one<3>(o[3], vb, pa0, pa1, pa2, pa3); \
        pv2_one<4>(o[4], vb, pa0, pa1, pa2, pa3); pv2_one<5>(o[5], vb, pa0, pa1, pa2, pa3); pv2_one<6>(o[6], vb, pa0, pa1, pa2, pa3); pv2_one<7>(o[7], vb, pa0, pa1, pa2, pa3); } while (0)
#define U3_EVEN_ISSUE(jj_) do { if ((jj_) + 2 < NT) DMA_K((jj_) + 2, ki); ki = ki == 2 ? 0 : ki + 1; asm volatile("" ::: "memory"); } while (0)
#define U3_ODD_ISSUE(jj_) do { if ((jj_) + 2 < NT) DMA_V((jj_) + 2, vi); vi = vi == 2 ? 0 : vi + 1; asm volatile("" ::: "memory"); } while (0)
#define U3_EVEN_END(jj_) do { if ((jj_) + 2 < NT) asm volatile("s_waitcnt vmcnt(6)" ::: "memory"); else if ((jj_) + 1 < NT) asm volatile("s_waitcnt vmcnt(4)" ::: "memory"); else asm volatile("s_waitcnt vmcnt(0)" ::: "memory");   \
        asm volatile("s_waitcnt lgkmcnt(0)" ::: "memory"); __builtin_amdgcn_s_barrier(); asm volatile("" ::: "memory"); } while (0)
#define U3_ODD_END() do { asm volatile("s_waitcnt lgkmcnt(0)" ::: "memory"); __builtin_amdgcn_s_barrier(); asm volatile("" ::: "memory"); } while (0)
    if (hb == 0) {
#pragma unroll 1
        for (int jj = 0; jj < NT; ++jj) {
            U3_EVEN_ISSUE(jj); U3_QS(jj); U3_EVEN_END(jj);
            U3_ODD_ISSUE(jj); U3_PV(jj); U3_ODD_END();
        }
        U3_EVEN_ISSUE(NT); U3_EVEN_END(NT);
    } else {
        U3_EVEN_ISSUE(0); U3_EVEN_END(0);
#pragma unroll 1
        for (int jj = 0; jj < NT; ++jj) {
            U3_ODD_ISSUE(jj); U3_QS(jj); U3_ODD_END();
            U3_EVEN_ISSUE(jj + 1); U3_PV(jj); U3_EVEN_END(jj + 1);
        }
    }
#undef U3_QS
#undef U3_PV
#undef U3_EVEN_ISSUE
#undef U3_ODD_ISSUE
#undef U3_EVEN_END
#undef U3_ODD_END
    if (hi == 0) li_l[r32] = l_reg; asm volatile("s_waitcnt lgkmcnt(0)" ::: "memory");
    float rli[16];
#pragma unroll
    for (int r = 0; r < 16; ++r) rli[r] = __builtin_amdgcn_rcpf(li_l[crow(r, hi)]);
    bf16_t* Ow = Ob + (long)(wid * QBLK) * LDO;
#pragma unroll
    for (int r = 0; r < 16; ++r) { const int orow = crow(r, hi);
#pragma unroll
        for (int d0 = 0; d0 < 8; ++d0) Ow[(long)orow * LDO + d0 * 32 + r32] = f2bf(o[d0][r] * rli[r]); }
    asm volatile("s_waitcnt vmcnt(0) lgkmcnt(0)" ::: "memory"); __builtin_amdgcn_s_barrier(); asm volatile("" ::: "memory");
#undef DMA_K
#undef DMA_V
}

__device__ __forceinline__ void unit4(const bf16_t* __restrict__ Qb, const bf16_t* __restrict__ Kh, const bf16_t* __restrict__ Vh, bf16_t* __restrict__ Ob, int NT, int lim, unsigned char* ldsg, LAS unsigned char* lds) {
    int tid_ = threadIdx.x; asm volatile("" : "+v"(tid_));
    const int tid = tid_, wid = __builtin_amdgcn_readfirstlane(tid >> 6), lane = tid & 63, hb = MK_HB(wid);
    LAS float* wsf = (LAS float*)(lds + OFF_W) + wid * 64; LAS float* li_l = wsf; LAS float* al_l = wsf + 32;
    float m_reg = -1e30f, l_reg = 0; f32x16 o[8] = {}; bf16x8 qr[8];
    { const int r32 = lane & 31, hi = lane >> 5; const bf16_t* Qw = Qb + (long)(wid * QBLK + r32) * LDQ + hi * 8;
#pragma unroll
      for (int d0 = 0; d0 < 8; ++d0) qr[d0] = *reinterpret_cast<const bf16x8*>(Qw + d0 * 16); }
#define DMA_K(t_, b_) do { const char* gk = (const char*)Kh + (size_t)(t_) * (KVBLK * LDQ * 2); int ln_ = lane; asm volatile("" : "+v"(ln_)); _Pragma("unroll") for (int i = 0; i < 2; ++i) { \
        const int row = wid * 4 + i * 32 + (ln_ >> 4); const unsigned ko = (unsigned)(row * LDQ * 2 + (((ln_ & 15) * 16) ^ ((row & MK_KSWM) << 4))); \
        __builtin_amdgcn_global_load_lds((const unsigned*)(gk + ko), (LAS unsigned*)(lds + (b_) * KB + wid * 1024 + i * 8192), 16, 0, 0); } } while (0)
#define DMA_V(t_, b_) do { const char* gv = (const char*)Vh + (size_t)(t_) * (KVBLK * LDQ * 2); int ln_ = lane; asm volatile("" : "+v"(ln_)); _Pragma("unroll") for (int i = 0; i < 4; ++i) { \
        const int st = wid * 2 + i * 16 + (ln_ >> 5), q = ln_ & 31; const int kk = (st >> 3) * 8 + (q >> 2); const int k = (kk & ~0xC) | ((kk & 4) << 1) | ((kk & 8) >> 1); \
        const unsigned vo = (unsigned)(k * LDQ * 2 + ((st & 7) * 32 + (q & 3) * 8) * 2); \
        __builtin_amdgcn_global_load_lds((const unsigned*)(gv + vo), (LAS unsigned*)(lds + OFF_V + (b_) * VB + wid * 1024 + i * 8192), 16, 0, 0); } } while (0)
    DMA_K(0, 0); DMA_V(0, 0); if (1 < NT) { DMA_K(1, 1); DMA_V(1, 1); } if (2 < NT) DMA_K(2, 2);
    asm volatile("s_waitcnt vmcnt(0)" ::: "memory"); __builtin_amdgcn_s_barrier(); asm volatile("" ::: "memory");
    f32x16 p0, p1; bf16x8 pa0, pa1, pa2, pa3;
    int kq = 0, ki = 0, vq = 0, vi = 2;
#define U4_QK() do { int lq_ = lane; asm volatile("" : "+v"(lq_)); qkt(p0, p1, (const char*)ldsg + kq * KB, qr, lq_ & 31, lq_ >> 5); kq = kq == 2 ? 0 : kq + 1; } while (0)
#define U4_SM(j_) do { float mn, alpha; int lq_ = lane; asm volatile("" : "+v"(lq_)); const int r32 = lq_ & 31, hi = lq_ >> 5; \
        mask_tile(p0, p1, (j_), lim); \
        partialSM(p0, p1, m_reg, mn, alpha); \
        if (__any(alpha < 1.f)) { if (hi == 0) al_l[r32] = alpha; asm volatile("s_waitcnt lgkmcnt(0)" ::: "memory"); \
            _Pragma("unroll") for (int d = 0; d < 8; ++d) _Pragma("unroll") for (int r = 0; r < 16; ++r) o[d][r] *= al_l[crow(r, hi)]; } \
        finishSM(p0, p1, alpha, l_reg, pa0, pa1, pa2, pa3); } while (0)
#define U4_PV() do { int lp_ = lane; asm volatile("" : "+v"(lp_)); const int vb = (int)(uintptr_t)(ldsg + OFF_V) + v_rd_base(lp_) + vq * VB; vq = vq == 2 ? 0 : vq + 1; \
        pv2_all(o, vb, pa0, pa1, pa2, pa3); } while (0)
#define U4_ISSUE(s_) do { if (((s_) & 1) == 0) { if ((s_) >= 2) { if ((s_) / 2 + 2 < NT) DMA_K((s_) / 2 + 2, ki); ki = ki == 2 ? 0 : ki + 1; } } \
        else { if ((s_) >= 3) { if (((s_) + 1) / 2 < NT) DMA_V(((s_) + 1) / 2, vi); vi = vi == 2 ? 0 : vi + 1; } } asm volatile("" ::: "memory"); } while (0)
#define U4_END(s_) do { if ((s_) & 1) { const int kt = ((s_) + 1) / 2 + 1, vt = ((s_) + 1) / 2;     \
            if ((s_) >= 3 && kt < NT && vt < NT) asm volatile("s_waitcnt vmcnt(6)" ::: "memory"); \
            else if ((s_) >= 3 && vt < NT) asm volatile("s_waitcnt vmcnt(4)" ::: "memory"); \
            else asm volatile("s_waitcnt vmcnt(0)" ::: "memory"); } \
        asm volatile("s_waitcnt lgkmcnt(0)" ::: "memory"); __builtin_amdgcn_s_barrier(); asm volatile("" ::: "memory"); } while (0)
    if (hb == 0) {
        U4_ISSUE(0); U4_QK(); U4_END(0);
#pragma unroll 1
        for (int m = 0; m < NT; ++m) {
            U4_ISSUE(2 * m + 1); U4_SM(m); U4_END(2 * m + 1);
            U4_ISSUE(2 * m + 2); U4_PV(); if (m + 1 < NT) U4_QK(); U4_END(2 * m + 2);
        }
        U4_ISSUE(2 * NT + 1); U4_END(2 * NT + 1);
    } else {
        U4_ISSUE(0); U4_END(0);
        U4_ISSUE(1); U4_QK(); U4_END(1);
#pragma unroll 1
        for (int m = 0; m < NT; ++m) {
            U4_ISSUE(2 * m + 2); U4_SM(m); U4_END(2 * m + 2);
            U4_ISSUE(2 * m + 3); U4_PV(); if (m + 1 < NT) U4_QK(); U4_END(2 * m + 3);
        }
    }
#undef U4_QK
#undef U4_SM
#undef U4_PV
#undef U4_ISSUE
#undef U4_END
    const int r32 = lane & 31, hi = lane >> 5;
    if (hi == 0) li_l[r32] = l_reg; asm volatile("s_waitcnt lgkmcnt(0)" ::: "memory");
    float rli[16];
#pragma unroll
    for (int r = 0; r < 16; ++r) rli[r] = __builtin_amdgcn_rcpf(li_l[crow(r, hi)]);
    bf16_t* Ow = Ob + (long)(wid * QBLK) * LDO;
#pragma unroll
    for (int r = 0; r < 16; ++r) { const int orow = crow(r, hi);
#pragma unroll
        for (int d0 = 0; d0 < 8; ++d0) Ow[(long)orow * LDO + d0 * 32 + r32] = f2bf(o[d0][r] * rli[r]); }
    asm volatile("s_waitcnt vmcnt(0) lgkmcnt(0)" ::: "memory"); __builtin_amdgcn_s_barrier(); asm volatile("" ::: "memory");
#undef DMA_K
#undef DMA_V
}

__device__ __forceinline__ void unit5(const bf16_t* __restrict__ Qb, const bf16_t* __restrict__ Kh, const bf16_t* __restrict__ Vh, bf16_t* __restrict__ Ob, int NT, int lim, unsigned char* ldsg, LAS unsigned char* lds) {
    int tid_ = threadIdx.x; asm volatile("" : "+v"(tid_));
    const int tid = tid_, wid = __builtin_amdgcn_readfirstlane(tid >> 6), lane = tid & 63, hb = MK_HB(wid);
    LAS float* wsf = (LAS float*)(lds + OFF_W) + wid * 64; LAS float* li_l = wsf; LAS float* al_l = wsf + 32;
    float m_reg = -1e30f, l_reg = 0; f32x16 o[8] = {}; bf16x8 qr[8];
    { const int r32 = lane & 31, hi = lane >> 5; const bf16_t* Qw = Qb + (long)(wid * QBLK + r32) * LDQ + hi * 8;
#pragma unroll
      for (int d0 = 0; d0 < 8; ++d0) qr[d0] = *reinterpret_cast<const bf16x8*>(Qw + d0 * 16); }
#define DMA_K(t_, b_) do { const char* gk = (const char*)Kh + (size_t)(t_) * (KVBLK * LDQ * 2); int ln_ = lane; asm volatile("" : "+v"(ln_)); _Pragma("unroll") for (int i = 0; i < 2; ++i) { \
        const int row = wid * 4 + i * 32 + (ln_ >> 4); const unsigned ko = (unsigned)(row * LDQ * 2 + (((ln_ & 15) * 16) ^ ((row & MK_KSWM) << 4))); \
        __builtin_amdgcn_global_load_lds((const unsigned*)(gk + ko), (LAS unsigned*)(lds + (b_) * KB + wid * 1024 + i * 8192), 16, 0, 0); } } while (0)
#define DMA_V(t_, b_) do { const char* gv = (const char*)Vh + (size_t)(t_) * (KVBLK * LDQ * 2); int ln_ = lane; asm volatile("" : "+v"(ln_)); _Pragma("unroll") for (int i = 0; i < 4; ++i) { \
        const int st = wid * 2 + i * 16 + (ln_ >> 5), q = ln_ & 31; const int kk = (st >> 3) * 8 + (q >> 2); const int k = (kk & ~0xC) | ((kk & 4) << 1) | ((kk & 8) >> 1); \
        const unsigned vo = (unsigned)(k * LDQ * 2 + ((st & 7) * 32 + (q & 3) * 8) * 2); \
        __builtin_amdgcn_global_load_lds((const unsigned*)(gv + vo), (LAS unsigned*)(lds + OFF_V + (b_) * VB + wid * 1024 + i * 8192), 16, 0, 0); } } while (0)
    DMA_K(0, 0); DMA_V(0, 0); if (1 < NT) DMA_K(1, 1);
    asm volatile("s_waitcnt vmcnt(0)" ::: "memory"); __builtin_amdgcn_s_barrier(); asm volatile("" ::: "memory");
    bf16x8 pa0, pa1, pa2, pa3;
    int kb = 0, kb1 = 1, kb2 = 2;
#define U5_ISSUE(j_) do { if ((j_) + 1 < NT) DMA_V((j_) + 1, kb1); asm volatile("" ::: "memory"); if ((j_) + 2 < NT) DMA_K((j_) + 2, kb2); asm volatile("" ::: "memory"); } while (0)
#define U5_QS(j_) do { f32x16 p0, p1; float mn, alpha; int lq_ = lane; asm volatile("" : "+v"(lq_)); const int r32 = lq_ & 31, hi = lq_ >> 5; \
        qkt(p0, p1, (const char*)ldsg + kb * KB, qr, r32, hi); \
        mask_tile(p0, p1, (j_), lim); \
        partialSM(p0, p1, m_reg, mn, alpha); \
        if (__any(alpha < 1.f)) { if (hi == 0) al_l[r32] = alpha; asm volatile("s_waitcnt lgkmcnt(0)" ::: "memory"); \
            _Pragma("unroll") for (int d = 0; d < 8; ++d) _Pragma("unroll") for (int r = 0; r < 16; ++r) o[d][r] *= al_l[crow(r, hi)]; } \
        finishSM(p0, p1, alpha, l_reg, pa0, pa1, pa2, pa3); } while (0)
#define U5_PV(vbuf_) do { int lp_ = lane; asm volatile("" : "+v"(lp_)); const int vb = (int)(uintptr_t)(ldsg + OFF_V) + v_rd_base(lp_) + (vbuf_) * VB; pv2_all(o, vb, pa0, pa1, pa2, pa3); } while (0)
#define U5_END(j_) do { if ((j_) + 2 < NT) asm volatile("s_waitcnt vmcnt(2)" ::: "memory"); else asm volatile("s_waitcnt vmcnt(0)" ::: "memory"); \
        asm volatile("s_waitcnt lgkmcnt(0)" ::: "memory"); __builtin_amdgcn_s_barrier(); asm volatile("" ::: "memory"); \
        { const int t_ = kb; kb = kb1; kb1 = kb2; kb2 = t_; } } while (0)
    if (hb == 0) {
#pragma unroll 1
        for (int j = 0; j < NT; ++j) { U5_ISSUE(j); U5_QS(j); U5_PV(kb); U5_END(j); }
    } else {
#pragma unroll 1
        for (int j = 0; j < NT; ++j) { U5_ISSUE(j); if (j > 0) U5_PV(kb2); U5_QS(j); U5_END(j); }
        U5_PV(kb2);
    }
#undef U5_ISSUE
#undef U5_QS
#undef U5_PV
#undef U5_END
    const int r32 = lane & 31, hi = lane >> 5;
    if (hi == 0) li_l[r32] = l_reg; asm volatile("s_waitcnt lgkmcnt(0)" ::: "memory");
    float rli[16];
#pragma unroll
    for (int r = 0; r < 16; ++r) rli[r] = __builtin_amdgcn_rcpf(li_l[crow(r, hi)]);
    bf16_t* Ow = Ob + (long)(wid * QBLK) * LDO;
#pragma unroll
    for (int r = 0; r < 16; ++r) { const int orow = crow(r, hi);
#pragma unroll
        for (int d0 = 0; d0 < 8; ++d0) Ow[(long)orow * LDO + d0 * 32 + r32] = f2bf(o[d0][r] * rli[r]); }
    asm volatile("s_waitcnt vmcnt(0) lgkmcnt(0)" ::: "memory"); __builtin_amdgcn_s_barrier(); asm volatile("" ::: "memory");
#undef DMA_K
#undef DMA_V
}

constexpr int v6_off(int c, int cb, int h) { return c * 16384 + h * 8192 + cb * 256; }
struct V6Set { s16x4 l0, h0, l1, h1, l2, h2, l3, h3; };
template <int C, int G> __device__ __forceinline__ void v6_load(V6Set& f, int vb) {
    f.l0 = tr_read<v6_off(C, 4 * G + 0, 0)>(vb); f.h0 = tr_read<v6_off(C, 4 * G + 0, 1)>(vb); f.l1 = tr_read<v6_off(C, 4 * G + 1, 0)>(vb); f.h1 = tr_read<v6_off(C, 4 * G + 1, 1)>(vb);
    f.l2 = tr_read<v6_off(C, 4 * G + 2, 0)>(vb); f.h2 = tr_read<v6_off(C, 4 * G + 2, 1)>(vb); f.l3 = tr_read<v6_off(C, 4 * G + 3, 0)>(vb); f.h3 = tr_read<v6_off(C, 4 * G + 3, 1)>(vb);
}
template <int G> __device__ __forceinline__ void v6_mma(f32x4 (&o)[2][16], const V6Set& f, bf16x8 pa0, bf16x8 pa1) {
#define PK(Lo, Hi) (bf16x8){Lo[0], Lo[1], Lo[2], Lo[3], Hi[0], Hi[1], Hi[2], Hi[3]}
    o[0][4 * G + 0] = __builtin_amdgcn_mfma_f32_16x16x32_bf16(pa0, PK(f.l0, f.h0), o[0][4 * G + 0], 0, 0, 0);
    o[1][4 * G + 0] = __builtin_amdgcn_mfma_f32_16x16x32_bf16(pa1, PK(f.l0, f.h0), o[1][4 * G + 0], 0, 0, 0);
    o[0][4 * G + 1] = __builtin_amdgcn_mfma_f32_16x16x32_bf16(pa0, PK(f.l1, f.h1), o[0][4 * G + 1], 0, 0, 0);
    o[1][4 * G + 1] = __builtin_amdgcn_mfma_f32_16x16x32_bf16(pa1, PK(f.l1, f.h1), o[1][4 * G + 1], 0, 0, 0);
    o[0][4 * G + 2] = __builtin_amdgcn_mfma_f32_16x16x32_bf16(pa0, PK(f.l2, f.h2), o[0][4 * G + 2], 0, 0, 0);
    o[1][4 * G + 2] = __builtin_amdgcn_mfma_f32_16x16x32_bf16(pa1, PK(f.l2, f.h2), o[1][4 * G + 2], 0, 0, 0);
    o[0][4 * G + 3] = __builtin_amdgcn_mfma_f32_16x16x32_bf16(pa0, PK(f.l3, f.h3), o[0][4 * G + 3], 0, 0, 0);
    o[1][4 * G + 3] = __builtin_amdgcn_mfma_f32_16x16x32_bf16(pa1, PK(f.l3, f.h3), o[1][4 * G + 3], 0, 0, 0);
#undef PK
}
__device__ __forceinline__ void pv6_all(f32x4 (&o)[2][16], int vb, bf16x8 pa00, bf16x8 pa01, bf16x8 pa10, bf16x8 pa11) {
    V6Set A, B;
#define W8() do { asm volatile("s_waitcnt lgkmcnt(8)" ::: "memory"); SBAR(); } while (0)
    v6_load<0, 0>(A, vb);
    v6_load<0, 1>(B, vb); W8(); v6_mma<0>(o, A, pa00, pa10); SBAR();
    v6_load<0, 2>(A, vb); W8(); v6_mma<1>(o, B, pa00, pa10); SBAR();
    v6_load<0, 3>(B, vb); W8(); v6_mma<2>(o, A, pa00, pa10); SBAR();
    v6_load<1, 0>(A, vb); W8(); v6_mma<3>(o, B, pa00, pa10); SBAR();
    v6_load<1, 1>(B, vb); W8(); v6_mma<0>(o, A, pa01, pa11); SBAR();
    v6_load<1, 2>(A, vb); W8(); v6_mma<1>(o, B, pa01, pa11); SBAR();
    v6_load<1, 3>(B, vb); W8(); v6_mma<2>(o, A, pa01, pa11); SBAR();
    asm volatile("s_waitcnt lgkmcnt(0)" ::: "memory"); SBAR(); v6_mma<3>(o, B, pa01, pa11); SBAR();
#undef W8
}
#ifndef MK_X16SWAP
#define MK_X16SWAP 0
#endif
__device__ __forceinline__ float grp_max(float v) {
#if MK_X16SWAP
    { auto rr = __builtin_amdgcn_permlane16_swap(__float_as_uint(v), __float_as_uint(v), false, false); v = fmaxf(__uint_as_float(rr[0]), __uint_as_float(rr[1])); }
#else
    v = fmaxf(v, __shfl_xor(v, 16));
#endif
    { auto rr = __builtin_amdgcn_permlane32_swap(__float_as_uint(v), __float_as_uint(v), false, false); v = fmaxf(__uint_as_float(rr[0]), __uint_as_float(rr[1])); }
    return v;
}
__device__ __forceinline__ float grp_sum(float v) {
#if MK_X16SWAP
    { auto rr = __builtin_amdgcn_permlane16_swap(__float_as_uint(v), __float_as_uint(v), false, false); v = __uint_as_float(rr[0]) + __uint_as_float(rr[1]); }
#else
    v += __shfl_xor(v, 16);
#endif
    { auto rr = __builtin_amdgcn_permlane32_swap(__float_as_uint(v), __float_as_uint(v), false, false); v = __uint_as_float(rr[0]) + __uint_as_float(rr[1]); }
    return v;
}
__device__ __forceinline__ void unit6(const bf16_t* __restrict__ Qb, const bf16_t* __restrict__ Kh, const bf16_t* __restrict__ Vh, bf16_t* __restrict__ Ob, int NT, int lim, unsigned char* ldsg, LAS unsigned char* lds) {
    int tid_ = threadIdx.x; asm volatile("" : "+v"(tid_));
    const int tid = tid_, wid = __builtin_amdgcn_readfirstlane(tid >> 6), lane = tid & 63, c16 = lane & 15, g = lane >> 4;
    LAS float* wsf = (LAS float*)(lds + OFF_W) + wid * 64; LAS float* li_l = wsf; LAS float* al_l = wsf + 32;
    float m0 = -1e30f, m1 = -1e30f, l0 = 0.f, l1 = 0.f;
    f32x4 o[2][16];
#pragma unroll
    for (int qb = 0; qb < 2; ++qb)
#pragma unroll
        for (int cb = 0; cb < 16; ++cb) o[qb][cb] = (f32x4){0.f, 0.f, 0.f, 0.f};
    bf16x8 qr[2][4];
    { const bf16_t* Qw = Qb + (long)(wid * QBLK + c16) * LDQ + g * 8;
#pragma unroll
      for (int qb = 0; qb < 2; ++qb)
#pragma unroll
          for (int ds = 0; ds < 4; ++ds) qr[qb][ds] = *reinterpret_cast<const bf16x8*>(Qw + (long)qb * 16 * LDQ + ds * 32); }
    const int ka0 = c16 * 256 + ((g * 16) ^ (c16 << 4));
    const int vb0 = (int)(uintptr_t)(ldsg + OFF_V) + (g >> 1) * 4096 + (g & 1) * 128 + (c16 >> 2) * 32 + (c16 & 3) * 8;
    unsigned ko0, vo0;
    { const int row = wid * 4 + (lane >> 4); ko0 = (unsigned)(row * LDQ * 2 + (((lane & 15) * 16) ^ ((row & 15) << 4)));
      const int key = (wid >> 2) * 8 + ((lane & 15) >> 1), col = (4 * (wid & 3) + (lane >> 4)) * 16 + (lane & 1) * 8;
      vo0 = (unsigned)(key * LDQ * 2 + col * 2); }
#define DMA_K(t_, b_) do { const char* gk = (const char*)Kh + (size_t)(t_) * (KVBLK * LDQ * 2); _Pragma("unroll") for (int i = 0; i < 2; ++i) { \
        __builtin_amdgcn_global_load_lds((const unsigned*)(gk + (size_t)i * (32 * LDQ * 2) + ko0), (LAS unsigned*)(lds + (b_) * KB + wid * 1024 + i * 8192), 16, 0, 0); } } while (0)
#define DMA_V(t_, b_) do { const char* gv = (const char*)Vh + (size_t)(t_) * (KVBLK * LDQ * 2); _Pragma("unroll") for (int i = 0; i < 4; ++i) { \
        __builtin_amdgcn_global_load_lds((const unsigned*)(gv + (size_t)i * (16 * LDQ * 2) + vo0), (LAS unsigned*)(lds + OFF_V + (b_) * VB + wid * 1024 + i * 8192), 16, 0, 0); } } while (0)
    DMA_K(0, 0); DMA_V(0, 0); if (1 < NT) { DMA_K(1, 1); DMA_V(1, 1); }
    asm volatile("s_waitcnt vmcnt(0)" ::: "memory"); __builtin_amdgcn_s_barrier(); asm volatile("" ::: "memory");
    int kb3 = 0;
    for (int j = 0; j < NT; ++j) {
        const int kb2 = kb3 == 0 ? 2 : kb3 - 1;
        if (j + 2 < NT) DMA_V(j + 2, kb2);
        asm volatile("" ::: "memory");
        if (j + 2 < NT) DMA_K(j + 2, kb2);
        asm volatile("" ::: "memory");
        if (j <= lim) {
        constexpr float C = SCALE * 1.4426950408889634f;
        f32x4 s[4][2];
#pragma unroll
        for (int kb = 0; kb < 4; ++kb) { s[kb][0] = (f32x4){0.f, 0.f, 0.f, 0.f}; s[kb][1] = (f32x4){0.f, 0.f, 0.f, 0.f}; }
        { const char* Ks = (const char*)ldsg + kb3 * KB;
#pragma unroll
          for (int ds = 0; ds < 4; ++ds) {
              bf16x8 kf[4];
#pragma unroll
              for (int kb = 0; kb < 4; ++kb) kf[kb] = *reinterpret_cast<const bf16x8*>(Ks + kb * 4096 + (ka0 ^ (ds << 6)));
#pragma unroll
              for (int kb = 0; kb < 4; ++kb) { s[kb][0] = __builtin_amdgcn_mfma_f32_16x16x32_bf16(kf[kb], qr[0][ds], s[kb][0], 0, 0, 0);
                                               s[kb][1] = __builtin_amdgcn_mfma_f32_16x16x32_bf16(kf[kb], qr[1][ds], s[kb][1], 0, 0, 0); } } }
        int jz = j; asm volatile("" : "+s"(jz));
        if (jz == 0) {
            asm volatile("; tile-0 mask" ::: "memory");
#pragma unroll
            for (int kb = 0; kb < 3; ++kb)
#pragma unroll
                for (int r = 0; r < 4; ++r) { s[kb][0][r] = -1e30f; s[kb][1][r] = -1e30f; }
        }
        float pm0 = s[0][0][0], pm1 = s[0][1][0];
#pragma unroll
        for (int kb = 0; kb < 4; ++kb)
#pragma unroll
            for (int r = 0; r < 4; ++r) { pm0 = fmaxf(pm0, s[kb][0][r]); pm1 = fmaxf(pm1, s[kb][1][r]); }
        pm0 = grp_max(pm0); pm1 = grp_max(pm1);
        float a0, a1;
        if (__builtin_expect(__all(fmaxf(pm0 - m0, pm1 - m1) <= THR / SCALE), 1)) { a0 = 1.f; a1 = 1.f; }
        else { const float n0 = fmaxf(m0, pm0), n1 = fmaxf(m1, pm1); a0 = __builtin_amdgcn_exp2f((m0 - n0) * C); a1 = __builtin_amdgcn_exp2f((m1 - n1) * C); m0 = n0; m1 = n1; }
        if (__any(a0 < 1.f || a1 < 1.f)) {
            if (g == 0) { al_l[c16] = a0; al_l[16 + c16] = a1; } asm volatile("s_waitcnt lgkmcnt(0)" ::: "memory");
            const f32x4 q0 = *(const LAS f32x4*)(al_l + 4 * g), q1 = *(const LAS f32x4*)(al_l + 16 + 4 * g);
            asm volatile("s_waitcnt lgkmcnt(0)" ::: "memory");
#pragma unroll
            for (int cb = 0; cb < 16; ++cb)
#pragma unroll
                for (int r = 0; r < 4; ++r) { o[0][cb][r] *= q0[r]; o[1][cb][r] *= q1[r]; }
        }
        const float mc0 = -m0 * C, mc1 = -m1 * C;
        float ps0 = 0.f, ps1 = 0.f;
#pragma unroll
        for (int kb = 0; kb < 4; ++kb)
#pragma unroll
            for (int r = 0; r < 4; ++r) { s[kb][0][r] = __builtin_amdgcn_exp2f(fmaf(s[kb][0][r], C, mc0)); s[kb][1][r] = __builtin_amdgcn_exp2f(fmaf(s[kb][1][r], C, mc1)); }
#pragma unroll
        for (int kb = 0; kb < 4; ++kb)
#pragma unroll
            for (int r = 0; r < 4; ++r) { ps0 += s[kb][0][r]; ps1 += s[kb][1][r]; }
        ps0 = grp_sum(ps0); ps1 = grp_sum(ps1);
        l0 = l0 * a0 + ps0; l1 = l1 * a1 + ps1;
        bf16x8 pa00, pa01, pa10, pa11;
#define PK6(QB, CH, OUT) do { u32x4 w_ = {cvt_pk_bf16(s[2 * CH][QB][0], s[2 * CH][QB][1]), cvt_pk_bf16(s[2 * CH][QB][2], s[2 * CH][QB][3]), \
                                          cvt_pk_bf16(s[2 * CH + 1][QB][0], s[2 * CH + 1][QB][1]), cvt_pk_bf16(s[2 * CH + 1][QB][2], s[2 * CH + 1][QB][3])}; OUT = *reinterpret_cast<bf16x8*>(&w_); } while (0)
        PK6(0, 0, pa00); PK6(0, 1, pa01); PK6(1, 0, pa10); PK6(1, 1, pa11);
#undef PK6
        SBAR();
        pv6_all(o, vb0 + kb3 * VB, pa00, pa01, pa10, pa11);
        }
        if (j + 2 < NT) asm volatile("s_waitcnt vmcnt(6)" ::: "memory"); else asm volatile("s_waitcnt vmcnt(0)" ::: "memory");
        __builtin_amdgcn_s_barrier(); asm volatile("" ::: "memory");
        kb3 = kb3 == 2 ? 0 : kb3 + 1;
    }
    if (g == 0) { li_l[c16] = l0; li_l[16 + c16] = l1; } asm volatile("s_waitcnt lgkmcnt(0)" ::: "memory");
    f32x4 r0 = *(const LAS f32x4*)(li_l + 4 * g), r1 = *(const LAS f32x4*)(li_l + 16 + 4 * g);
#pragma unroll
    for (int r = 0; r < 4; ++r) { r0[r] = __builtin_amdgcn_rcpf(r0[r]); r1[r] = __builtin_amdgcn_rcpf(r1[r]); }
    bf16_t* Ow = Ob + (long)(wid * QBLK + 4 * g) * LDO + c16;
#pragma unroll
    for (int r = 0; r < 4; ++r)
#pragma unroll
        for (int cb = 0; cb < 16; ++cb) { Ow[(long)r * LDO + cb * 16] = f2bf(o[0][cb][r] * r0[r]); Ow[(long)(16 + r) * LDO + cb * 16] = f2bf(o[1][cb][r] * r1[r]); }
    asm volatile("s_waitcnt vmcnt(0) lgkmcnt(0)" ::: "memory"); __builtin_amdgcn_s_barrier(); asm volatile("" ::: "memory");
#undef DMA_K
#undef DMA_V
}
}

#ifndef MK_ATT2
#define MK_ATT2 1
#endif
#ifndef MK_PROBE_QK2
#define MK_PROBE_QK2 0
#endif
#ifndef MK_PROBE_DMA2
#define MK_PROBE_DMA2 0
#endif
#ifndef MK_ATT_UNIT
#define MK_ATT_UNIT unit2
#endif
#ifndef MK_ATT_REV
#define MK_ATT_REV 0
#endif
#if MK_ATT2
__device__ __forceinline__ void attn_phase(const Fr& F) {
    const bf16_t* Q = slotY(F, 0); const bf16_t* K = slotY(F, 1); const bf16_t* V = slotY(F, 2);
    bf16_t* AO = slotU(F, 1);
    const int x = F.bid & 7, j = (F.bid >> 3) & 31;
#pragma unroll 1
    for (int k = 0; k < 4; ++k) {
        if (F.bid >= 256) break;
        const int sub = 4 * x + k, head = sub >> 1, c = sub & 1;
        const bf16_t* Kp = K + head * 256 + c * 128; const bf16_t* Vp = V + head * 256;
#pragma unroll 1
        for (int u = 0; u < 2; ++u) {
            const int t = u == 0 ? 63 - j : j;
            const int row0 = 256 * t + 128;
            att2::MK_ATT_UNIT(Q + (size_t)row0 * D + head * 256 + c * 128, Kp, Vp, AO + (size_t)row0 * 8192 + head * 512 + c * 256, 4 * t + 6, 4 * t + 2 + (F.wave >> 1), F.ldsg, F.lds, MK_ATT_REV ? u : 0);
        }
        if (j == 8 * k) att2::MK_ATT_UNIT(Q + head * 256 + c * 128, Kp, Vp, AO + head * 512 + c * 256, 4, F.wave >> 1, F.ldsg, F.lds);
    }
}
#else
__device__ __forceinline__ void attn_phase(const Fr& F) {
    const bf16_t* Q = slotY(F, 0); const bf16_t* K = slotY(F, 1); const bf16_t* V = slotY(F, 2);
    bf16_t* AO = slotU(F, 1);
    const int x = F.bid & 7, j = (F.bid >> 3) & 31;
#pragma unroll 1
    for (int k = 0; k < 8; ++k) {
        if (F.bid >= 256) break;
        const int sub = 8 * x + k, head = sub >> 2, c = (sub >> 1) & 1, half = sub & 1;
        const bf16_t* Kp = K + head * 256 + c * 128; const bf16_t* Vp = V + head * 256 + half * 128;
#pragma unroll 1
        for (int u = 0; u < 2; ++u) {
            const int t = u == 0 ? 63 - j : j;
            const int row0 = 256 * t + 128;
            att::unit(Q + (size_t)row0 * D + head * 256 + c * 128, Kp, Vp, AO + (size_t)row0 * 8192 + head * 512 + c * 256 + half * 128, 4 * t + 6, 4 * t + 2 + (F.wave >> 1), (char*)F.ldsg);
        }
        if (j == 4 * k) att::unit(Q + head * 256 + c * 128, Kp, Vp, AO + head * 512 + c * 256 + half * 128, 4, F.wave >> 1, (char*)F.ldsg);
    }
}
#endif
__device__ __forceinline__ void attn_post(const Fr& F) {
    const bf16_t* AO = slotU(F, 1); const bf16_t* GT = slotY(F, 3); bf16_t* Z = slotU(F, 0);
    const float* sg = F.in(13);
    constexpr float LINIT = 0.35550906759096934f;
    float lam;
    { const float* q1 = F.in(9); const float* k1 = F.in(10); const float* q2 = F.in(11); const float* k2 = F.in(12);
      const float d1 = wave_sum(q1[F.lane] * k1[F.lane] + q1[F.lane + 64] * k1[F.lane + 64]), d2 = wave_sum(q2[F.lane] * k2[F.lane] + q2[F.lane + 64] * k2[F.lane + 64]);
      lam = expf(d1) - expf(d2) + LINIT; }
    const f32x4 g4 = ((const f32x4*)sg)[F.lane];
    for (int r = F.gw; r < R; r += F.NGW) {
        const bool real = (r >= NPAD && r < NREAL);
        u32x2* zr = (u32x2*)(Z + (size_t)r * D) + F.lane;
        if (!real) { const u32x2 z = {0u, 0u};
#pragma unroll
            for (int hd = 0; hd < 16; ++hd) zr[64 * hd] = z;
            continue; }
        gp_ ao0 = (gp_)(AO + (size_t)r * 8192) + F.lane * 8 + 4096; gp_ ao1 = ao0 + 8192; asm volatile("" : "+v"(ao0), "+v"(ao1));
        ROW_BF(gq, GT + (size_t)r * D, F.lane); ROW_BF(zq, Z + (size_t)r * D, F.lane);
        u32x2 a0v[16], a1v[16], gtv[16];
#pragma unroll
        for (int hd = 0; hd < 16; ++hd) {
            a0v[hd] = *(GAS u32x2*)(hd < 8 ? ao0 + (2 * hd) * 512 - 4096 : ao1 + (2 * hd - 16) * 512 - 4096);
            a1v[hd] = *(GAS u32x2*)(hd < 8 ? ao0 + (2 * hd + 1) * 512 - 4096 : ao1 + (2 * hd - 15) * 512 - 4096);
            gtv[hd] = AT_BF(gq, hd);
        }
#pragma unroll
        for (int hd = 0; hd < 16; ++hd) {
            const u32x2 a0 = a0v[hd], a1 = a1v[hd], gt = gtv[hd];
            const float o0 = bflo(a0.x) - lam * bflo(a1.x), o1 = bfhi(a0.x) - lam * bfhi(a1.x), o2 = bflo(a0.y) - lam * bflo(a1.y), o3 = bfhi(a0.y) - lam * bfhi(a1.y);
            const float ss = wave_sum((o0 * o0 + o1 * o1) + (o2 * o2 + o3 * o3));
            const float rs = __builtin_amdgcn_rsqf(ss * (1.f / 256.f) + 1e-5f) * (1.f - LINIT);
            u32x2 w; w.x = cvt_pk_bf16(o0 * rs * g4.x * silu_f(bflo(gt.x)), o1 * rs * g4.y * silu_f(bfhi(gt.x))); w.y = cvt_pk_bf16(o2 * rs * g4.z * silu_f(bflo(gt.y)), o3 * rs * g4.w * silu_f(bfhi(gt.y)));
            AT_BF(zq, hd) = w;
        }
    }
}

constexpr int RW_TT = 32, RW_TOKF = 384, RW_TILEF = RW_TT * RW_TOKF, RW_NTILE = 513;
__device__ __forceinline__ void rwkv_scan_seq(const Fr& F) {
    const bf16_t* Rr = slotY(F, 0); const bf16_t* K = slotY(F, 1); const bf16_t* V = slotY(F, 2); const bf16_t* W = slotY(F, 4); const bf16_t* A = slotY(F, 5);
    float* O32 = (float*)slotU(F, 1);
    LAS float* ring = (LAS float*)F.lds; LAS float* otile = ring + 2 * RW_TILEF;
    const int tid = F.tid, lane = F.lane, wid = F.wave;
    for (int unit = F.bid; unit < 256; unit += F.G) {
        const int h = unit >> 2, rg = unit & 3;
        const int ptid = tid - 256, ptt = ptid >> 3, dg = ptid & 7;
        float kkc[8], kac[8];
        if (wid >= 4) {
#pragma unroll
            for (int i = 0; i < 8; ++i) { kkc[i] = F.in(23)[h * 64 + 8 * dg + i]; kac[i] = F.in(24)[h * 64 + 8 * dg + i]; }
        }
        float S0 = 0.f, S1 = 0.f, S2 = 0.f, S3 = 0.f;
        const int cg = lane & 15, irow = 4 * wid + (lane >> 4);
#define RW_PRODUCE(m, buf) do { const int row = NPAD + 32 * (m) + ptt; const size_t off = (size_t)row * D + h * 64 + 8 * dg; \
        const u32x4 r8 = *(const u32x4*)(Rr + off), k8 = *(const u32x4*)(K + off), v8 = *(const u32x4*)(V + off), w8 = *(const u32x4*)(W + off), a8 = *(const u32x4*)(A + off); \
        const unsigned rw[4] = {r8.x, r8.y, r8.z, r8.w}, kw[4] = {k8.x, k8.y, k8.z, k8.w}, vw[4] = {v8.x, v8.y, v8.z, v8.w}, ww[4] = {w8.x, w8.y, w8.z, w8.w}, aw[4] = {a8.x, a8.y, a8.z, a8.w}; \
        float rf[8], kf[8], vf[8], wf[8], af[8], kk[8]; float ssq = 0.f; \
        _Pragma("unroll") for (int i = 0; i < 4; ++i) { rf[2 * i] = bflo(rw[i]); rf[2 * i + 1] = bfhi(rw[i]); kf[2 * i] = bflo(kw[i]); kf[2 * i + 1] = bfhi(kw[i]); vf[2 * i] = bflo(vw[i]); vf[2 * i + 1] = bfhi(vw[i]); \
            wf[2 * i] = bflo(ww[i]); wf[2 * i + 1] = bfhi(ww[i]); af[2 * i] = bflo(aw[i]); af[2 * i + 1] = bfhi(aw[i]); } \
        _Pragma("unroll") for (int i = 0; i < 8; ++i) { kk[i] = kf[i] * kkc[i]; ssq += kk[i] * kk[i]; } \
        ssq = red8(ssq); const float inv = 1.f / fmaxf(sqrtf(ssq), 1e-12f); \
        LAS float* tb = ring + (buf) * RW_TILEF + ptt * RW_TOKF; \
        _Pragma("unroll") for (int q = 0; q < 2; ++q) { LAS f32x4* p = (LAS f32x4*)(tb + (2 * dg + q) * 20); \
            f32x4 t0, t1, t2, t3, t4; \
            _Pragma("unroll") for (int e = 0; e < 4; ++e) { const int i = 4 * q + e; const float kn = kk[i] * inv; t0[e] = wf[i]; t1[e] = -kn; t2[e] = kn * af[i]; t3[e] = kf[i] * (1.f + (af[i] - 1.f) * kac[i]); t4[e] = rf[i]; } \
            p[0] = t0; p[1] = t1; p[2] = t2; p[3] = t3; p[4] = t4; } \
        LAS f32x4* pv = (LAS f32x4*)(tb + 320 + 8 * dg); pv[0] = (f32x4){vf[0], vf[1], vf[2], vf[3]}; pv[1] = (f32x4){vf[4], vf[5], vf[6], vf[7]}; } while (0)
#define RW_FLUSH(m, buf) do { const int row = NPAD + 32 * (m) + ptt; if (row < NREAL) { const LAS float* ot = otile + (buf) * 512 + ptt * 16 + 2 * dg; \
        *(float2*)(O32 + (size_t)row * D + h * 64 + 16 * rg + 2 * dg) = make_float2(ot[0], ot[1]); } } while (0)
        if (wid >= 4) RW_PRODUCE(0, 0);
        __syncthreads();
        for (int n = 0; n < RW_NTILE; ++n) {
            if (wid < 4) {
                const LAS float* tb = ring + (n & 1) * RW_TILEF; LAS float* ot = otile + (n & 1) * 512;
#pragma unroll 4
                for (int tt = 0; tt < RW_TT; ++tt) {
                    const LAS float* p = tb + tt * RW_TOKF + cg * 20;
                    const f32x4 w4 = *(const LAS f32x4*)p, nk = *(const LAS f32x4*)(p + 4), ka = *(const LAS f32x4*)(p + 8), kp = *(const LAS f32x4*)(p + 12), r4 = *(const LAS f32x4*)(p + 16);
                    const float v = tb[tt * RW_TOKF + 320 + 16 * rg + irow];
                    float sa = (S0 * nk.x + S1 * nk.y) + (S2 * nk.z + S3 * nk.w);
                    sa = red16(sa);
                    S0 = S0 * w4.x + (sa * ka.x + v * kp.x); S1 = S1 * w4.y + (sa * ka.y + v * kp.y); S2 = S2 * w4.z + (sa * ka.z + v * kp.z); S3 = S3 * w4.w + (sa * ka.w + v * kp.w);
                    float o = (S0 * r4.x + S1 * r4.y) + (S2 * r4.z + S3 * r4.w);
                    o = red16(o);
                    if (cg == 0) ot[tt * 16 + irow] = o;
                }
            } else {
                if (n + 1 < RW_NTILE) RW_PRODUCE(n + 1, (n + 1) & 1);
                if (n > 0) RW_FLUSH(n - 1, (n - 1) & 1);
            }
            __syncthreads();
        }
        if (wid >= 4) RW_FLUSH(RW_NTILE - 1, (RW_NTILE - 1) & 1);
        __syncthreads();
#undef RW_PRODUCE
#undef RW_FLUSH
    }
}

#ifndef RC_SYNC
#define RC_SYNC 0
#endif
constexpr int RC_SLOT = 13312, RC_NSLOT = 8, RC_SCR0 = RC_NSLOT * RC_SLOT, RC_SCR = 5632, RC_FLAGS = RC_SCR0 + 7 * RC_SCR, RC_NCH = 1025;
constexpr int RC_AT = 0, RC_RT = 2176, RC_BTT = 4352, RC_KTT = 6912, RC_TT = 9472, RC_G3F = 9984, RC_VTF = 10496, RC_P1 = 11008, RC_P2 = 12032, RC_WC = 13056;
static_assert(RC_FLAGS + 64 <= 147456 - 256, "rwkv LDS map");
typedef short s16x4v __attribute__((ext_vector_type(4)));
__device__ __forceinline__ void lora2_phase(const Fr& F) {
    const bf16_t* T = (const bf16_t*)(F.ws + WS_T); const bf16_t* W2T = (const bf16_t*)(F.ws + WS_W2P);
    const int c16 = F.lane & 15, g = F.lane >> 4;
    struct BSet { bf16x8 f[2][4]; f32x4 b0, b1; };
#define L2_LOAD(S_, grp_) do { _Pragma("unroll") for (int b = 0; b < 2; ++b) _Pragma("unroll") for (int ks = 0; ks < 4; ++ks) S_.f[b][ks] = *reinterpret_cast<const bf16x8*>(wb + (size_t)((grp_) * 32 + 4 * b) * 128 + ks * 32); \
        S_.b0 = *(const GAS f32x4*)(bias + (grp_) * 32); S_.b1 = *(const GAS f32x4*)(bias + (grp_) * 32 + 4); } while (0)
#define L2_COMP(S_, grp_) do { f32x4 acc[2][4]; \
        _Pragma("unroll") for (int b = 0; b < 2; ++b) _Pragma("unroll") for (int rb = 0; rb < 4; ++rb) acc[b][rb] = (f32x4){0.f, 0.f, 0.f, 0.f}; \
        _Pragma("unroll") for (int ks = 0; ks < 4; ++ks) _Pragma("unroll") for (int b = 0; b < 2; ++b) _Pragma("unroll") for (int rb = 0; rb < 4; ++rb) \
            acc[b][rb] = __builtin_amdgcn_mfma_f32_16x16x32_bf16(S_.f[b][ks], af[rb][ks], acc[b][rb], 0, 0, 0); \
        _Pragma("unroll") for (int rb = 0; rb < 4; ++rb) { f32x4 v0 = acc[0][rb] + S_.b0, v1 = acc[1][rb] + S_.b1; \
            _Pragma("unroll") for (int jj = 0; jj < 4; ++jj) { float s0 = __builtin_amdgcn_rcpf(1.f + __expf(-v0[jj])), s1 = __builtin_amdgcn_rcpf(1.f + __expf(-v1[jj])); \
                if (!sel) { s0 = __expf(-0.606531f * s0); s1 = __expf(-0.606531f * s1); } L2_PROBE_MATH(v0[jj], v1[jj]); v0[jj] = s0; v1[jj] = s1; } \
            st_bf8(dst + (size_t)rb * 16 * D + (grp_) * 32, v0, v1); } } while (0)
#ifdef MK_L2MATH2
#define L2_PROBE_MATH(x0_, x1_) do { float t0_ = (x0_), t1_ = (x1_); asm volatile("" : "+v"(t0_), "+v"(t1_)); t0_ = __builtin_amdgcn_rcpf(1.f + __expf(-t0_)); t1_ = __builtin_amdgcn_rcpf(1.f + __expf(-t1_)); \
        if (!sel) { t0_ = __expf(-0.606531f * t0_); t1_ = __expf(-0.606531f * t1_); } asm volatile("" :: "v"(t0_), "v"(t1_)); } while (0)
#else
#define L2_PROBE_MATH(x0_, x1_) do { } while (0)
#endif
#define L2_WAIT(n_) do { SBAR(); asm volatile("s_waitcnt vmcnt(" #n_ ")" ::: "memory"); SBAR(); } while (0)
#pragma unroll 1
    for (int it = F.bid; it < (R / 64) * 8; it += F.G) {
        const int panel = it >> 3, sel = (it >> 2) & 1, q = it & 3;
        const int row0 = panel * 64, colw = q * 1024 + F.wave * 128;
        const GAS float* bias = (const GAS float*)(sel ? F.in(20) : F.in(17)) + colw + 8 * g;
        bf16_t* dst = slotY(F, sel ? 5 : 4) + (size_t)(row0 + c16) * D + colw + 8 * g;
        const bf16_t* ta = T + (size_t)(row0 + c16) * 256 + sel * 128 + 8 * g;
        const bf16_t* wb = W2T + (size_t)(sel * 4096 + colw + 8 * (c16 >> 2) + (c16 & 3)) * 128 + 8 * g;
        bf16x8 af[4][4]; BSet A, B;
#pragma unroll
        for (int rb = 0; rb < 4; ++rb)
#pragma unroll
            for (int ks = 0; ks < 4; ++ks) af[rb][ks] = *reinterpret_cast<const bf16x8*>(ta + (size_t)rb * 16 * 256 + ks * 32);
        L2_LOAD(A, 0); SBAR();
        L2_LOAD(B, 1); L2_WAIT(10); L2_COMP(A, 0); SBAR();
        L2_LOAD(A, 2); L2_WAIT(14); L2_COMP(B, 1); SBAR();
        L2_LOAD(B, 3); L2_WAIT(14); L2_COMP(A, 2); SBAR();
        L2_WAIT(4); L2_COMP(B, 3); SBAR();
    }
#undef L2_LOAD
#undef L2_COMP
#undef L2_WAIT
}
__device__ __forceinline__ void rwkv_kknorm(const Fr& F) {
    const bf16_t* K = slotY(F, 1); const float* k_k = F.in(23); float* INV = (float*)(F.ws + WS_HE);
    f32x4 c4v[16];
    { ROW_F32(cq, k_k, F.lane);
#pragma unroll
      for (int it = 0; it < 16; ++it) c4v[it] = AT_F32(cq, it); }
    for (int r = F.gw; r < R; r += F.NGW) {
        ROW_BF(kq_, K + (size_t)r * D, F.lane);
        u32x2 kv[16];
#pragma unroll
        for (int it = 0; it < 16; ++it) kv[it] = AT_BF(kq_, it);
#pragma unroll
        for (int it = 0; it < 16; ++it) {
            const u32x2 kk = kv[it]; const f32x4 c4 = c4v[it];
            const float a = bflo(kk.x) * c4.x, b = bfhi(kk.x) * c4.y, c = bflo(kk.y) * c4.z, d = bfhi(kk.y) * c4.w;
            const float ss = red16((a * a + b * b) + (c * c + d * d));
            if ((F.lane & 15) == 0) INV[(size_t)r * 64 + it * 4 + (F.lane >> 4)] = fminf(__builtin_amdgcn_rsqf(ss), 1e12f);
        }
    }
}
__device__ __forceinline__ unsigned lds_poll(volatile LAS unsigned* p) { return *p; }
__device__ __forceinline__ void rwkv_scan(const Fr& F) {
    const bf16_t* Rr = slotY(F, 0); const bf16_t* K = slotY(F, 1); const bf16_t* V = slotY(F, 2); const bf16_t* W = slotY(F, 4); const bf16_t* A = slotY(F, 5);
    const float* INV = (const float*)(F.ws + WS_HE);
    float* O32 = (float*)slotU(F, 1);
    LAS unsigned char* L = F.lds;
    volatile LAS unsigned* flags = (volatile LAS unsigned*)(L + RC_FLAGS);
    const int lane = F.lane, wid = F.wave, l15 = lane & 15, kg = lane >> 4;
    for (int unit = F.bid; unit < 256; unit += F.G) {
        const int h = unit >> 2, rgw = unit & 3;
        if (F.tid < 16) flags[F.tid] = 0u;
        __syncthreads();
        if (wid == 0) {
            __builtin_amdgcn_s_setprio(3);
            f32x4 S0 = {0.f, 0.f, 0.f, 0.f}, S1 = S0, S2 = S0, S3 = S0;
            struct SlotRegs { u32x2 a0l, a0h, a1l, a1h, r0l, r0h, r1l, r1h; f32x4 P1, P2; s16x4v ttf, g3f, vtf, b0, b1, b2, b3, k0, k1, k2, k3; f32x4 w0, w1, w2, w3; };
#if RC_SYNC
#define CH_WAIT(n_) do { if ((n_) % 7 == 0) { __builtin_amdgcn_s_barrier(); __builtin_amdgcn_s_barrier(); } } while (0)
#else
#define CH_WAIT(n_) do { unsigned sp = 0; while (lds_poll(flags + ((n_) & 7)) != (unsigned)((n_) + 1)) { __builtin_amdgcn_s_sleep(1); if (++sp > (1u << 22)) break; } } while (0)
#endif
#define CH_LOAD(R_, n_) do { CH_WAIT(n_); asm volatile("s_waitcnt lgkmcnt(0)" ::: "memory"); const LAS unsigned char* SL = L + ((n_) & 7) * RC_SLOT; \
                const LAS unsigned char* ap = SL + RC_AT + l15 * 136 + kg * 8; const LAS unsigned char* rp = SL + RC_RT + l15 * 136 + kg * 8; \
                R_.a0l = *(const LAS u32x2*)(ap); R_.a0h = *(const LAS u32x2*)(ap + 32); R_.a1l = *(const LAS u32x2*)(ap + 64); R_.a1h = *(const LAS u32x2*)(ap + 96); \
                R_.r0l = *(const LAS u32x2*)(rp); R_.r0h = *(const LAS u32x2*)(rp + 32); R_.r1l = *(const LAS u32x2*)(rp + 64); R_.r1h = *(const LAS u32x2*)(rp + 96); \
                R_.P1 = *(const LAS f32x4*)(SL + RC_P1 + lane * 16); R_.P2 = *(const LAS f32x4*)(SL + RC_P2 + lane * 16); \
                R_.ttf = *(const LAS s16x4v*)(SL + RC_TT + lane * 8); R_.g3f = *(const LAS s16x4v*)(SL + RC_G3F + lane * 8); R_.vtf = *(const LAS s16x4v*)(SL + RC_VTF + lane * 8); \
                const LAS unsigned char* bp = SL + RC_BTT + l15 * 40 + kg * 8; const LAS unsigned char* kp = SL + RC_KTT + l15 * 40 + kg * 8; \
                R_.b0 = *(const LAS s16x4v*)(bp); R_.b1 = *(const LAS s16x4v*)(bp + 640); R_.b2 = *(const LAS s16x4v*)(bp + 1280); R_.b3 = *(const LAS s16x4v*)(bp + 1920); \
                R_.k0 = *(const LAS s16x4v*)(kp); R_.k1 = *(const LAS s16x4v*)(kp + 640); R_.k2 = *(const LAS s16x4v*)(kp + 1280); R_.k3 = *(const LAS s16x4v*)(kp + 1920); \
                const LAS f32x4* wc = (const LAS f32x4*)(SL + RC_WC + kg * 16); R_.w0 = wc[0]; R_.w1 = wc[4]; R_.w2 = wc[8]; R_.w3 = wc[12]; \
                asm volatile("s_waitcnt lgkmcnt(0)" ::: "memory"); \
                if (lane == 0) flags[8] = (unsigned)((n_) + 1); } while (0)
#define CH_COMPUTE(R_, n_, NEXT_) do { \
                u32x4 sb0, sb1; sb0.x = cvt_pk_bf16(S0.x, S0.y); sb0.y = cvt_pk_bf16(S0.z, S0.w); sb0.z = cvt_pk_bf16(S1.x, S1.y); sb0.w = cvt_pk_bf16(S1.z, S1.w); \
                sb1.x = cvt_pk_bf16(S2.x, S2.y); sb1.y = cvt_pk_bf16(S2.z, S2.w); sb1.z = cvt_pk_bf16(S3.x, S3.y); sb1.w = cvt_pk_bf16(S3.z, S3.w); \
                const bf16x8 Sb0 = *reinterpret_cast<bf16x8*>(&sb0), Sb1 = *reinterpret_cast<bf16x8*>(&sb1); \
                u32x4 t4; \
                t4 = (u32x4){R_.a0l.x, R_.a0l.y, R_.a0h.x, R_.a0h.y}; const bf16x8 Aq0 = *reinterpret_cast<bf16x8*>(&t4); \
                t4 = (u32x4){R_.a1l.x, R_.a1l.y, R_.a1h.x, R_.a1h.y}; const bf16x8 Aq1 = *reinterpret_cast<bf16x8*>(&t4); \
                t4 = (u32x4){R_.r0l.x, R_.r0l.y, R_.r0h.x, R_.r0h.y}; const bf16x8 Rq0 = *reinterpret_cast<bf16x8*>(&t4); \
                t4 = (u32x4){R_.r1l.x, R_.r1l.y, R_.r1h.x, R_.r1h.y}; const bf16x8 Rq1 = *reinterpret_cast<bf16x8*>(&t4); \
                f32x4 X = R_.P1, O = R_.P2; \
                X = __builtin_amdgcn_mfma_f32_16x16x32_bf16(Aq0, Sb0, X, 0, 0, 0); \
                X = __builtin_amdgcn_mfma_f32_16x16x32_bf16(Aq1, Sb1, X, 0, 0, 0);                   \
                O = __builtin_amdgcn_mfma_f32_16x16x32_bf16(Rq0, Sb0, O, 0, 0, 0); \
                O = __builtin_amdgcn_mfma_f32_16x16x32_bf16(Rq1, Sb1, O, 0, 0, 0);                   \
                u32x2 yb; yb.x = cvt_pk_bf16(X.x, X.y); yb.y = cvt_pk_bf16(X.z, X.w); \
                f32x4 U = {0.f, 0.f, 0.f, 0.f}; \
                U = __builtin_amdgcn_mfma_f32_16x16x16bf16_1k(R_.ttf, *reinterpret_cast<s16x4v*>(&yb), U, 0, 0, 0);     \
                u32x2 ub; ub.x = cvt_pk_bf16(U.x, U.y); ub.y = cvt_pk_bf16(U.z, U.w); \
                const s16x4v Ub = *reinterpret_cast<s16x4v*>(&ub); \
                S0 = __builtin_amdgcn_mfma_f32_16x16x16bf16_1k(R_.k0, R_.vtf, S0, 0, 0, 0); S1 = __builtin_amdgcn_mfma_f32_16x16x16bf16_1k(R_.k1, R_.vtf, S1, 0, 0, 0); \
                S2 = __builtin_amdgcn_mfma_f32_16x16x16bf16_1k(R_.k2, R_.vtf, S2, 0, 0, 0); S3 = __builtin_amdgcn_mfma_f32_16x16x16bf16_1k(R_.k3, R_.vtf, S3, 0, 0, 0); \
                S0 = __builtin_amdgcn_mfma_f32_16x16x16bf16_1k(R_.b0, Ub, S0, 0, 0, 0); S1 = __builtin_amdgcn_mfma_f32_16x16x16bf16_1k(R_.b1, Ub, S1, 0, 0, 0); \
                S2 = __builtin_amdgcn_mfma_f32_16x16x16bf16_1k(R_.b2, Ub, S2, 0, 0, 0); S3 = __builtin_amdgcn_mfma_f32_16x16x16bf16_1k(R_.b3, Ub, S3, 0, 0, 0); \
                O = __builtin_amdgcn_mfma_f32_16x16x16bf16_1k(R_.g3f, Ub, O, 0, 0, 0);                   \
                NEXT_; \
                S0 = S0 * R_.w0; S1 = S1 * R_.w1; S2 = S2 * R_.w2; S3 = S3 * R_.w3; \
                float* op = O32 + (size_t)(NPAD + 16 * (n_) + 4 * kg) * D + h * 64 + 16 * rgw + l15;     \
                op[0] = O.x; op[D] = O.y; op[2 * D] = O.z; op[3 * D] = O.w; } while (0)
            SlotRegs RA, RB;
            CH_LOAD(RA, 0);
            for (int n = 0; n + 1 < RC_NCH; n += 2) {
#ifdef MK_RC_CHAIN_SLEEP
                __builtin_amdgcn_s_sleep(MK_RC_CHAIN_SLEEP);
#endif
                CH_COMPUTE(RA, n, CH_LOAD(RB, n + 1));
                if (n + 2 < RC_NCH) { CH_COMPUTE(RB, n + 1, CH_LOAD(RA, n + 2)); } else { CH_COMPUTE(RB, n + 1, (void)0); }
            }
            if (RC_NCH & 1) { CH_COMPUTE(RA, RC_NCH - 1, (void)0); }
            __builtin_amdgcn_s_setprio(0);
#undef CH_WAIT
#undef CH_LOAD
#undef CH_COMPUTE
        } else {
            const int p = wid - 1;
            LAS unsigned char* SC = L + RC_SCR0 + p * RC_SCR;
            const float kkc = F.in(23)[h * 64 + lane], kac = F.in(24)[h * 64 + lane];
            unsigned short cr[16], ck[16], cw[16], ca[16], nvq[4]; float civ[16];
#define RC_LOADS(nn) do { const int r0n = NPAD + 16 * (nn); \
                _Pragma("unroll") for (int e = 0; e < 4; ++e) nvq[e] = V[(size_t)(r0n + 4 * kg + e) * D + h * 64 + 16 * rgw + l15]; \
                _Pragma("unroll") for (int s = 0; s < 16; ++s) { const size_t off = (size_t)(r0n + s) * D + h * 64 + lane; cr[s] = Rr[off]; ck[s] = K[off]; cw[s] = W[off]; ca[s] = A[off]; civ[s] = INV[(size_t)(r0n + s) * 64 + h]; } } while (0)
            RC_LOADS(p);
            for (int n = p; n < RC_NCH; n += 7) {
#ifdef MK_RC_PREP_SLEEP
                __builtin_amdgcn_s_sleep(MK_RC_PREP_SLEEP);
#endif
                const int slot = n & 7; LAS unsigned char* SL = L + slot * RC_SLOT;
                unsigned short vq[4];
#pragma unroll
                for (int e = 0; e < 4; ++e) vq[e] = nvq[e];
#if RC_SYNC
                asm volatile("s_waitcnt lgkmcnt(0)" ::: "memory"); __builtin_amdgcn_s_barrier();
#else
                if (n >= 8) { unsigned sp = 0; while (lds_poll(flags + 8) < (unsigned)(n - 7)) { __builtin_amdgcn_s_sleep(2); if (++sp > (1u << 22)) break; } }
#endif
                asm volatile("" ::: "memory");
                float Wp = 1.f; unsigned btp[8], ktp[8];
#pragma unroll
                for (int hb = 0; hb < 2; ++hb) {
                    unsigned short rq[8], kq[8], wq[8], aq[8]; float iv[8];
#pragma unroll
                    for (int s = 0; s < 8; ++s) { rq[s] = cr[8 * hb + s]; kq[s] = ck[8 * hb + s]; wq[s] = cw[8 * hb + s]; aq[s] = ca[8 * hb + s]; iv[s] = civ[8 * hb + s]; }
                    float btv[8], ktv[8];
#pragma unroll
                    for (int s = 0; s < 8; ++s) {
                        const int t = 8 * hb + s;
                        const float rs = bf2f(rq[s]), ks = bf2f(kq[s]), wsv = bf2f(wq[s]), as = bf2f(aq[s]);
                        const float kk = ks * kkc * iv[s];
                        const float Wprev = Wp; Wp *= wsv; const float iW = __builtin_amdgcn_rcpf(Wp);
                        const float at = -kk * Wprev, rt = rs * Wp, bt = kk * as * iW, kt = ks * (1.f + (as - 1.f) * kac) * iW;
                        *(LAS bf16_t*)(SL + RC_AT + t * 136 + lane * 2) = f2bf(at); *(LAS bf16_t*)(SL + RC_RT + t * 136 + lane * 2) = f2bf(rt);
                        *(LAS bf16_t*)(SC + t * 136 + lane * 2) = f2bf(bt); *(LAS bf16_t*)(SC + 2176 + t * 136 + lane * 2) = f2bf(kt);
                        btv[s] = bt; ktv[s] = kt;
                    }
#pragma unroll
                    for (int s = 0; s < 4; ++s) { btp[4 * hb + s] = cvt_pk_bf16(btv[2 * s], btv[2 * s + 1]); ktp[4 * hb + s] = cvt_pk_bf16(ktv[2 * s], ktv[2 * s + 1]); }
                }
                {
                    LAS u32x2* bq = (LAS u32x2*)(SL + RC_BTT + lane * 40); LAS u32x2* kq2 = (LAS u32x2*)(SL + RC_KTT + lane * 40);
#pragma unroll
                    for (int q = 0; q < 4; ++q) { bq[q] = (u32x2){btp[2 * q], btp[2 * q + 1]}; kq2[q] = (u32x2){ktp[2 * q], ktp[2 * q + 1]}; }
                    *(LAS float*)(SL + RC_WC + lane * 4) = Wp;
                    u32x2 vt; vt.x = (unsigned)vq[0] | ((unsigned)vq[1] << 16); vt.y = (unsigned)vq[2] | ((unsigned)vq[3] << 16);
                    *(LAS u32x2*)(SL + RC_VTF + lane * 8) = vt;
                }
                if (n + 7 < RC_NCH) RC_LOADS(n + 7);
                asm volatile("s_waitcnt lgkmcnt(0)" ::: "memory");
                f32x4 G1 = {0.f, 0.f, 0.f, 0.f}, G2 = G1, G3 = G1, G4 = G1, G1t = G1;
#pragma unroll
                for (int ks = 0; ks < 2; ++ks) {
                    const bf16x8 fb = *(const LAS bf16x8*)(SC + l15 * 136 + (32 * ks + 8 * kg) * 2), fk = *(const LAS bf16x8*)(SC + 2176 + l15 * 136 + (32 * ks + 8 * kg) * 2);
                    const bf16x8 fa = *(const LAS bf16x8*)(SL + RC_AT + l15 * 136 + (32 * ks + 8 * kg) * 2), fr_ = *(const LAS bf16x8*)(SL + RC_RT + l15 * 136 + (32 * ks + 8 * kg) * 2);
                    G1 = __builtin_amdgcn_mfma_f32_16x16x32_bf16(fb, fa, G1, 0, 0, 0); G2 = __builtin_amdgcn_mfma_f32_16x16x32_bf16(fk, fa, G2, 0, 0, 0);
                    G1t = __builtin_amdgcn_mfma_f32_16x16x32_bf16(fa, fb, G1t, 0, 0, 0);
                    G3 = __builtin_amdgcn_mfma_f32_16x16x32_bf16(fb, fr_, G3, 0, 0, 0); G4 = __builtin_amdgcn_mfma_f32_16x16x32_bf16(fk, fr_, G4, 0, 0, 0);
                }
                {
#pragma unroll
                    for (int e = 0; e < 4; ++e) { const int s = 4 * kg + e; const bool lt = s < l15, le = s <= l15;
                        G1[e] = lt ? G1[e] : 0.f; G1t[e] = (l15 < s) ? G1t[e] : 0.f; G2[e] = lt ? G2[e] : 0.f; G3[e] = le ? G3[e] : 0.f; G4[e] = le ? G4[e] : 0.f; }
                    u32x2 g2, g3, g4; g2.x = cvt_pk_bf16(G2.x, G2.y); g2.y = cvt_pk_bf16(G2.z, G2.w); g3.x = cvt_pk_bf16(G3.x, G3.y); g3.y = cvt_pk_bf16(G3.z, G3.w); g4.x = cvt_pk_bf16(G4.x, G4.y); g4.y = cvt_pk_bf16(G4.z, G4.w);
                    *(LAS u32x2*)(SL + RC_G3F + lane * 8) = g3;
                    u32x2 vt; vt.x = (unsigned)vq[0] | ((unsigned)vq[1] << 16); vt.y = (unsigned)vq[2] | ((unsigned)vq[3] << 16);
                    const s16x4v vtf = *reinterpret_cast<s16x4v*>(&vt);
                    f32x4 P1 = {0.f, 0.f, 0.f, 0.f}, P2 = P1;
                    P1 = __builtin_amdgcn_mfma_f32_16x16x16bf16_1k(*reinterpret_cast<s16x4v*>(&g2), vtf, P1, 0, 0, 0);
                    P2 = __builtin_amdgcn_mfma_f32_16x16x16bf16_1k(*reinterpret_cast<s16x4v*>(&g4), vtf, P2, 0, 0, 0);
                    *(LAS f32x4*)(SL + RC_P1 + lane * 16) = P1; *(LAS f32x4*)(SL + RC_P2 + lane * 16) = P2;
#define RC_BF(v) ({ u32x2 t_; t_.x = cvt_pk_bf16((v).x, (v).y); t_.y = cvt_pk_bf16((v).z, (v).w); *reinterpret_cast<s16x4v*>(&t_); })
                    const f32x4 Z4 = {0.f, 0.f, 0.f, 0.f};
                    const s16x4v n1 = RC_BF(G1), n1t = RC_BF(G1t);
                    const f32x4 X2 = __builtin_amdgcn_mfma_f32_16x16x16bf16_1k(n1t, n1, Z4, 0, 0, 0), X2t = __builtin_amdgcn_mfma_f32_16x16x16bf16_1k(n1, n1t, Z4, 0, 0, 0);
                    const s16x4v n2 = RC_BF(X2), n2t = RC_BF(X2t);
                    const f32x4 X4 = __builtin_amdgcn_mfma_f32_16x16x16bf16_1k(n2t, n2, Z4, 0, 0, 0), X4t = __builtin_amdgcn_mfma_f32_16x16x16bf16_1k(n2, n2t, Z4, 0, 0, 0);
                    const s16x4v n4 = RC_BF(X4), n4t = RC_BF(X4t);
                    f32x4 Tm = __builtin_amdgcn_mfma_f32_16x16x16bf16_1k(n4t, n4, Z4, 0, 0, 0);
#pragma unroll
                    for (int e = 0; e < 4; ++e) Tm[e] += (4 * kg + e == l15) ? 1.f : 0.f;
                    Tm = __builtin_amdgcn_mfma_f32_16x16x16bf16_1k(n4t, RC_BF(Tm), Tm, 0, 0, 0);
                    Tm = __builtin_amdgcn_mfma_f32_16x16x16bf16_1k(n2t, RC_BF(Tm), Tm, 0, 0, 0);
                    Tm = __builtin_amdgcn_mfma_f32_16x16x16bf16_1k(n1t, RC_BF(Tm), Tm, 0, 0, 0);
                    { u32x2 tt; tt.x = cvt_pk_bf16(Tm.x, Tm.y); tt.y = cvt_pk_bf16(Tm.z, Tm.w); *(LAS u32x2*)(SL + RC_TT + lane * 8) = tt; }
#undef RC_BF
                }
                asm volatile("s_waitcnt lgkmcnt(0)" ::: "memory");
#if RC_SYNC
                __builtin_amdgcn_s_barrier();
#else
                if (lane == 0) flags[slot] = (unsigned)(n + 1);
#endif
            }
#if RC_SYNC
            if (p >= RC_NCH % 7) { __builtin_amdgcn_s_barrier(); __builtin_amdgcn_s_barrier(); }
#endif
        }
#undef RC_LOADS
        __syncthreads();
    }
}
__device__ __forceinline__ void rwkv_post(const Fr& F) {
    const bf16_t* Rr = slotY(F, 0); const bf16_t* K = slotY(F, 1); const bf16_t* V = slotY(F, 2); const bf16_t* GT = slotY(F, 3); const bf16_t* A = slotY(F, 5);
    const float* O32 = (const float*)slotU(F, 1); bf16_t* Z = slotU(F, 0);
    const float* k_a = F.in(24); const float* r_k = F.in(25); const float* lw = F.in(26); const float* lb = F.in(27);
    for (int r = F.gw; r < R; r += F.NGW) {
        const bool real = (r >= NPAD && r < NREAL);
        u32x2* zr = (u32x2*)(Z + (size_t)r * D) + F.lane;
        if (!real) { const u32x2 z = {0u, 0u};
#pragma unroll
            for (int it = 0; it < 16; ++it) zr[64 * it] = z;
            continue; }
        ROW_F32(oq, O32 + (size_t)r * D, F.lane); ROW_BF(rq_, Rr + (size_t)r * D, F.lane); ROW_BF(kq_, K + (size_t)r * D, F.lane); ROW_BF(vq_, V + (size_t)r * D, F.lane);
        ROW_BF(gq_, GT + (size_t)r * D, F.lane); ROW_BF(aq_, A + (size_t)r * D, F.lane); ROW_BF(zq_, Z + (size_t)r * D, F.lane);
        ROW_F32(kap, k_a, F.lane); ROW_F32(rkp, r_k, F.lane); ROW_F32(lwp, lw, F.lane); ROW_F32(lbp, lb, F.lane);
#pragma unroll
        for (int hh = 0; hh < 2; ++hh) {
            f32x4 o4v[8]; u32x2 rrv[8], kkv[8], vvv[8], ggv[8], aav[8];
#pragma unroll
            for (int i8 = 0; i8 < 8; ++i8) { const int it = 8 * hh + i8; o4v[i8] = AT_F32(oq, it); rrv[i8] = AT_BF(rq_, it); kkv[i8] = AT_BF(kq_, it); vvv[i8] = AT_BF(vq_, it); ggv[i8] = AT_BF(gq_, it); aav[i8] = AT_BF(aq_, it); }
#pragma unroll
            for (int i8 = 0; i8 < 8; ++i8) { const int it = 8 * hh + i8;
                const f32x4 o4 = o4v[i8]; const u32x2 rr = rrv[i8], kk = kkv[i8], vv = vvv[i8], gg = ggv[i8], aa = aav[i8];
                const f32x4 ka4 = AT_F32(kap, it), rk4 = AT_F32(rkp, it), lw4 = AT_F32(lwp, it), lb4 = AT_F32(lbp, it);
                const float mean = red16((o4.x + o4.y) + (o4.z + o4.w)) * (1.f / 64.f);
                const float d0 = o4.x - mean, d1 = o4.y - mean, d2 = o4.z - mean, d3 = o4.w - mean;
                const float var = red16((d0 * d0 + d1 * d1) + (d2 * d2 + d3 * d3)) * (1.f / 64.f);
                const float rs = __builtin_amdgcn_rsqf(var + 64e-5f);
                const float r0 = bflo(rr.x), r1 = bfhi(rr.x), r2 = bflo(rr.y), r3 = bfhi(rr.y);
                const float kp0 = bflo(kk.x) * (1.f + (bflo(aa.x) - 1.f) * ka4.x), kp1 = bfhi(kk.x) * (1.f + (bfhi(aa.x) - 1.f) * ka4.y), kp2 = bflo(kk.y) * (1.f + (bflo(aa.y) - 1.f) * ka4.z), kp3 = bfhi(kk.y) * (1.f + (bfhi(aa.y) - 1.f) * ka4.w);
                const float bs = red16((r0 * kp0 * rk4.x + r1 * kp1 * rk4.y) + (r2 * kp2 * rk4.z + r3 * kp3 * rk4.w));
                const float y0 = d0 * rs * lw4.x + lb4.x + bs * bflo(vv.x), y1 = d1 * rs * lw4.y + lb4.y + bs * bfhi(vv.x), y2 = d2 * rs * lw4.z + lb4.z + bs * bflo(vv.y), y3 = d3 * rs * lw4.w + lb4.w + bs * bfhi(vv.y);
                u32x2 w; w.x = cvt_pk_bf16(y0 * silu_f(bflo(gg.x)), y1 * silu_f(bfhi(gg.x))); w.y = cvt_pk_bf16(y2 * silu_f(bflo(gg.y)), y3 * silu_f(bfhi(gg.y)));
                AT_BF(zq_, it) = w;
            }
        }
    }
}
}
namespace mk {
constexpr int LDS_BYTES = 163840;
constexpr int LDS_MISC = LDS_BYTES - 128;
struct Args { const float* in[29]; float* out; unsigned char* ws; };

#define MK_GEMM(EPI, e, Aptr, aps_, Bptr, M_, N_, K_) do { int kk_ = (K_); asm volatile("" : "+s"(kk_));     \
    pg8::Gemm g_{(const bf16_t*)(Aptr), (const bf16_t*)(Bptr), (M_), (N_), kk_, (size_t)(aps_)}; pg8::StaticOrder S_; S_.init((M_), (N_), F.G, F.bid); \
    pg8::gemm_phase<EPI, pg8::StaticOrder, false>(F.lds, g_, S_, e, nullptr); } while (0)

struct TailOrder { int pn;
    __device__ bool next(int i, pg8::Unit& u) const { if (i > 0 || pn < 0) return false; u.pm = 64; u.pn = pn; return true; }
    __device__ __forceinline__ void a_ready(const pg8::Unit&) const {}
    __device__ __forceinline__ void done(const pg8::Unit&) const {}
};
struct RwTail { int pm, pn;
    __device__ bool next(int i, pg8::Unit& u) const { if (i > 0) return false; u.pm = pm; u.pn = pn; return true; }
    __device__ __forceinline__ void a_ready(const pg8::Unit&) const {}
    __device__ __forceinline__ void done(const pg8::Unit&) const {}
};
#define MK_GEMM1(EPI, e, aps_, NTOT_, L_) do { MK_GEMM(EPI, e, slotU(F, 0), aps_, wtin_of(F, L_), 16384, NTOT_, D); \
    if (F.bid < (NTOT_) / 256) { int kk_ = D; asm volatile("" : "+s"(kk_)); pg8::Gemm g_{(const bf16_t*)slotU(F, 0), (const bf16_t*)wtin_of(F, L_), R, (NTOT_), kk_, (size_t)(aps_)}; TailOrder St_{F.bid}; \
        pg8::gemm_phase<EPI, TailOrder, false, true>(F.lds, g_, St_, e, nullptr); } } while (0)
#define MK_GEMM2_NORM(prev, next, udst) do { \
    MK_GEMM(EpiY, ey, slotU(F, 0), 0, wtout, 16384, D, D); \
    GRID_BAR(); \
    if (F.bid < 16) { int kk_ = D; asm volatile("" : "+s"(kk_)); pg8::Gemm g_{(const bf16_t*)slotU(F, 0), (const bf16_t*)wtout, R, D, kk_, (size_t)0}; TailOrder St_{F.bid}; \
        pg8::gemm_phase<EpiY, TailOrder, false, true>(F.lds, g_, St_, ey, nullptr); } \
    else { const Fr P = F.fresh(); norm_phase(P, prev, next, slotY(P, 0), udst, 0, 16384, 16); } \
    GRID_BAR(); \
    { const Fr P = F.fresh(); norm_phase(P, prev, next, slotY(P, 0), udst, 16384, R, 0); if ((next) >= 0) convert_layer(P, next, (next) == 3); } \
    GRID_BAR(); } while (0)

__global__ void __launch_bounds__(512, 2) fwd(Args a) {
    extern __shared__ __attribute__((aligned(16))) unsigned char lds_raw[];
    Fr F;
    F.lds = (LAS unsigned char*)lds_raw; F.ldsg = lds_raw;
    F.tid = threadIdx.x; F.lane = F.tid & 63; F.wave = __builtin_amdgcn_readfirstlane(F.tid >> 6);
    F.G = gridDim.x; F.bid = blockIdx.x; F.gw = F.bid * 8 + F.wave; F.NGW = F.G * 8;
    F.out = a.out; F.ws = a.ws;
    volatile LAS unsigned* misc = (volatile LAS unsigned*)(F.lds + LDS_MISC);
    if (F.tid < 16) misc[F.tid] = 0u;
    __syncthreads();
    XcdBarrier bar = xcd_barrier_post((unsigned*)(F.ws + WS_CTL) + 4096, misc + 8);
#ifdef MK_BAR2
#define GRID_BAR() do { xcd_barrier(bar); xcd_barrier(bar); } while (0)
#else
#define GRID_BAR() xcd_barrier(bar)
#endif
#ifndef MK_DUP
#define MK_DUP 0
#endif
#ifndef MK_CLK
#define MK_CLK 0
#endif
#define CLK_SPIN() do { const unsigned long long dc_ = clock64() - clk_c0, dr_ = wall_clock64() - clk_r0; const long mhz_ = (long)(dc_ * 100ull / (dr_ ? dr_ : 1ull)); \
        const long ticks_ = (2400 - mhz_) * 200; const unsigned long long r1_ = wall_clock64(); while ((long)(wall_clock64() - r1_) < ticks_) __builtin_amdgcn_s_sleep(8); } while (0)
#ifndef MK_PH
#define MK_PH 0
#endif
    unsigned long long ph_r0_ = 0ull;
#define PH_BEGIN(id) do { if ((MK_PH >> (id)) & 1) ph_r0_ = wall_clock64(); } while (0)
#define PH_END(id) do { if ((MK_PH >> (id)) & 1) { const unsigned long long dr_ = wall_clock64() - ph_r0_, r1_ = wall_clock64(); while ((unsigned long long)(wall_clock64() - r1_) < dr_) __builtin_amdgcn_s_sleep(8); } } while (0)
#define DUPN(k, ...) do { __VA_ARGS__; if ((MK_DUP >> (k)) & 1) { GRID_BAR(); __VA_ARGS__; } } while (0)
    bf16_t* wtout = (bf16_t*)(F.ws + WS_WTOUT);
    const EpiY ey{slotY(F, 0)};

    PH_BEGIN(1);
    DUPN(11, { const Fr P = F.fresh(); convert_layer(P, 0, true); rope_table(P); norm_phase(P, -1, 0, nullptr, slotU(P, 0)); });
    PH_END(1);
    GRID_BAR();
#if MK_CLK == 1 || MK_CLK == 11
    const unsigned long long clk_c0 = clock64(), clk_r0 = wall_clock64();
#endif
    PH_BEGIN(15);
    { const EpiH1 e{slotY(F, 0), F.in(5), 0}; MK_GEMM1(EpiH1, e, 0, 4 * D, 0); }
#if MK_CLK == 1
    CLK_SPIN();
#endif
#if MK_CLK == 11
    { const unsigned long long dr_ = wall_clock64() - clk_r0, r1_ = wall_clock64(); while ((unsigned long long)(wall_clock64() - r1_) < dr_) __builtin_amdgcn_s_sleep(8); }
#endif
#if defined(MK_KPROBE) && !defined(MK_KPROBE_L1)
    { __syncthreads(); const unsigned kc_ = misc[20]; const unsigned long long r1_ = wall_clock64(); while ((unsigned long long)(wall_clock64() - r1_) < (unsigned long long)kc_) __builtin_amdgcn_s_sleep(8); }
#endif
    if (F.bid >= 64) { const Fr P = F.fresh(); convert_win(P, 1, 64); }
    PH_END(15);
    GRID_BAR();
    PH_BEGIN(13);
    DUPN(1, { const Fr P = F.fresh(); hgrn_phase<false>(P, 0); });
    PH_END(13);
    GRID_BAR();
    PH_BEGIN(14);
    DUPN(2, { const Fr P = F.fresh(); hgrn_phase<true>(P, 0); });
    PH_END(14);
    GRID_BAR();
    PH_BEGIN(2);
    MK_GEMM2_NORM(0, 1, slotU(F, 0));
    PH_END(2);
    PH_BEGIN(16);
    { const EpiB1 e{slotY(F, 0), (const float*)(F.ws + WS_ROPE), (const float*)(F.ws + WS_ROPE) + (size_t)R * 16}; PH_BEGIN(20); MK_GEMM1(EpiB1, e, 0, 4 * D, 1); PH_END(20); }
    PH_BEGIN(21);
#ifdef MK_KPROBE_L1
    { __syncthreads(); const unsigned kc_ = misc[20]; const unsigned long long r1_ = wall_clock64(); while ((unsigned long long)(wall_clock64() - r1_) < (unsigned long long)kc_) __builtin_amdgcn_s_sleep(8); }
#endif
    if (F.bid >= 64) { const Fr P = F.fresh(); convert_win(P, 2, 64); }
    PH_END(21);
    PH_END(16);
    GRID_BAR();
#if MK_CLK == 3
    const unsigned long long clk_c0 = clock64(), clk_r0 = wall_clock64();
#endif
    PH_BEGIN(6);
    DUPN(3, { const Fr P = F.fresh(); attn_phase(P); });
    PH_END(6);
#if MK_CLK == 3
    CLK_SPIN();
#endif
    GRID_BAR();
    PH_BEGIN(7);
    DUPN(4, { const Fr P = F.fresh(); attn_post(P); });
    PH_END(7);
    GRID_BAR();
    PH_BEGIN(3);
    MK_GEMM2_NORM(1, 2, slotY(F, 1));
    PH_END(3);
    PH_BEGIN(8);
    DUPN(7, { const Fr P = F.fresh(); mix_phase(P, slotY(P, 1)); convert_layer2_b(P); });
    PH_END(8);
    GRID_BAR();
    PH_BEGIN(9);
    { const EpiC1 e{slotY(F, 0), (bf16_t*)(F.ws + WS_T)}; MK_GEMM(EpiC1, e, slotU(F, 0), (size_t)R * D, wtin_of(F, 2), 16384, 4 * D, D);
      if (F.bid < 194) { int kk_ = D; asm volatile("" : "+s"(kk_)); pg8::Gemm g_{(const bf16_t*)slotU(F, 0), (const bf16_t*)wtin_of(F, 2), R, 4 * D + 512, kk_, (size_t)R * D};
          if (F.bid < 64) { RwTail St_{64, F.bid}; pg8::gemm_phase<EpiC1, RwTail, false, true, false>(F.lds, g_, St_, e, nullptr); }
          else if (F.bid < 192) { RwTail St_{(F.bid - 64) >> 1, 64 + ((F.bid - 64) & 1)}; pg8::gemm_phase<EpiC1, RwTail, false, false, true>(F.lds, g_, St_, e, nullptr); }
          else { RwTail St_{64, 64 + (F.bid - 192)}; pg8::gemm_phase<EpiC1, RwTail, false, true, true>(F.lds, g_, St_, e, nullptr); } } }
    PH_END(9);
    GRID_BAR();
    PH_BEGIN(10);
    DUPN(9, { const Fr P = F.fresh(); lora2_phase(P); });
    { const Fr P = F.fresh(); rwkv_kknorm(P); }
    PH_END(10);
    GRID_BAR();
    PH_BEGIN(11);
    DUPN(5, { const Fr P = F.fresh(); rwkv_scan(P); });
    PH_END(11);
    GRID_BAR();
    PH_BEGIN(12);
    DUPN(6, { const Fr P = F.fresh(); rwkv_post(P); });
    PH_END(12);
    GRID_BAR();
    PH_BEGIN(4);
    MK_GEMM2_NORM(2, 3, slotU(F, 0));
    PH_END(4);
    PH_BEGIN(17);
    { const EpiH1 e{slotY(F, 0), F.in(5), 1}; MK_GEMM1(EpiH1, e, 0, 4 * D, 3); }
    if (F.bid >= 64) { const Fr P = F.fresh(); convert_wout3(P, 64); }
    PH_END(17);
    GRID_BAR();
    PH_BEGIN(18);
    { const Fr P = F.fresh(); hgrn_phase<false>(P, 1); }
    PH_END(18);
    GRID_BAR();
    PH_BEGIN(19);
    { const Fr P = F.fresh(); hgrn_phase<true>(P, 1); }
    PH_END(19);
    GRID_BAR();
    PH_BEGIN(5);
    MK_GEMM2_NORM(3, -1, (bf16_t*)nullptr);
    PH_END(5);
}
}

extern "C" void kernel_launch(void* const* d_in, const int* in_sizes, int n_in, void* d_out, int out_size, void* d_ws, size_t ws_size, hipStream_t stream) {
    static int grid = 0;
    if (grid == 0) {
        if (n_in != 29 || out_size != 16384 * 4096 || ws_size < mk::WS_END) { fprintf(stderr, "kernel_launch: unexpected shapes (n_in %d out %d ws %zu need %zu)\n", n_in, out_size, ws_size, (size_t)mk::WS_END); grid = -1; return; }
        int dev = 0, cus = 0, per_cu = 0;
        if (hipGetDevice(&dev) != hipSuccess || hipDeviceGetAttribute(&cus, hipDeviceAttributeMultiprocessorCount, dev) != hipSuccess) { grid = -1; return; }
        if (hipFuncSetAttribute((const void*)mk::fwd, hipFuncAttributeMaxDynamicSharedMemorySize, mk::LDS_BYTES) != hipSuccess) { fprintf(stderr, "kernel_launch: hipFuncSetAttribute failed\n"); grid = -1; return; }
        if (hipOccupancyMaxActiveBlocksPerMultiprocessor(&per_cu, (const void*)mk::fwd, 512, mk::LDS_BYTES) != hipSuccess || per_cu < 1) { fprintf(stderr, "kernel_launch: occupancy query says %d\n", per_cu); }
        (void)hipGetLastError();
        grid = cus;
    }
    if (grid < 0) return;
    if (hipMemsetAsync((char*)d_ws + mk::WS_CTL, 0, mk::CTL_BYTES, stream) != hipSuccess) return;
    mk::Args a{};
    for (int i = 0; i < 29; ++i) a.in[i] = (const float*)d_in[i];
    a.out = (float*)d_out; a.ws = (unsigned char*)d_ws;
    hipLaunchKernelGGL(mk::fwd, dim3(grid), dim3(512), mk::LDS_BYTES, stream, a);
}
```
